# Optimizing an MI355X kernel written in HIP

```python
import jax, jax.numpy as jnp
from jax import lax
import numpy as np

D_MODEL = 1024
BATCH = 8
SEQ = 2048
DEPTH = 4

CHUNK = 64
Q_BLOCK = 128
N_MIXERS = 3
N_FOX = (DEPTH + 2) // 3
N_GLA = (DEPTH + 1) // 3
N_HGRN = DEPTH // 3
EPS = 1e-6

FOX_HEADS = 16
FOX_HEAD_DIM = D_MODEL // FOX_HEADS
FOX_IN = 4 * D_MODEL + FOX_HEADS

GLA_HEADS = 4
GLA_DK = D_MODEL // 2 // GLA_HEADS
GLA_DV = D_MODEL // GLA_HEADS
GLA_RANK = 16
GLA_TAU = 16.0
GLA_IN = 2 * GLA_HEADS * GLA_DK + 2 * D_MODEL + GLA_RANK

HGRN_EXPAND = 128
HGRN_HEADS = D_MODEL // HGRN_EXPAND
HGRN_DV = D_MODEL // HGRN_HEADS
HGRN_IN = 4 * D_MODEL

PEER_HEADS = 8
PEER_NKEYS = 128
PEER_EXPERTS = PEER_NKEYS * PEER_NKEYS
PEER_DQ = 256
PEER_TOPK = 16
PEER_TOKEN_BLOCK = 128

kernel_name = "hybrid_fox_gla_hgrn2_peer_trunk"


def rms_norm(x, g):
    xf = x.astype(jnp.float32)
    y = xf * lax.rsqrt(jnp.mean(xf * xf, axis=-1, keepdims=True) + EPS)
    return (y * g.astype(jnp.float32)).astype(x.dtype)


def to_heads(a, n_heads):
    B, T, W = a.shape
    return a.reshape(B, T, n_heads, W // n_heads).transpose(0, 2, 1, 3)


def from_heads(a):
    B, H, T, d = a.shape
    return a.transpose(0, 2, 1, 3).reshape(B, T, H * d)


def forgetting_attention(q, k, v, log_f):
    B, H, T, d = q.shape
    c = jnp.cumsum(log_f, axis=-1)
    scale = d ** -0.5
    outs = []
    for i in range(T // Q_BLOCK):
        lo, hi = i * Q_BLOCK, (i + 1) * Q_BLOCK
        s = jnp.einsum('bhqd,bhkd->bhqk', q[:, :, lo:hi], k[:, :, :hi]).astype(jnp.float32) * scale
        s = s + (c[:, :, lo:hi, None] - c[:, :, None, :hi])
        mask = (lo + jnp.arange(Q_BLOCK))[:, None] >= jnp.arange(hi)[None, :]
        p = jax.nn.softmax(jnp.where(mask, s, -jnp.inf), axis=-1)
        outs.append(jnp.einsum('bhqk,bhkd->bhqd', p.astype(v.dtype), v[:, :, :hi]))
    return jnp.concatenate(outs, axis=2)


def chunked_gated_linear_attention(q, k, v, log_g):
    B, H, T, dk = q.shape
    dv = v.shape[-1]
    n = T // CHUNK

    def to_chunks(a):
        return a.astype(jnp.float32).reshape(B, H, n, CHUNK, a.shape[-1]).transpose(2, 0, 1, 3, 4)

    causal = jnp.tril(jnp.ones((CHUNK, CHUNK), dtype=bool))[:, :, None]

    def step(S, inp):
        qc, kc, vc, gc = inp
        b = jnp.cumsum(gc, axis=2)
        diff = b[:, :, :, None, :] - b[:, :, None, :, :]
        decay = jnp.where(causal, jnp.exp(jnp.where(causal, diff, 0.0)), 0.0)
        scores = jnp.einsum('bhtd,bhsd,bhtsd->bhts', qc, kc, decay)
        o = jnp.einsum('bhts,bhsv->bhtv', scores, vc) + jnp.einsum('bhtd,bhdv->bhtv', qc * jnp.exp(b), S)
        b_end = b[:, :, -1:, :]
        S = S * jnp.exp(b_end[:, :, 0, :, None]) + jnp.einsum('bhsd,bhsv->bhdv', kc * jnp.exp(b_end - b), vc)
        return S, o

    S0 = jnp.zeros((B, H, dk, dv), jnp.float32)
    _, o = lax.scan(step, S0, (to_chunks(q), to_chunks(k), to_chunks(v), to_chunks(log_g)))
    return o.transpose(1, 2, 0, 3, 4).reshape(B, H, T, dv).astype(v.dtype)


def fox_mixer(x, w_in, b_f, q_gain, k_gain, w_out):
    proj = x @ w_in
    q, k, v, g, f = jnp.split(proj, [D_MODEL, 2 * D_MODEL, 3 * D_MODEL, 4 * D_MODEL], axis=-1)
    q = rms_norm(to_heads(q, FOX_HEADS), q_gain)
    k = rms_norm(to_heads(k, FOX_HEADS), k_gain)
    log_f = jax.nn.log_sigmoid((f + b_f).astype(jnp.float32)).transpose(0, 2, 1)
    o = forgetting_attention(q, k, to_heads(v, FOX_HEADS), log_f)
    o = o * jax.nn.sigmoid(to_heads(g, FOX_HEADS))
    return from_heads(o) @ w_out


def gla_mixer(x, w_in, w_up, b_alpha, out_gain, w_out):
    gk = GLA_HEADS * GLA_DK
    proj = x @ w_in
    q, k, v, r, low = jnp.split(proj, [gk, 2 * gk, 2 * gk + D_MODEL, 2 * gk + 2 * D_MODEL], axis=-1)
    log_a = jax.nn.log_sigmoid((low @ w_up + b_alpha).astype(jnp.float32)) / GLA_TAU
    o = chunked_gated_linear_attention(to_heads(q, GLA_HEADS) * (GLA_DK ** -0.5), to_heads(k, GLA_HEADS),
                                       to_heads(v, GLA_HEADS), to_heads(log_a, GLA_HEADS))
    o = rms_norm(o, out_gain[:, None, :]) * jax.nn.silu(to_heads(r, GLA_HEADS))
    return from_heads(o) @ w_out


def hgrn2_mixer(x, w_in, lb, out_gain, w_out):
    proj = x @ w_in
    q, f, i, g = jnp.split(proj, 4, axis=-1)
    gate = lb + (1.0 - lb) * jax.nn.sigmoid(f.astype(jnp.float32))
    k = 1.0 - gate
    o = chunked_gated_linear_attention(to_heads(q, HGRN_HEADS) * (HGRN_EXPAND ** -0.5), to_heads(k, HGRN_HEADS),
                                       to_heads(i, HGRN_HEADS), to_heads(jnp.log(gate), HGRN_HEADS))
    o = rms_norm(o, out_gain[:, None, :]) * jax.nn.silu(to_heads(g, HGRN_HEADS))
    return from_heads(o) @ w_out


def peer_mixer(x, w_q, sub_keys, u, v):
    B, T, D = x.shape
    N = B * T
    xt = x.reshape(N, D)
    q = (xt @ w_q).reshape(N, PEER_HEADS, 2, PEER_DQ // 2)
    s = jnp.einsum('nhpd,hpkd->nhpk', q, sub_keys).astype(jnp.float32)
    s_top, i_top = lax.top_k(s, PEER_TOPK)
    cand = (s_top[:, :, 0, :, None] + s_top[:, :, 1, None, :]).reshape(N, PEER_HEADS, PEER_TOPK * PEER_TOPK)
    cand_idx = (i_top[:, :, 0, :, None] * PEER_NKEYS + i_top[:, :, 1, None, :]).reshape(N, PEER_HEADS, PEER_TOPK * PEER_TOPK)
    best, pos = lax.top_k(cand, PEER_TOPK)
    experts = jnp.take_along_axis(cand_idx, pos, axis=-1)
    gates = jax.nn.softmax(best, axis=-1)
    n_blk = N // PEER_TOKEN_BLOCK

    def apply(args):
        xb, eb, gb = args
        h = jax.nn.gelu(jnp.einsum('tpkd,td->tpk', u[eb], xb).astype(jnp.float32), approximate=False)
        return jnp.einsum('tpk,tpkd->td', (gb * h).astype(v.dtype), v[eb])

    y = lax.map(apply, (xt.reshape(n_blk, PEER_TOKEN_BLOCK, D),
                        experts.reshape(n_blk, PEER_TOKEN_BLOCK, PEER_HEADS, PEER_TOPK),
                        gates.reshape(n_blk, PEER_TOKEN_BLOCK, PEER_HEADS, PEER_TOPK)))
    return y.reshape(B, T, D)


def setup_inputs(seed: int = 0) -> dict:
    key = jax.random.key(seed)
    ks = jax.random.split(key, 24)
    nrm = jax.random.normal
    D = D_MODEL
    f32 = jnp.float32
    return {
        "x": nrm(ks[0], (BATCH, SEQ, D), f32),
        "norm_mix": 1.0 + 0.05 * nrm(ks[1], (DEPTH, D), f32),
        "norm_ffn": 1.0 + 0.05 * nrm(ks[2], (DEPTH, D), f32),
        "fox_w_in": nrm(ks[3], (N_FOX, D, FOX_IN), f32) * D ** -0.5,
        "fox_b_f": 2.0 + 0.5 * nrm(ks[4], (N_FOX, FOX_HEADS), f32),
        "fox_q_gain": 1.0 + 0.05 * nrm(ks[5], (N_FOX, FOX_HEAD_DIM), f32),
        "fox_k_gain": 1.0 + 0.05 * nrm(ks[6], (N_FOX, FOX_HEAD_DIM), f32),
        "fox_w_out": nrm(ks[7], (N_FOX, D, D), f32) * D ** -0.5,
        "gla_w_in": nrm(ks[8], (N_GLA, D, GLA_IN), f32) * D ** -0.5,
        "gla_w_up": nrm(ks[9], (N_GLA, GLA_RANK, GLA_HEADS * GLA_DK), f32) * GLA_RANK ** -0.5,
        "gla_b_alpha": 0.1 * nrm(ks[10], (N_GLA, GLA_HEADS * GLA_DK), f32),
        "gla_out_gain": 1.0 + 0.05 * nrm(ks[11], (N_GLA, GLA_HEADS, GLA_DV), f32),
        "gla_w_out": nrm(ks[12], (N_GLA, D, D), f32) * D ** -0.5,
        "hgrn_w_in": nrm(ks[13], (N_HGRN, D, HGRN_IN), f32) * D ** -0.5,
        "hgrn_lb_logits": 0.5 * nrm(ks[14], (DEPTH, D), f32),
        "hgrn_out_gain": 1.0 + 0.05 * nrm(ks[15], (N_HGRN, HGRN_HEADS, HGRN_DV), f32),
        "hgrn_w_out": nrm(ks[16], (N_HGRN, D, D), f32) * D ** -0.5,
        "peer_w_q": nrm(ks[17], (DEPTH, D, PEER_HEADS * PEER_DQ), f32) * D ** -0.5,
        "peer_sub_keys": nrm(ks[18], (DEPTH, PEER_HEADS, 2, PEER_NKEYS, PEER_DQ // 2), f32) * (PEER_DQ // 2) ** -0.5,
        "peer_u": nrm(ks[19], (DEPTH, PEER_EXPERTS, D), f32) * D ** -0.5,
        "peer_v": nrm(ks[20], (DEPTH, PEER_EXPERTS, D), f32) * (PEER_HEADS * PEER_TOPK) ** -0.5,
    }


def reference(x, norm_mix, norm_ffn, fox_w_in, fox_b_f, fox_q_gain, fox_k_gain, fox_w_out,
              gla_w_in, gla_w_up, gla_b_alpha, gla_out_gain, gla_w_out,
              hgrn_w_in, hgrn_lb_logits, hgrn_out_gain, hgrn_w_out,
              peer_w_q, peer_sub_keys, peer_u, peer_v):
    p = jax.nn.softmax(hgrn_lb_logits.astype(jnp.float32), axis=0)
    lower_bounds = jnp.cumsum(p, axis=0) - p[0:1]
    h = x
    for i in range(DEPTH):
        m, j = i % N_MIXERS, i // N_MIXERS
        hn = rms_norm(h, norm_mix[i])
        if m == 0:
            y = fox_mixer(hn, fox_w_in[j], fox_b_f[j], fox_q_gain[j], fox_k_gain[j], fox_w_out[j])
        elif m == 1:
            y = gla_mixer(hn, gla_w_in[j], gla_w_up[j], gla_b_alpha[j], gla_out_gain[j], gla_w_out[j])
        else:
            y = hgrn2_mixer(hn, hgrn_w_in[j], lower_bounds[i], hgrn_out_gain[j], hgrn_w_out[j])
        h = h + y.astype(h.dtype)
        h = h + peer_mixer(rms_norm(h, norm_ffn[i]), peer_w_q[i], peer_sub_keys[i], peer_u[i], peer_v[i]).astype(h.dtype)
    return h
```

```cpp
#include <hip/hip_runtime.h>
#include <hip/hip_cooperative_groups.h>
#include <cstdio>
#include <cstdint>
#include <cmath>
namespace pg8 {
#define PG8_LAS __attribute__((address_space(3)))
typedef unsigned short bf16_t;
typedef short bf16x8 __attribute__((ext_vector_type(8)));
typedef float f32x4 __attribute__((ext_vector_type(4)));
typedef unsigned u32x4 __attribute__((ext_vector_type(4)));
constexpr int BM = 256, BK = 64, HALF = 128, HTB = HALF * BK * 2  , STAGE_BYTES = 8 * HTB, NXCD = 8, WGM = 8;

__host__ __device__ __forceinline__ int lds_byte(int r, int c) { const int st = (r >> 4) * 2 + (c >> 5), rr = r & 15, cc = c & 31, ob = rr * 64 + cc * 2; return st * 1024 + (ob ^ (((ob >> 9) & 1) << 5)); }
__host__ __device__ __forceinline__ void stage_rc(int b, int& R, int& C) { const int st = b / 1024, sb = b % 1024, swz = sb ^ (((sb >> 9) & 1) << 5); R = (st >> 1) * 16 + swz / 64; C = (st & 1) * 32 + (swz % 64) / 2; }
__host__ __device__ __forceinline__ int perm32(int rho) { const int n = rho >> 4, i = rho & 15; return 8 * (i >> 2) + 4 * n + (i & 3); }

struct Unit { int pm, pn; };
struct Gemm { const bf16_t* A; const bf16_t* Bt; int M, N, K; };

struct StaticOrder {
    int nM, nN, nwg, G, c;
    __host__ __device__ void init(int M, int N, int G_, int c_) { nM = M / BM; nN = N / BM; nwg = nM * nN; G = G_; c = c_; }
    __host__ __device__ bool next(int i, Unit& u) const {
        const long L = (long)i * G + c; if (L >= nwg) return false;
        int wgid = (int)L; { const int q = nwg / NXCD, r = nwg % NXCD, xcd = wgid % NXCD, off = wgid / NXCD; wgid = (xcd < r ? xcd * (q + 1) : r * (q + 1) + (xcd - r) * q) + off; }
        const int nig = WGM * nN, gid = wgid / nig, fm = gid * WGM, gsz = (nM - fm) < WGM ? (nM - fm) : WGM;
        u.pm = fm + ((wgid % nig) % gsz); u.pn = (wgid % nig) / gsz; return true;
    }
    __device__ __forceinline__ void a_ready(const Unit&) const {}
    __device__ __forceinline__ void done(const Unit&) const {}
};

__device__ __forceinline__ unsigned cvt_pk_bf16(float lo, float hi) { unsigned r; asm volatile("v_cvt_pk_bf16_f32 %0, %1, %2" : "=v"(r) : "v"(lo), "v"(hi)); return r; }
typedef float f32x2 __attribute__((ext_vector_type(2)));
__device__ __forceinline__ f32x2 gelu_pk(f32x2 v) {
    const f32x2 av = __builtin_elementwise_abs(v), d = av * 0.2316418882f + 1.0f;
    f32x2 t; t.x = __builtin_amdgcn_rcpf(d.x); t.y = __builtin_amdgcn_rcpf(d.y);
    f32x2 q = t * 0.5307027145f + (-0.7265760135f); q = q * t + 0.7107068705f; q = q * t + (-0.142248368f); q = q * t + 0.127414796f; q = q * t;
    const f32x2 s = (v * v) * (-0.72134752044f);
    f32x2 e; e.x = __builtin_amdgcn_exp2f(s.x); e.y = __builtin_amdgcn_exp2f(s.y);
    const f32x2 m = v * (q * e), r = v - m;
    f32x2 o; o.x = v.x < 0.f ? m.x : r.x; o.y = v.y < 0.f ? m.y : r.y; return o;
}
template <int ACT  > struct EpiBf16 {
    static constexpr bool PERM = true, AFTER_DRAIN = false; static_assert(ACT == 0 || ACT == 1, "EpiBf16: ACT is 0 (none) or 1 (gelu_pk)");
    bf16_t* O; int ldc; const float* bias; int split_cols; size_t split_stride; float scale0;
    __device__ __forceinline__ void operator()(const f32x4 (&acc)[2][2][4][2], const Unit& u, int wr, int wc, int fr, int fq) const {
        const int row0 = u.pm * BM + wr * 64 + fr; int colt = u.pn * BM; bf16_t* base = O;
        float sc = 1.f; if (split_cols) { const int t = colt / split_cols; base += (size_t)t * split_stride; colt -= t * split_cols; if (t == 0) sc = scale0; }
        const int col0 = colt + wc * 32 + 8 * fq, bcol0 = u.pn * BM + wc * 32 + 8 * fq;
        f32x4 bv[2][2];
#pragma unroll
        for (int bj = 0; bj < 2; ++bj)
#pragma unroll
            for (int n = 0; n < 2; ++n) bv[bj][n] = bias ? *(const f32x4*)(bias + bcol0 + bj * HALF + 4 * n) : (f32x4){0.f, 0.f, 0.f, 0.f};
#pragma unroll
        for (int ai = 0; ai < 2; ++ai)
#pragma unroll
            for (int m = 0; m < 4; ++m) { bf16_t* rowp = base + (size_t)(row0 + ai * HALF + m * 16) * ldc + col0;
#pragma unroll
                for (int bj = 0; bj < 2; ++bj) { f32x4 v0 = acc[ai][bj][m][0] + bv[bj][0], v1 = acc[ai][bj][m][1] + bv[bj][1];
                    if (ACT == 1) { f32x2 a = gelu_pk((f32x2){v0[0], v0[1]}), b = gelu_pk((f32x2){v0[2], v0[3]}), c = gelu_pk((f32x2){v1[0], v1[1]}), d = gelu_pk((f32x2){v1[2], v1[3]});
                        v0 = (f32x4){a.x, a.y, b.x, b.y}; v1 = (f32x4){c.x, c.y, d.x, d.y}; }
                    v0 = v0 * sc; v1 = v1 * sc; u32x4 w; w.x = cvt_pk_bf16(v0[0], v0[1]); w.y = cvt_pk_bf16(v0[2], v0[3]); w.z = cvt_pk_bf16(v1[0], v1[1]); w.w = cvt_pk_bf16(v1[2], v1[3]);
                    *(u32x4*)(rowp + bj * HALF) = w; } }
    }
};
struct EpiResF32 {
    static constexpr bool PERM = false, AFTER_DRAIN = false;
    const float* base; float* out; int ldc;
    __device__ __forceinline__ void operator()(const f32x4 (&acc)[2][2][4][2], const Unit& u, int wr, int wc, int fr, int fq) const {
        const int col0 = u.pn * BM + wc * 32 + 4 * fq;
#pragma unroll
        for (int ai = 0; ai < 2; ++ai)
#pragma unroll
            for (int m = 0; m < 4; ++m) { const int r = ai * HALF + wr * 64 + m * 16 + fr; const size_t off = (size_t)(u.pm * BM + r) * ldc + col0;
#pragma unroll
                for (int bj = 0; bj < 2; ++bj)
#pragma unroll
                    for (int n = 0; n < 2; ++n) { const f32x4 bs = *(const f32x4*)(base + off + bj * HALF + n * 16); *(f32x4*)(out + off + bj * HALF + n * 16) = bs + acc[ai][bj][m][n]; } }
    }
};
template <class Epi, class Sched, bool ALIGN_EPI = false, bool SP2 = false>
__device__ __forceinline__ void gemm_phase(PG8_LAS unsigned char* lds, const Gemm g, const Sched& S, const Epi& E) {
    const int tid = threadIdx.x, wid = __builtin_amdgcn_readfirstlane(tid >> 6), lane = tid & 63, wr = wid >> 2, wc = wid & 3, fr = lane & 15, fq = lane >> 4;
    const int K = g.K, nt = K / BK;
    unsigned voffA[2], voffB[2];
#pragma unroll
    for (int i = 0; i < 2; ++i) { int R, C; stage_rc(tid * 16 + i * 8192, R, C); const int Rb = Epi::PERM ? ((R & ~31) + perm32(R & 31)) : R;
        voffA[i] = (unsigned)(R * K + C) * 2u; voffB[i] = (unsigned)(Rb * K + C) * 2u; }
    const size_t kstep = (size_t)(BK * 2);
    const size_t hstep = (size_t)HALF * K * 2;
    const size_t tstep = 2 * hstep;
    const unsigned ldsw = (unsigned)wid * 1024u;
    const int aoff = lds_byte(wr * 64 + fr, fq * 8), boff = lds_byte(wc * 32 + fr, fq * 8);
#define PG8_SA(b, h) (((b) * 2 + (h)) * HTB)
#define PG8_SB(b, h) ((4 + (b) * 2 + (h)) * HTB)
#define PG8_STAGE(bufoff, gbase, voff) do { _Pragma("unroll") for (int _i = 0; _i < 2; ++_i) \
        __builtin_amdgcn_global_load_lds((const unsigned*)((const char*)(gbase) + (voff)[_i]), (PG8_LAS unsigned*)(lds + (bufoff) + ldsw + _i * 8192), 16, 0, 0); } while (0)
#define PG8_LDA(dst, b, h) do { _Pragma("unroll") for (int m = 0; m < 4; ++m) _Pragma("unroll") for (int k = 0; k < 2; ++k) dst[m][k] = *(const PG8_LAS bf16x8*)(lds + PG8_SA(b, h) + aoff + m * 2048 + k * 1024); } while (0)
#define PG8_LDB(dst, b, h) do { _Pragma("unroll") for (int n = 0; n < 2; ++n) _Pragma("unroll") for (int k = 0; k < 2; ++k) dst[n][k] = *(const PG8_LAS bf16x8*)(lds + PG8_SB(b, h) + boff + n * 2048 + k * 1024); } while (0)
#define PG8_MMA(ai, bj, At, Bt) do { __builtin_amdgcn_s_setprio(1); _Pragma("unroll") for (int m = 0; m < 4; ++m) _Pragma("unroll") for (int n = 0; n < 2; ++n) _Pragma("unroll") for (int k = 0; k < 2; ++k) \
        acc[ai][bj][m][n] = __builtin_amdgcn_mfma_f32_16x16x32_bf16(Bt[n][k], At[m][k], acc[ai][bj][m][n], 0, 0, 0); __builtin_amdgcn_s_setprio(0); } while (0)
#define PG8_WAIT_V(n) asm volatile("s_waitcnt vmcnt(" #n ")" ::: "memory")
#define PG8_WAIT_L(n) asm volatile("s_waitcnt lgkmcnt(" #n ")" ::: "memory")
#define PG8_BAR __builtin_amdgcn_s_barrier()
#define PG8_SCHED __builtin_amdgcn_sched_barrier(0)
    Unit cur, nxt; int ui = 0;
    if (!S.next(0, cur)) return;
    f32x4 acc[2][2][4][2];
#pragma unroll
    for (int a = 0; a < 2; ++a)
#pragma unroll
        for (int b = 0; b < 2; ++b)
#pragma unroll
            for (int m = 0; m < 4; ++m)
#pragma unroll
                for (int n = 0; n < 2; ++n) acc[a][b][m][n] = (f32x4){0.f, 0.f, 0.f, 0.f};
    bf16x8 At[4][2], B0[2][2], B1[2][2];
    const char* cA = (const char*)g.A + (size_t)cur.pm * tstep; const char* cB = (const char*)g.Bt + (size_t)cur.pn * tstep;
    S.a_ready(cur);
    if constexpr (SP2) {
        PG8_STAGE(PG8_SB(0, 0), cB, voffB); PG8_STAGE(PG8_SB(0, 1), cB + hstep, voffB); PG8_STAGE(PG8_SA(0, 0), cA, voffA); PG8_STAGE(PG8_SA(0, 1), cA + hstep, voffA);
        if (wr == 1) PG8_BAR;
        PG8_WAIT_V(2); PG8_BAR;
        PG8_STAGE(PG8_SB(1, 0), cB + kstep, voffB); PG8_STAGE(PG8_SA(1, 0), cA + kstep, voffA); PG8_STAGE(PG8_SB(1, 1), cB + hstep + kstep, voffB);
        PG8_WAIT_V(6); PG8_BAR;
    } else {
        PG8_STAGE(PG8_SB(0, 0), cB, voffB); PG8_STAGE(PG8_SA(0, 0), cA, voffA); PG8_STAGE(PG8_SB(0, 1), cB + hstep, voffB); PG8_STAGE(PG8_SA(0, 1), cA + hstep, voffA);
        if (wr == 1) PG8_BAR;
        PG8_WAIT_V(4); PG8_BAR;
        PG8_STAGE(PG8_SB(1, 0), cB + kstep, voffB); PG8_STAGE(PG8_SA(1, 0), cA + kstep, voffA); PG8_STAGE(PG8_SB(1, 1), cB + hstep + kstep, voffB);
        PG8_WAIT_V(6); PG8_BAR;
    }
    for (;;) {
        const bool has_next = S.next(ui + 1, nxt);
        const char* nA = has_next ? (const char*)g.A + (size_t)nxt.pm * tstep : cA; const char* nB = has_next ? (const char*)g.Bt + (size_t)nxt.pn * tstep : cB;
        for (int t = 0; t < nt; t += 2) {
            const bool last = (t == nt - 2);
            const char* a1 = cA + (size_t)(t + 1) * kstep;
            const char* a2 = last ? nA : cA + (size_t)(t + 2) * kstep; const char* b2 = last ? nB : cB + (size_t)(t + 2) * kstep;
            const char* a3 = a2 + kstep; const char* b3 = b2 + kstep;
            if (last && has_next) S.a_ready(nxt);
            if constexpr (SP2) {
            PG8_LDB(B0, 0, 0); PG8_LDB(B1, 0, 1); PG8_SCHED; PG8_LDA(At, 0, 0); PG8_STAGE(PG8_SA(1, 1), a1 + hstep, voffA);
            PG8_WAIT_V(8); PG8_WAIT_L(0); PG8_BAR; PG8_MMA(0, 0, At, B0); PG8_MMA(0, 1, At, B1); PG8_BAR; PG8_SCHED;
            PG8_LDA(At, 0, 1); PG8_STAGE(PG8_SB(0, 0), b2, voffB); PG8_STAGE(PG8_SB(0, 1), b2 + hstep, voffB); PG8_STAGE(PG8_SA(0, 0), a2, voffA);
            PG8_WAIT_V(8); PG8_WAIT_L(0); PG8_BAR; PG8_MMA(1, 0, At, B0); PG8_MMA(1, 1, At, B1); PG8_BAR; PG8_SCHED;
            PG8_LDB(B0, 1, 0); PG8_LDB(B1, 1, 1); PG8_SCHED; PG8_LDA(At, 1, 0); PG8_STAGE(PG8_SA(0, 1), a2 + hstep, voffA);
            PG8_WAIT_V(8); PG8_WAIT_L(0); PG8_BAR; PG8_MMA(0, 0, At, B0); PG8_MMA(0, 1, At, B1); PG8_BAR; PG8_SCHED;
            PG8_LDA(At, 1, 1); PG8_STAGE(PG8_SB(1, 0), b3, voffB); PG8_STAGE(PG8_SB(1, 1), b3 + hstep, voffB); PG8_STAGE(PG8_SA(1, 0), a3, voffA);
            PG8_WAIT_V(8); PG8_WAIT_L(0); PG8_BAR; PG8_MMA(1, 0, At, B0); PG8_MMA(1, 1, At, B1); PG8_BAR; PG8_SCHED;
            } else {
            PG8_LDB(B0, 0, 0); PG8_SCHED; PG8_LDA(At, 0, 0); PG8_STAGE(PG8_SA(1, 1), a1 + hstep, voffA);
            PG8_WAIT_L(8); PG8_BAR; PG8_WAIT_L(0); PG8_MMA(0, 0, At, B0); PG8_BAR; PG8_SCHED;
            PG8_LDB(B1, 0, 1); PG8_STAGE(PG8_SB(0, 0), b2, voffB);
            PG8_BAR; PG8_WAIT_L(0); PG8_MMA(0, 1, At, B1); PG8_BAR;
            PG8_LDA(At, 0, 1); PG8_STAGE(PG8_SA(0, 0), a2, voffA);
            PG8_BAR; PG8_WAIT_L(0); PG8_MMA(1, 0, At, B0); PG8_BAR; PG8_SCHED;
            PG8_STAGE(PG8_SB(0, 1), b2 + hstep, voffB);
            PG8_WAIT_V(6); PG8_BAR; PG8_MMA(1, 1, At, B1); PG8_BAR;
            PG8_LDB(B0, 1, 0); PG8_SCHED; PG8_LDA(At, 1, 0); PG8_STAGE(PG8_SA(0, 1), a2 + hstep, voffA);
            PG8_WAIT_L(8); PG8_BAR; PG8_WAIT_L(0); PG8_MMA(0, 0, At, B0); PG8_BAR; PG8_SCHED;
            PG8_LDB(B1, 1, 1); PG8_STAGE(PG8_SB(1, 0), b3, voffB);
            PG8_BAR; PG8_WAIT_L(0); PG8_MMA(0, 1, At, B1); PG8_BAR;
            PG8_LDA(At, 1, 1); PG8_STAGE(PG8_SA(1, 0), a3, voffA);
            PG8_BAR; PG8_WAIT_L(0); PG8_MMA(1, 0, At, B0); PG8_BAR; PG8_SCHED;
            PG8_STAGE(PG8_SB(1, 1), b3 + hstep, voffB);
            PG8_WAIT_V(6); PG8_BAR; PG8_MMA(1, 1, At, B1); PG8_BAR;
            }
        }
        if constexpr (ALIGN_EPI) { if (wr == 0) PG8_BAR; }
        if constexpr (!Epi::AFTER_DRAIN) { E(acc, cur, wr, wc, fr, fq); S.done(cur); }
        if (!has_next) break;
#pragma unroll
        for (int a = 0; a < 2; ++a)
#pragma unroll
            for (int b = 0; b < 2; ++b)
#pragma unroll
                for (int m = 0; m < 4; ++m)
#pragma unroll
                    for (int n = 0; n < 2; ++n) acc[a][b][m][n] = (f32x4){0.f, 0.f, 0.f, 0.f};
        cur = nxt; cA = nA; cB = nB; ++ui;
        if constexpr (ALIGN_EPI) { if (wr == 1) PG8_BAR; }
    }
    PG8_WAIT_V(0);
    if constexpr (!ALIGN_EPI) { if (wr == 0) PG8_BAR; }
    PG8_BAR;
    if constexpr (Epi::AFTER_DRAIN) { E.fused(acc, cur, wr, wc, fr, fq, lds, wid, lane); S.done(cur); }
#undef PG8_SA
#undef PG8_SB
#undef PG8_STAGE
#undef PG8_LDA
#undef PG8_LDB
#undef PG8_MMA
#undef PG8_WAIT_V
#undef PG8_WAIT_L
#undef PG8_BAR
#undef PG8_SCHED
}
}
#define GAS __attribute__((address_space(1)))
#define LAS __attribute__((address_space(3)))
typedef unsigned short bf16;
typedef unsigned v4u __attribute__((ext_vector_type(4)));
typedef float f32x4 __attribute__((ext_vector_type(4)));
typedef short bf16x8 __attribute__((ext_vector_type(8)));
typedef GAS unsigned gu32;
typedef GAS unsigned long long gu64;
#define RLX_AGENT __ATOMIC_RELAXED, __HIP_MEMORY_SCOPE_AGENT
#define LDS_WAIT() asm volatile("s_waitcnt lgkmcnt(0)" ::: "memory")
#define VM_WAIT() asm volatile("s_waitcnt vmcnt(0)" ::: "memory")
__device__ __forceinline__ unsigned long long rt() { return __builtin_amdgcn_s_memrealtime(); }
__device__ __forceinline__ unsigned f2bf(float f) { unsigned u = __builtin_bit_cast(unsigned, f); return (u + 0x7fffu + ((u >> 16) & 1u)) >> 16; }
__device__ __forceinline__ unsigned pk2(float lo, float hi) { return f2bf(lo) | (f2bf(hi) << 16); }

#define XB_TMO      128
#define XB_XCNT(j)  (256  + 64 * (j))
#define XB_XSUB(j)  (1280 + 64 * (j))
#define XB_XGEN(j)  (2304 + 64 * (j))
#define XB_TOP      3328
#define XB_TOPGEN   3392
#define XCD_BAR_WORDS 3456
#define XB_SPIN_CAP (1u << 18)

__device__ __forceinline__ unsigned xb_ld(unsigned* p)              { return __hip_atomic_load(p, __ATOMIC_RELAXED, __HIP_MEMORY_SCOPE_AGENT); }
__device__ __forceinline__ unsigned xb_add(unsigned* p, unsigned v) { return __hip_atomic_fetch_add(p, v, __ATOMIC_RELAXED, __HIP_MEMORY_SCOPE_AGENT); }
__device__ __forceinline__ unsigned xb_xcc_id() { return (unsigned)__builtin_amdgcn_s_getreg((3 << 11) | 20) & 0xFu; }
#define XB_SPIN(cond, bar) do { unsigned _sp = 0; while (cond) { __builtin_amdgcn_s_sleep(1); \
    if ((++_sp & 255u) == 0u) { if (xb_ld(&(bar)[XB_TMO])) break; if (_sp > XB_SPIN_CAP) { atomicAdd(&(bar)[XB_TMO], 1u); break; } } } } while (0)

struct XcdBarrier {
    unsigned* bar; unsigned x;
    volatile LAS unsigned* st;
};

__device__ __forceinline__ XcdBarrier xcd_barrier_post(unsigned* bar, volatile LAS unsigned* st) {
    XcdBarrier b; b.bar = bar; b.x = xb_xcc_id(); b.st = st;
    if (threadIdx.x == 0) (void)xb_add(&bar[XB_XCNT(b.x)], 1u);
    return b;
}
__device__ __forceinline__ void xcd_barrier_complete(unsigned* bar, unsigned x, unsigned& nloc, unsigned& nx) {
    const unsigned G = gridDim.x * gridDim.y * gridDim.z;
    unsigned sum, cnt, mine, sp = 0u;
    for (;;) {
        sum = 0u; cnt = 0u; mine = 0u;
#pragma unroll
        for (unsigned j = 0; j < 16; ++j) { const unsigned c = xb_ld(&bar[XB_XCNT(j)]); sum += c; cnt += (c > 0u) ? 1u : 0u; mine = (j == x) ? c : mine; }
        if (sum == G) break;
        __builtin_amdgcn_s_sleep(1);
        if ((++sp & 255u) == 0u) { if (xb_ld(&bar[XB_TMO])) break; if (sp > XB_SPIN_CAP) { atomicAdd(&bar[XB_TMO], 1u); break; } }
    }
    nloc = mine > 0u ? mine : 1u; nx = cnt > 0u ? cnt : 1u;
}

__device__ __forceinline__ void xcd_barrier(const XcdBarrier& b) {
    asm volatile("s_waitcnt vmcnt(0)" ::: "memory");
    __syncthreads();
    if (threadIdx.x == 0) {
        unsigned* bar = b.bar;
        __builtin_amdgcn_s_waitcnt(0);
        unsigned nloc = b.st[0], nx = b.st[1];
        if (nloc == 0u) { xcd_barrier_complete(bar, b.x, nloc, nx); b.st[0] = nloc; b.st[1] = nx; }
        const unsigned old = xb_add(&bar[XB_XSUB(b.x)], 1u);
        const unsigned gen = old / nloc;
        if (old + 1u == (gen + 1u) * nloc) {
            __builtin_amdgcn_fence(__ATOMIC_RELEASE, "agent");
            asm volatile("s_waitcnt vmcnt(0)" ::: "memory");
            const unsigned og = xb_add(&bar[XB_TOP], 1u);
            const unsigned tg = og / nx;
            if (og + 1u == (tg + 1u) * nx) xb_add(&bar[XB_TOPGEN], 1u);
            else XB_SPIN(xb_ld(&bar[XB_TOPGEN]) == tg, bar);
            __builtin_amdgcn_fence(__ATOMIC_ACQUIRE, "agent");
            xb_add(&bar[XB_XGEN(b.x)], 1u);
            asm volatile("s_waitcnt vmcnt(0)" ::: "memory");
        } else {
            XB_SPIN(xb_ld(&bar[XB_XGEN(b.x)]) == gen, bar);
            __builtin_amdgcn_fence(__ATOMIC_ACQUIRE, "agent");
            asm volatile("s_waitcnt vmcnt(0)" ::: "memory");
        }
    }
    __syncthreads();
}
namespace cg = cooperative_groups;
constexpr int NTOK = 16384, DMODEL = 1024, NBATCH = 8, SEQLEN = 2048, DEPTH = 4;
constexpr int FOX_IN = 4112, GLA_IN = 3088, HGRN_IN = 4096;
constexpr float RMS_EPS = 1e-6f;
constexpr float LOG2E = 1.4426950408889634f;
constexpr float FOX_C2 = 0.125f * LOG2E;
constexpr int NWAVES = 8;

constexpr size_t MiB = 1u << 20;
constexpr size_t WS_CTL = 0, CTL_ZERO_BYTES = 1 * MiB;
constexpr size_t WS_FOXWIN = 2 * MiB, WS_FOXWOUT = 18 * MiB, WS_GLAWIN = 22 * MiB, WS_GLAWOUT = 28 * MiB, WS_HGRNWIN = 30 * MiB, WS_HGRNWOUT = 38 * MiB;
constexpr size_t WS_PEERWQ = 40 * MiB, WS_KEYS = 56 * MiB, WS_LB = 58 * MiB;
constexpr size_t WS_U = 64 * MiB, WS_V = 192 * MiB;
constexpr size_t WS_XN = 320 * MiB, WS_P = 352 * MiB, WS_OB = 480 * MiB, WS_Q2 = 512 * MiB, WS_TAIL = 576 * MiB, WS_CUM = 577 * MiB;
constexpr size_t WS_EXP = 580 * MiB, WS_GATE = 588 * MiB, WS_OF = 596 * MiB, WS_GLOG = 660 * MiB, WS_END = 724 * MiB;
constexpr size_t PSTRIDE = (size_t)NTOK * 1024;
constexpr int CW_BAR = 4096;

constexpr int RING_BYTES = 131072;
constexpr int LDSCTL_OFF = RING_BYTES, MISC_OFF = LDSCTL_OFF + 320;
constexpr int LDS_BYTES = 147456;

struct Ctx {
    LAS unsigned char* lds; int tid, lane, wave, vcu, G, gw, NGW;
    const float* in[21]; float* out; unsigned char* ws;
};

__device__ __forceinline__ float bf2f(unsigned short b) { return __uint_as_float(((unsigned)b) << 16); }
__device__ __forceinline__ float bflo(unsigned w) { return __uint_as_float(w << 16); }
__device__ __forceinline__ float bfhi(unsigned w) { return __uint_as_float(w & 0xffff0000u); }
__device__ __forceinline__ float wave_sum(float v) {
#pragma unroll
    for (int o = 1; o < 64; o <<= 1) v += __shfl_xor(v, o);
    return v;
}
__device__ __forceinline__ float wave_max(float v) {
#pragma unroll
    for (int o = 1; o < 64; o <<= 1) v = fmaxf(v, __shfl_xor(v, o));
    return v;
}
__device__ __forceinline__ float log_sigmoid_f(float x) { return fminf(x, 0.f) - log1pf(__expf(-fabsf(x))); }
__device__ __forceinline__ float sigmoid_f(float x) { return 1.f / (1.f + __expf(-x)); }

__device__ __forceinline__ void p0_transpose_item(const float* W, int ldw, int K, int Nuse, bf16* WT, LAS float* scr, int item, int lane) {
    const int nblk = Nuse / 32, kb = item / nblk, nb = item % nblk, k0 = 64 * kb, n0 = 32 * nb;
#pragma unroll 8
    for (int i = 0; i < 32; ++i) { const int kk = 2 * i + (lane >> 5); scr[kk * 33 + (lane & 31)] = W[(size_t)(k0 + kk) * ldw + n0 + (lane & 31)]; }
    LDS_WAIT(); asm volatile("" ::: "memory");
    const int c = lane & 7;
#pragma unroll
    for (int j = 0; j < 4; ++j) { const int n = (lane >> 3) + 8 * j; const LAS float* s = scr + (8 * c) * 33 + n;
        v4u o; o.x = pk2(s[0 * 33], s[1 * 33]); o.y = pk2(s[2 * 33], s[3 * 33]); o.z = pk2(s[4 * 33], s[5 * 33]); o.w = pk2(s[6 * 33], s[7 * 33]);
        *(GAS v4u*)(WT + (size_t)(n0 + n) * K + k0 + 8 * c) = o; }
    LDS_WAIT(); asm volatile("" ::: "memory");
}
__device__ __forceinline__ void rms_row_to_bf16(int lane, const float* xrow, const float* gain, bf16* orow) {
    const GAS f32x4* xr = (const GAS f32x4*)xrow + lane; const GAS f32x4* gr = (const GAS f32x4*)gain + lane;
    f32x4 v[4]; float s = 0.f;
#pragma unroll
    for (int j = 0; j < 4; ++j) { v[j] = xr[64 * j]; s += (v[j].x * v[j].x + v[j].y * v[j].y) + (v[j].z * v[j].z + v[j].w * v[j].w); }
    const float r = rsqrtf(wave_sum(s) * (1.f / 1024.f) + RMS_EPS);
    GAS unsigned long long* o8 = (GAS unsigned long long*)orow + lane;
#pragma unroll
    for (int j = 0; j < 4; ++j) { const f32x4 g = gr[64 * j];
        o8[64 * j] = (unsigned long long)pk2(v[j].x * r * g.x, v[j].y * r * g.y) | ((unsigned long long)pk2(v[j].z * r * g.z, v[j].w * r * g.w) << 32); }
}
__device__ __forceinline__ void cvt_f32_bf16(const Ctx& C, const float* src, bf16* dst, size_t n) {
    const size_t nth = (size_t)C.G * 512, t0 = (size_t)C.vcu * 512 + C.tid;
    for (size_t i = t0; i < n / 8; i += nth) {
        const f32x4 a = ((const GAS f32x4*)src)[2 * i], b = ((const GAS f32x4*)src)[2 * i + 1];
        v4u o; o.x = pk2(a.x, a.y); o.y = pk2(a.z, a.w); o.z = pk2(b.x, b.y); o.w = pk2(b.z, b.w);
        ((GAS v4u*)dst)[i] = o;
    }
}
__device__ __forceinline__ void p0_prologue(const Ctx& C) {
    LAS float* scr = (LAS float*)(C.lds + C.wave * 16384);
    constexpr int I_FOXIN = 16 * 128, I_SQ = 16 * 32, I_GLAIN = 16 * 96, I_HGRNIN = 16 * 128, I_WQ = 16 * 64;
    constexpr int NITEMS = 2 * I_FOXIN + 2 * I_SQ + I_GLAIN + I_SQ + I_HGRNIN + I_SQ + 4 * I_WQ;
    for (int it = C.gw; it < NITEMS; it += C.NGW) {
        int r = it;
        if (r < 2 * I_FOXIN) { const int j = r / I_FOXIN; p0_transpose_item(C.in[3] + (size_t)j * 1024 * FOX_IN, FOX_IN, 1024, 4096, (bf16*)(C.ws + WS_FOXWIN) + (size_t)j * 4096 * 1024, scr, r % I_FOXIN, C.lane); continue; } r -= 2 * I_FOXIN;
        if (r < 2 * I_SQ) { const int j = r / I_SQ; p0_transpose_item(C.in[7] + (size_t)j * 1024 * 1024, 1024, 1024, 1024, (bf16*)(C.ws + WS_FOXWOUT) + (size_t)j * 1024 * 1024, scr, r % I_SQ, C.lane); continue; } r -= 2 * I_SQ;
        if (r < I_GLAIN) { p0_transpose_item(C.in[8], GLA_IN, 1024, 3072, (bf16*)(C.ws + WS_GLAWIN), scr, r, C.lane); continue; } r -= I_GLAIN;
        if (r < I_SQ) { p0_transpose_item(C.in[12], 1024, 1024, 1024, (bf16*)(C.ws + WS_GLAWOUT), scr, r, C.lane); continue; } r -= I_SQ;
        if (r < I_HGRNIN) { p0_transpose_item(C.in[13], HGRN_IN, 1024, 4096, (bf16*)(C.ws + WS_HGRNWIN), scr, r, C.lane); continue; } r -= I_HGRNIN;
        if (r < I_SQ) { p0_transpose_item(C.in[16], 1024, 1024, 1024, (bf16*)(C.ws + WS_HGRNWOUT), scr, r, C.lane); continue; } r -= I_SQ;
        { const int j = r / I_WQ; p0_transpose_item(C.in[17] + (size_t)j * 1024 * 2048, 2048, 1024, 2048, (bf16*)(C.ws + WS_PEERWQ) + (size_t)j * 2048 * 1024, scr, r % I_WQ, C.lane); }
    }
    cvt_f32_bf16(C, C.in[18], (bf16*)(C.ws + WS_KEYS), (size_t)4 * 16 * 128 * 128);
    cvt_f32_bf16(C, C.in[19], (bf16*)(C.ws + WS_U), (size_t)4 * 16384 * 1024);
    cvt_f32_bf16(C, C.in[20], (bf16*)(C.ws + WS_V), (size_t)4 * 16384 * 1024);
    if (C.vcu == 0) for (int c = C.tid; c < 1024; c += 512) {
        const float l0 = C.in[14][c], l1 = C.in[14][1024 + c], l2 = C.in[14][2048 + c], l3 = C.in[14][3072 + c];
        const float m = fmaxf(fmaxf(l0, l1), fmaxf(l2, l3));
        const float e0 = expf(l0 - m), e1 = expf(l1 - m), e2 = expf(l2 - m), e3 = expf(l3 - m);
        ((float*)(C.ws + WS_LB))[c] = (e1 + e2) / (e0 + e1 + e2 + e3);
    }
    for (int m = C.gw; m < NTOK; m += C.NGW) rms_row_to_bf16(C.lane, C.in[0] + (size_t)m * 1024, C.in[1], (bf16*)(C.ws + WS_XN) + (size_t)m * 1024);
}

template <int EPI>
__device__ __forceinline__ void simple_gemm(const Ctx& C, const bf16* A, const bf16* Bt, int N, int K, bf16* Ob, int ldc, int split, const float* base, float* outf) {
    const int l = C.lane, fr = l & 15, fq = l >> 4;
    const int ntn = N / 64, nitems = (NTOK / 16) * ntn;
    for (int it = C.gw; it < nitems; it += C.NGW) {
        const int rt = it / ntn, ct = it % ntn, row0 = rt * 16, col0 = ct * 64;
        f32x4 acc[4];
#pragma unroll
        for (int n = 0; n < 4; ++n) acc[n] = (f32x4){0.f, 0.f, 0.f, 0.f};
        const bf16* ap = A + (size_t)(row0 + fr) * K + fq * 8;
        for (int k0 = 0; k0 < K; k0 += 32) {
            const bf16x8 a = *(const bf16x8*)(ap + k0);
#pragma unroll
            for (int n = 0; n < 4; ++n) { const bf16x8 b = *(const bf16x8*)(Bt + (size_t)(col0 + n * 16 + fr) * K + k0 + fq * 8);
                acc[n] = __builtin_amdgcn_mfma_f32_16x16x32_bf16(a, b, acc[n], 0, 0, 0); }
        }
#pragma unroll
        for (int n = 0; n < 4; ++n)
#pragma unroll
            for (int r = 0; r < 4; ++r) { const int row = row0 + fq * 4 + r, col = col0 + n * 16 + fr;
                if (EPI == 0) { bf16* o = Ob; int cc = col; if (split) { o += (size_t)(col / 1024) * PSTRIDE; cc = col % 1024; } o[(size_t)row * ldc + cc] = (bf16)f2bf(acc[n][r]); }
                else { const size_t off = (size_t)row * 1024 + col; outf[off] = base[off] + acc[n][r]; } }
    }
}

__device__ __forceinline__ void tail_stage_w(const Ctx& C, const float* W, int ldw, int col0) {
    LAS float* wt = (LAS float*)C.lds;
    for (int i = C.tid; i < 1024 * 16; i += 512) wt[i] = W[(size_t)(i >> 4) * ldw + col0 + (i & 15)];
}
__device__ __forceinline__ float tail_dot(const Ctx& C, int tok, int j) {
    const LAS float* wt = (const LAS float*)C.lds;
    const bf16* xr = (const bf16*)(C.ws + WS_XN) + (size_t)tok * 1024;
    float acc = 0.f;
    for (int k0 = 0; k0 < 1024; k0 += 8) {
        const v4u w = *(const GAS v4u*)(xr + k0);
        acc += bflo(w.x) * wt[(k0 + 0) * 16 + j] + bfhi(w.x) * wt[(k0 + 1) * 16 + j];
        acc += bflo(w.y) * wt[(k0 + 2) * 16 + j] + bfhi(w.y) * wt[(k0 + 3) * 16 + j];
        acc += bflo(w.z) * wt[(k0 + 4) * 16 + j] + bfhi(w.z) * wt[(k0 + 5) * 16 + j];
        acc += bflo(w.w) * wt[(k0 + 6) * 16 + j] + bfhi(w.w) * wt[(k0 + 7) * 16 + j];
    }
    return acc;
}

__device__ __forceinline__ void fox_step1(const Ctx& C, int j) {
    tail_stage_w(C, C.in[3] + (size_t)j * 1024 * FOX_IN, FOX_IN, 4096);
    __syncthreads();
    float* TAIL = (float*)(C.ws + WS_TAIL);
    for (int tb = C.vcu; tb < NTOK / 64; tb += C.G) {
#pragma unroll 1
        for (int rep = 0; rep < 2; ++rep) {
            const int tok = tb * 64 + rep * 32 + (C.tid >> 4), jj = C.tid & 15;
            const float f = tail_dot(C, tok, jj) + C.in[4][j * 16 + jj];
            TAIL[(size_t)tok * 16 + jj] = log_sigmoid_f(f);
        }
        const float* gq = C.in[5] + j * 64; const float* gk = C.in[6] + j * 64;
        for (int t = 0; t < 8; ++t) {
            const int tok = tb * 64 + C.wave * 8 + t;
#pragma unroll
            for (int which = 0; which < 2; ++which) {
                bf16* row = (bf16*)(C.ws + WS_P) + (size_t)which * PSTRIDE + (size_t)tok * 1024 + C.lane * 16;
                const v4u a = *(const GAS v4u*)row, b = *(const GAS v4u*)(row + 8);
                float v[16] = {bflo(a.x), bfhi(a.x), bflo(a.y), bfhi(a.y), bflo(a.z), bfhi(a.z), bflo(a.w), bfhi(a.w), bflo(b.x), bfhi(b.x), bflo(b.y), bfhi(b.y), bflo(b.z), bfhi(b.z), bflo(b.w), bfhi(b.w)};
                float ss = 0.f;
#pragma unroll
                for (int i = 0; i < 16; ++i) ss += v[i] * v[i];
                ss += __shfl_xor(ss, 1); ss += __shfl_xor(ss, 2);
                const float r = rsqrtf(ss * (1.f / 64.f) + RMS_EPS) * (which == 0 ? FOX_C2 : 1.f);
                const float* g = (which == 0 ? gq : gk) + (C.lane & 3) * 16;
#pragma unroll
                for (int i = 0; i < 16; ++i) v[i] = v[i] * r * g[i];
                v4u oa, ob; oa.x = pk2(v[0], v[1]); oa.y = pk2(v[2], v[3]); oa.z = pk2(v[4], v[5]); oa.w = pk2(v[6], v[7]);
                ob.x = pk2(v[8], v[9]); ob.y = pk2(v[10], v[11]); ob.z = pk2(v[12], v[13]); ob.w = pk2(v[14], v[15]);
                *(GAS v4u*)row = oa; *(GAS v4u*)(row + 8) = ob;
            }
        }
    }
}
__device__ __forceinline__ void fox_step2(const Ctx& C) {
    const float* TAIL = (const float*)(C.ws + WS_TAIL); float* CUM = (float*)(C.ws + WS_CUM);
    for (int s = C.gw; s < NBATCH * 16; s += C.NGW) {
        const int b = s >> 4, h = s & 15; float carry = 0.f;
        for (int t0 = 0; t0 < SEQLEN; t0 += 64) {
            float v = TAIL[(size_t)(b * SEQLEN + t0 + C.lane) * 16 + h];
#pragma unroll
            for (int o = 1; o < 64; o <<= 1) { const float u = __shfl_up(v, o); if (C.lane >= o) v += u; }
            v += carry; CUM[(size_t)s * SEQLEN + t0 + C.lane] = v * LOG2E; carry = __shfl(v, 63);
        }
    }
}
__device__ __forceinline__ void fox_attn_naive(const Ctx& C) {
    const bf16* Q = (const bf16*)(C.ws + WS_P); const bf16* K = Q + PSTRIDE; const bf16* V = Q + 2 * PSTRIDE; const bf16* Gt = Q + 3 * PSTRIDE;
    const float* CUM = (const float*)(C.ws + WS_CUM); bf16* OB = (bf16*)(C.ws + WS_OB);
    for (int it = C.gw; it < NBATCH * 16 * SEQLEN; it += C.NGW) {
        const int t = it % SEQLEN, bh = it / SEQLEN, h = bh & 15, b = bh >> 4;
        const size_t rowb = (size_t)b * SEQLEN;
        const float qd = bf2f(Q[(rowb + t) * 1024 + h * 64 + C.lane]);
        float m = -INFINITY, l = 0.f, o = 0.f;
        for (int kb = 0; kb <= t / 64; ++kb) {
            const int s = kb * 64 + C.lane;
            const bf16* kr = K + (rowb + s) * 1024 + h * 64;
            float sc = 0.f;
#pragma unroll
            for (int d0 = 0; d0 < 64; d0 += 8) { const v4u w = *(const GAS v4u*)(kr + d0);
                sc += __shfl(qd, d0 + 0) * bflo(w.x) + __shfl(qd, d0 + 1) * bfhi(w.x) + __shfl(qd, d0 + 2) * bflo(w.y) + __shfl(qd, d0 + 3) * bfhi(w.y)
                    + __shfl(qd, d0 + 4) * bflo(w.z) + __shfl(qd, d0 + 5) * bfhi(w.z) + __shfl(qd, d0 + 6) * bflo(w.w) + __shfl(qd, d0 + 7) * bfhi(w.w); }
            sc -= CUM[(size_t)bh * SEQLEN + s];
            if (s > t) sc = -INFINITY;
            const float mn = fmaxf(m, wave_max(sc)), p = exp2f(sc - mn), al = exp2f(m - mn);
            l = l * al + wave_sum(p); o *= al; m = mn;
            const bf16* vr = V + (rowb + kb * 64) * 1024 + h * 64 + C.lane;
            for (int ss = 0; ss < 64; ++ss) o += __shfl(p, ss) * bf2f(vr[(size_t)ss * 1024]);
        }
        const size_t oi = (rowb + t) * 1024 + h * 64 + C.lane;
        OB[oi] = (bf16)f2bf(o / l * sigmoid_f(bf2f(Gt[oi])));
    }
}

__device__ __forceinline__ void gla_step1(const Ctx& C) {
    tail_stage_w(C, C.in[8], GLA_IN, 3072);
    __syncthreads();
    LAS float* low = (LAS float*)(C.lds + 65536);
    float* GLOG = (float*)(C.ws + WS_GLOG);
    float wu[16];
#pragma unroll
    for (int r = 0; r < 16; ++r) wu[r] = C.in[9][r * 512 + C.tid];
    const float ba = C.in[10][C.tid];
    for (int tb = C.vcu; tb < NTOK / 64; tb += C.G) {
#pragma unroll 1
        for (int rep = 0; rep < 2; ++rep) { const int tl = rep * 32 + (C.tid >> 4), jj = C.tid & 15; low[tl * 16 + jj] = tail_dot(C, tb * 64 + tl, jj); }
        __syncthreads();
        for (int tl = 0; tl < 64; ++tl) {
            float z = ba;
#pragma unroll
            for (int r = 0; r < 16; ++r) z += low[tl * 16 + r] * wu[r];
            GLOG[(size_t)(tb * 64 + tl) * 512 + C.tid] = log_sigmoid_f(z) * (1.f / 16.f);
        }
        __syncthreads();
    }
}
__device__ __forceinline__ void hgrn_step1(const Ctx& C) {
    const float* LB = (const float*)(C.ws + WS_LB); float* GLOG = (float*)(C.ws + WS_GLOG); bf16* P1 = (bf16*)(C.ws + WS_P) + PSTRIDE;
    const size_t n8 = (size_t)NTOK * 1024 / 8, nth = (size_t)C.G * 512;
    for (size_t i = (size_t)C.vcu * 512 + C.tid; i < n8; i += nth) {
        const int c0 = (int)((i * 8) & 1023);
        const v4u w = ((const GAS v4u*)P1)[i];
        const float f[8] = {bflo(w.x), bfhi(w.x), bflo(w.y), bfhi(w.y), bflo(w.z), bfhi(w.z), bflo(w.w), bfhi(w.w)};
        float lg[8], kk[8];
#pragma unroll
        for (int e = 0; e < 8; ++e) { const float lb = LB[c0 + e]; const float g = lb + (1.f - lb) * sigmoid_f(f[e]); lg[e] = logf(g); kk[e] = 1.f - g; }
        ((GAS f32x4*)GLOG)[2 * i] = (f32x4){lg[0], lg[1], lg[2], lg[3]}; ((GAS f32x4*)GLOG)[2 * i + 1] = (f32x4){lg[4], lg[5], lg[6], lg[7]};
        v4u o; o.x = pk2(kk[0], kk[1]); o.y = pk2(kk[2], kk[3]); o.z = pk2(kk[4], kk[5]); o.w = pk2(kk[6], kk[7]);
        ((GAS v4u*)P1)[i] = o;
    }
}
template <int NH, int DV>
__device__ __forceinline__ void rec_naive(const Ctx& C, const bf16* Qp, int qoff, const bf16* Kp, int koff, const bf16* Vp, const float* GLOG, int gpitch) {
    float* OF = (float*)(C.ws + WS_OF);
    LAS float* sq = (LAS float*)C.lds; LAS float* sk = sq + 16 * 128; LAS float* sg = sk + 16 * 128;
    const float qs = 0.08838834764831845f;
    for (int bh = C.vcu; bh < NBATCH * NH; bh += C.G) {
        const int b = bh / NH, h = bh % NH; const size_t rowb = (size_t)b * SEQLEN;
        float S[128];
#pragma unroll
        for (int d = 0; d < 128; ++d) S[d] = 0.f;
        for (int t0 = 0; t0 < SEQLEN; t0 += 16) {
            __syncthreads();
            for (int i = C.tid; i < 16 * 128; i += 512) { const int ts = i >> 7, d = i & 127; const size_t r = rowb + t0 + ts;
                sq[i] = bf2f(Qp[r * 1024 + qoff + h * 128 + d]) * qs; sk[i] = bf2f(Kp[r * 1024 + koff + h * 128 + d]); sg[i] = __expf(GLOG[r * gpitch + h * 128 + d]); }
            __syncthreads();
            if (C.tid < DV) {
#pragma unroll 1
                for (int ts = 0; ts < 16; ++ts) {
                    const size_t r = rowb + t0 + ts;
                    const float v = bf2f(Vp[r * 1024 + h * DV + C.tid]);
                    float o = 0.f;
#pragma unroll
                    for (int d = 0; d < 128; d += 4) {
                        const f32x4 q4 = *(const LAS f32x4*)(sq + ts * 128 + d), k4 = *(const LAS f32x4*)(sk + ts * 128 + d), g4 = *(const LAS f32x4*)(sg + ts * 128 + d);
                        S[d] = g4.x * S[d] + k4.x * v; o += q4.x * S[d];
                        S[d + 1] = g4.y * S[d + 1] + k4.y * v; o += q4.y * S[d + 1];
                        S[d + 2] = g4.z * S[d + 2] + k4.z * v; o += q4.z * S[d + 2];
                        S[d + 3] = g4.w * S[d + 3] + k4.w * v; o += q4.w * S[d + 3];
                    }
                    OF[r * 1024 + h * DV + C.tid] = o;
                }
            }
        }
    }
}
template <int DV>
__device__ __forceinline__ void rec_norm_gate(const Ctx& C, const float* gain, const bf16* gate) {
    const float* OF = (const float*)(C.ws + WS_OF); bf16* OB = (bf16*)(C.ws + WS_OB);
    for (int tok = C.gw; tok < NTOK; tok += C.NGW) {
        const GAS f32x4* xr = (const GAS f32x4*)(OF + (size_t)tok * 1024) + C.lane;
        const GAS f32x4* gr = (const GAS f32x4*)gain + C.lane;
        const GAS unsigned long long* tr = (const GAS unsigned long long*)(gate + (size_t)tok * 1024) + C.lane;
        GAS unsigned long long* o8 = (GAS unsigned long long*)(OB + (size_t)tok * 1024) + C.lane;
#pragma unroll
        for (int j = 0; j < 4; ++j) {
            const f32x4 v = xr[64 * j]; float ss = (v.x * v.x + v.y * v.y) + (v.z * v.z + v.w * v.w);
#pragma unroll
            for (int o = 1; o < 32; o <<= 1) ss += __shfl_xor(ss, o);
            if (DV == 256) ss += __shfl_xor(ss, 32);
            const float r = rsqrtf(ss * (1.f / DV) + RMS_EPS);
            const f32x4 g = gr[64 * j]; const unsigned long long tw = tr[64 * j];
            const float t0 = bflo((unsigned)tw), t1 = bfhi((unsigned)tw), t2 = bflo((unsigned)(tw >> 32)), t3 = bfhi((unsigned)(tw >> 32));
            const float a0 = v.x * r * g.x * (t0 * sigmoid_f(t0)), a1 = v.y * r * g.y * (t1 * sigmoid_f(t1)), a2 = v.z * r * g.z * (t2 * sigmoid_f(t2)), a3 = v.w * r * g.w * (t3 * sigmoid_f(t3));
            o8[64 * j] = (unsigned long long)pk2(a0, a1) | ((unsigned long long)pk2(a2, a3) << 32);
        }
    }
}

__device__ __forceinline__ void peer_topk(const Ctx& C, int layer) {
    const bf16* Q2 = (const bf16*)(C.ws + WS_Q2); const bf16* KEYS = (const bf16*)(C.ws + WS_KEYS) + (size_t)layer * 16 * 128 * 128;
    int* EXPT = (int*)(C.ws + WS_EXP); float* GATE = (float*)(C.ws + WS_GATE);
    LAS float* sc = (LAS float*)C.lds;
    LAS float* stop = sc + 2 * 64 * 129;
    LAS int* itop = (LAS int*)(stop + 2 * 64 * 16);
    const int l = C.lane, fr = l & 15, fq = l >> 4;
    for (int it = C.vcu; it < (NTOK / 64) * 8; it += C.G) {
        const int tile = it >> 3, head = it & 7, tok0 = tile * 64;
        __syncthreads();
        {
            const int p = C.wave >> 2, ts = C.wave & 3;
            const bf16* qp = Q2 + (size_t)(tok0 + ts * 16 + fr) * 2048 + head * 256 + p * 128 + fq * 8;
            bf16x8 bq[4];
#pragma unroll
            for (int ks = 0; ks < 4; ++ks) bq[ks] = *(const bf16x8*)(qp + ks * 32);
            const bf16* kp = KEYS + (size_t)(head * 2 + p) * 128 * 128 + (size_t)fr * 128 + fq * 8;
#pragma unroll
            for (int kb = 0; kb < 8; ++kb) {
                f32x4 acc = (f32x4){0.f, 0.f, 0.f, 0.f};
#pragma unroll
                for (int ks = 0; ks < 4; ++ks) { const bf16x8 a = *(const bf16x8*)(kp + (size_t)kb * 16 * 128 + ks * 32); acc = __builtin_amdgcn_mfma_f32_16x16x32_bf16(a, bq[ks], acc, 0, 0, 0); }
#pragma unroll
                for (int r = 0; r < 4; ++r) sc[(p * 64 + ts * 16 + fr) * 129 + kb * 16 + fq * 4 + r] = acc[r];
            }
        }
        __syncthreads();
        if (C.tid < 128) {
            const LAS float* row = sc + C.tid * 129;
            float vals[16]; int idx[16];
#pragma unroll
            for (int i = 0; i < 16; ++i) { vals[i] = -INFINITY; idx[i] = 0; }
            for (int k = 0; k < 128; ++k) {
                const float v = row[k];
                if (v > vals[15]) {
#pragma unroll
                    for (int i = 15; i >= 1; --i) { const bool a = v > vals[i - 1], bb = v > vals[i]; vals[i] = a ? vals[i - 1] : (bb ? v : vals[i]); idx[i] = a ? idx[i - 1] : (bb ? k : idx[i]); }
                    { const bool bb = v > vals[0]; vals[0] = bb ? v : vals[0]; idx[0] = bb ? k : idx[0]; }
                }
            }
#pragma unroll
            for (int i = 0; i < 16; ++i) { stop[C.tid * 16 + i] = vals[i]; itop[C.tid * 16 + i] = idx[i]; }
        }
        __syncthreads();
        if (C.tid < 64) {
            const LAS float* a = stop + C.tid * 16; const LAS float* bb2 = stop + (64 + C.tid) * 16;
            float vals[16]; int idx[16];
#pragma unroll
            for (int i = 0; i < 16; ++i) { vals[i] = -INFINITY; idx[i] = 0; }
            for (int i = 0; i < 16; ++i) {
                const float ai = a[i]; const int jmax = 16 / (i + 1);
                for (int j = 0; j < jmax; ++j) {
                    const float v = ai + bb2[j]; const int k = i * 16 + j;
                    if (v > vals[15]) {
#pragma unroll
                        for (int q = 15; q >= 1; --q) { const bool x = v > vals[q - 1], y = v > vals[q]; vals[q] = x ? vals[q - 1] : (y ? v : vals[q]); idx[q] = x ? idx[q - 1] : (y ? k : idx[q]); }
                        { const bool y = v > vals[0]; vals[0] = y ? v : vals[0]; idx[0] = y ? k : idx[0]; }
                    }
                }
            }
            float e[16], sum = 0.f;
#pragma unroll
            for (int i = 0; i < 16; ++i) { e[i] = __expf(vals[i] - vals[0]); sum += e[i]; }
            const float inv = 1.f / sum;
            const size_t ob = (size_t)(tok0 + C.tid) * 128 + head * 16;
#pragma unroll
            for (int i = 0; i < 16; ++i) { const int pi = idx[i] >> 4, pj = idx[i] & 15;
                EXPT[ob + i] = itop[C.tid * 16 + pi] * 128 + itop[(64 + C.tid) * 16 + pj]; GATE[ob + i] = e[i] * inv; }
        }
    }
}
__device__ __forceinline__ void peer_gather(const Ctx& C, int layer) {
    const bf16* U = (const bf16*)(C.ws + WS_U) + (size_t)layer * 16384 * 1024; const bf16* V = (const bf16*)(C.ws + WS_V) + (size_t)layer * 16384 * 1024;
    const int* EXPT = (const int*)(C.ws + WS_EXP); const float* GATE = (const float*)(C.ws + WS_GATE);
    const float* gf = C.in[2] + layer * 1024; const float* gn = C.in[1] + (layer + 1) * 1024;
    const int l = C.lane;
    for (int tok = C.gw; tok < NTOK; tok += C.NGW) {
        float* hrow = C.out + (size_t)tok * 1024;
        float hv[16], x[16], y[16];
#pragma unroll
        for (int j = 0; j < 2; ++j) { const f32x4 a = *(const GAS f32x4*)(hrow + 512 * j + 8 * l), b = *(const GAS f32x4*)(hrow + 512 * j + 8 * l + 4);
            hv[8 * j + 0] = a.x; hv[8 * j + 1] = a.y; hv[8 * j + 2] = a.z; hv[8 * j + 3] = a.w; hv[8 * j + 4] = b.x; hv[8 * j + 5] = b.y; hv[8 * j + 6] = b.z; hv[8 * j + 7] = b.w; }
        float ss = 0.f;
#pragma unroll
        for (int i = 0; i < 16; ++i) ss += hv[i] * hv[i];
        const float r = rsqrtf(wave_sum(ss) * (1.f / 1024.f) + RMS_EPS);
#pragma unroll
        for (int j = 0; j < 2; ++j) { const f32x4 a = *(const GAS f32x4*)(gf + 512 * j + 8 * l), b = *(const GAS f32x4*)(gf + 512 * j + 8 * l + 4);
            x[8 * j + 0] = hv[8 * j + 0] * r * a.x; x[8 * j + 1] = hv[8 * j + 1] * r * a.y; x[8 * j + 2] = hv[8 * j + 2] * r * a.z; x[8 * j + 3] = hv[8 * j + 3] * r * a.w;
            x[8 * j + 4] = hv[8 * j + 4] * r * b.x; x[8 * j + 5] = hv[8 * j + 5] * r * b.y; x[8 * j + 6] = hv[8 * j + 6] * r * b.z; x[8 * j + 7] = hv[8 * j + 7] * r * b.w; }
#pragma unroll
        for (int i = 0; i < 16; ++i) y[i] = 0.f;
        const int e_lo = EXPT[(size_t)tok * 128 + l], e_hi = EXPT[(size_t)tok * 128 + 64 + l];
        const float g_lo = GATE[(size_t)tok * 128 + l], g_hi = GATE[(size_t)tok * 128 + 64 + l];
#pragma unroll 2
        for (int e = 0; e < 128; ++e) {
            const int ex = __shfl(e < 64 ? e_lo : e_hi, e & 63); const float gt = __shfl(e < 64 ? g_lo : g_hi, e & 63);
            const bf16* ur = U + (size_t)ex * 1024 + 8 * l; const bf16* vr = V + (size_t)ex * 1024 + 8 * l;
            const v4u u0 = *(const GAS v4u*)ur, u1 = *(const GAS v4u*)(ur + 512), v0 = *(const GAS v4u*)vr, v1 = *(const GAS v4u*)(vr + 512);
            float d = x[0] * bflo(u0.x) + x[1] * bfhi(u0.x) + x[2] * bflo(u0.y) + x[3] * bfhi(u0.y) + x[4] * bflo(u0.z) + x[5] * bfhi(u0.z) + x[6] * bflo(u0.w) + x[7] * bfhi(u0.w)
                    + x[8] * bflo(u1.x) + x[9] * bfhi(u1.x) + x[10] * bflo(u1.y) + x[11] * bfhi(u1.y) + x[12] * bflo(u1.z) + x[13] * bfhi(u1.z) + x[14] * bflo(u1.w) + x[15] * bfhi(u1.w);
            d = wave_sum(d);
            const float w = gt * 0.5f * d * (1.f + erff(d * 0.70710678118654752f));
            y[0] += w * bflo(v0.x); y[1] += w * bfhi(v0.x); y[2] += w * bflo(v0.y); y[3] += w * bfhi(v0.y); y[4] += w * bflo(v0.z); y[5] += w * bfhi(v0.z); y[6] += w * bflo(v0.w); y[7] += w * bfhi(v0.w);
            y[8] += w * bflo(v1.x); y[9] += w * bfhi(v1.x); y[10] += w * bflo(v1.y); y[11] += w * bfhi(v1.y); y[12] += w * bflo(v1.z); y[13] += w * bfhi(v1.z); y[14] += w * bflo(v1.w); y[15] += w * bfhi(v1.w);
        }
        float s2 = 0.f;
#pragma unroll
        for (int i = 0; i < 16; ++i) { hv[i] += y[i]; s2 += hv[i] * hv[i]; }
#pragma unroll
        for (int j = 0; j < 2; ++j) { *(GAS f32x4*)(hrow + 512 * j + 8 * l) = (f32x4){hv[8 * j], hv[8 * j + 1], hv[8 * j + 2], hv[8 * j + 3]}; *(GAS f32x4*)(hrow + 512 * j + 8 * l + 4) = (f32x4){hv[8 * j + 4], hv[8 * j + 5], hv[8 * j + 6], hv[8 * j + 7]}; }
        if (layer < DEPTH - 1) {
            const float r2 = rsqrtf(wave_sum(s2) * (1.f / 1024.f) + RMS_EPS);
            bf16* xo = (bf16*)(C.ws + WS_XN) + (size_t)tok * 1024;
#pragma unroll
            for (int j = 0; j < 2; ++j) { const f32x4 a = *(const GAS f32x4*)(gn + 512 * j + 8 * l), b = *(const GAS f32x4*)(gn + 512 * j + 8 * l + 4);
                v4u o; o.x = pk2(hv[8 * j] * r2 * a.x, hv[8 * j + 1] * r2 * a.y); o.y = pk2(hv[8 * j + 2] * r2 * a.z, hv[8 * j + 3] * r2 * a.w);
                o.z = pk2(hv[8 * j + 4] * r2 * b.x, hv[8 * j + 5] * r2 * b.y); o.w = pk2(hv[8 * j + 6] * r2 * b.z, hv[8 * j + 7] * r2 * b.w);
                *(GAS v4u*)(xo + 512 * j + 8 * l) = o; }
        }
    }
}

#ifndef MK_SINGLE
#define MK_SINGLE 0
#endif
#ifndef MK_FASTGEMM
#define MK_FASTGEMM 1
#endif
constexpr int STEPS = 10, NPHASE = 1 + DEPTH * STEPS;
struct Args { const float* in[21]; float* out; unsigned char* ws; int ph_lo, ph_hi; };

template <int EPI>
__device__ __forceinline__ void do_gemm(const Ctx& C, const bf16* A, const bf16* Bt, int N, bf16* Ob, int ldc, int split, const float* base, float* outf) {
#if MK_FASTGEMM
    pg8::Gemm g{A, Bt, NTOK, N, 1024}; pg8::StaticOrder S; S.init(NTOK, N, C.G, (int)blockIdx.x);
    if constexpr (EPI == 0) { pg8::EpiBf16<0> E{Ob, ldc, nullptr, split ? 1024 : 0, PSTRIDE, 1.f}; pg8::gemm_phase<pg8::EpiBf16<0>, pg8::StaticOrder, true, true>(C.lds, g, S, E); }
    else { pg8::EpiResF32 E{base, outf, 1024}; pg8::gemm_phase<pg8::EpiResF32, pg8::StaticOrder, true, true>(C.lds, g, S, E); }
#else
    simple_gemm<EPI>(C, A, Bt, N, 1024, Ob, ldc, split, base, outf);
#endif
}

template <int STEP, int MIXER>
__device__ __forceinline__ void run_step(const Ctx& C, int layer) {
    const int jx = layer / 3;
    bf16* XN = (bf16*)(C.ws + WS_XN); bf16* P = (bf16*)(C.ws + WS_P); bf16* OB = (bf16*)(C.ws + WS_OB); bf16* Q2 = (bf16*)(C.ws + WS_Q2);
    if constexpr (STEP == 0) {
        const bf16* Wt = MIXER == 0 ? (const bf16*)(C.ws + WS_FOXWIN) + (size_t)jx * 4096 * 1024 : MIXER == 1 ? (const bf16*)(C.ws + WS_GLAWIN) : (const bf16*)(C.ws + WS_HGRNWIN);
        do_gemm<0>(C, XN, Wt, MIXER == 1 ? 3072 : 4096, P, 1024, 1, nullptr, nullptr);
    } else if constexpr (STEP == 1) {
        if constexpr (MIXER == 0) fox_step1(C, jx); else if constexpr (MIXER == 1) gla_step1(C); else hgrn_step1(C);
    } else if constexpr (STEP == 2) {
        if constexpr (MIXER == 0) fox_step2(C);
    } else if constexpr (STEP == 3) {
        if constexpr (MIXER == 0) fox_attn_naive(C);
        else if constexpr (MIXER == 1) rec_naive<4, 256>(C, P, 0, P, 512, P + PSTRIDE, (const float*)(C.ws + WS_GLOG), 512);
        else rec_naive<8, 128>(C, P, 0, P + PSTRIDE, 0, P + 2 * PSTRIDE, (const float*)(C.ws + WS_GLOG), 1024);
    } else if constexpr (STEP == 4) {
        if constexpr (MIXER == 1) rec_norm_gate<256>(C, C.in[11], P + 2 * PSTRIDE);
        else if constexpr (MIXER == 2) rec_norm_gate<128>(C, C.in[15], P + 3 * PSTRIDE);
    } else if constexpr (STEP == 5) {
        const bf16* Wt = MIXER == 0 ? (const bf16*)(C.ws + WS_FOXWOUT) + (size_t)jx * 1024 * 1024 : MIXER == 1 ? (const bf16*)(C.ws + WS_GLAWOUT) : (const bf16*)(C.ws + WS_HGRNWOUT);
        do_gemm<1>(C, OB, Wt, 1024, nullptr, 0, 0, layer == 0 ? C.in[0] : C.out, C.out);
    } else if constexpr (STEP == 6) {
        for (int m = C.gw; m < NTOK; m += C.NGW) rms_row_to_bf16(C.lane, C.out + (size_t)m * 1024, C.in[2] + layer * 1024, XN + (size_t)m * 1024);
    } else if constexpr (STEP == 7) {
        do_gemm<0>(C, XN, (const bf16*)(C.ws + WS_PEERWQ) + (size_t)layer * 2048 * 1024, 2048, Q2, 2048, 0, nullptr, nullptr);
    } else if constexpr (STEP == 8) {
        peer_topk(C, layer);
    } else if constexpr (STEP == 9) {
        peer_gather(C, layer);
    } else {
        p0_prologue(C);
    }
}

__device__ __forceinline__ void make_ctx(Ctx& C, const Args& args, unsigned char* lds_raw) {
    C.lds = (LAS unsigned char*)lds_raw;
    C.tid = threadIdx.x; C.lane = C.tid & 63; C.wave = __builtin_amdgcn_readfirstlane(C.tid >> 6);
    C.G = gridDim.x; { const int bx = blockIdx.x; C.vcu = (C.G % 8 == 0) ? (bx % 8) * (C.G / 8) + bx / 8 : bx; }
    C.gw = C.vcu * NWAVES + C.wave; C.NGW = C.G * NWAVES;
#pragma unroll
    for (int i = 0; i < 21; ++i) C.in[i] = args.in[i];
    C.out = args.out; C.ws = args.ws;
}

template <int STEP, int MIXER>
__global__ void __launch_bounds__(NWAVES * 64, 2) mk_phase(Args args, int layer) {
    extern __shared__ __attribute__((aligned(16))) unsigned char lds_raw[];
    Ctx C; make_ctx(C, args, lds_raw);
    run_step<STEP, MIXER>(C, layer);
}

template <int STEP, int MIXER>
static void launch_phase(const Args& a, int layer, int grid, hipStream_t stream) {
    static bool attr_set = false;
    if (!attr_set) { (void)hipFuncSetAttribute((const void*)mk_phase<STEP, MIXER>, hipFuncAttributeMaxDynamicSharedMemorySize, LDS_BYTES); attr_set = true; }
    hipLaunchKernelGGL((mk_phase<STEP, MIXER>), dim3(grid), dim3(NWAVES * 64), LDS_BYTES, stream, a, layer);
}
template <int MIXER>
static void launch_layer(const Args& a, int layer, int grid, hipStream_t stream) {
    launch_phase<0, MIXER>(a, layer, grid, stream);
    launch_phase<1, MIXER>(a, layer, grid, stream);
    if (MIXER == 0) launch_phase<2, MIXER>(a, layer, grid, stream);
    launch_phase<3, MIXER>(a, layer, grid, stream);
    if (MIXER != 0) launch_phase<4, MIXER>(a, layer, grid, stream);
    launch_phase<5, MIXER>(a, layer, grid, stream);
    launch_phase<6, 0>(a, layer, grid, stream);
    launch_phase<7, 0>(a, layer, grid, stream);
    launch_phase<8, 0>(a, layer, grid, stream);
    launch_phase<9, 0>(a, layer, grid, stream);
}

extern "C" void kernel_launch(void* const* d_in, const int* in_sizes, int n_in, void* d_out, int out_size, void* d_ws, size_t ws_size, hipStream_t stream) {
    static int grid = 0;
    if (grid == 0) {
        if (n_in != 21 || out_size != NTOK * 1024 || ws_size < WS_END) { fprintf(stderr, "kernel_launch: unexpected shapes: n_in %d out %d ws %zu (need %zu)\n", n_in, out_size, ws_size, (size_t)WS_END); grid = -1; return; }
        int dev = 0, cus = 0;
        (void)hipGetDevice(&dev); (void)hipDeviceGetAttribute(&cus, hipDeviceAttributeMultiprocessorCount, dev);
        grid = cus;
    }
    if (grid < 0) return;
    Args a{};
    for (int i = 0; i < 21; ++i) a.in[i] = (const float*)d_in[i];
    a.out = (float*)d_out; a.ws = (unsigned char*)d_ws;
    launch_phase<10, 0>(a, 0, grid, stream);
    launch_layer<0>(a, 0, grid, stream);
    launch_layer<1>(a, 1, grid, stream);
    launch_layer<2>(a, 2, grid, stream);
    launch_layer<0>(a, 3, grid, stream);
}
```

```cpp
#include <hip/hip_runtime.h>
#include <hip/hip_cooperative_groups.h>
#include <cstdio>
#include <cstdint>
#include <cmath>
namespace pg8 {
#define PG8_LAS __attribute__((address_space(3)))
typedef unsigned short bf16_t;
typedef short bf16x8 __attribute__((ext_vector_type(8)));
typedef float f32x4 __attribute__((ext_vector_type(4)));
typedef unsigned u32x4 __attribute__((ext_vector_type(4)));
typedef int i32x4 __attribute__((ext_vector_type(4)));
constexpr int BM = 256, BK = 64, HALF = 128, HTB = HALF * BK * 2  , STAGE_BYTES = 8 * HTB, NXCD = 8, WGM = 8;

__host__ __device__ __forceinline__ int lds_byte(int r, int c) { const int st = (r >> 4) * 2 + (c >> 5), rr = r & 15, cc = c & 31, ob = rr * 64 + cc * 2; return st * 1024 + (ob ^ (((ob >> 9) & 1) << 5)); }
__host__ __device__ __forceinline__ void stage_rc(int b, int& R, int& C) { const int st = b / 1024, sb = b % 1024, swz = sb ^ (((sb >> 9) & 1) << 5); R = (st >> 1) * 16 + swz / 64; C = (st & 1) * 32 + (swz % 64) / 2; }
__host__ __device__ __forceinline__ int perm32(int rho) { const int n = rho >> 4, i = rho & 15; return 8 * (i >> 2) + 4 * n + (i & 3); }

struct Unit { int pm, pn; };
struct Gemm { const bf16_t* A; const bf16_t* Bt; int M, N, K; };

struct StaticOrder {
    int nM, nN, nwg, G, c;
    __host__ __device__ void init(int M, int N, int G_, int c_) { nM = M / BM; nN = N / BM; nwg = nM * nN; G = G_; c = c_; }
    __host__ __device__ bool next(int i, Unit& u) const {
        const long L = (long)i * G + c; if (L >= nwg) return false;
        int wgid = (int)L; { const int q = nwg / NXCD, r = nwg % NXCD, xcd = wgid % NXCD, off = wgid / NXCD; wgid = (xcd < r ? xcd * (q + 1) : r * (q + 1) + (xcd - r) * q) + off; }
        const int nig = WGM * nN, gid = wgid / nig, fm = gid * WGM, gsz = (nM - fm) < WGM ? (nM - fm) : WGM;
        u.pm = fm + ((wgid % nig) % gsz); u.pn = (wgid % nig) / gsz; return true;
    }
    __device__ __forceinline__ void a_ready(const Unit&) const {}
    __device__ __forceinline__ void done(const Unit&) const {}
};

__device__ __forceinline__ unsigned cvt_pk_bf16(float lo, float hi) { unsigned r; asm volatile("v_cvt_pk_bf16_f32 %0, %1, %2" : "=v"(r) : "v"(lo), "v"(hi)); return r; }
typedef float f32x2 __attribute__((ext_vector_type(2)));
__device__ __forceinline__ f32x2 gelu_pk(f32x2 v) {
    const f32x2 av = __builtin_elementwise_abs(v), d = av * 0.2316418882f + 1.0f;
    f32x2 t; t.x = __builtin_amdgcn_rcpf(d.x); t.y = __builtin_amdgcn_rcpf(d.y);
    f32x2 q = t * 0.5307027145f + (-0.7265760135f); q = q * t + 0.7107068705f; q = q * t + (-0.142248368f); q = q * t + 0.127414796f; q = q * t;
    const f32x2 s = (v * v) * (-0.72134752044f);
    f32x2 e; e.x = __builtin_amdgcn_exp2f(s.x); e.y = __builtin_amdgcn_exp2f(s.y);
    const f32x2 m = v * (q * e), r = v - m;
    f32x2 o; o.x = v.x < 0.f ? m.x : r.x; o.y = v.y < 0.f ? m.y : r.y; return o;
}
template <bool F16  > struct EpiBf16R {
    typedef f32x4 acc_t;
    static constexpr bool PERM = true, AFTER_DRAIN = false;
    bf16_t* O; int ldc; int split_cols; size_t split_stride; const float* rs;
    __device__ __forceinline__ void operator()(const f32x4 (&acc)[2][2][4][2], const Unit& u, int wr, int wc, int fr, int fq) const {
        const int row0 = u.pm * BM + wr * 64 + fr; int colt = u.pn * BM; bf16_t* base = O;
        if (split_cols) { const int t = colt / split_cols; base += (size_t)t * split_stride; colt -= t * split_cols; }
        const int col0 = colt + wc * 32 + 8 * fq;
#pragma unroll
        for (int ai = 0; ai < 2; ++ai)
#pragma unroll
            for (int m = 0; m < 4; ++m) { const int row = row0 + ai * HALF + m * 16; bf16_t* rowp = base + (size_t)row * ldc + col0;
                float sc = 1.f;
                if (rs) { const f32x4 a = *(const f32x4*)(rs + (size_t)row * 16), b = *(const f32x4*)(rs + (size_t)row * 16 + 4), c = *(const f32x4*)(rs + (size_t)row * 16 + 8), d = *(const f32x4*)(rs + (size_t)row * 16 + 12);
                    const float s = (((a[0] + a[1]) + (a[2] + a[3])) + ((b[0] + b[1]) + (b[2] + b[3]))) + (((c[0] + c[1]) + (c[2] + c[3])) + ((d[0] + d[1]) + (d[2] + d[3])));
                    sc = __builtin_amdgcn_rsqf(s * (1.0f / 1024.0f) + 1e-6f); }
#pragma unroll
                for (int bj = 0; bj < 2; ++bj) { const f32x4 v0 = acc[ai][bj][m][0] * sc, v1 = acc[ai][bj][m][1] * sc;
                    u32x4 w;
                    if (F16) { w.x = __builtin_bit_cast(unsigned, __builtin_amdgcn_cvt_pkrtz(v0[0], v0[1])); w.y = __builtin_bit_cast(unsigned, __builtin_amdgcn_cvt_pkrtz(v0[2], v0[3])); w.z = __builtin_bit_cast(unsigned, __builtin_amdgcn_cvt_pkrtz(v1[0], v1[1])); w.w = __builtin_bit_cast(unsigned, __builtin_amdgcn_cvt_pkrtz(v1[2], v1[3])); }
                    else { w.x = cvt_pk_bf16(v0[0], v0[1]); w.y = cvt_pk_bf16(v0[2], v0[3]); w.z = cvt_pk_bf16(v1[0], v1[1]); w.w = cvt_pk_bf16(v1[2], v1[3]); }
                    *(u32x4*)(rowp + bj * HALF) = w; } }
    }
};
struct EpiI8 {
    typedef i32x4 acc_t;
    static constexpr bool PERM = true, AFTER_DRAIN = false;
    bf16_t* O; size_t split_stride; const float* sx; const float* sw;
    __device__ __forceinline__ void operator()(const i32x4 (&acc)[2][2][4][2], const Unit& u, int wr, int wc, int fr, int fq) const {
        const int row0 = u.pm * BM + wr * 64 + fr; int colt = u.pn * BM; bf16_t* base = O;
        { const int t = colt / 1024; base += (size_t)t * split_stride; colt -= t * 1024; }
        const int col0 = colt + wc * 32 + 8 * fq, scol0 = u.pn * BM + wc * 32 + 8 * fq;
        f32x4 cw[2][2];
#pragma unroll
        for (int bj = 0; bj < 2; ++bj) { cw[bj][0] = *(const f32x4*)(sw + scol0 + bj * HALF); cw[bj][1] = *(const f32x4*)(sw + scol0 + bj * HALF + 4); }
#pragma unroll
        for (int ai = 0; ai < 2; ++ai)
#pragma unroll
            for (int m = 0; m < 4; ++m) { const int row = row0 + ai * HALF + m * 16; bf16_t* rowp = base + (size_t)row * 1024 + col0; const float rs = sx[row];
#pragma unroll
                for (int bj = 0; bj < 2; ++bj) { const i32x4 a0 = acc[ai][bj][m][0], a1 = acc[ai][bj][m][1];
                    const f32x4 v0 = (f32x4){(float)a0[0], (float)a0[1], (float)a0[2], (float)a0[3]} * cw[bj][0] * rs, v1 = (f32x4){(float)a1[0], (float)a1[1], (float)a1[2], (float)a1[3]} * cw[bj][1] * rs;
                    u32x4 w; w.x = cvt_pk_bf16(v0[0], v0[1]); w.y = cvt_pk_bf16(v0[2], v0[3]); w.z = cvt_pk_bf16(v1[0], v1[1]); w.w = cvt_pk_bf16(v1[2], v1[3]);
                    *(u32x4*)(rowp + bj * HALF) = w; } }
    }
};
struct EpiResNorm {
    typedef f32x4 acc_t;
    static constexpr bool PERM = false, AFTER_DRAIN = false;
    const float* base; float* out; bf16_t* hg; const float* gain; float* rs;
    __device__ __forceinline__ void operator()(const f32x4 (&acc)[2][2][4][2], const Unit& u, int wr, int wc, int fr, int fq) const {
        const int col0 = u.pn * BM + wc * 32 + 4 * fq, lane = fr + 16 * fq;
        f32x4 gv[2][2];
#pragma unroll
        for (int bj = 0; bj < 2; ++bj)
#pragma unroll
            for (int n = 0; n < 2; ++n) gv[bj][n] = *(const f32x4*)(gain + col0 + bj * HALF + n * 16);
#pragma unroll
        for (int ai = 0; ai < 2; ++ai)
#pragma unroll
            for (int m = 0; m < 4; ++m) { const int r = ai * HALF + wr * 64 + m * 16 + fr; const size_t off = (size_t)(u.pm * BM + r) * 1024 + col0;
                float ss = 0.f;
#pragma unroll
                for (int bj = 0; bj < 2; ++bj)
#pragma unroll
                    for (int n = 0; n < 2; ++n) { const f32x4 o = *(const f32x4*)(base + off + bj * HALF + n * 16) + acc[ai][bj][m][n]; *(f32x4*)(out + off + bj * HALF + n * 16) = o;
                        ss += (o[0] * o[0] + o[1] * o[1]) + (o[2] * o[2] + o[3] * o[3]);
                        const f32x4 h = o * gv[bj][n]; typedef unsigned u32x2 __attribute__((ext_vector_type(2))); u32x2 w; w.x = cvt_pk_bf16(h[0], h[1]); w.y = cvt_pk_bf16(h[2], h[3]);
                        *(u32x2*)(hg + off + bj * HALF + n * 16) = w; }
                ss += __builtin_bit_cast(float, __builtin_amdgcn_ds_bpermute((lane ^ 16) << 2, __builtin_bit_cast(int, ss)));
                ss += __builtin_bit_cast(float, __builtin_amdgcn_ds_bpermute((lane ^ 32) << 2, __builtin_bit_cast(int, ss)));
                if (fq == 0) rs[(size_t)(u.pm * BM + r) * 16 + u.pn * 4 + wc] = ss; }
    }
};
__device__ __forceinline__ f32x4 mma16(bf16x8 a, bf16x8 b, f32x4 c) { return __builtin_amdgcn_mfma_f32_16x16x32_bf16(a, b, c, 0, 0, 0); }
__device__ __forceinline__ i32x4 mma16(bf16x8 a, bf16x8 b, i32x4 c) { return __builtin_amdgcn_mfma_i32_16x16x64_i8(__builtin_bit_cast(i32x4, a), __builtin_bit_cast(i32x4, b), c, 0, 0, 0); }
template <class Epi, class Sched, bool ALIGN_EPI = false, bool SP2 = false>
__device__ __forceinline__ void gemm_phase(PG8_LAS unsigned char* lds, const Gemm g, const Sched& S, const Epi& E, int tid_in) {
    int tid_ = tid_in; asm volatile("" : "+v"(tid_));
    const int tid = tid_, wid = __builtin_amdgcn_readfirstlane(tid >> 6), lane = tid & 63, wr = wid >> 2, wc = wid & 3, fr = lane & 15, fq = lane >> 4;
    const int K = g.K, nt = K / BK;
    unsigned voffA[2], voffB[2];
#pragma unroll
    for (int i = 0; i < 2; ++i) { int R, C; stage_rc(tid * 16 + i * 8192, R, C); const int Rb = Epi::PERM ? ((R & ~31) + perm32(R & 31)) : R;
        voffA[i] = (unsigned)(R * K + C) * 2u; voffB[i] = (unsigned)(Rb * K + C) * 2u; }
    const size_t kstep = (size_t)(BK * 2);
    const size_t hstep = (size_t)HALF * K * 2;
    const size_t tstep = 2 * hstep;
    const unsigned ldsw = (unsigned)wid * 1024u;
    const int aoff = lds_byte(wr * 64 + fr, fq * 8), boff = lds_byte(wc * 32 + fr, fq * 8);
#define PG8_SA(b, h) (((b) * 2 + (h)) * HTB)
#define PG8_SB(b, h) ((4 + (b) * 2 + (h)) * HTB)
#define PG8_STAGE(bufoff, gbase, voff) do { _Pragma("unroll") for (int _i = 0; _i < 2; ++_i) \
        __builtin_amdgcn_global_load_lds((const unsigned*)((const char*)(gbase) + (voff)[_i]), (PG8_LAS unsigned*)(lds + (bufoff) + ldsw + _i * 8192), 16, 0, 0); } while (0)
#define PG8_LDA(dst, b, h) do { _Pragma("unroll") for (int m = 0; m < 4; ++m) _Pragma("unroll") for (int k = 0; k < 2; ++k) dst[m][k] = *(const PG8_LAS bf16x8*)(lds + PG8_SA(b, h) + aoff + m * 2048 + k * 1024); } while (0)
#define PG8_LDB(dst, b, h) do { _Pragma("unroll") for (int n = 0; n < 2; ++n) _Pragma("unroll") for (int k = 0; k < 2; ++k) dst[n][k] = *(const PG8_LAS bf16x8*)(lds + PG8_SB(b, h) + boff + n * 2048 + k * 1024); } while (0)
#define PG8_MMA(ai, bj, At, Bt) do { __builtin_amdgcn_s_setprio(1); _Pragma("unroll") for (int m = 0; m < 4; ++m) _Pragma("unroll") for (int n = 0; n < 2; ++n) _Pragma("unroll") for (int k = 0; k < 2; ++k) \
        acc[ai][bj][m][n] = mma16(Bt[n][k], At[m][k], acc[ai][bj][m][n]); __builtin_amdgcn_s_setprio(0); } while (0)
#define PG8_WAIT_V(n) asm volatile("s_waitcnt vmcnt(" #n ")" ::: "memory")
#define PG8_WAIT_L(n) asm volatile("s_waitcnt lgkmcnt(" #n ")" ::: "memory")
#define PG8_BAR __builtin_amdgcn_s_barrier()
#define PG8_SCHED __builtin_amdgcn_sched_barrier(0)
    Unit cur, nxt; int ui = 0;
    if (!S.next(0, cur)) return;
    typedef typename Epi::acc_t acc_t;
    acc_t acc[2][2][4][2];
#pragma unroll
    for (int a = 0; a < 2; ++a)
#pragma unroll
        for (int b = 0; b < 2; ++b)
#pragma unroll
            for (int m = 0; m < 4; ++m)
#pragma unroll
                for (int n = 0; n < 2; ++n) acc[a][b][m][n] = (acc_t){0, 0, 0, 0};
    bf16x8 At[4][2], B0[2][2], B1[2][2];
    const char* cA = (const char*)g.A + (size_t)cur.pm * tstep; const char* cB = (const char*)g.Bt + (size_t)cur.pn * tstep;
    S.a_ready(cur);
    if constexpr (SP2) {
        PG8_STAGE(PG8_SB(0, 0), cB, voffB); PG8_STAGE(PG8_SB(0, 1), cB + hstep, voffB); PG8_STAGE(PG8_SA(0, 0), cA, voffA); PG8_STAGE(PG8_SA(0, 1), cA + hstep, voffA);
        if (wr == 1) PG8_BAR;
        PG8_WAIT_V(2); PG8_BAR;
        PG8_STAGE(PG8_SB(1, 0), cB + kstep, voffB); PG8_STAGE(PG8_SA(1, 0), cA + kstep, voffA); PG8_STAGE(PG8_SB(1, 1), cB + hstep + kstep, voffB);
        PG8_WAIT_V(6); PG8_BAR;
    } else {
        PG8_STAGE(PG8_SB(0, 0), cB, voffB); PG8_STAGE(PG8_SA(0, 0), cA, voffA); PG8_STAGE(PG8_SB(0, 1), cB + hstep, voffB); PG8_STAGE(PG8_SA(0, 1), cA + hstep, voffA);
        if (wr == 1) PG8_BAR;
        PG8_WAIT_V(4); PG8_BAR;
        PG8_STAGE(PG8_SB(1, 0), cB + kstep, voffB); PG8_STAGE(PG8_SA(1, 0), cA + kstep, voffA); PG8_STAGE(PG8_SB(1, 1), cB + hstep + kstep, voffB);
        PG8_WAIT_V(6); PG8_BAR;
    }
    for (;;) {
        const bool has_next = S.next(ui + 1, nxt);
        const char* nA = has_next ? (const char*)g.A + (size_t)nxt.pm * tstep : cA; const char* nB = has_next ? (const char*)g.Bt + (size_t)nxt.pn * tstep : cB;
        for (int t = 0; t < nt; t += 2) {
            const bool last = (t == nt - 2);
            const char* a1 = cA + (size_t)(t + 1) * kstep;
            const char* a2 = last ? nA : cA + (size_t)(t + 2) * kstep; const char* b2 = last ? nB : cB + (size_t)(t + 2) * kstep;
            const char* a3 = a2 + kstep; const char* b3 = b2 + kstep;
            if (last && has_next) S.a_ready(nxt);
            if constexpr (SP2) {
            PG8_LDB(B0, 0, 0); PG8_LDB(B1, 0, 1); PG8_SCHED; PG8_LDA(At, 0, 0); PG8_STAGE(PG8_SA(1, 1), a1 + hstep, voffA);
            PG8_WAIT_V(8); PG8_WAIT_L(0); PG8_BAR; PG8_MMA(0, 0, At, B0); PG8_MMA(0, 1, At, B1); PG8_BAR; PG8_SCHED;
            PG8_LDA(At, 0, 1); PG8_STAGE(PG8_SB(0, 0), b2, voffB); PG8_STAGE(PG8_SB(0, 1), b2 + hstep, voffB); PG8_STAGE(PG8_SA(0, 0), a2, voffA);
            PG8_WAIT_V(8); PG8_WAIT_L(0); PG8_BAR; PG8_MMA(1, 0, At, B0); PG8_MMA(1, 1, At, B1); PG8_BAR; PG8_SCHED;
            PG8_LDB(B0, 1, 0); PG8_LDB(B1, 1, 1); PG8_SCHED; PG8_LDA(At, 1, 0); PG8_STAGE(PG8_SA(0, 1), a2 + hstep, voffA);
            PG8_WAIT_V(8); PG8_WAIT_L(0); PG8_BAR; PG8_MMA(0, 0, At, B0); PG8_MMA(0, 1, At, B1); PG8_BAR; PG8_SCHED;
            PG8_LDA(At, 1, 1); PG8_STAGE(PG8_SB(1, 0), b3, voffB); PG8_STAGE(PG8_SB(1, 1), b3 + hstep, voffB); PG8_STAGE(PG8_SA(1, 0), a3, voffA);
            PG8_WAIT_V(8); PG8_WAIT_L(0); PG8_BAR; PG8_MMA(1, 0, At, B0); PG8_MMA(1, 1, At, B1); PG8_BAR; PG8_SCHED;
            } else {
            PG8_LDB(B0, 0, 0); PG8_SCHED; PG8_LDA(At, 0, 0); PG8_STAGE(PG8_SA(1, 1), a1 + hstep, voffA);
            PG8_WAIT_L(8); PG8_BAR; PG8_WAIT_L(0); PG8_MMA(0, 0, At, B0); PG8_BAR; PG8_SCHED;
            PG8_LDB(B1, 0, 1); PG8_STAGE(PG8_SB(0, 0), b2, voffB);
            PG8_BAR; PG8_WAIT_L(0); PG8_MMA(0, 1, At, B1); PG8_BAR;
            PG8_LDA(At, 0, 1); PG8_STAGE(PG8_SA(0, 0), a2, voffA);
            PG8_BAR; PG8_WAIT_L(0); PG8_MMA(1, 0, At, B0); PG8_BAR; PG8_SCHED;
            PG8_STAGE(PG8_SB(0, 1), b2 + hstep, voffB);
            PG8_WAIT_V(6); PG8_BAR; PG8_MMA(1, 1, At, B1); PG8_BAR;
            PG8_LDB(B0, 1, 0); PG8_SCHED; PG8_LDA(At, 1, 0); PG8_STAGE(PG8_SA(0, 1), a2 + hstep, voffA);
            PG8_WAIT_L(8); PG8_BAR; PG8_WAIT_L(0); PG8_MMA(0, 0, At, B0); PG8_BAR; PG8_SCHED;
            PG8_LDB(B1, 1, 1); PG8_STAGE(PG8_SB(1, 0), b3, voffB);
            PG8_BAR; PG8_WAIT_L(0); PG8_MMA(0, 1, At, B1); PG8_BAR;
            PG8_LDA(At, 1, 1); PG8_STAGE(PG8_SA(1, 0), a3, voffA);
            PG8_BAR; PG8_WAIT_L(0); PG8_MMA(1, 0, At, B0); PG8_BAR; PG8_SCHED;
            PG8_STAGE(PG8_SB(1, 1), b3 + hstep, voffB);
            PG8_WAIT_V(6); PG8_BAR; PG8_MMA(1, 1, At, B1); PG8_BAR;
            }
        }
        if constexpr (ALIGN_EPI) { if (wr == 0) PG8_BAR; }
        if constexpr (!Epi::AFTER_DRAIN) { E(acc, cur, wr, wc, fr, fq); S.done(cur); }
        if (!has_next) break;
#pragma unroll
        for (int a = 0; a < 2; ++a)
#pragma unroll
            for (int b = 0; b < 2; ++b)
#pragma unroll
                for (int m = 0; m < 4; ++m)
#pragma unroll
                    for (int n = 0; n < 2; ++n) acc[a][b][m][n] = (acc_t){0, 0, 0, 0};
        cur = nxt; cA = nA; cB = nB; ++ui;
        if constexpr (ALIGN_EPI) { if (wr == 1) PG8_BAR; }
    }
    PG8_WAIT_V(0);
    if constexpr (!ALIGN_EPI) { if (wr == 0) PG8_BAR; }
    PG8_BAR;
    if constexpr (Epi::AFTER_DRAIN) { E.fused(acc, cur, wr, wc, fr, fq, lds, wid, lane); S.done(cur); }
#undef PG8_SA
#undef PG8_SB
#undef PG8_STAGE
#undef PG8_LDA
#undef PG8_LDB
#undef PG8_MMA
#undef PG8_WAIT_V
#undef PG8_WAIT_L
#undef PG8_BAR
#undef PG8_SCHED
}
}
#include <hip/hip_bf16.h>
#include <cmath>
namespace attn_body {
using bf16=__hip_bfloat16;
using bf16x8=__attribute__((ext_vector_type(8)))short;
using s16x4=__attribute__((ext_vector_type(4)))short;
using f32x16=__attribute__((ext_vector_type(16)))float;
using u32x4=__attribute__((ext_vector_type(4)))unsigned;
constexpr int BATCH=8,NHEAD=16,SEQ=2048,D=64,DM=NHEAD*D;
constexpr int NW=8,QBLK=32,QB=QBLK*NW,KVBLK=64,NQB=SEQ/QB;
constexpr int ATTN_PITCH=DM, ATTN_UNIT_ROWS=QB;
__device__ __forceinline__ int crow(int r,int hi){return (r&3)+8*(r>>2)+4*hi;}
#define SBAR() __builtin_amdgcn_sched_barrier(0)
__device__ __forceinline__ void cmask(f32x16&p0,f32x16&p1,int jb,int qrel,int hi){
  const float NEG=-INFINITY; int kb=64*jb+4*hi;
  #pragma unroll
  for(int r=0;r<16;++r){int kv=kb+(r&3)+8*(r>>2); if(kv>qrel)p0[r]=NEG; if(kv+32>qrel)p1[r]=NEG;}
}

constexpr int NSLOT=3, SLOTB=8192;
constexpr int LDS_K=0, LDS_V=NSLOT*SLOTB, LDS_WS=2*NSLOT*SLOTB, LDS_OST=LDS_WS+NW*64*4, LDS_CS=LDS_OST+NW*4096, LDS_BYTES=LDS_CS+SEQ*4;
constexpr float C2=0.125f*1.4426950408889634f;
__device__ __forceinline__ void glds16(const void*gsrc,unsigned lds_dst){unsigned keep;
  asm volatile("s_mov_b32 %0, m0\n\ts_mov_b32 m0, %2\n\ts_nop 0\n\tglobal_load_lds_dwordx4 %1, off\n\ts_mov_b32 m0, %0":"=&s"(keep):"v"(gsrc),"s"(lds_dst):"memory");}
__device__ __forceinline__ float max3f(float a,float b,float c){float r;asm("v_max3_f32 %0, %1, %2, %3":"=v"(r):"v"(a),"v"(b),"v"(c));return r;}
__device__ __forceinline__ float max2f(float a,float b){float r;asm("v_max_f32_e32 %0, %1, %2":"=v"(r):"v"(a),"v"(b));return r;}
__device__ __forceinline__ float fadd_s(float a,float b){float r;asm("v_add_f32_e32 %0, %1, %2":"=v"(r):"v"(a),"v"(b));return r;}
__device__ __forceinline__ float fsub_s(float a,float b){float r;asm("v_sub_f32_e32 %0, %1, %2":"=v"(r):"v"(a),"v"(b));return r;}
typedef float f32x2_t __attribute__((ext_vector_type(2))); typedef __bf16 bf16x2_t __attribute__((ext_vector_type(2)));
__device__ __forceinline__ unsigned cvtpk_s(float lo,float hi){f32x2_t v={lo,hi};bf16x2_t b=__builtin_convertvector(v,bf16x2_t);return __builtin_bit_cast(unsigned,b);}
#define WAIT_BAR(N) asm volatile("s_waitcnt vmcnt(" #N ") lgkmcnt(0)\n\ts_barrier":::"memory")

typedef __attribute__((address_space(3))) const char* lds_cptr;
__device__ __forceinline__ void qkt(f32x16&p0,f32x16&p1,const char*Kslot,lds_cptr qls,bf16x8 ax0,bf16x8 ax1,bf16x8 qx,int r32,int hi){
  const char*kb=Kslot+hi*1024+r32*16; const f32x16 z16=f32x16{};
  p0=__builtin_amdgcn_mfma_f32_32x32x16_bf16(ax0,qx,z16,0,0,0);p1=__builtin_amdgcn_mfma_f32_32x32x16_bf16(ax1,qx,z16,0,0,0);
  #pragma unroll
  for(int d0=0;d0<4;++d0){
    const bf16x8 b0=*reinterpret_cast<const bf16x8*>(kb+d0*2048);
    const bf16x8 b1=*reinterpret_cast<const bf16x8*>(kb+d0*2048+512);
    const bf16x8 qd=*(const __attribute__((address_space(3))) bf16x8*)(qls+d0*1024);
    p0=__builtin_amdgcn_mfma_f32_32x32x16_bf16(b0,qd,p0,0,0,0);p1=__builtin_amdgcn_mfma_f32_32x32x16_bf16(b1,qd,p1,0,0,0);}
}
typedef short v4i16_t __attribute__((ext_vector_type(4)));
__device__ __forceinline__ void kload8(bf16x8*kf,lds_cptr kp){
  kf[0]=*(const __attribute__((address_space(3))) bf16x8*)(kp);      kf[1]=*(const __attribute__((address_space(3))) bf16x8*)(kp+512);
  kf[2]=*(const __attribute__((address_space(3))) bf16x8*)(kp+2048); kf[3]=*(const __attribute__((address_space(3))) bf16x8*)(kp+2560);
  kf[4]=*(const __attribute__((address_space(3))) bf16x8*)(kp+4096); kf[5]=*(const __attribute__((address_space(3))) bf16x8*)(kp+4608);
  kf[6]=*(const __attribute__((address_space(3))) bf16x8*)(kp+6144); kf[7]=*(const __attribute__((address_space(3))) bf16x8*)(kp+6656);
}
__device__ __forceinline__ void kload2(bf16x8*kf,lds_cptr kp,int j){ kf[2*j]=*(const __attribute__((address_space(3))) bf16x8*)(kp+j*2048); kf[2*j+1]=*(const __attribute__((address_space(3))) bf16x8*)(kp+j*2048+512); }
__device__ __forceinline__ s16x4 vtr(lds_cptr p){ return __builtin_bit_cast(s16x4,__builtin_amdgcn_ds_read_tr16_b64_v4i16((__attribute__((address_space(3))) v4i16_t*)p)); }
__device__ __forceinline__ float rowmax(const f32x16&p0,const f32x16&p1){
  float a=max3f(p0[0],p0[1],p1[0]),b=max3f(p0[2],p0[3],p1[1]);a=max3f(a,p1[2],p1[3]);
  #pragma unroll
  for(int r=4;r<16;r+=4){a=max3f(a,p0[r],p0[r+1]);b=max3f(b,p0[r+2],p0[r+3]);a=max3f(a,p1[r],p1[r+1]);b=max3f(b,p1[r+2],p1[r+3]);}
  const float m=max2f(a,b);
  auto rr=__builtin_amdgcn_permlane32_swap(__float_as_uint(m),__float_as_uint(m),false,false);
  return max2f(__uint_as_float(rr[0]),__uint_as_float(rr[1]));
}
__device__ __forceinline__ void pv(f32x16*o,int vb,bf16x8 pa0,bf16x8 pa1,bf16x8 pa2,bf16x8 pa3){
  #pragma unroll
  for(int d0=0;d0<2;++d0){s16x4 lo[4],hi[4];
    #pragma unroll
    for(int ks=0;ks<4;++ks){
      asm volatile("ds_read_b64_tr_b16 %0,%1 offset:%c2":"=&v"(lo[ks]):"v"(vb),"i"(d0*4096+ks*1024):"memory");
      asm volatile("ds_read_b64_tr_b16 %0,%1 offset:%c2":"=&v"(hi[ks]):"v"(vb),"i"(d0*4096+ks*1024+512):"memory");}
    asm volatile("s_waitcnt lgkmcnt(0)":::"memory");SBAR();
    #define PK(k) (bf16x8){lo[k][0],lo[k][1],lo[k][2],lo[k][3],hi[k][0],hi[k][1],hi[k][2],hi[k][3]}
    o[d0]=__builtin_amdgcn_mfma_f32_32x32x16_bf16(pa0,PK(0),o[d0],0,0,0);
    o[d0]=__builtin_amdgcn_mfma_f32_32x32x16_bf16(pa1,PK(1),o[d0],0,0,0);
    o[d0]=__builtin_amdgcn_mfma_f32_32x32x16_bf16(pa2,PK(2),o[d0],0,0,0);
    o[d0]=__builtin_amdgcn_mfma_f32_32x32x16_bf16(pa3,PK(3),o[d0],0,0,0);
    #undef PK
  }
}

__device__ __forceinline__ void split3(float c,unsigned&hb,unsigned&mb,unsigned&lb){
  hb=__float_as_uint(c)&0xffff0000u; const float r1=c-__uint_as_float(hb); mb=__float_as_uint(r1)&0xffff0000u; const float r2=r1-__uint_as_float(mb); lb=__float_as_uint(r2)&0xffff0000u; }
__device__ __forceinline__ bf16x8 make_ax(float negc){ unsigned hb,mb,lb; split3(negc,hb,mb,lb);
  u32x4 w; w.x=(hb>>16)|mb; w.y=(lb>>16)|0x3f800000u; w.z=0x3f803f80u; w.w=0u; return __builtin_bit_cast(bf16x8,w); }
__device__ __forceinline__ bf16x8 make_qx(float negm,unsigned hm){ unsigned hb,mb,lb; split3(negm,hb,mb,lb);
  u32x4 w; w.x=0x3f803f80u&hm; w.y=(0x3f80u|hb)&hm; w.z=((mb>>16)|lb)&hm; w.w=0u; return __builtin_bit_cast(bf16x8,w); }
#ifndef ATTN_STORE16
#define ATTN_STORE16(p,v) (*(u32x4*)(p)=(v))
#endif
template<int THRL> __device__ __forceinline__ void attn_unit(int b,int h,int qb,const bf16*Q,const bf16*__restrict__ K,const bf16*__restrict__ V,bf16*O,const bf16*__restrict__ Gt,char*shm,const int tid_u){
  int tid=tid_u; asm volatile("":"+v"(tid));
  const int lane=tid&63,r32=lane&31,hi=lane>>5; const int wid=__builtin_amdgcn_readfirstlane(tid>>6);
  const long rowbase=(long)b*SEQ; const int q0=qb*QB;
  const bf16*Qw=Q+(rowbase+q0+wid*QBLK)*DM+h*D;
  float*csp=(float*)(shm+LDS_CS);
  int tskip=0;
  { const float cq0=csp[q0]; const int ntall=(q0+QB)/KVBLK; while(tskip+2<=ntall-4 && csp[KVBLK*(tskip+1)+KVBLK-1]-cq0< -200.f)tskip+=2; tskip=__builtin_amdgcn_readfirstlane(tskip); }
  const bf16*Kh=K+(rowbase+(long)tskip*KVBLK)*DM+h*D,*Vh=V+(rowbase+(long)tskip*KVBLK)*DM+h*D;
  const unsigned lds0=(unsigned)(uintptr_t)shm;
  float*wsf=(float*)(shm+LDS_WS)+wid*64;
  const unsigned koff=(unsigned)(lane*DM+wid*8), voff=(unsigned)((16*(wid&3)+(lane>>2))*DM+(wid>>2)*32+(lane&3)*8);
  const unsigned kdst=lds0+LDS_K+wid*1024, vdst=lds0+LDS_V+wid*1024;
  #define DMA_K(t,slot) do{unsigned o_=koff;asm volatile("":"+v"(o_));glds16(Kh+(long)(t)*KVBLK*DM+o_,(unsigned)__builtin_amdgcn_readfirstlane(kdst+(slot)));}while(0)
  #define DMA_V(t,slot) do{unsigned o_=voff;asm volatile("":"+v"(o_));glds16(Vh+(long)(t)*KVBLK*DM+o_,(unsigned)__builtin_amdgcn_readfirstlane(vdst+(slot)));}while(0)
  const int vb0=(int)(lds0+LDS_V)+((lane>>4)&1)*32+(lane&3)*8+(4*hi+((lane&15)>>2))*64;
  const char*Kbase=shm+LDS_K; bf16x8 kf[8];
  const lds_cptr shm3=(lds_cptr)shm; const lds_cptr kp0=shm3+LDS_K+hi*1024+r32*16; const lds_cptr vp0=shm3+LDS_V+((lane>>4)&1)*32+(lane&3)*8+(4*hi+((lane&15)>>2))*64;
  const int NT=(q0+QB)/KVBLK-tskip;
  const float*cst=csp+tskip*KVBLK;
  const unsigned hm=hi?0u:0xffffffffu;
  DMA_K(0,0);DMA_V(0,0);DMA_K(1,SLOTB);
  const lds_cptr qls=shm3+LDS_OST+wid*4096+hi*512+r32*16;
  { bf16x8 qr[4];
    #pragma unroll
    for(int d0=0;d0<4;++d0)qr[d0]=*reinterpret_cast<const bf16x8*>(&Qw[(long)r32*DM+d0*16+hi*8]);
    #pragma unroll
    for(int d0=0;d0<4;++d0)*(__attribute__((address_space(3))) bf16x8*)(shm3+LDS_OST+wid*4096+hi*512+r32*16+d0*1024)=qr[d0]; }
  #define QLD(k) (*(const __attribute__((address_space(3))) bf16x8*)(qls+(k)*1024))
  float mhat=csp[q0+wid*QBLK+r32],l_reg=0.f;f32x16 o[2];o[0]=f32x16{};o[1]=f32x16{}; bf16x8 qx=make_qx(-mhat,hm);
  const int qrel=wid*QBLK+r32;
  #define CMASK(P0,P1,t) do{int jb_=(t)-(NT-4); if(jb_>=0)cmask(P0,P1,jb_,qrel,hi);}while(0)
  bool resc=false;
  #define START(P0,P1) do{ const float rm=rowmax(P0,P1); resc=false; \
    if(__any(rm>(float)THRL)){ const float dl=__builtin_fmaxf(rm,0.f); mhat=fadd_s(mhat,dl); \
      _Pragma("unroll") for(int r=0;r<16;++r){P0[r]=fsub_s(P0[r],dl);P1[r]=fsub_s(P1[r],dl);} \
      qx=make_qx(-mhat,hm); } \
    _Pragma("unroll") for(int r=0;r<16;++r)P0[r]=__builtin_amdgcn_exp2f(P0[r]); }while(0)
  #define RESC() do{ if(resc){ asm volatile("s_waitcnt lgkmcnt(0)":::"memory"); \
      _Pragma("unroll") for(int d_=0;d_<2;++d_) _Pragma("unroll") for(int r=0;r<16;++r)o[d_][r]*=wsf[crow(r,hi)]; } }while(0)
  f32x16 pA0,pA1,pB0,pB1;
  int sl_prev=0,sl_cur=0,sl_next=SLOTB;
  #define ROT() do{sl_prev=sl_cur;sl_cur=sl_next;sl_next=(sl_next==(NSLOT-1)*SLOTB)?0:sl_next+SLOTB;}while(0)
  DMA_K(2,2*SLOTB);
  WAIT_BAR(3);
  qkt(pA0,pA1,Kbase,qls,make_ax(cst[r32]),make_ax(cst[32+r32]),qx,r32,hi);asm volatile("s_nop 15\n\ts_nop 7":"+v"(pA0),"+v"(pA1));CMASK(pA0,pA1,0);
  START(pA0,pA1);
  _Pragma("unroll") for(int r=0;r<16;++r)pA1[r]=__builtin_amdgcn_exp2f(pA1[r]);
  WAIT_BAR(0);
  DMA_K(3,0);DMA_V(1,SLOTB);
  ROT();
  kload8(kf,kp0+sl_cur);
  WAIT_BAR(2);
  s16x4 vlo[8],vhi[8]; u32x4 pw0,pw1,pw2,pw3;
  #define PKW(P,B) cvtpk_s(P[B],P[B+1])
  #define PAF(k) __builtin_bit_cast(bf16x8,pw##k)
  #define VFR(i) (bf16x8){vlo[i][0],vlo[i][1],vlo[i][2],vlo[i][3],vhi[i][0],vhi[i][1],vhi[i][2],vhi[i][3]}
  #define PIN(x) asm volatile("":"+v"(x))
  #define MX3(a,b,c) __builtin_fmaxf(__builtin_fmaxf((a),(b)),(c))
  #define GAPA(MF,A0,A1,A2,A3,W0,W1,PW) do{ MF; sacc+=A0; sacc+=A1; sacc+=A2; sacc+=A3; PIN(sacc); W0; W1; PIN(PW); SBAR(); }while(0)
  #define EX(v) __builtin_amdgcn_exp2f(v)
  #define GAPB(MF,X,B) do{ MF; X[B]=EX(X[B]); X[B+1]=EX(X[B+1]); X[B+2]=EX(X[B+2]); X[B+3]=EX(X[B+3]); PIN(X); SBAR(); }while(0)
  #define VRD(i) do{ vlo[i]=vtr(vp_+(((i)>>2)*4096+((i)&3)*1024)); vhi[i]=vtr(vp_+(((i)>>2)*4096+((i)&3)*1024+512)); }while(0)
  #define KRD(G,j) do{ if(G){ kload2(kf,kp0+sl_next,j); SBAR(); } }while(0)
  #define STEP(C0,C1,P0,P1,t,GK,GV,GL) do{ SBAR(); \
    const lds_cptr vp_=vp0+sl_prev; \
    const bf16x8 ax0_=make_ax(cst[(t)*KVBLK+r32]), ax1_=make_ax(cst[(t)*KVBLK+32+r32]); \
    C0=__builtin_amdgcn_mfma_f32_32x32x16_bf16(ax0_,qx,f32x16{},0,0,0); C1=__builtin_amdgcn_mfma_f32_32x32x16_bf16(ax1_,qx,f32x16{},0,0,0); SBAR(); \
    bf16x8 q0_=QLD(0), q1_=QLD(1); \
    VRD(0); SBAR(); float sacc=(P0[0]+P0[1]); \
    GAPA(C0=__builtin_amdgcn_mfma_f32_32x32x16_bf16(kf[0],q0_,C0,0,0,0), P0[2],P0[3],P0[4],P0[5],     pw0[0]=PKW(P0,0), pw0[1]=PKW(P0,2), pw0); \
    VRD(4); SBAR(); GAPA(C1=__builtin_amdgcn_mfma_f32_32x32x16_bf16(kf[1],q0_,C1,0,0,0), P0[6],P0[7],P0[8],P0[9],     pw0[2]=PKW(P0,4), pw0[3]=PKW(P0,6), pw0); q0_=QLD(2); \
    VRD(1); SBAR(); GAPA(C0=__builtin_amdgcn_mfma_f32_32x32x16_bf16(kf[2],q1_,C0,0,0,0),   P0[10],P0[11],P0[12],P0[13], pw1[0]=PKW(P0,8), pw1[1]=PKW(P0,10), pw1); \
    VRD(5); SBAR(); GAPA(C1=__builtin_amdgcn_mfma_f32_32x32x16_bf16(kf[3],q1_,C1,0,0,0),   P0[14],P0[15],P1[0],P1[1],   pw1[2]=PKW(P0,12),pw1[3]=PKW(P0,14), pw1); q1_=QLD(3); \
    VRD(2); SBAR(); GAPA(C0=__builtin_amdgcn_mfma_f32_32x32x16_bf16(kf[4],q0_,C0,0,0,0),   P1[2],P1[3],P1[4],P1[5],     pw2[0]=PKW(P1,0), pw2[1]=PKW(P1,2), pw2); \
    VRD(6); SBAR(); GAPA(C1=__builtin_amdgcn_mfma_f32_32x32x16_bf16(kf[5],q0_,C1,0,0,0),   P1[6],P1[7],P1[8],P1[9],     pw2[2]=PKW(P1,4), pw2[3]=PKW(P1,6), pw2); \
    VRD(3); SBAR(); GAPA(C0=__builtin_amdgcn_mfma_f32_32x32x16_bf16(kf[6],q1_,C0,0,0,0),   P1[10],P1[11],P1[12],P1[13], pw3[0]=PKW(P1,8), pw3[1]=PKW(P1,10), pw3); \
    VRD(7); SBAR(); GAPA(C1=__builtin_amdgcn_mfma_f32_32x32x16_bf16(kf[7],q1_,C1,0,0,0),   P1[14],P1[15],0.f,0.f,       pw3[2]=PKW(P1,12),pw3[3]=PKW(P1,14), pw3); \
    l_reg+=sacc; \
    if(GK){DMA_K((t)+3,sl_cur);} if(GV){DMA_V((t)+1,sl_next);} \
    CMASK(C0,C1,t); \
    { float a=MX3(C0[0],C0[1],C1[0]),b=MX3(C0[2],C0[3],C1[1]); a=MX3(a,C1[2],C1[3]); \
      _Pragma("unroll") for(int r=4;r<16;r+=4){a=MX3(a,C0[r],C0[r+1]);b=MX3(b,C0[r+2],C0[r+3]);a=MX3(a,C1[r],C1[r+1]);b=MX3(b,C1[r+2],C1[r+3]);} \
      float rm=__builtin_fmaxf(a,b); { auto rr=__builtin_amdgcn_permlane32_swap(__float_as_uint(rm),__float_as_uint(rm),false,false); rm=__builtin_fmaxf(__uint_as_float(rr[0]),__uint_as_float(rr[1])); } \
      resc=false; \
      if(__builtin_expect(__any(rm>(float)THRL),0)){ const float dl=__builtin_fmaxf(rm,0.f); mhat+=dl; \
        _Pragma("unroll") for(int r=0;r<16;++r){C0[r]-=dl;C1[r]-=dl;} \
        qx=make_qx(-mhat,hm); \
        const float f=__builtin_amdgcn_exp2f(-dl); l_reg*=f; if(hi==0)wsf[r32]=f; resc=true; } } \
    SBAR(); \
    GAPB(o[0]=__builtin_amdgcn_mfma_f32_32x32x16_bf16(PAF(0),VFR(0),o[0],0,0,0), C0,0); \
    GAPB(o[1]=__builtin_amdgcn_mfma_f32_32x32x16_bf16(PAF(0),VFR(4),o[1],0,0,0), C0,4); \
    KRD(GL,0); GAPB(o[0]=__builtin_amdgcn_mfma_f32_32x32x16_bf16(PAF(1),VFR(1),o[0],0,0,0), C0,8); \
    KRD(GL,1); GAPB(o[1]=__builtin_amdgcn_mfma_f32_32x32x16_bf16(PAF(1),VFR(5),o[1],0,0,0), C0,12); \
    KRD(GL,2); GAPB(o[0]=__builtin_amdgcn_mfma_f32_32x32x16_bf16(PAF(2),VFR(2),o[0],0,0,0), C1,0); \
    KRD(GL,3); GAPB(o[1]=__builtin_amdgcn_mfma_f32_32x32x16_bf16(PAF(2),VFR(6),o[1],0,0,0), C1,4); \
    GAPB(o[0]=__builtin_amdgcn_mfma_f32_32x32x16_bf16(PAF(3),VFR(3),o[0],0,0,0), C1,8); \
    GAPB(o[1]=__builtin_amdgcn_mfma_f32_32x32x16_bf16(PAF(3),VFR(7),o[1],0,0,0), C1,12); \
    }while(0)
  int t=1;
  #undef CMASK
  #define CMASK(P0,P1,t) do{}while(0)
  for(;t+5<NT;t+=2){
    STEP(pB0,pB1,pA0,pA1,t,true,true,true);     WAIT_BAR(2); RESC(); ROT();
    STEP(pA0,pA1,pB0,pB1,t+1,true,true,true);   WAIT_BAR(2); RESC(); ROT();
  }
  #undef CMASK
  #define CMASK(P0,P1,t) do{int jb_=(t)-(NT-4); if(jb_>=0)cmask(P0,P1,jb_,qrel,hi);}while(0)
  #define ENDW(tt) do{ if((tt)+3<NT){WAIT_BAR(2);} else if((tt)+2<NT){WAIT_BAR(1);} else {WAIT_BAR(0);} }while(0)
  for(;t+1<NT;t+=2){
    STEP(pB0,pB1,pA0,pA1,t,(t+3<NT),(t+1<NT),(t+1<NT));       ENDW(t);   RESC(); ROT();
    STEP(pA0,pA1,pB0,pB1,t+1,(t+4<NT),(t+2<NT),(t+2<NT));     ENDW(t+1); RESC(); ROT();
  }
  STEP(pB0,pB1,pA0,pA1,NT-1,false,false,false); RESC();
  { float sacc=pB0[0]+pB0[1]; _Pragma("unroll") for(int r=2;r<16;++r)sacc+=pB0[r]; _Pragma("unroll") for(int r=0;r<16;++r)sacc+=pB1[r]; l_reg+=sacc;
    pw0=(u32x4){PKW(pB0,0),PKW(pB0,2),PKW(pB0,4),PKW(pB0,6)};pw1=(u32x4){PKW(pB0,8),PKW(pB0,10),PKW(pB0,12),PKW(pB0,14)};pw2=(u32x4){PKW(pB1,0),PKW(pB1,2),PKW(pB1,4),PKW(pB1,6)};pw3=(u32x4){PKW(pB1,8),PKW(pB1,10),PKW(pB1,12),PKW(pB1,14)};
    SBAR(); pv(o,vb0+sl_cur,PAF(0),PAF(1),PAF(2),PAF(3)); }
  #undef PKW
  #undef PAF
  #undef VFR
  #undef PIN
  #undef MX3
  #undef GAPA
  #undef GAPB
  #undef EX
  #undef VRD
  #undef KRD
  #undef STEP
  #undef ENDW
  {auto rr=__builtin_amdgcn_permlane32_swap(__float_as_uint(l_reg),__float_as_uint(l_reg),false,false);l_reg=__uint_as_float(rr[0])+__uint_as_float(rr[1]);}
  { int te=tid; asm volatile("":"+v"(te));
    const int lane_e=te&63,r32e=lane_e&31,hie=lane_e>>5;
    if(hie==0)wsf[32+r32e]=l_reg;asm volatile("s_waitcnt lgkmcnt(0)":::"memory");
    float rli[16];
    #pragma unroll
    for(int r=0;r<16;++r)rli[r]=__builtin_amdgcn_rcpf(wsf[32+crow(r,hie)]);
    bf16*Ow=O+(rowbase+q0+wid*QBLK)*DM+h*D; const bf16*Gw=Gt+(rowbase+q0+wid*QBLK)*DM+h*D;
    bf16*stg=(bf16*)(shm+LDS_OST)+wid*2048;
    #pragma unroll
    for(int r=0;r<16;++r){const int orow=crow(r,hie);
      #pragma unroll
      for(int d0=0;d0<2;++d0)stg[orow*64+d0*32+r32e]=__float2bfloat16(o[d0][r]*rli[r]);}
    asm volatile("s_waitcnt lgkmcnt(0)":::"memory");
    #pragma unroll
    for(int i=0;i<4;++i){const int row=i*8+(lane_e>>3),ch=lane_e&7; u32x4 v=*(const u32x4*)(stg+row*64+ch*8); const u32x4 gv=*(const u32x4*)(Gw+(long)row*DM+ch*8);
      #pragma unroll
      for(int e=0;e<4;++e){ const float g0=__uint_as_float(gv[e]<<16),g1=__uint_as_float(gv[e]&0xffff0000u),x0=__uint_as_float(v[e]<<16),x1=__uint_as_float(v[e]&0xffff0000u);
        v[e]=cvtpk_s(x0*__builtin_amdgcn_rcpf(1.f+__expf(-g0)),x1*__builtin_amdgcn_rcpf(1.f+__expf(-g1))); }
      ATTN_STORE16(Ow+(long)row*DM+ch*8,v);} }
  asm volatile("s_waitcnt lgkmcnt(0)\n\ts_barrier":::"memory");
  #undef DMA_K
  #undef QLD
  #undef DMA_V
  #undef CMASK
  #undef START
  #undef RESC
  #undef ROT
}
constexpr int ATTN_LDS_BYTES=LDS_BYTES;
struct AttnTensors { const bf16* Q; const bf16* K; const bf16* V; bf16* O; const bf16* G; const float* CUM; };
struct AttnUnit { int bh; int qb; };
struct StaticOrder {
  int vcu;
  __device__ __forceinline__ explicit StaticOrder(int grid,int block):vcu((block%8)*(grid/8)+block/8){}
  __device__ __forceinline__ bool next(int i,AttnUnit&u)const{ if(i>=4)return false; const int s=2*(vcu&1)+(i>>1); u.bh=vcu>>1; u.qb=(i&1)?7-s:s; return true; }
  __device__ __forceinline__ void a_ready(const AttnUnit&)const{}
  __device__ __forceinline__ void done(const AttnUnit&)const{}
};
template<class Sched,int THRL=8> __device__ __forceinline__ void attn_phase(char*lds,const AttnTensors&T,const Sched&S,int tid_in){
  AttnUnit u; int tid_=tid_in; asm volatile("":"+v"(tid_));
  if(S.next(0,u)){ float*csp=(float*)(lds+LDS_CS); float*wt=(float*)(lds+LDS_WS); int tp=tid_in; asm volatile("":"+v"(tp));
    const float*lf=T.CUM+((long)(u.bh/NHEAD)*SEQ+4*tp)*NHEAD+u.bh%NHEAD;
    const float a0=lf[0],a1=a0+lf[NHEAD],a2=a1+lf[2*NHEAD],a3=a2+lf[3*NHEAD];
    float sc=a3; const int ln=tp&63;
    #pragma unroll
    for(int o=1;o<64;o<<=1){ const float up=__builtin_bit_cast(float,__builtin_amdgcn_ds_bpermute((ln-o)<<2,__builtin_bit_cast(int,sc))); if(ln>=o)sc+=up; }
    if(ln==63)wt[tp>>6]=sc;
    __syncthreads();
    float base=sc-a3;
    #pragma unroll
    for(int w=0;w<NW-1;++w)if(w<(tp>>6))base+=wt[w];
    const float k2=-1.4426950408889634f;
    csp[4*tp]=k2*(base+a0);csp[4*tp+1]=k2*(base+a1);csp[4*tp+2]=k2*(base+a2);csp[4*tp+3]=k2*(base+a3);
    __syncthreads(); }
  for(int i=0;S.next(i,u);++i){ S.a_ready(u); attn_unit<THRL>(u.bh/NHEAD,u.bh%NHEAD,u.qb,T.Q,T.K,T.V,T.O,T.G,lds,tid_); S.done(u); }
}
#undef SBAR
#undef WAIT_BAR
}
#define GAS __attribute__((address_space(1)))
#define LAS __attribute__((address_space(3)))
typedef unsigned short bf16;
typedef unsigned v4u __attribute__((ext_vector_type(4)));
typedef float f32x4 __attribute__((ext_vector_type(4)));
typedef short bf16x8 __attribute__((ext_vector_type(8)));
typedef GAS unsigned gu32;
typedef GAS unsigned long long gu64;
#define RLX_AGENT __ATOMIC_RELAXED, __HIP_MEMORY_SCOPE_AGENT
#define LDS_WAIT() asm volatile("s_waitcnt lgkmcnt(0)" ::: "memory")
#define VM_WAIT() asm volatile("s_waitcnt vmcnt(0)" ::: "memory")
__device__ __forceinline__ unsigned long long rt() { return __builtin_amdgcn_s_memrealtime(); }
__device__ __forceinline__ unsigned f2bf(float f) { unsigned u = __builtin_bit_cast(unsigned, f); return (u + 0x7fffu + ((u >> 16) & 1u)) >> 16; }
__device__ __forceinline__ unsigned pk2(float lo, float hi) { return f2bf(lo) | (f2bf(hi) << 16); }

#define XB_TMO      128
#define XB_XCNT(j)  (256  + 64 * (j))
#define XB_XSUB(j)  (1280 + 64 * (j))
#define XB_XGEN(j)  (2304 + 64 * (j))
#define XB_TOP      3328
#define XB_TOPGEN   3392
#define XCD_BAR_WORDS 3456
#define XB_SPIN_CAP (1u << 27)

__device__ __forceinline__ unsigned xb_ld(unsigned* p)              { return __hip_atomic_load(p, __ATOMIC_RELAXED, __HIP_MEMORY_SCOPE_AGENT); }
__device__ __forceinline__ unsigned xb_add(unsigned* p, unsigned v) { return __hip_atomic_fetch_add(p, v, __ATOMIC_RELAXED, __HIP_MEMORY_SCOPE_AGENT); }
__device__ __forceinline__ unsigned xb_xcc_id() { return (unsigned)__builtin_amdgcn_s_getreg((3 << 11) | 20) & 0xFu; }
#define XB_SPIN(cond, bar) do { unsigned _sp = 0; while (cond) { __builtin_amdgcn_s_sleep(1); \
    if ((++_sp & 255u) == 0u) { if (xb_ld(&(bar)[XB_TMO])) break; if (_sp > XB_SPIN_CAP) { atomicAdd(&(bar)[XB_TMO], 1u); break; } } } } while (0)

struct XcdBarrier {
    unsigned* bar; unsigned x;
    volatile LAS unsigned* st;
};

__device__ __forceinline__ XcdBarrier xcd_barrier_post(unsigned* bar, volatile LAS unsigned* st) {
    XcdBarrier b; b.bar = bar; b.x = xb_xcc_id(); b.st = st;
    if (threadIdx.x == 0) (void)xb_add(&bar[XB_XCNT(b.x)], 1u);
    return b;
}
__device__ __forceinline__ void xcd_barrier_complete(unsigned* bar, unsigned x, unsigned& nloc, unsigned& nx) {
    const unsigned G = gridDim.x * gridDim.y * gridDim.z;
    unsigned sum, cnt, mine, sp = 0u;
    for (;;) {
        sum = 0u; cnt = 0u; mine = 0u;
#pragma unroll
        for (unsigned j = 0; j < 16; ++j) { const unsigned c = xb_ld(&bar[XB_XCNT(j)]); sum += c; cnt += (c > 0u) ? 1u : 0u; mine = (j == x) ? c : mine; }
        if (sum == G) break;
        __builtin_amdgcn_s_sleep(1);
        if ((++sp & 255u) == 0u) { if (xb_ld(&bar[XB_TMO])) break; if (sp > XB_SPIN_CAP) { atomicAdd(&bar[XB_TMO], 1u); break; } }
    }
    nloc = mine > 0u ? mine : 1u; nx = cnt > 0u ? cnt : 1u;
}

__device__ __forceinline__ void xcd_barrier(const XcdBarrier& b, const bool leader  ) {
    asm volatile("s_waitcnt vmcnt(0)" ::: "memory");
    __syncthreads();
    if (leader) {
        unsigned* bar = b.bar;
        __builtin_amdgcn_s_waitcnt(0);
        unsigned nloc = b.st[0], nx = b.st[1];
        if (nloc == 0u) { xcd_barrier_complete(bar, b.x, nloc, nx); b.st[0] = nloc; b.st[1] = nx; }
        const unsigned old = xb_add(&bar[XB_XSUB(b.x)], 1u);
        const unsigned gen = old / nloc;
        if (old + 1u == (gen + 1u) * nloc) {
            __builtin_amdgcn_fence(__ATOMIC_RELEASE, "agent");
            asm volatile("s_waitcnt vmcnt(0)" ::: "memory");
            const unsigned og = xb_add(&bar[XB_TOP], 1u);
            const unsigned tg = og / nx;
            if (og + 1u == (tg + 1u) * nx) xb_add(&bar[XB_TOPGEN], 1u);
            else XB_SPIN(xb_ld(&bar[XB_TOPGEN]) == tg, bar);
            __builtin_amdgcn_fence(__ATOMIC_ACQUIRE, "agent");
            xb_add(&bar[XB_XGEN(b.x)], 1u);
            asm volatile("s_waitcnt vmcnt(0)" ::: "memory");
        } else {
            XB_SPIN(xb_ld(&bar[XB_XGEN(b.x)]) == gen, bar);
            __builtin_amdgcn_fence(__ATOMIC_ACQUIRE, "agent");
            asm volatile("s_waitcnt vmcnt(0)" ::: "memory");
        }
    }
    __syncthreads();
}
#ifndef MK_FASTATTN
#define MK_FASTATTN 1
#endif
#ifndef MK_FASTREC
#define MK_FASTREC 1
#endif
namespace cg = cooperative_groups;
constexpr int NTOK = 16384, DMODEL = 1024, NBATCH = 8, SEQLEN = 2048, DEPTH = 4;
constexpr int FOX_IN = 4112, GLA_IN = 3088, HGRN_IN = 4096;
constexpr float RMS_EPS = 1e-6f;
constexpr float LOG2E = 1.4426950408889634f;
constexpr float FOX_C2 = 0.125f * LOG2E;
constexpr int NWAVES = 8;

constexpr size_t MiB = 1u << 20;
constexpr size_t WS_CTL = 0, CTL_ZERO_BYTES = 1 * MiB;
constexpr size_t WS_FOXWIN = 2 * MiB, WS_FOXWOUT = 18 * MiB, WS_GLAWIN = 22 * MiB, WS_GLAWOUT = 28 * MiB, WS_HGRNWIN = 30 * MiB, WS_HGRNWOUT = 38 * MiB;
constexpr size_t WS_PEERWQ = 40 * MiB, WS_KEYS = 56 * MiB, WS_LB = 58 * MiB;
#ifndef I8MASK
#define I8MASK 13
#endif
constexpr size_t WS_SW = 58 * MiB + 65536, WS_SX = 58 * MiB + 262144, WS_XN8 = 724 * MiB;
constexpr size_t WS_TAILW = 63 * MiB;
constexpr size_t WS_RS = 62 * MiB;
constexpr size_t WS_U = 64 * MiB, WS_V = 128 * MiB, WS_SU = 60 * MiB, WS_SV = 61 * MiB;
constexpr size_t WS_XN = 320 * MiB, WS_P = 352 * MiB, WS_OB = 480 * MiB, WS_Q2 = 512 * MiB, WS_TAIL = 576 * MiB, WS_CUM = 577 * MiB;
constexpr size_t WS_EXP = 580 * MiB, WS_GATE = 588 * MiB, WS_OF = 596 * MiB, WS_GLOG = 660 * MiB, WS_END = 740 * MiB;
constexpr size_t PSTRIDE = (size_t)NTOK * 1024;
constexpr int CW_BAR = 4096;

constexpr int RING_BYTES = 131072;
constexpr int LDSCTL_OFF = RING_BYTES, MISC_OFF = LDSCTL_OFF + 320;
constexpr int LDS_BYTES = 147456;

typedef unsigned u32x4v __attribute__((ext_vector_type(4)));
struct Ctx {
    LAS unsigned char* lds; int tid, lane, wave, vcu, G, gw, NGW, bx;
    const float* in[21]; float* out; unsigned char* ws;
};

__device__ __forceinline__ float bf2f(unsigned short b) { return __uint_as_float(((unsigned)b) << 16); }
__device__ __forceinline__ float bflo(unsigned w) { return __uint_as_float(w << 16); }
__device__ __forceinline__ float bfhi(unsigned w) { return __uint_as_float(w & 0xffff0000u); }
#define DPP_ADD(v, ctrl, rm, bm) (v + __builtin_bit_cast(float, __builtin_amdgcn_update_dpp(0, __builtin_bit_cast(int, v), ctrl, rm, bm, false)))
#define DPP_MAX(v, ctrl, rm, bm) fmaxf(v, __builtin_bit_cast(float, __builtin_amdgcn_update_dpp(__builtin_bit_cast(int, v), __builtin_bit_cast(int, v), ctrl, rm, bm, false)))
#define DPP_SUM31(v) do { v = DPP_ADD(v, 0x111, 0xf, 0xf); v = DPP_ADD(v, 0x112, 0xf, 0xf); v = DPP_ADD(v, 0x114, 0xf, 0xe); v = DPP_ADD(v, 0x118, 0xf, 0xc); v = DPP_ADD(v, 0x142, 0xa, 0xf); } while (0)
#define DPP_SUM63(v) do { DPP_SUM31(v); v = DPP_ADD(v, 0x143, 0xc, 0xf); } while (0)
__device__ __forceinline__ float rdlane(float v, int lane) { return __builtin_bit_cast(float, __builtin_amdgcn_readlane(__builtin_bit_cast(int, v), lane)); }
__device__ __forceinline__ float wave_sum(float v) { DPP_SUM63(v); return rdlane(v, 63); }
__device__ __forceinline__ float wave_max(float v) {
    v = DPP_MAX(v, 0x111, 0xf, 0xf); v = DPP_MAX(v, 0x112, 0xf, 0xf); v = DPP_MAX(v, 0x114, 0xf, 0xe); v = DPP_MAX(v, 0x118, 0xf, 0xc); v = DPP_MAX(v, 0x142, 0xa, 0xf); v = DPP_MAX(v, 0x143, 0xc, 0xf);
    return rdlane(v, 63);
}
typedef __bf16 bf16x2_t __attribute__((ext_vector_type(2)));
__device__ __forceinline__ float dot2bf(unsigned w, unsigned x, float acc) { return __builtin_amdgcn_fdot2_f32_bf16(__builtin_bit_cast(bf16x2_t, w), __builtin_bit_cast(bf16x2_t, x), acc, false); }
__device__ __forceinline__ float bperm(float v, int src_lane) { return __builtin_bit_cast(float, __builtin_amdgcn_ds_bpermute(src_lane << 2, __builtin_bit_cast(int, v))); }
__device__ __forceinline__ float log_sigmoid_f(float x) { return fminf(x, 0.f) - log1pf(__expf(-fabsf(x))); }
__device__ __forceinline__ float sigmoid_f(float x) { return 1.f / (1.f + __expf(-x)); }

__device__ __forceinline__ void p0_transpose_item(const float* W, int ldw, int K, int Nuse, bf16* WT, LAS float* scr, int item, int lane) {
    const int nblk = Nuse / 32, kb = item / nblk, nb = item % nblk, k0 = 64 * kb, n0 = 32 * nb;
#pragma unroll
    for (int i = 0; i < 8; ++i) { const int kk = 8 * i + (lane >> 3); const f32x4 v = *(const GAS f32x4*)(W + (size_t)(k0 + kk) * ldw + n0 + 4 * (lane & 7));
        LAS float* d = scr + kk * 33 + 4 * (lane & 7); d[0] = v.x; d[1] = v.y; d[2] = v.z; d[3] = v.w; }
    LDS_WAIT(); asm volatile("" ::: "memory");
    const int c = lane & 7;
#pragma unroll
    for (int j = 0; j < 4; ++j) { const int n = (lane >> 3) + 8 * j; const LAS float* s = scr + (8 * c) * 33 + n;
        v4u o; o.x = pk2(s[0 * 33], s[1 * 33]); o.y = pk2(s[2 * 33], s[3 * 33]); o.z = pk2(s[4 * 33], s[5 * 33]); o.w = pk2(s[6 * 33], s[7 * 33]);
        *(GAS v4u*)(WT + (size_t)(n0 + n) * K + k0 + 8 * c) = o; }
    LDS_WAIT(); asm volatile("" ::: "memory");
}
__device__ __forceinline__ void p0_quant_strip(const float* W, int ldw, signed char* W8, float* sw, LAS float* scr, int nb, int lane) {
    const int n0 = 32 * nb; float mx[4] = {0.f, 0.f, 0.f, 0.f};
    for (int kb = 0; kb < 16; ++kb)
#pragma unroll
        for (int i = 0; i < 8; ++i) { const f32x4 v = *(const GAS f32x4*)(W + (size_t)(64 * kb + 8 * i + (lane >> 3)) * ldw + n0 + 4 * (lane & 7));
            mx[0] = fmaxf(mx[0], fabsf(v.x)); mx[1] = fmaxf(mx[1], fabsf(v.y)); mx[2] = fmaxf(mx[2], fabsf(v.z)); mx[3] = fmaxf(mx[3], fabsf(v.w)); }
#pragma unroll
    for (int j = 0; j < 4; ++j) { mx[j] = fmaxf(mx[j], bperm(mx[j], lane ^ 8)); mx[j] = fmaxf(mx[j], bperm(mx[j], lane ^ 16)); mx[j] = fmaxf(mx[j], bperm(mx[j], lane ^ 32)); }
    LAS float* cinv = scr + 64 * 33;
    if (lane < 8) {
#pragma unroll
        for (int j = 0; j < 4; ++j) { cinv[4 * lane + j] = mx[j] > 0.f ? 127.f / mx[j] : 0.f; sw[n0 + 4 * lane + j] = mx[j] * (1.f / 127.f); }
    }
    for (int kb = 0; kb < 16; ++kb) {
        LDS_WAIT(); asm volatile("" ::: "memory");
#pragma unroll
        for (int i = 0; i < 8; ++i) { const int kk = 8 * i + (lane >> 3); const f32x4 v = *(const GAS f32x4*)(W + (size_t)(64 * kb + kk) * ldw + n0 + 4 * (lane & 7));
            LAS float* d = scr + kk * 33 + 4 * (lane & 7); d[0] = v.x; d[1] = v.y; d[2] = v.z; d[3] = v.w; }
        LDS_WAIT(); asm volatile("" ::: "memory");
        const int c = lane & 7;
#pragma unroll
        for (int j = 0; j < 4; ++j) { const int n = (lane >> 3) + 8 * j; const LAS float* sp = scr + (8 * c) * 33 + n; const float ci = cinv[n];
            unsigned lo = 0u, hi = 0u;
#pragma unroll
            for (int e = 0; e < 4; ++e) { lo |= ((unsigned)(int)__builtin_rintf(sp[e * 33] * ci) & 0xffu) << (8 * e); hi |= ((unsigned)(int)__builtin_rintf(sp[(4 + e) * 33] * ci) & 0xffu) << (8 * e); }
            *(GAS unsigned long long*)(W8 + (size_t)(n0 + n) * 1024 + 64 * kb + 8 * c) = (unsigned long long)lo | ((unsigned long long)hi << 32); }
    }
    LDS_WAIT(); asm volatile("" ::: "memory");
}
__device__ __forceinline__ unsigned q8x4(float a, float b, float c, float d) {
    return ((unsigned)(int)__builtin_rintf(a) & 0xffu) | (((unsigned)(int)__builtin_rintf(b) & 0xffu) << 8) | (((unsigned)(int)__builtin_rintf(c) & 0xffu) << 16) | ((unsigned)(int)__builtin_rintf(d) << 24);
}
__device__ __forceinline__ void rms_row_to_bf16(int lane, const float* xrow, const float* gain, bf16* orow, signed char* orow8, float* sx) {
    const GAS f32x4* xr = (const GAS f32x4*)xrow + lane; const GAS f32x4* gr = (const GAS f32x4*)gain + lane;
    f32x4 v[4]; float s = 0.f;
#pragma unroll
    for (int j = 0; j < 4; ++j) { v[j] = xr[64 * j]; s += (v[j].x * v[j].x + v[j].y * v[j].y) + (v[j].z * v[j].z + v[j].w * v[j].w); }
    const float r = rsqrtf(wave_sum(s) * (1.f / 1024.f) + RMS_EPS);
    GAS unsigned long long* o8 = (GAS unsigned long long*)orow + lane; float am = 0.f;
#pragma unroll
    for (int j = 0; j < 4; ++j) { const f32x4 g = gr[64 * j]; v[j].x *= r * g.x; v[j].y *= r * g.y; v[j].z *= r * g.z; v[j].w *= r * g.w;
        am = fmaxf(fmaxf(am, fmaxf(fabsf(v[j].x), fabsf(v[j].y))), fmaxf(fabsf(v[j].z), fabsf(v[j].w)));
        o8[64 * j] = (unsigned long long)pk2(v[j].x, v[j].y) | ((unsigned long long)pk2(v[j].z, v[j].w) << 32); }
    am = wave_max(am); const float qi = am > 0.f ? 127.f / am : 0.f;
    GAS unsigned* q8 = (GAS unsigned*)orow8 + lane;
#pragma unroll
    for (int j = 0; j < 4; ++j) q8[64 * j] = q8x4(v[j].x * qi, v[j].y * qi, v[j].z * qi, v[j].w * qi);
    if (lane == 0) *(GAS float*)sx = am * (1.f / 127.f);
}
__device__ __forceinline__ void cvt_f32_bf16(const Ctx& C, const float* src, bf16* dst, size_t n) {
    const size_t nth = (size_t)C.G * 512, t0 = (size_t)C.vcu * 512 + C.tid;
    for (size_t i = t0; i < n / 8; i += nth) {
        const f32x4 a = ((const GAS f32x4*)src)[2 * i], b = ((const GAS f32x4*)src)[2 * i + 1];
        v4u o; o.x = pk2(a.x, a.y); o.y = pk2(a.z, a.w); o.z = pk2(b.x, b.y); o.w = pk2(b.z, b.w);
        ((GAS v4u*)dst)[i] = o;
    }
}
__device__ __forceinline__ void quant_rows_fp8(const Ctx& C, const float* src, unsigned char* dst, float* scales, int nrows) {
    for (int rw = C.gw; rw < nrows; rw += C.NGW) {
        const GAS f32x4* xr = (const GAS f32x4*)(src + (size_t)rw * 1024) + C.lane;
        f32x4 v[4]; float am = 0.f;
#pragma unroll
        for (int i = 0; i < 4; ++i) { v[i] = xr[64 * i]; am = fmaxf(am, fmaxf(fmaxf(fabsf(v[i].x), fabsf(v[i].y)), fmaxf(fabsf(v[i].z), fabsf(v[i].w)))); }
        am = wave_max(am);
        const float inv = am > 0.f ? 448.f / am : 0.f;
        GAS unsigned* o = (GAS unsigned*)(dst + (size_t)rw * 1024) + C.lane;
#pragma unroll
        for (int i = 0; i < 4; ++i) {
            const float a = fminf(fmaxf(v[i].x * inv, -448.f), 448.f), b = fminf(fmaxf(v[i].y * inv, -448.f), 448.f), c = fminf(fmaxf(v[i].z * inv, -448.f), 448.f), d = fminf(fmaxf(v[i].w * inv, -448.f), 448.f);
            int w = 0; w = __builtin_amdgcn_cvt_pk_fp8_f32(a, b, w, false); w = __builtin_amdgcn_cvt_pk_fp8_f32(c, d, w, true); o[64 * i] = (unsigned)w;
        }
        if (C.lane == 0) scales[rw] = am * (1.f / 448.f);
    }
}
__device__ __forceinline__ void p0_prologue(const Ctx& C) {
    LAS float* scr = (LAS float*)(C.lds + C.wave * 16384);
    constexpr int I_SQ = 16 * 32, N_F0 = (I8MASK & 1) ? 128 : 16 * 128, N_F3 = (I8MASK & 8) ? 128 : 16 * 128, N_G = (I8MASK & 2) ? 96 : 16 * 96, N_H = (I8MASK & 4) ? 128 : 16 * 128;
    constexpr int NITEMS = N_F0 + N_F3 + N_G + N_H + 2 * I_SQ + I_SQ + I_SQ;
    for (int it = C.gw; it < NITEMS; it += C.NGW) {
        int r = it;
        float* SW = (float*)(C.ws + WS_SW);
        if (r < N_F0) { if constexpr (I8MASK & 1) p0_quant_strip(C.in[3], FOX_IN, (signed char*)(C.ws + WS_FOXWIN), SW, scr, r, C.lane); else p0_transpose_item(C.in[3], FOX_IN, 1024, 4096, (bf16*)(C.ws + WS_FOXWIN), scr, r, C.lane); continue; } r -= N_F0;
        if (r < N_F3) { if constexpr (I8MASK & 8) p0_quant_strip(C.in[3] + (size_t)1024 * FOX_IN, FOX_IN, (signed char*)(C.ws + WS_FOXWIN + 8 * MiB), SW + 4096, scr, r, C.lane); else p0_transpose_item(C.in[3] + (size_t)1024 * FOX_IN, FOX_IN, 1024, 4096, (bf16*)(C.ws + WS_FOXWIN + 8 * MiB), scr, r, C.lane); continue; } r -= N_F3;
        if (r < N_G) { if constexpr (I8MASK & 2) p0_quant_strip(C.in[8], GLA_IN, (signed char*)(C.ws + WS_GLAWIN), SW + 8192, scr, r, C.lane); else p0_transpose_item(C.in[8], GLA_IN, 1024, 3072, (bf16*)(C.ws + WS_GLAWIN), scr, r, C.lane); continue; } r -= N_G;
        if (r < N_H) { if constexpr (I8MASK & 4) p0_quant_strip(C.in[13], HGRN_IN, (signed char*)(C.ws + WS_HGRNWIN), SW + 11264, scr, r, C.lane); else p0_transpose_item(C.in[13], HGRN_IN, 1024, 4096, (bf16*)(C.ws + WS_HGRNWIN), scr, r, C.lane); continue; } r -= N_H;
        if (r < 2 * I_SQ) { const int j = r / I_SQ; p0_transpose_item(C.in[7] + (size_t)j * 1024 * 1024, 1024, 1024, 1024, (bf16*)(C.ws + WS_FOXWOUT) + (size_t)j * 1024 * 1024, scr, r % I_SQ, C.lane); continue; } r -= 2 * I_SQ;
        if (r < I_SQ) { p0_transpose_item(C.in[12], 1024, 1024, 1024, (bf16*)(C.ws + WS_GLAWOUT), scr, r, C.lane); continue; } r -= I_SQ;
        p0_transpose_item(C.in[16], 1024, 1024, 1024, (bf16*)(C.ws + WS_HGRNWOUT), scr, r, C.lane);
    }
    for (int tile = C.gw; tile < 4 * 16 * 8 * 64; tile += C.NGW) {
        const int nb = tile & 63, kb = (tile >> 6) & 7, hp = (tile >> 9) & 15, layer = tile >> 13;
        const float* kp = C.in[18] + ((size_t)(layer * 16 + hp) * 128 + kb * 16 + (C.lane & 15)) * 128 + 4 * (C.lane >> 4);
        const float* wp = C.in[17] + ((size_t)layer * 1024 + nb * 16 + (C.lane & 15)) * 2048 + hp * 128 + 4 * (C.lane >> 4);
        f32x4 acc = (f32x4){0.f, 0.f, 0.f, 0.f};
#pragma unroll
        for (int s8 = 0; s8 < 8; ++s8) { const f32x4 a = *(const GAS f32x4*)(kp + 16 * s8), b = *(const GAS f32x4*)(wp + 16 * s8);
            acc = __builtin_amdgcn_mfma_f32_16x16x4f32(a.x, b.x, acc, 0, 0, 0); acc = __builtin_amdgcn_mfma_f32_16x16x4f32(a.y, b.y, acc, 0, 0, 0);
            acc = __builtin_amdgcn_mfma_f32_16x16x4f32(a.z, b.z, acc, 0, 0, 0); acc = __builtin_amdgcn_mfma_f32_16x16x4f32(a.w, b.w, acc, 0, 0, 0); }
        bf16* mt = (bf16*)(C.ws + WS_PEERWQ) + ((size_t)layer * 2048 + hp * 128 + kb * 16 + (C.lane >> 4) * 4) * 1024 + nb * 16 + (C.lane & 15);
#pragma unroll
        for (int r = 0; r < 4; ++r) mt[(size_t)r * 1024] = (bf16)f2bf(acc[r]);
    }
    quant_rows_fp8(C, C.in[19], C.ws + WS_U, (float*)(C.ws + WS_SU), 4 * 16384);
    quant_rows_fp8(C, C.in[20], C.ws + WS_V, (float*)(C.ws + WS_SV), 4 * 16384);
    for (int i = C.vcu * 512 + C.tid; i < 3 * 16 * 1024; i += C.G * 512) {
        const int w = i >> 14, n = (i >> 10) & 15, k = i & 1023;
        const float v = w < 2 ? C.in[3][(size_t)w * 1024 * FOX_IN + (size_t)k * FOX_IN + 4096 + n] : C.in[8][(size_t)k * GLA_IN + 3072 + n];
        ((bf16*)(C.ws + WS_TAILW))[i] = (bf16)f2bf(v);
    }
    if (C.vcu == 0) for (int c = C.tid; c < 1024; c += 512) {
        const float l0 = C.in[14][c], l1 = C.in[14][1024 + c], l2 = C.in[14][2048 + c], l3 = C.in[14][3072 + c];
        const float m = fmaxf(fmaxf(l0, l1), fmaxf(l2, l3));
        const float e0 = expf(l0 - m), e1 = expf(l1 - m), e2 = expf(l2 - m), e3 = expf(l3 - m);
        ((float*)(C.ws + WS_LB))[c] = (e1 + e2) / (e0 + e1 + e2 + e3);
    }
    for (int m = C.gw; m < NTOK; m += C.NGW) rms_row_to_bf16(C.lane, C.in[0] + (size_t)m * 1024, C.in[1], (bf16*)(C.ws + WS_XN) + (size_t)m * 1024, (signed char*)(C.ws + WS_XN8) + (size_t)m * 1024, (float*)(C.ws + WS_SX) + m);
}

__device__ __forceinline__ void tail_mfma(const Ctx& C, int tok0, const bf16* WT, LAS float* part) {
    const int l = C.lane, m = l & 15, g = l >> 4, tbk = C.wave & 3, kh = C.wave >> 2;
    const bf16* ap = (const bf16*)(C.ws + WS_XN) + (size_t)(tok0 + 16 * tbk + m) * 1024 + kh * 512 + 8 * g;
    const bf16* bp = WT + (size_t)m * 1024 + kh * 512 + 8 * g;
    f32x4 acc = (f32x4){0.f, 0.f, 0.f, 0.f};
#pragma unroll 4
    for (int ks = 0; ks < 16; ++ks) acc = __builtin_amdgcn_mfma_f32_16x16x32_bf16(*(const bf16x8*)(ap + 32 * ks), *(const bf16x8*)(bp + 32 * ks), acc, 0, 0, 0);
#pragma unroll
    for (int r = 0; r < 4; ++r) part[kh * 1024 + (16 * tbk + 4 * g + r) * 16 + m] = acc[r];
}
__device__ __forceinline__ void fox_step1(const Ctx& C, int j) {
    float* TAIL = (float*)(C.ws + WS_TAIL); LAS float* part = (LAS float*)C.lds;
    const bf16* WT = (const bf16*)(C.ws + WS_TAILW) + (size_t)j * 16 * 1024;
    for (int tb = C.vcu; tb < NTOK / 64; tb += C.G) {
        __syncthreads();
        tail_mfma(C, tb * 64, WT, part);
        __syncthreads();
#pragma unroll
        for (int rep = 0; rep < 2; ++rep) { const int i = rep * 512 + C.tid; TAIL[(size_t)tb * 1024 + i] = log_sigmoid_f(part[i] + part[1024 + i] + C.in[4][j * 16 + (i & 15)]); }
        const float* gq = C.in[5] + j * 64; const float* gk = C.in[6] + j * 64;
        for (int t = 0; t < 8; ++t) {
            const int tok = tb * 64 + C.wave * 8 + t;
#pragma unroll
            for (int which = 0; which < 2; ++which) {
                bf16* row = (bf16*)(C.ws + WS_P) + (size_t)which * PSTRIDE + (size_t)tok * 1024 + C.lane * 16;
                const v4u a = *(const GAS v4u*)row, b = *(const GAS v4u*)(row + 8);
                float v[16] = {bflo(a.x), bfhi(a.x), bflo(a.y), bfhi(a.y), bflo(a.z), bfhi(a.z), bflo(a.w), bfhi(a.w), bflo(b.x), bfhi(b.x), bflo(b.y), bfhi(b.y), bflo(b.z), bfhi(b.z), bflo(b.w), bfhi(b.w)};
                float ss = 0.f;
#pragma unroll
                for (int i = 0; i < 16; ++i) ss += v[i] * v[i];
                ss = DPP_ADD(ss, 0xB1, 0xf, 0xf); ss = DPP_ADD(ss, 0x4E, 0xf, 0xf);
                const float r = rsqrtf(ss * (1.f / 64.f) + RMS_EPS) * (which == 0 ? FOX_C2 : 1.f);
                const float* g = (which == 0 ? gq : gk) + (C.lane & 3) * 16;
#pragma unroll
                for (int i = 0; i < 16; ++i) v[i] = v[i] * r * g[i];
                v4u oa, ob; oa.x = pk2(v[0], v[1]); oa.y = pk2(v[2], v[3]); oa.z = pk2(v[4], v[5]); oa.w = pk2(v[6], v[7]);
                ob.x = pk2(v[8], v[9]); ob.y = pk2(v[10], v[11]); ob.z = pk2(v[12], v[13]); ob.w = pk2(v[14], v[15]);
                *(GAS v4u*)row = oa; *(GAS v4u*)(row + 8) = ob;
            }
        }
    }
}
constexpr size_t WS_ASC = WS_Q2, WS_Q1 = WS_Q2 + 16 * MiB, WS_KST = WS_Q2 + 48 * MiB, WS_DEC = 59 * MiB;
static_assert(WS_KST + 32 * MiB <= WS_OF && WS_Q1 + 32 * MiB <= WS_KST, "chunk workspace map");
template <int NH>
__device__ __forceinline__ void chunk_prepass(const Ctx& C) {
    bf16* ASC = (bf16*)(C.ws + WS_ASC); bf16* Q1 = (bf16*)(C.ws + WS_Q1); bf16* KST = (bf16*)(C.ws + WS_KST); float* DEC = (float*)(C.ws + WS_DEC);
    const bf16* P0 = (const bf16*)(C.ws + WS_P); const bf16* P1 = P0 + PSTRIDE;
    LAS bf16* tqs = (LAS bf16*)C.lds;
    LAS bf16* tks = tqs + 64 * 128;
    LAS bf16* q2s = tks + 64 * 128;
    LAS bf16* k2s = q2s + 64 * 136;
    LAS bf16* q1s = k2s + 64 * 136;
    LAS float* tot = (LAS float*)(q1s + 64 * 128);
    LAS float* part = tot + 512;
    const float qs = 0.08838834764831845f;
    const int d = C.tid & 127, tq = C.tid >> 7, l = C.lane, fr = l & 15, fq = l >> 4;
    const int dq = d;
    const int pr0 = C.tid >> 4, pc = (C.tid & 15) * 8;
#define PP_BAR() do { asm volatile("s_waitcnt lgkmcnt(0)" ::: "memory"); __builtin_amdgcn_s_barrier(); asm volatile("" ::: "memory"); } while (0)
    for (int itb = C.vcu; itb < NBATCH * 32; itb += C.G) {
        const int c = itb & 31, b = itb >> 5;
        const size_t rowb = (size_t)b * SEQLEN + c * 64;
        const size_t row0 = rowb + tq * 16;
        if (NH == 4) { __syncthreads(); tail_mfma(C, b * SEQLEN + c * 64, (const bf16*)(C.ws + WS_TAILW) + 2 * 16 * 1024, part); }
        v4u pq[2], pk[2];
#define PP_LOAD(h_) do { _Pragma("unroll") for (int j = 0; j < 2; ++j) { const size_t r_ = (rowb + pr0 + 32 * j) * 1024 + (h_) * 128 + pc; \
            pq[j] = *(const GAS v4u*)(P0 + r_); pk[j] = *(const GAS v4u*)((NH == 4 ? P0 + 512 : P1) + r_); } } while (0)
        PP_LOAD(0);
#pragma unroll 1
        for (int h = 0; h < NH; ++h) {
            const int it = (b * NH + h) * 32 + c;
            PP_BAR();
#pragma unroll
            for (int j = 0; j < 2; ++j) { *(LAS v4u*)(tqs + (pr0 + 32 * j) * 128 + pc) = pq[j]; *(LAS v4u*)(tks + (pr0 + 32 * j) * 128 + pc) = pk[j]; }
            if (h + 1 < NH) PP_LOAD(h + 1);
            PP_BAR();
            float bl[16], kk[16]; float run = 0.f;
            if (NH == 4) {
                float wu[16];
#pragma unroll
                for (int r = 0; r < 16; ++r) wu[r] = C.in[9][r * 512 + h * 128 + d];
                const float ba = C.in[10][h * 128 + d];
#pragma unroll
                for (int i = 0; i < 16; ++i) { float z = ba; const int t = tq * 16 + i;
#pragma unroll
                    for (int r = 0; r < 16; r += 4) { const f32x4 p0 = *(const LAS f32x4*)(part + t * 16 + r), p1 = *(const LAS f32x4*)(part + 1024 + t * 16 + r);
                        z += (p0[0] + p1[0]) * wu[r] + (p0[1] + p1[1]) * wu[r + 1] + (p0[2] + p1[2]) * wu[r + 2] + (p0[3] + p1[3]) * wu[r + 3]; }
                    run += log_sigmoid_f(z) * (1.f / 16.f); bl[i] = run; kk[i] = bf2f(tks[t * 128 + d]); }
            } else {
                const float lb = ((const float*)(C.ws + WS_LB))[h * 128 + d];
#pragma unroll
                for (int i = 0; i < 16; ++i) { const float gate = lb + (1.f - lb) * sigmoid_f(bf2f(tks[(tq * 16 + i) * 128 + d])); run += __logf(gate); bl[i] = run; kk[i] = 1.f - gate; }
            }
            tot[tq * 128 + d] = run;
            PP_BAR();
            const float t0 = tot[d], t1 = tot[128 + d], t2 = tot[256 + d], t3 = tot[384 + d];
            const float off = tq == 0 ? 0.f : tq == 1 ? t0 : tq == 2 ? t0 + t1 : t0 + t1 + t2;
            const float bref = t0 + t1, bend = (t0 + t1) + (t2 + t3);
            unsigned ksw[8];
#pragma unroll
            for (int i = 0; i < 16; ++i) {
                const float bb = bl[i] + off;
                const float qv = bf2f(tqs[(tq * 16 + i) * 128 + d]) * qs, kv = kk[i];
                q1s[(tq * 16 + i) * 128 + dq] = (bf16)f2bf(qv * __expf(bb));
                q2s[(tq * 16 + i) * 136 + d] = (bf16)f2bf(qv * __expf(bb - bref));
                k2s[(tq * 16 + i) * 136 + d] = (bf16)f2bf(kv * __expf(bref - bb));
                const unsigned kb = f2bf(kv * __expf(bend - bb));
                if (i & 1) ksw[i >> 1] |= kb << 16; else ksw[i >> 1] = kb;
            }
            { bf16* kt = KST + ((size_t)it * 128 + d) * 64 + tq * 16; *(GAS v4u*)kt = (v4u){ksw[0], ksw[1], ksw[2], ksw[3]}; *(GAS v4u*)(kt + 8) = (v4u){ksw[4], ksw[5], ksw[6], ksw[7]}; }
            if (tq == 0) DEC[(size_t)it * 128 + d] = __expf(bend);
            PP_BAR();
#pragma unroll
            for (int j = 0; j < 2; ++j) *(GAS v4u*)(Q1 + (rowb + pr0 + 32 * j) * 1024 + h * 128 + pc) = *(const LAS v4u*)(q1s + (pr0 + 32 * j) * 128 + pc);
            const int ti = C.wave >> 1;
#pragma unroll
            for (int sj = 0; sj < 2; ++sj) {
                const int si = 2 * (C.wave & 1) + sj;
                f32x4 acc = (f32x4){0.f, 0.f, 0.f, 0.f};
                if (si <= ti) {
#pragma unroll
                    for (int ks = 0; ks < 4; ++ks) {
                        const bf16x8 a = *(const LAS bf16x8*)(q2s + (16 * ti + fr) * 136 + ks * 32 + fq * 8), bb = *(const LAS bf16x8*)(k2s + (16 * si + fr) * 136 + ks * 32 + fq * 8);
                        acc = __builtin_amdgcn_mfma_f32_16x16x32_bf16(bb, a, acc, 0, 0, 0);
                    }
                }
                const int t = 16 * ti + fr, s0 = 16 * si + 4 * fq;
                typedef unsigned u32x2v __attribute__((ext_vector_type(2)));
                u32x2v w; w.x = pk2(s0 <= t ? acc[0] : 0.f, s0 + 1 <= t ? acc[1] : 0.f); w.y = pk2(s0 + 2 <= t ? acc[2] : 0.f, s0 + 3 <= t ? acc[3] : 0.f);
                *(GAS u32x2v*)(ASC + (size_t)it * 4096 + t * 64 + s0) = w;
            }
        }
    }
#undef PP_LOAD
#undef PP_BAR
}
struct RecFrag { bf16x8 vb[2]; bf16x8 a0, a1; unsigned long long q[4][2]; f32x4 dc[2]; bf16x8 ks[2][2]; };
template <int NH, int DV>
__device__ __forceinline__ void chunk_recur(const Ctx& C, const bf16* Vp) {
    const bf16* ASC = (const bf16*)(C.ws + WS_ASC); const bf16* Q1 = (const bf16*)(C.ws + WS_Q1); const bf16* KST = (const bf16*)(C.ws + WS_KST); const float* DEC = (const float*)(C.ws + WS_DEC);
    float* OF = (float*)(C.ws + WS_OF);
    constexpr int NCB = DV / 16, NTASK = NBATCH * NH * NCB;
    const int l = C.lane, m = l & 15, g = l >> 4, gi = C.wave >> 2, kq = C.wave & 3;
    LAS float* red = (LAS float*)C.lds + gi * 8192;
#define REC_LOAD(F, c_) do { const size_t row0_ = (size_t)b * SEQLEN + (c_) * 64; const size_t ch_ = (size_t)bh * 32 + (c_); \
        _Pragma("unroll") for (int ks = 0; ks < 2; ++ks) _Pragma("unroll") for (int j = 0; j < 8; ++j) F.vb[ks][j] = (short)Vp[(row0_ + 32 * ks + 8 * g + j) * 1024 + col]; \
        F.a0 = *(const bf16x8*)(ASC + ch_ * 4096 + (16 * kq + m) * 64 + 8 * g); F.a1 = *(const bf16x8*)(ASC + ch_ * 4096 + (16 * kq + m) * 64 + 32 + 8 * g); \
        _Pragma("unroll") for (int tb = 0; tb < 4; ++tb) { const bf16* qp = Q1 + (row0_ + 16 * tb + m) * 1024 + h * 128 + 32 * kq + 4 * g; F.q[tb][0] = *(const unsigned long long*)qp; F.q[tb][1] = *(const unsigned long long*)(qp + 16); } \
        _Pragma("unroll") for (int i = 0; i < 2; ++i) { F.dc[i] = *(const f32x4*)(DEC + ch_ * 128 + 32 * kq + 16 * i + 4 * g); \
            _Pragma("unroll") for (int ks = 0; ks < 2; ++ks) F.ks[i][ks] = *(const bf16x8*)(KST + (ch_ * 128 + 32 * kq + 16 * i + m) * 64 + 32 * ks + 8 * g); } } while (0)
#define REC_BODY(F, Fn, c_) do { \
        if ((c_) + 1 < 32) REC_LOAD(Fn, (c_) + 1); \
        LAS float* rb = red + ((c_) & 1) * 4096; \
        f32x4 oin = __builtin_amdgcn_mfma_f32_16x16x32_bf16(F.a0, F.vb[0], (f32x4){0.f, 0.f, 0.f, 0.f}, 0, 0, 0); \
        if (kq >= 2) oin = __builtin_amdgcn_mfma_f32_16x16x32_bf16(F.a1, F.vb[1], oin, 0, 0, 0); \
        { u32x4v sw; sw.x = pk2(S[0][0], S[0][1]); sw.y = pk2(S[0][2], S[0][3]); sw.z = pk2(S[1][0], S[1][1]); sw.w = pk2(S[1][2], S[1][3]); \
          const bf16x8 sb = __builtin_bit_cast(bf16x8, sw); \
          _Pragma("unroll") for (int tb = 0; tb < 4; ++tb) { u32x4v aw; aw.x = (unsigned)F.q[tb][0]; aw.y = (unsigned)(F.q[tb][0] >> 32); aw.z = (unsigned)F.q[tb][1]; aw.w = (unsigned)(F.q[tb][1] >> 32); \
              const f32x4 po = __builtin_amdgcn_mfma_f32_16x16x32_bf16(__builtin_bit_cast(bf16x8, aw), sb, (f32x4){0.f, 0.f, 0.f, 0.f}, 0, 0, 0); \
              *(LAS f32x4*)(rb + ((kq * 4 + tb) * 64 + l) * 4) = po; } } \
        _Pragma("unroll") for (int i = 0; i < 2; ++i) { S[i] = S[i] * F.dc[i]; \
            _Pragma("unroll") for (int ks = 0; ks < 2; ++ks) S[i] = __builtin_amdgcn_mfma_f32_16x16x32_bf16(F.ks[i][ks], F.vb[ks], S[i], 0, 0, 0); } \
        asm volatile("s_waitcnt lgkmcnt(0)" ::: "memory"); __builtin_amdgcn_s_barrier(); asm volatile("" ::: "memory"); \
        { f32x4 o = oin; \
          _Pragma("unroll") for (int k2 = 0; k2 < 4; ++k2) o = o + *(const LAS f32x4*)(rb + ((k2 * 4 + kq) * 64 + l) * 4); \
          const size_t orow = (size_t)b * SEQLEN + (c_) * 64 + 16 * kq + 4 * g; \
          _Pragma("unroll") for (int r = 0; r < 4; ++r) OF[(orow + r) * 1024 + col] = o[r]; } } while (0)
    for (int t0 = C.vcu; t0 < NTASK / 2; t0 += C.G) {
        const int task = gi * (NTASK / 2) + t0;
        const int cb = task % NCB, bh = task / NCB, b = bh / NH, h = bh % NH;
        const int col = h * DV + cb * 16 + m;
        f32x4 S[2];
        S[0] = (f32x4){0.f, 0.f, 0.f, 0.f}; S[1] = S[0];
        RecFrag FA, FB;
        REC_LOAD(FA, 0);
#pragma unroll 1
        for (int c = 0; c < 32; c += 2) { REC_BODY(FA, FB, c); REC_BODY(FB, FA, c + 1); }
        asm volatile("s_waitcnt lgkmcnt(0)" ::: "memory"); __builtin_amdgcn_s_barrier(); asm volatile("" ::: "memory");
    }
#undef REC_LOAD
#undef REC_BODY
}

template <int DV>
__device__ __forceinline__ void rec_norm_gate(const Ctx& C, const float* gain, const bf16* gate) {
    const float* OF = (const float*)(C.ws + WS_OF); bf16* OB = (bf16*)(C.ws + WS_OB);
    for (int tok = C.gw; tok < NTOK; tok += C.NGW) {
        const GAS f32x4* xr = (const GAS f32x4*)(OF + (size_t)tok * 1024) + C.lane;
        const GAS f32x4* gr = (const GAS f32x4*)gain + C.lane;
        const GAS unsigned long long* tr = (const GAS unsigned long long*)(gate + (size_t)tok * 1024) + C.lane;
        GAS unsigned long long* o8 = (GAS unsigned long long*)(OB + (size_t)tok * 1024) + C.lane;
#pragma unroll
        for (int j = 0; j < 4; ++j) {
            const f32x4 v = xr[64 * j]; float ss = (v.x * v.x + v.y * v.y) + (v.z * v.z + v.w * v.w);
            if (DV == 256) ss = wave_sum(ss); else { DPP_SUM31(ss); const float s_lo = rdlane(ss, 31), s_hi = rdlane(ss, 63); ss = C.lane < 32 ? s_lo : s_hi; }
            const float r = rsqrtf(ss * (1.f / DV) + RMS_EPS);
            const f32x4 g = gr[64 * j]; const unsigned long long tw = tr[64 * j];
            const float t0 = bflo((unsigned)tw), t1 = bfhi((unsigned)tw), t2 = bflo((unsigned)(tw >> 32)), t3 = bfhi((unsigned)(tw >> 32));
            const float a0 = v.x * r * g.x * (t0 * sigmoid_f(t0)), a1 = v.y * r * g.y * (t1 * sigmoid_f(t1)), a2 = v.z * r * g.z * (t2 * sigmoid_f(t2)), a3 = v.w * r * g.w * (t3 * sigmoid_f(t3));
            o8[64 * j] = (unsigned long long)pk2(a0, a1) | ((unsigned long long)pk2(a2, a3) << 32);
        }
    }
}

#define CE_D(a, b) do { const unsigned mx_ = (a) > (b) ? (a) : (b); const unsigned mn_ = (a) > (b) ? (b) : (a); (a) = mx_; (b) = mn_; } while (0)
__device__ __forceinline__ void sort16_desc(unsigned (&a)[16]) {
#pragma unroll
    for (int k = 2; k <= 16; k <<= 1)
#pragma unroll
        for (int j = k >> 1; j > 0; j >>= 1)
#pragma unroll
            for (int i = 0; i < 16; ++i) { const int l = i ^ j; if (l > i) { if ((i & k) == 0) CE_D(a[i], a[l]); else CE_D(a[l], a[i]); } }
}
__device__ __forceinline__ void merge_top16(unsigned (&a)[16], const unsigned (&b)[16]) {
#pragma unroll
    for (int i = 0; i < 16; ++i) a[i] = a[i] > b[15 - i] ? a[i] : b[15 - i];
#pragma unroll
    for (int j = 8; j > 0; j >>= 1)
#pragma unroll
        for (int i = 0; i < 16; ++i) { const int l = i ^ j; if (l > i) CE_D(a[i], a[l]); }
}
__device__ __forceinline__ void merge_quad(unsigned (&a)[16], int lane) {
    unsigned p[16];
#pragma unroll
    for (int i = 0; i < 16; ++i) p[i] = (unsigned)__builtin_amdgcn_ds_bpermute((lane ^ 16) << 2, (int)a[i]);
    merge_top16(a, p);
#pragma unroll
    for (int i = 0; i < 16; ++i) p[i] = (unsigned)__builtin_amdgcn_ds_bpermute((lane ^ 32) << 2, (int)a[i]);
    merge_top16(a, p);
}
__device__ __forceinline__ unsigned mono_key(float f) { const unsigned u = __float_as_uint(f); return (u & 0x80000000u) ? ~u : (u | 0x80000000u); }
__device__ __forceinline__ float mono_inv(unsigned k) { return __uint_as_float((k & 0x80000000u) ? (k ^ 0x80000000u) : ~k); }
__constant__ __attribute__((aligned(16))) unsigned char PEER_CAND[64] = {0, 1, 2, 3, 4, 5, 6, 7, 8, 9, 10, 11, 12, 13, 14, 15, 16, 17, 18, 19, 20, 21, 22, 23, 32, 33, 34, 35, 36, 64, 65, 66, 48, 49, 50, 51, 80, 81, 96, 97, 112, 113, 128, 144, 160, 176, 192, 208, 224, 240, 255, 255, 255, 255, 255, 255, 255, 255, 255, 255, 255, 255, 255, 255};
__device__ __forceinline__ void peer_topk_task(const Ctx& C, int layer, int tok0, int head, int trow0, LAS int* lexp, LAS float* lgate) {
    typedef _Float16 h8 __attribute__((ext_vector_type(8)));
    const _Float16* SC = (const _Float16*)(C.ws + WS_Q2);
    LAS unsigned* L0 = (LAS unsigned*)(C.lds + C.wave * 2048);
    LAS unsigned* L1 = L0 + 256;
    {
        int l = C.lane; asm volatile("" : "+v"(l));
        const int m = l & 15, g = l >> 4;
        unsigned cand_w[4];
#pragma unroll
        for (int c = 0; c < 4; ++c) cand_w[c] = ((const unsigned*)PEER_CAND)[g * 4 + c];
        unsigned top[2][16];
#pragma unroll
        for (int p = 0; p < 2; ++p) {
            const _Float16* sp = SC + (size_t)(tok0 + m) * 2048 + head * 256 + p * 128 + 32 * g;
            h8 hv[4];
#pragma unroll
            for (int q = 0; q < 4; ++q) hv[q] = *(const h8*)(sp + 8 * q);
            unsigned hi16[16];
#pragma unroll
            for (int q = 0; q < 4; ++q)
#pragma unroll
                for (int j = 0; j < 8; ++j) { const int i = 8 * q + j; const unsigned key = (mono_key((float)hv[q][j]) & ~0x7fu) | (unsigned)(127 - (32 * g + i));
                    if (i < 16) top[p][i] = key; else hi16[i - 16] = key; }
            sort16_desc(top[p]); sort16_desc(hi16); merge_top16(top[p], hi16);
            merge_quad(top[p], l);
        }
        if (g == 0) {
#pragma unroll
            for (int i = 0; i < 16; i += 4) { *(LAS u32x4v*)(L0 + m * 16 + i) = (u32x4v){top[0][i], top[0][i + 1], top[0][i + 2], top[0][i + 3]}; *(LAS u32x4v*)(L1 + m * 16 + i) = (u32x4v){top[1][i], top[1][i + 1], top[1][i + 2], top[1][i + 3]}; }
        }
        asm volatile("s_waitcnt lgkmcnt(0)" ::: "memory"); __builtin_amdgcn_wave_barrier();
        unsigned cd[16];
#pragma unroll
        for (int c = 0; c < 16; ++c) {
            const unsigned code = (cand_w[c >> 2] >> (8 * (c & 3))) & 0xffu, ci = (code >> 4) & 15u, cj = code & 15u;
            const float v = mono_inv(L0[m * 16 + ci]) + mono_inv(L1[m * 16 + cj]);
            cd[c] = code == 255u ? 0u : ((mono_key(v) & ~0xffu) | (255u - code));
        }
        sort16_desc(cd); merge_quad(cd, l);
        if (g == 0) {
            float best[16]; int ex[16]; float sum = 0.f;
#pragma unroll
            for (int r = 0; r < 16; ++r) { const unsigned pos = 255u - (cd[r] & 0xffu), pi = pos >> 4, pj = pos & 15u;
                ex[r] = (int)((127u - (L0[m * 16 + pi] & 0x7fu)) * 128u + (127u - (L1[m * 16 + pj] & 0x7fu))); best[r] = mono_inv(cd[r]); }
            const float bmax = best[0];
#pragma unroll
            for (int r = 0; r < 16; ++r) { best[r] = __expf(best[r] - bmax); sum += best[r]; }
            const float inv = 1.f / sum;
            const int ob = (trow0 + m) * 128 + head * 16;
#pragma unroll
            for (int r = 0; r < 16; r += 4) { *(LAS u32x4v*)(lexp + ob + r) = (u32x4v){(unsigned)ex[r], (unsigned)ex[r + 1], (unsigned)ex[r + 2], (unsigned)ex[r + 3]};
                *(LAS f32x4*)(lgate + ob + r) = (f32x4){best[r] * inv, best[r + 1] * inv, best[r + 2] * inv, best[r + 3] * inv}; }
        }
        asm volatile("s_waitcnt lgkmcnt(0)" ::: "memory"); __builtin_amdgcn_wave_barrier();
    }
}
typedef float f32x2v __attribute__((ext_vector_type(2)));
template <bool DRY>
__device__ __forceinline__ void peer_gather_token(const Ctx& C, int layer, int tok, const LAS int* lexp_row, const LAS float* lgate_row) {
    const unsigned char* U = C.ws + WS_U + (size_t)layer * 16384 * 1024; const unsigned char* V = C.ws + WS_V + (size_t)layer * 16384 * 1024;
    const float* SU = (const float*)(C.ws + WS_SU) + layer * 16384; const float* SV = (const float*)(C.ws + WS_SV) + layer * 16384;
    const float* gf = C.in[2] + layer * 1024; const float* gn = C.in[1] + (layer + 1) * 1024;
    const int l = C.lane; constexpr int GS = 8;
    {
        const float* hrow = C.out + (size_t)tok * 1024; float* hout = (DRY ? (float*)(C.ws + WS_OF) : C.out) + (size_t)tok * 1024;
        float hv[16], x[16];
#pragma unroll
        for (int i = 0; i < 4; ++i) { const f32x4 a = *(const GAS f32x4*)(hrow + 16 * l + 4 * i); hv[4 * i] = a.x; hv[4 * i + 1] = a.y; hv[4 * i + 2] = a.z; hv[4 * i + 3] = a.w; }
        float ss = 0.f;
#pragma unroll
        for (int i = 0; i < 16; ++i) ss += hv[i] * hv[i];
        const float r = rsqrtf(wave_sum(ss) * (1.f / 1024.f) + RMS_EPS);
#pragma unroll
        for (int i = 0; i < 4; ++i) { const f32x4 a = *(const GAS f32x4*)(gf + 16 * l + 4 * i); x[4 * i] = hv[4 * i] * r * a.x; x[4 * i + 1] = hv[4 * i + 1] * r * a.y; x[4 * i + 2] = hv[4 * i + 2] * r * a.z; x[4 * i + 3] = hv[4 * i + 3] * r * a.w; }
        int eid[2]; float gt[2];
        eid[0] = lexp_row[l]; eid[1] = lexp_row[64 + l]; gt[0] = lgate_row[l]; gt[1] = lgate_row[64 + l];
        const float su0 = SU[eid[0]], su1 = SU[eid[1]], sv0 = SV[eid[0]], sv1 = SV[eid[1]];
        float H[2] = {0.f, 0.f};
#ifndef MK_HOTG
#define MK_HOTG 0
#endif
#define GATHER_LOAD(T, buf, half, e0) _Pragma("unroll") for (int j = 0; j < GS; ++j) { int ex = __builtin_amdgcn_readlane(eid[half], (e0) + j); if (DRY && MK_HOTG) ex &= 255; buf[j] = *(const GAS v4u*)(T + (size_t)ex * 1024 + 16 * l); }
#define GATHER_DOT(buf, half, e0) _Pragma("unroll") for (int j = 0; j < GS; ++j) { float d = 0.f; \
            _Pragma("unroll") for (int q = 0; q < 4; ++q) { const f32x2v lo = __builtin_amdgcn_cvt_pk_f32_fp8((int)buf[j][q], false), hi = __builtin_amdgcn_cvt_pk_f32_fp8((int)buf[j][q], true); \
                d += x[4 * q] * lo.x; d += x[4 * q + 1] * lo.y; d += x[4 * q + 2] * hi.x; d += x[4 * q + 3] * hi.y; } \
            DPP_SUM63(d); const float sd = __builtin_bit_cast(float, __builtin_amdgcn_readlane(__builtin_bit_cast(int, d), 63)); \
            H[half] = (l == (e0) + j) ? sd : H[half]; }
        {
            v4u bA[GS], bB[GS];
#pragma unroll
            for (int half = 0; half < 2; ++half) {
                GATHER_LOAD(U, bA, half, 0);
#pragma unroll 1
                for (int e0 = 0; e0 < 64; e0 += 2 * GS) {
                    GATHER_LOAD(U, bB, half, e0 + GS);
                    GATHER_DOT(bA, half, e0);
                    if (e0 + 2 * GS < 64) { GATHER_LOAD(U, bA, half, e0 + 2 * GS); }
                    GATHER_DOT(bB, half, e0 + GS);
                }
            }
        }
        float W[2];
        { const pg8::f32x2 gl = pg8::gelu_pk((pg8::f32x2){H[0] * su0, H[1] * su1}); W[0] = gl.x * gt[0] * sv0; W[1] = gl.y * gt[1] * sv1; }
        float y[16];
#pragma unroll
        for (int i = 0; i < 16; ++i) y[i] = 0.f;
#define GATHER_AXPY(buf, half, e0) _Pragma("unroll") for (int j = 0; j < GS; ++j) { const float w = __builtin_bit_cast(float, __builtin_amdgcn_readlane(__builtin_bit_cast(int, W[half]), (e0) + j)); \
            _Pragma("unroll") for (int q = 0; q < 4; ++q) { const f32x2v lo = __builtin_amdgcn_cvt_pk_f32_fp8((int)buf[j][q], false), hi = __builtin_amdgcn_cvt_pk_f32_fp8((int)buf[j][q], true); \
                y[4 * q] += w * lo.x; y[4 * q + 1] += w * lo.y; y[4 * q + 2] += w * hi.x; y[4 * q + 3] += w * hi.y; } }
        {
            v4u bA[GS], bB[GS];
#pragma unroll
            for (int half = 0; half < 2; ++half) {
                GATHER_LOAD(V, bA, half, 0);
#pragma unroll 1
                for (int e0 = 0; e0 < 64; e0 += 2 * GS) {
                    GATHER_LOAD(V, bB, half, e0 + GS);
                    GATHER_AXPY(bA, half, e0);
                    if (e0 + 2 * GS < 64) { GATHER_LOAD(V, bA, half, e0 + 2 * GS); }
                    GATHER_AXPY(bB, half, e0 + GS);
                }
            }
        }
#undef GATHER_LOAD
#undef GATHER_DOT
#undef GATHER_AXPY
        float s2 = 0.f;
#pragma unroll
        for (int i = 0; i < 16; ++i) { hv[i] += y[i]; s2 += hv[i] * hv[i]; }
#pragma unroll
        for (int i = 0; i < 4; ++i) *(GAS f32x4*)(hout + 16 * l + 4 * i) = (f32x4){hv[4 * i], hv[4 * i + 1], hv[4 * i + 2], hv[4 * i + 3]};
        if (layer < DEPTH - 1) {
            const float r2 = rsqrtf(wave_sum(s2) * (1.f / 1024.f) + RMS_EPS);
            bf16* xo = (bf16*)(C.ws + (DRY ? WS_GLOG : WS_XN)) + (size_t)tok * 1024 + 16 * l;
            unsigned pw[8];
#pragma unroll
            for (int i = 0; i < 4; ++i) { const f32x4 a = *(const GAS f32x4*)(gn + 16 * l + 4 * i); pw[2 * i] = pk2(hv[4 * i] * r2 * a.x, hv[4 * i + 1] * r2 * a.y); pw[2 * i + 1] = pk2(hv[4 * i + 2] * r2 * a.z, hv[4 * i + 3] * r2 * a.w); }
            *(GAS v4u*)xo = (v4u){pw[0], pw[1], pw[2], pw[3]}; *(GAS v4u*)(xo + 8) = (v4u){pw[4], pw[5], pw[6], pw[7]};
        }
    }
}

__device__ __forceinline__ void wave_lds_sync() { asm volatile("s_waitcnt lgkmcnt(0)" ::: "memory"); __builtin_amdgcn_wave_barrier(); }
#define DEC16(B, rv) do { _Pragma("unroll") for (int q_ = 0; q_ < 4; ++q_) { const f32x2v lo_ = __builtin_amdgcn_cvt_pk_f32_fp8((int)B[q_], false), hi_ = __builtin_amdgcn_cvt_pk_f32_fp8((int)B[q_], true); \
        rv[4 * q_] = lo_.x; rv[4 * q_ + 1] = lo_.y; rv[4 * q_ + 2] = hi_.x; rv[4 * q_ + 3] = hi_.y; } } while (0)
template <bool DRY>
__device__ __forceinline__ void peer_sweep(const Ctx& C, int layer, int tokw, LAS int* lexp_w, const LAS float* lgate_w, LAS unsigned* sorted_w, LAS unsigned* hist_w) {
    const unsigned char* U = C.ws + WS_U + (size_t)layer * 16384 * 1024; const unsigned char* V = C.ws + WS_V + (size_t)layer * 16384 * 1024;
    const float* SU = (const float*)(C.ws + WS_SU) + layer * 16384; const float* SV = (const float*)(C.ws + WS_SV) + layer * 16384;
    const float* gf = C.in[2] + layer * 1024; const float* gn = C.in[1] + (layer + 1) * 1024;
    int l = C.lane; asm volatile("" : "+v"(l));
    LAS float* hbuf = (LAS float*)lexp_w;
    hist_w[l] = 0u; hist_w[64 + l] = 0u;
    wave_lds_sync();
    {
        unsigned ev[16], pos[16];
#pragma unroll
        for (int r = 0; r < 16; ++r) { ev[r] = (unsigned)lexp_w[l + 64 * r]; pos[r] = __hip_atomic_fetch_add(hist_w + (ev[r] >> 7), 1u, __ATOMIC_RELAXED, __HIP_MEMORY_SCOPE_WORKGROUP); }
        wave_lds_sync();
        const unsigned ha = hist_w[2 * l], hb = hist_w[2 * l + 1], hs = ha + hb; unsigned inc = hs;
#pragma unroll
        for (int o = 1; o < 64; o <<= 1) { const unsigned up = (unsigned)__builtin_amdgcn_ds_bpermute((l - o) << 2, (int)inc); if (l >= o) inc += up; }
        hist_w[128 + 2 * l] = inc - hs; hist_w[128 + 2 * l + 1] = inc - hs + ha;
        wave_lds_sync();
#pragma unroll
        for (int r = 0; r < 16; ++r) sorted_w[hist_w[128 + (ev[r] >> 7)] + pos[r]] = (ev[r] << 10) | (unsigned)(l + 64 * r);
        wave_lds_sync();
    }
    asm volatile("" : "+v"(l));
    unsigned x[8][8];
#pragma unroll
    for (int t = 0; t < 8; ++t) {
        const float* hrow = C.out + (size_t)(tokw + t) * 1024;
        f32x4 hq[4]; float ss = 0.f;
#pragma unroll
        for (int i = 0; i < 4; ++i) { hq[i] = *(const GAS f32x4*)(hrow + 16 * l + 4 * i); ss += (hq[i].x * hq[i].x + hq[i].y * hq[i].y) + (hq[i].z * hq[i].z + hq[i].w * hq[i].w); }
        const float r = rsqrtf(wave_sum(ss) * (1.f / 1024.f) + RMS_EPS);
#pragma unroll
        for (int i = 0; i < 4; ++i) { const f32x4 a = *(const GAS f32x4*)(gf + 16 * l + 4 * i); x[t][2 * i] = pk2(hq[i].x * r * a.x, hq[i].y * r * a.y); x[t][2 * i + 1] = pk2(hq[i].z * r * a.z, hq[i].w * r * a.w); }
    }
    asm volatile("" ::: "memory");
    asm volatile("" : "+v"(l));
#ifndef MK_HOT
#define MK_HOT 0
#endif
#define SWEEP_LOAD(T, j, item) do { const unsigned char* p_ = T + (size_t)((DRY && MK_HOT) ? (((item) >> 10) & 255u) : ((item) >> 10)) * 1024 + 16 * l; \
        asm volatile("global_load_dwordx4 %0, %1, off" : "=v"(buf[j]) : "v"(p_) : "memory"); } while (0)
#define SWEEP_WAIT(j) asm volatile("s_waitcnt vmcnt(7)" : "+v"(buf[j]) :: "memory")
    {
        v4u buf[8];
        unsigned icur = sorted_w[l];
#pragma unroll
        for (int j = 0; j < 8; ++j) SWEEP_LOAD(U, j, (unsigned)__builtin_amdgcn_readlane((int)icur, j));
#pragma unroll 1
        for (int q = 0; q < 16; ++q) {
            const unsigned inxt = sorted_w[((q + 1) & 15) * 64 + l];
#pragma unroll 1
            for (int g = 0; g < 8; ++g) {
                const unsigned isrc = g == 7 ? inxt : icur;
#pragma unroll
                for (int j = 0; j < 8; ++j) {
                    const unsigned item = (unsigned)__builtin_amdgcn_readlane((int)icur, 8 * g + j);
                    SWEEP_WAIT(j);
                    unsigned rp[8];
#pragma unroll
                    for (int q_ = 0; q_ < 4; ++q_) { const f32x2v lo_ = __builtin_amdgcn_cvt_pk_f32_fp8((int)buf[j][q_], false), hi_ = __builtin_amdgcn_cvt_pk_f32_fp8((int)buf[j][q_], true);
                        rp[2 * q_] = pg8::cvt_pk_bf16(lo_.x, lo_.y); rp[2 * q_ + 1] = pg8::cvt_pk_bf16(hi_.x, hi_.y); }
                    float d = 0.f;
#define UDOT(T) case T: { _Pragma("unroll") for (int i = 0; i < 8; ++i) d = dot2bf(rp[i], x[T][i], d); } break;
                    switch ((item >> 7) & 7u) { UDOT(0) UDOT(1) UDOT(2) UDOT(3) UDOT(4) UDOT(5) UDOT(6) default: { _Pragma("unroll") for (int i = 0; i < 8; ++i) d = dot2bf(rp[i], x[7][i], d); } break; }
#undef UDOT
                    DPP_SUM63(d);
                    if (l == 63) hbuf[q * 64 + g * 8 + j] = d;
                    SWEEP_LOAD(U, j, (unsigned)__builtin_amdgcn_readlane((int)isrc, (8 * g + j + 8) & 63));
                }
            }
            icur = inxt;
        }
        asm volatile("s_waitcnt vmcnt(0)" : "+v"(buf[0]), "+v"(buf[1]), "+v"(buf[2]), "+v"(buf[3]), "+v"(buf[4]), "+v"(buf[5]), "+v"(buf[6]), "+v"(buf[7]) :: "memory");
    }
    wave_lds_sync();
    asm volatile("" : "+v"(l));
#pragma unroll
    for (int r = 0; r < 16; r += 2) {
        const unsigned i0 = sorted_w[l + 64 * r], i1 = sorted_w[l + 64 * (r + 1)];
        const float h0 = hbuf[l + 64 * r] * SU[i0 >> 10], h1 = hbuf[l + 64 * (r + 1)] * SU[i1 >> 10];
        const pg8::f32x2 gl = pg8::gelu_pk((pg8::f32x2){h0, h1});
        hbuf[l + 64 * r] = gl.x * lgate_w[i0 & 1023u] * SV[i0 >> 10]; hbuf[l + 64 * (r + 1)] = gl.y * lgate_w[i1 & 1023u] * SV[i1 >> 10];
    }
    wave_lds_sync();
    asm volatile("" : "+v"(l));
    float y[8][16];
#pragma unroll
    for (int t = 0; t < 8; ++t)
#pragma unroll
        for (int i = 0; i < 16; ++i) y[t][i] = 0.f;
    {
        v4u buf[8]; float wq[8];
        unsigned icur = sorted_w[l];
#pragma unroll
        for (int j = 0; j < 8; ++j) { SWEEP_LOAD(V, j, (unsigned)__builtin_amdgcn_readlane((int)icur, j)); wq[j] = hbuf[j]; }
#pragma unroll 1
        for (int q = 0; q < 16; ++q) {
            const unsigned inxt = sorted_w[((q + 1) & 15) * 64 + l];
#pragma unroll 1
            for (int g = 0; g < 8; ++g) {
                const unsigned isrc = g == 7 ? inxt : icur;
#pragma unroll
                for (int j = 0; j < 8; ++j) {
                    const unsigned item = (unsigned)__builtin_amdgcn_readlane((int)icur, 8 * g + j);
                    SWEEP_WAIT(j);
                    const float w = wq[j];
#define VAXPY(T) { _Pragma("unroll") for (int q_ = 0; q_ < 4; ++q_) { const f32x2v lo_ = __builtin_amdgcn_cvt_pk_f32_fp8((int)buf[j][q_], false), hi_ = __builtin_amdgcn_cvt_pk_f32_fp8((int)buf[j][q_], true); \
                        y[T][4 * q_] += w * lo_.x; y[T][4 * q_ + 1] += w * lo_.y; y[T][4 * q_ + 2] += w * hi_.x; y[T][4 * q_ + 3] += w * hi_.y; } }
                    switch ((item >> 7) & 7u) { case 0: VAXPY(0) break; case 1: VAXPY(1) break; case 2: VAXPY(2) break; case 3: VAXPY(3) break; case 4: VAXPY(4) break; case 5: VAXPY(5) break; case 6: VAXPY(6) break; default: VAXPY(7) break; }
#undef VAXPY
                    SWEEP_LOAD(V, j, (unsigned)__builtin_amdgcn_readlane((int)isrc, (8 * g + j + 8) & 63));
                    wq[j] = hbuf[(q * 64 + g * 8 + j + 8) & 1023];
                }
            }
            icur = inxt;
        }
        asm volatile("s_waitcnt vmcnt(0)" : "+v"(buf[0]), "+v"(buf[1]), "+v"(buf[2]), "+v"(buf[3]), "+v"(buf[4]), "+v"(buf[5]), "+v"(buf[6]), "+v"(buf[7]) :: "memory");
    }
#undef SWEEP_LOAD
#undef SWEEP_WAIT
    asm volatile("" : "+v"(l));
#pragma unroll
    for (int t = 0; t < 8; ++t) {
        const float* hrow = C.out + (size_t)(tokw + t) * 1024; float* hout = (DRY ? (float*)(C.ws + WS_OF) : C.out) + (size_t)(tokw + t) * 1024;
        float hv[16]; float s2 = 0.f;
#pragma unroll
        for (int i = 0; i < 4; ++i) { const f32x4 a = *(const GAS f32x4*)(hrow + 16 * l + 4 * i); hv[4 * i] = a.x + y[t][4 * i]; hv[4 * i + 1] = a.y + y[t][4 * i + 1]; hv[4 * i + 2] = a.z + y[t][4 * i + 2]; hv[4 * i + 3] = a.w + y[t][4 * i + 3]; }
#pragma unroll
        for (int i = 0; i < 16; ++i) s2 += hv[i] * hv[i];
#pragma unroll
        for (int i = 0; i < 4; ++i) *(GAS f32x4*)(hout + 16 * l + 4 * i) = (f32x4){hv[4 * i], hv[4 * i + 1], hv[4 * i + 2], hv[4 * i + 3]};
        if (layer < DEPTH - 1) {
            const float r2 = rsqrtf(wave_sum(s2) * (1.f / 1024.f) + RMS_EPS);
            bf16* xo = (bf16*)(C.ws + (DRY ? WS_GLOG : WS_XN)) + (size_t)(tokw + t) * 1024 + 16 * l;
            unsigned pw[8];
#pragma unroll
            for (int i = 0; i < 4; ++i) { const f32x4 a = *(const GAS f32x4*)(gn + 16 * l + 4 * i); pw[2 * i] = pk2(hv[4 * i] * r2 * a.x, hv[4 * i + 1] * r2 * a.y); pw[2 * i + 1] = pk2(hv[4 * i + 2] * r2 * a.z, hv[4 * i + 3] * r2 * a.w); }
            *(GAS v4u*)xo = (v4u){pw[0], pw[1], pw[2], pw[3]}; *(GAS v4u*)(xo + 8) = (v4u){pw[4], pw[5], pw[6], pw[7]};
        }
    }
}
#define GRP8_SUM(v) do { v = DPP_ADD(v, 0xB1, 0xf, 0xf); v = DPP_ADD(v, 0x4E, 0xf, 0xf); v = DPP_ADD(v, 0x141, 0xf, 0xf); } while (0)
template <bool DRY>
__device__ __forceinline__ void peer_rounds(const Ctx& C, int layer, int tokw, LAS int* lexp_w, const LAS float* lgate_w, LAS unsigned* sorted_w, LAS unsigned* hist_w) {
    const unsigned char* U = C.ws + WS_U + (size_t)layer * 16384 * 1024; const unsigned char* V = C.ws + WS_V + (size_t)layer * 16384 * 1024;
    const float* SU = (const float*)(C.ws + WS_SU) + layer * 16384; const float* SV = (const float*)(C.ws + WS_SV) + layer * 16384;
    const float* gf = C.in[2] + layer * 1024; const float* gn = C.in[1] + (layer + 1) * 1024;
    int l = C.lane; asm volatile("" : "+v"(l));
    LAS float* hbuf = (LAS float*)lexp_w;
    {
        const int t = l >> 3, s = l & 7;
#pragma unroll
        for (int k = 0; k < 8; ++k) hist_w[l + 64 * k] = 0u;
        wave_lds_sync();
        unsigned ev[16], pos[16];
#pragma unroll
        for (int k = 0; k < 16; ++k) { ev[k] = (unsigned)lexp_w[t * 128 + s + 8 * k]; pos[k] = __hip_atomic_fetch_add(hist_w + t * 64 + (ev[k] >> 8), 1u, __ATOMIC_RELAXED, __HIP_MEMORY_SCOPE_WORKGROUP); }
        wave_lds_sync();
        unsigned cnt[8], run = 0u;
#pragma unroll
        for (int j = 0; j < 8; ++j) { cnt[j] = hist_w[t * 64 + 8 * s + j]; run += cnt[j]; }
        unsigned inc = run;
#pragma unroll
        for (int o = 1; o < 8; o <<= 1) { const unsigned up = (unsigned)__builtin_amdgcn_ds_bpermute((l - o) << 2, (int)inc); if (s >= o) inc += up; }
        unsigned off = inc - run;
        wave_lds_sync();
#pragma unroll
        for (int j = 0; j < 8; ++j) { hist_w[t * 64 + 8 * s + j] = off; off += cnt[j]; }
        wave_lds_sync();
#pragma unroll
        for (int k = 0; k < 16; ++k) sorted_w[t * 128 + hist_w[t * 64 + (ev[k] >> 8)] + pos[k]] = (ev[k] << 7) | (unsigned)(s + 8 * k);
        wave_lds_sync();
    }
    asm volatile("" : "+v"(l));
    unsigned xp[8][8];
    {
        const int t = l >> 3, s = l & 7;
        const float* hrow = C.out + (size_t)(tokw + t) * 1024 + 16 * s;
        f32x4 hq[8][4]; float ss = 0.f;
#pragma unroll
        for (int i = 0; i < 8; ++i)
#pragma unroll
            for (int q = 0; q < 4; ++q) { hq[i][q] = *(const GAS f32x4*)(hrow + 128 * i + 4 * q); ss += (hq[i][q].x * hq[i][q].x + hq[i][q].y * hq[i][q].y) + (hq[i][q].z * hq[i][q].z + hq[i][q].w * hq[i][q].w); }
        GRP8_SUM(ss);
        const float r = rsqrtf(ss * (1.f / 1024.f) + RMS_EPS);
#pragma unroll
        for (int i = 0; i < 8; ++i)
#pragma unroll
            for (int q = 0; q < 4; ++q) { const f32x4 a = *(const GAS f32x4*)(gf + 16 * s + 128 * i + 4 * q); xp[i][2 * q] = pk2(hq[i][q].x * r * a.x, hq[i][q].y * r * a.y); xp[i][2 * q + 1] = pk2(hq[i][q].z * r * a.z, hq[i][q].w * r * a.w); }
    }
    asm volatile("" : "+v"(l));
#define RND_LOAD(T, buf, item) do { const unsigned char* p_ = T + (size_t)((DRY && MK_HOT) ? (((item) >> 7) & 255u) : ((item) >> 7)) * 1024 + 16 * (l & 7); \
        _Pragma("unroll") for (int i = 0; i < 8; ++i) buf[i] = *(const GAS v4u*)(p_ + 128 * i); } while (0)
    {
        const int t = l >> 3, s = l & 7;
        const LAS unsigned* srt = sorted_w + t * 128;
        v4u bA[8], bB[8];
#define RND_DOT(buf, r_) do { float d = 0.f; \
            _Pragma("unroll") for (int i = 0; i < 8; ++i) { asm volatile("" : "+v"(buf[i])); _Pragma("unroll") for (int q = 0; q < 4; ++q) { \
                const f32x2v lo_ = __builtin_amdgcn_cvt_pk_f32_fp8((int)buf[i][q], false), hi_ = __builtin_amdgcn_cvt_pk_f32_fp8((int)buf[i][q], true); \
                d = dot2bf(pg8::cvt_pk_bf16(lo_.x, lo_.y), xp[i][2 * q], d); d = dot2bf(pg8::cvt_pk_bf16(hi_.x, hi_.y), xp[i][2 * q + 1], d); } } \
            GRP8_SUM(d); if (s == 0) hbuf[t * 128 + (r_)] = d; } while (0)
        RND_LOAD(U, bA, srt[0]);
#pragma unroll 1
        for (int r = 0; r < 128; r += 2) {
            RND_LOAD(U, bB, srt[r + 1]);
            RND_DOT(bA, r);
            RND_LOAD(U, bA, srt[(r + 2) & 127]);
            RND_DOT(bB, r + 1);
        }
#undef RND_DOT
    }
    wave_lds_sync();
    asm volatile("" : "+v"(l));
    {
        const int t = l >> 3, s = l & 7;
#pragma unroll
        for (int k = 0; k < 16; k += 2) {
            const int r0 = t * 128 + s + 8 * k, r1 = r0 + 8;
            const unsigned i0 = sorted_w[r0], i1 = sorted_w[r1];
            const float h0 = hbuf[r0] * SU[i0 >> 7], h1 = hbuf[r1] * SU[i1 >> 7];
            const pg8::f32x2 gl = pg8::gelu_pk((pg8::f32x2){h0, h1});
            hbuf[r0] = gl.x * lgate_w[t * 128 + (i0 & 127u)] * SV[i0 >> 7]; hbuf[r1] = gl.y * lgate_w[t * 128 + (i1 & 127u)] * SV[i1 >> 7];
        }
    }
    wave_lds_sync();
    asm volatile("" : "+v"(l));
    f32x2v y2[8][8];
#pragma unroll
    for (int i = 0; i < 8; ++i)
#pragma unroll
        for (int j = 0; j < 8; ++j) y2[i][j] = (f32x2v){0.f, 0.f};
    {
        const int t = l >> 3;
        const LAS unsigned* srt = sorted_w + t * 128; const LAS float* wv = hbuf + t * 128;
        v4u bA[8], bB[8];
#define RND_AXPY(buf, r_) do { const float w = wv[(r_)]; const f32x2v w2 = (f32x2v){w, w}; \
            _Pragma("unroll") for (int i = 0; i < 8; ++i) { asm volatile("" : "+v"(buf[i])); _Pragma("unroll") for (int q = 0; q < 4; ++q) { \
                const f32x2v lo_ = __builtin_amdgcn_cvt_pk_f32_fp8((int)buf[i][q], false), hi_ = __builtin_amdgcn_cvt_pk_f32_fp8((int)buf[i][q], true); \
                y2[i][2 * q] = w2 * lo_ + y2[i][2 * q]; y2[i][2 * q + 1] = w2 * hi_ + y2[i][2 * q + 1]; } } } while (0)
        RND_LOAD(V, bA, srt[0]);
#pragma unroll 1
        for (int r = 0; r < 128; r += 2) {
            RND_LOAD(V, bB, srt[r + 1]);
            RND_AXPY(bA, r);
            RND_LOAD(V, bA, srt[(r + 2) & 127]);
            RND_AXPY(bB, r + 1);
        }
#undef RND_AXPY
    }
#undef RND_LOAD
    asm volatile("" : "+v"(l));
    {
        const int t = l >> 3, s = l & 7;
        const float* hrow = C.out + (size_t)(tokw + t) * 1024 + 16 * s; float* hout = (DRY ? (float*)(C.ws + WS_OF) : C.out) + (size_t)(tokw + t) * 1024 + 16 * s;
        float s2 = 0.f;
#pragma unroll
        for (int i = 0; i < 8; ++i)
#pragma unroll
            for (int q = 0; q < 4; ++q) { const f32x4 a = *(const GAS f32x4*)(hrow + 128 * i + 4 * q);
                y2[i][2 * q].x += a.x; y2[i][2 * q].y += a.y; y2[i][2 * q + 1].x += a.z; y2[i][2 * q + 1].y += a.w;
                s2 += (y2[i][2 * q].x * y2[i][2 * q].x + y2[i][2 * q].y * y2[i][2 * q].y) + (y2[i][2 * q + 1].x * y2[i][2 * q + 1].x + y2[i][2 * q + 1].y * y2[i][2 * q + 1].y);
                *(GAS f32x4*)(hout + 128 * i + 4 * q) = (f32x4){y2[i][2 * q].x, y2[i][2 * q].y, y2[i][2 * q + 1].x, y2[i][2 * q + 1].y}; }
        if (layer < DEPTH - 1) {
            GRP8_SUM(s2);
            const float r2 = rsqrtf(s2 * (1.f / 1024.f) + RMS_EPS);
            bf16* xo = (bf16*)(C.ws + (DRY ? WS_GLOG : WS_XN)) + (size_t)(tokw + t) * 1024 + 16 * s; float am = 0.f;
#pragma unroll
            for (int i = 0; i < 8; ++i) { unsigned pw[8];
#pragma unroll
                for (int q = 0; q < 4; ++q) { const f32x4 a = *(const GAS f32x4*)(gn + 16 * s + 128 * i + 4 * q);
                    y2[i][2 * q].x *= r2 * a.x; y2[i][2 * q].y *= r2 * a.y; y2[i][2 * q + 1].x *= r2 * a.z; y2[i][2 * q + 1].y *= r2 * a.w;
                    am = fmaxf(fmaxf(am, fmaxf(fabsf(y2[i][2 * q].x), fabsf(y2[i][2 * q].y))), fmaxf(fabsf(y2[i][2 * q + 1].x), fabsf(y2[i][2 * q + 1].y)));
                    pw[2 * q] = pk2(y2[i][2 * q].x, y2[i][2 * q].y); pw[2 * q + 1] = pk2(y2[i][2 * q + 1].x, y2[i][2 * q + 1].y); }
                *(GAS v4u*)(xo + 128 * i) = (v4u){pw[0], pw[1], pw[2], pw[3]}; *(GAS v4u*)(xo + 128 * i + 8) = (v4u){pw[4], pw[5], pw[6], pw[7]}; }
            am = DPP_MAX(am, 0xB1, 0xf, 0xf); am = DPP_MAX(am, 0x4E, 0xf, 0xf); am = DPP_MAX(am, 0x141, 0xf, 0xf);
            const float qi = am > 0.f ? 127.f / am : 0.f;
            signed char* xq = (signed char*)(C.ws + (DRY ? WS_GLOG + 32 * MiB : WS_XN8)) + (size_t)(tokw + t) * 1024 + 16 * s;
#pragma unroll
            for (int i = 0; i < 8; ++i) { unsigned pq[4];
#pragma unroll
                for (int q = 0; q < 4; ++q) pq[q] = q8x4(y2[i][2 * q].x * qi, y2[i][2 * q].y * qi, y2[i][2 * q + 1].x * qi, y2[i][2 * q + 1].y * qi);
                *(GAS v4u*)(xq + 128 * i) = (v4u){pq[0], pq[1], pq[2], pq[3]}; }
            if (s == 0) *(GAS float*)((float*)(C.ws + (DRY ? WS_GLOG + 48 * MiB : WS_SX)) + tokw + t) = am * (1.f / 127.f);
        }
    }
}
#ifndef MK_SWEEP
#define MK_SWEEP 2
#endif
template <bool DRY>
__device__ __forceinline__ void peer_topk_gather(const Ctx& C, int layer) {
    LAS int* lexp = (LAS int*)(C.lds + 16384);
    LAS float* lgate = (LAS float*)(C.lds + 16384 + 32768);
    LAS unsigned* sorted = (LAS unsigned*)(C.lds + 16384 + 65536);
    for (int tb = C.vcu; tb < NTOK / 64; tb += C.G) {
#pragma unroll 1
        for (int q = 0; q < 4; ++q) peer_topk_task(C, layer, tb * 64 + (C.wave & 3) * 16, (C.wave >> 2) * 4 + q, (C.wave & 3) * 16, lexp, lgate);
        __syncthreads();
#if MK_SWEEP == 2
        peer_rounds<DRY>(C, layer, tb * 64 + C.wave * 8, lexp + C.wave * 1024, lgate + C.wave * 1024, sorted + C.wave * 1024, (LAS unsigned*)(C.lds + C.wave * 2048));
#elif MK_SWEEP == 1
        peer_sweep<DRY>(C, layer, tb * 64 + C.wave * 8, lexp + C.wave * 1024, lgate + C.wave * 1024, sorted + C.wave * 1024, (LAS unsigned*)(C.lds + C.wave * 1024));
#else
#pragma unroll 1
        for (int t = 0; t < 8; ++t) peer_gather_token<DRY>(C, layer, tb * 64 + C.wave * 8 + t, lexp + (C.wave * 8 + t) * 128, lgate + (C.wave * 8 + t) * 128);
#endif
        __syncthreads();
    }
}

#ifndef MK_SINGLE
#define MK_SINGLE 1
#endif
#ifndef MK_FASTGEMM
#define MK_FASTGEMM 1
#endif
constexpr int STEPS = 10, NPHASE = 1 + DEPTH * STEPS;
struct Args { const float* in[21]; float* out; unsigned char* ws; int ph_lo, ph_hi; };

template <int EPI>
__device__ __forceinline__ void do_gemm(const Ctx& C, const bf16* A, const bf16* Bt, int N, bf16* Ob, int ldc, int split, const float* rs_in, const float* base, float* outf, bf16* hg, const float* gain, float* rs_out) {
    pg8::Gemm g{A, Bt, NTOK, N, 1024}; pg8::StaticOrder S; S.init(NTOK, N, C.G, C.bx);
    if constexpr (EPI == 0) { pg8::EpiBf16R<false> E{Ob, ldc, split ? 1024 : 0, PSTRIDE, rs_in}; pg8::gemm_phase<pg8::EpiBf16R<false>, pg8::StaticOrder, true, true>(C.lds, g, S, E, C.tid); }
    else if constexpr (EPI == 2) { pg8::EpiBf16R<true> E{Ob, ldc, 0, PSTRIDE, rs_in}; pg8::gemm_phase<pg8::EpiBf16R<true>, pg8::StaticOrder, true, true>(C.lds, g, S, E, C.tid); }
    else if constexpr (EPI == 3) {
        pg8::Gemm g8{A, Bt, NTOK, N, 512}; pg8::EpiI8 E{Ob, PSTRIDE, rs_in, gain}; pg8::gemm_phase<pg8::EpiI8, pg8::StaticOrder, true, true>(C.lds, g8, S, E, C.tid); }
    else { pg8::EpiResNorm E{base, outf, hg, gain, rs_out}; pg8::gemm_phase<pg8::EpiResNorm, pg8::StaticOrder, true, true>(C.lds, g, S, E, C.tid); }
}

template <int STEP, int MIXER>
__device__ __forceinline__ void run_step(const Ctx& C, int layer) {
    const int jx = layer / 3;
    bf16* XN = (bf16*)(C.ws + WS_XN); bf16* P = (bf16*)(C.ws + WS_P); bf16* OB = (bf16*)(C.ws + WS_OB); bf16* Q2 = (bf16*)(C.ws + WS_Q2);
    if constexpr (STEP == 0) {
        const bf16* Wt = MIXER == 0 ? (const bf16*)(C.ws + WS_FOXWIN + (size_t)jx * 8 * MiB) : MIXER == 1 ? (const bf16*)(C.ws + WS_GLAWIN) : (const bf16*)(C.ws + WS_HGRNWIN);
        const float* sw = (const float*)(C.ws + WS_SW) + (MIXER == 0 ? jx * 4096 : MIXER == 1 ? 8192 : 11264);
        if ((I8MASK >> layer) & 1) do_gemm<3>(C, (const bf16*)(C.ws + WS_XN8), Wt, MIXER == 1 ? 3072 : 4096, P, 1024, 1, (const float*)(C.ws + WS_SX), nullptr, nullptr, nullptr, sw, nullptr);
        else do_gemm<0>(C, XN, Wt, MIXER == 1 ? 3072 : 4096, P, 1024, 1, nullptr, nullptr, nullptr, nullptr, nullptr, nullptr);
    } else if constexpr (STEP == 1) {
        if constexpr (MIXER == 0) fox_step1(C, jx);
    } else if constexpr (STEP == 2) {
        if constexpr (MIXER == 1) chunk_prepass<4>(C); else if constexpr (MIXER == 2) chunk_prepass<8>(C);
    } else if constexpr (STEP == 3) {
        if constexpr (MIXER == 0) {
            const attn_body::AttnTensors AT{(const attn_body::bf16*)P, (const attn_body::bf16*)(P + PSTRIDE), (const attn_body::bf16*)(P + 2 * PSTRIDE), (attn_body::bf16*)OB, (const attn_body::bf16*)(P + 3 * PSTRIDE), (const float*)(C.ws + WS_TAIL)};
            const attn_body::StaticOrder S(C.G, C.bx);
            attn_body::attn_phase<attn_body::StaticOrder>((char*)C.lds, AT, S, C.tid);
        }
        else if constexpr (MIXER == 1) chunk_recur<4, 256>(C, P + PSTRIDE);
        else chunk_recur<8, 128>(C, P + 2 * PSTRIDE);
    } else if constexpr (STEP == 4) {
        if constexpr (MIXER == 1) rec_norm_gate<256>(C, C.in[11], P + 2 * PSTRIDE);
        else if constexpr (MIXER == 2) rec_norm_gate<128>(C, C.in[15], P + 3 * PSTRIDE);
    } else if constexpr (STEP == 5) {
        const bf16* Wt = MIXER == 0 ? (const bf16*)(C.ws + WS_FOXWOUT) + (size_t)jx * 1024 * 1024 : MIXER == 1 ? (const bf16*)(C.ws + WS_GLAWOUT) : (const bf16*)(C.ws + WS_HGRNWOUT);
        do_gemm<1>(C, OB, Wt, 1024, nullptr, 0, 0, nullptr, layer == 0 ? C.in[0] : C.out, C.out, XN, C.in[2] + layer * 1024, (float*)(C.ws + WS_RS));
    } else if constexpr (STEP == 6) {
    } else if constexpr (STEP == 7) {
        do_gemm<2>(C, XN, (const bf16*)(C.ws + WS_PEERWQ) + (size_t)layer * 2048 * 1024, 2048, Q2, 2048, 0, (const float*)(C.ws + WS_RS), nullptr, nullptr, nullptr, nullptr, nullptr);
    } else if constexpr (STEP == 8) {
        peer_topk_gather<false>(C, layer);
    } else if constexpr (STEP == 9) {
    } else if constexpr (STEP == 11) {
        peer_topk_gather<true>(C, layer);
    } else {
        p0_prologue(C);
    }
}

__device__ __forceinline__ void make_ctx(Ctx& C, const Args& args, unsigned char* lds_raw) {
    C.lds = (LAS unsigned char*)lds_raw;
    C.tid = threadIdx.x; C.lane = C.tid & 63; C.wave = __builtin_amdgcn_readfirstlane(C.tid >> 6);
    C.G = gridDim.x; C.bx = blockIdx.x; { const int bx = blockIdx.x; C.vcu = (C.G % 8 == 0) ? (bx % 8) * (C.G / 8) + bx / 8 : bx; }
    C.gw = C.vcu * NWAVES + C.wave; C.NGW = C.G * NWAVES;
#pragma unroll
    for (int i = 0; i < 21; ++i) C.in[i] = args.in[i];
    C.out = args.out; C.ws = args.ws;
}

template <int STEP, int MIXER>
__global__ void __launch_bounds__(NWAVES * 64, 2) mk_phase(Args args, int layer) {
    extern __shared__ __attribute__((aligned(16))) unsigned char lds_raw[];
    Ctx C; make_ctx(C, args, lds_raw);
    run_step<STEP, MIXER>(C, layer);
}

template <int STEP, int MIXER>
static void launch_phase(const Args& a, int layer, int grid, hipStream_t stream) {
    static bool attr_set = false;
    if (!attr_set) { (void)hipFuncSetAttribute((const void*)mk_phase<STEP, MIXER>, hipFuncAttributeMaxDynamicSharedMemorySize, LDS_BYTES); attr_set = true; }
    hipLaunchKernelGGL((mk_phase<STEP, MIXER>), dim3(grid), dim3(NWAVES * 64), LDS_BYTES, stream, a, layer);
}
#ifndef MK_DUP
#define MK_DUP -1
#endif
#define LP(S, M) do { launch_phase<S, M>(a, layer, grid, stream); if (MK_DUP == S) launch_phase<(S == 8 ? 11 : S), M>(a, layer, grid, stream); } while (0)
template <int MIXER>
static void launch_layer(const Args& a, int layer, int grid, hipStream_t stream) {
    LP(0, MIXER);
    if (MIXER == 0) launch_phase<1, MIXER>(a, layer, grid, stream); else LP(2, MIXER);
    LP(3, MIXER);
    if (MIXER != 0) LP(4, MIXER);
    LP(5, MIXER);
    LP(7, 0);
    LP(8, 0);
}
#if MK_SINGLE
__device__ __forceinline__ const float* tab_ptr(volatile LAS unsigned long long* tab, int i) {
    const unsigned long long v = tab[i];
    const unsigned lo = __builtin_amdgcn_readfirstlane((unsigned)v), hi = __builtin_amdgcn_readfirstlane((unsigned)(v >> 32));
    return (const float*)(const GAS float*)(((unsigned long long)hi << 32) | lo);
}
__device__ __forceinline__ int lane_id_volatile() { int x; asm volatile("v_mbcnt_lo_u32_b32 %0, -1, 0\n\tv_mbcnt_hi_u32_b32 %0, -1, %0" : "=v"(x)); return x; }
__device__ __forceinline__ void make_ctx_opaque(Ctx& C, unsigned char* lds_raw, int wave_s) {
    int bx = blockIdx.x, G = gridDim.x; unsigned ldso = 0u;
    asm volatile("" : "+s"(bx), "+s"(G), "+s"(ldso), "+s"(wave_s));
    int tid = wave_s * 64 + lane_id_volatile();
    C.lds = (LAS unsigned char*)lds_raw + ldso;
    volatile LAS unsigned long long* tab = (volatile LAS unsigned long long*)(C.lds + LDSCTL_OFF);
    C.tid = tid; C.lane = tid & 63; C.wave = __builtin_amdgcn_readfirstlane(tid >> 6);
    C.G = G; C.bx = bx; C.vcu = (G % 8 == 0) ? (bx % 8) * (G / 8) + bx / 8 : bx;
    C.gw = C.vcu * NWAVES + C.wave; C.NGW = G * NWAVES;
#pragma unroll
    for (int i = 0; i < 21; ++i) C.in[i] = tab_ptr(tab, i);
    C.out = (float*)tab_ptr(tab, 21); C.ws = (unsigned char*)tab_ptr(tab, 22);
}
__device__ __forceinline__ void grid_bar(unsigned char* lds_raw, int wave_s) {
    unsigned ldso = 0u; asm volatile("" : "+s"(ldso), "+s"(wave_s));
    LAS unsigned char* lds = (LAS unsigned char*)lds_raw + ldso;
    volatile LAS unsigned long long* tab = (volatile LAS unsigned long long*)(lds + LDSCTL_OFF);
    XcdBarrier b; b.bar = (unsigned*)((unsigned char*)tab_ptr(tab, 22) + WS_CTL) + CW_BAR; b.x = xb_xcc_id(); b.st = (volatile LAS unsigned*)(lds + MISC_OFF) + 8;
    xcd_barrier(b, wave_s == 0 && lane_id_volatile() == 0);
}
#define MK_STEP(...) do { Ctx C; make_ctx_opaque(C, lds_raw, wave_s); __VA_ARGS__; } while (0)
__global__ void __launch_bounds__(NWAVES * 64, 2) mk_fwd(Args args) {
    extern __shared__ __attribute__((aligned(16))) unsigned char lds_raw[];
    const int wave_s = __builtin_amdgcn_readfirstlane(threadIdx.x >> 6);
    for (int u = threadIdx.x; u < (LDS_BYTES - LDSCTL_OFF) / 4; u += NWAVES * 64) ((LAS unsigned*)((LAS unsigned char*)lds_raw + LDSCTL_OFF))[u] = 0u;
    __syncthreads();
    if (threadIdx.x == 0) {
        LAS unsigned long long* tab = (LAS unsigned long long*)((LAS unsigned char*)lds_raw + LDSCTL_OFF);
#pragma unroll
        for (int i = 0; i < 21; ++i) tab[i] = (unsigned long long)args.in[i];
        tab[21] = (unsigned long long)args.out; tab[22] = (unsigned long long)args.ws;
    }
    (void)xcd_barrier_post((unsigned*)(args.ws + WS_CTL) + CW_BAR, (volatile LAS unsigned*)((LAS unsigned char*)lds_raw + MISC_OFF) + 8);
    __syncthreads();
    MK_STEP(p0_prologue(C));
    cg::this_grid().sync();
#pragma unroll 1
    for (int layer = 0; layer < DEPTH; ++layer) {
        const int mixer = layer % 3, jx = layer / 3;
        MK_STEP(const bf16* Wt = mixer == 0 ? (const bf16*)(C.ws + WS_FOXWIN + (size_t)jx * 8 * MiB) : mixer == 1 ? (const bf16*)(C.ws + WS_GLAWIN) : (const bf16*)(C.ws + WS_HGRNWIN);
                const float* sw = (const float*)(C.ws + WS_SW) + (mixer == 0 ? jx * 4096 : mixer == 1 ? 8192 : 11264);
                if (I8MASK == 15 || (I8MASK != 0 && ((I8MASK >> layer) & 1))) do_gemm<3>(C, (const bf16*)(C.ws + WS_XN8), Wt, mixer == 1 ? 3072 : 4096, (bf16*)(C.ws + WS_P), 1024, 1, (const float*)(C.ws + WS_SX), nullptr, nullptr, nullptr, sw, nullptr);
                else do_gemm<0>(C, (const bf16*)(C.ws + WS_XN), Wt, mixer == 1 ? 3072 : 4096, (bf16*)(C.ws + WS_P), 1024, 1, nullptr, nullptr, nullptr, nullptr, nullptr, nullptr));
        grid_bar(lds_raw, wave_s);
        MK_STEP(if (mixer == 0) run_step<1, 0>(C, layer); else if (mixer == 1) run_step<2, 1>(C, layer); else run_step<2, 2>(C, layer));
        grid_bar(lds_raw, wave_s);
        MK_STEP(if (mixer == 0) run_step<3, 0>(C, layer); else if (mixer == 1) run_step<3, 1>(C, layer); else run_step<3, 2>(C, layer));
        grid_bar(lds_raw, wave_s);
        if (mixer != 0) { MK_STEP(if (mixer == 1) run_step<4, 1>(C, layer); else run_step<4, 2>(C, layer)); grid_bar(lds_raw, wave_s); }
        MK_STEP(const bf16* Wt = mixer == 0 ? (const bf16*)(C.ws + WS_FOXWOUT) + (size_t)jx * 1024 * 1024 : mixer == 1 ? (const bf16*)(C.ws + WS_GLAWOUT) : (const bf16*)(C.ws + WS_HGRNWOUT);
                do_gemm<1>(C, (const bf16*)(C.ws + WS_OB), Wt, 1024, nullptr, 0, 0, nullptr, layer == 0 ? C.in[0] : C.out, C.out, (bf16*)(C.ws + WS_XN), C.in[2] + layer * 1024, (float*)(C.ws + WS_RS)));
        grid_bar(lds_raw, wave_s);
        MK_STEP(run_step<7, 0>(C, layer));
        grid_bar(lds_raw, wave_s);
        MK_STEP(run_step<8, 0>(C, layer));
        if (layer + 1 < DEPTH) grid_bar(lds_raw, wave_s);
    }
}
#endif

extern "C" void kernel_launch(void* const* d_in, const int* in_sizes, int n_in, void* d_out, int out_size, void* d_ws, size_t ws_size, hipStream_t stream) {
    static int grid = 0;
    if (grid == 0) {
        if (n_in != 21 || out_size != NTOK * 1024 || ws_size < WS_END) { fprintf(stderr, "kernel_launch: unexpected shapes: n_in %d out %d ws %zu (need %zu)\n", n_in, out_size, ws_size, (size_t)WS_END); grid = -1; return; }
        int dev = 0, cus = 0, per_cu = 0;
        (void)hipGetDevice(&dev); (void)hipDeviceGetAttribute(&cus, hipDeviceAttributeMultiprocessorCount, dev);
#if MK_SINGLE
        if (hipFuncSetAttribute((const void*)mk_fwd, hipFuncAttributeMaxDynamicSharedMemorySize, LDS_BYTES) != hipSuccess) { fprintf(stderr, "kernel_launch: hipFuncSetAttribute failed\n"); grid = -1; return; }
        if (hipOccupancyMaxActiveBlocksPerMultiprocessor(&per_cu, (const void*)mk_fwd, NWAVES * 64, LDS_BYTES) != hipSuccess || per_cu < 1) { fprintf(stderr, "kernel_launch: occupancy query says %d blocks per CU\n", per_cu); (void)hipGetLastError(); grid = -1; return; }
#endif
        (void)per_cu;
        grid = cus;
    }
    if (grid < 0) return;
    Args a{};
    for (int i = 0; i < 21; ++i) a.in[i] = (const float*)d_in[i];
    a.out = (float*)d_out; a.ws = (unsigned char*)d_ws;
#if MK_SINGLE
    (void)hipMemsetAsync((char*)d_ws + WS_CTL, 0, CTL_ZERO_BYTES, stream);
    a.ph_lo = 0; a.ph_hi = NPHASE;
    void* kargs[] = {&a};
    hipError_t e = hipLaunchCooperativeKernel((const void*)mk_fwd, dim3(grid), dim3(NWAVES * 64), kargs, LDS_BYTES, stream);
    if (e != hipSuccess) fprintf(stderr, "cooperative launch failed: %s (grid %d)\n", hipGetErrorString(e), grid);
#else
    launch_phase<10, 0>(a, 0, grid, stream); if (MK_DUP == 10) launch_phase<10, 0>(a, 0, grid, stream);
    launch_layer<0>(a, 0, grid, stream);
    launch_layer<1>(a, 1, grid, stream);
    launch_layer<2>(a, 2, grid, stream);
    launch_layer<0>(a, 3, grid, stream);
#endif
}
```

```cpp
#include <hip/hip_runtime.h>
#include <hip/hip_cooperative_groups.h>
#include <cstdio>
#include <cstdint>
#include <cmath>
namespace pg8 {
#define PG8_LAS __attribute__((address_space(3)))
typedef unsigned short bf16_t;
typedef short bf16x8 __attribute__((ext_vector_type(8)));
typedef float f32x4 __attribute__((ext_vector_type(4)));
typedef unsigned u32x4 __attribute__((ext_vector_type(4)));
typedef int i32x4 __attribute__((ext_vector_type(4)));
constexpr int BM = 256, BK = 64, HALF = 128, HTB = HALF * BK * 2  , STAGE_BYTES = 8 * HTB, NXCD = 8, WGM = 8;

__host__ __device__ __forceinline__ int lds_byte(int r, int c) { const int st = (r >> 4) * 2 + (c >> 5), rr = r & 15, cc = c & 31, ob = rr * 64 + cc * 2; return st * 1024 + (ob ^ (((ob >> 9) & 1) << 5)); }
__host__ __device__ __forceinline__ void stage_rc(int b, int& R, int& C) { const int st = b / 1024, sb = b % 1024, swz = sb ^ (((sb >> 9) & 1) << 5); R = (st >> 1) * 16 + swz / 64; C = (st & 1) * 32 + (swz % 64) / 2; }
__host__ __device__ __forceinline__ int perm32(int rho) { const int n = rho >> 4, i = rho & 15; return 8 * (i >> 2) + 4 * n + (i & 3); }

struct Unit { int pm, pn; };
struct Gemm { const bf16_t* A; const bf16_t* Bt; int M, N, K; };

struct StaticOrder {
    int nM, nN, nwg, G, c;
    __host__ __device__ void init(int M, int N, int G_, int c_) { nM = M / BM; nN = N / BM; nwg = nM * nN; G = G_; c = c_; }
    __host__ __device__ bool next(int i, Unit& u) const {
        const long L = (long)i * G + c; if (L >= nwg) return false;
        int wgid = (int)L; { const int q = nwg / NXCD, r = nwg % NXCD, xcd = wgid % NXCD, off = wgid / NXCD; wgid = (xcd < r ? xcd * (q + 1) : r * (q + 1) + (xcd - r) * q) + off; }
        const int nig = WGM * nN, gid = wgid / nig, fm = gid * WGM, gsz = (nM - fm) < WGM ? (nM - fm) : WGM;
        u.pm = fm + ((wgid % nig) % gsz); u.pn = (wgid % nig) / gsz; return true;
    }
    __device__ __forceinline__ void a_ready(const Unit&) const {}
    __device__ __forceinline__ void done(const Unit&) const {}
};

__device__ __forceinline__ unsigned cvt_pk_bf16(float lo, float hi) { unsigned r; asm volatile("v_cvt_pk_bf16_f32 %0, %1, %2" : "=v"(r) : "v"(lo), "v"(hi)); return r; }
typedef float f32x2 __attribute__((ext_vector_type(2)));
__device__ __forceinline__ f32x2 gelu_pk(f32x2 v) {
    const f32x2 av = __builtin_elementwise_abs(v), d = av * 0.2316418882f + 1.0f;
    f32x2 t; t.x = __builtin_amdgcn_rcpf(d.x); t.y = __builtin_amdgcn_rcpf(d.y);
    f32x2 q = t * 0.5307027145f + (-0.7265760135f); q = q * t + 0.7107068705f; q = q * t + (-0.142248368f); q = q * t + 0.127414796f; q = q * t;
    const f32x2 s = (v * v) * (-0.72134752044f);
    f32x2 e; e.x = __builtin_amdgcn_exp2f(s.x); e.y = __builtin_amdgcn_exp2f(s.y);
    const f32x2 m = v * (q * e), r = v - m;
    f32x2 o; o.x = v.x < 0.f ? m.x : r.x; o.y = v.y < 0.f ? m.y : r.y; return o;
}
template <bool F16  > struct EpiBf16R {
    typedef f32x4 acc_t;
    static constexpr bool PERM = true, AFTER_DRAIN = false;
    bf16_t* O; int ldc; int split_cols; size_t split_stride; const float* rs;
    __device__ __forceinline__ void operator()(const f32x4 (&acc)[2][2][4][2], const Unit& u, int wr, int wc, int fr, int fq) const {
        const int row0 = u.pm * BM + wr * 64 + fr; int colt = u.pn * BM; bf16_t* base = O;
        if (split_cols) { const int t = colt / split_cols; base += (size_t)t * split_stride; colt -= t * split_cols; }
        const int col0 = colt + wc * 32 + 8 * fq;
#pragma unroll
        for (int ai = 0; ai < 2; ++ai)
#pragma unroll
            for (int m = 0; m < 4; ++m) { const int row = row0 + ai * HALF + m * 16; bf16_t* rowp = base + (size_t)row * ldc + col0;
                float sc = 1.f;
                if (rs) { const f32x4 a = *(const f32x4*)(rs + (size_t)row * 16), b = *(const f32x4*)(rs + (size_t)row * 16 + 4), c = *(const f32x4*)(rs + (size_t)row * 16 + 8), d = *(const f32x4*)(rs + (size_t)row * 16 + 12);
                    const float s = (((a[0] + a[1]) + (a[2] + a[3])) + ((b[0] + b[1]) + (b[2] + b[3]))) + (((c[0] + c[1]) + (c[2] + c[3])) + ((d[0] + d[1]) + (d[2] + d[3])));
                    sc = __builtin_amdgcn_rsqf(s * (1.0f / 1024.0f) + 1e-6f); }
#pragma unroll
                for (int bj = 0; bj < 2; ++bj) { const f32x4 v0 = acc[ai][bj][m][0] * sc, v1 = acc[ai][bj][m][1] * sc;
                    u32x4 w;
                    if (F16) { w.x = __builtin_bit_cast(unsigned, __builtin_amdgcn_cvt_pkrtz(v0[0], v0[1])); w.y = __builtin_bit_cast(unsigned, __builtin_amdgcn_cvt_pkrtz(v0[2], v0[3])); w.z = __builtin_bit_cast(unsigned, __builtin_amdgcn_cvt_pkrtz(v1[0], v1[1])); w.w = __builtin_bit_cast(unsigned, __builtin_amdgcn_cvt_pkrtz(v1[2], v1[3])); }
                    else { w.x = cvt_pk_bf16(v0[0], v0[1]); w.y = cvt_pk_bf16(v0[2], v0[3]); w.z = cvt_pk_bf16(v1[0], v1[1]); w.w = cvt_pk_bf16(v1[2], v1[3]); }
                    *(u32x4*)(rowp + bj * HALF) = w; } }
    }
};
struct EpiI8 {
    typedef i32x4 acc_t;
    static constexpr bool PERM = true, AFTER_DRAIN = false;
    bf16_t* O; size_t split_stride; const float* sx; const float* sw;
    __device__ __forceinline__ void operator()(const i32x4 (&acc)[2][2][4][2], const Unit& u, int wr, int wc, int fr, int fq) const {
        const int row0 = u.pm * BM + wr * 64 + fr; int colt = u.pn * BM; bf16_t* base = O;
        { const int t = colt / 1024; base += (size_t)t * split_stride; colt -= t * 1024; }
        const int col0 = colt + wc * 32 + 8 * fq, scol0 = u.pn * BM + wc * 32 + 8 * fq;
        f32x4 cw[2][2];
#pragma unroll
        for (int bj = 0; bj < 2; ++bj) { cw[bj][0] = *(const f32x4*)(sw + scol0 + bj * HALF); cw[bj][1] = *(const f32x4*)(sw + scol0 + bj * HALF + 4); }
#pragma unroll
        for (int ai = 0; ai < 2; ++ai)
#pragma unroll
            for (int m = 0; m < 4; ++m) { const int row = row0 + ai * HALF + m * 16; bf16_t* rowp = base + (size_t)row * 1024 + col0; const float rs = sx[row];
#pragma unroll
                for (int bj = 0; bj < 2; ++bj) { const i32x4 a0 = acc[ai][bj][m][0], a1 = acc[ai][bj][m][1];
                    const f32x4 v0 = (f32x4){(float)a0[0], (float)a0[1], (float)a0[2], (float)a0[3]} * cw[bj][0] * rs, v1 = (f32x4){(float)a1[0], (float)a1[1], (float)a1[2], (float)a1[3]} * cw[bj][1] * rs;
                    u32x4 w; w.x = cvt_pk_bf16(v0[0], v0[1]); w.y = cvt_pk_bf16(v0[2], v0[3]); w.z = cvt_pk_bf16(v1[0], v1[1]); w.w = cvt_pk_bf16(v1[2], v1[3]);
                    *(u32x4*)(rowp + bj * HALF) = w; } }
    }
};
struct EpiResNorm {
    typedef f32x4 acc_t;
    static constexpr bool PERM = false, AFTER_DRAIN = false;
    const float* base; float* out; bf16_t* hg; const float* gain; float* rs;
    __device__ __forceinline__ void operator()(const f32x4 (&acc)[2][2][4][2], const Unit& u, int wr, int wc, int fr, int fq) const {
        const int col0 = u.pn * BM + wc * 32 + 4 * fq, lane = fr + 16 * fq;
        f32x4 gv[2][2];
#pragma unroll
        for (int bj = 0; bj < 2; ++bj)
#pragma unroll
            for (int n = 0; n < 2; ++n) gv[bj][n] = *(const f32x4*)(gain + col0 + bj * HALF + n * 16);
#pragma unroll
        for (int ai = 0; ai < 2; ++ai)
#pragma unroll
            for (int m = 0; m < 4; ++m) { const int r = ai * HALF + wr * 64 + m * 16 + fr; const size_t off = (size_t)(u.pm * BM + r) * 1024 + col0;
                float ss = 0.f;
#pragma unroll
                for (int bj = 0; bj < 2; ++bj)
#pragma unroll
                    for (int n = 0; n < 2; ++n) { const f32x4 o = *(const f32x4*)(base + off + bj * HALF + n * 16) + acc[ai][bj][m][n]; *(f32x4*)(out + off + bj * HALF + n * 16) = o;
                        ss += (o[0] * o[0] + o[1] * o[1]) + (o[2] * o[2] + o[3] * o[3]);
                        const f32x4 h = o * gv[bj][n]; typedef unsigned u32x2 __attribute__((ext_vector_type(2))); u32x2 w; w.x = cvt_pk_bf16(h[0], h[1]); w.y = cvt_pk_bf16(h[2], h[3]);
                        *(u32x2*)(hg + off + bj * HALF + n * 16) = w; }
                ss += __builtin_bit_cast(float, __builtin_amdgcn_ds_bpermute((lane ^ 16) << 2, __builtin_bit_cast(int, ss)));
                ss += __builtin_bit_cast(float, __builtin_amdgcn_ds_bpermute((lane ^ 32) << 2, __builtin_bit_cast(int, ss)));
                if (fq == 0) rs[(size_t)(u.pm * BM + r) * 16 + u.pn * 4 + wc] = ss; }
    }
};
__device__ __forceinline__ f32x4 mma16(bf16x8 a, bf16x8 b, f32x4 c) { return __builtin_amdgcn_mfma_f32_16x16x32_bf16(a, b, c, 0, 0, 0); }
__device__ __forceinline__ i32x4 mma16(bf16x8 a, bf16x8 b, i32x4 c) { return __builtin_amdgcn_mfma_i32_16x16x64_i8(__builtin_bit_cast(i32x4, a), __builtin_bit_cast(i32x4, b), c, 0, 0, 0); }
template <class Epi, class Sched, bool ALIGN_EPI = false, bool SP2 = false>
__device__ __forceinline__ void gemm_phase(PG8_LAS unsigned char* lds, const Gemm g, const Sched& S, const Epi& E, int tid_in) {
    int tid_ = tid_in; asm volatile("" : "+v"(tid_));
    const int tid = tid_, wid = __builtin_amdgcn_readfirstlane(tid >> 6), lane = tid & 63, wr = wid >> 2, wc = wid & 3, fr = lane & 15, fq = lane >> 4;
    const int K = g.K, nt = K / BK;
    unsigned voffA[2], voffB[2];
#pragma unroll
    for (int i = 0; i < 2; ++i) { int R, C; stage_rc(tid * 16 + i * 8192, R, C); const int Rb = Epi::PERM ? ((R & ~31) + perm32(R & 31)) : R;
        voffA[i] = (unsigned)(R * K + C) * 2u; voffB[i] = (unsigned)(Rb * K + C) * 2u; }
    const size_t kstep = (size_t)(BK * 2);
    const size_t hstep = (size_t)HALF * K * 2;
    const size_t tstep = 2 * hstep;
    const unsigned ldsw = (unsigned)wid * 1024u;
    const int aoff = lds_byte(wr * 64 + fr, fq * 8), boff = lds_byte(wc * 32 + fr, fq * 8);
#define PG8_SA(b, h) (((b) * 2 + (h)) * HTB)
#define PG8_SB(b, h) ((4 + (b) * 2 + (h)) * HTB)
#define PG8_STAGE(bufoff, gbase, voff) do { _Pragma("unroll") for (int _i = 0; _i < 2; ++_i) \
        __builtin_amdgcn_global_load_lds((const unsigned*)((const char*)(gbase) + (voff)[_i]), (PG8_LAS unsigned*)(lds + (bufoff) + ldsw + _i * 8192), 16, 0, 0); } while (0)
#define PG8_LDA(dst, b, h) do { _Pragma("unroll") for (int m = 0; m < 4; ++m) _Pragma("unroll") for (int k = 0; k < 2; ++k) dst[m][k] = *(const PG8_LAS bf16x8*)(lds + PG8_SA(b, h) + aoff + m * 2048 + k * 1024); } while (0)
#define PG8_LDB(dst, b, h) do { _Pragma("unroll") for (int n = 0; n < 2; ++n) _Pragma("unroll") for (int k = 0; k < 2; ++k) dst[n][k] = *(const PG8_LAS bf16x8*)(lds + PG8_SB(b, h) + boff + n * 2048 + k * 1024); } while (0)
#define PG8_MMA(ai, bj, At, Bt) do { __builtin_amdgcn_s_setprio(1); _Pragma("unroll") for (int m = 0; m < 4; ++m) _Pragma("unroll") for (int n = 0; n < 2; ++n) _Pragma("unroll") for (int k = 0; k < 2; ++k) \
        acc[ai][bj][m][n] = mma16(Bt[n][k], At[m][k], acc[ai][bj][m][n]); __builtin_amdgcn_s_setprio(0); } while (0)
#define PG8_WAIT_V(n) asm volatile("s_waitcnt vmcnt(" #n ")" ::: "memory")
#define PG8_WAIT_L(n) asm volatile("s_waitcnt lgkmcnt(" #n ")" ::: "memory")
#define PG8_BAR __builtin_amdgcn_s_barrier()
#define PG8_SCHED __builtin_amdgcn_sched_barrier(0)
    Unit cur, nxt; int ui = 0;
    if (!S.next(0, cur)) return;
    typedef typename Epi::acc_t acc_t;
    acc_t acc[2][2][4][2];
#pragma unroll
    for (int a = 0; a < 2; ++a)
#pragma unroll
        for (int b = 0; b < 2; ++b)
#pragma unroll
            for (int m = 0; m < 4; ++m)
#pragma unroll
                for (int n = 0; n < 2; ++n) acc[a][b][m][n] = (acc_t){0, 0, 0, 0};
    bf16x8 At[4][2], B0[2][2], B1[2][2];
    const char* cA = (const char*)g.A + (size_t)cur.pm * tstep; const char* cB = (const char*)g.Bt + (size_t)cur.pn * tstep;
    S.a_ready(cur);
    if constexpr (SP2) {
        PG8_STAGE(PG8_SB(0, 0), cB, voffB); PG8_STAGE(PG8_SB(0, 1), cB + hstep, voffB); PG8_STAGE(PG8_SA(0, 0), cA, voffA); PG8_STAGE(PG8_SA(0, 1), cA + hstep, voffA);
        if (wr == 1) PG8_BAR;
        PG8_WAIT_V(2); PG8_BAR;
        PG8_STAGE(PG8_SB(1, 0), cB + kstep, voffB); PG8_STAGE(PG8_SA(1, 0), cA + kstep, voffA); PG8_STAGE(PG8_SB(1, 1), cB + hstep + kstep, voffB);
        PG8_WAIT_V(6); PG8_BAR;
    } else {
        PG8_STAGE(PG8_SB(0, 0), cB, voffB); PG8_STAGE(PG8_SA(0, 0), cA, voffA); PG8_STAGE(PG8_SB(0, 1), cB + hstep, voffB); PG8_STAGE(PG8_SA(0, 1), cA + hstep, voffA);
        if (wr == 1) PG8_BAR;
        PG8_WAIT_V(4); PG8_BAR;
        PG8_STAGE(PG8_SB(1, 0), cB + kstep, voffB); PG8_STAGE(PG8_SA(1, 0), cA + kstep, voffA); PG8_STAGE(PG8_SB(1, 1), cB + hstep + kstep, voffB);
        PG8_WAIT_V(6); PG8_BAR;
    }
    for (;;) {
        const bool has_next = S.next(ui + 1, nxt);
        const char* nA = has_next ? (const char*)g.A + (size_t)nxt.pm * tstep : cA; const char* nB = has_next ? (const char*)g.Bt + (size_t)nxt.pn * tstep : cB;
        for (int t = 0; t < nt; t += 2) {
            const bool last = (t == nt - 2);
            const char* a1 = cA + (size_t)(t + 1) * kstep;
            const char* a2 = last ? nA : cA + (size_t)(t + 2) * kstep; const char* b2 = last ? nB : cB + (size_t)(t + 2) * kstep;
            const char* a3 = a2 + kstep; const char* b3 = b2 + kstep;
            if (last && has_next) S.a_ready(nxt);
            if constexpr (SP2) {
            PG8_LDB(B0, 0, 0); PG8_LDB(B1, 0, 1); PG8_SCHED; PG8_LDA(At, 0, 0); PG8_STAGE(PG8_SA(1, 1), a1 + hstep, voffA);
            PG8_WAIT_V(8); PG8_WAIT_L(0); PG8_BAR; PG8_MMA(0, 0, At, B0); PG8_MMA(0, 1, At, B1); PG8_BAR; PG8_SCHED;
            PG8_LDA(At, 0, 1); PG8_STAGE(PG8_SB(0, 0), b2, voffB); PG8_STAGE(PG8_SB(0, 1), b2 + hstep, voffB); PG8_STAGE(PG8_SA(0, 0), a2, voffA);
            PG8_WAIT_V(8); PG8_WAIT_L(0); PG8_BAR; PG8_MMA(1, 0, At, B0); PG8_MMA(1, 1, At, B1); PG8_BAR; PG8_SCHED;
            PG8_LDB(B0, 1, 0); PG8_LDB(B1, 1, 1); PG8_SCHED; PG8_LDA(At, 1, 0); PG8_STAGE(PG8_SA(0, 1), a2 + hstep, voffA);
            PG8_WAIT_V(8); PG8_WAIT_L(0); PG8_BAR; PG8_MMA(0, 0, At, B0); PG8_MMA(0, 1, At, B1); PG8_BAR; PG8_SCHED;
            PG8_LDA(At, 1, 1); PG8_STAGE(PG8_SB(1, 0), b3, voffB); PG8_STAGE(PG8_SB(1, 1), b3 + hstep, voffB); PG8_STAGE(PG8_SA(1, 0), a3, voffA);
            PG8_WAIT_V(8); PG8_WAIT_L(0); PG8_BAR; PG8_MMA(1, 0, At, B0); PG8_MMA(1, 1, At, B1); PG8_BAR; PG8_SCHED;
            } else {
            PG8_LDB(B0, 0, 0); PG8_SCHED; PG8_LDA(At, 0, 0); PG8_STAGE(PG8_SA(1, 1), a1 + hstep, voffA);
            PG8_WAIT_L(8); PG8_BAR; PG8_WAIT_L(0); PG8_MMA(0, 0, At, B0); PG8_BAR; PG8_SCHED;
            PG8_LDB(B1, 0, 1); PG8_STAGE(PG8_SB(0, 0), b2, voffB);
            PG8_BAR; PG8_WAIT_L(0); PG8_MMA(0, 1, At, B1); PG8_BAR;
            PG8_LDA(At, 0, 1); PG8_STAGE(PG8_SA(0, 0), a2, voffA);
            PG8_BAR; PG8_WAIT_L(0); PG8_MMA(1, 0, At, B0); PG8_BAR; PG8_SCHED;
            PG8_STAGE(PG8_SB(0, 1), b2 + hstep, voffB);
            PG8_WAIT_V(6); PG8_BAR; PG8_MMA(1, 1, At, B1); PG8_BAR;
            PG8_LDB(B0, 1, 0); PG8_SCHED; PG8_LDA(At, 1, 0); PG8_STAGE(PG8_SA(0, 1), a2 + hstep, voffA);
            PG8_WAIT_L(8); PG8_BAR; PG8_WAIT_L(0); PG8_MMA(0, 0, At, B0); PG8_BAR; PG8_SCHED;
            PG8_LDB(B1, 1, 1); PG8_STAGE(PG8_SB(1, 0), b3, voffB);
            PG8_BAR; PG8_WAIT_L(0); PG8_MMA(0, 1, At, B1); PG8_BAR;
            PG8_LDA(At, 1, 1); PG8_STAGE(PG8_SA(1, 0), a3, voffA);
            PG8_BAR; PG8_WAIT_L(0); PG8_MMA(1, 0, At, B0); PG8_BAR; PG8_SCHED;
            PG8_STAGE(PG8_SB(1, 1), b3 + hstep, voffB);
            PG8_WAIT_V(6); PG8_BAR; PG8_MMA(1, 1, At, B1); PG8_BAR;
            }
        }
        if constexpr (ALIGN_EPI) { if (wr == 0) PG8_BAR; }
        if constexpr (!Epi::AFTER_DRAIN) { E(acc, cur, wr, wc, fr, fq); S.done(cur); }
        if (!has_next) break;
#pragma unroll
        for (int a = 0; a < 2; ++a)
#pragma unroll
            for (int b = 0; b < 2; ++b)
#pragma unroll
                for (int m = 0; m < 4; ++m)
#pragma unroll
                    for (int n = 0; n < 2; ++n) acc[a][b][m][n] = (acc_t){0, 0, 0, 0};
        cur = nxt; cA = nA; cB = nB; ++ui;
        if constexpr (ALIGN_EPI) { if (wr == 1) PG8_BAR; }
    }
    PG8_WAIT_V(0);
    if constexpr (!ALIGN_EPI) { if (wr == 0) PG8_BAR; }
    PG8_BAR;
    if constexpr (Epi::AFTER_DRAIN) { E.fused(acc, cur, wr, wc, fr, fq, lds, wid, lane); S.done(cur); }
#undef PG8_SA
#undef PG8_SB
#undef PG8_STAGE
#undef PG8_LDA
#undef PG8_LDB
#undef PG8_MMA
#undef PG8_WAIT_V
#undef PG8_WAIT_L
#undef PG8_BAR
#undef PG8_SCHED
}
}
#include <hip/hip_bf16.h>
#include <cmath>
namespace attn_body {
using bf16=__hip_bfloat16;
using bf16x8=__attribute__((ext_vector_type(8)))short;
using s16x4=__attribute__((ext_vector_type(4)))short;
using f32x16=__attribute__((ext_vector_type(16)))float;
using u32x4=__attribute__((ext_vector_type(4)))unsigned;
constexpr int BATCH=8,NHEAD=16,SEQ=2048,D=64,DM=NHEAD*D;
constexpr int NW=8,QBLK=32,QB=QBLK*NW,KVBLK=64,NQB=SEQ/QB;
constexpr int ATTN_PITCH=DM, ATTN_UNIT_ROWS=QB;
__device__ __forceinline__ int crow(int r,int hi){return (r&3)+8*(r>>2)+4*hi;}
#define SBAR() __builtin_amdgcn_sched_barrier(0)
__device__ __forceinline__ void cmask(f32x16&p0,f32x16&p1,int jb,int qrel,int hi){
  const float NEG=-INFINITY; int kb=64*jb+4*hi;
  #pragma unroll
  for(int r=0;r<16;++r){int kv=kb+(r&3)+8*(r>>2); if(kv>qrel)p0[r]=NEG; if(kv+32>qrel)p1[r]=NEG;}
}

constexpr int NSLOT=3, SLOTB=8192;
constexpr int LDS_K=0, LDS_V=NSLOT*SLOTB, LDS_WS=2*NSLOT*SLOTB, LDS_OST=LDS_WS+NW*64*4, LDS_CS=LDS_OST+NW*4096, LDS_BYTES=LDS_CS+SEQ*4;
constexpr float C2=0.125f*1.4426950408889634f;
__device__ __forceinline__ void glds16(const void*gsrc,unsigned lds_dst){unsigned keep;
  asm volatile("s_mov_b32 %0, m0\n\ts_mov_b32 m0, %2\n\ts_nop 0\n\tglobal_load_lds_dwordx4 %1, off\n\ts_mov_b32 m0, %0":"=&s"(keep):"v"(gsrc),"s"(lds_dst):"memory");}
__device__ __forceinline__ float max3f(float a,float b,float c){float r;asm("v_max3_f32 %0, %1, %2, %3":"=v"(r):"v"(a),"v"(b),"v"(c));return r;}
__device__ __forceinline__ float max2f(float a,float b){float r;asm("v_max_f32_e32 %0, %1, %2":"=v"(r):"v"(a),"v"(b));return r;}
__device__ __forceinline__ float fadd_s(float a,float b){float r;asm("v_add_f32_e32 %0, %1, %2":"=v"(r):"v"(a),"v"(b));return r;}
__device__ __forceinline__ float fsub_s(float a,float b){float r;asm("v_sub_f32_e32 %0, %1, %2":"=v"(r):"v"(a),"v"(b));return r;}
typedef float f32x2_t __attribute__((ext_vector_type(2))); typedef __bf16 bf16x2_t __attribute__((ext_vector_type(2)));
__device__ __forceinline__ unsigned cvtpk_s(float lo,float hi){f32x2_t v={lo,hi};bf16x2_t b=__builtin_convertvector(v,bf16x2_t);return __builtin_bit_cast(unsigned,b);}
#define WAIT_BAR(N) asm volatile("s_waitcnt vmcnt(" #N ") lgkmcnt(0)\n\ts_barrier":::"memory")

typedef __attribute__((address_space(3))) const char* lds_cptr;
__device__ __forceinline__ void qkt(f32x16&p0,f32x16&p1,const char*Kslot,lds_cptr qls,bf16x8 ax0,bf16x8 ax1,bf16x8 qx,int r32,int hi){
  const char*kb=Kslot+hi*1024+r32*16; const f32x16 z16=f32x16{};
  p0=__builtin_amdgcn_mfma_f32_32x32x16_bf16(ax0,qx,z16,0,0,0);p1=__builtin_amdgcn_mfma_f32_32x32x16_bf16(ax1,qx,z16,0,0,0);
  #pragma unroll
  for(int d0=0;d0<4;++d0){
    const bf16x8 b0=*reinterpret_cast<const bf16x8*>(kb+d0*2048);
    const bf16x8 b1=*reinterpret_cast<const bf16x8*>(kb+d0*2048+512);
    const bf16x8 qd=*(const __attribute__((address_space(3))) bf16x8*)(qls+d0*1024);
    p0=__builtin_amdgcn_mfma_f32_32x32x16_bf16(b0,qd,p0,0,0,0);p1=__builtin_amdgcn_mfma_f32_32x32x16_bf16(b1,qd,p1,0,0,0);}
}
typedef short v4i16_t __attribute__((ext_vector_type(4)));
__device__ __forceinline__ void kload8(bf16x8*kf,lds_cptr kp){
  kf[0]=*(const __attribute__((address_space(3))) bf16x8*)(kp);      kf[1]=*(const __attribute__((address_space(3))) bf16x8*)(kp+512);
  kf[2]=*(const __attribute__((address_space(3))) bf16x8*)(kp+2048); kf[3]=*(const __attribute__((address_space(3))) bf16x8*)(kp+2560);
  kf[4]=*(const __attribute__((address_space(3))) bf16x8*)(kp+4096); kf[5]=*(const __attribute__((address_space(3))) bf16x8*)(kp+4608);
  kf[6]=*(const __attribute__((address_space(3))) bf16x8*)(kp+6144); kf[7]=*(const __attribute__((address_space(3))) bf16x8*)(kp+6656);
}
__device__ __forceinline__ void kload2(bf16x8*kf,lds_cptr kp,int j){ kf[2*j]=*(const __attribute__((address_space(3))) bf16x8*)(kp+j*2048); kf[2*j+1]=*(const __attribute__((address_space(3))) bf16x8*)(kp+j*2048+512); }
__device__ __forceinline__ s16x4 vtr(lds_cptr p){ return __builtin_bit_cast(s16x4,__builtin_amdgcn_ds_read_tr16_b64_v4i16((__attribute__((address_space(3))) v4i16_t*)p)); }
__device__ __forceinline__ float rowmax(const f32x16&p0,const f32x16&p1){
  float a=max3f(p0[0],p0[1],p1[0]),b=max3f(p0[2],p0[3],p1[1]);a=max3f(a,p1[2],p1[3]);
  #pragma unroll
  for(int r=4;r<16;r+=4){a=max3f(a,p0[r],p0[r+1]);b=max3f(b,p0[r+2],p0[r+3]);a=max3f(a,p1[r],p1[r+1]);b=max3f(b,p1[r+2],p1[r+3]);}
  const float m=max2f(a,b);
  auto rr=__builtin_amdgcn_permlane32_swap(__float_as_uint(m),__float_as_uint(m),false,false);
  return max2f(__uint_as_float(rr[0]),__uint_as_float(rr[1]));
}
__device__ __forceinline__ void pv(f32x16*o,int vb,bf16x8 pa0,bf16x8 pa1,bf16x8 pa2,bf16x8 pa3){
  #pragma unroll
  for(int d0=0;d0<2;++d0){s16x4 lo[4],hi[4];
    #pragma unroll
    for(int ks=0;ks<4;++ks){
      asm volatile("ds_read_b64_tr_b16 %0,%1 offset:%c2":"=&v"(lo[ks]):"v"(vb),"i"(d0*4096+ks*1024):"memory");
      asm volatile("ds_read_b64_tr_b16 %0,%1 offset:%c2":"=&v"(hi[ks]):"v"(vb),"i"(d0*4096+ks*1024+512):"memory");}
    asm volatile("s_waitcnt lgkmcnt(0)":::"memory");SBAR();
    #define PK(k) (bf16x8){lo[k][0],lo[k][1],lo[k][2],lo[k][3],hi[k][0],hi[k][1],hi[k][2],hi[k][3]}
    o[d0]=__builtin_amdgcn_mfma_f32_32x32x16_bf16(pa0,PK(0),o[d0],0,0,0);
    o[d0]=__builtin_amdgcn_mfma_f32_32x32x16_bf16(pa1,PK(1),o[d0],0,0,0);
    o[d0]=__builtin_amdgcn_mfma_f32_32x32x16_bf16(pa2,PK(2),o[d0],0,0,0);
    o[d0]=__builtin_amdgcn_mfma_f32_32x32x16_bf16(pa3,PK(3),o[d0],0,0,0);
    #undef PK
  }
}

__device__ __forceinline__ void split3(float c,unsigned&hb,unsigned&mb,unsigned&lb){
  hb=__float_as_uint(c)&0xffff0000u; const float r1=c-__uint_as_float(hb); mb=__float_as_uint(r1)&0xffff0000u; const float r2=r1-__uint_as_float(mb); lb=__float_as_uint(r2)&0xffff0000u; }
__device__ __forceinline__ bf16x8 make_ax(float negc){ unsigned hb,mb,lb; split3(negc,hb,mb,lb);
  u32x4 w; w.x=(hb>>16)|mb; w.y=(lb>>16)|0x3f800000u; w.z=0x3f803f80u; w.w=0u; return __builtin_bit_cast(bf16x8,w); }
__device__ __forceinline__ bf16x8 make_qx(float negm,unsigned hm){ unsigned hb,mb,lb; split3(negm,hb,mb,lb);
  u32x4 w; w.x=0x3f803f80u&hm; w.y=(0x3f80u|hb)&hm; w.z=((mb>>16)|lb)&hm; w.w=0u; return __builtin_bit_cast(bf16x8,w); }
#ifndef ATTN_STORE16
#define ATTN_STORE16(p,v) (*(u32x4*)(p)=(v))
#endif
template<int THRL> __device__ __forceinline__ void attn_unit(int b,int h,int qb,const bf16*Q,const bf16*__restrict__ K,const bf16*__restrict__ V,bf16*O,const bf16*__restrict__ Gt,char*shm,const int tid_u){
  int tid=tid_u; asm volatile("":"+v"(tid));
  const int lane=tid&63,r32=lane&31,hi=lane>>5; const int wid=__builtin_amdgcn_readfirstlane(tid>>6);
  const long rowbase=(long)b*SEQ; const int q0=qb*QB;
  const bf16*Qw=Q+(rowbase+q0+wid*QBLK)*DM+h*D;
  float*csp=(float*)(shm+LDS_CS);
  int tskip=0;
  { const float cq0=csp[q0]; const int ntall=(q0+QB)/KVBLK; while(tskip+2<=ntall-4 && csp[KVBLK*(tskip+1)+KVBLK-1]-cq0< -200.f)tskip+=2; tskip=__builtin_amdgcn_readfirstlane(tskip); }
  const bf16*Kh=K+(rowbase+(long)tskip*KVBLK)*DM+h*D,*Vh=V+(rowbase+(long)tskip*KVBLK)*DM+h*D;
  const unsigned lds0=(unsigned)(uintptr_t)shm;
  float*wsf=(float*)(shm+LDS_WS)+wid*64;
  const unsigned koff=(unsigned)(lane*DM+wid*8), voff=(unsigned)((16*(wid&3)+(lane>>2))*DM+(wid>>2)*32+(lane&3)*8);
  const unsigned kdst=lds0+LDS_K+wid*1024, vdst=lds0+LDS_V+wid*1024;
  #define DMA_K(t,slot) do{unsigned o_=koff;asm volatile("":"+v"(o_));glds16(Kh+(long)(t)*KVBLK*DM+o_,(unsigned)__builtin_amdgcn_readfirstlane(kdst+(slot)));}while(0)
  #define DMA_V(t,slot) do{unsigned o_=voff;asm volatile("":"+v"(o_));glds16(Vh+(long)(t)*KVBLK*DM+o_,(unsigned)__builtin_amdgcn_readfirstlane(vdst+(slot)));}while(0)
  const int vb0=(int)(lds0+LDS_V)+((lane>>4)&1)*32+(lane&3)*8+(4*hi+((lane&15)>>2))*64;
  const char*Kbase=shm+LDS_K; bf16x8 kf[8];
  const lds_cptr shm3=(lds_cptr)shm; const lds_cptr kp0=shm3+LDS_K+hi*1024+r32*16; const lds_cptr vp0=shm3+LDS_V+((lane>>4)&1)*32+(lane&3)*8+(4*hi+((lane&15)>>2))*64;
  const int NT=(q0+QB)/KVBLK-tskip;
  const float*cst=csp+tskip*KVBLK;
  const unsigned hm=hi?0u:0xffffffffu;
  DMA_K(0,0);DMA_V(0,0);DMA_K(1,SLOTB);
  const lds_cptr qls=shm3+LDS_OST+wid*4096+hi*512+r32*16;
  { bf16x8 qr[4];
    #pragma unroll
    for(int d0=0;d0<4;++d0)qr[d0]=*reinterpret_cast<const bf16x8*>(&Qw[(long)r32*DM+d0*16+hi*8]);
    #pragma unroll
    for(int d0=0;d0<4;++d0)*(__attribute__((address_space(3))) bf16x8*)(shm3+LDS_OST+wid*4096+hi*512+r32*16+d0*1024)=qr[d0]; }
  #define QLD(k) (*(const __attribute__((address_space(3))) bf16x8*)(qls+(k)*1024))
  float mhat=csp[q0+wid*QBLK+r32],l_reg=0.f;f32x16 o[2];o[0]=f32x16{};o[1]=f32x16{}; bf16x8 qx=make_qx(-mhat,hm);
  const int qrel=wid*QBLK+r32;
  #define CMASK(P0,P1,t) do{int jb_=(t)-(NT-4); if(jb_>=0)cmask(P0,P1,jb_,qrel,hi);}while(0)
  bool resc=false;
  #define START(P0,P1) do{ const float rm=rowmax(P0,P1); resc=false; \
    if(__any(rm>(float)THRL)){ const float dl=__builtin_fmaxf(rm,0.f); mhat=fadd_s(mhat,dl); \
      _Pragma("unroll") for(int r=0;r<16;++r){P0[r]=fsub_s(P0[r],dl);P1[r]=fsub_s(P1[r],dl);} \
      qx=make_qx(-mhat,hm); } \
    _Pragma("unroll") for(int r=0;r<16;++r)P0[r]=__builtin_amdgcn_exp2f(P0[r]); }while(0)
  #define RESC() do{ if(resc){ asm volatile("s_waitcnt lgkmcnt(0)":::"memory"); \
      _Pragma("unroll") for(int d_=0;d_<2;++d_) _Pragma("unroll") for(int r=0;r<16;++r)o[d_][r]*=wsf[crow(r,hi)]; } }while(0)
  f32x16 pA0,pA1,pB0,pB1;
  int sl_prev=0,sl_cur=0,sl_next=SLOTB;
  #define ROT() do{sl_prev=sl_cur;sl_cur=sl_next;sl_next=(sl_next==(NSLOT-1)*SLOTB)?0:sl_next+SLOTB;}while(0)
  DMA_K(2,2*SLOTB);
  WAIT_BAR(3);
  qkt(pA0,pA1,Kbase,qls,make_ax(cst[r32]),make_ax(cst[32+r32]),qx,r32,hi);asm volatile("s_nop 15\n\ts_nop 7":"+v"(pA0),"+v"(pA1));CMASK(pA0,pA1,0);
  START(pA0,pA1);
  _Pragma("unroll") for(int r=0;r<16;++r)pA1[r]=__builtin_amdgcn_exp2f(pA1[r]);
  WAIT_BAR(0);
  DMA_K(3,0);DMA_V(1,SLOTB);
  ROT();
  kload8(kf,kp0+sl_cur);
  WAIT_BAR(2);
  s16x4 vlo[8],vhi[8]; u32x4 pw0,pw1,pw2,pw3;
  #define PKW(P,B) cvtpk_s(P[B],P[B+1])
  #define PAF(k) __builtin_bit_cast(bf16x8,pw##k)
  #define VFR(i) (bf16x8){vlo[i][0],vlo[i][1],vlo[i][2],vlo[i][3],vhi[i][0],vhi[i][1],vhi[i][2],vhi[i][3]}
  #define PIN(x) asm volatile("":"+v"(x))
  #define MX3(a,b,c) __builtin_fmaxf(__builtin_fmaxf((a),(b)),(c))
  #define GAPA(MF,A0,A1,A2,A3,W0,W1,PW) do{ MF; sacc+=A0; sacc+=A1; sacc+=A2; sacc+=A3; PIN(sacc); W0; W1; PIN(PW); SBAR(); }while(0)
  #define EX(v) __builtin_amdgcn_exp2f(v)
  #define GAPB(MF,X,B) do{ MF; X[B]=EX(X[B]); X[B+1]=EX(X[B+1]); X[B+2]=EX(X[B+2]); X[B+3]=EX(X[B+3]); PIN(X); SBAR(); }while(0)
  #define VRD(i) do{ vlo[i]=vtr(vp_+(((i)>>2)*4096+((i)&3)*1024)); vhi[i]=vtr(vp_+(((i)>>2)*4096+((i)&3)*1024+512)); }while(0)
  #define KRD(G,j) do{ if(G){ kload2(kf,kp0+sl_next,j); SBAR(); } }while(0)
  #define STEP(C0,C1,P0,P1,t,GK,GV,GL) do{ SBAR(); \
    const lds_cptr vp_=vp0+sl_prev; \
    const bf16x8 ax0_=make_ax(cst[(t)*KVBLK+r32]), ax1_=make_ax(cst[(t)*KVBLK+32+r32]); \
    C0=__builtin_amdgcn_mfma_f32_32x32x16_bf16(ax0_,qx,f32x16{},0,0,0); C1=__builtin_amdgcn_mfma_f32_32x32x16_bf16(ax1_,qx,f32x16{},0,0,0); SBAR(); \
    bf16x8 q0_=QLD(0), q1_=QLD(1); \
    VRD(0); SBAR(); float sacc=(P0[0]+P0[1]); \
    GAPA(C0=__builtin_amdgcn_mfma_f32_32x32x16_bf16(kf[0],q0_,C0,0,0,0), P0[2],P0[3],P0[4],P0[5],     pw0[0]=PKW(P0,0), pw0[1]=PKW(P0,2), pw0); \
    VRD(4); SBAR(); GAPA(C1=__builtin_amdgcn_mfma_f32_32x32x16_bf16(kf[1],q0_,C1,0,0,0), P0[6],P0[7],P0[8],P0[9],     pw0[2]=PKW(P0,4), pw0[3]=PKW(P0,6), pw0); q0_=QLD(2); \
    VRD(1); SBAR(); GAPA(C0=__builtin_amdgcn_mfma_f32_32x32x16_bf16(kf[2],q1_,C0,0,0,0),   P0[10],P0[11],P0[12],P0[13], pw1[0]=PKW(P0,8), pw1[1]=PKW(P0,10), pw1); \
    VRD(5); SBAR(); GAPA(C1=__builtin_amdgcn_mfma_f32_32x32x16_bf16(kf[3],q1_,C1,0,0,0),   P0[14],P0[15],P1[0],P1[1],   pw1[2]=PKW(P0,12),pw1[3]=PKW(P0,14), pw1); q1_=QLD(3); \
    VRD(2); SBAR(); GAPA(C0=__builtin_amdgcn_mfma_f32_32x32x16_bf16(kf[4],q0_,C0,0,0,0),   P1[2],P1[3],P1[4],P1[5],     pw2[0]=PKW(P1,0), pw2[1]=PKW(P1,2), pw2); \
    VRD(6); SBAR(); GAPA(C1=__builtin_amdgcn_mfma_f32_32x32x16_bf16(kf[5],q0_,C1,0,0,0),   P1[6],P1[7],P1[8],P1[9],     pw2[2]=PKW(P1,4), pw2[3]=PKW(P1,6), pw2); \
    VRD(3); SBAR(); GAPA(C0=__builtin_amdgcn_mfma_f32_32x32x16_bf16(kf[6],q1_,C0,0,0,0),   P1[10],P1[11],P1[12],P1[13], pw3[0]=PKW(P1,8), pw3[1]=PKW(P1,10), pw3); \
    VRD(7); SBAR(); GAPA(C1=__builtin_amdgcn_mfma_f32_32x32x16_bf16(kf[7],q1_,C1,0,0,0),   P1[14],P1[15],0.f,0.f,       pw3[2]=PKW(P1,12),pw3[3]=PKW(P1,14), pw3); \
    l_reg+=sacc; \
    if(GK){DMA_K((t)+3,sl_cur);} if(GV){DMA_V((t)+1,sl_next);} \
    CMASK(C0,C1,t); \
    { float a=MX3(C0[0],C0[1],C1[0]),b=MX3(C0[2],C0[3],C1[1]); a=MX3(a,C1[2],C1[3]); \
      _Pragma("unroll") for(int r=4;r<16;r+=4){a=MX3(a,C0[r],C0[r+1]);b=MX3(b,C0[r+2],C0[r+3]);a=MX3(a,C1[r],C1[r+1]);b=MX3(b,C1[r+2],C1[r+3]);} \
      float rm=__builtin_fmaxf(a,b); { auto rr=__builtin_amdgcn_permlane32_swap(__float_as_uint(rm),__float_as_uint(rm),false,false); rm=__builtin_fmaxf(__uint_as_float(rr[0]),__uint_as_float(rr[1])); } \
      resc=false; \
      if(__builtin_expect(__any(rm>(float)THRL),0)){ const float dl=__builtin_fmaxf(rm,0.f); mhat+=dl; \
        _Pragma("unroll") for(int r=0;r<16;++r){C0[r]-=dl;C1[r]-=dl;} \
        qx=make_qx(-mhat,hm); \
        const float f=__builtin_amdgcn_exp2f(-dl); l_reg*=f; if(hi==0)wsf[r32]=f; resc=true; } } \
    SBAR(); \
    GAPB(o[0]=__builtin_amdgcn_mfma_f32_32x32x16_bf16(PAF(0),VFR(0),o[0],0,0,0), C0,0); \
    GAPB(o[1]=__builtin_amdgcn_mfma_f32_32x32x16_bf16(PAF(0),VFR(4),o[1],0,0,0), C0,4); \
    KRD(GL,0); GAPB(o[0]=__builtin_amdgcn_mfma_f32_32x32x16_bf16(PAF(1),VFR(1),o[0],0,0,0), C0,8); \
    KRD(GL,1); GAPB(o[1]=__builtin_amdgcn_mfma_f32_32x32x16_bf16(PAF(1),VFR(5),o[1],0,0,0), C0,12); \
    KRD(GL,2); GAPB(o[0]=__builtin_amdgcn_mfma_f32_32x32x16_bf16(PAF(2),VFR(2),o[0],0,0,0), C1,0); \
    KRD(GL,3); GAPB(o[1]=__builtin_amdgcn_mfma_f32_32x32x16_bf16(PAF(2),VFR(6),o[1],0,0,0), C1,4); \
    GAPB(o[0]=__builtin_amdgcn_mfma_f32_32x32x16_bf16(PAF(3),VFR(3),o[0],0,0,0), C1,8); \
    GAPB(o[1]=__builtin_amdgcn_mfma_f32_32x32x16_bf16(PAF(3),VFR(7),o[1],0,0,0), C1,12); \
    }while(0)
  int t=1;
  #undef CMASK
  #define CMASK(P0,P1,t) do{}while(0)
  for(;t+5<NT;t+=2){
    STEP(pB0,pB1,pA0,pA1,t,true,true,true);     WAIT_BAR(2); RESC(); ROT();
    STEP(pA0,pA1,pB0,pB1,t+1,true,true,true);   WAIT_BAR(2); RESC(); ROT();
  }
  #undef CMASK
  #define CMASK(P0,P1,t) do{int jb_=(t)-(NT-4); if(jb_>=0)cmask(P0,P1,jb_,qrel,hi);}while(0)
  #define ENDW(tt) do{ if((tt)+3<NT){WAIT_BAR(2);} else if((tt)+2<NT){WAIT_BAR(1);} else {WAIT_BAR(0);} }while(0)
  for(;t+1<NT;t+=2){
    STEP(pB0,pB1,pA0,pA1,t,(t+3<NT),(t+1<NT),(t+1<NT));       ENDW(t);   RESC(); ROT();
    STEP(pA0,pA1,pB0,pB1,t+1,(t+4<NT),(t+2<NT),(t+2<NT));     ENDW(t+1); RESC(); ROT();
  }
  STEP(pB0,pB1,pA0,pA1,NT-1,false,false,false); RESC();
  { float sacc=pB0[0]+pB0[1]; _Pragma("unroll") for(int r=2;r<16;++r)sacc+=pB0[r]; _Pragma("unroll") for(int r=0;r<16;++r)sacc+=pB1[r]; l_reg+=sacc;
    pw0=(u32x4){PKW(pB0,0),PKW(pB0,2),PKW(pB0,4),PKW(pB0,6)};pw1=(u32x4){PKW(pB0,8),PKW(pB0,10),PKW(pB0,12),PKW(pB0,14)};pw2=(u32x4){PKW(pB1,0),PKW(pB1,2),PKW(pB1,4),PKW(pB1,6)};pw3=(u32x4){PKW(pB1,8),PKW(pB1,10),PKW(pB1,12),PKW(pB1,14)};
    SBAR(); pv(o,vb0+sl_cur,PAF(0),PAF(1),PAF(2),PAF(3)); }
  #undef PKW
  #undef PAF
  #undef VFR
  #undef PIN
  #undef MX3
  #undef GAPA
  #undef GAPB
  #undef EX
  #undef VRD
  #undef KRD
  #undef STEP
  #undef ENDW
  {auto rr=__builtin_amdgcn_permlane32_swap(__float_as_uint(l_reg),__float_as_uint(l_reg),false,false);l_reg=__uint_as_float(rr[0])+__uint_as_float(rr[1]);}
  { int te=tid; asm volatile("":"+v"(te));
    const int lane_e=te&63,r32e=lane_e&31,hie=lane_e>>5;
    if(hie==0)wsf[32+r32e]=l_reg;asm volatile("s_waitcnt lgkmcnt(0)":::"memory");
    float rli[16];
    #pragma unroll
    for(int r=0;r<16;++r)rli[r]=__builtin_amdgcn_rcpf(wsf[32+crow(r,hie)]);
    bf16*Ow=O+(rowbase+q0+wid*QBLK)*DM+h*D; const bf16*Gw=Gt+(rowbase+q0+wid*QBLK)*DM+h*D;
    bf16*stg=(bf16*)(shm+LDS_OST)+wid*2048;
    #pragma unroll
    for(int r=0;r<16;++r){const int orow=crow(r,hie);
      #pragma unroll
      for(int d0=0;d0<2;++d0)stg[orow*64+d0*32+r32e]=__float2bfloat16(o[d0][r]*rli[r]);}
    asm volatile("s_waitcnt lgkmcnt(0)":::"memory");
    #pragma unroll
    for(int i=0;i<4;++i){const int row=i*8+(lane_e>>3),ch=lane_e&7; u32x4 v=*(const u32x4*)(stg+row*64+ch*8); const u32x4 gv=*(const u32x4*)(Gw+(long)row*DM+ch*8);
      #pragma unroll
      for(int e=0;e<4;++e){ const float g0=__uint_as_float(gv[e]<<16),g1=__uint_as_float(gv[e]&0xffff0000u),x0=__uint_as_float(v[e]<<16),x1=__uint_as_float(v[e]&0xffff0000u);
        v[e]=cvtpk_s(x0*__builtin_amdgcn_rcpf(1.f+__expf(-g0)),x1*__builtin_amdgcn_rcpf(1.f+__expf(-g1))); }
      ATTN_STORE16(Ow+(long)row*DM+ch*8,v);} }
  asm volatile("s_waitcnt lgkmcnt(0)\n\ts_barrier":::"memory");
  #undef DMA_K
  #undef QLD
  #undef DMA_V
  #undef CMASK
  #undef START
  #undef RESC
  #undef ROT
}
constexpr int ATTN_LDS_BYTES=LDS_BYTES;
struct AttnTensors { const bf16* Q; const bf16* K; const bf16* V; bf16* O; const bf16* G; const float* CUM; };
struct AttnUnit { int bh; int qb; };
struct StaticOrder {
  int vcu;
  __device__ __forceinline__ explicit StaticOrder(int grid,int block):vcu((block%8)*(grid/8)+block/8){}
  __device__ __forceinline__ bool next(int i,AttnUnit&u)const{ if(i>=4)return false; const int s=2*(vcu&1)+(i>>1); u.bh=vcu>>1; u.qb=(i&1)?7-s:s; return true; }
  __device__ __forceinline__ void a_ready(const AttnUnit&)const{}
  __device__ __forceinline__ void done(const AttnUnit&)const{}
};
template<class Sched,int THRL=8> __device__ __forceinline__ void attn_phase(char*lds,const AttnTensors&T,const Sched&S,int tid_in){
  AttnUnit u; int tid_=tid_in; asm volatile("":"+v"(tid_));
  if(S.next(0,u)){ float*csp=(float*)(lds+LDS_CS); float*wt=(float*)(lds+LDS_WS); int tp=tid_in; asm volatile("":"+v"(tp));
    const float*lf=T.CUM+((long)(u.bh/NHEAD)*SEQ+4*tp)*NHEAD+u.bh%NHEAD;
    const float a0=lf[0],a1=a0+lf[NHEAD],a2=a1+lf[2*NHEAD],a3=a2+lf[3*NHEAD];
    float sc=a3; const int ln=tp&63;
    #pragma unroll
    for(int o=1;o<64;o<<=1){ const float up=__builtin_bit_cast(float,__builtin_amdgcn_ds_bpermute((ln-o)<<2,__builtin_bit_cast(int,sc))); if(ln>=o)sc+=up; }
    if(ln==63)wt[tp>>6]=sc;
    __syncthreads();
    float base=sc-a3;
    #pragma unroll
    for(int w=0;w<NW-1;++w)if(w<(tp>>6))base+=wt[w];
    const float k2=-1.4426950408889634f;
    csp[4*tp]=k2*(base+a0);csp[4*tp+1]=k2*(base+a1);csp[4*tp+2]=k2*(base+a2);csp[4*tp+3]=k2*(base+a3);
    __syncthreads(); }
  for(int i=0;S.next(i,u);++i){ S.a_ready(u); attn_unit<THRL>(u.bh/NHEAD,u.bh%NHEAD,u.qb,T.Q,T.K,T.V,T.O,T.G,lds,tid_); S.done(u); }
}
#undef SBAR
#undef WAIT_BAR
}
#define GAS __attribute__((address_space(1)))
#define LAS __attribute__((address_space(3)))
typedef unsigned short bf16;
typedef unsigned v4u __attribute__((ext_vector_type(4)));
typedef float f32x4 __attribute__((ext_vector_type(4)));
typedef short bf16x8 __attribute__((ext_vector_type(8)));
typedef GAS unsigned gu32;
typedef GAS unsigned long long gu64;
#define RLX_AGENT __ATOMIC_RELAXED, __HIP_MEMORY_SCOPE_AGENT
#define LDS_WAIT() asm volatile("s_waitcnt lgkmcnt(0)" ::: "memory")
#define VM_WAIT() asm volatile("s_waitcnt vmcnt(0)" ::: "memory")
__device__ __forceinline__ unsigned long long rt() { return __builtin_amdgcn_s_memrealtime(); }
__device__ __forceinline__ unsigned f2bf(float f) { unsigned u = __builtin_bit_cast(unsigned, f); return (u + 0x7fffu + ((u >> 16) & 1u)) >> 16; }
__device__ __forceinline__ unsigned pk2(float lo, float hi) { return f2bf(lo) | (f2bf(hi) << 16); }

#define XB_TMO      128
#define XB_XCNT(j)  (256  + 64 * (j))
#define XB_XSUB(j)  (1280 + 64 * (j))
#define XB_XGEN(j)  (2304 + 64 * (j))
#define XB_TOP      3328
#define XB_TOPGEN   3392
#define XCD_BAR_WORDS 3456
#define XB_SPIN_CAP (1u << 27)

__device__ __forceinline__ unsigned xb_ld(unsigned* p)              { return __hip_atomic_load(p, __ATOMIC_RELAXED, __HIP_MEMORY_SCOPE_AGENT); }
__device__ __forceinline__ unsigned xb_add(unsigned* p, unsigned v) { return __hip_atomic_fetch_add(p, v, __ATOMIC_RELAXED, __HIP_MEMORY_SCOPE_AGENT); }
__device__ __forceinline__ unsigned xb_xcc_id() { return (unsigned)__builtin_amdgcn_s_getreg((3 << 11) | 20) & 0xFu; }
#define XB_SPIN(cond, bar) do { unsigned _sp = 0; while (cond) { __builtin_amdgcn_s_sleep(1); \
    if ((++_sp & 255u) == 0u) { if (xb_ld(&(bar)[XB_TMO])) break; if (_sp > XB_SPIN_CAP) { atomicAdd(&(bar)[XB_TMO], 1u); break; } } } } while (0)

struct XcdBarrier {
    unsigned* bar; unsigned x;
    volatile LAS unsigned* st;
};

__device__ __forceinline__ XcdBarrier xcd_barrier_post(unsigned* bar, volatile LAS unsigned* st) {
    XcdBarrier b; b.bar = bar; b.x = xb_xcc_id(); b.st = st;
    if (threadIdx.x == 0) (void)xb_add(&bar[XB_XCNT(b.x)], 1u);
    return b;
}
__device__ __forceinline__ void xcd_barrier_complete(unsigned* bar, unsigned x, unsigned& nloc, unsigned& nx) {
    const unsigned G = gridDim.x * gridDim.y * gridDim.z;
    unsigned sum, cnt, mine, sp = 0u;
    for (;;) {
        sum = 0u; cnt = 0u; mine = 0u;
#pragma unroll
        for (unsigned j = 0; j < 16; ++j) { const unsigned c = xb_ld(&bar[XB_XCNT(j)]); sum += c; cnt += (c > 0u) ? 1u : 0u; mine = (j == x) ? c : mine; }
        if (sum == G) break;
        __builtin_amdgcn_s_sleep(1);
        if ((++sp & 255u) == 0u) { if (xb_ld(&bar[XB_TMO])) break; if (sp > XB_SPIN_CAP) { atomicAdd(&bar[XB_TMO], 1u); break; } }
    }
    nloc = mine > 0u ? mine : 1u; nx = cnt > 0u ? cnt : 1u;
}

__device__ __forceinline__ void xcd_barrier(const XcdBarrier& b, const bool leader  ) {
    asm volatile("s_waitcnt vmcnt(0)" ::: "memory");
    __syncthreads();
    if (leader) {
        unsigned* bar = b.bar;
        __builtin_amdgcn_s_waitcnt(0);
        unsigned nloc = b.st[0], nx = b.st[1];
        if (nloc == 0u) { xcd_barrier_complete(bar, b.x, nloc, nx); b.st[0] = nloc; b.st[1] = nx; }
        const unsigned old = xb_add(&bar[XB_XSUB(b.x)], 1u);
        const unsigned gen = old / nloc;
        if (old + 1u == (gen + 1u) * nloc) {
            __builtin_amdgcn_fence(__ATOMIC_RELEASE, "agent");
            asm volatile("s_waitcnt vmcnt(0)" ::: "memory");
            const unsigned og = xb_add(&bar[XB_TOP], 1u);
            const unsigned tg = og / nx;
            if (og + 1u == (tg + 1u) * nx) xb_add(&bar[XB_TOPGEN], 1u);
            else XB_SPIN(xb_ld(&bar[XB_TOPGEN]) == tg, bar);
            __builtin_amdgcn_fence(__ATOMIC_ACQUIRE, "agent");
            xb_add(&bar[XB_XGEN(b.x)], 1u);
            asm volatile("s_waitcnt vmcnt(0)" ::: "memory");
        } else {
            XB_SPIN(xb_ld(&bar[XB_XGEN(b.x)]) == gen, bar);
            __builtin_amdgcn_fence(__ATOMIC_ACQUIRE, "agent");
            asm volatile("s_waitcnt vmcnt(0)" ::: "memory");
        }
    }
    __syncthreads();
}
#ifndef MK_FASTATTN
#define MK_FASTATTN 1
#endif
#ifndef MK_FASTREC
#define MK_FASTREC 1
#endif
namespace cg = cooperative_groups;
constexpr int NTOK = 16384, DMODEL = 1024, NBATCH = 8, SEQLEN = 2048, DEPTH = 4;
constexpr int FOX_IN = 4112, GLA_IN = 3088, HGRN_IN = 4096;
constexpr float RMS_EPS = 1e-6f;
constexpr float LOG2E = 1.4426950408889634f;
constexpr float FOX_C2 = 0.125f * LOG2E;
constexpr int NWAVES = 8;

constexpr size_t MiB = 1u << 20;
constexpr size_t WS_CTL = 0, CTL_ZERO_BYTES = 1 * MiB;
constexpr size_t WS_FOXWIN = 2 * MiB, WS_FOXWOUT = 18 * MiB, WS_GLAWIN = 22 * MiB, WS_GLAWOUT = 28 * MiB, WS_HGRNWIN = 30 * MiB, WS_HGRNWOUT = 38 * MiB;
constexpr size_t WS_PEERWQ = 40 * MiB, WS_KEYS = 56 * MiB, WS_LB = 58 * MiB;
#ifndef BGQ
#define BGQ 1
#endif
#ifndef I8MASK
#define I8MASK 13
#endif
constexpr size_t WS_SW = 58 * MiB + 65536, WS_SX = 58 * MiB + 262144, WS_XN8 = 724 * MiB;
constexpr size_t WS_TAILW = 63 * MiB;
constexpr size_t WS_RS = 62 * MiB;
constexpr size_t WS_U = 64 * MiB, WS_V = 128 * MiB, WS_SU = 60 * MiB, WS_SV = 61 * MiB;
constexpr size_t WS_XN = 320 * MiB, WS_P = 352 * MiB, WS_OB = 480 * MiB, WS_Q2 = 512 * MiB, WS_TAIL = 576 * MiB, WS_CUM = 577 * MiB;
constexpr size_t WS_EXP = 580 * MiB, WS_GATE = 588 * MiB, WS_OF = 596 * MiB, WS_GLOG = 660 * MiB, WS_END = 740 * MiB;
constexpr size_t PSTRIDE = (size_t)NTOK * 1024;
constexpr int CW_BAR = 4096;

constexpr int RING_BYTES = 131072;
constexpr int LDSCTL_OFF = RING_BYTES, MISC_OFF = LDSCTL_OFF + 320;
constexpr int LDS_BYTES = 147456;

typedef unsigned u32x4v __attribute__((ext_vector_type(4)));
struct Ctx {
    LAS unsigned char* lds; int tid, lane, wave, vcu, G, gw, NGW, bx;
    const float* in[21]; float* out; unsigned char* ws;
};

__device__ __forceinline__ float bf2f(unsigned short b) { return __uint_as_float(((unsigned)b) << 16); }
__device__ __forceinline__ float bflo(unsigned w) { return __uint_as_float(w << 16); }
__device__ __forceinline__ float bfhi(unsigned w) { return __uint_as_float(w & 0xffff0000u); }
#define DPP_ADD(v, ctrl, rm, bm) (v + __builtin_bit_cast(float, __builtin_amdgcn_update_dpp(0, __builtin_bit_cast(int, v), ctrl, rm, bm, false)))
#define DPP_MAX(v, ctrl, rm, bm) fmaxf(v, __builtin_bit_cast(float, __builtin_amdgcn_update_dpp(__builtin_bit_cast(int, v), __builtin_bit_cast(int, v), ctrl, rm, bm, false)))
#define DPP_SUM31(v) do { v = DPP_ADD(v, 0x111, 0xf, 0xf); v = DPP_ADD(v, 0x112, 0xf, 0xf); v = DPP_ADD(v, 0x114, 0xf, 0xe); v = DPP_ADD(v, 0x118, 0xf, 0xc); v = DPP_ADD(v, 0x142, 0xa, 0xf); } while (0)
#define DPP_SUM63(v) do { DPP_SUM31(v); v = DPP_ADD(v, 0x143, 0xc, 0xf); } while (0)
__device__ __forceinline__ float rdlane(float v, int lane) { return __builtin_bit_cast(float, __builtin_amdgcn_readlane(__builtin_bit_cast(int, v), lane)); }
__device__ __forceinline__ float wave_sum(float v) { DPP_SUM63(v); return rdlane(v, 63); }
__device__ __forceinline__ float wave_max(float v) {
    v = DPP_MAX(v, 0x111, 0xf, 0xf); v = DPP_MAX(v, 0x112, 0xf, 0xf); v = DPP_MAX(v, 0x114, 0xf, 0xe); v = DPP_MAX(v, 0x118, 0xf, 0xc); v = DPP_MAX(v, 0x142, 0xa, 0xf); v = DPP_MAX(v, 0x143, 0xc, 0xf);
    return rdlane(v, 63);
}
typedef __bf16 bf16x2_t __attribute__((ext_vector_type(2)));
__device__ __forceinline__ float dot2bf(unsigned w, unsigned x, float acc) { return __builtin_amdgcn_fdot2_f32_bf16(__builtin_bit_cast(bf16x2_t, w), __builtin_bit_cast(bf16x2_t, x), acc, false); }
__device__ __forceinline__ float bperm(float v, int src_lane) { return __builtin_bit_cast(float, __builtin_amdgcn_ds_bpermute(src_lane << 2, __builtin_bit_cast(int, v))); }
__device__ __forceinline__ float log_sigmoid_f(float x) { return fminf(x, 0.f) - log1pf(__expf(-fabsf(x))); }
__device__ __forceinline__ float sigmoid_f(float x) { return 1.f / (1.f + __expf(-x)); }

__device__ __forceinline__ void p0_transpose_item(const float* W, int ldw, int K, int Nuse, bf16* WT, LAS float* scr, int item, int lane) {
    const int nblk = Nuse / 32, kb = item / nblk, nb = item % nblk, k0 = 64 * kb, n0 = 32 * nb;
#pragma unroll
    for (int i = 0; i < 8; ++i) { const int kk = 8 * i + (lane >> 3); const f32x4 v = *(const GAS f32x4*)(W + (size_t)(k0 + kk) * ldw + n0 + 4 * (lane & 7));
        LAS float* d = scr + kk * 33 + 4 * (lane & 7); d[0] = v.x; d[1] = v.y; d[2] = v.z; d[3] = v.w; }
    LDS_WAIT(); asm volatile("" ::: "memory");
    const int c = lane & 7;
#pragma unroll
    for (int j = 0; j < 4; ++j) { const int n = (lane >> 3) + 8 * j; const LAS float* s = scr + (8 * c) * 33 + n;
        v4u o; o.x = pk2(s[0 * 33], s[1 * 33]); o.y = pk2(s[2 * 33], s[3 * 33]); o.z = pk2(s[4 * 33], s[5 * 33]); o.w = pk2(s[6 * 33], s[7 * 33]);
        *(GAS v4u*)(WT + (size_t)(n0 + n) * K + k0 + 8 * c) = o; }
    LDS_WAIT(); asm volatile("" ::: "memory");
}
__device__ __forceinline__ unsigned q8x4(float a, float b, float c, float d) {
    return ((unsigned)(int)__builtin_rintf(a) & 0xffu) | (((unsigned)(int)__builtin_rintf(b) & 0xffu) << 8) | (((unsigned)(int)__builtin_rintf(c) & 0xffu) << 16) | ((unsigned)(int)__builtin_rintf(d) << 24);
}
__device__ __forceinline__ void p0_colmax_item(const float* W, int ldw, unsigned* cmax, int item, int lane) {
    const int nb = item >> 3, n0 = 32 * nb, k0 = 128 * (item & 7);
    f32x4 v[16];
#pragma unroll
    for (int i = 0; i < 16; ++i) v[i] = *(const GAS f32x4*)(W + (size_t)(k0 + 8 * i + (lane >> 3)) * ldw + n0 + 4 * (lane & 7));
    __builtin_amdgcn_sched_barrier(0);
    float mx[4] = {0.f, 0.f, 0.f, 0.f};
#pragma unroll
    for (int i = 0; i < 16; ++i) { mx[0] = fmaxf(mx[0], fabsf(v[i].x)); mx[1] = fmaxf(mx[1], fabsf(v[i].y)); mx[2] = fmaxf(mx[2], fabsf(v[i].z)); mx[3] = fmaxf(mx[3], fabsf(v[i].w)); }
#pragma unroll
    for (int j = 0; j < 4; ++j) { mx[j] = fmaxf(mx[j], bperm(mx[j], lane ^ 8)); mx[j] = fmaxf(mx[j], bperm(mx[j], lane ^ 16)); mx[j] = fmaxf(mx[j], bperm(mx[j], lane ^ 32)); }
    if (lane < 8) {
#pragma unroll
        for (int j = 0; j < 4; ++j) (void)__hip_atomic_fetch_max(cmax + n0 + 4 * lane + j, __float_as_uint(mx[j]), __ATOMIC_RELAXED, __HIP_MEMORY_SCOPE_AGENT);
    }
}
__device__ __forceinline__ void p0_quant_item(const float* W, int ldw, const unsigned* cmax, signed char* W8, float* sw, LAS float* scr, int item, int lane) {
    const int nb = item >> 3, n0 = 32 * nb, k0 = 128 * (item & 7);
    f32x4 v[2][8];
#pragma unroll
    for (int h = 0; h < 2; ++h)
#pragma unroll
        for (int i = 0; i < 8; ++i) v[h][i] = *(const GAS f32x4*)(W + (size_t)(k0 + 64 * h + 8 * i + (lane >> 3)) * ldw + n0 + 4 * (lane & 7));
    float ci[4];
#pragma unroll
    for (int j = 0; j < 4; ++j) { const float m = __uint_as_float(*(const GAS unsigned*)(cmax + n0 + (lane >> 3) + 8 * j)); ci[j] = m > 0.f ? 127.f / m : 0.f; }
    if ((item & 7) == 0 && lane < 32) *(GAS float*)(sw + n0 + lane) = __uint_as_float(*(const GAS unsigned*)(cmax + n0 + lane)) * (1.f / 127.f);
    __builtin_amdgcn_sched_barrier(0);
    const int c = lane & 7;
#pragma unroll
    for (int h = 0; h < 2; ++h) {
        LDS_WAIT(); asm volatile("" ::: "memory");
#pragma unroll
        for (int i = 0; i < 8; ++i) { LAS float* d = scr + (8 * i + (lane >> 3)) * 33 + 4 * (lane & 7); d[0] = v[h][i].x; d[1] = v[h][i].y; d[2] = v[h][i].z; d[3] = v[h][i].w; }
        LDS_WAIT(); asm volatile("" ::: "memory");
#pragma unroll
        for (int j = 0; j < 4; ++j) { const int n = (lane >> 3) + 8 * j; const LAS float* sp = scr + (8 * c) * 33 + n;
            const unsigned lo = q8x4(sp[0] * ci[j], sp[33] * ci[j], sp[66] * ci[j], sp[99] * ci[j]), hi = q8x4(sp[132] * ci[j], sp[165] * ci[j], sp[198] * ci[j], sp[231] * ci[j]);
            *(GAS unsigned long long*)(W8 + (size_t)(n0 + n) * 1024 + k0 + 64 * h + 8 * c) = (unsigned long long)lo | ((unsigned long long)hi << 32); }
    }
    LDS_WAIT(); asm volatile("" ::: "memory");
}
__device__ __forceinline__ void rms_row_to_bf16(int lane, f32x4 (&v)[4], const float* gain, bf16* orow, signed char* orow8, float* sx) {
    const GAS f32x4* gr = (const GAS f32x4*)gain + lane;
    float s = 0.f;
#pragma unroll
    for (int j = 0; j < 4; ++j) s += (v[j].x * v[j].x + v[j].y * v[j].y) + (v[j].z * v[j].z + v[j].w * v[j].w);
    const float r = rsqrtf(wave_sum(s) * (1.f / 1024.f) + RMS_EPS);
    GAS unsigned long long* o8 = (GAS unsigned long long*)orow + lane; float am = 0.f;
#pragma unroll
    for (int j = 0; j < 4; ++j) { const f32x4 g = gr[64 * j]; v[j].x *= r * g.x; v[j].y *= r * g.y; v[j].z *= r * g.z; v[j].w *= r * g.w;
        am = fmaxf(fmaxf(am, fmaxf(fabsf(v[j].x), fabsf(v[j].y))), fmaxf(fabsf(v[j].z), fabsf(v[j].w)));
        o8[64 * j] = (unsigned long long)pk2(v[j].x, v[j].y) | ((unsigned long long)pk2(v[j].z, v[j].w) << 32); }
    am = wave_max(am); const float qi = am > 0.f ? 127.f / am : 0.f;
    GAS unsigned* q8 = (GAS unsigned*)orow8 + lane;
#pragma unroll
    for (int j = 0; j < 4; ++j) q8[64 * j] = q8x4(v[j].x * qi, v[j].y * qi, v[j].z * qi, v[j].w * qi);
    if (lane == 0) *(GAS float*)sx = am * (1.f / 127.f);
}
__device__ __forceinline__ void cvt_f32_bf16(const Ctx& C, const float* src, bf16* dst, size_t n) {
    const size_t nth = (size_t)C.G * 512, t0 = (size_t)C.vcu * 512 + C.tid;
    for (size_t i = t0; i < n / 8; i += nth) {
        const f32x4 a = ((const GAS f32x4*)src)[2 * i], b = ((const GAS f32x4*)src)[2 * i + 1];
        v4u o; o.x = pk2(a.x, a.y); o.y = pk2(a.z, a.w); o.z = pk2(b.x, b.y); o.w = pk2(b.z, b.w);
        ((GAS v4u*)dst)[i] = o;
    }
}
__device__ __forceinline__ void quant_row_fp8(int lane, const f32x4 (&v)[4], unsigned char* drow, float* sc) {
    float am = 0.f;
#pragma unroll
    for (int i = 0; i < 4; ++i) am = fmaxf(am, fmaxf(fmaxf(fabsf(v[i].x), fabsf(v[i].y)), fmaxf(fabsf(v[i].z), fabsf(v[i].w))));
    am = wave_max(am);
    const float inv = am > 0.f ? 448.f / am : 0.f;
    GAS unsigned* o = (GAS unsigned*)drow + lane;
#pragma unroll
    for (int i = 0; i < 4; ++i) {
        const float a = fminf(fmaxf(v[i].x * inv, -448.f), 448.f), b = fminf(fmaxf(v[i].y * inv, -448.f), 448.f), c = fminf(fmaxf(v[i].z * inv, -448.f), 448.f), d = fminf(fmaxf(v[i].w * inv, -448.f), 448.f);
        int w = 0; w = __builtin_amdgcn_cvt_pk_fp8_f32(a, b, w, false); w = __builtin_amdgcn_cvt_pk_fp8_f32(c, d, w, true); o[64 * i] = (unsigned)w;
    }
    if (lane == 0) *(GAS float*)sc = am * (1.f / 448.f);
}
__device__ __forceinline__ void quant_rows_fp8(const Ctx& C, const float* src, unsigned char* dst, float* scales, int nrows) {
    int rw = C.gw;
    for (; rw + 3 * C.NGW < nrows; rw += 4 * C.NGW) {
        f32x4 v[4][4];
#pragma unroll
        for (int j = 0; j < 4; ++j) { const GAS f32x4* xr = (const GAS f32x4*)(src + (size_t)(rw + j * C.NGW) * 1024) + C.lane;
#pragma unroll
            for (int i = 0; i < 4; ++i) v[j][i] = xr[64 * i]; }
        __builtin_amdgcn_sched_barrier(0);
#pragma unroll
        for (int j = 0; j < 4; ++j) quant_row_fp8(C.lane, v[j], dst + (size_t)(rw + j * C.NGW) * 1024, scales + rw + j * C.NGW);
    }
    for (; rw < nrows; rw += C.NGW) {
        const GAS f32x4* xr = (const GAS f32x4*)(src + (size_t)rw * 1024) + C.lane;
        f32x4 v[4];
#pragma unroll
        for (int i = 0; i < 4; ++i) v[i] = xr[64 * i];
        quant_row_fp8(C.lane, v, dst + (size_t)rw * 1024, scales + rw);
    }
}
constexpr int BGQ_ROWS = 3 * 16384;
template <int JOB> __device__ __forceinline__ void bgq_row(const Ctx& C, int idx, const float*& src, unsigned char*& dst, float*& sc) {
    const int seg = idx >> 14, row = idx & 16383;
    const bool isV = seg == 1 || (seg == 2 && JOB == 2);
    const size_t flat = (size_t)(seg < 2 ? JOB : 3) * 16384 + row;
    src = (isV ? C.in[20] : C.in[19]) + flat * 1024; dst = C.ws + (isV ? WS_V : WS_U) + flat * 1024; sc = (float*)(C.ws + (isV ? WS_SV : WS_SU)) + flat;
}
template <int JOB> __device__ __forceinline__ void bgq_step(const Ctx& C, int idx_prev, int idx, f32x4 (&v)[4]) {
    const float* src; unsigned char* dst; float* sc;
    if (idx_prev >= 0 && idx_prev < BGQ_ROWS) { bgq_row<JOB>(C, idx_prev, src, dst, sc); quant_row_fp8(C.lane, v, dst, sc); }
    if (idx < BGQ_ROWS) { bgq_row<JOB>(C, idx, src, dst, sc); const GAS f32x4* xr = (const GAS f32x4*)src + C.lane;
#pragma unroll
        for (int i = 0; i < 4; ++i) v[i] = xr[64 * i]; }
}
#ifndef PRO_PROBE
#define PRO_PROBE 0
#endif
constexpr int CW_CMAX = 131072;
constexpr int I8_NF0 = (I8MASK & 1) ? 1024 : 0, I8_NF3 = (I8MASK & 8) ? 1024 : 0, I8_NG = (I8MASK & 2) ? 768 : 0, I8_NH = (I8MASK & 4) ? 1024 : 0, I8_NITEMS = I8_NF0 + I8_NF3 + I8_NG + I8_NH;
template <bool PASS2> __device__ __forceinline__ void p0_i8_items(const Ctx& C, LAS float* scr) {
    unsigned* CM = (unsigned*)(C.ws + WS_CTL) + CW_CMAX; float* SW = (float*)(C.ws + WS_SW);
    for (int it = C.gw; it < I8_NITEMS; it += C.NGW) {
        int r = it; const float* W; int ldw; signed char* W8; int q;
        if (r < I8_NF0) { W = C.in[3]; ldw = FOX_IN; W8 = (signed char*)(C.ws + WS_FOXWIN); q = 0; }
        else if ((r -= I8_NF0) < I8_NF3) { W = C.in[3] + (size_t)1024 * FOX_IN; ldw = FOX_IN; W8 = (signed char*)(C.ws + WS_FOXWIN + 8 * MiB); q = 1; }
        else if ((r -= I8_NF3) < I8_NG) { W = C.in[8]; ldw = GLA_IN; W8 = (signed char*)(C.ws + WS_GLAWIN); q = 2; }
        else { r -= I8_NG; W = C.in[13]; ldw = HGRN_IN; W8 = (signed char*)(C.ws + WS_HGRNWIN); q = 3; }
        const int swo = q == 0 ? 0 : q == 1 ? 4096 : q == 2 ? 8192 : 11264;
        if (PASS2) p0_quant_item(W, ldw, CM + q * 4096, W8, SW + swo, scr, r, C.lane); else p0_colmax_item(W, ldw, CM + q * 4096, r, C.lane);
    }
}
__device__ __forceinline__ void p0_prologue_b(const Ctx& C) { p0_i8_items<true>(C, (LAS float*)(C.lds + C.wave * 16384)); }
__device__ __forceinline__ void p0_prologue(const Ctx& C) {
    LAS float* scr = (LAS float*)(C.lds + C.wave * 16384);
    for (int rep_ = 0; rep_ < (PRO_PROBE == 1 ? 2 : 1); ++rep_) {
    p0_i8_items<false>(C, scr);
    constexpr int I_SQ = 16 * 32, N_F0 = (I8MASK & 1) ? 0 : 16 * 128, N_F3 = (I8MASK & 8) ? 0 : 16 * 128, N_G = (I8MASK & 2) ? 0 : 16 * 96, N_H = (I8MASK & 4) ? 0 : 16 * 128;
    constexpr int NITEMS = N_F0 + N_F3 + N_G + N_H + 2 * I_SQ + I_SQ + I_SQ;
    for (int it = C.gw; it < NITEMS; it += C.NGW) {
        int r = it;
        if (r < N_F0) { p0_transpose_item(C.in[3], FOX_IN, 1024, 4096, (bf16*)(C.ws + WS_FOXWIN), scr, r, C.lane); continue; } r -= N_F0;
        if (r < N_F3) { p0_transpose_item(C.in[3] + (size_t)1024 * FOX_IN, FOX_IN, 1024, 4096, (bf16*)(C.ws + WS_FOXWIN + 8 * MiB), scr, r, C.lane); continue; } r -= N_F3;
        if (r < N_G) { p0_transpose_item(C.in[8], GLA_IN, 1024, 3072, (bf16*)(C.ws + WS_GLAWIN), scr, r, C.lane); continue; } r -= N_G;
        if (r < N_H) { p0_transpose_item(C.in[13], HGRN_IN, 1024, 4096, (bf16*)(C.ws + WS_HGRNWIN), scr, r, C.lane); continue; } r -= N_H;
        if (r < 2 * I_SQ) { const int j = r / I_SQ; p0_transpose_item(C.in[7] + (size_t)j * 1024 * 1024, 1024, 1024, 1024, (bf16*)(C.ws + WS_FOXWOUT) + (size_t)j * 1024 * 1024, scr, r % I_SQ, C.lane); continue; } r -= 2 * I_SQ;
        if (r < I_SQ) { p0_transpose_item(C.in[12], 1024, 1024, 1024, (bf16*)(C.ws + WS_GLAWOUT), scr, r, C.lane); continue; } r -= I_SQ;
        p0_transpose_item(C.in[16], 1024, 1024, 1024, (bf16*)(C.ws + WS_HGRNWOUT), scr, r, C.lane);
    }
    }
    for (int rep_ = 0; rep_ < (PRO_PROBE == 2 ? 2 : 1); ++rep_) {
    constexpr int MT_GROUPS = 4 * 16 * 4 * 32;
    for (int grp = C.gw; grp < MT_GROUPS; grp += C.NGW) {
        const int nb2 = grp & 31, kb2 = (grp >> 5) & 3, hp = (grp >> 7) & 15, layer = grp >> 11;
        const float* kp = C.in[18] + ((size_t)(layer * 16 + hp) * 128 + kb2 * 32 + (C.lane & 15)) * 128 + 4 * (C.lane >> 4);
        const float* wp = C.in[17] + ((size_t)layer * 1024 + nb2 * 32 + (C.lane & 15)) * 2048 + hp * 128 + 4 * (C.lane >> 4);
        f32x4 ka[2][8], wb[2][8];
#pragma unroll
        for (int u = 0; u < 2; ++u)
#pragma unroll
            for (int s8 = 0; s8 < 8; ++s8) { ka[u][s8] = *(const GAS f32x4*)(kp + (size_t)u * 16 * 128 + 16 * s8); wb[u][s8] = *(const GAS f32x4*)(wp + (size_t)u * 16 * 2048 + 16 * s8); }
        __builtin_amdgcn_sched_barrier(0);
        f32x4 acc[2][2];
#pragma unroll
        for (int a = 0; a < 2; ++a)
#pragma unroll
            for (int b = 0; b < 2; ++b) acc[a][b] = (f32x4){0.f, 0.f, 0.f, 0.f};
#pragma unroll
        for (int s8 = 0; s8 < 8; ++s8)
#pragma unroll
            for (int a = 0; a < 2; ++a)
#pragma unroll
                for (int b = 0; b < 2; ++b) { const f32x4 x = ka[a][s8], y = wb[b][s8];
                    acc[a][b] = __builtin_amdgcn_mfma_f32_16x16x4f32(x.x, y.x, acc[a][b], 0, 0, 0); acc[a][b] = __builtin_amdgcn_mfma_f32_16x16x4f32(x.y, y.y, acc[a][b], 0, 0, 0);
                    acc[a][b] = __builtin_amdgcn_mfma_f32_16x16x4f32(x.z, y.z, acc[a][b], 0, 0, 0); acc[a][b] = __builtin_amdgcn_mfma_f32_16x16x4f32(x.w, y.w, acc[a][b], 0, 0, 0); }
#pragma unroll
        for (int a = 0; a < 2; ++a)
#pragma unroll
            for (int b = 0; b < 2; ++b) {
                bf16* mt = (bf16*)(C.ws + WS_PEERWQ) + ((size_t)layer * 2048 + hp * 128 + kb2 * 32 + a * 16 + (C.lane >> 4) * 4) * 1024 + nb2 * 32 + b * 16 + (C.lane & 15);
#pragma unroll
                for (int r = 0; r < 4; ++r) mt[(size_t)r * 1024] = (bf16)f2bf(acc[a][b][r]); }
    }
    }
    for (int rep_ = 0; rep_ < (PRO_PROBE == 3 ? 2 : 1); ++rep_) {
    quant_rows_fp8(C, C.in[19], C.ws + WS_U, (float*)(C.ws + WS_SU), BGQ ? 16384 : 4 * 16384);
    quant_rows_fp8(C, C.in[20], C.ws + WS_V, (float*)(C.ws + WS_SV), BGQ ? 16384 : 4 * 16384);
    }
    for (int rep_ = 0; rep_ < (PRO_PROBE == 4 ? 2 : 1); ++rep_) {
    for (int i = C.vcu * 512 + C.tid; i < 3 * 16 * 1024; i += C.G * 512) {
        const int w = i >> 14, n = (i >> 10) & 15, k = i & 1023;
        const float v = w < 2 ? C.in[3][(size_t)w * 1024 * FOX_IN + (size_t)k * FOX_IN + 4096 + n] : C.in[8][(size_t)k * GLA_IN + 3072 + n];
        ((bf16*)(C.ws + WS_TAILW))[i] = (bf16)f2bf(v);
    }
    if (C.vcu == 0) for (int c = C.tid; c < 1024; c += 512) {
        const float l0 = C.in[14][c], l1 = C.in[14][1024 + c], l2 = C.in[14][2048 + c], l3 = C.in[14][3072 + c];
        const float m = fmaxf(fmaxf(l0, l1), fmaxf(l2, l3));
        const float e0 = expf(l0 - m), e1 = expf(l1 - m), e2 = expf(l2 - m), e3 = expf(l3 - m);
        ((float*)(C.ws + WS_LB))[c] = (e1 + e2) / (e0 + e1 + e2 + e3);
    }
    for (int m0 = C.gw; m0 < NTOK; m0 += 4 * C.NGW) {
        f32x4 v[4][4];
#pragma unroll
        for (int u = 0; u < 4; ++u) { const int m = m0 + u * C.NGW; if (m < NTOK) { const GAS f32x4* xr = (const GAS f32x4*)(C.in[0] + (size_t)m * 1024) + C.lane;
#pragma unroll
            for (int j = 0; j < 4; ++j) v[u][j] = xr[64 * j]; } }
        __builtin_amdgcn_sched_barrier(0);
#pragma unroll
        for (int u = 0; u < 4; ++u) { const int m = m0 + u * C.NGW; if (m < NTOK)
            rms_row_to_bf16(C.lane, v[u], C.in[1], (bf16*)(C.ws + WS_XN) + (size_t)m * 1024, (signed char*)(C.ws + WS_XN8) + (size_t)m * 1024, (float*)(C.ws + WS_SX) + m); }
    }
    }
}

__device__ __forceinline__ void tail_mfma(const Ctx& C, int tok0, const bf16* WT, LAS float* part) {
    const int l = C.lane, m = l & 15, g = l >> 4, tbk = C.wave & 3, kh = C.wave >> 2;
    const bf16* ap = (const bf16*)(C.ws + WS_XN) + (size_t)(tok0 + 16 * tbk + m) * 1024 + kh * 512 + 8 * g;
    const bf16* bp = WT + (size_t)m * 1024 + kh * 512 + 8 * g;
    f32x4 acc = (f32x4){0.f, 0.f, 0.f, 0.f};
#pragma unroll 4
    for (int ks = 0; ks < 16; ++ks) acc = __builtin_amdgcn_mfma_f32_16x16x32_bf16(*(const bf16x8*)(ap + 32 * ks), *(const bf16x8*)(bp + 32 * ks), acc, 0, 0, 0);
#pragma unroll
    for (int r = 0; r < 4; ++r) part[kh * 1024 + (16 * tbk + 4 * g + r) * 16 + m] = acc[r];
}
__device__ __forceinline__ void fox_step1(const Ctx& C, int j) {
    float* TAIL = (float*)(C.ws + WS_TAIL); LAS float* part = (LAS float*)C.lds;
    const bf16* WT = (const bf16*)(C.ws + WS_TAILW) + (size_t)j * 16 * 1024;
    for (int tb = C.vcu; tb < NTOK / 64; tb += C.G) {
        __syncthreads();
        tail_mfma(C, tb * 64, WT, part);
        __syncthreads();
#pragma unroll
        for (int rep = 0; rep < 2; ++rep) { const int i = rep * 512 + C.tid; TAIL[(size_t)tb * 1024 + i] = log_sigmoid_f(part[i] + part[1024 + i] + C.in[4][j * 16 + (i & 15)]); }
        const float* gq = C.in[5] + j * 64; const float* gk = C.in[6] + j * 64;
        for (int t = 0; t < 8; ++t) {
            const int tok = tb * 64 + C.wave * 8 + t;
#pragma unroll
            for (int which = 0; which < 2; ++which) {
                bf16* row = (bf16*)(C.ws + WS_P) + (size_t)which * PSTRIDE + (size_t)tok * 1024 + C.lane * 16;
                const v4u a = *(const GAS v4u*)row, b = *(const GAS v4u*)(row + 8);
                float v[16] = {bflo(a.x), bfhi(a.x), bflo(a.y), bfhi(a.y), bflo(a.z), bfhi(a.z), bflo(a.w), bfhi(a.w), bflo(b.x), bfhi(b.x), bflo(b.y), bfhi(b.y), bflo(b.z), bfhi(b.z), bflo(b.w), bfhi(b.w)};
                float ss = 0.f;
#pragma unroll
                for (int i = 0; i < 16; ++i) ss += v[i] * v[i];
                ss = DPP_ADD(ss, 0xB1, 0xf, 0xf); ss = DPP_ADD(ss, 0x4E, 0xf, 0xf);
                const float r = rsqrtf(ss * (1.f / 64.f) + RMS_EPS) * (which == 0 ? FOX_C2 : 1.f);
                const float* g = (which == 0 ? gq : gk) + (C.lane & 3) * 16;
#pragma unroll
                for (int i = 0; i < 16; ++i) v[i] = v[i] * r * g[i];
                v4u oa, ob; oa.x = pk2(v[0], v[1]); oa.y = pk2(v[2], v[3]); oa.z = pk2(v[4], v[5]); oa.w = pk2(v[6], v[7]);
                ob.x = pk2(v[8], v[9]); ob.y = pk2(v[10], v[11]); ob.z = pk2(v[12], v[13]); ob.w = pk2(v[14], v[15]);
                *(GAS v4u*)row = oa; *(GAS v4u*)(row + 8) = ob;
            }
        }
    }
}
constexpr size_t WS_ASC = WS_Q2, WS_Q1 = WS_Q2 + 16 * MiB, WS_KST = WS_Q2 + 48 * MiB, WS_DEC = 59 * MiB;
static_assert(WS_KST + 32 * MiB <= WS_OF && WS_Q1 + 32 * MiB <= WS_KST, "chunk workspace map");
template <int NH>
__device__ __forceinline__ void chunk_prepass(const Ctx& C) {
    bf16* ASC = (bf16*)(C.ws + WS_ASC); bf16* Q1 = (bf16*)(C.ws + WS_Q1); bf16* KST = (bf16*)(C.ws + WS_KST); float* DEC = (float*)(C.ws + WS_DEC);
    const bf16* P0 = (const bf16*)(C.ws + WS_P); const bf16* P1 = P0 + PSTRIDE;
    LAS bf16* tqs = (LAS bf16*)C.lds;
    LAS bf16* tks = tqs + 64 * 128;
    LAS bf16* q2s = tks + 64 * 128;
    LAS bf16* k2s = q2s + 64 * 136;
    LAS bf16* q1s = k2s + 64 * 136;
    LAS float* tot = (LAS float*)(q1s + 64 * 128);
    LAS float* part = tot + 512;
    const float qs = 0.08838834764831845f;
    const int d = C.tid & 127, tq = C.tid >> 7, l = C.lane, fr = l & 15, fq = l >> 4;
    const int dq = d;
    const int pr0 = C.tid >> 4, pc = (C.tid & 15) * 8;
#define PP_BAR() do { asm volatile("s_waitcnt lgkmcnt(0)" ::: "memory"); __builtin_amdgcn_s_barrier(); asm volatile("" ::: "memory"); } while (0)
    for (int itb = C.vcu; itb < NBATCH * 32; itb += C.G) {
        const int c = itb & 31, b = itb >> 5;
        const size_t rowb = (size_t)b * SEQLEN + c * 64;
        const size_t row0 = rowb + tq * 16;
        if (NH == 4) { __syncthreads(); tail_mfma(C, b * SEQLEN + c * 64, (const bf16*)(C.ws + WS_TAILW) + 2 * 16 * 1024, part); }
        v4u pq[2], pk[2];
#define PP_LOAD(h_) do { _Pragma("unroll") for (int j = 0; j < 2; ++j) { const size_t r_ = (rowb + pr0 + 32 * j) * 1024 + (h_) * 128 + pc; \
            pq[j] = *(const GAS v4u*)(P0 + r_); pk[j] = *(const GAS v4u*)((NH == 4 ? P0 + 512 : P1) + r_); } } while (0)
        PP_LOAD(0);
#pragma unroll 1
        for (int h = 0; h < NH; ++h) {
            const int it = (b * NH + h) * 32 + c;
            PP_BAR();
#pragma unroll
            for (int j = 0; j < 2; ++j) { *(LAS v4u*)(tqs + (pr0 + 32 * j) * 128 + pc) = pq[j]; *(LAS v4u*)(tks + (pr0 + 32 * j) * 128 + pc) = pk[j]; }
            if (h + 1 < NH) PP_LOAD(h + 1);
            PP_BAR();
            float bl[16], kk[16]; float run = 0.f;
            if (NH == 4) {
                float wu[16];
#pragma unroll
                for (int r = 0; r < 16; ++r) wu[r] = C.in[9][r * 512 + h * 128 + d];
                const float ba = C.in[10][h * 128 + d];
#pragma unroll
                for (int i = 0; i < 16; ++i) { float z = ba; const int t = tq * 16 + i;
#pragma unroll
                    for (int r = 0; r < 16; r += 4) { const f32x4 p0 = *(const LAS f32x4*)(part + t * 16 + r), p1 = *(const LAS f32x4*)(part + 1024 + t * 16 + r);
                        z += (p0[0] + p1[0]) * wu[r] + (p0[1] + p1[1]) * wu[r + 1] + (p0[2] + p1[2]) * wu[r + 2] + (p0[3] + p1[3]) * wu[r + 3]; }
                    run += log_sigmoid_f(z) * (1.f / 16.f); bl[i] = run; kk[i] = bf2f(tks[t * 128 + d]); }
            } else {
                const float lb = ((const float*)(C.ws + WS_LB))[h * 128 + d];
#pragma unroll
                for (int i = 0; i < 16; ++i) { const float gate = lb + (1.f - lb) * sigmoid_f(bf2f(tks[(tq * 16 + i) * 128 + d])); run += __logf(gate); bl[i] = run; kk[i] = 1.f - gate; }
            }
            tot[tq * 128 + d] = run;
            PP_BAR();
            const float t0 = tot[d], t1 = tot[128 + d], t2 = tot[256 + d], t3 = tot[384 + d];
            const float off = tq == 0 ? 0.f : tq == 1 ? t0 : tq == 2 ? t0 + t1 : t0 + t1 + t2;
            const float bref = t0 + t1, bend = (t0 + t1) + (t2 + t3);
            unsigned ksw[8];
#pragma unroll
            for (int i = 0; i < 16; ++i) {
                const float bb = bl[i] + off;
                const float qv = bf2f(tqs[(tq * 16 + i) * 128 + d]) * qs, kv = kk[i];
                q1s[(tq * 16 + i) * 128 + dq] = (bf16)f2bf(qv * __expf(bb));
                q2s[(tq * 16 + i) * 136 + d] = (bf16)f2bf(qv * __expf(bb - bref));
                k2s[(tq * 16 + i) * 136 + d] = (bf16)f2bf(kv * __expf(bref - bb));
                const unsigned kb = f2bf(kv * __expf(bend - bb));
                if (i & 1) ksw[i >> 1] |= kb << 16; else ksw[i >> 1] = kb;
            }
            { bf16* kt = KST + ((size_t)it * 128 + d) * 64 + tq * 16; *(GAS v4u*)kt = (v4u){ksw[0], ksw[1], ksw[2], ksw[3]}; *(GAS v4u*)(kt + 8) = (v4u){ksw[4], ksw[5], ksw[6], ksw[7]}; }
            if (tq == 0) DEC[(size_t)it * 128 + d] = __expf(bend);
            PP_BAR();
#pragma unroll
            for (int j = 0; j < 2; ++j) *(GAS v4u*)(Q1 + (rowb + pr0 + 32 * j) * 1024 + h * 128 + pc) = *(const LAS v4u*)(q1s + (pr0 + 32 * j) * 128 + pc);
            const int ti = C.wave >> 1;
#pragma unroll
            for (int sj = 0; sj < 2; ++sj) {
                const int si = 2 * (C.wave & 1) + sj;
                f32x4 acc = (f32x4){0.f, 0.f, 0.f, 0.f};
                if (si <= ti) {
#pragma unroll
                    for (int ks = 0; ks < 4; ++ks) {
                        const bf16x8 a = *(const LAS bf16x8*)(q2s + (16 * ti + fr) * 136 + ks * 32 + fq * 8), bb = *(const LAS bf16x8*)(k2s + (16 * si + fr) * 136 + ks * 32 + fq * 8);
                        acc = __builtin_amdgcn_mfma_f32_16x16x32_bf16(bb, a, acc, 0, 0, 0);
                    }
                }
                const int t = 16 * ti + fr, s0 = 16 * si + 4 * fq;
                typedef unsigned u32x2v __attribute__((ext_vector_type(2)));
                u32x2v w; w.x = pk2(s0 <= t ? acc[0] : 0.f, s0 + 1 <= t ? acc[1] : 0.f); w.y = pk2(s0 + 2 <= t ? acc[2] : 0.f, s0 + 3 <= t ? acc[3] : 0.f);
                *(GAS u32x2v*)(ASC + (size_t)it * 4096 + t * 64 + s0) = w;
            }
        }
    }
#undef PP_LOAD
#undef PP_BAR
}
struct RecFrag { bf16x8 vb[2]; bf16x8 a0, a1; unsigned long long q[4][2]; f32x4 dc[2]; bf16x8 ks[2][2]; };
template <int NH, int DV>
__device__ __forceinline__ void chunk_recur(const Ctx& C, const bf16* Vp) {
    const bf16* ASC = (const bf16*)(C.ws + WS_ASC); const bf16* Q1 = (const bf16*)(C.ws + WS_Q1); const bf16* KST = (const bf16*)(C.ws + WS_KST); const float* DEC = (const float*)(C.ws + WS_DEC);
    float* OF = (float*)(C.ws + WS_OF);
    constexpr int NCB = DV / 16, NTASK = NBATCH * NH * NCB;
    const int l = C.lane, m = l & 15, g = l >> 4, gi = C.wave >> 2, kq = C.wave & 3;
    LAS float* red = (LAS float*)C.lds + gi * 8192;
#define REC_LOAD(F, c_) do { const size_t row0_ = (size_t)b * SEQLEN + (c_) * 64; const size_t ch_ = (size_t)bh * 32 + (c_); \
        _Pragma("unroll") for (int ks = 0; ks < 2; ++ks) _Pragma("unroll") for (int j = 0; j < 8; ++j) F.vb[ks][j] = (short)Vp[(row0_ + 32 * ks + 8 * g + j) * 1024 + col]; \
        F.a0 = *(const bf16x8*)(ASC + ch_ * 4096 + (16 * kq + m) * 64 + 8 * g); F.a1 = *(const bf16x8*)(ASC + ch_ * 4096 + (16 * kq + m) * 64 + 32 + 8 * g); \
        _Pragma("unroll") for (int tb = 0; tb < 4; ++tb) { const bf16* qp = Q1 + (row0_ + 16 * tb + m) * 1024 + h * 128 + 32 * kq + 4 * g; F.q[tb][0] = *(const unsigned long long*)qp; F.q[tb][1] = *(const unsigned long long*)(qp + 16); } \
        _Pragma("unroll") for (int i = 0; i < 2; ++i) { F.dc[i] = *(const f32x4*)(DEC + ch_ * 128 + 32 * kq + 16 * i + 4 * g); \
            _Pragma("unroll") for (int ks = 0; ks < 2; ++ks) F.ks[i][ks] = *(const bf16x8*)(KST + (ch_ * 128 + 32 * kq + 16 * i + m) * 64 + 32 * ks + 8 * g); } } while (0)
#define REC_BODY(F, Fn, c_) do { \
        if ((c_) + 1 < 32) REC_LOAD(Fn, (c_) + 1); \
        if (BGQ) { const int bgn = (bgit * 32 + (c_)) * C.NGW + C.gw; bgq_step<JOB>(C, bgi, bgn, bgv); bgi = bgn; } \
        LAS float* rb = red + ((c_) & 1) * 4096; \
        f32x4 oin = __builtin_amdgcn_mfma_f32_16x16x32_bf16(F.a0, F.vb[0], (f32x4){0.f, 0.f, 0.f, 0.f}, 0, 0, 0); \
        if (kq >= 2) oin = __builtin_amdgcn_mfma_f32_16x16x32_bf16(F.a1, F.vb[1], oin, 0, 0, 0); \
        { u32x4v sw; sw.x = pk2(S[0][0], S[0][1]); sw.y = pk2(S[0][2], S[0][3]); sw.z = pk2(S[1][0], S[1][1]); sw.w = pk2(S[1][2], S[1][3]); \
          const bf16x8 sb = __builtin_bit_cast(bf16x8, sw); \
          _Pragma("unroll") for (int tb = 0; tb < 4; ++tb) { u32x4v aw; aw.x = (unsigned)F.q[tb][0]; aw.y = (unsigned)(F.q[tb][0] >> 32); aw.z = (unsigned)F.q[tb][1]; aw.w = (unsigned)(F.q[tb][1] >> 32); \
              const f32x4 po = __builtin_amdgcn_mfma_f32_16x16x32_bf16(__builtin_bit_cast(bf16x8, aw), sb, (f32x4){0.f, 0.f, 0.f, 0.f}, 0, 0, 0); \
              *(LAS f32x4*)(rb + ((kq * 4 + tb) * 64 + l) * 4) = po; } } \
        _Pragma("unroll") for (int i = 0; i < 2; ++i) { S[i] = S[i] * F.dc[i]; \
            _Pragma("unroll") for (int ks = 0; ks < 2; ++ks) S[i] = __builtin_amdgcn_mfma_f32_16x16x32_bf16(F.ks[i][ks], F.vb[ks], S[i], 0, 0, 0); } \
        asm volatile("s_waitcnt lgkmcnt(0)" ::: "memory"); __builtin_amdgcn_s_barrier(); asm volatile("" ::: "memory"); \
        { f32x4 o = oin; \
          _Pragma("unroll") for (int k2 = 0; k2 < 4; ++k2) o = o + *(const LAS f32x4*)(rb + ((k2 * 4 + kq) * 64 + l) * 4); \
          const size_t orow = (size_t)b * SEQLEN + (c_) * 64 + 16 * kq + 4 * g; \
          _Pragma("unroll") for (int r = 0; r < 4; ++r) OF[(orow + r) * 1024 + col] = o[r]; } } while (0)
    constexpr int JOB = NH == 4 ? 1 : 2;
    f32x4 bgv[4]; int bgi = -1, bgit = 0;
    for (int t0 = C.vcu; t0 < NTASK / 2; t0 += C.G, ++bgit) {
        const int task = gi * (NTASK / 2) + t0;
        const int cb = task % NCB, bh = task / NCB, b = bh / NH, h = bh % NH;
        const int col = h * DV + cb * 16 + m;
        f32x4 S[2];
        S[0] = (f32x4){0.f, 0.f, 0.f, 0.f}; S[1] = S[0];
        RecFrag FA, FB;
        REC_LOAD(FA, 0);
#pragma unroll 1
        for (int c = 0; c < 32; c += 2) { REC_BODY(FA, FB, c); REC_BODY(FB, FA, c + 1); }
        asm volatile("s_waitcnt lgkmcnt(0)" ::: "memory"); __builtin_amdgcn_s_barrier(); asm volatile("" ::: "memory");
    }
    if (BGQ) {
        for (int bgn = bgit * 32 * C.NGW + C.gw; bgi < BGQ_ROWS; bgn += C.NGW) { bgq_step<JOB>(C, bgi, bgn, bgv); bgi = bgn; }
    }
#undef REC_LOAD
#undef REC_BODY
}

template <int DV>
__device__ __forceinline__ void rec_norm_gate(const Ctx& C, const float* gain, const bf16* gate) {
    const float* OF = (const float*)(C.ws + WS_OF); bf16* OB = (bf16*)(C.ws + WS_OB);
    for (int tok = C.gw; tok < NTOK; tok += C.NGW) {
        const GAS f32x4* xr = (const GAS f32x4*)(OF + (size_t)tok * 1024) + C.lane;
        const GAS f32x4* gr = (const GAS f32x4*)gain + C.lane;
        const GAS unsigned long long* tr = (const GAS unsigned long long*)(gate + (size_t)tok * 1024) + C.lane;
        GAS unsigned long long* o8 = (GAS unsigned long long*)(OB + (size_t)tok * 1024) + C.lane;
#pragma unroll
        for (int j = 0; j < 4; ++j) {
            const f32x4 v = xr[64 * j]; float ss = (v.x * v.x + v.y * v.y) + (v.z * v.z + v.w * v.w);
            if (DV == 256) ss = wave_sum(ss); else { DPP_SUM31(ss); const float s_lo = rdlane(ss, 31), s_hi = rdlane(ss, 63); ss = C.lane < 32 ? s_lo : s_hi; }
            const float r = rsqrtf(ss * (1.f / DV) + RMS_EPS);
            const f32x4 g = gr[64 * j]; const unsigned long long tw = tr[64 * j];
            const float t0 = bflo((unsigned)tw), t1 = bfhi((unsigned)tw), t2 = bflo((unsigned)(tw >> 32)), t3 = bfhi((unsigned)(tw >> 32));
            const float a0 = v.x * r * g.x * (t0 * sigmoid_f(t0)), a1 = v.y * r * g.y * (t1 * sigmoid_f(t1)), a2 = v.z * r * g.z * (t2 * sigmoid_f(t2)), a3 = v.w * r * g.w * (t3 * sigmoid_f(t3));
            o8[64 * j] = (unsigned long long)pk2(a0, a1) | ((unsigned long long)pk2(a2, a3) << 32);
        }
    }
}

#define CE_D(a, b) do { const unsigned mx_ = (a) > (b) ? (a) : (b); const unsigned mn_ = (a) > (b) ? (b) : (a); (a) = mx_; (b) = mn_; } while (0)
__device__ __forceinline__ void sort16_desc(unsigned (&a)[16]) {
#pragma unroll
    for (int k = 2; k <= 16; k <<= 1)
#pragma unroll
        for (int j = k >> 1; j > 0; j >>= 1)
#pragma unroll
            for (int i = 0; i < 16; ++i) { const int l = i ^ j; if (l > i) { if ((i & k) == 0) CE_D(a[i], a[l]); else CE_D(a[l], a[i]); } }
}
__device__ __forceinline__ void merge_top16(unsigned (&a)[16], const unsigned (&b)[16]) {
#pragma unroll
    for (int i = 0; i < 16; ++i) a[i] = a[i] > b[15 - i] ? a[i] : b[15 - i];
#pragma unroll
    for (int j = 8; j > 0; j >>= 1)
#pragma unroll
        for (int i = 0; i < 16; ++i) { const int l = i ^ j; if (l > i) CE_D(a[i], a[l]); }
}
__device__ __forceinline__ void merge_quad(unsigned (&a)[16], int lane) {
    unsigned p[16];
#pragma unroll
    for (int i = 0; i < 16; ++i) p[i] = (unsigned)__builtin_amdgcn_ds_bpermute((lane ^ 16) << 2, (int)a[i]);
    merge_top16(a, p);
#pragma unroll
    for (int i = 0; i < 16; ++i) p[i] = (unsigned)__builtin_amdgcn_ds_bpermute((lane ^ 32) << 2, (int)a[i]);
    merge_top16(a, p);
}
__device__ __forceinline__ unsigned mono_key(float f) { const unsigned u = __float_as_uint(f); return (u & 0x80000000u) ? ~u : (u | 0x80000000u); }
__device__ __forceinline__ float mono_inv(unsigned k) { return __uint_as_float((k & 0x80000000u) ? (k ^ 0x80000000u) : ~k); }
__constant__ __attribute__((aligned(16))) unsigned char PEER_CAND[64] = {0, 1, 2, 3, 4, 5, 6, 7, 8, 9, 10, 11, 12, 13, 14, 15, 16, 17, 18, 19, 20, 21, 22, 23, 32, 33, 34, 35, 36, 64, 65, 66, 48, 49, 50, 51, 80, 81, 96, 97, 112, 113, 128, 144, 160, 176, 192, 208, 224, 240, 255, 255, 255, 255, 255, 255, 255, 255, 255, 255, 255, 255, 255, 255};
__device__ __forceinline__ void peer_topk_task(const Ctx& C, int layer, int tok0, int head, int trow0, LAS int* lexp, LAS float* lgate) {
    typedef _Float16 h8 __attribute__((ext_vector_type(8)));
    const _Float16* SC = (const _Float16*)(C.ws + WS_Q2);
    LAS unsigned* L0 = (LAS unsigned*)(C.lds + C.wave * 2048);
    LAS unsigned* L1 = L0 + 256;
    {
        int l = C.lane; asm volatile("" : "+v"(l));
        const int m = l & 15, g = l >> 4;
        unsigned cand_w[4];
#pragma unroll
        for (int c = 0; c < 4; ++c) cand_w[c] = ((const unsigned*)PEER_CAND)[g * 4 + c];
        unsigned top[2][16];
#pragma unroll
        for (int p = 0; p < 2; ++p) {
            const _Float16* sp = SC + (size_t)(tok0 + m) * 2048 + head * 256 + p * 128 + 32 * g;
            h8 hv[4];
#pragma unroll
            for (int q = 0; q < 4; ++q) hv[q] = *(const h8*)(sp + 8 * q);
            unsigned hi16[16];
#pragma unroll
            for (int q = 0; q < 4; ++q)
#pragma unroll
                for (int j = 0; j < 8; ++j) { const int i = 8 * q + j; const unsigned key = (mono_key((float)hv[q][j]) & ~0x7fu) | (unsigned)(127 - (32 * g + i));
                    if (i < 16) top[p][i] = key; else hi16[i - 16] = key; }
            sort16_desc(top[p]); sort16_desc(hi16); merge_top16(top[p], hi16);
            merge_quad(top[p], l);
        }
        if (g == 0) {
#pragma unroll
            for (int i = 0; i < 16; i += 4) { *(LAS u32x4v*)(L0 + m * 16 + i) = (u32x4v){top[0][i], top[0][i + 1], top[0][i + 2], top[0][i + 3]}; *(LAS u32x4v*)(L1 + m * 16 + i) = (u32x4v){top[1][i], top[1][i + 1], top[1][i + 2], top[1][i + 3]}; }
        }
        asm volatile("s_waitcnt lgkmcnt(0)" ::: "memory"); __builtin_amdgcn_wave_barrier();
        unsigned cd[16];
#pragma unroll
        for (int c = 0; c < 16; ++c) {
            const unsigned code = (cand_w[c >> 2] >> (8 * (c & 3))) & 0xffu, ci = (code >> 4) & 15u, cj = code & 15u;
            const float v = mono_inv(L0[m * 16 + ci]) + mono_inv(L1[m * 16 + cj]);
            cd[c] = code == 255u ? 0u : ((mono_key(v) & ~0xffu) | (255u - code));
        }
        sort16_desc(cd); merge_quad(cd, l);
        if (g == 0) {
            float best[16]; int ex[16]; float sum = 0.f;
#pragma unroll
            for (int r = 0; r < 16; ++r) { const unsigned pos = 255u - (cd[r] & 0xffu), pi = pos >> 4, pj = pos & 15u;
                ex[r] = (int)((127u - (L0[m * 16 + pi] & 0x7fu)) * 128u + (127u - (L1[m * 16 + pj] & 0x7fu))); best[r] = mono_inv(cd[r]); }
            const float bmax = best[0];
#pragma unroll
            for (int r = 0; r < 16; ++r) { best[r] = __expf(best[r] - bmax); sum += best[r]; }
            const float inv = 1.f / sum;
            const int ob = (trow0 + m) * 128 + head * 16;
#pragma unroll
            for (int r = 0; r < 16; r += 4) { *(LAS u32x4v*)(lexp + ob + r) = (u32x4v){(unsigned)ex[r], (unsigned)ex[r + 1], (unsigned)ex[r + 2], (unsigned)ex[r + 3]};
                *(LAS f32x4*)(lgate + ob + r) = (f32x4){best[r] * inv, best[r + 1] * inv, best[r + 2] * inv, best[r + 3] * inv}; }
        }
        asm volatile("s_waitcnt lgkmcnt(0)" ::: "memory"); __builtin_amdgcn_wave_barrier();
    }
}
typedef float f32x2v __attribute__((ext_vector_type(2)));
template <bool DRY>
__device__ __forceinline__ void peer_gather_token(const Ctx& C, int layer, int tok, const LAS int* lexp_row, const LAS float* lgate_row) {
    const unsigned char* U = C.ws + WS_U + (size_t)layer * 16384 * 1024; const unsigned char* V = C.ws + WS_V + (size_t)layer * 16384 * 1024;
    const float* SU = (const float*)(C.ws + WS_SU) + layer * 16384; const float* SV = (const float*)(C.ws + WS_SV) + layer * 16384;
    const float* gf = C.in[2] + layer * 1024; const float* gn = C.in[1] + (layer + 1) * 1024;
    const int l = C.lane; constexpr int GS = 8;
    {
        const float* hrow = C.out + (size_t)tok * 1024; float* hout = (DRY ? (float*)(C.ws + WS_OF) : C.out) + (size_t)tok * 1024;
        float hv[16], x[16];
#pragma unroll
        for (int i = 0; i < 4; ++i) { const f32x4 a = *(const GAS f32x4*)(hrow + 16 * l + 4 * i); hv[4 * i] = a.x; hv[4 * i + 1] = a.y; hv[4 * i + 2] = a.z; hv[4 * i + 3] = a.w; }
        float ss = 0.f;
#pragma unroll
        for (int i = 0; i < 16; ++i) ss += hv[i] * hv[i];
        const float r = rsqrtf(wave_sum(ss) * (1.f / 1024.f) + RMS_EPS);
#pragma unroll
        for (int i = 0; i < 4; ++i) { const f32x4 a = *(const GAS f32x4*)(gf + 16 * l + 4 * i); x[4 * i] = hv[4 * i] * r * a.x; x[4 * i + 1] = hv[4 * i + 1] * r * a.y; x[4 * i + 2] = hv[4 * i + 2] * r * a.z; x[4 * i + 3] = hv[4 * i + 3] * r * a.w; }
        int eid[2]; float gt[2];
        eid[0] = lexp_row[l]; eid[1] = lexp_row[64 + l]; gt[0] = lgate_row[l]; gt[1] = lgate_row[64 + l];
        const float su0 = SU[eid[0]], su1 = SU[eid[1]], sv0 = SV[eid[0]], sv1 = SV[eid[1]];
        float H[2] = {0.f, 0.f};
#ifndef MK_HOTG
#define MK_HOTG 0
#endif
#define GATHER_LOAD(T, buf, half, e0) _Pragma("unroll") for (int j = 0; j < GS; ++j) { int ex = __builtin_amdgcn_readlane(eid[half], (e0) + j); if (DRY && MK_HOTG) ex &= 255; buf[j] = *(const GAS v4u*)(T + (size_t)ex * 1024 + 16 * l); }
#define GATHER_DOT(buf, half, e0) _Pragma("unroll") for (int j = 0; j < GS; ++j) { float d = 0.f; \
            _Pragma("unroll") for (int q = 0; q < 4; ++q) { const f32x2v lo = __builtin_amdgcn_cvt_pk_f32_fp8((int)buf[j][q], false), hi = __builtin_amdgcn_cvt_pk_f32_fp8((int)buf[j][q], true); \
                d += x[4 * q] * lo.x; d += x[4 * q + 1] * lo.y; d += x[4 * q + 2] * hi.x; d += x[4 * q + 3] * hi.y; } \
            DPP_SUM63(d); const float sd = __builtin_bit_cast(float, __builtin_amdgcn_readlane(__builtin_bit_cast(int, d), 63)); \
            H[half] = (l == (e0) + j) ? sd : H[half]; }
        {
            v4u bA[GS], bB[GS];
#pragma unroll
            for (int half = 0; half < 2; ++half) {
                GATHER_LOAD(U, bA, half, 0);
#pragma unroll 1
                for (int e0 = 0; e0 < 64; e0 += 2 * GS) {
                    GATHER_LOAD(U, bB, half, e0 + GS);
                    GATHER_DOT(bA, half, e0);
                    if (e0 + 2 * GS < 64) { GATHER_LOAD(U, bA, half, e0 + 2 * GS); }
                    GATHER_DOT(bB, half, e0 + GS);
                }
            }
        }
        float W[2];
        { const pg8::f32x2 gl = pg8::gelu_pk((pg8::f32x2){H[0] * su0, H[1] * su1}); W[0] = gl.x * gt[0] * sv0; W[1] = gl.y * gt[1] * sv1; }
        float y[16];
#pragma unroll
        for (int i = 0; i < 16; ++i) y[i] = 0.f;
#define GATHER_AXPY(buf, half, e0) _Pragma("unroll") for (int j = 0; j < GS; ++j) { const float w = __builtin_bit_cast(float, __builtin_amdgcn_readlane(__builtin_bit_cast(int, W[half]), (e0) + j)); \
            _Pragma("unroll") for (int q = 0; q < 4; ++q) { const f32x2v lo = __builtin_amdgcn_cvt_pk_f32_fp8((int)buf[j][q], false), hi = __builtin_amdgcn_cvt_pk_f32_fp8((int)buf[j][q], true); \
                y[4 * q] += w * lo.x; y[4 * q + 1] += w * lo.y; y[4 * q + 2] += w * hi.x; y[4 * q + 3] += w * hi.y; } }
        {
            v4u bA[GS], bB[GS];
#pragma unroll
            for (int half = 0; half < 2; ++half) {
                GATHER_LOAD(V, bA, half, 0);
#pragma unroll 1
                for (int e0 = 0; e0 < 64; e0 += 2 * GS) {
                    GATHER_LOAD(V, bB, half, e0 + GS);
                    GATHER_AXPY(bA, half, e0);
                    if (e0 + 2 * GS < 64) { GATHER_LOAD(V, bA, half, e0 + 2 * GS); }
                    GATHER_AXPY(bB, half, e0 + GS);
                }
            }
        }
#undef GATHER_LOAD
#undef GATHER_DOT
#undef GATHER_AXPY
        float s2 = 0.f;
#pragma unroll
        for (int i = 0; i < 16; ++i) { hv[i] += y[i]; s2 += hv[i] * hv[i]; }
#pragma unroll
        for (int i = 0; i < 4; ++i) *(GAS f32x4*)(hout + 16 * l + 4 * i) = (f32x4){hv[4 * i], hv[4 * i + 1], hv[4 * i + 2], hv[4 * i + 3]};
        if (layer < DEPTH - 1) {
            const float r2 = rsqrtf(wave_sum(s2) * (1.f / 1024.f) + RMS_EPS);
            bf16* xo = (bf16*)(C.ws + (DRY ? WS_GLOG : WS_XN)) + (size_t)tok * 1024 + 16 * l;
            unsigned pw[8];
#pragma unroll
            for (int i = 0; i < 4; ++i) { const f32x4 a = *(const GAS f32x4*)(gn + 16 * l + 4 * i); pw[2 * i] = pk2(hv[4 * i] * r2 * a.x, hv[4 * i + 1] * r2 * a.y); pw[2 * i + 1] = pk2(hv[4 * i + 2] * r2 * a.z, hv[4 * i + 3] * r2 * a.w); }
            *(GAS v4u*)xo = (v4u){pw[0], pw[1], pw[2], pw[3]}; *(GAS v4u*)(xo + 8) = (v4u){pw[4], pw[5], pw[6], pw[7]};
        }
    }
}

__device__ __forceinline__ void wave_lds_sync() { asm volatile("s_waitcnt lgkmcnt(0)" ::: "memory"); __builtin_amdgcn_wave_barrier(); }
#define DEC16(B, rv) do { _Pragma("unroll") for (int q_ = 0; q_ < 4; ++q_) { const f32x2v lo_ = __builtin_amdgcn_cvt_pk_f32_fp8((int)B[q_], false), hi_ = __builtin_amdgcn_cvt_pk_f32_fp8((int)B[q_], true); \
        rv[4 * q_] = lo_.x; rv[4 * q_ + 1] = lo_.y; rv[4 * q_ + 2] = hi_.x; rv[4 * q_ + 3] = hi_.y; } } while (0)
template <bool DRY>
__device__ __forceinline__ void peer_sweep(const Ctx& C, int layer, int tokw, LAS int* lexp_w, const LAS float* lgate_w, LAS unsigned* sorted_w, LAS unsigned* hist_w) {
    const unsigned char* U = C.ws + WS_U + (size_t)layer * 16384 * 1024; const unsigned char* V = C.ws + WS_V + (size_t)layer * 16384 * 1024;
    const float* SU = (const float*)(C.ws + WS_SU) + layer * 16384; const float* SV = (const float*)(C.ws + WS_SV) + layer * 16384;
    const float* gf = C.in[2] + layer * 1024; const float* gn = C.in[1] + (layer + 1) * 1024;
    int l = C.lane; asm volatile("" : "+v"(l));
    LAS float* hbuf = (LAS float*)lexp_w;
    hist_w[l] = 0u; hist_w[64 + l] = 0u;
    wave_lds_sync();
    {
        unsigned ev[16], pos[16];
#pragma unroll
        for (int r = 0; r < 16; ++r) { ev[r] = (unsigned)lexp_w[l + 64 * r]; pos[r] = __hip_atomic_fetch_add(hist_w + (ev[r] >> 7), 1u, __ATOMIC_RELAXED, __HIP_MEMORY_SCOPE_WORKGROUP); }
        wave_lds_sync();
        const unsigned ha = hist_w[2 * l], hb = hist_w[2 * l + 1], hs = ha + hb; unsigned inc = hs;
#pragma unroll
        for (int o = 1; o < 64; o <<= 1) { const unsigned up = (unsigned)__builtin_amdgcn_ds_bpermute((l - o) << 2, (int)inc); if (l >= o) inc += up; }
        hist_w[128 + 2 * l] = inc - hs; hist_w[128 + 2 * l + 1] = inc - hs + ha;
        wave_lds_sync();
#pragma unroll
        for (int r = 0; r < 16; ++r) sorted_w[hist_w[128 + (ev[r] >> 7)] + pos[r]] = (ev[r] << 10) | (unsigned)(l + 64 * r);
        wave_lds_sync();
    }
    asm volatile("" : "+v"(l));
    unsigned x[8][8];
#pragma unroll
    for (int t = 0; t < 8; ++t) {
        const float* hrow = C.out + (size_t)(tokw + t) * 1024;
        f32x4 hq[4]; float ss = 0.f;
#pragma unroll
        for (int i = 0; i < 4; ++i) { hq[i] = *(const GAS f32x4*)(hrow + 16 * l + 4 * i); ss += (hq[i].x * hq[i].x + hq[i].y * hq[i].y) + (hq[i].z * hq[i].z + hq[i].w * hq[i].w); }
        const float r = rsqrtf(wave_sum(ss) * (1.f / 1024.f) + RMS_EPS);
#pragma unroll
        for (int i = 0; i < 4; ++i) { const f32x4 a = *(const GAS f32x4*)(gf + 16 * l + 4 * i); x[t][2 * i] = pk2(hq[i].x * r * a.x, hq[i].y * r * a.y); x[t][2 * i + 1] = pk2(hq[i].z * r * a.z, hq[i].w * r * a.w); }
    }
    asm volatile("" ::: "memory");
    asm volatile("" : "+v"(l));
#ifndef MK_HOT
#define MK_HOT 0
#endif
#define SWEEP_LOAD(T, j, item) do { const unsigned char* p_ = T + (size_t)((DRY && MK_HOT) ? (((item) >> 10) & 255u) : ((item) >> 10)) * 1024 + 16 * l; \
        asm volatile("global_load_dwordx4 %0, %1, off" : "=v"(buf[j]) : "v"(p_) : "memory"); } while (0)
#define SWEEP_WAIT(j) asm volatile("s_waitcnt vmcnt(7)" : "+v"(buf[j]) :: "memory")
    {
        v4u buf[8];
        unsigned icur = sorted_w[l];
#pragma unroll
        for (int j = 0; j < 8; ++j) SWEEP_LOAD(U, j, (unsigned)__builtin_amdgcn_readlane((int)icur, j));
#pragma unroll 1
        for (int q = 0; q < 16; ++q) {
            const unsigned inxt = sorted_w[((q + 1) & 15) * 64 + l];
#pragma unroll 1
            for (int g = 0; g < 8; ++g) {
                const unsigned isrc = g == 7 ? inxt : icur;
#pragma unroll
                for (int j = 0; j < 8; ++j) {
                    const unsigned item = (unsigned)__builtin_amdgcn_readlane((int)icur, 8 * g + j);
                    SWEEP_WAIT(j);
                    unsigned rp[8];
#pragma unroll
                    for (int q_ = 0; q_ < 4; ++q_) { const f32x2v lo_ = __builtin_amdgcn_cvt_pk_f32_fp8((int)buf[j][q_], false), hi_ = __builtin_amdgcn_cvt_pk_f32_fp8((int)buf[j][q_], true);
                        rp[2 * q_] = pg8::cvt_pk_bf16(lo_.x, lo_.y); rp[2 * q_ + 1] = pg8::cvt_pk_bf16(hi_.x, hi_.y); }
                    float d = 0.f;
#define UDOT(T) case T: { _Pragma("unroll") for (int i = 0; i < 8; ++i) d = dot2bf(rp[i], x[T][i], d); } break;
                    switch ((item >> 7) & 7u) { UDOT(0) UDOT(1) UDOT(2) UDOT(3) UDOT(4) UDOT(5) UDOT(6) default: { _Pragma("unroll") for (int i = 0; i < 8; ++i) d = dot2bf(rp[i], x[7][i], d); } break; }
#undef UDOT
                    DPP_SUM63(d);
                    if (l == 63) hbuf[q * 64 + g * 8 + j] = d;
                    SWEEP_LOAD(U, j, (unsigned)__builtin_amdgcn_readlane((int)isrc, (8 * g + j + 8) & 63));
                }
            }
            icur = inxt;
        }
        asm volatile("s_waitcnt vmcnt(0)" : "+v"(buf[0]), "+v"(buf[1]), "+v"(buf[2]), "+v"(buf[3]), "+v"(buf[4]), "+v"(buf[5]), "+v"(buf[6]), "+v"(buf[7]) :: "memory");
    }
    wave_lds_sync();
    asm volatile("" : "+v"(l));
#pragma unroll
    for (int r = 0; r < 16; r += 2) {
        const unsigned i0 = sorted_w[l + 64 * r], i1 = sorted_w[l + 64 * (r + 1)];
        const float h0 = hbuf[l + 64 * r] * SU[i0 >> 10], h1 = hbuf[l + 64 * (r + 1)] * SU[i1 >> 10];
        const pg8::f32x2 gl = pg8::gelu_pk((pg8::f32x2){h0, h1});
        hbuf[l + 64 * r] = gl.x * lgate_w[i0 & 1023u] * SV[i0 >> 10]; hbuf[l + 64 * (r + 1)] = gl.y * lgate_w[i1 & 1023u] * SV[i1 >> 10];
    }
    wave_lds_sync();
    asm volatile("" : "+v"(l));
    float y[8][16];
#pragma unroll
    for (int t = 0; t < 8; ++t)
#pragma unroll
        for (int i = 0; i < 16; ++i) y[t][i] = 0.f;
    {
        v4u buf[8]; float wq[8];
        unsigned icur = sorted_w[l];
#pragma unroll
        for (int j = 0; j < 8; ++j) { SWEEP_LOAD(V, j, (unsigned)__builtin_amdgcn_readlane((int)icur, j)); wq[j] = hbuf[j]; }
#pragma unroll 1
        for (int q = 0; q < 16; ++q) {
            const unsigned inxt = sorted_w[((q + 1) & 15) * 64 + l];
#pragma unroll 1
            for (int g = 0; g < 8; ++g) {
                const unsigned isrc = g == 7 ? inxt : icur;
#pragma unroll
                for (int j = 0; j < 8; ++j) {
                    const unsigned item = (unsigned)__builtin_amdgcn_readlane((int)icur, 8 * g + j);
                    SWEEP_WAIT(j);
                    const float w = wq[j];
#define VAXPY(T) { _Pragma("unroll") for (int q_ = 0; q_ < 4; ++q_) { const f32x2v lo_ = __builtin_amdgcn_cvt_pk_f32_fp8((int)buf[j][q_], false), hi_ = __builtin_amdgcn_cvt_pk_f32_fp8((int)buf[j][q_], true); \
                        y[T][4 * q_] += w * lo_.x; y[T][4 * q_ + 1] += w * lo_.y; y[T][4 * q_ + 2] += w * hi_.x; y[T][4 * q_ + 3] += w * hi_.y; } }
                    switch ((item >> 7) & 7u) { case 0: VAXPY(0) break; case 1: VAXPY(1) break; case 2: VAXPY(2) break; case 3: VAXPY(3) break; case 4: VAXPY(4) break; case 5: VAXPY(5) break; case 6: VAXPY(6) break; default: VAXPY(7) break; }
#undef VAXPY
                    SWEEP_LOAD(V, j, (unsigned)__builtin_amdgcn_readlane((int)isrc, (8 * g + j + 8) & 63));
                    wq[j] = hbuf[(q * 64 + g * 8 + j + 8) & 1023];
                }
            }
            icur = inxt;
        }
        asm volatile("s_waitcnt vmcnt(0)" : "+v"(buf[0]), "+v"(buf[1]), "+v"(buf[2]), "+v"(buf[3]), "+v"(buf[4]), "+v"(buf[5]), "+v"(buf[6]), "+v"(buf[7]) :: "memory");
    }
#undef SWEEP_LOAD
#undef SWEEP_WAIT
    asm volatile("" : "+v"(l));
#pragma unroll
    for (int t = 0; t < 8; ++t) {
        const float* hrow = C.out + (size_t)(tokw + t) * 1024; float* hout = (DRY ? (float*)(C.ws + WS_OF) : C.out) + (size_t)(tokw + t) * 1024;
        float hv[16]; float s2 = 0.f;
#pragma unroll
        for (int i = 0; i < 4; ++i) { const f32x4 a = *(const GAS f32x4*)(hrow + 16 * l + 4 * i); hv[4 * i] = a.x + y[t][4 * i]; hv[4 * i + 1] = a.y + y[t][4 * i + 1]; hv[4 * i + 2] = a.z + y[t][4 * i + 2]; hv[4 * i + 3] = a.w + y[t][4 * i + 3]; }
#pragma unroll
        for (int i = 0; i < 16; ++i) s2 += hv[i] * hv[i];
#pragma unroll
        for (int i = 0; i < 4; ++i) *(GAS f32x4*)(hout + 16 * l + 4 * i) = (f32x4){hv[4 * i], hv[4 * i + 1], hv[4 * i + 2], hv[4 * i + 3]};
        if (layer < DEPTH - 1) {
            const float r2 = rsqrtf(wave_sum(s2) * (1.f / 1024.f) + RMS_EPS);
            bf16* xo = (bf16*)(C.ws + (DRY ? WS_GLOG : WS_XN)) + (size_t)(tokw + t) * 1024 + 16 * l;
            unsigned pw[8];
#pragma unroll
            for (int i = 0; i < 4; ++i) { const f32x4 a = *(const GAS f32x4*)(gn + 16 * l + 4 * i); pw[2 * i] = pk2(hv[4 * i] * r2 * a.x, hv[4 * i + 1] * r2 * a.y); pw[2 * i + 1] = pk2(hv[4 * i + 2] * r2 * a.z, hv[4 * i + 3] * r2 * a.w); }
            *(GAS v4u*)xo = (v4u){pw[0], pw[1], pw[2], pw[3]}; *(GAS v4u*)(xo + 8) = (v4u){pw[4], pw[5], pw[6], pw[7]};
        }
    }
}
#define GRP8_SUM(v) do { v = DPP_ADD(v, 0xB1, 0xf, 0xf); v = DPP_ADD(v, 0x4E, 0xf, 0xf); v = DPP_ADD(v, 0x141, 0xf, 0xf); } while (0)
template <bool DRY>
__device__ __forceinline__ void peer_rounds(const Ctx& C, int layer, int tokw, LAS int* lexp_w, const LAS float* lgate_w, LAS unsigned* sorted_w, LAS unsigned* hist_w) {
    const unsigned char* U = C.ws + WS_U + (size_t)layer * 16384 * 1024; const unsigned char* V = C.ws + WS_V + (size_t)layer * 16384 * 1024;
    const float* SU = (const float*)(C.ws + WS_SU) + layer * 16384; const float* SV = (const float*)(C.ws + WS_SV) + layer * 16384;
    const float* gf = C.in[2] + layer * 1024; const float* gn = C.in[1] + (layer + 1) * 1024;
    int l = C.lane; asm volatile("" : "+v"(l));
    LAS float* hbuf = (LAS float*)lexp_w;
    {
        const int t = l >> 3, s = l & 7;
#pragma unroll
        for (int k = 0; k < 8; ++k) hist_w[l + 64 * k] = 0u;
        wave_lds_sync();
        unsigned ev[16], pos[16];
#pragma unroll
        for (int k = 0; k < 16; ++k) { ev[k] = (unsigned)lexp_w[t * 128 + s + 8 * k]; pos[k] = __hip_atomic_fetch_add(hist_w + t * 64 + (ev[k] >> 8), 1u, __ATOMIC_RELAXED, __HIP_MEMORY_SCOPE_WORKGROUP); }
        wave_lds_sync();
        unsigned cnt[8], run = 0u;
#pragma unroll
        for (int j = 0; j < 8; ++j) { cnt[j] = hist_w[t * 64 + 8 * s + j]; run += cnt[j]; }
        unsigned inc = run;
#pragma unroll
        for (int o = 1; o < 8; o <<= 1) { const unsigned up = (unsigned)__builtin_amdgcn_ds_bpermute((l - o) << 2, (int)inc); if (s >= o) inc += up; }
        unsigned off = inc - run;
        wave_lds_sync();
#pragma unroll
        for (int j = 0; j < 8; ++j) { hist_w[t * 64 + 8 * s + j] = off; off += cnt[j]; }
        wave_lds_sync();
#pragma unroll
        for (int k = 0; k < 16; ++k) sorted_w[t * 128 + hist_w[t * 64 + (ev[k] >> 8)] + pos[k]] = (ev[k] << 7) | (unsigned)(s + 8 * k);
        wave_lds_sync();
    }
    asm volatile("" : "+v"(l));
    unsigned xp[8][8];
    {
        const int t = l >> 3, s = l & 7;
        const float* hrow = C.out + (size_t)(tokw + t) * 1024 + 16 * s;
        f32x4 hq[8][4]; float ss = 0.f;
#pragma unroll
        for (int i = 0; i < 8; ++i)
#pragma unroll
            for (int q = 0; q < 4; ++q) { hq[i][q] = *(const GAS f32x4*)(hrow + 128 * i + 4 * q); ss += (hq[i][q].x * hq[i][q].x + hq[i][q].y * hq[i][q].y) + (hq[i][q].z * hq[i][q].z + hq[i][q].w * hq[i][q].w); }
        GRP8_SUM(ss);
        const float r = rsqrtf(ss * (1.f / 1024.f) + RMS_EPS);
#pragma unroll
        for (int i = 0; i < 8; ++i)
#pragma unroll
            for (int q = 0; q < 4; ++q) { const f32x4 a = *(const GAS f32x4*)(gf + 16 * s + 128 * i + 4 * q); xp[i][2 * q] = pk2(hq[i][q].x * r * a.x, hq[i][q].y * r * a.y); xp[i][2 * q + 1] = pk2(hq[i][q].z * r * a.z, hq[i][q].w * r * a.w); }
    }
    asm volatile("" : "+v"(l));
#define RND_LOAD(T, buf, item) do { const unsigned char* p_ = T + (size_t)((DRY && MK_HOT) ? (((item) >> 7) & 255u) : ((item) >> 7)) * 1024 + 16 * (l & 7); \
        _Pragma("unroll") for (int i = 0; i < 8; ++i) buf[i] = *(const GAS v4u*)(p_ + 128 * i); } while (0)
    {
        const int t = l >> 3, s = l & 7;
        const LAS unsigned* srt = sorted_w + t * 128;
        v4u bA[8], bB[8];
#define RND_DOT(buf, r_) do { float d = 0.f; \
            _Pragma("unroll") for (int i = 0; i < 8; ++i) { asm volatile("" : "+v"(buf[i])); _Pragma("unroll") for (int q = 0; q < 4; ++q) { \
                const f32x2v lo_ = __builtin_amdgcn_cvt_pk_f32_fp8((int)buf[i][q], false), hi_ = __builtin_amdgcn_cvt_pk_f32_fp8((int)buf[i][q], true); \
                d = dot2bf(pg8::cvt_pk_bf16(lo_.x, lo_.y), xp[i][2 * q], d); d = dot2bf(pg8::cvt_pk_bf16(hi_.x, hi_.y), xp[i][2 * q + 1], d); } } \
            GRP8_SUM(d); if (s == 0) hbuf[t * 128 + (r_)] = d; } while (0)
        RND_LOAD(U, bA, srt[0]);
#pragma unroll 1
        for (int r = 0; r < 128; r += 2) {
            RND_LOAD(U, bB, srt[r + 1]);
            RND_DOT(bA, r);
            RND_LOAD(U, bA, srt[(r + 2) & 127]);
            RND_DOT(bB, r + 1);
        }
#undef RND_DOT
    }
    wave_lds_sync();
    asm volatile("" : "+v"(l));
    {
        const int t = l >> 3, s = l & 7;
#pragma unroll
        for (int k = 0; k < 16; k += 2) {
            const int r0 = t * 128 + s + 8 * k, r1 = r0 + 8;
            const unsigned i0 = sorted_w[r0], i1 = sorted_w[r1];
            const float h0 = hbuf[r0] * SU[i0 >> 7], h1 = hbuf[r1] * SU[i1 >> 7];
            const pg8::f32x2 gl = pg8::gelu_pk((pg8::f32x2){h0, h1});
            hbuf[r0] = gl.x * lgate_w[t * 128 + (i0 & 127u)] * SV[i0 >> 7]; hbuf[r1] = gl.y * lgate_w[t * 128 + (i1 & 127u)] * SV[i1 >> 7];
        }
    }
    wave_lds_sync();
    asm volatile("" : "+v"(l));
    f32x2v y2[8][8];
#pragma unroll
    for (int i = 0; i < 8; ++i)
#pragma unroll
        for (int j = 0; j < 8; ++j) y2[i][j] = (f32x2v){0.f, 0.f};
    {
        const int t = l >> 3;
        const LAS unsigned* srt = sorted_w + t * 128; const LAS float* wv = hbuf + t * 128;
        v4u bA[8], bB[8];
#define RND_AXPY(buf, r_) do { const float w = wv[(r_)]; const f32x2v w2 = (f32x2v){w, w}; \
            _Pragma("unroll") for (int i = 0; i < 8; ++i) { asm volatile("" : "+v"(buf[i])); _Pragma("unroll") for (int q = 0; q < 4; ++q) { \
                const f32x2v lo_ = __builtin_amdgcn_cvt_pk_f32_fp8((int)buf[i][q], false), hi_ = __builtin_amdgcn_cvt_pk_f32_fp8((int)buf[i][q], true); \
                y2[i][2 * q] = w2 * lo_ + y2[i][2 * q]; y2[i][2 * q + 1] = w2 * hi_ + y2[i][2 * q + 1]; } } } while (0)
        RND_LOAD(V, bA, srt[0]);
#pragma unroll 1
        for (int r = 0; r < 128; r += 2) {
            RND_LOAD(V, bB, srt[r + 1]);
            RND_AXPY(bA, r);
            RND_LOAD(V, bA, srt[(r + 2) & 127]);
            RND_AXPY(bB, r + 1);
        }
#undef RND_AXPY
    }
#undef RND_LOAD
    asm volatile("" : "+v"(l));
    {
        const int t = l >> 3, s = l & 7;
        const float* hrow = C.out + (size_t)(tokw + t) * 1024 + 16 * s; float* hout = (DRY ? (float*)(C.ws + WS_OF) : C.out) + (size_t)(tokw + t) * 1024 + 16 * s;
        float s2 = 0.f;
#pragma unroll
        for (int i = 0; i < 8; ++i)
#pragma unroll
            for (int q = 0; q < 4; ++q) { const f32x4 a = *(const GAS f32x4*)(hrow + 128 * i + 4 * q);
                y2[i][2 * q].x += a.x; y2[i][2 * q].y += a.y; y2[i][2 * q + 1].x += a.z; y2[i][2 * q + 1].y += a.w;
                s2 += (y2[i][2 * q].x * y2[i][2 * q].x + y2[i][2 * q].y * y2[i][2 * q].y) + (y2[i][2 * q + 1].x * y2[i][2 * q + 1].x + y2[i][2 * q + 1].y * y2[i][2 * q + 1].y);
                *(GAS f32x4*)(hout + 128 * i + 4 * q) = (f32x4){y2[i][2 * q].x, y2[i][2 * q].y, y2[i][2 * q + 1].x, y2[i][2 * q + 1].y}; }
        if (layer < DEPTH - 1) {
            GRP8_SUM(s2);
            const float r2 = rsqrtf(s2 * (1.f / 1024.f) + RMS_EPS);
            bf16* xo = (bf16*)(C.ws + (DRY ? WS_GLOG : WS_XN)) + (size_t)(tokw + t) * 1024 + 16 * s; float am = 0.f;
#pragma unroll
            for (int i = 0; i < 8; ++i) { unsigned pw[8];
#pragma unroll
                for (int q = 0; q < 4; ++q) { const f32x4 a = *(const GAS f32x4*)(gn + 16 * s + 128 * i + 4 * q);
                    y2[i][2 * q].x *= r2 * a.x; y2[i][2 * q].y *= r2 * a.y; y2[i][2 * q + 1].x *= r2 * a.z; y2[i][2 * q + 1].y *= r2 * a.w;
                    am = fmaxf(fmaxf(am, fmaxf(fabsf(y2[i][2 * q].x), fabsf(y2[i][2 * q].y))), fmaxf(fabsf(y2[i][2 * q + 1].x), fabsf(y2[i][2 * q + 1].y)));
                    pw[2 * q] = pk2(y2[i][2 * q].x, y2[i][2 * q].y); pw[2 * q + 1] = pk2(y2[i][2 * q + 1].x, y2[i][2 * q + 1].y); }
                *(GAS v4u*)(xo + 128 * i) = (v4u){pw[0], pw[1], pw[2], pw[3]}; *(GAS v4u*)(xo + 128 * i + 8) = (v4u){pw[4], pw[5], pw[6], pw[7]}; }
            am = DPP_MAX(am, 0xB1, 0xf, 0xf); am = DPP_MAX(am, 0x4E, 0xf, 0xf); am = DPP_MAX(am, 0x141, 0xf, 0xf);
            const float qi = am > 0.f ? 127.f / am : 0.f;
            signed char* xq = (signed char*)(C.ws + (DRY ? WS_GLOG + 32 * MiB : WS_XN8)) + (size_t)(tokw + t) * 1024 + 16 * s;
#pragma unroll
            for (int i = 0; i < 8; ++i) { unsigned pq[4];
#pragma unroll
                for (int q = 0; q < 4; ++q) pq[q] = q8x4(y2[i][2 * q].x * qi, y2[i][2 * q].y * qi, y2[i][2 * q + 1].x * qi, y2[i][2 * q + 1].y * qi);
                *(GAS v4u*)(xq + 128 * i) = (v4u){pq[0], pq[1], pq[2], pq[3]}; }
            if (s == 0) *(GAS float*)((float*)(C.ws + (DRY ? WS_GLOG + 48 * MiB : WS_SX)) + tokw + t) = am * (1.f / 127.f);
        }
    }
}
#ifndef MK_SWEEP
#define MK_SWEEP 2
#endif
template <bool DRY>
__device__ __forceinline__ void peer_topk_gather(const Ctx& C, int layer) {
    LAS int* lexp = (LAS int*)(C.lds + 16384);
    LAS float* lgate = (LAS float*)(C.lds + 16384 + 32768);
    LAS unsigned* sorted = (LAS unsigned*)(C.lds + 16384 + 65536);
    for (int tb = C.vcu; tb < NTOK / 64; tb += C.G) {
#pragma unroll 1
        for (int q = 0; q < 4; ++q) peer_topk_task(C, layer, tb * 64 + (C.wave & 3) * 16, (C.wave >> 2) * 4 + q, (C.wave & 3) * 16, lexp, lgate);
        __syncthreads();
#if MK_SWEEP == 2
        peer_rounds<DRY>(C, layer, tb * 64 + C.wave * 8, lexp + C.wave * 1024, lgate + C.wave * 1024, sorted + C.wave * 1024, (LAS unsigned*)(C.lds + C.wave * 2048));
#elif MK_SWEEP == 1
        peer_sweep<DRY>(C, layer, tb * 64 + C.wave * 8, lexp + C.wave * 1024, lgate + C.wave * 1024, sorted + C.wave * 1024, (LAS unsigned*)(C.lds + C.wave * 1024));
#else
#pragma unroll 1
        for (int t = 0; t < 8; ++t) peer_gather_token<DRY>(C, layer, tb * 64 + C.wave * 8 + t, lexp + (C.wave * 8 + t) * 128, lgate + (C.wave * 8 + t) * 128);
#endif
        __syncthreads();
    }
}

#ifndef MK_SINGLE
#define MK_SINGLE 1
#endif
#ifndef MK_FASTGEMM
#define MK_FASTGEMM 1
#endif
constexpr int STEPS = 10, NPHASE = 1 + DEPTH * STEPS;
struct Args { const float* in[21]; float* out; unsigned char* ws; int ph_lo, ph_hi; };

template <int EPI>
__device__ __forceinline__ void do_gemm(const Ctx& C, const bf16* A, const bf16* Bt, int N, bf16* Ob, int ldc, int split, const float* rs_in, const float* base, float* outf, bf16* hg, const float* gain, float* rs_out) {
    pg8::Gemm g{A, Bt, NTOK, N, 1024}; pg8::StaticOrder S; S.init(NTOK, N, C.G, C.bx);
    if constexpr (EPI == 0) { pg8::EpiBf16R<false> E{Ob, ldc, split ? 1024 : 0, PSTRIDE, rs_in}; pg8::gemm_phase<pg8::EpiBf16R<false>, pg8::StaticOrder, true, true>(C.lds, g, S, E, C.tid); }
    else if constexpr (EPI == 2) { pg8::EpiBf16R<true> E{Ob, ldc, 0, PSTRIDE, rs_in}; pg8::gemm_phase<pg8::EpiBf16R<true>, pg8::StaticOrder, true, true>(C.lds, g, S, E, C.tid); }
    else if constexpr (EPI == 3) {
        pg8::Gemm g8{A, Bt, NTOK, N, 512}; pg8::EpiI8 E{Ob, PSTRIDE, rs_in, gain}; pg8::gemm_phase<pg8::EpiI8, pg8::StaticOrder, true, true>(C.lds, g8, S, E, C.tid); }
    else { pg8::EpiResNorm E{base, outf, hg, gain, rs_out}; pg8::gemm_phase<pg8::EpiResNorm, pg8::StaticOrder, true, true>(C.lds, g, S, E, C.tid); }
}

template <int STEP, int MIXER>
__device__ __forceinline__ void run_step(const Ctx& C, int layer) {
    const int jx = layer / 3;
    bf16* XN = (bf16*)(C.ws + WS_XN); bf16* P = (bf16*)(C.ws + WS_P); bf16* OB = (bf16*)(C.ws + WS_OB); bf16* Q2 = (bf16*)(C.ws + WS_Q2);
    if constexpr (STEP == 0) {
        const bf16* Wt = MIXER == 0 ? (const bf16*)(C.ws + WS_FOXWIN + (size_t)jx * 8 * MiB) : MIXER == 1 ? (const bf16*)(C.ws + WS_GLAWIN) : (const bf16*)(C.ws + WS_HGRNWIN);
        const float* sw = (const float*)(C.ws + WS_SW) + (MIXER == 0 ? jx * 4096 : MIXER == 1 ? 8192 : 11264);
        if ((I8MASK >> layer) & 1) do_gemm<3>(C, (const bf16*)(C.ws + WS_XN8), Wt, MIXER == 1 ? 3072 : 4096, P, 1024, 1, (const float*)(C.ws + WS_SX), nullptr, nullptr, nullptr, sw, nullptr);
        else do_gemm<0>(C, XN, Wt, MIXER == 1 ? 3072 : 4096, P, 1024, 1, nullptr, nullptr, nullptr, nullptr, nullptr, nullptr);
    } else if constexpr (STEP == 1) {
        if constexpr (MIXER == 0) fox_step1(C, jx);
    } else if constexpr (STEP == 2) {
        if constexpr (MIXER == 1) chunk_prepass<4>(C); else if constexpr (MIXER == 2) chunk_prepass<8>(C);
    } else if constexpr (STEP == 3) {
        if constexpr (MIXER == 0) {
            const attn_body::AttnTensors AT{(const attn_body::bf16*)P, (const attn_body::bf16*)(P + PSTRIDE), (const attn_body::bf16*)(P + 2 * PSTRIDE), (attn_body::bf16*)OB, (const attn_body::bf16*)(P + 3 * PSTRIDE), (const float*)(C.ws + WS_TAIL)};
            const attn_body::StaticOrder S(C.G, C.bx);
            attn_body::attn_phase<attn_body::StaticOrder>((char*)C.lds, AT, S, C.tid);
        }
        else if constexpr (MIXER == 1) chunk_recur<4, 256>(C, P + PSTRIDE);
        else chunk_recur<8, 128>(C, P + 2 * PSTRIDE);
    } else if constexpr (STEP == 4) {
        if constexpr (MIXER == 1) rec_norm_gate<256>(C, C.in[11], P + 2 * PSTRIDE);
        else if constexpr (MIXER == 2) rec_norm_gate<128>(C, C.in[15], P + 3 * PSTRIDE);
    } else if constexpr (STEP == 5) {
        const bf16* Wt = MIXER == 0 ? (const bf16*)(C.ws + WS_FOXWOUT) + (size_t)jx * 1024 * 1024 : MIXER == 1 ? (const bf16*)(C.ws + WS_GLAWOUT) : (const bf16*)(C.ws + WS_HGRNWOUT);
        do_gemm<1>(C, OB, Wt, 1024, nullptr, 0, 0, nullptr, layer == 0 ? C.in[0] : C.out, C.out, XN, C.in[2] + layer * 1024, (float*)(C.ws + WS_RS));
    } else if constexpr (STEP == 6) {
    } else if constexpr (STEP == 7) {
        do_gemm<2>(C, XN, (const bf16*)(C.ws + WS_PEERWQ) + (size_t)layer * 2048 * 1024, 2048, Q2, 2048, 0, (const float*)(C.ws + WS_RS), nullptr, nullptr, nullptr, nullptr, nullptr);
    } else if constexpr (STEP == 8) {
        peer_topk_gather<false>(C, layer);
    } else if constexpr (STEP == 9) {
    } else if constexpr (STEP == 11) {
        peer_topk_gather<true>(C, layer);
    } else if constexpr (STEP == 12) {
        p0_prologue_b(C);
    } else {
        p0_prologue(C);
    }
}

__device__ __forceinline__ void make_ctx(Ctx& C, const Args& args, unsigned char* lds_raw) {
    C.lds = (LAS unsigned char*)lds_raw;
    C.tid = threadIdx.x; C.lane = C.tid & 63; C.wave = __builtin_amdgcn_readfirstlane(C.tid >> 6);
    C.G = gridDim.x; C.bx = blockIdx.x; { const int bx = blockIdx.x; C.vcu = (C.G % 8 == 0) ? (bx % 8) * (C.G / 8) + bx / 8 : bx; }
    C.gw = C.vcu * NWAVES + C.wave; C.NGW = C.G * NWAVES;
#pragma unroll
    for (int i = 0; i < 21; ++i) C.in[i] = args.in[i];
    C.out = args.out; C.ws = args.ws;
}

template <int STEP, int MIXER>
__global__ void __launch_bounds__(NWAVES * 64, 2) mk_phase(Args args, int layer) {
    extern __shared__ __attribute__((aligned(16))) unsigned char lds_raw[];
    Ctx C; make_ctx(C, args, lds_raw);
    run_step<STEP, MIXER>(C, layer);
}

template <int STEP, int MIXER>
static void launch_phase(const Args& a, int layer, int grid, hipStream_t stream) {
    static bool attr_set = false;
    if (!attr_set) { (void)hipFuncSetAttribute((const void*)mk_phase<STEP, MIXER>, hipFuncAttributeMaxDynamicSharedMemorySize, LDS_BYTES); attr_set = true; }
    hipLaunchKernelGGL((mk_phase<STEP, MIXER>), dim3(grid), dim3(NWAVES * 64), LDS_BYTES, stream, a, layer);
}
#ifndef MK_DUP
#define MK_DUP -1
#endif
#define LP(S, M) do { launch_phase<S, M>(a, layer, grid, stream); if (MK_DUP == S) launch_phase<(S == 8 ? 11 : S), M>(a, layer, grid, stream); } while (0)
template <int MIXER>
static void launch_layer(const Args& a, int layer, int grid, hipStream_t stream) {
    LP(0, MIXER);
    if (MIXER == 0) launch_phase<1, MIXER>(a, layer, grid, stream); else LP(2, MIXER);
    LP(3, MIXER);
    if (MIXER != 0) LP(4, MIXER);
    LP(5, MIXER);
    LP(7, 0);
    LP(8, 0);
}
#if MK_SINGLE
__device__ __forceinline__ const float* tab_ptr(volatile LAS unsigned long long* tab, int i) {
    const unsigned long long v = tab[i];
    const unsigned lo = __builtin_amdgcn_readfirstlane((unsigned)v), hi = __builtin_amdgcn_readfirstlane((unsigned)(v >> 32));
    return (const float*)(const GAS float*)(((unsigned long long)hi << 32) | lo);
}
__device__ __forceinline__ int lane_id_volatile() { int x; asm volatile("v_mbcnt_lo_u32_b32 %0, -1, 0\n\tv_mbcnt_hi_u32_b32 %0, -1, %0" : "=v"(x)); return x; }
__device__ __forceinline__ void make_ctx_opaque(Ctx& C, unsigned char* lds_raw, int wave_s) {
    int bx = blockIdx.x, G = gridDim.x; unsigned ldso = 0u;
    asm volatile("" : "+s"(bx), "+s"(G), "+s"(ldso), "+s"(wave_s));
    int tid = wave_s * 64 + lane_id_volatile();
    C.lds = (LAS unsigned char*)lds_raw + ldso;
    volatile LAS unsigned long long* tab = (volatile LAS unsigned long long*)(C.lds + LDSCTL_OFF);
    C.tid = tid; C.lane = tid & 63; C.wave = __builtin_amdgcn_readfirstlane(tid >> 6);
    C.G = G; C.bx = bx; C.vcu = (G % 8 == 0) ? (bx % 8) * (G / 8) + bx / 8 : bx;
    C.gw = C.vcu * NWAVES + C.wave; C.NGW = G * NWAVES;
#pragma unroll
    for (int i = 0; i < 21; ++i) C.in[i] = tab_ptr(tab, i);
    C.out = (float*)tab_ptr(tab, 21); C.ws = (unsigned char*)tab_ptr(tab, 22);
}
__device__ __forceinline__ void grid_bar(unsigned char* lds_raw, int wave_s) {
    unsigned ldso = 0u; asm volatile("" : "+s"(ldso), "+s"(wave_s));
    LAS unsigned char* lds = (LAS unsigned char*)lds_raw + ldso;
    volatile LAS unsigned long long* tab = (volatile LAS unsigned long long*)(lds + LDSCTL_OFF);
    XcdBarrier b; b.bar = (unsigned*)((unsigned char*)tab_ptr(tab, 22) + WS_CTL) + CW_BAR; b.x = xb_xcc_id(); b.st = (volatile LAS unsigned*)(lds + MISC_OFF) + 8;
    xcd_barrier(b, wave_s == 0 && lane_id_volatile() == 0);
}
#define MK_STEP(...) do { Ctx C; make_ctx_opaque(C, lds_raw, wave_s); __VA_ARGS__; } while (0)
__global__ void __launch_bounds__(NWAVES * 64, 2) mk_fwd(Args args) {
    extern __shared__ __attribute__((aligned(16))) unsigned char lds_raw[];
    const int wave_s = __builtin_amdgcn_readfirstlane(threadIdx.x >> 6);
    for (int u = threadIdx.x; u < (LDS_BYTES - LDSCTL_OFF) / 4; u += NWAVES * 64) ((LAS unsigned*)((LAS unsigned char*)lds_raw + LDSCTL_OFF))[u] = 0u;
    __syncthreads();
    if (threadIdx.x == 0) {
        LAS unsigned long long* tab = (LAS unsigned long long*)((LAS unsigned char*)lds_raw + LDSCTL_OFF);
#pragma unroll
        for (int i = 0; i < 21; ++i) tab[i] = (unsigned long long)args.in[i];
        tab[21] = (unsigned long long)args.out; tab[22] = (unsigned long long)args.ws;
    }
    (void)xcd_barrier_post((unsigned*)(args.ws + WS_CTL) + CW_BAR, (volatile LAS unsigned*)((LAS unsigned char*)lds_raw + MISC_OFF) + 8);
    __syncthreads();
    MK_STEP(p0_prologue(C));
    if (I8_NITEMS) { grid_bar(lds_raw, wave_s); MK_STEP(p0_prologue_b(C)); }
    cg::this_grid().sync();
#pragma unroll 1
    for (int layer = 0; layer < DEPTH; ++layer) {
        const int mixer = layer % 3, jx = layer / 3;
        MK_STEP(const bf16* Wt = mixer == 0 ? (const bf16*)(C.ws + WS_FOXWIN + (size_t)jx * 8 * MiB) : mixer == 1 ? (const bf16*)(C.ws + WS_GLAWIN) : (const bf16*)(C.ws + WS_HGRNWIN);
                const float* sw = (const float*)(C.ws + WS_SW) + (mixer == 0 ? jx * 4096 : mixer == 1 ? 8192 : 11264);
                if (I8MASK == 15 || (I8MASK != 0 && ((I8MASK >> layer) & 1))) do_gemm<3>(C, (const bf16*)(C.ws + WS_XN8), Wt, mixer == 1 ? 3072 : 4096, (bf16*)(C.ws + WS_P), 1024, 1, (const float*)(C.ws + WS_SX), nullptr, nullptr, nullptr, sw, nullptr);
                else do_gemm<0>(C, (const bf16*)(C.ws + WS_XN), Wt, mixer == 1 ? 3072 : 4096, (bf16*)(C.ws + WS_P), 1024, 1, nullptr, nullptr, nullptr, nullptr, nullptr, nullptr));
        grid_bar(lds_raw, wave_s);
        MK_STEP(if (mixer == 0) run_step<1, 0>(C, layer); else if (mixer == 1) run_step<2, 1>(C, layer); else run_step<2, 2>(C, layer));
        grid_bar(lds_raw, wave_s);
        MK_STEP(if (mixer == 0) run_step<3, 0>(C, layer); else if (mixer == 1) run_step<3, 1>(C, layer); else run_step<3, 2>(C, layer));
        grid_bar(lds_raw, wave_s);
        if (mixer != 0) { MK_STEP(if (mixer == 1) run_step<4, 1>(C, layer); else run_step<4, 2>(C, layer)); grid_bar(lds_raw, wave_s); }
        MK_STEP(const bf16* Wt = mixer == 0 ? (const bf16*)(C.ws + WS_FOXWOUT) + (size_t)jx * 1024 * 1024 : mixer == 1 ? (const bf16*)(C.ws + WS_GLAWOUT) : (const bf16*)(C.ws + WS_HGRNWOUT);
                do_gemm<1>(C, (const bf16*)(C.ws + WS_OB), Wt, 1024, nullptr, 0, 0, nullptr, layer == 0 ? C.in[0] : C.out, C.out, (bf16*)(C.ws + WS_XN), C.in[2] + layer * 1024, (float*)(C.ws + WS_RS)));
        grid_bar(lds_raw, wave_s);
        MK_STEP(run_step<7, 0>(C, layer));
        grid_bar(lds_raw, wave_s);
        MK_STEP(run_step<8, 0>(C, layer));
        if (layer + 1 < DEPTH) grid_bar(lds_raw, wave_s);
    }
}
#endif

extern "C" void kernel_launch(void* const* d_in, const int* in_sizes, int n_in, void* d_out, int out_size, void* d_ws, size_t ws_size, hipStream_t stream) {
    static int grid = 0;
    if (grid == 0) {
        if (n_in != 21 || out_size != NTOK * 1024 || ws_size < WS_END) { fprintf(stderr, "kernel_launch: unexpected shapes: n_in %d out %d ws %zu (need %zu)\n", n_in, out_size, ws_size, (size_t)WS_END); grid = -1; return; }
        int dev = 0, cus = 0, per_cu = 0;
        (void)hipGetDevice(&dev); (void)hipDeviceGetAttribute(&cus, hipDeviceAttributeMultiprocessorCount, dev);
#if MK_SINGLE
        if (hipFuncSetAttribute((const void*)mk_fwd, hipFuncAttributeMaxDynamicSharedMemorySize, LDS_BYTES) != hipSuccess) { fprintf(stderr, "kernel_launch: hipFuncSetAttribute failed\n"); grid = -1; return; }
        if (hipOccupancyMaxActiveBlocksPerMultiprocessor(&per_cu, (const void*)mk_fwd, NWAVES * 64, LDS_BYTES) != hipSuccess || per_cu < 1) { fprintf(stderr, "kernel_launch: occupancy query says %d blocks per CU\n", per_cu); (void)hipGetLastError(); grid = -1; return; }
#endif
        (void)per_cu;
        grid = cus;
    }
    if (grid < 0) return;
    Args a{};
    for (int i = 0; i < 21; ++i) a.in[i] = (const float*)d_in[i];
    a.out = (float*)d_out; a.ws = (unsigned char*)d_ws;
#if MK_SINGLE
    (void)hipMemsetAsync((char*)d_ws + WS_CTL, 0, CTL_ZERO_BYTES, stream);
    a.ph_lo = 0; a.ph_hi = NPHASE;
    void* kargs[] = {&a};
    hipError_t e = hipLaunchCooperativeKernel((const void*)mk_fwd, dim3(grid), dim3(NWAVES * 64), kargs, LDS_BYTES, stream);
    if (e != hipSuccess) fprintf(stderr, "cooperative launch failed: %s (grid %d)\n", hipGetErrorString(e), grid);
#else
    (void)hipMemsetAsync((char*)d_ws + WS_CTL, 0, CTL_ZERO_BYTES, stream);
    launch_phase<10, 0>(a, 0, grid, stream); if (MK_DUP == 10) launch_phase<10, 0>(a, 0, grid, stream);
    launch_phase<12, 0>(a, 0, grid, stream);
    launch_layer<0>(a, 0, grid, stream);
    launch_layer<1>(a, 1, grid, stream);
    launch_layer<2>(a, 2, grid, stream);
    launch_layer<0>(a, 3, grid, stream);
#endif
}
```

```cpp
#include <hip/hip_runtime.h>
#include <hip/hip_cooperative_groups.h>
#include <cstdio>
#include <cstdint>
#include <cmath>
namespace pg8 {
#define PG8_LAS __attribute__((address_space(3)))
typedef unsigned short bf16_t;
typedef short bf16x8 __attribute__((ext_vector_type(8)));
typedef float f32x4 __attribute__((ext_vector_type(4)));
typedef unsigned u32x4 __attribute__((ext_vector_type(4)));
typedef int i32x4 __attribute__((ext_vector_type(4)));
constexpr int BM = 256, BK = 64, HALF = 128, HTB = HALF * BK * 2  , STAGE_BYTES = 8 * HTB, NXCD = 8, WGM = 8;

__host__ __device__ __forceinline__ int lds_byte(int r, int c) { const int st = (r >> 4) * 2 + (c >> 5), rr = r & 15, cc = c & 31, ob = rr * 64 + cc * 2; return st * 1024 + (ob ^ (((ob >> 9) & 1) << 5)); }
__host__ __device__ __forceinline__ void stage_rc(int b, int& R, int& C) { const int st = b / 1024, sb = b % 1024, swz = sb ^ (((sb >> 9) & 1) << 5); R = (st >> 1) * 16 + swz / 64; C = (st & 1) * 32 + (swz % 64) / 2; }
__host__ __device__ __forceinline__ int perm32(int rho) { const int n = rho >> 4, i = rho & 15; return 8 * (i >> 2) + 4 * n + (i & 3); }

struct Unit { int pm, pn; };
struct Gemm { const bf16_t* A; const bf16_t* Bt; int M, N, K; };

struct StaticOrder {
    int nM, nN, nwg, G, c;
    __host__ __device__ void init(int M, int N, int G_, int c_) { nM = M / BM; nN = N / BM; nwg = nM * nN; G = G_; c = c_; }
    __host__ __device__ bool next(int i, Unit& u) const {
        const long L = (long)i * G + c; if (L >= nwg) return false;
        int wgid = (int)L; { const int q = nwg / NXCD, r = nwg % NXCD, xcd = wgid % NXCD, off = wgid / NXCD; wgid = (xcd < r ? xcd * (q + 1) : r * (q + 1) + (xcd - r) * q) + off; }
        const int nig = WGM * nN, gid = wgid / nig, fm = gid * WGM, gsz = (nM - fm) < WGM ? (nM - fm) : WGM;
        u.pm = fm + ((wgid % nig) % gsz); u.pn = (wgid % nig) / gsz; return true;
    }
    __device__ __forceinline__ void a_ready(const Unit&) const {}
    __device__ __forceinline__ void done(const Unit&) const {}
};

__device__ __forceinline__ unsigned cvt_pk_bf16(float lo, float hi) { unsigned r; asm volatile("v_cvt_pk_bf16_f32 %0, %1, %2" : "=v"(r) : "v"(lo), "v"(hi)); return r; }
typedef float f32x2 __attribute__((ext_vector_type(2)));
__device__ __forceinline__ f32x2 gelu_pk(f32x2 v) {
    const f32x2 av = __builtin_elementwise_abs(v), d = av * 0.2316418882f + 1.0f;
    f32x2 t; t.x = __builtin_amdgcn_rcpf(d.x); t.y = __builtin_amdgcn_rcpf(d.y);
    f32x2 q = t * 0.5307027145f + (-0.7265760135f); q = q * t + 0.7107068705f; q = q * t + (-0.142248368f); q = q * t + 0.127414796f; q = q * t;
    const f32x2 s = (v * v) * (-0.72134752044f);
    f32x2 e; e.x = __builtin_amdgcn_exp2f(s.x); e.y = __builtin_amdgcn_exp2f(s.y);
    const f32x2 m = v * (q * e), r = v - m;
    f32x2 o; o.x = v.x < 0.f ? m.x : r.x; o.y = v.y < 0.f ? m.y : r.y; return o;
}
#ifndef EPI_AUX
#define EPI_AUX 16
#endif
template <bool F16  > struct EpiBf16R {
    typedef f32x4 acc_t;
    static constexpr bool PERM = true, AFTER_DRAIN = false;
    bf16_t* O; int ldc; int split_cols; size_t split_stride; const float* rs;
    __device__ __forceinline__ void operator()(const f32x4 (&acc)[2][2][4][2], const Unit& u, int wr, int wc, int fr, int fq) const {
        const int row0 = u.pm * BM + wr * 64 + fr; int colt = u.pn * BM; unsigned boff = 0u;
        if (split_cols) { const int t = colt / split_cols; boff = (unsigned)(t * split_stride * 2); colt -= t * split_cols; }
        const int col0 = colt + wc * 32 + 8 * fq;
        const __amdgpu_buffer_rsrc_t orsrc = __builtin_amdgcn_make_buffer_rsrc((void*)O, (short)0, 0x7ffffff0, 0x00020000);
#pragma unroll
        for (int ai = 0; ai < 2; ++ai)
#pragma unroll
            for (int m = 0; m < 4; ++m) { const int row = row0 + ai * HALF + m * 16; const unsigned roff = boff + (unsigned)(row * ldc + col0) * 2u;
                float sc = 1.f;
                if (rs) { const f32x4 a = *(const f32x4*)(rs + (size_t)row * 16), b = *(const f32x4*)(rs + (size_t)row * 16 + 4), c = *(const f32x4*)(rs + (size_t)row * 16 + 8), d = *(const f32x4*)(rs + (size_t)row * 16 + 12);
                    const float s = (((a[0] + a[1]) + (a[2] + a[3])) + ((b[0] + b[1]) + (b[2] + b[3]))) + (((c[0] + c[1]) + (c[2] + c[3])) + ((d[0] + d[1]) + (d[2] + d[3])));
                    sc = __builtin_amdgcn_rsqf(s * (1.0f / 1024.0f) + 1e-6f); }
#pragma unroll
                for (int bj = 0; bj < 2; ++bj) { const f32x4 v0 = acc[ai][bj][m][0] * sc, v1 = acc[ai][bj][m][1] * sc;
                    u32x4 w;
                    if (F16) { w.x = __builtin_bit_cast(unsigned, __builtin_amdgcn_cvt_pkrtz(v0[0], v0[1])); w.y = __builtin_bit_cast(unsigned, __builtin_amdgcn_cvt_pkrtz(v0[2], v0[3])); w.z = __builtin_bit_cast(unsigned, __builtin_amdgcn_cvt_pkrtz(v1[0], v1[1])); w.w = __builtin_bit_cast(unsigned, __builtin_amdgcn_cvt_pkrtz(v1[2], v1[3])); }
                    else { w.x = cvt_pk_bf16(v0[0], v0[1]); w.y = cvt_pk_bf16(v0[2], v0[3]); w.z = cvt_pk_bf16(v1[0], v1[1]); w.w = cvt_pk_bf16(v1[2], v1[3]); }
                    __builtin_amdgcn_raw_buffer_store_b128(w, orsrc, (int)(roff + bj * HALF * 2), 0, EPI_AUX); } }
    }
};
struct EpiI8 {
    typedef i32x4 acc_t;
    static constexpr bool PERM = true, AFTER_DRAIN = false;
    bf16_t* O; size_t split_stride; const float* sx; const float* sw;
    __device__ __forceinline__ void operator()(const i32x4 (&acc)[2][2][4][2], const Unit& u, int wr, int wc, int fr, int fq) const {
        const int row0 = u.pm * BM + wr * 64 + fr; int colt = u.pn * BM; unsigned boff;
        { const int t = colt / 1024; boff = (unsigned)(t * split_stride * 2); colt -= t * 1024; }
        const __amdgpu_buffer_rsrc_t orsrc = __builtin_amdgcn_make_buffer_rsrc((void*)O, (short)0, 0x7ffffff0, 0x00020000);
        const int col0 = colt + wc * 32 + 8 * fq, scol0 = u.pn * BM + wc * 32 + 8 * fq;
        f32x4 cw[2][2];
#pragma unroll
        for (int bj = 0; bj < 2; ++bj) { cw[bj][0] = *(const f32x4*)(sw + scol0 + bj * HALF); cw[bj][1] = *(const f32x4*)(sw + scol0 + bj * HALF + 4); }
#pragma unroll
        for (int ai = 0; ai < 2; ++ai)
#pragma unroll
            for (int m = 0; m < 4; ++m) { const int row = row0 + ai * HALF + m * 16; const unsigned roff = boff + (unsigned)(row * 1024 + col0) * 2u; const float rs = sx[row];
#pragma unroll
                for (int bj = 0; bj < 2; ++bj) { const i32x4 a0 = acc[ai][bj][m][0], a1 = acc[ai][bj][m][1];
                    const f32x4 v0 = (f32x4){(float)a0[0], (float)a0[1], (float)a0[2], (float)a0[3]} * cw[bj][0] * rs, v1 = (f32x4){(float)a1[0], (float)a1[1], (float)a1[2], (float)a1[3]} * cw[bj][1] * rs;
                    u32x4 w; w.x = cvt_pk_bf16(v0[0], v0[1]); w.y = cvt_pk_bf16(v0[2], v0[3]); w.z = cvt_pk_bf16(v1[0], v1[1]); w.w = cvt_pk_bf16(v1[2], v1[3]);
                    __builtin_amdgcn_raw_buffer_store_b128(w, orsrc, (int)(roff + bj * HALF * 2), 0, EPI_AUX); } }
    }
};
template <bool BASE16> struct EpiResNorm {
    typedef f32x4 acc_t;
    static constexpr bool PERM = false, AFTER_DRAIN = false;
    const void* base; bf16_t* out; bf16_t* hg; const float* gain; float* rs;
    __device__ __forceinline__ void operator()(const f32x4 (&acc)[2][2][4][2], const Unit& u, int wr, int wc, int fr, int fq) const {
        const int col0 = u.pn * BM + wc * 32 + 4 * fq, lane = fr + 16 * fq;
        f32x4 gv[2][2];
#pragma unroll
        for (int bj = 0; bj < 2; ++bj)
#pragma unroll
            for (int n = 0; n < 2; ++n) gv[bj][n] = *(const f32x4*)(gain + col0 + bj * HALF + n * 16);
#pragma unroll
        for (int ai = 0; ai < 2; ++ai)
#pragma unroll
            for (int m = 0; m < 4; ++m) { const int r = ai * HALF + wr * 64 + m * 16 + fr; const size_t off = (size_t)(u.pm * BM + r) * 1024 + col0;
                float ss = 0.f;
#pragma unroll
                for (int bj = 0; bj < 2; ++bj)
#pragma unroll
                    for (int n = 0; n < 2; ++n) { typedef unsigned u32x2 __attribute__((ext_vector_type(2))); f32x4 b;
                        if (BASE16) { const u32x2 bw = *(const u32x2*)((const bf16_t*)base + off + bj * HALF + n * 16);
                            b = (f32x4){__builtin_bit_cast(float, bw.x << 16), __builtin_bit_cast(float, bw.x & 0xffff0000u), __builtin_bit_cast(float, bw.y << 16), __builtin_bit_cast(float, bw.y & 0xffff0000u)}; }
                        else b = *(const f32x4*)((const float*)base + off + bj * HALF + n * 16);
                        const f32x4 o = b + acc[ai][bj][m][n];
                        u32x2 wo; wo.x = cvt_pk_bf16(o[0], o[1]); wo.y = cvt_pk_bf16(o[2], o[3]); *(u32x2*)(out + off + bj * HALF + n * 16) = wo;
                        ss += (o[0] * o[0] + o[1] * o[1]) + (o[2] * o[2] + o[3] * o[3]);
                        const f32x4 h = o * gv[bj][n]; u32x2 w; w.x = cvt_pk_bf16(h[0], h[1]); w.y = cvt_pk_bf16(h[2], h[3]);
                        *(u32x2*)(hg + off + bj * HALF + n * 16) = w; }
                ss += __builtin_bit_cast(float, __builtin_amdgcn_ds_bpermute((lane ^ 16) << 2, __builtin_bit_cast(int, ss)));
                ss += __builtin_bit_cast(float, __builtin_amdgcn_ds_bpermute((lane ^ 32) << 2, __builtin_bit_cast(int, ss)));
                if (fq == 0) rs[(size_t)(u.pm * BM + r) * 16 + u.pn * 4 + wc] = ss; }
    }
};
__device__ __forceinline__ f32x4 mma16(bf16x8 a, bf16x8 b, f32x4 c) { return __builtin_amdgcn_mfma_f32_16x16x32_bf16(a, b, c, 0, 0, 0); }
__device__ __forceinline__ i32x4 mma16(bf16x8 a, bf16x8 b, i32x4 c) { return __builtin_amdgcn_mfma_i32_16x16x64_i8(__builtin_bit_cast(i32x4, a), __builtin_bit_cast(i32x4, b), c, 0, 0, 0); }
template <class Epi, class Sched, bool ALIGN_EPI = false, bool SP2 = false>
__device__ __forceinline__ void gemm_phase(PG8_LAS unsigned char* lds, const Gemm g, const Sched& S, const Epi& E, int tid_in) {
    int tid_ = tid_in; asm volatile("" : "+v"(tid_));
    const int tid = tid_, wid = __builtin_amdgcn_readfirstlane(tid >> 6), lane = tid & 63, wr = wid >> 2, wc = wid & 3, fr = lane & 15, fq = lane >> 4;
    const int K = g.K, nt = K / BK;
    unsigned voffA[2], voffB[2];
#pragma unroll
    for (int i = 0; i < 2; ++i) { int R, C; stage_rc(tid * 16 + i * 8192, R, C); const int Rb = Epi::PERM ? ((R & ~31) + perm32(R & 31)) : R;
        voffA[i] = (unsigned)(R * K + C) * 2u; voffB[i] = (unsigned)(Rb * K + C) * 2u; }
    const size_t kstep = (size_t)(BK * 2);
    const size_t hstep = (size_t)HALF * K * 2;
    const size_t tstep = 2 * hstep;
    const unsigned ldsw = (unsigned)wid * 1024u;
    const int aoff = lds_byte(wr * 64 + fr, fq * 8), boff = lds_byte(wc * 32 + fr, fq * 8);
#define PG8_SA(b, h) (((b) * 2 + (h)) * HTB)
#define PG8_SB(b, h) ((4 + (b) * 2 + (h)) * HTB)
#define PG8_STAGE(bufoff, gbase, voff) do { _Pragma("unroll") for (int _i = 0; _i < 2; ++_i) \
        __builtin_amdgcn_global_load_lds((const unsigned*)((const char*)(gbase) + (voff)[_i]), (PG8_LAS unsigned*)(lds + (bufoff) + ldsw + _i * 8192), 16, 0, 0); } while (0)
#define PG8_LDA(dst, b, h) do { _Pragma("unroll") for (int m = 0; m < 4; ++m) _Pragma("unroll") for (int k = 0; k < 2; ++k) dst[m][k] = *(const PG8_LAS bf16x8*)(lds + PG8_SA(b, h) + aoff + m * 2048 + k * 1024); } while (0)
#define PG8_LDB(dst, b, h) do { _Pragma("unroll") for (int n = 0; n < 2; ++n) _Pragma("unroll") for (int k = 0; k < 2; ++k) dst[n][k] = *(const PG8_LAS bf16x8*)(lds + PG8_SB(b, h) + boff + n * 2048 + k * 1024); } while (0)
#define PG8_MMA(ai, bj, At, Bt) do { __builtin_amdgcn_s_setprio(1); _Pragma("unroll") for (int m = 0; m < 4; ++m) _Pragma("unroll") for (int n = 0; n < 2; ++n) _Pragma("unroll") for (int k = 0; k < 2; ++k) \
        acc[ai][bj][m][n] = mma16(Bt[n][k], At[m][k], acc[ai][bj][m][n]); __builtin_amdgcn_s_setprio(0); } while (0)
#define PG8_WAIT_V(n) asm volatile("s_waitcnt vmcnt(" #n ")" ::: "memory")
#define PG8_WAIT_L(n) asm volatile("s_waitcnt lgkmcnt(" #n ")" ::: "memory")
#define PG8_BAR __builtin_amdgcn_s_barrier()
#define PG8_SCHED __builtin_amdgcn_sched_barrier(0)
    Unit cur, nxt; int ui = 0;
    if (!S.next(0, cur)) return;
    typedef typename Epi::acc_t acc_t;
    acc_t acc[2][2][4][2];
#pragma unroll
    for (int a = 0; a < 2; ++a)
#pragma unroll
        for (int b = 0; b < 2; ++b)
#pragma unroll
            for (int m = 0; m < 4; ++m)
#pragma unroll
                for (int n = 0; n < 2; ++n) acc[a][b][m][n] = (acc_t){0, 0, 0, 0};
    bf16x8 At[4][2], B0[2][2], B1[2][2];
    const char* cA = (const char*)g.A + (size_t)cur.pm * tstep; const char* cB = (const char*)g.Bt + (size_t)cur.pn * tstep;
    S.a_ready(cur);
    if constexpr (SP2) {
        PG8_STAGE(PG8_SB(0, 0), cB, voffB); PG8_STAGE(PG8_SB(0, 1), cB + hstep, voffB); PG8_STAGE(PG8_SA(0, 0), cA, voffA); PG8_STAGE(PG8_SA(0, 1), cA + hstep, voffA);
        if (wr == 1) PG8_BAR;
        PG8_WAIT_V(2); PG8_BAR;
        PG8_STAGE(PG8_SB(1, 0), cB + kstep, voffB); PG8_STAGE(PG8_SA(1, 0), cA + kstep, voffA); PG8_STAGE(PG8_SB(1, 1), cB + hstep + kstep, voffB);
        PG8_WAIT_V(6); PG8_BAR;
    } else {
        PG8_STAGE(PG8_SB(0, 0), cB, voffB); PG8_STAGE(PG8_SA(0, 0), cA, voffA); PG8_STAGE(PG8_SB(0, 1), cB + hstep, voffB); PG8_STAGE(PG8_SA(0, 1), cA + hstep, voffA);
        if (wr == 1) PG8_BAR;
        PG8_WAIT_V(4); PG8_BAR;
        PG8_STAGE(PG8_SB(1, 0), cB + kstep, voffB); PG8_STAGE(PG8_SA(1, 0), cA + kstep, voffA); PG8_STAGE(PG8_SB(1, 1), cB + hstep + kstep, voffB);
        PG8_WAIT_V(6); PG8_BAR;
    }
    for (;;) {
        const bool has_next = S.next(ui + 1, nxt);
        const char* nA = has_next ? (const char*)g.A + (size_t)nxt.pm * tstep : cA; const char* nB = has_next ? (const char*)g.Bt + (size_t)nxt.pn * tstep : cB;
        for (int t = 0; t < nt; t += 2) {
            const bool last = (t == nt - 2);
            const char* a1 = cA + (size_t)(t + 1) * kstep;
            const char* a2 = last ? nA : cA + (size_t)(t + 2) * kstep; const char* b2 = last ? nB : cB + (size_t)(t + 2) * kstep;
            const char* a3 = a2 + kstep; const char* b3 = b2 + kstep;
            if (last && has_next) S.a_ready(nxt);
            if constexpr (SP2) {
            PG8_LDB(B0, 0, 0); PG8_LDB(B1, 0, 1); PG8_SCHED; PG8_LDA(At, 0, 0); PG8_STAGE(PG8_SA(1, 1), a1 + hstep, voffA);
            PG8_WAIT_V(8); PG8_WAIT_L(0); PG8_BAR; PG8_MMA(0, 0, At, B0); PG8_MMA(0, 1, At, B1); PG8_BAR; PG8_SCHED;
            PG8_LDA(At, 0, 1); PG8_STAGE(PG8_SB(0, 0), b2, voffB); PG8_STAGE(PG8_SB(0, 1), b2 + hstep, voffB); PG8_STAGE(PG8_SA(0, 0), a2, voffA);
            PG8_WAIT_V(8); PG8_WAIT_L(0); PG8_BAR; PG8_MMA(1, 0, At, B0); PG8_MMA(1, 1, At, B1); PG8_BAR; PG8_SCHED;
            PG8_LDB(B0, 1, 0); PG8_LDB(B1, 1, 1); PG8_SCHED; PG8_LDA(At, 1, 0); PG8_STAGE(PG8_SA(0, 1), a2 + hstep, voffA);
            PG8_WAIT_V(8); PG8_WAIT_L(0); PG8_BAR; PG8_MMA(0, 0, At, B0); PG8_MMA(0, 1, At, B1); PG8_BAR; PG8_SCHED;
            PG8_LDA(At, 1, 1); PG8_STAGE(PG8_SB(1, 0), b3, voffB); PG8_STAGE(PG8_SB(1, 1), b3 + hstep, voffB); PG8_STAGE(PG8_SA(1, 0), a3, voffA);
            PG8_WAIT_V(8); PG8_WAIT_L(0); PG8_BAR; PG8_MMA(1, 0, At, B0); PG8_MMA(1, 1, At, B1); PG8_BAR; PG8_SCHED;
            } else {
            PG8_LDB(B0, 0, 0); PG8_SCHED; PG8_LDA(At, 0, 0); PG8_STAGE(PG8_SA(1, 1), a1 + hstep, voffA);
            PG8_WAIT_L(8); PG8_BAR; PG8_WAIT_L(0); PG8_MMA(0, 0, At, B0); PG8_BAR; PG8_SCHED;
            PG8_LDB(B1, 0, 1); PG8_STAGE(PG8_SB(0, 0), b2, voffB);
            PG8_BAR; PG8_WAIT_L(0); PG8_MMA(0, 1, At, B1); PG8_BAR;
            PG8_LDA(At, 0, 1); PG8_STAGE(PG8_SA(0, 0), a2, voffA);
            PG8_BAR; PG8_WAIT_L(0); PG8_MMA(1, 0, At, B0); PG8_BAR; PG8_SCHED;
            PG8_STAGE(PG8_SB(0, 1), b2 + hstep, voffB);
            PG8_WAIT_V(6); PG8_BAR; PG8_MMA(1, 1, At, B1); PG8_BAR;
            PG8_LDB(B0, 1, 0); PG8_SCHED; PG8_LDA(At, 1, 0); PG8_STAGE(PG8_SA(0, 1), a2 + hstep, voffA);
            PG8_WAIT_L(8); PG8_BAR; PG8_WAIT_L(0); PG8_MMA(0, 0, At, B0); PG8_BAR; PG8_SCHED;
            PG8_LDB(B1, 1, 1); PG8_STAGE(PG8_SB(1, 0), b3, voffB);
            PG8_BAR; PG8_WAIT_L(0); PG8_MMA(0, 1, At, B1); PG8_BAR;
            PG8_LDA(At, 1, 1); PG8_STAGE(PG8_SA(1, 0), a3, voffA);
            PG8_BAR; PG8_WAIT_L(0); PG8_MMA(1, 0, At, B0); PG8_BAR; PG8_SCHED;
            PG8_STAGE(PG8_SB(1, 1), b3 + hstep, voffB);
            PG8_WAIT_V(6); PG8_BAR; PG8_MMA(1, 1, At, B1); PG8_BAR;
            }
        }
        if constexpr (ALIGN_EPI) { if (wr == 0) PG8_BAR; }
        if constexpr (!Epi::AFTER_DRAIN) { E(acc, cur, wr, wc, fr, fq); S.done(cur); }
        if (!has_next) break;
#pragma unroll
        for (int a = 0; a < 2; ++a)
#pragma unroll
            for (int b = 0; b < 2; ++b)
#pragma unroll
                for (int m = 0; m < 4; ++m)
#pragma unroll
                    for (int n = 0; n < 2; ++n) acc[a][b][m][n] = (acc_t){0, 0, 0, 0};
        cur = nxt; cA = nA; cB = nB; ++ui;
        if constexpr (ALIGN_EPI) { if (wr == 1) PG8_BAR; }
    }
    PG8_WAIT_V(0);
    if constexpr (!ALIGN_EPI) { if (wr == 0) PG8_BAR; }
    PG8_BAR;
    if constexpr (Epi::AFTER_DRAIN) { E.fused(acc, cur, wr, wc, fr, fq, lds, wid, lane); S.done(cur); }
#undef PG8_SA
#undef PG8_SB
#undef PG8_STAGE
#undef PG8_LDA
#undef PG8_LDB
#undef PG8_MMA
#undef PG8_WAIT_V
#undef PG8_WAIT_L
#undef PG8_BAR
#undef PG8_SCHED
}
}
#include <hip/hip_bf16.h>
#include <cmath>
namespace attn_body {
using bf16=__hip_bfloat16;
using bf16x8=__attribute__((ext_vector_type(8)))short;
using s16x4=__attribute__((ext_vector_type(4)))short;
using f32x16=__attribute__((ext_vector_type(16)))float;
using u32x4=__attribute__((ext_vector_type(4)))unsigned;
constexpr int BATCH=8,NHEAD=16,SEQ=2048,D=64,DM=NHEAD*D;
constexpr int NW=8,QBLK=32,QB=QBLK*NW,KVBLK=64,NQB=SEQ/QB;
constexpr int ATTN_PITCH=DM, ATTN_UNIT_ROWS=QB;
__device__ __forceinline__ int crow(int r,int hi){return (r&3)+8*(r>>2)+4*hi;}
#define SBAR() __builtin_amdgcn_sched_barrier(0)
__device__ __forceinline__ void cmask(f32x16&p0,f32x16&p1,int jb,int qrel,int hi){
  const float NEG=-INFINITY; int kb=64*jb+4*hi;
  #pragma unroll
  for(int r=0;r<16;++r){int kv=kb+(r&3)+8*(r>>2); if(kv>qrel)p0[r]=NEG; if(kv+32>qrel)p1[r]=NEG;}
}

constexpr int NSLOT=3, SLOTB=8192;
constexpr int LDS_K=0, LDS_V=NSLOT*SLOTB, LDS_WS=2*NSLOT*SLOTB, LDS_OST=LDS_WS+NW*64*4, LDS_CS=LDS_OST+NW*4096, LDS_BYTES=LDS_CS+SEQ*4;
constexpr float C2=0.125f*1.4426950408889634f;
__device__ __forceinline__ void glds16(const void*gsrc,unsigned lds_dst){unsigned keep;
  asm volatile("s_mov_b32 %0, m0\n\ts_mov_b32 m0, %2\n\ts_nop 0\n\tglobal_load_lds_dwordx4 %1, off\n\ts_mov_b32 m0, %0":"=&s"(keep):"v"(gsrc),"s"(lds_dst):"memory");}
__device__ __forceinline__ float max3f(float a,float b,float c){float r;asm("v_max3_f32 %0, %1, %2, %3":"=v"(r):"v"(a),"v"(b),"v"(c));return r;}
__device__ __forceinline__ float max2f(float a,float b){float r;asm("v_max_f32_e32 %0, %1, %2":"=v"(r):"v"(a),"v"(b));return r;}
__device__ __forceinline__ float fadd_s(float a,float b){float r;asm("v_add_f32_e32 %0, %1, %2":"=v"(r):"v"(a),"v"(b));return r;}
__device__ __forceinline__ float fsub_s(float a,float b){float r;asm("v_sub_f32_e32 %0, %1, %2":"=v"(r):"v"(a),"v"(b));return r;}
typedef float f32x2_t __attribute__((ext_vector_type(2))); typedef __bf16 bf16x2_t __attribute__((ext_vector_type(2)));
__device__ __forceinline__ unsigned cvtpk_s(float lo,float hi){f32x2_t v={lo,hi};bf16x2_t b=__builtin_convertvector(v,bf16x2_t);return __builtin_bit_cast(unsigned,b);}
#define WAIT_BAR(N) asm volatile("s_waitcnt vmcnt(" #N ") lgkmcnt(0)\n\ts_barrier":::"memory")

typedef __attribute__((address_space(3))) const char* lds_cptr;
__device__ __forceinline__ void qkt(f32x16&p0,f32x16&p1,const char*Kslot,lds_cptr qls,bf16x8 ax0,bf16x8 ax1,bf16x8 qx,int r32,int hi){
  const char*kb=Kslot+hi*1024+r32*16; const f32x16 z16=f32x16{};
  p0=__builtin_amdgcn_mfma_f32_32x32x16_bf16(ax0,qx,z16,0,0,0);p1=__builtin_amdgcn_mfma_f32_32x32x16_bf16(ax1,qx,z16,0,0,0);
  #pragma unroll
  for(int d0=0;d0<4;++d0){
    const bf16x8 b0=*reinterpret_cast<const bf16x8*>(kb+d0*2048);
    const bf16x8 b1=*reinterpret_cast<const bf16x8*>(kb+d0*2048+512);
    const bf16x8 qd=*(const __attribute__((address_space(3))) bf16x8*)(qls+d0*1024);
    p0=__builtin_amdgcn_mfma_f32_32x32x16_bf16(b0,qd,p0,0,0,0);p1=__builtin_amdgcn_mfma_f32_32x32x16_bf16(b1,qd,p1,0,0,0);}
}
typedef short v4i16_t __attribute__((ext_vector_type(4)));
__device__ __forceinline__ void kload8(bf16x8*kf,lds_cptr kp){
  kf[0]=*(const __attribute__((address_space(3))) bf16x8*)(kp);      kf[1]=*(const __attribute__((address_space(3))) bf16x8*)(kp+512);
  kf[2]=*(const __attribute__((address_space(3))) bf16x8*)(kp+2048); kf[3]=*(const __attribute__((address_space(3))) bf16x8*)(kp+2560);
  kf[4]=*(const __attribute__((address_space(3))) bf16x8*)(kp+4096); kf[5]=*(const __attribute__((address_space(3))) bf16x8*)(kp+4608);
  kf[6]=*(const __attribute__((address_space(3))) bf16x8*)(kp+6144); kf[7]=*(const __attribute__((address_space(3))) bf16x8*)(kp+6656);
}
__device__ __forceinline__ void kload2(bf16x8*kf,lds_cptr kp,int j){ kf[2*j]=*(const __attribute__((address_space(3))) bf16x8*)(kp+j*2048); kf[2*j+1]=*(const __attribute__((address_space(3))) bf16x8*)(kp+j*2048+512); }
__device__ __forceinline__ s16x4 vtr(lds_cptr p){ return __builtin_bit_cast(s16x4,__builtin_amdgcn_ds_read_tr16_b64_v4i16((__attribute__((address_space(3))) v4i16_t*)p)); }
__device__ __forceinline__ float rowmax(const f32x16&p0,const f32x16&p1){
  float a=max3f(p0[0],p0[1],p1[0]),b=max3f(p0[2],p0[3],p1[1]);a=max3f(a,p1[2],p1[3]);
  #pragma unroll
  for(int r=4;r<16;r+=4){a=max3f(a,p0[r],p0[r+1]);b=max3f(b,p0[r+2],p0[r+3]);a=max3f(a,p1[r],p1[r+1]);b=max3f(b,p1[r+2],p1[r+3]);}
  const float m=max2f(a,b);
  auto rr=__builtin_amdgcn_permlane32_swap(__float_as_uint(m),__float_as_uint(m),false,false);
  return max2f(__uint_as_float(rr[0]),__uint_as_float(rr[1]));
}
__device__ __forceinline__ void pv(f32x16*o,int vb,bf16x8 pa0,bf16x8 pa1,bf16x8 pa2,bf16x8 pa3){
  #pragma unroll
  for(int d0=0;d0<2;++d0){s16x4 lo[4],hi[4];
    #pragma unroll
    for(int ks=0;ks<4;++ks){
      asm volatile("ds_read_b64_tr_b16 %0,%1 offset:%c2":"=&v"(lo[ks]):"v"(vb),"i"(d0*4096+ks*1024):"memory");
      asm volatile("ds_read_b64_tr_b16 %0,%1 offset:%c2":"=&v"(hi[ks]):"v"(vb),"i"(d0*4096+ks*1024+512):"memory");}
    asm volatile("s_waitcnt lgkmcnt(0)":::"memory");SBAR();
    #define PK(k) (bf16x8){lo[k][0],lo[k][1],lo[k][2],lo[k][3],hi[k][0],hi[k][1],hi[k][2],hi[k][3]}
    o[d0]=__builtin_amdgcn_mfma_f32_32x32x16_bf16(pa0,PK(0),o[d0],0,0,0);
    o[d0]=__builtin_amdgcn_mfma_f32_32x32x16_bf16(pa1,PK(1),o[d0],0,0,0);
    o[d0]=__builtin_amdgcn_mfma_f32_32x32x16_bf16(pa2,PK(2),o[d0],0,0,0);
    o[d0]=__builtin_amdgcn_mfma_f32_32x32x16_bf16(pa3,PK(3),o[d0],0,0,0);
    #undef PK
  }
}

__device__ __forceinline__ void split3(float c,unsigned&hb,unsigned&mb,unsigned&lb){
  hb=__float_as_uint(c)&0xffff0000u; const float r1=c-__uint_as_float(hb); mb=__float_as_uint(r1)&0xffff0000u; const float r2=r1-__uint_as_float(mb); lb=__float_as_uint(r2)&0xffff0000u; }
__device__ __forceinline__ bf16x8 make_ax(float negc){ unsigned hb,mb,lb; split3(negc,hb,mb,lb);
  u32x4 w; w.x=(hb>>16)|mb; w.y=(lb>>16)|0x3f800000u; w.z=0x3f803f80u; w.w=0u; return __builtin_bit_cast(bf16x8,w); }
__device__ __forceinline__ bf16x8 make_qx(float negm,unsigned hm){ unsigned hb,mb,lb; split3(negm,hb,mb,lb);
  u32x4 w; w.x=0x3f803f80u&hm; w.y=(0x3f80u|hb)&hm; w.z=((mb>>16)|lb)&hm; w.w=0u; return __builtin_bit_cast(bf16x8,w); }
#ifndef ATTN_STORE16
#define ATTN_STORE16(p,v) (*(u32x4*)(p)=(v))
#endif
template<int THRL> __device__ __forceinline__ void attn_unit(int b,int h,int qb,const bf16*Q,const bf16*__restrict__ K,const bf16*__restrict__ V,bf16*O,const bf16*__restrict__ Gt,char*shm,const int tid_u,const float skip_thr){
  int tid=tid_u; asm volatile("":"+v"(tid));
  const int lane=tid&63,r32=lane&31,hi=lane>>5; const int wid=__builtin_amdgcn_readfirstlane(tid>>6);
  const long rowbase=(long)b*SEQ; const int q0=qb*QB;
  const bf16*Qw=Q+(rowbase+q0+wid*QBLK)*DM+h*D;
  float*csp=(float*)(shm+LDS_CS);
  int tskip=0;
  { const float cq0=csp[q0]; const int ntall=(q0+QB)/KVBLK; while(tskip+2<=ntall-4 && csp[KVBLK*(tskip+1)+KVBLK-1]-cq0<skip_thr)tskip+=2; tskip=__builtin_amdgcn_readfirstlane(tskip); }
  const bf16*Kh=K+(rowbase+(long)tskip*KVBLK)*DM+h*D,*Vh=V+(rowbase+(long)tskip*KVBLK)*DM+h*D;
  const unsigned lds0=(unsigned)(uintptr_t)shm;
  float*wsf=(float*)(shm+LDS_WS)+wid*64;
  const unsigned koff=(unsigned)(lane*DM+wid*8), voff=(unsigned)((16*(wid&3)+(lane>>2))*DM+(wid>>2)*32+(lane&3)*8);
  const unsigned kdst=lds0+LDS_K+wid*1024, vdst=lds0+LDS_V+wid*1024;
  #define DMA_K(t,slot) do{unsigned o_=koff;asm volatile("":"+v"(o_));glds16(Kh+(long)(t)*KVBLK*DM+o_,(unsigned)__builtin_amdgcn_readfirstlane(kdst+(slot)));}while(0)
  #define DMA_V(t,slot) do{unsigned o_=voff;asm volatile("":"+v"(o_));glds16(Vh+(long)(t)*KVBLK*DM+o_,(unsigned)__builtin_amdgcn_readfirstlane(vdst+(slot)));}while(0)
  const int vb0=(int)(lds0+LDS_V)+((lane>>4)&1)*32+(lane&3)*8+(4*hi+((lane&15)>>2))*64;
  const char*Kbase=shm+LDS_K; bf16x8 kf[8];
  const lds_cptr shm3=(lds_cptr)shm; const lds_cptr kp0=shm3+LDS_K+hi*1024+r32*16; const lds_cptr vp0=shm3+LDS_V+((lane>>4)&1)*32+(lane&3)*8+(4*hi+((lane&15)>>2))*64;
  const int NT=(q0+QB)/KVBLK-tskip;
  const float*cst=csp+tskip*KVBLK;
  const unsigned hm=hi?0u:0xffffffffu;
  DMA_K(0,0);DMA_V(0,0);DMA_K(1,SLOTB);
  const lds_cptr qls=shm3+LDS_OST+wid*4096+hi*512+r32*16;
  { bf16x8 qr[4];
    #pragma unroll
    for(int d0=0;d0<4;++d0)qr[d0]=*reinterpret_cast<const bf16x8*>(&Qw[(long)r32*DM+d0*16+hi*8]);
    #pragma unroll
    for(int d0=0;d0<4;++d0)*(__attribute__((address_space(3))) bf16x8*)(shm3+LDS_OST+wid*4096+hi*512+r32*16+d0*1024)=qr[d0]; }
  #define QLD(k) (*(const __attribute__((address_space(3))) bf16x8*)(qls+(k)*1024))
  float mhat=csp[q0+wid*QBLK+r32],l_reg=0.f;f32x16 o[2];o[0]=f32x16{};o[1]=f32x16{}; bf16x8 qx=make_qx(-mhat,hm);
  const int qrel=wid*QBLK+r32;
  #define CMASK(P0,P1,t) do{int jb_=(t)-(NT-4); if(jb_>=0)cmask(P0,P1,jb_,qrel,hi);}while(0)
  bool resc=false;
  #define START(P0,P1) do{ const float rm=rowmax(P0,P1); resc=false; \
    if(__any(rm>(float)THRL)){ const float dl=__builtin_fmaxf(rm,0.f); mhat=fadd_s(mhat,dl); \
      _Pragma("unroll") for(int r=0;r<16;++r){P0[r]=fsub_s(P0[r],dl);P1[r]=fsub_s(P1[r],dl);} \
      qx=make_qx(-mhat,hm); } \
    _Pragma("unroll") for(int r=0;r<16;++r)P0[r]=__builtin_amdgcn_exp2f(P0[r]); }while(0)
  #define RESC() do{ if(resc){ asm volatile("s_waitcnt lgkmcnt(0)":::"memory"); \
      _Pragma("unroll") for(int d_=0;d_<2;++d_) _Pragma("unroll") for(int r=0;r<16;++r)o[d_][r]*=wsf[crow(r,hi)]; } }while(0)
  f32x16 pA0,pA1,pB0,pB1;
  int sl_prev=0,sl_cur=0,sl_next=SLOTB;
  #define ROT() do{sl_prev=sl_cur;sl_cur=sl_next;sl_next=(sl_next==(NSLOT-1)*SLOTB)?0:sl_next+SLOTB;}while(0)
  DMA_K(2,2*SLOTB);
  WAIT_BAR(3);
  qkt(pA0,pA1,Kbase,qls,make_ax(cst[r32]),make_ax(cst[32+r32]),qx,r32,hi);asm volatile("s_nop 15\n\ts_nop 7":"+v"(pA0),"+v"(pA1));CMASK(pA0,pA1,0);
  START(pA0,pA1);
  _Pragma("unroll") for(int r=0;r<16;++r)pA1[r]=__builtin_amdgcn_exp2f(pA1[r]);
  WAIT_BAR(0);
  DMA_K(3,0);DMA_V(1,SLOTB);
  ROT();
  kload8(kf,kp0+sl_cur);
  WAIT_BAR(2);
  s16x4 vlo[8],vhi[8]; u32x4 pw0,pw1,pw2,pw3;
  #define PKW(P,B) cvtpk_s(P[B],P[B+1])
  #define PAF(k) __builtin_bit_cast(bf16x8,pw##k)
  #define VFR(i) (bf16x8){vlo[i][0],vlo[i][1],vlo[i][2],vlo[i][3],vhi[i][0],vhi[i][1],vhi[i][2],vhi[i][3]}
  #define PIN(x) asm volatile("":"+v"(x))
  #define MX3(a,b,c) __builtin_fmaxf(__builtin_fmaxf((a),(b)),(c))
  #define GAPA(MF,A0,A1,A2,A3,W0,W1,PW) do{ MF; sacc+=A0; sacc+=A1; sacc+=A2; sacc+=A3; PIN(sacc); W0; W1; PIN(PW); SBAR(); }while(0)
  #define EX(v) __builtin_amdgcn_exp2f(v)
  #define GAPB(MF,X,B) do{ MF; X[B]=EX(X[B]); X[B+1]=EX(X[B+1]); X[B+2]=EX(X[B+2]); X[B+3]=EX(X[B+3]); PIN(X); SBAR(); }while(0)
  #define VRD(i) do{ vlo[i]=vtr(vp_+(((i)>>2)*4096+((i)&3)*1024)); vhi[i]=vtr(vp_+(((i)>>2)*4096+((i)&3)*1024+512)); }while(0)
  #define KRD(G,j) do{ if(G){ kload2(kf,kp0+sl_next,j); SBAR(); } }while(0)
  #define STEP(C0,C1,P0,P1,t,GK,GV,GL) do{ SBAR(); \
    const lds_cptr vp_=vp0+sl_prev; \
    const bf16x8 ax0_=make_ax(cst[(t)*KVBLK+r32]), ax1_=make_ax(cst[(t)*KVBLK+32+r32]); \
    C0=__builtin_amdgcn_mfma_f32_32x32x16_bf16(ax0_,qx,f32x16{},0,0,0); C1=__builtin_amdgcn_mfma_f32_32x32x16_bf16(ax1_,qx,f32x16{},0,0,0); SBAR(); \
    bf16x8 q0_=QLD(0), q1_=QLD(1); \
    VRD(0); SBAR(); float sacc=(P0[0]+P0[1]); \
    GAPA(C0=__builtin_amdgcn_mfma_f32_32x32x16_bf16(kf[0],q0_,C0,0,0,0), P0[2],P0[3],P0[4],P0[5],     pw0[0]=PKW(P0,0), pw0[1]=PKW(P0,2), pw0); \
    VRD(4); SBAR(); GAPA(C1=__builtin_amdgcn_mfma_f32_32x32x16_bf16(kf[1],q0_,C1,0,0,0), P0[6],P0[7],P0[8],P0[9],     pw0[2]=PKW(P0,4), pw0[3]=PKW(P0,6), pw0); q0_=QLD(2); \
    VRD(1); SBAR(); GAPA(C0=__builtin_amdgcn_mfma_f32_32x32x16_bf16(kf[2],q1_,C0,0,0,0),   P0[10],P0[11],P0[12],P0[13], pw1[0]=PKW(P0,8), pw1[1]=PKW(P0,10), pw1); \
    VRD(5); SBAR(); GAPA(C1=__builtin_amdgcn_mfma_f32_32x32x16_bf16(kf[3],q1_,C1,0,0,0),   P0[14],P0[15],P1[0],P1[1],   pw1[2]=PKW(P0,12),pw1[3]=PKW(P0,14), pw1); q1_=QLD(3); \
    VRD(2); SBAR(); GAPA(C0=__builtin_amdgcn_mfma_f32_32x32x16_bf16(kf[4],q0_,C0,0,0,0),   P1[2],P1[3],P1[4],P1[5],     pw2[0]=PKW(P1,0), pw2[1]=PKW(P1,2), pw2); \
    VRD(6); SBAR(); GAPA(C1=__builtin_amdgcn_mfma_f32_32x32x16_bf16(kf[5],q0_,C1,0,0,0),   P1[6],P1[7],P1[8],P1[9],     pw2[2]=PKW(P1,4), pw2[3]=PKW(P1,6), pw2); \
    VRD(3); SBAR(); GAPA(C0=__builtin_amdgcn_mfma_f32_32x32x16_bf16(kf[6],q1_,C0,0,0,0),   P1[10],P1[11],P1[12],P1[13], pw3[0]=PKW(P1,8), pw3[1]=PKW(P1,10), pw3); \
    VRD(7); SBAR(); GAPA(C1=__builtin_amdgcn_mfma_f32_32x32x16_bf16(kf[7],q1_,C1,0,0,0),   P1[14],P1[15],0.f,0.f,       pw3[2]=PKW(P1,12),pw3[3]=PKW(P1,14), pw3); \
    l_reg+=sacc; \
    if(GK){DMA_K((t)+3,sl_cur);} if(GV){DMA_V((t)+1,sl_next);} \
    CMASK(C0,C1,t); \
    { float a=MX3(C0[0],C0[1],C1[0]),b=MX3(C0[2],C0[3],C1[1]); a=MX3(a,C1[2],C1[3]); \
      _Pragma("unroll") for(int r=4;r<16;r+=4){a=MX3(a,C0[r],C0[r+1]);b=MX3(b,C0[r+2],C0[r+3]);a=MX3(a,C1[r],C1[r+1]);b=MX3(b,C1[r+2],C1[r+3]);} \
      float rm=__builtin_fmaxf(a,b); { auto rr=__builtin_amdgcn_permlane32_swap(__float_as_uint(rm),__float_as_uint(rm),false,false); rm=__builtin_fmaxf(__uint_as_float(rr[0]),__uint_as_float(rr[1])); } \
      resc=false; \
      if(__builtin_expect(__any(rm>(float)THRL),0)){ const float dl=__builtin_fmaxf(rm,0.f); mhat+=dl; \
        _Pragma("unroll") for(int r=0;r<16;++r){C0[r]-=dl;C1[r]-=dl;} \
        qx=make_qx(-mhat,hm); \
        const float f=__builtin_amdgcn_exp2f(-dl); l_reg*=f; if(hi==0)wsf[r32]=f; resc=true; } } \
    SBAR(); \
    GAPB(o[0]=__builtin_amdgcn_mfma_f32_32x32x16_bf16(PAF(0),VFR(0),o[0],0,0,0), C0,0); \
    GAPB(o[1]=__builtin_amdgcn_mfma_f32_32x32x16_bf16(PAF(0),VFR(4),o[1],0,0,0), C0,4); \
    KRD(GL,0); GAPB(o[0]=__builtin_amdgcn_mfma_f32_32x32x16_bf16(PAF(1),VFR(1),o[0],0,0,0), C0,8); \
    KRD(GL,1); GAPB(o[1]=__builtin_amdgcn_mfma_f32_32x32x16_bf16(PAF(1),VFR(5),o[1],0,0,0), C0,12); \
    KRD(GL,2); GAPB(o[0]=__builtin_amdgcn_mfma_f32_32x32x16_bf16(PAF(2),VFR(2),o[0],0,0,0), C1,0); \
    KRD(GL,3); GAPB(o[1]=__builtin_amdgcn_mfma_f32_32x32x16_bf16(PAF(2),VFR(6),o[1],0,0,0), C1,4); \
    GAPB(o[0]=__builtin_amdgcn_mfma_f32_32x32x16_bf16(PAF(3),VFR(3),o[0],0,0,0), C1,8); \
    GAPB(o[1]=__builtin_amdgcn_mfma_f32_32x32x16_bf16(PAF(3),VFR(7),o[1],0,0,0), C1,12); \
    }while(0)
  int t=1;
  #undef CMASK
  #define CMASK(P0,P1,t) do{}while(0)
  for(;t+5<NT;t+=2){
    STEP(pB0,pB1,pA0,pA1,t,true,true,true);     WAIT_BAR(2); RESC(); ROT();
    STEP(pA0,pA1,pB0,pB1,t+1,true,true,true);   WAIT_BAR(2); RESC(); ROT();
  }
  #undef CMASK
  #define CMASK(P0,P1,t) do{int jb_=(t)-(NT-4); if(jb_>=0)cmask(P0,P1,jb_,qrel,hi);}while(0)
  #define ENDW(tt) do{ if((tt)+3<NT){WAIT_BAR(2);} else if((tt)+2<NT){WAIT_BAR(1);} else {WAIT_BAR(0);} }while(0)
  for(;t+1<NT;t+=2){
    STEP(pB0,pB1,pA0,pA1,t,(t+3<NT),(t+1<NT),(t+1<NT));       ENDW(t);   RESC(); ROT();
    STEP(pA0,pA1,pB0,pB1,t+1,(t+4<NT),(t+2<NT),(t+2<NT));     ENDW(t+1); RESC(); ROT();
  }
  STEP(pB0,pB1,pA0,pA1,NT-1,false,false,false); RESC();
  { float sacc=pB0[0]+pB0[1]; _Pragma("unroll") for(int r=2;r<16;++r)sacc+=pB0[r]; _Pragma("unroll") for(int r=0;r<16;++r)sacc+=pB1[r]; l_reg+=sacc;
    pw0=(u32x4){PKW(pB0,0),PKW(pB0,2),PKW(pB0,4),PKW(pB0,6)};pw1=(u32x4){PKW(pB0,8),PKW(pB0,10),PKW(pB0,12),PKW(pB0,14)};pw2=(u32x4){PKW(pB1,0),PKW(pB1,2),PKW(pB1,4),PKW(pB1,6)};pw3=(u32x4){PKW(pB1,8),PKW(pB1,10),PKW(pB1,12),PKW(pB1,14)};
    SBAR(); pv(o,vb0+sl_cur,PAF(0),PAF(1),PAF(2),PAF(3)); }
  #undef PKW
  #undef PAF
  #undef VFR
  #undef PIN
  #undef MX3
  #undef GAPA
  #undef GAPB
  #undef EX
  #undef VRD
  #undef KRD
  #undef STEP
  #undef ENDW
  {auto rr=__builtin_amdgcn_permlane32_swap(__float_as_uint(l_reg),__float_as_uint(l_reg),false,false);l_reg=__uint_as_float(rr[0])+__uint_as_float(rr[1]);}
  { int te=tid; asm volatile("":"+v"(te));
    const int lane_e=te&63,r32e=lane_e&31,hie=lane_e>>5;
    if(hie==0)wsf[32+r32e]=l_reg;asm volatile("s_waitcnt lgkmcnt(0)":::"memory");
    float rli[16];
    #pragma unroll
    for(int r=0;r<16;++r)rli[r]=__builtin_amdgcn_rcpf(wsf[32+crow(r,hie)]);
    bf16*Ow=O+(rowbase+q0+wid*QBLK)*DM+h*D; const bf16*Gw=Gt+(rowbase+q0+wid*QBLK)*DM+h*D;
    bf16*stg=(bf16*)(shm+LDS_OST)+wid*2048;
    #pragma unroll
    for(int r=0;r<16;++r){const int orow=crow(r,hie);
      #pragma unroll
      for(int d0=0;d0<2;++d0)stg[orow*64+d0*32+r32e]=__float2bfloat16(o[d0][r]*rli[r]);}
    asm volatile("s_waitcnt lgkmcnt(0)":::"memory");
    #pragma unroll
    for(int i=0;i<4;++i){const int row=i*8+(lane_e>>3),ch=lane_e&7; u32x4 v=*(const u32x4*)(stg+row*64+ch*8); const u32x4 gv=*(const u32x4*)(Gw+(long)row*DM+ch*8);
      #pragma unroll
      for(int e=0;e<4;++e){ const float g0=__uint_as_float(gv[e]<<16),g1=__uint_as_float(gv[e]&0xffff0000u),x0=__uint_as_float(v[e]<<16),x1=__uint_as_float(v[e]&0xffff0000u);
        v[e]=cvtpk_s(x0*__builtin_amdgcn_rcpf(1.f+__expf(-g0)),x1*__builtin_amdgcn_rcpf(1.f+__expf(-g1))); }
      ATTN_STORE16(Ow+(long)row*DM+ch*8,v);} }
  asm volatile("s_waitcnt lgkmcnt(0)\n\ts_barrier":::"memory");
  #undef DMA_K
  #undef QLD
  #undef DMA_V
  #undef CMASK
  #undef START
  #undef RESC
  #undef ROT
}
constexpr int ATTN_LDS_BYTES=LDS_BYTES;
struct AttnTensors { const bf16* Q; const bf16* K; const bf16* V; bf16* O; const bf16* G; const float* CUM; float THR; };
struct AttnUnit { int bh; int qb; };
struct StaticOrder {
  int vcu;
  __device__ __forceinline__ explicit StaticOrder(int grid,int block):vcu((block%8)*(grid/8)+block/8){}
  __device__ __forceinline__ bool next(int i,AttnUnit&u)const{ if(i>=4)return false; const int s=2*(vcu&1)+(i>>1); u.bh=vcu>>1; u.qb=(i&1)?7-s:s; return true; }
  __device__ __forceinline__ void a_ready(const AttnUnit&)const{}
  __device__ __forceinline__ void done(const AttnUnit&)const{}
};
template<class Sched,int THRL=8> __device__ __forceinline__ void attn_phase(char*lds,const AttnTensors&T,const Sched&S,int tid_in){
  AttnUnit u; int tid_=tid_in; asm volatile("":"+v"(tid_));
  if(S.next(0,u)){ float*csp=(float*)(lds+LDS_CS); float*wt=(float*)(lds+LDS_WS); int tp=tid_in; asm volatile("":"+v"(tp));
    const float*lf=T.CUM+((long)(u.bh/NHEAD)*SEQ+4*tp)*NHEAD+u.bh%NHEAD;
    const float a0=lf[0],a1=a0+lf[NHEAD],a2=a1+lf[2*NHEAD],a3=a2+lf[3*NHEAD];
    float sc=a3; const int ln=tp&63;
    #pragma unroll
    for(int o=1;o<64;o<<=1){ const float up=__builtin_bit_cast(float,__builtin_amdgcn_ds_bpermute((ln-o)<<2,__builtin_bit_cast(int,sc))); if(ln>=o)sc+=up; }
    if(ln==63)wt[tp>>6]=sc;
    __syncthreads();
    float base=sc-a3;
    #pragma unroll
    for(int w=0;w<NW-1;++w)if(w<(tp>>6))base+=wt[w];
    const float k2=-1.4426950408889634f;
    csp[4*tp]=k2*(base+a0);csp[4*tp+1]=k2*(base+a1);csp[4*tp+2]=k2*(base+a2);csp[4*tp+3]=k2*(base+a3);
    __syncthreads(); }
  for(int i=0;S.next(i,u);++i){ S.a_ready(u); attn_unit<THRL>(u.bh/NHEAD,u.bh%NHEAD,u.qb,T.Q,T.K,T.V,T.O,T.G,lds,tid_,T.THR); S.done(u); }
}
#undef SBAR
#undef WAIT_BAR
}
#define GAS __attribute__((address_space(1)))
#define LAS __attribute__((address_space(3)))
typedef unsigned short bf16;
typedef unsigned v4u __attribute__((ext_vector_type(4)));
typedef float f32x4 __attribute__((ext_vector_type(4)));
typedef short bf16x8 __attribute__((ext_vector_type(8)));
typedef GAS unsigned gu32;
typedef GAS unsigned long long gu64;
#define RLX_AGENT __ATOMIC_RELAXED, __HIP_MEMORY_SCOPE_AGENT
#define LDS_WAIT() asm volatile("s_waitcnt lgkmcnt(0)" ::: "memory")
#define VM_WAIT() asm volatile("s_waitcnt vmcnt(0)" ::: "memory")
__device__ __forceinline__ unsigned long long rt() { return __builtin_amdgcn_s_memrealtime(); }
__device__ __forceinline__ unsigned f2bf(float f) { unsigned u = __builtin_bit_cast(unsigned, f); return (u + 0x7fffu + ((u >> 16) & 1u)) >> 16; }
__device__ __forceinline__ unsigned pk2(float lo, float hi) { return f2bf(lo) | (f2bf(hi) << 16); }

#define XB_TMO      128
#define XB_XCNT(j)  (256  + 64 * (j))
#define XB_XSUB(j)  (1280 + 64 * (j))
#define XB_XGEN(j)  (2304 + 64 * (j))
#define XB_TOP      3328
#define XB_TOPGEN   3392
#define XCD_BAR_WORDS 3456
#define XB_SPIN_CAP (1u << 27)

__device__ __forceinline__ unsigned xb_ld(unsigned* p)              { return __hip_atomic_load(p, __ATOMIC_RELAXED, __HIP_MEMORY_SCOPE_AGENT); }
__device__ __forceinline__ unsigned xb_add(unsigned* p, unsigned v) { return __hip_atomic_fetch_add(p, v, __ATOMIC_RELAXED, __HIP_MEMORY_SCOPE_AGENT); }
__device__ __forceinline__ unsigned xb_xcc_id() { return (unsigned)__builtin_amdgcn_s_getreg((3 << 11) | 20) & 0xFu; }
#define XB_SPIN(cond, bar) do { unsigned _sp = 0; while (cond) { __builtin_amdgcn_s_sleep(1); \
    if ((++_sp & 255u) == 0u) { if (xb_ld(&(bar)[XB_TMO])) break; if (_sp > XB_SPIN_CAP) { atomicAdd(&(bar)[XB_TMO], 1u); break; } } } } while (0)

struct XcdBarrier {
    unsigned* bar; unsigned x;
    volatile LAS unsigned* st;
};

__device__ __forceinline__ XcdBarrier xcd_barrier_post(unsigned* bar, volatile LAS unsigned* st) {
    XcdBarrier b; b.bar = bar; b.x = xb_xcc_id(); b.st = st;
    if (threadIdx.x == 0) (void)xb_add(&bar[XB_XCNT(b.x)], 1u);
    return b;
}
__device__ __forceinline__ void xcd_barrier_complete(unsigned* bar, unsigned x, unsigned& nloc, unsigned& nx) {
    const unsigned G = gridDim.x * gridDim.y * gridDim.z;
    unsigned sum, cnt, mine, sp = 0u;
    for (;;) {
        sum = 0u; cnt = 0u; mine = 0u;
#pragma unroll
        for (unsigned j = 0; j < 16; ++j) { const unsigned c = xb_ld(&bar[XB_XCNT(j)]); sum += c; cnt += (c > 0u) ? 1u : 0u; mine = (j == x) ? c : mine; }
        if (sum == G) break;
        __builtin_amdgcn_s_sleep(1);
        if ((++sp & 255u) == 0u) { if (xb_ld(&bar[XB_TMO])) break; if (sp > XB_SPIN_CAP) { atomicAdd(&bar[XB_TMO], 1u); break; } }
    }
    nloc = mine > 0u ? mine : 1u; nx = cnt > 0u ? cnt : 1u;
}

__device__ __forceinline__ void xcd_barrier(const XcdBarrier& b, const bool leader  ) {
    asm volatile("s_waitcnt vmcnt(0)" ::: "memory");
    __syncthreads();
    if (leader) {
        unsigned* bar = b.bar;
        __builtin_amdgcn_s_waitcnt(0);
        unsigned nloc = b.st[0], nx = b.st[1];
        if (nloc == 0u) { xcd_barrier_complete(bar, b.x, nloc, nx); b.st[0] = nloc; b.st[1] = nx; }
        const unsigned old = xb_add(&bar[XB_XSUB(b.x)], 1u);
        const unsigned gen = old / nloc;
        if (old + 1u == (gen + 1u) * nloc) {
            __builtin_amdgcn_fence(__ATOMIC_RELEASE, "agent");
            asm volatile("s_waitcnt vmcnt(0)" ::: "memory");
            const unsigned og = xb_add(&bar[XB_TOP], 1u);
            const unsigned tg = og / nx;
            if (og + 1u == (tg + 1u) * nx) xb_add(&bar[XB_TOPGEN], 1u);
            else XB_SPIN(xb_ld(&bar[XB_TOPGEN]) == tg, bar);
            __builtin_amdgcn_fence(__ATOMIC_ACQUIRE, "agent");
            xb_add(&bar[XB_XGEN(b.x)], 1u);
            asm volatile("s_waitcnt vmcnt(0)" ::: "memory");
        } else {
            XB_SPIN(xb_ld(&bar[XB_XGEN(b.x)]) == gen, bar);
            __builtin_amdgcn_fence(__ATOMIC_ACQUIRE, "agent");
            asm volatile("s_waitcnt vmcnt(0)" ::: "memory");
        }
    }
    __syncthreads();
}
#ifndef MK_FASTATTN
#define MK_FASTATTN 1
#endif
#ifndef MK_FASTREC
#define MK_FASTREC 1
#endif
namespace cg = cooperative_groups;
constexpr int NTOK = 16384, DMODEL = 1024, NBATCH = 8, SEQLEN = 2048, DEPTH = 4;
constexpr int FOX_IN = 4112, GLA_IN = 3088, HGRN_IN = 4096;
constexpr float RMS_EPS = 1e-6f;
constexpr float LOG2E = 1.4426950408889634f;
constexpr float FOX_C2 = 0.125f * LOG2E;
constexpr int NWAVES = 8;

constexpr size_t MiB = 1u << 20;
constexpr size_t WS_CTL = 0, CTL_ZERO_BYTES = 1 * MiB;
constexpr size_t WS_FOXWIN = 2 * MiB, WS_FOXWOUT = 18 * MiB, WS_GLAWIN = 22 * MiB, WS_GLAWOUT = 28 * MiB, WS_HGRNWIN = 30 * MiB, WS_HGRNWOUT = 38 * MiB;
constexpr size_t WS_PEERWQ = 40 * MiB, WS_KEYS = 56 * MiB, WS_LB = 58 * MiB;
#ifndef BGQ
#define BGQ 1
#endif
#ifndef I8MASK
#define I8MASK 13
#endif
constexpr size_t WS_SW = 58 * MiB + 65536, WS_SX = 58 * MiB + 262144, WS_XN8 = 724 * MiB;
constexpr size_t WS_TAILW = 63 * MiB;
constexpr size_t WS_RS = 62 * MiB;
constexpr size_t WS_U = 64 * MiB, WS_V = 128 * MiB, WS_SU = 60 * MiB, WS_SV = 61 * MiB;
constexpr size_t WS_XN = 320 * MiB, WS_P = 352 * MiB, WS_OB = 480 * MiB, WS_Q2 = 512 * MiB, WS_TAIL = 576 * MiB, WS_CUM = 577 * MiB;
constexpr size_t WS_EXP = 580 * MiB, WS_GATE = 588 * MiB, WS_OF = 596 * MiB, WS_GLOG = 660 * MiB, WS_HB = 740 * MiB, WS_END = 772 * MiB;
constexpr size_t PSTRIDE = (size_t)NTOK * 1024;
constexpr int CW_BAR = 4096;

constexpr int RING_BYTES = 131072;
constexpr int LDSCTL_OFF = RING_BYTES, MISC_OFF = LDSCTL_OFF + 320;
constexpr int LDS_BYTES = 147456;

typedef unsigned u32x4v __attribute__((ext_vector_type(4)));
struct Ctx {
    LAS unsigned char* lds; int tid, lane, wave, vcu, G, gw, NGW, bx;
    const float* in[21]; float* out; unsigned char* ws;
};

__device__ __forceinline__ float bf2f(unsigned short b) { return __uint_as_float(((unsigned)b) << 16); }
__device__ __forceinline__ float bflo(unsigned w) { return __uint_as_float(w << 16); }
__device__ __forceinline__ float bfhi(unsigned w) { return __uint_as_float(w & 0xffff0000u); }
#define DPP_ADD(v, ctrl, rm, bm) (v + __builtin_bit_cast(float, __builtin_amdgcn_update_dpp(0, __builtin_bit_cast(int, v), ctrl, rm, bm, false)))
#define DPP_MAX(v, ctrl, rm, bm) fmaxf(v, __builtin_bit_cast(float, __builtin_amdgcn_update_dpp(__builtin_bit_cast(int, v), __builtin_bit_cast(int, v), ctrl, rm, bm, false)))
#define DPP_SUM31(v) do { v = DPP_ADD(v, 0x111, 0xf, 0xf); v = DPP_ADD(v, 0x112, 0xf, 0xf); v = DPP_ADD(v, 0x114, 0xf, 0xe); v = DPP_ADD(v, 0x118, 0xf, 0xc); v = DPP_ADD(v, 0x142, 0xa, 0xf); } while (0)
#define DPP_SUM63(v) do { DPP_SUM31(v); v = DPP_ADD(v, 0x143, 0xc, 0xf); } while (0)
__device__ __forceinline__ float rdlane(float v, int lane) { return __builtin_bit_cast(float, __builtin_amdgcn_readlane(__builtin_bit_cast(int, v), lane)); }
__device__ __forceinline__ float wave_sum(float v) { DPP_SUM63(v); return rdlane(v, 63); }
__device__ __forceinline__ float wave_max(float v) {
    v = DPP_MAX(v, 0x111, 0xf, 0xf); v = DPP_MAX(v, 0x112, 0xf, 0xf); v = DPP_MAX(v, 0x114, 0xf, 0xe); v = DPP_MAX(v, 0x118, 0xf, 0xc); v = DPP_MAX(v, 0x142, 0xa, 0xf); v = DPP_MAX(v, 0x143, 0xc, 0xf);
    return rdlane(v, 63);
}
typedef __bf16 bf16x2_t __attribute__((ext_vector_type(2)));
__device__ __forceinline__ float dot2bf(unsigned w, unsigned x, float acc) { return __builtin_amdgcn_fdot2_f32_bf16(__builtin_bit_cast(bf16x2_t, w), __builtin_bit_cast(bf16x2_t, x), acc, false); }
__device__ __forceinline__ float bperm(float v, int src_lane) { return __builtin_bit_cast(float, __builtin_amdgcn_ds_bpermute(src_lane << 2, __builtin_bit_cast(int, v))); }
__device__ __forceinline__ float log_sigmoid_f(float x) { return fminf(x, 0.f) - log1pf(__expf(-fabsf(x))); }
__device__ __forceinline__ float sigmoid_f(float x) { return 1.f / (1.f + __expf(-x)); }

__device__ __forceinline__ void p0_transpose_item(const float* W, int ldw, int K, int Nuse, bf16* WT, LAS float* scr, int item, int lane) {
    const int nblk = Nuse / 32, kb = item / nblk, nb = item % nblk, k0 = 64 * kb, n0 = 32 * nb;
#pragma unroll
    for (int i = 0; i < 8; ++i) { const int kk = 8 * i + (lane >> 3); const f32x4 v = *(const GAS f32x4*)(W + (size_t)(k0 + kk) * ldw + n0 + 4 * (lane & 7));
        LAS float* d = scr + kk * 33 + 4 * (lane & 7); d[0] = v.x; d[1] = v.y; d[2] = v.z; d[3] = v.w; }
    LDS_WAIT(); asm volatile("" ::: "memory");
    const int c = lane & 7;
#pragma unroll
    for (int j = 0; j < 4; ++j) { const int n = (lane >> 3) + 8 * j; const LAS float* s = scr + (8 * c) * 33 + n;
        v4u o; o.x = pk2(s[0 * 33], s[1 * 33]); o.y = pk2(s[2 * 33], s[3 * 33]); o.z = pk2(s[4 * 33], s[5 * 33]); o.w = pk2(s[6 * 33], s[7 * 33]);
        *(GAS v4u*)(WT + (size_t)(n0 + n) * K + k0 + 8 * c) = o; }
    LDS_WAIT(); asm volatile("" ::: "memory");
}
__device__ __forceinline__ unsigned q8x4(float a, float b, float c, float d) {
    return ((unsigned)(int)__builtin_rintf(a) & 0xffu) | (((unsigned)(int)__builtin_rintf(b) & 0xffu) << 8) | (((unsigned)(int)__builtin_rintf(c) & 0xffu) << 16) | ((unsigned)(int)__builtin_rintf(d) << 24);
}
__device__ __forceinline__ void p0_colmax_item(const float* W, int ldw, unsigned* cmax, int item, int lane) {
    const int nb = item >> 3, n0 = 32 * nb, k0 = 128 * (item & 7);
    f32x4 v[16];
#pragma unroll
    for (int i = 0; i < 16; ++i) v[i] = *(const GAS f32x4*)(W + (size_t)(k0 + 8 * i + (lane >> 3)) * ldw + n0 + 4 * (lane & 7));
    __builtin_amdgcn_sched_barrier(0);
    float mx[4] = {0.f, 0.f, 0.f, 0.f};
#pragma unroll
    for (int i = 0; i < 16; ++i) { mx[0] = fmaxf(mx[0], fabsf(v[i].x)); mx[1] = fmaxf(mx[1], fabsf(v[i].y)); mx[2] = fmaxf(mx[2], fabsf(v[i].z)); mx[3] = fmaxf(mx[3], fabsf(v[i].w)); }
#pragma unroll
    for (int j = 0; j < 4; ++j) { mx[j] = fmaxf(mx[j], bperm(mx[j], lane ^ 8)); mx[j] = fmaxf(mx[j], bperm(mx[j], lane ^ 16)); mx[j] = fmaxf(mx[j], bperm(mx[j], lane ^ 32)); }
    if (lane < 8) {
#pragma unroll
        for (int j = 0; j < 4; ++j) (void)__hip_atomic_fetch_max(cmax + n0 + 4 * lane + j, __float_as_uint(mx[j]), __ATOMIC_RELAXED, __HIP_MEMORY_SCOPE_AGENT);
    }
}
__device__ __forceinline__ void p0_quant_item(const float* W, int ldw, const unsigned* cmax, signed char* W8, float* sw, LAS float* scr, int item, int lane) {
    const int nb = item >> 3, n0 = 32 * nb, k0 = 128 * (item & 7);
    f32x4 v[2][8];
#pragma unroll
    for (int h = 0; h < 2; ++h)
#pragma unroll
        for (int i = 0; i < 8; ++i) v[h][i] = *(const GAS f32x4*)(W + (size_t)(k0 + 64 * h + 8 * i + (lane >> 3)) * ldw + n0 + 4 * (lane & 7));
    float ci[4];
#pragma unroll
    for (int j = 0; j < 4; ++j) { const float m = __uint_as_float(*(const GAS unsigned*)(cmax + n0 + (lane >> 3) + 8 * j)); ci[j] = m > 0.f ? 127.f / m : 0.f; }
    if ((item & 7) == 0 && lane < 32) *(GAS float*)(sw + n0 + lane) = __uint_as_float(*(const GAS unsigned*)(cmax + n0 + lane)) * (1.f / 127.f);
    __builtin_amdgcn_sched_barrier(0);
    const int c = lane & 7;
#pragma unroll
    for (int h = 0; h < 2; ++h) {
        LDS_WAIT(); asm volatile("" ::: "memory");
#pragma unroll
        for (int i = 0; i < 8; ++i) { LAS float* d = scr + (8 * i + (lane >> 3)) * 33 + 4 * (lane & 7); d[0] = v[h][i].x; d[1] = v[h][i].y; d[2] = v[h][i].z; d[3] = v[h][i].w; }
        LDS_WAIT(); asm volatile("" ::: "memory");
#pragma unroll
        for (int j = 0; j < 4; ++j) { const int n = (lane >> 3) + 8 * j; const LAS float* sp = scr + (8 * c) * 33 + n;
            const unsigned lo = q8x4(sp[0] * ci[j], sp[33] * ci[j], sp[66] * ci[j], sp[99] * ci[j]), hi = q8x4(sp[132] * ci[j], sp[165] * ci[j], sp[198] * ci[j], sp[231] * ci[j]);
            *(GAS unsigned long long*)(W8 + (size_t)(n0 + n) * 1024 + k0 + 64 * h + 8 * c) = (unsigned long long)lo | ((unsigned long long)hi << 32); }
    }
    LDS_WAIT(); asm volatile("" ::: "memory");
}
__device__ __forceinline__ void rms_row_to_bf16(int lane, f32x4 (&v)[4], const float* gain, bf16* orow, signed char* orow8, float* sx) {
    const GAS f32x4* gr = (const GAS f32x4*)gain + lane;
    float s = 0.f;
#pragma unroll
    for (int j = 0; j < 4; ++j) s += (v[j].x * v[j].x + v[j].y * v[j].y) + (v[j].z * v[j].z + v[j].w * v[j].w);
    const float r = rsqrtf(wave_sum(s) * (1.f / 1024.f) + RMS_EPS);
    GAS unsigned long long* o8 = (GAS unsigned long long*)orow + lane; float am = 0.f;
#pragma unroll
    for (int j = 0; j < 4; ++j) { const f32x4 g = gr[64 * j]; v[j].x *= r * g.x; v[j].y *= r * g.y; v[j].z *= r * g.z; v[j].w *= r * g.w;
        am = fmaxf(fmaxf(am, fmaxf(fabsf(v[j].x), fabsf(v[j].y))), fmaxf(fabsf(v[j].z), fabsf(v[j].w)));
        o8[64 * j] = (unsigned long long)pk2(v[j].x, v[j].y) | ((unsigned long long)pk2(v[j].z, v[j].w) << 32); }
    am = wave_max(am); const float qi = am > 0.f ? 127.f / am : 0.f;
    GAS unsigned* q8 = (GAS unsigned*)orow8 + lane;
#pragma unroll
    for (int j = 0; j < 4; ++j) q8[64 * j] = q8x4(v[j].x * qi, v[j].y * qi, v[j].z * qi, v[j].w * qi);
    if (lane == 0) *(GAS float*)sx = am * (1.f / 127.f);
}
__device__ __forceinline__ void cvt_f32_bf16(const Ctx& C, const float* src, bf16* dst, size_t n) {
    const size_t nth = (size_t)C.G * 512, t0 = (size_t)C.vcu * 512 + C.tid;
    for (size_t i = t0; i < n / 8; i += nth) {
        const f32x4 a = ((const GAS f32x4*)src)[2 * i], b = ((const GAS f32x4*)src)[2 * i + 1];
        v4u o; o.x = pk2(a.x, a.y); o.y = pk2(a.z, a.w); o.z = pk2(b.x, b.y); o.w = pk2(b.z, b.w);
        ((GAS v4u*)dst)[i] = o;
    }
}
__device__ __forceinline__ void quant_row_fp8(int lane, const f32x4 (&v)[4], unsigned char* drow, float* sc) {
    float am = 0.f;
#pragma unroll
    for (int i = 0; i < 4; ++i) am = fmaxf(am, fmaxf(fmaxf(fabsf(v[i].x), fabsf(v[i].y)), fmaxf(fabsf(v[i].z), fabsf(v[i].w))));
    am = wave_max(am);
    const float inv = am > 0.f ? 448.f / am : 0.f;
    GAS unsigned* o = (GAS unsigned*)drow + lane;
#pragma unroll
    for (int i = 0; i < 4; ++i) {
        const float a = fminf(fmaxf(v[i].x * inv, -448.f), 448.f), b = fminf(fmaxf(v[i].y * inv, -448.f), 448.f), c = fminf(fmaxf(v[i].z * inv, -448.f), 448.f), d = fminf(fmaxf(v[i].w * inv, -448.f), 448.f);
        int w = 0; w = __builtin_amdgcn_cvt_pk_fp8_f32(a, b, w, false); w = __builtin_amdgcn_cvt_pk_fp8_f32(c, d, w, true); o[64 * i] = (unsigned)w;
    }
    if (lane == 0) *(GAS float*)sc = am * (1.f / 448.f);
}
__device__ __forceinline__ void quant_rows_fp8(const Ctx& C, const float* src, unsigned char* dst, float* scales, int nrows) {
    int rw = C.gw;
    for (; rw + 3 * C.NGW < nrows; rw += 4 * C.NGW) {
        f32x4 v[4][4];
#pragma unroll
        for (int j = 0; j < 4; ++j) { const GAS f32x4* xr = (const GAS f32x4*)(src + (size_t)(rw + j * C.NGW) * 1024) + C.lane;
#pragma unroll
            for (int i = 0; i < 4; ++i) v[j][i] = xr[64 * i]; }
        __builtin_amdgcn_sched_barrier(0);
#pragma unroll
        for (int j = 0; j < 4; ++j) quant_row_fp8(C.lane, v[j], dst + (size_t)(rw + j * C.NGW) * 1024, scales + rw + j * C.NGW);
    }
    for (; rw < nrows; rw += C.NGW) {
        const GAS f32x4* xr = (const GAS f32x4*)(src + (size_t)rw * 1024) + C.lane;
        f32x4 v[4];
#pragma unroll
        for (int i = 0; i < 4; ++i) v[i] = xr[64 * i];
        quant_row_fp8(C.lane, v, dst + (size_t)rw * 1024, scales + rw);
    }
}
constexpr int BGQ_ROWS = 3 * 16384;
template <int JOB> __device__ __forceinline__ void bgq_row(const Ctx& C, int idx, const float*& src, unsigned char*& dst, float*& sc) {
    const int seg = idx >> 14, row = idx & 16383;
    const bool isV = seg == 1 || (seg == 2 && JOB == 2);
    const size_t flat = (size_t)(seg < 2 ? JOB : 3) * 16384 + row;
    src = (isV ? C.in[20] : C.in[19]) + flat * 1024; dst = C.ws + (isV ? WS_V : WS_U) + flat * 1024; sc = (float*)(C.ws + (isV ? WS_SV : WS_SU)) + flat;
}
template <int JOB> __device__ __forceinline__ void bgq_step(const Ctx& C, int idx_prev, int idx, f32x4 (&v)[4]) {
    const float* src; unsigned char* dst; float* sc;
    if (idx_prev >= 0 && idx_prev < BGQ_ROWS) { bgq_row<JOB>(C, idx_prev, src, dst, sc); quant_row_fp8(C.lane, v, dst, sc); }
    if (idx < BGQ_ROWS) { bgq_row<JOB>(C, idx, src, dst, sc); const GAS f32x4* xr = (const GAS f32x4*)src + C.lane;
#pragma unroll
        for (int i = 0; i < 4; ++i) v[i] = xr[64 * i]; }
}
#ifndef PRO_PROBE
#define PRO_PROBE 0
#endif
constexpr int CW_CMAX = 131072;
constexpr int I8_NF0 = (I8MASK & 1) ? 1024 : 0, I8_NF3 = (I8MASK & 8) ? 1024 : 0, I8_NG = (I8MASK & 2) ? 768 : 0, I8_NH = (I8MASK & 4) ? 1024 : 0, I8_NITEMS = I8_NF0 + I8_NF3 + I8_NG + I8_NH;
template <bool PASS2> __device__ __forceinline__ void p0_i8_items(const Ctx& C, LAS float* scr) {
    unsigned* CM = (unsigned*)(C.ws + WS_CTL) + CW_CMAX; float* SW = (float*)(C.ws + WS_SW);
    for (int it = C.gw; it < I8_NITEMS; it += C.NGW) {
        int r = it; const float* W; int ldw; signed char* W8; int q;
        if (r < I8_NF0) { W = C.in[3]; ldw = FOX_IN; W8 = (signed char*)(C.ws + WS_FOXWIN); q = 0; }
        else if ((r -= I8_NF0) < I8_NF3) { W = C.in[3] + (size_t)1024 * FOX_IN; ldw = FOX_IN; W8 = (signed char*)(C.ws + WS_FOXWIN + 8 * MiB); q = 1; }
        else if ((r -= I8_NF3) < I8_NG) { W = C.in[8]; ldw = GLA_IN; W8 = (signed char*)(C.ws + WS_GLAWIN); q = 2; }
        else { r -= I8_NG; W = C.in[13]; ldw = HGRN_IN; W8 = (signed char*)(C.ws + WS_HGRNWIN); q = 3; }
        const int swo = q == 0 ? 0 : q == 1 ? 4096 : q == 2 ? 8192 : 11264;
        if (PASS2) p0_quant_item(W, ldw, CM + q * 4096, W8, SW + swo, scr, r, C.lane); else p0_colmax_item(W, ldw, CM + q * 4096, r, C.lane);
    }
}
__device__ __forceinline__ void p0_prologue_b(const Ctx& C) { p0_i8_items<true>(C, (LAS float*)(C.lds + C.wave * 16384)); }
__device__ __forceinline__ void p0_prologue(const Ctx& C) {
    LAS float* scr = (LAS float*)(C.lds + C.wave * 16384);
    for (int rep_ = 0; rep_ < (PRO_PROBE == 1 ? 2 : 1); ++rep_) {
    p0_i8_items<false>(C, scr);
    constexpr int I_SQ = 16 * 32, N_F0 = (I8MASK & 1) ? 0 : 16 * 128, N_F3 = (I8MASK & 8) ? 0 : 16 * 128, N_G = (I8MASK & 2) ? 0 : 16 * 96, N_H = (I8MASK & 4) ? 0 : 16 * 128;
    constexpr int NITEMS = N_F0 + N_F3 + N_G + N_H + 2 * I_SQ + I_SQ + I_SQ;
    for (int it = C.gw; it < NITEMS; it += C.NGW) {
        int r = it;
        if (r < N_F0) { p0_transpose_item(C.in[3], FOX_IN, 1024, 4096, (bf16*)(C.ws + WS_FOXWIN), scr, r, C.lane); continue; } r -= N_F0;
        if (r < N_F3) { p0_transpose_item(C.in[3] + (size_t)1024 * FOX_IN, FOX_IN, 1024, 4096, (bf16*)(C.ws + WS_FOXWIN + 8 * MiB), scr, r, C.lane); continue; } r -= N_F3;
        if (r < N_G) { p0_transpose_item(C.in[8], GLA_IN, 1024, 3072, (bf16*)(C.ws + WS_GLAWIN), scr, r, C.lane); continue; } r -= N_G;
        if (r < N_H) { p0_transpose_item(C.in[13], HGRN_IN, 1024, 4096, (bf16*)(C.ws + WS_HGRNWIN), scr, r, C.lane); continue; } r -= N_H;
        if (r < 2 * I_SQ) { const int j = r / I_SQ; p0_transpose_item(C.in[7] + (size_t)j * 1024 * 1024, 1024, 1024, 1024, (bf16*)(C.ws + WS_FOXWOUT) + (size_t)j * 1024 * 1024, scr, r % I_SQ, C.lane); continue; } r -= 2 * I_SQ;
        if (r < I_SQ) { p0_transpose_item(C.in[12], 1024, 1024, 1024, (bf16*)(C.ws + WS_GLAWOUT), scr, r, C.lane); continue; } r -= I_SQ;
        p0_transpose_item(C.in[16], 1024, 1024, 1024, (bf16*)(C.ws + WS_HGRNWOUT), scr, r, C.lane);
    }
    }
    for (int rep_ = 0; rep_ < (PRO_PROBE == 2 ? 2 : 1); ++rep_) {
    constexpr int MT_GROUPS = 4 * 16 * 4 * 32;
    for (int grp = C.gw; grp < MT_GROUPS; grp += C.NGW) {
        const int nb2 = grp & 31, kb2 = (grp >> 5) & 3, hp = (grp >> 7) & 15, layer = grp >> 11;
        const float* kp = C.in[18] + ((size_t)(layer * 16 + hp) * 128 + kb2 * 32 + (C.lane & 15)) * 128 + 4 * (C.lane >> 4);
        const float* wp = C.in[17] + ((size_t)layer * 1024 + nb2 * 32 + (C.lane & 15)) * 2048 + hp * 128 + 4 * (C.lane >> 4);
        f32x4 ka[2][8], wb[2][8];
#pragma unroll
        for (int u = 0; u < 2; ++u)
#pragma unroll
            for (int s8 = 0; s8 < 8; ++s8) { ka[u][s8] = *(const GAS f32x4*)(kp + (size_t)u * 16 * 128 + 16 * s8); wb[u][s8] = *(const GAS f32x4*)(wp + (size_t)u * 16 * 2048 + 16 * s8); }
        __builtin_amdgcn_sched_barrier(0);
        f32x4 acc[2][2];
#pragma unroll
        for (int a = 0; a < 2; ++a)
#pragma unroll
            for (int b = 0; b < 2; ++b) acc[a][b] = (f32x4){0.f, 0.f, 0.f, 0.f};
#pragma unroll
        for (int s8 = 0; s8 < 8; ++s8)
#pragma unroll
            for (int a = 0; a < 2; ++a)
#pragma unroll
                for (int b = 0; b < 2; ++b) { const f32x4 x = ka[a][s8], y = wb[b][s8];
                    acc[a][b] = __builtin_amdgcn_mfma_f32_16x16x4f32(x.x, y.x, acc[a][b], 0, 0, 0); acc[a][b] = __builtin_amdgcn_mfma_f32_16x16x4f32(x.y, y.y, acc[a][b], 0, 0, 0);
                    acc[a][b] = __builtin_amdgcn_mfma_f32_16x16x4f32(x.z, y.z, acc[a][b], 0, 0, 0); acc[a][b] = __builtin_amdgcn_mfma_f32_16x16x4f32(x.w, y.w, acc[a][b], 0, 0, 0); }
#pragma unroll
        for (int a = 0; a < 2; ++a)
#pragma unroll
            for (int b = 0; b < 2; ++b) {
                bf16* mt = (bf16*)(C.ws + WS_PEERWQ) + ((size_t)layer * 2048 + hp * 128 + kb2 * 32 + a * 16 + (C.lane >> 4) * 4) * 1024 + nb2 * 32 + b * 16 + (C.lane & 15);
#pragma unroll
                for (int r = 0; r < 4; ++r) mt[(size_t)r * 1024] = (bf16)f2bf(acc[a][b][r]); }
    }
    }
    for (int rep_ = 0; rep_ < (PRO_PROBE == 3 ? 2 : 1); ++rep_) {
    quant_rows_fp8(C, C.in[19], C.ws + WS_U, (float*)(C.ws + WS_SU), BGQ ? 16384 : 4 * 16384);
    quant_rows_fp8(C, C.in[20], C.ws + WS_V, (float*)(C.ws + WS_SV), BGQ ? 16384 : 4 * 16384);
    }
    for (int rep_ = 0; rep_ < (PRO_PROBE == 4 ? 2 : 1); ++rep_) {
    for (int i = C.vcu * 512 + C.tid; i < 3 * 16 * 1024; i += C.G * 512) {
        const int w = i >> 14, n = (i >> 10) & 15, k = i & 1023;
        const float v = w < 2 ? C.in[3][(size_t)w * 1024 * FOX_IN + (size_t)k * FOX_IN + 4096 + n] : C.in[8][(size_t)k * GLA_IN + 3072 + n];
        ((bf16*)(C.ws + WS_TAILW))[i] = (bf16)f2bf(v);
    }
    if (C.vcu == 0) for (int c = C.tid; c < 1024; c += 512) {
        const float l0 = C.in[14][c], l1 = C.in[14][1024 + c], l2 = C.in[14][2048 + c], l3 = C.in[14][3072 + c];
        const float m = fmaxf(fmaxf(l0, l1), fmaxf(l2, l3));
        const float e0 = expf(l0 - m), e1 = expf(l1 - m), e2 = expf(l2 - m), e3 = expf(l3 - m);
        ((float*)(C.ws + WS_LB))[c] = (e1 + e2) / (e0 + e1 + e2 + e3);
    }
    for (int m0 = C.gw; m0 < NTOK; m0 += 4 * C.NGW) {
        f32x4 v[4][4];
#pragma unroll
        for (int u = 0; u < 4; ++u) { const int m = m0 + u * C.NGW; if (m < NTOK) { const GAS f32x4* xr = (const GAS f32x4*)(C.in[0] + (size_t)m * 1024) + C.lane;
#pragma unroll
            for (int j = 0; j < 4; ++j) v[u][j] = xr[64 * j]; } }
        __builtin_amdgcn_sched_barrier(0);
#pragma unroll
        for (int u = 0; u < 4; ++u) { const int m = m0 + u * C.NGW; if (m < NTOK)
            rms_row_to_bf16(C.lane, v[u], C.in[1], (bf16*)(C.ws + WS_XN) + (size_t)m * 1024, (signed char*)(C.ws + WS_XN8) + (size_t)m * 1024, (float*)(C.ws + WS_SX) + m); }
    }
    }
}

__device__ __forceinline__ void tail_mfma(const Ctx& C, int tok0, const bf16* WT, LAS float* part) {
    const int l = C.lane, m = l & 15, g = l >> 4, tbk = C.wave & 3, kh = C.wave >> 2;
    const bf16* ap = (const bf16*)(C.ws + WS_XN) + (size_t)(tok0 + 16 * tbk + m) * 1024 + kh * 512 + 8 * g;
    const bf16* bp = WT + (size_t)m * 1024 + kh * 512 + 8 * g;
    f32x4 acc = (f32x4){0.f, 0.f, 0.f, 0.f};
#pragma unroll 4
    for (int ks = 0; ks < 16; ++ks) acc = __builtin_amdgcn_mfma_f32_16x16x32_bf16(*(const bf16x8*)(ap + 32 * ks), *(const bf16x8*)(bp + 32 * ks), acc, 0, 0, 0);
#pragma unroll
    for (int r = 0; r < 4; ++r) part[kh * 1024 + (16 * tbk + 4 * g + r) * 16 + m] = acc[r];
}
__device__ __forceinline__ void fox_step1(const Ctx& C, int j) {
    float* TAIL = (float*)(C.ws + WS_TAIL); LAS float* part = (LAS float*)C.lds;
    const bf16* WT = (const bf16*)(C.ws + WS_TAILW) + (size_t)j * 16 * 1024;
    for (int tb = C.vcu; tb < NTOK / 64; tb += C.G) {
        __syncthreads();
        tail_mfma(C, tb * 64, WT, part);
        __syncthreads();
#pragma unroll
        for (int rep = 0; rep < 2; ++rep) { const int i = rep * 512 + C.tid; TAIL[(size_t)tb * 1024 + i] = log_sigmoid_f(part[i] + part[1024 + i] + C.in[4][j * 16 + (i & 15)]); }
        const float* gq = C.in[5] + j * 64; const float* gk = C.in[6] + j * 64;
        for (int t = 0; t < 8; ++t) {
            const int tok = tb * 64 + C.wave * 8 + t;
#pragma unroll
            for (int which = 0; which < 2; ++which) {
                bf16* row = (bf16*)(C.ws + WS_P) + (size_t)which * PSTRIDE + (size_t)tok * 1024 + C.lane * 16;
                const v4u a = *(const GAS v4u*)row, b = *(const GAS v4u*)(row + 8);
                float v[16] = {bflo(a.x), bfhi(a.x), bflo(a.y), bfhi(a.y), bflo(a.z), bfhi(a.z), bflo(a.w), bfhi(a.w), bflo(b.x), bfhi(b.x), bflo(b.y), bfhi(b.y), bflo(b.z), bfhi(b.z), bflo(b.w), bfhi(b.w)};
                float ss = 0.f;
#pragma unroll
                for (int i = 0; i < 16; ++i) ss += v[i] * v[i];
                ss = DPP_ADD(ss, 0xB1, 0xf, 0xf); ss = DPP_ADD(ss, 0x4E, 0xf, 0xf);
                const float r = rsqrtf(ss * (1.f / 64.f) + RMS_EPS) * (which == 0 ? FOX_C2 : 1.f);
                const float* g = (which == 0 ? gq : gk) + (C.lane & 3) * 16;
#pragma unroll
                for (int i = 0; i < 16; ++i) v[i] = v[i] * r * g[i];
                v4u oa, ob; oa.x = pk2(v[0], v[1]); oa.y = pk2(v[2], v[3]); oa.z = pk2(v[4], v[5]); oa.w = pk2(v[6], v[7]);
                ob.x = pk2(v[8], v[9]); ob.y = pk2(v[10], v[11]); ob.z = pk2(v[12], v[13]); ob.w = pk2(v[14], v[15]);
                *(GAS v4u*)row = oa; *(GAS v4u*)(row + 8) = ob;
            }
        }
    }
}
constexpr size_t WS_ASC = WS_Q2, WS_Q1 = WS_Q2 + 16 * MiB, WS_KST = WS_Q2 + 48 * MiB, WS_DEC = 59 * MiB;
static_assert(WS_KST + 32 * MiB <= WS_OF && WS_Q1 + 32 * MiB <= WS_KST, "chunk workspace map");
template <int NH>
__device__ __forceinline__ void chunk_prepass(const Ctx& C) {
    bf16* ASC = (bf16*)(C.ws + WS_ASC); bf16* Q1 = (bf16*)(C.ws + WS_Q1); bf16* KST = (bf16*)(C.ws + WS_KST); float* DEC = (float*)(C.ws + WS_DEC);
    const bf16* P0 = (const bf16*)(C.ws + WS_P); const bf16* P1 = P0 + PSTRIDE;
    LAS bf16* tqs = (LAS bf16*)C.lds;
    LAS bf16* tks = tqs + 64 * 128;
    LAS bf16* q2s = tks + 64 * 128;
    LAS bf16* k2s = q2s + 64 * 136;
    LAS bf16* q1s = k2s + 64 * 136;
    LAS float* tot = (LAS float*)(q1s + 64 * 128);
    LAS float* part = tot + 512;
    const float qs = 0.08838834764831845f;
    const int d = C.tid & 127, tq = C.tid >> 7, l = C.lane, fr = l & 15, fq = l >> 4;
    const int dq = d;
    const int pr0 = C.tid >> 4, pc = (C.tid & 15) * 8;
#define PP_BAR() do { asm volatile("s_waitcnt lgkmcnt(0)" ::: "memory"); __builtin_amdgcn_s_barrier(); asm volatile("" ::: "memory"); } while (0)
    for (int itb = C.vcu; itb < NBATCH * 32; itb += C.G) {
        const int c = itb & 31, b = itb >> 5;
        const size_t rowb = (size_t)b * SEQLEN + c * 64;
        const size_t row0 = rowb + tq * 16;
        if (NH == 4) { __syncthreads(); tail_mfma(C, b * SEQLEN + c * 64, (const bf16*)(C.ws + WS_TAILW) + 2 * 16 * 1024, part); }
        v4u pq[2], pk[2];
#define PP_LOAD(h_) do { _Pragma("unroll") for (int j = 0; j < 2; ++j) { const size_t r_ = (rowb + pr0 + 32 * j) * 1024 + (h_) * 128 + pc; \
            pq[j] = *(const GAS v4u*)(P0 + r_); pk[j] = *(const GAS v4u*)((NH == 4 ? P0 + 512 : P1) + r_); } } while (0)
        PP_LOAD(0);
#pragma unroll 1
        for (int h = 0; h < NH; ++h) {
            const int it = (b * NH + h) * 32 + c;
            PP_BAR();
#pragma unroll
            for (int j = 0; j < 2; ++j) { *(LAS v4u*)(tqs + (pr0 + 32 * j) * 128 + pc) = pq[j]; *(LAS v4u*)(tks + (pr0 + 32 * j) * 128 + pc) = pk[j]; }
            if (h + 1 < NH) PP_LOAD(h + 1);
            PP_BAR();
            float bl[16], kk[16]; float run = 0.f;
            if (NH == 4) {
                float wu[16];
#pragma unroll
                for (int r = 0; r < 16; ++r) wu[r] = C.in[9][r * 512 + h * 128 + d];
                const float ba = C.in[10][h * 128 + d];
#pragma unroll
                for (int i = 0; i < 16; ++i) { float z = ba; const int t = tq * 16 + i;
#pragma unroll
                    for (int r = 0; r < 16; r += 4) { const f32x4 p0 = *(const LAS f32x4*)(part + t * 16 + r), p1 = *(const LAS f32x4*)(part + 1024 + t * 16 + r);
                        z += (p0[0] + p1[0]) * wu[r] + (p0[1] + p1[1]) * wu[r + 1] + (p0[2] + p1[2]) * wu[r + 2] + (p0[3] + p1[3]) * wu[r + 3]; }
                    run += log_sigmoid_f(z) * (1.f / 16.f); bl[i] = run; kk[i] = bf2f(tks[t * 128 + d]); }
            } else {
                const float lb = ((const float*)(C.ws + WS_LB))[h * 128 + d];
#pragma unroll
                for (int i = 0; i < 16; ++i) { const float gate = lb + (1.f - lb) * sigmoid_f(bf2f(tks[(tq * 16 + i) * 128 + d])); run += __logf(gate); bl[i] = run; kk[i] = 1.f - gate; }
            }
            tot[tq * 128 + d] = run;
            PP_BAR();
            const float t0 = tot[d], t1 = tot[128 + d], t2 = tot[256 + d], t3 = tot[384 + d];
            const float off = tq == 0 ? 0.f : tq == 1 ? t0 : tq == 2 ? t0 + t1 : t0 + t1 + t2;
            const float bref = t0 + t1, bend = (t0 + t1) + (t2 + t3);
            unsigned ksw[8];
#pragma unroll
            for (int i = 0; i < 16; ++i) {
                const float bb = bl[i] + off;
                const float qv = bf2f(tqs[(tq * 16 + i) * 128 + d]) * qs, kv = kk[i];
                q1s[(tq * 16 + i) * 128 + dq] = (bf16)f2bf(qv * __expf(bb));
                q2s[(tq * 16 + i) * 136 + d] = (bf16)f2bf(qv * __expf(bb - bref));
                k2s[(tq * 16 + i) * 136 + d] = (bf16)f2bf(kv * __expf(bref - bb));
                const unsigned kb = f2bf(kv * __expf(bend - bb));
                if (i & 1) ksw[i >> 1] |= kb << 16; else ksw[i >> 1] = kb;
            }
            { bf16* kt = KST + ((size_t)it * 128 + d) * 64 + tq * 16; *(GAS v4u*)kt = (v4u){ksw[0], ksw[1], ksw[2], ksw[3]}; *(GAS v4u*)(kt + 8) = (v4u){ksw[4], ksw[5], ksw[6], ksw[7]}; }
            if (tq == 0) DEC[(size_t)it * 128 + d] = __expf(bend);
            PP_BAR();
#pragma unroll
            for (int j = 0; j < 2; ++j) *(GAS v4u*)(Q1 + (rowb + pr0 + 32 * j) * 1024 + h * 128 + pc) = *(const LAS v4u*)(q1s + (pr0 + 32 * j) * 128 + pc);
            const int ti = C.wave >> 1;
#pragma unroll
            for (int sj = 0; sj < 2; ++sj) {
                const int si = 2 * (C.wave & 1) + sj;
                f32x4 acc = (f32x4){0.f, 0.f, 0.f, 0.f};
                if (si <= ti) {
#pragma unroll
                    for (int ks = 0; ks < 4; ++ks) {
                        const bf16x8 a = *(const LAS bf16x8*)(q2s + (16 * ti + fr) * 136 + ks * 32 + fq * 8), bb = *(const LAS bf16x8*)(k2s + (16 * si + fr) * 136 + ks * 32 + fq * 8);
                        acc = __builtin_amdgcn_mfma_f32_16x16x32_bf16(bb, a, acc, 0, 0, 0);
                    }
                }
                const int t = 16 * ti + fr, s0 = 16 * si + 4 * fq;
                typedef unsigned u32x2v __attribute__((ext_vector_type(2)));
                u32x2v w; w.x = pk2(s0 <= t ? acc[0] : 0.f, s0 + 1 <= t ? acc[1] : 0.f); w.y = pk2(s0 + 2 <= t ? acc[2] : 0.f, s0 + 3 <= t ? acc[3] : 0.f);
                *(GAS u32x2v*)(ASC + (size_t)it * 4096 + t * 64 + s0) = w;
            }
        }
    }
#undef PP_LOAD
#undef PP_BAR
}
struct RecFrag { bf16x8 vb[2]; bf16x8 a0, a1; unsigned long long q[4][2]; f32x4 dc[2]; bf16x8 ks[2][2]; };
template <int NH, int DV>
__device__ __forceinline__ void chunk_recur(const Ctx& C, const bf16* Vp) {
    const bf16* ASC = (const bf16*)(C.ws + WS_ASC); const bf16* Q1 = (const bf16*)(C.ws + WS_Q1); const bf16* KST = (const bf16*)(C.ws + WS_KST); const float* DEC = (const float*)(C.ws + WS_DEC);
    float* OF = (float*)(C.ws + WS_OF);
    constexpr int NCB = DV / 16, NTASK = NBATCH * NH * NCB;
    const int l = C.lane, m = l & 15, g = l >> 4, gi = C.wave >> 2, kq = C.wave & 3;
    LAS float* red = (LAS float*)C.lds + gi * 8192;
#define REC_LOAD(F, c_) do { const size_t row0_ = (size_t)b * SEQLEN + (c_) * 64; const size_t ch_ = (size_t)bh * 32 + (c_); \
        _Pragma("unroll") for (int ks = 0; ks < 2; ++ks) _Pragma("unroll") for (int j = 0; j < 8; ++j) F.vb[ks][j] = (short)Vp[(row0_ + 32 * ks + 8 * g + j) * 1024 + col]; \
        F.a0 = *(const bf16x8*)(ASC + ch_ * 4096 + (16 * kq + m) * 64 + 8 * g); F.a1 = *(const bf16x8*)(ASC + ch_ * 4096 + (16 * kq + m) * 64 + 32 + 8 * g); \
        _Pragma("unroll") for (int tb = 0; tb < 4; ++tb) { const bf16* qp = Q1 + (row0_ + 16 * tb + m) * 1024 + h * 128 + 32 * kq + 4 * g; F.q[tb][0] = *(const unsigned long long*)qp; F.q[tb][1] = *(const unsigned long long*)(qp + 16); } \
        _Pragma("unroll") for (int i = 0; i < 2; ++i) { F.dc[i] = *(const f32x4*)(DEC + ch_ * 128 + 32 * kq + 16 * i + 4 * g); \
            _Pragma("unroll") for (int ks = 0; ks < 2; ++ks) F.ks[i][ks] = *(const bf16x8*)(KST + (ch_ * 128 + 32 * kq + 16 * i + m) * 64 + 32 * ks + 8 * g); } } while (0)
#define REC_BODY(F, Fn, c_) do { \
        if ((c_) + 1 < 32) REC_LOAD(Fn, (c_) + 1); \
        if (BGQ) { const int bgn = (bgit * 32 + (c_)) * C.NGW + C.gw; bgq_step<JOB>(C, bgi, bgn, bgv); bgi = bgn; } \
        LAS float* rb = red + ((c_) & 1) * 4096; \
        f32x4 oin = __builtin_amdgcn_mfma_f32_16x16x32_bf16(F.a0, F.vb[0], (f32x4){0.f, 0.f, 0.f, 0.f}, 0, 0, 0); \
        if (kq >= 2) oin = __builtin_amdgcn_mfma_f32_16x16x32_bf16(F.a1, F.vb[1], oin, 0, 0, 0); \
        { u32x4v sw; sw.x = pk2(S[0][0], S[0][1]); sw.y = pk2(S[0][2], S[0][3]); sw.z = pk2(S[1][0], S[1][1]); sw.w = pk2(S[1][2], S[1][3]); \
          const bf16x8 sb = __builtin_bit_cast(bf16x8, sw); \
          _Pragma("unroll") for (int tb = 0; tb < 4; ++tb) { u32x4v aw; aw.x = (unsigned)F.q[tb][0]; aw.y = (unsigned)(F.q[tb][0] >> 32); aw.z = (unsigned)F.q[tb][1]; aw.w = (unsigned)(F.q[tb][1] >> 32); \
              const f32x4 po = __builtin_amdgcn_mfma_f32_16x16x32_bf16(__builtin_bit_cast(bf16x8, aw), sb, (f32x4){0.f, 0.f, 0.f, 0.f}, 0, 0, 0); \
              *(LAS f32x4*)(rb + ((kq * 4 + tb) * 64 + l) * 4) = po; } } \
        _Pragma("unroll") for (int i = 0; i < 2; ++i) { S[i] = S[i] * F.dc[i]; \
            _Pragma("unroll") for (int ks = 0; ks < 2; ++ks) S[i] = __builtin_amdgcn_mfma_f32_16x16x32_bf16(F.ks[i][ks], F.vb[ks], S[i], 0, 0, 0); } \
        asm volatile("s_waitcnt lgkmcnt(0)" ::: "memory"); __builtin_amdgcn_s_barrier(); asm volatile("" ::: "memory"); \
        { f32x4 o = oin; \
          _Pragma("unroll") for (int k2 = 0; k2 < 4; ++k2) o = o + *(const LAS f32x4*)(rb + ((k2 * 4 + kq) * 64 + l) * 4); \
          const size_t orow = (size_t)b * SEQLEN + (c_) * 64 + 16 * kq + 4 * g; \
          _Pragma("unroll") for (int r = 0; r < 4; ++r) OF[(orow + r) * 1024 + col] = o[r]; } } while (0)
    constexpr int JOB = NH == 4 ? 1 : 2;
    f32x4 bgv[4]; int bgi = -1, bgit = 0;
    for (int t0 = C.vcu; t0 < NTASK / 2; t0 += C.G, ++bgit) {
        const int task = gi * (NTASK / 2) + t0;
        const int cb = task % NCB, bh = task / NCB, b = bh / NH, h = bh % NH;
        const int col = h * DV + cb * 16 + m;
        f32x4 S[2];
        S[0] = (f32x4){0.f, 0.f, 0.f, 0.f}; S[1] = S[0];
        RecFrag FA, FB;
        REC_LOAD(FA, 0);
#pragma unroll 1
        for (int c = 0; c < 32; c += 2) { REC_BODY(FA, FB, c); REC_BODY(FB, FA, c + 1); }
        asm volatile("s_waitcnt lgkmcnt(0)" ::: "memory"); __builtin_amdgcn_s_barrier(); asm volatile("" ::: "memory");
    }
    if (BGQ) {
        for (int bgn = bgit * 32 * C.NGW + C.gw; bgi < BGQ_ROWS; bgn += C.NGW) { bgq_step<JOB>(C, bgi, bgn, bgv); bgi = bgn; }
    }
#undef REC_LOAD
#undef REC_BODY
}

template <int DV>
__device__ __forceinline__ void rec_norm_gate(const Ctx& C, const float* gain, const bf16* gate) {
    const float* OF = (const float*)(C.ws + WS_OF); bf16* OB = (bf16*)(C.ws + WS_OB);
    for (int tok = C.gw; tok < NTOK; tok += C.NGW) {
        const GAS f32x4* xr = (const GAS f32x4*)(OF + (size_t)tok * 1024) + C.lane;
        const GAS f32x4* gr = (const GAS f32x4*)gain + C.lane;
        const GAS unsigned long long* tr = (const GAS unsigned long long*)(gate + (size_t)tok * 1024) + C.lane;
        GAS unsigned long long* o8 = (GAS unsigned long long*)(OB + (size_t)tok * 1024) + C.lane;
#pragma unroll
        for (int j = 0; j < 4; ++j) {
            const f32x4 v = xr[64 * j]; float ss = (v.x * v.x + v.y * v.y) + (v.z * v.z + v.w * v.w);
            if (DV == 256) ss = wave_sum(ss); else { DPP_SUM31(ss); const float s_lo = rdlane(ss, 31), s_hi = rdlane(ss, 63); ss = C.lane < 32 ? s_lo : s_hi; }
            const float r = rsqrtf(ss * (1.f / DV) + RMS_EPS);
            const f32x4 g = gr[64 * j]; const unsigned long long tw = tr[64 * j];
            const float t0 = bflo((unsigned)tw), t1 = bfhi((unsigned)tw), t2 = bflo((unsigned)(tw >> 32)), t3 = bfhi((unsigned)(tw >> 32));
            const float a0 = v.x * r * g.x * (t0 * sigmoid_f(t0)), a1 = v.y * r * g.y * (t1 * sigmoid_f(t1)), a2 = v.z * r * g.z * (t2 * sigmoid_f(t2)), a3 = v.w * r * g.w * (t3 * sigmoid_f(t3));
            o8[64 * j] = (unsigned long long)pk2(a0, a1) | ((unsigned long long)pk2(a2, a3) << 32);
        }
    }
}

#define CE_D(a, b) do { const unsigned mx_ = (a) > (b) ? (a) : (b); const unsigned mn_ = (a) > (b) ? (b) : (a); (a) = mx_; (b) = mn_; } while (0)
__device__ __forceinline__ void sort16_desc(unsigned (&a)[16]) {
#pragma unroll
    for (int k = 2; k <= 16; k <<= 1)
#pragma unroll
        for (int j = k >> 1; j > 0; j >>= 1)
#pragma unroll
            for (int i = 0; i < 16; ++i) { const int l = i ^ j; if (l > i) { if ((i & k) == 0) CE_D(a[i], a[l]); else CE_D(a[l], a[i]); } }
}
__device__ __forceinline__ void merge_top16(unsigned (&a)[16], const unsigned (&b)[16]) {
#pragma unroll
    for (int i = 0; i < 16; ++i) a[i] = a[i] > b[15 - i] ? a[i] : b[15 - i];
#pragma unroll
    for (int j = 8; j > 0; j >>= 1)
#pragma unroll
        for (int i = 0; i < 16; ++i) { const int l = i ^ j; if (l > i) CE_D(a[i], a[l]); }
}
__device__ __forceinline__ void merge_quad(unsigned (&a)[16], int lane) {
    unsigned p[16];
#pragma unroll
    for (int i = 0; i < 16; ++i) p[i] = (unsigned)__builtin_amdgcn_ds_bpermute((lane ^ 16) << 2, (int)a[i]);
    merge_top16(a, p);
#pragma unroll
    for (int i = 0; i < 16; ++i) p[i] = (unsigned)__builtin_amdgcn_ds_bpermute((lane ^ 32) << 2, (int)a[i]);
    merge_top16(a, p);
}
__device__ __forceinline__ unsigned mono_key(float f) { const unsigned u = __float_as_uint(f); return (u & 0x80000000u) ? ~u : (u | 0x80000000u); }
__device__ __forceinline__ float mono_inv(unsigned k) { return __uint_as_float((k & 0x80000000u) ? (k ^ 0x80000000u) : ~k); }
__constant__ __attribute__((aligned(16))) unsigned char PEER_CAND[64] = {0, 1, 2, 3, 4, 5, 6, 7, 8, 9, 10, 11, 12, 13, 14, 15, 16, 17, 18, 19, 20, 21, 22, 23, 32, 33, 34, 35, 36, 64, 65, 66, 48, 49, 50, 51, 80, 81, 96, 97, 112, 113, 128, 144, 160, 176, 192, 208, 224, 240, 255, 255, 255, 255, 255, 255, 255, 255, 255, 255, 255, 255, 255, 255};
__device__ __forceinline__ void peer_topk_task(const Ctx& C, int layer, int tok0, int head, int trow0, LAS int* lexp, LAS float* lgate) {
    typedef _Float16 h8 __attribute__((ext_vector_type(8)));
    const _Float16* SC = (const _Float16*)(C.ws + WS_Q2);
    LAS unsigned* L0 = (LAS unsigned*)(C.lds + C.wave * 2048);
    LAS unsigned* L1 = L0 + 256;
    {
        int l = C.lane; asm volatile("" : "+v"(l));
        const int m = l & 15, g = l >> 4;
        unsigned cand_w[4];
#pragma unroll
        for (int c = 0; c < 4; ++c) cand_w[c] = ((const unsigned*)PEER_CAND)[g * 4 + c];
        unsigned top[2][16];
#pragma unroll
        for (int p = 0; p < 2; ++p) {
            const _Float16* sp = SC + (size_t)(tok0 + m) * 2048 + head * 256 + p * 128 + 32 * g;
            h8 hv[4];
#pragma unroll
            for (int q = 0; q < 4; ++q) hv[q] = *(const h8*)(sp + 8 * q);
            unsigned hi16[16];
#pragma unroll
            for (int q = 0; q < 4; ++q)
#pragma unroll
                for (int j = 0; j < 8; ++j) { const int i = 8 * q + j; const unsigned key = (mono_key((float)hv[q][j]) & ~0x7fu) | (unsigned)(127 - (32 * g + i));
                    if (i < 16) top[p][i] = key; else hi16[i - 16] = key; }
            sort16_desc(top[p]); sort16_desc(hi16); merge_top16(top[p], hi16);
            merge_quad(top[p], l);
        }
        if (g == 0) {
#pragma unroll
            for (int i = 0; i < 16; i += 4) { *(LAS u32x4v*)(L0 + m * 16 + i) = (u32x4v){top[0][i], top[0][i + 1], top[0][i + 2], top[0][i + 3]}; *(LAS u32x4v*)(L1 + m * 16 + i) = (u32x4v){top[1][i], top[1][i + 1], top[1][i + 2], top[1][i + 3]}; }
        }
        asm volatile("s_waitcnt lgkmcnt(0)" ::: "memory"); __builtin_amdgcn_wave_barrier();
        unsigned cd[16];
#pragma unroll
        for (int c = 0; c < 16; ++c) {
            const unsigned code = (cand_w[c >> 2] >> (8 * (c & 3))) & 0xffu, ci = (code >> 4) & 15u, cj = code & 15u;
            const float v = mono_inv(L0[m * 16 + ci]) + mono_inv(L1[m * 16 + cj]);
            cd[c] = code == 255u ? 0u : ((mono_key(v) & ~0xffu) | (255u - code));
        }
        sort16_desc(cd); merge_quad(cd, l);
        if (g == 0) {
            float best[16]; int ex[16]; float sum = 0.f;
#pragma unroll
            for (int r = 0; r < 16; ++r) { const unsigned pos = 255u - (cd[r] & 0xffu), pi = pos >> 4, pj = pos & 15u;
                ex[r] = (int)((127u - (L0[m * 16 + pi] & 0x7fu)) * 128u + (127u - (L1[m * 16 + pj] & 0x7fu))); best[r] = mono_inv(cd[r]); }
            const float bmax = best[0];
#pragma unroll
            for (int r = 0; r < 16; ++r) { best[r] = __expf(best[r] - bmax); sum += best[r]; }
            const float inv = 1.f / sum;
            const int ob = (trow0 + m) * 128 + head * 16;
#pragma unroll
            for (int r = 0; r < 16; r += 4) { *(LAS u32x4v*)(lexp + ob + r) = (u32x4v){(unsigned)ex[r], (unsigned)ex[r + 1], (unsigned)ex[r + 2], (unsigned)ex[r + 3]};
                *(LAS f32x4*)(lgate + ob + r) = (f32x4){best[r] * inv, best[r + 1] * inv, best[r + 2] * inv, best[r + 3] * inv}; }
        }
        asm volatile("s_waitcnt lgkmcnt(0)" ::: "memory"); __builtin_amdgcn_wave_barrier();
    }
}
typedef float f32x2v __attribute__((ext_vector_type(2)));
#define GRP8_SUM(v) do { v = DPP_ADD(v, 0xB1, 0xf, 0xf); v = DPP_ADD(v, 0x4E, 0xf, 0xf); v = DPP_ADD(v, 0x141, 0xf, 0xf); } while (0)
#ifndef MK_HOT
#define MK_HOT 0
#endif
__device__ __forceinline__ void wave_lds_sync() { asm volatile("s_waitcnt lgkmcnt(0)" ::: "memory"); __builtin_amdgcn_wave_barrier(); }
template <bool DRY>
__device__ __forceinline__ void peer_rounds(const Ctx& C, int layer, int tokw, LAS int* lexp_w, const LAS float* lgate_w, LAS unsigned* sorted_w, LAS unsigned* hist_w) {
    const unsigned char* U = C.ws + WS_U + (size_t)layer * 16384 * 1024; const unsigned char* V = C.ws + WS_V + (size_t)layer * 16384 * 1024;
    const float* SU = (const float*)(C.ws + WS_SU) + layer * 16384; const float* SV = (const float*)(C.ws + WS_SV) + layer * 16384;
    const float* gf = C.in[2] + layer * 1024; const float* gn = C.in[1] + (layer + 1) * 1024;
    int l = C.lane; asm volatile("" : "+v"(l));
    LAS float* hbuf = (LAS float*)lexp_w;
    {
        const int t = l >> 3, s = l & 7;
#pragma unroll
        for (int k = 0; k < 8; ++k) hist_w[l + 64 * k] = 0u;
        wave_lds_sync();
        unsigned ev[16], pos[16];
#pragma unroll
        for (int k = 0; k < 16; ++k) { ev[k] = (unsigned)lexp_w[t * 128 + s + 8 * k]; pos[k] = __hip_atomic_fetch_add(hist_w + t * 64 + (ev[k] >> 8), 1u, __ATOMIC_RELAXED, __HIP_MEMORY_SCOPE_WORKGROUP); }
        wave_lds_sync();
        unsigned cnt[8], run = 0u;
#pragma unroll
        for (int j = 0; j < 8; ++j) { cnt[j] = hist_w[t * 64 + 8 * s + j]; run += cnt[j]; }
        unsigned inc = run;
#pragma unroll
        for (int o = 1; o < 8; o <<= 1) { const unsigned up = (unsigned)__builtin_amdgcn_ds_bpermute((l - o) << 2, (int)inc); if (s >= o) inc += up; }
        unsigned off = inc - run;
        wave_lds_sync();
#pragma unroll
        for (int j = 0; j < 8; ++j) { hist_w[t * 64 + 8 * s + j] = off; off += cnt[j]; }
        wave_lds_sync();
#pragma unroll
        for (int k = 0; k < 16; ++k) sorted_w[t * 128 + hist_w[t * 64 + (ev[k] >> 8)] + pos[k]] = (ev[k] << 7) | (unsigned)(s + 8 * k);
        wave_lds_sync();
    }
    asm volatile("" : "+v"(l));
    unsigned xp[8][8];
    {
        const int t = l >> 3, s = l & 7;
        const bf16* hrow = (const bf16*)(C.ws + WS_HB) + (size_t)(tokw + t) * 1024 + 16 * s;
        float ss = 0.f;
#pragma unroll
        for (int i = 0; i < 8; ++i) { const v4u a = *(const GAS v4u*)(hrow + 128 * i), b = *(const GAS v4u*)(hrow + 128 * i + 8);
            xp[i][0] = a.x; xp[i][1] = a.y; xp[i][2] = a.z; xp[i][3] = a.w; xp[i][4] = b.x; xp[i][5] = b.y; xp[i][6] = b.z; xp[i][7] = b.w;
#pragma unroll
            for (int j = 0; j < 8; ++j) { const float lo = bflo(xp[i][j]), hi = bfhi(xp[i][j]); ss += lo * lo + hi * hi; } }
        GRP8_SUM(ss);
        const float r = rsqrtf(ss * (1.f / 1024.f) + RMS_EPS);
#pragma unroll
        for (int i = 0; i < 8; ++i)
#pragma unroll
            for (int q = 0; q < 4; ++q) { const f32x4 a = *(const GAS f32x4*)(gf + 16 * s + 128 * i + 4 * q);
                xp[i][2 * q] = pk2(bflo(xp[i][2 * q]) * r * a.x, bfhi(xp[i][2 * q]) * r * a.y); xp[i][2 * q + 1] = pk2(bflo(xp[i][2 * q + 1]) * r * a.z, bfhi(xp[i][2 * q + 1]) * r * a.w); }
    }
    asm volatile("" : "+v"(l));
#define RND_LOAD(T, buf, item) do { const unsigned char* p_ = T + (size_t)((DRY && MK_HOT) ? (((item) >> 7) & 255u) : ((item) >> 7)) * 1024 + 16 * (l & 7); \
        _Pragma("unroll") for (int i = 0; i < 8; ++i) buf[i] = *(const GAS v4u*)(p_ + 128 * i); } while (0)
    {
        const int t = l >> 3, s = l & 7;
        const LAS unsigned* srt = sorted_w + t * 128;
        v4u bA[8], bB[8];
#define RND_DOT(buf, r_) do { float d = 0.f; \
            _Pragma("unroll") for (int i = 0; i < 8; ++i) { asm volatile("" : "+v"(buf[i])); _Pragma("unroll") for (int q = 0; q < 4; ++q) { \
                const f32x2v lo_ = __builtin_amdgcn_cvt_pk_f32_fp8((int)buf[i][q], false), hi_ = __builtin_amdgcn_cvt_pk_f32_fp8((int)buf[i][q], true); \
                d = dot2bf(pg8::cvt_pk_bf16(lo_.x, lo_.y), xp[i][2 * q], d); d = dot2bf(pg8::cvt_pk_bf16(hi_.x, hi_.y), xp[i][2 * q + 1], d); } } \
            GRP8_SUM(d); if (s == 0) hbuf[t * 128 + (r_)] = d; } while (0)
        RND_LOAD(U, bA, srt[0]);
#pragma unroll 1
        for (int r = 0; r < 128; r += 2) {
            RND_LOAD(U, bB, srt[r + 1]);
            RND_DOT(bA, r);
            RND_LOAD(U, bA, srt[(r + 2) & 127]);
            RND_DOT(bB, r + 1);
        }
#undef RND_DOT
    }
    wave_lds_sync();
    asm volatile("" : "+v"(l));
    {
        const int t = l >> 3, s = l & 7;
#pragma unroll
        for (int k = 0; k < 16; k += 2) {
            const int r0 = t * 128 + s + 8 * k, r1 = r0 + 8;
            const unsigned i0 = sorted_w[r0], i1 = sorted_w[r1];
            const float h0 = hbuf[r0] * SU[i0 >> 7], h1 = hbuf[r1] * SU[i1 >> 7];
            const pg8::f32x2 gl = pg8::gelu_pk((pg8::f32x2){h0, h1});
            hbuf[r0] = gl.x * lgate_w[t * 128 + (i0 & 127u)] * SV[i0 >> 7]; hbuf[r1] = gl.y * lgate_w[t * 128 + (i1 & 127u)] * SV[i1 >> 7];
        }
    }
    wave_lds_sync();
    asm volatile("" : "+v"(l));
    f32x2v y2[8][8];
#pragma unroll
    for (int i = 0; i < 8; ++i)
#pragma unroll
        for (int j = 0; j < 8; ++j) y2[i][j] = (f32x2v){0.f, 0.f};
    {
        const int t = l >> 3;
        const LAS unsigned* srt = sorted_w + t * 128; const LAS float* wv = hbuf + t * 128;
        v4u bA[8], bB[8];
#define RND_AXPY(buf, r_) do { const float w = wv[(r_)]; const f32x2v w2 = (f32x2v){w, w}; \
            _Pragma("unroll") for (int i = 0; i < 8; ++i) { asm volatile("" : "+v"(buf[i])); _Pragma("unroll") for (int q = 0; q < 4; ++q) { \
                const f32x2v lo_ = __builtin_amdgcn_cvt_pk_f32_fp8((int)buf[i][q], false), hi_ = __builtin_amdgcn_cvt_pk_f32_fp8((int)buf[i][q], true); \
                y2[i][2 * q] = w2 * lo_ + y2[i][2 * q]; y2[i][2 * q + 1] = w2 * hi_ + y2[i][2 * q + 1]; } } } while (0)
        RND_LOAD(V, bA, srt[0]);
#pragma unroll 1
        for (int r = 0; r < 128; r += 2) {
            RND_LOAD(V, bB, srt[r + 1]);
            RND_AXPY(bA, r);
            RND_LOAD(V, bA, srt[(r + 2) & 127]);
            RND_AXPY(bB, r + 1);
        }
#undef RND_AXPY
    }
#undef RND_LOAD
    asm volatile("" : "+v"(l));
    {
        const int t = l >> 3, s = l & 7;
        const bf16* hrow = (const bf16*)(C.ws + WS_HB) + (size_t)(tokw + t) * 1024 + 16 * s;
        float* hout = (DRY ? (float*)(C.ws + WS_OF) : C.out) + (size_t)(tokw + t) * 1024 + 16 * s;
        bf16* hb = (bf16*)(C.ws + (DRY ? WS_OF : WS_HB)) + (size_t)(tokw + t) * 1024 + 16 * s;
        float s2 = 0.f;
#pragma unroll
        for (int i = 0; i < 8; ++i) { const v4u a = *(const GAS v4u*)(hrow + 128 * i), b = *(const GAS v4u*)(hrow + 128 * i + 8);
            const unsigned hw[8] = {a.x, a.y, a.z, a.w, b.x, b.y, b.z, b.w};
#pragma unroll
            for (int j = 0; j < 8; ++j) { y2[i][j].x += bflo(hw[j]); y2[i][j].y += bfhi(hw[j]); s2 += y2[i][j].x * y2[i][j].x + y2[i][j].y * y2[i][j].y; }
            if (layer == DEPTH - 1) {
#pragma unroll
                for (int q = 0; q < 4; ++q) *(GAS f32x4*)(hout + 128 * i + 4 * q) = (f32x4){y2[i][2 * q].x, y2[i][2 * q].y, y2[i][2 * q + 1].x, y2[i][2 * q + 1].y};
            } else {
                *(GAS v4u*)(hb + 128 * i) = (v4u){pk2(y2[i][0].x, y2[i][0].y), pk2(y2[i][1].x, y2[i][1].y), pk2(y2[i][2].x, y2[i][2].y), pk2(y2[i][3].x, y2[i][3].y)};
                *(GAS v4u*)(hb + 128 * i + 8) = (v4u){pk2(y2[i][4].x, y2[i][4].y), pk2(y2[i][5].x, y2[i][5].y), pk2(y2[i][6].x, y2[i][6].y), pk2(y2[i][7].x, y2[i][7].y)};
            } }
        if (layer < DEPTH - 1) {
            GRP8_SUM(s2);
            const float r2 = rsqrtf(s2 * (1.f / 1024.f) + RMS_EPS);
            bf16* xo = (bf16*)(C.ws + (DRY ? WS_GLOG : WS_XN)) + (size_t)(tokw + t) * 1024 + 16 * s; float am = 0.f;
#pragma unroll
            for (int i = 0; i < 8; ++i) { unsigned pw[8];
#pragma unroll
                for (int q = 0; q < 4; ++q) { const f32x4 a = *(const GAS f32x4*)(gn + 16 * s + 128 * i + 4 * q);
                    y2[i][2 * q].x *= r2 * a.x; y2[i][2 * q].y *= r2 * a.y; y2[i][2 * q + 1].x *= r2 * a.z; y2[i][2 * q + 1].y *= r2 * a.w;
                    am = fmaxf(fmaxf(am, fmaxf(fabsf(y2[i][2 * q].x), fabsf(y2[i][2 * q].y))), fmaxf(fabsf(y2[i][2 * q + 1].x), fabsf(y2[i][2 * q + 1].y)));
                    pw[2 * q] = pk2(y2[i][2 * q].x, y2[i][2 * q].y); pw[2 * q + 1] = pk2(y2[i][2 * q + 1].x, y2[i][2 * q + 1].y); }
                *(GAS v4u*)(xo + 128 * i) = (v4u){pw[0], pw[1], pw[2], pw[3]}; *(GAS v4u*)(xo + 128 * i + 8) = (v4u){pw[4], pw[5], pw[6], pw[7]}; }
            am = DPP_MAX(am, 0xB1, 0xf, 0xf); am = DPP_MAX(am, 0x4E, 0xf, 0xf); am = DPP_MAX(am, 0x141, 0xf, 0xf);
            const float qi = am > 0.f ? 127.f / am : 0.f;
            signed char* xq = (signed char*)(C.ws + (DRY ? WS_GLOG + 32 * MiB : WS_XN8)) + (size_t)(tokw + t) * 1024 + 16 * s;
#pragma unroll
            for (int i = 0; i < 8; ++i) { unsigned pq[4];
#pragma unroll
                for (int q = 0; q < 4; ++q) pq[q] = q8x4(y2[i][2 * q].x * qi, y2[i][2 * q].y * qi, y2[i][2 * q + 1].x * qi, y2[i][2 * q + 1].y * qi);
                *(GAS v4u*)(xq + 128 * i) = (v4u){pq[0], pq[1], pq[2], pq[3]}; }
            if (s == 0) *(GAS float*)((float*)(C.ws + (DRY ? WS_GLOG + 48 * MiB : WS_SX)) + tokw + t) = am * (1.f / 127.f);
        }
    }
}
#ifndef MK_SWEEP
#define MK_SWEEP 2
#endif
template <bool DRY>
__device__ __forceinline__ void peer_topk_gather(const Ctx& C, int layer) {
    LAS int* lexp = (LAS int*)(C.lds + 16384);
    LAS float* lgate = (LAS float*)(C.lds + 16384 + 32768);
    LAS unsigned* sorted = (LAS unsigned*)(C.lds + 16384 + 65536);
    for (int tb = C.vcu; tb < NTOK / 64; tb += C.G) {
#pragma unroll 1
        for (int q = 0; q < 4; ++q) peer_topk_task(C, layer, tb * 64 + (C.wave & 3) * 16, (C.wave >> 2) * 4 + q, (C.wave & 3) * 16, lexp, lgate);
        __syncthreads();
#if MK_SWEEP == 2
        peer_rounds<DRY>(C, layer, tb * 64 + C.wave * 8, lexp + C.wave * 1024, lgate + C.wave * 1024, sorted + C.wave * 1024, (LAS unsigned*)(C.lds + C.wave * 2048));
#elif MK_SWEEP == 1
#error removed variant
        peer_sweep<DRY>(C, layer, tb * 64 + C.wave * 8, lexp + C.wave * 1024, lgate + C.wave * 1024, sorted + C.wave * 1024, (LAS unsigned*)(C.lds + C.wave * 1024));
#else
#pragma unroll 1
        for (int t = 0; t < 8; ++t) peer_gather_token<DRY>(C, layer, tb * 64 + C.wave * 8 + t, lexp + (C.wave * 8 + t) * 128, lgate + (C.wave * 8 + t) * 128);
#endif
        __syncthreads();
    }
}

#ifndef MK_SINGLE
#define MK_SINGLE 1
#endif
#ifndef MK_FASTGEMM
#define MK_FASTGEMM 1
#endif
constexpr int STEPS = 10, NPHASE = 1 + DEPTH * STEPS;
struct Args { const float* in[21]; float* out; unsigned char* ws; int ph_lo, ph_hi; };

template <int EPI>
__device__ __forceinline__ void do_gemm(const Ctx& C, const bf16* A, const bf16* Bt, int N, bf16* Ob, int ldc, int split, const float* rs_in, const float* base, float* outf, bf16* hg, const float* gain, float* rs_out) {
    pg8::Gemm g{A, Bt, NTOK, N, 1024}; pg8::StaticOrder S; S.init(NTOK, N, C.G, C.bx);
    if constexpr (EPI == 0) { pg8::EpiBf16R<false> E{Ob, ldc, split ? 1024 : 0, PSTRIDE, rs_in}; pg8::gemm_phase<pg8::EpiBf16R<false>, pg8::StaticOrder, true, true>(C.lds, g, S, E, C.tid); }
    else if constexpr (EPI == 2) { pg8::EpiBf16R<true> E{Ob, ldc, 0, PSTRIDE, rs_in}; pg8::gemm_phase<pg8::EpiBf16R<true>, pg8::StaticOrder, true, true>(C.lds, g, S, E, C.tid); }
    else if constexpr (EPI == 3) {
        pg8::Gemm g8{A, Bt, NTOK, N, 512}; pg8::EpiI8 E{Ob, PSTRIDE, rs_in, gain}; pg8::gemm_phase<pg8::EpiI8, pg8::StaticOrder, true, true>(C.lds, g8, S, E, C.tid); }
    else {
        bf16* HB = (bf16*)(C.ws + WS_HB); (void)outf;
        if (base) { pg8::EpiResNorm<false> E{base, HB, hg, gain, rs_out}; pg8::gemm_phase<pg8::EpiResNorm<false>, pg8::StaticOrder, true, true>(C.lds, g, S, E, C.tid); }
        else { pg8::EpiResNorm<true> E{HB, HB, hg, gain, rs_out}; pg8::gemm_phase<pg8::EpiResNorm<true>, pg8::StaticOrder, true, true>(C.lds, g, S, E, C.tid); } }
}

template <int STEP, int MIXER>
__device__ __forceinline__ void run_step(const Ctx& C, int layer) {
    const int jx = layer / 3;
    bf16* XN = (bf16*)(C.ws + WS_XN); bf16* P = (bf16*)(C.ws + WS_P); bf16* OB = (bf16*)(C.ws + WS_OB); bf16* Q2 = (bf16*)(C.ws + WS_Q2);
    if constexpr (STEP == 0) {
        const bf16* Wt = MIXER == 0 ? (const bf16*)(C.ws + WS_FOXWIN + (size_t)jx * 8 * MiB) : MIXER == 1 ? (const bf16*)(C.ws + WS_GLAWIN) : (const bf16*)(C.ws + WS_HGRNWIN);
        const float* sw = (const float*)(C.ws + WS_SW) + (MIXER == 0 ? jx * 4096 : MIXER == 1 ? 8192 : 11264);
        if ((I8MASK >> layer) & 1) do_gemm<3>(C, (const bf16*)(C.ws + WS_XN8), Wt, MIXER == 1 ? 3072 : 4096, P, 1024, 1, (const float*)(C.ws + WS_SX), nullptr, nullptr, nullptr, sw, nullptr);
        else do_gemm<0>(C, XN, Wt, MIXER == 1 ? 3072 : 4096, P, 1024, 1, nullptr, nullptr, nullptr, nullptr, nullptr, nullptr);
    } else if constexpr (STEP == 1) {
        if constexpr (MIXER == 0) fox_step1(C, jx);
    } else if constexpr (STEP == 2) {
        if constexpr (MIXER == 1) chunk_prepass<4>(C); else if constexpr (MIXER == 2) chunk_prepass<8>(C);
    } else if constexpr (STEP == 3) {
        if constexpr (MIXER == 0) {
            float gq = 0.f, gk = 0.f;
            for (int i = 0; i < 64; ++i) { gq = fmaxf(gq, fabsf(C.in[5][jx * 64 + i])); gk = fmaxf(gk, fabsf(C.in[6][jx * 64 + i])); }
            const float smax = 64.f * gq * gk * 0.125f * 1.4426950408889634f;
            const attn_body::AttnTensors AT{(const attn_body::bf16*)P, (const attn_body::bf16*)(P + PSTRIDE), (const attn_body::bf16*)(P + 2 * PSTRIDE), (attn_body::bf16*)OB, (const attn_body::bf16*)(P + 3 * PSTRIDE), (const float*)(C.ws + WS_TAIL), -(56.f + 2.f * smax)};
            const attn_body::StaticOrder S(C.G, C.bx);
            attn_body::attn_phase<attn_body::StaticOrder>((char*)C.lds, AT, S, C.tid);
        }
        else if constexpr (MIXER == 1) chunk_recur<4, 256>(C, P + PSTRIDE);
        else chunk_recur<8, 128>(C, P + 2 * PSTRIDE);
    } else if constexpr (STEP == 4) {
        if constexpr (MIXER == 1) rec_norm_gate<256>(C, C.in[11], P + 2 * PSTRIDE);
        else if constexpr (MIXER == 2) rec_norm_gate<128>(C, C.in[15], P + 3 * PSTRIDE);
    } else if constexpr (STEP == 5) {
        const bf16* Wt = MIXER == 0 ? (const bf16*)(C.ws + WS_FOXWOUT) + (size_t)jx * 1024 * 1024 : MIXER == 1 ? (const bf16*)(C.ws + WS_GLAWOUT) : (const bf16*)(C.ws + WS_HGRNWOUT);
        do_gemm<1>(C, OB, Wt, 1024, nullptr, 0, 0, nullptr, layer == 0 ? C.in[0] : nullptr, nullptr, XN, C.in[2] + layer * 1024, (float*)(C.ws + WS_RS));
    } else if constexpr (STEP == 6) {
    } else if constexpr (STEP == 7) {
        do_gemm<2>(C, XN, (const bf16*)(C.ws + WS_PEERWQ) + (size_t)layer * 2048 * 1024, 2048, Q2, 2048, 0, (const float*)(C.ws + WS_RS), nullptr, nullptr, nullptr, nullptr, nullptr);
    } else if constexpr (STEP == 8) {
        peer_topk_gather<false>(C, layer);
    } else if constexpr (STEP == 9) {
    } else if constexpr (STEP == 11) {
        peer_topk_gather<true>(C, layer);
    } else if constexpr (STEP == 12) {
        p0_prologue_b(C);
    } else {
        p0_prologue(C);
    }
}

__device__ __forceinline__ void make_ctx(Ctx& C, const Args& args, unsigned char* lds_raw) {
    C.lds = (LAS unsigned char*)lds_raw;
    C.tid = threadIdx.x; C.lane = C.tid & 63; C.wave = __builtin_amdgcn_readfirstlane(C.tid >> 6);
    C.G = gridDim.x; C.bx = blockIdx.x; { const int bx = blockIdx.x; C.vcu = (C.G % 8 == 0) ? (bx % 8) * (C.G / 8) + bx / 8 : bx; }
    C.gw = C.vcu * NWAVES + C.wave; C.NGW = C.G * NWAVES;
#pragma unroll
    for (int i = 0; i < 21; ++i) C.in[i] = args.in[i];
    C.out = args.out; C.ws = args.ws;
}

template <int STEP, int MIXER>
__global__ void __launch_bounds__(NWAVES * 64, 2) mk_phase(Args args, int layer) {
    extern __shared__ __attribute__((aligned(16))) unsigned char lds_raw[];
    Ctx C; make_ctx(C, args, lds_raw);
    run_step<STEP, MIXER>(C, layer);
}

template <int STEP, int MIXER>
static void launch_phase(const Args& a, int layer, int grid, hipStream_t stream) {
    static bool attr_set = false;
    if (!attr_set) { (void)hipFuncSetAttribute((const void*)mk_phase<STEP, MIXER>, hipFuncAttributeMaxDynamicSharedMemorySize, LDS_BYTES); attr_set = true; }
    hipLaunchKernelGGL((mk_phase<STEP, MIXER>), dim3(grid), dim3(NWAVES * 64), LDS_BYTES, stream, a, layer);
}
#ifndef MK_DUP
#define MK_DUP -1
#endif
#define LP(S, M) do { launch_phase<S, M>(a, layer, grid, stream); if (MK_DUP == S) launch_phase<(S == 8 ? 11 : S), M>(a, layer, grid, stream); } while (0)
template <int MIXER>
static void launch_layer(const Args& a, int layer, int grid, hipStream_t stream) {
    LP(0, MIXER);
    if (MIXER == 0) launch_phase<1, MIXER>(a, layer, grid, stream); else LP(2, MIXER);
    LP(3, MIXER);
    if (MIXER != 0) LP(4, MIXER);
    LP(5, MIXER);
    LP(7, 0);
    LP(8, 0);
}
#if MK_SINGLE
__device__ __forceinline__ const float* tab_ptr(volatile LAS unsigned long long* tab, int i) {
    const unsigned long long v = tab[i];
    const unsigned lo = __builtin_amdgcn_readfirstlane((unsigned)v), hi = __builtin_amdgcn_readfirstlane((unsigned)(v >> 32));
    return (const float*)(const GAS float*)(((unsigned long long)hi << 32) | lo);
}
__device__ __forceinline__ int lane_id_volatile() { int x; asm volatile("v_mbcnt_lo_u32_b32 %0, -1, 0\n\tv_mbcnt_hi_u32_b32 %0, -1, %0" : "=v"(x)); return x; }
__device__ __forceinline__ void make_ctx_opaque(Ctx& C, unsigned char* lds_raw, int wave_s) {
    int bx = blockIdx.x, G = gridDim.x; unsigned ldso = 0u;
    asm volatile("" : "+s"(bx), "+s"(G), "+s"(ldso), "+s"(wave_s));
    int tid = wave_s * 64 + lane_id_volatile();
    C.lds = (LAS unsigned char*)lds_raw + ldso;
    volatile LAS unsigned long long* tab = (volatile LAS unsigned long long*)(C.lds + LDSCTL_OFF);
    C.tid = tid; C.lane = tid & 63; C.wave = __builtin_amdgcn_readfirstlane(tid >> 6);
    C.G = G; C.bx = bx; C.vcu = (G % 8 == 0) ? (bx % 8) * (G / 8) + bx / 8 : bx;
    C.gw = C.vcu * NWAVES + C.wave; C.NGW = G * NWAVES;
#pragma unroll
    for (int i = 0; i < 21; ++i) C.in[i] = tab_ptr(tab, i);
    C.out = (float*)tab_ptr(tab, 21); C.ws = (unsigned char*)tab_ptr(tab, 22);
}
__device__ __forceinline__ void grid_bar(unsigned char* lds_raw, int wave_s) {
    unsigned ldso = 0u; asm volatile("" : "+s"(ldso), "+s"(wave_s));
    LAS unsigned char* lds = (LAS unsigned char*)lds_raw + ldso;
    volatile LAS unsigned long long* tab = (volatile LAS unsigned long long*)(lds + LDSCTL_OFF);
    XcdBarrier b; b.bar = (unsigned*)((unsigned char*)tab_ptr(tab, 22) + WS_CTL) + CW_BAR; b.x = xb_xcc_id(); b.st = (volatile LAS unsigned*)(lds + MISC_OFF) + 8;
    xcd_barrier(b, wave_s == 0 && lane_id_volatile() == 0);
}
#define MK_STEP(...) do { Ctx C; make_ctx_opaque(C, lds_raw, wave_s); __VA_ARGS__; } while (0)
__global__ void __launch_bounds__(NWAVES * 64, 2) mk_fwd(Args args) {
    extern __shared__ __attribute__((aligned(16))) unsigned char lds_raw[];
    const int wave_s = __builtin_amdgcn_readfirstlane(threadIdx.x >> 6);
    for (int u = threadIdx.x; u < (LDS_BYTES - LDSCTL_OFF) / 4; u += NWAVES * 64) ((LAS unsigned*)((LAS unsigned char*)lds_raw + LDSCTL_OFF))[u] = 0u;
    __syncthreads();
    if (threadIdx.x == 0) {
        LAS unsigned long long* tab = (LAS unsigned long long*)((LAS unsigned char*)lds_raw + LDSCTL_OFF);
#pragma unroll
        for (int i = 0; i < 21; ++i) tab[i] = (unsigned long long)args.in[i];
        tab[21] = (unsigned long long)args.out; tab[22] = (unsigned long long)args.ws;
    }
    (void)xcd_barrier_post((unsigned*)(args.ws + WS_CTL) + CW_BAR, (volatile LAS unsigned*)((LAS unsigned char*)lds_raw + MISC_OFF) + 8);
    __syncthreads();
    MK_STEP(p0_prologue(C));
    if (I8_NITEMS) { grid_bar(lds_raw, wave_s); MK_STEP(p0_prologue_b(C)); }
    cg::this_grid().sync();
#pragma unroll 1
    for (int layer = 0; layer < DEPTH; ++layer) {
        const int mixer = layer % 3, jx = layer / 3;
        MK_STEP(const bf16* Wt = mixer == 0 ? (const bf16*)(C.ws + WS_FOXWIN + (size_t)jx * 8 * MiB) : mixer == 1 ? (const bf16*)(C.ws + WS_GLAWIN) : (const bf16*)(C.ws + WS_HGRNWIN);
                const float* sw = (const float*)(C.ws + WS_SW) + (mixer == 0 ? jx * 4096 : mixer == 1 ? 8192 : 11264);
                if (I8MASK == 15 || (I8MASK != 0 && ((I8MASK >> layer) & 1))) do_gemm<3>(C, (const bf16*)(C.ws + WS_XN8), Wt, mixer == 1 ? 3072 : 4096, (bf16*)(C.ws + WS_P), 1024, 1, (const float*)(C.ws + WS_SX), nullptr, nullptr, nullptr, sw, nullptr);
                else do_gemm<0>(C, (const bf16*)(C.ws + WS_XN), Wt, mixer == 1 ? 3072 : 4096, (bf16*)(C.ws + WS_P), 1024, 1, nullptr, nullptr, nullptr, nullptr, nullptr, nullptr));
        grid_bar(lds_raw, wave_s);
        MK_STEP(if (mixer == 0) run_step<1, 0>(C, layer); else if (mixer == 1) run_step<2, 1>(C, layer); else run_step<2, 2>(C, layer));
        grid_bar(lds_raw, wave_s);
        MK_STEP(if (mixer == 0) run_step<3, 0>(C, layer); else if (mixer == 1) run_step<3, 1>(C, layer); else run_step<3, 2>(C, layer));
        grid_bar(lds_raw, wave_s);
        if (mixer != 0) { MK_STEP(if (mixer == 1) run_step<4, 1>(C, layer); else run_step<4, 2>(C, layer)); grid_bar(lds_raw, wave_s); }
        MK_STEP(const bf16* Wt = mixer == 0 ? (const bf16*)(C.ws + WS_FOXWOUT) + (size_t)jx * 1024 * 1024 : mixer == 1 ? (const bf16*)(C.ws + WS_GLAWOUT) : (const bf16*)(C.ws + WS_HGRNWOUT);
                do_gemm<1>(C, (const bf16*)(C.ws + WS_OB), Wt, 1024, nullptr, 0, 0, nullptr, layer == 0 ? C.in[0] : nullptr, nullptr, (bf16*)(C.ws + WS_XN), C.in[2] + layer * 1024, (float*)(C.ws + WS_RS)));
        grid_bar(lds_raw, wave_s);
        MK_STEP(run_step<7, 0>(C, layer));
        grid_bar(lds_raw, wave_s);
        MK_STEP(run_step<8, 0>(C, layer));
        if (layer + 1 < DEPTH) grid_bar(lds_raw, wave_s);
    }
}
#endif

extern "C" void kernel_launch(void* const* d_in, const int* in_sizes, int n_in, void* d_out, int out_size, void* d_ws, size_t ws_size, hipStream_t stream) {
    static int grid = 0;
    if (grid == 0) {
        if (n_in != 21 || out_size != NTOK * 1024 || ws_size < WS_END) { fprintf(stderr, "kernel_launch: unexpected shapes: n_in %d out %d ws %zu (need %zu)\n", n_in, out_size, ws_size, (size_t)WS_END); grid = -1; return; }
        int dev = 0, cus = 0, per_cu = 0;
        (void)hipGetDevice(&dev); (void)hipDeviceGetAttribute(&cus, hipDeviceAttributeMultiprocessorCount, dev);
#if MK_SINGLE
        if (hipFuncSetAttribute((const void*)mk_fwd, hipFuncAttributeMaxDynamicSharedMemorySize, LDS_BYTES) != hipSuccess) { fprintf(stderr, "kernel_launch: hipFuncSetAttribute failed\n"); grid = -1; return; }
        if (hipOccupancyMaxActiveBlocksPerMultiprocessor(&per_cu, (const void*)mk_fwd, NWAVES * 64, LDS_BYTES) != hipSuccess || per_cu < 1) { fprintf(stderr, "kernel_launch: occupancy query says %d blocks per CU\n", per_cu); (void)hipGetLastError(); grid = -1; return; }
#endif
        (void)per_cu;
        grid = cus;
    }
    if (grid < 0) return;
    Args a{};
    for (int i = 0; i < 21; ++i) a.in[i] = (const float*)d_in[i];
    a.out = (float*)d_out; a.ws = (unsigned char*)d_ws;
#if MK_SINGLE
    (void)hipMemsetAsync((char*)d_ws + WS_CTL, 0, CTL_ZERO_BYTES, stream);
    a.ph_lo = 0; a.ph_hi = NPHASE;
    void* kargs[] = {&a};
    hipError_t e = hipLaunchCooperativeKernel((const void*)mk_fwd, dim3(grid), dim3(NWAVES * 64), kargs, LDS_BYTES, stream);
    if (e != hipSuccess) fprintf(stderr, "cooperative launch failed: %s (grid %d)\n", hipGetErrorString(e), grid);
#else
    (void)hipMemsetAsync((char*)d_ws + WS_CTL, 0, CTL_ZERO_BYTES, stream);
    launch_phase<10, 0>(a, 0, grid, stream); if (MK_DUP == 10) launch_phase<10, 0>(a, 0, grid, stream);
    launch_phase<12, 0>(a, 0, grid, stream);
    launch_layer<0>(a, 0, grid, stream);
    launch_layer<1>(a, 1, grid, stream);
    launch_layer<2>(a, 2, grid, stream);
    launch_layer<0>(a, 3, grid, stream);
#endif
}
```

```cpp
#include <hip/hip_runtime.h>
#include <hip/hip_cooperative_groups.h>
#include <cstdio>
#include <cstdint>
#include <cmath>
namespace pg8 {
#define PG8_LAS __attribute__((address_space(3)))
typedef unsigned short bf16_t;
typedef short bf16x8 __attribute__((ext_vector_type(8)));
typedef float f32x4 __attribute__((ext_vector_type(4)));
typedef unsigned u32x4 __attribute__((ext_vector_type(4)));
typedef int i32x4 __attribute__((ext_vector_type(4)));
constexpr int BM = 256, BK = 64, HALF = 128, HTB = HALF * BK * 2  , STAGE_BYTES = 8 * HTB, NXCD = 8, WGM = 8;

__host__ __device__ __forceinline__ int lds_byte(int r, int c) { const int st = (r >> 4) * 2 + (c >> 5), rr = r & 15, cc = c & 31, ob = rr * 64 + cc * 2; return st * 1024 + (ob ^ (((ob >> 9) & 1) << 5)); }
__host__ __device__ __forceinline__ void stage_rc(int b, int& R, int& C) { const int st = b / 1024, sb = b % 1024, swz = sb ^ (((sb >> 9) & 1) << 5); R = (st >> 1) * 16 + swz / 64; C = (st & 1) * 32 + (swz % 64) / 2; }
__host__ __device__ __forceinline__ int perm32(int rho) { const int n = rho >> 4, i = rho & 15; return 8 * (i >> 2) + 4 * n + (i & 3); }

struct Unit { int pm, pn; };
struct Gemm { const bf16_t* A; const bf16_t* Bt; int M, N, K; };

struct StaticOrder {
    int nM, nN, nwg, G, c;
    __host__ __device__ void init(int M, int N, int G_, int c_) { nM = M / BM; nN = N / BM; nwg = nM * nN; G = G_; c = c_; }
    __host__ __device__ bool next(int i, Unit& u) const {
        const long L = (long)i * G + c; if (L >= nwg) return false;
        int wgid = (int)L; { const int q = nwg / NXCD, r = nwg % NXCD, xcd = wgid % NXCD, off = wgid / NXCD; wgid = (xcd < r ? xcd * (q + 1) : r * (q + 1) + (xcd - r) * q) + off; }
        const int nig = WGM * nN, gid = wgid / nig, fm = gid * WGM, gsz = (nM - fm) < WGM ? (nM - fm) : WGM;
        u.pm = fm + ((wgid % nig) % gsz); u.pn = (wgid % nig) / gsz; return true;
    }
    __device__ __forceinline__ void a_ready(const Unit&) const {}
    __device__ __forceinline__ void done(const Unit&) const {}
};

__device__ __forceinline__ unsigned cvt_pk_bf16(float lo, float hi) { unsigned r; asm volatile("v_cvt_pk_bf16_f32 %0, %1, %2" : "=v"(r) : "v"(lo), "v"(hi)); return r; }
typedef float f32x2 __attribute__((ext_vector_type(2)));
__device__ __forceinline__ f32x2 gelu_pk(f32x2 v) {
    const f32x2 av = __builtin_elementwise_abs(v), d = av * 0.2316418882f + 1.0f;
    f32x2 t; t.x = __builtin_amdgcn_rcpf(d.x); t.y = __builtin_amdgcn_rcpf(d.y);
    f32x2 q = t * 0.5307027145f + (-0.7265760135f); q = q * t + 0.7107068705f; q = q * t + (-0.142248368f); q = q * t + 0.127414796f; q = q * t;
    const f32x2 s = (v * v) * (-0.72134752044f);
    f32x2 e; e.x = __builtin_amdgcn_exp2f(s.x); e.y = __builtin_amdgcn_exp2f(s.y);
    const f32x2 m = v * (q * e), r = v - m;
    f32x2 o; o.x = v.x < 0.f ? m.x : r.x; o.y = v.y < 0.f ? m.y : r.y; return o;
}
#ifndef EPI_AUX
#define EPI_AUX 16
#endif
template <bool F16  > struct EpiBf16R {
    typedef f32x4 acc_t;
    static constexpr bool PERM = true, AFTER_DRAIN = false;
    bf16_t* O; int ldc; int split_cols; size_t split_stride; const float* rs;
    __device__ __forceinline__ void operator()(const f32x4 (&acc)[2][2][4][2], const Unit& u, int wr, int wc, int fr, int fq) const {
        const int row0 = u.pm * BM + wr * 64 + fr; int colt = u.pn * BM; unsigned boff = 0u;
        if (split_cols) { const int t = colt / split_cols; boff = (unsigned)(t * split_stride * 2); colt -= t * split_cols; }
        const int col0 = colt + wc * 32 + 8 * fq;
        const __amdgpu_buffer_rsrc_t orsrc = __builtin_amdgcn_make_buffer_rsrc((void*)O, (short)0, 0x7ffffff0, 0x00020000);
#pragma unroll
        for (int ai = 0; ai < 2; ++ai)
#pragma unroll
            for (int m = 0; m < 4; ++m) { const int row = row0 + ai * HALF + m * 16; const unsigned roff = boff + (unsigned)(row * ldc + col0) * 2u;
                float sc = 1.f;
                if (rs) { const f32x4 a = *(const f32x4*)(rs + (size_t)row * 16), b = *(const f32x4*)(rs + (size_t)row * 16 + 4), c = *(const f32x4*)(rs + (size_t)row * 16 + 8), d = *(const f32x4*)(rs + (size_t)row * 16 + 12);
                    const float s = (((a[0] + a[1]) + (a[2] + a[3])) + ((b[0] + b[1]) + (b[2] + b[3]))) + (((c[0] + c[1]) + (c[2] + c[3])) + ((d[0] + d[1]) + (d[2] + d[3])));
                    sc = __builtin_amdgcn_rsqf(s * (1.0f / 1024.0f) + 1e-6f); }
#pragma unroll
                for (int bj = 0; bj < 2; ++bj) { const f32x4 v0 = acc[ai][bj][m][0] * sc, v1 = acc[ai][bj][m][1] * sc;
                    u32x4 w;
                    if (F16) { w.x = __builtin_bit_cast(unsigned, __builtin_amdgcn_cvt_pkrtz(v0[0], v0[1])); w.y = __builtin_bit_cast(unsigned, __builtin_amdgcn_cvt_pkrtz(v0[2], v0[3])); w.z = __builtin_bit_cast(unsigned, __builtin_amdgcn_cvt_pkrtz(v1[0], v1[1])); w.w = __builtin_bit_cast(unsigned, __builtin_amdgcn_cvt_pkrtz(v1[2], v1[3])); }
                    else { w.x = cvt_pk_bf16(v0[0], v0[1]); w.y = cvt_pk_bf16(v0[2], v0[3]); w.z = cvt_pk_bf16(v1[0], v1[1]); w.w = cvt_pk_bf16(v1[2], v1[3]); }
                    __builtin_amdgcn_raw_buffer_store_b128(w, orsrc, (int)(roff + bj * HALF * 2), 0, EPI_AUX); } }
    }
};
struct EpiI8 {
    typedef i32x4 acc_t;
    static constexpr bool PERM = true, AFTER_DRAIN = false;
    bf16_t* O; size_t split_stride; const float* sx; const float* sw;
    __device__ __forceinline__ void operator()(const i32x4 (&acc)[2][2][4][2], const Unit& u, int wr, int wc, int fr, int fq) const {
        const int row0 = u.pm * BM + wr * 64 + fr; int colt = u.pn * BM; unsigned boff;
        { const int t = colt / 1024; boff = (unsigned)(t * split_stride * 2); colt -= t * 1024; }
        const __amdgpu_buffer_rsrc_t orsrc = __builtin_amdgcn_make_buffer_rsrc((void*)O, (short)0, 0x7ffffff0, 0x00020000);
        const int col0 = colt + wc * 32 + 8 * fq, scol0 = u.pn * BM + wc * 32 + 8 * fq;
        f32x4 cw[2][2];
#pragma unroll
        for (int bj = 0; bj < 2; ++bj) { cw[bj][0] = *(const f32x4*)(sw + scol0 + bj * HALF); cw[bj][1] = *(const f32x4*)(sw + scol0 + bj * HALF + 4); }
#pragma unroll
        for (int ai = 0; ai < 2; ++ai)
#pragma unroll
            for (int m = 0; m < 4; ++m) { const int row = row0 + ai * HALF + m * 16; const unsigned roff = boff + (unsigned)(row * 1024 + col0) * 2u; const float rs = sx[row];
#pragma unroll
                for (int bj = 0; bj < 2; ++bj) { const i32x4 a0 = acc[ai][bj][m][0], a1 = acc[ai][bj][m][1];
                    const f32x4 v0 = (f32x4){(float)a0[0], (float)a0[1], (float)a0[2], (float)a0[3]} * cw[bj][0] * rs, v1 = (f32x4){(float)a1[0], (float)a1[1], (float)a1[2], (float)a1[3]} * cw[bj][1] * rs;
                    u32x4 w; w.x = cvt_pk_bf16(v0[0], v0[1]); w.y = cvt_pk_bf16(v0[2], v0[3]); w.z = cvt_pk_bf16(v1[0], v1[1]); w.w = cvt_pk_bf16(v1[2], v1[3]);
                    __builtin_amdgcn_raw_buffer_store_b128(w, orsrc, (int)(roff + bj * HALF * 2), 0, EPI_AUX); } }
    }
};
template <bool BASE16> struct EpiResNorm {
    typedef f32x4 acc_t;
    static constexpr bool PERM = false, AFTER_DRAIN = false;
    const void* base; bf16_t* out; bf16_t* hg; const float* gain; float* rs;
    __device__ __forceinline__ void operator()(const f32x4 (&acc)[2][2][4][2], const Unit& u, int wr, int wc, int fr, int fq) const {
        const int col0 = u.pn * BM + wc * 32 + 4 * fq, lane = fr + 16 * fq;
        f32x4 gv[2][2];
#pragma unroll
        for (int bj = 0; bj < 2; ++bj)
#pragma unroll
            for (int n = 0; n < 2; ++n) gv[bj][n] = *(const f32x4*)(gain + col0 + bj * HALF + n * 16);
#pragma unroll
        for (int ai = 0; ai < 2; ++ai)
#pragma unroll
            for (int m = 0; m < 4; ++m) { const int r = ai * HALF + wr * 64 + m * 16 + fr; const size_t off = (size_t)(u.pm * BM + r) * 1024 + col0;
                float ss = 0.f;
#pragma unroll
                for (int bj = 0; bj < 2; ++bj)
#pragma unroll
                    for (int n = 0; n < 2; ++n) { typedef unsigned u32x2 __attribute__((ext_vector_type(2))); f32x4 b;
                        if (BASE16) { const u32x2 bw = *(const u32x2*)((const bf16_t*)base + off + bj * HALF + n * 16);
                            b = (f32x4){__builtin_bit_cast(float, bw.x << 16), __builtin_bit_cast(float, bw.x & 0xffff0000u), __builtin_bit_cast(float, bw.y << 16), __builtin_bit_cast(float, bw.y & 0xffff0000u)}; }
                        else b = *(const f32x4*)((const float*)base + off + bj * HALF + n * 16);
                        const f32x4 o = b + acc[ai][bj][m][n];
                        u32x2 wo; wo.x = cvt_pk_bf16(o[0], o[1]); wo.y = cvt_pk_bf16(o[2], o[3]); *(u32x2*)(out + off + bj * HALF + n * 16) = wo;
                        ss += (o[0] * o[0] + o[1] * o[1]) + (o[2] * o[2] + o[3] * o[3]);
                        const f32x4 h = o * gv[bj][n]; u32x2 w; w.x = cvt_pk_bf16(h[0], h[1]); w.y = cvt_pk_bf16(h[2], h[3]);
                        *(u32x2*)(hg + off + bj * HALF + n * 16) = w; }
                ss += __builtin_bit_cast(float, __builtin_amdgcn_ds_bpermute((lane ^ 16) << 2, __builtin_bit_cast(int, ss)));
                ss += __builtin_bit_cast(float, __builtin_amdgcn_ds_bpermute((lane ^ 32) << 2, __builtin_bit_cast(int, ss)));
                if (fq == 0) rs[(size_t)(u.pm * BM + r) * 16 + u.pn * 4 + wc] = ss; }
    }
};
__device__ __forceinline__ f32x4 mma16(bf16x8 a, bf16x8 b, f32x4 c) { return __builtin_amdgcn_mfma_f32_16x16x32_bf16(a, b, c, 0, 0, 0); }
__device__ __forceinline__ i32x4 mma16(bf16x8 a, bf16x8 b, i32x4 c) { return __builtin_amdgcn_mfma_i32_16x16x64_i8(__builtin_bit_cast(i32x4, a), __builtin_bit_cast(i32x4, b), c, 0, 0, 0); }
template <class Epi, class Sched, bool ALIGN_EPI = false, bool SP2 = false>
__device__ __forceinline__ void gemm_phase(PG8_LAS unsigned char* lds, const Gemm g, const Sched& S, const Epi& E, int tid_in) {
    int tid_ = tid_in; asm volatile("" : "+v"(tid_));
    const int tid = tid_, wid = __builtin_amdgcn_readfirstlane(tid >> 6), lane = tid & 63, wr = wid >> 2, wc = wid & 3, fr = lane & 15, fq = lane >> 4;
    const int K = g.K, nt = K / BK;
    unsigned voffA[2], voffB[2];
#pragma unroll
    for (int i = 0; i < 2; ++i) { int R, C; stage_rc(tid * 16 + i * 8192, R, C); const int Rb = Epi::PERM ? ((R & ~31) + perm32(R & 31)) : R;
        voffA[i] = (unsigned)(R * K + C) * 2u; voffB[i] = (unsigned)(Rb * K + C) * 2u; }
    const size_t kstep = (size_t)(BK * 2);
    const size_t hstep = (size_t)HALF * K * 2;
    const size_t tstep = 2 * hstep;
    const unsigned ldsw = (unsigned)wid * 1024u;
    const int aoff = lds_byte(wr * 64 + fr, fq * 8), boff = lds_byte(wc * 32 + fr, fq * 8);
#define PG8_SA(b, h) (((b) * 2 + (h)) * HTB)
#define PG8_SB(b, h) ((4 + (b) * 2 + (h)) * HTB)
#define PG8_STAGE(bufoff, gbase, voff) do { _Pragma("unroll") for (int _i = 0; _i < 2; ++_i) \
        __builtin_amdgcn_global_load_lds((const unsigned*)((const char*)(gbase) + (voff)[_i]), (PG8_LAS unsigned*)(lds + (bufoff) + ldsw + _i * 8192), 16, 0, 0); } while (0)
#define PG8_LDA(dst, b, h) do { _Pragma("unroll") for (int m = 0; m < 4; ++m) _Pragma("unroll") for (int k = 0; k < 2; ++k) dst[m][k] = *(const PG8_LAS bf16x8*)(lds + PG8_SA(b, h) + aoff + m * 2048 + k * 1024); } while (0)
#define PG8_LDB(dst, b, h) do { _Pragma("unroll") for (int n = 0; n < 2; ++n) _Pragma("unroll") for (int k = 0; k < 2; ++k) dst[n][k] = *(const PG8_LAS bf16x8*)(lds + PG8_SB(b, h) + boff + n * 2048 + k * 1024); } while (0)
#define PG8_MMA(ai, bj, At, Bt) do { __builtin_amdgcn_s_setprio(1); _Pragma("unroll") for (int m = 0; m < 4; ++m) _Pragma("unroll") for (int n = 0; n < 2; ++n) _Pragma("unroll") for (int k = 0; k < 2; ++k) \
        acc[ai][bj][m][n] = mma16(Bt[n][k], At[m][k], acc[ai][bj][m][n]); __builtin_amdgcn_s_setprio(0); } while (0)
#define PG8_WAIT_V(n) asm volatile("s_waitcnt vmcnt(" #n ")" ::: "memory")
#define PG8_WAIT_L(n) asm volatile("s_waitcnt lgkmcnt(" #n ")" ::: "memory")
#define PG8_BAR __builtin_amdgcn_s_barrier()
#define PG8_SCHED __builtin_amdgcn_sched_barrier(0)
    Unit cur, nxt; int ui = 0;
    if (!S.next(0, cur)) return;
    typedef typename Epi::acc_t acc_t;
    acc_t acc[2][2][4][2];
#pragma unroll
    for (int a = 0; a < 2; ++a)
#pragma unroll
        for (int b = 0; b < 2; ++b)
#pragma unroll
            for (int m = 0; m < 4; ++m)
#pragma unroll
                for (int n = 0; n < 2; ++n) acc[a][b][m][n] = (acc_t){0, 0, 0, 0};
    bf16x8 At[4][2], B0[2][2], B1[2][2];
    const char* cA = (const char*)g.A + (size_t)cur.pm * tstep; const char* cB = (const char*)g.Bt + (size_t)cur.pn * tstep;
    S.a_ready(cur);
    if constexpr (SP2) {
        PG8_STAGE(PG8_SB(0, 0), cB, voffB); PG8_STAGE(PG8_SB(0, 1), cB + hstep, voffB); PG8_STAGE(PG8_SA(0, 0), cA, voffA); PG8_STAGE(PG8_SA(0, 1), cA + hstep, voffA);
        if (wr == 1) PG8_BAR;
        PG8_WAIT_V(2); PG8_BAR;
        PG8_STAGE(PG8_SB(1, 0), cB + kstep, voffB); PG8_STAGE(PG8_SA(1, 0), cA + kstep, voffA); PG8_STAGE(PG8_SB(1, 1), cB + hstep + kstep, voffB);
        PG8_WAIT_V(6); PG8_BAR;
    } else {
        PG8_STAGE(PG8_SB(0, 0), cB, voffB); PG8_STAGE(PG8_SA(0, 0), cA, voffA); PG8_STAGE(PG8_SB(0, 1), cB + hstep, voffB); PG8_STAGE(PG8_SA(0, 1), cA + hstep, voffA);
        if (wr == 1) PG8_BAR;
        PG8_WAIT_V(4); PG8_BAR;
        PG8_STAGE(PG8_SB(1, 0), cB + kstep, voffB); PG8_STAGE(PG8_SA(1, 0), cA + kstep, voffA); PG8_STAGE(PG8_SB(1, 1), cB + hstep + kstep, voffB);
        PG8_WAIT_V(6); PG8_BAR;
    }
    for (;;) {
        const bool has_next = S.next(ui + 1, nxt);
        const char* nA = has_next ? (const char*)g.A + (size_t)nxt.pm * tstep : cA; const char* nB = has_next ? (const char*)g.Bt + (size_t)nxt.pn * tstep : cB;
        for (int t = 0; t < nt; t += 2) {
            const bool last = (t == nt - 2);
            const char* a1 = cA + (size_t)(t + 1) * kstep;
            const char* a2 = last ? nA : cA + (size_t)(t + 2) * kstep; const char* b2 = last ? nB : cB + (size_t)(t + 2) * kstep;
            const char* a3 = a2 + kstep; const char* b3 = b2 + kstep;
            if (last && has_next) S.a_ready(nxt);
            if constexpr (SP2) {
            PG8_LDB(B0, 0, 0); PG8_LDB(B1, 0, 1); PG8_SCHED; PG8_LDA(At, 0, 0); PG8_STAGE(PG8_SA(1, 1), a1 + hstep, voffA);
            PG8_WAIT_V(8); PG8_WAIT_L(0); PG8_BAR; PG8_MMA(0, 0, At, B0); PG8_MMA(0, 1, At, B1); PG8_BAR; PG8_SCHED;
            PG8_LDA(At, 0, 1); PG8_STAGE(PG8_SB(0, 0), b2, voffB); PG8_STAGE(PG8_SB(0, 1), b2 + hstep, voffB); PG8_STAGE(PG8_SA(0, 0), a2, voffA);
            PG8_WAIT_V(8); PG8_WAIT_L(0); PG8_BAR; PG8_MMA(1, 0, At, B0); PG8_MMA(1, 1, At, B1); PG8_BAR; PG8_SCHED;
            PG8_LDB(B0, 1, 0); PG8_LDB(B1, 1, 1); PG8_SCHED; PG8_LDA(At, 1, 0); PG8_STAGE(PG8_SA(0, 1), a2 + hstep, voffA);
            PG8_WAIT_V(8); PG8_WAIT_L(0); PG8_BAR; PG8_MMA(0, 0, At, B0); PG8_MMA(0, 1, At, B1); PG8_BAR; PG8_SCHED;
            PG8_LDA(At, 1, 1); PG8_STAGE(PG8_SB(1, 0), b3, voffB); PG8_STAGE(PG8_SB(1, 1), b3 + hstep, voffB); PG8_STAGE(PG8_SA(1, 0), a3, voffA);
            PG8_WAIT_V(8); PG8_WAIT_L(0); PG8_BAR; PG8_MMA(1, 0, At, B0); PG8_MMA(1, 1, At, B1); PG8_BAR; PG8_SCHED;
            } else {
            PG8_LDB(B0, 0, 0); PG8_SCHED; PG8_LDA(At, 0, 0); PG8_STAGE(PG8_SA(1, 1), a1 + hstep, voffA);
            PG8_WAIT_L(8); PG8_BAR; PG8_WAIT_L(0); PG8_MMA(0, 0, At, B0); PG8_BAR; PG8_SCHED;
            PG8_LDB(B1, 0, 1); PG8_STAGE(PG8_SB(0, 0), b2, voffB);
            PG8_BAR; PG8_WAIT_L(0); PG8_MMA(0, 1, At, B1); PG8_BAR;
            PG8_LDA(At, 0, 1); PG8_STAGE(PG8_SA(0, 0), a2, voffA);
            PG8_BAR; PG8_WAIT_L(0); PG8_MMA(1, 0, At, B0); PG8_BAR; PG8_SCHED;
            PG8_STAGE(PG8_SB(0, 1), b2 + hstep, voffB);
            PG8_WAIT_V(6); PG8_BAR; PG8_MMA(1, 1, At, B1); PG8_BAR;
            PG8_LDB(B0, 1, 0); PG8_SCHED; PG8_LDA(At, 1, 0); PG8_STAGE(PG8_SA(0, 1), a2 + hstep, voffA);
            PG8_WAIT_L(8); PG8_BAR; PG8_WAIT_L(0); PG8_MMA(0, 0, At, B0); PG8_BAR; PG8_SCHED;
            PG8_LDB(B1, 1, 1); PG8_STAGE(PG8_SB(1, 0), b3, voffB);
            PG8_BAR; PG8_WAIT_L(0); PG8_MMA(0, 1, At, B1); PG8_BAR;
            PG8_LDA(At, 1, 1); PG8_STAGE(PG8_SA(1, 0), a3, voffA);
            PG8_BAR; PG8_WAIT_L(0); PG8_MMA(1, 0, At, B0); PG8_BAR; PG8_SCHED;
            PG8_STAGE(PG8_SB(1, 1), b3 + hstep, voffB);
            PG8_WAIT_V(6); PG8_BAR; PG8_MMA(1, 1, At, B1); PG8_BAR;
            }
        }
        if constexpr (ALIGN_EPI) { if (wr == 0) PG8_BAR; }
        if constexpr (!Epi::AFTER_DRAIN) { E(acc, cur, wr, wc, fr, fq); S.done(cur); }
        if (!has_next) break;
#pragma unroll
        for (int a = 0; a < 2; ++a)
#pragma unroll
            for (int b = 0; b < 2; ++b)
#pragma unroll
                for (int m = 0; m < 4; ++m)
#pragma unroll
                    for (int n = 0; n < 2; ++n) acc[a][b][m][n] = (acc_t){0, 0, 0, 0};
        cur = nxt; cA = nA; cB = nB; ++ui;
        if constexpr (ALIGN_EPI) { if (wr == 1) PG8_BAR; }
    }
    PG8_WAIT_V(0);
    if constexpr (!ALIGN_EPI) { if (wr == 0) PG8_BAR; }
    PG8_BAR;
    if constexpr (Epi::AFTER_DRAIN) { E.fused(acc, cur, wr, wc, fr, fq, lds, wid, lane); S.done(cur); }
#undef PG8_SA
#undef PG8_SB
#undef PG8_STAGE
#undef PG8_LDA
#undef PG8_LDB
#undef PG8_MMA
#undef PG8_WAIT_V
#undef PG8_WAIT_L
#undef PG8_BAR
#undef PG8_SCHED
}
}
#include <hip/hip_bf16.h>
#include <cmath>
namespace attn_body {
using bf16=__hip_bfloat16;
using bf16x8=__attribute__((ext_vector_type(8)))short;
using s16x4=__attribute__((ext_vector_type(4)))short;
using f32x16=__attribute__((ext_vector_type(16)))float;
using u32x4=__attribute__((ext_vector_type(4)))unsigned;
constexpr int BATCH=8,NHEAD=16,SEQ=2048,D=64,DM=NHEAD*D;
constexpr int NW=8,QBLK=32,QB=QBLK*NW,KVBLK=64,NQB=SEQ/QB;
constexpr int ATTN_PITCH=DM, ATTN_UNIT_ROWS=QB;
__device__ __forceinline__ int crow(int r,int hi){return (r&3)+8*(r>>2)+4*hi;}
#define SBAR() __builtin_amdgcn_sched_barrier(0)
__device__ __forceinline__ void cmask(f32x16&p0,f32x16&p1,int jb,int qrel,int hi){
  const float NEG=-INFINITY; int kb=64*jb+4*hi;
  #pragma unroll
  for(int r=0;r<16;++r){int kv=kb+(r&3)+8*(r>>2); if(kv>qrel)p0[r]=NEG; if(kv+32>qrel)p1[r]=NEG;}
}

constexpr int NSLOT=3, SLOTB=8192;
constexpr int LDS_K=0, LDS_V=NSLOT*SLOTB, LDS_WS=2*NSLOT*SLOTB, LDS_OST=LDS_WS+NW*64*4, LDS_CS=LDS_OST+NW*4096, LDS_BYTES=LDS_CS+SEQ*4;
constexpr float C2=0.125f*1.4426950408889634f;
__device__ __forceinline__ void glds16(const void*gsrc,unsigned lds_dst){unsigned keep;
  asm volatile("s_mov_b32 %0, m0\n\ts_mov_b32 m0, %2\n\ts_nop 0\n\tglobal_load_lds_dwordx4 %1, off\n\ts_mov_b32 m0, %0":"=&s"(keep):"v"(gsrc),"s"(lds_dst):"memory");}
__device__ __forceinline__ float max3f(float a,float b,float c){float r;asm("v_max3_f32 %0, %1, %2, %3":"=v"(r):"v"(a),"v"(b),"v"(c));return r;}
__device__ __forceinline__ float max2f(float a,float b){float r;asm("v_max_f32_e32 %0, %1, %2":"=v"(r):"v"(a),"v"(b));return r;}
__device__ __forceinline__ float fadd_s(float a,float b){float r;asm("v_add_f32_e32 %0, %1, %2":"=v"(r):"v"(a),"v"(b));return r;}
__device__ __forceinline__ float fsub_s(float a,float b){float r;asm("v_sub_f32_e32 %0, %1, %2":"=v"(r):"v"(a),"v"(b));return r;}
typedef float f32x2_t __attribute__((ext_vector_type(2))); typedef __bf16 bf16x2_t __attribute__((ext_vector_type(2)));
__device__ __forceinline__ unsigned cvtpk_s(float lo,float hi){f32x2_t v={lo,hi};bf16x2_t b=__builtin_convertvector(v,bf16x2_t);return __builtin_bit_cast(unsigned,b);}
#define WAIT_BAR(N) asm volatile("s_waitcnt vmcnt(" #N ") lgkmcnt(0)\n\ts_barrier":::"memory")

typedef __attribute__((address_space(3))) const char* lds_cptr;
__device__ __forceinline__ void qkt(f32x16&p0,f32x16&p1,const char*Kslot,lds_cptr qls,bf16x8 ax0,bf16x8 ax1,bf16x8 qx,int r32,int hi){
  const char*kb=Kslot+hi*1024+r32*16; const f32x16 z16=f32x16{};
  p0=__builtin_amdgcn_mfma_f32_32x32x16_bf16(ax0,qx,z16,0,0,0);p1=__builtin_amdgcn_mfma_f32_32x32x16_bf16(ax1,qx,z16,0,0,0);
  #pragma unroll
  for(int d0=0;d0<4;++d0){
    const bf16x8 b0=*reinterpret_cast<const bf16x8*>(kb+d0*2048);
    const bf16x8 b1=*reinterpret_cast<const bf16x8*>(kb+d0*2048+512);
    const bf16x8 qd=*(const __attribute__((address_space(3))) bf16x8*)(qls+d0*1024);
    p0=__builtin_amdgcn_mfma_f32_32x32x16_bf16(b0,qd,p0,0,0,0);p1=__builtin_amdgcn_mfma_f32_32x32x16_bf16(b1,qd,p1,0,0,0);}
}
typedef short v4i16_t __attribute__((ext_vector_type(4)));
__device__ __forceinline__ void kload8(bf16x8*kf,lds_cptr kp){
  kf[0]=*(const __attribute__((address_space(3))) bf16x8*)(kp);      kf[1]=*(const __attribute__((address_space(3))) bf16x8*)(kp+512);
  kf[2]=*(const __attribute__((address_space(3))) bf16x8*)(kp+2048); kf[3]=*(const __attribute__((address_space(3))) bf16x8*)(kp+2560);
  kf[4]=*(const __attribute__((address_space(3))) bf16x8*)(kp+4096); kf[5]=*(const __attribute__((address_space(3))) bf16x8*)(kp+4608);
  kf[6]=*(const __attribute__((address_space(3))) bf16x8*)(kp+6144); kf[7]=*(const __attribute__((address_space(3))) bf16x8*)(kp+6656);
}
__device__ __forceinline__ void kload2(bf16x8*kf,lds_cptr kp,int j){ kf[2*j]=*(const __attribute__((address_space(3))) bf16x8*)(kp+j*2048); kf[2*j+1]=*(const __attribute__((address_space(3))) bf16x8*)(kp+j*2048+512); }
__device__ __forceinline__ s16x4 vtr(lds_cptr p){ return __builtin_bit_cast(s16x4,__builtin_amdgcn_ds_read_tr16_b64_v4i16((__attribute__((address_space(3))) v4i16_t*)p)); }
__device__ __forceinline__ float rowmax(const f32x16&p0,const f32x16&p1){
  float a=max3f(p0[0],p0[1],p1[0]),b=max3f(p0[2],p0[3],p1[1]);a=max3f(a,p1[2],p1[3]);
  #pragma unroll
  for(int r=4;r<16;r+=4){a=max3f(a,p0[r],p0[r+1]);b=max3f(b,p0[r+2],p0[r+3]);a=max3f(a,p1[r],p1[r+1]);b=max3f(b,p1[r+2],p1[r+3]);}
  const float m=max2f(a,b);
  auto rr=__builtin_amdgcn_permlane32_swap(__float_as_uint(m),__float_as_uint(m),false,false);
  return max2f(__uint_as_float(rr[0]),__uint_as_float(rr[1]));
}
__device__ __forceinline__ void pv(f32x16*o,int vb,bf16x8 pa0,bf16x8 pa1,bf16x8 pa2,bf16x8 pa3){
  #pragma unroll
  for(int d0=0;d0<2;++d0){s16x4 lo[4],hi[4];
    #pragma unroll
    for(int ks=0;ks<4;++ks){
      asm volatile("ds_read_b64_tr_b16 %0,%1 offset:%c2":"=&v"(lo[ks]):"v"(vb),"i"(d0*4096+ks*1024):"memory");
      asm volatile("ds_read_b64_tr_b16 %0,%1 offset:%c2":"=&v"(hi[ks]):"v"(vb),"i"(d0*4096+ks*1024+512):"memory");}
    asm volatile("s_waitcnt lgkmcnt(0)":::"memory");SBAR();
    #define PK(k) (bf16x8){lo[k][0],lo[k][1],lo[k][2],lo[k][3],hi[k][0],hi[k][1],hi[k][2],hi[k][3]}
    o[d0]=__builtin_amdgcn_mfma_f32_32x32x16_bf16(pa0,PK(0),o[d0],0,0,0);
    o[d0]=__builtin_amdgcn_mfma_f32_32x32x16_bf16(pa1,PK(1),o[d0],0,0,0);
    o[d0]=__builtin_amdgcn_mfma_f32_32x32x16_bf16(pa2,PK(2),o[d0],0,0,0);
    o[d0]=__builtin_amdgcn_mfma_f32_32x32x16_bf16(pa3,PK(3),o[d0],0,0,0);
    #undef PK
  }
}

__device__ __forceinline__ void split3(float c,unsigned&hb,unsigned&mb,unsigned&lb){
  hb=__float_as_uint(c)&0xffff0000u; const float r1=c-__uint_as_float(hb); mb=__float_as_uint(r1)&0xffff0000u; const float r2=r1-__uint_as_float(mb); lb=__float_as_uint(r2)&0xffff0000u; }
__device__ __forceinline__ bf16x8 make_ax(float negc){ unsigned hb,mb,lb; split3(negc,hb,mb,lb);
  u32x4 w; w.x=(hb>>16)|mb; w.y=(lb>>16)|0x3f800000u; w.z=0x3f803f80u; w.w=0u; return __builtin_bit_cast(bf16x8,w); }
__device__ __forceinline__ bf16x8 make_qx(float negm,unsigned hm){ unsigned hb,mb,lb; split3(negm,hb,mb,lb);
  u32x4 w; w.x=0x3f803f80u&hm; w.y=(0x3f80u|hb)&hm; w.z=((mb>>16)|lb)&hm; w.w=0u; return __builtin_bit_cast(bf16x8,w); }
#ifndef ATTN_STORE16
#define ATTN_STORE16(p,v) (*(u32x4*)(p)=(v))
#endif
template<int THRL> __device__ __forceinline__ void attn_unit(int b,int h,int qb,const bf16*Q,const bf16*__restrict__ K,const bf16*__restrict__ V,bf16*O,const bf16*__restrict__ Gt,char*shm,const int tid_u,const float skip_thr){
  int tid=tid_u; asm volatile("":"+v"(tid));
  const int lane=tid&63,r32=lane&31,hi=lane>>5; const int wid=__builtin_amdgcn_readfirstlane(tid>>6);
  const long rowbase=(long)b*SEQ; const int q0=qb*QB;
  const bf16*Qw=Q+(rowbase+q0+wid*QBLK)*DM+h*D;
  float*csp=(float*)(shm+LDS_CS);
  int tskip=0;
  { const float cq0=csp[q0]; const int ntall=(q0+QB)/KVBLK; while(tskip+2<=ntall-4 && csp[KVBLK*(tskip+1)+KVBLK-1]-cq0<skip_thr)tskip+=2; tskip=__builtin_amdgcn_readfirstlane(tskip); }
  const bf16*Kh=K+(rowbase+(long)tskip*KVBLK)*DM+h*D,*Vh=V+(rowbase+(long)tskip*KVBLK)*DM+h*D;
  const unsigned lds0=(unsigned)(uintptr_t)shm;
  float*wsf=(float*)(shm+LDS_WS)+wid*64;
  const unsigned koff=(unsigned)(lane*DM+wid*8), voff=(unsigned)((16*(wid&3)+(lane>>2))*DM+(wid>>2)*32+(lane&3)*8);
  const unsigned kdst=lds0+LDS_K+wid*1024, vdst=lds0+LDS_V+wid*1024;
  #define DMA_K(t,slot) do{unsigned o_=koff;asm volatile("":"+v"(o_));glds16(Kh+(long)(t)*KVBLK*DM+o_,(unsigned)__builtin_amdgcn_readfirstlane(kdst+(slot)));}while(0)
  #define DMA_V(t,slot) do{unsigned o_=voff;asm volatile("":"+v"(o_));glds16(Vh+(long)(t)*KVBLK*DM+o_,(unsigned)__builtin_amdgcn_readfirstlane(vdst+(slot)));}while(0)
  const int vb0=(int)(lds0+LDS_V)+((lane>>4)&1)*32+(lane&3)*8+(4*hi+((lane&15)>>2))*64;
  const char*Kbase=shm+LDS_K; bf16x8 kf[8];
  const lds_cptr shm3=(lds_cptr)shm; const lds_cptr kp0=shm3+LDS_K+hi*1024+r32*16; const lds_cptr vp0=shm3+LDS_V+((lane>>4)&1)*32+(lane&3)*8+(4*hi+((lane&15)>>2))*64;
  const int NT=(q0+QB)/KVBLK-tskip;
  const float*cst=csp+tskip*KVBLK;
  const unsigned hm=hi?0u:0xffffffffu;
  DMA_K(0,0);DMA_V(0,0);DMA_K(1,SLOTB);
  const lds_cptr qls=shm3+LDS_OST+wid*4096+hi*512+r32*16;
  { bf16x8 qr[4];
    #pragma unroll
    for(int d0=0;d0<4;++d0)qr[d0]=*reinterpret_cast<const bf16x8*>(&Qw[(long)r32*DM+d0*16+hi*8]);
    #pragma unroll
    for(int d0=0;d0<4;++d0)*(__attribute__((address_space(3))) bf16x8*)(shm3+LDS_OST+wid*4096+hi*512+r32*16+d0*1024)=qr[d0]; }
  #define QLD(k) (*(const __attribute__((address_space(3))) bf16x8*)(qls+(k)*1024))
  float mhat=csp[q0+wid*QBLK+r32],l_reg=0.f;f32x16 o[2];o[0]=f32x16{};o[1]=f32x16{}; bf16x8 qx=make_qx(-mhat,hm);
  const int qrel=wid*QBLK+r32;
  #define CMASK(P0,P1,t) do{int jb_=(t)-(NT-4); if(jb_>=0)cmask(P0,P1,jb_,qrel,hi);}while(0)
  bool resc=false;
  #define START(P0,P1) do{ const float rm=rowmax(P0,P1); resc=false; \
    if(__any(rm>(float)THRL)){ const float dl=__builtin_fmaxf(rm,0.f); mhat=fadd_s(mhat,dl); \
      _Pragma("unroll") for(int r=0;r<16;++r){P0[r]=fsub_s(P0[r],dl);P1[r]=fsub_s(P1[r],dl);} \
      qx=make_qx(-mhat,hm); } \
    _Pragma("unroll") for(int r=0;r<16;++r)P0[r]=__builtin_amdgcn_exp2f(P0[r]); }while(0)
  #define RESC() do{ if(resc){ asm volatile("s_waitcnt lgkmcnt(0)":::"memory"); \
      _Pragma("unroll") for(int d_=0;d_<2;++d_) _Pragma("unroll") for(int r=0;r<16;++r)o[d_][r]*=wsf[crow(r,hi)]; } }while(0)
  f32x16 pA0,pA1,pB0,pB1;
  int sl_prev=0,sl_cur=0,sl_next=SLOTB;
  #define ROT() do{sl_prev=sl_cur;sl_cur=sl_next;sl_next=(sl_next==(NSLOT-1)*SLOTB)?0:sl_next+SLOTB;}while(0)
  DMA_K(2,2*SLOTB);
  WAIT_BAR(3);
  qkt(pA0,pA1,Kbase,qls,make_ax(cst[r32]),make_ax(cst[32+r32]),qx,r32,hi);asm volatile("s_nop 15\n\ts_nop 7":"+v"(pA0),"+v"(pA1));CMASK(pA0,pA1,0);
  START(pA0,pA1);
  _Pragma("unroll") for(int r=0;r<16;++r)pA1[r]=__builtin_amdgcn_exp2f(pA1[r]);
  WAIT_BAR(0);
  DMA_K(3,0);DMA_V(1,SLOTB);
  ROT();
  kload8(kf,kp0+sl_cur);
  WAIT_BAR(2);
  s16x4 vlo[8],vhi[8]; u32x4 pw0,pw1,pw2,pw3;
  #define PKW(P,B) cvtpk_s(P[B],P[B+1])
  #define PAF(k) __builtin_bit_cast(bf16x8,pw##k)
  #define VFR(i) (bf16x8){vlo[i][0],vlo[i][1],vlo[i][2],vlo[i][3],vhi[i][0],vhi[i][1],vhi[i][2],vhi[i][3]}
  #define PIN(x) asm volatile("":"+v"(x))
  #define MX3(a,b,c) __builtin_fmaxf(__builtin_fmaxf((a),(b)),(c))
  #define GAPA(MF,A0,A1,A2,A3,W0,W1,PW) do{ MF; sacc+=A0; sacc+=A1; sacc+=A2; sacc+=A3; PIN(sacc); W0; W1; PIN(PW); SBAR(); }while(0)
  #define EX(v) __builtin_amdgcn_exp2f(v)
  #define GAPB(MF,X,B) do{ MF; X[B]=EX(X[B]); X[B+1]=EX(X[B+1]); X[B+2]=EX(X[B+2]); X[B+3]=EX(X[B+3]); PIN(X); SBAR(); }while(0)
  #define VRD(i) do{ vlo[i]=vtr(vp_+(((i)>>2)*4096+((i)&3)*1024)); vhi[i]=vtr(vp_+(((i)>>2)*4096+((i)&3)*1024+512)); }while(0)
  #define KRD(G,j) do{ if(G){ kload2(kf,kp0+sl_next,j); SBAR(); } }while(0)
  #define STEP(C0,C1,P0,P1,t,GK,GV,GL) do{ SBAR(); \
    const lds_cptr vp_=vp0+sl_prev; \
    const bf16x8 ax0_=make_ax(cst[(t)*KVBLK+r32]), ax1_=make_ax(cst[(t)*KVBLK+32+r32]); \
    C0=__builtin_amdgcn_mfma_f32_32x32x16_bf16(ax0_,qx,f32x16{},0,0,0); C1=__builtin_amdgcn_mfma_f32_32x32x16_bf16(ax1_,qx,f32x16{},0,0,0); SBAR(); \
    bf16x8 q0_=QLD(0), q1_=QLD(1); \
    VRD(0); SBAR(); float sacc=(P0[0]+P0[1]); \
    GAPA(C0=__builtin_amdgcn_mfma_f32_32x32x16_bf16(kf[0],q0_,C0,0,0,0), P0[2],P0[3],P0[4],P0[5],     pw0[0]=PKW(P0,0), pw0[1]=PKW(P0,2), pw0); \
    VRD(4); SBAR(); GAPA(C1=__builtin_amdgcn_mfma_f32_32x32x16_bf16(kf[1],q0_,C1,0,0,0), P0[6],P0[7],P0[8],P0[9],     pw0[2]=PKW(P0,4), pw0[3]=PKW(P0,6), pw0); q0_=QLD(2); \
    VRD(1); SBAR(); GAPA(C0=__builtin_amdgcn_mfma_f32_32x32x16_bf16(kf[2],q1_,C0,0,0,0),   P0[10],P0[11],P0[12],P0[13], pw1[0]=PKW(P0,8), pw1[1]=PKW(P0,10), pw1); \
    VRD(5); SBAR(); GAPA(C1=__builtin_amdgcn_mfma_f32_32x32x16_bf16(kf[3],q1_,C1,0,0,0),   P0[14],P0[15],P1[0],P1[1],   pw1[2]=PKW(P0,12),pw1[3]=PKW(P0,14), pw1); q1_=QLD(3); \
    VRD(2); SBAR(); GAPA(C0=__builtin_amdgcn_mfma_f32_32x32x16_bf16(kf[4],q0_,C0,0,0,0),   P1[2],P1[3],P1[4],P1[5],     pw2[0]=PKW(P1,0), pw2[1]=PKW(P1,2), pw2); \
    VRD(6); SBAR(); GAPA(C1=__builtin_amdgcn_mfma_f32_32x32x16_bf16(kf[5],q0_,C1,0,0,0),   P1[6],P1[7],P1[8],P1[9],     pw2[2]=PKW(P1,4), pw2[3]=PKW(P1,6), pw2); \
    VRD(3); SBAR(); GAPA(C0=__builtin_amdgcn_mfma_f32_32x32x16_bf16(kf[6],q1_,C0,0,0,0),   P1[10],P1[11],P1[12],P1[13], pw3[0]=PKW(P1,8), pw3[1]=PKW(P1,10), pw3); \
    VRD(7); SBAR(); GAPA(C1=__builtin_amdgcn_mfma_f32_32x32x16_bf16(kf[7],q1_,C1,0,0,0),   P1[14],P1[15],0.f,0.f,       pw3[2]=PKW(P1,12),pw3[3]=PKW(P1,14), pw3); \
    l_reg+=sacc; \
    if(GK){DMA_K((t)+3,sl_cur);} if(GV){DMA_V((t)+1,sl_next);} \
    CMASK(C0,C1,t); \
    { float a=MX3(C0[0],C0[1],C1[0]),b=MX3(C0[2],C0[3],C1[1]); a=MX3(a,C1[2],C1[3]); \
      _Pragma("unroll") for(int r=4;r<16;r+=4){a=MX3(a,C0[r],C0[r+1]);b=MX3(b,C0[r+2],C0[r+3]);a=MX3(a,C1[r],C1[r+1]);b=MX3(b,C1[r+2],C1[r+3]);} \
      float rm=__builtin_fmaxf(a,b); { auto rr=__builtin_amdgcn_permlane32_swap(__float_as_uint(rm),__float_as_uint(rm),false,false); rm=__builtin_fmaxf(__uint_as_float(rr[0]),__uint_as_float(rr[1])); } \
      resc=false; \
      if(__builtin_expect(__any(rm>(float)THRL),0)){ const float dl=__builtin_fmaxf(rm,0.f); mhat+=dl; \
        _Pragma("unroll") for(int r=0;r<16;++r){C0[r]-=dl;C1[r]-=dl;} \
        qx=make_qx(-mhat,hm); \
        const float f=__builtin_amdgcn_exp2f(-dl); l_reg*=f; if(hi==0)wsf[r32]=f; resc=true; } } \
    SBAR(); \
    GAPB(o[0]=__builtin_amdgcn_mfma_f32_32x32x16_bf16(PAF(0),VFR(0),o[0],0,0,0), C0,0); \
    GAPB(o[1]=__builtin_amdgcn_mfma_f32_32x32x16_bf16(PAF(0),VFR(4),o[1],0,0,0), C0,4); \
    KRD(GL,0); GAPB(o[0]=__builtin_amdgcn_mfma_f32_32x32x16_bf16(PAF(1),VFR(1),o[0],0,0,0), C0,8); \
    KRD(GL,1); GAPB(o[1]=__builtin_amdgcn_mfma_f32_32x32x16_bf16(PAF(1),VFR(5),o[1],0,0,0), C0,12); \
    KRD(GL,2); GAPB(o[0]=__builtin_amdgcn_mfma_f32_32x32x16_bf16(PAF(2),VFR(2),o[0],0,0,0), C1,0); \
    KRD(GL,3); GAPB(o[1]=__builtin_amdgcn_mfma_f32_32x32x16_bf16(PAF(2),VFR(6),o[1],0,0,0), C1,4); \
    GAPB(o[0]=__builtin_amdgcn_mfma_f32_32x32x16_bf16(PAF(3),VFR(3),o[0],0,0,0), C1,8); \
    GAPB(o[1]=__builtin_amdgcn_mfma_f32_32x32x16_bf16(PAF(3),VFR(7),o[1],0,0,0), C1,12); \
    }while(0)
  int t=1;
  #undef CMASK
  #define CMASK(P0,P1,t) do{}while(0)
  for(;t+5<NT;t+=2){
    STEP(pB0,pB1,pA0,pA1,t,true,true,true);     WAIT_BAR(2); RESC(); ROT();
    STEP(pA0,pA1,pB0,pB1,t+1,true,true,true);   WAIT_BAR(2); RESC(); ROT();
  }
  #undef CMASK
  #define CMASK(P0,P1,t) do{int jb_=(t)-(NT-4); if(jb_>=0)cmask(P0,P1,jb_,qrel,hi);}while(0)
  #define ENDW(tt) do{ if((tt)+3<NT){WAIT_BAR(2);} else if((tt)+2<NT){WAIT_BAR(1);} else {WAIT_BAR(0);} }while(0)
  for(;t+1<NT;t+=2){
    STEP(pB0,pB1,pA0,pA1,t,(t+3<NT),(t+1<NT),(t+1<NT));       ENDW(t);   RESC(); ROT();
    STEP(pA0,pA1,pB0,pB1,t+1,(t+4<NT),(t+2<NT),(t+2<NT));     ENDW(t+1); RESC(); ROT();
  }
  STEP(pB0,pB1,pA0,pA1,NT-1,false,false,false); RESC();
  { float sacc=pB0[0]+pB0[1]; _Pragma("unroll") for(int r=2;r<16;++r)sacc+=pB0[r]; _Pragma("unroll") for(int r=0;r<16;++r)sacc+=pB1[r]; l_reg+=sacc;
    pw0=(u32x4){PKW(pB0,0),PKW(pB0,2),PKW(pB0,4),PKW(pB0,6)};pw1=(u32x4){PKW(pB0,8),PKW(pB0,10),PKW(pB0,12),PKW(pB0,14)};pw2=(u32x4){PKW(pB1,0),PKW(pB1,2),PKW(pB1,4),PKW(pB1,6)};pw3=(u32x4){PKW(pB1,8),PKW(pB1,10),PKW(pB1,12),PKW(pB1,14)};
    SBAR(); pv(o,vb0+sl_cur,PAF(0),PAF(1),PAF(2),PAF(3)); }
  #undef PKW
  #undef PAF
  #undef VFR
  #undef PIN
  #undef MX3
  #undef GAPA
  #undef GAPB
  #undef EX
  #undef VRD
  #undef KRD
  #undef STEP
  #undef ENDW
  {auto rr=__builtin_amdgcn_permlane32_swap(__float_as_uint(l_reg),__float_as_uint(l_reg),false,false);l_reg=__uint_as_float(rr[0])+__uint_as_float(rr[1]);}
  { int te=tid; asm volatile("":"+v"(te));
    const int lane_e=te&63,r32e=lane_e&31,hie=lane_e>>5;
    if(hie==0)wsf[32+r32e]=l_reg;asm volatile("s_waitcnt lgkmcnt(0)":::"memory");
    float rli[16];
    #pragma unroll
    for(int r=0;r<16;++r)rli[r]=__builtin_amdgcn_rcpf(wsf[32+crow(r,hie)]);
    bf16*Ow=O+(rowbase+q0+wid*QBLK)*DM+h*D; const bf16*Gw=Gt+(rowbase+q0+wid*QBLK)*DM+h*D;
    bf16*stg=(bf16*)(shm+LDS_OST)+wid*2048;
    #pragma unroll
    for(int r=0;r<16;++r){const int orow=crow(r,hie);
      #pragma unroll
      for(int d0=0;d0<2;++d0)stg[orow*64+d0*32+r32e]=__float2bfloat16(o[d0][r]*rli[r]);}
    asm volatile("s_waitcnt lgkmcnt(0)":::"memory");
    #pragma unroll
    for(int i=0;i<4;++i){const int row=i*8+(lane_e>>3),ch=lane_e&7; u32x4 v=*(const u32x4*)(stg+row*64+ch*8); const u32x4 gv=*(const u32x4*)(Gw+(long)row*DM+ch*8);
      #pragma unroll
      for(int e=0;e<4;++e){ const float g0=__uint_as_float(gv[e]<<16),g1=__uint_as_float(gv[e]&0xffff0000u),x0=__uint_as_float(v[e]<<16),x1=__uint_as_float(v[e]&0xffff0000u);
        v[e]=cvtpk_s(x0*__builtin_amdgcn_rcpf(1.f+__expf(-g0)),x1*__builtin_amdgcn_rcpf(1.f+__expf(-g1))); }
      ATTN_STORE16(Ow+(long)row*DM+ch*8,v);} }
  asm volatile("s_waitcnt lgkmcnt(0)\n\ts_barrier":::"memory");
  #undef DMA_K
  #undef QLD
  #undef DMA_V
  #undef CMASK
  #undef START
  #undef RESC
  #undef ROT
}
constexpr int ATTN_LDS_BYTES=LDS_BYTES;
struct AttnTensors { const bf16* Q; const bf16* K; const bf16* V; bf16* O; const bf16* G; const float* CUM; float THR; };
struct AttnUnit { int bh; int qb; };
struct StaticOrder {
  int vcu;
  __device__ __forceinline__ explicit StaticOrder(int grid,int block):vcu((block%8)*(grid/8)+block/8){}
  __device__ __forceinline__ bool next(int i,AttnUnit&u)const{ if(i>=4)return false; const int s=2*(vcu&1)+(i>>1); u.bh=vcu>>1; u.qb=(i&1)?7-s:s; return true; }
  __device__ __forceinline__ void a_ready(const AttnUnit&)const{}
  __device__ __forceinline__ void done(const AttnUnit&)const{}
};
template<class Sched,int THRL=8> __device__ __forceinline__ void attn_phase(char*lds,const AttnTensors&T,const Sched&S,int tid_in){
  AttnUnit u; int tid_=tid_in; asm volatile("":"+v"(tid_));
  if(S.next(0,u)){ float*csp=(float*)(lds+LDS_CS); float*wt=(float*)(lds+LDS_WS); int tp=tid_in; asm volatile("":"+v"(tp));
    const float*lf=T.CUM+((long)(u.bh/NHEAD)*SEQ+4*tp)*NHEAD+u.bh%NHEAD;
    const float a0=lf[0],a1=a0+lf[NHEAD],a2=a1+lf[2*NHEAD],a3=a2+lf[3*NHEAD];
    float sc=a3; const int ln=tp&63;
    #pragma unroll
    for(int o=1;o<64;o<<=1){ const float up=__builtin_bit_cast(float,__builtin_amdgcn_ds_bpermute((ln-o)<<2,__builtin_bit_cast(int,sc))); if(ln>=o)sc+=up; }
    if(ln==63)wt[tp>>6]=sc;
    __syncthreads();
    float base=sc-a3;
    #pragma unroll
    for(int w=0;w<NW-1;++w)if(w<(tp>>6))base+=wt[w];
    const float k2=-1.4426950408889634f;
    csp[4*tp]=k2*(base+a0);csp[4*tp+1]=k2*(base+a1);csp[4*tp+2]=k2*(base+a2);csp[4*tp+3]=k2*(base+a3);
    __syncthreads(); }
  for(int i=0;S.next(i,u);++i){ S.a_ready(u); attn_unit<THRL>(u.bh/NHEAD,u.bh%NHEAD,u.qb,T.Q,T.K,T.V,T.O,T.G,lds,tid_,T.THR); S.done(u); }
}
#undef SBAR
#undef WAIT_BAR
}
#define GAS __attribute__((address_space(1)))
#define LAS __attribute__((address_space(3)))
typedef unsigned short bf16;
typedef unsigned v4u __attribute__((ext_vector_type(4)));
typedef float f32x4 __attribute__((ext_vector_type(4)));
typedef short bf16x8 __attribute__((ext_vector_type(8)));
typedef GAS unsigned gu32;
typedef GAS unsigned long long gu64;
#define RLX_AGENT __ATOMIC_RELAXED, __HIP_MEMORY_SCOPE_AGENT
#define LDS_WAIT() asm volatile("s_waitcnt lgkmcnt(0)" ::: "memory")
#define VM_WAIT() asm volatile("s_waitcnt vmcnt(0)" ::: "memory")
__device__ __forceinline__ unsigned long long rt() { return __builtin_amdgcn_s_memrealtime(); }
__device__ __forceinline__ unsigned f2bf(float f) { unsigned u = __builtin_bit_cast(unsigned, f); return (u + 0x7fffu + ((u >> 16) & 1u)) >> 16; }
__device__ __forceinline__ unsigned pk2(float lo, float hi) { return f2bf(lo) | (f2bf(hi) << 16); }

#define XB_TMO      128
#define XB_XCNT(j)  (256  + 64 * (j))
#define XB_XSUB(j)  (1280 + 64 * (j))
#define XB_XGEN(j)  (2304 + 64 * (j))
#define XB_TOP      3328
#define XB_TOPGEN   3392
#define XCD_BAR_WORDS 3456
#define XB_SPIN_CAP (1u << 27)

__device__ __forceinline__ unsigned xb_ld(unsigned* p)              { return __hip_atomic_load(p, __ATOMIC_RELAXED, __HIP_MEMORY_SCOPE_AGENT); }
__device__ __forceinline__ unsigned xb_add(unsigned* p, unsigned v) { return __hip_atomic_fetch_add(p, v, __ATOMIC_RELAXED, __HIP_MEMORY_SCOPE_AGENT); }
__device__ __forceinline__ unsigned xb_xcc_id() { return (unsigned)__builtin_amdgcn_s_getreg((3 << 11) | 20) & 0xFu; }
#define XB_SPIN(cond, bar) do { unsigned _sp = 0; while (cond) { __builtin_amdgcn_s_sleep(1); \
    if ((++_sp & 255u) == 0u) { if (xb_ld(&(bar)[XB_TMO])) break; if (_sp > XB_SPIN_CAP) { atomicAdd(&(bar)[XB_TMO], 1u); break; } } } } while (0)

struct XcdBarrier {
    unsigned* bar; unsigned x;
    volatile LAS unsigned* st;
};

__device__ __forceinline__ XcdBarrier xcd_barrier_post(unsigned* bar, volatile LAS unsigned* st) {
    XcdBarrier b; b.bar = bar; b.x = xb_xcc_id(); b.st = st;
    if (threadIdx.x == 0) (void)xb_add(&bar[XB_XCNT(b.x)], 1u);
    return b;
}
__device__ __forceinline__ void xcd_barrier_complete(unsigned* bar, unsigned x, unsigned& nloc, unsigned& nx) {
    const unsigned G = gridDim.x * gridDim.y * gridDim.z;
    unsigned sum, cnt, mine, sp = 0u;
    for (;;) {
        sum = 0u; cnt = 0u; mine = 0u;
#pragma unroll
        for (unsigned j = 0; j < 16; ++j) { const unsigned c = xb_ld(&bar[XB_XCNT(j)]); sum += c; cnt += (c > 0u) ? 1u : 0u; mine = (j == x) ? c : mine; }
        if (sum == G) break;
        __builtin_amdgcn_s_sleep(1);
        if ((++sp & 255u) == 0u) { if (xb_ld(&bar[XB_TMO])) break; if (sp > XB_SPIN_CAP) { atomicAdd(&bar[XB_TMO], 1u); break; } }
    }
    nloc = mine > 0u ? mine : 1u; nx = cnt > 0u ? cnt : 1u;
}

__device__ __forceinline__ void xcd_barrier(const XcdBarrier& b, const bool leader  ) {
    asm volatile("s_waitcnt vmcnt(0)" ::: "memory");
    __syncthreads();
    if (leader) {
        unsigned* bar = b.bar;
        __builtin_amdgcn_s_waitcnt(0);
        unsigned nloc = b.st[0], nx = b.st[1];
        if (nloc == 0u) { xcd_barrier_complete(bar, b.x, nloc, nx); b.st[0] = nloc; b.st[1] = nx; }
        const unsigned old = xb_add(&bar[XB_XSUB(b.x)], 1u);
        const unsigned gen = old / nloc;
        if (old + 1u == (gen + 1u) * nloc) {
            __builtin_amdgcn_fence(__ATOMIC_RELEASE, "agent");
            asm volatile("s_waitcnt vmcnt(0)" ::: "memory");
            const unsigned og = xb_add(&bar[XB_TOP], 1u);
            const unsigned tg = og / nx;
            if (og + 1u == (tg + 1u) * nx) xb_add(&bar[XB_TOPGEN], 1u);
            else XB_SPIN(xb_ld(&bar[XB_TOPGEN]) == tg, bar);
            __builtin_amdgcn_fence(__ATOMIC_ACQUIRE, "agent");
            xb_add(&bar[XB_XGEN(b.x)], 1u);
            asm volatile("s_waitcnt vmcnt(0)" ::: "memory");
        } else {
            XB_SPIN(xb_ld(&bar[XB_XGEN(b.x)]) == gen, bar);
            __builtin_amdgcn_fence(__ATOMIC_ACQUIRE, "agent");
            asm volatile("s_waitcnt vmcnt(0)" ::: "memory");
        }
    }
    __syncthreads();
}
#ifndef MK_FASTATTN
#define MK_FASTATTN 1
#endif
#ifndef MK_FASTREC
#define MK_FASTREC 1
#endif
namespace cg = cooperative_groups;
constexpr int NTOK = 16384, DMODEL = 1024, NBATCH = 8, SEQLEN = 2048, DEPTH = 4;
constexpr int FOX_IN = 4112, GLA_IN = 3088, HGRN_IN = 4096;
constexpr float RMS_EPS = 1e-6f;
constexpr float LOG2E = 1.4426950408889634f;
constexpr float FOX_C2 = 0.125f * LOG2E;
constexpr int NWAVES = 8;

constexpr size_t MiB = 1u << 20;
constexpr size_t WS_CTL = 0, CTL_ZERO_BYTES = 1 * MiB;
constexpr size_t WS_FOXWIN = 2 * MiB, WS_FOXWOUT = 18 * MiB, WS_GLAWIN = 22 * MiB, WS_GLAWOUT = 28 * MiB, WS_HGRNWIN = 30 * MiB, WS_HGRNWOUT = 38 * MiB;
constexpr size_t WS_PEERWQ = 40 * MiB, WS_KEYS = 56 * MiB, WS_LB = 58 * MiB;
#ifndef BGQ
#define BGQ 1
#endif
#ifndef I8MASK
#define I8MASK 13
#endif
constexpr size_t WS_SW = 58 * MiB + 65536, WS_SX = 58 * MiB + 262144, WS_XN8 = 724 * MiB;
constexpr size_t WS_TAILW = 63 * MiB;
constexpr size_t WS_RS = 62 * MiB;
constexpr size_t WS_U = 64 * MiB, WS_V = 128 * MiB, WS_SU = 60 * MiB, WS_SV = 61 * MiB;
constexpr size_t WS_XN = 320 * MiB, WS_P = 352 * MiB, WS_OB = 480 * MiB, WS_Q2 = 512 * MiB, WS_TAIL = 576 * MiB, WS_CUM = 577 * MiB;
constexpr size_t WS_EXP = 580 * MiB, WS_GATE = 588 * MiB, WS_OF = 596 * MiB, WS_GLOG = 660 * MiB, WS_HB = 740 * MiB, WS_END = 772 * MiB;
constexpr size_t PSTRIDE = (size_t)NTOK * 1024;
constexpr int CW_BAR = 4096;

constexpr int RING_BYTES = 131072;
constexpr int LDSCTL_OFF = RING_BYTES, MISC_OFF = LDSCTL_OFF + 320;
constexpr int LDS_BYTES = 147456;

typedef unsigned u32x4v __attribute__((ext_vector_type(4)));
struct Ctx {
    LAS unsigned char* lds; int tid, lane, wave, vcu, G, gw, NGW, bx;
    const float* in[21]; float* out; unsigned char* ws;
};

__device__ __forceinline__ float bf2f(unsigned short b) { return __uint_as_float(((unsigned)b) << 16); }
__device__ __forceinline__ float bflo(unsigned w) { return __uint_as_float(w << 16); }
__device__ __forceinline__ float bfhi(unsigned w) { return __uint_as_float(w & 0xffff0000u); }
#define DPP_ADD(v, ctrl, rm, bm) (v + __builtin_bit_cast(float, __builtin_amdgcn_update_dpp(0, __builtin_bit_cast(int, v), ctrl, rm, bm, false)))
#define DPP_MAX(v, ctrl, rm, bm) fmaxf(v, __builtin_bit_cast(float, __builtin_amdgcn_update_dpp(__builtin_bit_cast(int, v), __builtin_bit_cast(int, v), ctrl, rm, bm, false)))
#define DPP_SUM31(v) do { v = DPP_ADD(v, 0x111, 0xf, 0xf); v = DPP_ADD(v, 0x112, 0xf, 0xf); v = DPP_ADD(v, 0x114, 0xf, 0xe); v = DPP_ADD(v, 0x118, 0xf, 0xc); v = DPP_ADD(v, 0x142, 0xa, 0xf); } while (0)
#define DPP_SUM63(v) do { DPP_SUM31(v); v = DPP_ADD(v, 0x143, 0xc, 0xf); } while (0)
__device__ __forceinline__ float rdlane(float v, int lane) { return __builtin_bit_cast(float, __builtin_amdgcn_readlane(__builtin_bit_cast(int, v), lane)); }
__device__ __forceinline__ float wave_sum(float v) { DPP_SUM63(v); return rdlane(v, 63); }
__device__ __forceinline__ float wave_max(float v) {
    v = DPP_MAX(v, 0x111, 0xf, 0xf); v = DPP_MAX(v, 0x112, 0xf, 0xf); v = DPP_MAX(v, 0x114, 0xf, 0xe); v = DPP_MAX(v, 0x118, 0xf, 0xc); v = DPP_MAX(v, 0x142, 0xa, 0xf); v = DPP_MAX(v, 0x143, 0xc, 0xf);
    return rdlane(v, 63);
}
typedef __bf16 bf16x2_t __attribute__((ext_vector_type(2)));
__device__ __forceinline__ float dot2bf(unsigned w, unsigned x, float acc) { return __builtin_amdgcn_fdot2_f32_bf16(__builtin_bit_cast(bf16x2_t, w), __builtin_bit_cast(bf16x2_t, x), acc, false); }
__device__ __forceinline__ float bperm(float v, int src_lane) { return __builtin_bit_cast(float, __builtin_amdgcn_ds_bpermute(src_lane << 2, __builtin_bit_cast(int, v))); }
__device__ __forceinline__ float log_sigmoid_f(float x) { return fminf(x, 0.f) - log1pf(__expf(-fabsf(x))); }
__device__ __forceinline__ float sigmoid_f(float x) { return 1.f / (1.f + __expf(-x)); }

__device__ __forceinline__ void p0_transpose_item(const float* W, int ldw, int K, int Nuse, bf16* WT, LAS float* scr, int item, int lane) {
    const int nblk = Nuse / 32, kb = item / nblk, nb = item % nblk, k0 = 64 * kb, n0 = 32 * nb;
#pragma unroll
    for (int i = 0; i < 8; ++i) { const int kk = 8 * i + (lane >> 3); const f32x4 v = *(const GAS f32x4*)(W + (size_t)(k0 + kk) * ldw + n0 + 4 * (lane & 7));
        LAS float* d = scr + kk * 33 + 4 * (lane & 7); d[0] = v.x; d[1] = v.y; d[2] = v.z; d[3] = v.w; }
    LDS_WAIT(); asm volatile("" ::: "memory");
    const int c = lane & 7;
#pragma unroll
    for (int j = 0; j < 4; ++j) { const int n = (lane >> 3) + 8 * j; const LAS float* s = scr + (8 * c) * 33 + n;
        v4u o; o.x = pk2(s[0 * 33], s[1 * 33]); o.y = pk2(s[2 * 33], s[3 * 33]); o.z = pk2(s[4 * 33], s[5 * 33]); o.w = pk2(s[6 * 33], s[7 * 33]);
        *(GAS v4u*)(WT + (size_t)(n0 + n) * K + k0 + 8 * c) = o; }
    LDS_WAIT(); asm volatile("" ::: "memory");
}
__device__ __forceinline__ unsigned q8x4(float a, float b, float c, float d) {
    return ((unsigned)(int)__builtin_rintf(a) & 0xffu) | (((unsigned)(int)__builtin_rintf(b) & 0xffu) << 8) | (((unsigned)(int)__builtin_rintf(c) & 0xffu) << 16) | ((unsigned)(int)__builtin_rintf(d) << 24);
}
__device__ __forceinline__ void p0_colmax_item(const float* W, int ldw, unsigned* cmax, int item, int lane) {
    const int nb = item >> 3, n0 = 32 * nb, k0 = 128 * (item & 7);
    f32x4 v[16];
#pragma unroll
    for (int i = 0; i < 16; ++i) v[i] = *(const GAS f32x4*)(W + (size_t)(k0 + 8 * i + (lane >> 3)) * ldw + n0 + 4 * (lane & 7));
    __builtin_amdgcn_sched_barrier(0);
    float mx[4] = {0.f, 0.f, 0.f, 0.f};
#pragma unroll
    for (int i = 0; i < 16; ++i) { mx[0] = fmaxf(mx[0], fabsf(v[i].x)); mx[1] = fmaxf(mx[1], fabsf(v[i].y)); mx[2] = fmaxf(mx[2], fabsf(v[i].z)); mx[3] = fmaxf(mx[3], fabsf(v[i].w)); }
#pragma unroll
    for (int j = 0; j < 4; ++j) { mx[j] = fmaxf(mx[j], bperm(mx[j], lane ^ 8)); mx[j] = fmaxf(mx[j], bperm(mx[j], lane ^ 16)); mx[j] = fmaxf(mx[j], bperm(mx[j], lane ^ 32)); }
    if (lane < 8) {
#pragma unroll
        for (int j = 0; j < 4; ++j) (void)__hip_atomic_fetch_max(cmax + n0 + 4 * lane + j, __float_as_uint(mx[j]), __ATOMIC_RELAXED, __HIP_MEMORY_SCOPE_AGENT);
    }
}
__device__ __forceinline__ void p0_quant_item(const float* W, int ldw, const unsigned* cmax, signed char* W8, float* sw, LAS float* scr, int item, int lane) {
    const int nb = item >> 3, n0 = 32 * nb, k0 = 128 * (item & 7);
    f32x4 v[2][8];
#pragma unroll
    for (int h = 0; h < 2; ++h)
#pragma unroll
        for (int i = 0; i < 8; ++i) v[h][i] = *(const GAS f32x4*)(W + (size_t)(k0 + 64 * h + 8 * i + (lane >> 3)) * ldw + n0 + 4 * (lane & 7));
    float ci[4];
#pragma unroll
    for (int j = 0; j < 4; ++j) { const float m = __uint_as_float(*(const GAS unsigned*)(cmax + n0 + (lane >> 3) + 8 * j)); ci[j] = m > 0.f ? 127.f / m : 0.f; }
    if ((item & 7) == 0 && lane < 32) *(GAS float*)(sw + n0 + lane) = __uint_as_float(*(const GAS unsigned*)(cmax + n0 + lane)) * (1.f / 127.f);
    __builtin_amdgcn_sched_barrier(0);
    const int c = lane & 7;
#pragma unroll
    for (int h = 0; h < 2; ++h) {
        LDS_WAIT(); asm volatile("" ::: "memory");
#pragma unroll
        for (int i = 0; i < 8; ++i) { LAS float* d = scr + (8 * i + (lane >> 3)) * 33 + 4 * (lane & 7); d[0] = v[h][i].x; d[1] = v[h][i].y; d[2] = v[h][i].z; d[3] = v[h][i].w; }
        LDS_WAIT(); asm volatile("" ::: "memory");
#pragma unroll
        for (int j = 0; j < 4; ++j) { const int n = (lane >> 3) + 8 * j; const LAS float* sp = scr + (8 * c) * 33 + n;
            const unsigned lo = q8x4(sp[0] * ci[j], sp[33] * ci[j], sp[66] * ci[j], sp[99] * ci[j]), hi = q8x4(sp[132] * ci[j], sp[165] * ci[j], sp[198] * ci[j], sp[231] * ci[j]);
            *(GAS unsigned long long*)(W8 + (size_t)(n0 + n) * 1024 + k0 + 64 * h + 8 * c) = (unsigned long long)lo | ((unsigned long long)hi << 32); }
    }
    LDS_WAIT(); asm volatile("" ::: "memory");
}
__device__ __forceinline__ void rms_row_to_bf16(int lane, f32x4 (&v)[4], const float* gain, bf16* orow, signed char* orow8, float* sx) {
    const GAS f32x4* gr = (const GAS f32x4*)gain + lane;
    float s = 0.f;
#pragma unroll
    for (int j = 0; j < 4; ++j) s += (v[j].x * v[j].x + v[j].y * v[j].y) + (v[j].z * v[j].z + v[j].w * v[j].w);
    const float r = rsqrtf(wave_sum(s) * (1.f / 1024.f) + RMS_EPS);
    GAS unsigned long long* o8 = (GAS unsigned long long*)orow + lane; float am = 0.f;
#pragma unroll
    for (int j = 0; j < 4; ++j) { const f32x4 g = gr[64 * j]; v[j].x *= r * g.x; v[j].y *= r * g.y; v[j].z *= r * g.z; v[j].w *= r * g.w;
        am = fmaxf(fmaxf(am, fmaxf(fabsf(v[j].x), fabsf(v[j].y))), fmaxf(fabsf(v[j].z), fabsf(v[j].w)));
        o8[64 * j] = (unsigned long long)pk2(v[j].x, v[j].y) | ((unsigned long long)pk2(v[j].z, v[j].w) << 32); }
    am = wave_max(am); const float qi = am > 0.f ? 127.f / am : 0.f;
    GAS unsigned* q8 = (GAS unsigned*)orow8 + lane;
#pragma unroll
    for (int j = 0; j < 4; ++j) q8[64 * j] = q8x4(v[j].x * qi, v[j].y * qi, v[j].z * qi, v[j].w * qi);
    if (lane == 0) *(GAS float*)sx = am * (1.f / 127.f);
}
__device__ __forceinline__ void cvt_f32_bf16(const Ctx& C, const float* src, bf16* dst, size_t n) {
    const size_t nth = (size_t)C.G * 512, t0 = (size_t)C.vcu * 512 + C.tid;
    for (size_t i = t0; i < n / 8; i += nth) {
        const f32x4 a = ((const GAS f32x4*)src)[2 * i], b = ((const GAS f32x4*)src)[2 * i + 1];
        v4u o; o.x = pk2(a.x, a.y); o.y = pk2(a.z, a.w); o.z = pk2(b.x, b.y); o.w = pk2(b.z, b.w);
        ((GAS v4u*)dst)[i] = o;
    }
}
__device__ __forceinline__ void quant_row_fp8(int lane, const f32x4 (&v)[4], unsigned char* drow, float* sc) {
    float am = 0.f;
#pragma unroll
    for (int i = 0; i < 4; ++i) am = fmaxf(am, fmaxf(fmaxf(fabsf(v[i].x), fabsf(v[i].y)), fmaxf(fabsf(v[i].z), fabsf(v[i].w))));
    am = wave_max(am);
    const float inv = am > 0.f ? 448.f / am : 0.f;
    GAS unsigned* o = (GAS unsigned*)drow + lane;
#pragma unroll
    for (int i = 0; i < 4; ++i) {
        const float a = fminf(fmaxf(v[i].x * inv, -448.f), 448.f), b = fminf(fmaxf(v[i].y * inv, -448.f), 448.f), c = fminf(fmaxf(v[i].z * inv, -448.f), 448.f), d = fminf(fmaxf(v[i].w * inv, -448.f), 448.f);
        int w = 0; w = __builtin_amdgcn_cvt_pk_fp8_f32(a, b, w, false); w = __builtin_amdgcn_cvt_pk_fp8_f32(c, d, w, true); o[64 * i] = (unsigned)w;
    }
    if (lane == 0) *(GAS float*)sc = am * (1.f / 448.f);
}
__device__ __forceinline__ void quant_rows_fp8(const Ctx& C, const float* src, unsigned char* dst, float* scales, int nrows) {
    int rw = C.gw;
    for (; rw + 3 * C.NGW < nrows; rw += 4 * C.NGW) {
        f32x4 v[4][4];
#pragma unroll
        for (int j = 0; j < 4; ++j) { const GAS f32x4* xr = (const GAS f32x4*)(src + (size_t)(rw + j * C.NGW) * 1024) + C.lane;
#pragma unroll
            for (int i = 0; i < 4; ++i) v[j][i] = xr[64 * i]; }
        __builtin_amdgcn_sched_barrier(0);
#pragma unroll
        for (int j = 0; j < 4; ++j) quant_row_fp8(C.lane, v[j], dst + (size_t)(rw + j * C.NGW) * 1024, scales + rw + j * C.NGW);
    }
    for (; rw < nrows; rw += C.NGW) {
        const GAS f32x4* xr = (const GAS f32x4*)(src + (size_t)rw * 1024) + C.lane;
        f32x4 v[4];
#pragma unroll
        for (int i = 0; i < 4; ++i) v[i] = xr[64 * i];
        quant_row_fp8(C.lane, v, dst + (size_t)rw * 1024, scales + rw);
    }
}
constexpr int BGQ_ROWS = 3 * 16384;
template <int JOB> __device__ __forceinline__ void bgq_row(const Ctx& C, int idx, const float*& src, unsigned char*& dst, float*& sc) {
    const int seg = idx >> 14, row = idx & 16383;
    const bool isV = seg == 1 || (seg == 2 && JOB == 2);
    const size_t flat = (size_t)(seg < 2 ? JOB : 3) * 16384 + row;
    src = (isV ? C.in[20] : C.in[19]) + flat * 1024; dst = C.ws + (isV ? WS_V : WS_U) + flat * 1024; sc = (float*)(C.ws + (isV ? WS_SV : WS_SU)) + flat;
}
template <int JOB> __device__ __forceinline__ void bgq_step(const Ctx& C, int idx_prev, int idx, f32x4 (&v)[4]) {
    const float* src; unsigned char* dst; float* sc;
    if (idx_prev >= 0 && idx_prev < BGQ_ROWS) { bgq_row<JOB>(C, idx_prev, src, dst, sc); quant_row_fp8(C.lane, v, dst, sc); }
    if (idx < BGQ_ROWS) { bgq_row<JOB>(C, idx, src, dst, sc); const GAS f32x4* xr = (const GAS f32x4*)src + C.lane;
#pragma unroll
        for (int i = 0; i < 4; ++i) v[i] = xr[64 * i]; }
}
#ifndef PRO_PROBE
#define PRO_PROBE 0
#endif
constexpr int CW_CMAX = 131072;
constexpr int I8_NF0 = (I8MASK & 1) ? 1024 : 0, I8_NF3 = (I8MASK & 8) ? 1024 : 0, I8_NG = (I8MASK & 2) ? 768 : 0, I8_NH = (I8MASK & 4) ? 1024 : 0, I8_NITEMS = I8_NF0 + I8_NF3 + I8_NG + I8_NH;
template <bool PASS2> __device__ __forceinline__ void p0_i8_items(const Ctx& C, LAS float* scr) {
    unsigned* CM = (unsigned*)(C.ws + WS_CTL) + CW_CMAX; float* SW = (float*)(C.ws + WS_SW);
    for (int it = C.gw; it < I8_NITEMS; it += C.NGW) {
        int r = it; const float* W; int ldw; signed char* W8; int q;
        if (r < I8_NF0) { W = C.in[3]; ldw = FOX_IN; W8 = (signed char*)(C.ws + WS_FOXWIN); q = 0; }
        else if ((r -= I8_NF0) < I8_NF3) { W = C.in[3] + (size_t)1024 * FOX_IN; ldw = FOX_IN; W8 = (signed char*)(C.ws + WS_FOXWIN + 8 * MiB); q = 1; }
        else if ((r -= I8_NF3) < I8_NG) { W = C.in[8]; ldw = GLA_IN; W8 = (signed char*)(C.ws + WS_GLAWIN); q = 2; }
        else { r -= I8_NG; W = C.in[13]; ldw = HGRN_IN; W8 = (signed char*)(C.ws + WS_HGRNWIN); q = 3; }
        const int swo = q == 0 ? 0 : q == 1 ? 4096 : q == 2 ? 8192 : 11264;
        if (PASS2) p0_quant_item(W, ldw, CM + q * 4096, W8, SW + swo, scr, r, C.lane); else p0_colmax_item(W, ldw, CM + q * 4096, r, C.lane);
    }
}
__device__ __forceinline__ void p0_prologue_b(const Ctx& C) { p0_i8_items<true>(C, (LAS float*)(C.lds + C.wave * 16384)); }
__device__ __forceinline__ void p0_prologue(const Ctx& C) {
    LAS float* scr = (LAS float*)(C.lds + C.wave * 16384);
    for (int rep_ = 0; rep_ < (PRO_PROBE == 1 ? 2 : 1); ++rep_) {
    p0_i8_items<false>(C, scr);
    constexpr int I_SQ = 16 * 32, N_F0 = (I8MASK & 1) ? 0 : 16 * 128, N_F3 = (I8MASK & 8) ? 0 : 16 * 128, N_G = (I8MASK & 2) ? 0 : 16 * 96, N_H = (I8MASK & 4) ? 0 : 16 * 128;
    constexpr int NITEMS = N_F0 + N_F3 + N_G + N_H + 2 * I_SQ + I_SQ + I_SQ;
    for (int it = C.gw; it < NITEMS; it += C.NGW) {
        int r = it;
        if (r < N_F0) { p0_transpose_item(C.in[3], FOX_IN, 1024, 4096, (bf16*)(C.ws + WS_FOXWIN), scr, r, C.lane); continue; } r -= N_F0;
        if (r < N_F3) { p0_transpose_item(C.in[3] + (size_t)1024 * FOX_IN, FOX_IN, 1024, 4096, (bf16*)(C.ws + WS_FOXWIN + 8 * MiB), scr, r, C.lane); continue; } r -= N_F3;
        if (r < N_G) { p0_transpose_item(C.in[8], GLA_IN, 1024, 3072, (bf16*)(C.ws + WS_GLAWIN), scr, r, C.lane); continue; } r -= N_G;
        if (r < N_H) { p0_transpose_item(C.in[13], HGRN_IN, 1024, 4096, (bf16*)(C.ws + WS_HGRNWIN), scr, r, C.lane); continue; } r -= N_H;
        if (r < 2 * I_SQ) { const int j = r / I_SQ; p0_transpose_item(C.in[7] + (size_t)j * 1024 * 1024, 1024, 1024, 1024, (bf16*)(C.ws + WS_FOXWOUT) + (size_t)j * 1024 * 1024, scr, r % I_SQ, C.lane); continue; } r -= 2 * I_SQ;
        if (r < I_SQ) { p0_transpose_item(C.in[12], 1024, 1024, 1024, (bf16*)(C.ws + WS_GLAWOUT), scr, r, C.lane); continue; } r -= I_SQ;
        p0_transpose_item(C.in[16], 1024, 1024, 1024, (bf16*)(C.ws + WS_HGRNWOUT), scr, r, C.lane);
    }
    }
    for (int rep_ = 0; rep_ < (PRO_PROBE == 2 ? 2 : 1); ++rep_) {
    constexpr int MT_GROUPS = 4 * 16 * 4 * 32;
    for (int grp = C.gw; grp < MT_GROUPS; grp += C.NGW) {
        const int nb2 = grp & 31, kb2 = (grp >> 5) & 3, hp = (grp >> 7) & 15, layer = grp >> 11;
        const float* kp = C.in[18] + ((size_t)(layer * 16 + hp) * 128 + kb2 * 32 + (C.lane & 15)) * 128 + 4 * (C.lane >> 4);
        const float* wp = C.in[17] + ((size_t)layer * 1024 + nb2 * 32 + (C.lane & 15)) * 2048 + hp * 128 + 4 * (C.lane >> 4);
        f32x4 ka[2][8], wb[2][8];
#pragma unroll
        for (int u = 0; u < 2; ++u)
#pragma unroll
            for (int s8 = 0; s8 < 8; ++s8) { ka[u][s8] = *(const GAS f32x4*)(kp + (size_t)u * 16 * 128 + 16 * s8); wb[u][s8] = *(const GAS f32x4*)(wp + (size_t)u * 16 * 2048 + 16 * s8); }
        __builtin_amdgcn_sched_barrier(0);
        f32x4 acc[2][2];
#pragma unroll
        for (int a = 0; a < 2; ++a)
#pragma unroll
            for (int b = 0; b < 2; ++b) acc[a][b] = (f32x4){0.f, 0.f, 0.f, 0.f};
#pragma unroll
        for (int s8 = 0; s8 < 8; ++s8)
#pragma unroll
            for (int a = 0; a < 2; ++a)
#pragma unroll
                for (int b = 0; b < 2; ++b) { const f32x4 x = ka[a][s8], y = wb[b][s8];
                    acc[a][b] = __builtin_amdgcn_mfma_f32_16x16x4f32(x.x, y.x, acc[a][b], 0, 0, 0); acc[a][b] = __builtin_amdgcn_mfma_f32_16x16x4f32(x.y, y.y, acc[a][b], 0, 0, 0);
                    acc[a][b] = __builtin_amdgcn_mfma_f32_16x16x4f32(x.z, y.z, acc[a][b], 0, 0, 0); acc[a][b] = __builtin_amdgcn_mfma_f32_16x16x4f32(x.w, y.w, acc[a][b], 0, 0, 0); }
#pragma unroll
        for (int a = 0; a < 2; ++a)
#pragma unroll
            for (int b = 0; b < 2; ++b) {
                bf16* mt = (bf16*)(C.ws + WS_PEERWQ) + ((size_t)layer * 2048 + hp * 128 + kb2 * 32 + a * 16 + (C.lane >> 4) * 4) * 1024 + nb2 * 32 + b * 16 + (C.lane & 15);
#pragma unroll
                for (int r = 0; r < 4; ++r) mt[(size_t)r * 1024] = (bf16)f2bf(acc[a][b][r]); }
    }
    }
    for (int rep_ = 0; rep_ < (PRO_PROBE == 3 ? 2 : 1); ++rep_) {
    quant_rows_fp8(C, C.in[19], C.ws + WS_U, (float*)(C.ws + WS_SU), BGQ ? 16384 : 4 * 16384);
    quant_rows_fp8(C, C.in[20], C.ws + WS_V, (float*)(C.ws + WS_SV), BGQ ? 16384 : 4 * 16384);
    }
    for (int rep_ = 0; rep_ < (PRO_PROBE == 4 ? 2 : 1); ++rep_) {
    for (int i = C.vcu * 512 + C.tid; i < 3 * 16 * 1024; i += C.G * 512) {
        const int w = i >> 14, n = (i >> 10) & 15, k = i & 1023;
        const float v = w < 2 ? C.in[3][(size_t)w * 1024 * FOX_IN + (size_t)k * FOX_IN + 4096 + n] : C.in[8][(size_t)k * GLA_IN + 3072 + n];
        ((bf16*)(C.ws + WS_TAILW))[i] = (bf16)f2bf(v);
    }
    if (C.vcu == 0) for (int c = C.tid; c < 1024; c += 512) {
        const float l0 = C.in[14][c], l1 = C.in[14][1024 + c], l2 = C.in[14][2048 + c], l3 = C.in[14][3072 + c];
        const float m = fmaxf(fmaxf(l0, l1), fmaxf(l2, l3));
        const float e0 = expf(l0 - m), e1 = expf(l1 - m), e2 = expf(l2 - m), e3 = expf(l3 - m);
        ((float*)(C.ws + WS_LB))[c] = (e1 + e2) / (e0 + e1 + e2 + e3);
    }
    for (int m0 = C.gw; m0 < NTOK; m0 += 4 * C.NGW) {
        f32x4 v[4][4];
#pragma unroll
        for (int u = 0; u < 4; ++u) { const int m = m0 + u * C.NGW; if (m < NTOK) { const GAS f32x4* xr = (const GAS f32x4*)(C.in[0] + (size_t)m * 1024) + C.lane;
#pragma unroll
            for (int j = 0; j < 4; ++j) v[u][j] = xr[64 * j]; } }
        __builtin_amdgcn_sched_barrier(0);
#pragma unroll
        for (int u = 0; u < 4; ++u) { const int m = m0 + u * C.NGW; if (m < NTOK)
            rms_row_to_bf16(C.lane, v[u], C.in[1], (bf16*)(C.ws + WS_XN) + (size_t)m * 1024, (signed char*)(C.ws + WS_XN8) + (size_t)m * 1024, (float*)(C.ws + WS_SX) + m); }
    }
    }
}

__device__ __forceinline__ void tail_mfma(const Ctx& C, int tok0, const bf16* WT, LAS float* part) {
    const int l = C.lane, m = l & 15, g = l >> 4, tbk = C.wave & 3, kh = C.wave >> 2;
    const bf16* ap = (const bf16*)(C.ws + WS_XN) + (size_t)(tok0 + 16 * tbk + m) * 1024 + kh * 512 + 8 * g;
    const bf16* bp = WT + (size_t)m * 1024 + kh * 512 + 8 * g;
    f32x4 acc = (f32x4){0.f, 0.f, 0.f, 0.f};
#pragma unroll 4
    for (int ks = 0; ks < 16; ++ks) acc = __builtin_amdgcn_mfma_f32_16x16x32_bf16(*(const bf16x8*)(ap + 32 * ks), *(const bf16x8*)(bp + 32 * ks), acc, 0, 0, 0);
#pragma unroll
    for (int r = 0; r < 4; ++r) part[kh * 1024 + (16 * tbk + 4 * g + r) * 16 + m] = acc[r];
}
__device__ __forceinline__ void fox_step1(const Ctx& C, int j) {
    float* TAIL = (float*)(C.ws + WS_TAIL); LAS float* part = (LAS float*)C.lds;
    const bf16* WT = (const bf16*)(C.ws + WS_TAILW) + (size_t)j * 16 * 1024;
    for (int tb = C.vcu; tb < NTOK / 64; tb += C.G) {
        __syncthreads();
        tail_mfma(C, tb * 64, WT, part);
        __syncthreads();
#pragma unroll
        for (int rep = 0; rep < 2; ++rep) { const int i = rep * 512 + C.tid; TAIL[(size_t)tb * 1024 + i] = log_sigmoid_f(part[i] + part[1024 + i] + C.in[4][j * 16 + (i & 15)]); }
        const float* gq = C.in[5] + j * 64; const float* gk = C.in[6] + j * 64;
        v4u ra[2][8], rb[2][8];
#pragma unroll
        for (int which = 0; which < 2; ++which)
#pragma unroll
            for (int t = 0; t < 8; ++t) { const bf16* row = (const bf16*)(C.ws + WS_P) + (size_t)which * PSTRIDE + (size_t)(tb * 64 + C.wave * 8 + t) * 1024 + C.lane * 16;
                ra[which][t] = *(const GAS v4u*)row; rb[which][t] = *(const GAS v4u*)(row + 8); }
        __builtin_amdgcn_sched_barrier(0);
#pragma unroll
        for (int which = 0; which < 2; ++which) {
            const float* g = (which == 0 ? gq : gk) + (C.lane & 3) * 16;
            float gv[16];
#pragma unroll
            for (int i = 0; i < 16; ++i) gv[i] = g[i];
#pragma unroll
            for (int t = 0; t < 8; ++t) {
                bf16* row = (bf16*)(C.ws + WS_P) + (size_t)which * PSTRIDE + (size_t)(tb * 64 + C.wave * 8 + t) * 1024 + C.lane * 16;
                const v4u a = ra[which][t], b = rb[which][t];
                float v[16] = {bflo(a.x), bfhi(a.x), bflo(a.y), bfhi(a.y), bflo(a.z), bfhi(a.z), bflo(a.w), bfhi(a.w), bflo(b.x), bfhi(b.x), bflo(b.y), bfhi(b.y), bflo(b.z), bfhi(b.z), bflo(b.w), bfhi(b.w)};
                float ss = 0.f;
#pragma unroll
                for (int i = 0; i < 16; ++i) ss += v[i] * v[i];
                ss = DPP_ADD(ss, 0xB1, 0xf, 0xf); ss = DPP_ADD(ss, 0x4E, 0xf, 0xf);
                const float r = rsqrtf(ss * (1.f / 64.f) + RMS_EPS) * (which == 0 ? FOX_C2 : 1.f);
#pragma unroll
                for (int i = 0; i < 16; ++i) v[i] = v[i] * r * gv[i];
                v4u oa, ob; oa.x = pk2(v[0], v[1]); oa.y = pk2(v[2], v[3]); oa.z = pk2(v[4], v[5]); oa.w = pk2(v[6], v[7]);
                ob.x = pk2(v[8], v[9]); ob.y = pk2(v[10], v[11]); ob.z = pk2(v[12], v[13]); ob.w = pk2(v[14], v[15]);
                *(GAS v4u*)row = oa; *(GAS v4u*)(row + 8) = ob;
            }
        }
    }
}
constexpr size_t WS_ASC = WS_Q2, WS_Q1 = WS_Q2 + 16 * MiB, WS_KST = WS_Q2 + 48 * MiB, WS_DEC = 59 * MiB;
static_assert(WS_KST + 32 * MiB <= WS_OF && WS_Q1 + 32 * MiB <= WS_KST, "chunk workspace map");
template <int NH>
__device__ __forceinline__ void chunk_prepass(const Ctx& C) {
    bf16* ASC = (bf16*)(C.ws + WS_ASC); bf16* Q1 = (bf16*)(C.ws + WS_Q1); bf16* KST = (bf16*)(C.ws + WS_KST); float* DEC = (float*)(C.ws + WS_DEC);
    const bf16* P0 = (const bf16*)(C.ws + WS_P); const bf16* P1 = P0 + PSTRIDE;
    LAS bf16* tqs = (LAS bf16*)C.lds;
    LAS bf16* tks = tqs + 64 * 128;
    LAS bf16* q2s = tks + 64 * 128;
    LAS bf16* k2s = q2s + 64 * 136;
    LAS bf16* q1s = k2s + 64 * 136;
    LAS float* tot = (LAS float*)(q1s + 64 * 128);
    LAS float* part = tot + 512;
    const float qs = 0.08838834764831845f;
    const int d = C.tid & 127, tq = C.tid >> 7, l = C.lane, fr = l & 15, fq = l >> 4;
    const int dq = d;
    const int pr0 = C.tid >> 4, pc = (C.tid & 15) * 8;
#define PP_BAR() do { asm volatile("s_waitcnt lgkmcnt(0)" ::: "memory"); __builtin_amdgcn_s_barrier(); asm volatile("" ::: "memory"); } while (0)
    for (int itb = C.vcu; itb < NBATCH * 32; itb += C.G) {
        const int c = itb & 31, b = itb >> 5;
        const size_t rowb = (size_t)b * SEQLEN + c * 64;
        const size_t row0 = rowb + tq * 16;
        if (NH == 4) { __syncthreads(); tail_mfma(C, b * SEQLEN + c * 64, (const bf16*)(C.ws + WS_TAILW) + 2 * 16 * 1024, part); }
        v4u pq[2], pk[2];
#define PP_LOAD(h_) do { _Pragma("unroll") for (int j = 0; j < 2; ++j) { const size_t r_ = (rowb + pr0 + 32 * j) * 1024 + (h_) * 128 + pc; \
            pq[j] = *(const GAS v4u*)(P0 + r_); pk[j] = *(const GAS v4u*)((NH == 4 ? P0 + 512 : P1) + r_); } } while (0)
        PP_LOAD(0);
#pragma unroll 1
        for (int h = 0; h < NH; ++h) {
            const int it = (b * NH + h) * 32 + c;
            PP_BAR();
#pragma unroll
            for (int j = 0; j < 2; ++j) { *(LAS v4u*)(tqs + (pr0 + 32 * j) * 128 + pc) = pq[j]; *(LAS v4u*)(tks + (pr0 + 32 * j) * 128 + pc) = pk[j]; }
            if (h + 1 < NH) PP_LOAD(h + 1);
            PP_BAR();
            float bl[16], kk[16]; float run = 0.f;
            if (NH == 4) {
                float wu[16];
#pragma unroll
                for (int r = 0; r < 16; ++r) wu[r] = C.in[9][r * 512 + h * 128 + d];
                const float ba = C.in[10][h * 128 + d];
#pragma unroll
                for (int i = 0; i < 16; ++i) { float z = ba; const int t = tq * 16 + i;
#pragma unroll
                    for (int r = 0; r < 16; r += 4) { const f32x4 p0 = *(const LAS f32x4*)(part + t * 16 + r), p1 = *(const LAS f32x4*)(part + 1024 + t * 16 + r);
                        z += (p0[0] + p1[0]) * wu[r] + (p0[1] + p1[1]) * wu[r + 1] + (p0[2] + p1[2]) * wu[r + 2] + (p0[3] + p1[3]) * wu[r + 3]; }
                    run += log_sigmoid_f(z) * (1.f / 16.f); bl[i] = run; kk[i] = bf2f(tks[t * 128 + d]); }
            } else {
                const float lb = ((const float*)(C.ws + WS_LB))[h * 128 + d];
#pragma unroll
                for (int i = 0; i < 16; ++i) { const float gate = lb + (1.f - lb) * sigmoid_f(bf2f(tks[(tq * 16 + i) * 128 + d])); run += __logf(gate); bl[i] = run; kk[i] = 1.f - gate; }
            }
            tot[tq * 128 + d] = run;
            PP_BAR();
            const float t0 = tot[d], t1 = tot[128 + d], t2 = tot[256 + d], t3 = tot[384 + d];
            const float off = tq == 0 ? 0.f : tq == 1 ? t0 : tq == 2 ? t0 + t1 : t0 + t1 + t2;
            const float bref = t0 + t1, bend = (t0 + t1) + (t2 + t3);
            unsigned ksw[8];
#pragma unroll
            for (int i = 0; i < 16; ++i) {
                const float bb = bl[i] + off;
                const float qv = bf2f(tqs[(tq * 16 + i) * 128 + d]) * qs, kv = kk[i];
                q1s[(tq * 16 + i) * 128 + dq] = (bf16)f2bf(qv * __expf(bb));
                q2s[(tq * 16 + i) * 136 + d] = (bf16)f2bf(qv * __expf(bb - bref));
                k2s[(tq * 16 + i) * 136 + d] = (bf16)f2bf(kv * __expf(bref - bb));
                const unsigned kb = f2bf(kv * __expf(bend - bb));
                if (i & 1) ksw[i >> 1] |= kb << 16; else ksw[i >> 1] = kb;
            }
            { bf16* kt = KST + ((size_t)it * 128 + d) * 64 + tq * 16; *(GAS v4u*)kt = (v4u){ksw[0], ksw[1], ksw[2], ksw[3]}; *(GAS v4u*)(kt + 8) = (v4u){ksw[4], ksw[5], ksw[6], ksw[7]}; }
            if (tq == 0) DEC[(size_t)it * 128 + d] = __expf(bend);
            PP_BAR();
#pragma unroll
            for (int j = 0; j < 2; ++j) *(GAS v4u*)(Q1 + (rowb + pr0 + 32 * j) * 1024 + h * 128 + pc) = *(const LAS v4u*)(q1s + (pr0 + 32 * j) * 128 + pc);
            const int ti = C.wave >> 1;
#pragma unroll
            for (int sj = 0; sj < 2; ++sj) {
                const int si = 2 * (C.wave & 1) + sj;
                f32x4 acc = (f32x4){0.f, 0.f, 0.f, 0.f};
                if (si <= ti) {
#pragma unroll
                    for (int ks = 0; ks < 4; ++ks) {
                        const bf16x8 a = *(const LAS bf16x8*)(q2s + (16 * ti + fr) * 136 + ks * 32 + fq * 8), bb = *(const LAS bf16x8*)(k2s + (16 * si + fr) * 136 + ks * 32 + fq * 8);
                        acc = __builtin_amdgcn_mfma_f32_16x16x32_bf16(bb, a, acc, 0, 0, 0);
                    }
                }
                const int t = 16 * ti + fr, s0 = 16 * si + 4 * fq;
                typedef unsigned u32x2v __attribute__((ext_vector_type(2)));
                u32x2v w; w.x = pk2(s0 <= t ? acc[0] : 0.f, s0 + 1 <= t ? acc[1] : 0.f); w.y = pk2(s0 + 2 <= t ? acc[2] : 0.f, s0 + 3 <= t ? acc[3] : 0.f);
                *(GAS u32x2v*)(ASC + (size_t)it * 4096 + t * 64 + s0) = w;
            }
        }
    }
#undef PP_LOAD
#undef PP_BAR
}
struct RecFrag { bf16x8 vb[2]; bf16x8 a0, a1; unsigned long long q[4][2]; f32x4 dc[2]; bf16x8 ks[2][2]; };
template <int NH, int DV>
__device__ __forceinline__ void chunk_recur(const Ctx& C, const bf16* Vp) {
    const bf16* ASC = (const bf16*)(C.ws + WS_ASC); const bf16* Q1 = (const bf16*)(C.ws + WS_Q1); const bf16* KST = (const bf16*)(C.ws + WS_KST); const float* DEC = (const float*)(C.ws + WS_DEC);
    bf16* OF = (bf16*)(C.ws + WS_OF);
    constexpr int NCB = DV / 16, NTASK = NBATCH * NH * NCB;
    const int l = C.lane, m = l & 15, g = l >> 4, gi = C.wave >> 2, kq = C.wave & 3;
    LAS float* red = (LAS float*)C.lds + gi * 8192;
#define REC_LOAD(F, c_) do { const size_t row0_ = (size_t)b * SEQLEN + (c_) * 64; const size_t ch_ = (size_t)bh * 32 + (c_); \
        _Pragma("unroll") for (int ks = 0; ks < 2; ++ks) _Pragma("unroll") for (int j = 0; j < 8; ++j) F.vb[ks][j] = (short)Vp[(row0_ + 32 * ks + 8 * g + j) * 1024 + col]; \
        F.a0 = *(const bf16x8*)(ASC + ch_ * 4096 + (16 * kq + m) * 64 + 8 * g); F.a1 = *(const bf16x8*)(ASC + ch_ * 4096 + (16 * kq + m) * 64 + 32 + 8 * g); \
        _Pragma("unroll") for (int tb = 0; tb < 4; ++tb) { const bf16* qp = Q1 + (row0_ + 16 * tb + m) * 1024 + h * 128 + 32 * kq + 4 * g; F.q[tb][0] = *(const unsigned long long*)qp; F.q[tb][1] = *(const unsigned long long*)(qp + 16); } \
        _Pragma("unroll") for (int i = 0; i < 2; ++i) { F.dc[i] = *(const f32x4*)(DEC + ch_ * 128 + 32 * kq + 16 * i + 4 * g); \
            _Pragma("unroll") for (int ks = 0; ks < 2; ++ks) F.ks[i][ks] = *(const bf16x8*)(KST + (ch_ * 128 + 32 * kq + 16 * i + m) * 64 + 32 * ks + 8 * g); } } while (0)
#define REC_BODY(F, Fn, c_) do { \
        if ((c_) + 1 < 32) REC_LOAD(Fn, (c_) + 1); \
        if (BGQ) { const int bgn = (bgit * 32 + (c_)) * C.NGW + C.gw; bgq_step<JOB>(C, bgi, bgn, bgv); bgi = bgn; } \
        LAS float* rb = red + ((c_) & 1) * 4096; \
        f32x4 oin = __builtin_amdgcn_mfma_f32_16x16x32_bf16(F.a0, F.vb[0], (f32x4){0.f, 0.f, 0.f, 0.f}, 0, 0, 0); \
        if (kq >= 2) oin = __builtin_amdgcn_mfma_f32_16x16x32_bf16(F.a1, F.vb[1], oin, 0, 0, 0); \
        { u32x4v sw; sw.x = pk2(S[0][0], S[0][1]); sw.y = pk2(S[0][2], S[0][3]); sw.z = pk2(S[1][0], S[1][1]); sw.w = pk2(S[1][2], S[1][3]); \
          const bf16x8 sb = __builtin_bit_cast(bf16x8, sw); \
          _Pragma("unroll") for (int tb = 0; tb < 4; ++tb) { u32x4v aw; aw.x = (unsigned)F.q[tb][0]; aw.y = (unsigned)(F.q[tb][0] >> 32); aw.z = (unsigned)F.q[tb][1]; aw.w = (unsigned)(F.q[tb][1] >> 32); \
              const f32x4 po = __builtin_amdgcn_mfma_f32_16x16x32_bf16(__builtin_bit_cast(bf16x8, aw), sb, (f32x4){0.f, 0.f, 0.f, 0.f}, 0, 0, 0); \
              *(LAS f32x4*)(rb + ((kq * 4 + tb) * 64 + l) * 4) = po; } } \
        _Pragma("unroll") for (int i = 0; i < 2; ++i) { S[i] = S[i] * F.dc[i]; \
            _Pragma("unroll") for (int ks = 0; ks < 2; ++ks) S[i] = __builtin_amdgcn_mfma_f32_16x16x32_bf16(F.ks[i][ks], F.vb[ks], S[i], 0, 0, 0); } \
        asm volatile("s_waitcnt lgkmcnt(0)" ::: "memory"); __builtin_amdgcn_s_barrier(); asm volatile("" ::: "memory"); \
        { f32x4 o = oin; \
          _Pragma("unroll") for (int k2 = 0; k2 < 4; ++k2) o = o + *(const LAS f32x4*)(rb + ((k2 * 4 + kq) * 64 + l) * 4); \
          const size_t orow = (size_t)b * SEQLEN + (c_) * 64 + 16 * kq + 4 * g; \
          _Pragma("unroll") for (int r = 0; r < 4; ++r) OF[(orow + r) * 1024 + col] = (bf16)f2bf(o[r]); } } while (0)
    constexpr int JOB = NH == 4 ? 1 : 2;
    f32x4 bgv[4]; int bgi = -1, bgit = 0;
    for (int t0 = C.vcu; t0 < NTASK / 2; t0 += C.G, ++bgit) {
        const int task = gi * (NTASK / 2) + t0;
        const int cb = task % NCB, bh = task / NCB, b = bh / NH, h = bh % NH;
        const int col = h * DV + cb * 16 + m;
        f32x4 S[2];
        S[0] = (f32x4){0.f, 0.f, 0.f, 0.f}; S[1] = S[0];
        RecFrag FA, FB;
        REC_LOAD(FA, 0);
#pragma unroll 1
        for (int c = 0; c < 32; c += 2) { REC_BODY(FA, FB, c); REC_BODY(FB, FA, c + 1); }
        asm volatile("s_waitcnt lgkmcnt(0)" ::: "memory"); __builtin_amdgcn_s_barrier(); asm volatile("" ::: "memory");
    }
    if (BGQ) {
        for (int bgn = bgit * 32 * C.NGW + C.gw; bgi < BGQ_ROWS; bgn += C.NGW) { bgq_step<JOB>(C, bgi, bgn, bgv); bgi = bgn; }
    }
#undef REC_LOAD
#undef REC_BODY
}

template <int DV>
__device__ __forceinline__ void rec_norm_gate(const Ctx& C, const float* gain, const bf16* gate) {
    const bf16* OF = (const bf16*)(C.ws + WS_OF); bf16* OB = (bf16*)(C.ws + WS_OB);
    f32x4 g[4];
#pragma unroll
    for (int j = 0; j < 4; ++j) g[j] = *((const GAS f32x4*)gain + C.lane + 64 * j);
    for (int tok0 = C.gw; tok0 < NTOK; tok0 += 4 * C.NGW) {
        unsigned long long vw[4][4], tw[4][4];
#pragma unroll
        for (int u = 0; u < 4; ++u) { const int tok = tok0 + u * C.NGW; if (tok < NTOK) {
            const GAS unsigned long long* xr = (const GAS unsigned long long*)(OF + (size_t)tok * 1024) + C.lane;
            const GAS unsigned long long* tr = (const GAS unsigned long long*)(gate + (size_t)tok * 1024) + C.lane;
#pragma unroll
            for (int j = 0; j < 4; ++j) { vw[u][j] = xr[64 * j]; tw[u][j] = tr[64 * j]; } } }
        __builtin_amdgcn_sched_barrier(0);
#pragma unroll
        for (int u = 0; u < 4; ++u) { const int tok = tok0 + u * C.NGW; if (tok < NTOK) {
            GAS unsigned long long* o8 = (GAS unsigned long long*)(OB + (size_t)tok * 1024) + C.lane;
#pragma unroll
            for (int j = 0; j < 4; ++j) {
                const f32x4 v = (f32x4){bflo((unsigned)vw[u][j]), bfhi((unsigned)vw[u][j]), bflo((unsigned)(vw[u][j] >> 32)), bfhi((unsigned)(vw[u][j] >> 32))}; float ss = (v.x * v.x + v.y * v.y) + (v.z * v.z + v.w * v.w);
                if (DV == 256) ss = wave_sum(ss); else { DPP_SUM31(ss); const float s_lo = rdlane(ss, 31), s_hi = rdlane(ss, 63); ss = C.lane < 32 ? s_lo : s_hi; }
                const float r = rsqrtf(ss * (1.f / DV) + RMS_EPS);
                const unsigned long long t8 = tw[u][j];
                const float t0 = bflo((unsigned)t8), t1 = bfhi((unsigned)t8), t2 = bflo((unsigned)(t8 >> 32)), t3 = bfhi((unsigned)(t8 >> 32));
                const float a0 = v.x * r * g[j].x * (t0 * sigmoid_f(t0)), a1 = v.y * r * g[j].y * (t1 * sigmoid_f(t1)), a2 = v.z * r * g[j].z * (t2 * sigmoid_f(t2)), a3 = v.w * r * g[j].w * (t3 * sigmoid_f(t3));
                o8[64 * j] = (unsigned long long)pk2(a0, a1) | ((unsigned long long)pk2(a2, a3) << 32);
            } } }
    }
}

#define CE_D(a, b) do { const unsigned mx_ = (a) > (b) ? (a) : (b); const unsigned mn_ = (a) > (b) ? (b) : (a); (a) = mx_; (b) = mn_; } while (0)
__device__ __forceinline__ void sort16_desc(unsigned (&a)[16]) {
#pragma unroll
    for (int k = 2; k <= 16; k <<= 1)
#pragma unroll
        for (int j = k >> 1; j > 0; j >>= 1)
#pragma unroll
            for (int i = 0; i < 16; ++i) { const int l = i ^ j; if (l > i) { if ((i & k) == 0) CE_D(a[i], a[l]); else CE_D(a[l], a[i]); } }
}
__device__ __forceinline__ void merge_top16(unsigned (&a)[16], const unsigned (&b)[16]) {
#pragma unroll
    for (int i = 0; i < 16; ++i) a[i] = a[i] > b[15 - i] ? a[i] : b[15 - i];
#pragma unroll
    for (int j = 8; j > 0; j >>= 1)
#pragma unroll
        for (int i = 0; i < 16; ++i) { const int l = i ^ j; if (l > i) CE_D(a[i], a[l]); }
}
__device__ __forceinline__ void merge_quad(unsigned (&a)[16], int lane) {
    unsigned p[16];
#pragma unroll
    for (int i = 0; i < 16; ++i) p[i] = (unsigned)__builtin_amdgcn_ds_bpermute((lane ^ 16) << 2, (int)a[i]);
    merge_top16(a, p);
#pragma unroll
    for (int i = 0; i < 16; ++i) p[i] = (unsigned)__builtin_amdgcn_ds_bpermute((lane ^ 32) << 2, (int)a[i]);
    merge_top16(a, p);
}
__device__ __forceinline__ unsigned mono_key(float f) { const unsigned u = __float_as_uint(f); return (u & 0x80000000u) ? ~u : (u | 0x80000000u); }
__device__ __forceinline__ float mono_inv(unsigned k) { return __uint_as_float((k & 0x80000000u) ? (k ^ 0x80000000u) : ~k); }
__constant__ __attribute__((aligned(16))) unsigned char PEER_CAND[64] = {0, 1, 2, 3, 4, 5, 6, 7, 8, 9, 10, 11, 12, 13, 14, 15, 16, 17, 18, 19, 20, 21, 22, 23, 32, 33, 34, 35, 36, 64, 65, 66, 48, 49, 50, 51, 80, 81, 96, 97, 112, 113, 128, 144, 160, 176, 192, 208, 224, 240, 255, 255, 255, 255, 255, 255, 255, 255, 255, 255, 255, 255, 255, 255};
__device__ __forceinline__ void peer_topk_task(const Ctx& C, int layer, int tok0, int head, int trow0, LAS int* lexp, LAS float* lgate) {
    typedef _Float16 h8 __attribute__((ext_vector_type(8)));
    const _Float16* SC = (const _Float16*)(C.ws + WS_Q2);
    LAS unsigned* L0 = (LAS unsigned*)(C.lds + C.wave * 2048);
    LAS unsigned* L1 = L0 + 256;
    {
        int l = C.lane; asm volatile("" : "+v"(l));
        const int m = l & 15, g = l >> 4;
        unsigned cand_w[4];
#pragma unroll
        for (int c = 0; c < 4; ++c) cand_w[c] = ((const unsigned*)PEER_CAND)[g * 4 + c];
        unsigned top[2][16];
#pragma unroll
        for (int p = 0; p < 2; ++p) {
            const _Float16* sp = SC + (size_t)(tok0 + m) * 2048 + head * 256 + p * 128 + 32 * g;
            h8 hv[4];
#pragma unroll
            for (int q = 0; q < 4; ++q) hv[q] = *(const h8*)(sp + 8 * q);
            unsigned hi16[16];
#pragma unroll
            for (int q = 0; q < 4; ++q)
#pragma unroll
                for (int j = 0; j < 8; ++j) { const int i = 8 * q + j; const unsigned key = (mono_key((float)hv[q][j]) & ~0x7fu) | (unsigned)(127 - (32 * g + i));
                    if (i < 16) top[p][i] = key; else hi16[i - 16] = key; }
            sort16_desc(top[p]); sort16_desc(hi16); merge_top16(top[p], hi16);
            merge_quad(top[p], l);
        }
        if (g == 0) {
#pragma unroll
            for (int i = 0; i < 16; i += 4) { *(LAS u32x4v*)(L0 + m * 16 + i) = (u32x4v){top[0][i], top[0][i + 1], top[0][i + 2], top[0][i + 3]}; *(LAS u32x4v*)(L1 + m * 16 + i) = (u32x4v){top[1][i], top[1][i + 1], top[1][i + 2], top[1][i + 3]}; }
        }
        asm volatile("s_waitcnt lgkmcnt(0)" ::: "memory"); __builtin_amdgcn_wave_barrier();
        unsigned cd[16];
#pragma unroll
        for (int c = 0; c < 16; ++c) {
            const unsigned code = (cand_w[c >> 2] >> (8 * (c & 3))) & 0xffu, ci = (code >> 4) & 15u, cj = code & 15u;
            const float v = mono_inv(L0[m * 16 + ci]) + mono_inv(L1[m * 16 + cj]);
            cd[c] = code == 255u ? 0u : ((mono_key(v) & ~0xffu) | (255u - code));
        }
        sort16_desc(cd); merge_quad(cd, l);
        if (g == 0) {
            float best[16]; int ex[16]; float sum = 0.f;
#pragma unroll
            for (int r = 0; r < 16; ++r) { const unsigned pos = 255u - (cd[r] & 0xffu), pi = pos >> 4, pj = pos & 15u;
                ex[r] = (int)((127u - (L0[m * 16 + pi] & 0x7fu)) * 128u + (127u - (L1[m * 16 + pj] & 0x7fu))); best[r] = mono_inv(cd[r]); }
            const float bmax = best[0];
#pragma unroll
            for (int r = 0; r < 16; ++r) { best[r] = __expf(best[r] - bmax); sum += best[r]; }
            const float inv = 1.f / sum;
            const int ob = (trow0 + m) * 128 + head * 16;
#pragma unroll
            for (int r = 0; r < 16; r += 4) { *(LAS u32x4v*)(lexp + ob + r) = (u32x4v){(unsigned)ex[r], (unsigned)ex[r + 1], (unsigned)ex[r + 2], (unsigned)ex[r + 3]};
                *(LAS f32x4*)(lgate + ob + r) = (f32x4){best[r] * inv, best[r + 1] * inv, best[r + 2] * inv, best[r + 3] * inv}; }
        }
        asm volatile("s_waitcnt lgkmcnt(0)" ::: "memory"); __builtin_amdgcn_wave_barrier();
    }
}
typedef float f32x2v __attribute__((ext_vector_type(2)));
#define GRP8_SUM(v) do { v = DPP_ADD(v, 0xB1, 0xf, 0xf); v = DPP_ADD(v, 0x4E, 0xf, 0xf); v = DPP_ADD(v, 0x141, 0xf, 0xf); } while (0)
#ifndef MK_HOT
#define MK_HOT 0
#endif
__device__ __forceinline__ void wave_lds_sync() { asm volatile("s_waitcnt lgkmcnt(0)" ::: "memory"); __builtin_amdgcn_wave_barrier(); }
template <bool DRY>
__device__ __forceinline__ void peer_rounds(const Ctx& C, int layer, int tokw, LAS int* lexp_w, const LAS float* lgate_w, LAS unsigned* sorted_w, LAS unsigned* hist_w) {
    const unsigned char* U = C.ws + WS_U + (size_t)layer * 16384 * 1024; const unsigned char* V = C.ws + WS_V + (size_t)layer * 16384 * 1024;
    const float* SU = (const float*)(C.ws + WS_SU) + layer * 16384; const float* SV = (const float*)(C.ws + WS_SV) + layer * 16384;
    const float* gf = C.in[2] + layer * 1024; const float* gn = C.in[1] + (layer + 1) * 1024;
    int l = C.lane; asm volatile("" : "+v"(l));
    LAS float* hbuf = (LAS float*)lexp_w;
    {
        const int t = l >> 3, s = l & 7;
#pragma unroll
        for (int k = 0; k < 8; ++k) hist_w[l + 64 * k] = 0u;
        wave_lds_sync();
        unsigned ev[16], pos[16];
#pragma unroll
        for (int k = 0; k < 16; ++k) { ev[k] = (unsigned)lexp_w[t * 128 + s + 8 * k]; pos[k] = __hip_atomic_fetch_add(hist_w + t * 64 + (ev[k] >> 8), 1u, __ATOMIC_RELAXED, __HIP_MEMORY_SCOPE_WORKGROUP); }
        wave_lds_sync();
        unsigned cnt[8], run = 0u;
#pragma unroll
        for (int j = 0; j < 8; ++j) { cnt[j] = hist_w[t * 64 + 8 * s + j]; run += cnt[j]; }
        unsigned inc = run;
#pragma unroll
        for (int o = 1; o < 8; o <<= 1) { const unsigned up = (unsigned)__builtin_amdgcn_ds_bpermute((l - o) << 2, (int)inc); if (s >= o) inc += up; }
        unsigned off = inc - run;
        wave_lds_sync();
#pragma unroll
        for (int j = 0; j < 8; ++j) { hist_w[t * 64 + 8 * s + j] = off; off += cnt[j]; }
        wave_lds_sync();
#pragma unroll
        for (int k = 0; k < 16; ++k) sorted_w[t * 128 + hist_w[t * 64 + (ev[k] >> 8)] + pos[k]] = (ev[k] << 7) | (unsigned)(s + 8 * k);
        wave_lds_sync();
    }
    asm volatile("" : "+v"(l));
    unsigned xp[8][8];
    {
        const int t = l >> 3, s = l & 7;
        const bf16* hrow = (const bf16*)(C.ws + WS_HB) + (size_t)(tokw + t) * 1024 + 16 * s;
        float ss = 0.f;
#pragma unroll
        for (int i = 0; i < 8; ++i) { const v4u a = *(const GAS v4u*)(hrow + 128 * i), b = *(const GAS v4u*)(hrow + 128 * i + 8);
            xp[i][0] = a.x; xp[i][1] = a.y; xp[i][2] = a.z; xp[i][3] = a.w; xp[i][4] = b.x; xp[i][5] = b.y; xp[i][6] = b.z; xp[i][7] = b.w;
#pragma unroll
            for (int j = 0; j < 8; ++j) { const float lo = bflo(xp[i][j]), hi = bfhi(xp[i][j]); ss += lo * lo + hi * hi; } }
        GRP8_SUM(ss);
        const float r = rsqrtf(ss * (1.f / 1024.f) + RMS_EPS);
#pragma unroll
        for (int i = 0; i < 8; ++i)
#pragma unroll
            for (int q = 0; q < 4; ++q) { const f32x4 a = *(const GAS f32x4*)(gf + 16 * s + 128 * i + 4 * q);
                xp[i][2 * q] = pk2(bflo(xp[i][2 * q]) * r * a.x, bfhi(xp[i][2 * q]) * r * a.y); xp[i][2 * q + 1] = pk2(bflo(xp[i][2 * q + 1]) * r * a.z, bfhi(xp[i][2 * q + 1]) * r * a.w); }
    }
    asm volatile("" : "+v"(l));
#define RND_LOAD(T, buf, item) do { const unsigned char* p_ = T + (size_t)((DRY && MK_HOT) ? (((item) >> 7) & 255u) : ((item) >> 7)) * 1024 + 16 * (l & 7); \
        _Pragma("unroll") for (int i = 0; i < 8; ++i) buf[i] = *(const GAS v4u*)(p_ + 128 * i); } while (0)
    {
        const int t = l >> 3, s = l & 7;
        const LAS unsigned* srt = sorted_w + t * 128;
        v4u bA[8], bB[8];
#define RND_DOT(buf, r_) do { float d = 0.f; \
            _Pragma("unroll") for (int i = 0; i < 8; ++i) { asm volatile("" : "+v"(buf[i])); _Pragma("unroll") for (int q = 0; q < 4; ++q) { \
                const f32x2v lo_ = __builtin_amdgcn_cvt_pk_f32_fp8((int)buf[i][q], false), hi_ = __builtin_amdgcn_cvt_pk_f32_fp8((int)buf[i][q], true); \
                d = dot2bf(pg8::cvt_pk_bf16(lo_.x, lo_.y), xp[i][2 * q], d); d = dot2bf(pg8::cvt_pk_bf16(hi_.x, hi_.y), xp[i][2 * q + 1], d); } } \
            GRP8_SUM(d); if (s == 0) hbuf[t * 128 + (r_)] = d; } while (0)
        RND_LOAD(U, bA, srt[0]);
#pragma unroll 1
        for (int r = 0; r < 128; r += 2) {
            RND_LOAD(U, bB, srt[r + 1]);
            RND_DOT(bA, r);
            RND_LOAD(U, bA, srt[(r + 2) & 127]);
            RND_DOT(bB, r + 1);
        }
#undef RND_DOT
    }
    wave_lds_sync();
    asm volatile("" : "+v"(l));
    {
        const int t = l >> 3, s = l & 7;
#pragma unroll
        for (int k = 0; k < 16; k += 2) {
            const int r0 = t * 128 + s + 8 * k, r1 = r0 + 8;
            const unsigned i0 = sorted_w[r0], i1 = sorted_w[r1];
            const float h0 = hbuf[r0] * SU[i0 >> 7], h1 = hbuf[r1] * SU[i1 >> 7];
            const pg8::f32x2 gl = pg8::gelu_pk((pg8::f32x2){h0, h1});
            hbuf[r0] = gl.x * lgate_w[t * 128 + (i0 & 127u)] * SV[i0 >> 7]; hbuf[r1] = gl.y * lgate_w[t * 128 + (i1 & 127u)] * SV[i1 >> 7];
        }
    }
    wave_lds_sync();
    asm volatile("" : "+v"(l));
    f32x2v y2[8][8];
#pragma unroll
    for (int i = 0; i < 8; ++i)
#pragma unroll
        for (int j = 0; j < 8; ++j) y2[i][j] = (f32x2v){0.f, 0.f};
    {
        const int t = l >> 3;
        const LAS unsigned* srt = sorted_w + t * 128; const LAS float* wv = hbuf + t * 128;
        v4u bA[8], bB[8];
#define RND_AXPY(buf, r_) do { const float w = wv[(r_)]; const f32x2v w2 = (f32x2v){w, w}; \
            _Pragma("unroll") for (int i = 0; i < 8; ++i) { asm volatile("" : "+v"(buf[i])); _Pragma("unroll") for (int q = 0; q < 4; ++q) { \
                const f32x2v lo_ = __builtin_amdgcn_cvt_pk_f32_fp8((int)buf[i][q], false), hi_ = __builtin_amdgcn_cvt_pk_f32_fp8((int)buf[i][q], true); \
                y2[i][2 * q] = w2 * lo_ + y2[i][2 * q]; y2[i][2 * q + 1] = w2 * hi_ + y2[i][2 * q + 1]; } } } while (0)
        RND_LOAD(V, bA, srt[0]);
#pragma unroll 1
        for (int r = 0; r < 128; r += 2) {
            RND_LOAD(V, bB, srt[r + 1]);
            RND_AXPY(bA, r);
            RND_LOAD(V, bA, srt[(r + 2) & 127]);
            RND_AXPY(bB, r + 1);
        }
#undef RND_AXPY
    }
#undef RND_LOAD
    asm volatile("" : "+v"(l));
    {
        const int t = l >> 3, s = l & 7;
        const bf16* hrow = (const bf16*)(C.ws + WS_HB) + (size_t)(tokw + t) * 1024 + 16 * s;
        float* hout = (DRY ? (float*)(C.ws + WS_OF) : C.out) + (size_t)(tokw + t) * 1024 + 16 * s;
        bf16* hb = (bf16*)(C.ws + (DRY ? WS_OF : WS_HB)) + (size_t)(tokw + t) * 1024 + 16 * s;
        float s2 = 0.f;
#pragma unroll
        for (int i = 0; i < 8; ++i) { const v4u a = *(const GAS v4u*)(hrow + 128 * i), b = *(const GAS v4u*)(hrow + 128 * i + 8);
            const unsigned hw[8] = {a.x, a.y, a.z, a.w, b.x, b.y, b.z, b.w};
#pragma unroll
            for (int j = 0; j < 8; ++j) { y2[i][j].x += bflo(hw[j]); y2[i][j].y += bfhi(hw[j]); s2 += y2[i][j].x * y2[i][j].x + y2[i][j].y * y2[i][j].y; }
            if (layer == DEPTH - 1) {
#pragma unroll
                for (int q = 0; q < 4; ++q) *(GAS f32x4*)(hout + 128 * i + 4 * q) = (f32x4){y2[i][2 * q].x, y2[i][2 * q].y, y2[i][2 * q + 1].x, y2[i][2 * q + 1].y};
            } else {
                *(GAS v4u*)(hb + 128 * i) = (v4u){pk2(y2[i][0].x, y2[i][0].y), pk2(y2[i][1].x, y2[i][1].y), pk2(y2[i][2].x, y2[i][2].y), pk2(y2[i][3].x, y2[i][3].y)};
                *(GAS v4u*)(hb + 128 * i + 8) = (v4u){pk2(y2[i][4].x, y2[i][4].y), pk2(y2[i][5].x, y2[i][5].y), pk2(y2[i][6].x, y2[i][6].y), pk2(y2[i][7].x, y2[i][7].y)};
            } }
        if (layer < DEPTH - 1) {
            GRP8_SUM(s2);
            const float r2 = rsqrtf(s2 * (1.f / 1024.f) + RMS_EPS);
            const bool wx8 = ((I8MASK >> (layer + 1)) & 1) != 0, wxn = ((layer + 1) % 3 != 2) || !wx8;
            bf16* xo = (bf16*)(C.ws + (DRY ? WS_GLOG : WS_XN)) + (size_t)(tokw + t) * 1024 + 16 * s; float am = 0.f;
#pragma unroll
            for (int i = 0; i < 8; ++i) { unsigned pw[8];
#pragma unroll
                for (int q = 0; q < 4; ++q) { const f32x4 a = *(const GAS f32x4*)(gn + 16 * s + 128 * i + 4 * q);
                    y2[i][2 * q].x *= r2 * a.x; y2[i][2 * q].y *= r2 * a.y; y2[i][2 * q + 1].x *= r2 * a.z; y2[i][2 * q + 1].y *= r2 * a.w;
                    am = fmaxf(fmaxf(am, fmaxf(fabsf(y2[i][2 * q].x), fabsf(y2[i][2 * q].y))), fmaxf(fabsf(y2[i][2 * q + 1].x), fabsf(y2[i][2 * q + 1].y)));
                    pw[2 * q] = pk2(y2[i][2 * q].x, y2[i][2 * q].y); pw[2 * q + 1] = pk2(y2[i][2 * q + 1].x, y2[i][2 * q + 1].y); }
                if (wxn) { *(GAS v4u*)(xo + 128 * i) = (v4u){pw[0], pw[1], pw[2], pw[3]}; *(GAS v4u*)(xo + 128 * i + 8) = (v4u){pw[4], pw[5], pw[6], pw[7]}; } }
            if (wx8) {
            am = DPP_MAX(am, 0xB1, 0xf, 0xf); am = DPP_MAX(am, 0x4E, 0xf, 0xf); am = DPP_MAX(am, 0x141, 0xf, 0xf);
            const float qi = am > 0.f ? 127.f / am : 0.f;
            signed char* xq = (signed char*)(C.ws + (DRY ? WS_GLOG + 32 * MiB : WS_XN8)) + (size_t)(tokw + t) * 1024 + 16 * s;
#pragma unroll
            for (int i = 0; i < 8; ++i) { unsigned pq[4];
#pragma unroll
                for (int q = 0; q < 4; ++q) pq[q] = q8x4(y2[i][2 * q].x * qi, y2[i][2 * q].y * qi, y2[i][2 * q + 1].x * qi, y2[i][2 * q + 1].y * qi);
                *(GAS v4u*)(xq + 128 * i) = (v4u){pq[0], pq[1], pq[2], pq[3]}; }
            if (s == 0) *(GAS float*)((float*)(C.ws + (DRY ? WS_GLOG + 48 * MiB : WS_SX)) + tokw + t) = am * (1.f / 127.f);
            }
        }
    }
}
#ifndef MK_SWEEP
#define MK_SWEEP 2
#endif
template <bool DRY>
__device__ __forceinline__ void peer_topk_gather(const Ctx& C, int layer) {
    LAS int* lexp = (LAS int*)(C.lds + 16384);
    LAS float* lgate = (LAS float*)(C.lds + 16384 + 32768);
    LAS unsigned* sorted = (LAS unsigned*)(C.lds + 16384 + 65536);
    for (int tb = C.vcu; tb < NTOK / 64; tb += C.G) {
#pragma unroll 1
        for (int q = 0; q < 4; ++q) peer_topk_task(C, layer, tb * 64 + (C.wave & 3) * 16, (C.wave >> 2) * 4 + q, (C.wave & 3) * 16, lexp, lgate);
        __syncthreads();
#if MK_SWEEP == 2
        peer_rounds<DRY>(C, layer, tb * 64 + C.wave * 8, lexp + C.wave * 1024, lgate + C.wave * 1024, sorted + C.wave * 1024, (LAS unsigned*)(C.lds + C.wave * 2048));
#elif MK_SWEEP == 1
#error removed variant
        peer_sweep<DRY>(C, layer, tb * 64 + C.wave * 8, lexp + C.wave * 1024, lgate + C.wave * 1024, sorted + C.wave * 1024, (LAS unsigned*)(C.lds + C.wave * 1024));
#else
#pragma unroll 1
        for (int t = 0; t < 8; ++t) peer_gather_token<DRY>(C, layer, tb * 64 + C.wave * 8 + t, lexp + (C.wave * 8 + t) * 128, lgate + (C.wave * 8 + t) * 128);
#endif
        __syncthreads();
    }
}

#ifndef MK_SINGLE
#define MK_SINGLE 1
#endif
#ifndef MK_FASTGEMM
#define MK_FASTGEMM 1
#endif
constexpr int STEPS = 10, NPHASE = 1 + DEPTH * STEPS;
struct Args { const float* in[21]; float* out; unsigned char* ws; int ph_lo, ph_hi; };

template <int EPI>
__device__ __forceinline__ void do_gemm(const Ctx& C, const bf16* A, const bf16* Bt, int N, bf16* Ob, int ldc, int split, const float* rs_in, const float* base, float* outf, bf16* hg, const float* gain, float* rs_out) {
    pg8::Gemm g{A, Bt, NTOK, N, 1024}; pg8::StaticOrder S; S.init(NTOK, N, C.G, C.bx);
    if constexpr (EPI == 0) { pg8::EpiBf16R<false> E{Ob, ldc, split ? 1024 : 0, PSTRIDE, rs_in}; pg8::gemm_phase<pg8::EpiBf16R<false>, pg8::StaticOrder, true, true>(C.lds, g, S, E, C.tid); }
    else if constexpr (EPI == 2) { pg8::EpiBf16R<true> E{Ob, ldc, 0, PSTRIDE, rs_in}; pg8::gemm_phase<pg8::EpiBf16R<true>, pg8::StaticOrder, true, true>(C.lds, g, S, E, C.tid); }
    else if constexpr (EPI == 3) {
        pg8::Gemm g8{A, Bt, NTOK, N, 512}; pg8::EpiI8 E{Ob, PSTRIDE, rs_in, gain}; pg8::gemm_phase<pg8::EpiI8, pg8::StaticOrder, true, true>(C.lds, g8, S, E, C.tid); }
    else {
        bf16* HB = (bf16*)(C.ws + WS_HB); (void)outf;
        if (base) { pg8::EpiResNorm<false> E{base, HB, hg, gain, rs_out}; pg8::gemm_phase<pg8::EpiResNorm<false>, pg8::StaticOrder, true, true>(C.lds, g, S, E, C.tid); }
        else { pg8::EpiResNorm<true> E{HB, HB, hg, gain, rs_out}; pg8::gemm_phase<pg8::EpiResNorm<true>, pg8::StaticOrder, true, true>(C.lds, g, S, E, C.tid); } }
}

template <int STEP, int MIXER>
__device__ __forceinline__ void run_step(const Ctx& C, int layer) {
    const int jx = layer / 3;
    bf16* XN = (bf16*)(C.ws + WS_XN); bf16* P = (bf16*)(C.ws + WS_P); bf16* OB = (bf16*)(C.ws + WS_OB); bf16* Q2 = (bf16*)(C.ws + WS_Q2);
    if constexpr (STEP == 0) {
        const bf16* Wt = MIXER == 0 ? (const bf16*)(C.ws + WS_FOXWIN + (size_t)jx * 8 * MiB) : MIXER == 1 ? (const bf16*)(C.ws + WS_GLAWIN) : (const bf16*)(C.ws + WS_HGRNWIN);
        const float* sw = (const float*)(C.ws + WS_SW) + (MIXER == 0 ? jx * 4096 : MIXER == 1 ? 8192 : 11264);
        if ((I8MASK >> layer) & 1) do_gemm<3>(C, (const bf16*)(C.ws + WS_XN8), Wt, MIXER == 1 ? 3072 : 4096, P, 1024, 1, (const float*)(C.ws + WS_SX), nullptr, nullptr, nullptr, sw, nullptr);
        else do_gemm<0>(C, XN, Wt, MIXER == 1 ? 3072 : 4096, P, 1024, 1, nullptr, nullptr, nullptr, nullptr, nullptr, nullptr);
    } else if constexpr (STEP == 1) {
        if constexpr (MIXER == 0) fox_step1(C, jx);
    } else if constexpr (STEP == 2) {
        if constexpr (MIXER == 1) chunk_prepass<4>(C); else if constexpr (MIXER == 2) chunk_prepass<8>(C);
    } else if constexpr (STEP == 3) {
        if constexpr (MIXER == 0) {
            float gq = 0.f, gk = 0.f;
            for (int i = 0; i < 64; ++i) { gq = fmaxf(gq, fabsf(C.in[5][jx * 64 + i])); gk = fmaxf(gk, fabsf(C.in[6][jx * 64 + i])); }
            const float smax = 64.f * gq * gk * 0.125f * 1.4426950408889634f;
            const attn_body::AttnTensors AT{(const attn_body::bf16*)P, (const attn_body::bf16*)(P + PSTRIDE), (const attn_body::bf16*)(P + 2 * PSTRIDE), (attn_body::bf16*)OB, (const attn_body::bf16*)(P + 3 * PSTRIDE), (const float*)(C.ws + WS_TAIL), -(56.f + 2.f * smax)};
            const attn_body::StaticOrder S(C.G, C.bx);
            attn_body::attn_phase<attn_body::StaticOrder>((char*)C.lds, AT, S, C.tid);
        }
        else if constexpr (MIXER == 1) chunk_recur<4, 256>(C, P + PSTRIDE);
        else chunk_recur<8, 128>(C, P + 2 * PSTRIDE);
    } else if constexpr (STEP == 4) {
        if constexpr (MIXER == 1) rec_norm_gate<256>(C, C.in[11], P + 2 * PSTRIDE);
        else if constexpr (MIXER == 2) rec_norm_gate<128>(C, C.in[15], P + 3 * PSTRIDE);
    } else if constexpr (STEP == 5) {
        const bf16* Wt = MIXER == 0 ? (const bf16*)(C.ws + WS_FOXWOUT) + (size_t)jx * 1024 * 1024 : MIXER == 1 ? (const bf16*)(C.ws + WS_GLAWOUT) : (const bf16*)(C.ws + WS_HGRNWOUT);
        do_gemm<1>(C, OB, Wt, 1024, nullptr, 0, 0, nullptr, layer == 0 ? C.in[0] : nullptr, nullptr, XN, C.in[2] + layer * 1024, (float*)(C.ws + WS_RS));
    } else if constexpr (STEP == 6) {
    } else if constexpr (STEP == 7) {
        do_gemm<2>(C, XN, (const bf16*)(C.ws + WS_PEERWQ) + (size_t)layer * 2048 * 1024, 2048, Q2, 2048, 0, (const float*)(C.ws + WS_RS), nullptr, nullptr, nullptr, nullptr, nullptr);
    } else if constexpr (STEP == 8) {
        peer_topk_gather<false>(C, layer);
    } else if constexpr (STEP == 9) {
    } else if constexpr (STEP == 11) {
        peer_topk_gather<true>(C, layer);
    } else if constexpr (STEP == 12) {
        p0_prologue_b(C);
    } else {
        p0_prologue(C);
    }
}

__device__ __forceinline__ void make_ctx(Ctx& C, const Args& args, unsigned char* lds_raw) {
    C.lds = (LAS unsigned char*)lds_raw;
    C.tid = threadIdx.x; C.lane = C.tid & 63; C.wave = __builtin_amdgcn_readfirstlane(C.tid >> 6);
    C.G = gridDim.x; C.bx = blockIdx.x; { const int bx = blockIdx.x; C.vcu = (C.G % 8 == 0) ? (bx % 8) * (C.G / 8) + bx / 8 : bx; }
    C.gw = C.vcu * NWAVES + C.wave; C.NGW = C.G * NWAVES;
#pragma unroll
    for (int i = 0; i < 21; ++i) C.in[i] = args.in[i];
    C.out = args.out; C.ws = args.ws;
}

template <int STEP, int MIXER>
__global__ void __launch_bounds__(NWAVES * 64, 2) mk_phase(Args args, int layer) {
    extern __shared__ __attribute__((aligned(16))) unsigned char lds_raw[];
    Ctx C; make_ctx(C, args, lds_raw);
    run_step<STEP, MIXER>(C, layer);
}

template <int STEP, int MIXER>
static void launch_phase(const Args& a, int layer, int grid, hipStream_t stream) {
    static bool attr_set = false;
    if (!attr_set) { (void)hipFuncSetAttribute((const void*)mk_phase<STEP, MIXER>, hipFuncAttributeMaxDynamicSharedMemorySize, LDS_BYTES); attr_set = true; }
    hipLaunchKernelGGL((mk_phase<STEP, MIXER>), dim3(grid), dim3(NWAVES * 64), LDS_BYTES, stream, a, layer);
}
#ifndef MK_DUP
#define MK_DUP -1
#endif
#define LP(S, M) do { launch_phase<S, M>(a, layer, grid, stream); if (MK_DUP == S) launch_phase<(S == 8 ? 11 : S), M>(a, layer, grid, stream); } while (0)
template <int MIXER>
static void launch_layer(const Args& a, int layer, int grid, hipStream_t stream) {
    LP(0, MIXER);
    if (MIXER == 0) launch_phase<1, MIXER>(a, layer, grid, stream); else LP(2, MIXER);
    LP(3, MIXER);
    if (MIXER != 0) LP(4, MIXER);
    LP(5, MIXER);
    LP(7, 0);
    LP(8, 0);
}
#if MK_SINGLE
__device__ __forceinline__ const float* tab_ptr(volatile LAS unsigned long long* tab, int i) {
    const unsigned long long v = tab[i];
    const unsigned lo = __builtin_amdgcn_readfirstlane((unsigned)v), hi = __builtin_amdgcn_readfirstlane((unsigned)(v >> 32));
    return (const float*)(const GAS float*)(((unsigned long long)hi << 32) | lo);
}
__device__ __forceinline__ int lane_id_volatile() { int x; asm volatile("v_mbcnt_lo_u32_b32 %0, -1, 0\n\tv_mbcnt_hi_u32_b32 %0, -1, %0" : "=v"(x)); return x; }
__device__ __forceinline__ void make_ctx_opaque(Ctx& C, unsigned char* lds_raw, int wave_s) {
    int bx = blockIdx.x, G = gridDim.x; unsigned ldso = 0u;
    asm volatile("" : "+s"(bx), "+s"(G), "+s"(ldso), "+s"(wave_s));
    int tid = wave_s * 64 + lane_id_volatile();
    C.lds = (LAS unsigned char*)lds_raw + ldso;
    volatile LAS unsigned long long* tab = (volatile LAS unsigned long long*)(C.lds + LDSCTL_OFF);
    C.tid = tid; C.lane = tid & 63; C.wave = __builtin_amdgcn_readfirstlane(tid >> 6);
    C.G = G; C.bx = bx; C.vcu = (G % 8 == 0) ? (bx % 8) * (G / 8) + bx / 8 : bx;
    C.gw = C.vcu * NWAVES + C.wave; C.NGW = G * NWAVES;
#pragma unroll
    for (int i = 0; i < 21; ++i) C.in[i] = tab_ptr(tab, i);
    C.out = (float*)tab_ptr(tab, 21); C.ws = (unsigned char*)tab_ptr(tab, 22);
}
__device__ __forceinline__ void grid_bar(unsigned char* lds_raw, int wave_s) {
    unsigned ldso = 0u; asm volatile("" : "+s"(ldso), "+s"(wave_s));
    LAS unsigned char* lds = (LAS unsigned char*)lds_raw + ldso;
    volatile LAS unsigned long long* tab = (volatile LAS unsigned long long*)(lds + LDSCTL_OFF);
    XcdBarrier b; b.bar = (unsigned*)((unsigned char*)tab_ptr(tab, 22) + WS_CTL) + CW_BAR; b.x = xb_xcc_id(); b.st = (volatile LAS unsigned*)(lds + MISC_OFF) + 8;
    xcd_barrier(b, wave_s == 0 && lane_id_volatile() == 0);
}
#define MK_STEP(...) do { Ctx C; make_ctx_opaque(C, lds_raw, wave_s); __VA_ARGS__; } while (0)
__global__ void __launch_bounds__(NWAVES * 64, 2) mk_fwd(Args args) {
    extern __shared__ __attribute__((aligned(16))) unsigned char lds_raw[];
    const int wave_s = __builtin_amdgcn_readfirstlane(threadIdx.x >> 6);
    for (int u = threadIdx.x; u < (LDS_BYTES - LDSCTL_OFF) / 4; u += NWAVES * 64) ((LAS unsigned*)((LAS unsigned char*)lds_raw + LDSCTL_OFF))[u] = 0u;
    __syncthreads();
    if (threadIdx.x == 0) {
        LAS unsigned long long* tab = (LAS unsigned long long*)((LAS unsigned char*)lds_raw + LDSCTL_OFF);
#pragma unroll
        for (int i = 0; i < 21; ++i) tab[i] = (unsigned long long)args.in[i];
        tab[21] = (unsigned long long)args.out; tab[22] = (unsigned long long)args.ws;
    }
    (void)xcd_barrier_post((unsigned*)(args.ws + WS_CTL) + CW_BAR, (volatile LAS unsigned*)((LAS unsigned char*)lds_raw + MISC_OFF) + 8);
    __syncthreads();
    MK_STEP(p0_prologue(C));
    if (I8_NITEMS) { grid_bar(lds_raw, wave_s); MK_STEP(p0_prologue_b(C)); }
    cg::this_grid().sync();
#pragma unroll 1
    for (int layer = 0; layer < DEPTH; ++layer) {
        const int mixer = layer % 3, jx = layer / 3;
        MK_STEP(const bf16* Wt = mixer == 0 ? (const bf16*)(C.ws + WS_FOXWIN + (size_t)jx * 8 * MiB) : mixer == 1 ? (const bf16*)(C.ws + WS_GLAWIN) : (const bf16*)(C.ws + WS_HGRNWIN);
                const float* sw = (const float*)(C.ws + WS_SW) + (mixer == 0 ? jx * 4096 : mixer == 1 ? 8192 : 11264);
                if (I8MASK == 15 || (I8MASK != 0 && ((I8MASK >> layer) & 1))) do_gemm<3>(C, (const bf16*)(C.ws + WS_XN8), Wt, mixer == 1 ? 3072 : 4096, (bf16*)(C.ws + WS_P), 1024, 1, (const float*)(C.ws + WS_SX), nullptr, nullptr, nullptr, sw, nullptr);
                else do_gemm<0>(C, (const bf16*)(C.ws + WS_XN), Wt, mixer == 1 ? 3072 : 4096, (bf16*)(C.ws + WS_P), 1024, 1, nullptr, nullptr, nullptr, nullptr, nullptr, nullptr));
        grid_bar(lds_raw, wave_s);
        MK_STEP(if (mixer == 0) run_step<1, 0>(C, layer); else if (mixer == 1) run_step<2, 1>(C, layer); else run_step<2, 2>(C, layer));
        grid_bar(lds_raw, wave_s);
        MK_STEP(if (mixer == 0) run_step<3, 0>(C, layer); else if (mixer == 1) run_step<3, 1>(C, layer); else run_step<3, 2>(C, layer));
        grid_bar(lds_raw, wave_s);
        if (mixer != 0) { MK_STEP(if (mixer == 1) run_step<4, 1>(C, layer); else run_step<4, 2>(C, layer)); grid_bar(lds_raw, wave_s); }
        MK_STEP(const bf16* Wt = mixer == 0 ? (const bf16*)(C.ws + WS_FOXWOUT) + (size_t)jx * 1024 * 1024 : mixer == 1 ? (const bf16*)(C.ws + WS_GLAWOUT) : (const bf16*)(C.ws + WS_HGRNWOUT);
                do_gemm<1>(C, (const bf16*)(C.ws + WS_OB), Wt, 1024, nullptr, 0, 0, nullptr, layer == 0 ? C.in[0] : nullptr, nullptr, (bf16*)(C.ws + WS_XN), C.in[2] + layer * 1024, (float*)(C.ws + WS_RS)));
        grid_bar(lds_raw, wave_s);
        MK_STEP(run_step<7, 0>(C, layer));
        grid_bar(lds_raw, wave_s);
        MK_STEP(run_step<8, 0>(C, layer));
        if (layer + 1 < DEPTH) grid_bar(lds_raw, wave_s);
    }
}
#endif

extern "C" void kernel_launch(void* const* d_in, const int* in_sizes, int n_in, void* d_out, int out_size, void* d_ws, size_t ws_size, hipStream_t stream) {
    static int grid = 0;
    if (grid == 0) {
        if (n_in != 21 || out_size != NTOK * 1024 || ws_size < WS_END) { fprintf(stderr, "kernel_launch: unexpected shapes: n_in %d out %d ws %zu (need %zu)\n", n_in, out_size, ws_size, (size_t)WS_END); grid = -1; return; }
        int dev = 0, cus = 0, per_cu = 0;
        (void)hipGetDevice(&dev); (void)hipDeviceGetAttribute(&cus, hipDeviceAttributeMultiprocessorCount, dev);
#if MK_SINGLE
        if (hipFuncSetAttribute((const void*)mk_fwd, hipFuncAttributeMaxDynamicSharedMemorySize, LDS_BYTES) != hipSuccess) { fprintf(stderr, "kernel_launch: hipFuncSetAttribute failed\n"); grid = -1; return; }
        if (hipOccupancyMaxActiveBlocksPerMultiprocessor(&per_cu, (const void*)mk_fwd, NWAVES * 64, LDS_BYTES) != hipSuccess || per_cu < 1) { fprintf(stderr, "kernel_launch: occupancy query says %d blocks per CU\n", per_cu); (void)hipGetLastError(); grid = -1; return; }
#endif
        (void)per_cu;
        grid = cus;
    }
    if (grid < 0) return;
    Args a{};
    for (int i = 0; i < 21; ++i) a.in[i] = (const float*)d_in[i];
    a.out = (float*)d_out; a.ws = (unsigned char*)d_ws;
#if MK_SINGLE
    (void)hipMemsetAsync((char*)d_ws + WS_CTL, 0, CTL_ZERO_BYTES, stream);
    a.ph_lo = 0; a.ph_hi = NPHASE;
    void* kargs[] = {&a};
    hipError_t e = hipLaunchCooperativeKernel((const void*)mk_fwd, dim3(grid), dim3(NWAVES * 64), kargs, LDS_BYTES, stream);
    if (e != hipSuccess) fprintf(stderr, "cooperative launch failed: %s (grid %d)\n", hipGetErrorString(e), grid);
#else
    (void)hipMemsetAsync((char*)d_ws + WS_CTL, 0, CTL_ZERO_BYTES, stream);
    launch_phase<10, 0>(a, 0, grid, stream); if (MK_DUP == 10) launch_phase<10, 0>(a, 0, grid, stream);
    launch_phase<12, 0>(a, 0, grid, stream);
    launch_layer<0>(a, 0, grid, stream);
    launch_layer<1>(a, 1, grid, stream);
    launch_layer<2>(a, 2, grid, stream);
    launch_layer<0>(a, 3, grid, stream);
#endif
}
```

```cpp
#include <hip/hip_runtime.h>
#include <hip/hip_cooperative_groups.h>
#include <cstdio>
#include <cstdint>
#include <cmath>
namespace pg8 {
#define PG8_LAS __attribute__((address_space(3)))
typedef unsigned short bf16_t;
typedef short bf16x8 __attribute__((ext_vector_type(8)));
typedef float f32x4 __attribute__((ext_vector_type(4)));
typedef unsigned u32x4 __attribute__((ext_vector_type(4)));
typedef int i32x4 __attribute__((ext_vector_type(4)));
constexpr int BM = 256, BK = 64, HALF = 128, HTB = HALF * BK * 2  , STAGE_BYTES = 8 * HTB, NXCD = 8, WGM = 8;

__host__ __device__ __forceinline__ int lds_byte(int r, int c) { const int st = (r >> 4) * 2 + (c >> 5), rr = r & 15, cc = c & 31, ob = rr * 64 + cc * 2; return st * 1024 + (ob ^ (((ob >> 9) & 1) << 5)); }
__host__ __device__ __forceinline__ void stage_rc(int b, int& R, int& C) { const int st = b / 1024, sb = b % 1024, swz = sb ^ (((sb >> 9) & 1) << 5); R = (st >> 1) * 16 + swz / 64; C = (st & 1) * 32 + (swz % 64) / 2; }
__host__ __device__ __forceinline__ int perm32(int rho) { const int n = rho >> 4, i = rho & 15; return 8 * (i >> 2) + 4 * n + (i & 3); }

struct Unit { int pm, pn; };
struct Gemm { const bf16_t* A; const bf16_t* Bt; int M, N, K; };

struct StaticOrder {
    int nM, nN, nwg, G, c;
    __host__ __device__ void init(int M, int N, int G_, int c_) { nM = M / BM; nN = N / BM; nwg = nM * nN; G = G_; c = c_; }
    __host__ __device__ bool next(int i, Unit& u) const {
        const long L = (long)i * G + c; if (L >= nwg) return false;
        int wgid = (int)L; { const int q = nwg / NXCD, r = nwg % NXCD, xcd = wgid % NXCD, off = wgid / NXCD; wgid = (xcd < r ? xcd * (q + 1) : r * (q + 1) + (xcd - r) * q) + off; }
        const int nig = WGM * nN, gid = wgid / nig, fm = gid * WGM, gsz = (nM - fm) < WGM ? (nM - fm) : WGM;
        u.pm = fm + ((wgid % nig) % gsz); u.pn = (wgid % nig) / gsz; return true;
    }
    __device__ __forceinline__ void a_ready(const Unit&) const {}
    __device__ __forceinline__ void done(const Unit&) const {}
};

__device__ __forceinline__ unsigned cvt_pk_bf16(float lo, float hi) { unsigned r; asm volatile("v_cvt_pk_bf16_f32 %0, %1, %2" : "=v"(r) : "v"(lo), "v"(hi)); return r; }
typedef float f32x2 __attribute__((ext_vector_type(2)));
__device__ __forceinline__ f32x2 gelu_pk(f32x2 v) {
    const f32x2 av = __builtin_elementwise_abs(v), d = av * 0.2316418882f + 1.0f;
    f32x2 t; t.x = __builtin_amdgcn_rcpf(d.x); t.y = __builtin_amdgcn_rcpf(d.y);
    f32x2 q = t * 0.5307027145f + (-0.7265760135f); q = q * t + 0.7107068705f; q = q * t + (-0.142248368f); q = q * t + 0.127414796f; q = q * t;
    const f32x2 s = (v * v) * (-0.72134752044f);
    f32x2 e; e.x = __builtin_amdgcn_exp2f(s.x); e.y = __builtin_amdgcn_exp2f(s.y);
    const f32x2 m = v * (q * e), r = v - m;
    f32x2 o; o.x = v.x < 0.f ? m.x : r.x; o.y = v.y < 0.f ? m.y : r.y; return o;
}
#ifndef EPI_AUX
#define EPI_AUX 16
#endif
template <bool F16  > struct EpiBf16R {
    typedef f32x4 acc_t;
    static constexpr bool PERM = true, AFTER_DRAIN = false;
    bf16_t* O; int ldc; int split_cols; size_t split_stride; const float* rs;
    __device__ __forceinline__ void operator()(const f32x4 (&acc)[2][2][4][2], const Unit& u, int wr, int wc, int fr, int fq) const {
        const int row0 = u.pm * BM + wr * 64 + fr; int colt = u.pn * BM; unsigned boff = 0u;
        if (split_cols) { const int t = colt / split_cols; boff = (unsigned)(t * split_stride * 2); colt -= t * split_cols; }
        const int col0 = colt + wc * 32 + 8 * fq;
        const __amdgpu_buffer_rsrc_t orsrc = __builtin_amdgcn_make_buffer_rsrc((void*)O, (short)0, 0x7ffffff0, 0x00020000);
#pragma unroll
        for (int ai = 0; ai < 2; ++ai)
#pragma unroll
            for (int m = 0; m < 4; ++m) { const int row = row0 + ai * HALF + m * 16; const unsigned roff = boff + (unsigned)(row * ldc + col0) * 2u;
                float sc = 1.f;
                if (rs) { const f32x4 a = *(const f32x4*)(rs + (size_t)row * 16), b = *(const f32x4*)(rs + (size_t)row * 16 + 4), c = *(const f32x4*)(rs + (size_t)row * 16 + 8), d = *(const f32x4*)(rs + (size_t)row * 16 + 12);
                    const float s = (((a[0] + a[1]) + (a[2] + a[3])) + ((b[0] + b[1]) + (b[2] + b[3]))) + (((c[0] + c[1]) + (c[2] + c[3])) + ((d[0] + d[1]) + (d[2] + d[3])));
                    sc = __builtin_amdgcn_rsqf(s * (1.0f / 1024.0f) + 1e-6f); }
#pragma unroll
                for (int bj = 0; bj < 2; ++bj) { const f32x4 v0 = acc[ai][bj][m][0] * sc, v1 = acc[ai][bj][m][1] * sc;
                    u32x4 w;
                    if (F16) { w.x = __builtin_bit_cast(unsigned, __builtin_amdgcn_cvt_pkrtz(v0[0], v0[1])); w.y = __builtin_bit_cast(unsigned, __builtin_amdgcn_cvt_pkrtz(v0[2], v0[3])); w.z = __builtin_bit_cast(unsigned, __builtin_amdgcn_cvt_pkrtz(v1[0], v1[1])); w.w = __builtin_bit_cast(unsigned, __builtin_amdgcn_cvt_pkrtz(v1[2], v1[3])); }
                    else { w.x = cvt_pk_bf16(v0[0], v0[1]); w.y = cvt_pk_bf16(v0[2], v0[3]); w.z = cvt_pk_bf16(v1[0], v1[1]); w.w = cvt_pk_bf16(v1[2], v1[3]); }
                    __builtin_amdgcn_raw_buffer_store_b128(w, orsrc, (int)(roff + bj * HALF * 2), 0, EPI_AUX); } }
    }
};
template <bool QKN> struct EpiI8 {
    typedef i32x4 acc_t;
    static constexpr bool PERM = true, AFTER_DRAIN = false;
    bf16_t* O; size_t split_stride; const float* sx; const float* sw; const float* gq; const float* gk; float c2;
    __device__ __forceinline__ void operator()(const i32x4 (&acc)[2][2][4][2], const Unit& u, int wr, int wc, int fr, int fq) const {
        const int row0 = u.pm * BM + wr * 64 + fr; int colt = u.pn * BM; unsigned boff;
        { const int t = colt / 1024; boff = (unsigned)(t * split_stride * 2); colt -= t * 1024; }
        const __amdgpu_buffer_rsrc_t orsrc = __builtin_amdgcn_make_buffer_rsrc((void*)O, (short)0, 0x7ffffff0, 0x00020000);
        const int scol0 = u.pn * BM + wc * 32 + 8 * fq;
        f32x4 cw[2][2];
#pragma unroll
        for (int bj = 0; bj < 2; ++bj) { cw[bj][0] = *(const f32x4*)(sw + scol0 + bj * HALF); cw[bj][1] = *(const f32x4*)(sw + scol0 + bj * HALF + 4); }
        if (QKN && u.pn < 8) {
            const float* g = u.pn < 4 ? gq : gk; const float cc = u.pn < 4 ? c2 : 1.f; const int lane = fr + 16 * fq;
            f32x4 gv[2][2];
#pragma unroll
            for (int bj = 0; bj < 2; ++bj) { gv[bj][0] = *(const f32x4*)(g + 32 * bj + 8 * fq) * cc; gv[bj][1] = *(const f32x4*)(g + 32 * bj + 8 * fq + 4) * cc; }
            const int col0 = colt + 64 * wc + 8 * fq;
#pragma unroll
            for (int ai = 0; ai < 2; ++ai)
#pragma unroll
                for (int m = 0; m < 4; ++m) { const int row = row0 + ai * HALF + m * 16; const unsigned roff = boff + (unsigned)(row * 1024 + col0) * 2u; const float rs = sx[row];
                    f32x4 v[2][2]; float ss = 0.f;
#pragma unroll
                    for (int bj = 0; bj < 2; ++bj) { const i32x4 a0 = acc[ai][bj][m][0], a1 = acc[ai][bj][m][1];
                        v[bj][0] = (f32x4){(float)a0[0], (float)a0[1], (float)a0[2], (float)a0[3]} * cw[bj][0] * rs; v[bj][1] = (f32x4){(float)a1[0], (float)a1[1], (float)a1[2], (float)a1[3]} * cw[bj][1] * rs;
                        ss += ((v[bj][0][0] * v[bj][0][0] + v[bj][0][1] * v[bj][0][1]) + (v[bj][0][2] * v[bj][0][2] + v[bj][0][3] * v[bj][0][3])) + ((v[bj][1][0] * v[bj][1][0] + v[bj][1][1] * v[bj][1][1]) + (v[bj][1][2] * v[bj][1][2] + v[bj][1][3] * v[bj][1][3])); }
                    ss += __builtin_bit_cast(float, __builtin_amdgcn_ds_bpermute((lane ^ 16) << 2, __builtin_bit_cast(int, ss)));
                    ss += __builtin_bit_cast(float, __builtin_amdgcn_ds_bpermute((lane ^ 32) << 2, __builtin_bit_cast(int, ss)));
                    const float r = __builtin_amdgcn_rsqf(ss * (1.f / 64.f) + 1e-6f);
#pragma unroll
                    for (int bj = 0; bj < 2; ++bj) { const f32x4 o0 = v[bj][0] * r * gv[bj][0], o1 = v[bj][1] * r * gv[bj][1];
                        u32x4 w; w.x = cvt_pk_bf16(o0[0], o0[1]); w.y = cvt_pk_bf16(o0[2], o0[3]); w.z = cvt_pk_bf16(o1[0], o1[1]); w.w = cvt_pk_bf16(o1[2], o1[3]);
                        __builtin_amdgcn_raw_buffer_store_b128(w, orsrc, (int)(roff + bj * 32 * 2), 0, EPI_AUX); } }
            return;
        }
        const int col0 = colt + wc * 32 + 8 * fq;
#pragma unroll
        for (int ai = 0; ai < 2; ++ai)
#pragma unroll
            for (int m = 0; m < 4; ++m) { const int row = row0 + ai * HALF + m * 16; const unsigned roff = boff + (unsigned)(row * 1024 + col0) * 2u; const float rs = sx[row];
#pragma unroll
                for (int bj = 0; bj < 2; ++bj) { const i32x4 a0 = acc[ai][bj][m][0], a1 = acc[ai][bj][m][1];
                    const f32x4 v0 = (f32x4){(float)a0[0], (float)a0[1], (float)a0[2], (float)a0[3]} * cw[bj][0] * rs, v1 = (f32x4){(float)a1[0], (float)a1[1], (float)a1[2], (float)a1[3]} * cw[bj][1] * rs;
                    u32x4 w; w.x = cvt_pk_bf16(v0[0], v0[1]); w.y = cvt_pk_bf16(v0[2], v0[3]); w.z = cvt_pk_bf16(v1[0], v1[1]); w.w = cvt_pk_bf16(v1[2], v1[3]);
                    __builtin_amdgcn_raw_buffer_store_b128(w, orsrc, (int)(roff + bj * HALF * 2), 0, EPI_AUX); } }
    }
};
template <bool BASE16> struct EpiResNorm {
    typedef f32x4 acc_t;
    static constexpr bool PERM = false, AFTER_DRAIN = false;
    const void* base; bf16_t* out; bf16_t* hg; const float* gain; float* rs;
    __device__ __forceinline__ void operator()(const f32x4 (&acc)[2][2][4][2], const Unit& u, int wr, int wc, int fr, int fq) const {
        const int col0 = u.pn * BM + wc * 32 + 4 * fq, lane = fr + 16 * fq;
        f32x4 gv[2][2];
#pragma unroll
        for (int bj = 0; bj < 2; ++bj)
#pragma unroll
            for (int n = 0; n < 2; ++n) gv[bj][n] = *(const f32x4*)(gain + col0 + bj * HALF + n * 16);
#pragma unroll
        for (int ai = 0; ai < 2; ++ai)
#pragma unroll
            for (int m = 0; m < 4; ++m) { const int r = ai * HALF + wr * 64 + m * 16 + fr; const size_t off = (size_t)(u.pm * BM + r) * 1024 + col0;
                float ss = 0.f;
#pragma unroll
                for (int bj = 0; bj < 2; ++bj)
#pragma unroll
                    for (int n = 0; n < 2; ++n) { typedef unsigned u32x2 __attribute__((ext_vector_type(2))); f32x4 b;
                        if (BASE16) { const u32x2 bw = *(const u32x2*)((const bf16_t*)base + off + bj * HALF + n * 16);
                            b = (f32x4){__builtin_bit_cast(float, bw.x << 16), __builtin_bit_cast(float, bw.x & 0xffff0000u), __builtin_bit_cast(float, bw.y << 16), __builtin_bit_cast(float, bw.y & 0xffff0000u)}; }
                        else b = *(const f32x4*)((const float*)base + off + bj * HALF + n * 16);
                        const f32x4 o = b + acc[ai][bj][m][n];
                        u32x2 wo; wo.x = cvt_pk_bf16(o[0], o[1]); wo.y = cvt_pk_bf16(o[2], o[3]); *(u32x2*)(out + off + bj * HALF + n * 16) = wo;
                        ss += (o[0] * o[0] + o[1] * o[1]) + (o[2] * o[2] + o[3] * o[3]);
                        const f32x4 h = o * gv[bj][n]; u32x2 w; w.x = cvt_pk_bf16(h[0], h[1]); w.y = cvt_pk_bf16(h[2], h[3]);
                        *(u32x2*)(hg + off + bj * HALF + n * 16) = w; }
                ss += __builtin_bit_cast(float, __builtin_amdgcn_ds_bpermute((lane ^ 16) << 2, __builtin_bit_cast(int, ss)));
                ss += __builtin_bit_cast(float, __builtin_amdgcn_ds_bpermute((lane ^ 32) << 2, __builtin_bit_cast(int, ss)));
                if (fq == 0) rs[(size_t)(u.pm * BM + r) * 16 + u.pn * 4 + wc] = ss; }
    }
};
__device__ __forceinline__ f32x4 mma16(bf16x8 a, bf16x8 b, f32x4 c) { return __builtin_amdgcn_mfma_f32_16x16x32_bf16(a, b, c, 0, 0, 0); }
__device__ __forceinline__ i32x4 mma16(bf16x8 a, bf16x8 b, i32x4 c) { return __builtin_amdgcn_mfma_i32_16x16x64_i8(__builtin_bit_cast(i32x4, a), __builtin_bit_cast(i32x4, b), c, 0, 0, 0); }
template <class Epi, class Sched, bool ALIGN_EPI = false, bool SP2 = false>
__device__ __forceinline__ void gemm_phase(PG8_LAS unsigned char* lds, const Gemm g, const Sched& S, const Epi& E, int tid_in) {
    int tid_ = tid_in; asm volatile("" : "+v"(tid_));
    const int tid = tid_, wid = __builtin_amdgcn_readfirstlane(tid >> 6), lane = tid & 63, wr = wid >> 2, wc = wid & 3, fr = lane & 15, fq = lane >> 4;
    const int K = g.K, nt = K / BK;
    unsigned voffA[2], voffB[2];
#pragma unroll
    for (int i = 0; i < 2; ++i) { int R, C; stage_rc(tid * 16 + i * 8192, R, C); const int Rb = Epi::PERM ? ((R & ~31) + perm32(R & 31)) : R;
        voffA[i] = (unsigned)(R * K + C) * 2u; voffB[i] = (unsigned)(Rb * K + C) * 2u; }
    const size_t kstep = (size_t)(BK * 2);
    const size_t hstep = (size_t)HALF * K * 2;
    const size_t tstep = 2 * hstep;
    const unsigned ldsw = (unsigned)wid * 1024u;
    const int aoff = lds_byte(wr * 64 + fr, fq * 8), boff = lds_byte(wc * 32 + fr, fq * 8);
#define PG8_SA(b, h) (((b) * 2 + (h)) * HTB)
#define PG8_SB(b, h) ((4 + (b) * 2 + (h)) * HTB)
#define PG8_STAGE(bufoff, gbase, voff) do { _Pragma("unroll") for (int _i = 0; _i < 2; ++_i) \
        __builtin_amdgcn_global_load_lds((const unsigned*)((const char*)(gbase) + (voff)[_i]), (PG8_LAS unsigned*)(lds + (bufoff) + ldsw + _i * 8192), 16, 0, 0); } while (0)
#define PG8_LDA(dst, b, h) do { _Pragma("unroll") for (int m = 0; m < 4; ++m) _Pragma("unroll") for (int k = 0; k < 2; ++k) dst[m][k] = *(const PG8_LAS bf16x8*)(lds + PG8_SA(b, h) + aoff + m * 2048 + k * 1024); } while (0)
#define PG8_LDB(dst, b, h) do { _Pragma("unroll") for (int n = 0; n < 2; ++n) _Pragma("unroll") for (int k = 0; k < 2; ++k) dst[n][k] = *(const PG8_LAS bf16x8*)(lds + PG8_SB(b, h) + boff + n * 2048 + k * 1024); } while (0)
#define PG8_MMA(ai, bj, At, Bt) do { __builtin_amdgcn_s_setprio(1); _Pragma("unroll") for (int m = 0; m < 4; ++m) _Pragma("unroll") for (int n = 0; n < 2; ++n) _Pragma("unroll") for (int k = 0; k < 2; ++k) \
        acc[ai][bj][m][n] = mma16(Bt[n][k], At[m][k], acc[ai][bj][m][n]); __builtin_amdgcn_s_setprio(0); } while (0)
#define PG8_WAIT_V(n) asm volatile("s_waitcnt vmcnt(" #n ")" ::: "memory")
#define PG8_WAIT_L(n) asm volatile("s_waitcnt lgkmcnt(" #n ")" ::: "memory")
#define PG8_BAR __builtin_amdgcn_s_barrier()
#define PG8_SCHED __builtin_amdgcn_sched_barrier(0)
    Unit cur, nxt; int ui = 0;
    if (!S.next(0, cur)) return;
    typedef typename Epi::acc_t acc_t;
    acc_t acc[2][2][4][2];
#pragma unroll
    for (int a = 0; a < 2; ++a)
#pragma unroll
        for (int b = 0; b < 2; ++b)
#pragma unroll
            for (int m = 0; m < 4; ++m)
#pragma unroll
                for (int n = 0; n < 2; ++n) acc[a][b][m][n] = (acc_t){0, 0, 0, 0};
    bf16x8 At[4][2], B0[2][2], B1[2][2];
    const char* cA = (const char*)g.A + (size_t)cur.pm * tstep; const char* cB = (const char*)g.Bt + (size_t)cur.pn * tstep;
    S.a_ready(cur);
    if constexpr (SP2) {
        PG8_STAGE(PG8_SB(0, 0), cB, voffB); PG8_STAGE(PG8_SB(0, 1), cB + hstep, voffB); PG8_STAGE(PG8_SA(0, 0), cA, voffA); PG8_STAGE(PG8_SA(0, 1), cA + hstep, voffA);
        if (wr == 1) PG8_BAR;
        PG8_WAIT_V(2); PG8_BAR;
        PG8_STAGE(PG8_SB(1, 0), cB + kstep, voffB); PG8_STAGE(PG8_SA(1, 0), cA + kstep, voffA); PG8_STAGE(PG8_SB(1, 1), cB + hstep + kstep, voffB);
        PG8_WAIT_V(6); PG8_BAR;
    } else {
        PG8_STAGE(PG8_SB(0, 0), cB, voffB); PG8_STAGE(PG8_SA(0, 0), cA, voffA); PG8_STAGE(PG8_SB(0, 1), cB + hstep, voffB); PG8_STAGE(PG8_SA(0, 1), cA + hstep, voffA);
        if (wr == 1) PG8_BAR;
        PG8_WAIT_V(4); PG8_BAR;
        PG8_STAGE(PG8_SB(1, 0), cB + kstep, voffB); PG8_STAGE(PG8_SA(1, 0), cA + kstep, voffA); PG8_STAGE(PG8_SB(1, 1), cB + hstep + kstep, voffB);
        PG8_WAIT_V(6); PG8_BAR;
    }
    for (;;) {
        const bool has_next = S.next(ui + 1, nxt);
        const char* nA = has_next ? (const char*)g.A + (size_t)nxt.pm * tstep : cA; const char* nB = has_next ? (const char*)g.Bt + (size_t)nxt.pn * tstep : cB;
        for (int t = 0; t < nt; t += 2) {
            const bool last = (t == nt - 2);
            const char* a1 = cA + (size_t)(t + 1) * kstep;
            const char* a2 = last ? nA : cA + (size_t)(t + 2) * kstep; const char* b2 = last ? nB : cB + (size_t)(t + 2) * kstep;
            const char* a3 = a2 + kstep; const char* b3 = b2 + kstep;
            if (last && has_next) S.a_ready(nxt);
            if constexpr (SP2) {
            PG8_LDB(B0, 0, 0); PG8_LDB(B1, 0, 1); PG8_SCHED; PG8_LDA(At, 0, 0); PG8_STAGE(PG8_SA(1, 1), a1 + hstep, voffA);
            PG8_WAIT_V(8); PG8_WAIT_L(0); PG8_BAR; PG8_MMA(0, 0, At, B0); PG8_MMA(0, 1, At, B1); PG8_BAR; PG8_SCHED;
            PG8_LDA(At, 0, 1); PG8_STAGE(PG8_SB(0, 0), b2, voffB); PG8_STAGE(PG8_SB(0, 1), b2 + hstep, voffB); PG8_STAGE(PG8_SA(0, 0), a2, voffA);
            PG8_WAIT_V(8); PG8_WAIT_L(0); PG8_BAR; PG8_MMA(1, 0, At, B0); PG8_MMA(1, 1, At, B1); PG8_BAR; PG8_SCHED;
            PG8_LDB(B0, 1, 0); PG8_LDB(B1, 1, 1); PG8_SCHED; PG8_LDA(At, 1, 0); PG8_STAGE(PG8_SA(0, 1), a2 + hstep, voffA);
            PG8_WAIT_V(8); PG8_WAIT_L(0); PG8_BAR; PG8_MMA(0, 0, At, B0); PG8_MMA(0, 1, At, B1); PG8_BAR; PG8_SCHED;
            PG8_LDA(At, 1, 1); PG8_STAGE(PG8_SB(1, 0), b3, voffB); PG8_STAGE(PG8_SB(1, 1), b3 + hstep, voffB); PG8_STAGE(PG8_SA(1, 0), a3, voffA);
            PG8_WAIT_V(8); PG8_WAIT_L(0); PG8_BAR; PG8_MMA(1, 0, At, B0); PG8_MMA(1, 1, At, B1); PG8_BAR; PG8_SCHED;
            } else {
            PG8_LDB(B0, 0, 0); PG8_SCHED; PG8_LDA(At, 0, 0); PG8_STAGE(PG8_SA(1, 1), a1 + hstep, voffA);
            PG8_WAIT_L(8); PG8_BAR; PG8_WAIT_L(0); PG8_MMA(0, 0, At, B0); PG8_BAR; PG8_SCHED;
            PG8_LDB(B1, 0, 1); PG8_STAGE(PG8_SB(0, 0), b2, voffB);
            PG8_BAR; PG8_WAIT_L(0); PG8_MMA(0, 1, At, B1); PG8_BAR;
            PG8_LDA(At, 0, 1); PG8_STAGE(PG8_SA(0, 0), a2, voffA);
            PG8_BAR; PG8_WAIT_L(0); PG8_MMA(1, 0, At, B0); PG8_BAR; PG8_SCHED;
            PG8_STAGE(PG8_SB(0, 1), b2 + hstep, voffB);
            PG8_WAIT_V(6); PG8_BAR; PG8_MMA(1, 1, At, B1); PG8_BAR;
            PG8_LDB(B0, 1, 0); PG8_SCHED; PG8_LDA(At, 1, 0); PG8_STAGE(PG8_SA(0, 1), a2 + hstep, voffA);
            PG8_WAIT_L(8); PG8_BAR; PG8_WAIT_L(0); PG8_MMA(0, 0, At, B0); PG8_BAR; PG8_SCHED;
            PG8_LDB(B1, 1, 1); PG8_STAGE(PG8_SB(1, 0), b3, voffB);
            PG8_BAR; PG8_WAIT_L(0); PG8_MMA(0, 1, At, B1); PG8_BAR;
            PG8_LDA(At, 1, 1); PG8_STAGE(PG8_SA(1, 0), a3, voffA);
            PG8_BAR; PG8_WAIT_L(0); PG8_MMA(1, 0, At, B0); PG8_BAR; PG8_SCHED;
            PG8_STAGE(PG8_SB(1, 1), b3 + hstep, voffB);
            PG8_WAIT_V(6); PG8_BAR; PG8_MMA(1, 1, At, B1); PG8_BAR;
            }
        }
        if constexpr (ALIGN_EPI) { if (wr == 0) PG8_BAR; }
        if constexpr (!Epi::AFTER_DRAIN) { E(acc, cur, wr, wc, fr, fq); S.done(cur); }
        if (!has_next) break;
#pragma unroll
        for (int a = 0; a < 2; ++a)
#pragma unroll
            for (int b = 0; b < 2; ++b)
#pragma unroll
                for (int m = 0; m < 4; ++m)
#pragma unroll
                    for (int n = 0; n < 2; ++n) acc[a][b][m][n] = (acc_t){0, 0, 0, 0};
        cur = nxt; cA = nA; cB = nB; ++ui;
        if constexpr (ALIGN_EPI) { if (wr == 1) PG8_BAR; }
    }
    PG8_WAIT_V(0);
    if constexpr (!ALIGN_EPI) { if (wr == 0) PG8_BAR; }
    PG8_BAR;
    if constexpr (Epi::AFTER_DRAIN) { E.fused(acc, cur, wr, wc, fr, fq, lds, wid, lane); S.done(cur); }
#undef PG8_SA
#undef PG8_SB
#undef PG8_STAGE
#undef PG8_LDA
#undef PG8_LDB
#undef PG8_MMA
#undef PG8_WAIT_V
#undef PG8_WAIT_L
#undef PG8_BAR
#undef PG8_SCHED
}
}
#include <hip/hip_bf16.h>
#include <cmath>
namespace attn_body {
using bf16=__hip_bfloat16;
using bf16x8=__attribute__((ext_vector_type(8)))short;
using s16x4=__attribute__((ext_vector_type(4)))short;
using f32x16=__attribute__((ext_vector_type(16)))float;
using u32x4=__attribute__((ext_vector_type(4)))unsigned;
constexpr int BATCH=8,NHEAD=16,SEQ=2048,D=64,DM=NHEAD*D;
constexpr int NW=8,QBLK=32,QB=QBLK*NW,KVBLK=64,NQB=SEQ/QB;
constexpr int ATTN_PITCH=DM, ATTN_UNIT_ROWS=QB;
__device__ __forceinline__ int crow(int r,int hi){return (r&3)+8*(r>>2)+4*hi;}
#define SBAR() __builtin_amdgcn_sched_barrier(0)
__device__ __forceinline__ void cmask(f32x16&p0,f32x16&p1,int jb,int qrel,int hi){
  const float NEG=-INFINITY; int kb=64*jb+4*hi;
  #pragma unroll
  for(int r=0;r<16;++r){int kv=kb+(r&3)+8*(r>>2); if(kv>qrel)p0[r]=NEG; if(kv+32>qrel)p1[r]=NEG;}
}

constexpr int NSLOT=3, SLOTB=8192;
constexpr int LDS_K=0, LDS_V=NSLOT*SLOTB, LDS_WS=2*NSLOT*SLOTB, LDS_OST=LDS_WS+NW*64*4, LDS_CS=LDS_OST+NW*4096, LDS_BYTES=LDS_CS+SEQ*4;
constexpr float C2=0.125f*1.4426950408889634f;
__device__ __forceinline__ void glds16(const void*gsrc,unsigned lds_dst){unsigned keep;
  asm volatile("s_mov_b32 %0, m0\n\ts_mov_b32 m0, %2\n\ts_nop 0\n\tglobal_load_lds_dwordx4 %1, off\n\ts_mov_b32 m0, %0":"=&s"(keep):"v"(gsrc),"s"(lds_dst):"memory");}
__device__ __forceinline__ float max3f(float a,float b,float c){float r;asm("v_max3_f32 %0, %1, %2, %3":"=v"(r):"v"(a),"v"(b),"v"(c));return r;}
__device__ __forceinline__ float max2f(float a,float b){float r;asm("v_max_f32_e32 %0, %1, %2":"=v"(r):"v"(a),"v"(b));return r;}
__device__ __forceinline__ float fadd_s(float a,float b){float r;asm("v_add_f32_e32 %0, %1, %2":"=v"(r):"v"(a),"v"(b));return r;}
__device__ __forceinline__ float fsub_s(float a,float b){float r;asm("v_sub_f32_e32 %0, %1, %2":"=v"(r):"v"(a),"v"(b));return r;}
typedef float f32x2_t __attribute__((ext_vector_type(2))); typedef __bf16 bf16x2_t __attribute__((ext_vector_type(2)));
__device__ __forceinline__ unsigned cvtpk_s(float lo,float hi){f32x2_t v={lo,hi};bf16x2_t b=__builtin_convertvector(v,bf16x2_t);return __builtin_bit_cast(unsigned,b);}
#define WAIT_BAR(N) asm volatile("s_waitcnt vmcnt(" #N ") lgkmcnt(0)\n\ts_barrier":::"memory")

typedef __attribute__((address_space(3))) const char* lds_cptr;
__device__ __forceinline__ void qkt(f32x16&p0,f32x16&p1,const char*Kslot,lds_cptr qls,bf16x8 ax0,bf16x8 ax1,bf16x8 qx,int r32,int hi){
  const char*kb=Kslot+hi*1024+r32*16; const f32x16 z16=f32x16{};
  p0=__builtin_amdgcn_mfma_f32_32x32x16_bf16(ax0,qx,z16,0,0,0);p1=__builtin_amdgcn_mfma_f32_32x32x16_bf16(ax1,qx,z16,0,0,0);
  #pragma unroll
  for(int d0=0;d0<4;++d0){
    const bf16x8 b0=*reinterpret_cast<const bf16x8*>(kb+d0*2048);
    const bf16x8 b1=*reinterpret_cast<const bf16x8*>(kb+d0*2048+512);
    const bf16x8 qd=*(const __attribute__((address_space(3))) bf16x8*)(qls+d0*1024);
    p0=__builtin_amdgcn_mfma_f32_32x32x16_bf16(b0,qd,p0,0,0,0);p1=__builtin_amdgcn_mfma_f32_32x32x16_bf16(b1,qd,p1,0,0,0);}
}
typedef short v4i16_t __attribute__((ext_vector_type(4)));
__device__ __forceinline__ void kload8(bf16x8*kf,lds_cptr kp){
  kf[0]=*(const __attribute__((address_space(3))) bf16x8*)(kp);      kf[1]=*(const __attribute__((address_space(3))) bf16x8*)(kp+512);
  kf[2]=*(const __attribute__((address_space(3))) bf16x8*)(kp+2048); kf[3]=*(const __attribute__((address_space(3))) bf16x8*)(kp+2560);
  kf[4]=*(const __attribute__((address_space(3))) bf16x8*)(kp+4096); kf[5]=*(const __attribute__((address_space(3))) bf16x8*)(kp+4608);
  kf[6]=*(const __attribute__((address_space(3))) bf16x8*)(kp+6144); kf[7]=*(const __attribute__((address_space(3))) bf16x8*)(kp+6656);
}
__device__ __forceinline__ void kload2(bf16x8*kf,lds_cptr kp,int j){ kf[2*j]=*(const __attribute__((address_space(3))) bf16x8*)(kp+j*2048); kf[2*j+1]=*(const __attribute__((address_space(3))) bf16x8*)(kp+j*2048+512); }
__device__ __forceinline__ s16x4 vtr(lds_cptr p){ return __builtin_bit_cast(s16x4,__builtin_amdgcn_ds_read_tr16_b64_v4i16((__attribute__((address_space(3))) v4i16_t*)p)); }
__device__ __forceinline__ float rowmax(const f32x16&p0,const f32x16&p1){
  float a=max3f(p0[0],p0[1],p1[0]),b=max3f(p0[2],p0[3],p1[1]);a=max3f(a,p1[2],p1[3]);
  #pragma unroll
  for(int r=4;r<16;r+=4){a=max3f(a,p0[r],p0[r+1]);b=max3f(b,p0[r+2],p0[r+3]);a=max3f(a,p1[r],p1[r+1]);b=max3f(b,p1[r+2],p1[r+3]);}
  const float m=max2f(a,b);
  auto rr=__builtin_amdgcn_permlane32_swap(__float_as_uint(m),__float_as_uint(m),false,false);
  return max2f(__uint_as_float(rr[0]),__uint_as_float(rr[1]));
}
__device__ __forceinline__ void pv(f32x16*o,int vb,bf16x8 pa0,bf16x8 pa1,bf16x8 pa2,bf16x8 pa3){
  #pragma unroll
  for(int d0=0;d0<2;++d0){s16x4 lo[4],hi[4];
    #pragma unroll
    for(int ks=0;ks<4;++ks){
      asm volatile("ds_read_b64_tr_b16 %0,%1 offset:%c2":"=&v"(lo[ks]):"v"(vb),"i"(d0*4096+ks*1024):"memory");
      asm volatile("ds_read_b64_tr_b16 %0,%1 offset:%c2":"=&v"(hi[ks]):"v"(vb),"i"(d0*4096+ks*1024+512):"memory");}
    asm volatile("s_waitcnt lgkmcnt(0)":::"memory");SBAR();
    #define PK(k) (bf16x8){lo[k][0],lo[k][1],lo[k][2],lo[k][3],hi[k][0],hi[k][1],hi[k][2],hi[k][3]}
    o[d0]=__builtin_amdgcn_mfma_f32_32x32x16_bf16(pa0,PK(0),o[d0],0,0,0);
    o[d0]=__builtin_amdgcn_mfma_f32_32x32x16_bf16(pa1,PK(1),o[d0],0,0,0);
    o[d0]=__builtin_amdgcn_mfma_f32_32x32x16_bf16(pa2,PK(2),o[d0],0,0,0);
    o[d0]=__builtin_amdgcn_mfma_f32_32x32x16_bf16(pa3,PK(3),o[d0],0,0,0);
    #undef PK
  }
}

__device__ __forceinline__ void split3(float c,unsigned&hb,unsigned&mb,unsigned&lb){
  hb=__float_as_uint(c)&0xffff0000u; const float r1=c-__uint_as_float(hb); mb=__float_as_uint(r1)&0xffff0000u; const float r2=r1-__uint_as_float(mb); lb=__float_as_uint(r2)&0xffff0000u; }
__device__ __forceinline__ bf16x8 make_ax(float negc){ unsigned hb,mb,lb; split3(negc,hb,mb,lb);
  u32x4 w; w.x=(hb>>16)|mb; w.y=(lb>>16)|0x3f800000u; w.z=0x3f803f80u; w.w=0u; return __builtin_bit_cast(bf16x8,w); }
__device__ __forceinline__ bf16x8 make_qx(float negm,unsigned hm){ unsigned hb,mb,lb; split3(negm,hb,mb,lb);
  u32x4 w; w.x=0x3f803f80u&hm; w.y=(0x3f80u|hb)&hm; w.z=((mb>>16)|lb)&hm; w.w=0u; return __builtin_bit_cast(bf16x8,w); }
#ifndef ATTN_STORE16
#define ATTN_STORE16(p,v) (*(u32x4*)(p)=(v))
#endif
template<int THRL> __device__ __forceinline__ void attn_unit(int b,int h,int qb,const bf16*Q,const bf16*__restrict__ K,const bf16*__restrict__ V,bf16*O,const bf16*__restrict__ Gt,char*shm,const int tid_u,const float skip_thr){
  int tid=tid_u; asm volatile("":"+v"(tid));
  const int lane=tid&63,r32=lane&31,hi=lane>>5; const int wid=__builtin_amdgcn_readfirstlane(tid>>6);
  const long rowbase=(long)b*SEQ; const int q0=qb*QB;
  const bf16*Qw=Q+(rowbase+q0+wid*QBLK)*DM+h*D;
  float*csp=(float*)(shm+LDS_CS);
  int tskip=0;
  { const float cq0=csp[q0]; const int ntall=(q0+QB)/KVBLK; while(tskip+2<=ntall-4 && csp[KVBLK*(tskip+1)+KVBLK-1]-cq0<skip_thr)tskip+=2; tskip=__builtin_amdgcn_readfirstlane(tskip); }
  const bf16*Kh=K+(rowbase+(long)tskip*KVBLK)*DM+h*D,*Vh=V+(rowbase+(long)tskip*KVBLK)*DM+h*D;
  const unsigned lds0=(unsigned)(uintptr_t)shm;
  float*wsf=(float*)(shm+LDS_WS)+wid*64;
  const unsigned koff=(unsigned)(lane*DM+wid*8), voff=(unsigned)((16*(wid&3)+(lane>>2))*DM+(wid>>2)*32+(lane&3)*8);
  const unsigned kdst=lds0+LDS_K+wid*1024, vdst=lds0+LDS_V+wid*1024;
  #define DMA_K(t,slot) do{unsigned o_=koff;asm volatile("":"+v"(o_));glds16(Kh+(long)(t)*KVBLK*DM+o_,(unsigned)__builtin_amdgcn_readfirstlane(kdst+(slot)));}while(0)
  #define DMA_V(t,slot) do{unsigned o_=voff;asm volatile("":"+v"(o_));glds16(Vh+(long)(t)*KVBLK*DM+o_,(unsigned)__builtin_amdgcn_readfirstlane(vdst+(slot)));}while(0)
  const int vb0=(int)(lds0+LDS_V)+((lane>>4)&1)*32+(lane&3)*8+(4*hi+((lane&15)>>2))*64;
  const char*Kbase=shm+LDS_K; bf16x8 kf[8];
  const lds_cptr shm3=(lds_cptr)shm; const lds_cptr kp0=shm3+LDS_K+hi*1024+r32*16; const lds_cptr vp0=shm3+LDS_V+((lane>>4)&1)*32+(lane&3)*8+(4*hi+((lane&15)>>2))*64;
  const int NT=(q0+QB)/KVBLK-tskip;
  const float*cst=csp+tskip*KVBLK;
  const unsigned hm=hi?0u:0xffffffffu;
  DMA_K(0,0);DMA_V(0,0);DMA_K(1,SLOTB);
  const lds_cptr qls=shm3+LDS_OST+wid*4096+hi*512+r32*16;
  { bf16x8 qr[4];
    #pragma unroll
    for(int d0=0;d0<4;++d0)qr[d0]=*reinterpret_cast<const bf16x8*>(&Qw[(long)r32*DM+d0*16+hi*8]);
    #pragma unroll
    for(int d0=0;d0<4;++d0)*(__attribute__((address_space(3))) bf16x8*)(shm3+LDS_OST+wid*4096+hi*512+r32*16+d0*1024)=qr[d0]; }
  #define QLD(k) (*(const __attribute__((address_space(3))) bf16x8*)(qls+(k)*1024))
  float mhat=csp[q0+wid*QBLK+r32],l_reg=0.f;f32x16 o[2];o[0]=f32x16{};o[1]=f32x16{}; bf16x8 qx=make_qx(-mhat,hm);
  const int qrel=wid*QBLK+r32;
  #define CMASK(P0,P1,t) do{int jb_=(t)-(NT-4); if(jb_>=0)cmask(P0,P1,jb_,qrel,hi);}while(0)
  bool resc=false;
  #define START(P0,P1) do{ const float rm=rowmax(P0,P1); resc=false; \
    if(__any(rm>(float)THRL)){ const float dl=__builtin_fmaxf(rm,0.f); mhat=fadd_s(mhat,dl); \
      _Pragma("unroll") for(int r=0;r<16;++r){P0[r]=fsub_s(P0[r],dl);P1[r]=fsub_s(P1[r],dl);} \
      qx=make_qx(-mhat,hm); } \
    _Pragma("unroll") for(int r=0;r<16;++r)P0[r]=__builtin_amdgcn_exp2f(P0[r]); }while(0)
  #define RESC() do{ if(resc){ asm volatile("s_waitcnt lgkmcnt(0)":::"memory"); \
      _Pragma("unroll") for(int d_=0;d_<2;++d_) _Pragma("unroll") for(int r=0;r<16;++r)o[d_][r]*=wsf[crow(r,hi)]; } }while(0)
  f32x16 pA0,pA1,pB0,pB1;
  int sl_prev=0,sl_cur=0,sl_next=SLOTB;
  #define ROT() do{sl_prev=sl_cur;sl_cur=sl_next;sl_next=(sl_next==(NSLOT-1)*SLOTB)?0:sl_next+SLOTB;}while(0)
  DMA_K(2,2*SLOTB);
  WAIT_BAR(3);
  qkt(pA0,pA1,Kbase,qls,make_ax(cst[r32]),make_ax(cst[32+r32]),qx,r32,hi);asm volatile("s_nop 15\n\ts_nop 7":"+v"(pA0),"+v"(pA1));CMASK(pA0,pA1,0);
  START(pA0,pA1);
  _Pragma("unroll") for(int r=0;r<16;++r)pA1[r]=__builtin_amdgcn_exp2f(pA1[r]);
  WAIT_BAR(0);
  DMA_K(3,0);DMA_V(1,SLOTB);
  ROT();
  kload8(kf,kp0+sl_cur);
  WAIT_BAR(2);
  s16x4 vlo[8],vhi[8]; u32x4 pw0,pw1,pw2,pw3;
  #define PKW(P,B) cvtpk_s(P[B],P[B+1])
  #define PAF(k) __builtin_bit_cast(bf16x8,pw##k)
  #define VFR(i) (bf16x8){vlo[i][0],vlo[i][1],vlo[i][2],vlo[i][3],vhi[i][0],vhi[i][1],vhi[i][2],vhi[i][3]}
  #define PIN(x) asm volatile("":"+v"(x))
  #define MX3(a,b,c) __builtin_fmaxf(__builtin_fmaxf((a),(b)),(c))
  #define GAPA(MF,A0,A1,A2,A3,W0,W1,PW) do{ MF; sacc+=A0; sacc+=A1; sacc+=A2; sacc+=A3; PIN(sacc); W0; W1; PIN(PW); SBAR(); }while(0)
  #define EX(v) __builtin_amdgcn_exp2f(v)
  #define GAPB(MF,X,B) do{ MF; X[B]=EX(X[B]); X[B+1]=EX(X[B+1]); X[B+2]=EX(X[B+2]); X[B+3]=EX(X[B+3]); PIN(X); SBAR(); }while(0)
  #define VRD(i) do{ vlo[i]=vtr(vp_+(((i)>>2)*4096+((i)&3)*1024)); vhi[i]=vtr(vp_+(((i)>>2)*4096+((i)&3)*1024+512)); }while(0)
  #define KRD(G,j) do{ if(G){ kload2(kf,kp0+sl_next,j); SBAR(); } }while(0)
  #define STEP(C0,C1,P0,P1,t,GK,GV,GL) do{ SBAR(); \
    const lds_cptr vp_=vp0+sl_prev; \
    const bf16x8 ax0_=make_ax(cst[(t)*KVBLK+r32]), ax1_=make_ax(cst[(t)*KVBLK+32+r32]); \
    C0=__builtin_amdgcn_mfma_f32_32x32x16_bf16(ax0_,qx,f32x16{},0,0,0); C1=__builtin_amdgcn_mfma_f32_32x32x16_bf16(ax1_,qx,f32x16{},0,0,0); SBAR(); \
    bf16x8 q0_=QLD(0), q1_=QLD(1); \
    VRD(0); SBAR(); float sacc=(P0[0]+P0[1]); \
    GAPA(C0=__builtin_amdgcn_mfma_f32_32x32x16_bf16(kf[0],q0_,C0,0,0,0), P0[2],P0[3],P0[4],P0[5],     pw0[0]=PKW(P0,0), pw0[1]=PKW(P0,2), pw0); \
    VRD(4); SBAR(); GAPA(C1=__builtin_amdgcn_mfma_f32_32x32x16_bf16(kf[1],q0_,C1,0,0,0), P0[6],P0[7],P0[8],P0[9],     pw0[2]=PKW(P0,4), pw0[3]=PKW(P0,6), pw0); q0_=QLD(2); \
    VRD(1); SBAR(); GAPA(C0=__builtin_amdgcn_mfma_f32_32x32x16_bf16(kf[2],q1_,C0,0,0,0),   P0[10],P0[11],P0[12],P0[13], pw1[0]=PKW(P0,8), pw1[1]=PKW(P0,10), pw1); \
    VRD(5); SBAR(); GAPA(C1=__builtin_amdgcn_mfma_f32_32x32x16_bf16(kf[3],q1_,C1,0,0,0),   P0[14],P0[15],P1[0],P1[1],   pw1[2]=PKW(P0,12),pw1[3]=PKW(P0,14), pw1); q1_=QLD(3); \
    VRD(2); SBAR(); GAPA(C0=__builtin_amdgcn_mfma_f32_32x32x16_bf16(kf[4],q0_,C0,0,0,0),   P1[2],P1[3],P1[4],P1[5],     pw2[0]=PKW(P1,0), pw2[1]=PKW(P1,2), pw2); \
    VRD(6); SBAR(); GAPA(C1=__builtin_amdgcn_mfma_f32_32x32x16_bf16(kf[5],q0_,C1,0,0,0),   P1[6],P1[7],P1[8],P1[9],     pw2[2]=PKW(P1,4), pw2[3]=PKW(P1,6), pw2); \
    VRD(3); SBAR(); GAPA(C0=__builtin_amdgcn_mfma_f32_32x32x16_bf16(kf[6],q1_,C0,0,0,0),   P1[10],P1[11],P1[12],P1[13], pw3[0]=PKW(P1,8), pw3[1]=PKW(P1,10), pw3); \
    VRD(7); SBAR(); GAPA(C1=__builtin_amdgcn_mfma_f32_32x32x16_bf16(kf[7],q1_,C1,0,0,0),   P1[14],P1[15],0.f,0.f,       pw3[2]=PKW(P1,12),pw3[3]=PKW(P1,14), pw3); \
    l_reg+=sacc; \
    if(GK){DMA_K((t)+3,sl_cur);} if(GV){DMA_V((t)+1,sl_next);} \
    CMASK(C0,C1,t); \
    { float a=MX3(C0[0],C0[1],C1[0]),b=MX3(C0[2],C0[3],C1[1]); a=MX3(a,C1[2],C1[3]); \
      _Pragma("unroll") for(int r=4;r<16;r+=4){a=MX3(a,C0[r],C0[r+1]);b=MX3(b,C0[r+2],C0[r+3]);a=MX3(a,C1[r],C1[r+1]);b=MX3(b,C1[r+2],C1[r+3]);} \
      float rm=__builtin_fmaxf(a,b); { auto rr=__builtin_amdgcn_permlane32_swap(__float_as_uint(rm),__float_as_uint(rm),false,false); rm=__builtin_fmaxf(__uint_as_float(rr[0]),__uint_as_float(rr[1])); } \
      resc=false; \
      if(__builtin_expect(__any(rm>(float)THRL),0)){ const float dl=__builtin_fmaxf(rm,0.f); mhat+=dl; \
        _Pragma("unroll") for(int r=0;r<16;++r){C0[r]-=dl;C1[r]-=dl;} \
        qx=make_qx(-mhat,hm); \
        const float f=__builtin_amdgcn_exp2f(-dl); l_reg*=f; if(hi==0)wsf[r32]=f; resc=true; } } \
    SBAR(); \
    GAPB(o[0]=__builtin_amdgcn_mfma_f32_32x32x16_bf16(PAF(0),VFR(0),o[0],0,0,0), C0,0); \
    GAPB(o[1]=__builtin_amdgcn_mfma_f32_32x32x16_bf16(PAF(0),VFR(4),o[1],0,0,0), C0,4); \
    KRD(GL,0); GAPB(o[0]=__builtin_amdgcn_mfma_f32_32x32x16_bf16(PAF(1),VFR(1),o[0],0,0,0), C0,8); \
    KRD(GL,1); GAPB(o[1]=__builtin_amdgcn_mfma_f32_32x32x16_bf16(PAF(1),VFR(5),o[1],0,0,0), C0,12); \
    KRD(GL,2); GAPB(o[0]=__builtin_amdgcn_mfma_f32_32x32x16_bf16(PAF(2),VFR(2),o[0],0,0,0), C1,0); \
    KRD(GL,3); GAPB(o[1]=__builtin_amdgcn_mfma_f32_32x32x16_bf16(PAF(2),VFR(6),o[1],0,0,0), C1,4); \
    GAPB(o[0]=__builtin_amdgcn_mfma_f32_32x32x16_bf16(PAF(3),VFR(3),o[0],0,0,0), C1,8); \
    GAPB(o[1]=__builtin_amdgcn_mfma_f32_32x32x16_bf16(PAF(3),VFR(7),o[1],0,0,0), C1,12); \
    }while(0)
  int t=1;
  #undef CMASK
  #define CMASK(P0,P1,t) do{}while(0)
  for(;t+5<NT;t+=2){
    STEP(pB0,pB1,pA0,pA1,t,true,true,true);     WAIT_BAR(2); RESC(); ROT();
    STEP(pA0,pA1,pB0,pB1,t+1,true,true,true);   WAIT_BAR(2); RESC(); ROT();
  }
  #undef CMASK
  #define CMASK(P0,P1,t) do{int jb_=(t)-(NT-4); if(jb_>=0)cmask(P0,P1,jb_,qrel,hi);}while(0)
  #define ENDW(tt) do{ if((tt)+3<NT){WAIT_BAR(2);} else if((tt)+2<NT){WAIT_BAR(1);} else {WAIT_BAR(0);} }while(0)
  for(;t+1<NT;t+=2){
    STEP(pB0,pB1,pA0,pA1,t,(t+3<NT),(t+1<NT),(t+1<NT));       ENDW(t);   RESC(); ROT();
    STEP(pA0,pA1,pB0,pB1,t+1,(t+4<NT),(t+2<NT),(t+2<NT));     ENDW(t+1); RESC(); ROT();
  }
  STEP(pB0,pB1,pA0,pA1,NT-1,false,false,false); RESC();
  { float sacc=pB0[0]+pB0[1]; _Pragma("unroll") for(int r=2;r<16;++r)sacc+=pB0[r]; _Pragma("unroll") for(int r=0;r<16;++r)sacc+=pB1[r]; l_reg+=sacc;
    pw0=(u32x4){PKW(pB0,0),PKW(pB0,2),PKW(pB0,4),PKW(pB0,6)};pw1=(u32x4){PKW(pB0,8),PKW(pB0,10),PKW(pB0,12),PKW(pB0,14)};pw2=(u32x4){PKW(pB1,0),PKW(pB1,2),PKW(pB1,4),PKW(pB1,6)};pw3=(u32x4){PKW(pB1,8),PKW(pB1,10),PKW(pB1,12),PKW(pB1,14)};
    SBAR(); pv(o,vb0+sl_cur,PAF(0),PAF(1),PAF(2),PAF(3)); }
  #undef PKW
  #undef PAF
  #undef VFR
  #undef PIN
  #undef MX3
  #undef GAPA
  #undef GAPB
  #undef EX
  #undef VRD
  #undef KRD
  #undef STEP
  #undef ENDW
  {auto rr=__builtin_amdgcn_permlane32_swap(__float_as_uint(l_reg),__float_as_uint(l_reg),false,false);l_reg=__uint_as_float(rr[0])+__uint_as_float(rr[1]);}
  { int te=tid; asm volatile("":"+v"(te));
    const int lane_e=te&63,r32e=lane_e&31,hie=lane_e>>5;
    if(hie==0)wsf[32+r32e]=l_reg;asm volatile("s_waitcnt lgkmcnt(0)":::"memory");
    float rli[16];
    #pragma unroll
    for(int r=0;r<16;++r)rli[r]=__builtin_amdgcn_rcpf(wsf[32+crow(r,hie)]);
    bf16*Ow=O+(rowbase+q0+wid*QBLK)*DM+h*D; const bf16*Gw=Gt+(rowbase+q0+wid*QBLK)*DM+h*D;
    bf16*stg=(bf16*)(shm+LDS_OST)+wid*2048;
    #pragma unroll
    for(int r=0;r<16;++r){const int orow=crow(r,hie);
      #pragma unroll
      for(int d0=0;d0<2;++d0)stg[orow*64+d0*32+r32e]=__float2bfloat16(o[d0][r]*rli[r]);}
    asm volatile("s_waitcnt lgkmcnt(0)":::"memory");
    #pragma unroll
    for(int i=0;i<4;++i){const int row=i*8+(lane_e>>3),ch=lane_e&7; u32x4 v=*(const u32x4*)(stg+row*64+ch*8); const u32x4 gv=*(const u32x4*)(Gw+(long)row*DM+ch*8);
      #pragma unroll
      for(int e=0;e<4;++e){ const float g0=__uint_as_float(gv[e]<<16),g1=__uint_as_float(gv[e]&0xffff0000u),x0=__uint_as_float(v[e]<<16),x1=__uint_as_float(v[e]&0xffff0000u);
        v[e]=cvtpk_s(x0*__builtin_amdgcn_rcpf(1.f+__expf(-g0)),x1*__builtin_amdgcn_rcpf(1.f+__expf(-g1))); }
      ATTN_STORE16(Ow+(long)row*DM+ch*8,v);} }
  asm volatile("s_waitcnt lgkmcnt(0)\n\ts_barrier":::"memory");
  #undef DMA_K
  #undef QLD
  #undef DMA_V
  #undef CMASK
  #undef START
  #undef RESC
  #undef ROT
}
constexpr int ATTN_LDS_BYTES=LDS_BYTES;
struct AttnTensors { const bf16* Q; const bf16* K; const bf16* V; bf16* O; const bf16* G; const float* CUM; float THR; };
struct AttnUnit { int bh; int qb; };
struct StaticOrder {
  int vcu;
  __device__ __forceinline__ explicit StaticOrder(int grid,int block):vcu((block%8)*(grid/8)+block/8){}
  __device__ __forceinline__ bool next(int i,AttnUnit&u)const{ if(i>=4)return false; const int s=2*(vcu&1)+(i>>1); u.bh=vcu>>1; u.qb=(i&1)?7-s:s; return true; }
  __device__ __forceinline__ void a_ready(const AttnUnit&)const{}
  __device__ __forceinline__ void done(const AttnUnit&)const{}
};
template<class Sched,int THRL=8> __device__ __forceinline__ void attn_phase(char*lds,const AttnTensors&T,const Sched&S,int tid_in){
  AttnUnit u; int tid_=tid_in; asm volatile("":"+v"(tid_));
  if(S.next(0,u)){ float*csp=(float*)(lds+LDS_CS); float*wt=(float*)(lds+LDS_WS); int tp=tid_in; asm volatile("":"+v"(tp));
    const float*lf=T.CUM+((long)(u.bh/NHEAD)*SEQ+4*tp)*NHEAD+u.bh%NHEAD;
    const float a0=lf[0],a1=a0+lf[NHEAD],a2=a1+lf[2*NHEAD],a3=a2+lf[3*NHEAD];
    float sc=a3; const int ln=tp&63;
    #pragma unroll
    for(int o=1;o<64;o<<=1){ const float up=__builtin_bit_cast(float,__builtin_amdgcn_ds_bpermute((ln-o)<<2,__builtin_bit_cast(int,sc))); if(ln>=o)sc+=up; }
    if(ln==63)wt[tp>>6]=sc;
    __syncthreads();
    float base=sc-a3;
    #pragma unroll
    for(int w=0;w<NW-1;++w)if(w<(tp>>6))base+=wt[w];
    const float k2=-1.4426950408889634f;
    csp[4*tp]=k2*(base+a0);csp[4*tp+1]=k2*(base+a1);csp[4*tp+2]=k2*(base+a2);csp[4*tp+3]=k2*(base+a3);
    __syncthreads(); }
  for(int i=0;S.next(i,u);++i){ S.a_ready(u); attn_unit<THRL>(u.bh/NHEAD,u.bh%NHEAD,u.qb,T.Q,T.K,T.V,T.O,T.G,lds,tid_,T.THR); S.done(u); }
}
#undef SBAR
#undef WAIT_BAR
}
#define GAS __attribute__((address_space(1)))
#define LAS __attribute__((address_space(3)))
typedef unsigned short bf16;
typedef unsigned v4u __attribute__((ext_vector_type(4)));
typedef float f32x4 __attribute__((ext_vector_type(4)));
typedef short bf16x8 __attribute__((ext_vector_type(8)));
typedef GAS unsigned gu32;
typedef GAS unsigned long long gu64;
#define RLX_AGENT __ATOMIC_RELAXED, __HIP_MEMORY_SCOPE_AGENT
#define LDS_WAIT() asm volatile("s_waitcnt lgkmcnt(0)" ::: "memory")
#define VM_WAIT() asm volatile("s_waitcnt vmcnt(0)" ::: "memory")
__device__ __forceinline__ unsigned long long rt() { return __builtin_amdgcn_s_memrealtime(); }
__device__ __forceinline__ unsigned f2bf(float f) { unsigned u = __builtin_bit_cast(unsigned, f); return (u + 0x7fffu + ((u >> 16) & 1u)) >> 16; }
__device__ __forceinline__ unsigned pk2(float lo, float hi) { return f2bf(lo) | (f2bf(hi) << 16); }

#define XB_TMO      128
#define XB_XCNT(j)  (256  + 64 * (j))
#define XB_XSUB(j)  (1280 + 64 * (j))
#define XB_XGEN(j)  (2304 + 64 * (j))
#define XB_TOP      3328
#define XB_TOPGEN   3392
#define XCD_BAR_WORDS 3456
#define XB_SPIN_CAP (1u << 27)

__device__ __forceinline__ unsigned xb_ld(unsigned* p)              { return __hip_atomic_load(p, __ATOMIC_RELAXED, __HIP_MEMORY_SCOPE_AGENT); }
__device__ __forceinline__ unsigned xb_add(unsigned* p, unsigned v) { return __hip_atomic_fetch_add(p, v, __ATOMIC_RELAXED, __HIP_MEMORY_SCOPE_AGENT); }
__device__ __forceinline__ unsigned xb_xcc_id() { return (unsigned)__builtin_amdgcn_s_getreg((3 << 11) | 20) & 0xFu; }
#define XB_SPIN(cond, bar) do { unsigned _sp = 0; while (cond) { __builtin_amdgcn_s_sleep(1); \
    if ((++_sp & 255u) == 0u) { if (xb_ld(&(bar)[XB_TMO])) break; if (_sp > XB_SPIN_CAP) { atomicAdd(&(bar)[XB_TMO], 1u); break; } } } } while (0)

struct XcdBarrier {
    unsigned* bar; unsigned x;
    volatile LAS unsigned* st;
};

__device__ __forceinline__ XcdBarrier xcd_barrier_post(unsigned* bar, volatile LAS unsigned* st) {
    XcdBarrier b; b.bar = bar; b.x = xb_xcc_id(); b.st = st;
    if (threadIdx.x == 0) (void)xb_add(&bar[XB_XCNT(b.x)], 1u);
    return b;
}
__device__ __forceinline__ void xcd_barrier_complete(unsigned* bar, unsigned x, unsigned& nloc, unsigned& nx) {
    const unsigned G = gridDim.x * gridDim.y * gridDim.z;
    unsigned sum, cnt, mine, sp = 0u;
    for (;;) {
        sum = 0u; cnt = 0u; mine = 0u;
#pragma unroll
        for (unsigned j = 0; j < 16; ++j) { const unsigned c = xb_ld(&bar[XB_XCNT(j)]); sum += c; cnt += (c > 0u) ? 1u : 0u; mine = (j == x) ? c : mine; }
        if (sum == G) break;
        __builtin_amdgcn_s_sleep(1);
        if ((++sp & 255u) == 0u) { if (xb_ld(&bar[XB_TMO])) break; if (sp > XB_SPIN_CAP) { atomicAdd(&bar[XB_TMO], 1u); break; } }
    }
    nloc = mine > 0u ? mine : 1u; nx = cnt > 0u ? cnt : 1u;
}

__device__ __forceinline__ void xcd_barrier(const XcdBarrier& b, const bool leader  ) {
    asm volatile("s_waitcnt vmcnt(0)" ::: "memory");
    __syncthreads();
    if (leader) {
        unsigned* bar = b.bar;
        __builtin_amdgcn_s_waitcnt(0);
        unsigned nloc = b.st[0], nx = b.st[1];
        if (nloc == 0u) { xcd_barrier_complete(bar, b.x, nloc, nx); b.st[0] = nloc; b.st[1] = nx; }
        const unsigned old = xb_add(&bar[XB_XSUB(b.x)], 1u);
        const unsigned gen = old / nloc;
        if (old + 1u == (gen + 1u) * nloc) {
            __builtin_amdgcn_fence(__ATOMIC_RELEASE, "agent");
            asm volatile("s_waitcnt vmcnt(0)" ::: "memory");
            const unsigned og = xb_add(&bar[XB_TOP], 1u);
            const unsigned tg = og / nx;
            if (og + 1u == (tg + 1u) * nx) xb_add(&bar[XB_TOPGEN], 1u);
            else XB_SPIN(xb_ld(&bar[XB_TOPGEN]) == tg, bar);
            __builtin_amdgcn_fence(__ATOMIC_ACQUIRE, "agent");
            xb_add(&bar[XB_XGEN(b.x)], 1u);
            asm volatile("s_waitcnt vmcnt(0)" ::: "memory");
        } else {
            XB_SPIN(xb_ld(&bar[XB_XGEN(b.x)]) == gen, bar);
            __builtin_amdgcn_fence(__ATOMIC_ACQUIRE, "agent");
            asm volatile("s_waitcnt vmcnt(0)" ::: "memory");
        }
    }
    __syncthreads();
}
#ifndef MK_FASTATTN
#define MK_FASTATTN 1
#endif
#ifndef MK_FASTREC
#define MK_FASTREC 1
#endif
namespace cg = cooperative_groups;
constexpr int NTOK = 16384, DMODEL = 1024, NBATCH = 8, SEQLEN = 2048, DEPTH = 4;
constexpr int FOX_IN = 4112, GLA_IN = 3088, HGRN_IN = 4096;
constexpr float RMS_EPS = 1e-6f;
constexpr float LOG2E = 1.4426950408889634f;
constexpr float FOX_C2 = 0.125f * LOG2E;
constexpr int NWAVES = 8;

constexpr size_t MiB = 1u << 20;
constexpr size_t WS_CTL = 0, CTL_ZERO_BYTES = 1 * MiB;
constexpr size_t WS_FOXWIN = 2 * MiB, WS_FOXWOUT = 18 * MiB, WS_GLAWIN = 22 * MiB, WS_GLAWOUT = 28 * MiB, WS_HGRNWIN = 30 * MiB, WS_HGRNWOUT = 38 * MiB;
constexpr size_t WS_PEERWQ = 40 * MiB, WS_KEYS = 56 * MiB, WS_LB = 58 * MiB;
#define FOXFUSE ((I8MASK & 9) == 9)
#ifndef BGQ
#define BGQ 1
#endif
#ifndef I8MASK
#define I8MASK 13
#endif
constexpr size_t WS_SW = 58 * MiB + 65536, WS_SX = 58 * MiB + 262144, WS_XN8 = 724 * MiB;
constexpr size_t WS_TAILW = 63 * MiB;
constexpr size_t WS_RS = 62 * MiB;
constexpr size_t WS_U = 64 * MiB, WS_V = 128 * MiB, WS_SU = 60 * MiB, WS_SV = 61 * MiB;
constexpr size_t WS_XN = 320 * MiB, WS_P = 352 * MiB, WS_OB = 480 * MiB, WS_Q2 = 512 * MiB, WS_TAIL = 576 * MiB, WS_CUM = 577 * MiB;
constexpr size_t WS_EXP = 580 * MiB, WS_GATE = 588 * MiB, WS_OF = 596 * MiB, WS_GLOG = 660 * MiB, WS_HB = 740 * MiB, WS_END = 772 * MiB;
constexpr size_t PSTRIDE = (size_t)NTOK * 1024;
constexpr int CW_BAR = 4096;

constexpr int RING_BYTES = 131072;
constexpr int LDSCTL_OFF = RING_BYTES, MISC_OFF = LDSCTL_OFF + 320;
constexpr int LDS_BYTES = 147456;

typedef unsigned u32x4v __attribute__((ext_vector_type(4)));
struct Ctx {
    LAS unsigned char* lds; int tid, lane, wave, vcu, G, gw, NGW, bx;
    const float* in[21]; float* out; unsigned char* ws;
};

__device__ __forceinline__ float bf2f(unsigned short b) { return __uint_as_float(((unsigned)b) << 16); }
__device__ __forceinline__ float bflo(unsigned w) { return __uint_as_float(w << 16); }
__device__ __forceinline__ float bfhi(unsigned w) { return __uint_as_float(w & 0xffff0000u); }
#define DPP_ADD(v, ctrl, rm, bm) (v + __builtin_bit_cast(float, __builtin_amdgcn_update_dpp(0, __builtin_bit_cast(int, v), ctrl, rm, bm, false)))
#define DPP_MAX(v, ctrl, rm, bm) fmaxf(v, __builtin_bit_cast(float, __builtin_amdgcn_update_dpp(__builtin_bit_cast(int, v), __builtin_bit_cast(int, v), ctrl, rm, bm, false)))
#define DPP_SUM31(v) do { v = DPP_ADD(v, 0x111, 0xf, 0xf); v = DPP_ADD(v, 0x112, 0xf, 0xf); v = DPP_ADD(v, 0x114, 0xf, 0xe); v = DPP_ADD(v, 0x118, 0xf, 0xc); v = DPP_ADD(v, 0x142, 0xa, 0xf); } while (0)
#define DPP_SUM63(v) do { DPP_SUM31(v); v = DPP_ADD(v, 0x143, 0xc, 0xf); } while (0)
__device__ __forceinline__ float rdlane(float v, int lane) { return __builtin_bit_cast(float, __builtin_amdgcn_readlane(__builtin_bit_cast(int, v), lane)); }
__device__ __forceinline__ float wave_sum(float v) { DPP_SUM63(v); return rdlane(v, 63); }
__device__ __forceinline__ float wave_max(float v) {
    v = DPP_MAX(v, 0x111, 0xf, 0xf); v = DPP_MAX(v, 0x112, 0xf, 0xf); v = DPP_MAX(v, 0x114, 0xf, 0xe); v = DPP_MAX(v, 0x118, 0xf, 0xc); v = DPP_MAX(v, 0x142, 0xa, 0xf); v = DPP_MAX(v, 0x143, 0xc, 0xf);
    return rdlane(v, 63);
}
typedef __bf16 bf16x2_t __attribute__((ext_vector_type(2)));
__device__ __forceinline__ float dot2bf(unsigned w, unsigned x, float acc) { return __builtin_amdgcn_fdot2_f32_bf16(__builtin_bit_cast(bf16x2_t, w), __builtin_bit_cast(bf16x2_t, x), acc, false); }
__device__ __forceinline__ float bperm(float v, int src_lane) { return __builtin_bit_cast(float, __builtin_amdgcn_ds_bpermute(src_lane << 2, __builtin_bit_cast(int, v))); }
__device__ __forceinline__ float log_sigmoid_f(float x) { return fminf(x, 0.f) - log1pf(__expf(-fabsf(x))); }
__device__ __forceinline__ float sigmoid_f(float x) { return 1.f / (1.f + __expf(-x)); }

__device__ __forceinline__ void p0_transpose_item(const float* W, int ldw, int K, int Nuse, bf16* WT, LAS float* scr, int item, int lane) {
    const int nblk = Nuse / 32, kb = item / nblk, nb = item % nblk, k0 = 64 * kb, n0 = 32 * nb;
#pragma unroll
    for (int i = 0; i < 8; ++i) { const int kk = 8 * i + (lane >> 3); const f32x4 v = *(const GAS f32x4*)(W + (size_t)(k0 + kk) * ldw + n0 + 4 * (lane & 7));
        LAS float* d = scr + kk * 33 + 4 * (lane & 7); d[0] = v.x; d[1] = v.y; d[2] = v.z; d[3] = v.w; }
    LDS_WAIT(); asm volatile("" ::: "memory");
    const int c = lane & 7;
#pragma unroll
    for (int j = 0; j < 4; ++j) { const int n = (lane >> 3) + 8 * j; const LAS float* s = scr + (8 * c) * 33 + n;
        v4u o; o.x = pk2(s[0 * 33], s[1 * 33]); o.y = pk2(s[2 * 33], s[3 * 33]); o.z = pk2(s[4 * 33], s[5 * 33]); o.w = pk2(s[6 * 33], s[7 * 33]);
        *(GAS v4u*)(WT + (size_t)(n0 + n) * K + k0 + 8 * c) = o; }
    LDS_WAIT(); asm volatile("" ::: "memory");
}
__device__ __forceinline__ unsigned q8x4(float a, float b, float c, float d) {
    return ((unsigned)(int)__builtin_rintf(a) & 0xffu) | (((unsigned)(int)__builtin_rintf(b) & 0xffu) << 8) | (((unsigned)(int)__builtin_rintf(c) & 0xffu) << 16) | ((unsigned)(int)__builtin_rintf(d) << 24);
}
__device__ __forceinline__ void p0_colmax_item(const float* W, int ldw, unsigned* cmax, int item, int lane) {
    const int nb = item >> 3, n0 = 32 * nb, k0 = 128 * (item & 7);
    f32x4 v[16];
#pragma unroll
    for (int i = 0; i < 16; ++i) v[i] = *(const GAS f32x4*)(W + (size_t)(k0 + 8 * i + (lane >> 3)) * ldw + n0 + 4 * (lane & 7));
    __builtin_amdgcn_sched_barrier(0);
    float mx[4] = {0.f, 0.f, 0.f, 0.f};
#pragma unroll
    for (int i = 0; i < 16; ++i) { mx[0] = fmaxf(mx[0], fabsf(v[i].x)); mx[1] = fmaxf(mx[1], fabsf(v[i].y)); mx[2] = fmaxf(mx[2], fabsf(v[i].z)); mx[3] = fmaxf(mx[3], fabsf(v[i].w)); }
#pragma unroll
    for (int j = 0; j < 4; ++j) { mx[j] = fmaxf(mx[j], bperm(mx[j], lane ^ 8)); mx[j] = fmaxf(mx[j], bperm(mx[j], lane ^ 16)); mx[j] = fmaxf(mx[j], bperm(mx[j], lane ^ 32)); }
    if (lane < 8) {
#pragma unroll
        for (int j = 0; j < 4; ++j) (void)__hip_atomic_fetch_max(cmax + n0 + 4 * lane + j, __float_as_uint(mx[j]), __ATOMIC_RELAXED, __HIP_MEMORY_SCOPE_AGENT);
    }
}
__device__ __forceinline__ void p0_quant_item(const float* W, int ldw, const unsigned* cmax, signed char* W8, float* sw, LAS float* scr, int item, int lane, bool headperm) {
    const int nb = item >> 3, n0 = 32 * nb, k0 = 128 * (item & 7);
    const int n0s = (headperm && nb < 64) ? (nb >> 3) * 256 + 64 * (nb & 3) + 32 * ((nb >> 2) & 1) : n0;
    f32x4 v[2][8];
#pragma unroll
    for (int h = 0; h < 2; ++h)
#pragma unroll
        for (int i = 0; i < 8; ++i) v[h][i] = *(const GAS f32x4*)(W + (size_t)(k0 + 64 * h + 8 * i + (lane >> 3)) * ldw + n0s + 4 * (lane & 7));
    float ci[4];
#pragma unroll
    for (int j = 0; j < 4; ++j) { const float m = __uint_as_float(*(const GAS unsigned*)(cmax + n0s + (lane >> 3) + 8 * j)); ci[j] = m > 0.f ? 127.f / m : 0.f; }
    if ((item & 7) == 0 && lane < 32) *(GAS float*)(sw + n0 + lane) = __uint_as_float(*(const GAS unsigned*)(cmax + n0s + lane)) * (1.f / 127.f);
    __builtin_amdgcn_sched_barrier(0);
    const int c = lane & 7;
#pragma unroll
    for (int h = 0; h < 2; ++h) {
        LDS_WAIT(); asm volatile("" ::: "memory");
#pragma unroll
        for (int i = 0; i < 8; ++i) { LAS float* d = scr + (8 * i + (lane >> 3)) * 33 + 4 * (lane & 7); d[0] = v[h][i].x; d[1] = v[h][i].y; d[2] = v[h][i].z; d[3] = v[h][i].w; }
        LDS_WAIT(); asm volatile("" ::: "memory");
#pragma unroll
        for (int j = 0; j < 4; ++j) { const int n = (lane >> 3) + 8 * j; const LAS float* sp = scr + (8 * c) * 33 + n;
            const unsigned lo = q8x4(sp[0] * ci[j], sp[33] * ci[j], sp[66] * ci[j], sp[99] * ci[j]), hi = q8x4(sp[132] * ci[j], sp[165] * ci[j], sp[198] * ci[j], sp[231] * ci[j]);
            *(GAS unsigned long long*)(W8 + (size_t)(n0 + n) * 1024 + k0 + 64 * h + 8 * c) = (unsigned long long)lo | ((unsigned long long)hi << 32); }
    }
    LDS_WAIT(); asm volatile("" ::: "memory");
}
__device__ __forceinline__ void rms_row_to_bf16(int lane, f32x4 (&v)[4], const float* gain, bf16* orow, signed char* orow8, float* sx) {
    const GAS f32x4* gr = (const GAS f32x4*)gain + lane;
    float s = 0.f;
#pragma unroll
    for (int j = 0; j < 4; ++j) s += (v[j].x * v[j].x + v[j].y * v[j].y) + (v[j].z * v[j].z + v[j].w * v[j].w);
    const float r = rsqrtf(wave_sum(s) * (1.f / 1024.f) + RMS_EPS);
    GAS unsigned long long* o8 = (GAS unsigned long long*)orow + lane; float am = 0.f;
#pragma unroll
    for (int j = 0; j < 4; ++j) { const f32x4 g = gr[64 * j]; v[j].x *= r * g.x; v[j].y *= r * g.y; v[j].z *= r * g.z; v[j].w *= r * g.w;
        am = fmaxf(fmaxf(am, fmaxf(fabsf(v[j].x), fabsf(v[j].y))), fmaxf(fabsf(v[j].z), fabsf(v[j].w)));
        o8[64 * j] = (unsigned long long)pk2(v[j].x, v[j].y) | ((unsigned long long)pk2(v[j].z, v[j].w) << 32); }
    am = wave_max(am); const float qi = am > 0.f ? 127.f / am : 0.f;
    GAS unsigned* q8 = (GAS unsigned*)orow8 + lane;
#pragma unroll
    for (int j = 0; j < 4; ++j) q8[64 * j] = q8x4(v[j].x * qi, v[j].y * qi, v[j].z * qi, v[j].w * qi);
    if (lane == 0) *(GAS float*)sx = am * (1.f / 127.f);
}
__device__ __forceinline__ void cvt_f32_bf16(const Ctx& C, const float* src, bf16* dst, size_t n) {
    const size_t nth = (size_t)C.G * 512, t0 = (size_t)C.vcu * 512 + C.tid;
    for (size_t i = t0; i < n / 8; i += nth) {
        const f32x4 a = ((const GAS f32x4*)src)[2 * i], b = ((const GAS f32x4*)src)[2 * i + 1];
        v4u o; o.x = pk2(a.x, a.y); o.y = pk2(a.z, a.w); o.z = pk2(b.x, b.y); o.w = pk2(b.z, b.w);
        ((GAS v4u*)dst)[i] = o;
    }
}
__device__ __forceinline__ void quant_row_fp8(int lane, const f32x4 (&v)[4], unsigned char* drow, float* sc) {
    float am = 0.f;
#pragma unroll
    for (int i = 0; i < 4; ++i) am = fmaxf(am, fmaxf(fmaxf(fabsf(v[i].x), fabsf(v[i].y)), fmaxf(fabsf(v[i].z), fabsf(v[i].w))));
    am = wave_max(am);
    const float inv = am > 0.f ? 448.f / am : 0.f;
    GAS unsigned* o = (GAS unsigned*)drow + lane;
#pragma unroll
    for (int i = 0; i < 4; ++i) {
        const float a = fminf(fmaxf(v[i].x * inv, -448.f), 448.f), b = fminf(fmaxf(v[i].y * inv, -448.f), 448.f), c = fminf(fmaxf(v[i].z * inv, -448.f), 448.f), d = fminf(fmaxf(v[i].w * inv, -448.f), 448.f);
        int w = 0; w = __builtin_amdgcn_cvt_pk_fp8_f32(a, b, w, false); w = __builtin_amdgcn_cvt_pk_fp8_f32(c, d, w, true); o[64 * i] = (unsigned)w;
    }
    if (lane == 0) *(GAS float*)sc = am * (1.f / 448.f);
}
__device__ __forceinline__ void quant_rows_fp8(const Ctx& C, const float* src, unsigned char* dst, float* scales, int nrows) {
    int rw = C.gw;
    for (; rw + 3 * C.NGW < nrows; rw += 4 * C.NGW) {
        f32x4 v[4][4];
#pragma unroll
        for (int j = 0; j < 4; ++j) { const GAS f32x4* xr = (const GAS f32x4*)(src + (size_t)(rw + j * C.NGW) * 1024) + C.lane;
#pragma unroll
            for (int i = 0; i < 4; ++i) v[j][i] = xr[64 * i]; }
        __builtin_amdgcn_sched_barrier(0);
#pragma unroll
        for (int j = 0; j < 4; ++j) quant_row_fp8(C.lane, v[j], dst + (size_t)(rw + j * C.NGW) * 1024, scales + rw + j * C.NGW);
    }
    for (; rw < nrows; rw += C.NGW) {
        const GAS f32x4* xr = (const GAS f32x4*)(src + (size_t)rw * 1024) + C.lane;
        f32x4 v[4];
#pragma unroll
        for (int i = 0; i < 4; ++i) v[i] = xr[64 * i];
        quant_row_fp8(C.lane, v, dst + (size_t)rw * 1024, scales + rw);
    }
}
constexpr int BGQ_ROWS = 3 * 16384;
template <int JOB> __device__ __forceinline__ void bgq_row(const Ctx& C, int idx, const float*& src, unsigned char*& dst, float*& sc) {
    const int seg = idx >> 14, row = idx & 16383;
    const bool isV = seg == 1 || (seg == 2 && JOB == 2);
    const size_t flat = (size_t)(seg < 2 ? JOB : 3) * 16384 + row;
    src = (isV ? C.in[20] : C.in[19]) + flat * 1024; dst = C.ws + (isV ? WS_V : WS_U) + flat * 1024; sc = (float*)(C.ws + (isV ? WS_SV : WS_SU)) + flat;
}
template <int JOB> __device__ __forceinline__ void bgq_step(const Ctx& C, int idx_prev, int idx, f32x4 (&v)[4]) {
    const float* src; unsigned char* dst; float* sc;
    if (idx_prev >= 0 && idx_prev < BGQ_ROWS) { bgq_row<JOB>(C, idx_prev, src, dst, sc); quant_row_fp8(C.lane, v, dst, sc); }
    if (idx < BGQ_ROWS) { bgq_row<JOB>(C, idx, src, dst, sc); const GAS f32x4* xr = (const GAS f32x4*)src + C.lane;
#pragma unroll
        for (int i = 0; i < 4; ++i) v[i] = xr[64 * i]; }
}
#ifndef PRO_PROBE
#define PRO_PROBE 0
#endif
constexpr int CW_CMAX = 131072;
constexpr int I8_NF0 = (I8MASK & 1) ? 1024 : 0, I8_NF3 = (I8MASK & 8) ? 1024 : 0, I8_NG = (I8MASK & 2) ? 768 : 0, I8_NH = (I8MASK & 4) ? 1024 : 0, I8_NITEMS = I8_NF0 + I8_NF3 + I8_NG + I8_NH;
template <bool PASS2> __device__ __forceinline__ void p0_i8_items(const Ctx& C, LAS float* scr) {
    unsigned* CM = (unsigned*)(C.ws + WS_CTL) + CW_CMAX; float* SW = (float*)(C.ws + WS_SW);
    for (int it = C.gw; it < I8_NITEMS; it += C.NGW) {
        int r = it; const float* W; int ldw; signed char* W8; int q;
        if (r < I8_NF0) { W = C.in[3]; ldw = FOX_IN; W8 = (signed char*)(C.ws + WS_FOXWIN); q = 0; }
        else if ((r -= I8_NF0) < I8_NF3) { W = C.in[3] + (size_t)1024 * FOX_IN; ldw = FOX_IN; W8 = (signed char*)(C.ws + WS_FOXWIN + 8 * MiB); q = 1; }
        else if ((r -= I8_NF3) < I8_NG) { W = C.in[8]; ldw = GLA_IN; W8 = (signed char*)(C.ws + WS_GLAWIN); q = 2; }
        else { r -= I8_NG; W = C.in[13]; ldw = HGRN_IN; W8 = (signed char*)(C.ws + WS_HGRNWIN); q = 3; }
        const int swo = q == 0 ? 0 : q == 1 ? 4096 : q == 2 ? 8192 : 11264;
        if (PASS2) p0_quant_item(W, ldw, CM + q * 4096, W8, SW + swo, scr, r, C.lane, FOXFUSE && q < 2); else p0_colmax_item(W, ldw, CM + q * 4096, r, C.lane);
    }
}
__device__ __forceinline__ void p0_prologue_b(const Ctx& C) { p0_i8_items<true>(C, (LAS float*)(C.lds + C.wave * 16384)); }
__device__ __forceinline__ void p0_prologue(const Ctx& C) {
    LAS float* scr = (LAS float*)(C.lds + C.wave * 16384);
    for (int rep_ = 0; rep_ < (PRO_PROBE == 1 ? 2 : 1); ++rep_) {
    p0_i8_items<false>(C, scr);
    constexpr int I_SQ = 16 * 32, N_F0 = (I8MASK & 1) ? 0 : 16 * 128, N_F3 = (I8MASK & 8) ? 0 : 16 * 128, N_G = (I8MASK & 2) ? 0 : 16 * 96, N_H = (I8MASK & 4) ? 0 : 16 * 128;
    constexpr int NITEMS = N_F0 + N_F3 + N_G + N_H + 2 * I_SQ + I_SQ + I_SQ;
    for (int it = C.gw; it < NITEMS; it += C.NGW) {
        int r = it;
        if (r < N_F0) { p0_transpose_item(C.in[3], FOX_IN, 1024, 4096, (bf16*)(C.ws + WS_FOXWIN), scr, r, C.lane); continue; } r -= N_F0;
        if (r < N_F3) { p0_transpose_item(C.in[3] + (size_t)1024 * FOX_IN, FOX_IN, 1024, 4096, (bf16*)(C.ws + WS_FOXWIN + 8 * MiB), scr, r, C.lane); continue; } r -= N_F3;
        if (r < N_G) { p0_transpose_item(C.in[8], GLA_IN, 1024, 3072, (bf16*)(C.ws + WS_GLAWIN), scr, r, C.lane); continue; } r -= N_G;
        if (r < N_H) { p0_transpose_item(C.in[13], HGRN_IN, 1024, 4096, (bf16*)(C.ws + WS_HGRNWIN), scr, r, C.lane); continue; } r -= N_H;
        if (r < 2 * I_SQ) { const int j = r / I_SQ; p0_transpose_item(C.in[7] + (size_t)j * 1024 * 1024, 1024, 1024, 1024, (bf16*)(C.ws + WS_FOXWOUT) + (size_t)j * 1024 * 1024, scr, r % I_SQ, C.lane); continue; } r -= 2 * I_SQ;
        if (r < I_SQ) { p0_transpose_item(C.in[12], 1024, 1024, 1024, (bf16*)(C.ws + WS_GLAWOUT), scr, r, C.lane); continue; } r -= I_SQ;
        p0_transpose_item(C.in[16], 1024, 1024, 1024, (bf16*)(C.ws + WS_HGRNWOUT), scr, r, C.lane);
    }
    }
    for (int rep_ = 0; rep_ < (PRO_PROBE == 2 ? 2 : 1); ++rep_) {
    constexpr int MT_GROUPS = 4 * 16 * 4 * 32;
    for (int grp = C.gw; grp < MT_GROUPS; grp += C.NGW) {
        const int nb2 = grp & 31, kb2 = (grp >> 5) & 3, hp = (grp >> 7) & 15, layer = grp >> 11;
        const float* kp = C.in[18] + ((size_t)(layer * 16 + hp) * 128 + kb2 * 32 + (C.lane & 15)) * 128 + 4 * (C.lane >> 4);
        const float* wp = C.in[17] + ((size_t)layer * 1024 + nb2 * 32 + (C.lane & 15)) * 2048 + hp * 128 + 4 * (C.lane >> 4);
        f32x4 ka[2][8], wb[2][8];
#pragma unroll
        for (int u = 0; u < 2; ++u)
#pragma unroll
            for (int s8 = 0; s8 < 8; ++s8) { ka[u][s8] = *(const GAS f32x4*)(kp + (size_t)u * 16 * 128 + 16 * s8); wb[u][s8] = *(const GAS f32x4*)(wp + (size_t)u * 16 * 2048 + 16 * s8); }
        __builtin_amdgcn_sched_barrier(0);
        f32x4 acc[2][2];
#pragma unroll
        for (int a = 0; a < 2; ++a)
#pragma unroll
            for (int b = 0; b < 2; ++b) acc[a][b] = (f32x4){0.f, 0.f, 0.f, 0.f};
#pragma unroll
        for (int s8 = 0; s8 < 8; ++s8)
#pragma unroll
            for (int a = 0; a < 2; ++a)
#pragma unroll
                for (int b = 0; b < 2; ++b) { const f32x4 x = ka[a][s8], y = wb[b][s8];
                    acc[a][b] = __builtin_amdgcn_mfma_f32_16x16x4f32(x.x, y.x, acc[a][b], 0, 0, 0); acc[a][b] = __builtin_amdgcn_mfma_f32_16x16x4f32(x.y, y.y, acc[a][b], 0, 0, 0);
                    acc[a][b] = __builtin_amdgcn_mfma_f32_16x16x4f32(x.z, y.z, acc[a][b], 0, 0, 0); acc[a][b] = __builtin_amdgcn_mfma_f32_16x16x4f32(x.w, y.w, acc[a][b], 0, 0, 0); }
#pragma unroll
        for (int a = 0; a < 2; ++a)
#pragma unroll
            for (int b = 0; b < 2; ++b) {
                bf16* mt = (bf16*)(C.ws + WS_PEERWQ) + ((size_t)layer * 2048 + hp * 128 + kb2 * 32 + a * 16 + (C.lane >> 4) * 4) * 1024 + nb2 * 32 + b * 16 + (C.lane & 15);
#pragma unroll
                for (int r = 0; r < 4; ++r) mt[(size_t)r * 1024] = (bf16)f2bf(acc[a][b][r]); }
    }
    }
    for (int rep_ = 0; rep_ < (PRO_PROBE == 3 ? 2 : 1); ++rep_) {
    quant_rows_fp8(C, C.in[19], C.ws + WS_U, (float*)(C.ws + WS_SU), BGQ ? 16384 : 4 * 16384);
    quant_rows_fp8(C, C.in[20], C.ws + WS_V, (float*)(C.ws + WS_SV), BGQ ? 16384 : 4 * 16384);
    }
    for (int rep_ = 0; rep_ < (PRO_PROBE == 4 ? 2 : 1); ++rep_) {
    for (int i = C.vcu * 512 + C.tid; i < 3 * 16 * 1024; i += C.G * 512) {
        const int w = i >> 14, n = (i >> 10) & 15, k = i & 1023;
        const float v = w < 2 ? C.in[3][(size_t)w * 1024 * FOX_IN + (size_t)k * FOX_IN + 4096 + n] : C.in[8][(size_t)k * GLA_IN + 3072 + n];
        ((bf16*)(C.ws + WS_TAILW))[i] = (bf16)f2bf(v);
    }
    if (C.vcu == 0) for (int c = C.tid; c < 1024; c += 512) {
        const float l0 = C.in[14][c], l1 = C.in[14][1024 + c], l2 = C.in[14][2048 + c], l3 = C.in[14][3072 + c];
        const float m = fmaxf(fmaxf(l0, l1), fmaxf(l2, l3));
        const float e0 = expf(l0 - m), e1 = expf(l1 - m), e2 = expf(l2 - m), e3 = expf(l3 - m);
        ((float*)(C.ws + WS_LB))[c] = (e1 + e2) / (e0 + e1 + e2 + e3);
    }
    for (int m0 = C.gw; m0 < NTOK; m0 += 4 * C.NGW) {
        f32x4 v[4][4];
#pragma unroll
        for (int u = 0; u < 4; ++u) { const int m = m0 + u * C.NGW; if (m < NTOK) { const GAS f32x4* xr = (const GAS f32x4*)(C.in[0] + (size_t)m * 1024) + C.lane;
#pragma unroll
            for (int j = 0; j < 4; ++j) v[u][j] = xr[64 * j]; } }
        __builtin_amdgcn_sched_barrier(0);
#pragma unroll
        for (int u = 0; u < 4; ++u) { const int m = m0 + u * C.NGW; if (m < NTOK)
            rms_row_to_bf16(C.lane, v[u], C.in[1], (bf16*)(C.ws + WS_XN) + (size_t)m * 1024, (signed char*)(C.ws + WS_XN8) + (size_t)m * 1024, (float*)(C.ws + WS_SX) + m); }
    }
    }
}

__device__ __forceinline__ void tail_mfma(const Ctx& C, int tok0, const bf16* WT, LAS float* part) {
    const int l = C.lane, m = l & 15, g = l >> 4, tbk = C.wave & 3, kh = C.wave >> 2;
    const bf16* ap = (const bf16*)(C.ws + WS_XN) + (size_t)(tok0 + 16 * tbk + m) * 1024 + kh * 512 + 8 * g;
    const bf16* bp = WT + (size_t)m * 1024 + kh * 512 + 8 * g;
    f32x4 acc = (f32x4){0.f, 0.f, 0.f, 0.f};
#pragma unroll 4
    for (int ks = 0; ks < 16; ++ks) acc = __builtin_amdgcn_mfma_f32_16x16x32_bf16(*(const bf16x8*)(ap + 32 * ks), *(const bf16x8*)(bp + 32 * ks), acc, 0, 0, 0);
#pragma unroll
    for (int r = 0; r < 4; ++r) part[kh * 1024 + (16 * tbk + 4 * g + r) * 16 + m] = acc[r];
}
template <bool QK> __device__ __forceinline__ void fox_step1(const Ctx& C, int j) {
    float* TAIL = (float*)(C.ws + WS_TAIL); LAS float* part = (LAS float*)C.lds;
    const bf16* WT = (const bf16*)(C.ws + WS_TAILW) + (size_t)j * 16 * 1024;
    for (int tb = C.vcu; tb < NTOK / 64; tb += C.G) {
        __syncthreads();
        tail_mfma(C, tb * 64, WT, part);
        __syncthreads();
#pragma unroll
        for (int rep = 0; rep < 2; ++rep) { const int i = rep * 512 + C.tid; TAIL[(size_t)tb * 1024 + i] = log_sigmoid_f(part[i] + part[1024 + i] + C.in[4][j * 16 + (i & 15)]); }
        if (!QK) continue;
        const float* gq = C.in[5] + j * 64; const float* gk = C.in[6] + j * 64;
        v4u ra[2][8], rb[2][8];
#pragma unroll
        for (int which = 0; which < 2; ++which)
#pragma unroll
            for (int t = 0; t < 8; ++t) { const bf16* row = (const bf16*)(C.ws + WS_P) + (size_t)which * PSTRIDE + (size_t)(tb * 64 + C.wave * 8 + t) * 1024 + C.lane * 16;
                ra[which][t] = *(const GAS v4u*)row; rb[which][t] = *(const GAS v4u*)(row + 8); }
        __builtin_amdgcn_sched_barrier(0);
#pragma unroll
        for (int which = 0; which < 2; ++which) {
            const float* g = (which == 0 ? gq : gk) + (C.lane & 3) * 16;
            float gv[16];
#pragma unroll
            for (int i = 0; i < 16; ++i) gv[i] = g[i];
#pragma unroll
            for (int t = 0; t < 8; ++t) {
                bf16* row = (bf16*)(C.ws + WS_P) + (size_t)which * PSTRIDE + (size_t)(tb * 64 + C.wave * 8 + t) * 1024 + C.lane * 16;
                const v4u a = ra[which][t], b = rb[which][t];
                float v[16] = {bflo(a.x), bfhi(a.x), bflo(a.y), bfhi(a.y), bflo(a.z), bfhi(a.z), bflo(a.w), bfhi(a.w), bflo(b.x), bfhi(b.x), bflo(b.y), bfhi(b.y), bflo(b.z), bfhi(b.z), bflo(b.w), bfhi(b.w)};
                float ss = 0.f;
#pragma unroll
                for (int i = 0; i < 16; ++i) ss += v[i] * v[i];
                ss = DPP_ADD(ss, 0xB1, 0xf, 0xf); ss = DPP_ADD(ss, 0x4E, 0xf, 0xf);
                const float r = rsqrtf(ss * (1.f / 64.f) + RMS_EPS) * (which == 0 ? FOX_C2 : 1.f);
#pragma unroll
                for (int i = 0; i < 16; ++i) v[i] = v[i] * r * gv[i];
                v4u oa, ob; oa.x = pk2(v[0], v[1]); oa.y = pk2(v[2], v[3]); oa.z = pk2(v[4], v[5]); oa.w = pk2(v[6], v[7]);
                ob.x = pk2(v[8], v[9]); ob.y = pk2(v[10], v[11]); ob.z = pk2(v[12], v[13]); ob.w = pk2(v[14], v[15]);
                *(GAS v4u*)row = oa; *(GAS v4u*)(row + 8) = ob;
            }
        }
    }
}
constexpr size_t WS_ASC = WS_Q2, WS_Q1 = WS_Q2 + 16 * MiB, WS_KST = WS_Q2 + 48 * MiB, WS_DEC = 59 * MiB;
static_assert(WS_KST + 32 * MiB <= WS_OF && WS_Q1 + 32 * MiB <= WS_KST, "chunk workspace map");
template <int NH>
__device__ __forceinline__ void chunk_prepass(const Ctx& C) {
    bf16* ASC = (bf16*)(C.ws + WS_ASC); bf16* Q1 = (bf16*)(C.ws + WS_Q1); bf16* KST = (bf16*)(C.ws + WS_KST); float* DEC = (float*)(C.ws + WS_DEC);
    const bf16* P0 = (const bf16*)(C.ws + WS_P); const bf16* P1 = P0 + PSTRIDE;
    LAS bf16* tqs = (LAS bf16*)C.lds;
    LAS bf16* tks = tqs + 64 * 128;
    LAS bf16* q2s = tks + 64 * 128;
    LAS bf16* k2s = q2s + 64 * 136;
    LAS bf16* q1s = k2s + 64 * 136;
    LAS float* tot = (LAS float*)(q1s + 64 * 128);
    LAS float* part = tot + 512;
    const float qs = 0.08838834764831845f;
    const int d = C.tid & 127, tq = C.tid >> 7, l = C.lane, fr = l & 15, fq = l >> 4;
    const int dq = d;
    const int pr0 = C.tid >> 4, pc = (C.tid & 15) * 8;
#define PP_BAR() do { asm volatile("s_waitcnt lgkmcnt(0)" ::: "memory"); __builtin_amdgcn_s_barrier(); asm volatile("" ::: "memory"); } while (0)
    for (int itb = C.vcu; itb < NBATCH * 32; itb += C.G) {
        const int c = itb & 31, b = itb >> 5;
        const size_t rowb = (size_t)b * SEQLEN + c * 64;
        const size_t row0 = rowb + tq * 16;
        if (NH == 4) { __syncthreads(); tail_mfma(C, b * SEQLEN + c * 64, (const bf16*)(C.ws + WS_TAILW) + 2 * 16 * 1024, part); }
        v4u pq[2], pk[2];
#define PP_LOAD(h_) do { _Pragma("unroll") for (int j = 0; j < 2; ++j) { const size_t r_ = (rowb + pr0 + 32 * j) * 1024 + (h_) * 128 + pc; \
            pq[j] = *(const GAS v4u*)(P0 + r_); pk[j] = *(const GAS v4u*)((NH == 4 ? P0 + 512 : P1) + r_); } } while (0)
        PP_LOAD(0);
#pragma unroll 1
        for (int h = 0; h < NH; ++h) {
            const int it = (b * NH + h) * 32 + c;
            PP_BAR();
#pragma unroll
            for (int j = 0; j < 2; ++j) { *(LAS v4u*)(tqs + (pr0 + 32 * j) * 128 + pc) = pq[j]; *(LAS v4u*)(tks + (pr0 + 32 * j) * 128 + pc) = pk[j]; }
            if (h + 1 < NH) PP_LOAD(h + 1);
            PP_BAR();
            float bl[16], kk[16]; float run = 0.f;
            if (NH == 4) {
                float wu[16];
#pragma unroll
                for (int r = 0; r < 16; ++r) wu[r] = C.in[9][r * 512 + h * 128 + d];
                const float ba = C.in[10][h * 128 + d];
#pragma unroll
                for (int i = 0; i < 16; ++i) { float z = ba; const int t = tq * 16 + i;
#pragma unroll
                    for (int r = 0; r < 16; r += 4) { const f32x4 p0 = *(const LAS f32x4*)(part + t * 16 + r), p1 = *(const LAS f32x4*)(part + 1024 + t * 16 + r);
                        z += (p0[0] + p1[0]) * wu[r] + (p0[1] + p1[1]) * wu[r + 1] + (p0[2] + p1[2]) * wu[r + 2] + (p0[3] + p1[3]) * wu[r + 3]; }
                    run += log_sigmoid_f(z) * (1.f / 16.f); bl[i] = run; kk[i] = bf2f(tks[t * 128 + d]); }
            } else {
                const float lb = ((const float*)(C.ws + WS_LB))[h * 128 + d];
#pragma unroll
                for (int i = 0; i < 16; ++i) { const float gate = lb + (1.f - lb) * sigmoid_f(bf2f(tks[(tq * 16 + i) * 128 + d])); run += __logf(gate); bl[i] = run; kk[i] = 1.f - gate; }
            }
            tot[tq * 128 + d] = run;
            PP_BAR();
            const float t0 = tot[d], t1 = tot[128 + d], t2 = tot[256 + d], t3 = tot[384 + d];
            const float off = tq == 0 ? 0.f : tq == 1 ? t0 : tq == 2 ? t0 + t1 : t0 + t1 + t2;
            const float bref = t0 + t1, bend = (t0 + t1) + (t2 + t3);
            unsigned ksw[8];
#pragma unroll
            for (int i = 0; i < 16; ++i) {
                const float bb = bl[i] + off;
                const float qv = bf2f(tqs[(tq * 16 + i) * 128 + d]) * qs, kv = kk[i];
                q1s[(tq * 16 + i) * 128 + dq] = (bf16)f2bf(qv * __expf(bb));
                q2s[(tq * 16 + i) * 136 + d] = (bf16)f2bf(qv * __expf(bb - bref));
                k2s[(tq * 16 + i) * 136 + d] = (bf16)f2bf(kv * __expf(bref - bb));
                const unsigned kb = f2bf(kv * __expf(bend - bb));
                if (i & 1) ksw[i >> 1] |= kb << 16; else ksw[i >> 1] = kb;
            }
            { bf16* kt = KST + ((size_t)it * 128 + d) * 64 + tq * 16; *(GAS v4u*)kt = (v4u){ksw[0], ksw[1], ksw[2], ksw[3]}; *(GAS v4u*)(kt + 8) = (v4u){ksw[4], ksw[5], ksw[6], ksw[7]}; }
            if (tq == 0) DEC[(size_t)it * 128 + d] = __expf(bend);
            PP_BAR();
#pragma unroll
            for (int j = 0; j < 2; ++j) *(GAS v4u*)(Q1 + (rowb + pr0 + 32 * j) * 1024 + h * 128 + pc) = *(const LAS v4u*)(q1s + (pr0 + 32 * j) * 128 + pc);
            const int ti = C.wave >> 1;
#pragma unroll
            for (int sj = 0; sj < 2; ++sj) {
                const int si = 2 * (C.wave & 1) + sj;
                f32x4 acc = (f32x4){0.f, 0.f, 0.f, 0.f};
                if (si <= ti) {
#pragma unroll
                    for (int ks = 0; ks < 4; ++ks) {
                        const bf16x8 a = *(const LAS bf16x8*)(q2s + (16 * ti + fr) * 136 + ks * 32 + fq * 8), bb = *(const LAS bf16x8*)(k2s + (16 * si + fr) * 136 + ks * 32 + fq * 8);
                        acc = __builtin_amdgcn_mfma_f32_16x16x32_bf16(bb, a, acc, 0, 0, 0);
                    }
                }
                const int t = 16 * ti + fr, s0 = 16 * si + 4 * fq;
                typedef unsigned u32x2v __attribute__((ext_vector_type(2)));
                u32x2v w; w.x = pk2(s0 <= t ? acc[0] : 0.f, s0 + 1 <= t ? acc[1] : 0.f); w.y = pk2(s0 + 2 <= t ? acc[2] : 0.f, s0 + 3 <= t ? acc[3] : 0.f);
                *(GAS u32x2v*)(ASC + (size_t)it * 4096 + t * 64 + s0) = w;
            }
        }
    }
#undef PP_LOAD
#undef PP_BAR
}
struct RecFrag { bf16x8 vb[2]; bf16x8 a0, a1; unsigned long long q[4][2]; f32x4 dc[2]; bf16x8 ks[2][2]; };
template <int NH, int DV>
__device__ __forceinline__ void chunk_recur(const Ctx& C, const bf16* Vp) {
    const bf16* ASC = (const bf16*)(C.ws + WS_ASC); const bf16* Q1 = (const bf16*)(C.ws + WS_Q1); const bf16* KST = (const bf16*)(C.ws + WS_KST); const float* DEC = (const float*)(C.ws + WS_DEC);
    bf16* OF = (bf16*)(C.ws + WS_OF);
    constexpr int NCB = DV / 16, NTASK = NBATCH * NH * NCB;
    const int l = C.lane, m = l & 15, g = l >> 4, gi = C.wave >> 2, kq = C.wave & 3;
    LAS float* red = (LAS float*)C.lds + gi * 8192;
#define REC_LOAD(F, c_) do { const size_t row0_ = (size_t)b * SEQLEN + (c_) * 64; const size_t ch_ = (size_t)bh * 32 + (c_); \
        _Pragma("unroll") for (int ks = 0; ks < 2; ++ks) _Pragma("unroll") for (int j = 0; j < 8; ++j) F.vb[ks][j] = (short)Vp[(row0_ + 32 * ks + 8 * g + j) * 1024 + col]; \
        F.a0 = *(const bf16x8*)(ASC + ch_ * 4096 + (16 * kq + m) * 64 + 8 * g); F.a1 = *(const bf16x8*)(ASC + ch_ * 4096 + (16 * kq + m) * 64 + 32 + 8 * g); \
        _Pragma("unroll") for (int tb = 0; tb < 4; ++tb) { const bf16* qp = Q1 + (row0_ + 16 * tb + m) * 1024 + h * 128 + 32 * kq + 4 * g; F.q[tb][0] = *(const unsigned long long*)qp; F.q[tb][1] = *(const unsigned long long*)(qp + 16); } \
        _Pragma("unroll") for (int i = 0; i < 2; ++i) { F.dc[i] = *(const f32x4*)(DEC + ch_ * 128 + 32 * kq + 16 * i + 4 * g); \
            _Pragma("unroll") for (int ks = 0; ks < 2; ++ks) F.ks[i][ks] = *(const bf16x8*)(KST + (ch_ * 128 + 32 * kq + 16 * i + m) * 64 + 32 * ks + 8 * g); } } while (0)
#define REC_BODY(F, Fn, c_) do { \
        if ((c_) + 1 < 32) REC_LOAD(Fn, (c_) + 1); \
        if (BGQ) { const int bgn = (bgit * 32 + (c_)) * C.NGW + C.gw; bgq_step<JOB>(C, bgi, bgn, bgv); bgi = bgn; } \
        LAS float* rb = red + ((c_) & 1) * 4096; \
        f32x4 oin = __builtin_amdgcn_mfma_f32_16x16x32_bf16(F.a0, F.vb[0], (f32x4){0.f, 0.f, 0.f, 0.f}, 0, 0, 0); \
        if (kq >= 2) oin = __builtin_amdgcn_mfma_f32_16x16x32_bf16(F.a1, F.vb[1], oin, 0, 0, 0); \
        { u32x4v sw; sw.x = pk2(S[0][0], S[0][1]); sw.y = pk2(S[0][2], S[0][3]); sw.z = pk2(S[1][0], S[1][1]); sw.w = pk2(S[1][2], S[1][3]); \
          const bf16x8 sb = __builtin_bit_cast(bf16x8, sw); \
          _Pragma("unroll") for (int tb = 0; tb < 4; ++tb) { u32x4v aw; aw.x = (unsigned)F.q[tb][0]; aw.y = (unsigned)(F.q[tb][0] >> 32); aw.z = (unsigned)F.q[tb][1]; aw.w = (unsigned)(F.q[tb][1] >> 32); \
              const f32x4 po = __builtin_amdgcn_mfma_f32_16x16x32_bf16(__builtin_bit_cast(bf16x8, aw), sb, (f32x4){0.f, 0.f, 0.f, 0.f}, 0, 0, 0); \
              *(LAS f32x4*)(rb + ((kq * 4 + tb) * 64 + l) * 4) = po; } } \
        _Pragma("unroll") for (int i = 0; i < 2; ++i) { S[i] = S[i] * F.dc[i]; \
            _Pragma("unroll") for (int ks = 0; ks < 2; ++ks) S[i] = __builtin_amdgcn_mfma_f32_16x16x32_bf16(F.ks[i][ks], F.vb[ks], S[i], 0, 0, 0); } \
        asm volatile("s_waitcnt lgkmcnt(0)" ::: "memory"); __builtin_amdgcn_s_barrier(); asm volatile("" ::: "memory"); \
        { f32x4 o = oin; \
          _Pragma("unroll") for (int k2 = 0; k2 < 4; ++k2) o = o + *(const LAS f32x4*)(rb + ((k2 * 4 + kq) * 64 + l) * 4); \
          const size_t orow = (size_t)b * SEQLEN + (c_) * 64 + 16 * kq + 4 * g; \
          _Pragma("unroll") for (int r = 0; r < 4; ++r) OF[(orow + r) * 1024 + col] = (bf16)f2bf(o[r]); } } while (0)
    constexpr int JOB = NH == 4 ? 1 : 2;
    f32x4 bgv[4]; int bgi = -1, bgit = 0;
    for (int t0 = C.vcu; t0 < NTASK / 2; t0 += C.G, ++bgit) {
        const int task = gi * (NTASK / 2) + t0;
        const int cb = task % NCB, bh = task / NCB, b = bh / NH, h = bh % NH;
        const int col = h * DV + cb * 16 + m;
        f32x4 S[2];
        S[0] = (f32x4){0.f, 0.f, 0.f, 0.f}; S[1] = S[0];
        RecFrag FA, FB;
        REC_LOAD(FA, 0);
#pragma unroll 1
        for (int c = 0; c < 32; c += 2) { REC_BODY(FA, FB, c); REC_BODY(FB, FA, c + 1); }
        asm volatile("s_waitcnt lgkmcnt(0)" ::: "memory"); __builtin_amdgcn_s_barrier(); asm volatile("" ::: "memory");
    }
    if (BGQ) {
        for (int bgn = bgit * 32 * C.NGW + C.gw; bgi < BGQ_ROWS; bgn += C.NGW) { bgq_step<JOB>(C, bgi, bgn, bgv); bgi = bgn; }
    }
#undef REC_LOAD
#undef REC_BODY
}

template <int DV>
__device__ __forceinline__ void rec_norm_gate(const Ctx& C, const float* gain, const bf16* gate) {
    const bf16* OF = (const bf16*)(C.ws + WS_OF); bf16* OB = (bf16*)(C.ws + WS_OB);
    f32x4 g[4];
#pragma unroll
    for (int j = 0; j < 4; ++j) g[j] = *((const GAS f32x4*)gain + C.lane + 64 * j);
    for (int tok0 = C.gw; tok0 < NTOK; tok0 += 4 * C.NGW) {
        unsigned long long vw[4][4], tw[4][4];
#pragma unroll
        for (int u = 0; u < 4; ++u) { const int tok = tok0 + u * C.NGW; if (tok < NTOK) {
            const GAS unsigned long long* xr = (const GAS unsigned long long*)(OF + (size_t)tok * 1024) + C.lane;
            const GAS unsigned long long* tr = (const GAS unsigned long long*)(gate + (size_t)tok * 1024) + C.lane;
#pragma unroll
            for (int j = 0; j < 4; ++j) { vw[u][j] = xr[64 * j]; tw[u][j] = tr[64 * j]; } } }
        __builtin_amdgcn_sched_barrier(0);
#pragma unroll
        for (int u = 0; u < 4; ++u) { const int tok = tok0 + u * C.NGW; if (tok < NTOK) {
            GAS unsigned long long* o8 = (GAS unsigned long long*)(OB + (size_t)tok * 1024) + C.lane;
#pragma unroll
            for (int j = 0; j < 4; ++j) {
                const f32x4 v = (f32x4){bflo((unsigned)vw[u][j]), bfhi((unsigned)vw[u][j]), bflo((unsigned)(vw[u][j] >> 32)), bfhi((unsigned)(vw[u][j] >> 32))}; float ss = (v.x * v.x + v.y * v.y) + (v.z * v.z + v.w * v.w);
                if (DV == 256) ss = wave_sum(ss); else { DPP_SUM31(ss); const float s_lo = rdlane(ss, 31), s_hi = rdlane(ss, 63); ss = C.lane < 32 ? s_lo : s_hi; }
                const float r = rsqrtf(ss * (1.f / DV) + RMS_EPS);
                const unsigned long long t8 = tw[u][j];
                const float t0 = bflo((unsigned)t8), t1 = bfhi((unsigned)t8), t2 = bflo((unsigned)(t8 >> 32)), t3 = bfhi((unsigned)(t8 >> 32));
                const float a0 = v.x * r * g[j].x * (t0 * sigmoid_f(t0)), a1 = v.y * r * g[j].y * (t1 * sigmoid_f(t1)), a2 = v.z * r * g[j].z * (t2 * sigmoid_f(t2)), a3 = v.w * r * g[j].w * (t3 * sigmoid_f(t3));
                o8[64 * j] = (unsigned long long)pk2(a0, a1) | ((unsigned long long)pk2(a2, a3) << 32);
            } } }
    }
}

#define CE_D(a, b) do { const unsigned mx_ = (a) > (b) ? (a) : (b); const unsigned mn_ = (a) > (b) ? (b) : (a); (a) = mx_; (b) = mn_; } while (0)
__device__ __forceinline__ void sort16_desc(unsigned (&a)[16]) {
#pragma unroll
    for (int k = 2; k <= 16; k <<= 1)
#pragma unroll
        for (int j = k >> 1; j > 0; j >>= 1)
#pragma unroll
            for (int i = 0; i < 16; ++i) { const int l = i ^ j; if (l > i) { if ((i & k) == 0) CE_D(a[i], a[l]); else CE_D(a[l], a[i]); } }
}
__device__ __forceinline__ void merge_top16(unsigned (&a)[16], const unsigned (&b)[16]) {
#pragma unroll
    for (int i = 0; i < 16; ++i) a[i] = a[i] > b[15 - i] ? a[i] : b[15 - i];
#pragma unroll
    for (int j = 8; j > 0; j >>= 1)
#pragma unroll
        for (int i = 0; i < 16; ++i) { const int l = i ^ j; if (l > i) CE_D(a[i], a[l]); }
}
__device__ __forceinline__ void merge_quad(unsigned (&a)[16], int lane) {
    unsigned p[16];
#pragma unroll
    for (int i = 0; i < 16; ++i) p[i] = (unsigned)__builtin_amdgcn_ds_bpermute((lane ^ 16) << 2, (int)a[i]);
    merge_top16(a, p);
#pragma unroll
    for (int i = 0; i < 16; ++i) p[i] = (unsigned)__builtin_amdgcn_ds_bpermute((lane ^ 32) << 2, (int)a[i]);
    merge_top16(a, p);
}
__device__ __forceinline__ unsigned mono_key(float f) { const unsigned u = __float_as_uint(f); return (u & 0x80000000u) ? ~u : (u | 0x80000000u); }
__device__ __forceinline__ float mono_inv(unsigned k) { return __uint_as_float((k & 0x80000000u) ? (k ^ 0x80000000u) : ~k); }
__constant__ __attribute__((aligned(16))) unsigned char PEER_CAND[64] = {0, 1, 2, 3, 4, 5, 6, 7, 8, 9, 10, 11, 12, 13, 14, 15, 16, 17, 18, 19, 20, 21, 22, 23, 32, 33, 34, 35, 36, 64, 65, 66, 48, 49, 50, 51, 80, 81, 96, 97, 112, 113, 128, 144, 160, 176, 192, 208, 224, 240, 255, 255, 255, 255, 255, 255, 255, 255, 255, 255, 255, 255, 255, 255};
__device__ __forceinline__ void peer_topk_task(const Ctx& C, int layer, int tok0, int head, int trow0, LAS int* lexp, LAS float* lgate) {
    typedef _Float16 h8 __attribute__((ext_vector_type(8)));
    const _Float16* SC = (const _Float16*)(C.ws + WS_Q2);
    LAS unsigned* L0 = (LAS unsigned*)(C.lds + C.wave * 2048);
    LAS unsigned* L1 = L0 + 256;
    {
        int l = C.lane; asm volatile("" : "+v"(l));
        const int m = l & 15, g = l >> 4;
        unsigned cand_w[4];
#pragma unroll
        for (int c = 0; c < 4; ++c) cand_w[c] = ((const unsigned*)PEER_CAND)[g * 4 + c];
        unsigned top[2][16];
#pragma unroll
        for (int p = 0; p < 2; ++p) {
            const _Float16* sp = SC + (size_t)(tok0 + m) * 2048 + head * 256 + p * 128 + 32 * g;
            h8 hv[4];
#pragma unroll
            for (int q = 0; q < 4; ++q) hv[q] = *(const h8*)(sp + 8 * q);
            unsigned hi16[16];
#pragma unroll
            for (int q = 0; q < 4; ++q)
#pragma unroll
                for (int j = 0; j < 8; ++j) { const int i = 8 * q + j; const unsigned key = (mono_key((float)hv[q][j]) & ~0x7fu) | (unsigned)(127 - (32 * g + i));
                    if (i < 16) top[p][i] = key; else hi16[i - 16] = key; }
            sort16_desc(top[p]); sort16_desc(hi16); merge_top16(top[p], hi16);
            merge_quad(top[p], l);
        }
        if (g == 0) {
#pragma unroll
            for (int i = 0; i < 16; i += 4) { *(LAS u32x4v*)(L0 + m * 16 + i) = (u32x4v){top[0][i], top[0][i + 1], top[0][i + 2], top[0][i + 3]}; *(LAS u32x4v*)(L1 + m * 16 + i) = (u32x4v){top[1][i], top[1][i + 1], top[1][i + 2], top[1][i + 3]}; }
        }
        asm volatile("s_waitcnt lgkmcnt(0)" ::: "memory"); __builtin_amdgcn_wave_barrier();
        unsigned cd[16];
#pragma unroll
        for (int c = 0; c < 16; ++c) {
            const unsigned code = (cand_w[c >> 2] >> (8 * (c & 3))) & 0xffu, ci = (code >> 4) & 15u, cj = code & 15u;
            const float v = mono_inv(L0[m * 16 + ci]) + mono_inv(L1[m * 16 + cj]);
            cd[c] = code == 255u ? 0u : ((mono_key(v) & ~0xffu) | (255u - code));
        }
        sort16_desc(cd); merge_quad(cd, l);
        if (g == 0) {
            float best[16]; int ex[16]; float sum = 0.f;
#pragma unroll
            for (int r = 0; r < 16; ++r) { const unsigned pos = 255u - (cd[r] & 0xffu), pi = pos >> 4, pj = pos & 15u;
                ex[r] = (int)((127u - (L0[m * 16 + pi] & 0x7fu)) * 128u + (127u - (L1[m * 16 + pj] & 0x7fu))); best[r] = mono_inv(cd[r]); }
            const float bmax = best[0];
#pragma unroll
            for (int r = 0; r < 16; ++r) { best[r] = __expf(best[r] - bmax); sum += best[r]; }
            const float inv = 1.f / sum;
            const int ob = (trow0 + m) * 128 + head * 16;
#pragma unroll
            for (int r = 0; r < 16; r += 4) { *(LAS u32x4v*)(lexp + ob + r) = (u32x4v){(unsigned)ex[r], (unsigned)ex[r + 1], (unsigned)ex[r + 2], (unsigned)ex[r + 3]};
                *(LAS f32x4*)(lgate + ob + r) = (f32x4){best[r] * inv, best[r + 1] * inv, best[r + 2] * inv, best[r + 3] * inv}; }
        }
        asm volatile("s_waitcnt lgkmcnt(0)" ::: "memory"); __builtin_amdgcn_wave_barrier();
    }
}
typedef float f32x2v __attribute__((ext_vector_type(2)));
#define GRP8_SUM(v) do { v = DPP_ADD(v, 0xB1, 0xf, 0xf); v = DPP_ADD(v, 0x4E, 0xf, 0xf); v = DPP_ADD(v, 0x141, 0xf, 0xf); } while (0)
#ifndef MK_HOT
#define MK_HOT 0
#endif
__device__ __forceinline__ void wave_lds_sync() { asm volatile("s_waitcnt lgkmcnt(0)" ::: "memory"); __builtin_amdgcn_wave_barrier(); }
template <bool DRY>
__device__ __forceinline__ void peer_rounds(const Ctx& C, int layer, int tokw, LAS int* lexp_w, const LAS float* lgate_w, LAS unsigned* sorted_w, LAS unsigned* hist_w) {
    const unsigned char* U = C.ws + WS_U + (size_t)layer * 16384 * 1024; const unsigned char* V = C.ws + WS_V + (size_t)layer * 16384 * 1024;
    const float* SU = (const float*)(C.ws + WS_SU) + layer * 16384; const float* SV = (const float*)(C.ws + WS_SV) + layer * 16384;
    const float* gf = C.in[2] + layer * 1024; const float* gn = C.in[1] + (layer + 1) * 1024;
    int l = C.lane; asm volatile("" : "+v"(l));
    LAS float* hbuf = (LAS float*)lexp_w;
    {
        const int t = l >> 3, s = l & 7;
#pragma unroll
        for (int k = 0; k < 8; ++k) hist_w[l + 64 * k] = 0u;
        wave_lds_sync();
        unsigned ev[16], pos[16];
#pragma unroll
        for (int k = 0; k < 16; ++k) { ev[k] = (unsigned)lexp_w[t * 128 + s + 8 * k]; pos[k] = __hip_atomic_fetch_add(hist_w + t * 64 + (ev[k] >> 8), 1u, __ATOMIC_RELAXED, __HIP_MEMORY_SCOPE_WORKGROUP); }
        wave_lds_sync();
        unsigned cnt[8], run = 0u;
#pragma unroll
        for (int j = 0; j < 8; ++j) { cnt[j] = hist_w[t * 64 + 8 * s + j]; run += cnt[j]; }
        unsigned inc = run;
#pragma unroll
        for (int o = 1; o < 8; o <<= 1) { const unsigned up = (unsigned)__builtin_amdgcn_ds_bpermute((l - o) << 2, (int)inc); if (s >= o) inc += up; }
        unsigned off = inc - run;
        wave_lds_sync();
#pragma unroll
        for (int j = 0; j < 8; ++j) { hist_w[t * 64 + 8 * s + j] = off; off += cnt[j]; }
        wave_lds_sync();
#pragma unroll
        for (int k = 0; k < 16; ++k) sorted_w[t * 128 + hist_w[t * 64 + (ev[k] >> 8)] + pos[k]] = (ev[k] << 7) | (unsigned)(s + 8 * k);
        wave_lds_sync();
    }
    asm volatile("" : "+v"(l));
    unsigned xp[8][8];
    {
        const int t = l >> 3, s = l & 7;
        const bf16* hrow = (const bf16*)(C.ws + WS_HB) + (size_t)(tokw + t) * 1024 + 16 * s;
        float ss = 0.f;
#pragma unroll
        for (int i = 0; i < 8; ++i) { const v4u a = *(const GAS v4u*)(hrow + 128 * i), b = *(const GAS v4u*)(hrow + 128 * i + 8);
            xp[i][0] = a.x; xp[i][1] = a.y; xp[i][2] = a.z; xp[i][3] = a.w; xp[i][4] = b.x; xp[i][5] = b.y; xp[i][6] = b.z; xp[i][7] = b.w;
#pragma unroll
            for (int j = 0; j < 8; ++j) { const float lo = bflo(xp[i][j]), hi = bfhi(xp[i][j]); ss += lo * lo + hi * hi; } }
        GRP8_SUM(ss);
        const float r = rsqrtf(ss * (1.f / 1024.f) + RMS_EPS);
#pragma unroll
        for (int i = 0; i < 8; ++i)
#pragma unroll
            for (int q = 0; q < 4; ++q) { const f32x4 a = *(const GAS f32x4*)(gf + 16 * s + 128 * i + 4 * q);
                xp[i][2 * q] = pk2(bflo(xp[i][2 * q]) * r * a.x, bfhi(xp[i][2 * q]) * r * a.y); xp[i][2 * q + 1] = pk2(bflo(xp[i][2 * q + 1]) * r * a.z, bfhi(xp[i][2 * q + 1]) * r * a.w); }
    }
    asm volatile("" : "+v"(l));
#define RND_LOAD(T, buf, item) do { const unsigned char* p_ = T + (size_t)((DRY && MK_HOT) ? (((item) >> 7) & 255u) : ((item) >> 7)) * 1024 + 16 * (l & 7); \
        _Pragma("unroll") for (int i = 0; i < 8; ++i) buf[i] = *(const GAS v4u*)(p_ + 128 * i); } while (0)
    {
        const int t = l >> 3, s = l & 7;
        const LAS unsigned* srt = sorted_w + t * 128;
        v4u bA[8], bB[8];
#define RND_DOT(buf, r_) do { float d = 0.f; \
            _Pragma("unroll") for (int i = 0; i < 8; ++i) { asm volatile("" : "+v"(buf[i])); _Pragma("unroll") for (int q = 0; q < 4; ++q) { \
                const f32x2v lo_ = __builtin_amdgcn_cvt_pk_f32_fp8((int)buf[i][q], false), hi_ = __builtin_amdgcn_cvt_pk_f32_fp8((int)buf[i][q], true); \
                d = dot2bf(pg8::cvt_pk_bf16(lo_.x, lo_.y), xp[i][2 * q], d); d = dot2bf(pg8::cvt_pk_bf16(hi_.x, hi_.y), xp[i][2 * q + 1], d); } } \
            GRP8_SUM(d); if (s == 0) hbuf[t * 128 + (r_)] = d; } while (0)
        RND_LOAD(U, bA, srt[0]);
#pragma unroll 1
        for (int r = 0; r < 128; r += 2) {
            RND_LOAD(U, bB, srt[r + 1]);
            RND_DOT(bA, r);
            RND_LOAD(U, bA, srt[(r + 2) & 127]);
            RND_DOT(bB, r + 1);
        }
#undef RND_DOT
    }
    wave_lds_sync();
    asm volatile("" : "+v"(l));
    {
        const int t = l >> 3, s = l & 7;
#pragma unroll
        for (int k = 0; k < 16; k += 2) {
            const int r0 = t * 128 + s + 8 * k, r1 = r0 + 8;
            const unsigned i0 = sorted_w[r0], i1 = sorted_w[r1];
            const float h0 = hbuf[r0] * SU[i0 >> 7], h1 = hbuf[r1] * SU[i1 >> 7];
            const pg8::f32x2 gl = pg8::gelu_pk((pg8::f32x2){h0, h1});
            hbuf[r0] = gl.x * lgate_w[t * 128 + (i0 & 127u)] * SV[i0 >> 7]; hbuf[r1] = gl.y * lgate_w[t * 128 + (i1 & 127u)] * SV[i1 >> 7];
        }
    }
    wave_lds_sync();
    asm volatile("" : "+v"(l));
    f32x2v y2[8][8];
#pragma unroll
    for (int i = 0; i < 8; ++i)
#pragma unroll
        for (int j = 0; j < 8; ++j) y2[i][j] = (f32x2v){0.f, 0.f};
    {
        const int t = l >> 3;
        const LAS unsigned* srt = sorted_w + t * 128; const LAS float* wv = hbuf + t * 128;
        v4u bA[8], bB[8];
#define RND_AXPY(buf, r_) do { const float w = wv[(r_)]; const f32x2v w2 = (f32x2v){w, w}; \
            _Pragma("unroll") for (int i = 0; i < 8; ++i) { asm volatile("" : "+v"(buf[i])); _Pragma("unroll") for (int q = 0; q < 4; ++q) { \
                const f32x2v lo_ = __builtin_amdgcn_cvt_pk_f32_fp8((int)buf[i][q], false), hi_ = __builtin_amdgcn_cvt_pk_f32_fp8((int)buf[i][q], true); \
                y2[i][2 * q] = w2 * lo_ + y2[i][2 * q]; y2[i][2 * q + 1] = w2 * hi_ + y2[i][2 * q + 1]; } } } while (0)
        RND_LOAD(V, bA, srt[0]);
#pragma unroll 1
        for (int r = 0; r < 128; r += 2) {
            RND_LOAD(V, bB, srt[r + 1]);
            RND_AXPY(bA, r);
            RND_LOAD(V, bA, srt[(r + 2) & 127]);
            RND_AXPY(bB, r + 1);
        }
#undef RND_AXPY
    }
#undef RND_LOAD
    asm volatile("" : "+v"(l));
    {
        const int t = l >> 3, s = l & 7;
        const bf16* hrow = (const bf16*)(C.ws + WS_HB) + (size_t)(tokw + t) * 1024 + 16 * s;
        float* hout = (DRY ? (float*)(C.ws + WS_OF) : C.out) + (size_t)(tokw + t) * 1024 + 16 * s;
        bf16* hb = (bf16*)(C.ws + (DRY ? WS_OF : WS_HB)) + (size_t)(tokw + t) * 1024 + 16 * s;
        float s2 = 0.f;
#pragma unroll
        for (int i = 0; i < 8; ++i) { const v4u a = *(const GAS v4u*)(hrow + 128 * i), b = *(const GAS v4u*)(hrow + 128 * i + 8);
            const unsigned hw[8] = {a.x, a.y, a.z, a.w, b.x, b.y, b.z, b.w};
#pragma unroll
            for (int j = 0; j < 8; ++j) { y2[i][j].x += bflo(hw[j]); y2[i][j].y += bfhi(hw[j]); s2 += y2[i][j].x * y2[i][j].x + y2[i][j].y * y2[i][j].y; }
            if (layer == DEPTH - 1) {
#pragma unroll
                for (int q = 0; q < 4; ++q) *(GAS f32x4*)(hout + 128 * i + 4 * q) = (f32x4){y2[i][2 * q].x, y2[i][2 * q].y, y2[i][2 * q + 1].x, y2[i][2 * q + 1].y};
            } else {
                *(GAS v4u*)(hb + 128 * i) = (v4u){pk2(y2[i][0].x, y2[i][0].y), pk2(y2[i][1].x, y2[i][1].y), pk2(y2[i][2].x, y2[i][2].y), pk2(y2[i][3].x, y2[i][3].y)};
                *(GAS v4u*)(hb + 128 * i + 8) = (v4u){pk2(y2[i][4].x, y2[i][4].y), pk2(y2[i][5].x, y2[i][5].y), pk2(y2[i][6].x, y2[i][6].y), pk2(y2[i][7].x, y2[i][7].y)};
            } }
        if (layer < DEPTH - 1) {
            GRP8_SUM(s2);
            const float r2 = rsqrtf(s2 * (1.f / 1024.f) + RMS_EPS);
            const bool wx8 = ((I8MASK >> (layer + 1)) & 1) != 0, wxn = ((layer + 1) % 3 != 2) || !wx8;
            bf16* xo = (bf16*)(C.ws + (DRY ? WS_GLOG : WS_XN)) + (size_t)(tokw + t) * 1024 + 16 * s; float am = 0.f;
#pragma unroll
            for (int i = 0; i < 8; ++i) { unsigned pw[8];
#pragma unroll
                for (int q = 0; q < 4; ++q) { const f32x4 a = *(const GAS f32x4*)(gn + 16 * s + 128 * i + 4 * q);
                    y2[i][2 * q].x *= r2 * a.x; y2[i][2 * q].y *= r2 * a.y; y2[i][2 * q + 1].x *= r2 * a.z; y2[i][2 * q + 1].y *= r2 * a.w;
                    am = fmaxf(fmaxf(am, fmaxf(fabsf(y2[i][2 * q].x), fabsf(y2[i][2 * q].y))), fmaxf(fabsf(y2[i][2 * q + 1].x), fabsf(y2[i][2 * q + 1].y)));
                    pw[2 * q] = pk2(y2[i][2 * q].x, y2[i][2 * q].y); pw[2 * q + 1] = pk2(y2[i][2 * q + 1].x, y2[i][2 * q + 1].y); }
                if (wxn) { *(GAS v4u*)(xo + 128 * i) = (v4u){pw[0], pw[1], pw[2], pw[3]}; *(GAS v4u*)(xo + 128 * i + 8) = (v4u){pw[4], pw[5], pw[6], pw[7]}; } }
            if (wx8) {
            am = DPP_MAX(am, 0xB1, 0xf, 0xf); am = DPP_MAX(am, 0x4E, 0xf, 0xf); am = DPP_MAX(am, 0x141, 0xf, 0xf);
            const float qi = am > 0.f ? 127.f / am : 0.f;
            signed char* xq = (signed char*)(C.ws + (DRY ? WS_GLOG + 32 * MiB : WS_XN8)) + (size_t)(tokw + t) * 1024 + 16 * s;
#pragma unroll
            for (int i = 0; i < 8; ++i) { unsigned pq[4];
#pragma unroll
                for (int q = 0; q < 4; ++q) pq[q] = q8x4(y2[i][2 * q].x * qi, y2[i][2 * q].y * qi, y2[i][2 * q + 1].x * qi, y2[i][2 * q + 1].y * qi);
                *(GAS v4u*)(xq + 128 * i) = (v4u){pq[0], pq[1], pq[2], pq[3]}; }
            if (s == 0) *(GAS float*)((float*)(C.ws + (DRY ? WS_GLOG + 48 * MiB : WS_SX)) + tokw + t) = am * (1.f / 127.f);
            }
        }
    }
}
#ifndef MK_SWEEP
#define MK_SWEEP 2
#endif
template <bool DRY>
__device__ __forceinline__ void peer_topk_gather(const Ctx& C, int layer) {
    LAS int* lexp = (LAS int*)(C.lds + 16384);
    LAS float* lgate = (LAS float*)(C.lds + 16384 + 32768);
    LAS unsigned* sorted = (LAS unsigned*)(C.lds + 16384 + 65536);
    for (int tb = C.vcu; tb < NTOK / 64; tb += C.G) {
#pragma unroll 1
        for (int q = 0; q < 4; ++q) peer_topk_task(C, layer, tb * 64 + (C.wave & 3) * 16, (C.wave >> 2) * 4 + q, (C.wave & 3) * 16, lexp, lgate);
        __syncthreads();
#if MK_SWEEP == 2
        peer_rounds<DRY>(C, layer, tb * 64 + C.wave * 8, lexp + C.wave * 1024, lgate + C.wave * 1024, sorted + C.wave * 1024, (LAS unsigned*)(C.lds + C.wave * 2048));
#elif MK_SWEEP == 1
#error removed variant
        peer_sweep<DRY>(C, layer, tb * 64 + C.wave * 8, lexp + C.wave * 1024, lgate + C.wave * 1024, sorted + C.wave * 1024, (LAS unsigned*)(C.lds + C.wave * 1024));
#else
#pragma unroll 1
        for (int t = 0; t < 8; ++t) peer_gather_token<DRY>(C, layer, tb * 64 + C.wave * 8 + t, lexp + (C.wave * 8 + t) * 128, lgate + (C.wave * 8 + t) * 128);
#endif
        __syncthreads();
    }
}

#ifndef MK_SINGLE
#define MK_SINGLE 1
#endif
#ifndef MK_FASTGEMM
#define MK_FASTGEMM 1
#endif
constexpr int STEPS = 10, NPHASE = 1 + DEPTH * STEPS;
struct Args { const float* in[21]; float* out; unsigned char* ws; int ph_lo, ph_hi; };

template <int EPI>
__device__ __forceinline__ void do_gemm(const Ctx& C, const bf16* A, const bf16* Bt, int N, bf16* Ob, int ldc, int split, const float* rs_in, const float* base, float* outf, bf16* hg, const float* gain, float* rs_out) {
    pg8::Gemm g{A, Bt, NTOK, N, 1024}; pg8::StaticOrder S; S.init(NTOK, N, C.G, C.bx);
    if constexpr (EPI == 0) { pg8::EpiBf16R<false> E{Ob, ldc, split ? 1024 : 0, PSTRIDE, rs_in}; pg8::gemm_phase<pg8::EpiBf16R<false>, pg8::StaticOrder, true, true>(C.lds, g, S, E, C.tid); }
    else if constexpr (EPI == 2) { pg8::EpiBf16R<true> E{Ob, ldc, 0, PSTRIDE, rs_in}; pg8::gemm_phase<pg8::EpiBf16R<true>, pg8::StaticOrder, true, true>(C.lds, g, S, E, C.tid); }
    else if constexpr (EPI == 3) {
        pg8::Gemm g8{A, Bt, NTOK, N, 512}; pg8::EpiI8<false> E{Ob, PSTRIDE, rs_in, gain, nullptr, nullptr, 1.f}; pg8::gemm_phase<pg8::EpiI8<false>, pg8::StaticOrder, true, true>(C.lds, g8, S, E, C.tid); }
    else if constexpr (EPI == 4) {
        pg8::Gemm g8{A, Bt, NTOK, N, 512}; pg8::EpiI8<true> E{Ob, PSTRIDE, rs_in, gain, base, (const float*)outf, FOX_C2}; pg8::gemm_phase<pg8::EpiI8<true>, pg8::StaticOrder, true, true>(C.lds, g8, S, E, C.tid); }
    else {
        bf16* HB = (bf16*)(C.ws + WS_HB); (void)outf;
        if (base) { pg8::EpiResNorm<false> E{base, HB, hg, gain, rs_out}; pg8::gemm_phase<pg8::EpiResNorm<false>, pg8::StaticOrder, true, true>(C.lds, g, S, E, C.tid); }
        else { pg8::EpiResNorm<true> E{HB, HB, hg, gain, rs_out}; pg8::gemm_phase<pg8::EpiResNorm<true>, pg8::StaticOrder, true, true>(C.lds, g, S, E, C.tid); } }
}

template <int STEP, int MIXER>
__device__ __forceinline__ void run_step(const Ctx& C, int layer) {
    const int jx = layer / 3;
    bf16* XN = (bf16*)(C.ws + WS_XN); bf16* P = (bf16*)(C.ws + WS_P); bf16* OB = (bf16*)(C.ws + WS_OB); bf16* Q2 = (bf16*)(C.ws + WS_Q2);
    if constexpr (STEP == 0) {
        const bf16* Wt = MIXER == 0 ? (const bf16*)(C.ws + WS_FOXWIN + (size_t)jx * 8 * MiB) : MIXER == 1 ? (const bf16*)(C.ws + WS_GLAWIN) : (const bf16*)(C.ws + WS_HGRNWIN);
        const float* sw = (const float*)(C.ws + WS_SW) + (MIXER == 0 ? jx * 4096 : MIXER == 1 ? 8192 : 11264);
        if (FOXFUSE && MIXER == 0) { do_gemm<4>(C, (const bf16*)(C.ws + WS_XN8), Wt, 4096, P, 1024, 1, (const float*)(C.ws + WS_SX), C.in[5] + jx * 64, (float*)(C.in[6] + jx * 64), nullptr, sw, nullptr); fox_step1<false>(C, jx); }
        else if ((I8MASK >> layer) & 1) do_gemm<3>(C, (const bf16*)(C.ws + WS_XN8), Wt, MIXER == 1 ? 3072 : 4096, P, 1024, 1, (const float*)(C.ws + WS_SX), nullptr, nullptr, nullptr, sw, nullptr);
        else do_gemm<0>(C, XN, Wt, MIXER == 1 ? 3072 : 4096, P, 1024, 1, nullptr, nullptr, nullptr, nullptr, nullptr, nullptr);
    } else if constexpr (STEP == 1) {
        if constexpr (MIXER == 0) { if (!FOXFUSE) fox_step1<true>(C, jx); }
    } else if constexpr (STEP == 2) {
        if constexpr (MIXER == 1) chunk_prepass<4>(C); else if constexpr (MIXER == 2) chunk_prepass<8>(C);
    } else if constexpr (STEP == 3) {
        if constexpr (MIXER == 0) {
            float gq = 0.f, gk = 0.f;
            for (int i = 0; i < 64; ++i) { gq = fmaxf(gq, fabsf(C.in[5][jx * 64 + i])); gk = fmaxf(gk, fabsf(C.in[6][jx * 64 + i])); }
            const float smax = 64.f * gq * gk * 0.125f * 1.4426950408889634f;
            const attn_body::AttnTensors AT{(const attn_body::bf16*)P, (const attn_body::bf16*)(P + PSTRIDE), (const attn_body::bf16*)(P + 2 * PSTRIDE), (attn_body::bf16*)OB, (const attn_body::bf16*)(P + 3 * PSTRIDE), (const float*)(C.ws + WS_TAIL), -(56.f + 2.f * smax)};
            const attn_body::StaticOrder S(C.G, C.bx);
            attn_body::attn_phase<attn_body::StaticOrder>((char*)C.lds, AT, S, C.tid);
        }
        else if constexpr (MIXER == 1) chunk_recur<4, 256>(C, P + PSTRIDE);
        else chunk_recur<8, 128>(C, P + 2 * PSTRIDE);
    } else if constexpr (STEP == 4) {
        if constexpr (MIXER == 1) rec_norm_gate<256>(C, C.in[11], P + 2 * PSTRIDE);
        else if constexpr (MIXER == 2) rec_norm_gate<128>(C, C.in[15], P + 3 * PSTRIDE);
    } else if constexpr (STEP == 5) {
        const bf16* Wt = MIXER == 0 ? (const bf16*)(C.ws + WS_FOXWOUT) + (size_t)jx * 1024 * 1024 : MIXER == 1 ? (const bf16*)(C.ws + WS_GLAWOUT) : (const bf16*)(C.ws + WS_HGRNWOUT);
        do_gemm<1>(C, OB, Wt, 1024, nullptr, 0, 0, nullptr, layer == 0 ? C.in[0] : nullptr, nullptr, XN, C.in[2] + layer * 1024, (float*)(C.ws + WS_RS));
    } else if constexpr (STEP == 6) {
    } else if constexpr (STEP == 7) {
        do_gemm<2>(C, XN, (const bf16*)(C.ws + WS_PEERWQ) + (size_t)layer * 2048 * 1024, 2048, Q2, 2048, 0, (const float*)(C.ws + WS_RS), nullptr, nullptr, nullptr, nullptr, nullptr);
    } else if constexpr (STEP == 8) {
        peer_topk_gather<false>(C, layer);
    } else if constexpr (STEP == 9) {
    } else if constexpr (STEP == 11) {
        peer_topk_gather<true>(C, layer);
    } else if constexpr (STEP == 12) {
        p0_prologue_b(C);
    } else {
        p0_prologue(C);
    }
}

__device__ __forceinline__ void make_ctx(Ctx& C, const Args& args, unsigned char* lds_raw) {
    C.lds = (LAS unsigned char*)lds_raw;
    C.tid = threadIdx.x; C.lane = C.tid & 63; C.wave = __builtin_amdgcn_readfirstlane(C.tid >> 6);
    C.G = gridDim.x; C.bx = blockIdx.x; { const int bx = blockIdx.x; C.vcu = (C.G % 8 == 0) ? (bx % 8) * (C.G / 8) + bx / 8 : bx; }
    C.gw = C.vcu * NWAVES + C.wave; C.NGW = C.G * NWAVES;
#pragma unroll
    for (int i = 0; i < 21; ++i) C.in[i] = args.in[i];
    C.out = args.out; C.ws = args.ws;
}

template <int STEP, int MIXER>
__global__ void __launch_bounds__(NWAVES * 64, 2) mk_phase(Args args, int layer) {
    extern __shared__ __attribute__((aligned(16))) unsigned char lds_raw[];
    Ctx C; make_ctx(C, args, lds_raw);
    run_step<STEP, MIXER>(C, layer);
}

template <int STEP, int MIXER>
static void launch_phase(const Args& a, int layer, int grid, hipStream_t stream) {
    static bool attr_set = false;
    if (!attr_set) { (void)hipFuncSetAttribute((const void*)mk_phase<STEP, MIXER>, hipFuncAttributeMaxDynamicSharedMemorySize, LDS_BYTES); attr_set = true; }
    hipLaunchKernelGGL((mk_phase<STEP, MIXER>), dim3(grid), dim3(NWAVES * 64), LDS_BYTES, stream, a, layer);
}
#ifndef MK_DUP
#define MK_DUP -1
#endif
#define LP(S, M) do { launch_phase<S, M>(a, layer, grid, stream); if (MK_DUP == S) launch_phase<(S == 8 ? 11 : S), M>(a, layer, grid, stream); } while (0)
template <int MIXER>
static void launch_layer(const Args& a, int layer, int grid, hipStream_t stream) {
    LP(0, MIXER);
    if (MIXER == 0) launch_phase<1, MIXER>(a, layer, grid, stream); else LP(2, MIXER);
    LP(3, MIXER);
    if (MIXER != 0) LP(4, MIXER);
    LP(5, MIXER);
    LP(7, 0);
    LP(8, 0);
}
#if MK_SINGLE
__device__ __forceinline__ const float* tab_ptr(volatile LAS unsigned long long* tab, int i) {
    const unsigned long long v = tab[i];
    const unsigned lo = __builtin_amdgcn_readfirstlane((unsigned)v), hi = __builtin_amdgcn_readfirstlane((unsigned)(v >> 32));
    return (const float*)(const GAS float*)(((unsigned long long)hi << 32) | lo);
}
__device__ __forceinline__ int lane_id_volatile() { int x; asm volatile("v_mbcnt_lo_u32_b32 %0, -1, 0\n\tv_mbcnt_hi_u32_b32 %0, -1, %0" : "=v"(x)); return x; }
__device__ __forceinline__ void make_ctx_opaque(Ctx& C, unsigned char* lds_raw, int wave_s) {
    int bx = blockIdx.x, G = gridDim.x; unsigned ldso = 0u;
    asm volatile("" : "+s"(bx), "+s"(G), "+s"(ldso), "+s"(wave_s));
    int tid = wave_s * 64 + lane_id_volatile();
    C.lds = (LAS unsigned char*)lds_raw + ldso;
    volatile LAS unsigned long long* tab = (volatile LAS unsigned long long*)(C.lds + LDSCTL_OFF);
    C.tid = tid; C.lane = tid & 63; C.wave = __builtin_amdgcn_readfirstlane(tid >> 6);
    C.G = G; C.bx = bx; C.vcu = (G % 8 == 0) ? (bx % 8) * (G / 8) + bx / 8 : bx;
    C.gw = C.vcu * NWAVES + C.wave; C.NGW = G * NWAVES;
#pragma unroll
    for (int i = 0; i < 21; ++i) C.in[i] = tab_ptr(tab, i);
    C.out = (float*)tab_ptr(tab, 21); C.ws = (unsigned char*)tab_ptr(tab, 22);
}
__device__ __forceinline__ void grid_bar(unsigned char* lds_raw, int wave_s) {
    unsigned ldso = 0u; asm volatile("" : "+s"(ldso), "+s"(wave_s));
    LAS unsigned char* lds = (LAS unsigned char*)lds_raw + ldso;
    volatile LAS unsigned long long* tab = (volatile LAS unsigned long long*)(lds + LDSCTL_OFF);
    XcdBarrier b; b.bar = (unsigned*)((unsigned char*)tab_ptr(tab, 22) + WS_CTL) + CW_BAR; b.x = xb_xcc_id(); b.st = (volatile LAS unsigned*)(lds + MISC_OFF) + 8;
    xcd_barrier(b, wave_s == 0 && lane_id_volatile() == 0);
}
#define MK_STEP(...) do { Ctx C; make_ctx_opaque(C, lds_raw, wave_s); __VA_ARGS__; } while (0)
__global__ void __launch_bounds__(NWAVES * 64, 2) mk_fwd(Args args) {
    extern __shared__ __attribute__((aligned(16))) unsigned char lds_raw[];
    const int wave_s = __builtin_amdgcn_readfirstlane(threadIdx.x >> 6);
    for (int u = threadIdx.x; u < (LDS_BYTES - LDSCTL_OFF) / 4; u += NWAVES * 64) ((LAS unsigned*)((LAS unsigned char*)lds_raw + LDSCTL_OFF))[u] = 0u;
    __syncthreads();
    if (threadIdx.x == 0) {
        LAS unsigned long long* tab = (LAS unsigned long long*)((LAS unsigned char*)lds_raw + LDSCTL_OFF);
#pragma unroll
        for (int i = 0; i < 21; ++i) tab[i] = (unsigned long long)args.in[i];
        tab[21] = (unsigned long long)args.out; tab[22] = (unsigned long long)args.ws;
    }
    (void)xcd_barrier_post((unsigned*)(args.ws + WS_CTL) + CW_BAR, (volatile LAS unsigned*)((LAS unsigned char*)lds_raw + MISC_OFF) + 8);
    __syncthreads();
    MK_STEP(p0_prologue(C));
    if (I8_NITEMS) { grid_bar(lds_raw, wave_s); MK_STEP(p0_prologue_b(C)); }
    cg::this_grid().sync();
#pragma unroll 1
    for (int layer = 0; layer < DEPTH; ++layer) {
        const int mixer = layer % 3, jx = layer / 3;
        MK_STEP(const bf16* Wt = mixer == 0 ? (const bf16*)(C.ws + WS_FOXWIN + (size_t)jx * 8 * MiB) : mixer == 1 ? (const bf16*)(C.ws + WS_GLAWIN) : (const bf16*)(C.ws + WS_HGRNWIN);
                const float* sw = (const float*)(C.ws + WS_SW) + (mixer == 0 ? jx * 4096 : mixer == 1 ? 8192 : 11264);
                if (FOXFUSE && mixer == 0) { do_gemm<4>(C, (const bf16*)(C.ws + WS_XN8), Wt, 4096, (bf16*)(C.ws + WS_P), 1024, 1, (const float*)(C.ws + WS_SX), C.in[5] + jx * 64, (float*)(C.in[6] + jx * 64), nullptr, sw, nullptr);
                    fox_step1<false>(C, jx); }
                else if (I8MASK == 15 || (I8MASK != 0 && ((I8MASK >> layer) & 1))) do_gemm<3>(C, (const bf16*)(C.ws + WS_XN8), Wt, mixer == 1 ? 3072 : 4096, (bf16*)(C.ws + WS_P), 1024, 1, (const float*)(C.ws + WS_SX), nullptr, nullptr, nullptr, sw, nullptr);
                else do_gemm<0>(C, (const bf16*)(C.ws + WS_XN), Wt, mixer == 1 ? 3072 : 4096, (bf16*)(C.ws + WS_P), 1024, 1, nullptr, nullptr, nullptr, nullptr, nullptr, nullptr));
        grid_bar(lds_raw, wave_s);
        if (!(FOXFUSE && mixer == 0)) {
        MK_STEP(if (mixer == 0) run_step<1, 0>(C, layer); else if (mixer == 1) run_step<2, 1>(C, layer); else run_step<2, 2>(C, layer));
        grid_bar(lds_raw, wave_s); }
        MK_STEP(if (mixer == 0) run_step<3, 0>(C, layer); else if (mixer == 1) run_step<3, 1>(C, layer); else run_step<3, 2>(C, layer));
        grid_bar(lds_raw, wave_s);
        if (mixer != 0) { MK_STEP(if (mixer == 1) run_step<4, 1>(C, layer); else run_step<4, 2>(C, layer)); grid_bar(lds_raw, wave_s); }
        MK_STEP(const bf16* Wt = mixer == 0 ? (const bf16*)(C.ws + WS_FOXWOUT) + (size_t)jx * 1024 * 1024 : mixer == 1 ? (const bf16*)(C.ws + WS_GLAWOUT) : (const bf16*)(C.ws + WS_HGRNWOUT);
                do_gemm<1>(C, (const bf16*)(C.ws + WS_OB), Wt, 1024, nullptr, 0, 0, nullptr, layer == 0 ? C.in[0] : nullptr, nullptr, (bf16*)(C.ws + WS_XN), C.in[2] + layer * 1024, (float*)(C.ws + WS_RS)));
        grid_bar(lds_raw, wave_s);
        MK_STEP(run_step<7, 0>(C, layer));
        grid_bar(lds_raw, wave_s);
        MK_STEP(run_step<8, 0>(C, layer));
        if (layer + 1 < DEPTH) grid_bar(lds_raw, wave_s);
    }
}
#endif

extern "C" void kernel_launch(void* const* d_in, const int* in_sizes, int n_in, void* d_out, int out_size, void* d_ws, size_t ws_size, hipStream_t stream) {
    static int grid = 0;
    if (grid == 0) {
        if (n_in != 21 || out_size != NTOK * 1024 || ws_size < WS_END) { fprintf(stderr, "kernel_launch: unexpected shapes: n_in %d out %d ws %zu (need %zu)\n", n_in, out_size, ws_size, (size_t)WS_END); grid = -1; return; }
        int dev = 0, cus = 0, per_cu = 0;
        (void)hipGetDevice(&dev); (void)hipDeviceGetAttribute(&cus, hipDeviceAttributeMultiprocessorCount, dev);
#if MK_SINGLE
        if (hipFuncSetAttribute((const void*)mk_fwd, hipFuncAttributeMaxDynamicSharedMemorySize, LDS_BYTES) != hipSuccess) { fprintf(stderr, "kernel_launch: hipFuncSetAttribute failed\n"); grid = -1; return; }
        if (hipOccupancyMaxActiveBlocksPerMultiprocessor(&per_cu, (const void*)mk_fwd, NWAVES * 64, LDS_BYTES) != hipSuccess || per_cu < 1) { fprintf(stderr, "kernel_launch: occupancy query says %d blocks per CU\n", per_cu); (void)hipGetLastError(); grid = -1; return; }
#endif
        (void)per_cu;
        grid = cus;
    }
    if (grid < 0) return;
    Args a{};
    for (int i = 0; i < 21; ++i) a.in[i] = (const float*)d_in[i];
    a.out = (float*)d_out; a.ws = (unsigned char*)d_ws;
#if MK_SINGLE
    (void)hipMemsetAsync((char*)d_ws + WS_CTL, 0, CTL_ZERO_BYTES, stream);
    a.ph_lo = 0; a.ph_hi = NPHASE;
    void* kargs[] = {&a};
    hipError_t e = hipLaunchCooperativeKernel((const void*)mk_fwd, dim3(grid), dim3(NWAVES * 64), kargs, LDS_BYTES, stream);
    if (e != hipSuccess) fprintf(stderr, "cooperative launch failed: %s (grid %d)\n", hipGetErrorString(e), grid);
#else
    (void)hipMemsetAsync((char*)d_ws + WS_CTL, 0, CTL_ZERO_BYTES, stream);
    launch_phase<10, 0>(a, 0, grid, stream); if (MK_DUP == 10) launch_phase<10, 0>(a, 0, grid, stream);
    launch_phase<12, 0>(a, 0, grid, stream);
    launch_layer<0>(a, 0, grid, stream);
    launch_layer<1>(a, 1, grid, stream);
    launch_layer<2>(a, 2, grid, stream);
    launch_layer<0>(a, 3, grid, stream);
#endif
}
```

```cpp
#include <hip/hip_runtime.h>
#include <hip/hip_cooperative_groups.h>
#include <cstdio>
#include <cstdint>
#include <cmath>
namespace pg8 {
#define PG8_LAS __attribute__((address_space(3)))
typedef unsigned short bf16_t;
typedef short bf16x8 __attribute__((ext_vector_type(8)));
typedef float f32x4 __attribute__((ext_vector_type(4)));
typedef unsigned u32x4 __attribute__((ext_vector_type(4)));
typedef int i32x4 __attribute__((ext_vector_type(4)));
constexpr int BM = 256, BK = 64, HALF = 128, HTB = HALF * BK * 2  , STAGE_BYTES = 8 * HTB, NXCD = 8, WGM = 8;

__host__ __device__ __forceinline__ int lds_byte(int r, int c) { const int st = (r >> 4) * 2 + (c >> 5), rr = r & 15, cc = c & 31, ob = rr * 64 + cc * 2; return st * 1024 + (ob ^ (((ob >> 9) & 1) << 5)); }
__host__ __device__ __forceinline__ void stage_rc(int b, int& R, int& C) { const int st = b / 1024, sb = b % 1024, swz = sb ^ (((sb >> 9) & 1) << 5); R = (st >> 1) * 16 + swz / 64; C = (st & 1) * 32 + (swz % 64) / 2; }
__host__ __device__ __forceinline__ int perm32(int rho) { const int n = rho >> 4, i = rho & 15; return 8 * (i >> 2) + 4 * n + (i & 3); }

struct Unit { int pm, pn; };
struct Gemm { const bf16_t* A; const bf16_t* Bt; int M, N, K; };

struct StaticOrder {
    int nM, nN, nwg, G, c;
    __host__ __device__ void init(int M, int N, int G_, int c_) { nM = M / BM; nN = N / BM; nwg = nM * nN; G = G_; c = c_; }
    __host__ __device__ bool next(int i, Unit& u) const {
        const long L = (long)i * G + c; if (L >= nwg) return false;
        int wgid = (int)L; { const int q = nwg / NXCD, r = nwg % NXCD, xcd = wgid % NXCD, off = wgid / NXCD; wgid = (xcd < r ? xcd * (q + 1) : r * (q + 1) + (xcd - r) * q) + off; }
        const int nig = WGM * nN, gid = wgid / nig, fm = gid * WGM, gsz = (nM - fm) < WGM ? (nM - fm) : WGM;
        u.pm = fm + ((wgid % nig) % gsz); u.pn = (wgid % nig) / gsz; return true;
    }
    __device__ __forceinline__ void a_ready(const Unit&) const {}
    __device__ __forceinline__ void done(const Unit&) const {}
};

__device__ __forceinline__ unsigned cvt_pk_bf16(float lo, float hi) { unsigned r; asm volatile("v_cvt_pk_bf16_f32 %0, %1, %2" : "=v"(r) : "v"(lo), "v"(hi)); return r; }
typedef float f32x2 __attribute__((ext_vector_type(2)));
__device__ __forceinline__ f32x2 gelu_pk(f32x2 v) {
    const f32x2 av = __builtin_elementwise_abs(v), d = av * 0.2316418882f + 1.0f;
    f32x2 t; t.x = __builtin_amdgcn_rcpf(d.x); t.y = __builtin_amdgcn_rcpf(d.y);
    f32x2 q = t * 0.5307027145f + (-0.7265760135f); q = q * t + 0.7107068705f; q = q * t + (-0.142248368f); q = q * t + 0.127414796f; q = q * t;
    const f32x2 s = (v * v) * (-0.72134752044f);
    f32x2 e; e.x = __builtin_amdgcn_exp2f(s.x); e.y = __builtin_amdgcn_exp2f(s.y);
    const f32x2 m = v * (q * e), r = v - m;
    f32x2 o; o.x = v.x < 0.f ? m.x : r.x; o.y = v.y < 0.f ? m.y : r.y; return o;
}
#ifndef EPI_AUX
#define EPI_AUX 16
#endif
template <bool F16  > struct EpiBf16R {
    typedef f32x4 acc_t;
    static constexpr bool PERM = true, AFTER_DRAIN = false;
    bf16_t* O; int ldc; int split_cols; size_t split_stride; const float* rs;
    __device__ __forceinline__ void operator()(const f32x4 (&acc)[2][2][4][2], const Unit& u, int wr, int wc, int fr, int fq) const {
        const int row0 = u.pm * BM + wr * 64 + fr; int colt = u.pn * BM; unsigned boff = 0u;
        if (split_cols) { const int t = colt / split_cols; boff = (unsigned)(t * split_stride * 2); colt -= t * split_cols; }
        const int col0 = colt + wc * 32 + 8 * fq;
        const __amdgpu_buffer_rsrc_t orsrc = __builtin_amdgcn_make_buffer_rsrc((void*)O, (short)0, 0x7ffffff0, 0x00020000);
#pragma unroll
        for (int ai = 0; ai < 2; ++ai)
#pragma unroll
            for (int m = 0; m < 4; ++m) { const int row = row0 + ai * HALF + m * 16; const unsigned roff = boff + (unsigned)(row * ldc + col0) * 2u;
                float sc = 1.f;
                if (rs) { const f32x4 a = *(const f32x4*)(rs + (size_t)row * 16), b = *(const f32x4*)(rs + (size_t)row * 16 + 4), c = *(const f32x4*)(rs + (size_t)row * 16 + 8), d = *(const f32x4*)(rs + (size_t)row * 16 + 12);
                    const float s = (((a[0] + a[1]) + (a[2] + a[3])) + ((b[0] + b[1]) + (b[2] + b[3]))) + (((c[0] + c[1]) + (c[2] + c[3])) + ((d[0] + d[1]) + (d[2] + d[3])));
                    sc = __builtin_amdgcn_rsqf(s * (1.0f / 1024.0f) + 1e-6f); }
#pragma unroll
                for (int bj = 0; bj < 2; ++bj) { const f32x4 v0 = acc[ai][bj][m][0] * sc, v1 = acc[ai][bj][m][1] * sc;
                    u32x4 w;
                    if (F16) { w.x = __builtin_bit_cast(unsigned, __builtin_amdgcn_cvt_pkrtz(v0[0], v0[1])); w.y = __builtin_bit_cast(unsigned, __builtin_amdgcn_cvt_pkrtz(v0[2], v0[3])); w.z = __builtin_bit_cast(unsigned, __builtin_amdgcn_cvt_pkrtz(v1[0], v1[1])); w.w = __builtin_bit_cast(unsigned, __builtin_amdgcn_cvt_pkrtz(v1[2], v1[3])); }
                    else { w.x = cvt_pk_bf16(v0[0], v0[1]); w.y = cvt_pk_bf16(v0[2], v0[3]); w.z = cvt_pk_bf16(v1[0], v1[1]); w.w = cvt_pk_bf16(v1[2], v1[3]); }
                    __builtin_amdgcn_raw_buffer_store_b128(w, orsrc, (int)(roff + bj * HALF * 2), 0, EPI_AUX); } }
    }
};
template <bool QKN> struct EpiI8 {
    typedef i32x4 acc_t;
    static constexpr bool PERM = true, AFTER_DRAIN = false;
    bf16_t* O; size_t split_stride; const float* sx; const float* sw; const float* gq; const float* gk; float c2;
    __device__ __forceinline__ void operator()(const i32x4 (&acc)[2][2][4][2], const Unit& u, int wr, int wc, int fr, int fq) const {
        const int row0 = u.pm * BM + wr * 64 + fr; int colt = u.pn * BM; unsigned boff;
        { const int t = colt / 1024; boff = (unsigned)(t * split_stride * 2); colt -= t * 1024; }
        const __amdgpu_buffer_rsrc_t orsrc = __builtin_amdgcn_make_buffer_rsrc((void*)O, (short)0, 0x7ffffff0, 0x00020000);
        const int scol0 = u.pn * BM + wc * 32 + 8 * fq;
        f32x4 cw[2][2];
#pragma unroll
        for (int bj = 0; bj < 2; ++bj) { cw[bj][0] = *(const f32x4*)(sw + scol0 + bj * HALF); cw[bj][1] = *(const f32x4*)(sw + scol0 + bj * HALF + 4); }
        if (QKN && u.pn < 8) {
            const float* g = u.pn < 4 ? gq : gk; const float cc = u.pn < 4 ? c2 : 1.f; const int lane = fr + 16 * fq;
            f32x4 gv[2][2];
#pragma unroll
            for (int bj = 0; bj < 2; ++bj) { gv[bj][0] = *(const f32x4*)(g + 32 * bj + 8 * fq) * cc; gv[bj][1] = *(const f32x4*)(g + 32 * bj + 8 * fq + 4) * cc; }
            const int col0 = colt + 64 * wc + 8 * fq;
#pragma unroll
            for (int ai = 0; ai < 2; ++ai)
#pragma unroll
                for (int m = 0; m < 4; ++m) { const int row = row0 + ai * HALF + m * 16; const unsigned roff = boff + (unsigned)(row * 1024 + col0) * 2u; const float rs = sx[row];
                    f32x4 v[2][2]; float ss = 0.f;
#pragma unroll
                    for (int bj = 0; bj < 2; ++bj) { const i32x4 a0 = acc[ai][bj][m][0], a1 = acc[ai][bj][m][1];
                        v[bj][0] = (f32x4){(float)a0[0], (float)a0[1], (float)a0[2], (float)a0[3]} * cw[bj][0] * rs; v[bj][1] = (f32x4){(float)a1[0], (float)a1[1], (float)a1[2], (float)a1[3]} * cw[bj][1] * rs;
                        ss += ((v[bj][0][0] * v[bj][0][0] + v[bj][0][1] * v[bj][0][1]) + (v[bj][0][2] * v[bj][0][2] + v[bj][0][3] * v[bj][0][3])) + ((v[bj][1][0] * v[bj][1][0] + v[bj][1][1] * v[bj][1][1]) + (v[bj][1][2] * v[bj][1][2] + v[bj][1][3] * v[bj][1][3])); }
                    ss += __builtin_bit_cast(float, __builtin_amdgcn_ds_bpermute((lane ^ 16) << 2, __builtin_bit_cast(int, ss)));
                    ss += __builtin_bit_cast(float, __builtin_amdgcn_ds_bpermute((lane ^ 32) << 2, __builtin_bit_cast(int, ss)));
                    const float r = __builtin_amdgcn_rsqf(ss * (1.f / 64.f) + 1e-6f);
#pragma unroll
                    for (int bj = 0; bj < 2; ++bj) { const f32x4 o0 = v[bj][0] * r * gv[bj][0], o1 = v[bj][1] * r * gv[bj][1];
                        u32x4 w; w.x = cvt_pk_bf16(o0[0], o0[1]); w.y = cvt_pk_bf16(o0[2], o0[3]); w.z = cvt_pk_bf16(o1[0], o1[1]); w.w = cvt_pk_bf16(o1[2], o1[3]);
                        __builtin_amdgcn_raw_buffer_store_b128(w, orsrc, (int)(roff + bj * 32 * 2), 0, EPI_AUX); } }
            return;
        }
        const int col0 = colt + wc * 32 + 8 * fq;
#pragma unroll
        for (int ai = 0; ai < 2; ++ai)
#pragma unroll
            for (int m = 0; m < 4; ++m) { const int row = row0 + ai * HALF + m * 16; const unsigned roff = boff + (unsigned)(row * 1024 + col0) * 2u; const float rs = sx[row];
#pragma unroll
                for (int bj = 0; bj < 2; ++bj) { const i32x4 a0 = acc[ai][bj][m][0], a1 = acc[ai][bj][m][1];
                    const f32x4 v0 = (f32x4){(float)a0[0], (float)a0[1], (float)a0[2], (float)a0[3]} * cw[bj][0] * rs, v1 = (f32x4){(float)a1[0], (float)a1[1], (float)a1[2], (float)a1[3]} * cw[bj][1] * rs;
                    u32x4 w; w.x = cvt_pk_bf16(v0[0], v0[1]); w.y = cvt_pk_bf16(v0[2], v0[3]); w.z = cvt_pk_bf16(v1[0], v1[1]); w.w = cvt_pk_bf16(v1[2], v1[3]);
                    __builtin_amdgcn_raw_buffer_store_b128(w, orsrc, (int)(roff + bj * HALF * 2), 0, EPI_AUX); } }
    }
};
template <bool BASE16> struct EpiResNorm {
    typedef f32x4 acc_t;
    static constexpr bool PERM = false, AFTER_DRAIN = false;
    const void* base; bf16_t* out; bf16_t* hg; const float* gain; float* rs;
    __device__ __forceinline__ void operator()(const f32x4 (&acc)[2][2][4][2], const Unit& u, int wr, int wc, int fr, int fq) const {
        const int col0 = u.pn * BM + wc * 32 + 4 * fq, lane = fr + 16 * fq;
        f32x4 gv[2][2];
#pragma unroll
        for (int bj = 0; bj < 2; ++bj)
#pragma unroll
            for (int n = 0; n < 2; ++n) gv[bj][n] = *(const f32x4*)(gain + col0 + bj * HALF + n * 16);
#pragma unroll
        for (int ai = 0; ai < 2; ++ai)
#pragma unroll
            for (int m = 0; m < 4; ++m) { const int r = ai * HALF + wr * 64 + m * 16 + fr; const size_t off = (size_t)(u.pm * BM + r) * 1024 + col0;
                float ss = 0.f;
#pragma unroll
                for (int bj = 0; bj < 2; ++bj)
#pragma unroll
                    for (int n = 0; n < 2; ++n) { typedef unsigned u32x2 __attribute__((ext_vector_type(2))); f32x4 b;
                        if (BASE16) { const u32x2 bw = *(const u32x2*)((const bf16_t*)base + off + bj * HALF + n * 16);
                            b = (f32x4){__builtin_bit_cast(float, bw.x << 16), __builtin_bit_cast(float, bw.x & 0xffff0000u), __builtin_bit_cast(float, bw.y << 16), __builtin_bit_cast(float, bw.y & 0xffff0000u)}; }
                        else b = *(const f32x4*)((const float*)base + off + bj * HALF + n * 16);
                        const f32x4 o = b + acc[ai][bj][m][n];
                        u32x2 wo; wo.x = cvt_pk_bf16(o[0], o[1]); wo.y = cvt_pk_bf16(o[2], o[3]); *(u32x2*)(out + off + bj * HALF + n * 16) = wo;
                        ss += (o[0] * o[0] + o[1] * o[1]) + (o[2] * o[2] + o[3] * o[3]);
                        const f32x4 h = o * gv[bj][n]; u32x2 w; w.x = cvt_pk_bf16(h[0], h[1]); w.y = cvt_pk_bf16(h[2], h[3]);
                        *(u32x2*)(hg + off + bj * HALF + n * 16) = w; }
                ss += __builtin_bit_cast(float, __builtin_amdgcn_ds_bpermute((lane ^ 16) << 2, __builtin_bit_cast(int, ss)));
                ss += __builtin_bit_cast(float, __builtin_amdgcn_ds_bpermute((lane ^ 32) << 2, __builtin_bit_cast(int, ss)));
                if (fq == 0) rs[(size_t)(u.pm * BM + r) * 16 + u.pn * 4 + wc] = ss; }
    }
};
__device__ __forceinline__ f32x4 mma16(bf16x8 a, bf16x8 b, f32x4 c) { return __builtin_amdgcn_mfma_f32_16x16x32_bf16(a, b, c, 0, 0, 0); }
__device__ __forceinline__ i32x4 mma16(bf16x8 a, bf16x8 b, i32x4 c) { return __builtin_amdgcn_mfma_i32_16x16x64_i8(__builtin_bit_cast(i32x4, a), __builtin_bit_cast(i32x4, b), c, 0, 0, 0); }
template <class Epi, class Sched, bool ALIGN_EPI = false, bool SP2 = false>
__device__ __forceinline__ void gemm_phase(PG8_LAS unsigned char* lds, const Gemm g, const Sched& S, const Epi& E, int tid_in) {
    int tid_ = tid_in; asm volatile("" : "+v"(tid_));
    const int tid = tid_, wid = __builtin_amdgcn_readfirstlane(tid >> 6), lane = tid & 63, wr = wid >> 2, wc = wid & 3, fr = lane & 15, fq = lane >> 4;
    const int K = g.K, nt = K / BK;
    unsigned voffA[2], voffB[2];
#pragma unroll
    for (int i = 0; i < 2; ++i) { int R, C; stage_rc(tid * 16 + i * 8192, R, C); const int Rb = Epi::PERM ? ((R & ~31) + perm32(R & 31)) : R;
        voffA[i] = (unsigned)(R * K + C) * 2u; voffB[i] = (unsigned)(Rb * K + C) * 2u; }
    const size_t kstep = (size_t)(BK * 2);
    const size_t hstep = (size_t)HALF * K * 2;
    const size_t tstep = 2 * hstep;
    const unsigned ldsw = (unsigned)wid * 1024u;
    const int aoff = lds_byte(wr * 64 + fr, fq * 8), boff = lds_byte(wc * 32 + fr, fq * 8);
#define PG8_SA(b, h) (((b) * 2 + (h)) * HTB)
#define PG8_SB(b, h) ((4 + (b) * 2 + (h)) * HTB)
#define PG8_STAGE(bufoff, gbase, voff) do { _Pragma("unroll") for (int _i = 0; _i < 2; ++_i) \
        __builtin_amdgcn_global_load_lds((const unsigned*)((const char*)(gbase) + (voff)[_i]), (PG8_LAS unsigned*)(lds + (bufoff) + ldsw + _i * 8192), 16, 0, 0); } while (0)
#define PG8_LDA(dst, b, h) do { _Pragma("unroll") for (int m = 0; m < 4; ++m) _Pragma("unroll") for (int k = 0; k < 2; ++k) dst[m][k] = *(const PG8_LAS bf16x8*)(lds + PG8_SA(b, h) + aoff + m * 2048 + k * 1024); } while (0)
#define PG8_LDB(dst, b, h) do { _Pragma("unroll") for (int n = 0; n < 2; ++n) _Pragma("unroll") for (int k = 0; k < 2; ++k) dst[n][k] = *(const PG8_LAS bf16x8*)(lds + PG8_SB(b, h) + boff + n * 2048 + k * 1024); } while (0)
#define PG8_MMA(ai, bj, At, Bt) do { __builtin_amdgcn_s_setprio(1); _Pragma("unroll") for (int m = 0; m < 4; ++m) _Pragma("unroll") for (int n = 0; n < 2; ++n) _Pragma("unroll") for (int k = 0; k < 2; ++k) \
        acc[ai][bj][m][n] = mma16(Bt[n][k], At[m][k], acc[ai][bj][m][n]); __builtin_amdgcn_s_setprio(0); } while (0)
#define PG8_WAIT_V(n) asm volatile("s_waitcnt vmcnt(" #n ")" ::: "memory")
#define PG8_WAIT_L(n) asm volatile("s_waitcnt lgkmcnt(" #n ")" ::: "memory")
#define PG8_BAR __builtin_amdgcn_s_barrier()
#define PG8_SCHED __builtin_amdgcn_sched_barrier(0)
    Unit cur, nxt; int ui = 0;
    if (!S.next(0, cur)) return;
    typedef typename Epi::acc_t acc_t;
    acc_t acc[2][2][4][2];
#pragma unroll
    for (int a = 0; a < 2; ++a)
#pragma unroll
        for (int b = 0; b < 2; ++b)
#pragma unroll
            for (int m = 0; m < 4; ++m)
#pragma unroll
                for (int n = 0; n < 2; ++n) acc[a][b][m][n] = (acc_t){0, 0, 0, 0};
    bf16x8 At[4][2], B0[2][2], B1[2][2];
    const char* cA = (const char*)g.A + (size_t)cur.pm * tstep; const char* cB = (const char*)g.Bt + (size_t)cur.pn * tstep;
    S.a_ready(cur);
    if constexpr (SP2) {
        PG8_STAGE(PG8_SB(0, 0), cB, voffB); PG8_STAGE(PG8_SB(0, 1), cB + hstep, voffB); PG8_STAGE(PG8_SA(0, 0), cA, voffA); PG8_STAGE(PG8_SA(0, 1), cA + hstep, voffA);
        if (wr == 1) PG8_BAR;
        PG8_WAIT_V(2); PG8_BAR;
        PG8_STAGE(PG8_SB(1, 0), cB + kstep, voffB); PG8_STAGE(PG8_SA(1, 0), cA + kstep, voffA); PG8_STAGE(PG8_SB(1, 1), cB + hstep + kstep, voffB);
        PG8_WAIT_V(6); PG8_BAR;
    } else {
        PG8_STAGE(PG8_SB(0, 0), cB, voffB); PG8_STAGE(PG8_SA(0, 0), cA, voffA); PG8_STAGE(PG8_SB(0, 1), cB + hstep, voffB); PG8_STAGE(PG8_SA(0, 1), cA + hstep, voffA);
        if (wr == 1) PG8_BAR;
        PG8_WAIT_V(4); PG8_BAR;
        PG8_STAGE(PG8_SB(1, 0), cB + kstep, voffB); PG8_STAGE(PG8_SA(1, 0), cA + kstep, voffA); PG8_STAGE(PG8_SB(1, 1), cB + hstep + kstep, voffB);
        PG8_WAIT_V(6); PG8_BAR;
    }
    for (;;) {
        const bool has_next = S.next(ui + 1, nxt);
        const char* nA = has_next ? (const char*)g.A + (size_t)nxt.pm * tstep : cA; const char* nB = has_next ? (const char*)g.Bt + (size_t)nxt.pn * tstep : cB;
        for (int t = 0; t < nt; t += 2) {
            const bool last = (t == nt - 2);
            const char* a1 = cA + (size_t)(t + 1) * kstep;
            const char* a2 = last ? nA : cA + (size_t)(t + 2) * kstep; const char* b2 = last ? nB : cB + (size_t)(t + 2) * kstep;
            const char* a3 = a2 + kstep; const char* b3 = b2 + kstep;
            if (last && has_next) S.a_ready(nxt);
            if constexpr (SP2) {
            PG8_LDB(B0, 0, 0); PG8_LDB(B1, 0, 1); PG8_SCHED; PG8_LDA(At, 0, 0); PG8_STAGE(PG8_SA(1, 1), a1 + hstep, voffA);
            PG8_WAIT_V(8); PG8_WAIT_L(0); PG8_BAR; PG8_MMA(0, 0, At, B0); PG8_MMA(0, 1, At, B1); PG8_BAR; PG8_SCHED;
            PG8_LDA(At, 0, 1); PG8_STAGE(PG8_SB(0, 0), b2, voffB); PG8_STAGE(PG8_SB(0, 1), b2 + hstep, voffB); PG8_STAGE(PG8_SA(0, 0), a2, voffA);
            PG8_WAIT_V(8); PG8_WAIT_L(0); PG8_BAR; PG8_MMA(1, 0, At, B0); PG8_MMA(1, 1, At, B1); PG8_BAR; PG8_SCHED;
            PG8_LDB(B0, 1, 0); PG8_LDB(B1, 1, 1); PG8_SCHED; PG8_LDA(At, 1, 0); PG8_STAGE(PG8_SA(0, 1), a2 + hstep, voffA);
            PG8_WAIT_V(8); PG8_WAIT_L(0); PG8_BAR; PG8_MMA(0, 0, At, B0); PG8_MMA(0, 1, At, B1); PG8_BAR; PG8_SCHED;
            PG8_LDA(At, 1, 1); PG8_STAGE(PG8_SB(1, 0), b3, voffB); PG8_STAGE(PG8_SB(1, 1), b3 + hstep, voffB); PG8_STAGE(PG8_SA(1, 0), a3, voffA);
            PG8_WAIT_V(8); PG8_WAIT_L(0); PG8_BAR; PG8_MMA(1, 0, At, B0); PG8_MMA(1, 1, At, B1); PG8_BAR; PG8_SCHED;
            } else {
            PG8_LDB(B0, 0, 0); PG8_SCHED; PG8_LDA(At, 0, 0); PG8_STAGE(PG8_SA(1, 1), a1 + hstep, voffA);
            PG8_WAIT_L(8); PG8_BAR; PG8_WAIT_L(0); PG8_MMA(0, 0, At, B0); PG8_BAR; PG8_SCHED;
            PG8_LDB(B1, 0, 1); PG8_STAGE(PG8_SB(0, 0), b2, voffB);
            PG8_BAR; PG8_WAIT_L(0); PG8_MMA(0, 1, At, B1); PG8_BAR;
            PG8_LDA(At, 0, 1); PG8_STAGE(PG8_SA(0, 0), a2, voffA);
            PG8_BAR; PG8_WAIT_L(0); PG8_MMA(1, 0, At, B0); PG8_BAR; PG8_SCHED;
            PG8_STAGE(PG8_SB(0, 1), b2 + hstep, voffB);
            PG8_WAIT_V(6); PG8_BAR; PG8_MMA(1, 1, At, B1); PG8_BAR;
            PG8_LDB(B0, 1, 0); PG8_SCHED; PG8_LDA(At, 1, 0); PG8_STAGE(PG8_SA(0, 1), a2 + hstep, voffA);
            PG8_WAIT_L(8); PG8_BAR; PG8_WAIT_L(0); PG8_MMA(0, 0, At, B0); PG8_BAR; PG8_SCHED;
            PG8_LDB(B1, 1, 1); PG8_STAGE(PG8_SB(1, 0), b3, voffB);
            PG8_BAR; PG8_WAIT_L(0); PG8_MMA(0, 1, At, B1); PG8_BAR;
            PG8_LDA(At, 1, 1); PG8_STAGE(PG8_SA(1, 0), a3, voffA);
            PG8_BAR; PG8_WAIT_L(0); PG8_MMA(1, 0, At, B0); PG8_BAR; PG8_SCHED;
            PG8_STAGE(PG8_SB(1, 1), b3 + hstep, voffB);
            PG8_WAIT_V(6); PG8_BAR; PG8_MMA(1, 1, At, B1); PG8_BAR;
            }
        }
        if constexpr (ALIGN_EPI) { if (wr == 0) PG8_BAR; }
        if constexpr (!Epi::AFTER_DRAIN) { E(acc, cur, wr, wc, fr, fq); S.done(cur); }
        if (!has_next) break;
#pragma unroll
        for (int a = 0; a < 2; ++a)
#pragma unroll
            for (int b = 0; b < 2; ++b)
#pragma unroll
                for (int m = 0; m < 4; ++m)
#pragma unroll
                    for (int n = 0; n < 2; ++n) acc[a][b][m][n] = (acc_t){0, 0, 0, 0};
        cur = nxt; cA = nA; cB = nB; ++ui;
        if constexpr (ALIGN_EPI) { if (wr == 1) PG8_BAR; }
    }
    PG8_WAIT_V(0);
    if constexpr (!ALIGN_EPI) { if (wr == 0) PG8_BAR; }
    PG8_BAR;
    if constexpr (Epi::AFTER_DRAIN) { E.fused(acc, cur, wr, wc, fr, fq, lds, wid, lane); S.done(cur); }
#undef PG8_SA
#undef PG8_SB
#undef PG8_STAGE
#undef PG8_LDA
#undef PG8_LDB
#undef PG8_MMA
#undef PG8_WAIT_V
#undef PG8_WAIT_L
#undef PG8_BAR
#undef PG8_SCHED
}
}
#include <hip/hip_bf16.h>
#include <cmath>
namespace attn_body {
using bf16=__hip_bfloat16;
using bf16x8=__attribute__((ext_vector_type(8)))short;
using s16x4=__attribute__((ext_vector_type(4)))short;
using f32x16=__attribute__((ext_vector_type(16)))float;
using u32x4=__attribute__((ext_vector_type(4)))unsigned;
constexpr int BATCH=8,NHEAD=16,SEQ=2048,D=64,DM=NHEAD*D;
constexpr int NW=8,QBLK=32,QB=QBLK*NW,KVBLK=64,NQB=SEQ/QB;
constexpr int ATTN_PITCH=DM, ATTN_UNIT_ROWS=QB;
__device__ __forceinline__ int crow(int r,int hi){return (r&3)+8*(r>>2)+4*hi;}
#define SBAR() __builtin_amdgcn_sched_barrier(0)
__device__ __forceinline__ void cmask(f32x16&p0,f32x16&p1,int jb,int qrel,int hi){
  const float NEG=-INFINITY; int kb=64*jb+4*hi;
  #pragma unroll
  for(int r=0;r<16;++r){int kv=kb+(r&3)+8*(r>>2); if(kv>qrel)p0[r]=NEG; if(kv+32>qrel)p1[r]=NEG;}
}

constexpr int NSLOT=3, SLOTB=8192;
constexpr int LDS_K=0, LDS_V=NSLOT*SLOTB, LDS_WS=2*NSLOT*SLOTB, LDS_OST=LDS_WS+NW*64*4, LDS_CS=LDS_OST+NW*4096, LDS_BYTES=LDS_CS+SEQ*4;
constexpr float C2=0.125f*1.4426950408889634f;
__device__ __forceinline__ void glds16(const void*gsrc,unsigned lds_dst){unsigned keep;
  asm volatile("s_mov_b32 %0, m0\n\ts_mov_b32 m0, %2\n\ts_nop 0\n\tglobal_load_lds_dwordx4 %1, off\n\ts_mov_b32 m0, %0":"=&s"(keep):"v"(gsrc),"s"(lds_dst):"memory");}
__device__ __forceinline__ float max3f(float a,float b,float c){float r;asm("v_max3_f32 %0, %1, %2, %3":"=v"(r):"v"(a),"v"(b),"v"(c));return r;}
__device__ __forceinline__ float max2f(float a,float b){float r;asm("v_max_f32_e32 %0, %1, %2":"=v"(r):"v"(a),"v"(b));return r;}
__device__ __forceinline__ float fadd_s(float a,float b){float r;asm("v_add_f32_e32 %0, %1, %2":"=v"(r):"v"(a),"v"(b));return r;}
__device__ __forceinline__ float fsub_s(float a,float b){float r;asm("v_sub_f32_e32 %0, %1, %2":"=v"(r):"v"(a),"v"(b));return r;}
typedef float f32x2_t __attribute__((ext_vector_type(2))); typedef __bf16 bf16x2_t __attribute__((ext_vector_type(2)));
__device__ __forceinline__ unsigned cvtpk_s(float lo,float hi){f32x2_t v={lo,hi};bf16x2_t b=__builtin_convertvector(v,bf16x2_t);return __builtin_bit_cast(unsigned,b);}
#define WAIT_BAR(N) asm volatile("s_waitcnt vmcnt(" #N ") lgkmcnt(0)\n\ts_barrier":::"memory")

typedef __attribute__((address_space(3))) const char* lds_cptr;
__device__ __forceinline__ void qkt(f32x16&p0,f32x16&p1,const char*Kslot,lds_cptr qls,bf16x8 ax0,bf16x8 ax1,bf16x8 qx,int r32,int hi){
  const char*kb=Kslot+hi*1024+r32*16; const f32x16 z16=f32x16{};
  p0=__builtin_amdgcn_mfma_f32_32x32x16_bf16(ax0,qx,z16,0,0,0);p1=__builtin_amdgcn_mfma_f32_32x32x16_bf16(ax1,qx,z16,0,0,0);
  #pragma unroll
  for(int d0=0;d0<4;++d0){
    const bf16x8 b0=*reinterpret_cast<const bf16x8*>(kb+d0*2048);
    const bf16x8 b1=*reinterpret_cast<const bf16x8*>(kb+d0*2048+512);
    const bf16x8 qd=*(const __attribute__((address_space(3))) bf16x8*)(qls+d0*1024);
    p0=__builtin_amdgcn_mfma_f32_32x32x16_bf16(b0,qd,p0,0,0,0);p1=__builtin_amdgcn_mfma_f32_32x32x16_bf16(b1,qd,p1,0,0,0);}
}
typedef short v4i16_t __attribute__((ext_vector_type(4)));
__device__ __forceinline__ void kload8(bf16x8*kf,lds_cptr kp){
  kf[0]=*(const __attribute__((address_space(3))) bf16x8*)(kp);      kf[1]=*(const __attribute__((address_space(3))) bf16x8*)(kp+512);
  kf[2]=*(const __attribute__((address_space(3))) bf16x8*)(kp+2048); kf[3]=*(const __attribute__((address_space(3))) bf16x8*)(kp+2560);
  kf[4]=*(const __attribute__((address_space(3))) bf16x8*)(kp+4096); kf[5]=*(const __attribute__((address_space(3))) bf16x8*)(kp+4608);
  kf[6]=*(const __attribute__((address_space(3))) bf16x8*)(kp+6144); kf[7]=*(const __attribute__((address_space(3))) bf16x8*)(kp+6656);
}
__device__ __forceinline__ void kload2(bf16x8*kf,lds_cptr kp,int j){ kf[2*j]=*(const __attribute__((address_space(3))) bf16x8*)(kp+j*2048); kf[2*j+1]=*(const __attribute__((address_space(3))) bf16x8*)(kp+j*2048+512); }
__device__ __forceinline__ s16x4 vtr(lds_cptr p){ return __builtin_bit_cast(s16x4,__builtin_amdgcn_ds_read_tr16_b64_v4i16((__attribute__((address_space(3))) v4i16_t*)p)); }
__device__ __forceinline__ float rowmax(const f32x16&p0,const f32x16&p1){
  float a=max3f(p0[0],p0[1],p1[0]),b=max3f(p0[2],p0[3],p1[1]);a=max3f(a,p1[2],p1[3]);
  #pragma unroll
  for(int r=4;r<16;r+=4){a=max3f(a,p0[r],p0[r+1]);b=max3f(b,p0[r+2],p0[r+3]);a=max3f(a,p1[r],p1[r+1]);b=max3f(b,p1[r+2],p1[r+3]);}
  const float m=max2f(a,b);
  auto rr=__builtin_amdgcn_permlane32_swap(__float_as_uint(m),__float_as_uint(m),false,false);
  return max2f(__uint_as_float(rr[0]),__uint_as_float(rr[1]));
}
__device__ __forceinline__ void pv(f32x16*o,int vb,bf16x8 pa0,bf16x8 pa1,bf16x8 pa2,bf16x8 pa3){
  #pragma unroll
  for(int d0=0;d0<2;++d0){s16x4 lo[4],hi[4];
    #pragma unroll
    for(int ks=0;ks<4;++ks){
      asm volatile("ds_read_b64_tr_b16 %0,%1 offset:%c2":"=&v"(lo[ks]):"v"(vb),"i"(d0*4096+ks*1024):"memory");
      asm volatile("ds_read_b64_tr_b16 %0,%1 offset:%c2":"=&v"(hi[ks]):"v"(vb),"i"(d0*4096+ks*1024+512):"memory");}
    asm volatile("s_waitcnt lgkmcnt(0)":::"memory");SBAR();
    #define PK(k) (bf16x8){lo[k][0],lo[k][1],lo[k][2],lo[k][3],hi[k][0],hi[k][1],hi[k][2],hi[k][3]}
    o[d0]=__builtin_amdgcn_mfma_f32_32x32x16_bf16(pa0,PK(0),o[d0],0,0,0);
    o[d0]=__builtin_amdgcn_mfma_f32_32x32x16_bf16(pa1,PK(1),o[d0],0,0,0);
    o[d0]=__builtin_amdgcn_mfma_f32_32x32x16_bf16(pa2,PK(2),o[d0],0,0,0);
    o[d0]=__builtin_amdgcn_mfma_f32_32x32x16_bf16(pa3,PK(3),o[d0],0,0,0);
    #undef PK
  }
}

__device__ __forceinline__ void split3(float c,unsigned&hb,unsigned&mb,unsigned&lb){
  hb=__float_as_uint(c)&0xffff0000u; const float r1=c-__uint_as_float(hb); mb=__float_as_uint(r1)&0xffff0000u; const float r2=r1-__uint_as_float(mb); lb=__float_as_uint(r2)&0xffff0000u; }
__device__ __forceinline__ bf16x8 make_ax(float negc){ unsigned hb,mb,lb; split3(negc,hb,mb,lb);
  u32x4 w; w.x=(hb>>16)|mb; w.y=(lb>>16)|0x3f800000u; w.z=0x3f803f80u; w.w=0u; return __builtin_bit_cast(bf16x8,w); }
__device__ __forceinline__ bf16x8 make_qx(float negm,unsigned hm){ unsigned hb,mb,lb; split3(negm,hb,mb,lb);
  u32x4 w; w.x=0x3f803f80u&hm; w.y=(0x3f80u|hb)&hm; w.z=((mb>>16)|lb)&hm; w.w=0u; return __builtin_bit_cast(bf16x8,w); }
#ifndef ATTN_STORE16
#define ATTN_STORE16(p,v) (*(u32x4*)(p)=(v))
#endif
template<int THRL> __device__ __forceinline__ void attn_unit(int b,int h,int qb,const bf16*Q,const bf16*__restrict__ K,const bf16*__restrict__ V,bf16*O,const bf16*__restrict__ Gt,char*shm,const int tid_u,const float skip_thr){
  int tid=tid_u; asm volatile("":"+v"(tid));
  const int lane=tid&63,r32=lane&31,hi=lane>>5; const int wid=__builtin_amdgcn_readfirstlane(tid>>6);
  const long rowbase=(long)b*SEQ; const int q0=qb*QB;
  const bf16*Qw=Q+(rowbase+q0+wid*QBLK)*DM+h*D;
  float*csp=(float*)(shm+LDS_CS);
  int tskip=0;
  { const float cq0=csp[q0]; const int ntall=(q0+QB)/KVBLK; while(tskip+2<=ntall-4 && csp[KVBLK*(tskip+1)+KVBLK-1]-cq0<skip_thr)tskip+=2; tskip=__builtin_amdgcn_readfirstlane(tskip); }
  const bf16*Kh=K+(rowbase+(long)tskip*KVBLK)*DM+h*D,*Vh=V+(rowbase+(long)tskip*KVBLK)*DM+h*D;
  const unsigned lds0=(unsigned)(uintptr_t)shm;
  float*wsf=(float*)(shm+LDS_WS)+wid*64;
  const unsigned koff=(unsigned)(lane*DM+wid*8), voff=(unsigned)((16*(wid&3)+(lane>>2))*DM+(wid>>2)*32+(lane&3)*8);
  const unsigned kdst=lds0+LDS_K+wid*1024, vdst=lds0+LDS_V+wid*1024;
  #define DMA_K(t,slot) do{unsigned o_=koff;asm volatile("":"+v"(o_));glds16(Kh+(long)(t)*KVBLK*DM+o_,(unsigned)__builtin_amdgcn_readfirstlane(kdst+(slot)));}while(0)
  #define DMA_V(t,slot) do{unsigned o_=voff;asm volatile("":"+v"(o_));glds16(Vh+(long)(t)*KVBLK*DM+o_,(unsigned)__builtin_amdgcn_readfirstlane(vdst+(slot)));}while(0)
  const int vb0=(int)(lds0+LDS_V)+((lane>>4)&1)*32+(lane&3)*8+(4*hi+((lane&15)>>2))*64;
  const char*Kbase=shm+LDS_K; bf16x8 kf[8];
  const lds_cptr shm3=(lds_cptr)shm; const lds_cptr kp0=shm3+LDS_K+hi*1024+r32*16; const lds_cptr vp0=shm3+LDS_V+((lane>>4)&1)*32+(lane&3)*8+(4*hi+((lane&15)>>2))*64;
  const int NT=(q0+QB)/KVBLK-tskip;
  const float*cst=csp+tskip*KVBLK;
  const unsigned hm=hi?0u:0xffffffffu;
  DMA_K(0,0);DMA_V(0,0);DMA_K(1,SLOTB);
  const lds_cptr qls=shm3+LDS_OST+wid*4096+hi*512+r32*16;
  { bf16x8 qr[4];
    #pragma unroll
    for(int d0=0;d0<4;++d0)qr[d0]=*reinterpret_cast<const bf16x8*>(&Qw[(long)r32*DM+d0*16+hi*8]);
    #pragma unroll
    for(int d0=0;d0<4;++d0)*(__attribute__((address_space(3))) bf16x8*)(shm3+LDS_OST+wid*4096+hi*512+r32*16+d0*1024)=qr[d0]; }
  #define QLD(k) (*(const __attribute__((address_space(3))) bf16x8*)(qls+(k)*1024))
  float mhat=csp[q0+wid*QBLK+r32],l_reg=0.f;f32x16 o[2];o[0]=f32x16{};o[1]=f32x16{}; bf16x8 qx=make_qx(-mhat,hm);
  const int qrel=wid*QBLK+r32;
  #define CMASK(P0,P1,t) do{int jb_=(t)-(NT-4); if(jb_>=0)cmask(P0,P1,jb_,qrel,hi);}while(0)
  bool resc=false;
  #define START(P0,P1) do{ const float rm=rowmax(P0,P1); resc=false; \
    if(__any(rm>(float)THRL)){ const float dl=__builtin_fmaxf(rm,0.f); mhat=fadd_s(mhat,dl); \
      _Pragma("unroll") for(int r=0;r<16;++r){P0[r]=fsub_s(P0[r],dl);P1[r]=fsub_s(P1[r],dl);} \
      qx=make_qx(-mhat,hm); } \
    _Pragma("unroll") for(int r=0;r<16;++r)P0[r]=__builtin_amdgcn_exp2f(P0[r]); }while(0)
  #define RESC() do{ if(resc){ asm volatile("s_waitcnt lgkmcnt(0)":::"memory"); \
      _Pragma("unroll") for(int d_=0;d_<2;++d_) _Pragma("unroll") for(int r=0;r<16;++r)o[d_][r]*=wsf[crow(r,hi)]; } }while(0)
  f32x16 pA0,pA1,pB0,pB1;
  int sl_prev=0,sl_cur=0,sl_next=SLOTB;
  #define ROT() do{sl_prev=sl_cur;sl_cur=sl_next;sl_next=(sl_next==(NSLOT-1)*SLOTB)?0:sl_next+SLOTB;}while(0)
  DMA_K(2,2*SLOTB);
  WAIT_BAR(3);
  qkt(pA0,pA1,Kbase,qls,make_ax(cst[r32]),make_ax(cst[32+r32]),qx,r32,hi);asm volatile("s_nop 15\n\ts_nop 7":"+v"(pA0),"+v"(pA1));CMASK(pA0,pA1,0);
  START(pA0,pA1);
  _Pragma("unroll") for(int r=0;r<16;++r)pA1[r]=__builtin_amdgcn_exp2f(pA1[r]);
  WAIT_BAR(0);
  DMA_K(3,0);DMA_V(1,SLOTB);
  ROT();
  kload8(kf,kp0+sl_cur);
  WAIT_BAR(2);
  s16x4 vlo[8],vhi[8]; u32x4 pw0,pw1,pw2,pw3;
  #define PKW(P,B) cvtpk_s(P[B],P[B+1])
  #define PAF(k) __builtin_bit_cast(bf16x8,pw##k)
  #define VFR(i) (bf16x8){vlo[i][0],vlo[i][1],vlo[i][2],vlo[i][3],vhi[i][0],vhi[i][1],vhi[i][2],vhi[i][3]}
  #define PIN(x) asm volatile("":"+v"(x))
  #define MX3(a,b,c) __builtin_fmaxf(__builtin_fmaxf((a),(b)),(c))
  #define GAPA(MF,A0,A1,A2,A3,W0,W1,PW) do{ MF; sacc+=A0; sacc+=A1; sacc+=A2; sacc+=A3; PIN(sacc); W0; W1; PIN(PW); SBAR(); }while(0)
  #define EX(v) __builtin_amdgcn_exp2f(v)
  #define GAPB(MF,X,B) do{ MF; X[B]=EX(X[B]); X[B+1]=EX(X[B+1]); X[B+2]=EX(X[B+2]); X[B+3]=EX(X[B+3]); PIN(X); SBAR(); }while(0)
  #define VRD(i) do{ vlo[i]=vtr(vp_+(((i)>>2)*4096+((i)&3)*1024)); vhi[i]=vtr(vp_+(((i)>>2)*4096+((i)&3)*1024+512)); }while(0)
  #define KRD(G,j) do{ if(G){ kload2(kf,kp0+sl_next,j); SBAR(); } }while(0)
  #define STEP(C0,C1,P0,P1,t,GK,GV,GL) do{ SBAR(); \
    const lds_cptr vp_=vp0+sl_prev; \
    const bf16x8 ax0_=make_ax(cst[(t)*KVBLK+r32]), ax1_=make_ax(cst[(t)*KVBLK+32+r32]); \
    C0=__builtin_amdgcn_mfma_f32_32x32x16_bf16(ax0_,qx,f32x16{},0,0,0); C1=__builtin_amdgcn_mfma_f32_32x32x16_bf16(ax1_,qx,f32x16{},0,0,0); SBAR(); \
    bf16x8 q0_=QLD(0), q1_=QLD(1); \
    VRD(0); SBAR(); float sacc=(P0[0]+P0[1]); \
    GAPA(C0=__builtin_amdgcn_mfma_f32_32x32x16_bf16(kf[0],q0_,C0,0,0,0), P0[2],P0[3],P0[4],P0[5],     pw0[0]=PKW(P0,0), pw0[1]=PKW(P0,2), pw0); \
    VRD(4); SBAR(); GAPA(C1=__builtin_amdgcn_mfma_f32_32x32x16_bf16(kf[1],q0_,C1,0,0,0), P0[6],P0[7],P0[8],P0[9],     pw0[2]=PKW(P0,4), pw0[3]=PKW(P0,6), pw0); q0_=QLD(2); \
    VRD(1); SBAR(); GAPA(C0=__builtin_amdgcn_mfma_f32_32x32x16_bf16(kf[2],q1_,C0,0,0,0),   P0[10],P0[11],P0[12],P0[13], pw1[0]=PKW(P0,8), pw1[1]=PKW(P0,10), pw1); \
    VRD(5); SBAR(); GAPA(C1=__builtin_amdgcn_mfma_f32_32x32x16_bf16(kf[3],q1_,C1,0,0,0),   P0[14],P0[15],P1[0],P1[1],   pw1[2]=PKW(P0,12),pw1[3]=PKW(P0,14), pw1); q1_=QLD(3); \
    VRD(2); SBAR(); GAPA(C0=__builtin_amdgcn_mfma_f32_32x32x16_bf16(kf[4],q0_,C0,0,0,0),   P1[2],P1[3],P1[4],P1[5],     pw2[0]=PKW(P1,0), pw2[1]=PKW(P1,2), pw2); \
    VRD(6); SBAR(); GAPA(C1=__builtin_amdgcn_mfma_f32_32x32x16_bf16(kf[5],q0_,C1,0,0,0),   P1[6],P1[7],P1[8],P1[9],     pw2[2]=PKW(P1,4), pw2[3]=PKW(P1,6), pw2); \
    VRD(3); SBAR(); GAPA(C0=__builtin_amdgcn_mfma_f32_32x32x16_bf16(kf[6],q1_,C0,0,0,0),   P1[10],P1[11],P1[12],P1[13], pw3[0]=PKW(P1,8), pw3[1]=PKW(P1,10), pw3); \
    VRD(7); SBAR(); GAPA(C1=__builtin_amdgcn_mfma_f32_32x32x16_bf16(kf[7],q1_,C1,0,0,0),   P1[14],P1[15],0.f,0.f,       pw3[2]=PKW(P1,12),pw3[3]=PKW(P1,14), pw3); \
    l_reg+=sacc; \
    if(GK){DMA_K((t)+3,sl_cur);} if(GV){DMA_V((t)+1,sl_next);} \
    CMASK(C0,C1,t); \
    { float a=MX3(C0[0],C0[1],C1[0]),b=MX3(C0[2],C0[3],C1[1]); a=MX3(a,C1[2],C1[3]); \
      _Pragma("unroll") for(int r=4;r<16;r+=4){a=MX3(a,C0[r],C0[r+1]);b=MX3(b,C0[r+2],C0[r+3]);a=MX3(a,C1[r],C1[r+1]);b=MX3(b,C1[r+2],C1[r+3]);} \
      float rm=__builtin_fmaxf(a,b); { auto rr=__builtin_amdgcn_permlane32_swap(__float_as_uint(rm),__float_as_uint(rm),false,false); rm=__builtin_fmaxf(__uint_as_float(rr[0]),__uint_as_float(rr[1])); } \
      resc=false; \
      if(__builtin_expect(__any(rm>(float)THRL),0)){ const float dl=__builtin_fmaxf(rm,0.f); mhat+=dl; \
        _Pragma("unroll") for(int r=0;r<16;++r){C0[r]-=dl;C1[r]-=dl;} \
        qx=make_qx(-mhat,hm); \
        const float f=__builtin_amdgcn_exp2f(-dl); l_reg*=f; if(hi==0)wsf[r32]=f; resc=true; } } \
    SBAR(); \
    GAPB(o[0]=__builtin_amdgcn_mfma_f32_32x32x16_bf16(PAF(0),VFR(0),o[0],0,0,0), C0,0); \
    GAPB(o[1]=__builtin_amdgcn_mfma_f32_32x32x16_bf16(PAF(0),VFR(4),o[1],0,0,0), C0,4); \
    KRD(GL,0); GAPB(o[0]=__builtin_amdgcn_mfma_f32_32x32x16_bf16(PAF(1),VFR(1),o[0],0,0,0), C0,8); \
    KRD(GL,1); GAPB(o[1]=__builtin_amdgcn_mfma_f32_32x32x16_bf16(PAF(1),VFR(5),o[1],0,0,0), C0,12); \
    KRD(GL,2); GAPB(o[0]=__builtin_amdgcn_mfma_f32_32x32x16_bf16(PAF(2),VFR(2),o[0],0,0,0), C1,0); \
    KRD(GL,3); GAPB(o[1]=__builtin_amdgcn_mfma_f32_32x32x16_bf16(PAF(2),VFR(6),o[1],0,0,0), C1,4); \
    GAPB(o[0]=__builtin_amdgcn_mfma_f32_32x32x16_bf16(PAF(3),VFR(3),o[0],0,0,0), C1,8); \
    GAPB(o[1]=__builtin_amdgcn_mfma_f32_32x32x16_bf16(PAF(3),VFR(7),o[1],0,0,0), C1,12); \
    }while(0)
  int t=1;
  #undef CMASK
  #define CMASK(P0,P1,t) do{}while(0)
  for(;t+5<NT;t+=2){
    STEP(pB0,pB1,pA0,pA1,t,true,true,true);     WAIT_BAR(2); RESC(); ROT();
    STEP(pA0,pA1,pB0,pB1,t+1,true,true,true);   WAIT_BAR(2); RESC(); ROT();
  }
  #undef CMASK
  #define CMASK(P0,P1,t) do{int jb_=(t)-(NT-4); if(jb_>=0)cmask(P0,P1,jb_,qrel,hi);}while(0)
  #define ENDW(tt) do{ if((tt)+3<NT){WAIT_BAR(2);} else if((tt)+2<NT){WAIT_BAR(1);} else {WAIT_BAR(0);} }while(0)
  for(;t+1<NT;t+=2){
    STEP(pB0,pB1,pA0,pA1,t,(t+3<NT),(t+1<NT),(t+1<NT));       ENDW(t);   RESC(); ROT();
    STEP(pA0,pA1,pB0,pB1,t+1,(t+4<NT),(t+2<NT),(t+2<NT));     ENDW(t+1); RESC(); ROT();
  }
  STEP(pB0,pB1,pA0,pA1,NT-1,false,false,false); RESC();
  { float sacc=pB0[0]+pB0[1]; _Pragma("unroll") for(int r=2;r<16;++r)sacc+=pB0[r]; _Pragma("unroll") for(int r=0;r<16;++r)sacc+=pB1[r]; l_reg+=sacc;
    pw0=(u32x4){PKW(pB0,0),PKW(pB0,2),PKW(pB0,4),PKW(pB0,6)};pw1=(u32x4){PKW(pB0,8),PKW(pB0,10),PKW(pB0,12),PKW(pB0,14)};pw2=(u32x4){PKW(pB1,0),PKW(pB1,2),PKW(pB1,4),PKW(pB1,6)};pw3=(u32x4){PKW(pB1,8),PKW(pB1,10),PKW(pB1,12),PKW(pB1,14)};
    SBAR(); pv(o,vb0+sl_cur,PAF(0),PAF(1),PAF(2),PAF(3)); }
  #undef PKW
  #undef PAF
  #undef VFR
  #undef PIN
  #undef MX3
  #undef GAPA
  #undef GAPB
  #undef EX
  #undef VRD
  #undef KRD
  #undef STEP
  #undef ENDW
  {auto rr=__builtin_amdgcn_permlane32_swap(__float_as_uint(l_reg),__float_as_uint(l_reg),false,false);l_reg=__uint_as_float(rr[0])+__uint_as_float(rr[1]);}
  { int te=tid; asm volatile("":"+v"(te));
    const int lane_e=te&63,r32e=lane_e&31,hie=lane_e>>5;
    if(hie==0)wsf[32+r32e]=l_reg;asm volatile("s_waitcnt lgkmcnt(0)":::"memory");
    float rli[16];
    #pragma unroll
    for(int r=0;r<16;++r)rli[r]=__builtin_amdgcn_rcpf(wsf[32+crow(r,hie)]);
    bf16*Ow=O+(rowbase+q0+wid*QBLK)*DM+h*D; const bf16*Gw=Gt+(rowbase+q0+wid*QBLK)*DM+h*D;
    bf16*stg=(bf16*)(shm+LDS_OST)+wid*2048;
    #pragma unroll
    for(int r=0;r<16;++r){const int orow=crow(r,hie);
      #pragma unroll
      for(int d0=0;d0<2;++d0)stg[orow*64+d0*32+r32e]=__float2bfloat16(o[d0][r]*rli[r]);}
    asm volatile("s_waitcnt lgkmcnt(0)":::"memory");
    #pragma unroll
    for(int i=0;i<4;++i){const int row=i*8+(lane_e>>3),ch=lane_e&7; u32x4 v=*(const u32x4*)(stg+row*64+ch*8); const u32x4 gv=*(const u32x4*)(Gw+(long)row*DM+ch*8);
      #pragma unroll
      for(int e=0;e<4;++e){ const float g0=__uint_as_float(gv[e]<<16),g1=__uint_as_float(gv[e]&0xffff0000u),x0=__uint_as_float(v[e]<<16),x1=__uint_as_float(v[e]&0xffff0000u);
        v[e]=cvtpk_s(x0*__builtin_amdgcn_rcpf(1.f+__expf(-g0)),x1*__builtin_amdgcn_rcpf(1.f+__expf(-g1))); }
      ATTN_STORE16(Ow+(long)row*DM+ch*8,v);} }
  asm volatile("s_waitcnt lgkmcnt(0)\n\ts_barrier":::"memory");
  #undef DMA_K
  #undef QLD
  #undef DMA_V
  #undef CMASK
  #undef START
  #undef RESC
  #undef ROT
}
constexpr int ATTN_LDS_BYTES=LDS_BYTES;
struct AttnTensors { const bf16* Q; const bf16* K; const bf16* V; bf16* O; const bf16* G; const float* CUM; float THR; };
struct AttnUnit { int bh; int qb; };
struct StaticOrder {
  int vcu;
  __device__ __forceinline__ explicit StaticOrder(int grid,int block):vcu((block%8)*(grid/8)+block/8){}
  __device__ __forceinline__ bool next(int i,AttnUnit&u)const{ if(i>=4)return false; const int s=2*(vcu&1)+(i>>1); u.bh=vcu>>1; u.qb=(i&1)?7-s:s; return true; }
  __device__ __forceinline__ void a_ready(const AttnUnit&)const{}
  __device__ __forceinline__ void done(const AttnUnit&)const{}
};
template<class Sched,int THRL=8> __device__ __forceinline__ void attn_phase(char*lds,const AttnTensors&T,const Sched&S,int tid_in){
  AttnUnit u; int tid_=tid_in; asm volatile("":"+v"(tid_));
  if(S.next(0,u)){ float*csp=(float*)(lds+LDS_CS); float*wt=(float*)(lds+LDS_WS); int tp=tid_in; asm volatile("":"+v"(tp));
    const float*lf=T.CUM+((long)(u.bh/NHEAD)*SEQ+4*tp)*NHEAD+u.bh%NHEAD;
    const float a0=lf[0],a1=a0+lf[NHEAD],a2=a1+lf[2*NHEAD],a3=a2+lf[3*NHEAD];
    float sc=a3; const int ln=tp&63;
    #pragma unroll
    for(int o=1;o<64;o<<=1){ const float up=__builtin_bit_cast(float,__builtin_amdgcn_ds_bpermute((ln-o)<<2,__builtin_bit_cast(int,sc))); if(ln>=o)sc+=up; }
    if(ln==63)wt[tp>>6]=sc;
    __syncthreads();
    float base=sc-a3;
    #pragma unroll
    for(int w=0;w<NW-1;++w)if(w<(tp>>6))base+=wt[w];
    const float k2=-1.4426950408889634f;
    csp[4*tp]=k2*(base+a0);csp[4*tp+1]=k2*(base+a1);csp[4*tp+2]=k2*(base+a2);csp[4*tp+3]=k2*(base+a3);
    __syncthreads(); }
  for(int i=0;S.next(i,u);++i){ S.a_ready(u); attn_unit<THRL>(u.bh/NHEAD,u.bh%NHEAD,u.qb,T.Q,T.K,T.V,T.O,T.G,lds,tid_,T.THR); S.done(u); }
}
#undef SBAR
#undef WAIT_BAR
}
#define GAS __attribute__((address_space(1)))
#define LAS __attribute__((address_space(3)))
typedef unsigned short bf16;
typedef unsigned v4u __attribute__((ext_vector_type(4)));
typedef float f32x4 __attribute__((ext_vector_type(4)));
typedef short bf16x8 __attribute__((ext_vector_type(8)));
typedef GAS unsigned gu32;
typedef GAS unsigned long long gu64;
#define RLX_AGENT __ATOMIC_RELAXED, __HIP_MEMORY_SCOPE_AGENT
#define LDS_WAIT() asm volatile("s_waitcnt lgkmcnt(0)" ::: "memory")
#define VM_WAIT() asm volatile("s_waitcnt vmcnt(0)" ::: "memory")
__device__ __forceinline__ unsigned long long rt() { return __builtin_amdgcn_s_memrealtime(); }
__device__ __forceinline__ unsigned f2bf(float f) { unsigned u = __builtin_bit_cast(unsigned, f); return (u + 0x7fffu + ((u >> 16) & 1u)) >> 16; }
__device__ __forceinline__ unsigned pk2(float lo, float hi) { return f2bf(lo) | (f2bf(hi) << 16); }

#define XB_TMO      128
#define XB_XCNT(j)  (256  + 64 * (j))
#define XB_XSUB(j)  (1280 + 64 * (j))
#define XB_XGEN(j)  (2304 + 64 * (j))
#define XB_TOP      3328
#define XB_TOPGEN   3392
#define XCD_BAR_WORDS 3456
#define XB_SPIN_CAP (1u << 27)

__device__ __forceinline__ unsigned xb_ld(unsigned* p)              { return __hip_atomic_load(p, __ATOMIC_RELAXED, __HIP_MEMORY_SCOPE_AGENT); }
__device__ __forceinline__ unsigned xb_add(unsigned* p, unsigned v) { return __hip_atomic_fetch_add(p, v, __ATOMIC_RELAXED, __HIP_MEMORY_SCOPE_AGENT); }
__device__ __forceinline__ unsigned xb_xcc_id() { return (unsigned)__builtin_amdgcn_s_getreg((3 << 11) | 20) & 0xFu; }
#define XB_SPIN(cond, bar) do { unsigned _sp = 0; while (cond) { __builtin_amdgcn_s_sleep(1); \
    if ((++_sp & 255u) == 0u) { if (xb_ld(&(bar)[XB_TMO])) break; if (_sp > XB_SPIN_CAP) { atomicAdd(&(bar)[XB_TMO], 1u); break; } } } } while (0)

struct XcdBarrier {
    unsigned* bar; unsigned x;
    volatile LAS unsigned* st;
};

__device__ __forceinline__ XcdBarrier xcd_barrier_post(unsigned* bar, volatile LAS unsigned* st) {
    XcdBarrier b; b.bar = bar; b.x = xb_xcc_id(); b.st = st;
    if (threadIdx.x == 0) (void)xb_add(&bar[XB_XCNT(b.x)], 1u);
    return b;
}
__device__ __forceinline__ void xcd_barrier_complete(unsigned* bar, unsigned x, unsigned& nloc, unsigned& nx) {
    const unsigned G = gridDim.x * gridDim.y * gridDim.z;
    unsigned sum, cnt, mine, sp = 0u;
    for (;;) {
        sum = 0u; cnt = 0u; mine = 0u;
#pragma unroll
        for (unsigned j = 0; j < 16; ++j) { const unsigned c = xb_ld(&bar[XB_XCNT(j)]); sum += c; cnt += (c > 0u) ? 1u : 0u; mine = (j == x) ? c : mine; }
        if (sum == G) break;
        __builtin_amdgcn_s_sleep(1);
        if ((++sp & 255u) == 0u) { if (xb_ld(&bar[XB_TMO])) break; if (sp > XB_SPIN_CAP) { atomicAdd(&bar[XB_TMO], 1u); break; } }
    }
    nloc = mine > 0u ? mine : 1u; nx = cnt > 0u ? cnt : 1u;
}

__device__ __forceinline__ void xcd_barrier(const XcdBarrier& b, const bool leader  ) {
    asm volatile("s_waitcnt vmcnt(0)" ::: "memory");
    __syncthreads();
    if (leader) {
        unsigned* bar = b.bar;
        __builtin_amdgcn_s_waitcnt(0);
        unsigned nloc = b.st[0], nx = b.st[1];
        if (nloc == 0u) { xcd_barrier_complete(bar, b.x, nloc, nx); b.st[0] = nloc; b.st[1] = nx; }
        const unsigned old = xb_add(&bar[XB_XSUB(b.x)], 1u);
        const unsigned gen = old / nloc;
        if (old + 1u == (gen + 1u) * nloc) {
            __builtin_amdgcn_fence(__ATOMIC_RELEASE, "agent");
            asm volatile("s_waitcnt vmcnt(0)" ::: "memory");
            const unsigned og = xb_add(&bar[XB_TOP], 1u);
            const unsigned tg = og / nx;
            if (og + 1u == (tg + 1u) * nx) xb_add(&bar[XB_TOPGEN], 1u);
            else XB_SPIN(xb_ld(&bar[XB_TOPGEN]) == tg, bar);
            __builtin_amdgcn_fence(__ATOMIC_ACQUIRE, "agent");
            xb_add(&bar[XB_XGEN(b.x)], 1u);
            asm volatile("s_waitcnt vmcnt(0)" ::: "memory");
        } else {
            XB_SPIN(xb_ld(&bar[XB_XGEN(b.x)]) == gen, bar);
            __builtin_amdgcn_fence(__ATOMIC_ACQUIRE, "agent");
            asm volatile("s_waitcnt vmcnt(0)" ::: "memory");
        }
    }
    __syncthreads();
}
#ifndef MK_FASTATTN
#define MK_FASTATTN 1
#endif
#ifndef MK_FASTREC
#define MK_FASTREC 1
#endif
namespace cg = cooperative_groups;
constexpr int NTOK = 16384, DMODEL = 1024, NBATCH = 8, SEQLEN = 2048, DEPTH = 4;
constexpr int FOX_IN = 4112, GLA_IN = 3088, HGRN_IN = 4096;
constexpr float RMS_EPS = 1e-6f;
constexpr float LOG2E = 1.4426950408889634f;
constexpr float FOX_C2 = 0.125f * LOG2E;
constexpr int NWAVES = 8;

constexpr size_t MiB = 1u << 20;
constexpr size_t WS_CTL = 0, CTL_ZERO_BYTES = 1 * MiB;
constexpr size_t WS_FOXWIN = 2 * MiB, WS_FOXWOUT = 18 * MiB, WS_GLAWIN = 22 * MiB, WS_GLAWOUT = 28 * MiB, WS_HGRNWIN = 30 * MiB, WS_HGRNWOUT = 38 * MiB;
constexpr size_t WS_PEERWQ = 40 * MiB, WS_KEYS = 56 * MiB, WS_LB = 58 * MiB;
#define FOXFUSE ((I8MASK & 9) == 9)
#ifndef RPROBE
#define RPROBE 0
#endif
#ifndef BGQ
#define BGQ 1
#endif
#ifndef I8MASK
#define I8MASK 13
#endif
constexpr size_t WS_SW = 58 * MiB + 65536, WS_SX = 58 * MiB + 262144, WS_XN8 = 724 * MiB;
constexpr size_t WS_TAILW = 63 * MiB;
constexpr size_t WS_RS = 62 * MiB;
constexpr size_t WS_U = 64 * MiB, WS_V = 128 * MiB, WS_SU = 60 * MiB, WS_SV = 61 * MiB;
constexpr size_t WS_XN = 320 * MiB, WS_P = 352 * MiB, WS_OB = 480 * MiB, WS_Q2 = 512 * MiB, WS_TAIL = 576 * MiB, WS_CUM = 577 * MiB;
constexpr size_t WS_EXP = 580 * MiB, WS_GATE = 588 * MiB, WS_OF = 596 * MiB, WS_GLOG = 660 * MiB, WS_HB = 740 * MiB, WS_END = 772 * MiB;
constexpr size_t PSTRIDE = (size_t)NTOK * 1024;
constexpr int CW_BAR = 4096;

constexpr int RING_BYTES = 131072;
constexpr int LDSCTL_OFF = RING_BYTES, MISC_OFF = LDSCTL_OFF + 320;
constexpr int LDS_BYTES = 147456;

typedef unsigned u32x4v __attribute__((ext_vector_type(4)));
struct Ctx {
    LAS unsigned char* lds; int tid, lane, wave, vcu, G, gw, NGW, bx;
    const float* in[21]; float* out; unsigned char* ws;
};

__device__ __forceinline__ float bf2f(unsigned short b) { return __uint_as_float(((unsigned)b) << 16); }
__device__ __forceinline__ float bflo(unsigned w) { return __uint_as_float(w << 16); }
__device__ __forceinline__ float bfhi(unsigned w) { return __uint_as_float(w & 0xffff0000u); }
#define DPP_ADD(v, ctrl, rm, bm) (v + __builtin_bit_cast(float, __builtin_amdgcn_update_dpp(0, __builtin_bit_cast(int, v), ctrl, rm, bm, false)))
#define DPP_MAX(v, ctrl, rm, bm) fmaxf(v, __builtin_bit_cast(float, __builtin_amdgcn_update_dpp(__builtin_bit_cast(int, v), __builtin_bit_cast(int, v), ctrl, rm, bm, false)))
#define DPP_SUM31(v) do { v = DPP_ADD(v, 0x111, 0xf, 0xf); v = DPP_ADD(v, 0x112, 0xf, 0xf); v = DPP_ADD(v, 0x114, 0xf, 0xe); v = DPP_ADD(v, 0x118, 0xf, 0xc); v = DPP_ADD(v, 0x142, 0xa, 0xf); } while (0)
#define DPP_SUM63(v) do { DPP_SUM31(v); v = DPP_ADD(v, 0x143, 0xc, 0xf); } while (0)
__device__ __forceinline__ float rdlane(float v, int lane) { return __builtin_bit_cast(float, __builtin_amdgcn_readlane(__builtin_bit_cast(int, v), lane)); }
__device__ __forceinline__ float wave_sum(float v) { DPP_SUM63(v); return rdlane(v, 63); }
__device__ __forceinline__ float wave_max(float v) {
    v = DPP_MAX(v, 0x111, 0xf, 0xf); v = DPP_MAX(v, 0x112, 0xf, 0xf); v = DPP_MAX(v, 0x114, 0xf, 0xe); v = DPP_MAX(v, 0x118, 0xf, 0xc); v = DPP_MAX(v, 0x142, 0xa, 0xf); v = DPP_MAX(v, 0x143, 0xc, 0xf);
    return rdlane(v, 63);
}
typedef __bf16 bf16x2_t __attribute__((ext_vector_type(2)));
__device__ __forceinline__ float dot2bf(unsigned w, unsigned x, float acc) { return __builtin_amdgcn_fdot2_f32_bf16(__builtin_bit_cast(bf16x2_t, w), __builtin_bit_cast(bf16x2_t, x), acc, false); }
__device__ __forceinline__ float bperm(float v, int src_lane) { return __builtin_bit_cast(float, __builtin_amdgcn_ds_bpermute(src_lane << 2, __builtin_bit_cast(int, v))); }
__device__ __forceinline__ float log_sigmoid_f(float x) { return fminf(x, 0.f) - log1pf(__expf(-fabsf(x))); }
__device__ __forceinline__ float sigmoid_f(float x) { return 1.f / (1.f + __expf(-x)); }

__device__ __forceinline__ void p0_transpose_item(const float* W, int ldw, int K, int Nuse, bf16* WT, LAS float* scr, int item, int lane) {
    const int nblk = Nuse / 32, kb = item / nblk, nb = item % nblk, k0 = 64 * kb, n0 = 32 * nb;
#pragma unroll
    for (int i = 0; i < 8; ++i) { const int kk = 8 * i + (lane >> 3); const f32x4 v = *(const GAS f32x4*)(W + (size_t)(k0 + kk) * ldw + n0 + 4 * (lane & 7));
        LAS float* d = scr + kk * 33 + 4 * (lane & 7); d[0] = v.x; d[1] = v.y; d[2] = v.z; d[3] = v.w; }
    LDS_WAIT(); asm volatile("" ::: "memory");
    const int c = lane & 7;
#pragma unroll
    for (int j = 0; j < 4; ++j) { const int n = (lane >> 3) + 8 * j; const LAS float* s = scr + (8 * c) * 33 + n;
        v4u o; o.x = pk2(s[0 * 33], s[1 * 33]); o.y = pk2(s[2 * 33], s[3 * 33]); o.z = pk2(s[4 * 33], s[5 * 33]); o.w = pk2(s[6 * 33], s[7 * 33]);
        *(GAS v4u*)(WT + (size_t)(n0 + n) * K + k0 + 8 * c) = o; }
    LDS_WAIT(); asm volatile("" ::: "memory");
}
__device__ __forceinline__ unsigned q8x4(float a, float b, float c, float d) {
    return ((unsigned)(int)__builtin_rintf(a) & 0xffu) | (((unsigned)(int)__builtin_rintf(b) & 0xffu) << 8) | (((unsigned)(int)__builtin_rintf(c) & 0xffu) << 16) | ((unsigned)(int)__builtin_rintf(d) << 24);
}
__device__ __forceinline__ void p0_colmax_item(const float* W, int ldw, unsigned* cmax, int item, int lane) {
    const int nb = item >> 3, n0 = 32 * nb, k0 = 128 * (item & 7);
    f32x4 v[16];
#pragma unroll
    for (int i = 0; i < 16; ++i) v[i] = *(const GAS f32x4*)(W + (size_t)(k0 + 8 * i + (lane >> 3)) * ldw + n0 + 4 * (lane & 7));
    __builtin_amdgcn_sched_barrier(0);
    float mx[4] = {0.f, 0.f, 0.f, 0.f};
#pragma unroll
    for (int i = 0; i < 16; ++i) { mx[0] = fmaxf(mx[0], fabsf(v[i].x)); mx[1] = fmaxf(mx[1], fabsf(v[i].y)); mx[2] = fmaxf(mx[2], fabsf(v[i].z)); mx[3] = fmaxf(mx[3], fabsf(v[i].w)); }
#pragma unroll
    for (int j = 0; j < 4; ++j) { mx[j] = fmaxf(mx[j], bperm(mx[j], lane ^ 8)); mx[j] = fmaxf(mx[j], bperm(mx[j], lane ^ 16)); mx[j] = fmaxf(mx[j], bperm(mx[j], lane ^ 32)); }
    if (lane < 8) {
#pragma unroll
        for (int j = 0; j < 4; ++j) (void)__hip_atomic_fetch_max(cmax + n0 + 4 * lane + j, __float_as_uint(mx[j]), __ATOMIC_RELAXED, __HIP_MEMORY_SCOPE_AGENT);
    }
}
__device__ __forceinline__ void p0_quant_item(const float* W, int ldw, const unsigned* cmax, signed char* W8, float* sw, LAS float* scr, int item, int lane, bool headperm) {
    const int nb = item >> 3, n0 = 32 * nb, k0 = 128 * (item & 7);
    const int n0s = (headperm && nb < 64) ? (nb >> 3) * 256 + 64 * (nb & 3) + 32 * ((nb >> 2) & 1) : n0;
    f32x4 v[2][8];
#pragma unroll
    for (int h = 0; h < 2; ++h)
#pragma unroll
        for (int i = 0; i < 8; ++i) v[h][i] = *(const GAS f32x4*)(W + (size_t)(k0 + 64 * h + 8 * i + (lane >> 3)) * ldw + n0s + 4 * (lane & 7));
    float ci[4];
#pragma unroll
    for (int j = 0; j < 4; ++j) { const float m = __uint_as_float(*(const GAS unsigned*)(cmax + n0s + (lane >> 3) + 8 * j)); ci[j] = m > 0.f ? 127.f / m : 0.f; }
    if ((item & 7) == 0 && lane < 32) *(GAS float*)(sw + n0 + lane) = __uint_as_float(*(const GAS unsigned*)(cmax + n0s + lane)) * (1.f / 127.f);
    __builtin_amdgcn_sched_barrier(0);
    const int c = lane & 7;
#pragma unroll
    for (int h = 0; h < 2; ++h) {
        LDS_WAIT(); asm volatile("" ::: "memory");
#pragma unroll
        for (int i = 0; i < 8; ++i) { LAS float* d = scr + (8 * i + (lane >> 3)) * 33 + 4 * (lane & 7); d[0] = v[h][i].x; d[1] = v[h][i].y; d[2] = v[h][i].z; d[3] = v[h][i].w; }
        LDS_WAIT(); asm volatile("" ::: "memory");
#pragma unroll
        for (int j = 0; j < 4; ++j) { const int n = (lane >> 3) + 8 * j; const LAS float* sp = scr + (8 * c) * 33 + n;
            const unsigned lo = q8x4(sp[0] * ci[j], sp[33] * ci[j], sp[66] * ci[j], sp[99] * ci[j]), hi = q8x4(sp[132] * ci[j], sp[165] * ci[j], sp[198] * ci[j], sp[231] * ci[j]);
            *(GAS unsigned long long*)(W8 + (size_t)(n0 + n) * 1024 + k0 + 64 * h + 8 * c) = (unsigned long long)lo | ((unsigned long long)hi << 32); }
    }
    LDS_WAIT(); asm volatile("" ::: "memory");
}
__device__ __forceinline__ void rms_row_to_bf16(int lane, f32x4 (&v)[4], const float* gain, bf16* orow, signed char* orow8, float* sx) {
    const GAS f32x4* gr = (const GAS f32x4*)gain + lane;
    float s = 0.f;
#pragma unroll
    for (int j = 0; j < 4; ++j) s += (v[j].x * v[j].x + v[j].y * v[j].y) + (v[j].z * v[j].z + v[j].w * v[j].w);
    const float r = rsqrtf(wave_sum(s) * (1.f / 1024.f) + RMS_EPS);
    GAS unsigned long long* o8 = (GAS unsigned long long*)orow + lane; float am = 0.f;
#pragma unroll
    for (int j = 0; j < 4; ++j) { const f32x4 g = gr[64 * j]; v[j].x *= r * g.x; v[j].y *= r * g.y; v[j].z *= r * g.z; v[j].w *= r * g.w;
        am = fmaxf(fmaxf(am, fmaxf(fabsf(v[j].x), fabsf(v[j].y))), fmaxf(fabsf(v[j].z), fabsf(v[j].w)));
        o8[64 * j] = (unsigned long long)pk2(v[j].x, v[j].y) | ((unsigned long long)pk2(v[j].z, v[j].w) << 32); }
    am = wave_max(am); const float qi = am > 0.f ? 127.f / am : 0.f;
    GAS unsigned* q8 = (GAS unsigned*)orow8 + lane;
#pragma unroll
    for (int j = 0; j < 4; ++j) q8[64 * j] = q8x4(v[j].x * qi, v[j].y * qi, v[j].z * qi, v[j].w * qi);
    if (lane == 0) *(GAS float*)sx = am * (1.f / 127.f);
}
__device__ __forceinline__ void cvt_f32_bf16(const Ctx& C, const float* src, bf16* dst, size_t n) {
    const size_t nth = (size_t)C.G * 512, t0 = (size_t)C.vcu * 512 + C.tid;
    for (size_t i = t0; i < n / 8; i += nth) {
        const f32x4 a = ((const GAS f32x4*)src)[2 * i], b = ((const GAS f32x4*)src)[2 * i + 1];
        v4u o; o.x = pk2(a.x, a.y); o.y = pk2(a.z, a.w); o.z = pk2(b.x, b.y); o.w = pk2(b.z, b.w);
        ((GAS v4u*)dst)[i] = o;
    }
}
__device__ __forceinline__ void quant_row_fp8(int lane, const f32x4 (&v)[4], unsigned char* drow, float* sc) {
    float am = 0.f;
#pragma unroll
    for (int i = 0; i < 4; ++i) am = fmaxf(am, fmaxf(fmaxf(fabsf(v[i].x), fabsf(v[i].y)), fmaxf(fabsf(v[i].z), fabsf(v[i].w))));
    am = wave_max(am);
    const float inv = am > 0.f ? 448.f / am : 0.f;
    GAS unsigned* o = (GAS unsigned*)drow + lane;
#pragma unroll
    for (int i = 0; i < 4; ++i) {
        const float a = fminf(fmaxf(v[i].x * inv, -448.f), 448.f), b = fminf(fmaxf(v[i].y * inv, -448.f), 448.f), c = fminf(fmaxf(v[i].z * inv, -448.f), 448.f), d = fminf(fmaxf(v[i].w * inv, -448.f), 448.f);
        int w = 0; w = __builtin_amdgcn_cvt_pk_fp8_f32(a, b, w, false); w = __builtin_amdgcn_cvt_pk_fp8_f32(c, d, w, true); o[64 * i] = (unsigned)w;
    }
    if (lane == 0) *(GAS float*)sc = am * (1.f / 448.f);
}
__device__ __forceinline__ void quant_rows_fp8(const Ctx& C, const float* src, unsigned char* dst, float* scales, int nrows) {
    int rw = C.gw;
    for (; rw + 3 * C.NGW < nrows; rw += 4 * C.NGW) {
        f32x4 v[4][4];
#pragma unroll
        for (int j = 0; j < 4; ++j) { const GAS f32x4* xr = (const GAS f32x4*)(src + (size_t)(rw + j * C.NGW) * 1024) + C.lane;
#pragma unroll
            for (int i = 0; i < 4; ++i) v[j][i] = xr[64 * i]; }
        __builtin_amdgcn_sched_barrier(0);
#pragma unroll
        for (int j = 0; j < 4; ++j) quant_row_fp8(C.lane, v[j], dst + (size_t)(rw + j * C.NGW) * 1024, scales + rw + j * C.NGW);
    }
    for (; rw < nrows; rw += C.NGW) {
        const GAS f32x4* xr = (const GAS f32x4*)(src + (size_t)rw * 1024) + C.lane;
        f32x4 v[4];
#pragma unroll
        for (int i = 0; i < 4; ++i) v[i] = xr[64 * i];
        quant_row_fp8(C.lane, v, dst + (size_t)rw * 1024, scales + rw);
    }
}
constexpr int BGQ_ROWS = 3 * 16384;
template <int JOB> __device__ __forceinline__ void bgq_row(const Ctx& C, int idx, const float*& src, unsigned char*& dst, float*& sc) {
    const int seg = idx >> 14, row = idx & 16383;
    const bool isV = seg == 1 || (seg == 2 && JOB == 2);
    const size_t flat = (size_t)(seg < 2 ? JOB : 3) * 16384 + row;
    src = (isV ? C.in[20] : C.in[19]) + flat * 1024; dst = C.ws + (isV ? WS_V : WS_U) + flat * 1024; sc = (float*)(C.ws + (isV ? WS_SV : WS_SU)) + flat;
}
template <int JOB> __device__ __forceinline__ void bgq_step(const Ctx& C, int idx_prev, int idx, f32x4 (&v)[4]) {
    const float* src; unsigned char* dst; float* sc;
    if (idx_prev >= 0 && idx_prev < BGQ_ROWS) { bgq_row<JOB>(C, idx_prev, src, dst, sc); quant_row_fp8(C.lane, v, dst, sc); }
    if (idx < BGQ_ROWS) { bgq_row<JOB>(C, idx, src, dst, sc); const GAS f32x4* xr = (const GAS f32x4*)src + C.lane;
#pragma unroll
        for (int i = 0; i < 4; ++i) v[i] = xr[64 * i]; }
}
#ifndef PRO_PROBE
#define PRO_PROBE 0
#endif
constexpr int CW_CMAX = 131072;
constexpr int I8_NF0 = (I8MASK & 1) ? 1024 : 0, I8_NF3 = (I8MASK & 8) ? 1024 : 0, I8_NG = (I8MASK & 2) ? 768 : 0, I8_NH = (I8MASK & 4) ? 1024 : 0, I8_NITEMS = I8_NF0 + I8_NF3 + I8_NG + I8_NH;
template <bool PASS2> __device__ __forceinline__ void p0_i8_items(const Ctx& C, LAS float* scr) {
    unsigned* CM = (unsigned*)(C.ws + WS_CTL) + CW_CMAX; float* SW = (float*)(C.ws + WS_SW);
    for (int it = C.gw; it < I8_NITEMS; it += C.NGW) {
        int r = it; const float* W; int ldw; signed char* W8; int q;
        if (r < I8_NF0) { W = C.in[3]; ldw = FOX_IN; W8 = (signed char*)(C.ws + WS_FOXWIN); q = 0; }
        else if ((r -= I8_NF0) < I8_NF3) { W = C.in[3] + (size_t)1024 * FOX_IN; ldw = FOX_IN; W8 = (signed char*)(C.ws + WS_FOXWIN + 8 * MiB); q = 1; }
        else if ((r -= I8_NF3) < I8_NG) { W = C.in[8]; ldw = GLA_IN; W8 = (signed char*)(C.ws + WS_GLAWIN); q = 2; }
        else { r -= I8_NG; W = C.in[13]; ldw = HGRN_IN; W8 = (signed char*)(C.ws + WS_HGRNWIN); q = 3; }
        const int swo = q == 0 ? 0 : q == 1 ? 4096 : q == 2 ? 8192 : 11264;
        if (PASS2) p0_quant_item(W, ldw, CM + q * 4096, W8, SW + swo, scr, r, C.lane, FOXFUSE && q < 2); else p0_colmax_item(W, ldw, CM + q * 4096, r, C.lane);
    }
}
__device__ __forceinline__ void p0_prologue_b(const Ctx& C) { p0_i8_items<true>(C, (LAS float*)(C.lds + C.wave * 16384)); }
__device__ __forceinline__ void p0_prologue(const Ctx& C) {
    LAS float* scr = (LAS float*)(C.lds + C.wave * 16384);
    for (int rep_ = 0; rep_ < (PRO_PROBE == 1 ? 2 : 1); ++rep_) {
    p0_i8_items<false>(C, scr);
    constexpr int I_SQ = 16 * 32, N_F0 = (I8MASK & 1) ? 0 : 16 * 128, N_F3 = (I8MASK & 8) ? 0 : 16 * 128, N_G = (I8MASK & 2) ? 0 : 16 * 96, N_H = (I8MASK & 4) ? 0 : 16 * 128;
    constexpr int NITEMS = N_F0 + N_F3 + N_G + N_H + 2 * I_SQ + I_SQ + I_SQ;
    for (int it = C.gw; it < NITEMS; it += C.NGW) {
        int r = it;
        if (r < N_F0) { p0_transpose_item(C.in[3], FOX_IN, 1024, 4096, (bf16*)(C.ws + WS_FOXWIN), scr, r, C.lane); continue; } r -= N_F0;
        if (r < N_F3) { p0_transpose_item(C.in[3] + (size_t)1024 * FOX_IN, FOX_IN, 1024, 4096, (bf16*)(C.ws + WS_FOXWIN + 8 * MiB), scr, r, C.lane); continue; } r -= N_F3;
        if (r < N_G) { p0_transpose_item(C.in[8], GLA_IN, 1024, 3072, (bf16*)(C.ws + WS_GLAWIN), scr, r, C.lane); continue; } r -= N_G;
        if (r < N_H) { p0_transpose_item(C.in[13], HGRN_IN, 1024, 4096, (bf16*)(C.ws + WS_HGRNWIN), scr, r, C.lane); continue; } r -= N_H;
        if (r < 2 * I_SQ) { const int j = r / I_SQ; p0_transpose_item(C.in[7] + (size_t)j * 1024 * 1024, 1024, 1024, 1024, (bf16*)(C.ws + WS_FOXWOUT) + (size_t)j * 1024 * 1024, scr, r % I_SQ, C.lane); continue; } r -= 2 * I_SQ;
        if (r < I_SQ) { p0_transpose_item(C.in[12], 1024, 1024, 1024, (bf16*)(C.ws + WS_GLAWOUT), scr, r, C.lane); continue; } r -= I_SQ;
        p0_transpose_item(C.in[16], 1024, 1024, 1024, (bf16*)(C.ws + WS_HGRNWOUT), scr, r, C.lane);
    }
    }
    for (int rep_ = 0; rep_ < (PRO_PROBE == 2 ? 2 : 1); ++rep_) {
    constexpr int MT_GROUPS = 4 * 16 * 4 * 32;
    for (int grp = C.gw; grp < MT_GROUPS; grp += C.NGW) {
        const int nb2 = grp & 31, kb2 = (grp >> 5) & 3, hp = (grp >> 7) & 15, layer = grp >> 11;
        const float* kp = C.in[18] + ((size_t)(layer * 16 + hp) * 128 + kb2 * 32 + (C.lane & 15)) * 128 + 4 * (C.lane >> 4);
        const float* wp = C.in[17] + ((size_t)layer * 1024 + nb2 * 32 + (C.lane & 15)) * 2048 + hp * 128 + 4 * (C.lane >> 4);
        f32x4 ka[2][8], wb[2][8];
#pragma unroll
        for (int u = 0; u < 2; ++u)
#pragma unroll
            for (int s8 = 0; s8 < 8; ++s8) { ka[u][s8] = *(const GAS f32x4*)(kp + (size_t)u * 16 * 128 + 16 * s8); wb[u][s8] = *(const GAS f32x4*)(wp + (size_t)u * 16 * 2048 + 16 * s8); }
        __builtin_amdgcn_sched_barrier(0);
        f32x4 acc[2][2];
#pragma unroll
        for (int a = 0; a < 2; ++a)
#pragma unroll
            for (int b = 0; b < 2; ++b) acc[a][b] = (f32x4){0.f, 0.f, 0.f, 0.f};
#pragma unroll
        for (int s8 = 0; s8 < 8; ++s8)
#pragma unroll
            for (int a = 0; a < 2; ++a)
#pragma unroll
                for (int b = 0; b < 2; ++b) { const f32x4 x = ka[a][s8], y = wb[b][s8];
                    acc[a][b] = __builtin_amdgcn_mfma_f32_16x16x4f32(x.x, y.x, acc[a][b], 0, 0, 0); acc[a][b] = __builtin_amdgcn_mfma_f32_16x16x4f32(x.y, y.y, acc[a][b], 0, 0, 0);
                    acc[a][b] = __builtin_amdgcn_mfma_f32_16x16x4f32(x.z, y.z, acc[a][b], 0, 0, 0); acc[a][b] = __builtin_amdgcn_mfma_f32_16x16x4f32(x.w, y.w, acc[a][b], 0, 0, 0); }
#pragma unroll
        for (int a = 0; a < 2; ++a)
#pragma unroll
            for (int b = 0; b < 2; ++b) {
                bf16* mt = (bf16*)(C.ws + WS_PEERWQ) + ((size_t)layer * 2048 + hp * 128 + kb2 * 32 + a * 16 + (C.lane >> 4) * 4) * 1024 + nb2 * 32 + b * 16 + (C.lane & 15);
#pragma unroll
                for (int r = 0; r < 4; ++r) mt[(size_t)r * 1024] = (bf16)f2bf(acc[a][b][r]); }
    }
    }
    for (int rep_ = 0; rep_ < (PRO_PROBE == 3 ? 2 : 1); ++rep_) {
    quant_rows_fp8(C, C.in[19], C.ws + WS_U, (float*)(C.ws + WS_SU), BGQ ? 16384 : 4 * 16384);
    quant_rows_fp8(C, C.in[20], C.ws + WS_V, (float*)(C.ws + WS_SV), BGQ ? 16384 : 4 * 16384);
    }
    for (int rep_ = 0; rep_ < (PRO_PROBE == 4 ? 2 : 1); ++rep_) {
    for (int i = C.vcu * 512 + C.tid; i < 3 * 16 * 1024; i += C.G * 512) {
        const int w = i >> 14, n = (i >> 10) & 15, k = i & 1023;
        const float v = w < 2 ? C.in[3][(size_t)w * 1024 * FOX_IN + (size_t)k * FOX_IN + 4096 + n] : C.in[8][(size_t)k * GLA_IN + 3072 + n];
        ((bf16*)(C.ws + WS_TAILW))[i] = (bf16)f2bf(v);
    }
    if (C.vcu == 0) for (int c = C.tid; c < 1024; c += 512) {
        const float l0 = C.in[14][c], l1 = C.in[14][1024 + c], l2 = C.in[14][2048 + c], l3 = C.in[14][3072 + c];
        const float m = fmaxf(fmaxf(l0, l1), fmaxf(l2, l3));
        const float e0 = expf(l0 - m), e1 = expf(l1 - m), e2 = expf(l2 - m), e3 = expf(l3 - m);
        ((float*)(C.ws + WS_LB))[c] = (e1 + e2) / (e0 + e1 + e2 + e3);
    }
    for (int m0 = C.gw; m0 < NTOK; m0 += 4 * C.NGW) {
        f32x4 v[4][4];
#pragma unroll
        for (int u = 0; u < 4; ++u) { const int m = m0 + u * C.NGW; if (m < NTOK) { const GAS f32x4* xr = (const GAS f32x4*)(C.in[0] + (size_t)m * 1024) + C.lane;
#pragma unroll
            for (int j = 0; j < 4; ++j) v[u][j] = xr[64 * j]; } }
        __builtin_amdgcn_sched_barrier(0);
#pragma unroll
        for (int u = 0; u < 4; ++u) { const int m = m0 + u * C.NGW; if (m < NTOK)
            rms_row_to_bf16(C.lane, v[u], C.in[1], (bf16*)(C.ws + WS_XN) + (size_t)m * 1024, (signed char*)(C.ws + WS_XN8) + (size_t)m * 1024, (float*)(C.ws + WS_SX) + m); }
    }
    }
}

__device__ __forceinline__ void tail_mfma(const Ctx& C, int tok0, const bf16* WT, LAS float* part) {
    const int l = C.lane, m = l & 15, g = l >> 4, tbk = C.wave & 3, kh = C.wave >> 2;
    const bf16* ap = (const bf16*)(C.ws + WS_XN) + (size_t)(tok0 + 16 * tbk + m) * 1024 + kh * 512 + 8 * g;
    const bf16* bp = WT + (size_t)m * 1024 + kh * 512 + 8 * g;
    f32x4 acc = (f32x4){0.f, 0.f, 0.f, 0.f};
#pragma unroll 4
    for (int ks = 0; ks < 16; ++ks) acc = __builtin_amdgcn_mfma_f32_16x16x32_bf16(*(const bf16x8*)(ap + 32 * ks), *(const bf16x8*)(bp + 32 * ks), acc, 0, 0, 0);
#pragma unroll
    for (int r = 0; r < 4; ++r) part[kh * 1024 + (16 * tbk + 4 * g + r) * 16 + m] = acc[r];
}
template <bool QK> __device__ __forceinline__ void fox_step1(const Ctx& C, int j) {
    float* TAIL = (float*)(C.ws + WS_TAIL); LAS float* part = (LAS float*)C.lds;
    const bf16* WT = (const bf16*)(C.ws + WS_TAILW) + (size_t)j * 16 * 1024;
    for (int tb = C.vcu; tb < NTOK / 64; tb += C.G) {
        __syncthreads();
        tail_mfma(C, tb * 64, WT, part);
        __syncthreads();
#pragma unroll
        for (int rep = 0; rep < 2; ++rep) { const int i = rep * 512 + C.tid; TAIL[(size_t)tb * 1024 + i] = log_sigmoid_f(part[i] + part[1024 + i] + C.in[4][j * 16 + (i & 15)]); }
        if (!QK) continue;
        const float* gq = C.in[5] + j * 64; const float* gk = C.in[6] + j * 64;
        v4u ra[2][8], rb[2][8];
#pragma unroll
        for (int which = 0; which < 2; ++which)
#pragma unroll
            for (int t = 0; t < 8; ++t) { const bf16* row = (const bf16*)(C.ws + WS_P) + (size_t)which * PSTRIDE + (size_t)(tb * 64 + C.wave * 8 + t) * 1024 + C.lane * 16;
                ra[which][t] = *(const GAS v4u*)row; rb[which][t] = *(const GAS v4u*)(row + 8); }
        __builtin_amdgcn_sched_barrier(0);
#pragma unroll
        for (int which = 0; which < 2; ++which) {
            const float* g = (which == 0 ? gq : gk) + (C.lane & 3) * 16;
            float gv[16];
#pragma unroll
            for (int i = 0; i < 16; ++i) gv[i] = g[i];
#pragma unroll
            for (int t = 0; t < 8; ++t) {
                bf16* row = (bf16*)(C.ws + WS_P) + (size_t)which * PSTRIDE + (size_t)(tb * 64 + C.wave * 8 + t) * 1024 + C.lane * 16;
                const v4u a = ra[which][t], b = rb[which][t];
                float v[16] = {bflo(a.x), bfhi(a.x), bflo(a.y), bfhi(a.y), bflo(a.z), bfhi(a.z), bflo(a.w), bfhi(a.w), bflo(b.x), bfhi(b.x), bflo(b.y), bfhi(b.y), bflo(b.z), bfhi(b.z), bflo(b.w), bfhi(b.w)};
                float ss = 0.f;
#pragma unroll
                for (int i = 0; i < 16; ++i) ss += v[i] * v[i];
                ss = DPP_ADD(ss, 0xB1, 0xf, 0xf); ss = DPP_ADD(ss, 0x4E, 0xf, 0xf);
                const float r = rsqrtf(ss * (1.f / 64.f) + RMS_EPS) * (which == 0 ? FOX_C2 : 1.f);
#pragma unroll
                for (int i = 0; i < 16; ++i) v[i] = v[i] * r * gv[i];
                v4u oa, ob; oa.x = pk2(v[0], v[1]); oa.y = pk2(v[2], v[3]); oa.z = pk2(v[4], v[5]); oa.w = pk2(v[6], v[7]);
                ob.x = pk2(v[8], v[9]); ob.y = pk2(v[10], v[11]); ob.z = pk2(v[12], v[13]); ob.w = pk2(v[14], v[15]);
                *(GAS v4u*)row = oa; *(GAS v4u*)(row + 8) = ob;
            }
        }
    }
}
constexpr size_t WS_ASC = WS_Q2, WS_Q1 = WS_Q2 + 16 * MiB, WS_KST = WS_Q2 + 48 * MiB, WS_DEC = 59 * MiB;
static_assert(WS_KST + 32 * MiB <= WS_OF && WS_Q1 + 32 * MiB <= WS_KST, "chunk workspace map");
template <int NH>
__device__ __forceinline__ void chunk_prepass(const Ctx& C) {
    bf16* ASC = (bf16*)(C.ws + WS_ASC); bf16* Q1 = (bf16*)(C.ws + WS_Q1); bf16* KST = (bf16*)(C.ws + WS_KST); float* DEC = (float*)(C.ws + WS_DEC);
    const bf16* P0 = (const bf16*)(C.ws + WS_P); const bf16* P1 = P0 + PSTRIDE;
    LAS bf16* tqs = (LAS bf16*)C.lds;
    LAS bf16* tks = tqs + 64 * 128;
    LAS bf16* q2s = tks + 64 * 128;
    LAS bf16* k2s = q2s + 64 * 136;
    LAS bf16* q1s = k2s + 64 * 136;
    LAS float* tot = (LAS float*)(q1s + 64 * 128);
    LAS float* part = tot + 512;
    const float qs = 0.08838834764831845f;
    const int d = C.tid & 127, tq = C.tid >> 7, l = C.lane, fr = l & 15, fq = l >> 4;
    const int dq = (d & ~31) + ((d & 16) ? 8 * ((d & 15) >> 2) + 4 + (d & 3) : 8 * ((d & 15) >> 2) + (d & 3));
    const int pr0 = C.tid >> 4, pc = (C.tid & 15) * 8;
#define PP_BAR() do { asm volatile("s_waitcnt lgkmcnt(0)" ::: "memory"); __builtin_amdgcn_s_barrier(); asm volatile("" ::: "memory"); } while (0)
    for (int itb = C.vcu; itb < NBATCH * 32; itb += C.G) {
        const int c = itb & 31, b = itb >> 5;
        const size_t rowb = (size_t)b * SEQLEN + c * 64;
        const size_t row0 = rowb + tq * 16;
        if (NH == 4) { __syncthreads(); tail_mfma(C, b * SEQLEN + c * 64, (const bf16*)(C.ws + WS_TAILW) + 2 * 16 * 1024, part); }
        v4u pq[2], pk[2];
#define PP_LOAD(h_) do { _Pragma("unroll") for (int j = 0; j < 2; ++j) { const size_t r_ = (rowb + pr0 + 32 * j) * 1024 + (h_) * 128 + pc; \
            pq[j] = *(const GAS v4u*)(P0 + r_); pk[j] = *(const GAS v4u*)((NH == 4 ? P0 + 512 : P1) + r_); } } while (0)
        PP_LOAD(0);
#pragma unroll 1
        for (int h = 0; h < NH; ++h) {
            const int it = (b * NH + h) * 32 + c;
            PP_BAR();
#pragma unroll
            for (int j = 0; j < 2; ++j) { *(LAS v4u*)(tqs + (pr0 + 32 * j) * 128 + pc) = pq[j]; *(LAS v4u*)(tks + (pr0 + 32 * j) * 128 + pc) = pk[j]; }
            if (h + 1 < NH) PP_LOAD(h + 1);
            PP_BAR();
            float bl[16], kk[16]; float run = 0.f;
            if (NH == 4) {
                float wu[16];
#pragma unroll
                for (int r = 0; r < 16; ++r) wu[r] = C.in[9][r * 512 + h * 128 + d];
                const float ba = C.in[10][h * 128 + d];
#pragma unroll
                for (int i = 0; i < 16; ++i) { float z = ba; const int t = tq * 16 + i;
#pragma unroll
                    for (int r = 0; r < 16; r += 4) { const f32x4 p0 = *(const LAS f32x4*)(part + t * 16 + r), p1 = *(const LAS f32x4*)(part + 1024 + t * 16 + r);
                        z += (p0[0] + p1[0]) * wu[r] + (p0[1] + p1[1]) * wu[r + 1] + (p0[2] + p1[2]) * wu[r + 2] + (p0[3] + p1[3]) * wu[r + 3]; }
                    run += log_sigmoid_f(z) * (1.f / 16.f); bl[i] = run; kk[i] = bf2f(tks[t * 128 + d]); }
            } else {
                const float lb = ((const float*)(C.ws + WS_LB))[h * 128 + d];
#pragma unroll
                for (int i = 0; i < 16; ++i) { const float gate = lb + (1.f - lb) * sigmoid_f(bf2f(tks[(tq * 16 + i) * 128 + d])); run += __logf(gate); bl[i] = run; kk[i] = 1.f - gate; }
            }
            tot[tq * 128 + d] = run;
            PP_BAR();
            const float t0 = tot[d], t1 = tot[128 + d], t2 = tot[256 + d], t3 = tot[384 + d];
            const float off = tq == 0 ? 0.f : tq == 1 ? t0 : tq == 2 ? t0 + t1 : t0 + t1 + t2;
            const float bref = t0 + t1, bend = (t0 + t1) + (t2 + t3);
            unsigned ksw[8];
#pragma unroll
            for (int i = 0; i < 16; ++i) {
                const float bb = bl[i] + off;
                const float qv = bf2f(tqs[(tq * 16 + i) * 128 + d]) * qs, kv = kk[i];
                q1s[(tq * 16 + i) * 128 + dq] = (bf16)f2bf(qv * __expf(bb));
                q2s[(tq * 16 + i) * 136 + d] = (bf16)f2bf(qv * __expf(bb - bref));
                k2s[(tq * 16 + i) * 136 + d] = (bf16)f2bf(kv * __expf(bref - bb));
                const unsigned kb = f2bf(kv * __expf(bend - bb));
                if (i & 1) ksw[i >> 1] |= kb << 16; else ksw[i >> 1] = kb;
            }
            { bf16* kt = KST + ((size_t)it * 128 + d) * 64 + tq * 16; *(GAS v4u*)kt = (v4u){ksw[0], ksw[1], ksw[2], ksw[3]}; *(GAS v4u*)(kt + 8) = (v4u){ksw[4], ksw[5], ksw[6], ksw[7]}; }
            if (tq == 0) DEC[(size_t)it * 128 + d] = __expf(bend);
            PP_BAR();
#pragma unroll
            for (int j = 0; j < 2; ++j) *(GAS v4u*)(Q1 + (((size_t)it * 4 + (pc >> 5)) * 64 + pr0 + 32 * j) * 32 + (pc & 31)) = *(const LAS v4u*)(q1s + (pr0 + 32 * j) * 128 + pc);
            const int ti = C.wave >> 1;
#pragma unroll
            for (int sj = 0; sj < 2; ++sj) {
                const int si = 2 * (C.wave & 1) + sj;
                f32x4 acc = (f32x4){0.f, 0.f, 0.f, 0.f};
                if (si <= ti) {
#pragma unroll
                    for (int ks = 0; ks < 4; ++ks) {
                        const bf16x8 a = *(const LAS bf16x8*)(q2s + (16 * ti + fr) * 136 + ks * 32 + fq * 8), bb = *(const LAS bf16x8*)(k2s + (16 * si + fr) * 136 + ks * 32 + fq * 8);
                        acc = __builtin_amdgcn_mfma_f32_16x16x32_bf16(bb, a, acc, 0, 0, 0);
                    }
                }
                const int t = 16 * ti + fr, s0 = 16 * si + 4 * fq;
                typedef unsigned u32x2v __attribute__((ext_vector_type(2)));
                u32x2v w; w.x = pk2(s0 <= t ? acc[0] : 0.f, s0 + 1 <= t ? acc[1] : 0.f); w.y = pk2(s0 + 2 <= t ? acc[2] : 0.f, s0 + 3 <= t ? acc[3] : 0.f);
                *(GAS u32x2v*)(ASC + (size_t)it * 4096 + t * 64 + s0) = w;
            }
        }
    }
#undef PP_LOAD
#undef PP_BAR
}
struct RecFrag { bf16x8 a0, a1; bf16x8 q[4]; f32x4 dc[2]; bf16x8 ks[2][2]; };
template <int NH, int DV, int RP = 0  >
__device__ __forceinline__ void chunk_recur(const Ctx& C, const bf16* Vp) {
    const bf16* ASC = (const bf16*)(C.ws + WS_ASC); const bf16* Q1 = (const bf16*)(C.ws + WS_Q1); const bf16* KST = (const bf16*)(C.ws + WS_KST); const float* DEC = (const float*)(C.ws + WS_DEC);
    bf16* OF = (bf16*)(C.ws + (RP ? WS_GLOG : WS_OF));
    constexpr int NCB = DV / 16, NTASK = NBATCH * NH * NCB;
    const int l = C.lane, m = l & 15, g = l >> 4, gi = C.wave >> 2, kq = C.wave & 3;
    LAS float* red = (LAS float*)C.lds + gi * 8192;
    LAS bf16* vt = (LAS bf16*)(C.lds + 65536) + gi * 2048;
    typedef short v4i16_t __attribute__((ext_vector_type(4)));
#define REC_LOAD(F, c_) do { const size_t row0_ = (size_t)b * SEQLEN + (c_) * 64; const size_t ch_ = (size_t)bh * 32 + (c_); \
        F.a0 = *(const bf16x8*)(ASC + ch_ * 4096 + (16 * kq + m) * 64 + 8 * g); F.a1 = *(const bf16x8*)(ASC + ch_ * 4096 + (16 * kq + m) * 64 + 32 + 8 * g); \
        _Pragma("unroll") for (int tb = 0; tb < 4; ++tb) F.q[tb] = *(const bf16x8*)(Q1 + ((ch_ * 4 + kq) * 64 + 16 * tb + m) * 32 + 8 * g); \
        _Pragma("unroll") for (int i = 0; i < 2; ++i) { F.dc[i] = *(const f32x4*)(DEC + ch_ * 128 + 32 * kq + 16 * i + 4 * g); \
            _Pragma("unroll") for (int ks = 0; ks < 2; ++ks) F.ks[i][ks] = *(const bf16x8*)(KST + (ch_ * 128 + 32 * kq + 16 * i + m) * 64 + 32 * ks + 8 * g); } } while (0)
#define VP_LOAD(c_) (*(const unsigned long long*)(Vp + ((size_t)b * SEQLEN + (c_) * 64 + 16 * kq + (l >> 2)) * 1024 + h * DV + cb * 16 + 4 * (l & 3)))
#define VT_PUT(c_, v_) (*(LAS unsigned long long*)(vt + ((c_) & 1) * 1024 + (16 * kq + (l >> 2)) * 16 + 4 * (l & 3)) = (v_))
#define REC_BODY(F, Fn, c_, vcur_, vnew_) do { \
        if ((c_) + 1 < 32 && RP != 3) REC_LOAD(Fn, (c_) + 1); \
        if ((c_) + 2 < 32) vnew_ = VP_LOAD((c_) + 2); \
        bf16x8 vb[2]; \
        _Pragma("unroll") for (int ks = 0; ks < 2; ++ks) { const LAS bf16* tp_ = vt + ((c_) & 1) * 1024 + (32 * ks + 8 * g + ((l & 15) >> 2)) * 16 + 4 * (l & 3); \
            const v4i16_t lo_ = __builtin_amdgcn_ds_read_tr16_b64_v4i16((LAS v4i16_t*)tp_), hi_ = __builtin_amdgcn_ds_read_tr16_b64_v4i16((LAS v4i16_t*)(tp_ + 64)); \
            vb[ks] = (bf16x8){lo_[0], lo_[1], lo_[2], lo_[3], hi_[0], hi_[1], hi_[2], hi_[3]}; } \
        if ((c_) + 1 < 32) VT_PUT((c_) + 1, vcur_);              \
        if (BGQ && RP == 0) { const int bgn = (bgit * 32 + (c_)) * C.NGW + C.gw; bgq_step<JOB>(C, bgi, bgn, bgv); bgi = bgn; } \
        LAS float* rb = red + ((c_) & 1) * 4096; \
        f32x4 oin = __builtin_amdgcn_mfma_f32_16x16x32_bf16(F.a0, vb[0], (f32x4){0.f, 0.f, 0.f, 0.f}, 0, 0, 0); \
        if (kq >= 2) oin = __builtin_amdgcn_mfma_f32_16x16x32_bf16(F.a1, vb[1], oin, 0, 0, 0); \
        { u32x4v sw; sw.x = pk2(S[0][0], S[0][1]); sw.y = pk2(S[0][2], S[0][3]); sw.z = pk2(S[1][0], S[1][1]); sw.w = pk2(S[1][2], S[1][3]); \
          const bf16x8 sb = __builtin_bit_cast(bf16x8, sw); \
          _Pragma("unroll") for (int tb = 0; tb < 4; ++tb) { \
              const f32x4 po = __builtin_amdgcn_mfma_f32_16x16x32_bf16(F.q[tb], sb, (f32x4){0.f, 0.f, 0.f, 0.f}, 0, 0, 0); \
              *(LAS f32x4*)(rb + ((kq * 4 + tb) * 64 + l) * 4) = po; } } \
        _Pragma("unroll") for (int i = 0; i < 2; ++i) { S[i] = S[i] * F.dc[i]; \
            _Pragma("unroll") for (int ks = 0; ks < 2; ++ks) S[i] = __builtin_amdgcn_mfma_f32_16x16x32_bf16(F.ks[i][ks], vb[ks], S[i], 0, 0, 0); } \
        if (RP != 2) { asm volatile("s_waitcnt lgkmcnt(0)" ::: "memory"); __builtin_amdgcn_s_barrier(); asm volatile("" ::: "memory"); } \
        { f32x4 o = oin; \
          if (RP != 2) { _Pragma("unroll") for (int k2 = 0; k2 < 4; ++k2) o = o + *(const LAS f32x4*)(rb + ((k2 * 4 + kq) * 64 + l) * 4); } \
          const size_t orow = (size_t)b * SEQLEN + (c_) * 64 + 16 * kq + 4 * g; \
          if (RP != 4 || (c_) == 31) { _Pragma("unroll") for (int r = 0; r < 4; ++r) OF[(orow + r) * 1024 + col] = (bf16)f2bf(o[r]); } } } while (0)
    constexpr int JOB = NH == 4 ? 1 : 2;
    f32x4 bgv[4]; int bgi = -1, bgit = 0;
    for (int t0 = C.vcu; t0 < NTASK / 2; t0 += C.G, ++bgit) {
        const int task = gi * (NTASK / 2) + t0;
        const int cb = task % NCB, bh = task / NCB, b = bh / NH, h = bh % NH;
        const int col = h * DV + cb * 16 + m;
        f32x4 S[2];
        S[0] = (f32x4){0.f, 0.f, 0.f, 0.f}; S[1] = S[0];
        RecFrag FA, FB;
        REC_LOAD(FA, 0);
        if (RP == 3) REC_LOAD(FB, 1);
        unsigned long long vA = VP_LOAD(0), vB = VP_LOAD(1);
        VT_PUT(0, vA); vA = vB;
        asm volatile("s_waitcnt lgkmcnt(0)" ::: "memory"); __builtin_amdgcn_s_barrier(); asm volatile("" ::: "memory");
#pragma unroll 1
        for (int c = 0; c < 32; c += 2) { REC_BODY(FA, FB, c, vA, vB); REC_BODY(FB, FA, c + 1, vB, vA); }
        asm volatile("s_waitcnt lgkmcnt(0)" ::: "memory"); __builtin_amdgcn_s_barrier(); asm volatile("" ::: "memory");
    }
    if (BGQ && RP == 0) {
        for (int bgn = bgit * 32 * C.NGW + C.gw; bgi < BGQ_ROWS; bgn += C.NGW) { bgq_step<JOB>(C, bgi, bgn, bgv); bgi = bgn; }
    }
#undef REC_LOAD
#undef REC_BODY
#undef VP_LOAD
#undef VT_PUT
}

template <int DV>
__device__ __forceinline__ void rec_norm_gate(const Ctx& C, const float* gain, const bf16* gate) {
    const bf16* OF = (const bf16*)(C.ws + WS_OF); bf16* OB = (bf16*)(C.ws + WS_OB);
    f32x4 g[4];
#pragma unroll
    for (int j = 0; j < 4; ++j) g[j] = *((const GAS f32x4*)gain + C.lane + 64 * j);
    for (int tok0 = C.gw; tok0 < NTOK; tok0 += 4 * C.NGW) {
        unsigned long long vw[4][4], tw[4][4];
#pragma unroll
        for (int u = 0; u < 4; ++u) { const int tok = tok0 + u * C.NGW; if (tok < NTOK) {
            const GAS unsigned long long* xr = (const GAS unsigned long long*)(OF + (size_t)tok * 1024) + C.lane;
            const GAS unsigned long long* tr = (const GAS unsigned long long*)(gate + (size_t)tok * 1024) + C.lane;
#pragma unroll
            for (int j = 0; j < 4; ++j) { vw[u][j] = xr[64 * j]; tw[u][j] = tr[64 * j]; } } }
        __builtin_amdgcn_sched_barrier(0);
#pragma unroll
        for (int u = 0; u < 4; ++u) { const int tok = tok0 + u * C.NGW; if (tok < NTOK) {
            GAS unsigned long long* o8 = (GAS unsigned long long*)(OB + (size_t)tok * 1024) + C.lane;
#pragma unroll
            for (int j = 0; j < 4; ++j) {
                const f32x4 v = (f32x4){bflo((unsigned)vw[u][j]), bfhi((unsigned)vw[u][j]), bflo((unsigned)(vw[u][j] >> 32)), bfhi((unsigned)(vw[u][j] >> 32))}; float ss = (v.x * v.x + v.y * v.y) + (v.z * v.z + v.w * v.w);
                if (DV == 256) ss = wave_sum(ss); else { DPP_SUM31(ss); const float s_lo = rdlane(ss, 31), s_hi = rdlane(ss, 63); ss = C.lane < 32 ? s_lo : s_hi; }
                const float r = rsqrtf(ss * (1.f / DV) + RMS_EPS);
                const unsigned long long t8 = tw[u][j];
                const float t0 = bflo((unsigned)t8), t1 = bfhi((unsigned)t8), t2 = bflo((unsigned)(t8 >> 32)), t3 = bfhi((unsigned)(t8 >> 32));
                const float a0 = v.x * r * g[j].x * (t0 * sigmoid_f(t0)), a1 = v.y * r * g[j].y * (t1 * sigmoid_f(t1)), a2 = v.z * r * g[j].z * (t2 * sigmoid_f(t2)), a3 = v.w * r * g[j].w * (t3 * sigmoid_f(t3));
                o8[64 * j] = (unsigned long long)pk2(a0, a1) | ((unsigned long long)pk2(a2, a3) << 32);
            } } }
    }
}

#define CE_D(a, b) do { const unsigned mx_ = (a) > (b) ? (a) : (b); const unsigned mn_ = (a) > (b) ? (b) : (a); (a) = mx_; (b) = mn_; } while (0)
__device__ __forceinline__ void sort16_desc(unsigned (&a)[16]) {
#pragma unroll
    for (int k = 2; k <= 16; k <<= 1)
#pragma unroll
        for (int j = k >> 1; j > 0; j >>= 1)
#pragma unroll
            for (int i = 0; i < 16; ++i) { const int l = i ^ j; if (l > i) { if ((i & k) == 0) CE_D(a[i], a[l]); else CE_D(a[l], a[i]); } }
}
__device__ __forceinline__ void merge_top16(unsigned (&a)[16], const unsigned (&b)[16]) {
#pragma unroll
    for (int i = 0; i < 16; ++i) a[i] = a[i] > b[15 - i] ? a[i] : b[15 - i];
#pragma unroll
    for (int j = 8; j > 0; j >>= 1)
#pragma unroll
        for (int i = 0; i < 16; ++i) { const int l = i ^ j; if (l > i) CE_D(a[i], a[l]); }
}
__device__ __forceinline__ void merge_quad(unsigned (&a)[16], int lane) {
    unsigned p[16];
#pragma unroll
    for (int i = 0; i < 16; ++i) p[i] = (unsigned)__builtin_amdgcn_ds_bpermute((lane ^ 16) << 2, (int)a[i]);
    merge_top16(a, p);
#pragma unroll
    for (int i = 0; i < 16; ++i) p[i] = (unsigned)__builtin_amdgcn_ds_bpermute((lane ^ 32) << 2, (int)a[i]);
    merge_top16(a, p);
}
__device__ __forceinline__ unsigned mono_key(float f) { const unsigned u = __float_as_uint(f); return (u & 0x80000000u) ? ~u : (u | 0x80000000u); }
__device__ __forceinline__ float mono_inv(unsigned k) { return __uint_as_float((k & 0x80000000u) ? (k ^ 0x80000000u) : ~k); }
__constant__ __attribute__((aligned(16))) unsigned char PEER_CAND[64] = {0, 1, 2, 3, 4, 5, 6, 7, 8, 9, 10, 11, 12, 13, 14, 15, 16, 17, 18, 19, 20, 21, 22, 23, 32, 33, 34, 35, 36, 64, 65, 66, 48, 49, 50, 51, 80, 81, 96, 97, 112, 113, 128, 144, 160, 176, 192, 208, 224, 240, 255, 255, 255, 255, 255, 255, 255, 255, 255, 255, 255, 255, 255, 255};
__device__ __forceinline__ void peer_topk_task(const Ctx& C, int layer, int tok0, int head, int trow0, LAS int* lexp, LAS float* lgate) {
    typedef _Float16 h8 __attribute__((ext_vector_type(8)));
    const _Float16* SC = (const _Float16*)(C.ws + WS_Q2);
    LAS unsigned* L0 = (LAS unsigned*)(C.lds + C.wave * 2048);
    LAS unsigned* L1 = L0 + 256;
    {
        int l = C.lane; asm volatile("" : "+v"(l));
        const int m = l & 15, g = l >> 4;
        unsigned cand_w[4];
#pragma unroll
        for (int c = 0; c < 4; ++c) cand_w[c] = ((const unsigned*)PEER_CAND)[g * 4 + c];
        unsigned top[2][16];
#pragma unroll
        for (int p = 0; p < 2; ++p) {
            const _Float16* sp = SC + (size_t)(tok0 + m) * 2048 + head * 256 + p * 128 + 32 * g;
            h8 hv[4];
#pragma unroll
            for (int q = 0; q < 4; ++q) hv[q] = *(const h8*)(sp + 8 * q);
            unsigned hi16[16];
#pragma unroll
            for (int q = 0; q < 4; ++q)
#pragma unroll
                for (int j = 0; j < 8; ++j) { const int i = 8 * q + j; const unsigned key = (mono_key((float)hv[q][j]) & ~0x7fu) | (unsigned)(127 - (32 * g + i));
                    if (i < 16) top[p][i] = key; else hi16[i - 16] = key; }
            sort16_desc(top[p]); sort16_desc(hi16); merge_top16(top[p], hi16);
            merge_quad(top[p], l);
        }
        if (g == 0) {
#pragma unroll
            for (int i = 0; i < 16; i += 4) { *(LAS u32x4v*)(L0 + m * 16 + i) = (u32x4v){top[0][i], top[0][i + 1], top[0][i + 2], top[0][i + 3]}; *(LAS u32x4v*)(L1 + m * 16 + i) = (u32x4v){top[1][i], top[1][i + 1], top[1][i + 2], top[1][i + 3]}; }
        }
        asm volatile("s_waitcnt lgkmcnt(0)" ::: "memory"); __builtin_amdgcn_wave_barrier();
        unsigned cd[16];
#pragma unroll
        for (int c = 0; c < 16; ++c) {
            const unsigned code = (cand_w[c >> 2] >> (8 * (c & 3))) & 0xffu, ci = (code >> 4) & 15u, cj = code & 15u;
            const float v = mono_inv(L0[m * 16 + ci]) + mono_inv(L1[m * 16 + cj]);
            cd[c] = code == 255u ? 0u : ((mono_key(v) & ~0xffu) | (255u - code));
        }
        sort16_desc(cd); merge_quad(cd, l);
        if (g == 0) {
            float best[16]; int ex[16]; float sum = 0.f;
#pragma unroll
            for (int r = 0; r < 16; ++r) { const unsigned pos = 255u - (cd[r] & 0xffu), pi = pos >> 4, pj = pos & 15u;
                ex[r] = (int)((127u - (L0[m * 16 + pi] & 0x7fu)) * 128u + (127u - (L1[m * 16 + pj] & 0x7fu))); best[r] = mono_inv(cd[r]); }
            const float bmax = best[0];
#pragma unroll
            for (int r = 0; r < 16; ++r) { best[r] = __expf(best[r] - bmax); sum += best[r]; }
            const float inv = 1.f / sum;
            const int ob = (trow0 + m) * 128 + head * 16;
#pragma unroll
            for (int r = 0; r < 16; r += 4) { *(LAS u32x4v*)(lexp + ob + r) = (u32x4v){(unsigned)ex[r], (unsigned)ex[r + 1], (unsigned)ex[r + 2], (unsigned)ex[r + 3]};
                *(LAS f32x4*)(lgate + ob + r) = (f32x4){best[r] * inv, best[r + 1] * inv, best[r + 2] * inv, best[r + 3] * inv}; }
        }
        asm volatile("s_waitcnt lgkmcnt(0)" ::: "memory"); __builtin_amdgcn_wave_barrier();
    }
}
typedef float f32x2v __attribute__((ext_vector_type(2)));
#define GRP8_SUM(v) do { v = DPP_ADD(v, 0xB1, 0xf, 0xf); v = DPP_ADD(v, 0x4E, 0xf, 0xf); v = DPP_ADD(v, 0x141, 0xf, 0xf); } while (0)
#ifndef MK_HOT
#define MK_HOT 0
#endif
__device__ __forceinline__ void wave_lds_sync() { asm volatile("s_waitcnt lgkmcnt(0)" ::: "memory"); __builtin_amdgcn_wave_barrier(); }
template <bool DRY>
__device__ __forceinline__ void peer_rounds(const Ctx& C, int layer, int tokw, LAS int* lexp_w, const LAS float* lgate_w, LAS unsigned* sorted_w, LAS unsigned* hist_w) {
    const unsigned char* U = C.ws + WS_U + (size_t)layer * 16384 * 1024; const unsigned char* V = C.ws + WS_V + (size_t)layer * 16384 * 1024;
    const float* SU = (const float*)(C.ws + WS_SU) + layer * 16384; const float* SV = (const float*)(C.ws + WS_SV) + layer * 16384;
    const float* gf = C.in[2] + layer * 1024; const float* gn = C.in[1] + (layer + 1) * 1024;
    int l = C.lane; asm volatile("" : "+v"(l));
    LAS float* hbuf = (LAS float*)lexp_w;
    {
        const int t = l >> 3, s = l & 7;
#pragma unroll
        for (int k = 0; k < 8; ++k) hist_w[l + 64 * k] = 0u;
        wave_lds_sync();
        unsigned ev[16], pos[16];
#pragma unroll
        for (int k = 0; k < 16; ++k) { ev[k] = (unsigned)lexp_w[t * 128 + s + 8 * k]; pos[k] = __hip_atomic_fetch_add(hist_w + t * 64 + (ev[k] >> 8), 1u, __ATOMIC_RELAXED, __HIP_MEMORY_SCOPE_WORKGROUP); }
        wave_lds_sync();
        unsigned cnt[8], run = 0u;
#pragma unroll
        for (int j = 0; j < 8; ++j) { cnt[j] = hist_w[t * 64 + 8 * s + j]; run += cnt[j]; }
        unsigned inc = run;
#pragma unroll
        for (int o = 1; o < 8; o <<= 1) { const unsigned up = (unsigned)__builtin_amdgcn_ds_bpermute((l - o) << 2, (int)inc); if (s >= o) inc += up; }
        unsigned off = inc - run;
        wave_lds_sync();
#pragma unroll
        for (int j = 0; j < 8; ++j) { hist_w[t * 64 + 8 * s + j] = off; off += cnt[j]; }
        wave_lds_sync();
#pragma unroll
        for (int k = 0; k < 16; ++k) sorted_w[t * 128 + hist_w[t * 64 + (ev[k] >> 8)] + pos[k]] = (ev[k] << 7) | (unsigned)(s + 8 * k);
        wave_lds_sync();
    }
    asm volatile("" : "+v"(l));
    unsigned xp[8][8];
    {
        const int t = l >> 3, s = l & 7;
        const bf16* hrow = (const bf16*)(C.ws + WS_HB) + (size_t)(tokw + t) * 1024 + 16 * s;
        float ss = 0.f;
#pragma unroll
        for (int i = 0; i < 8; ++i) { const v4u a = *(const GAS v4u*)(hrow + 128 * i), b = *(const GAS v4u*)(hrow + 128 * i + 8);
            xp[i][0] = a.x; xp[i][1] = a.y; xp[i][2] = a.z; xp[i][3] = a.w; xp[i][4] = b.x; xp[i][5] = b.y; xp[i][6] = b.z; xp[i][7] = b.w;
#pragma unroll
            for (int j = 0; j < 8; ++j) { const float lo = bflo(xp[i][j]), hi = bfhi(xp[i][j]); ss += lo * lo + hi * hi; } }
        GRP8_SUM(ss);
        const float r = rsqrtf(ss * (1.f / 1024.f) + RMS_EPS);
#pragma unroll
        for (int i = 0; i < 8; ++i)
#pragma unroll
            for (int q = 0; q < 4; ++q) { const f32x4 a = *(const GAS f32x4*)(gf + 16 * s + 128 * i + 4 * q);
                xp[i][2 * q] = pk2(bflo(xp[i][2 * q]) * r * a.x, bfhi(xp[i][2 * q]) * r * a.y); xp[i][2 * q + 1] = pk2(bflo(xp[i][2 * q + 1]) * r * a.z, bfhi(xp[i][2 * q + 1]) * r * a.w); }
    }
    asm volatile("" : "+v"(l));
#define RND_LOAD(T, buf, item) do { const unsigned char* p_ = T + (size_t)((DRY && MK_HOT) ? (((item) >> 7) & 255u) : ((item) >> 7)) * 1024 + 16 * (l & 7); \
        _Pragma("unroll") for (int i = 0; i < 8; ++i) buf[i] = *(const GAS v4u*)(p_ + 128 * i); } while (0)
    {
        const int t = l >> 3, s = l & 7;
        const LAS unsigned* srt = sorted_w + t * 128;
        v4u bA[8], bB[8];
#define RND_DOT(buf, r_) do { float d = 0.f; \
            _Pragma("unroll") for (int i = 0; i < 8; ++i) { asm volatile("" : "+v"(buf[i])); _Pragma("unroll") for (int q = 0; q < 4; ++q) { \
                const f32x2v lo_ = __builtin_amdgcn_cvt_pk_f32_fp8((int)buf[i][q], false), hi_ = __builtin_amdgcn_cvt_pk_f32_fp8((int)buf[i][q], true); \
                d = dot2bf(pg8::cvt_pk_bf16(lo_.x, lo_.y), xp[i][2 * q], d); d = dot2bf(pg8::cvt_pk_bf16(hi_.x, hi_.y), xp[i][2 * q + 1], d); } } \
            GRP8_SUM(d); if (s == 0) hbuf[t * 128 + (r_)] = d; } while (0)
        RND_LOAD(U, bA, srt[0]);
#pragma unroll 1
        for (int r = 0; r < 128; r += 2) {
            RND_LOAD(U, bB, srt[r + 1]);
            RND_DOT(bA, r);
            RND_LOAD(U, bA, srt[(r + 2) & 127]);
            RND_DOT(bB, r + 1);
        }
#undef RND_DOT
    }
    wave_lds_sync();
    asm volatile("" : "+v"(l));
    {
        const int t = l >> 3, s = l & 7;
#pragma unroll
        for (int k = 0; k < 16; k += 2) {
            const int r0 = t * 128 + s + 8 * k, r1 = r0 + 8;
            const unsigned i0 = sorted_w[r0], i1 = sorted_w[r1];
            const float h0 = hbuf[r0] * SU[i0 >> 7], h1 = hbuf[r1] * SU[i1 >> 7];
            const pg8::f32x2 gl = pg8::gelu_pk((pg8::f32x2){h0, h1});
            hbuf[r0] = gl.x * lgate_w[t * 128 + (i0 & 127u)] * SV[i0 >> 7]; hbuf[r1] = gl.y * lgate_w[t * 128 + (i1 & 127u)] * SV[i1 >> 7];
        }
    }
    wave_lds_sync();
    asm volatile("" : "+v"(l));
    f32x2v y2[8][8];
#pragma unroll
    for (int i = 0; i < 8; ++i)
#pragma unroll
        for (int j = 0; j < 8; ++j) y2[i][j] = (f32x2v){0.f, 0.f};
    {
        const int t = l >> 3;
        const LAS unsigned* srt = sorted_w + t * 128; const LAS float* wv = hbuf + t * 128;
        v4u bA[8], bB[8];
#define RND_AXPY(buf, r_) do { const float w = wv[(r_)]; const f32x2v w2 = (f32x2v){w, w}; \
            _Pragma("unroll") for (int i = 0; i < 8; ++i) { asm volatile("" : "+v"(buf[i])); _Pragma("unroll") for (int q = 0; q < 4; ++q) { \
                const f32x2v lo_ = __builtin_amdgcn_cvt_pk_f32_fp8((int)buf[i][q], false), hi_ = __builtin_amdgcn_cvt_pk_f32_fp8((int)buf[i][q], true); \
                y2[i][2 * q] = w2 * lo_ + y2[i][2 * q]; y2[i][2 * q + 1] = w2 * hi_ + y2[i][2 * q + 1]; } } } while (0)
        RND_LOAD(V, bA, srt[0]);
#pragma unroll 1
        for (int r = 0; r < 128; r += 2) {
            RND_LOAD(V, bB, srt[r + 1]);
            RND_AXPY(bA, r);
            RND_LOAD(V, bA, srt[(r + 2) & 127]);
            RND_AXPY(bB, r + 1);
        }
#undef RND_AXPY
    }
#undef RND_LOAD
    asm volatile("" : "+v"(l));
    {
        const int t = l >> 3, s = l & 7;
        const bf16* hrow = (const bf16*)(C.ws + WS_HB) + (size_t)(tokw + t) * 1024 + 16 * s;
        float* hout = (DRY ? (float*)(C.ws + WS_OF) : C.out) + (size_t)(tokw + t) * 1024 + 16 * s;
        bf16* hb = (bf16*)(C.ws + (DRY ? WS_OF : WS_HB)) + (size_t)(tokw + t) * 1024 + 16 * s;
        float s2 = 0.f;
#pragma unroll
        for (int i = 0; i < 8; ++i) { const v4u a = *(const GAS v4u*)(hrow + 128 * i), b = *(const GAS v4u*)(hrow + 128 * i + 8);
            const unsigned hw[8] = {a.x, a.y, a.z, a.w, b.x, b.y, b.z, b.w};
#pragma unroll
            for (int j = 0; j < 8; ++j) { y2[i][j].x += bflo(hw[j]); y2[i][j].y += bfhi(hw[j]); s2 += y2[i][j].x * y2[i][j].x + y2[i][j].y * y2[i][j].y; }
            if (layer == DEPTH - 1) {
#pragma unroll
                for (int q = 0; q < 4; ++q) *(GAS f32x4*)(hout + 128 * i + 4 * q) = (f32x4){y2[i][2 * q].x, y2[i][2 * q].y, y2[i][2 * q + 1].x, y2[i][2 * q + 1].y};
            } else {
                *(GAS v4u*)(hb + 128 * i) = (v4u){pk2(y2[i][0].x, y2[i][0].y), pk2(y2[i][1].x, y2[i][1].y), pk2(y2[i][2].x, y2[i][2].y), pk2(y2[i][3].x, y2[i][3].y)};
                *(GAS v4u*)(hb + 128 * i + 8) = (v4u){pk2(y2[i][4].x, y2[i][4].y), pk2(y2[i][5].x, y2[i][5].y), pk2(y2[i][6].x, y2[i][6].y), pk2(y2[i][7].x, y2[i][7].y)};
            } }
        if (layer < DEPTH - 1) {
            GRP8_SUM(s2);
            const float r2 = rsqrtf(s2 * (1.f / 1024.f) + RMS_EPS);
            const bool wx8 = ((I8MASK >> (layer + 1)) & 1) != 0, wxn = ((layer + 1) % 3 != 2) || !wx8;
            bf16* xo = (bf16*)(C.ws + (DRY ? WS_GLOG : WS_XN)) + (size_t)(tokw + t) * 1024 + 16 * s; float am = 0.f;
#pragma unroll
            for (int i = 0; i < 8; ++i) { unsigned pw[8];
#pragma unroll
                for (int q = 0; q < 4; ++q) { const f32x4 a = *(const GAS f32x4*)(gn + 16 * s + 128 * i + 4 * q);
                    y2[i][2 * q].x *= r2 * a.x; y2[i][2 * q].y *= r2 * a.y; y2[i][2 * q + 1].x *= r2 * a.z; y2[i][2 * q + 1].y *= r2 * a.w;
                    am = fmaxf(fmaxf(am, fmaxf(fabsf(y2[i][2 * q].x), fabsf(y2[i][2 * q].y))), fmaxf(fabsf(y2[i][2 * q + 1].x), fabsf(y2[i][2 * q + 1].y)));
                    pw[2 * q] = pk2(y2[i][2 * q].x, y2[i][2 * q].y); pw[2 * q + 1] = pk2(y2[i][2 * q + 1].x, y2[i][2 * q + 1].y); }
                if (wxn) { *(GAS v4u*)(xo + 128 * i) = (v4u){pw[0], pw[1], pw[2], pw[3]}; *(GAS v4u*)(xo + 128 * i + 8) = (v4u){pw[4], pw[5], pw[6], pw[7]}; } }
            if (wx8) {
            am = DPP_MAX(am, 0xB1, 0xf, 0xf); am = DPP_MAX(am, 0x4E, 0xf, 0xf); am = DPP_MAX(am, 0x141, 0xf, 0xf);
            const float qi = am > 0.f ? 127.f / am : 0.f;
            signed char* xq = (signed char*)(C.ws + (DRY ? WS_GLOG + 32 * MiB : WS_XN8)) + (size_t)(tokw + t) * 1024 + 16 * s;
#pragma unroll
            for (int i = 0; i < 8; ++i) { unsigned pq[4];
#pragma unroll
                for (int q = 0; q < 4; ++q) pq[q] = q8x4(y2[i][2 * q].x * qi, y2[i][2 * q].y * qi, y2[i][2 * q + 1].x * qi, y2[i][2 * q + 1].y * qi);
                *(GAS v4u*)(xq + 128 * i) = (v4u){pq[0], pq[1], pq[2], pq[3]}; }
            if (s == 0) *(GAS float*)((float*)(C.ws + (DRY ? WS_GLOG + 48 * MiB : WS_SX)) + tokw + t) = am * (1.f / 127.f);
            }
        }
    }
}
#ifndef MK_SWEEP
#define MK_SWEEP 2
#endif
template <bool DRY>
__device__ __forceinline__ void peer_topk_gather(const Ctx& C, int layer) {
    LAS int* lexp = (LAS int*)(C.lds + 16384);
    LAS float* lgate = (LAS float*)(C.lds + 16384 + 32768);
    LAS unsigned* sorted = (LAS unsigned*)(C.lds + 16384 + 65536);
    for (int tb = C.vcu; tb < NTOK / 64; tb += C.G) {
#pragma unroll 1
        for (int q = 0; q < 4; ++q) peer_topk_task(C, layer, tb * 64 + (C.wave & 3) * 16, (C.wave >> 2) * 4 + q, (C.wave & 3) * 16, lexp, lgate);
        __syncthreads();
#if MK_SWEEP == 2
        peer_rounds<DRY>(C, layer, tb * 64 + C.wave * 8, lexp + C.wave * 1024, lgate + C.wave * 1024, sorted + C.wave * 1024, (LAS unsigned*)(C.lds + C.wave * 2048));
#elif MK_SWEEP == 1
#error removed variant
        peer_sweep<DRY>(C, layer, tb * 64 + C.wave * 8, lexp + C.wave * 1024, lgate + C.wave * 1024, sorted + C.wave * 1024, (LAS unsigned*)(C.lds + C.wave * 1024));
#else
#pragma unroll 1
        for (int t = 0; t < 8; ++t) peer_gather_token<DRY>(C, layer, tb * 64 + C.wave * 8 + t, lexp + (C.wave * 8 + t) * 128, lgate + (C.wave * 8 + t) * 128);
#endif
        __syncthreads();
    }
}

#ifndef MK_SINGLE
#define MK_SINGLE 1
#endif
#ifndef MK_FASTGEMM
#define MK_FASTGEMM 1
#endif
constexpr int STEPS = 10, NPHASE = 1 + DEPTH * STEPS;
struct Args { const float* in[21]; float* out; unsigned char* ws; int ph_lo, ph_hi; };

template <int EPI>
__device__ __forceinline__ void do_gemm(const Ctx& C, const bf16* A, const bf16* Bt, int N, bf16* Ob, int ldc, int split, const float* rs_in, const float* base, float* outf, bf16* hg, const float* gain, float* rs_out) {
    pg8::Gemm g{A, Bt, NTOK, N, 1024}; pg8::StaticOrder S; S.init(NTOK, N, C.G, C.bx);
    if constexpr (EPI == 0) { pg8::EpiBf16R<false> E{Ob, ldc, split ? 1024 : 0, PSTRIDE, rs_in}; pg8::gemm_phase<pg8::EpiBf16R<false>, pg8::StaticOrder, true, true>(C.lds, g, S, E, C.tid); }
    else if constexpr (EPI == 2) { pg8::EpiBf16R<true> E{Ob, ldc, 0, PSTRIDE, rs_in}; pg8::gemm_phase<pg8::EpiBf16R<true>, pg8::StaticOrder, true, true>(C.lds, g, S, E, C.tid); }
    else if constexpr (EPI == 3) {
        pg8::Gemm g8{A, Bt, NTOK, N, 512}; pg8::EpiI8<false> E{Ob, PSTRIDE, rs_in, gain, nullptr, nullptr, 1.f}; pg8::gemm_phase<pg8::EpiI8<false>, pg8::StaticOrder, true, true>(C.lds, g8, S, E, C.tid); }
    else if constexpr (EPI == 4) {
        pg8::Gemm g8{A, Bt, NTOK, N, 512}; pg8::EpiI8<true> E{Ob, PSTRIDE, rs_in, gain, base, (const float*)outf, FOX_C2}; pg8::gemm_phase<pg8::EpiI8<true>, pg8::StaticOrder, true, true>(C.lds, g8, S, E, C.tid); }
    else {
        bf16* HB = (bf16*)(C.ws + WS_HB); (void)outf;
        if (base) { pg8::EpiResNorm<false> E{base, HB, hg, gain, rs_out}; pg8::gemm_phase<pg8::EpiResNorm<false>, pg8::StaticOrder, true, true>(C.lds, g, S, E, C.tid); }
        else { pg8::EpiResNorm<true> E{HB, HB, hg, gain, rs_out}; pg8::gemm_phase<pg8::EpiResNorm<true>, pg8::StaticOrder, true, true>(C.lds, g, S, E, C.tid); } }
}

template <int STEP, int MIXER>
__device__ __forceinline__ void run_step(const Ctx& C, int layer) {
    const int jx = layer / 3;
    bf16* XN = (bf16*)(C.ws + WS_XN); bf16* P = (bf16*)(C.ws + WS_P); bf16* OB = (bf16*)(C.ws + WS_OB); bf16* Q2 = (bf16*)(C.ws + WS_Q2);
    if constexpr (STEP == 0) {
        const bf16* Wt = MIXER == 0 ? (const bf16*)(C.ws + WS_FOXWIN + (size_t)jx * 8 * MiB) : MIXER == 1 ? (const bf16*)(C.ws + WS_GLAWIN) : (const bf16*)(C.ws + WS_HGRNWIN);
        const float* sw = (const float*)(C.ws + WS_SW) + (MIXER == 0 ? jx * 4096 : MIXER == 1 ? 8192 : 11264);
        if (FOXFUSE && MIXER == 0) { do_gemm<4>(C, (const bf16*)(C.ws + WS_XN8), Wt, 4096, P, 1024, 1, (const float*)(C.ws + WS_SX), C.in[5] + jx * 64, (float*)(C.in[6] + jx * 64), nullptr, sw, nullptr); fox_step1<false>(C, jx); }
        else if ((I8MASK >> layer) & 1) do_gemm<3>(C, (const bf16*)(C.ws + WS_XN8), Wt, MIXER == 1 ? 3072 : 4096, P, 1024, 1, (const float*)(C.ws + WS_SX), nullptr, nullptr, nullptr, sw, nullptr);
        else do_gemm<0>(C, XN, Wt, MIXER == 1 ? 3072 : 4096, P, 1024, 1, nullptr, nullptr, nullptr, nullptr, nullptr, nullptr);
    } else if constexpr (STEP == 1) {
        if constexpr (MIXER == 0) { if (!FOXFUSE) fox_step1<true>(C, jx); }
    } else if constexpr (STEP == 2) {
        if constexpr (MIXER == 1) chunk_prepass<4>(C); else if constexpr (MIXER == 2) chunk_prepass<8>(C);
    } else if constexpr (STEP == 3) {
        if constexpr (MIXER == 0) {
            float gq = 0.f, gk = 0.f;
            for (int i = 0; i < 64; ++i) { gq = fmaxf(gq, fabsf(C.in[5][jx * 64 + i])); gk = fmaxf(gk, fabsf(C.in[6][jx * 64 + i])); }
            const float smax = 64.f * gq * gk * 0.125f * 1.4426950408889634f;
            const attn_body::AttnTensors AT{(const attn_body::bf16*)P, (const attn_body::bf16*)(P + PSTRIDE), (const attn_body::bf16*)(P + 2 * PSTRIDE), (attn_body::bf16*)OB, (const attn_body::bf16*)(P + 3 * PSTRIDE), (const float*)(C.ws + WS_TAIL), -(56.f + 2.f * smax)};
            const attn_body::StaticOrder S(C.G, C.bx);
            attn_body::attn_phase<attn_body::StaticOrder>((char*)C.lds, AT, S, C.tid);
        }
        else if constexpr (MIXER == 1) chunk_recur<4, 256>(C, P + PSTRIDE);
        else chunk_recur<8, 128>(C, P + 2 * PSTRIDE);
    } else if constexpr (STEP == 4) {
        if constexpr (MIXER == 1) rec_norm_gate<256>(C, C.in[11], P + 2 * PSTRIDE);
        else if constexpr (MIXER == 2) rec_norm_gate<128>(C, C.in[15], P + 3 * PSTRIDE);
    } else if constexpr (STEP == 5) {
        const bf16* Wt = MIXER == 0 ? (const bf16*)(C.ws + WS_FOXWOUT) + (size_t)jx * 1024 * 1024 : MIXER == 1 ? (const bf16*)(C.ws + WS_GLAWOUT) : (const bf16*)(C.ws + WS_HGRNWOUT);
        do_gemm<1>(C, OB, Wt, 1024, nullptr, 0, 0, nullptr, layer == 0 ? C.in[0] : nullptr, nullptr, XN, C.in[2] + layer * 1024, (float*)(C.ws + WS_RS));
    } else if constexpr (STEP == 6) {
    } else if constexpr (STEP == 7) {
        do_gemm<2>(C, XN, (const bf16*)(C.ws + WS_PEERWQ) + (size_t)layer * 2048 * 1024, 2048, Q2, 2048, 0, (const float*)(C.ws + WS_RS), nullptr, nullptr, nullptr, nullptr, nullptr);
    } else if constexpr (STEP == 8) {
        peer_topk_gather<false>(C, layer);
    } else if constexpr (STEP == 9) {
    } else if constexpr (STEP == 11) {
        peer_topk_gather<true>(C, layer);
    } else if constexpr (STEP == 12) {
        p0_prologue_b(C);
    } else {
        p0_prologue(C);
    }
}

__device__ __forceinline__ void make_ctx(Ctx& C, const Args& args, unsigned char* lds_raw) {
    C.lds = (LAS unsigned char*)lds_raw;
    C.tid = threadIdx.x; C.lane = C.tid & 63; C.wave = __builtin_amdgcn_readfirstlane(C.tid >> 6);
    C.G = gridDim.x; C.bx = blockIdx.x; { const int bx = blockIdx.x; C.vcu = (C.G % 8 == 0) ? (bx % 8) * (C.G / 8) + bx / 8 : bx; }
    C.gw = C.vcu * NWAVES + C.wave; C.NGW = C.G * NWAVES;
#pragma unroll
    for (int i = 0; i < 21; ++i) C.in[i] = args.in[i];
    C.out = args.out; C.ws = args.ws;
}

template <int STEP, int MIXER>
__global__ void __launch_bounds__(NWAVES * 64, 2) mk_phase(Args args, int layer) {
    extern __shared__ __attribute__((aligned(16))) unsigned char lds_raw[];
    Ctx C; make_ctx(C, args, lds_raw);
    run_step<STEP, MIXER>(C, layer);
}

template <int STEP, int MIXER>
static void launch_phase(const Args& a, int layer, int grid, hipStream_t stream) {
    static bool attr_set = false;
    if (!attr_set) { (void)hipFuncSetAttribute((const void*)mk_phase<STEP, MIXER>, hipFuncAttributeMaxDynamicSharedMemorySize, LDS_BYTES); attr_set = true; }
    hipLaunchKernelGGL((mk_phase<STEP, MIXER>), dim3(grid), dim3(NWAVES * 64), LDS_BYTES, stream, a, layer);
}
#ifndef MK_DUP
#define MK_DUP -1
#endif
#define LP(S, M) do { launch_phase<S, M>(a, layer, grid, stream); if (MK_DUP == S) launch_phase<(S == 8 ? 11 : S), M>(a, layer, grid, stream); } while (0)
template <int MIXER>
static void launch_layer(const Args& a, int layer, int grid, hipStream_t stream) {
    LP(0, MIXER);
    if (MIXER == 0) launch_phase<1, MIXER>(a, layer, grid, stream); else LP(2, MIXER);
    LP(3, MIXER);
    if (MIXER != 0) LP(4, MIXER);
    LP(5, MIXER);
    LP(7, 0);
    LP(8, 0);
}
#if MK_SINGLE
__device__ __forceinline__ const float* tab_ptr(volatile LAS unsigned long long* tab, int i) {
    const unsigned long long v = tab[i];
    const unsigned lo = __builtin_amdgcn_readfirstlane((unsigned)v), hi = __builtin_amdgcn_readfirstlane((unsigned)(v >> 32));
    return (const float*)(const GAS float*)(((unsigned long long)hi << 32) | lo);
}
__device__ __forceinline__ int lane_id_volatile() { int x; asm volatile("v_mbcnt_lo_u32_b32 %0, -1, 0\n\tv_mbcnt_hi_u32_b32 %0, -1, %0" : "=v"(x)); return x; }
__device__ __forceinline__ void make_ctx_opaque(Ctx& C, unsigned char* lds_raw, int wave_s) {
    int bx = blockIdx.x, G = gridDim.x; unsigned ldso = 0u;
    asm volatile("" : "+s"(bx), "+s"(G), "+s"(ldso), "+s"(wave_s));
    int tid = wave_s * 64 + lane_id_volatile();
    C.lds = (LAS unsigned char*)lds_raw + ldso;
    volatile LAS unsigned long long* tab = (volatile LAS unsigned long long*)(C.lds + LDSCTL_OFF);
    C.tid = tid; C.lane = tid & 63; C.wave = __builtin_amdgcn_readfirstlane(tid >> 6);
    C.G = G; C.bx = bx; C.vcu = (G % 8 == 0) ? (bx % 8) * (G / 8) + bx / 8 : bx;
    C.gw = C.vcu * NWAVES + C.wave; C.NGW = G * NWAVES;
#pragma unroll
    for (int i = 0; i < 21; ++i) C.in[i] = tab_ptr(tab, i);
    C.out = (float*)tab_ptr(tab, 21); C.ws = (unsigned char*)tab_ptr(tab, 22);
}
__device__ __forceinline__ void grid_bar(unsigned char* lds_raw, int wave_s) {
    unsigned ldso = 0u; asm volatile("" : "+s"(ldso), "+s"(wave_s));
    LAS unsigned char* lds = (LAS unsigned char*)lds_raw + ldso;
    volatile LAS unsigned long long* tab = (volatile LAS unsigned long long*)(lds + LDSCTL_OFF);
    XcdBarrier b; b.bar = (unsigned*)((unsigned char*)tab_ptr(tab, 22) + WS_CTL) + CW_BAR; b.x = xb_xcc_id(); b.st = (volatile LAS unsigned*)(lds + MISC_OFF) + 8;
    xcd_barrier(b, wave_s == 0 && lane_id_volatile() == 0);
}
#define MK_STEP(...) do { Ctx C; make_ctx_opaque(C, lds_raw, wave_s); __VA_ARGS__; } while (0)
__global__ void __launch_bounds__(NWAVES * 64, 2) mk_fwd(Args args) {
    extern __shared__ __attribute__((aligned(16))) unsigned char lds_raw[];
    const int wave_s = __builtin_amdgcn_readfirstlane(threadIdx.x >> 6);
    for (int u = threadIdx.x; u < (LDS_BYTES - LDSCTL_OFF) / 4; u += NWAVES * 64) ((LAS unsigned*)((LAS unsigned char*)lds_raw + LDSCTL_OFF))[u] = 0u;
    __syncthreads();
    if (threadIdx.x == 0) {
        LAS unsigned long long* tab = (LAS unsigned long long*)((LAS unsigned char*)lds_raw + LDSCTL_OFF);
#pragma unroll
        for (int i = 0; i < 21; ++i) tab[i] = (unsigned long long)args.in[i];
        tab[21] = (unsigned long long)args.out; tab[22] = (unsigned long long)args.ws;
    }
    (void)xcd_barrier_post((unsigned*)(args.ws + WS_CTL) + CW_BAR, (volatile LAS unsigned*)((LAS unsigned char*)lds_raw + MISC_OFF) + 8);
    __syncthreads();
    MK_STEP(p0_prologue(C));
    if (I8_NITEMS) { grid_bar(lds_raw, wave_s); MK_STEP(p0_prologue_b(C)); }
    cg::this_grid().sync();
#pragma unroll 1
    for (int layer = 0; layer < DEPTH; ++layer) {
        const int mixer = layer % 3, jx = layer / 3;
        MK_STEP(const bf16* Wt = mixer == 0 ? (const bf16*)(C.ws + WS_FOXWIN + (size_t)jx * 8 * MiB) : mixer == 1 ? (const bf16*)(C.ws + WS_GLAWIN) : (const bf16*)(C.ws + WS_HGRNWIN);
                const float* sw = (const float*)(C.ws + WS_SW) + (mixer == 0 ? jx * 4096 : mixer == 1 ? 8192 : 11264);
                if (FOXFUSE && mixer == 0) { do_gemm<4>(C, (const bf16*)(C.ws + WS_XN8), Wt, 4096, (bf16*)(C.ws + WS_P), 1024, 1, (const float*)(C.ws + WS_SX), C.in[5] + jx * 64, (float*)(C.in[6] + jx * 64), nullptr, sw, nullptr);
                    fox_step1<false>(C, jx); }
                else if (I8MASK == 15 || (I8MASK != 0 && ((I8MASK >> layer) & 1))) do_gemm<3>(C, (const bf16*)(C.ws + WS_XN8), Wt, mixer == 1 ? 3072 : 4096, (bf16*)(C.ws + WS_P), 1024, 1, (const float*)(C.ws + WS_SX), nullptr, nullptr, nullptr, sw, nullptr);
                else do_gemm<0>(C, (const bf16*)(C.ws + WS_XN), Wt, mixer == 1 ? 3072 : 4096, (bf16*)(C.ws + WS_P), 1024, 1, nullptr, nullptr, nullptr, nullptr, nullptr, nullptr));
        grid_bar(lds_raw, wave_s);
        if (!(FOXFUSE && mixer == 0)) {
        MK_STEP(if (mixer == 0) run_step<1, 0>(C, layer); else if (mixer == 1) run_step<2, 1>(C, layer); else run_step<2, 2>(C, layer));
        grid_bar(lds_raw, wave_s); }
        MK_STEP(if (mixer == 0) run_step<3, 0>(C, layer); else if (mixer == 1) run_step<3, 1>(C, layer); else run_step<3, 2>(C, layer));
        grid_bar(lds_raw, wave_s);
#if RPROBE
        if (mixer != 0) { MK_STEP(if (mixer == 1) chunk_recur<4, 256, RPROBE>(C, (const bf16*)(C.ws + WS_P) + PSTRIDE); else chunk_recur<8, 128, RPROBE>(C, (const bf16*)(C.ws + WS_P) + 2 * PSTRIDE)); grid_bar(lds_raw, wave_s); }
#endif
        if (mixer != 0) { MK_STEP(if (mixer == 1) run_step<4, 1>(C, layer); else run_step<4, 2>(C, layer)); grid_bar(lds_raw, wave_s); }
        MK_STEP(const bf16* Wt = mixer == 0 ? (const bf16*)(C.ws + WS_FOXWOUT) + (size_t)jx * 1024 * 1024 : mixer == 1 ? (const bf16*)(C.ws + WS_GLAWOUT) : (const bf16*)(C.ws + WS_HGRNWOUT);
                do_gemm<1>(C, (const bf16*)(C.ws + WS_OB), Wt, 1024, nullptr, 0, 0, nullptr, layer == 0 ? C.in[0] : nullptr, nullptr, (bf16*)(C.ws + WS_XN), C.in[2] + layer * 1024, (float*)(C.ws + WS_RS)));
        grid_bar(lds_raw, wave_s);
        MK_STEP(run_step<7, 0>(C, layer));
        grid_bar(lds_raw, wave_s);
        MK_STEP(run_step<8, 0>(C, layer));
        if (layer + 1 < DEPTH) grid_bar(lds_raw, wave_s);
    }
}
#endif

extern "C" void kernel_launch(void* const* d_in, const int* in_sizes, int n_in, void* d_out, int out_size, void* d_ws, size_t ws_size, hipStream_t stream) {
    static int grid = 0;
    if (grid == 0) {
        if (n_in != 21 || out_size != NTOK * 1024 || ws_size < WS_END) { fprintf(stderr, "kernel_launch: unexpected shapes: n_in %d out %d ws %zu (need %zu)\n", n_in, out_size, ws_size, (size_t)WS_END); grid = -1; return; }
        int dev = 0, cus = 0, per_cu = 0;
        (void)hipGetDevice(&dev); (void)hipDeviceGetAttribute(&cus, hipDeviceAttributeMultiprocessorCount, dev);
#if MK_SINGLE
        if (hipFuncSetAttribute((const void*)mk_fwd, hipFuncAttributeMaxDynamicSharedMemorySize, LDS_BYTES) != hipSuccess) { fprintf(stderr, "kernel_launch: hipFuncSetAttribute failed\n"); grid = -1; return; }
        if (hipOccupancyMaxActiveBlocksPerMultiprocessor(&per_cu, (const void*)mk_fwd, NWAVES * 64, LDS_BYTES) != hipSuccess || per_cu < 1) { fprintf(stderr, "kernel_launch: occupancy query says %d blocks per CU\n", per_cu); (void)hipGetLastError(); grid = -1; return; }
#endif
        (void)per_cu;
        grid = cus;
    }
    if (grid < 0) return;
    Args a{};
    for (int i = 0; i < 21; ++i) a.in[i] = (const float*)d_in[i];
    a.out = (float*)d_out; a.ws = (unsigned char*)d_ws;
#if MK_SINGLE
    (void)hipMemsetAsync((char*)d_ws + WS_CTL, 0, CTL_ZERO_BYTES, stream);
    a.ph_lo = 0; a.ph_hi = NPHASE;
    void* kargs[] = {&a};
    hipError_t e = hipLaunchCooperativeKernel((const void*)mk_fwd, dim3(grid), dim3(NWAVES * 64), kargs, LDS_BYTES, stream);
    if (e != hipSuccess) fprintf(stderr, "cooperative launch failed: %s (grid %d)\n", hipGetErrorString(e), grid);
#else
    (void)hipMemsetAsync((char*)d_ws + WS_CTL, 0, CTL_ZERO_BYTES, stream);
    launch_phase<10, 0>(a, 0, grid, stream); if (MK_DUP == 10) launch_phase<10, 0>(a, 0, grid, stream);
    launch_phase<12, 0>(a, 0, grid, stream);
    launch_layer<0>(a, 0, grid, stream);
    launch_layer<1>(a, 1, grid, stream);
    launch_layer<2>(a, 2, grid, stream);
    launch_layer<0>(a, 3, grid, stream);
#endif
}
```

```cpp
#include <hip/hip_runtime.h>
#include <hip/hip_cooperative_groups.h>
#include <cstdio>
#include <cstdint>
#include <cmath>
namespace pg8 {
#define PG8_LAS __attribute__((address_space(3)))
typedef unsigned short bf16_t;
typedef short bf16x8 __attribute__((ext_vector_type(8)));
typedef float f32x4 __attribute__((ext_vector_type(4)));
typedef unsigned u32x4 __attribute__((ext_vector_type(4)));
typedef int i32x4 __attribute__((ext_vector_type(4)));
constexpr int BM = 256, BK = 64, HALF = 128, HTB = HALF * BK * 2  , STAGE_BYTES = 8 * HTB, NXCD = 8, WGM = 8;

__host__ __device__ __forceinline__ int lds_byte(int r, int c) { const int st = (r >> 4) * 2 + (c >> 5), rr = r & 15, cc = c & 31, ob = rr * 64 + cc * 2; return st * 1024 + (ob ^ (((ob >> 9) & 1) << 5)); }
__host__ __device__ __forceinline__ void stage_rc(int b, int& R, int& C) { const int st = b / 1024, sb = b % 1024, swz = sb ^ (((sb >> 9) & 1) << 5); R = (st >> 1) * 16 + swz / 64; C = (st & 1) * 32 + (swz % 64) / 2; }
__host__ __device__ __forceinline__ int perm32(int rho) { const int n = rho >> 4, i = rho & 15; return 8 * (i >> 2) + 4 * n + (i & 3); }

struct Unit { int pm, pn; };
struct Gemm { const bf16_t* A; const bf16_t* Bt; int M, N, K; };

struct StaticOrder {
    int nM, nN, nwg, G, c;
    __host__ __device__ void init(int M, int N, int G_, int c_) { nM = M / BM; nN = N / BM; nwg = nM * nN; G = G_; c = c_; }
    __host__ __device__ bool next(int i, Unit& u) const {
        const long L = (long)i * G + c; if (L >= nwg) return false;
        int wgid = (int)L; { const int q = nwg / NXCD, r = nwg % NXCD, xcd = wgid % NXCD, off = wgid / NXCD; wgid = (xcd < r ? xcd * (q + 1) : r * (q + 1) + (xcd - r) * q) + off; }
        const int nig = WGM * nN, gid = wgid / nig, fm = gid * WGM, gsz = (nM - fm) < WGM ? (nM - fm) : WGM;
        u.pm = fm + ((wgid % nig) % gsz); u.pn = (wgid % nig) / gsz; return true;
    }
    __device__ __forceinline__ void a_ready(const Unit&) const {}
    __device__ __forceinline__ void done(const Unit&) const {}
};

__device__ __forceinline__ unsigned cvt_pk_bf16(float lo, float hi) { unsigned r; asm volatile("v_cvt_pk_bf16_f32 %0, %1, %2" : "=v"(r) : "v"(lo), "v"(hi)); return r; }
typedef float f32x2 __attribute__((ext_vector_type(2)));
__device__ __forceinline__ f32x2 gelu_pk(f32x2 v) {
    const f32x2 av = __builtin_elementwise_abs(v), d = av * 0.2316418882f + 1.0f;
    f32x2 t; t.x = __builtin_amdgcn_rcpf(d.x); t.y = __builtin_amdgcn_rcpf(d.y);
    f32x2 q = t * 0.5307027145f + (-0.7265760135f); q = q * t + 0.7107068705f; q = q * t + (-0.142248368f); q = q * t + 0.127414796f; q = q * t;
    const f32x2 s = (v * v) * (-0.72134752044f);
    f32x2 e; e.x = __builtin_amdgcn_exp2f(s.x); e.y = __builtin_amdgcn_exp2f(s.y);
    const f32x2 m = v * (q * e), r = v - m;
    f32x2 o; o.x = v.x < 0.f ? m.x : r.x; o.y = v.y < 0.f ? m.y : r.y; return o;
}
#ifndef EPI_AUX
#define EPI_AUX 16
#endif
template <bool F16  > struct EpiBf16R {
    typedef f32x4 acc_t;
    static constexpr bool PERM = true, AFTER_DRAIN = false;
    bf16_t* O; int ldc; int split_cols; size_t split_stride; const float* rs;
    __device__ __forceinline__ void operator()(const f32x4 (&acc)[2][2][4][2], const Unit& u, int wr, int wc, int fr, int fq) const {
        const int row0 = u.pm * BM + wr * 64 + fr; int colt = u.pn * BM; unsigned boff = 0u;
        if (split_cols) { const int t = colt / split_cols; boff = (unsigned)(t * split_stride * 2); colt -= t * split_cols; }
        const int col0 = colt + wc * 32 + 8 * fq;
        const __amdgpu_buffer_rsrc_t orsrc = __builtin_amdgcn_make_buffer_rsrc((void*)O, (short)0, 0x7ffffff0, 0x00020000);
#pragma unroll
        for (int ai = 0; ai < 2; ++ai)
#pragma unroll
            for (int m = 0; m < 4; ++m) { const int row = row0 + ai * HALF + m * 16; const unsigned roff = boff + (unsigned)(row * ldc + col0) * 2u;
                float sc = 1.f;
                if (rs) { const f32x4 a = *(const f32x4*)(rs + (size_t)row * 16), b = *(const f32x4*)(rs + (size_t)row * 16 + 4), c = *(const f32x4*)(rs + (size_t)row * 16 + 8), d = *(const f32x4*)(rs + (size_t)row * 16 + 12);
                    const float s = (((a[0] + a[1]) + (a[2] + a[3])) + ((b[0] + b[1]) + (b[2] + b[3]))) + (((c[0] + c[1]) + (c[2] + c[3])) + ((d[0] + d[1]) + (d[2] + d[3])));
                    sc = __builtin_amdgcn_rsqf(s * (1.0f / 1024.0f) + 1e-6f); }
#pragma unroll
                for (int bj = 0; bj < 2; ++bj) { const f32x4 v0 = acc[ai][bj][m][0] * sc, v1 = acc[ai][bj][m][1] * sc;
                    u32x4 w;
                    if (F16) { w.x = __builtin_bit_cast(unsigned, __builtin_amdgcn_cvt_pkrtz(v0[0], v0[1])); w.y = __builtin_bit_cast(unsigned, __builtin_amdgcn_cvt_pkrtz(v0[2], v0[3])); w.z = __builtin_bit_cast(unsigned, __builtin_amdgcn_cvt_pkrtz(v1[0], v1[1])); w.w = __builtin_bit_cast(unsigned, __builtin_amdgcn_cvt_pkrtz(v1[2], v1[3])); }
                    else { w.x = cvt_pk_bf16(v0[0], v0[1]); w.y = cvt_pk_bf16(v0[2], v0[3]); w.z = cvt_pk_bf16(v1[0], v1[1]); w.w = cvt_pk_bf16(v1[2], v1[3]); }
                    __builtin_amdgcn_raw_buffer_store_b128(w, orsrc, (int)(roff + bj * HALF * 2), 0, EPI_AUX); } }
    }
};
template <bool QKN> struct EpiI8 {
    typedef i32x4 acc_t;
    static constexpr bool PERM = true, AFTER_DRAIN = false;
    bf16_t* O; size_t split_stride; const float* sx; const float* sw; const float* gq; const float* gk; float c2;
    __device__ __forceinline__ void operator()(const i32x4 (&acc)[2][2][4][2], const Unit& u, int wr, int wc, int fr, int fq) const {
        const int row0 = u.pm * BM + wr * 64 + fr; int colt = u.pn * BM; unsigned boff;
        { const int t = colt / 1024; boff = (unsigned)(t * split_stride * 2); colt -= t * 1024; }
        const __amdgpu_buffer_rsrc_t orsrc = __builtin_amdgcn_make_buffer_rsrc((void*)O, (short)0, 0x7ffffff0, 0x00020000);
        const int scol0 = u.pn * BM + wc * 32 + 8 * fq;
        f32x4 cw[2][2];
#pragma unroll
        for (int bj = 0; bj < 2; ++bj) { cw[bj][0] = *(const f32x4*)(sw + scol0 + bj * HALF); cw[bj][1] = *(const f32x4*)(sw + scol0 + bj * HALF + 4); }
        if (QKN && u.pn < 8) {
            const float* g = u.pn < 4 ? gq : gk; const float cc = u.pn < 4 ? c2 : 1.f; const int lane = fr + 16 * fq;
            f32x4 gv[2][2];
#pragma unroll
            for (int bj = 0; bj < 2; ++bj) { gv[bj][0] = *(const f32x4*)(g + 32 * bj + 8 * fq) * cc; gv[bj][1] = *(const f32x4*)(g + 32 * bj + 8 * fq + 4) * cc; }
            const int col0 = colt + 64 * wc + 8 * fq;
#pragma unroll
            for (int ai = 0; ai < 2; ++ai)
#pragma unroll
                for (int m = 0; m < 4; ++m) { const int row = row0 + ai * HALF + m * 16; const unsigned roff = boff + (unsigned)(row * 1024 + col0) * 2u; const float rs = sx[row];
                    f32x4 v[2][2]; float ss = 0.f;
#pragma unroll
                    for (int bj = 0; bj < 2; ++bj) { const i32x4 a0 = acc[ai][bj][m][0], a1 = acc[ai][bj][m][1];
                        v[bj][0] = (f32x4){(float)a0[0], (float)a0[1], (float)a0[2], (float)a0[3]} * cw[bj][0] * rs; v[bj][1] = (f32x4){(float)a1[0], (float)a1[1], (float)a1[2], (float)a1[3]} * cw[bj][1] * rs;
                        ss += ((v[bj][0][0] * v[bj][0][0] + v[bj][0][1] * v[bj][0][1]) + (v[bj][0][2] * v[bj][0][2] + v[bj][0][3] * v[bj][0][3])) + ((v[bj][1][0] * v[bj][1][0] + v[bj][1][1] * v[bj][1][1]) + (v[bj][1][2] * v[bj][1][2] + v[bj][1][3] * v[bj][1][3])); }
                    ss += __builtin_bit_cast(float, __builtin_amdgcn_ds_bpermute((lane ^ 16) << 2, __builtin_bit_cast(int, ss)));
                    ss += __builtin_bit_cast(float, __builtin_amdgcn_ds_bpermute((lane ^ 32) << 2, __builtin_bit_cast(int, ss)));
                    const float r = __builtin_amdgcn_rsqf(ss * (1.f / 64.f) + 1e-6f);
#pragma unroll
                    for (int bj = 0; bj < 2; ++bj) { const f32x4 o0 = v[bj][0] * r * gv[bj][0], o1 = v[bj][1] * r * gv[bj][1];
                        u32x4 w; w.x = cvt_pk_bf16(o0[0], o0[1]); w.y = cvt_pk_bf16(o0[2], o0[3]); w.z = cvt_pk_bf16(o1[0], o1[1]); w.w = cvt_pk_bf16(o1[2], o1[3]);
                        __builtin_amdgcn_raw_buffer_store_b128(w, orsrc, (int)(roff + bj * 32 * 2), 0, EPI_AUX); } }
            return;
        }
        const int col0 = colt + wc * 32 + 8 * fq;
#pragma unroll
        for (int ai = 0; ai < 2; ++ai)
#pragma unroll
            for (int m = 0; m < 4; ++m) { const int row = row0 + ai * HALF + m * 16; const unsigned roff = boff + (unsigned)(row * 1024 + col0) * 2u; const float rs = sx[row];
#pragma unroll
                for (int bj = 0; bj < 2; ++bj) { const i32x4 a0 = acc[ai][bj][m][0], a1 = acc[ai][bj][m][1];
                    const f32x4 v0 = (f32x4){(float)a0[0], (float)a0[1], (float)a0[2], (float)a0[3]} * cw[bj][0] * rs, v1 = (f32x4){(float)a1[0], (float)a1[1], (float)a1[2], (float)a1[3]} * cw[bj][1] * rs;
                    u32x4 w; w.x = cvt_pk_bf16(v0[0], v0[1]); w.y = cvt_pk_bf16(v0[2], v0[3]); w.z = cvt_pk_bf16(v1[0], v1[1]); w.w = cvt_pk_bf16(v1[2], v1[3]);
                    __builtin_amdgcn_raw_buffer_store_b128(w, orsrc, (int)(roff + bj * HALF * 2), 0, EPI_AUX); } }
    }
};
template <bool BASE16> struct EpiResNorm {
    typedef f32x4 acc_t;
    static constexpr bool PERM = true, AFTER_DRAIN = false;
    const void* base; bf16_t* out; bf16_t* hg; const float* gain; float* rs;
    __device__ __forceinline__ void operator()(const f32x4 (&acc)[2][2][4][2], const Unit& u, int wr, int wc, int fr, int fq) const {
        const int col0 = u.pn * BM + wc * 32 + 8 * fq, lane = fr + 16 * fq;
        f32x4 gv[2][2];
#pragma unroll
        for (int bj = 0; bj < 2; ++bj)
#pragma unroll
            for (int n = 0; n < 2; ++n) gv[bj][n] = *(const f32x4*)(gain + col0 + bj * HALF + n * 4);
#pragma unroll
        for (int ai = 0; ai < 2; ++ai)
#pragma unroll
            for (int m = 0; m < 4; ++m) { const int r = ai * HALF + wr * 64 + m * 16 + fr; const size_t off = (size_t)(u.pm * BM + r) * 1024 + col0;
                float ss = 0.f;
#pragma unroll
                for (int bj = 0; bj < 2; ++bj) { f32x4 b0, b1;
                    if (BASE16) { const u32x4 bw = *(const u32x4*)((const bf16_t*)base + off + bj * HALF);
                        b0 = (f32x4){__builtin_bit_cast(float, bw.x << 16), __builtin_bit_cast(float, bw.x & 0xffff0000u), __builtin_bit_cast(float, bw.y << 16), __builtin_bit_cast(float, bw.y & 0xffff0000u)};
                        b1 = (f32x4){__builtin_bit_cast(float, bw.z << 16), __builtin_bit_cast(float, bw.z & 0xffff0000u), __builtin_bit_cast(float, bw.w << 16), __builtin_bit_cast(float, bw.w & 0xffff0000u)}; }
                    else { b0 = *(const f32x4*)((const float*)base + off + bj * HALF); b1 = *(const f32x4*)((const float*)base + off + bj * HALF + 4); }
                    const f32x4 o0 = b0 + acc[ai][bj][m][0], o1 = b1 + acc[ai][bj][m][1];
                    u32x4 wo; wo.x = cvt_pk_bf16(o0[0], o0[1]); wo.y = cvt_pk_bf16(o0[2], o0[3]); wo.z = cvt_pk_bf16(o1[0], o1[1]); wo.w = cvt_pk_bf16(o1[2], o1[3]);
                    *(u32x4*)(out + off + bj * HALF) = wo;
                    ss += ((o0[0] * o0[0] + o0[1] * o0[1]) + (o0[2] * o0[2] + o0[3] * o0[3])) + ((o1[0] * o1[0] + o1[1] * o1[1]) + (o1[2] * o1[2] + o1[3] * o1[3]));
                    const f32x4 h0 = o0 * gv[bj][0], h1 = o1 * gv[bj][1];
                    u32x4 w; w.x = cvt_pk_bf16(h0[0], h0[1]); w.y = cvt_pk_bf16(h0[2], h0[3]); w.z = cvt_pk_bf16(h1[0], h1[1]); w.w = cvt_pk_bf16(h1[2], h1[3]);
                    *(u32x4*)(hg + off + bj * HALF) = w; }
                ss += __builtin_bit_cast(float, __builtin_amdgcn_ds_bpermute((lane ^ 16) << 2, __builtin_bit_cast(int, ss)));
                ss += __builtin_bit_cast(float, __builtin_amdgcn_ds_bpermute((lane ^ 32) << 2, __builtin_bit_cast(int, ss)));
                if (fq == 0) rs[(size_t)(u.pm * BM + r) * 16 + u.pn * 4 + wc] = ss; }
    }
};
__device__ __forceinline__ f32x4 mma16(bf16x8 a, bf16x8 b, f32x4 c) { return __builtin_amdgcn_mfma_f32_16x16x32_bf16(a, b, c, 0, 0, 0); }
__device__ __forceinline__ i32x4 mma16(bf16x8 a, bf16x8 b, i32x4 c) { return __builtin_amdgcn_mfma_i32_16x16x64_i8(__builtin_bit_cast(i32x4, a), __builtin_bit_cast(i32x4, b), c, 0, 0, 0); }
template <class Epi, class Sched, bool ALIGN_EPI = false, bool SP2 = false>
__device__ __forceinline__ void gemm_phase(PG8_LAS unsigned char* lds, const Gemm g, const Sched& S, const Epi& E, int tid_in) {
    int tid_ = tid_in; asm volatile("" : "+v"(tid_));
    const int tid = tid_, wid = __builtin_amdgcn_readfirstlane(tid >> 6), lane = tid & 63, wr = wid >> 2, wc = wid & 3, fr = lane & 15, fq = lane >> 4;
    const int K = g.K, nt = K / BK;
    unsigned voffA[2], voffB[2];
#pragma unroll
    for (int i = 0; i < 2; ++i) { int R, C; stage_rc(tid * 16 + i * 8192, R, C); const int Rb = Epi::PERM ? ((R & ~31) + perm32(R & 31)) : R;
        voffA[i] = (unsigned)(R * K + C) * 2u; voffB[i] = (unsigned)(Rb * K + C) * 2u; }
    const size_t kstep = (size_t)(BK * 2);
    const size_t hstep = (size_t)HALF * K * 2;
    const size_t tstep = 2 * hstep;
    const unsigned ldsw = (unsigned)wid * 1024u;
    const int aoff = lds_byte(wr * 64 + fr, fq * 8), boff = lds_byte(wc * 32 + fr, fq * 8);
#define PG8_SA(b, h) (((b) * 2 + (h)) * HTB)
#define PG8_SB(b, h) ((4 + (b) * 2 + (h)) * HTB)
#define PG8_STAGE(bufoff, gbase, voff) do { _Pragma("unroll") for (int _i = 0; _i < 2; ++_i) \
        __builtin_amdgcn_global_load_lds((const unsigned*)((const char*)(gbase) + (voff)[_i]), (PG8_LAS unsigned*)(lds + (bufoff) + ldsw + _i * 8192), 16, 0, 0); } while (0)
#define PG8_LDA(dst, b, h) do { _Pragma("unroll") for (int m = 0; m < 4; ++m) _Pragma("unroll") for (int k = 0; k < 2; ++k) dst[m][k] = *(const PG8_LAS bf16x8*)(lds + PG8_SA(b, h) + aoff + m * 2048 + k * 1024); } while (0)
#define PG8_LDB(dst, b, h) do { _Pragma("unroll") for (int n = 0; n < 2; ++n) _Pragma("unroll") for (int k = 0; k < 2; ++k) dst[n][k] = *(const PG8_LAS bf16x8*)(lds + PG8_SB(b, h) + boff + n * 2048 + k * 1024); } while (0)
#define PG8_MMA(ai, bj, At, Bt) do { __builtin_amdgcn_s_setprio(1); _Pragma("unroll") for (int m = 0; m < 4; ++m) _Pragma("unroll") for (int n = 0; n < 2; ++n) _Pragma("unroll") for (int k = 0; k < 2; ++k) \
        acc[ai][bj][m][n] = mma16(Bt[n][k], At[m][k], acc[ai][bj][m][n]); __builtin_amdgcn_s_setprio(0); } while (0)
#define PG8_WAIT_V(n) asm volatile("s_waitcnt vmcnt(" #n ")" ::: "memory")
#define PG8_WAIT_L(n) asm volatile("s_waitcnt lgkmcnt(" #n ")" ::: "memory")
#define PG8_BAR __builtin_amdgcn_s_barrier()
#define PG8_SCHED __builtin_amdgcn_sched_barrier(0)
    Unit cur, nxt; int ui = 0;
    if (!S.next(0, cur)) return;
    typedef typename Epi::acc_t acc_t;
    acc_t acc[2][2][4][2];
#pragma unroll
    for (int a = 0; a < 2; ++a)
#pragma unroll
        for (int b = 0; b < 2; ++b)
#pragma unroll
            for (int m = 0; m < 4; ++m)
#pragma unroll
                for (int n = 0; n < 2; ++n) acc[a][b][m][n] = (acc_t){0, 0, 0, 0};
    bf16x8 At[4][2], B0[2][2], B1[2][2];
    const char* cA = (const char*)g.A + (size_t)cur.pm * tstep; const char* cB = (const char*)g.Bt + (size_t)cur.pn * tstep;
    S.a_ready(cur);
    if constexpr (SP2) {
        PG8_STAGE(PG8_SB(0, 0), cB, voffB); PG8_STAGE(PG8_SB(0, 1), cB + hstep, voffB); PG8_STAGE(PG8_SA(0, 0), cA, voffA); PG8_STAGE(PG8_SA(0, 1), cA + hstep, voffA);
        if (wr == 1) PG8_BAR;
        PG8_WAIT_V(2); PG8_BAR;
        PG8_STAGE(PG8_SB(1, 0), cB + kstep, voffB); PG8_STAGE(PG8_SA(1, 0), cA + kstep, voffA); PG8_STAGE(PG8_SB(1, 1), cB + hstep + kstep, voffB);
        PG8_WAIT_V(6); PG8_BAR;
    } else {
        PG8_STAGE(PG8_SB(0, 0), cB, voffB); PG8_STAGE(PG8_SA(0, 0), cA, voffA); PG8_STAGE(PG8_SB(0, 1), cB + hstep, voffB); PG8_STAGE(PG8_SA(0, 1), cA + hstep, voffA);
        if (wr == 1) PG8_BAR;
        PG8_WAIT_V(4); PG8_BAR;
        PG8_STAGE(PG8_SB(1, 0), cB + kstep, voffB); PG8_STAGE(PG8_SA(1, 0), cA + kstep, voffA); PG8_STAGE(PG8_SB(1, 1), cB + hstep + kstep, voffB);
        PG8_WAIT_V(6); PG8_BAR;
    }
    for (;;) {
        const bool has_next = S.next(ui + 1, nxt);
        const char* nA = has_next ? (const char*)g.A + (size_t)nxt.pm * tstep : cA; const char* nB = has_next ? (const char*)g.Bt + (size_t)nxt.pn * tstep : cB;
        for (int t = 0; t < nt; t += 2) {
            const bool last = (t == nt - 2);
            const char* a1 = cA + (size_t)(t + 1) * kstep;
            const char* a2 = last ? nA : cA + (size_t)(t + 2) * kstep; const char* b2 = last ? nB : cB + (size_t)(t + 2) * kstep;
            const char* a3 = a2 + kstep; const char* b3 = b2 + kstep;
            if (last && has_next) S.a_ready(nxt);
            if constexpr (SP2) {
            PG8_LDB(B0, 0, 0); PG8_LDB(B1, 0, 1); PG8_SCHED; PG8_LDA(At, 0, 0); PG8_STAGE(PG8_SA(1, 1), a1 + hstep, voffA);
            PG8_WAIT_V(8); PG8_WAIT_L(0); PG8_BAR; PG8_MMA(0, 0, At, B0); PG8_MMA(0, 1, At, B1); PG8_BAR; PG8_SCHED;
            PG8_LDA(At, 0, 1); PG8_STAGE(PG8_SB(0, 0), b2, voffB); PG8_STAGE(PG8_SB(0, 1), b2 + hstep, voffB); PG8_STAGE(PG8_SA(0, 0), a2, voffA);
            PG8_WAIT_V(8); PG8_WAIT_L(0); PG8_BAR; PG8_MMA(1, 0, At, B0); PG8_MMA(1, 1, At, B1); PG8_BAR; PG8_SCHED;
            PG8_LDB(B0, 1, 0); PG8_LDB(B1, 1, 1); PG8_SCHED; PG8_LDA(At, 1, 0); PG8_STAGE(PG8_SA(0, 1), a2 + hstep, voffA);
            PG8_WAIT_V(8); PG8_WAIT_L(0); PG8_BAR; PG8_MMA(0, 0, At, B0); PG8_MMA(0, 1, At, B1); PG8_BAR; PG8_SCHED;
            PG8_LDA(At, 1, 1); PG8_STAGE(PG8_SB(1, 0), b3, voffB); PG8_STAGE(PG8_SB(1, 1), b3 + hstep, voffB); PG8_STAGE(PG8_SA(1, 0), a3, voffA);
            PG8_WAIT_V(8); PG8_WAIT_L(0); PG8_BAR; PG8_MMA(1, 0, At, B0); PG8_MMA(1, 1, At, B1); PG8_BAR; PG8_SCHED;
            } else {
            PG8_LDB(B0, 0, 0); PG8_SCHED; PG8_LDA(At, 0, 0); PG8_STAGE(PG8_SA(1, 1), a1 + hstep, voffA);
            PG8_WAIT_L(8); PG8_BAR; PG8_WAIT_L(0); PG8_MMA(0, 0, At, B0); PG8_BAR; PG8_SCHED;
            PG8_LDB(B1, 0, 1); PG8_STAGE(PG8_SB(0, 0), b2, voffB);
            PG8_BAR; PG8_WAIT_L(0); PG8_MMA(0, 1, At, B1); PG8_BAR;
            PG8_LDA(At, 0, 1); PG8_STAGE(PG8_SA(0, 0), a2, voffA);
            PG8_BAR; PG8_WAIT_L(0); PG8_MMA(1, 0, At, B0); PG8_BAR; PG8_SCHED;
            PG8_STAGE(PG8_SB(0, 1), b2 + hstep, voffB);
            PG8_WAIT_V(6); PG8_BAR; PG8_MMA(1, 1, At, B1); PG8_BAR;
            PG8_LDB(B0, 1, 0); PG8_SCHED; PG8_LDA(At, 1, 0); PG8_STAGE(PG8_SA(0, 1), a2 + hstep, voffA);
            PG8_WAIT_L(8); PG8_BAR; PG8_WAIT_L(0); PG8_MMA(0, 0, At, B0); PG8_BAR; PG8_SCHED;
            PG8_LDB(B1, 1, 1); PG8_STAGE(PG8_SB(1, 0), b3, voffB);
            PG8_BAR; PG8_WAIT_L(0); PG8_MMA(0, 1, At, B1); PG8_BAR;
            PG8_LDA(At, 1, 1); PG8_STAGE(PG8_SA(1, 0), a3, voffA);
            PG8_BAR; PG8_WAIT_L(0); PG8_MMA(1, 0, At, B0); PG8_BAR; PG8_SCHED;
            PG8_STAGE(PG8_SB(1, 1), b3 + hstep, voffB);
            PG8_WAIT_V(6); PG8_BAR; PG8_MMA(1, 1, At, B1); PG8_BAR;
            }
        }
        if constexpr (ALIGN_EPI) { if (wr == 0) PG8_BAR; }
        if constexpr (!Epi::AFTER_DRAIN) { E(acc, cur, wr, wc, fr, fq); S.done(cur); }
        if (!has_next) break;
#pragma unroll
        for (int a = 0; a < 2; ++a)
#pragma unroll
            for (int b = 0; b < 2; ++b)
#pragma unroll
                for (int m = 0; m < 4; ++m)
#pragma unroll
                    for (int n = 0; n < 2; ++n) acc[a][b][m][n] = (acc_t){0, 0, 0, 0};
        cur = nxt; cA = nA; cB = nB; ++ui;
        if constexpr (ALIGN_EPI) { if (wr == 1) PG8_BAR; }
    }
    PG8_WAIT_V(0);
    if constexpr (!ALIGN_EPI) { if (wr == 0) PG8_BAR; }
    PG8_BAR;
    if constexpr (Epi::AFTER_DRAIN) { E.fused(acc, cur, wr, wc, fr, fq, lds, wid, lane); S.done(cur); }
#undef PG8_SA
#undef PG8_SB
#undef PG8_STAGE
#undef PG8_LDA
#undef PG8_LDB
#undef PG8_MMA
#undef PG8_WAIT_V
#undef PG8_WAIT_L
#undef PG8_BAR
#undef PG8_SCHED
}
}
#include <hip/hip_bf16.h>
#include <cmath>
namespace attn_body {
using bf16=__hip_bfloat16;
using bf16x8=__attribute__((ext_vector_type(8)))short;
using s16x4=__attribute__((ext_vector_type(4)))short;
using f32x16=__attribute__((ext_vector_type(16)))float;
using u32x4=__attribute__((ext_vector_type(4)))unsigned;
constexpr int BATCH=8,NHEAD=16,SEQ=2048,D=64,DM=NHEAD*D;
constexpr int NW=8,QBLK=32,QB=QBLK*NW,KVBLK=64,NQB=SEQ/QB;
constexpr int ATTN_PITCH=DM, ATTN_UNIT_ROWS=QB;
__device__ __forceinline__ int crow(int r,int hi){return (r&3)+8*(r>>2)+4*hi;}
#define SBAR() __builtin_amdgcn_sched_barrier(0)
__device__ __forceinline__ void cmask(f32x16&p0,f32x16&p1,int jb,int qrel,int hi){
  const float NEG=-INFINITY; int kb=64*jb+4*hi;
  #pragma unroll
  for(int r=0;r<16;++r){int kv=kb+(r&3)+8*(r>>2); if(kv>qrel)p0[r]=NEG; if(kv+32>qrel)p1[r]=NEG;}
}

constexpr int NSLOT=3, SLOTB=8192;
constexpr int LDS_K=0, LDS_V=NSLOT*SLOTB, LDS_WS=2*NSLOT*SLOTB, LDS_OST=LDS_WS+NW*64*4, LDS_CS=LDS_OST+NW*4096, LDS_BYTES=LDS_CS+SEQ*4;
constexpr float C2=0.125f*1.4426950408889634f;
__device__ __forceinline__ void glds16(const void*gsrc,unsigned lds_dst){unsigned keep;
  asm volatile("s_mov_b32 %0, m0\n\ts_mov_b32 m0, %2\n\ts_nop 0\n\tglobal_load_lds_dwordx4 %1, off\n\ts_mov_b32 m0, %0":"=&s"(keep):"v"(gsrc),"s"(lds_dst):"memory");}
__device__ __forceinline__ float max3f(float a,float b,float c){float r;asm("v_max3_f32 %0, %1, %2, %3":"=v"(r):"v"(a),"v"(b),"v"(c));return r;}
__device__ __forceinline__ float max2f(float a,float b){float r;asm("v_max_f32_e32 %0, %1, %2":"=v"(r):"v"(a),"v"(b));return r;}
__device__ __forceinline__ float fadd_s(float a,float b){float r;asm("v_add_f32_e32 %0, %1, %2":"=v"(r):"v"(a),"v"(b));return r;}
__device__ __forceinline__ float fsub_s(float a,float b){float r;asm("v_sub_f32_e32 %0, %1, %2":"=v"(r):"v"(a),"v"(b));return r;}
typedef float f32x2_t __attribute__((ext_vector_type(2))); typedef __bf16 bf16x2_t __attribute__((ext_vector_type(2)));
__device__ __forceinline__ unsigned cvtpk_s(float lo,float hi){f32x2_t v={lo,hi};bf16x2_t b=__builtin_convertvector(v,bf16x2_t);return __builtin_bit_cast(unsigned,b);}
#define WAIT_BAR(N) asm volatile("s_waitcnt vmcnt(" #N ") lgkmcnt(0)\n\ts_barrier":::"memory")

typedef __attribute__((address_space(3))) const char* lds_cptr;
__device__ __forceinline__ void qkt(f32x16&p0,f32x16&p1,const char*Kslot,lds_cptr qls,bf16x8 ax0,bf16x8 ax1,bf16x8 qx,int r32,int hi){
  const char*kb=Kslot+hi*1024+r32*16; const f32x16 z16=f32x16{};
  p0=__builtin_amdgcn_mfma_f32_32x32x16_bf16(ax0,qx,z16,0,0,0);p1=__builtin_amdgcn_mfma_f32_32x32x16_bf16(ax1,qx,z16,0,0,0);
  #pragma unroll
  for(int d0=0;d0<4;++d0){
    const bf16x8 b0=*reinterpret_cast<const bf16x8*>(kb+d0*2048);
    const bf16x8 b1=*reinterpret_cast<const bf16x8*>(kb+d0*2048+512);
    const bf16x8 qd=*(const __attribute__((address_space(3))) bf16x8*)(qls+d0*1024);
    p0=__builtin_amdgcn_mfma_f32_32x32x16_bf16(b0,qd,p0,0,0,0);p1=__builtin_amdgcn_mfma_f32_32x32x16_bf16(b1,qd,p1,0,0,0);}
}
typedef short v4i16_t __attribute__((ext_vector_type(4)));
__device__ __forceinline__ void kload8(bf16x8*kf,lds_cptr kp){
  kf[0]=*(const __attribute__((address_space(3))) bf16x8*)(kp);      kf[1]=*(const __attribute__((address_space(3))) bf16x8*)(kp+512);
  kf[2]=*(const __attribute__((address_space(3))) bf16x8*)(kp+2048); kf[3]=*(const __attribute__((address_space(3))) bf16x8*)(kp+2560);
  kf[4]=*(const __attribute__((address_space(3))) bf16x8*)(kp+4096); kf[5]=*(const __attribute__((address_space(3))) bf16x8*)(kp+4608);
  kf[6]=*(const __attribute__((address_space(3))) bf16x8*)(kp+6144); kf[7]=*(const __attribute__((address_space(3))) bf16x8*)(kp+6656);
}
__device__ __forceinline__ void kload2(bf16x8*kf,lds_cptr kp,int j){ kf[2*j]=*(const __attribute__((address_space(3))) bf16x8*)(kp+j*2048); kf[2*j+1]=*(const __attribute__((address_space(3))) bf16x8*)(kp+j*2048+512); }
__device__ __forceinline__ s16x4 vtr(lds_cptr p){ return __builtin_bit_cast(s16x4,__builtin_amdgcn_ds_read_tr16_b64_v4i16((__attribute__((address_space(3))) v4i16_t*)p)); }
__device__ __forceinline__ float rowmax(const f32x16&p0,const f32x16&p1){
  float a=max3f(p0[0],p0[1],p1[0]),b=max3f(p0[2],p0[3],p1[1]);a=max3f(a,p1[2],p1[3]);
  #pragma unroll
  for(int r=4;r<16;r+=4){a=max3f(a,p0[r],p0[r+1]);b=max3f(b,p0[r+2],p0[r+3]);a=max3f(a,p1[r],p1[r+1]);b=max3f(b,p1[r+2],p1[r+3]);}
  const float m=max2f(a,b);
  auto rr=__builtin_amdgcn_permlane32_swap(__float_as_uint(m),__float_as_uint(m),false,false);
  return max2f(__uint_as_float(rr[0]),__uint_as_float(rr[1]));
}
__device__ __forceinline__ void pv(f32x16*o,int vb,bf16x8 pa0,bf16x8 pa1,bf16x8 pa2,bf16x8 pa3){
  #pragma unroll
  for(int d0=0;d0<2;++d0){s16x4 lo[4],hi[4];
    #pragma unroll
    for(int ks=0;ks<4;++ks){
      asm volatile("ds_read_b64_tr_b16 %0,%1 offset:%c2":"=&v"(lo[ks]):"v"(vb),"i"(d0*4096+ks*1024):"memory");
      asm volatile("ds_read_b64_tr_b16 %0,%1 offset:%c2":"=&v"(hi[ks]):"v"(vb),"i"(d0*4096+ks*1024+512):"memory");}
    asm volatile("s_waitcnt lgkmcnt(0)":::"memory");SBAR();
    #define PK(k) (bf16x8){lo[k][0],lo[k][1],lo[k][2],lo[k][3],hi[k][0],hi[k][1],hi[k][2],hi[k][3]}
    o[d0]=__builtin_amdgcn_mfma_f32_32x32x16_bf16(pa0,PK(0),o[d0],0,0,0);
    o[d0]=__builtin_amdgcn_mfma_f32_32x32x16_bf16(pa1,PK(1),o[d0],0,0,0);
    o[d0]=__builtin_amdgcn_mfma_f32_32x32x16_bf16(pa2,PK(2),o[d0],0,0,0);
    o[d0]=__builtin_amdgcn_mfma_f32_32x32x16_bf16(pa3,PK(3),o[d0],0,0,0);
    #undef PK
  }
}

__device__ __forceinline__ void split3(float c,unsigned&hb,unsigned&mb,unsigned&lb){
  hb=__float_as_uint(c)&0xffff0000u; const float r1=c-__uint_as_float(hb); mb=__float_as_uint(r1)&0xffff0000u; const float r2=r1-__uint_as_float(mb); lb=__float_as_uint(r2)&0xffff0000u; }
__device__ __forceinline__ bf16x8 make_ax(float negc){ unsigned hb,mb,lb; split3(negc,hb,mb,lb);
  u32x4 w; w.x=(hb>>16)|mb; w.y=(lb>>16)|0x3f800000u; w.z=0x3f803f80u; w.w=0u; return __builtin_bit_cast(bf16x8,w); }
__device__ __forceinline__ bf16x8 make_qx(float negm,unsigned hm){ unsigned hb,mb,lb; split3(negm,hb,mb,lb);
  u32x4 w; w.x=0x3f803f80u&hm; w.y=(0x3f80u|hb)&hm; w.z=((mb>>16)|lb)&hm; w.w=0u; return __builtin_bit_cast(bf16x8,w); }
#ifndef ATTN_STORE16
#define ATTN_STORE16(p,v) (*(u32x4*)(p)=(v))
#endif
template<int THRL> __device__ __forceinline__ void attn_unit(int b,int h,int qb,const bf16*Q,const bf16*__restrict__ K,const bf16*__restrict__ V,bf16*O,const bf16*__restrict__ Gt,char*shm,const int tid_u,const float skip_thr){
  int tid=tid_u; asm volatile("":"+v"(tid));
  const int lane=tid&63,r32=lane&31,hi=lane>>5; const int wid=__builtin_amdgcn_readfirstlane(tid>>6);
  const long rowbase=(long)b*SEQ; const int q0=qb*QB;
  const bf16*Qw=Q+(rowbase+q0+wid*QBLK)*DM+h*D;
  float*csp=(float*)(shm+LDS_CS);
  int tskip=0;
  { const float cq0=csp[q0]; const int ntall=(q0+QB)/KVBLK; while(tskip+2<=ntall-4 && csp[KVBLK*(tskip+1)+KVBLK-1]-cq0<skip_thr)tskip+=2; tskip=__builtin_amdgcn_readfirstlane(tskip); }
  const bf16*Kh=K+(rowbase+(long)tskip*KVBLK)*DM+h*D,*Vh=V+(rowbase+(long)tskip*KVBLK)*DM+h*D;
  const unsigned lds0=(unsigned)(uintptr_t)shm;
  float*wsf=(float*)(shm+LDS_WS)+wid*64;
  const unsigned koff=(unsigned)(lane*DM+wid*8), voff=(unsigned)((16*(wid&3)+(lane>>2))*DM+(wid>>2)*32+(lane&3)*8);
  const unsigned kdst=lds0+LDS_K+wid*1024, vdst=lds0+LDS_V+wid*1024;
  #define DMA_K(t,slot) do{unsigned o_=koff;asm volatile("":"+v"(o_));glds16(Kh+(long)(t)*KVBLK*DM+o_,(unsigned)__builtin_amdgcn_readfirstlane(kdst+(slot)));}while(0)
  #define DMA_V(t,slot) do{unsigned o_=voff;asm volatile("":"+v"(o_));glds16(Vh+(long)(t)*KVBLK*DM+o_,(unsigned)__builtin_amdgcn_readfirstlane(vdst+(slot)));}while(0)
  const int vb0=(int)(lds0+LDS_V)+((lane>>4)&1)*32+(lane&3)*8+(4*hi+((lane&15)>>2))*64;
  const char*Kbase=shm+LDS_K; bf16x8 kf[8];
  const lds_cptr shm3=(lds_cptr)shm; const lds_cptr kp0=shm3+LDS_K+hi*1024+r32*16; const lds_cptr vp0=shm3+LDS_V+((lane>>4)&1)*32+(lane&3)*8+(4*hi+((lane&15)>>2))*64;
  const int NT=(q0+QB)/KVBLK-tskip;
  const float*cst=csp+tskip*KVBLK;
  const unsigned hm=hi?0u:0xffffffffu;
  DMA_K(0,0);DMA_V(0,0);DMA_K(1,SLOTB);
  const lds_cptr qls=shm3+LDS_OST+wid*4096+hi*512+r32*16;
  { bf16x8 qr[4];
    #pragma unroll
    for(int d0=0;d0<4;++d0)qr[d0]=*reinterpret_cast<const bf16x8*>(&Qw[(long)r32*DM+d0*16+hi*8]);
    #pragma unroll
    for(int d0=0;d0<4;++d0)*(__attribute__((address_space(3))) bf16x8*)(shm3+LDS_OST+wid*4096+hi*512+r32*16+d0*1024)=qr[d0]; }
  #define QLD(k) (*(const __attribute__((address_space(3))) bf16x8*)(qls+(k)*1024))
  float mhat=csp[q0+wid*QBLK+r32],l_reg=0.f;f32x16 o[2];o[0]=f32x16{};o[1]=f32x16{}; bf16x8 qx=make_qx(-mhat,hm);
  const int qrel=wid*QBLK+r32;
  #define CMASK(P0,P1,t) do{int jb_=(t)-(NT-4); if(jb_>=0)cmask(P0,P1,jb_,qrel,hi);}while(0)
  bool resc=false;
  #define START(P0,P1) do{ const float rm=rowmax(P0,P1); resc=false; \
    if(__any(rm>(float)THRL)){ const float dl=__builtin_fmaxf(rm,0.f); mhat=fadd_s(mhat,dl); \
      _Pragma("unroll") for(int r=0;r<16;++r){P0[r]=fsub_s(P0[r],dl);P1[r]=fsub_s(P1[r],dl);} \
      qx=make_qx(-mhat,hm); } \
    _Pragma("unroll") for(int r=0;r<16;++r)P0[r]=__builtin_amdgcn_exp2f(P0[r]); }while(0)
  #define RESC() do{ if(resc){ asm volatile("s_waitcnt lgkmcnt(0)":::"memory"); \
      _Pragma("unroll") for(int d_=0;d_<2;++d_) _Pragma("unroll") for(int r=0;r<16;++r)o[d_][r]*=wsf[crow(r,hi)]; } }while(0)
  f32x16 pA0,pA1,pB0,pB1;
  int sl_prev=0,sl_cur=0,sl_next=SLOTB;
  #define ROT() do{sl_prev=sl_cur;sl_cur=sl_next;sl_next=(sl_next==(NSLOT-1)*SLOTB)?0:sl_next+SLOTB;}while(0)
  DMA_K(2,2*SLOTB);
  WAIT_BAR(3);
  qkt(pA0,pA1,Kbase,qls,make_ax(cst[r32]),make_ax(cst[32+r32]),qx,r32,hi);asm volatile("s_nop 15\n\ts_nop 7":"+v"(pA0),"+v"(pA1));CMASK(pA0,pA1,0);
  START(pA0,pA1);
  _Pragma("unroll") for(int r=0;r<16;++r)pA1[r]=__builtin_amdgcn_exp2f(pA1[r]);
  WAIT_BAR(0);
  DMA_K(3,0);DMA_V(1,SLOTB);
  ROT();
  kload8(kf,kp0+sl_cur);
  WAIT_BAR(2);
  s16x4 vlo[8],vhi[8]; u32x4 pw0,pw1,pw2,pw3;
  #define PKW(P,B) cvtpk_s(P[B],P[B+1])
  #define PAF(k) __builtin_bit_cast(bf16x8,pw##k)
  #define VFR(i) (bf16x8){vlo[i][0],vlo[i][1],vlo[i][2],vlo[i][3],vhi[i][0],vhi[i][1],vhi[i][2],vhi[i][3]}
  #define PIN(x) asm volatile("":"+v"(x))
  #define MX3(a,b,c) __builtin_fmaxf(__builtin_fmaxf((a),(b)),(c))
  #define GAPA(MF,A0,A1,A2,A3,W0,W1,PW) do{ MF; sacc+=A0; sacc+=A1; sacc+=A2; sacc+=A3; PIN(sacc); W0; W1; PIN(PW); SBAR(); }while(0)
  #define EX(v) __builtin_amdgcn_exp2f(v)
  #define GAPB(MF,X,B) do{ MF; X[B]=EX(X[B]); X[B+1]=EX(X[B+1]); X[B+2]=EX(X[B+2]); X[B+3]=EX(X[B+3]); PIN(X); SBAR(); }while(0)
  #define VRD(i) do{ vlo[i]=vtr(vp_+(((i)>>2)*4096+((i)&3)*1024)); vhi[i]=vtr(vp_+(((i)>>2)*4096+((i)&3)*1024+512)); }while(0)
  #define KRD(G,j) do{ if(G){ kload2(kf,kp0+sl_next,j); SBAR(); } }while(0)
  #define STEP(C0,C1,P0,P1,t,GK,GV,GL) do{ SBAR(); \
    const lds_cptr vp_=vp0+sl_prev; \
    const bf16x8 ax0_=make_ax(cst[(t)*KVBLK+r32]), ax1_=make_ax(cst[(t)*KVBLK+32+r32]); \
    C0=__builtin_amdgcn_mfma_f32_32x32x16_bf16(ax0_,qx,f32x16{},0,0,0); C1=__builtin_amdgcn_mfma_f32_32x32x16_bf16(ax1_,qx,f32x16{},0,0,0); SBAR(); \
    bf16x8 q0_=QLD(0), q1_=QLD(1); \
    VRD(0); SBAR(); float sacc=(P0[0]+P0[1]); \
    GAPA(C0=__builtin_amdgcn_mfma_f32_32x32x16_bf16(kf[0],q0_,C0,0,0,0), P0[2],P0[3],P0[4],P0[5],     pw0[0]=PKW(P0,0), pw0[1]=PKW(P0,2), pw0); \
    VRD(4); SBAR(); GAPA(C1=__builtin_amdgcn_mfma_f32_32x32x16_bf16(kf[1],q0_,C1,0,0,0), P0[6],P0[7],P0[8],P0[9],     pw0[2]=PKW(P0,4), pw0[3]=PKW(P0,6), pw0); q0_=QLD(2); \
    VRD(1); SBAR(); GAPA(C0=__builtin_amdgcn_mfma_f32_32x32x16_bf16(kf[2],q1_,C0,0,0,0),   P0[10],P0[11],P0[12],P0[13], pw1[0]=PKW(P0,8), pw1[1]=PKW(P0,10), pw1); \
    VRD(5); SBAR(); GAPA(C1=__builtin_amdgcn_mfma_f32_32x32x16_bf16(kf[3],q1_,C1,0,0,0),   P0[14],P0[15],P1[0],P1[1],   pw1[2]=PKW(P0,12),pw1[3]=PKW(P0,14), pw1); q1_=QLD(3); \
    VRD(2); SBAR(); GAPA(C0=__builtin_amdgcn_mfma_f32_32x32x16_bf16(kf[4],q0_,C0,0,0,0),   P1[2],P1[3],P1[4],P1[5],     pw2[0]=PKW(P1,0), pw2[1]=PKW(P1,2), pw2); \
    VRD(6); SBAR(); GAPA(C1=__builtin_amdgcn_mfma_f32_32x32x16_bf16(kf[5],q0_,C1,0,0,0),   P1[6],P1[7],P1[8],P1[9],     pw2[2]=PKW(P1,4), pw2[3]=PKW(P1,6), pw2); \
    VRD(3); SBAR(); GAPA(C0=__builtin_amdgcn_mfma_f32_32x32x16_bf16(kf[6],q1_,C0,0,0,0),   P1[10],P1[11],P1[12],P1[13], pw3[0]=PKW(P1,8), pw3[1]=PKW(P1,10), pw3); \
    VRD(7); SBAR(); GAPA(C1=__builtin_amdgcn_mfma_f32_32x32x16_bf16(kf[7],q1_,C1,0,0,0),   P1[14],P1[15],0.f,0.f,       pw3[2]=PKW(P1,12),pw3[3]=PKW(P1,14), pw3); \
    l_reg+=sacc; \
    if(GK){DMA_K((t)+3,sl_cur);} if(GV){DMA_V((t)+1,sl_next);} \
    CMASK(C0,C1,t); \
    { float a=MX3(C0[0],C0[1],C1[0]),b=MX3(C0[2],C0[3],C1[1]); a=MX3(a,C1[2],C1[3]); \
      _Pragma("unroll") for(int r=4;r<16;r+=4){a=MX3(a,C0[r],C0[r+1]);b=MX3(b,C0[r+2],C0[r+3]);a=MX3(a,C1[r],C1[r+1]);b=MX3(b,C1[r+2],C1[r+3]);} \
      float rm=__builtin_fmaxf(a,b); { auto rr=__builtin_amdgcn_permlane32_swap(__float_as_uint(rm),__float_as_uint(rm),false,false); rm=__builtin_fmaxf(__uint_as_float(rr[0]),__uint_as_float(rr[1])); } \
      resc=false; \
      if(__builtin_expect(__any(rm>(float)THRL),0)){ const float dl=__builtin_fmaxf(rm,0.f); mhat+=dl; \
        _Pragma("unroll") for(int r=0;r<16;++r){C0[r]-=dl;C1[r]-=dl;} \
        qx=make_qx(-mhat,hm); \
        const float f=__builtin_amdgcn_exp2f(-dl); l_reg*=f; if(hi==0)wsf[r32]=f; resc=true; } } \
    SBAR(); \
    GAPB(o[0]=__builtin_amdgcn_mfma_f32_32x32x16_bf16(PAF(0),VFR(0),o[0],0,0,0), C0,0); \
    GAPB(o[1]=__builtin_amdgcn_mfma_f32_32x32x16_bf16(PAF(0),VFR(4),o[1],0,0,0), C0,4); \
    KRD(GL,0); GAPB(o[0]=__builtin_amdgcn_mfma_f32_32x32x16_bf16(PAF(1),VFR(1),o[0],0,0,0), C0,8); \
    KRD(GL,1); GAPB(o[1]=__builtin_amdgcn_mfma_f32_32x32x16_bf16(PAF(1),VFR(5),o[1],0,0,0), C0,12); \
    KRD(GL,2); GAPB(o[0]=__builtin_amdgcn_mfma_f32_32x32x16_bf16(PAF(2),VFR(2),o[0],0,0,0), C1,0); \
    KRD(GL,3); GAPB(o[1]=__builtin_amdgcn_mfma_f32_32x32x16_bf16(PAF(2),VFR(6),o[1],0,0,0), C1,4); \
    GAPB(o[0]=__builtin_amdgcn_mfma_f32_32x32x16_bf16(PAF(3),VFR(3),o[0],0,0,0), C1,8); \
    GAPB(o[1]=__builtin_amdgcn_mfma_f32_32x32x16_bf16(PAF(3),VFR(7),o[1],0,0,0), C1,12); \
    }while(0)
  int t=1;
  #undef CMASK
  #define CMASK(P0,P1,t) do{}while(0)
  for(;t+5<NT;t+=2){
    STEP(pB0,pB1,pA0,pA1,t,true,true,true);     WAIT_BAR(2); RESC(); ROT();
    STEP(pA0,pA1,pB0,pB1,t+1,true,true,true);   WAIT_BAR(2); RESC(); ROT();
  }
  #undef CMASK
  #define CMASK(P0,P1,t) do{int jb_=(t)-(NT-4); if(jb_>=0)cmask(P0,P1,jb_,qrel,hi);}while(0)
  #define ENDW(tt) do{ if((tt)+3<NT){WAIT_BAR(2);} else if((tt)+2<NT){WAIT_BAR(1);} else {WAIT_BAR(0);} }while(0)
  for(;t+1<NT;t+=2){
    STEP(pB0,pB1,pA0,pA1,t,(t+3<NT),(t+1<NT),(t+1<NT));       ENDW(t);   RESC(); ROT();
    STEP(pA0,pA1,pB0,pB1,t+1,(t+4<NT),(t+2<NT),(t+2<NT));     ENDW(t+1); RESC(); ROT();
  }
  STEP(pB0,pB1,pA0,pA1,NT-1,false,false,false); RESC();
  { float sacc=pB0[0]+pB0[1]; _Pragma("unroll") for(int r=2;r<16;++r)sacc+=pB0[r]; _Pragma("unroll") for(int r=0;r<16;++r)sacc+=pB1[r]; l_reg+=sacc;
    pw0=(u32x4){PKW(pB0,0),PKW(pB0,2),PKW(pB0,4),PKW(pB0,6)};pw1=(u32x4){PKW(pB0,8),PKW(pB0,10),PKW(pB0,12),PKW(pB0,14)};pw2=(u32x4){PKW(pB1,0),PKW(pB1,2),PKW(pB1,4),PKW(pB1,6)};pw3=(u32x4){PKW(pB1,8),PKW(pB1,10),PKW(pB1,12),PKW(pB1,14)};
    SBAR(); pv(o,vb0+sl_cur,PAF(0),PAF(1),PAF(2),PAF(3)); }
  #undef PKW
  #undef PAF
  #undef VFR
  #undef PIN
  #undef MX3
  #undef GAPA
  #undef GAPB
  #undef EX
  #undef VRD
  #undef KRD
  #undef STEP
  #undef ENDW
  {auto rr=__builtin_amdgcn_permlane32_swap(__float_as_uint(l_reg),__float_as_uint(l_reg),false,false);l_reg=__uint_as_float(rr[0])+__uint_as_float(rr[1]);}
  { int te=tid; asm volatile("":"+v"(te));
    const int lane_e=te&63,r32e=lane_e&31,hie=lane_e>>5;
    if(hie==0)wsf[32+r32e]=l_reg;asm volatile("s_waitcnt lgkmcnt(0)":::"memory");
    float rli[16];
    #pragma unroll
    for(int r=0;r<16;++r)rli[r]=__builtin_amdgcn_rcpf(wsf[32+crow(r,hie)]);
    bf16*Ow=O+(rowbase+q0+wid*QBLK)*DM+h*D; const bf16*Gw=Gt+(rowbase+q0+wid*QBLK)*DM+h*D;
    bf16*stg=(bf16*)(shm+LDS_OST)+wid*2048;
    #pragma unroll
    for(int r=0;r<16;++r){const int orow=crow(r,hie);
      #pragma unroll
      for(int d0=0;d0<2;++d0)stg[orow*64+d0*32+r32e]=__float2bfloat16(o[d0][r]*rli[r]);}
    asm volatile("s_waitcnt lgkmcnt(0)":::"memory");
    #pragma unroll
    for(int i=0;i<4;++i){const int row=i*8+(lane_e>>3),ch=lane_e&7; u32x4 v=*(const u32x4*)(stg+row*64+ch*8); const u32x4 gv=*(const u32x4*)(Gw+(long)row*DM+ch*8);
      #pragma unroll
      for(int e=0;e<4;++e){ const float g0=__uint_as_float(gv[e]<<16),g1=__uint_as_float(gv[e]&0xffff0000u),x0=__uint_as_float(v[e]<<16),x1=__uint_as_float(v[e]&0xffff0000u);
        v[e]=cvtpk_s(x0*__builtin_amdgcn_rcpf(1.f+__expf(-g0)),x1*__builtin_amdgcn_rcpf(1.f+__expf(-g1))); }
      ATTN_STORE16(Ow+(long)row*DM+ch*8,v);} }
  asm volatile("s_waitcnt lgkmcnt(0)\n\ts_barrier":::"memory");
  #undef DMA_K
  #undef QLD
  #undef DMA_V
  #undef CMASK
  #undef START
  #undef RESC
  #undef ROT
}
constexpr int ATTN_LDS_BYTES=LDS_BYTES;
struct AttnTensors { const bf16* Q; const bf16* K; const bf16* V; bf16* O; const bf16* G; const float* CUM; float THR; };
struct AttnUnit { int bh; int qb; };
struct StaticOrder {
  int vcu;
  __device__ __forceinline__ explicit StaticOrder(int grid,int block):vcu((block%8)*(grid/8)+block/8){}
  __device__ __forceinline__ bool next(int i,AttnUnit&u)const{ if(i>=4)return false; const int s=2*(vcu&1)+(i>>1); u.bh=vcu>>1; u.qb=(i&1)?7-s:s; return true; }
  __device__ __forceinline__ void a_ready(const AttnUnit&)const{}
  __device__ __forceinline__ void done(const AttnUnit&)const{}
};
template<class Sched,int THRL=8> __device__ __forceinline__ void attn_phase(char*lds,const AttnTensors&T,const Sched&S,int tid_in){
  AttnUnit u; int tid_=tid_in; asm volatile("":"+v"(tid_));
  if(S.next(0,u)){ float*csp=(float*)(lds+LDS_CS); float*wt=(float*)(lds+LDS_WS); int tp=tid_in; asm volatile("":"+v"(tp));
    const float*lf=T.CUM+((long)(u.bh/NHEAD)*SEQ+4*tp)*NHEAD+u.bh%NHEAD;
    const float a0=lf[0],a1=a0+lf[NHEAD],a2=a1+lf[2*NHEAD],a3=a2+lf[3*NHEAD];
    float sc=a3; const int ln=tp&63;
    #pragma unroll
    for(int o=1;o<64;o<<=1){ const float up=__builtin_bit_cast(float,__builtin_amdgcn_ds_bpermute((ln-o)<<2,__builtin_bit_cast(int,sc))); if(ln>=o)sc+=up; }
    if(ln==63)wt[tp>>6]=sc;
    __syncthreads();
    float base=sc-a3;
    #pragma unroll
    for(int w=0;w<NW-1;++w)if(w<(tp>>6))base+=wt[w];
    const float k2=-1.4426950408889634f;
    csp[4*tp]=k2*(base+a0);csp[4*tp+1]=k2*(base+a1);csp[4*tp+2]=k2*(base+a2);csp[4*tp+3]=k2*(base+a3);
    __syncthreads(); }
  for(int i=0;S.next(i,u);++i){ S.a_ready(u); attn_unit<THRL>(u.bh/NHEAD,u.bh%NHEAD,u.qb,T.Q,T.K,T.V,T.O,T.G,lds,tid_,T.THR); S.done(u); }
}
#undef SBAR
#undef WAIT_BAR
}
#define GAS __attribute__((address_space(1)))
#define LAS __attribute__((address_space(3)))
typedef unsigned short bf16;
typedef unsigned v4u __attribute__((ext_vector_type(4)));
typedef float f32x4 __attribute__((ext_vector_type(4)));
typedef short bf16x8 __attribute__((ext_vector_type(8)));
typedef GAS unsigned gu32;
typedef GAS unsigned long long gu64;
#define RLX_AGENT __ATOMIC_RELAXED, __HIP_MEMORY_SCOPE_AGENT
#define LDS_WAIT() asm volatile("s_waitcnt lgkmcnt(0)" ::: "memory")
#define VM_WAIT() asm volatile("s_waitcnt vmcnt(0)" ::: "memory")
__device__ __forceinline__ unsigned long long rt() { return __builtin_amdgcn_s_memrealtime(); }
__device__ __forceinline__ unsigned f2bf(float f) { unsigned u = __builtin_bit_cast(unsigned, f); return (u + 0x7fffu + ((u >> 16) & 1u)) >> 16; }
__device__ __forceinline__ unsigned pk2(float lo, float hi) { return f2bf(lo) | (f2bf(hi) << 16); }
__device__ __forceinline__ unsigned pk2h(float lo, float hi) { unsigned r; asm("v_cvt_pk_bf16_f32 %0, %1, %2" : "=v"(r) : "v"(lo), "v"(hi)); return r; }
__device__ __forceinline__ unsigned f2bfh(float f) { return pk2h(f, 0.f) & 0xffffu; }

#define XB_TMO      128
#define XB_XCNT(j)  (256  + 64 * (j))
#define XB_XSUB(j)  (1280 + 64 * (j))
#define XB_XGEN(j)  (2304 + 64 * (j))
#define XB_TOP      3328
#define XB_TOPGEN   3392
#define XCD_BAR_WORDS 3456
#define XB_SPIN_CAP (1u << 27)

__device__ __forceinline__ unsigned xb_ld(unsigned* p)              { return __hip_atomic_load(p, __ATOMIC_RELAXED, __HIP_MEMORY_SCOPE_AGENT); }
__device__ __forceinline__ unsigned xb_add(unsigned* p, unsigned v) { return __hip_atomic_fetch_add(p, v, __ATOMIC_RELAXED, __HIP_MEMORY_SCOPE_AGENT); }
__device__ __forceinline__ unsigned xb_xcc_id() { return (unsigned)__builtin_amdgcn_s_getreg((3 << 11) | 20) & 0xFu; }
#define XB_SPIN(cond, bar) do { unsigned _sp = 0; while (cond) { __builtin_amdgcn_s_sleep(1); \
    if ((++_sp & 255u) == 0u) { if (xb_ld(&(bar)[XB_TMO])) break; if (_sp > XB_SPIN_CAP) { atomicAdd(&(bar)[XB_TMO], 1u); break; } } } } while (0)

struct XcdBarrier {
    unsigned* bar; unsigned x;
    volatile LAS unsigned* st;
};

__device__ __forceinline__ XcdBarrier xcd_barrier_post(unsigned* bar, volatile LAS unsigned* st) {
    XcdBarrier b; b.bar = bar; b.x = xb_xcc_id(); b.st = st;
    if (threadIdx.x == 0) (void)xb_add(&bar[XB_XCNT(b.x)], 1u);
    return b;
}
__device__ __forceinline__ void xcd_barrier_complete(unsigned* bar, unsigned x, unsigned& nloc, unsigned& nx) {
    const unsigned G = gridDim.x * gridDim.y * gridDim.z;
    unsigned sum, cnt, mine, sp = 0u;
    for (;;) {
        sum = 0u; cnt = 0u; mine = 0u;
#pragma unroll
        for (unsigned j = 0; j < 16; ++j) { const unsigned c = xb_ld(&bar[XB_XCNT(j)]); sum += c; cnt += (c > 0u) ? 1u : 0u; mine = (j == x) ? c : mine; }
        if (sum == G) break;
        __builtin_amdgcn_s_sleep(1);
        if ((++sp & 255u) == 0u) { if (xb_ld(&bar[XB_TMO])) break; if (sp > XB_SPIN_CAP) { atomicAdd(&bar[XB_TMO], 1u); break; } }
    }
    nloc = mine > 0u ? mine : 1u; nx = cnt > 0u ? cnt : 1u;
}

__device__ __forceinline__ void xcd_barrier(const XcdBarrier& b, const bool leader  ) {
    asm volatile("s_waitcnt vmcnt(0)" ::: "memory");
    __syncthreads();
    if (leader) {
        unsigned* bar = b.bar;
        __builtin_amdgcn_s_waitcnt(0);
        unsigned nloc = b.st[0], nx = b.st[1];
        if (nloc == 0u) { xcd_barrier_complete(bar, b.x, nloc, nx); b.st[0] = nloc; b.st[1] = nx; }
        const unsigned old = xb_add(&bar[XB_XSUB(b.x)], 1u);
        const unsigned gen = old / nloc;
        if (old + 1u == (gen + 1u) * nloc) {
            __builtin_amdgcn_fence(__ATOMIC_RELEASE, "agent");
            asm volatile("s_waitcnt vmcnt(0)" ::: "memory");
            const unsigned og = xb_add(&bar[XB_TOP], 1u);
            const unsigned tg = og / nx;
            if (og + 1u == (tg + 1u) * nx) xb_add(&bar[XB_TOPGEN], 1u);
            else XB_SPIN(xb_ld(&bar[XB_TOPGEN]) == tg, bar);
            __builtin_amdgcn_fence(__ATOMIC_ACQUIRE, "agent");
            xb_add(&bar[XB_XGEN(b.x)], 1u);
            asm volatile("s_waitcnt vmcnt(0)" ::: "memory");
        } else {
            XB_SPIN(xb_ld(&bar[XB_XGEN(b.x)]) == gen, bar);
            __builtin_amdgcn_fence(__ATOMIC_ACQUIRE, "agent");
            asm volatile("s_waitcnt vmcnt(0)" ::: "memory");
        }
    }
    __syncthreads();
}
#ifndef MK_FASTATTN
#define MK_FASTATTN 1
#endif
#ifndef MK_FASTREC
#define MK_FASTREC 1
#endif
namespace cg = cooperative_groups;
constexpr int NTOK = 16384, DMODEL = 1024, NBATCH = 8, SEQLEN = 2048, DEPTH = 4;
constexpr int FOX_IN = 4112, GLA_IN = 3088, HGRN_IN = 4096;
constexpr float RMS_EPS = 1e-6f;
constexpr float LOG2E = 1.4426950408889634f;
constexpr float FOX_C2 = 0.125f * LOG2E;
constexpr int NWAVES = 8;

constexpr size_t MiB = 1u << 20;
constexpr size_t WS_CTL = 0, CTL_ZERO_BYTES = 1 * MiB;
constexpr size_t WS_FOXWIN = 2 * MiB, WS_FOXWOUT = 18 * MiB, WS_GLAWIN = 22 * MiB, WS_GLAWOUT = 28 * MiB, WS_HGRNWIN = 30 * MiB, WS_HGRNWOUT = 38 * MiB;
constexpr size_t WS_PEERWQ = 40 * MiB, WS_KEYS = 56 * MiB, WS_LB = 58 * MiB;
#define FOXFUSE ((I8MASK & 9) == 9)
#ifndef RPROBE
#define RPROBE 0
#endif
#ifndef BGQ
#define BGQ 1
#endif
#ifndef I8MASK
#define I8MASK 13
#endif
constexpr size_t WS_SW = 58 * MiB + 65536, WS_SX = 58 * MiB + 262144, WS_XN8 = 724 * MiB;
constexpr size_t WS_TAILW = 63 * MiB;
constexpr size_t WS_RS = 62 * MiB;
constexpr size_t WS_U = 64 * MiB, WS_V = 128 * MiB, WS_SU = 60 * MiB, WS_SV = 61 * MiB;
constexpr size_t WS_XN = 320 * MiB, WS_P = 352 * MiB, WS_OB = 480 * MiB, WS_Q2 = 512 * MiB, WS_TAIL = 576 * MiB, WS_CUM = 577 * MiB;
constexpr size_t WS_EXP = 580 * MiB, WS_GATE = 588 * MiB, WS_OF = 596 * MiB, WS_GLOG = 660 * MiB, WS_HB = 740 * MiB, WS_END = 772 * MiB;
constexpr size_t PSTRIDE = (size_t)NTOK * 1024;
constexpr int CW_BAR = 4096;

constexpr int RING_BYTES = 131072;
constexpr int LDSCTL_OFF = 162816, MISC_OFF = LDSCTL_OFF + 320;
constexpr int LDS_BYTES = 163840;

typedef unsigned u32x4v __attribute__((ext_vector_type(4)));
struct Ctx {
    LAS unsigned char* lds; int tid, lane, wave, vcu, G, gw, NGW, bx;
    const float* in[21]; float* out; unsigned char* ws;
};

__device__ __forceinline__ float bf2f(unsigned short b) { return __uint_as_float(((unsigned)b) << 16); }
__device__ __forceinline__ float bflo(unsigned w) { return __uint_as_float(w << 16); }
__device__ __forceinline__ float bfhi(unsigned w) { return __uint_as_float(w & 0xffff0000u); }
#define DPP_ADD(v, ctrl, rm, bm) (v + __builtin_bit_cast(float, __builtin_amdgcn_update_dpp(0, __builtin_bit_cast(int, v), ctrl, rm, bm, false)))
#define DPP_MAX(v, ctrl, rm, bm) fmaxf(v, __builtin_bit_cast(float, __builtin_amdgcn_update_dpp(__builtin_bit_cast(int, v), __builtin_bit_cast(int, v), ctrl, rm, bm, false)))
#define DPP_SUM31(v) do { v = DPP_ADD(v, 0x111, 0xf, 0xf); v = DPP_ADD(v, 0x112, 0xf, 0xf); v = DPP_ADD(v, 0x114, 0xf, 0xe); v = DPP_ADD(v, 0x118, 0xf, 0xc); v = DPP_ADD(v, 0x142, 0xa, 0xf); } while (0)
#define DPP_SUM63(v) do { DPP_SUM31(v); v = DPP_ADD(v, 0x143, 0xc, 0xf); } while (0)
__device__ __forceinline__ float rdlane(float v, int lane) { return __builtin_bit_cast(float, __builtin_amdgcn_readlane(__builtin_bit_cast(int, v), lane)); }
__device__ __forceinline__ float wave_sum(float v) { DPP_SUM63(v); return rdlane(v, 63); }
__device__ __forceinline__ float wave_max(float v) {
    v = DPP_MAX(v, 0x111, 0xf, 0xf); v = DPP_MAX(v, 0x112, 0xf, 0xf); v = DPP_MAX(v, 0x114, 0xf, 0xe); v = DPP_MAX(v, 0x118, 0xf, 0xc); v = DPP_MAX(v, 0x142, 0xa, 0xf); v = DPP_MAX(v, 0x143, 0xc, 0xf);
    return rdlane(v, 63);
}
typedef __bf16 bf16x2_t __attribute__((ext_vector_type(2)));
__device__ __forceinline__ float dot2bf(unsigned w, unsigned x, float acc) { return __builtin_amdgcn_fdot2_f32_bf16(__builtin_bit_cast(bf16x2_t, w), __builtin_bit_cast(bf16x2_t, x), acc, false); }
__device__ __forceinline__ float bperm(float v, int src_lane) { return __builtin_bit_cast(float, __builtin_amdgcn_ds_bpermute(src_lane << 2, __builtin_bit_cast(int, v))); }
__device__ __forceinline__ float log_sigmoid_f(float x) { return fminf(x, 0.f) - log1pf(__expf(-fabsf(x))); }
__device__ __forceinline__ float sigmoid_f(float x) { return 1.f / (1.f + __expf(-x)); }

__device__ __forceinline__ void p0_transpose_item(const float* W, int ldw, int K, int Nuse, bf16* WT, LAS float* scr, int item, int lane) {
    const int nblk = Nuse / 32, kb = item / nblk, nb = item % nblk, k0 = 64 * kb, n0 = 32 * nb;
#pragma unroll
    for (int i = 0; i < 8; ++i) { const int kk = 8 * i + (lane >> 3); const f32x4 v = *(const GAS f32x4*)(W + (size_t)(k0 + kk) * ldw + n0 + 4 * (lane & 7));
        LAS float* d = scr + kk * 33 + 4 * (lane & 7); d[0] = v.x; d[1] = v.y; d[2] = v.z; d[3] = v.w; }
    LDS_WAIT(); asm volatile("" ::: "memory");
    const int c = lane & 7;
#pragma unroll
    for (int j = 0; j < 4; ++j) { const int n = (lane >> 3) + 8 * j; const LAS float* s = scr + (8 * c) * 33 + n;
        v4u o; o.x = pk2(s[0 * 33], s[1 * 33]); o.y = pk2(s[2 * 33], s[3 * 33]); o.z = pk2(s[4 * 33], s[5 * 33]); o.w = pk2(s[6 * 33], s[7 * 33]);
        *(GAS v4u*)(WT + (size_t)(n0 + n) * K + k0 + 8 * c) = o; }
    LDS_WAIT(); asm volatile("" ::: "memory");
}
__device__ __forceinline__ unsigned q8x4(float a, float b, float c, float d) {
    return ((unsigned)(int)__builtin_rintf(a) & 0xffu) | (((unsigned)(int)__builtin_rintf(b) & 0xffu) << 8) | (((unsigned)(int)__builtin_rintf(c) & 0xffu) << 16) | ((unsigned)(int)__builtin_rintf(d) << 24);
}
__device__ __forceinline__ void p0_colmax_item(const float* W, int ldw, unsigned* cmax, int item, int lane) {
    const int nb = item >> 3, n0 = 32 * nb, k0 = 128 * (item & 7);
    f32x4 v[16];
#pragma unroll
    for (int i = 0; i < 16; ++i) v[i] = *(const GAS f32x4*)(W + (size_t)(k0 + 8 * i + (lane >> 3)) * ldw + n0 + 4 * (lane & 7));
    __builtin_amdgcn_sched_barrier(0);
    float mx[4] = {0.f, 0.f, 0.f, 0.f};
#pragma unroll
    for (int i = 0; i < 16; ++i) { mx[0] = fmaxf(mx[0], fabsf(v[i].x)); mx[1] = fmaxf(mx[1], fabsf(v[i].y)); mx[2] = fmaxf(mx[2], fabsf(v[i].z)); mx[3] = fmaxf(mx[3], fabsf(v[i].w)); }
#pragma unroll
    for (int j = 0; j < 4; ++j) { mx[j] = fmaxf(mx[j], bperm(mx[j], lane ^ 8)); mx[j] = fmaxf(mx[j], bperm(mx[j], lane ^ 16)); mx[j] = fmaxf(mx[j], bperm(mx[j], lane ^ 32)); }
    if (lane < 8) {
#pragma unroll
        for (int j = 0; j < 4; ++j) (void)__hip_atomic_fetch_max(cmax + n0 + 4 * lane + j, __float_as_uint(mx[j]), __ATOMIC_RELAXED, __HIP_MEMORY_SCOPE_AGENT);
    }
}
__device__ __forceinline__ void p0_quant_item(const float* W, int ldw, const unsigned* cmax, signed char* W8, float* sw, LAS float* scr, int item, int lane, bool headperm) {
    const int nb = item >> 3, n0 = 32 * nb, k0 = 128 * (item & 7);
    const int n0s = (headperm && nb < 64) ? (nb >> 3) * 256 + 64 * (nb & 3) + 32 * ((nb >> 2) & 1) : n0;
    f32x4 v[2][8];
#pragma unroll
    for (int h = 0; h < 2; ++h)
#pragma unroll
        for (int i = 0; i < 8; ++i) v[h][i] = *(const GAS f32x4*)(W + (size_t)(k0 + 64 * h + 8 * i + (lane >> 3)) * ldw + n0s + 4 * (lane & 7));
    float ci[4];
#pragma unroll
    for (int j = 0; j < 4; ++j) { const float m = __uint_as_float(*(const GAS unsigned*)(cmax + n0s + (lane >> 3) + 8 * j)); ci[j] = m > 0.f ? 127.f / m : 0.f; }
    if ((item & 7) == 0 && lane < 32) *(GAS float*)(sw + n0 + lane) = __uint_as_float(*(const GAS unsigned*)(cmax + n0s + lane)) * (1.f / 127.f);
    __builtin_amdgcn_sched_barrier(0);
    const int c = lane & 7;
#pragma unroll
    for (int h = 0; h < 2; ++h) {
        LDS_WAIT(); asm volatile("" ::: "memory");
#pragma unroll
        for (int i = 0; i < 8; ++i) { LAS float* d = scr + (8 * i + (lane >> 3)) * 33 + 4 * (lane & 7); d[0] = v[h][i].x; d[1] = v[h][i].y; d[2] = v[h][i].z; d[3] = v[h][i].w; }
        LDS_WAIT(); asm volatile("" ::: "memory");
#pragma unroll
        for (int j = 0; j < 4; ++j) { const int n = (lane >> 3) + 8 * j; const LAS float* sp = scr + (8 * c) * 33 + n;
            const unsigned lo = q8x4(sp[0] * ci[j], sp[33] * ci[j], sp[66] * ci[j], sp[99] * ci[j]), hi = q8x4(sp[132] * ci[j], sp[165] * ci[j], sp[198] * ci[j], sp[231] * ci[j]);
            *(GAS unsigned long long*)(W8 + (size_t)(n0 + n) * 1024 + k0 + 64 * h + 8 * c) = (unsigned long long)lo | ((unsigned long long)hi << 32); }
    }
    LDS_WAIT(); asm volatile("" ::: "memory");
}
__device__ __forceinline__ void rms_row_to_bf16(int lane, f32x4 (&v)[4], const float* gain, bf16* orow, signed char* orow8, float* sx) {
    const GAS f32x4* gr = (const GAS f32x4*)gain + lane;
    float s = 0.f;
#pragma unroll
    for (int j = 0; j < 4; ++j) s += (v[j].x * v[j].x + v[j].y * v[j].y) + (v[j].z * v[j].z + v[j].w * v[j].w);
    const float r = rsqrtf(wave_sum(s) * (1.f / 1024.f) + RMS_EPS);
    GAS unsigned long long* o8 = (GAS unsigned long long*)orow + lane; float am = 0.f;
#pragma unroll
    for (int j = 0; j < 4; ++j) { const f32x4 g = gr[64 * j]; v[j].x *= r * g.x; v[j].y *= r * g.y; v[j].z *= r * g.z; v[j].w *= r * g.w;
        am = fmaxf(fmaxf(am, fmaxf(fabsf(v[j].x), fabsf(v[j].y))), fmaxf(fabsf(v[j].z), fabsf(v[j].w)));
        o8[64 * j] = (unsigned long long)pk2(v[j].x, v[j].y) | ((unsigned long long)pk2(v[j].z, v[j].w) << 32); }
    am = wave_max(am); const float qi = am > 0.f ? 127.f / am : 0.f;
    GAS unsigned* q8 = (GAS unsigned*)orow8 + lane;
#pragma unroll
    for (int j = 0; j < 4; ++j) q8[64 * j] = q8x4(v[j].x * qi, v[j].y * qi, v[j].z * qi, v[j].w * qi);
    if (lane == 0) *(GAS float*)sx = am * (1.f / 127.f);
}
__device__ __forceinline__ void cvt_f32_bf16(const Ctx& C, const float* src, bf16* dst, size_t n) {
    const size_t nth = (size_t)C.G * 512, t0 = (size_t)C.vcu * 512 + C.tid;
    for (size_t i = t0; i < n / 8; i += nth) {
        const f32x4 a = ((const GAS f32x4*)src)[2 * i], b = ((const GAS f32x4*)src)[2 * i + 1];
        v4u o; o.x = pk2(a.x, a.y); o.y = pk2(a.z, a.w); o.z = pk2(b.x, b.y); o.w = pk2(b.z, b.w);
        ((GAS v4u*)dst)[i] = o;
    }
}
__device__ __forceinline__ void quant_row_fp8(int lane, const f32x4 (&v)[4], unsigned char* drow, unsigned char* sc) {
    float am = 0.f;
#pragma unroll
    for (int i = 0; i < 4; ++i) am = fmaxf(am, fmaxf(fmaxf(fabsf(v[i].x), fabsf(v[i].y)), fmaxf(fabsf(v[i].z), fabsf(v[i].w))));
    am = wave_max(am);
    const unsigned sbits = __float_as_uint(am * (1.f / 448.f));
    unsigned e = (sbits >> 23) + ((sbits & 0x7fffffu) ? 1u : 0u); e = am > 0.f ? (e < 1u ? 1u : e > 254u ? 254u : e) : 127u;
    const float inv = __uint_as_float((254u - e) << 23);
    GAS unsigned* o = (GAS unsigned*)drow + lane;
#pragma unroll
    for (int i = 0; i < 4; ++i) {
        const float a = fminf(fmaxf(v[i].x * inv, -448.f), 448.f), b = fminf(fmaxf(v[i].y * inv, -448.f), 448.f), c = fminf(fmaxf(v[i].z * inv, -448.f), 448.f), d = fminf(fmaxf(v[i].w * inv, -448.f), 448.f);
        int w = 0; w = __builtin_amdgcn_cvt_pk_fp8_f32(a, b, w, false); w = __builtin_amdgcn_cvt_pk_fp8_f32(c, d, w, true); o[64 * i] = (unsigned)w;
    }
    if (lane == 0) *(GAS unsigned char*)sc = (unsigned char)e;
}
__device__ __forceinline__ void quant_rows_fp8(const Ctx& C, const float* src, unsigned char* dst, unsigned char* scales, int nrows) {
    int rw = C.gw;
    for (; rw + 3 * C.NGW < nrows; rw += 4 * C.NGW) {
        f32x4 v[4][4];
#pragma unroll
        for (int j = 0; j < 4; ++j) { const GAS f32x4* xr = (const GAS f32x4*)(src + (size_t)(rw + j * C.NGW) * 1024) + C.lane;
#pragma unroll
            for (int i = 0; i < 4; ++i) v[j][i] = xr[64 * i]; }
        __builtin_amdgcn_sched_barrier(0);
#pragma unroll
        for (int j = 0; j < 4; ++j) quant_row_fp8(C.lane, v[j], dst + (size_t)(rw + j * C.NGW) * 1024, scales + rw + j * C.NGW);
    }
    for (; rw < nrows; rw += C.NGW) {
        const GAS f32x4* xr = (const GAS f32x4*)(src + (size_t)rw * 1024) + C.lane;
        f32x4 v[4];
#pragma unroll
        for (int i = 0; i < 4; ++i) v[i] = xr[64 * i];
        quant_row_fp8(C.lane, v, dst + (size_t)rw * 1024, scales + rw);
    }
}
constexpr int BGQ_ROWS = 3 * 16384;
template <int JOB> __device__ __forceinline__ void bgq_row(const Ctx& C, int idx, const float*& src, unsigned char*& dst, unsigned char*& sc) {
    const int seg = idx >> 14, row = idx & 16383;
    const bool isV = seg == 1 || (seg == 2 && JOB == 2);
    const size_t flat = (size_t)(seg < 2 ? JOB : 3) * 16384 + row;
    src = (isV ? C.in[20] : C.in[19]) + flat * 1024; dst = C.ws + (isV ? WS_V : WS_U) + flat * 1024; sc = C.ws + (isV ? WS_SV : WS_SU) + flat;
}
template <int JOB> __device__ __forceinline__ void bgq_step(const Ctx& C, int idx_prev, int idx, f32x4 (&v)[4]) {
    const float* src; unsigned char* dst; unsigned char* sc;
    if (idx_prev >= 0 && idx_prev < BGQ_ROWS) { bgq_row<JOB>(C, idx_prev, src, dst, sc); quant_row_fp8(C.lane, v, dst, sc); }
    if (idx < BGQ_ROWS) { bgq_row<JOB>(C, idx, src, dst, sc); const GAS f32x4* xr = (const GAS f32x4*)src + C.lane;
#pragma unroll
        for (int i = 0; i < 4; ++i) v[i] = xr[64 * i]; }
}
#ifndef PRO_PROBE
#define PRO_PROBE 0
#endif
constexpr int CW_CMAX = 131072;
constexpr int I8_NF0 = (I8MASK & 1) ? 1024 : 0, I8_NF3 = (I8MASK & 8) ? 1024 : 0, I8_NG = (I8MASK & 2) ? 768 : 0, I8_NH = (I8MASK & 4) ? 1024 : 0, I8_NITEMS = I8_NF0 + I8_NF3 + I8_NG + I8_NH;
template <bool PASS2> __device__ __forceinline__ void p0_i8_items(const Ctx& C, LAS float* scr) {
    unsigned* CM = (unsigned*)(C.ws + WS_CTL) + CW_CMAX; float* SW = (float*)(C.ws + WS_SW);
    for (int it = C.gw; it < I8_NITEMS; it += C.NGW) {
        int r = it; const float* W; int ldw; signed char* W8; int q;
        if (r < I8_NF0) { W = C.in[3]; ldw = FOX_IN; W8 = (signed char*)(C.ws + WS_FOXWIN); q = 0; }
        else if ((r -= I8_NF0) < I8_NF3) { W = C.in[3] + (size_t)1024 * FOX_IN; ldw = FOX_IN; W8 = (signed char*)(C.ws + WS_FOXWIN + 8 * MiB); q = 1; }
        else if ((r -= I8_NF3) < I8_NG) { W = C.in[8]; ldw = GLA_IN; W8 = (signed char*)(C.ws + WS_GLAWIN); q = 2; }
        else { r -= I8_NG; W = C.in[13]; ldw = HGRN_IN; W8 = (signed char*)(C.ws + WS_HGRNWIN); q = 3; }
        const int swo = q == 0 ? 0 : q == 1 ? 4096 : q == 2 ? 8192 : 11264;
        if (PASS2) p0_quant_item(W, ldw, CM + q * 4096, W8, SW + swo, scr, r, C.lane, FOXFUSE && q < 2); else p0_colmax_item(W, ldw, CM + q * 4096, r, C.lane);
    }
}
__device__ __forceinline__ void p0_prologue_b(const Ctx& C) { p0_i8_items<true>(C, (LAS float*)(C.lds + C.wave * 16384)); }
__device__ __forceinline__ void p0_prologue(const Ctx& C) {
    LAS float* scr = (LAS float*)(C.lds + C.wave * 16384);
    for (int rep_ = 0; rep_ < (PRO_PROBE == 1 ? 2 : 1); ++rep_) {
    p0_i8_items<false>(C, scr);
    constexpr int I_SQ = 16 * 32, N_F0 = (I8MASK & 1) ? 0 : 16 * 128, N_F3 = (I8MASK & 8) ? 0 : 16 * 128, N_G = (I8MASK & 2) ? 0 : 16 * 96, N_H = (I8MASK & 4) ? 0 : 16 * 128;
    constexpr int NITEMS = N_F0 + N_F3 + N_G + N_H + 2 * I_SQ + I_SQ + I_SQ;
    for (int it = C.gw; it < NITEMS; it += C.NGW) {
        int r = it;
        if (r < N_F0) { p0_transpose_item(C.in[3], FOX_IN, 1024, 4096, (bf16*)(C.ws + WS_FOXWIN), scr, r, C.lane); continue; } r -= N_F0;
        if (r < N_F3) { p0_transpose_item(C.in[3] + (size_t)1024 * FOX_IN, FOX_IN, 1024, 4096, (bf16*)(C.ws + WS_FOXWIN + 8 * MiB), scr, r, C.lane); continue; } r -= N_F3;
        if (r < N_G) { p0_transpose_item(C.in[8], GLA_IN, 1024, 3072, (bf16*)(C.ws + WS_GLAWIN), scr, r, C.lane); continue; } r -= N_G;
        if (r < N_H) { p0_transpose_item(C.in[13], HGRN_IN, 1024, 4096, (bf16*)(C.ws + WS_HGRNWIN), scr, r, C.lane); continue; } r -= N_H;
        if (r < 2 * I_SQ) { const int j = r / I_SQ; p0_transpose_item(C.in[7] + (size_t)j * 1024 * 1024, 1024, 1024, 1024, (bf16*)(C.ws + WS_FOXWOUT) + (size_t)j * 1024 * 1024, scr, r % I_SQ, C.lane); continue; } r -= 2 * I_SQ;
        if (r < I_SQ) { p0_transpose_item(C.in[12], 1024, 1024, 1024, (bf16*)(C.ws + WS_GLAWOUT), scr, r, C.lane); continue; } r -= I_SQ;
        p0_transpose_item(C.in[16], 1024, 1024, 1024, (bf16*)(C.ws + WS_HGRNWOUT), scr, r, C.lane);
    }
    }
    for (int rep_ = 0; rep_ < (PRO_PROBE == 2 ? 2 : 1); ++rep_) {
    constexpr int MT_GROUPS = 4 * 16 * 4 * 32;
    for (int grp = C.gw; grp < MT_GROUPS; grp += C.NGW) {
        const int nb2 = grp & 31, kb2 = (grp >> 5) & 3, hp = (grp >> 7) & 15, layer = grp >> 11;
        const float* kp = C.in[18] + ((size_t)(layer * 16 + hp) * 128 + kb2 * 32 + (C.lane & 15)) * 128 + 4 * (C.lane >> 4);
        const float* wp = C.in[17] + ((size_t)layer * 1024 + nb2 * 32 + (C.lane & 15)) * 2048 + hp * 128 + 4 * (C.lane >> 4);
        f32x4 ka[2][8], wb[2][8];
#pragma unroll
        for (int u = 0; u < 2; ++u)
#pragma unroll
            for (int s8 = 0; s8 < 8; ++s8) { ka[u][s8] = *(const GAS f32x4*)(kp + (size_t)u * 16 * 128 + 16 * s8); wb[u][s8] = *(const GAS f32x4*)(wp + (size_t)u * 16 * 2048 + 16 * s8); }
        __builtin_amdgcn_sched_barrier(0);
        f32x4 acc[2][2];
#pragma unroll
        for (int a = 0; a < 2; ++a)
#pragma unroll
            for (int b = 0; b < 2; ++b) acc[a][b] = (f32x4){0.f, 0.f, 0.f, 0.f};
#pragma unroll
        for (int s8 = 0; s8 < 8; ++s8)
#pragma unroll
            for (int a = 0; a < 2; ++a)
#pragma unroll
                for (int b = 0; b < 2; ++b) { const f32x4 x = ka[a][s8], y = wb[b][s8];
                    acc[a][b] = __builtin_amdgcn_mfma_f32_16x16x4f32(x.x, y.x, acc[a][b], 0, 0, 0); acc[a][b] = __builtin_amdgcn_mfma_f32_16x16x4f32(x.y, y.y, acc[a][b], 0, 0, 0);
                    acc[a][b] = __builtin_amdgcn_mfma_f32_16x16x4f32(x.z, y.z, acc[a][b], 0, 0, 0); acc[a][b] = __builtin_amdgcn_mfma_f32_16x16x4f32(x.w, y.w, acc[a][b], 0, 0, 0); }
#pragma unroll
        for (int a = 0; a < 2; ++a)
#pragma unroll
            for (int b = 0; b < 2; ++b) {
                bf16* mt = (bf16*)(C.ws + WS_PEERWQ) + ((size_t)layer * 2048 + hp * 128 + kb2 * 32 + a * 16 + (C.lane >> 4) * 4) * 1024 + nb2 * 32 + b * 16 + (C.lane & 15);
#pragma unroll
                for (int r = 0; r < 4; ++r) mt[(size_t)r * 1024] = (bf16)f2bf(acc[a][b][r]); }
    }
    }
    for (int rep_ = 0; rep_ < (PRO_PROBE == 3 ? 2 : 1); ++rep_) {
    quant_rows_fp8(C, C.in[19], C.ws + WS_U, C.ws + WS_SU, BGQ ? 16384 : 4 * 16384);
    quant_rows_fp8(C, C.in[20], C.ws + WS_V, C.ws + WS_SV, BGQ ? 16384 : 4 * 16384);
    }
    for (int rep_ = 0; rep_ < (PRO_PROBE == 4 ? 2 : 1); ++rep_) {
    for (int i = C.vcu * 512 + C.tid; i < 3 * 16 * 1024; i += C.G * 512) {
        const int w = i >> 14, n = (i >> 10) & 15, k = i & 1023;
        const float v = w < 2 ? C.in[3][(size_t)w * 1024 * FOX_IN + (size_t)k * FOX_IN + 4096 + n] : C.in[8][(size_t)k * GLA_IN + 3072 + n];
        ((bf16*)(C.ws + WS_TAILW))[i] = (bf16)f2bf(v);
    }
    if (C.vcu == 0) for (int c = C.tid; c < 1024; c += 512) {
        const float l0 = C.in[14][c], l1 = C.in[14][1024 + c], l2 = C.in[14][2048 + c], l3 = C.in[14][3072 + c];
        const float m = fmaxf(fmaxf(l0, l1), fmaxf(l2, l3));
        const float e0 = expf(l0 - m), e1 = expf(l1 - m), e2 = expf(l2 - m), e3 = expf(l3 - m);
        ((float*)(C.ws + WS_LB))[c] = (e1 + e2) / (e0 + e1 + e2 + e3);
    }
    for (int m0 = C.gw; m0 < NTOK; m0 += 4 * C.NGW) {
        f32x4 v[4][4];
#pragma unroll
        for (int u = 0; u < 4; ++u) { const int m = m0 + u * C.NGW; if (m < NTOK) { const GAS f32x4* xr = (const GAS f32x4*)(C.in[0] + (size_t)m * 1024) + C.lane;
#pragma unroll
            for (int j = 0; j < 4; ++j) v[u][j] = xr[64 * j]; } }
        __builtin_amdgcn_sched_barrier(0);
#pragma unroll
        for (int u = 0; u < 4; ++u) { const int m = m0 + u * C.NGW; if (m < NTOK)
            rms_row_to_bf16(C.lane, v[u], C.in[1], (bf16*)(C.ws + WS_XN) + (size_t)m * 1024, (signed char*)(C.ws + WS_XN8) + (size_t)m * 1024, (float*)(C.ws + WS_SX) + m); }
    }
    }
}

__device__ __forceinline__ void tail_mfma(const Ctx& C, int tok0, const bf16* WT, LAS float* part) {
    const int l = C.lane, m = l & 15, g = l >> 4, tbk = C.wave & 3, kh = C.wave >> 2;
    const bf16* ap = (const bf16*)(C.ws + WS_XN) + (size_t)(tok0 + 16 * tbk + m) * 1024 + kh * 512 + 8 * g;
    const bf16* bp = WT + (size_t)m * 1024 + kh * 512 + 8 * g;
    f32x4 acc = (f32x4){0.f, 0.f, 0.f, 0.f};
#pragma unroll 4
    for (int ks = 0; ks < 16; ++ks) acc = __builtin_amdgcn_mfma_f32_16x16x32_bf16(*(const bf16x8*)(ap + 32 * ks), *(const bf16x8*)(bp + 32 * ks), acc, 0, 0, 0);
#pragma unroll
    for (int r = 0; r < 4; ++r) part[kh * 1024 + (16 * tbk + 4 * g + r) * 16 + m] = acc[r];
}
template <bool QK> __device__ __forceinline__ void fox_step1(const Ctx& C, int j) {
    float* TAIL = (float*)(C.ws + WS_TAIL); LAS float* part = (LAS float*)C.lds;
    const bf16* WT = (const bf16*)(C.ws + WS_TAILW) + (size_t)j * 16 * 1024;
    for (int tb = C.vcu; tb < NTOK / 64; tb += C.G) {
        __syncthreads();
        tail_mfma(C, tb * 64, WT, part);
        __syncthreads();
#pragma unroll
        for (int rep = 0; rep < 2; ++rep) { const int i = rep * 512 + C.tid; TAIL[(size_t)tb * 1024 + i] = log_sigmoid_f(part[i] + part[1024 + i] + C.in[4][j * 16 + (i & 15)]); }
        if (!QK) continue;
        const float* gq = C.in[5] + j * 64; const float* gk = C.in[6] + j * 64;
        v4u ra[2][8], rb[2][8];
#pragma unroll
        for (int which = 0; which < 2; ++which)
#pragma unroll
            for (int t = 0; t < 8; ++t) { const bf16* row = (const bf16*)(C.ws + WS_P) + (size_t)which * PSTRIDE + (size_t)(tb * 64 + C.wave * 8 + t) * 1024 + C.lane * 16;
                ra[which][t] = *(const GAS v4u*)row; rb[which][t] = *(const GAS v4u*)(row + 8); }
        __builtin_amdgcn_sched_barrier(0);
#pragma unroll
        for (int which = 0; which < 2; ++which) {
            const float* g = (which == 0 ? gq : gk) + (C.lane & 3) * 16;
            float gv[16];
#pragma unroll
            for (int i = 0; i < 16; ++i) gv[i] = g[i];
#pragma unroll
            for (int t = 0; t < 8; ++t) {
                bf16* row = (bf16*)(C.ws + WS_P) + (size_t)which * PSTRIDE + (size_t)(tb * 64 + C.wave * 8 + t) * 1024 + C.lane * 16;
                const v4u a = ra[which][t], b = rb[which][t];
                float v[16] = {bflo(a.x), bfhi(a.x), bflo(a.y), bfhi(a.y), bflo(a.z), bfhi(a.z), bflo(a.w), bfhi(a.w), bflo(b.x), bfhi(b.x), bflo(b.y), bfhi(b.y), bflo(b.z), bfhi(b.z), bflo(b.w), bfhi(b.w)};
                float ss = 0.f;
#pragma unroll
                for (int i = 0; i < 16; ++i) ss += v[i] * v[i];
                ss = DPP_ADD(ss, 0xB1, 0xf, 0xf); ss = DPP_ADD(ss, 0x4E, 0xf, 0xf);
                const float r = rsqrtf(ss * (1.f / 64.f) + RMS_EPS) * (which == 0 ? FOX_C2 : 1.f);
#pragma unroll
                for (int i = 0; i < 16; ++i) v[i] = v[i] * r * gv[i];
                v4u oa, ob; oa.x = pk2(v[0], v[1]); oa.y = pk2(v[2], v[3]); oa.z = pk2(v[4], v[5]); oa.w = pk2(v[6], v[7]);
                ob.x = pk2(v[8], v[9]); ob.y = pk2(v[10], v[11]); ob.z = pk2(v[12], v[13]); ob.w = pk2(v[14], v[15]);
                *(GAS v4u*)row = oa; *(GAS v4u*)(row + 8) = ob;
            }
        }
    }
}
constexpr size_t WS_ASC = WS_Q2, WS_Q1 = WS_Q2 + 16 * MiB, WS_KST = WS_Q2 + 48 * MiB, WS_DEC = 59 * MiB;
static_assert(WS_KST + 32 * MiB <= WS_OF && WS_Q1 + 32 * MiB <= WS_KST, "chunk workspace map");
template <int NH>
__device__ __forceinline__ void chunk_prepass(const Ctx& C) {
    bf16* ASC = (bf16*)(C.ws + WS_ASC); bf16* Q1 = (bf16*)(C.ws + WS_Q1); bf16* KST = (bf16*)(C.ws + WS_KST); float* DEC = (float*)(C.ws + WS_DEC);
    const bf16* P0 = (const bf16*)(C.ws + WS_P); const bf16* P1 = P0 + PSTRIDE;
    LAS bf16* tqs = (LAS bf16*)C.lds;
    LAS bf16* tks = tqs + 64 * 128;
    LAS bf16* q2s = tks + 64 * 128;
    LAS bf16* k2s = q2s + 64 * 136;
    LAS bf16* q1s = k2s + 64 * 136;
    LAS float* tot = (LAS float*)(q1s + 64 * 128);
    LAS float* part = tot + 512;
    const float qs = 0.08838834764831845f;
    const int d = C.tid & 127, tq = C.tid >> 7, l = C.lane, fr = l & 15, fq = l >> 4;
    const int dq = (d & ~31) + ((d & 16) ? 8 * ((d & 15) >> 2) + 4 + (d & 3) : 8 * ((d & 15) >> 2) + (d & 3));
    const int pr0 = C.tid >> 4, pc = (C.tid & 15) * 8;
#define PP_BAR() do { asm volatile("s_waitcnt lgkmcnt(0)" ::: "memory"); __builtin_amdgcn_s_barrier(); asm volatile("" ::: "memory"); } while (0)
    for (int itb = C.vcu; itb < NBATCH * 32; itb += C.G) {
        const int c = itb & 31, b = itb >> 5;
        const size_t rowb = (size_t)b * SEQLEN + c * 64;
        const size_t row0 = rowb + tq * 16;
        if (NH == 4) { __syncthreads(); tail_mfma(C, b * SEQLEN + c * 64, (const bf16*)(C.ws + WS_TAILW) + 2 * 16 * 1024, part); }
        v4u pq[2], pk[2];
#define PP_LOAD(h_) do { _Pragma("unroll") for (int j = 0; j < 2; ++j) { const size_t r_ = (rowb + pr0 + 32 * j) * 1024 + (h_) * 128 + pc; \
            pq[j] = *(const GAS v4u*)(P0 + r_); pk[j] = *(const GAS v4u*)((NH == 4 ? P0 + 512 : P1) + r_); } } while (0)
        PP_LOAD(0);
#pragma unroll 1
        for (int h = 0; h < NH; ++h) {
            const int it = (b * NH + h) * 32 + c;
            PP_BAR();
#pragma unroll
            for (int j = 0; j < 2; ++j) { *(LAS v4u*)(tqs + (pr0 + 32 * j) * 128 + pc) = pq[j]; *(LAS v4u*)(tks + (pr0 + 32 * j) * 128 + pc) = pk[j]; }
            if (h + 1 < NH) PP_LOAD(h + 1);
            PP_BAR();
            float bl[16], kk[16]; float run = 0.f;
            if (NH == 4) {
                float wu[16];
#pragma unroll
                for (int r = 0; r < 16; ++r) wu[r] = C.in[9][r * 512 + h * 128 + d];
                const float ba = C.in[10][h * 128 + d];
#pragma unroll
                for (int i = 0; i < 16; ++i) { float z = ba; const int t = tq * 16 + i;
#pragma unroll
                    for (int r = 0; r < 16; r += 4) { const f32x4 p0 = *(const LAS f32x4*)(part + t * 16 + r), p1 = *(const LAS f32x4*)(part + 1024 + t * 16 + r);
                        z += (p0[0] + p1[0]) * wu[r] + (p0[1] + p1[1]) * wu[r + 1] + (p0[2] + p1[2]) * wu[r + 2] + (p0[3] + p1[3]) * wu[r + 3]; }
                    run += log_sigmoid_f(z) * (1.f / 16.f); bl[i] = run; kk[i] = bf2f(tks[t * 128 + d]); }
            } else {
                const float lb = ((const float*)(C.ws + WS_LB))[h * 128 + d];
#pragma unroll
                for (int i = 0; i < 16; ++i) { const float gate = lb + (1.f - lb) * sigmoid_f(bf2f(tks[(tq * 16 + i) * 128 + d])); run += __logf(gate); bl[i] = run; kk[i] = 1.f - gate; }
            }
            tot[tq * 128 + d] = run;
            PP_BAR();
            const float t0 = tot[d], t1 = tot[128 + d], t2 = tot[256 + d], t3 = tot[384 + d];
            const float off = tq == 0 ? 0.f : tq == 1 ? t0 : tq == 2 ? t0 + t1 : t0 + t1 + t2;
            const float bref = t0 + t1, bend = (t0 + t1) + (t2 + t3);
            unsigned ksw[8];
#pragma unroll
            for (int i = 0; i < 16; ++i) {
                const float bb = bl[i] + off;
                const float qv = bf2f(tqs[(tq * 16 + i) * 128 + d]) * qs, kv = kk[i];
                q1s[(tq * 16 + i) * 128 + dq] = (bf16)f2bfh(qv * __expf(bb));
                q2s[(tq * 16 + i) * 136 + d] = (bf16)f2bfh(qv * __expf(bb - bref));
                k2s[(tq * 16 + i) * 136 + d] = (bf16)f2bfh(kv * __expf(bref - bb));
                const unsigned kb = f2bfh(kv * __expf(bend - bb));
                if (i & 1) ksw[i >> 1] |= kb << 16; else ksw[i >> 1] = kb;
            }
            { bf16* kt = KST + ((size_t)it * 128 + d) * 64 + tq * 16; *(GAS v4u*)kt = (v4u){ksw[0], ksw[1], ksw[2], ksw[3]}; *(GAS v4u*)(kt + 8) = (v4u){ksw[4], ksw[5], ksw[6], ksw[7]}; }
            if (tq == 0) DEC[(size_t)it * 128 + d] = __expf(bend);
            PP_BAR();
#pragma unroll
            for (int j = 0; j < 2; ++j) *(GAS v4u*)(Q1 + (((size_t)it * 4 + (pc >> 5)) * 64 + pr0 + 32 * j) * 32 + (pc & 31)) = *(const LAS v4u*)(q1s + (pr0 + 32 * j) * 128 + pc);
            const int ti = C.wave >> 1;
#pragma unroll
            for (int sj = 0; sj < 2; ++sj) {
                const int si = 2 * (C.wave & 1) + sj;
                f32x4 acc = (f32x4){0.f, 0.f, 0.f, 0.f};
                if (si <= ti) {
#pragma unroll
                    for (int ks = 0; ks < 4; ++ks) {
                        const bf16x8 a = *(const LAS bf16x8*)(q2s + (16 * ti + fr) * 136 + ks * 32 + fq * 8), bb = *(const LAS bf16x8*)(k2s + (16 * si + fr) * 136 + ks * 32 + fq * 8);
                        acc = __builtin_amdgcn_mfma_f32_16x16x32_bf16(bb, a, acc, 0, 0, 0);
                    }
                }
                const int t = 16 * ti + fr, s0 = 16 * si + 4 * fq;
                typedef unsigned u32x2v __attribute__((ext_vector_type(2)));
                u32x2v w; w.x = pk2(s0 <= t ? acc[0] : 0.f, s0 + 1 <= t ? acc[1] : 0.f); w.y = pk2(s0 + 2 <= t ? acc[2] : 0.f, s0 + 3 <= t ? acc[3] : 0.f);
                *(GAS u32x2v*)(ASC + (size_t)it * 4096 + t * 64 + s0) = w;
            }
        }
    }
#undef PP_LOAD
#undef PP_BAR
}
struct RecFrag { bf16x8 a0, a1; bf16x8 q[4]; f32x4 dc[2]; bf16x8 ks[2][2]; };
template <int NH, int DV, int RP = 0  >
__device__ __forceinline__ void chunk_recur(const Ctx& C, const bf16* Vp) {
    const bf16* ASC = (const bf16*)(C.ws + WS_ASC); const bf16* Q1 = (const bf16*)(C.ws + WS_Q1); const bf16* KST = (const bf16*)(C.ws + WS_KST); const float* DEC = (const float*)(C.ws + WS_DEC);
    bf16* OF = (bf16*)(C.ws + (RP ? WS_GLOG : WS_OF));
    constexpr int NCB = DV / 16, NTASK = NBATCH * NH * NCB;
    const int l = C.lane, m = l & 15, g = l >> 4, gi = C.wave >> 2, kq = C.wave & 3;
    LAS float* red = (LAS float*)C.lds + gi * 8192;
    LAS bf16* vt = (LAS bf16*)(C.lds + 65536) + gi * 2048;
    typedef short v4i16_t __attribute__((ext_vector_type(4)));
#define REC_LOAD(F, c_) do { const size_t row0_ = (size_t)b * SEQLEN + (c_) * 64; const size_t ch_ = (size_t)bh * 32 + (c_); \
        F.a0 = *(const bf16x8*)(ASC + ch_ * 4096 + (16 * kq + m) * 64 + 8 * g); F.a1 = *(const bf16x8*)(ASC + ch_ * 4096 + (16 * kq + m) * 64 + 32 + 8 * g); \
        _Pragma("unroll") for (int tb = 0; tb < 4; ++tb) F.q[tb] = *(const bf16x8*)(Q1 + ((ch_ * 4 + kq) * 64 + 16 * tb + m) * 32 + 8 * g); \
        _Pragma("unroll") for (int i = 0; i < 2; ++i) { F.dc[i] = *(const f32x4*)(DEC + ch_ * 128 + 32 * kq + 16 * i + 4 * g); \
            _Pragma("unroll") for (int ks = 0; ks < 2; ++ks) F.ks[i][ks] = *(const bf16x8*)(KST + (ch_ * 128 + 32 * kq + 16 * i + m) * 64 + 32 * ks + 8 * g); } } while (0)
#define VP_LOAD(c_) (*(const unsigned long long*)(Vp + ((size_t)b * SEQLEN + (c_) * 64 + 16 * kq + (l >> 2)) * 1024 + h * DV + cb * 16 + 4 * (l & 3)))
#define VT_PUT(c_, v_) (*(LAS unsigned long long*)(vt + ((c_) & 1) * 1024 + (16 * kq + (l >> 2)) * 16 + 4 * (l & 3)) = (v_))
#define REC_BODY(F, Fn, c_, vcur_, vnew_) do { \
        if ((c_) + 1 < 32 && RP != 3) REC_LOAD(Fn, (c_) + 1); \
        if ((c_) + 2 < 32) vnew_ = VP_LOAD((c_) + 2); \
        bf16x8 vb[2]; \
        _Pragma("unroll") for (int ks = 0; ks < 2; ++ks) { const LAS bf16* tp_ = vt + ((c_) & 1) * 1024 + (32 * ks + 8 * g + ((l & 15) >> 2)) * 16 + 4 * (l & 3); \
            const v4i16_t lo_ = __builtin_amdgcn_ds_read_tr16_b64_v4i16((LAS v4i16_t*)tp_), hi_ = __builtin_amdgcn_ds_read_tr16_b64_v4i16((LAS v4i16_t*)(tp_ + 64)); \
            vb[ks] = (bf16x8){lo_[0], lo_[1], lo_[2], lo_[3], hi_[0], hi_[1], hi_[2], hi_[3]}; } \
        if ((c_) + 1 < 32) VT_PUT((c_) + 1, vcur_);              \
        if (BGQ && RP == 0) { const int bgn = (bgit * 32 + (c_)) * C.NGW + C.gw; bgq_step<JOB>(C, bgi, bgn, bgv); bgi = bgn; } \
        LAS float* rb = red + ((c_) & 1) * 4096; \
        f32x4 oin = __builtin_amdgcn_mfma_f32_16x16x32_bf16(F.a0, vb[0], (f32x4){0.f, 0.f, 0.f, 0.f}, 0, 0, 0); \
        if (kq >= 2) oin = __builtin_amdgcn_mfma_f32_16x16x32_bf16(F.a1, vb[1], oin, 0, 0, 0); \
        { u32x4v sw; sw.x = pk2(S[0][0], S[0][1]); sw.y = pk2(S[0][2], S[0][3]); sw.z = pk2(S[1][0], S[1][1]); sw.w = pk2(S[1][2], S[1][3]); \
          const bf16x8 sb = __builtin_bit_cast(bf16x8, sw); \
          _Pragma("unroll") for (int tb = 0; tb < 4; ++tb) { \
              const f32x4 po = __builtin_amdgcn_mfma_f32_16x16x32_bf16(F.q[tb], sb, (f32x4){0.f, 0.f, 0.f, 0.f}, 0, 0, 0); \
              *(LAS f32x4*)(rb + ((kq * 4 + tb) * 64 + l) * 4) = po; } } \
        _Pragma("unroll") for (int i = 0; i < 2; ++i) { S[i] = S[i] * F.dc[i]; \
            _Pragma("unroll") for (int ks = 0; ks < 2; ++ks) S[i] = __builtin_amdgcn_mfma_f32_16x16x32_bf16(F.ks[i][ks], vb[ks], S[i], 0, 0, 0); } \
        if (RP != 2) { asm volatile("s_waitcnt lgkmcnt(0)" ::: "memory"); __builtin_amdgcn_s_barrier(); asm volatile("" ::: "memory"); } \
        { f32x4 o = oin; \
          if (RP != 2) { _Pragma("unroll") for (int k2 = 0; k2 < 4; ++k2) o = o + *(const LAS f32x4*)(rb + ((k2 * 4 + kq) * 64 + l) * 4); } \
          const size_t orow = (size_t)b * SEQLEN + (c_) * 64 + 16 * kq + 4 * g; \
          if (RP != 4 || (c_) == 31) { _Pragma("unroll") for (int r = 0; r < 4; ++r) OF[(orow + r) * 1024 + col] = (bf16)f2bf(o[r]); } } } while (0)
    constexpr int JOB = NH == 4 ? 1 : 2;
    f32x4 bgv[4]; int bgi = -1, bgit = 0;
    for (int t0 = C.vcu; t0 < NTASK / 2; t0 += C.G, ++bgit) {
        const int task = gi * (NTASK / 2) + t0;
        const int cb = task % NCB, bh = task / NCB, b = bh / NH, h = bh % NH;
        const int col = h * DV + cb * 16 + m;
        f32x4 S[2];
        S[0] = (f32x4){0.f, 0.f, 0.f, 0.f}; S[1] = S[0];
        RecFrag FA, FB;
        REC_LOAD(FA, 0);
        if (RP == 3) REC_LOAD(FB, 1);
        unsigned long long vA = VP_LOAD(0), vB = VP_LOAD(1);
        VT_PUT(0, vA); vA = vB;
        asm volatile("s_waitcnt lgkmcnt(0)" ::: "memory"); __builtin_amdgcn_s_barrier(); asm volatile("" ::: "memory");
#pragma unroll 1
        for (int c = 0; c < 32; c += 2) { REC_BODY(FA, FB, c, vA, vB); REC_BODY(FB, FA, c + 1, vB, vA); }
        asm volatile("s_waitcnt lgkmcnt(0)" ::: "memory"); __builtin_amdgcn_s_barrier(); asm volatile("" ::: "memory");
    }
    if (BGQ && RP == 0) {
        for (int bgn = bgit * 32 * C.NGW + C.gw; bgi < BGQ_ROWS; bgn += C.NGW) { bgq_step<JOB>(C, bgi, bgn, bgv); bgi = bgn; }
    }
#undef REC_LOAD
#undef REC_BODY
#undef VP_LOAD
#undef VT_PUT
}

template <int DV>
__device__ __forceinline__ void rec_norm_gate(const Ctx& C, const float* gain, const bf16* gate) {
    const bf16* OF = (const bf16*)(C.ws + WS_OF); bf16* OB = (bf16*)(C.ws + WS_OB);
    f32x4 g[4];
#pragma unroll
    for (int j = 0; j < 4; ++j) g[j] = *((const GAS f32x4*)gain + C.lane + 64 * j);
    for (int tok0 = C.gw; tok0 < NTOK; tok0 += 4 * C.NGW) {
        unsigned long long vw[4][4], tw[4][4];
#pragma unroll
        for (int u = 0; u < 4; ++u) { const int tok = tok0 + u * C.NGW; if (tok < NTOK) {
            const GAS unsigned long long* xr = (const GAS unsigned long long*)(OF + (size_t)tok * 1024) + C.lane;
            const GAS unsigned long long* tr = (const GAS unsigned long long*)(gate + (size_t)tok * 1024) + C.lane;
#pragma unroll
            for (int j = 0; j < 4; ++j) { vw[u][j] = xr[64 * j]; tw[u][j] = tr[64 * j]; } } }
        __builtin_amdgcn_sched_barrier(0);
#pragma unroll
        for (int u = 0; u < 4; ++u) { const int tok = tok0 + u * C.NGW; if (tok < NTOK) {
            GAS unsigned long long* o8 = (GAS unsigned long long*)(OB + (size_t)tok * 1024) + C.lane;
#pragma unroll
            for (int j = 0; j < 4; ++j) {
                const f32x4 v = (f32x4){bflo((unsigned)vw[u][j]), bfhi((unsigned)vw[u][j]), bflo((unsigned)(vw[u][j] >> 32)), bfhi((unsigned)(vw[u][j] >> 32))}; float ss = (v.x * v.x + v.y * v.y) + (v.z * v.z + v.w * v.w);
                if (DV == 256) ss = wave_sum(ss); else { DPP_SUM31(ss); const float s_lo = rdlane(ss, 31), s_hi = rdlane(ss, 63); ss = C.lane < 32 ? s_lo : s_hi; }
                const float r = rsqrtf(ss * (1.f / DV) + RMS_EPS);
                const unsigned long long t8 = tw[u][j];
                const float t0 = bflo((unsigned)t8), t1 = bfhi((unsigned)t8), t2 = bflo((unsigned)(t8 >> 32)), t3 = bfhi((unsigned)(t8 >> 32));
                const float a0 = v.x * r * g[j].x * (t0 * sigmoid_f(t0)), a1 = v.y * r * g[j].y * (t1 * sigmoid_f(t1)), a2 = v.z * r * g[j].z * (t2 * sigmoid_f(t2)), a3 = v.w * r * g[j].w * (t3 * sigmoid_f(t3));
                o8[64 * j] = (unsigned long long)pk2h(a0, a1) | ((unsigned long long)pk2h(a2, a3) << 32);
            } } }
    }
}

#define CE_D(a, b) do { const unsigned mx_ = (a) > (b) ? (a) : (b); const unsigned mn_ = (a) > (b) ? (b) : (a); (a) = mx_; (b) = mn_; } while (0)
__device__ __forceinline__ void sort16_desc(unsigned (&a)[16]) {
#pragma unroll
    for (int k = 2; k <= 16; k <<= 1)
#pragma unroll
        for (int j = k >> 1; j > 0; j >>= 1)
#pragma unroll
            for (int i = 0; i < 16; ++i) { const int l = i ^ j; if (l > i) { if ((i & k) == 0) CE_D(a[i], a[l]); else CE_D(a[l], a[i]); } }
}
__device__ __forceinline__ void merge_top16(unsigned (&a)[16], const unsigned (&b)[16]) {
#pragma unroll
    for (int i = 0; i < 16; ++i) a[i] = a[i] > b[15 - i] ? a[i] : b[15 - i];
#pragma unroll
    for (int j = 8; j > 0; j >>= 1)
#pragma unroll
        for (int i = 0; i < 16; ++i) { const int l = i ^ j; if (l > i) CE_D(a[i], a[l]); }
}
__device__ __forceinline__ void merge_quad(unsigned (&a)[16], int lane) {
    unsigned p[16];
#pragma unroll
    for (int i = 0; i < 16; ++i) p[i] = (unsigned)__builtin_amdgcn_ds_bpermute((lane ^ 16) << 2, (int)a[i]);
    merge_top16(a, p);
#pragma unroll
    for (int i = 0; i < 16; ++i) p[i] = (unsigned)__builtin_amdgcn_ds_bpermute((lane ^ 32) << 2, (int)a[i]);
    merge_top16(a, p);
}
__device__ __forceinline__ unsigned mono_key(float f) { const unsigned u = __float_as_uint(f); return (u & 0x80000000u) ? ~u : (u | 0x80000000u); }
__device__ __forceinline__ float mono_inv(unsigned k) { return __uint_as_float((k & 0x80000000u) ? (k ^ 0x80000000u) : ~k); }
__constant__ __attribute__((aligned(16))) unsigned char PEER_CAND[64] = {0, 1, 2, 3, 4, 5, 6, 7, 8, 9, 10, 11, 12, 13, 14, 15, 16, 17, 18, 19, 20, 21, 22, 23, 32, 33, 34, 35, 36, 64, 65, 66, 48, 49, 50, 51, 80, 81, 96, 97, 112, 113, 128, 144, 160, 176, 192, 208, 224, 240, 255, 255, 255, 255, 255, 255, 255, 255, 255, 255, 255, 255, 255, 255};
__device__ __forceinline__ void peer_topk_task(const Ctx& C, int layer, int tok0, int head, int trow0, LAS int* lexp, LAS float* lgate) {
    typedef _Float16 h8 __attribute__((ext_vector_type(8)));
    const _Float16* SC = (const _Float16*)(C.ws + WS_Q2);
    LAS unsigned* L0 = (LAS unsigned*)(C.lds + C.wave * 2048);
    LAS unsigned* L1 = L0 + 256;
    {
        int l = C.lane; asm volatile("" : "+v"(l));
        const int m = l & 15, g = l >> 4;
        unsigned cand_w[4];
#pragma unroll
        for (int c = 0; c < 4; ++c) cand_w[c] = ((const unsigned*)PEER_CAND)[g * 4 + c];
        unsigned top[2][16];
#pragma unroll
        for (int p = 0; p < 2; ++p) {
            const _Float16* sp = SC + (size_t)(tok0 + m) * 2048 + head * 256 + p * 128 + 32 * g;
            h8 hv[4];
#pragma unroll
            for (int q = 0; q < 4; ++q) hv[q] = *(const h8*)(sp + 8 * q);
            unsigned hi16[16];
#pragma unroll
            for (int q = 0; q < 4; ++q)
#pragma unroll
                for (int j = 0; j < 8; ++j) { const int i = 8 * q + j; const unsigned key = (mono_key((float)hv[q][j]) & ~0x7fu) | (unsigned)(127 - (32 * g + i));
                    if (i < 16) top[p][i] = key; else hi16[i - 16] = key; }
            sort16_desc(top[p]); sort16_desc(hi16); merge_top16(top[p], hi16);
            merge_quad(top[p], l);
        }
        if (g == 0) {
#pragma unroll
            for (int i = 0; i < 16; i += 4) { *(LAS u32x4v*)(L0 + m * 16 + i) = (u32x4v){top[0][i], top[0][i + 1], top[0][i + 2], top[0][i + 3]}; *(LAS u32x4v*)(L1 + m * 16 + i) = (u32x4v){top[1][i], top[1][i + 1], top[1][i + 2], top[1][i + 3]}; }
        }
        asm volatile("s_waitcnt lgkmcnt(0)" ::: "memory"); __builtin_amdgcn_wave_barrier();
        unsigned cd[16];
#pragma unroll
        for (int c = 0; c < 16; ++c) {
            const unsigned code = (cand_w[c >> 2] >> (8 * (c & 3))) & 0xffu, ci = (code >> 4) & 15u, cj = code & 15u;
            const float v = mono_inv(L0[m * 16 + ci]) + mono_inv(L1[m * 16 + cj]);
            cd[c] = code == 255u ? 0u : ((mono_key(v) & ~0xffu) | (255u - code));
        }
        sort16_desc(cd); merge_quad(cd, l);
        if (g == 0) {
            float best[16]; int ex[16]; float sum = 0.f;
#pragma unroll
            for (int r = 0; r < 16; ++r) { const unsigned pos = 255u - (cd[r] & 0xffu), pi = pos >> 4, pj = pos & 15u;
                ex[r] = (int)((127u - (L0[m * 16 + pi] & 0x7fu)) * 128u + (127u - (L1[m * 16 + pj] & 0x7fu))); best[r] = mono_inv(cd[r]); }
            const float bmax = best[0];
#pragma unroll
            for (int r = 0; r < 16; ++r) { best[r] = __expf(best[r] - bmax); sum += best[r]; }
            const float inv = 1.f / sum;
            const int ob = (trow0 + m) * 128 + head * 16;
#pragma unroll
            for (int r = 0; r < 16; r += 4) { *(LAS u32x4v*)(lexp + ob + r) = (u32x4v){(unsigned)ex[r], (unsigned)ex[r + 1], (unsigned)ex[r + 2], (unsigned)ex[r + 3]};
                *(LAS f32x4*)(lgate + ob + r) = (f32x4){best[r] * inv, best[r + 1] * inv, best[r + 2] * inv, best[r + 3] * inv}; }
        }
        asm volatile("s_waitcnt lgkmcnt(0)" ::: "memory"); __builtin_amdgcn_wave_barrier();
    }
}
typedef float f32x2v __attribute__((ext_vector_type(2)));
#define GRP8_SUM(v) do { v = DPP_ADD(v, 0xB1, 0xf, 0xf); v = DPP_ADD(v, 0x4E, 0xf, 0xf); v = DPP_ADD(v, 0x141, 0xf, 0xf); } while (0)
#ifndef MK_HOT
#define MK_HOT 0
#endif
__device__ __forceinline__ void wave_lds_sync() { asm volatile("s_waitcnt lgkmcnt(0)" ::: "memory"); __builtin_amdgcn_wave_barrier(); }
template <bool DRY>
__device__ __forceinline__ void peer_rounds(const Ctx& C, int layer, int tokw, LAS int* lexp_w, const LAS float* lgate_w, LAS unsigned* sorted_w, LAS unsigned* hist_w) {
    const unsigned char* U = C.ws + WS_U + (size_t)layer * 16384 * 1024; const unsigned char* V = C.ws + WS_V + (size_t)layer * 16384 * 1024;
    const LAS unsigned char* SU = (const LAS unsigned char*)(C.lds + 114688); const LAS unsigned char* SV = SU + 16384;
    const float* gf = C.in[2] + layer * 1024; const float* gn = C.in[1] + (layer + 1) * 1024;
    int l = C.lane; asm volatile("" : "+v"(l));
    LAS float* hbuf = (LAS float*)lexp_w;
    {
        const int t = l >> 3, s = l & 7;
#pragma unroll
        for (int k = 0; k < 8; ++k) hist_w[l + 64 * k] = 0u;
        wave_lds_sync();
        unsigned ev[16], pos[16];
#pragma unroll
        for (int k = 0; k < 16; ++k) { ev[k] = (unsigned)lexp_w[t * 128 + s + 8 * k]; pos[k] = __hip_atomic_fetch_add(hist_w + t * 64 + (ev[k] >> 8), 1u, __ATOMIC_RELAXED, __HIP_MEMORY_SCOPE_WORKGROUP); }
        wave_lds_sync();
        unsigned cnt[8], run = 0u;
#pragma unroll
        for (int j = 0; j < 8; ++j) { cnt[j] = hist_w[t * 64 + 8 * s + j]; run += cnt[j]; }
        unsigned inc = run;
#pragma unroll
        for (int o = 1; o < 8; o <<= 1) { const unsigned up = (unsigned)__builtin_amdgcn_ds_bpermute((l - o) << 2, (int)inc); if (s >= o) inc += up; }
        unsigned off = inc - run;
        wave_lds_sync();
#pragma unroll
        for (int j = 0; j < 8; ++j) { hist_w[t * 64 + 8 * s + j] = off; off += cnt[j]; }
        wave_lds_sync();
#pragma unroll
        for (int k = 0; k < 16; ++k) sorted_w[t * 128 + hist_w[t * 64 + (ev[k] >> 8)] + pos[k]] = (ev[k] << 7) | (unsigned)(s + 8 * k);
        wave_lds_sync();
    }
    asm volatile("" : "+v"(l));
    unsigned xp[8][8];
    {
        const int t = l >> 3, s = l & 7;
        const bf16* hrow = (const bf16*)(C.ws + WS_HB) + (size_t)(tokw + t) * 1024 + 16 * s;
        float ss = 0.f;
#pragma unroll
        for (int i = 0; i < 8; ++i) { const v4u a = *(const GAS v4u*)(hrow + 128 * i), b = *(const GAS v4u*)(hrow + 128 * i + 8);
            xp[i][0] = a.x; xp[i][1] = a.y; xp[i][2] = a.z; xp[i][3] = a.w; xp[i][4] = b.x; xp[i][5] = b.y; xp[i][6] = b.z; xp[i][7] = b.w;
#pragma unroll
            for (int j = 0; j < 8; ++j) { const float lo = bflo(xp[i][j]), hi = bfhi(xp[i][j]); ss += lo * lo + hi * hi; } }
        GRP8_SUM(ss);
        const float r = rsqrtf(ss * (1.f / 1024.f) + RMS_EPS);
#pragma unroll
        for (int i = 0; i < 8; ++i)
#pragma unroll
            for (int q = 0; q < 4; ++q) { const f32x4 a = *(const GAS f32x4*)(gf + 16 * s + 128 * i + 4 * q);
                xp[i][2 * q] = pk2(bflo(xp[i][2 * q]) * r * a.x, bfhi(xp[i][2 * q]) * r * a.y); xp[i][2 * q + 1] = pk2(bflo(xp[i][2 * q + 1]) * r * a.z, bfhi(xp[i][2 * q + 1]) * r * a.w); }
    }
    asm volatile("" : "+v"(l));
#define RND_LOAD(T, buf, item) do { const unsigned char* p_ = T + (size_t)((DRY && MK_HOT) ? (((item) >> 7) & 255u) : ((item) >> 7)) * 1024 + 16 * (l & 7); \
        _Pragma("unroll") for (int i = 0; i < 8; ++i) buf[i] = *(const GAS v4u*)(p_ + 128 * i); } while (0)
    {
        const int t = l >> 3, s = l & 7;
        const LAS unsigned* srt = sorted_w + t * 128;
        v4u bA[8], bB[8];
#define RND_DOT(buf, r_) do { float d = 0.f; \
            _Pragma("unroll") for (int i = 0; i < 8; ++i) { asm volatile("" : "+v"(buf[i])); _Pragma("unroll") for (int q = 0; q < 4; ++q) { \
                const f32x2v lo_ = __builtin_amdgcn_cvt_pk_f32_fp8((int)buf[i][q], false), hi_ = __builtin_amdgcn_cvt_pk_f32_fp8((int)buf[i][q], true); \
                d = dot2bf(pg8::cvt_pk_bf16(lo_.x, lo_.y), xp[i][2 * q], d); d = dot2bf(pg8::cvt_pk_bf16(hi_.x, hi_.y), xp[i][2 * q + 1], d); } } \
            GRP8_SUM(d); if (s == 0) hbuf[t * 128 + (r_)] = d; } while (0)
        RND_LOAD(U, bA, srt[0]);
#pragma unroll 1
        for (int r = 0; r < 128; r += 2) {
            RND_LOAD(U, bB, srt[r + 1]);
            RND_DOT(bA, r);
            RND_LOAD(U, bA, srt[(r + 2) & 127]);
            RND_DOT(bB, r + 1);
        }
#undef RND_DOT
    }
    wave_lds_sync();
    asm volatile("" : "+v"(l));
    {
        const int t = l >> 3, s = l & 7;
#pragma unroll
        for (int k = 0; k < 16; k += 2) {
            const int r0 = t * 128 + s + 8 * k, r1 = r0 + 8;
            const unsigned i0 = sorted_w[r0], i1 = sorted_w[r1];
            const float h0 = hbuf[r0] * __uint_as_float((unsigned)SU[i0 >> 7] << 23), h1 = hbuf[r1] * __uint_as_float((unsigned)SU[i1 >> 7] << 23);
            const pg8::f32x2 gl = pg8::gelu_pk((pg8::f32x2){h0, h1});
            hbuf[r0] = gl.x * lgate_w[t * 128 + (i0 & 127u)] * __uint_as_float((unsigned)SV[i0 >> 7] << 23); hbuf[r1] = gl.y * lgate_w[t * 128 + (i1 & 127u)] * __uint_as_float((unsigned)SV[i1 >> 7] << 23);
        }
    }
    wave_lds_sync();
    asm volatile("" : "+v"(l));
    f32x2v y2[8][8];
#pragma unroll
    for (int i = 0; i < 8; ++i)
#pragma unroll
        for (int j = 0; j < 8; ++j) y2[i][j] = (f32x2v){0.f, 0.f};
    {
        const int t = l >> 3;
        const LAS unsigned* srt = sorted_w + t * 128; const LAS float* wv = hbuf + t * 128;
        v4u bA[8], bB[8];
#define RND_AXPY(buf, r_) do { const float w = wv[(r_)]; const f32x2v w2 = (f32x2v){w, w}; \
            _Pragma("unroll") for (int i = 0; i < 8; ++i) { asm volatile("" : "+v"(buf[i])); _Pragma("unroll") for (int q = 0; q < 4; ++q) { \
                const f32x2v lo_ = __builtin_amdgcn_cvt_pk_f32_fp8((int)buf[i][q], false), hi_ = __builtin_amdgcn_cvt_pk_f32_fp8((int)buf[i][q], true); \
                y2[i][2 * q] = w2 * lo_ + y2[i][2 * q]; y2[i][2 * q + 1] = w2 * hi_ + y2[i][2 * q + 1]; } } } while (0)
        RND_LOAD(V, bA, srt[0]);
#pragma unroll 1
        for (int r = 0; r < 128; r += 2) {
            RND_LOAD(V, bB, srt[r + 1]);
            RND_AXPY(bA, r);
            RND_LOAD(V, bA, srt[(r + 2) & 127]);
            RND_AXPY(bB, r + 1);
        }
#undef RND_AXPY
    }
#undef RND_LOAD
    asm volatile("" : "+v"(l));
    {
        const int t = l >> 3, s = l & 7;
        const bf16* hrow = (const bf16*)(C.ws + WS_HB) + (size_t)(tokw + t) * 1024 + 16 * s;
        float* hout = (DRY ? (float*)(C.ws + WS_OF) : C.out) + (size_t)(tokw + t) * 1024 + 16 * s;
        bf16* hb = (bf16*)(C.ws + (DRY ? WS_OF : WS_HB)) + (size_t)(tokw + t) * 1024 + 16 * s;
        float s2 = 0.f;
#pragma unroll
        for (int i = 0; i < 8; ++i) { const v4u a = *(const GAS v4u*)(hrow + 128 * i), b = *(const GAS v4u*)(hrow + 128 * i + 8);
            const unsigned hw[8] = {a.x, a.y, a.z, a.w, b.x, b.y, b.z, b.w};
#pragma unroll
            for (int j = 0; j < 8; ++j) { y2[i][j].x += bflo(hw[j]); y2[i][j].y += bfhi(hw[j]); s2 += y2[i][j].x * y2[i][j].x + y2[i][j].y * y2[i][j].y; }
            if (layer == DEPTH - 1) {
#pragma unroll
                for (int q = 0; q < 4; ++q) *(GAS f32x4*)(hout + 128 * i + 4 * q) = (f32x4){y2[i][2 * q].x, y2[i][2 * q].y, y2[i][2 * q + 1].x, y2[i][2 * q + 1].y};
            } else {
                *(GAS v4u*)(hb + 128 * i) = (v4u){pk2(y2[i][0].x, y2[i][0].y), pk2(y2[i][1].x, y2[i][1].y), pk2(y2[i][2].x, y2[i][2].y), pk2(y2[i][3].x, y2[i][3].y)};
                *(GAS v4u*)(hb + 128 * i + 8) = (v4u){pk2(y2[i][4].x, y2[i][4].y), pk2(y2[i][5].x, y2[i][5].y), pk2(y2[i][6].x, y2[i][6].y), pk2(y2[i][7].x, y2[i][7].y)};
            } }
        if (layer < DEPTH - 1) {
            GRP8_SUM(s2);
            const float r2 = rsqrtf(s2 * (1.f / 1024.f) + RMS_EPS);
            const bool wx8 = ((I8MASK >> (layer + 1)) & 1) != 0, wxn = ((layer + 1) % 3 != 2) || !wx8;
            bf16* xo = (bf16*)(C.ws + (DRY ? WS_GLOG : WS_XN)) + (size_t)(tokw + t) * 1024 + 16 * s; float am = 0.f;
#pragma unroll
            for (int i = 0; i < 8; ++i) { unsigned pw[8];
#pragma unroll
                for (int q = 0; q < 4; ++q) { const f32x4 a = *(const GAS f32x4*)(gn + 16 * s + 128 * i + 4 * q);
                    y2[i][2 * q].x *= r2 * a.x; y2[i][2 * q].y *= r2 * a.y; y2[i][2 * q + 1].x *= r2 * a.z; y2[i][2 * q + 1].y *= r2 * a.w;
                    am = fmaxf(fmaxf(am, fmaxf(fabsf(y2[i][2 * q].x), fabsf(y2[i][2 * q].y))), fmaxf(fabsf(y2[i][2 * q + 1].x), fabsf(y2[i][2 * q + 1].y)));
                    pw[2 * q] = pk2(y2[i][2 * q].x, y2[i][2 * q].y); pw[2 * q + 1] = pk2(y2[i][2 * q + 1].x, y2[i][2 * q + 1].y); }
                if (wxn) { *(GAS v4u*)(xo + 128 * i) = (v4u){pw[0], pw[1], pw[2], pw[3]}; *(GAS v4u*)(xo + 128 * i + 8) = (v4u){pw[4], pw[5], pw[6], pw[7]}; } }
            if (wx8) {
            am = DPP_MAX(am, 0xB1, 0xf, 0xf); am = DPP_MAX(am, 0x4E, 0xf, 0xf); am = DPP_MAX(am, 0x141, 0xf, 0xf);
            const float qi = am > 0.f ? 127.f / am : 0.f;
            signed char* xq = (signed char*)(C.ws + (DRY ? WS_GLOG + 32 * MiB : WS_XN8)) + (size_t)(tokw + t) * 1024 + 16 * s;
#pragma unroll
            for (int i = 0; i < 8; ++i) { unsigned pq[4];
#pragma unroll
                for (int q = 0; q < 4; ++q) pq[q] = q8x4(y2[i][2 * q].x * qi, y2[i][2 * q].y * qi, y2[i][2 * q + 1].x * qi, y2[i][2 * q + 1].y * qi);
                *(GAS v4u*)(xq + 128 * i) = (v4u){pq[0], pq[1], pq[2], pq[3]}; }
            if (s == 0) *(GAS float*)((float*)(C.ws + (DRY ? WS_GLOG + 48 * MiB : WS_SX)) + tokw + t) = am * (1.f / 127.f);
            }
        }
    }
}
#ifndef MK_SWEEP
#define MK_SWEEP 2
#endif
template <bool DRY>
__device__ __forceinline__ void peer_topk_gather(const Ctx& C, int layer) {
    LAS int* lexp = (LAS int*)(C.lds + 16384);
    LAS float* lgate = (LAS float*)(C.lds + 16384 + 32768);
    LAS unsigned* sorted = (LAS unsigned*)(C.lds + 16384 + 65536);
    {
        int tid = C.tid; asm volatile("" : "+v"(tid));
        const v4u a0 = *(const GAS v4u*)(C.ws + WS_SU + (size_t)layer * 16384 + tid * 32), a1 = *(const GAS v4u*)(C.ws + WS_SU + (size_t)layer * 16384 + tid * 32 + 16);
        const v4u b0 = *(const GAS v4u*)(C.ws + WS_SV + (size_t)layer * 16384 + tid * 32), b1 = *(const GAS v4u*)(C.ws + WS_SV + (size_t)layer * 16384 + tid * 32 + 16);
        LAS unsigned char* lsc = C.lds + 114688;
        *(LAS v4u*)(lsc + tid * 32) = a0; *(LAS v4u*)(lsc + tid * 32 + 16) = a1; *(LAS v4u*)(lsc + 16384 + tid * 32) = b0; *(LAS v4u*)(lsc + 16384 + tid * 32 + 16) = b1;
    }
    for (int tb = C.vcu; tb < NTOK / 64; tb += C.G) {
#pragma unroll 1
        for (int q = 0; q < 4; ++q) peer_topk_task(C, layer, tb * 64 + (C.wave & 3) * 16, (C.wave >> 2) * 4 + q, (C.wave & 3) * 16, lexp, lgate);
        __syncthreads();
#if MK_SWEEP == 2
        peer_rounds<DRY>(C, layer, tb * 64 + C.wave * 8, lexp + C.wave * 1024, lgate + C.wave * 1024, sorted + C.wave * 1024, (LAS unsigned*)(C.lds + C.wave * 2048));
#elif MK_SWEEP == 1
#error removed variant
        peer_sweep<DRY>(C, layer, tb * 64 + C.wave * 8, lexp + C.wave * 1024, lgate + C.wave * 1024, sorted + C.wave * 1024, (LAS unsigned*)(C.lds + C.wave * 1024));
#else
#pragma unroll 1
        for (int t = 0; t < 8; ++t) peer_gather_token<DRY>(C, layer, tb * 64 + C.wave * 8 + t, lexp + (C.wave * 8 + t) * 128, lgate + (C.wave * 8 + t) * 128);
#endif
        __syncthreads();
    }
}

#ifndef MK_SINGLE
#define MK_SINGLE 1
#endif
#ifndef MK_FASTGEMM
#define MK_FASTGEMM 1
#endif
constexpr int STEPS = 10, NPHASE = 1 + DEPTH * STEPS;
struct Args { const float* in[21]; float* out; unsigned char* ws; int ph_lo, ph_hi; };

template <int EPI>
__device__ __forceinline__ void do_gemm(const Ctx& C, const bf16* A, const bf16* Bt, int N, bf16* Ob, int ldc, int split, const float* rs_in, const float* base, float* outf, bf16* hg, const float* gain, float* rs_out) {
    pg8::Gemm g{A, Bt, NTOK, N, 1024}; pg8::StaticOrder S; S.init(NTOK, N, C.G, C.bx);
    if constexpr (EPI == 0) { pg8::EpiBf16R<false> E{Ob, ldc, split ? 1024 : 0, PSTRIDE, rs_in}; pg8::gemm_phase<pg8::EpiBf16R<false>, pg8::StaticOrder, true, true>(C.lds, g, S, E, C.tid); }
    else if constexpr (EPI == 2) { pg8::EpiBf16R<true> E{Ob, ldc, 0, PSTRIDE, rs_in}; pg8::gemm_phase<pg8::EpiBf16R<true>, pg8::StaticOrder, true, true>(C.lds, g, S, E, C.tid); }
    else if constexpr (EPI == 3) {
        pg8::Gemm g8{A, Bt, NTOK, N, 512}; pg8::EpiI8<false> E{Ob, PSTRIDE, rs_in, gain, nullptr, nullptr, 1.f}; pg8::gemm_phase<pg8::EpiI8<false>, pg8::StaticOrder, true, true>(C.lds, g8, S, E, C.tid); }
    else if constexpr (EPI == 4) {
        pg8::Gemm g8{A, Bt, NTOK, N, 512}; pg8::EpiI8<true> E{Ob, PSTRIDE, rs_in, gain, base, (const float*)outf, FOX_C2}; pg8::gemm_phase<pg8::EpiI8<true>, pg8::StaticOrder, true, true>(C.lds, g8, S, E, C.tid); }
    else {
        bf16* HB = (bf16*)(C.ws + WS_HB); (void)outf;
        if (base) { pg8::EpiResNorm<false> E{base, HB, hg, gain, rs_out}; pg8::gemm_phase<pg8::EpiResNorm<false>, pg8::StaticOrder, true, true>(C.lds, g, S, E, C.tid); }
        else { pg8::EpiResNorm<true> E{HB, HB, hg, gain, rs_out}; pg8::gemm_phase<pg8::EpiResNorm<true>, pg8::StaticOrder, true, true>(C.lds, g, S, E, C.tid); } }
}

template <int STEP, int MIXER>
__device__ __forceinline__ void run_step(const Ctx& C, int layer) {
    const int jx = layer / 3;
    bf16* XN = (bf16*)(C.ws + WS_XN); bf16* P = (bf16*)(C.ws + WS_P); bf16* OB = (bf16*)(C.ws + WS_OB); bf16* Q2 = (bf16*)(C.ws + WS_Q2);
    if constexpr (STEP == 0) {
        const bf16* Wt = MIXER == 0 ? (const bf16*)(C.ws + WS_FOXWIN + (size_t)jx * 8 * MiB) : MIXER == 1 ? (const bf16*)(C.ws + WS_GLAWIN) : (const bf16*)(C.ws + WS_HGRNWIN);
        const float* sw = (const float*)(C.ws + WS_SW) + (MIXER == 0 ? jx * 4096 : MIXER == 1 ? 8192 : 11264);
        if (FOXFUSE && MIXER == 0) { do_gemm<4>(C, (const bf16*)(C.ws + WS_XN8), Wt, 4096, P, 1024, 1, (const float*)(C.ws + WS_SX), C.in[5] + jx * 64, (float*)(C.in[6] + jx * 64), nullptr, sw, nullptr); fox_step1<false>(C, jx); }
        else if ((I8MASK >> layer) & 1) do_gemm<3>(C, (const bf16*)(C.ws + WS_XN8), Wt, MIXER == 1 ? 3072 : 4096, P, 1024, 1, (const float*)(C.ws + WS_SX), nullptr, nullptr, nullptr, sw, nullptr);
        else do_gemm<0>(C, XN, Wt, MIXER == 1 ? 3072 : 4096, P, 1024, 1, nullptr, nullptr, nullptr, nullptr, nullptr, nullptr);
    } else if constexpr (STEP == 1) {
        if constexpr (MIXER == 0) { if (!FOXFUSE) fox_step1<true>(C, jx); }
    } else if constexpr (STEP == 2) {
        if constexpr (MIXER == 1) chunk_prepass<4>(C); else if constexpr (MIXER == 2) chunk_prepass<8>(C);
    } else if constexpr (STEP == 3) {
        if constexpr (MIXER == 0) {
            float gq = 0.f, gk = 0.f;
            for (int i = 0; i < 64; ++i) { gq = fmaxf(gq, fabsf(C.in[5][jx * 64 + i])); gk = fmaxf(gk, fabsf(C.in[6][jx * 64 + i])); }
            const float smax = 64.f * gq * gk * 0.125f * 1.4426950408889634f;
            const attn_body::AttnTensors AT{(const attn_body::bf16*)P, (const attn_body::bf16*)(P + PSTRIDE), (const attn_body::bf16*)(P + 2 * PSTRIDE), (attn_body::bf16*)OB, (const attn_body::bf16*)(P + 3 * PSTRIDE), (const float*)(C.ws + WS_TAIL), -(56.f + 2.f * smax)};
            const attn_body::StaticOrder S(C.G, C.bx);
            attn_body::attn_phase<attn_body::StaticOrder>((char*)C.lds, AT, S, C.tid);
        }
        else if constexpr (MIXER == 1) chunk_recur<4, 256>(C, P + PSTRIDE);
        else chunk_recur<8, 128>(C, P + 2 * PSTRIDE);
    } else if constexpr (STEP == 4) {
        if constexpr (MIXER == 1) rec_norm_gate<256>(C, C.in[11], P + 2 * PSTRIDE);
        else if constexpr (MIXER == 2) rec_norm_gate<128>(C, C.in[15], P + 3 * PSTRIDE);
    } else if constexpr (STEP == 5) {
        const bf16* Wt = MIXER == 0 ? (const bf16*)(C.ws + WS_FOXWOUT) + (size_t)jx * 1024 * 1024 : MIXER == 1 ? (const bf16*)(C.ws + WS_GLAWOUT) : (const bf16*)(C.ws + WS_HGRNWOUT);
        do_gemm<1>(C, OB, Wt, 1024, nullptr, 0, 0, nullptr, layer == 0 ? C.in[0] : nullptr, nullptr, XN, C.in[2] + layer * 1024, (float*)(C.ws + WS_RS));
    } else if constexpr (STEP == 6) {
    } else if constexpr (STEP == 7) {
        do_gemm<2>(C, XN, (const bf16*)(C.ws + WS_PEERWQ) + (size_t)layer * 2048 * 1024, 2048, Q2, 2048, 0, (const float*)(C.ws + WS_RS), nullptr, nullptr, nullptr, nullptr, nullptr);
    } else if constexpr (STEP == 8) {
        peer_topk_gather<false>(C, layer);
    } else if constexpr (STEP == 9) {
    } else if constexpr (STEP == 11) {
        peer_topk_gather<true>(C, layer);
    } else if constexpr (STEP == 12) {
        p0_prologue_b(C);
    } else {
        p0_prologue(C);
    }
}

__device__ __forceinline__ void make_ctx(Ctx& C, const Args& args, unsigned char* lds_raw) {
    C.lds = (LAS unsigned char*)lds_raw;
    C.tid = threadIdx.x; C.lane = C.tid & 63; C.wave = __builtin_amdgcn_readfirstlane(C.tid >> 6);
    C.G = gridDim.x; C.bx = blockIdx.x; { const int bx = blockIdx.x; C.vcu = (C.G % 8 == 0) ? (bx % 8) * (C.G / 8) + bx / 8 : bx; }
    C.gw = C.vcu * NWAVES + C.wave; C.NGW = C.G * NWAVES;
#pragma unroll
    for (int i = 0; i < 21; ++i) C.in[i] = args.in[i];
    C.out = args.out; C.ws = args.ws;
}

template <int STEP, int MIXER>
__global__ void __launch_bounds__(NWAVES * 64, 2) mk_phase(Args args, int layer) {
    extern __shared__ __attribute__((aligned(16))) unsigned char lds_raw[];
    Ctx C; make_ctx(C, args, lds_raw);
    run_step<STEP, MIXER>(C, layer);
}

template <int STEP, int MIXER>
static void launch_phase(const Args& a, int layer, int grid, hipStream_t stream) {
    static bool attr_set = false;
    if (!attr_set) { (void)hipFuncSetAttribute((const void*)mk_phase<STEP, MIXER>, hipFuncAttributeMaxDynamicSharedMemorySize, LDS_BYTES); attr_set = true; }
    hipLaunchKernelGGL((mk_phase<STEP, MIXER>), dim3(grid), dim3(NWAVES * 64), LDS_BYTES, stream, a, layer);
}
#ifndef MK_DUP
#define MK_DUP -1
#endif
#define LP(S, M) do { launch_phase<S, M>(a, layer, grid, stream); if (MK_DUP == S) launch_phase<(S == 8 ? 11 : S), M>(a, layer, grid, stream); } while (0)
template <int MIXER>
static void launch_layer(const Args& a, int layer, int grid, hipStream_t stream) {
    LP(0, MIXER);
    if (MIXER == 0) launch_phase<1, MIXER>(a, layer, grid, stream); else LP(2, MIXER);
    LP(3, MIXER);
    if (MIXER != 0) LP(4, MIXER);
    LP(5, MIXER);
    LP(7, 0);
    LP(8, 0);
}
#if MK_SINGLE
__device__ __forceinline__ const float* tab_ptr(volatile LAS unsigned long long* tab, int i) {
    const unsigned long long v = tab[i];
    const unsigned lo = __builtin_amdgcn_readfirstlane((unsigned)v), hi = __builtin_amdgcn_readfirstlane((unsigned)(v >> 32));
    return (const float*)(const GAS float*)(((unsigned long long)hi << 32) | lo);
}
__device__ __forceinline__ int lane_id_volatile() { int x; asm volatile("v_mbcnt_lo_u32_b32 %0, -1, 0\n\tv_mbcnt_hi_u32_b32 %0, -1, %0" : "=v"(x)); return x; }
__device__ __forceinline__ void make_ctx_opaque(Ctx& C, unsigned char* lds_raw, int wave_s) {
    int bx = blockIdx.x, G = gridDim.x; unsigned ldso = 0u;
    asm volatile("" : "+s"(bx), "+s"(G), "+s"(ldso), "+s"(wave_s));
    int tid = wave_s * 64 + lane_id_volatile();
    C.lds = (LAS unsigned char*)lds_raw + ldso;
    volatile LAS unsigned long long* tab = (volatile LAS unsigned long long*)(C.lds + LDSCTL_OFF);
    C.tid = tid; C.lane = tid & 63; C.wave = __builtin_amdgcn_readfirstlane(tid >> 6);
    C.G = G; C.bx = bx; C.vcu = (G % 8 == 0) ? (bx % 8) * (G / 8) + bx / 8 : bx;
    C.gw = C.vcu * NWAVES + C.wave; C.NGW = G * NWAVES;
#pragma unroll
    for (int i = 0; i < 21; ++i) C.in[i] = tab_ptr(tab, i);
    C.out = (float*)tab_ptr(tab, 21); C.ws = (unsigned char*)tab_ptr(tab, 22);
}
__device__ __forceinline__ void grid_bar(unsigned char* lds_raw, int wave_s) {
    unsigned ldso = 0u; asm volatile("" : "+s"(ldso), "+s"(wave_s));
    LAS unsigned char* lds = (LAS unsigned char*)lds_raw + ldso;
    volatile LAS unsigned long long* tab = (volatile LAS unsigned long long*)(lds + LDSCTL_OFF);
    XcdBarrier b; b.bar = (unsigned*)((unsigned char*)tab_ptr(tab, 22) + WS_CTL) + CW_BAR; b.x = xb_xcc_id(); b.st = (volatile LAS unsigned*)(lds + MISC_OFF) + 8;
    xcd_barrier(b, wave_s == 0 && lane_id_volatile() == 0);
}
#define MK_STEP(...) do { Ctx C; make_ctx_opaque(C, lds_raw, wave_s); __VA_ARGS__; } while (0)
__global__ void __launch_bounds__(NWAVES * 64, 2) mk_fwd(Args args) {
    extern __shared__ __attribute__((aligned(16))) unsigned char lds_raw[];
    const int wave_s = __builtin_amdgcn_readfirstlane(threadIdx.x >> 6);
    for (int u = threadIdx.x; u < (LDS_BYTES - LDSCTL_OFF) / 4; u += NWAVES * 64) ((LAS unsigned*)((LAS unsigned char*)lds_raw + LDSCTL_OFF))[u] = 0u;
    __syncthreads();
    if (threadIdx.x == 0) {
        LAS unsigned long long* tab = (LAS unsigned long long*)((LAS unsigned char*)lds_raw + LDSCTL_OFF);
#pragma unroll
        for (int i = 0; i < 21; ++i) tab[i] = (unsigned long long)args.in[i];
        tab[21] = (unsigned long long)args.out; tab[22] = (unsigned long long)args.ws;
    }
    (void)xcd_barrier_post((unsigned*)(args.ws + WS_CTL) + CW_BAR, (volatile LAS unsigned*)((LAS unsigned char*)lds_raw + MISC_OFF) + 8);
    __syncthreads();
    MK_STEP(p0_prologue(C));
    if (I8_NITEMS) { grid_bar(lds_raw, wave_s); MK_STEP(p0_prologue_b(C)); }
    cg::this_grid().sync();
#pragma unroll 1
    for (int layer = 0; layer < DEPTH; ++layer) {
        const int mixer = layer % 3, jx = layer / 3;
        MK_STEP(const bf16* Wt = mixer == 0 ? (const bf16*)(C.ws + WS_FOXWIN + (size_t)jx * 8 * MiB) : mixer == 1 ? (const bf16*)(C.ws + WS_GLAWIN) : (const bf16*)(C.ws + WS_HGRNWIN);
                const float* sw = (const float*)(C.ws + WS_SW) + (mixer == 0 ? jx * 4096 : mixer == 1 ? 8192 : 11264);
                if (FOXFUSE && mixer == 0) { do_gemm<4>(C, (const bf16*)(C.ws + WS_XN8), Wt, 4096, (bf16*)(C.ws + WS_P), 1024, 1, (const float*)(C.ws + WS_SX), C.in[5] + jx * 64, (float*)(C.in[6] + jx * 64), nullptr, sw, nullptr);
                    fox_step1<false>(C, jx); }
                else if (I8MASK == 15 || (I8MASK != 0 && ((I8MASK >> layer) & 1))) do_gemm<3>(C, (const bf16*)(C.ws + WS_XN8), Wt, mixer == 1 ? 3072 : 4096, (bf16*)(C.ws + WS_P), 1024, 1, (const float*)(C.ws + WS_SX), nullptr, nullptr, nullptr, sw, nullptr);
                else do_gemm<0>(C, (const bf16*)(C.ws + WS_XN), Wt, mixer == 1 ? 3072 : 4096, (bf16*)(C.ws + WS_P), 1024, 1, nullptr, nullptr, nullptr, nullptr, nullptr, nullptr));
        grid_bar(lds_raw, wave_s);
        if (!(FOXFUSE && mixer == 0)) {
        MK_STEP(if (mixer == 0) run_step<1, 0>(C, layer); else if (mixer == 1) run_step<2, 1>(C, layer); else run_step<2, 2>(C, layer));
        grid_bar(lds_raw, wave_s); }
        MK_STEP(if (mixer == 0) run_step<3, 0>(C, layer); else if (mixer == 1) run_step<3, 1>(C, layer); else run_step<3, 2>(C, layer));
        grid_bar(lds_raw, wave_s);
#if RPROBE
        if (mixer != 0) { MK_STEP(if (mixer == 1) chunk_recur<4, 256, RPROBE>(C, (const bf16*)(C.ws + WS_P) + PSTRIDE); else chunk_recur<8, 128, RPROBE>(C, (const bf16*)(C.ws + WS_P) + 2 * PSTRIDE)); grid_bar(lds_raw, wave_s); }
#endif
        if (mixer != 0) { MK_STEP(if (mixer == 1) run_step<4, 1>(C, layer); else run_step<4, 2>(C, layer)); grid_bar(lds_raw, wave_s); }
        MK_STEP(const bf16* Wt = mixer == 0 ? (const bf16*)(C.ws + WS_FOXWOUT) + (size_t)jx * 1024 * 1024 : mixer == 1 ? (const bf16*)(C.ws + WS_GLAWOUT) : (const bf16*)(C.ws + WS_HGRNWOUT);
                do_gemm<1>(C, (const bf16*)(C.ws + WS_OB), Wt, 1024, nullptr, 0, 0, nullptr, layer == 0 ? C.in[0] : nullptr, nullptr, (bf16*)(C.ws + WS_XN), C.in[2] + layer * 1024, (float*)(C.ws + WS_RS)));
        grid_bar(lds_raw, wave_s);
        MK_STEP(run_step<7, 0>(C, layer));
        grid_bar(lds_raw, wave_s);
        MK_STEP(run_step<8, 0>(C, layer));
        if (layer + 1 < DEPTH) grid_bar(lds_raw, wave_s);
    }
}
#endif

extern "C" void kernel_launch(void* const* d_in, const int* in_sizes, int n_in, void* d_out, int out_size, void* d_ws, size_t ws_size, hipStream_t stream) {
    static int grid = 0;
    if (grid == 0) {
        if (n_in != 21 || out_size != NTOK * 1024 || ws_size < WS_END) { fprintf(stderr, "kernel_launch: unexpected shapes: n_in %d out %d ws %zu (need %zu)\n", n_in, out_size, ws_size, (size_t)WS_END); grid = -1; return; }
        int dev = 0, cus = 0, per_cu = 0;
        (void)hipGetDevice(&dev); (void)hipDeviceGetAttribute(&cus, hipDeviceAttributeMultiprocessorCount, dev);
#if MK_SINGLE
        if (hipFuncSetAttribute((const void*)mk_fwd, hipFuncAttributeMaxDynamicSharedMemorySize, LDS_BYTES) != hipSuccess) { fprintf(stderr, "kernel_launch: hipFuncSetAttribute failed\n"); grid = -1; return; }
        if (hipOccupancyMaxActiveBlocksPerMultiprocessor(&per_cu, (const void*)mk_fwd, NWAVES * 64, LDS_BYTES) != hipSuccess || per_cu < 1) { fprintf(stderr, "kernel_launch: occupancy query says %d blocks per CU\n", per_cu); (void)hipGetLastError(); grid = -1; return; }
#endif
        (void)per_cu;
        grid = cus;
    }
    if (grid < 0) return;
    Args a{};
    for (int i = 0; i < 21; ++i) a.in[i] = (const float*)d_in[i];
    a.out = (float*)d_out; a.ws = (unsigned char*)d_ws;
#if MK_SINGLE
    (void)hipMemsetAsync((char*)d_ws + WS_CTL, 0, CTL_ZERO_BYTES, stream);
    a.ph_lo = 0; a.ph_hi = NPHASE;
    void* kargs[] = {&a};
    hipError_t e = hipLaunchCooperativeKernel((const void*)mk_fwd, dim3(grid), dim3(NWAVES * 64), kargs, LDS_BYTES, stream);
    if (e != hipSuccess) fprintf(stderr, "cooperative launch failed: %s (grid %d)\n", hipGetErrorString(e), grid);
#else
    (void)hipMemsetAsync((char*)d_ws + WS_CTL, 0, CTL_ZERO_BYTES, stream);
    launch_phase<10, 0>(a, 0, grid, stream); if (MK_DUP == 10) launch_phase<10, 0>(a, 0, grid, stream);
    launch_phase<12, 0>(a, 0, grid, stream);
    launch_layer<0>(a, 0, grid, stream);
    launch_layer<1>(a, 1, grid, stream);
    launch_layer<2>(a, 2, grid, stream);
    launch_layer<0>(a, 3, grid, stream);
#endif
}
```

```cpp
#include <hip/hip_runtime.h>
#include <hip/hip_cooperative_groups.h>
#include <cstdio>
#include <cstdint>
#include <cmath>
namespace pg8 {
#define PG8_LAS __attribute__((address_space(3)))
typedef unsigned short bf16_t;
typedef short bf16x8 __attribute__((ext_vector_type(8)));
typedef float f32x4 __attribute__((ext_vector_type(4)));
typedef unsigned u32x4 __attribute__((ext_vector_type(4)));
typedef int i32x4 __attribute__((ext_vector_type(4)));
constexpr int BM = 256, BK = 64, HALF = 128, HTB = HALF * BK * 2  , STAGE_BYTES = 8 * HTB, NXCD = 8, WGM = 8;

__host__ __device__ __forceinline__ int lds_byte(int r, int c) { const int st = (r >> 4) * 2 + (c >> 5), rr = r & 15, cc = c & 31, ob = rr * 64 + cc * 2; return st * 1024 + (ob ^ (((ob >> 9) & 1) << 5)); }
__host__ __device__ __forceinline__ void stage_rc(int b, int& R, int& C) { const int st = b / 1024, sb = b % 1024, swz = sb ^ (((sb >> 9) & 1) << 5); R = (st >> 1) * 16 + swz / 64; C = (st & 1) * 32 + (swz % 64) / 2; }
__host__ __device__ __forceinline__ int perm32(int rho) { const int n = rho >> 4, i = rho & 15; return 8 * (i >> 2) + 4 * n + (i & 3); }

struct Unit { int pm, pn; };
struct Gemm { const bf16_t* A; const bf16_t* Bt; int M, N, K; };

struct StaticOrder {
    int nM, nN, nwg, G, c;
    __host__ __device__ void init(int M, int N, int G_, int c_) { nM = M / BM; nN = N / BM; nwg = nM * nN; G = G_; c = c_; }
    __host__ __device__ bool next(int i, Unit& u) const {
        const long L = (long)i * G + c; if (L >= nwg) return false;
        int wgid = (int)L; { const int q = nwg / NXCD, r = nwg % NXCD, xcd = wgid % NXCD, off = wgid / NXCD; wgid = (xcd < r ? xcd * (q + 1) : r * (q + 1) + (xcd - r) * q) + off; }
        const int nig = WGM * nN, gid = wgid / nig, fm = gid * WGM, gsz = (nM - fm) < WGM ? (nM - fm) : WGM;
        u.pm = fm + ((wgid % nig) % gsz); u.pn = (wgid % nig) / gsz; return true;
    }
    __device__ __forceinline__ void a_ready(const Unit&) const {}
    __device__ __forceinline__ void done(const Unit&) const {}
};

__device__ __forceinline__ unsigned cvt_pk_bf16(float lo, float hi) { unsigned r; asm volatile("v_cvt_pk_bf16_f32 %0, %1, %2" : "=v"(r) : "v"(lo), "v"(hi)); return r; }
typedef float f32x2 __attribute__((ext_vector_type(2)));
__device__ __forceinline__ f32x2 gelu_pk(f32x2 v) {
    const f32x2 av = __builtin_elementwise_abs(v), d = av * 0.2316418882f + 1.0f;
    f32x2 t; t.x = __builtin_amdgcn_rcpf(d.x); t.y = __builtin_amdgcn_rcpf(d.y);
    f32x2 q = t * 0.5307027145f + (-0.7265760135f); q = q * t + 0.7107068705f; q = q * t + (-0.142248368f); q = q * t + 0.127414796f; q = q * t;
    const f32x2 s = (v * v) * (-0.72134752044f);
    f32x2 e; e.x = __builtin_amdgcn_exp2f(s.x); e.y = __builtin_amdgcn_exp2f(s.y);
    const f32x2 m = v * (q * e), r = v - m;
    f32x2 o; o.x = v.x < 0.f ? m.x : r.x; o.y = v.y < 0.f ? m.y : r.y; return o;
}
#ifndef EPI_AUX
#define EPI_AUX 16
#endif
template <bool F16  > struct EpiBf16R {
    typedef f32x4 acc_t;
    static constexpr bool PERM = true, AFTER_DRAIN = false;
    bf16_t* O; int ldc; int split_cols; size_t split_stride; const float* rs;
    __device__ __forceinline__ void operator()(const f32x4 (&acc)[2][2][4][2], const Unit& u, int wr, int wc, int fr, int fq) const {
        const int row0 = u.pm * BM + wr * 64 + fr; int colt = u.pn * BM; unsigned boff = 0u;
        if (split_cols) { const int t = colt / split_cols; boff = (unsigned)(t * split_stride * 2); colt -= t * split_cols; }
        const int col0 = colt + wc * 32 + 8 * fq;
        const __amdgpu_buffer_rsrc_t orsrc = __builtin_amdgcn_make_buffer_rsrc((void*)O, (short)0, 0x7ffffff0, 0x00020000);
#pragma unroll
        for (int ai = 0; ai < 2; ++ai)
#pragma unroll
            for (int m = 0; m < 4; ++m) { const int row = row0 + ai * HALF + m * 16; const unsigned roff = boff + (unsigned)(row * ldc + col0) * 2u;
                float sc = 1.f;
                if (rs) {
                    const f32x4 a = *(const f32x4*)(rs + (size_t)row * 16 + 4 * fq); float s = (a[0] + a[1]) + (a[2] + a[3]); const int lane_ = fr + 16 * fq;
                    s += __builtin_bit_cast(float, __builtin_amdgcn_ds_bpermute((lane_ ^ 16) << 2, __builtin_bit_cast(int, s)));
                    s += __builtin_bit_cast(float, __builtin_amdgcn_ds_bpermute((lane_ ^ 32) << 2, __builtin_bit_cast(int, s)));
                    sc = __builtin_amdgcn_rsqf(s * (1.0f / 1024.0f) + 1e-6f); }
#pragma unroll
                for (int bj = 0; bj < 2; ++bj) { const f32x4 v0 = acc[ai][bj][m][0] * sc, v1 = acc[ai][bj][m][1] * sc;
                    u32x4 w;
                    if (F16) { w.x = __builtin_bit_cast(unsigned, __builtin_amdgcn_cvt_pkrtz(v0[0], v0[1])); w.y = __builtin_bit_cast(unsigned, __builtin_amdgcn_cvt_pkrtz(v0[2], v0[3])); w.z = __builtin_bit_cast(unsigned, __builtin_amdgcn_cvt_pkrtz(v1[0], v1[1])); w.w = __builtin_bit_cast(unsigned, __builtin_amdgcn_cvt_pkrtz(v1[2], v1[3])); }
                    else { w.x = cvt_pk_bf16(v0[0], v0[1]); w.y = cvt_pk_bf16(v0[2], v0[3]); w.z = cvt_pk_bf16(v1[0], v1[1]); w.w = cvt_pk_bf16(v1[2], v1[3]); }
                    __builtin_amdgcn_raw_buffer_store_b128(w, orsrc, (int)(roff + bj * HALF * 2), 0, EPI_AUX); } }
    }
};
template <bool QKN> struct EpiI8 {
    typedef i32x4 acc_t;
    static constexpr bool PERM = true, AFTER_DRAIN = false;
    bf16_t* O; size_t split_stride; const float* sx; const float* sw; const float* gq; const float* gk; float c2;
    __device__ __forceinline__ void operator()(const i32x4 (&acc)[2][2][4][2], const Unit& u, int wr, int wc, int fr, int fq) const {
        const int row0 = u.pm * BM + wr * 64 + fr; int colt = u.pn * BM; unsigned boff;
        { const int t = colt / 1024; boff = (unsigned)(t * split_stride * 2); colt -= t * 1024; }
        const __amdgpu_buffer_rsrc_t orsrc = __builtin_amdgcn_make_buffer_rsrc((void*)O, (short)0, 0x7ffffff0, 0x00020000);
        const int scol0 = u.pn * BM + wc * 32 + 8 * fq;
        f32x4 cw[2][2];
#pragma unroll
        for (int bj = 0; bj < 2; ++bj) { cw[bj][0] = *(const f32x4*)(sw + scol0 + bj * HALF); cw[bj][1] = *(const f32x4*)(sw + scol0 + bj * HALF + 4); }
        if (QKN && u.pn < 8) {
            const float* g = u.pn < 4 ? gq : gk; const float cc = u.pn < 4 ? c2 : 1.f; const int lane = fr + 16 * fq;
            f32x4 gv[2][2];
#pragma unroll
            for (int bj = 0; bj < 2; ++bj) { gv[bj][0] = *(const f32x4*)(g + 32 * bj + 8 * fq) * cc; gv[bj][1] = *(const f32x4*)(g + 32 * bj + 8 * fq + 4) * cc; }
            const int col0 = colt + 64 * wc + 8 * fq;
#pragma unroll
            for (int ai = 0; ai < 2; ++ai)
#pragma unroll
                for (int m = 0; m < 4; ++m) { const int row = row0 + ai * HALF + m * 16; const unsigned roff = boff + (unsigned)(row * 1024 + col0) * 2u; const float rs = sx[row];
                    f32x4 v[2][2]; float ss = 0.f;
#pragma unroll
                    for (int bj = 0; bj < 2; ++bj) { const i32x4 a0 = acc[ai][bj][m][0], a1 = acc[ai][bj][m][1];
                        v[bj][0] = (f32x4){(float)a0[0], (float)a0[1], (float)a0[2], (float)a0[3]} * cw[bj][0] * rs; v[bj][1] = (f32x4){(float)a1[0], (float)a1[1], (float)a1[2], (float)a1[3]} * cw[bj][1] * rs;
                        ss += ((v[bj][0][0] * v[bj][0][0] + v[bj][0][1] * v[bj][0][1]) + (v[bj][0][2] * v[bj][0][2] + v[bj][0][3] * v[bj][0][3])) + ((v[bj][1][0] * v[bj][1][0] + v[bj][1][1] * v[bj][1][1]) + (v[bj][1][2] * v[bj][1][2] + v[bj][1][3] * v[bj][1][3])); }
                    ss += __builtin_bit_cast(float, __builtin_amdgcn_ds_bpermute((lane ^ 16) << 2, __builtin_bit_cast(int, ss)));
                    ss += __builtin_bit_cast(float, __builtin_amdgcn_ds_bpermute((lane ^ 32) << 2, __builtin_bit_cast(int, ss)));
                    const float r = __builtin_amdgcn_rsqf(ss * (1.f / 64.f) + 1e-6f);
#pragma unroll
                    for (int bj = 0; bj < 2; ++bj) { const f32x4 o0 = v[bj][0] * r * gv[bj][0], o1 = v[bj][1] * r * gv[bj][1];
                        u32x4 w; w.x = cvt_pk_bf16(o0[0], o0[1]); w.y = cvt_pk_bf16(o0[2], o0[3]); w.z = cvt_pk_bf16(o1[0], o1[1]); w.w = cvt_pk_bf16(o1[2], o1[3]);
                        __builtin_amdgcn_raw_buffer_store_b128(w, orsrc, (int)(roff + bj * 32 * 2), 0, EPI_AUX); } }
            return;
        }
        const int col0 = colt + wc * 32 + 8 * fq;
#pragma unroll
        for (int ai = 0; ai < 2; ++ai)
#pragma unroll
            for (int m = 0; m < 4; ++m) { const int row = row0 + ai * HALF + m * 16; const unsigned roff = boff + (unsigned)(row * 1024 + col0) * 2u; const float rs = sx[row];
#pragma unroll
                for (int bj = 0; bj < 2; ++bj) { const i32x4 a0 = acc[ai][bj][m][0], a1 = acc[ai][bj][m][1];
                    const f32x4 v0 = (f32x4){(float)a0[0], (float)a0[1], (float)a0[2], (float)a0[3]} * cw[bj][0] * rs, v1 = (f32x4){(float)a1[0], (float)a1[1], (float)a1[2], (float)a1[3]} * cw[bj][1] * rs;
                    u32x4 w; w.x = cvt_pk_bf16(v0[0], v0[1]); w.y = cvt_pk_bf16(v0[2], v0[3]); w.z = cvt_pk_bf16(v1[0], v1[1]); w.w = cvt_pk_bf16(v1[2], v1[3]);
                    __builtin_amdgcn_raw_buffer_store_b128(w, orsrc, (int)(roff + bj * HALF * 2), 0, EPI_AUX); } }
    }
};
template <bool BASE16> struct EpiResNorm {
    typedef f32x4 acc_t;
    static constexpr bool PERM = true, AFTER_DRAIN = false;
    const void* base; bf16_t* out; bf16_t* hg; const float* gain; float* rs;
    __device__ __forceinline__ void operator()(const f32x4 (&acc)[2][2][4][2], const Unit& u, int wr, int wc, int fr, int fq) const {
        const int col0 = u.pn * BM + wc * 32 + 8 * fq, lane = fr + 16 * fq;
        f32x4 gv[2][2];
#pragma unroll
        for (int bj = 0; bj < 2; ++bj)
#pragma unroll
            for (int n = 0; n < 2; ++n) gv[bj][n] = *(const f32x4*)(gain + col0 + bj * HALF + n * 4);
#pragma unroll
        for (int ai = 0; ai < 2; ++ai)
#pragma unroll
            for (int m = 0; m < 4; ++m) { const int r = ai * HALF + wr * 64 + m * 16 + fr; const size_t off = (size_t)(u.pm * BM + r) * 1024 + col0;
                float ss = 0.f;
#pragma unroll
                for (int bj = 0; bj < 2; ++bj) { f32x4 b0, b1;
                    if (BASE16) { const u32x4 bw = *(const u32x4*)((const bf16_t*)base + off + bj * HALF);
                        b0 = (f32x4){__builtin_bit_cast(float, bw.x << 16), __builtin_bit_cast(float, bw.x & 0xffff0000u), __builtin_bit_cast(float, bw.y << 16), __builtin_bit_cast(float, bw.y & 0xffff0000u)};
                        b1 = (f32x4){__builtin_bit_cast(float, bw.z << 16), __builtin_bit_cast(float, bw.z & 0xffff0000u), __builtin_bit_cast(float, bw.w << 16), __builtin_bit_cast(float, bw.w & 0xffff0000u)}; }
                    else { b0 = *(const f32x4*)((const float*)base + off + bj * HALF); b1 = *(const f32x4*)((const float*)base + off + bj * HALF + 4); }
                    const f32x4 o0 = b0 + acc[ai][bj][m][0], o1 = b1 + acc[ai][bj][m][1];
                    u32x4 wo; wo.x = cvt_pk_bf16(o0[0], o0[1]); wo.y = cvt_pk_bf16(o0[2], o0[3]); wo.z = cvt_pk_bf16(o1[0], o1[1]); wo.w = cvt_pk_bf16(o1[2], o1[3]);
                    *(u32x4*)(out + off + bj * HALF) = wo;
                    ss += ((o0[0] * o0[0] + o0[1] * o0[1]) + (o0[2] * o0[2] + o0[3] * o0[3])) + ((o1[0] * o1[0] + o1[1] * o1[1]) + (o1[2] * o1[2] + o1[3] * o1[3]));
                    const f32x4 h0 = o0 * gv[bj][0], h1 = o1 * gv[bj][1];
                    u32x4 w; w.x = cvt_pk_bf16(h0[0], h0[1]); w.y = cvt_pk_bf16(h0[2], h0[3]); w.z = cvt_pk_bf16(h1[0], h1[1]); w.w = cvt_pk_bf16(h1[2], h1[3]);
                    *(u32x4*)(hg + off + bj * HALF) = w; }
                ss += __builtin_bit_cast(float, __builtin_amdgcn_ds_bpermute((lane ^ 16) << 2, __builtin_bit_cast(int, ss)));
                ss += __builtin_bit_cast(float, __builtin_amdgcn_ds_bpermute((lane ^ 32) << 2, __builtin_bit_cast(int, ss)));
                if (fq == 0) rs[(size_t)(u.pm * BM + r) * 16 + u.pn * 4 + wc] = ss; }
    }
};
__device__ __forceinline__ f32x4 mma16(bf16x8 a, bf16x8 b, f32x4 c) { return __builtin_amdgcn_mfma_f32_16x16x32_bf16(a, b, c, 0, 0, 0); }
__device__ __forceinline__ i32x4 mma16(bf16x8 a, bf16x8 b, i32x4 c) { return __builtin_amdgcn_mfma_i32_16x16x64_i8(__builtin_bit_cast(i32x4, a), __builtin_bit_cast(i32x4, b), c, 0, 0, 0); }
template <class Epi, class Sched, bool ALIGN_EPI = false, bool SP2 = false>
__device__ __forceinline__ void gemm_phase(PG8_LAS unsigned char* lds, const Gemm g, const Sched& S, const Epi& E, int tid_in) {
    int tid_ = tid_in; asm volatile("" : "+v"(tid_));
    const int tid = tid_, wid = __builtin_amdgcn_readfirstlane(tid >> 6), lane = tid & 63, wr = wid >> 2, wc = wid & 3, fr = lane & 15, fq = lane >> 4;
    const int K = g.K, nt = K / BK;
    unsigned voffA[2], voffB[2];
#pragma unroll
    for (int i = 0; i < 2; ++i) { int R, C; stage_rc(tid * 16 + i * 8192, R, C); const int Rb = Epi::PERM ? ((R & ~31) + perm32(R & 31)) : R;
        voffA[i] = (unsigned)(R * K + C) * 2u; voffB[i] = (unsigned)(Rb * K + C) * 2u; }
    const size_t kstep = (size_t)(BK * 2);
    const size_t hstep = (size_t)HALF * K * 2;
    const size_t tstep = 2 * hstep;
    const unsigned ldsw = (unsigned)wid * 1024u;
    const int aoff = lds_byte(wr * 64 + fr, fq * 8), boff = lds_byte(wc * 32 + fr, fq * 8);
#define PG8_SA(b, h) (((b) * 2 + (h)) * HTB)
#define PG8_SB(b, h) ((4 + (b) * 2 + (h)) * HTB)
#define PG8_STAGE(bufoff, gbase, voff) do { _Pragma("unroll") for (int _i = 0; _i < 2; ++_i) \
        __builtin_amdgcn_global_load_lds((const unsigned*)((const char*)(gbase) + (voff)[_i]), (PG8_LAS unsigned*)(lds + (bufoff) + ldsw + _i * 8192), 16, 0, 0); } while (0)
#define PG8_LDA(dst, b, h) do { _Pragma("unroll") for (int m = 0; m < 4; ++m) _Pragma("unroll") for (int k = 0; k < 2; ++k) dst[m][k] = *(const PG8_LAS bf16x8*)(lds + PG8_SA(b, h) + aoff + m * 2048 + k * 1024); } while (0)
#define PG8_LDB(dst, b, h) do { _Pragma("unroll") for (int n = 0; n < 2; ++n) _Pragma("unroll") for (int k = 0; k < 2; ++k) dst[n][k] = *(const PG8_LAS bf16x8*)(lds + PG8_SB(b, h) + boff + n * 2048 + k * 1024); } while (0)
#define PG8_MMA(ai, bj, At, Bt) do { __builtin_amdgcn_s_setprio(1); _Pragma("unroll") for (int m = 0; m < 4; ++m) _Pragma("unroll") for (int n = 0; n < 2; ++n) _Pragma("unroll") for (int k = 0; k < 2; ++k) \
        acc[ai][bj][m][n] = mma16(Bt[n][k], At[m][k], acc[ai][bj][m][n]); __builtin_amdgcn_s_setprio(0); } while (0)
#define PG8_WAIT_V(n) asm volatile("s_waitcnt vmcnt(" #n ")" ::: "memory")
#define PG8_WAIT_L(n) asm volatile("s_waitcnt lgkmcnt(" #n ")" ::: "memory")
#define PG8_BAR __builtin_amdgcn_s_barrier()
#define PG8_SCHED __builtin_amdgcn_sched_barrier(0)
    Unit cur, nxt; int ui = 0;
    if (!S.next(0, cur)) return;
    typedef typename Epi::acc_t acc_t;
    acc_t acc[2][2][4][2];
#pragma unroll
    for (int a = 0; a < 2; ++a)
#pragma unroll
        for (int b = 0; b < 2; ++b)
#pragma unroll
            for (int m = 0; m < 4; ++m)
#pragma unroll
                for (int n = 0; n < 2; ++n) acc[a][b][m][n] = (acc_t){0, 0, 0, 0};
    bf16x8 At[4][2], B0[2][2], B1[2][2];
    const char* cA = (const char*)g.A + (size_t)cur.pm * tstep; const char* cB = (const char*)g.Bt + (size_t)cur.pn * tstep;
    S.a_ready(cur);
    if constexpr (SP2) {
        PG8_STAGE(PG8_SB(0, 0), cB, voffB); PG8_STAGE(PG8_SB(0, 1), cB + hstep, voffB); PG8_STAGE(PG8_SA(0, 0), cA, voffA); PG8_STAGE(PG8_SA(0, 1), cA + hstep, voffA);
        if (wr == 1) PG8_BAR;
        PG8_WAIT_V(2); PG8_BAR;
        PG8_STAGE(PG8_SB(1, 0), cB + kstep, voffB); PG8_STAGE(PG8_SA(1, 0), cA + kstep, voffA); PG8_STAGE(PG8_SB(1, 1), cB + hstep + kstep, voffB);
        PG8_WAIT_V(6); PG8_BAR;
    } else {
        PG8_STAGE(PG8_SB(0, 0), cB, voffB); PG8_STAGE(PG8_SA(0, 0), cA, voffA); PG8_STAGE(PG8_SB(0, 1), cB + hstep, voffB); PG8_STAGE(PG8_SA(0, 1), cA + hstep, voffA);
        if (wr == 1) PG8_BAR;
        PG8_WAIT_V(4); PG8_BAR;
        PG8_STAGE(PG8_SB(1, 0), cB + kstep, voffB); PG8_STAGE(PG8_SA(1, 0), cA + kstep, voffA); PG8_STAGE(PG8_SB(1, 1), cB + hstep + kstep, voffB);
        PG8_WAIT_V(6); PG8_BAR;
    }
    for (;;) {
        const bool has_next = S.next(ui + 1, nxt);
        const char* nA = has_next ? (const char*)g.A + (size_t)nxt.pm * tstep : cA; const char* nB = has_next ? (const char*)g.Bt + (size_t)nxt.pn * tstep : cB;
        for (int t = 0; t < nt; t += 2) {
            const bool last = (t == nt - 2);
            const char* a1 = cA + (size_t)(t + 1) * kstep;
            const char* a2 = last ? nA : cA + (size_t)(t + 2) * kstep; const char* b2 = last ? nB : cB + (size_t)(t + 2) * kstep;
            const char* a3 = a2 + kstep; const char* b3 = b2 + kstep;
            if (last && has_next) S.a_ready(nxt);
            if constexpr (SP2) {
            PG8_LDB(B0, 0, 0); PG8_LDB(B1, 0, 1); PG8_SCHED; PG8_LDA(At, 0, 0); PG8_STAGE(PG8_SA(1, 1), a1 + hstep, voffA);
            PG8_WAIT_V(8); PG8_WAIT_L(0); PG8_BAR; PG8_MMA(0, 0, At, B0); PG8_MMA(0, 1, At, B1); PG8_BAR; PG8_SCHED;
            PG8_LDA(At, 0, 1); PG8_STAGE(PG8_SB(0, 0), b2, voffB); PG8_STAGE(PG8_SB(0, 1), b2 + hstep, voffB); PG8_STAGE(PG8_SA(0, 0), a2, voffA);
            PG8_WAIT_V(8); PG8_WAIT_L(0); PG8_BAR; PG8_MMA(1, 0, At, B0); PG8_MMA(1, 1, At, B1); PG8_BAR; PG8_SCHED;
            PG8_LDB(B0, 1, 0); PG8_LDB(B1, 1, 1); PG8_SCHED; PG8_LDA(At, 1, 0); PG8_STAGE(PG8_SA(0, 1), a2 + hstep, voffA);
            PG8_WAIT_V(8); PG8_WAIT_L(0); PG8_BAR; PG8_MMA(0, 0, At, B0); PG8_MMA(0, 1, At, B1); PG8_BAR; PG8_SCHED;
            PG8_LDA(At, 1, 1); PG8_STAGE(PG8_SB(1, 0), b3, voffB); PG8_STAGE(PG8_SB(1, 1), b3 + hstep, voffB); PG8_STAGE(PG8_SA(1, 0), a3, voffA);
            PG8_WAIT_V(8); PG8_WAIT_L(0); PG8_BAR; PG8_MMA(1, 0, At, B0); PG8_MMA(1, 1, At, B1); PG8_BAR; PG8_SCHED;
            } else {
            PG8_LDB(B0, 0, 0); PG8_SCHED; PG8_LDA(At, 0, 0); PG8_STAGE(PG8_SA(1, 1), a1 + hstep, voffA);
            PG8_WAIT_L(8); PG8_BAR; PG8_WAIT_L(0); PG8_MMA(0, 0, At, B0); PG8_BAR; PG8_SCHED;
            PG8_LDB(B1, 0, 1); PG8_STAGE(PG8_SB(0, 0), b2, voffB);
            PG8_BAR; PG8_WAIT_L(0); PG8_MMA(0, 1, At, B1); PG8_BAR;
            PG8_LDA(At, 0, 1); PG8_STAGE(PG8_SA(0, 0), a2, voffA);
            PG8_BAR; PG8_WAIT_L(0); PG8_MMA(1, 0, At, B0); PG8_BAR; PG8_SCHED;
            PG8_STAGE(PG8_SB(0, 1), b2 + hstep, voffB);
            PG8_WAIT_V(6); PG8_BAR; PG8_MMA(1, 1, At, B1); PG8_BAR;
            PG8_LDB(B0, 1, 0); PG8_SCHED; PG8_LDA(At, 1, 0); PG8_STAGE(PG8_SA(0, 1), a2 + hstep, voffA);
            PG8_WAIT_L(8); PG8_BAR; PG8_WAIT_L(0); PG8_MMA(0, 0, At, B0); PG8_BAR; PG8_SCHED;
            PG8_LDB(B1, 1, 1); PG8_STAGE(PG8_SB(1, 0), b3, voffB);
            PG8_BAR; PG8_WAIT_L(0); PG8_MMA(0, 1, At, B1); PG8_BAR;
            PG8_LDA(At, 1, 1); PG8_STAGE(PG8_SA(1, 0), a3, voffA);
            PG8_BAR; PG8_WAIT_L(0); PG8_MMA(1, 0, At, B0); PG8_BAR; PG8_SCHED;
            PG8_STAGE(PG8_SB(1, 1), b3 + hstep, voffB);
            PG8_WAIT_V(6); PG8_BAR; PG8_MMA(1, 1, At, B1); PG8_BAR;
            }
        }
        if constexpr (ALIGN_EPI) { if (wr == 0) PG8_BAR; }
        if constexpr (!Epi::AFTER_DRAIN) { E(acc, cur, wr, wc, fr, fq); S.done(cur); }
        if (!has_next) break;
#pragma unroll
        for (int a = 0; a < 2; ++a)
#pragma unroll
            for (int b = 0; b < 2; ++b)
#pragma unroll
                for (int m = 0; m < 4; ++m)
#pragma unroll
                    for (int n = 0; n < 2; ++n) acc[a][b][m][n] = (acc_t){0, 0, 0, 0};
        cur = nxt; cA = nA; cB = nB; ++ui;
        if constexpr (ALIGN_EPI) { if (wr == 1) PG8_BAR; }
    }
    PG8_WAIT_V(0);
    if constexpr (!ALIGN_EPI) { if (wr == 0) PG8_BAR; }
    PG8_BAR;
    if constexpr (Epi::AFTER_DRAIN) { E.fused(acc, cur, wr, wc, fr, fq, lds, wid, lane); S.done(cur); }
#undef PG8_SA
#undef PG8_SB
#undef PG8_STAGE
#undef PG8_LDA
#undef PG8_LDB
#undef PG8_MMA
#undef PG8_WAIT_V
#undef PG8_WAIT_L
#undef PG8_BAR
#undef PG8_SCHED
}
}
#include <hip/hip_bf16.h>
#include <cmath>
namespace attn_body {
using bf16=__hip_bfloat16;
using bf16x8=__attribute__((ext_vector_type(8)))short;
using s16x4=__attribute__((ext_vector_type(4)))short;
using f32x16=__attribute__((ext_vector_type(16)))float;
using u32x4=__attribute__((ext_vector_type(4)))unsigned;
constexpr int BATCH=8,NHEAD=16,SEQ=2048,D=64,DM=NHEAD*D;
constexpr int NW=8,QBLK=32,QB=QBLK*NW,KVBLK=64,NQB=SEQ/QB;
constexpr int ATTN_PITCH=DM, ATTN_UNIT_ROWS=QB;
__device__ __forceinline__ int crow(int r,int hi){return (r&3)+8*(r>>2)+4*hi;}
#define SBAR() __builtin_amdgcn_sched_barrier(0)
__device__ __forceinline__ void cmask(f32x16&p0,f32x16&p1,int jb,int qrel,int hi){
  const float NEG=-INFINITY; int kb=64*jb+4*hi;
  #pragma unroll
  for(int r=0;r<16;++r){int kv=kb+(r&3)+8*(r>>2); if(kv>qrel)p0[r]=NEG; if(kv+32>qrel)p1[r]=NEG;}
}

constexpr int NSLOT=3, SLOTB=8192;
constexpr int LDS_K=0, LDS_V=NSLOT*SLOTB, LDS_WS=2*NSLOT*SLOTB, LDS_OST=LDS_WS+NW*64*4, LDS_CS=LDS_OST+NW*4096, LDS_BYTES=LDS_CS+SEQ*4;
constexpr float C2=0.125f*1.4426950408889634f;
__device__ __forceinline__ void glds16(const void*gsrc,unsigned lds_dst){unsigned keep;
  asm volatile("s_mov_b32 %0, m0\n\ts_mov_b32 m0, %2\n\ts_nop 0\n\tglobal_load_lds_dwordx4 %1, off\n\ts_mov_b32 m0, %0":"=&s"(keep):"v"(gsrc),"s"(lds_dst):"memory");}
__device__ __forceinline__ float max3f(float a,float b,float c){float r;asm("v_max3_f32 %0, %1, %2, %3":"=v"(r):"v"(a),"v"(b),"v"(c));return r;}
__device__ __forceinline__ float max2f(float a,float b){float r;asm("v_max_f32_e32 %0, %1, %2":"=v"(r):"v"(a),"v"(b));return r;}
__device__ __forceinline__ float fadd_s(float a,float b){float r;asm("v_add_f32_e32 %0, %1, %2":"=v"(r):"v"(a),"v"(b));return r;}
__device__ __forceinline__ float fsub_s(float a,float b){float r;asm("v_sub_f32_e32 %0, %1, %2":"=v"(r):"v"(a),"v"(b));return r;}
typedef float f32x2_t __attribute__((ext_vector_type(2))); typedef __bf16 bf16x2_t __attribute__((ext_vector_type(2)));
__device__ __forceinline__ unsigned cvtpk_s(float lo,float hi){f32x2_t v={lo,hi};bf16x2_t b=__builtin_convertvector(v,bf16x2_t);return __builtin_bit_cast(unsigned,b);}
#define WAIT_BAR(N) asm volatile("s_waitcnt vmcnt(" #N ") lgkmcnt(0)\n\ts_barrier":::"memory")

typedef __attribute__((address_space(3))) const char* lds_cptr;
__device__ __forceinline__ void qkt(f32x16&p0,f32x16&p1,const char*Kslot,lds_cptr qls,bf16x8 ax0,bf16x8 ax1,bf16x8 qx,int r32,int hi){
  const char*kb=Kslot+hi*1024+r32*16; const f32x16 z16=f32x16{};
  p0=__builtin_amdgcn_mfma_f32_32x32x16_bf16(ax0,qx,z16,0,0,0);p1=__builtin_amdgcn_mfma_f32_32x32x16_bf16(ax1,qx,z16,0,0,0);
  #pragma unroll
  for(int d0=0;d0<4;++d0){
    const bf16x8 b0=*reinterpret_cast<const bf16x8*>(kb+d0*2048);
    const bf16x8 b1=*reinterpret_cast<const bf16x8*>(kb+d0*2048+512);
    const bf16x8 qd=*(const __attribute__((address_space(3))) bf16x8*)(qls+d0*1024);
    p0=__builtin_amdgcn_mfma_f32_32x32x16_bf16(b0,qd,p0,0,0,0);p1=__builtin_amdgcn_mfma_f32_32x32x16_bf16(b1,qd,p1,0,0,0);}
}
typedef short v4i16_t __attribute__((ext_vector_type(4)));
__device__ __forceinline__ void kload8(bf16x8*kf,lds_cptr kp){
  kf[0]=*(const __attribute__((address_space(3))) bf16x8*)(kp);      kf[1]=*(const __attribute__((address_space(3))) bf16x8*)(kp+512);
  kf[2]=*(const __attribute__((address_space(3))) bf16x8*)(kp+2048); kf[3]=*(const __attribute__((address_space(3))) bf16x8*)(kp+2560);
  kf[4]=*(const __attribute__((address_space(3))) bf16x8*)(kp+4096); kf[5]=*(const __attribute__((address_space(3))) bf16x8*)(kp+4608);
  kf[6]=*(const __attribute__((address_space(3))) bf16x8*)(kp+6144); kf[7]=*(const __attribute__((address_space(3))) bf16x8*)(kp+6656);
}
__device__ __forceinline__ void kload2(bf16x8*kf,lds_cptr kp,int j){ kf[2*j]=*(const __attribute__((address_space(3))) bf16x8*)(kp+j*2048); kf[2*j+1]=*(const __attribute__((address_space(3))) bf16x8*)(kp+j*2048+512); }
__device__ __forceinline__ s16x4 vtr(lds_cptr p){ return __builtin_bit_cast(s16x4,__builtin_amdgcn_ds_read_tr16_b64_v4i16((__attribute__((address_space(3))) v4i16_t*)p)); }
__device__ __forceinline__ float rowmax(const f32x16&p0,const f32x16&p1){
  float a=max3f(p0[0],p0[1],p1[0]),b=max3f(p0[2],p0[3],p1[1]);a=max3f(a,p1[2],p1[3]);
  #pragma unroll
  for(int r=4;r<16;r+=4){a=max3f(a,p0[r],p0[r+1]);b=max3f(b,p0[r+2],p0[r+3]);a=max3f(a,p1[r],p1[r+1]);b=max3f(b,p1[r+2],p1[r+3]);}
  const float m=max2f(a,b);
  auto rr=__builtin_amdgcn_permlane32_swap(__float_as_uint(m),__float_as_uint(m),false,false);
  return max2f(__uint_as_float(rr[0]),__uint_as_float(rr[1]));
}
__device__ __forceinline__ void pv(f32x16*o,int vb,bf16x8 pa0,bf16x8 pa1,bf16x8 pa2,bf16x8 pa3){
  #pragma unroll
  for(int d0=0;d0<2;++d0){s16x4 lo[4],hi[4];
    #pragma unroll
    for(int ks=0;ks<4;++ks){
      asm volatile("ds_read_b64_tr_b16 %0,%1 offset:%c2":"=&v"(lo[ks]):"v"(vb),"i"(d0*4096+ks*1024):"memory");
      asm volatile("ds_read_b64_tr_b16 %0,%1 offset:%c2":"=&v"(hi[ks]):"v"(vb),"i"(d0*4096+ks*1024+512):"memory");}
    asm volatile("s_waitcnt lgkmcnt(0)":::"memory");SBAR();
    #define PK(k) (bf16x8){lo[k][0],lo[k][1],lo[k][2],lo[k][3],hi[k][0],hi[k][1],hi[k][2],hi[k][3]}
    o[d0]=__builtin_amdgcn_mfma_f32_32x32x16_bf16(pa0,PK(0),o[d0],0,0,0);
    o[d0]=__builtin_amdgcn_mfma_f32_32x32x16_bf16(pa1,PK(1),o[d0],0,0,0);
    o[d0]=__builtin_amdgcn_mfma_f32_32x32x16_bf16(pa2,PK(2),o[d0],0,0,0);
    o[d0]=__builtin_amdgcn_mfma_f32_32x32x16_bf16(pa3,PK(3),o[d0],0,0,0);
    #undef PK
  }
}

__device__ __forceinline__ void split3(float c,unsigned&hb,unsigned&mb,unsigned&lb){
  hb=__float_as_uint(c)&0xffff0000u; const float r1=c-__uint_as_float(hb); mb=__float_as_uint(r1)&0xffff0000u; const float r2=r1-__uint_as_float(mb); lb=__float_as_uint(r2)&0xffff0000u; }
__device__ __forceinline__ bf16x8 make_ax(float negc){ unsigned hb,mb,lb; split3(negc,hb,mb,lb);
  u32x4 w; w.x=(hb>>16)|mb; w.y=(lb>>16)|0x3f800000u; w.z=0x3f803f80u; w.w=0u; return __builtin_bit_cast(bf16x8,w); }
__device__ __forceinline__ bf16x8 make_qx(float negm,unsigned hm){ unsigned hb,mb,lb; split3(negm,hb,mb,lb);
  u32x4 w; w.x=0x3f803f80u&hm; w.y=(0x3f80u|hb)&hm; w.z=((mb>>16)|lb)&hm; w.w=0u; return __builtin_bit_cast(bf16x8,w); }
#ifndef ATTN_STORE16
#define ATTN_STORE16(p,v) (*(u32x4*)(p)=(v))
#endif
template<int THRL> __device__ __forceinline__ void attn_unit(int b,int h,int qb,const bf16*Q,const bf16*__restrict__ K,const bf16*__restrict__ V,bf16*O,const bf16*__restrict__ Gt,char*shm,const int tid_u,const float skip_thr){
  int tid=tid_u; asm volatile("":"+v"(tid));
  const int lane=tid&63,r32=lane&31,hi=lane>>5; const int wid=__builtin_amdgcn_readfirstlane(tid>>6);
  const long rowbase=(long)b*SEQ; const int q0=qb*QB;
  const bf16*Qw=Q+(rowbase+q0+wid*QBLK)*DM+h*D;
  float*csp=(float*)(shm+LDS_CS);
  int tskip=0;
  { const float cq0=csp[q0]; const int ntall=(q0+QB)/KVBLK; while(tskip+2<=ntall-4 && csp[KVBLK*(tskip+1)+KVBLK-1]-cq0<skip_thr)tskip+=2; tskip=__builtin_amdgcn_readfirstlane(tskip); }
  const bf16*Kh=K+(rowbase+(long)tskip*KVBLK)*DM+h*D,*Vh=V+(rowbase+(long)tskip*KVBLK)*DM+h*D;
  const unsigned lds0=(unsigned)(uintptr_t)shm;
  float*wsf=(float*)(shm+LDS_WS)+wid*64;
  const unsigned koff=(unsigned)(lane*DM+wid*8), voff=(unsigned)((16*(wid&3)+(lane>>2))*DM+(wid>>2)*32+(lane&3)*8);
  const unsigned kdst=lds0+LDS_K+wid*1024, vdst=lds0+LDS_V+wid*1024;
  #define DMA_K(t,slot) do{unsigned o_=koff;asm volatile("":"+v"(o_));glds16(Kh+(long)(t)*KVBLK*DM+o_,(unsigned)__builtin_amdgcn_readfirstlane(kdst+(slot)));}while(0)
  #define DMA_V(t,slot) do{unsigned o_=voff;asm volatile("":"+v"(o_));glds16(Vh+(long)(t)*KVBLK*DM+o_,(unsigned)__builtin_amdgcn_readfirstlane(vdst+(slot)));}while(0)
  const int vb0=(int)(lds0+LDS_V)+((lane>>4)&1)*32+(lane&3)*8+(4*hi+((lane&15)>>2))*64;
  const char*Kbase=shm+LDS_K; bf16x8 kf[8];
  const lds_cptr shm3=(lds_cptr)shm; const lds_cptr kp0=shm3+LDS_K+hi*1024+r32*16; const lds_cptr vp0=shm3+LDS_V+((lane>>4)&1)*32+(lane&3)*8+(4*hi+((lane&15)>>2))*64;
  const int NT=(q0+QB)/KVBLK-tskip;
  const float*cst=csp+tskip*KVBLK;
  const unsigned hm=hi?0u:0xffffffffu;
  DMA_K(0,0);DMA_V(0,0);DMA_K(1,SLOTB);
  const lds_cptr qls=shm3+LDS_OST+wid*4096+hi*512+r32*16;
  { bf16x8 qr[4];
    #pragma unroll
    for(int d0=0;d0<4;++d0)qr[d0]=*reinterpret_cast<const bf16x8*>(&Qw[(long)r32*DM+d0*16+hi*8]);
    #pragma unroll
    for(int d0=0;d0<4;++d0)*(__attribute__((address_space(3))) bf16x8*)(shm3+LDS_OST+wid*4096+hi*512+r32*16+d0*1024)=qr[d0]; }
  #define QLD(k) (*(const __attribute__((address_space(3))) bf16x8*)(qls+(k)*1024))
  float mhat=csp[q0+wid*QBLK+r32],l_reg=0.f;f32x16 o[2];o[0]=f32x16{};o[1]=f32x16{}; bf16x8 qx=make_qx(-mhat,hm);
  const int qrel=wid*QBLK+r32;
  #define CMASK(P0,P1,t) do{int jb_=(t)-(NT-4); if(jb_>=0)cmask(P0,P1,jb_,qrel,hi);}while(0)
  bool resc=false;
  #define START(P0,P1) do{ const float rm=rowmax(P0,P1); resc=false; \
    if(__any(rm>(float)THRL)){ const float dl=__builtin_fmaxf(rm,0.f); mhat=fadd_s(mhat,dl); \
      _Pragma("unroll") for(int r=0;r<16;++r){P0[r]=fsub_s(P0[r],dl);P1[r]=fsub_s(P1[r],dl);} \
      qx=make_qx(-mhat,hm); } \
    _Pragma("unroll") for(int r=0;r<16;++r)P0[r]=__builtin_amdgcn_exp2f(P0[r]); }while(0)
  #define RESC() do{ if(resc){ asm volatile("s_waitcnt lgkmcnt(0)":::"memory"); \
      _Pragma("unroll") for(int d_=0;d_<2;++d_) _Pragma("unroll") for(int r=0;r<16;++r)o[d_][r]*=wsf[crow(r,hi)]; } }while(0)
  f32x16 pA0,pA1,pB0,pB1;
  int sl_prev=0,sl_cur=0,sl_next=SLOTB;
  #define ROT() do{sl_prev=sl_cur;sl_cur=sl_next;sl_next=(sl_next==(NSLOT-1)*SLOTB)?0:sl_next+SLOTB;}while(0)
  DMA_K(2,2*SLOTB);
  WAIT_BAR(3);
  qkt(pA0,pA1,Kbase,qls,make_ax(cst[r32]),make_ax(cst[32+r32]),qx,r32,hi);asm volatile("s_nop 15\n\ts_nop 7":"+v"(pA0),"+v"(pA1));CMASK(pA0,pA1,0);
  START(pA0,pA1);
  _Pragma("unroll") for(int r=0;r<16;++r)pA1[r]=__builtin_amdgcn_exp2f(pA1[r]);
  WAIT_BAR(0);
  DMA_K(3,0);DMA_V(1,SLOTB);
  ROT();
  kload8(kf,kp0+sl_cur);
  WAIT_BAR(2);
  s16x4 vlo[8],vhi[8]; u32x4 pw0,pw1,pw2,pw3;
  #define PKW(P,B) cvtpk_s(P[B],P[B+1])
  #define PAF(k) __builtin_bit_cast(bf16x8,pw##k)
  #define VFR(i) (bf16x8){vlo[i][0],vlo[i][1],vlo[i][2],vlo[i][3],vhi[i][0],vhi[i][1],vhi[i][2],vhi[i][3]}
  #define PIN(x) asm volatile("":"+v"(x))
  #define MX3(a,b,c) __builtin_fmaxf(__builtin_fmaxf((a),(b)),(c))
  #define GAPA(MF,A0,A1,A2,A3,W0,W1,PW) do{ MF; sacc+=A0; sacc+=A1; sacc+=A2; sacc+=A3; PIN(sacc); W0; W1; PIN(PW); SBAR(); }while(0)
  #define EX(v) __builtin_amdgcn_exp2f(v)
  #define GAPB(MF,X,B) do{ MF; X[B]=EX(X[B]); X[B+1]=EX(X[B+1]); X[B+2]=EX(X[B+2]); X[B+3]=EX(X[B+3]); PIN(X); SBAR(); }while(0)
  #define VRD(i) do{ vlo[i]=vtr(vp_+(((i)>>2)*4096+((i)&3)*1024)); vhi[i]=vtr(vp_+(((i)>>2)*4096+((i)&3)*1024+512)); }while(0)
  #define KRD(G,j) do{ if(G){ kload2(kf,kp0+sl_next,j); SBAR(); } }while(0)
  #define STEP(C0,C1,P0,P1,t,GK,GV,GL) do{ SBAR(); \
    const lds_cptr vp_=vp0+sl_prev; \
    const bf16x8 ax0_=make_ax(cst[(t)*KVBLK+r32]), ax1_=make_ax(cst[(t)*KVBLK+32+r32]); \
    C0=__builtin_amdgcn_mfma_f32_32x32x16_bf16(ax0_,qx,f32x16{},0,0,0); C1=__builtin_amdgcn_mfma_f32_32x32x16_bf16(ax1_,qx,f32x16{},0,0,0); SBAR(); \
    bf16x8 q0_=QLD(0), q1_=QLD(1); \
    VRD(0); SBAR(); float sacc=(P0[0]+P0[1]); \
    GAPA(C0=__builtin_amdgcn_mfma_f32_32x32x16_bf16(kf[0],q0_,C0,0,0,0), P0[2],P0[3],P0[4],P0[5],     pw0[0]=PKW(P0,0), pw0[1]=PKW(P0,2), pw0); \
    VRD(4); SBAR(); GAPA(C1=__builtin_amdgcn_mfma_f32_32x32x16_bf16(kf[1],q0_,C1,0,0,0), P0[6],P0[7],P0[8],P0[9],     pw0[2]=PKW(P0,4), pw0[3]=PKW(P0,6), pw0); q0_=QLD(2); \
    VRD(1); SBAR(); GAPA(C0=__builtin_amdgcn_mfma_f32_32x32x16_bf16(kf[2],q1_,C0,0,0,0),   P0[10],P0[11],P0[12],P0[13], pw1[0]=PKW(P0,8), pw1[1]=PKW(P0,10), pw1); \
    VRD(5); SBAR(); GAPA(C1=__builtin_amdgcn_mfma_f32_32x32x16_bf16(kf[3],q1_,C1,0,0,0),   P0[14],P0[15],P1[0],P1[1],   pw1[2]=PKW(P0,12),pw1[3]=PKW(P0,14), pw1); q1_=QLD(3); \
    VRD(2); SBAR(); GAPA(C0=__builtin_amdgcn_mfma_f32_32x32x16_bf16(kf[4],q0_,C0,0,0,0),   P1[2],P1[3],P1[4],P1[5],     pw2[0]=PKW(P1,0), pw2[1]=PKW(P1,2), pw2); \
    VRD(6); SBAR(); GAPA(C1=__builtin_amdgcn_mfma_f32_32x32x16_bf16(kf[5],q0_,C1,0,0,0),   P1[6],P1[7],P1[8],P1[9],     pw2[2]=PKW(P1,4), pw2[3]=PKW(P1,6), pw2); \
    VRD(3); SBAR(); GAPA(C0=__builtin_amdgcn_mfma_f32_32x32x16_bf16(kf[6],q1_,C0,0,0,0),   P1[10],P1[11],P1[12],P1[13], pw3[0]=PKW(P1,8), pw3[1]=PKW(P1,10), pw3); \
    VRD(7); SBAR(); GAPA(C1=__builtin_amdgcn_mfma_f32_32x32x16_bf16(kf[7],q1_,C1,0,0,0),   P1[14],P1[15],0.f,0.f,       pw3[2]=PKW(P1,12),pw3[3]=PKW(P1,14), pw3); \
    l_reg+=sacc; \
    if(GK){DMA_K((t)+3,sl_cur);} if(GV){DMA_V((t)+1,sl_next);} \
    CMASK(C0,C1,t); \
    { float a=MX3(C0[0],C0[1],C1[0]),b=MX3(C0[2],C0[3],C1[1]); a=MX3(a,C1[2],C1[3]); \
      _Pragma("unroll") for(int r=4;r<16;r+=4){a=MX3(a,C0[r],C0[r+1]);b=MX3(b,C0[r+2],C0[r+3]);a=MX3(a,C1[r],C1[r+1]);b=MX3(b,C1[r+2],C1[r+3]);} \
      float rm=__builtin_fmaxf(a,b); { auto rr=__builtin_amdgcn_permlane32_swap(__float_as_uint(rm),__float_as_uint(rm),false,false); rm=__builtin_fmaxf(__uint_as_float(rr[0]),__uint_as_float(rr[1])); } \
      resc=false; \
      if(__builtin_expect(__any(rm>(float)THRL),0)){ const float dl=__builtin_fmaxf(rm,0.f); mhat+=dl; \
        _Pragma("unroll") for(int r=0;r<16;++r){C0[r]-=dl;C1[r]-=dl;} \
        qx=make_qx(-mhat,hm); \
        const float f=__builtin_amdgcn_exp2f(-dl); l_reg*=f; if(hi==0)wsf[r32]=f; resc=true; } } \
    SBAR(); \
    GAPB(o[0]=__builtin_amdgcn_mfma_f32_32x32x16_bf16(PAF(0),VFR(0),o[0],0,0,0), C0,0); \
    GAPB(o[1]=__builtin_amdgcn_mfma_f32_32x32x16_bf16(PAF(0),VFR(4),o[1],0,0,0), C0,4); \
    KRD(GL,0); GAPB(o[0]=__builtin_amdgcn_mfma_f32_32x32x16_bf16(PAF(1),VFR(1),o[0],0,0,0), C0,8); \
    KRD(GL,1); GAPB(o[1]=__builtin_amdgcn_mfma_f32_32x32x16_bf16(PAF(1),VFR(5),o[1],0,0,0), C0,12); \
    KRD(GL,2); GAPB(o[0]=__builtin_amdgcn_mfma_f32_32x32x16_bf16(PAF(2),VFR(2),o[0],0,0,0), C1,0); \
    KRD(GL,3); GAPB(o[1]=__builtin_amdgcn_mfma_f32_32x32x16_bf16(PAF(2),VFR(6),o[1],0,0,0), C1,4); \
    GAPB(o[0]=__builtin_amdgcn_mfma_f32_32x32x16_bf16(PAF(3),VFR(3),o[0],0,0,0), C1,8); \
    GAPB(o[1]=__builtin_amdgcn_mfma_f32_32x32x16_bf16(PAF(3),VFR(7),o[1],0,0,0), C1,12); \
    }while(0)
  int t=1;
  #undef CMASK
  #define CMASK(P0,P1,t) do{}while(0)
  for(;t+5<NT;t+=2){
    STEP(pB0,pB1,pA0,pA1,t,true,true,true);     WAIT_BAR(2); RESC(); ROT();
    STEP(pA0,pA1,pB0,pB1,t+1,true,true,true);   WAIT_BAR(2); RESC(); ROT();
  }
  #undef CMASK
  #define CMASK(P0,P1,t) do{int jb_=(t)-(NT-4); if(jb_>=0)cmask(P0,P1,jb_,qrel,hi);}while(0)
  #define ENDW(tt) do{ if((tt)+3<NT){WAIT_BAR(2);} else if((tt)+2<NT){WAIT_BAR(1);} else {WAIT_BAR(0);} }while(0)
  for(;t+1<NT;t+=2){
    STEP(pB0,pB1,pA0,pA1,t,(t+3<NT),(t+1<NT),(t+1<NT));       ENDW(t);   RESC(); ROT();
    STEP(pA0,pA1,pB0,pB1,t+1,(t+4<NT),(t+2<NT),(t+2<NT));     ENDW(t+1); RESC(); ROT();
  }
  STEP(pB0,pB1,pA0,pA1,NT-1,false,false,false); RESC();
  { float sacc=pB0[0]+pB0[1]; _Pragma("unroll") for(int r=2;r<16;++r)sacc+=pB0[r]; _Pragma("unroll") for(int r=0;r<16;++r)sacc+=pB1[r]; l_reg+=sacc;
    pw0=(u32x4){PKW(pB0,0),PKW(pB0,2),PKW(pB0,4),PKW(pB0,6)};pw1=(u32x4){PKW(pB0,8),PKW(pB0,10),PKW(pB0,12),PKW(pB0,14)};pw2=(u32x4){PKW(pB1,0),PKW(pB1,2),PKW(pB1,4),PKW(pB1,6)};pw3=(u32x4){PKW(pB1,8),PKW(pB1,10),PKW(pB1,12),PKW(pB1,14)};
    SBAR(); pv(o,vb0+sl_cur,PAF(0),PAF(1),PAF(2),PAF(3)); }
  #undef PKW
  #undef PAF
  #undef VFR
  #undef PIN
  #undef MX3
  #undef GAPA
  #undef GAPB
  #undef EX
  #undef VRD
  #undef KRD
  #undef STEP
  #undef ENDW
  {auto rr=__builtin_amdgcn_permlane32_swap(__float_as_uint(l_reg),__float_as_uint(l_reg),false,false);l_reg=__uint_as_float(rr[0])+__uint_as_float(rr[1]);}
  { int te=tid; asm volatile("":"+v"(te));
    const int lane_e=te&63,r32e=lane_e&31,hie=lane_e>>5;
    if(hie==0)wsf[32+r32e]=l_reg;asm volatile("s_waitcnt lgkmcnt(0)":::"memory");
    float rli[16];
    #pragma unroll
    for(int r=0;r<16;++r)rli[r]=__builtin_amdgcn_rcpf(wsf[32+crow(r,hie)]);
    bf16*Ow=O+(rowbase+q0+wid*QBLK)*DM+h*D; const bf16*Gw=Gt+(rowbase+q0+wid*QBLK)*DM+h*D;
    bf16*stg=(bf16*)(shm+LDS_OST)+wid*2048;
    #pragma unroll
    for(int r=0;r<16;++r){const int orow=crow(r,hie);
      #pragma unroll
      for(int d0=0;d0<2;++d0)stg[orow*64+d0*32+r32e]=__float2bfloat16(o[d0][r]*rli[r]);}
    asm volatile("s_waitcnt lgkmcnt(0)":::"memory");
    #pragma unroll
    for(int i=0;i<4;++i){const int row=i*8+(lane_e>>3),ch=lane_e&7; u32x4 v=*(const u32x4*)(stg+row*64+ch*8); const u32x4 gv=*(const u32x4*)(Gw+(long)row*DM+ch*8);
      #pragma unroll
      for(int e=0;e<4;++e){ const float g0=__uint_as_float(gv[e]<<16),g1=__uint_as_float(gv[e]&0xffff0000u),x0=__uint_as_float(v[e]<<16),x1=__uint_as_float(v[e]&0xffff0000u);
        v[e]=cvtpk_s(x0*__builtin_amdgcn_rcpf(1.f+__expf(-g0)),x1*__builtin_amdgcn_rcpf(1.f+__expf(-g1))); }
      ATTN_STORE16(Ow+(long)row*DM+ch*8,v);} }
  asm volatile("s_waitcnt lgkmcnt(0)\n\ts_barrier":::"memory");
  #undef DMA_K
  #undef QLD
  #undef DMA_V
  #undef CMASK
  #undef START
  #undef RESC
  #undef ROT
}
constexpr int ATTN_LDS_BYTES=LDS_BYTES;
struct AttnTensors { const bf16* Q; const bf16* K; const bf16* V; bf16* O; const bf16* G; const float* CUM; float THR; };
struct AttnUnit { int bh; int qb; };
struct StaticOrder {
  int vcu;
  __device__ __forceinline__ explicit StaticOrder(int grid,int block):vcu((block%8)*(grid/8)+block/8){}
  __device__ __forceinline__ bool next(int i,AttnUnit&u)const{ if(i>=4)return false; const int s=2*(vcu&1)+(i>>1); u.bh=vcu>>1; u.qb=(i&1)?7-s:s; return true; }
  __device__ __forceinline__ void a_ready(const AttnUnit&)const{}
  __device__ __forceinline__ void done(const AttnUnit&)const{}
};
template<class Sched,int THRL=8> __device__ __forceinline__ void attn_phase(char*lds,const AttnTensors&T,const Sched&S,int tid_in){
  AttnUnit u; int tid_=tid_in; asm volatile("":"+v"(tid_));
  if(S.next(0,u)){ float*csp=(float*)(lds+LDS_CS); float*wt=(float*)(lds+LDS_WS); int tp=tid_in; asm volatile("":"+v"(tp));
    const float*lf=T.CUM+((long)(u.bh/NHEAD)*SEQ+4*tp)*NHEAD+u.bh%NHEAD;
    const float a0=lf[0],a1=a0+lf[NHEAD],a2=a1+lf[2*NHEAD],a3=a2+lf[3*NHEAD];
    float sc=a3; const int ln=tp&63;
    #pragma unroll
    for(int o=1;o<64;o<<=1){ const float up=__builtin_bit_cast(float,__builtin_amdgcn_ds_bpermute((ln-o)<<2,__builtin_bit_cast(int,sc))); if(ln>=o)sc+=up; }
    if(ln==63)wt[tp>>6]=sc;
    __syncthreads();
    float base=sc-a3;
    #pragma unroll
    for(int w=0;w<NW-1;++w)if(w<(tp>>6))base+=wt[w];
    const float k2=-1.4426950408889634f;
    csp[4*tp]=k2*(base+a0);csp[4*tp+1]=k2*(base+a1);csp[4*tp+2]=k2*(base+a2);csp[4*tp+3]=k2*(base+a3);
    __syncthreads(); }
  for(int i=0;S.next(i,u);++i){ S.a_ready(u); attn_unit<THRL>(u.bh/NHEAD,u.bh%NHEAD,u.qb,T.Q,T.K,T.V,T.O,T.G,lds,tid_,T.THR); S.done(u); }
}
#undef SBAR
#undef WAIT_BAR
}
#define GAS __attribute__((address_space(1)))
#define LAS __attribute__((address_space(3)))
typedef unsigned short bf16;
typedef unsigned v4u __attribute__((ext_vector_type(4)));
typedef float f32x4 __attribute__((ext_vector_type(4)));
typedef short bf16x8 __attribute__((ext_vector_type(8)));
typedef GAS unsigned gu32;
typedef GAS unsigned long long gu64;
#define RLX_AGENT __ATOMIC_RELAXED, __HIP_MEMORY_SCOPE_AGENT
#define LDS_WAIT() asm volatile("s_waitcnt lgkmcnt(0)" ::: "memory")
#define VM_WAIT() asm volatile("s_waitcnt vmcnt(0)" ::: "memory")
__device__ __forceinline__ unsigned long long rt() { return __builtin_amdgcn_s_memrealtime(); }
__device__ __forceinline__ unsigned f2bf(float f) { unsigned u = __builtin_bit_cast(unsigned, f); return (u + 0x7fffu + ((u >> 16) & 1u)) >> 16; }
__device__ __forceinline__ unsigned pk2(float lo, float hi) { return f2bf(lo) | (f2bf(hi) << 16); }
__device__ __forceinline__ unsigned pk2h(float lo, float hi) { unsigned r; asm("v_cvt_pk_bf16_f32 %0, %1, %2" : "=v"(r) : "v"(lo), "v"(hi)); return r; }
__device__ __forceinline__ unsigned f2bfh(float f) { return pk2h(f, 0.f) & 0xffffu; }

#define XB_TMO      128
#define XB_XCNT(j)  (256  + 64 * (j))
#define XB_XSUB(j)  (1280 + 64 * (j))
#define XB_XGEN(j)  (2304 + 64 * (j))
#define XB_TOP      3328
#define XB_TOPGEN   3392
#define XCD_BAR_WORDS 3456
#define XB_SPIN_CAP (1u << 27)

__device__ __forceinline__ unsigned xb_ld(unsigned* p)              { return __hip_atomic_load(p, __ATOMIC_RELAXED, __HIP_MEMORY_SCOPE_AGENT); }
__device__ __forceinline__ unsigned xb_add(unsigned* p, unsigned v) { return __hip_atomic_fetch_add(p, v, __ATOMIC_RELAXED, __HIP_MEMORY_SCOPE_AGENT); }
__device__ __forceinline__ unsigned xb_xcc_id() { return (unsigned)__builtin_amdgcn_s_getreg((3 << 11) | 20) & 0xFu; }
#define XB_SPIN(cond, bar) do { unsigned _sp = 0; while (cond) { __builtin_amdgcn_s_sleep(1); \
    if ((++_sp & 255u) == 0u) { if (xb_ld(&(bar)[XB_TMO])) break; if (_sp > XB_SPIN_CAP) { atomicAdd(&(bar)[XB_TMO], 1u); break; } } } } while (0)

struct XcdBarrier {
    unsigned* bar; unsigned x;
    volatile LAS unsigned* st;
};

__device__ __forceinline__ XcdBarrier xcd_barrier_post(unsigned* bar, volatile LAS unsigned* st) {
    XcdBarrier b; b.bar = bar; b.x = xb_xcc_id(); b.st = st;
    if (threadIdx.x == 0) (void)xb_add(&bar[XB_XCNT(b.x)], 1u);
    return b;
}
__device__ __forceinline__ void xcd_barrier_complete(unsigned* bar, unsigned x, unsigned& nloc, unsigned& nx) {
    const unsigned G = gridDim.x * gridDim.y * gridDim.z;
    unsigned sum, cnt, mine, sp = 0u;
    for (;;) {
        sum = 0u; cnt = 0u; mine = 0u;
#pragma unroll
        for (unsigned j = 0; j < 16; ++j) { const unsigned c = xb_ld(&bar[XB_XCNT(j)]); sum += c; cnt += (c > 0u) ? 1u : 0u; mine = (j == x) ? c : mine; }
        if (sum == G) break;
        __builtin_amdgcn_s_sleep(1);
        if ((++sp & 255u) == 0u) { if (xb_ld(&bar[XB_TMO])) break; if (sp > XB_SPIN_CAP) { atomicAdd(&bar[XB_TMO], 1u); break; } }
    }
    nloc = mine > 0u ? mine : 1u; nx = cnt > 0u ? cnt : 1u;
}

__device__ __forceinline__ void xcd_barrier(const XcdBarrier& b, const bool leader  ) {
    asm volatile("s_waitcnt vmcnt(0)" ::: "memory");
    __syncthreads();
    if (leader) {
        unsigned* bar = b.bar;
        __builtin_amdgcn_s_waitcnt(0);
        unsigned nloc = b.st[0], nx = b.st[1];
        if (nloc == 0u) { xcd_barrier_complete(bar, b.x, nloc, nx); b.st[0] = nloc; b.st[1] = nx; }
        const unsigned old = xb_add(&bar[XB_XSUB(b.x)], 1u);
        const unsigned gen = old / nloc;
        if (old + 1u == (gen + 1u) * nloc) {
            __builtin_amdgcn_fence(__ATOMIC_RELEASE, "agent");
            asm volatile("s_waitcnt vmcnt(0)" ::: "memory");
            const unsigned og = xb_add(&bar[XB_TOP], 1u);
            const unsigned tg = og / nx;
            if (og + 1u == (tg + 1u) * nx) xb_add(&bar[XB_TOPGEN], 1u);
            else XB_SPIN(xb_ld(&bar[XB_TOPGEN]) == tg, bar);
            __builtin_amdgcn_fence(__ATOMIC_ACQUIRE, "agent");
            xb_add(&bar[XB_XGEN(b.x)], 1u);
            asm volatile("s_waitcnt vmcnt(0)" ::: "memory");
        } else {
            XB_SPIN(xb_ld(&bar[XB_XGEN(b.x)]) == gen, bar);
            __builtin_amdgcn_fence(__ATOMIC_ACQUIRE, "agent");
            asm volatile("s_waitcnt vmcnt(0)" ::: "memory");
        }
    }
    __syncthreads();
}
#ifndef MK_FASTATTN
#define MK_FASTATTN 1
#endif
#ifndef MK_FASTREC
#define MK_FASTREC 1
#endif
namespace cg = cooperative_groups;
constexpr int NTOK = 16384, DMODEL = 1024, NBATCH = 8, SEQLEN = 2048, DEPTH = 4;
constexpr int FOX_IN = 4112, GLA_IN = 3088, HGRN_IN = 4096;
constexpr float RMS_EPS = 1e-6f;
constexpr float LOG2E = 1.4426950408889634f;
constexpr float FOX_C2 = 0.125f * LOG2E;
constexpr int NWAVES = 8;

constexpr size_t MiB = 1u << 20;
constexpr size_t WS_CTL = 0, CTL_ZERO_BYTES = 1 * MiB;
constexpr size_t WS_FOXWIN = 2 * MiB, WS_FOXWOUT = 18 * MiB, WS_GLAWIN = 22 * MiB, WS_GLAWOUT = 28 * MiB, WS_HGRNWIN = 30 * MiB, WS_HGRNWOUT = 38 * MiB;
constexpr size_t WS_PEERWQ = 40 * MiB, WS_KEYS = 56 * MiB, WS_LB = 58 * MiB;
#define FOXFUSE ((I8MASK & 9) == 9)
#ifndef RPROBE
#define RPROBE 0
#endif
#ifndef GPROBE
#define GPROBE 0
#endif
#ifndef BGQ
#define BGQ 1
#endif
#ifndef I8MASK
#define I8MASK 13
#endif
constexpr size_t WS_SW = 58 * MiB + 65536, WS_SX = 58 * MiB + 262144, WS_XN8 = 724 * MiB;
constexpr size_t WS_TAILW = 63 * MiB;
constexpr size_t WS_RS = 62 * MiB;
constexpr size_t WS_U = 64 * MiB, WS_V = 128 * MiB, WS_SU = 60 * MiB, WS_SV = 61 * MiB;
constexpr size_t WS_XN = 320 * MiB, WS_P = 352 * MiB, WS_OB = 480 * MiB, WS_Q2 = 512 * MiB, WS_TAIL = 576 * MiB, WS_CUM = 577 * MiB;
constexpr size_t WS_EXP = 580 * MiB, WS_GATE = 588 * MiB, WS_OF = 596 * MiB, WS_GLOG = 660 * MiB, WS_HB = 740 * MiB, WS_END = 772 * MiB;
constexpr size_t PSTRIDE = (size_t)NTOK * 1024;
constexpr int CW_BAR = 4096;

constexpr int RING_BYTES = 131072;
constexpr int LDSCTL_OFF = 162816, MISC_OFF = LDSCTL_OFF + 320;
constexpr int LDS_BYTES = 163840;

typedef unsigned u32x4v __attribute__((ext_vector_type(4)));
struct Ctx {
    LAS unsigned char* lds; int tid, lane, wave, vcu, G, gw, NGW, bx;
    const float* in[21]; float* out; unsigned char* ws;
};

__device__ __forceinline__ float bf2f(unsigned short b) { return __uint_as_float(((unsigned)b) << 16); }
__device__ __forceinline__ float bflo(unsigned w) { return __uint_as_float(w << 16); }
__device__ __forceinline__ float bfhi(unsigned w) { return __uint_as_float(w & 0xffff0000u); }
#define DPP_ADD(v, ctrl, rm, bm) (v + __builtin_bit_cast(float, __builtin_amdgcn_update_dpp(0, __builtin_bit_cast(int, v), ctrl, rm, bm, false)))
#define DPP_MAX(v, ctrl, rm, bm) fmaxf(v, __builtin_bit_cast(float, __builtin_amdgcn_update_dpp(__builtin_bit_cast(int, v), __builtin_bit_cast(int, v), ctrl, rm, bm, false)))
#define DPP_SUM31(v) do { v = DPP_ADD(v, 0x111, 0xf, 0xf); v = DPP_ADD(v, 0x112, 0xf, 0xf); v = DPP_ADD(v, 0x114, 0xf, 0xe); v = DPP_ADD(v, 0x118, 0xf, 0xc); v = DPP_ADD(v, 0x142, 0xa, 0xf); } while (0)
#define DPP_SUM63(v) do { DPP_SUM31(v); v = DPP_ADD(v, 0x143, 0xc, 0xf); } while (0)
__device__ __forceinline__ float rdlane(float v, int lane) { return __builtin_bit_cast(float, __builtin_amdgcn_readlane(__builtin_bit_cast(int, v), lane)); }
__device__ __forceinline__ float wave_sum(float v) { DPP_SUM63(v); return rdlane(v, 63); }
__device__ __forceinline__ float wave_max(float v) {
    v = DPP_MAX(v, 0x111, 0xf, 0xf); v = DPP_MAX(v, 0x112, 0xf, 0xf); v = DPP_MAX(v, 0x114, 0xf, 0xe); v = DPP_MAX(v, 0x118, 0xf, 0xc); v = DPP_MAX(v, 0x142, 0xa, 0xf); v = DPP_MAX(v, 0x143, 0xc, 0xf);
    return rdlane(v, 63);
}
typedef __bf16 bf16x2_t __attribute__((ext_vector_type(2)));
__device__ __forceinline__ float dot2bf(unsigned w, unsigned x, float acc) { return __builtin_amdgcn_fdot2_f32_bf16(__builtin_bit_cast(bf16x2_t, w), __builtin_bit_cast(bf16x2_t, x), acc, false); }
__device__ __forceinline__ float bperm(float v, int src_lane) { return __builtin_bit_cast(float, __builtin_amdgcn_ds_bpermute(src_lane << 2, __builtin_bit_cast(int, v))); }
__device__ __forceinline__ float log_sigmoid_f(float x) { return fminf(x, 0.f) - log1pf(__expf(-fabsf(x))); }
__device__ __forceinline__ float sigmoid_f(float x) { return 1.f / (1.f + __expf(-x)); }

__device__ __forceinline__ void p0_transpose_item(const float* W, int ldw, int K, int Nuse, bf16* WT, LAS float* scr, int item, int lane) {
    const int nblk = Nuse / 32, kb = item / nblk, nb = item % nblk, k0 = 64 * kb, n0 = 32 * nb;
#pragma unroll
    for (int i = 0; i < 8; ++i) { const int kk = 8 * i + (lane >> 3); const f32x4 v = *(const GAS f32x4*)(W + (size_t)(k0 + kk) * ldw + n0 + 4 * (lane & 7));
        LAS float* d = scr + kk * 33 + 4 * (lane & 7); d[0] = v.x; d[1] = v.y; d[2] = v.z; d[3] = v.w; }
    LDS_WAIT(); asm volatile("" ::: "memory");
    const int c = lane & 7;
#pragma unroll
    for (int j = 0; j < 4; ++j) { const int n = (lane >> 3) + 8 * j; const LAS float* s = scr + (8 * c) * 33 + n;
        v4u o; o.x = pk2(s[0 * 33], s[1 * 33]); o.y = pk2(s[2 * 33], s[3 * 33]); o.z = pk2(s[4 * 33], s[5 * 33]); o.w = pk2(s[6 * 33], s[7 * 33]);
        *(GAS v4u*)(WT + (size_t)(n0 + n) * K + k0 + 8 * c) = o; }
    LDS_WAIT(); asm volatile("" ::: "memory");
}
__device__ __forceinline__ unsigned q8x4(float a, float b, float c, float d) {
    return ((unsigned)(int)__builtin_rintf(a) & 0xffu) | (((unsigned)(int)__builtin_rintf(b) & 0xffu) << 8) | (((unsigned)(int)__builtin_rintf(c) & 0xffu) << 16) | ((unsigned)(int)__builtin_rintf(d) << 24);
}
__device__ __forceinline__ void p0_colmax_item(const float* W, int ldw, unsigned* cmax, int item, int lane) {
    const int nb = item >> 3, n0 = 32 * nb, k0 = 128 * (item & 7);
    f32x4 v[16];
#pragma unroll
    for (int i = 0; i < 16; ++i) v[i] = *(const GAS f32x4*)(W + (size_t)(k0 + 8 * i + (lane >> 3)) * ldw + n0 + 4 * (lane & 7));
    __builtin_amdgcn_sched_barrier(0);
    float mx[4] = {0.f, 0.f, 0.f, 0.f};
#pragma unroll
    for (int i = 0; i < 16; ++i) { mx[0] = fmaxf(mx[0], fabsf(v[i].x)); mx[1] = fmaxf(mx[1], fabsf(v[i].y)); mx[2] = fmaxf(mx[2], fabsf(v[i].z)); mx[3] = fmaxf(mx[3], fabsf(v[i].w)); }
#pragma unroll
    for (int j = 0; j < 4; ++j) { mx[j] = fmaxf(mx[j], bperm(mx[j], lane ^ 8)); mx[j] = fmaxf(mx[j], bperm(mx[j], lane ^ 16)); mx[j] = fmaxf(mx[j], bperm(mx[j], lane ^ 32)); }
    if (lane < 8) {
#pragma unroll
        for (int j = 0; j < 4; ++j) (void)__hip_atomic_fetch_max(cmax + n0 + 4 * lane + j, __float_as_uint(mx[j]), __ATOMIC_RELAXED, __HIP_MEMORY_SCOPE_AGENT);
    }
}
__device__ __forceinline__ void p0_quant_item(const float* W, int ldw, const unsigned* cmax, signed char* W8, float* sw, LAS float* scr, int item, int lane, bool headperm) {
    const int nb = item >> 3, n0 = 32 * nb, k0 = 128 * (item & 7);
    const int n0s = (headperm && nb < 64) ? (nb >> 3) * 256 + 64 * (nb & 3) + 32 * ((nb >> 2) & 1) : n0;
    f32x4 v[2][8];
#pragma unroll
    for (int h = 0; h < 2; ++h)
#pragma unroll
        for (int i = 0; i < 8; ++i) v[h][i] = *(const GAS f32x4*)(W + (size_t)(k0 + 64 * h + 8 * i + (lane >> 3)) * ldw + n0s + 4 * (lane & 7));
    float ci[4];
#pragma unroll
    for (int j = 0; j < 4; ++j) { const float m = __uint_as_float(*(const GAS unsigned*)(cmax + n0s + (lane >> 3) + 8 * j)); ci[j] = m > 0.f ? 127.f / m : 0.f; }
    if ((item & 7) == 0 && lane < 32) *(GAS float*)(sw + n0 + lane) = __uint_as_float(*(const GAS unsigned*)(cmax + n0s + lane)) * (1.f / 127.f);
    __builtin_amdgcn_sched_barrier(0);
    const int c = lane & 7;
#pragma unroll
    for (int h = 0; h < 2; ++h) {
        LDS_WAIT(); asm volatile("" ::: "memory");
#pragma unroll
        for (int i = 0; i < 8; ++i) { LAS float* d = scr + (8 * i + (lane >> 3)) * 33 + 4 * (lane & 7); d[0] = v[h][i].x; d[1] = v[h][i].y; d[2] = v[h][i].z; d[3] = v[h][i].w; }
        LDS_WAIT(); asm volatile("" ::: "memory");
#pragma unroll
        for (int j = 0; j < 4; ++j) { const int n = (lane >> 3) + 8 * j; const LAS float* sp = scr + (8 * c) * 33 + n;
            const unsigned lo = q8x4(sp[0] * ci[j], sp[33] * ci[j], sp[66] * ci[j], sp[99] * ci[j]), hi = q8x4(sp[132] * ci[j], sp[165] * ci[j], sp[198] * ci[j], sp[231] * ci[j]);
            *(GAS unsigned long long*)(W8 + (size_t)(n0 + n) * 1024 + k0 + 64 * h + 8 * c) = (unsigned long long)lo | ((unsigned long long)hi << 32); }
    }
    LDS_WAIT(); asm volatile("" ::: "memory");
}
__device__ __forceinline__ void rms_row_to_bf16(int lane, f32x4 (&v)[4], const float* gain, bf16* orow, signed char* orow8, float* sx) {
    const GAS f32x4* gr = (const GAS f32x4*)gain + lane;
    float s = 0.f;
#pragma unroll
    for (int j = 0; j < 4; ++j) s += (v[j].x * v[j].x + v[j].y * v[j].y) + (v[j].z * v[j].z + v[j].w * v[j].w);
    const float r = rsqrtf(wave_sum(s) * (1.f / 1024.f) + RMS_EPS);
    GAS unsigned long long* o8 = (GAS unsigned long long*)orow + lane; float am = 0.f;
#pragma unroll
    for (int j = 0; j < 4; ++j) { const f32x4 g = gr[64 * j]; v[j].x *= r * g.x; v[j].y *= r * g.y; v[j].z *= r * g.z; v[j].w *= r * g.w;
        am = fmaxf(fmaxf(am, fmaxf(fabsf(v[j].x), fabsf(v[j].y))), fmaxf(fabsf(v[j].z), fabsf(v[j].w)));
        o8[64 * j] = (unsigned long long)pk2(v[j].x, v[j].y) | ((unsigned long long)pk2(v[j].z, v[j].w) << 32); }
    am = wave_max(am); const float qi = am > 0.f ? 127.f / am : 0.f;
    GAS unsigned* q8 = (GAS unsigned*)orow8 + lane;
#pragma unroll
    for (int j = 0; j < 4; ++j) q8[64 * j] = q8x4(v[j].x * qi, v[j].y * qi, v[j].z * qi, v[j].w * qi);
    if (lane == 0) *(GAS float*)sx = am * (1.f / 127.f);
}
__device__ __forceinline__ void cvt_f32_bf16(const Ctx& C, const float* src, bf16* dst, size_t n) {
    const size_t nth = (size_t)C.G * 512, t0 = (size_t)C.vcu * 512 + C.tid;
    for (size_t i = t0; i < n / 8; i += nth) {
        const f32x4 a = ((const GAS f32x4*)src)[2 * i], b = ((const GAS f32x4*)src)[2 * i + 1];
        v4u o; o.x = pk2(a.x, a.y); o.y = pk2(a.z, a.w); o.z = pk2(b.x, b.y); o.w = pk2(b.z, b.w);
        ((GAS v4u*)dst)[i] = o;
    }
}
__device__ __forceinline__ void quant_row_fp8(int lane, const f32x4 (&v)[4], unsigned char* drow, unsigned char* sc) {
    float am = 0.f;
#pragma unroll
    for (int i = 0; i < 4; ++i) am = fmaxf(am, fmaxf(fmaxf(fabsf(v[i].x), fabsf(v[i].y)), fmaxf(fabsf(v[i].z), fabsf(v[i].w))));
    am = wave_max(am);
    const unsigned sbits = __float_as_uint(am * (1.f / 448.f));
    unsigned e = (sbits >> 23) + ((sbits & 0x7fffffu) ? 1u : 0u); e = am > 0.f ? (e < 1u ? 1u : e > 254u ? 254u : e) : 127u;
    const float inv = __uint_as_float((254u - e) << 23);
    GAS unsigned* o = (GAS unsigned*)drow + lane;
#pragma unroll
    for (int i = 0; i < 4; ++i) {
        const float a = fminf(fmaxf(v[i].x * inv, -448.f), 448.f), b = fminf(fmaxf(v[i].y * inv, -448.f), 448.f), c = fminf(fmaxf(v[i].z * inv, -448.f), 448.f), d = fminf(fmaxf(v[i].w * inv, -448.f), 448.f);
        int w = 0; w = __builtin_amdgcn_cvt_pk_fp8_f32(a, b, w, false); w = __builtin_amdgcn_cvt_pk_fp8_f32(c, d, w, true); o[64 * i] = (unsigned)w;
    }
    if (lane == 0) *(GAS unsigned char*)sc = (unsigned char)e;
}
__device__ __forceinline__ void quant_rows_fp8(const Ctx& C, const float* src, unsigned char* dst, unsigned char* scales, int nrows) {
    int rw = C.gw;
    for (; rw + 3 * C.NGW < nrows; rw += 4 * C.NGW) {
        f32x4 v[4][4];
#pragma unroll
        for (int j = 0; j < 4; ++j) { const GAS f32x4* xr = (const GAS f32x4*)(src + (size_t)(rw + j * C.NGW) * 1024) + C.lane;
#pragma unroll
            for (int i = 0; i < 4; ++i) v[j][i] = xr[64 * i]; }
        __builtin_amdgcn_sched_barrier(0);
#pragma unroll
        for (int j = 0; j < 4; ++j) quant_row_fp8(C.lane, v[j], dst + (size_t)(rw + j * C.NGW) * 1024, scales + rw + j * C.NGW);
    }
    for (; rw < nrows; rw += C.NGW) {
        const GAS f32x4* xr = (const GAS f32x4*)(src + (size_t)rw * 1024) + C.lane;
        f32x4 v[4];
#pragma unroll
        for (int i = 0; i < 4; ++i) v[i] = xr[64 * i];
        quant_row_fp8(C.lane, v, dst + (size_t)rw * 1024, scales + rw);
    }
}
constexpr int BGQ_ROWS = 3 * 16384;
template <int JOB> __device__ __forceinline__ void bgq_row(const Ctx& C, int idx, const float*& src, unsigned char*& dst, unsigned char*& sc) {
    const int seg = idx >> 14, row = idx & 16383;
    const bool isV = seg == 1 || (seg == 2 && JOB == 2);
    const size_t flat = (size_t)(seg < 2 ? JOB : 3) * 16384 + row;
    src = (isV ? C.in[20] : C.in[19]) + flat * 1024; dst = C.ws + (isV ? WS_V : WS_U) + flat * 1024; sc = C.ws + (isV ? WS_SV : WS_SU) + flat;
}
template <int JOB> __device__ __forceinline__ void bgq_step(const Ctx& C, int idx_prev, int idx, f32x4 (&v)[4]) {
    const float* src; unsigned char* dst; unsigned char* sc;
    if (idx_prev >= 0 && idx_prev < BGQ_ROWS) { bgq_row<JOB>(C, idx_prev, src, dst, sc); quant_row_fp8(C.lane, v, dst, sc); }
    if (idx < BGQ_ROWS) { bgq_row<JOB>(C, idx, src, dst, sc); const GAS f32x4* xr = (const GAS f32x4*)src + C.lane;
#pragma unroll
        for (int i = 0; i < 4; ++i) v[i] = xr[64 * i]; }
}
#ifndef PRO_PROBE
#define PRO_PROBE 0
#endif
constexpr int CW_CMAX = 131072;
constexpr int I8_NF0 = (I8MASK & 1) ? 1024 : 0, I8_NF3 = (I8MASK & 8) ? 1024 : 0, I8_NG = (I8MASK & 2) ? 768 : 0, I8_NH = (I8MASK & 4) ? 1024 : 0, I8_NITEMS = I8_NF0 + I8_NF3 + I8_NG + I8_NH;
template <bool PASS2> __device__ __forceinline__ void p0_i8_items(const Ctx& C, LAS float* scr) {
    unsigned* CM = (unsigned*)(C.ws + WS_CTL) + CW_CMAX; float* SW = (float*)(C.ws + WS_SW);
    for (int it = C.gw; it < I8_NITEMS; it += C.NGW) {
        int r = it; const float* W; int ldw; signed char* W8; int q;
        if (r < I8_NF0) { W = C.in[3]; ldw = FOX_IN; W8 = (signed char*)(C.ws + WS_FOXWIN); q = 0; }
        else if ((r -= I8_NF0) < I8_NF3) { W = C.in[3] + (size_t)1024 * FOX_IN; ldw = FOX_IN; W8 = (signed char*)(C.ws + WS_FOXWIN + 8 * MiB); q = 1; }
        else if ((r -= I8_NF3) < I8_NG) { W = C.in[8]; ldw = GLA_IN; W8 = (signed char*)(C.ws + WS_GLAWIN); q = 2; }
        else { r -= I8_NG; W = C.in[13]; ldw = HGRN_IN; W8 = (signed char*)(C.ws + WS_HGRNWIN); q = 3; }
        const int swo = q == 0 ? 0 : q == 1 ? 4096 : q == 2 ? 8192 : 11264;
        if (PASS2) p0_quant_item(W, ldw, CM + q * 4096, W8, SW + swo, scr, r, C.lane, FOXFUSE && q < 2); else p0_colmax_item(W, ldw, CM + q * 4096, r, C.lane);
    }
}
__device__ __forceinline__ void p0_prologue_b(const Ctx& C) { p0_i8_items<true>(C, (LAS float*)(C.lds + C.wave * 16384)); }
__device__ __forceinline__ void p0_prologue(const Ctx& C) {
    LAS float* scr = (LAS float*)(C.lds + C.wave * 16384);
    for (int rep_ = 0; rep_ < (PRO_PROBE == 1 ? 2 : 1); ++rep_) {
    p0_i8_items<false>(C, scr);
    constexpr int I_SQ = 16 * 32, N_F0 = (I8MASK & 1) ? 0 : 16 * 128, N_F3 = (I8MASK & 8) ? 0 : 16 * 128, N_G = (I8MASK & 2) ? 0 : 16 * 96, N_H = (I8MASK & 4) ? 0 : 16 * 128;
    constexpr int NITEMS = N_F0 + N_F3 + N_G + N_H + 2 * I_SQ + I_SQ + I_SQ;
    for (int it = C.gw; it < NITEMS; it += C.NGW) {
        int r = it;
        if (r < N_F0) { p0_transpose_item(C.in[3], FOX_IN, 1024, 4096, (bf16*)(C.ws + WS_FOXWIN), scr, r, C.lane); continue; } r -= N_F0;
        if (r < N_F3) { p0_transpose_item(C.in[3] + (size_t)1024 * FOX_IN, FOX_IN, 1024, 4096, (bf16*)(C.ws + WS_FOXWIN + 8 * MiB), scr, r, C.lane); continue; } r -= N_F3;
        if (r < N_G) { p0_transpose_item(C.in[8], GLA_IN, 1024, 3072, (bf16*)(C.ws + WS_GLAWIN), scr, r, C.lane); continue; } r -= N_G;
        if (r < N_H) { p0_transpose_item(C.in[13], HGRN_IN, 1024, 4096, (bf16*)(C.ws + WS_HGRNWIN), scr, r, C.lane); continue; } r -= N_H;
        if (r < 2 * I_SQ) { const int j = r / I_SQ; p0_transpose_item(C.in[7] + (size_t)j * 1024 * 1024, 1024, 1024, 1024, (bf16*)(C.ws + WS_FOXWOUT) + (size_t)j * 1024 * 1024, scr, r % I_SQ, C.lane); continue; } r -= 2 * I_SQ;
        if (r < I_SQ) { p0_transpose_item(C.in[12], 1024, 1024, 1024, (bf16*)(C.ws + WS_GLAWOUT), scr, r, C.lane); continue; } r -= I_SQ;
        p0_transpose_item(C.in[16], 1024, 1024, 1024, (bf16*)(C.ws + WS_HGRNWOUT), scr, r, C.lane);
    }
    }
    for (int rep_ = 0; rep_ < (PRO_PROBE == 2 ? 2 : 1); ++rep_) {
    constexpr int MT_GROUPS = 4 * 16 * 4 * 32;
    for (int grp = C.gw; grp < MT_GROUPS; grp += C.NGW) {
        const int nb2 = grp & 31, kb2 = (grp >> 5) & 3, hp = (grp >> 7) & 15, layer = grp >> 11;
        const float* kp = C.in[18] + ((size_t)(layer * 16 + hp) * 128 + kb2 * 32 + (C.lane & 15)) * 128 + 4 * (C.lane >> 4);
        const float* wp = C.in[17] + ((size_t)layer * 1024 + nb2 * 32 + (C.lane & 15)) * 2048 + hp * 128 + 4 * (C.lane >> 4);
        f32x4 ka[2][8], wb[2][8];
#pragma unroll
        for (int u = 0; u < 2; ++u)
#pragma unroll
            for (int s8 = 0; s8 < 8; ++s8) { ka[u][s8] = *(const GAS f32x4*)(kp + (size_t)u * 16 * 128 + 16 * s8); wb[u][s8] = *(const GAS f32x4*)(wp + (size_t)u * 16 * 2048 + 16 * s8); }
        __builtin_amdgcn_sched_barrier(0);
        f32x4 acc[2][2];
#pragma unroll
        for (int a = 0; a < 2; ++a)
#pragma unroll
            for (int b = 0; b < 2; ++b) acc[a][b] = (f32x4){0.f, 0.f, 0.f, 0.f};
#pragma unroll
        for (int s8 = 0; s8 < 8; ++s8)
#pragma unroll
            for (int a = 0; a < 2; ++a)
#pragma unroll
                for (int b = 0; b < 2; ++b) { const f32x4 x = ka[a][s8], y = wb[b][s8];
                    acc[a][b] = __builtin_amdgcn_mfma_f32_16x16x4f32(x.x, y.x, acc[a][b], 0, 0, 0); acc[a][b] = __builtin_amdgcn_mfma_f32_16x16x4f32(x.y, y.y, acc[a][b], 0, 0, 0);
                    acc[a][b] = __builtin_amdgcn_mfma_f32_16x16x4f32(x.z, y.z, acc[a][b], 0, 0, 0); acc[a][b] = __builtin_amdgcn_mfma_f32_16x16x4f32(x.w, y.w, acc[a][b], 0, 0, 0); }
#pragma unroll
        for (int a = 0; a < 2; ++a)
#pragma unroll
            for (int b = 0; b < 2; ++b) {
                bf16* mt = (bf16*)(C.ws + WS_PEERWQ) + ((size_t)layer * 2048 + hp * 128 + kb2 * 32 + a * 16 + (C.lane >> 4) * 4) * 1024 + nb2 * 32 + b * 16 + (C.lane & 15);
#pragma unroll
                for (int r = 0; r < 4; ++r) mt[(size_t)r * 1024] = (bf16)f2bf(acc[a][b][r]); }
    }
    }
    for (int rep_ = 0; rep_ < (PRO_PROBE == 3 ? 2 : 1); ++rep_) {
    quant_rows_fp8(C, C.in[19], C.ws + WS_U, C.ws + WS_SU, BGQ ? 16384 : 4 * 16384);
    quant_rows_fp8(C, C.in[20], C.ws + WS_V, C.ws + WS_SV, BGQ ? 16384 : 4 * 16384);
    }
    for (int rep_ = 0; rep_ < (PRO_PROBE == 4 ? 2 : 1); ++rep_) {
    for (int i = C.vcu * 512 + C.tid; i < 3 * 16 * 1024; i += C.G * 512) {
        const int w = i >> 14, n = (i >> 10) & 15, k = i & 1023;
        const float v = w < 2 ? C.in[3][(size_t)w * 1024 * FOX_IN + (size_t)k * FOX_IN + 4096 + n] : C.in[8][(size_t)k * GLA_IN + 3072 + n];
        ((bf16*)(C.ws + WS_TAILW))[i] = (bf16)f2bf(v);
    }
    if (C.vcu == 0) for (int c = C.tid; c < 1024; c += 512) {
        const float l0 = C.in[14][c], l1 = C.in[14][1024 + c], l2 = C.in[14][2048 + c], l3 = C.in[14][3072 + c];
        const float m = fmaxf(fmaxf(l0, l1), fmaxf(l2, l3));
        const float e0 = expf(l0 - m), e1 = expf(l1 - m), e2 = expf(l2 - m), e3 = expf(l3 - m);
        ((float*)(C.ws + WS_LB))[c] = (e1 + e2) / (e0 + e1 + e2 + e3);
    }
    for (int m0 = C.gw; m0 < NTOK; m0 += 4 * C.NGW) {
        f32x4 v[4][4];
#pragma unroll
        for (int u = 0; u < 4; ++u) { const int m = m0 + u * C.NGW; if (m < NTOK) { const GAS f32x4* xr = (const GAS f32x4*)(C.in[0] + (size_t)m * 1024) + C.lane;
#pragma unroll
            for (int j = 0; j < 4; ++j) v[u][j] = xr[64 * j]; } }
        __builtin_amdgcn_sched_barrier(0);
#pragma unroll
        for (int u = 0; u < 4; ++u) { const int m = m0 + u * C.NGW; if (m < NTOK)
            rms_row_to_bf16(C.lane, v[u], C.in[1], (bf16*)(C.ws + WS_XN) + (size_t)m * 1024, (signed char*)(C.ws + WS_XN8) + (size_t)m * 1024, (float*)(C.ws + WS_SX) + m); }
    }
    }
}

__device__ __forceinline__ void tail_mfma(const Ctx& C, int tok0, const bf16* WT, LAS float* part) {
    const int l = C.lane, m = l & 15, g = l >> 4, tbk = C.wave & 3, kh = C.wave >> 2;
    const bf16* ap = (const bf16*)(C.ws + WS_XN) + (size_t)(tok0 + 16 * tbk + m) * 1024 + kh * 512 + 8 * g;
    const bf16* bp = WT + (size_t)m * 1024 + kh * 512 + 8 * g;
    f32x4 acc = (f32x4){0.f, 0.f, 0.f, 0.f};
#pragma unroll 4
    for (int ks = 0; ks < 16; ++ks) acc = __builtin_amdgcn_mfma_f32_16x16x32_bf16(*(const bf16x8*)(ap + 32 * ks), *(const bf16x8*)(bp + 32 * ks), acc, 0, 0, 0);
#pragma unroll
    for (int r = 0; r < 4; ++r) part[kh * 1024 + (16 * tbk + 4 * g + r) * 16 + m] = acc[r];
}
template <bool QK> __device__ __forceinline__ void fox_step1(const Ctx& C, int j) {
    float* TAIL = (float*)(C.ws + WS_TAIL); LAS float* part = (LAS float*)C.lds;
    const bf16* WT = (const bf16*)(C.ws + WS_TAILW) + (size_t)j * 16 * 1024;
    for (int tb = C.vcu; tb < NTOK / 64; tb += C.G) {
        __syncthreads();
        tail_mfma(C, tb * 64, WT, part);
        __syncthreads();
#pragma unroll
        for (int rep = 0; rep < 2; ++rep) { const int i = rep * 512 + C.tid; TAIL[(size_t)tb * 1024 + i] = log_sigmoid_f(part[i] + part[1024 + i] + C.in[4][j * 16 + (i & 15)]); }
        if (!QK) continue;
        const float* gq = C.in[5] + j * 64; const float* gk = C.in[6] + j * 64;
        v4u ra[2][8], rb[2][8];
#pragma unroll
        for (int which = 0; which < 2; ++which)
#pragma unroll
            for (int t = 0; t < 8; ++t) { const bf16* row = (const bf16*)(C.ws + WS_P) + (size_t)which * PSTRIDE + (size_t)(tb * 64 + C.wave * 8 + t) * 1024 + C.lane * 16;
                ra[which][t] = *(const GAS v4u*)row; rb[which][t] = *(const GAS v4u*)(row + 8); }
        __builtin_amdgcn_sched_barrier(0);
#pragma unroll
        for (int which = 0; which < 2; ++which) {
            const float* g = (which == 0 ? gq : gk) + (C.lane & 3) * 16;
            float gv[16];
#pragma unroll
            for (int i = 0; i < 16; ++i) gv[i] = g[i];
#pragma unroll
            for (int t = 0; t < 8; ++t) {
                bf16* row = (bf16*)(C.ws + WS_P) + (size_t)which * PSTRIDE + (size_t)(tb * 64 + C.wave * 8 + t) * 1024 + C.lane * 16;
                const v4u a = ra[which][t], b = rb[which][t];
                float v[16] = {bflo(a.x), bfhi(a.x), bflo(a.y), bfhi(a.y), bflo(a.z), bfhi(a.z), bflo(a.w), bfhi(a.w), bflo(b.x), bfhi(b.x), bflo(b.y), bfhi(b.y), bflo(b.z), bfhi(b.z), bflo(b.w), bfhi(b.w)};
                float ss = 0.f;
#pragma unroll
                for (int i = 0; i < 16; ++i) ss += v[i] * v[i];
                ss = DPP_ADD(ss, 0xB1, 0xf, 0xf); ss = DPP_ADD(ss, 0x4E, 0xf, 0xf);
                const float r = rsqrtf(ss * (1.f / 64.f) + RMS_EPS) * (which == 0 ? FOX_C2 : 1.f);
#pragma unroll
                for (int i = 0; i < 16; ++i) v[i] = v[i] * r * gv[i];
                v4u oa, ob; oa.x = pk2(v[0], v[1]); oa.y = pk2(v[2], v[3]); oa.z = pk2(v[4], v[5]); oa.w = pk2(v[6], v[7]);
                ob.x = pk2(v[8], v[9]); ob.y = pk2(v[10], v[11]); ob.z = pk2(v[12], v[13]); ob.w = pk2(v[14], v[15]);
                *(GAS v4u*)row = oa; *(GAS v4u*)(row + 8) = ob;
            }
        }
    }
}
constexpr size_t WS_ASC = WS_Q2, WS_Q1 = WS_Q2 + 16 * MiB, WS_KST = WS_Q2 + 48 * MiB, WS_DEC = 59 * MiB;
static_assert(WS_KST + 32 * MiB <= WS_OF && WS_Q1 + 32 * MiB <= WS_KST, "chunk workspace map");
template <int NH>
__device__ __forceinline__ void chunk_prepass(const Ctx& C) {
    bf16* ASC = (bf16*)(C.ws + WS_ASC); bf16* Q1 = (bf16*)(C.ws + WS_Q1); bf16* KST = (bf16*)(C.ws + WS_KST); float* DEC = (float*)(C.ws + WS_DEC);
    const bf16* P0 = (const bf16*)(C.ws + WS_P); const bf16* P1 = P0 + PSTRIDE;
    LAS bf16* tqs = (LAS bf16*)C.lds;
    LAS bf16* tks = tqs + 64 * 128;
    LAS bf16* q2s = tks + 64 * 128;
    LAS bf16* k2s = q2s + 64 * 136;
    LAS bf16* q1s = k2s + 64 * 136;
    LAS float* tot = (LAS float*)(q1s + 64 * 128);
    LAS float* part = tot + 512;
    const float qs = 0.08838834764831845f;
    const int d = C.tid & 127, tq = C.tid >> 7, l = C.lane, fr = l & 15, fq = l >> 4;
    const int dq = (d & ~31) + ((d & 16) ? 8 * ((d & 15) >> 2) + 4 + (d & 3) : 8 * ((d & 15) >> 2) + (d & 3));
    const int pr0 = C.tid >> 4, pc = (C.tid & 15) * 8;
#define PP_BAR() do { asm volatile("s_waitcnt lgkmcnt(0)" ::: "memory"); __builtin_amdgcn_s_barrier(); asm volatile("" ::: "memory"); } while (0)
    for (int itb = C.vcu; itb < NBATCH * 32; itb += C.G) {
        const int c = itb & 31, b = itb >> 5;
        const size_t rowb = (size_t)b * SEQLEN + c * 64;
        const size_t row0 = rowb + tq * 16;
        if (NH == 4) { __syncthreads(); tail_mfma(C, b * SEQLEN + c * 64, (const bf16*)(C.ws + WS_TAILW) + 2 * 16 * 1024, part); }
        v4u pq[2], pk[2];
#define PP_LOAD(h_) do { _Pragma("unroll") for (int j = 0; j < 2; ++j) { const size_t r_ = (rowb + pr0 + 32 * j) * 1024 + (h_) * 128 + pc; \
            pq[j] = *(const GAS v4u*)(P0 + r_); pk[j] = *(const GAS v4u*)((NH == 4 ? P0 + 512 : P1) + r_); } } while (0)
        PP_LOAD(0);
#pragma unroll 1
        for (int h = 0; h < NH; ++h) {
            const int it = (b * NH + h) * 32 + c;
            float wu[16]; float ba = 0.f, lb = 0.f;
            if (NH == 4) {
#pragma unroll
                for (int r = 0; r < 16; ++r) wu[r] = C.in[9][r * 512 + h * 128 + d];
                ba = C.in[10][h * 128 + d];
            } else lb = ((const float*)(C.ws + WS_LB))[h * 128 + d];
            PP_BAR();
#pragma unroll
            for (int j = 0; j < 2; ++j) { *(LAS v4u*)(tqs + (pr0 + 32 * j) * 128 + pc) = pq[j]; *(LAS v4u*)(tks + (pr0 + 32 * j) * 128 + pc) = pk[j]; }
            if (h + 1 < NH) PP_LOAD(h + 1);
            PP_BAR();
            float bl[16], kk[16]; float run = 0.f;
            if (NH == 4) {
#pragma unroll
                for (int i = 0; i < 16; ++i) { float z = ba; const int t = tq * 16 + i;
#pragma unroll
                    for (int r = 0; r < 16; r += 4) { const f32x4 p0 = *(const LAS f32x4*)(part + t * 16 + r), p1 = *(const LAS f32x4*)(part + 1024 + t * 16 + r);
                        z += (p0[0] + p1[0]) * wu[r] + (p0[1] + p1[1]) * wu[r + 1] + (p0[2] + p1[2]) * wu[r + 2] + (p0[3] + p1[3]) * wu[r + 3]; }
                    run += log_sigmoid_f(z) * (1.f / 16.f); bl[i] = run; kk[i] = bf2f(tks[t * 128 + d]); }
            } else {
#pragma unroll
                for (int i = 0; i < 16; ++i) { const float gate = lb + (1.f - lb) * sigmoid_f(bf2f(tks[(tq * 16 + i) * 128 + d])); run += __logf(gate); bl[i] = run; kk[i] = 1.f - gate; }
            }
            tot[tq * 128 + d] = run;
            PP_BAR();
            const float t0 = tot[d], t1 = tot[128 + d], t2 = tot[256 + d], t3 = tot[384 + d];
            const float off = tq == 0 ? 0.f : tq == 1 ? t0 : tq == 2 ? t0 + t1 : t0 + t1 + t2;
            const float bref = t0 + t1, bend = (t0 + t1) + (t2 + t3);
            unsigned ksw[8];
#pragma unroll
            for (int i = 0; i < 16; ++i) {
                const float bb = bl[i] + off;
                const float qv = bf2f(tqs[(tq * 16 + i) * 128 + d]) * qs, kv = kk[i];
                q1s[(tq * 16 + i) * 128 + dq] = (bf16)f2bfh(qv * __expf(bb));
                q2s[(tq * 16 + i) * 136 + d] = (bf16)f2bfh(qv * __expf(bb - bref));
                k2s[(tq * 16 + i) * 136 + d] = (bf16)f2bfh(kv * __expf(bref - bb));
                const unsigned kb = f2bfh(kv * __expf(bend - bb));
                if (i & 1) ksw[i >> 1] |= kb << 16; else ksw[i >> 1] = kb;
            }
            { bf16* kt = KST + ((size_t)it * 128 + d) * 64 + tq * 16; *(GAS v4u*)kt = (v4u){ksw[0], ksw[1], ksw[2], ksw[3]}; *(GAS v4u*)(kt + 8) = (v4u){ksw[4], ksw[5], ksw[6], ksw[7]}; }
            if (tq == 0) DEC[(size_t)it * 128 + d] = __expf(bend);
            PP_BAR();
#pragma unroll
            for (int j = 0; j < 2; ++j) *(GAS v4u*)(Q1 + (((size_t)it * 4 + (pc >> 5)) * 64 + pr0 + 32 * j) * 32 + (pc & 31)) = *(const LAS v4u*)(q1s + (pr0 + 32 * j) * 128 + pc);
            const int ti = C.wave >> 1;
#pragma unroll
            for (int sj = 0; sj < 2; ++sj) {
                const int si = 2 * (C.wave & 1) + sj;
                f32x4 acc = (f32x4){0.f, 0.f, 0.f, 0.f};
                if (si <= ti) {
#pragma unroll
                    for (int ks = 0; ks < 4; ++ks) {
                        const bf16x8 a = *(const LAS bf16x8*)(q2s + (16 * ti + fr) * 136 + ks * 32 + fq * 8), bb = *(const LAS bf16x8*)(k2s + (16 * si + fr) * 136 + ks * 32 + fq * 8);
                        acc = __builtin_amdgcn_mfma_f32_16x16x32_bf16(bb, a, acc, 0, 0, 0);
                    }
                }
                const int t = 16 * ti + fr, s0 = 16 * si + 4 * fq;
                typedef unsigned u32x2v __attribute__((ext_vector_type(2)));
                u32x2v w; w.x = pk2(s0 <= t ? acc[0] : 0.f, s0 + 1 <= t ? acc[1] : 0.f); w.y = pk2(s0 + 2 <= t ? acc[2] : 0.f, s0 + 3 <= t ? acc[3] : 0.f);
                *(GAS u32x2v*)(ASC + (size_t)it * 4096 + t * 64 + s0) = w;
            }
        }
    }
#undef PP_LOAD
#undef PP_BAR
}
struct RecFrag { bf16x8 a0, a1; bf16x8 q[4]; f32x4 dc[2]; bf16x8 ks[2][2]; };
template <int NH, int DV, int RP = 0  >
__device__ __forceinline__ void chunk_recur(const Ctx& C, const bf16* Vp) {
    const bf16* ASC = (const bf16*)(C.ws + WS_ASC); const bf16* Q1 = (const bf16*)(C.ws + WS_Q1); const bf16* KST = (const bf16*)(C.ws + WS_KST); const float* DEC = (const float*)(C.ws + WS_DEC);
    bf16* OF = (bf16*)(C.ws + (RP ? WS_GLOG : WS_OF));
    constexpr int NCB = DV / 16, NTASK = NBATCH * NH * NCB;
    const int l = C.lane, m = l & 15, g = l >> 4, gi = C.wave >> 2, kq = C.wave & 3;
    LAS float* red = (LAS float*)C.lds + gi * 8192;
    LAS bf16* vt = (LAS bf16*)(C.lds + 65536) + gi * 2048;
    typedef short v4i16_t __attribute__((ext_vector_type(4)));
#define REC_LOAD(F, c_) do { const size_t row0_ = (size_t)b * SEQLEN + (c_) * 64; const size_t ch_ = (size_t)bh * 32 + (c_); \
        F.a0 = *(const bf16x8*)(ASC + ch_ * 4096 + (16 * kq + m) * 64 + 8 * g); F.a1 = *(const bf16x8*)(ASC + ch_ * 4096 + (16 * kq + m) * 64 + 32 + 8 * g); \
        _Pragma("unroll") for (int tb = 0; tb < 4; ++tb) F.q[tb] = *(const bf16x8*)(Q1 + ((ch_ * 4 + kq) * 64 + 16 * tb + m) * 32 + 8 * g); \
        _Pragma("unroll") for (int i = 0; i < 2; ++i) { F.dc[i] = *(const f32x4*)(DEC + ch_ * 128 + 32 * kq + 16 * i + 4 * g); \
            _Pragma("unroll") for (int ks = 0; ks < 2; ++ks) F.ks[i][ks] = *(const bf16x8*)(KST + (ch_ * 128 + 32 * kq + 16 * i + m) * 64 + 32 * ks + 8 * g); } } while (0)
#define VP_LOAD(c_) (*(const unsigned long long*)(Vp + ((size_t)b * SEQLEN + (c_) * 64 + 16 * kq + (l >> 2)) * 1024 + h * DV + cb * 16 + 4 * (l & 3)))
#define VT_PUT(c_, v_) (*(LAS unsigned long long*)(vt + ((c_) & 1) * 1024 + (16 * kq + (l >> 2)) * 16 + 4 * (l & 3)) = (v_))
#define REC_BODY(F, Fn, c_, vcur_, vnew_) do { \
        if ((c_) + 1 < 32 && RP != 3) REC_LOAD(Fn, (c_) + 1); \
        if ((c_) + 2 < 32) vnew_ = VP_LOAD((c_) + 2); \
        bf16x8 vb[2]; \
        _Pragma("unroll") for (int ks = 0; ks < 2; ++ks) { const LAS bf16* tp_ = vt + ((c_) & 1) * 1024 + (32 * ks + 8 * g + ((l & 15) >> 2)) * 16 + 4 * (l & 3); \
            const v4i16_t lo_ = __builtin_amdgcn_ds_read_tr16_b64_v4i16((LAS v4i16_t*)tp_), hi_ = __builtin_amdgcn_ds_read_tr16_b64_v4i16((LAS v4i16_t*)(tp_ + 64)); \
            vb[ks] = (bf16x8){lo_[0], lo_[1], lo_[2], lo_[3], hi_[0], hi_[1], hi_[2], hi_[3]}; } \
        if ((c_) + 1 < 32) VT_PUT((c_) + 1, vcur_);              \
        if (BGQ && RP == 0) { const int bgn = (bgit * 32 + (c_)) * C.NGW + C.gw; bgq_step<JOB>(C, bgi, bgn, bgv); bgi = bgn; } \
        LAS float* rb = red + ((c_) & 1) * 4096; \
        f32x4 oin = __builtin_amdgcn_mfma_f32_16x16x32_bf16(F.a0, vb[0], (f32x4){0.f, 0.f, 0.f, 0.f}, 0, 0, 0); \
        if (kq >= 2) oin = __builtin_amdgcn_mfma_f32_16x16x32_bf16(F.a1, vb[1], oin, 0, 0, 0); \
        { u32x4v sw; sw.x = pk2(S[0][0], S[0][1]); sw.y = pk2(S[0][2], S[0][3]); sw.z = pk2(S[1][0], S[1][1]); sw.w = pk2(S[1][2], S[1][3]); \
          const bf16x8 sb = __builtin_bit_cast(bf16x8, sw); \
          _Pragma("unroll") for (int tb = 0; tb < 4; ++tb) { \
              const f32x4 po = __builtin_amdgcn_mfma_f32_16x16x32_bf16(F.q[tb], sb, (f32x4){0.f, 0.f, 0.f, 0.f}, 0, 0, 0); \
              *(LAS f32x4*)(rb + ((kq * 4 + tb) * 64 + l) * 4) = po; } } \
        _Pragma("unroll") for (int i = 0; i < 2; ++i) { S[i] = S[i] * F.dc[i]; \
            _Pragma("unroll") for (int ks = 0; ks < 2; ++ks) S[i] = __builtin_amdgcn_mfma_f32_16x16x32_bf16(F.ks[i][ks], vb[ks], S[i], 0, 0, 0); } \
        if (RP != 2) { asm volatile("s_waitcnt lgkmcnt(0)" ::: "memory"); __builtin_amdgcn_s_barrier(); asm volatile("" ::: "memory"); } \
        { f32x4 o = oin; \
          if (RP != 2) { _Pragma("unroll") for (int k2 = 0; k2 < 4; ++k2) o = o + *(const LAS f32x4*)(rb + ((k2 * 4 + kq) * 64 + l) * 4); } \
          const size_t orow = (size_t)b * SEQLEN + (c_) * 64 + 16 * kq + 4 * g; \
          if (RP != 4 || (c_) == 31) { _Pragma("unroll") for (int r = 0; r < 4; ++r) OF[(orow + r) * 1024 + col] = (bf16)f2bf(o[r]); } } } while (0)
    constexpr int JOB = NH == 4 ? 1 : 2;
    f32x4 bgv[4]; int bgi = -1, bgit = 0;
    for (int t0 = C.vcu; t0 < NTASK / 2; t0 += C.G, ++bgit) {
        const int task = gi * (NTASK / 2) + t0;
        const int cb = task % NCB, bh = task / NCB, b = bh / NH, h = bh % NH;
        const int col = h * DV + cb * 16 + m;
        f32x4 S[2];
        S[0] = (f32x4){0.f, 0.f, 0.f, 0.f}; S[1] = S[0];
        RecFrag FA, FB;
        REC_LOAD(FA, 0);
        if (RP == 3) REC_LOAD(FB, 1);
        unsigned long long vA = VP_LOAD(0), vB = VP_LOAD(1);
        VT_PUT(0, vA); vA = vB;
        asm volatile("s_waitcnt lgkmcnt(0)" ::: "memory"); __builtin_amdgcn_s_barrier(); asm volatile("" ::: "memory");
#pragma unroll 1
        for (int c = 0; c < 32; c += 2) { REC_BODY(FA, FB, c, vA, vB); REC_BODY(FB, FA, c + 1, vB, vA); }
        asm volatile("s_waitcnt lgkmcnt(0)" ::: "memory"); __builtin_amdgcn_s_barrier(); asm volatile("" ::: "memory");
    }
    if (BGQ && RP == 0) {
        for (int bgn = bgit * 32 * C.NGW + C.gw; bgi < BGQ_ROWS; bgn += C.NGW) { bgq_step<JOB>(C, bgi, bgn, bgv); bgi = bgn; }
    }
#undef REC_LOAD
#undef REC_BODY
#undef VP_LOAD
#undef VT_PUT
}

template <int DV>
__device__ __forceinline__ void rec_norm_gate(const Ctx& C, const float* gain, const bf16* gate) {
    const bf16* OF = (const bf16*)(C.ws + WS_OF); bf16* OB = (bf16*)(C.ws + WS_OB);
    f32x4 g[4];
#pragma unroll
    for (int j = 0; j < 4; ++j) g[j] = *((const GAS f32x4*)gain + C.lane + 64 * j);
    for (int tok0 = C.gw; tok0 < NTOK; tok0 += 4 * C.NGW) {
        unsigned long long vw[4][4], tw[4][4];
#pragma unroll
        for (int u = 0; u < 4; ++u) { const int tok = tok0 + u * C.NGW; if (tok < NTOK) {
            const GAS unsigned long long* xr = (const GAS unsigned long long*)(OF + (size_t)tok * 1024) + C.lane;
            const GAS unsigned long long* tr = (const GAS unsigned long long*)(gate + (size_t)tok * 1024) + C.lane;
#pragma unroll
            for (int j = 0; j < 4; ++j) { vw[u][j] = xr[64 * j]; tw[u][j] = tr[64 * j]; } } }
        __builtin_amdgcn_sched_barrier(0);
#pragma unroll
        for (int u = 0; u < 4; ++u) { const int tok = tok0 + u * C.NGW; if (tok < NTOK) {
            GAS unsigned long long* o8 = (GAS unsigned long long*)(OB + (size_t)tok * 1024) + C.lane;
#pragma unroll
            for (int j = 0; j < 4; ++j) {
                const f32x4 v = (f32x4){bflo((unsigned)vw[u][j]), bfhi((unsigned)vw[u][j]), bflo((unsigned)(vw[u][j] >> 32)), bfhi((unsigned)(vw[u][j] >> 32))}; float ss = (v.x * v.x + v.y * v.y) + (v.z * v.z + v.w * v.w);
                if (DV == 256) ss = wave_sum(ss); else { DPP_SUM31(ss); const float s_lo = rdlane(ss, 31), s_hi = rdlane(ss, 63); ss = C.lane < 32 ? s_lo : s_hi; }
                const float r = rsqrtf(ss * (1.f / DV) + RMS_EPS);
                const unsigned long long t8 = tw[u][j];
                const float t0 = bflo((unsigned)t8), t1 = bfhi((unsigned)t8), t2 = bflo((unsigned)(t8 >> 32)), t3 = bfhi((unsigned)(t8 >> 32));
                const float a0 = v.x * r * g[j].x * (t0 * sigmoid_f(t0)), a1 = v.y * r * g[j].y * (t1 * sigmoid_f(t1)), a2 = v.z * r * g[j].z * (t2 * sigmoid_f(t2)), a3 = v.w * r * g[j].w * (t3 * sigmoid_f(t3));
                o8[64 * j] = (unsigned long long)pk2h(a0, a1) | ((unsigned long long)pk2h(a2, a3) << 32);
            } } }
    }
}

#define CE_D(a, b) do { const unsigned mx_ = (a) > (b) ? (a) : (b); const unsigned mn_ = (a) > (b) ? (b) : (a); (a) = mx_; (b) = mn_; } while (0)
__device__ __forceinline__ void sort16_desc(unsigned (&a)[16]) {
#define S16(i, j) CE_D(a[i], a[j])
    S16(0,13); S16(1,12); S16(2,15); S16(3,14); S16(4,8); S16(5,6); S16(7,11); S16(9,10);
    S16(0,5); S16(1,7); S16(2,9); S16(3,4); S16(6,13); S16(8,14); S16(10,15); S16(11,12);
    S16(0,1); S16(2,3); S16(4,5); S16(6,8); S16(7,9); S16(10,11); S16(12,13); S16(14,15);
    S16(0,2); S16(1,3); S16(4,10); S16(5,11); S16(6,7); S16(8,9); S16(12,14); S16(13,15);
    S16(1,2); S16(3,12); S16(4,6); S16(5,7); S16(8,10); S16(9,11); S16(13,14);
    S16(1,4); S16(2,6); S16(5,8); S16(7,10); S16(9,13); S16(11,14);
    S16(2,4); S16(3,6); S16(9,12); S16(11,13);
    S16(3,5); S16(6,8); S16(7,9); S16(10,12);
    S16(3,4); S16(5,6); S16(7,8); S16(9,10); S16(11,12);
    S16(6,7); S16(8,9);
#undef S16
}
__device__ __forceinline__ void merge_top16(unsigned (&a)[16], const unsigned (&b)[16]) {
#pragma unroll
    for (int i = 0; i < 16; ++i) a[i] = a[i] > b[15 - i] ? a[i] : b[15 - i];
#pragma unroll
    for (int j = 8; j > 0; j >>= 1)
#pragma unroll
        for (int i = 0; i < 16; ++i) { const int l = i ^ j; if (l > i) CE_D(a[i], a[l]); }
}
__device__ __forceinline__ void merge_quad(unsigned (&a)[16], int lane) {
    unsigned p[16];
#pragma unroll
    for (int i = 0; i < 16; ++i) p[i] = (unsigned)__builtin_amdgcn_ds_bpermute((lane ^ 16) << 2, (int)a[i]);
    merge_top16(a, p);
#pragma unroll
    for (int i = 0; i < 16; ++i) p[i] = (unsigned)__builtin_amdgcn_ds_bpermute((lane ^ 32) << 2, (int)a[i]);
    merge_top16(a, p);
}
__device__ __forceinline__ unsigned mono_key(float f) { const unsigned u = __float_as_uint(f); return (u & 0x80000000u) ? ~u : (u | 0x80000000u); }
__device__ __forceinline__ float mono_inv(unsigned k) { return __uint_as_float((k & 0x80000000u) ? (k ^ 0x80000000u) : ~k); }
__constant__ __attribute__((aligned(16))) unsigned char PEER_CAND[64] = {0, 1, 2, 3, 4, 5, 6, 7, 8, 9, 10, 11, 12, 13, 14, 15, 16, 17, 18, 19, 20, 21, 22, 23, 32, 33, 34, 35, 36, 64, 65, 66, 48, 49, 50, 51, 80, 81, 96, 97, 112, 113, 128, 144, 160, 176, 192, 208, 224, 240, 255, 255, 255, 255, 255, 255, 255, 255, 255, 255, 255, 255, 255, 255};
typedef _Float16 h8 __attribute__((ext_vector_type(8)));
__device__ __forceinline__ void peer_topk_load(const Ctx& C, int tok0, int head, h8 (&hv)[2][4]) {
    int l = C.lane; asm volatile("" : "+v"(l));
    const _Float16* SC = (const _Float16*)(C.ws + WS_Q2);
#pragma unroll
    for (int p = 0; p < 2; ++p) { const _Float16* sp = SC + (size_t)(tok0 + (l & 15)) * 2048 + head * 256 + p * 128 + 32 * (l >> 4);
#pragma unroll
        for (int q = 0; q < 4; ++q) hv[p][q] = *(const GAS h8*)(sp + 8 * q); }
}
__device__ __forceinline__ void peer_topk_task(const Ctx& C, int layer, int tok0, int head, int trow0, LAS int* lexp, LAS float* lgate, const h8 (&hvin)[2][4]) {
    LAS unsigned* L0 = (LAS unsigned*)(C.lds + C.wave * 2048);
    LAS unsigned* L1 = L0 + 256;
    {
        int l = C.lane; asm volatile("" : "+v"(l));
        const int m = l & 15, g = l >> 4;
        unsigned cand_w[4];
#pragma unroll
        for (int c = 0; c < 4; ++c) cand_w[c] = ((const unsigned*)PEER_CAND)[g * 4 + c];
        unsigned top[2][16];
#pragma unroll
        for (int p = 0; p < 2; ++p) {
            h8 hv[4];
#pragma unroll
            for (int q = 0; q < 4; ++q) hv[q] = hvin[p][q];
            unsigned hi16[16];
#pragma unroll
            for (int q = 0; q < 4; ++q)
#pragma unroll
                for (int j = 0; j < 8; ++j) { const int i = 8 * q + j; const unsigned key = (mono_key((float)hv[q][j]) & ~0x7fu) | (unsigned)(127 - (32 * g + i));
                    if (i < 16) top[p][i] = key; else hi16[i - 16] = key; }
            sort16_desc(top[p]); sort16_desc(hi16); merge_top16(top[p], hi16);
            merge_quad(top[p], l);
        }
        if (g == 0) {
#pragma unroll
            for (int i = 0; i < 16; i += 4) { *(LAS u32x4v*)(L0 + m * 16 + i) = (u32x4v){top[0][i], top[0][i + 1], top[0][i + 2], top[0][i + 3]}; *(LAS u32x4v*)(L1 + m * 16 + i) = (u32x4v){top[1][i], top[1][i + 1], top[1][i + 2], top[1][i + 3]}; }
        }
        asm volatile("s_waitcnt lgkmcnt(0)" ::: "memory"); __builtin_amdgcn_wave_barrier();
        unsigned cd[16];
#pragma unroll
        for (int c = 0; c < 16; ++c) {
            const unsigned code = (cand_w[c >> 2] >> (8 * (c & 3))) & 0xffu, ci = (code >> 4) & 15u, cj = code & 15u;
            const float v = mono_inv(L0[m * 16 + ci]) + mono_inv(L1[m * 16 + cj]);
            cd[c] = code == 255u ? 0u : ((mono_key(v) & ~0xffu) | (255u - code));
        }
        sort16_desc(cd); merge_quad(cd, l);
        if (g == 0) {
            float best[16]; int ex[16]; float sum = 0.f;
#pragma unroll
            for (int r = 0; r < 16; ++r) { const unsigned pos = 255u - (cd[r] & 0xffu), pi = pos >> 4, pj = pos & 15u;
                ex[r] = (int)((127u - (L0[m * 16 + pi] & 0x7fu)) * 128u + (127u - (L1[m * 16 + pj] & 0x7fu))); best[r] = mono_inv(cd[r]); }
            const float bmax = best[0];
#pragma unroll
            for (int r = 0; r < 16; ++r) { best[r] = __expf(best[r] - bmax); sum += best[r]; }
            const float inv = 1.f / sum;
            const int ob = (trow0 + m) * 128 + head * 16;
#pragma unroll
            for (int r = 0; r < 16; r += 4) { *(LAS u32x4v*)(lexp + ob + r) = (u32x4v){(unsigned)ex[r], (unsigned)ex[r + 1], (unsigned)ex[r + 2], (unsigned)ex[r + 3]};
                *(LAS f32x4*)(lgate + ob + r) = (f32x4){best[r] * inv, best[r + 1] * inv, best[r + 2] * inv, best[r + 3] * inv}; }
        }
        asm volatile("s_waitcnt lgkmcnt(0)" ::: "memory"); __builtin_amdgcn_wave_barrier();
    }
}
typedef float f32x2v __attribute__((ext_vector_type(2)));
#define GRP8_SUM(v) do { v = DPP_ADD(v, 0xB1, 0xf, 0xf); v = DPP_ADD(v, 0x4E, 0xf, 0xf); v = DPP_ADD(v, 0x141, 0xf, 0xf); } while (0)
#ifndef MK_HOT
#define MK_HOT 0
#endif
__device__ __forceinline__ void wave_lds_sync() { asm volatile("s_waitcnt lgkmcnt(0)" ::: "memory"); __builtin_amdgcn_wave_barrier(); }
template <bool DRY>
__device__ __forceinline__ void peer_rounds(const Ctx& C, int layer, int tokw, LAS int* lexp_w, const LAS float* lgate_w, LAS unsigned* sorted_w, LAS unsigned* hist_w) {
    const unsigned char* U = C.ws + WS_U + (size_t)layer * 16384 * 1024; const unsigned char* V = C.ws + WS_V + (size_t)layer * 16384 * 1024;
    const LAS unsigned char* SU = (const LAS unsigned char*)(C.lds + 114688); const LAS unsigned char* SV = SU + 16384;
    const float* gf = C.in[2] + layer * 1024; const float* gn = C.in[1] + (layer + 1) * 1024;
    int l = C.lane; asm volatile("" : "+v"(l));
    LAS float* hbuf = (LAS float*)lexp_w;
    {
        const int t = l >> 3, s = l & 7;
#pragma unroll
        for (int k = 0; k < 8; ++k) hist_w[l + 64 * k] = 0u;
        wave_lds_sync();
        unsigned ev[16], pos[16];
#pragma unroll
        for (int k = 0; k < 16; ++k) { ev[k] = (unsigned)lexp_w[t * 128 + s + 8 * k]; pos[k] = __hip_atomic_fetch_add(hist_w + t * 64 + (ev[k] >> 8), 1u, __ATOMIC_RELAXED, __HIP_MEMORY_SCOPE_WORKGROUP); }
        wave_lds_sync();
        unsigned cnt[8], run = 0u;
#pragma unroll
        for (int j = 0; j < 8; ++j) { cnt[j] = hist_w[t * 64 + 8 * s + j]; run += cnt[j]; }
        unsigned inc = run;
#pragma unroll
        for (int o = 1; o < 8; o <<= 1) { const unsigned up = (unsigned)__builtin_amdgcn_ds_bpermute((l - o) << 2, (int)inc); if (s >= o) inc += up; }
        unsigned off = inc - run;
        wave_lds_sync();
#pragma unroll
        for (int j = 0; j < 8; ++j) { hist_w[t * 64 + 8 * s + j] = off; off += cnt[j]; }
        wave_lds_sync();
#pragma unroll
        for (int k = 0; k < 16; ++k) sorted_w[t * 128 + hist_w[t * 64 + (ev[k] >> 8)] + pos[k]] = (ev[k] << 7) | (unsigned)(s + 8 * k);
        wave_lds_sync();
    }
    asm volatile("" : "+v"(l));
    unsigned xp[8][8];
    {
        const int t = l >> 3, s = l & 7;
        const bf16* hrow = (const bf16*)(C.ws + WS_HB) + (size_t)(tokw + t) * 1024 + 16 * s;
        float ss = 0.f;
#pragma unroll
        for (int i = 0; i < 8; ++i) { const v4u a = *(const GAS v4u*)(hrow + 128 * i), b = *(const GAS v4u*)(hrow + 128 * i + 8);
            xp[i][0] = a.x; xp[i][1] = a.y; xp[i][2] = a.z; xp[i][3] = a.w; xp[i][4] = b.x; xp[i][5] = b.y; xp[i][6] = b.z; xp[i][7] = b.w;
#pragma unroll
            for (int j = 0; j < 8; ++j) { const float lo = bflo(xp[i][j]), hi = bfhi(xp[i][j]); ss += lo * lo + hi * hi; } }
        GRP8_SUM(ss);
        const float r = rsqrtf(ss * (1.f / 1024.f) + RMS_EPS);
#pragma unroll
        for (int i = 0; i < 8; ++i)
#pragma unroll
            for (int q = 0; q < 4; ++q) { const f32x4 a = *(const GAS f32x4*)(gf + 16 * s + 128 * i + 4 * q);
                xp[i][2 * q] = pk2(bflo(xp[i][2 * q]) * r * a.x, bfhi(xp[i][2 * q]) * r * a.y); xp[i][2 * q + 1] = pk2(bflo(xp[i][2 * q + 1]) * r * a.z, bfhi(xp[i][2 * q + 1]) * r * a.w); }
    }
    asm volatile("" : "+v"(l));
#define RND_LOAD(T, buf, item) do { const unsigned char* p_ = T + (size_t)((DRY && MK_HOT) ? (((item) >> 7) & 255u) : ((item) >> 7)) * 1024 + 16 * (l & 7); \
        _Pragma("unroll") for (int i = 0; i < 8; ++i) buf[i] = *(const GAS v4u*)(p_ + 128 * i); } while (0)
    {
        const int t = l >> 3, s = l & 7;
        const LAS unsigned* srt = sorted_w + t * 128;
        v4u bA[8], bB[8];
#define RND_DOT(buf, r_) do { float d = 0.f; \
            _Pragma("unroll") for (int i = 0; i < 8; ++i) { asm volatile("" : "+v"(buf[i])); _Pragma("unroll") for (int q = 0; q < 4; ++q) { \
                const f32x2v lo_ = __builtin_amdgcn_cvt_pk_f32_fp8((int)buf[i][q], false), hi_ = __builtin_amdgcn_cvt_pk_f32_fp8((int)buf[i][q], true); \
                d = dot2bf(pg8::cvt_pk_bf16(lo_.x, lo_.y), xp[i][2 * q], d); d = dot2bf(pg8::cvt_pk_bf16(hi_.x, hi_.y), xp[i][2 * q + 1], d); } } \
            GRP8_SUM(d); if (s == 0) hbuf[t * 128 + (r_)] = d; } while (0)
        RND_LOAD(U, bA, srt[0]);
#pragma unroll 1
        for (int r = 0; r < 128; r += 2) {
            RND_LOAD(U, bB, srt[r + 1]);
            RND_DOT(bA, r);
            RND_LOAD(U, bA, srt[(r + 2) & 127]);
            RND_DOT(bB, r + 1);
        }
#undef RND_DOT
    }
    wave_lds_sync();
    asm volatile("" : "+v"(l));
    {
        const int t = l >> 3, s = l & 7;
#pragma unroll
        for (int k = 0; k < 16; k += 2) {
            const int r0 = t * 128 + s + 8 * k, r1 = r0 + 8;
            const unsigned i0 = sorted_w[r0], i1 = sorted_w[r1];
            const float h0 = hbuf[r0] * __uint_as_float((unsigned)SU[i0 >> 7] << 23), h1 = hbuf[r1] * __uint_as_float((unsigned)SU[i1 >> 7] << 23);
            const pg8::f32x2 gl = pg8::gelu_pk((pg8::f32x2){h0, h1});
            hbuf[r0] = gl.x * lgate_w[t * 128 + (i0 & 127u)] * __uint_as_float((unsigned)SV[i0 >> 7] << 23); hbuf[r1] = gl.y * lgate_w[t * 128 + (i1 & 127u)] * __uint_as_float((unsigned)SV[i1 >> 7] << 23);
        }
    }
    wave_lds_sync();
    asm volatile("" : "+v"(l));
    f32x2v y2[8][8];
#pragma unroll
    for (int i = 0; i < 8; ++i)
#pragma unroll
        for (int j = 0; j < 8; ++j) y2[i][j] = (f32x2v){0.f, 0.f};
    {
        const int t = l >> 3;
        const LAS unsigned* srt = sorted_w + t * 128; const LAS float* wv = hbuf + t * 128;
        v4u bA[8], bB[8];
#define RND_AXPY(buf, r_) do { const float w = wv[(r_)]; const f32x2v w2 = (f32x2v){w, w}; \
            _Pragma("unroll") for (int i = 0; i < 8; ++i) { asm volatile("" : "+v"(buf[i])); _Pragma("unroll") for (int q = 0; q < 4; ++q) { \
                const f32x2v lo_ = __builtin_amdgcn_cvt_pk_f32_fp8((int)buf[i][q], false), hi_ = __builtin_amdgcn_cvt_pk_f32_fp8((int)buf[i][q], true); \
                y2[i][2 * q] = w2 * lo_ + y2[i][2 * q]; y2[i][2 * q + 1] = w2 * hi_ + y2[i][2 * q + 1]; } } } while (0)
        RND_LOAD(V, bA, srt[0]);
#pragma unroll 1
        for (int r = 0; r < 128; r += 2) {
            RND_LOAD(V, bB, srt[r + 1]);
            RND_AXPY(bA, r);
            RND_LOAD(V, bA, srt[(r + 2) & 127]);
            RND_AXPY(bB, r + 1);
        }
#undef RND_AXPY
    }
#undef RND_LOAD
    asm volatile("" : "+v"(l));
    {
        const int t = l >> 3, s = l & 7;
        const bf16* hrow = (const bf16*)(C.ws + WS_HB) + (size_t)(tokw + t) * 1024 + 16 * s;
        float* hout = (DRY ? (float*)(C.ws + WS_OF) : C.out) + (size_t)(tokw + t) * 1024 + 16 * s;
        bf16* hb = (bf16*)(C.ws + (DRY ? WS_OF : WS_HB)) + (size_t)(tokw + t) * 1024 + 16 * s;
        float s2 = 0.f;
#pragma unroll
        for (int i = 0; i < 8; ++i) { const v4u a = *(const GAS v4u*)(hrow + 128 * i), b = *(const GAS v4u*)(hrow + 128 * i + 8);
            const unsigned hw[8] = {a.x, a.y, a.z, a.w, b.x, b.y, b.z, b.w};
#pragma unroll
            for (int j = 0; j < 8; ++j) { y2[i][j].x += bflo(hw[j]); y2[i][j].y += bfhi(hw[j]); s2 += y2[i][j].x * y2[i][j].x + y2[i][j].y * y2[i][j].y; }
            if (layer == DEPTH - 1) {
#pragma unroll
                for (int q = 0; q < 4; ++q) *(GAS f32x4*)(hout + 128 * i + 4 * q) = (f32x4){y2[i][2 * q].x, y2[i][2 * q].y, y2[i][2 * q + 1].x, y2[i][2 * q + 1].y};
            } else {
                *(GAS v4u*)(hb + 128 * i) = (v4u){pk2(y2[i][0].x, y2[i][0].y), pk2(y2[i][1].x, y2[i][1].y), pk2(y2[i][2].x, y2[i][2].y), pk2(y2[i][3].x, y2[i][3].y)};
                *(GAS v4u*)(hb + 128 * i + 8) = (v4u){pk2(y2[i][4].x, y2[i][4].y), pk2(y2[i][5].x, y2[i][5].y), pk2(y2[i][6].x, y2[i][6].y), pk2(y2[i][7].x, y2[i][7].y)};
            } }
        if (layer < DEPTH - 1) {
            GRP8_SUM(s2);
            const float r2 = rsqrtf(s2 * (1.f / 1024.f) + RMS_EPS);
            const bool wx8 = ((I8MASK >> (layer + 1)) & 1) != 0, wxn = ((layer + 1) % 3 != 2) || !wx8;
            bf16* xo = (bf16*)(C.ws + (DRY ? WS_GLOG : WS_XN)) + (size_t)(tokw + t) * 1024 + 16 * s; float am = 0.f;
#pragma unroll
            for (int i = 0; i < 8; ++i) { unsigned pw[8];
#pragma unroll
                for (int q = 0; q < 4; ++q) { const f32x4 a = *(const GAS f32x4*)(gn + 16 * s + 128 * i + 4 * q);
                    y2[i][2 * q].x *= r2 * a.x; y2[i][2 * q].y *= r2 * a.y; y2[i][2 * q + 1].x *= r2 * a.z; y2[i][2 * q + 1].y *= r2 * a.w;
                    am = fmaxf(fmaxf(am, fmaxf(fabsf(y2[i][2 * q].x), fabsf(y2[i][2 * q].y))), fmaxf(fabsf(y2[i][2 * q + 1].x), fabsf(y2[i][2 * q + 1].y)));
                    pw[2 * q] = pk2(y2[i][2 * q].x, y2[i][2 * q].y); pw[2 * q + 1] = pk2(y2[i][2 * q + 1].x, y2[i][2 * q + 1].y); }
                if (wxn) { *(GAS v4u*)(xo + 128 * i) = (v4u){pw[0], pw[1], pw[2], pw[3]}; *(GAS v4u*)(xo + 128 * i + 8) = (v4u){pw[4], pw[5], pw[6], pw[7]}; } }
            if (wx8) {
            am = DPP_MAX(am, 0xB1, 0xf, 0xf); am = DPP_MAX(am, 0x4E, 0xf, 0xf); am = DPP_MAX(am, 0x141, 0xf, 0xf);
            const float qi = am > 0.f ? 127.f / am : 0.f;
            signed char* xq = (signed char*)(C.ws + (DRY ? WS_GLOG + 32 * MiB : WS_XN8)) + (size_t)(tokw + t) * 1024 + 16 * s;
#pragma unroll
            for (int i = 0; i < 8; ++i) { unsigned pq[4];
#pragma unroll
                for (int q = 0; q < 4; ++q) pq[q] = q8x4(y2[i][2 * q].x * qi, y2[i][2 * q].y * qi, y2[i][2 * q + 1].x * qi, y2[i][2 * q + 1].y * qi);
                *(GAS v4u*)(xq + 128 * i) = (v4u){pq[0], pq[1], pq[2], pq[3]}; }
            if (s == 0) *(GAS float*)((float*)(C.ws + (DRY ? WS_GLOG + 48 * MiB : WS_SX)) + tokw + t) = am * (1.f / 127.f);
            }
        }
    }
}
#ifndef MK_SWEEP
#define MK_SWEEP 2
#endif
template <bool DRY>
__device__ __forceinline__ void peer_topk_gather(const Ctx& C, int layer) {
    LAS int* lexp = (LAS int*)(C.lds + 16384);
    LAS float* lgate = (LAS float*)(C.lds + 16384 + 32768);
    LAS unsigned* sorted = (LAS unsigned*)(C.lds + 16384 + 65536);
    {
        int tid = C.tid; asm volatile("" : "+v"(tid));
        const v4u a0 = *(const GAS v4u*)(C.ws + WS_SU + (size_t)layer * 16384 + tid * 32), a1 = *(const GAS v4u*)(C.ws + WS_SU + (size_t)layer * 16384 + tid * 32 + 16);
        const v4u b0 = *(const GAS v4u*)(C.ws + WS_SV + (size_t)layer * 16384 + tid * 32), b1 = *(const GAS v4u*)(C.ws + WS_SV + (size_t)layer * 16384 + tid * 32 + 16);
        LAS unsigned char* lsc = C.lds + 114688;
        *(LAS v4u*)(lsc + tid * 32) = a0; *(LAS v4u*)(lsc + tid * 32 + 16) = a1; *(LAS v4u*)(lsc + 16384 + tid * 32) = b0; *(LAS v4u*)(lsc + 16384 + tid * 32 + 16) = b1;
    }
    for (int tb = C.vcu; tb < NTOK / 64; tb += C.G) {
        {
            h8 hva[2][4], hvb[2][4];
            const int tk0 = tb * 64 + (C.wave & 3) * 16, hd0 = (C.wave >> 2) * 4, tr0 = (C.wave & 3) * 16;
            peer_topk_load(C, tk0, hd0, hva);
#pragma unroll 1
            for (int q = 0; q < 4; q += 2) {
                peer_topk_load(C, tk0, hd0 + q + 1, hvb);
                peer_topk_task(C, layer, tk0, hd0 + q, tr0, lexp, lgate, hva);
                if (q + 2 < 4) peer_topk_load(C, tk0, hd0 + q + 2, hva);
                peer_topk_task(C, layer, tk0, hd0 + q + 1, tr0, lexp, lgate, hvb);
            }
        }
        __syncthreads();
#if MK_SWEEP == 2
        peer_rounds<DRY>(C, layer, tb * 64 + C.wave * 8, lexp + C.wave * 1024, lgate + C.wave * 1024, sorted + C.wave * 1024, (LAS unsigned*)(C.lds + C.wave * 2048));
#elif MK_SWEEP == 1
#error removed variant
        peer_sweep<DRY>(C, layer, tb * 64 + C.wave * 8, lexp + C.wave * 1024, lgate + C.wave * 1024, sorted + C.wave * 1024, (LAS unsigned*)(C.lds + C.wave * 1024));
#else
#pragma unroll 1
        for (int t = 0; t < 8; ++t) peer_gather_token<DRY>(C, layer, tb * 64 + C.wave * 8 + t, lexp + (C.wave * 8 + t) * 128, lgate + (C.wave * 8 + t) * 128);
#endif
        __syncthreads();
    }
}

#ifndef MK_SINGLE
#define MK_SINGLE 1
#endif
#ifndef MK_FASTGEMM
#define MK_FASTGEMM 1
#endif
constexpr int STEPS = 10, NPHASE = 1 + DEPTH * STEPS;
struct Args { const float* in[21]; float* out; unsigned char* ws; int ph_lo, ph_hi; };

template <int EPI>
__device__ __forceinline__ void do_gemm(const Ctx& C, const bf16* A, const bf16* Bt, int N, bf16* Ob, int ldc, int split, const float* rs_in, const float* base, float* outf, bf16* hg, const float* gain, float* rs_out) {
    pg8::Gemm g{A, Bt, NTOK, N, 1024}; pg8::StaticOrder S; S.init(NTOK, N, C.G, C.bx);
    if constexpr (EPI == 0) { pg8::EpiBf16R<false> E{Ob, ldc, split ? 1024 : 0, PSTRIDE, rs_in}; pg8::gemm_phase<pg8::EpiBf16R<false>, pg8::StaticOrder, true, true>(C.lds, g, S, E, C.tid); }
    else if constexpr (EPI == 2) { pg8::EpiBf16R<true> E{Ob, ldc, 0, PSTRIDE, rs_in}; pg8::gemm_phase<pg8::EpiBf16R<true>, pg8::StaticOrder, true, true>(C.lds, g, S, E, C.tid); }
    else if constexpr (EPI == 3) {
        pg8::Gemm g8{A, Bt, NTOK, N, 512}; pg8::EpiI8<false> E{Ob, PSTRIDE, rs_in, gain, nullptr, nullptr, 1.f}; pg8::gemm_phase<pg8::EpiI8<false>, pg8::StaticOrder, true, true>(C.lds, g8, S, E, C.tid); }
    else if constexpr (EPI == 4) {
        pg8::Gemm g8{A, Bt, NTOK, N, 512}; pg8::EpiI8<true> E{Ob, PSTRIDE, rs_in, gain, base, (const float*)outf, FOX_C2}; pg8::gemm_phase<pg8::EpiI8<true>, pg8::StaticOrder, true, true>(C.lds, g8, S, E, C.tid); }
    else {
        bf16* HB = (bf16*)(C.ws + WS_HB); (void)outf;
        if (base) { pg8::EpiResNorm<false> E{base, HB, hg, gain, rs_out}; pg8::gemm_phase<pg8::EpiResNorm<false>, pg8::StaticOrder, true, true>(C.lds, g, S, E, C.tid); }
        else { pg8::EpiResNorm<true> E{HB, HB, hg, gain, rs_out}; pg8::gemm_phase<pg8::EpiResNorm<true>, pg8::StaticOrder, true, true>(C.lds, g, S, E, C.tid); } }
}

template <int STEP, int MIXER>
__device__ __forceinline__ void run_step(const Ctx& C, int layer) {
    const int jx = layer / 3;
    bf16* XN = (bf16*)(C.ws + WS_XN); bf16* P = (bf16*)(C.ws + WS_P); bf16* OB = (bf16*)(C.ws + WS_OB); bf16* Q2 = (bf16*)(C.ws + WS_Q2);
    if constexpr (STEP == 0) {
        const bf16* Wt = MIXER == 0 ? (const bf16*)(C.ws + WS_FOXWIN + (size_t)jx * 8 * MiB) : MIXER == 1 ? (const bf16*)(C.ws + WS_GLAWIN) : (const bf16*)(C.ws + WS_HGRNWIN);
        const float* sw = (const float*)(C.ws + WS_SW) + (MIXER == 0 ? jx * 4096 : MIXER == 1 ? 8192 : 11264);
        if (FOXFUSE && MIXER == 0) { do_gemm<4>(C, (const bf16*)(C.ws + WS_XN8), Wt, 4096, P, 1024, 1, (const float*)(C.ws + WS_SX), C.in[5] + jx * 64, (float*)(C.in[6] + jx * 64), nullptr, sw, nullptr); fox_step1<false>(C, jx); }
        else if ((I8MASK >> layer) & 1) do_gemm<3>(C, (const bf16*)(C.ws + WS_XN8), Wt, MIXER == 1 ? 3072 : 4096, P, 1024, 1, (const float*)(C.ws + WS_SX), nullptr, nullptr, nullptr, sw, nullptr);
        else do_gemm<0>(C, XN, Wt, MIXER == 1 ? 3072 : 4096, P, 1024, 1, nullptr, nullptr, nullptr, nullptr, nullptr, nullptr);
    } else if constexpr (STEP == 1) {
        if constexpr (MIXER == 0) { if (!FOXFUSE) fox_step1<true>(C, jx); }
    } else if constexpr (STEP == 2) {
        if constexpr (MIXER == 1) chunk_prepass<4>(C); else if constexpr (MIXER == 2) chunk_prepass<8>(C);
    } else if constexpr (STEP == 3) {
        if constexpr (MIXER == 0) {
            float gq = 0.f, gk = 0.f;
            for (int i = 0; i < 64; ++i) { gq = fmaxf(gq, fabsf(C.in[5][jx * 64 + i])); gk = fmaxf(gk, fabsf(C.in[6][jx * 64 + i])); }
            const float smax = 64.f * gq * gk * 0.125f * 1.4426950408889634f;
            const attn_body::AttnTensors AT{(const attn_body::bf16*)P, (const attn_body::bf16*)(P + PSTRIDE), (const attn_body::bf16*)(P + 2 * PSTRIDE), (attn_body::bf16*)OB, (const attn_body::bf16*)(P + 3 * PSTRIDE), (const float*)(C.ws + WS_TAIL), -(56.f + 2.f * smax)};
            const attn_body::StaticOrder S(C.G, C.bx);
            attn_body::attn_phase<attn_body::StaticOrder>((char*)C.lds, AT, S, C.tid);
        }
        else if constexpr (MIXER == 1) chunk_recur<4, 256>(C, P + PSTRIDE);
        else chunk_recur<8, 128>(C, P + 2 * PSTRIDE);
    } else if constexpr (STEP == 4) {
        if constexpr (MIXER == 1) rec_norm_gate<256>(C, C.in[11], P + 2 * PSTRIDE);
        else if constexpr (MIXER == 2) rec_norm_gate<128>(C, C.in[15], P + 3 * PSTRIDE);
    } else if constexpr (STEP == 5) {
        const bf16* Wt = MIXER == 0 ? (const bf16*)(C.ws + WS_FOXWOUT) + (size_t)jx * 1024 * 1024 : MIXER == 1 ? (const bf16*)(C.ws + WS_GLAWOUT) : (const bf16*)(C.ws + WS_HGRNWOUT);
        do_gemm<1>(C, OB, Wt, 1024, nullptr, 0, 0, nullptr, layer == 0 ? C.in[0] : nullptr, nullptr, XN, C.in[2] + layer * 1024, (float*)(C.ws + WS_RS));
    } else if constexpr (STEP == 6) {
    } else if constexpr (STEP == 7) {
        do_gemm<2>(C, XN, (const bf16*)(C.ws + WS_PEERWQ) + (size_t)layer * 2048 * 1024, 2048, Q2, 2048, 0, (const float*)(C.ws + WS_RS), nullptr, nullptr, nullptr, nullptr, nullptr);
    } else if constexpr (STEP == 8) {
        peer_topk_gather<false>(C, layer);
    } else if constexpr (STEP == 9) {
    } else if constexpr (STEP == 11) {
        peer_topk_gather<true>(C, layer);
    } else if constexpr (STEP == 12) {
        p0_prologue_b(C);
    } else {
        p0_prologue(C);
    }
}

__device__ __forceinline__ void make_ctx(Ctx& C, const Args& args, unsigned char* lds_raw) {
    C.lds = (LAS unsigned char*)lds_raw;
    C.tid = threadIdx.x; C.lane = C.tid & 63; C.wave = __builtin_amdgcn_readfirstlane(C.tid >> 6);
    C.G = gridDim.x; C.bx = blockIdx.x; { const int bx = blockIdx.x; C.vcu = (C.G % 8 == 0) ? (bx % 8) * (C.G / 8) + bx / 8 : bx; }
    C.gw = C.vcu * NWAVES + C.wave; C.NGW = C.G * NWAVES;
#pragma unroll
    for (int i = 0; i < 21; ++i) C.in[i] = args.in[i];
    C.out = args.out; C.ws = args.ws;
}

template <int STEP, int MIXER>
__global__ void __launch_bounds__(NWAVES * 64, 2) mk_phase(Args args, int layer) {
    extern __shared__ __attribute__((aligned(16))) unsigned char lds_raw[];
    Ctx C; make_ctx(C, args, lds_raw);
    run_step<STEP, MIXER>(C, layer);
}

template <int STEP, int MIXER>
static void launch_phase(const Args& a, int layer, int grid, hipStream_t stream) {
    static bool attr_set = false;
    if (!attr_set) { (void)hipFuncSetAttribute((const void*)mk_phase<STEP, MIXER>, hipFuncAttributeMaxDynamicSharedMemorySize, LDS_BYTES); attr_set = true; }
    hipLaunchKernelGGL((mk_phase<STEP, MIXER>), dim3(grid), dim3(NWAVES * 64), LDS_BYTES, stream, a, layer);
}
#ifndef MK_DUP
#define MK_DUP -1
#endif
#define LP(S, M) do { launch_phase<S, M>(a, layer, grid, stream); if (MK_DUP == S) launch_phase<(S == 8 ? 11 : S), M>(a, layer, grid, stream); } while (0)
template <int MIXER>
static void launch_layer(const Args& a, int layer, int grid, hipStream_t stream) {
    LP(0, MIXER);
    if (MIXER == 0) launch_phase<1, MIXER>(a, layer, grid, stream); else LP(2, MIXER);
    LP(3, MIXER);
    if (MIXER != 0) LP(4, MIXER);
    LP(5, MIXER);
    LP(7, 0);
    LP(8, 0);
}
#if MK_SINGLE
__device__ __forceinline__ const float* tab_ptr(volatile LAS unsigned long long* tab, int i) {
    const unsigned long long v = tab[i];
    const unsigned lo = __builtin_amdgcn_readfirstlane((unsigned)v), hi = __builtin_amdgcn_readfirstlane((unsigned)(v >> 32));
    return (const float*)(const GAS float*)(((unsigned long long)hi << 32) | lo);
}
__device__ __forceinline__ int lane_id_volatile() { int x; asm volatile("v_mbcnt_lo_u32_b32 %0, -1, 0\n\tv_mbcnt_hi_u32_b32 %0, -1, %0" : "=v"(x)); return x; }
__device__ __forceinline__ void make_ctx_opaque(Ctx& C, unsigned char* lds_raw, int wave_s) {
    int bx = blockIdx.x, G = gridDim.x; unsigned ldso = 0u;
    asm volatile("" : "+s"(bx), "+s"(G), "+s"(ldso), "+s"(wave_s));
    int tid = wave_s * 64 + lane_id_volatile();
    C.lds = (LAS unsigned char*)lds_raw + ldso;
    volatile LAS unsigned long long* tab = (volatile LAS unsigned long long*)(C.lds + LDSCTL_OFF);
    C.tid = tid; C.lane = tid & 63; C.wave = __builtin_amdgcn_readfirstlane(tid >> 6);
    C.G = G; C.bx = bx; C.vcu = (G % 8 == 0) ? (bx % 8) * (G / 8) + bx / 8 : bx;
    C.gw = C.vcu * NWAVES + C.wave; C.NGW = G * NWAVES;
#pragma unroll
    for (int i = 0; i < 21; ++i) C.in[i] = tab_ptr(tab, i);
    C.out = (float*)tab_ptr(tab, 21); C.ws = (unsigned char*)tab_ptr(tab, 22);
}
__device__ __forceinline__ void grid_bar(unsigned char* lds_raw, int wave_s) {
    unsigned ldso = 0u; asm volatile("" : "+s"(ldso), "+s"(wave_s));
    LAS unsigned char* lds = (LAS unsigned char*)lds_raw + ldso;
    volatile LAS unsigned long long* tab = (volatile LAS unsigned long long*)(lds + LDSCTL_OFF);
    XcdBarrier b; b.bar = (unsigned*)((unsigned char*)tab_ptr(tab, 22) + WS_CTL) + CW_BAR; b.x = xb_xcc_id(); b.st = (volatile LAS unsigned*)(lds + MISC_OFF) + 8;
    xcd_barrier(b, wave_s == 0 && lane_id_volatile() == 0);
}
#define MK_STEP(...) do { Ctx C; make_ctx_opaque(C, lds_raw, wave_s); __VA_ARGS__; } while (0)
__global__ void __launch_bounds__(NWAVES * 64, 2) mk_fwd(Args args) {
    extern __shared__ __attribute__((aligned(16))) unsigned char lds_raw[];
    const int wave_s = __builtin_amdgcn_readfirstlane(threadIdx.x >> 6);
    for (int u = threadIdx.x; u < (LDS_BYTES - LDSCTL_OFF) / 4; u += NWAVES * 64) ((LAS unsigned*)((LAS unsigned char*)lds_raw + LDSCTL_OFF))[u] = 0u;
    __syncthreads();
    if (threadIdx.x == 0) {
        LAS unsigned long long* tab = (LAS unsigned long long*)((LAS unsigned char*)lds_raw + LDSCTL_OFF);
#pragma unroll
        for (int i = 0; i < 21; ++i) tab[i] = (unsigned long long)args.in[i];
        tab[21] = (unsigned long long)args.out; tab[22] = (unsigned long long)args.ws;
    }
    (void)xcd_barrier_post((unsigned*)(args.ws + WS_CTL) + CW_BAR, (volatile LAS unsigned*)((LAS unsigned char*)lds_raw + MISC_OFF) + 8);
    __syncthreads();
    MK_STEP(p0_prologue(C));
    if (I8_NITEMS) { grid_bar(lds_raw, wave_s); MK_STEP(p0_prologue_b(C)); }
    cg::this_grid().sync();
#pragma unroll 1
    for (int layer = 0; layer < DEPTH; ++layer) {
        const int mixer = layer % 3, jx = layer / 3;
        MK_STEP(const bf16* Wt = mixer == 0 ? (const bf16*)(C.ws + WS_FOXWIN + (size_t)jx * 8 * MiB) : mixer == 1 ? (const bf16*)(C.ws + WS_GLAWIN) : (const bf16*)(C.ws + WS_HGRNWIN);
                const float* sw = (const float*)(C.ws + WS_SW) + (mixer == 0 ? jx * 4096 : mixer == 1 ? 8192 : 11264);
                if (FOXFUSE && mixer == 0) { do_gemm<4>(C, (const bf16*)(C.ws + WS_XN8), Wt, 4096, (bf16*)(C.ws + WS_P), 1024, 1, (const float*)(C.ws + WS_SX), C.in[5] + jx * 64, (float*)(C.in[6] + jx * 64), nullptr, sw, nullptr);
                    fox_step1<false>(C, jx); }
                else if (I8MASK == 15 || (I8MASK != 0 && ((I8MASK >> layer) & 1))) do_gemm<3>(C, (const bf16*)(C.ws + WS_XN8), Wt, mixer == 1 ? 3072 : 4096, (bf16*)(C.ws + WS_P), 1024, 1, (const float*)(C.ws + WS_SX), nullptr, nullptr, nullptr, sw, nullptr);
                else do_gemm<0>(C, (const bf16*)(C.ws + WS_XN), Wt, mixer == 1 ? 3072 : 4096, (bf16*)(C.ws + WS_P), 1024, 1, nullptr, nullptr, nullptr, nullptr, nullptr, nullptr));
        grid_bar(lds_raw, wave_s);
#if GPROBE == 1
        MK_STEP(const bf16* Wt = mixer == 0 ? (const bf16*)(C.ws + WS_FOXWIN + (size_t)jx * 8 * MiB) : mixer == 1 ? (const bf16*)(C.ws + WS_GLAWIN) : (const bf16*)(C.ws + WS_HGRNWIN);
                const float* sw = (const float*)(C.ws + WS_SW) + (mixer == 0 ? jx * 4096 : mixer == 1 ? 8192 : 11264);
                if (FOXFUSE && mixer == 0) { do_gemm<4>(C, (const bf16*)(C.ws + WS_XN8), Wt, 4096, (bf16*)(C.ws + WS_P), 1024, 1, (const float*)(C.ws + WS_SX), C.in[5] + jx * 64, (float*)(C.in[6] + jx * 64), nullptr, sw, nullptr);
                    fox_step1<false>(C, jx); }
                else if (I8MASK == 15 || (I8MASK != 0 && ((I8MASK >> layer) & 1))) do_gemm<3>(C, (const bf16*)(C.ws + WS_XN8), Wt, mixer == 1 ? 3072 : 4096, (bf16*)(C.ws + WS_P), 1024, 1, (const float*)(C.ws + WS_SX), nullptr, nullptr, nullptr, sw, nullptr);
                else do_gemm<0>(C, (const bf16*)(C.ws + WS_XN), Wt, mixer == 1 ? 3072 : 4096, (bf16*)(C.ws + WS_P), 1024, 1, nullptr, nullptr, nullptr, nullptr, nullptr, nullptr));
        grid_bar(lds_raw, wave_s);
#endif
        if (!(FOXFUSE && mixer == 0)) {
        MK_STEP(if (mixer == 0) run_step<1, 0>(C, layer); else if (mixer == 1) run_step<2, 1>(C, layer); else run_step<2, 2>(C, layer));
        grid_bar(lds_raw, wave_s); }
        MK_STEP(if (mixer == 0) run_step<3, 0>(C, layer); else if (mixer == 1) run_step<3, 1>(C, layer); else run_step<3, 2>(C, layer));
        grid_bar(lds_raw, wave_s);
#if RPROBE
        if (mixer != 0) { MK_STEP(if (mixer == 1) chunk_recur<4, 256, RPROBE>(C, (const bf16*)(C.ws + WS_P) + PSTRIDE); else chunk_recur<8, 128, RPROBE>(C, (const bf16*)(C.ws + WS_P) + 2 * PSTRIDE)); grid_bar(lds_raw, wave_s); }
#endif
        if (mixer != 0) { MK_STEP(if (mixer == 1) run_step<4, 1>(C, layer); else run_step<4, 2>(C, layer)); grid_bar(lds_raw, wave_s); }
        MK_STEP(const bf16* Wt = mixer == 0 ? (const bf16*)(C.ws + WS_FOXWOUT) + (size_t)jx * 1024 * 1024 : mixer == 1 ? (const bf16*)(C.ws + WS_GLAWOUT) : (const bf16*)(C.ws + WS_HGRNWOUT);
                do_gemm<1>(C, (const bf16*)(C.ws + WS_OB), Wt, 1024, nullptr, 0, 0, nullptr, layer == 0 ? C.in[0] : nullptr, nullptr, (bf16*)(C.ws + WS_XN), C.in[2] + layer * 1024, (float*)(C.ws + WS_RS)));
        grid_bar(lds_raw, wave_s);
        MK_STEP(run_step<7, 0>(C, layer));
        grid_bar(lds_raw, wave_s);
#if GPROBE == 7
        MK_STEP(run_step<7, 0>(C, layer));
        grid_bar(lds_raw, wave_s);
#endif
        MK_STEP(run_step<8, 0>(C, layer));
        if (layer + 1 < DEPTH) grid_bar(lds_raw, wave_s);
    }
}
#endif

extern "C" void kernel_launch(void* const* d_in, const int* in_sizes, int n_in, void* d_out, int out_size, void* d_ws, size_t ws_size, hipStream_t stream) {
    static int grid = 0;
    if (grid == 0) {
        if (n_in != 21 || out_size != NTOK * 1024 || ws_size < WS_END) { fprintf(stderr, "kernel_launch: unexpected shapes: n_in %d out %d ws %zu (need %zu)\n", n_in, out_size, ws_size, (size_t)WS_END); grid = -1; return; }
        int dev = 0, cus = 0, per_cu = 0;
        (void)hipGetDevice(&dev); (void)hipDeviceGetAttribute(&cus, hipDeviceAttributeMultiprocessorCount, dev);
#if MK_SINGLE
        if (hipFuncSetAttribute((const void*)mk_fwd, hipFuncAttributeMaxDynamicSharedMemorySize, LDS_BYTES) != hipSuccess) { fprintf(stderr, "kernel_launch: hipFuncSetAttribute failed\n"); grid = -1; return; }
        if (hipOccupancyMaxActiveBlocksPerMultiprocessor(&per_cu, (const void*)mk_fwd, NWAVES * 64, LDS_BYTES) != hipSuccess || per_cu < 1) { fprintf(stderr, "kernel_launch: occupancy query says %d blocks per CU\n", per_cu); (void)hipGetLastError(); grid = -1; return; }
#endif
        (void)per_cu;
        grid = cus;
    }
    if (grid < 0) return;
    Args a{};
    for (int i = 0; i < 21; ++i) a.in[i] = (const float*)d_in[i];
    a.out = (float*)d_out; a.ws = (unsigned char*)d_ws;
#if MK_SINGLE
    (void)hipMemsetAsync((char*)d_ws + WS_CTL, 0, CTL_ZERO_BYTES, stream);
    a.ph_lo = 0; a.ph_hi = NPHASE;
    void* kargs[] = {&a};
    hipError_t e = hipLaunchCooperativeKernel((const void*)mk_fwd, dim3(grid), dim3(NWAVES * 64), kargs, LDS_BYTES, stream);
    if (e != hipSuccess) fprintf(stderr, "cooperative launch failed: %s (grid %d)\n", hipGetErrorString(e), grid);
#else
    (void)hipMemsetAsync((char*)d_ws + WS_CTL, 0, CTL_ZERO_BYTES, stream);
    launch_phase<10, 0>(a, 0, grid, stream); if (MK_DUP == 10) launch_phase<10, 0>(a, 0, grid, stream);
    launch_phase<12, 0>(a, 0, grid, stream);
    launch_layer<0>(a, 0, grid, stream);
    launch_layer<1>(a, 1, grid, stream);
    launch_layer<2>(a, 2, grid, stream);
    launch_layer<0>(a, 3, grid, stream);
#endif
}
```

```cpp
#include <hip/hip_runtime.h>
#include <hip/hip_cooperative_groups.h>
#include <cstdio>
#include <cstdint>
#include <cmath>
namespace pg8 {
#define PG8_LAS __attribute__((address_space(3)))
typedef unsigned short bf16_t;
typedef short bf16x8 __attribute__((ext_vector_type(8)));
typedef float f32x4 __attribute__((ext_vector_type(4)));
typedef unsigned u32x4 __attribute__((ext_vector_type(4)));
typedef int i32x4 __attribute__((ext_vector_type(4)));
constexpr int BM = 256, BK = 64, HALF = 128, HTB = HALF * BK * 2  , STAGE_BYTES = 8 * HTB, NXCD = 8, WGM = 8;

__host__ __device__ __forceinline__ int lds_byte(int r, int c) { const int st = (r >> 4) * 2 + (c >> 5), rr = r & 15, cc = c & 31, ob = rr * 64 + cc * 2; return st * 1024 + (ob ^ (((ob >> 9) & 1) << 5)); }
__host__ __device__ __forceinline__ void stage_rc(int b, int& R, int& C) { const int st = b / 1024, sb = b % 1024, swz = sb ^ (((sb >> 9) & 1) << 5); R = (st >> 1) * 16 + swz / 64; C = (st & 1) * 32 + (swz % 64) / 2; }
__host__ __device__ __forceinline__ int perm32(int rho) { const int n = rho >> 4, i = rho & 15; return 8 * (i >> 2) + 4 * n + (i & 3); }

struct Unit { int pm, pn; };
struct Gemm { const bf16_t* A; const bf16_t* Bt; int M, N, K; };

struct StaticOrder {
    int nM, nN, nwg, G, c;
    __host__ __device__ void init(int M, int N, int G_, int c_) { nM = M / BM; nN = N / BM; nwg = nM * nN; G = G_; c = c_; }
    __host__ __device__ bool next(int i, Unit& u) const {
        const long L = (long)i * G + c; if (L >= nwg) return false;
        int wgid = (int)L; { const int q = nwg / NXCD, r = nwg % NXCD, xcd = wgid % NXCD, off = wgid / NXCD; wgid = (xcd < r ? xcd * (q + 1) : r * (q + 1) + (xcd - r) * q) + off; }
        const int nig = WGM * nN, gid = wgid / nig, fm = gid * WGM, gsz = (nM - fm) < WGM ? (nM - fm) : WGM;
        u.pm = fm + ((wgid % nig) % gsz); u.pn = (wgid % nig) / gsz; return true;
    }
    __device__ __forceinline__ void a_ready(const Unit&) const {}
    __device__ __forceinline__ void done(const Unit&) const {}
};

__device__ __forceinline__ unsigned cvt_pk_bf16(float lo, float hi) { unsigned r; asm volatile("v_cvt_pk_bf16_f32 %0, %1, %2" : "=v"(r) : "v"(lo), "v"(hi)); return r; }
typedef float f32x2 __attribute__((ext_vector_type(2)));
__device__ __forceinline__ f32x2 gelu_pk(f32x2 v) {
    const f32x2 av = __builtin_elementwise_abs(v), d = av * 0.2316418882f + 1.0f;
    f32x2 t; t.x = __builtin_amdgcn_rcpf(d.x); t.y = __builtin_amdgcn_rcpf(d.y);
    f32x2 q = t * 0.5307027145f + (-0.7265760135f); q = q * t + 0.7107068705f; q = q * t + (-0.142248368f); q = q * t + 0.127414796f; q = q * t;
    const f32x2 s = (v * v) * (-0.72134752044f);
    f32x2 e; e.x = __builtin_amdgcn_exp2f(s.x); e.y = __builtin_amdgcn_exp2f(s.y);
    const f32x2 m = v * (q * e), r = v - m;
    f32x2 o; o.x = v.x < 0.f ? m.x : r.x; o.y = v.y < 0.f ? m.y : r.y; return o;
}
#ifndef EPI_AUX
#define EPI_AUX 16
#endif
template <bool F16  > struct EpiBf16R {
    typedef f32x4 acc_t;
    static constexpr bool PERM = true, AFTER_DRAIN = false;
    bf16_t* O; int ldc; int split_cols; size_t split_stride; const float* rs;
    __device__ __forceinline__ void operator()(const f32x4 (&acc)[2][2][4][2], const Unit& u, int wr, int wc, int fr, int fq) const {
        const int row0 = u.pm * BM + wr * 64 + fr; int colt = u.pn * BM; unsigned boff = 0u;
        if (split_cols) { const int t = colt / split_cols; boff = (unsigned)(t * split_stride * 2); colt -= t * split_cols; }
        const int col0 = colt + wc * 32 + 8 * fq;
        const __amdgpu_buffer_rsrc_t orsrc = __builtin_amdgcn_make_buffer_rsrc((void*)O, (short)0, 0x7ffffff0, 0x00020000);
#pragma unroll
        for (int ai = 0; ai < 2; ++ai)
#pragma unroll
            for (int m = 0; m < 4; ++m) { const int row = row0 + ai * HALF + m * 16; const unsigned roff = boff + (unsigned)(row * ldc + col0) * 2u;
                float sc = 1.f;
                if (rs) {
                    const f32x4 a = *(const f32x4*)(rs + (size_t)row * 16 + 4 * fq); float s = (a[0] + a[1]) + (a[2] + a[3]); const int lane_ = fr + 16 * fq;
                    s += __builtin_bit_cast(float, __builtin_amdgcn_ds_bpermute((lane_ ^ 16) << 2, __builtin_bit_cast(int, s)));
                    s += __builtin_bit_cast(float, __builtin_amdgcn_ds_bpermute((lane_ ^ 32) << 2, __builtin_bit_cast(int, s)));
                    sc = __builtin_amdgcn_rsqf(s * (1.0f / 1024.0f) + 1e-6f); }
#pragma unroll
                for (int bj = 0; bj < 2; ++bj) { const f32x4 v0 = acc[ai][bj][m][0] * sc, v1 = acc[ai][bj][m][1] * sc;
                    u32x4 w;
                    if (F16) { w.x = __builtin_bit_cast(unsigned, __builtin_amdgcn_cvt_pkrtz(v0[0], v0[1])); w.y = __builtin_bit_cast(unsigned, __builtin_amdgcn_cvt_pkrtz(v0[2], v0[3])); w.z = __builtin_bit_cast(unsigned, __builtin_amdgcn_cvt_pkrtz(v1[0], v1[1])); w.w = __builtin_bit_cast(unsigned, __builtin_amdgcn_cvt_pkrtz(v1[2], v1[3])); }
                    else { w.x = cvt_pk_bf16(v0[0], v0[1]); w.y = cvt_pk_bf16(v0[2], v0[3]); w.z = cvt_pk_bf16(v1[0], v1[1]); w.w = cvt_pk_bf16(v1[2], v1[3]); }
                    __builtin_amdgcn_raw_buffer_store_b128(w, orsrc, (int)(roff + bj * HALF * 2), 0, EPI_AUX); } }
    }
};
template <bool QKN> struct EpiI8 {
    typedef i32x4 acc_t;
    static constexpr bool PERM = true, AFTER_DRAIN = false;
    bf16_t* O; size_t split_stride; const float* sx; const float* sw; const float* gq; const float* gk; float c2;
    __device__ __forceinline__ void operator()(const i32x4 (&acc)[2][2][4][2], const Unit& u, int wr, int wc, int fr, int fq) const {
        const int row0 = u.pm * BM + wr * 64 + fr; int colt = u.pn * BM; unsigned boff;
        { const int t = colt / 1024; boff = (unsigned)(t * split_stride * 2); colt -= t * 1024; }
        const __amdgpu_buffer_rsrc_t orsrc = __builtin_amdgcn_make_buffer_rsrc((void*)O, (short)0, 0x7ffffff0, 0x00020000);
        const int scol0 = u.pn * BM + wc * 32 + 8 * fq;
        f32x4 cw[2][2];
#pragma unroll
        for (int bj = 0; bj < 2; ++bj) { cw[bj][0] = *(const f32x4*)(sw + scol0 + bj * HALF); cw[bj][1] = *(const f32x4*)(sw + scol0 + bj * HALF + 4); }
        if (QKN && u.pn < 8) {
            const float* g = u.pn < 4 ? gq : gk; const float cc = u.pn < 4 ? c2 : 1.f; const int lane = fr + 16 * fq;
            f32x4 gv[2][2];
#pragma unroll
            for (int bj = 0; bj < 2; ++bj) { gv[bj][0] = *(const f32x4*)(g + 32 * bj + 8 * fq) * cc; gv[bj][1] = *(const f32x4*)(g + 32 * bj + 8 * fq + 4) * cc; }
            const int col0 = colt + 64 * wc + 8 * fq;
#pragma unroll
            for (int ai = 0; ai < 2; ++ai)
#pragma unroll
                for (int m = 0; m < 4; ++m) { const int row = row0 + ai * HALF + m * 16; const unsigned roff = boff + (unsigned)(row * 1024 + col0) * 2u; const float rs = sx[row];
                    f32x4 v[2][2]; float ss = 0.f;
#pragma unroll
                    for (int bj = 0; bj < 2; ++bj) { const i32x4 a0 = acc[ai][bj][m][0], a1 = acc[ai][bj][m][1];
                        v[bj][0] = (f32x4){(float)a0[0], (float)a0[1], (float)a0[2], (float)a0[3]} * cw[bj][0] * rs; v[bj][1] = (f32x4){(float)a1[0], (float)a1[1], (float)a1[2], (float)a1[3]} * cw[bj][1] * rs;
                        ss += ((v[bj][0][0] * v[bj][0][0] + v[bj][0][1] * v[bj][0][1]) + (v[bj][0][2] * v[bj][0][2] + v[bj][0][3] * v[bj][0][3])) + ((v[bj][1][0] * v[bj][1][0] + v[bj][1][1] * v[bj][1][1]) + (v[bj][1][2] * v[bj][1][2] + v[bj][1][3] * v[bj][1][3])); }
                    ss += __builtin_bit_cast(float, __builtin_amdgcn_ds_bpermute((lane ^ 16) << 2, __builtin_bit_cast(int, ss)));
                    ss += __builtin_bit_cast(float, __builtin_amdgcn_ds_bpermute((lane ^ 32) << 2, __builtin_bit_cast(int, ss)));
                    const float r = __builtin_amdgcn_rsqf(ss * (1.f / 64.f) + 1e-6f);
#pragma unroll
                    for (int bj = 0; bj < 2; ++bj) { const f32x4 o0 = v[bj][0] * r * gv[bj][0], o1 = v[bj][1] * r * gv[bj][1];
                        u32x4 w; w.x = cvt_pk_bf16(o0[0], o0[1]); w.y = cvt_pk_bf16(o0[2], o0[3]); w.z = cvt_pk_bf16(o1[0], o1[1]); w.w = cvt_pk_bf16(o1[2], o1[3]);
                        __builtin_amdgcn_raw_buffer_store_b128(w, orsrc, (int)(roff + bj * 32 * 2), 0, EPI_AUX); } }
            return;
        }
        const int col0 = colt + wc * 32 + 8 * fq;
#pragma unroll
        for (int ai = 0; ai < 2; ++ai)
#pragma unroll
            for (int m = 0; m < 4; ++m) { const int row = row0 + ai * HALF + m * 16; const unsigned roff = boff + (unsigned)(row * 1024 + col0) * 2u; const float rs = sx[row];
#pragma unroll
                for (int bj = 0; bj < 2; ++bj) { const i32x4 a0 = acc[ai][bj][m][0], a1 = acc[ai][bj][m][1];
                    const f32x4 v0 = (f32x4){(float)a0[0], (float)a0[1], (float)a0[2], (float)a0[3]} * cw[bj][0] * rs, v1 = (f32x4){(float)a1[0], (float)a1[1], (float)a1[2], (float)a1[3]} * cw[bj][1] * rs;
                    u32x4 w; w.x = cvt_pk_bf16(v0[0], v0[1]); w.y = cvt_pk_bf16(v0[2], v0[3]); w.z = cvt_pk_bf16(v1[0], v1[1]); w.w = cvt_pk_bf16(v1[2], v1[3]);
                    __builtin_amdgcn_raw_buffer_store_b128(w, orsrc, (int)(roff + bj * HALF * 2), 0, EPI_AUX); } }
    }
};
template <bool BASE16> struct EpiResNorm {
    typedef f32x4 acc_t;
    static constexpr bool PERM = true, AFTER_DRAIN = false;
    const void* base; bf16_t* out; bf16_t* hg; const float* gain; float* rs;
    __device__ __forceinline__ void operator()(const f32x4 (&acc)[2][2][4][2], const Unit& u, int wr, int wc, int fr, int fq) const {
        const int col0 = u.pn * BM + wc * 32 + 8 * fq, lane = fr + 16 * fq;
        f32x4 gv[2][2];
#pragma unroll
        for (int bj = 0; bj < 2; ++bj)
#pragma unroll
            for (int n = 0; n < 2; ++n) gv[bj][n] = *(const f32x4*)(gain + col0 + bj * HALF + n * 4);
#pragma unroll
        for (int ai = 0; ai < 2; ++ai)
#pragma unroll
            for (int m = 0; m < 4; ++m) { const int r = ai * HALF + wr * 64 + m * 16 + fr; const size_t off = (size_t)(u.pm * BM + r) * 1024 + col0;
                float ss = 0.f;
#pragma unroll
                for (int bj = 0; bj < 2; ++bj) { f32x4 b0, b1;
                    if (BASE16) { const u32x4 bw = *(const u32x4*)((const bf16_t*)base + off + bj * HALF);
                        b0 = (f32x4){__builtin_bit_cast(float, bw.x << 16), __builtin_bit_cast(float, bw.x & 0xffff0000u), __builtin_bit_cast(float, bw.y << 16), __builtin_bit_cast(float, bw.y & 0xffff0000u)};
                        b1 = (f32x4){__builtin_bit_cast(float, bw.z << 16), __builtin_bit_cast(float, bw.z & 0xffff0000u), __builtin_bit_cast(float, bw.w << 16), __builtin_bit_cast(float, bw.w & 0xffff0000u)}; }
                    else { b0 = *(const f32x4*)((const float*)base + off + bj * HALF); b1 = *(const f32x4*)((const float*)base + off + bj * HALF + 4); }
                    const f32x4 o0 = b0 + acc[ai][bj][m][0], o1 = b1 + acc[ai][bj][m][1];
                    u32x4 wo; wo.x = cvt_pk_bf16(o0[0], o0[1]); wo.y = cvt_pk_bf16(o0[2], o0[3]); wo.z = cvt_pk_bf16(o1[0], o1[1]); wo.w = cvt_pk_bf16(o1[2], o1[3]);
                    *(u32x4*)(out + off + bj * HALF) = wo;
                    ss += ((o0[0] * o0[0] + o0[1] * o0[1]) + (o0[2] * o0[2] + o0[3] * o0[3])) + ((o1[0] * o1[0] + o1[1] * o1[1]) + (o1[2] * o1[2] + o1[3] * o1[3]));
                    const f32x4 h0 = o0 * gv[bj][0], h1 = o1 * gv[bj][1];
                    u32x4 w; w.x = cvt_pk_bf16(h0[0], h0[1]); w.y = cvt_pk_bf16(h0[2], h0[3]); w.z = cvt_pk_bf16(h1[0], h1[1]); w.w = cvt_pk_bf16(h1[2], h1[3]);
                    *(u32x4*)(hg + off + bj * HALF) = w; }
                ss += __builtin_bit_cast(float, __builtin_amdgcn_ds_bpermute((lane ^ 16) << 2, __builtin_bit_cast(int, ss)));
                ss += __builtin_bit_cast(float, __builtin_amdgcn_ds_bpermute((lane ^ 32) << 2, __builtin_bit_cast(int, ss)));
                if (fq == 0) rs[(size_t)(u.pm * BM + r) * 16 + u.pn * 4 + wc] = ss; }
    }
};
__device__ __forceinline__ f32x4 mma16(bf16x8 a, bf16x8 b, f32x4 c) { return __builtin_amdgcn_mfma_f32_16x16x32_bf16(a, b, c, 0, 0, 0); }
__device__ __forceinline__ i32x4 mma16(bf16x8 a, bf16x8 b, i32x4 c) { return __builtin_amdgcn_mfma_i32_16x16x64_i8(__builtin_bit_cast(i32x4, a), __builtin_bit_cast(i32x4, b), c, 0, 0, 0); }
template <class Epi, class Sched, bool ALIGN_EPI = false, bool SP2 = false>
__device__ __forceinline__ void gemm_phase(PG8_LAS unsigned char* lds, const Gemm g, const Sched& S, const Epi& E, int tid_in) {
    int tid_ = tid_in; asm volatile("" : "+v"(tid_));
    const int tid = tid_, wid = __builtin_amdgcn_readfirstlane(tid >> 6), lane = tid & 63, wr = wid >> 2, wc = wid & 3, fr = lane & 15, fq = lane >> 4;
    const int K = g.K, nt = K / BK;
    unsigned voffA[2], voffB[2];
#pragma unroll
    for (int i = 0; i < 2; ++i) { int R, C; stage_rc(tid * 16 + i * 8192, R, C); const int Rb = Epi::PERM ? ((R & ~31) + perm32(R & 31)) : R;
        voffA[i] = (unsigned)(R * K + C) * 2u; voffB[i] = (unsigned)(Rb * K + C) * 2u; }
    const size_t kstep = (size_t)(BK * 2);
    const size_t hstep = (size_t)HALF * K * 2;
    const size_t tstep = 2 * hstep;
    const unsigned ldsw = (unsigned)wid * 1024u;
    const int aoff = lds_byte(wr * 64 + fr, fq * 8), boff = lds_byte(wc * 32 + fr, fq * 8);
#define PG8_SA(b, h) (((b) * 2 + (h)) * HTB)
#define PG8_SB(b, h) ((4 + (b) * 2 + (h)) * HTB)
#define PG8_STAGE(bufoff, gbase, voff) do { _Pragma("unroll") for (int _i = 0; _i < 2; ++_i) \
        __builtin_amdgcn_global_load_lds((const unsigned*)((const char*)(gbase) + (voff)[_i]), (PG8_LAS unsigned*)(lds + (bufoff) + ldsw + _i * 8192), 16, 0, 0); } while (0)
#define PG8_LDA(dst, b, h) do { _Pragma("unroll") for (int m = 0; m < 4; ++m) _Pragma("unroll") for (int k = 0; k < 2; ++k) dst[m][k] = *(const PG8_LAS bf16x8*)(lds + PG8_SA(b, h) + aoff + m * 2048 + k * 1024); } while (0)
#define PG8_LDB(dst, b, h) do { _Pragma("unroll") for (int n = 0; n < 2; ++n) _Pragma("unroll") for (int k = 0; k < 2; ++k) dst[n][k] = *(const PG8_LAS bf16x8*)(lds + PG8_SB(b, h) + boff + n * 2048 + k * 1024); } while (0)
#define PG8_MMA(ai, bj, At, Bt) do { __builtin_amdgcn_s_setprio(1); _Pragma("unroll") for (int m = 0; m < 4; ++m) _Pragma("unroll") for (int n = 0; n < 2; ++n) _Pragma("unroll") for (int k = 0; k < 2; ++k) \
        acc[ai][bj][m][n] = mma16(Bt[n][k], At[m][k], acc[ai][bj][m][n]); __builtin_amdgcn_s_setprio(0); } while (0)
#define PG8_WAIT_V(n) asm volatile("s_waitcnt vmcnt(" #n ")" ::: "memory")
#define PG8_WAIT_L(n) asm volatile("s_waitcnt lgkmcnt(" #n ")" ::: "memory")
#define PG8_BAR __builtin_amdgcn_s_barrier()
#define PG8_SCHED __builtin_amdgcn_sched_barrier(0)
    Unit cur, nxt; int ui = 0;
    if (!S.next(0, cur)) return;
    typedef typename Epi::acc_t acc_t;
    acc_t acc[2][2][4][2];
#pragma unroll
    for (int a = 0; a < 2; ++a)
#pragma unroll
        for (int b = 0; b < 2; ++b)
#pragma unroll
            for (int m = 0; m < 4; ++m)
#pragma unroll
                for (int n = 0; n < 2; ++n) acc[a][b][m][n] = (acc_t){0, 0, 0, 0};
    bf16x8 At[4][2], B0[2][2], B1[2][2];
    const char* cA = (const char*)g.A + (size_t)cur.pm * tstep; const char* cB = (const char*)g.Bt + (size_t)cur.pn * tstep;
    S.a_ready(cur);
    if constexpr (SP2) {
        PG8_STAGE(PG8_SB(0, 0), cB, voffB); PG8_STAGE(PG8_SB(0, 1), cB + hstep, voffB); PG8_STAGE(PG8_SA(0, 0), cA, voffA); PG8_STAGE(PG8_SA(0, 1), cA + hstep, voffA);
        if (wr == 1) PG8_BAR;
        PG8_WAIT_V(2); PG8_BAR;
        PG8_STAGE(PG8_SB(1, 0), cB + kstep, voffB); PG8_STAGE(PG8_SA(1, 0), cA + kstep, voffA); PG8_STAGE(PG8_SB(1, 1), cB + hstep + kstep, voffB);
        PG8_WAIT_V(6); PG8_BAR;
    } else {
        PG8_STAGE(PG8_SB(0, 0), cB, voffB); PG8_STAGE(PG8_SA(0, 0), cA, voffA); PG8_STAGE(PG8_SB(0, 1), cB + hstep, voffB); PG8_STAGE(PG8_SA(0, 1), cA + hstep, voffA);
        if (wr == 1) PG8_BAR;
        PG8_WAIT_V(4); PG8_BAR;
        PG8_STAGE(PG8_SB(1, 0), cB + kstep, voffB); PG8_STAGE(PG8_SA(1, 0), cA + kstep, voffA); PG8_STAGE(PG8_SB(1, 1), cB + hstep + kstep, voffB);
        PG8_WAIT_V(6); PG8_BAR;
    }
    for (;;) {
        const bool has_next = S.next(ui + 1, nxt);
        const char* nA = has_next ? (const char*)g.A + (size_t)nxt.pm * tstep : cA; const char* nB = has_next ? (const char*)g.Bt + (size_t)nxt.pn * tstep : cB;
        for (int t = 0; t < nt; t += 2) {
            const bool last = (t == nt - 2);
            const char* a1 = cA + (size_t)(t + 1) * kstep;
            const char* a2 = last ? nA : cA + (size_t)(t + 2) * kstep; const char* b2 = last ? nB : cB + (size_t)(t + 2) * kstep;
            const char* a3 = a2 + kstep; const char* b3 = b2 + kstep;
            if (last && has_next) S.a_ready(nxt);
            if constexpr (SP2) {
            PG8_LDB(B0, 0, 0); PG8_LDB(B1, 0, 1); PG8_SCHED; PG8_LDA(At, 0, 0); PG8_STAGE(PG8_SA(1, 1), a1 + hstep, voffA);
            PG8_WAIT_V(8); PG8_WAIT_L(0); PG8_BAR; PG8_MMA(0, 0, At, B0); PG8_MMA(0, 1, At, B1); PG8_BAR; PG8_SCHED;
            PG8_LDA(At, 0, 1); PG8_STAGE(PG8_SB(0, 0), b2, voffB); PG8_STAGE(PG8_SB(0, 1), b2 + hstep, voffB); PG8_STAGE(PG8_SA(0, 0), a2, voffA);
            PG8_WAIT_V(8); PG8_WAIT_L(0); PG8_BAR; PG8_MMA(1, 0, At, B0); PG8_MMA(1, 1, At, B1); PG8_BAR; PG8_SCHED;
            PG8_LDB(B0, 1, 0); PG8_LDB(B1, 1, 1); PG8_SCHED; PG8_LDA(At, 1, 0); PG8_STAGE(PG8_SA(0, 1), a2 + hstep, voffA);
            PG8_WAIT_V(8); PG8_WAIT_L(0); PG8_BAR; PG8_MMA(0, 0, At, B0); PG8_MMA(0, 1, At, B1); PG8_BAR; PG8_SCHED;
            PG8_LDA(At, 1, 1); PG8_STAGE(PG8_SB(1, 0), b3, voffB); PG8_STAGE(PG8_SB(1, 1), b3 + hstep, voffB); PG8_STAGE(PG8_SA(1, 0), a3, voffA);
            PG8_WAIT_V(8); PG8_WAIT_L(0); PG8_BAR; PG8_MMA(1, 0, At, B0); PG8_MMA(1, 1, At, B1); PG8_BAR; PG8_SCHED;
            } else {
            PG8_LDB(B0, 0, 0); PG8_SCHED; PG8_LDA(At, 0, 0); PG8_STAGE(PG8_SA(1, 1), a1 + hstep, voffA);
            PG8_WAIT_L(8); PG8_BAR; PG8_WAIT_L(0); PG8_MMA(0, 0, At, B0); PG8_BAR; PG8_SCHED;
            PG8_LDB(B1, 0, 1); PG8_STAGE(PG8_SB(0, 0), b2, voffB);
            PG8_BAR; PG8_WAIT_L(0); PG8_MMA(0, 1, At, B1); PG8_BAR;
            PG8_LDA(At, 0, 1); PG8_STAGE(PG8_SA(0, 0), a2, voffA);
            PG8_BAR; PG8_WAIT_L(0); PG8_MMA(1, 0, At, B0); PG8_BAR; PG8_SCHED;
            PG8_STAGE(PG8_SB(0, 1), b2 + hstep, voffB);
            PG8_WAIT_V(6); PG8_BAR; PG8_MMA(1, 1, At, B1); PG8_BAR;
            PG8_LDB(B0, 1, 0); PG8_SCHED; PG8_LDA(At, 1, 0); PG8_STAGE(PG8_SA(0, 1), a2 + hstep, voffA);
            PG8_WAIT_L(8); PG8_BAR; PG8_WAIT_L(0); PG8_MMA(0, 0, At, B0); PG8_BAR; PG8_SCHED;
            PG8_LDB(B1, 1, 1); PG8_STAGE(PG8_SB(1, 0), b3, voffB);
            PG8_BAR; PG8_WAIT_L(0); PG8_MMA(0, 1, At, B1); PG8_BAR;
            PG8_LDA(At, 1, 1); PG8_STAGE(PG8_SA(1, 0), a3, voffA);
            PG8_BAR; PG8_WAIT_L(0); PG8_MMA(1, 0, At, B0); PG8_BAR; PG8_SCHED;
            PG8_STAGE(PG8_SB(1, 1), b3 + hstep, voffB);
            PG8_WAIT_V(6); PG8_BAR; PG8_MMA(1, 1, At, B1); PG8_BAR;
            }
        }
        if constexpr (ALIGN_EPI) { if (wr == 0) PG8_BAR; }
        if constexpr (!Epi::AFTER_DRAIN) { E(acc, cur, wr, wc, fr, fq); S.done(cur); }
        if (!has_next) break;
#pragma unroll
        for (int a = 0; a < 2; ++a)
#pragma unroll
            for (int b = 0; b < 2; ++b)
#pragma unroll
                for (int m = 0; m < 4; ++m)
#pragma unroll
                    for (int n = 0; n < 2; ++n) acc[a][b][m][n] = (acc_t){0, 0, 0, 0};
        cur = nxt; cA = nA; cB = nB; ++ui;
        if constexpr (ALIGN_EPI) { if (wr == 1) PG8_BAR; }
    }
    PG8_WAIT_V(0);
    if constexpr (!ALIGN_EPI) { if (wr == 0) PG8_BAR; }
    PG8_BAR;
    if constexpr (Epi::AFTER_DRAIN) { E.fused(acc, cur, wr, wc, fr, fq, lds, wid, lane); S.done(cur); }
#undef PG8_SA
#undef PG8_SB
#undef PG8_STAGE
#undef PG8_LDA
#undef PG8_LDB
#undef PG8_MMA
#undef PG8_WAIT_V
#undef PG8_WAIT_L
#undef PG8_BAR
#undef PG8_SCHED
}
}
#include <hip/hip_bf16.h>
#include <cmath>
namespace attn_body {
using bf16=__hip_bfloat16;
using bf16x8=__attribute__((ext_vector_type(8)))short;
using s16x4=__attribute__((ext_vector_type(4)))short;
using f32x16=__attribute__((ext_vector_type(16)))float;
using u32x4=__attribute__((ext_vector_type(4)))unsigned;
constexpr int BATCH=8,NHEAD=16,SEQ=2048,D=64,DM=NHEAD*D;
constexpr int NW=8,QBLK=32,QB=QBLK*NW,KVBLK=64,NQB=SEQ/QB;
constexpr int ATTN_PITCH=DM, ATTN_UNIT_ROWS=QB;
__device__ __forceinline__ int crow(int r,int hi){return (r&3)+8*(r>>2)+4*hi;}
#define SBAR() __builtin_amdgcn_sched_barrier(0)
__device__ __forceinline__ void cmask(f32x16&p0,f32x16&p1,int jb,int qrel,int hi){
  const float NEG=-INFINITY; int kb=64*jb+4*hi;
  #pragma unroll
  for(int r=0;r<16;++r){int kv=kb+(r&3)+8*(r>>2); if(kv>qrel)p0[r]=NEG; if(kv+32>qrel)p1[r]=NEG;}
}

constexpr int NSLOT=3, SLOTB=8192;
constexpr int LDS_K=0, LDS_V=NSLOT*SLOTB, LDS_WS=2*NSLOT*SLOTB, LDS_OST=LDS_WS+NW*64*4, LDS_CS=LDS_OST+NW*4096, LDS_BYTES=LDS_CS+SEQ*4;
constexpr float C2=0.125f*1.4426950408889634f;
__device__ __forceinline__ void glds16(const void*gsrc,unsigned lds_dst){unsigned keep;
  asm volatile("s_mov_b32 %0, m0\n\ts_mov_b32 m0, %2\n\ts_nop 0\n\tglobal_load_lds_dwordx4 %1, off\n\ts_mov_b32 m0, %0":"=&s"(keep):"v"(gsrc),"s"(lds_dst):"memory");}
__device__ __forceinline__ float max3f(float a,float b,float c){float r;asm("v_max3_f32 %0, %1, %2, %3":"=v"(r):"v"(a),"v"(b),"v"(c));return r;}
__device__ __forceinline__ float max2f(float a,float b){float r;asm("v_max_f32_e32 %0, %1, %2":"=v"(r):"v"(a),"v"(b));return r;}
__device__ __forceinline__ float fadd_s(float a,float b){float r;asm("v_add_f32_e32 %0, %1, %2":"=v"(r):"v"(a),"v"(b));return r;}
__device__ __forceinline__ float fsub_s(float a,float b){float r;asm("v_sub_f32_e32 %0, %1, %2":"=v"(r):"v"(a),"v"(b));return r;}
typedef float f32x2_t __attribute__((ext_vector_type(2))); typedef __bf16 bf16x2_t __attribute__((ext_vector_type(2)));
__device__ __forceinline__ unsigned cvtpk_s(float lo,float hi){f32x2_t v={lo,hi};bf16x2_t b=__builtin_convertvector(v,bf16x2_t);return __builtin_bit_cast(unsigned,b);}
#define WAIT_BAR(N) asm volatile("s_waitcnt vmcnt(" #N ") lgkmcnt(0)\n\ts_barrier":::"memory")

typedef __attribute__((address_space(3))) const char* lds_cptr;
__device__ __forceinline__ void qkt(f32x16&p0,f32x16&p1,const char*Kslot,lds_cptr qls,bf16x8 ax0,bf16x8 ax1,bf16x8 qx,int r32,int hi){
  const char*kb=Kslot+hi*1024+r32*16; const f32x16 z16=f32x16{};
  p0=__builtin_amdgcn_mfma_f32_32x32x16_bf16(ax0,qx,z16,0,0,0);p1=__builtin_amdgcn_mfma_f32_32x32x16_bf16(ax1,qx,z16,0,0,0);
  #pragma unroll
  for(int d0=0;d0<4;++d0){
    const bf16x8 b0=*reinterpret_cast<const bf16x8*>(kb+d0*2048);
    const bf16x8 b1=*reinterpret_cast<const bf16x8*>(kb+d0*2048+512);
    const bf16x8 qd=*(const __attribute__((address_space(3))) bf16x8*)(qls+d0*1024);
    p0=__builtin_amdgcn_mfma_f32_32x32x16_bf16(b0,qd,p0,0,0,0);p1=__builtin_amdgcn_mfma_f32_32x32x16_bf16(b1,qd,p1,0,0,0);}
}
typedef short v4i16_t __attribute__((ext_vector_type(4)));
__device__ __forceinline__ void kload8(bf16x8*kf,lds_cptr kp){
  kf[0]=*(const __attribute__((address_space(3))) bf16x8*)(kp);      kf[1]=*(const __attribute__((address_space(3))) bf16x8*)(kp+512);
  kf[2]=*(const __attribute__((address_space(3))) bf16x8*)(kp+2048); kf[3]=*(const __attribute__((address_space(3))) bf16x8*)(kp+2560);
  kf[4]=*(const __attribute__((address_space(3))) bf16x8*)(kp+4096); kf[5]=*(const __attribute__((address_space(3))) bf16x8*)(kp+4608);
  kf[6]=*(const __attribute__((address_space(3))) bf16x8*)(kp+6144); kf[7]=*(const __attribute__((address_space(3))) bf16x8*)(kp+6656);
}
__device__ __forceinline__ void kload2(bf16x8*kf,lds_cptr kp,int j){ kf[2*j]=*(const __attribute__((address_space(3))) bf16x8*)(kp+j*2048); kf[2*j+1]=*(const __attribute__((address_space(3))) bf16x8*)(kp+j*2048+512); }
__device__ __forceinline__ s16x4 vtr(lds_cptr p){ return __builtin_bit_cast(s16x4,__builtin_amdgcn_ds_read_tr16_b64_v4i16((__attribute__((address_space(3))) v4i16_t*)p)); }
__device__ __forceinline__ float rowmax(const f32x16&p0,const f32x16&p1){
  float a=max3f(p0[0],p0[1],p1[0]),b=max3f(p0[2],p0[3],p1[1]);a=max3f(a,p1[2],p1[3]);
  #pragma unroll
  for(int r=4;r<16;r+=4){a=max3f(a,p0[r],p0[r+1]);b=max3f(b,p0[r+2],p0[r+3]);a=max3f(a,p1[r],p1[r+1]);b=max3f(b,p1[r+2],p1[r+3]);}
  const float m=max2f(a,b);
  auto rr=__builtin_amdgcn_permlane32_swap(__float_as_uint(m),__float_as_uint(m),false,false);
  return max2f(__uint_as_float(rr[0]),__uint_as_float(rr[1]));
}
__device__ __forceinline__ void pv(f32x16*o,int vb,bf16x8 pa0,bf16x8 pa1,bf16x8 pa2,bf16x8 pa3){
  #pragma unroll
  for(int d0=0;d0<2;++d0){s16x4 lo[4],hi[4];
    #pragma unroll
    for(int ks=0;ks<4;++ks){
      asm volatile("ds_read_b64_tr_b16 %0,%1 offset:%c2":"=&v"(lo[ks]):"v"(vb),"i"(d0*4096+ks*1024):"memory");
      asm volatile("ds_read_b64_tr_b16 %0,%1 offset:%c2":"=&v"(hi[ks]):"v"(vb),"i"(d0*4096+ks*1024+512):"memory");}
    asm volatile("s_waitcnt lgkmcnt(0)":::"memory");SBAR();
    #define PK(k) (bf16x8){lo[k][0],lo[k][1],lo[k][2],lo[k][3],hi[k][0],hi[k][1],hi[k][2],hi[k][3]}
    o[d0]=__builtin_amdgcn_mfma_f32_32x32x16_bf16(pa0,PK(0),o[d0],0,0,0);
    o[d0]=__builtin_amdgcn_mfma_f32_32x32x16_bf16(pa1,PK(1),o[d0],0,0,0);
    o[d0]=__builtin_amdgcn_mfma_f32_32x32x16_bf16(pa2,PK(2),o[d0],0,0,0);
    o[d0]=__builtin_amdgcn_mfma_f32_32x32x16_bf16(pa3,PK(3),o[d0],0,0,0);
    #undef PK
  }
}

__device__ __forceinline__ void split3(float c,unsigned&hb,unsigned&mb,unsigned&lb){
  hb=__float_as_uint(c)&0xffff0000u; const float r1=c-__uint_as_float(hb); mb=__float_as_uint(r1)&0xffff0000u; const float r2=r1-__uint_as_float(mb); lb=__float_as_uint(r2)&0xffff0000u; }
__device__ __forceinline__ bf16x8 make_ax(float negc){ unsigned hb,mb,lb; split3(negc,hb,mb,lb);
  u32x4 w; w.x=(hb>>16)|mb; w.y=(lb>>16)|0x3f800000u; w.z=0x3f803f80u; w.w=0u; return __builtin_bit_cast(bf16x8,w); }
__device__ __forceinline__ bf16x8 make_qx(float negm,unsigned hm){ unsigned hb,mb,lb; split3(negm,hb,mb,lb);
  u32x4 w; w.x=0x3f803f80u&hm; w.y=(0x3f80u|hb)&hm; w.z=((mb>>16)|lb)&hm; w.w=0u; return __builtin_bit_cast(bf16x8,w); }
#ifndef ATTN_STORE16
#define ATTN_STORE16(p,v) (*(u32x4*)(p)=(v))
#endif
template<int THRL> __device__ __forceinline__ void attn_unit(int b,int h,int qb,const bf16*Q,const bf16*__restrict__ K,const bf16*__restrict__ V,bf16*O,const bf16*__restrict__ Gt,char*shm,const int tid_u,const float skip_thr){
  int tid=tid_u; asm volatile("":"+v"(tid));
  const int lane=tid&63,r32=lane&31,hi=lane>>5; const int wid=__builtin_amdgcn_readfirstlane(tid>>6);
  const long rowbase=(long)b*SEQ; const int q0=qb*QB;
  const bf16*Qw=Q+(rowbase+q0+wid*QBLK)*DM+h*D;
  float*csp=(float*)(shm+LDS_CS);
  int tskip=0;
  { const float cq0=csp[q0]; const int ntall=(q0+QB)/KVBLK; while(tskip+2<=ntall-4 && csp[KVBLK*(tskip+1)+KVBLK-1]-cq0<skip_thr)tskip+=2; tskip=__builtin_amdgcn_readfirstlane(tskip); }
  const bf16*Kh=K+(rowbase+(long)tskip*KVBLK)*DM+h*D,*Vh=V+(rowbase+(long)tskip*KVBLK)*DM+h*D;
  const unsigned lds0=(unsigned)(uintptr_t)shm;
  float*wsf=(float*)(shm+LDS_WS)+wid*64;
  const unsigned koff=(unsigned)(lane*DM+wid*8), voff=(unsigned)((16*(wid&3)+(lane>>2))*DM+(wid>>2)*32+(lane&3)*8);
  const unsigned kdst=lds0+LDS_K+wid*1024, vdst=lds0+LDS_V+wid*1024;
  #define DMA_K(t,slot) do{unsigned o_=koff;asm volatile("":"+v"(o_));glds16(Kh+(long)(t)*KVBLK*DM+o_,(unsigned)__builtin_amdgcn_readfirstlane(kdst+(slot)));}while(0)
  #define DMA_V(t,slot) do{unsigned o_=voff;asm volatile("":"+v"(o_));glds16(Vh+(long)(t)*KVBLK*DM+o_,(unsigned)__builtin_amdgcn_readfirstlane(vdst+(slot)));}while(0)
  const int vb0=(int)(lds0+LDS_V)+((lane>>4)&1)*32+(lane&3)*8+(4*hi+((lane&15)>>2))*64;
  const char*Kbase=shm+LDS_K; bf16x8 kf[8];
  const lds_cptr shm3=(lds_cptr)shm; const lds_cptr kp0=shm3+LDS_K+hi*1024+r32*16; const lds_cptr vp0=shm3+LDS_V+((lane>>4)&1)*32+(lane&3)*8+(4*hi+((lane&15)>>2))*64;
  const int NT=(q0+QB)/KVBLK-tskip;
  const float*cst=csp+tskip*KVBLK;
  const unsigned hm=hi?0u:0xffffffffu;
  DMA_K(0,0);DMA_V(0,0);DMA_K(1,SLOTB);
  const lds_cptr qls=shm3+LDS_OST+wid*4096+hi*512+r32*16;
  { bf16x8 qr[4];
    #pragma unroll
    for(int d0=0;d0<4;++d0)qr[d0]=*reinterpret_cast<const bf16x8*>(&Qw[(long)r32*DM+d0*16+hi*8]);
    #pragma unroll
    for(int d0=0;d0<4;++d0)*(__attribute__((address_space(3))) bf16x8*)(shm3+LDS_OST+wid*4096+hi*512+r32*16+d0*1024)=qr[d0]; }
  #define QLD(k) (*(const __attribute__((address_space(3))) bf16x8*)(qls+(k)*1024))
  float mhat=csp[q0+wid*QBLK+r32],l_reg=0.f;f32x16 o[2];o[0]=f32x16{};o[1]=f32x16{}; bf16x8 qx=make_qx(-mhat,hm);
  const int qrel=wid*QBLK+r32;
  #define CMASK(P0,P1,t) do{int jb_=(t)-(NT-4); if(jb_>=0)cmask(P0,P1,jb_,qrel,hi);}while(0)
  bool resc=false;
  #define START(P0,P1) do{ const float rm=rowmax(P0,P1); resc=false; \
    if(__any(rm>(float)THRL)){ const float dl=__builtin_fmaxf(rm,0.f); mhat=fadd_s(mhat,dl); \
      _Pragma("unroll") for(int r=0;r<16;++r){P0[r]=fsub_s(P0[r],dl);P1[r]=fsub_s(P1[r],dl);} \
      qx=make_qx(-mhat,hm); } \
    _Pragma("unroll") for(int r=0;r<16;++r)P0[r]=__builtin_amdgcn_exp2f(P0[r]); }while(0)
  #define RESC() do{ if(resc){ asm volatile("s_waitcnt lgkmcnt(0)":::"memory"); \
      _Pragma("unroll") for(int d_=0;d_<2;++d_) _Pragma("unroll") for(int r=0;r<16;++r)o[d_][r]*=wsf[crow(r,hi)]; } }while(0)
  f32x16 pA0,pA1,pB0,pB1;
  int sl_prev=0,sl_cur=0,sl_next=SLOTB;
  #define ROT() do{sl_prev=sl_cur;sl_cur=sl_next;sl_next=(sl_next==(NSLOT-1)*SLOTB)?0:sl_next+SLOTB;}while(0)
  DMA_K(2,2*SLOTB);
  WAIT_BAR(3);
  qkt(pA0,pA1,Kbase,qls,make_ax(cst[r32]),make_ax(cst[32+r32]),qx,r32,hi);asm volatile("s_nop 15\n\ts_nop 7":"+v"(pA0),"+v"(pA1));CMASK(pA0,pA1,0);
  START(pA0,pA1);
  _Pragma("unroll") for(int r=0;r<16;++r)pA1[r]=__builtin_amdgcn_exp2f(pA1[r]);
  WAIT_BAR(0);
  DMA_K(3,0);DMA_V(1,SLOTB);
  ROT();
  kload8(kf,kp0+sl_cur);
  WAIT_BAR(2);
  s16x4 vlo[8],vhi[8]; u32x4 pw0,pw1,pw2,pw3;
  #define PKW(P,B) cvtpk_s(P[B],P[B+1])
  #define PAF(k) __builtin_bit_cast(bf16x8,pw##k)
  #define VFR(i) (bf16x8){vlo[i][0],vlo[i][1],vlo[i][2],vlo[i][3],vhi[i][0],vhi[i][1],vhi[i][2],vhi[i][3]}
  #define PIN(x) asm volatile("":"+v"(x))
  #define MX3(a,b,c) __builtin_fmaxf(__builtin_fmaxf((a),(b)),(c))
  #define GAPA(MF,A0,A1,A2,A3,W0,W1,PW) do{ MF; sacc+=A0; sacc+=A1; sacc+=A2; sacc+=A3; PIN(sacc); W0; W1; PIN(PW); SBAR(); }while(0)
  #define EX(v) __builtin_amdgcn_exp2f(v)
  #define GAPB(MF,X,B) do{ MF; X[B]=EX(X[B]); X[B+1]=EX(X[B+1]); X[B+2]=EX(X[B+2]); X[B+3]=EX(X[B+3]); PIN(X); SBAR(); }while(0)
  #define VRD(i) do{ vlo[i]=vtr(vp_+(((i)>>2)*4096+((i)&3)*1024)); vhi[i]=vtr(vp_+(((i)>>2)*4096+((i)&3)*1024+512)); }while(0)
  #define KRD(G,j) do{ if(G){ kload2(kf,kp0+sl_next,j); SBAR(); } }while(0)
  #define STEP(C0,C1,P0,P1,t,GK,GV,GL) do{ SBAR(); \
    const lds_cptr vp_=vp0+sl_prev; \
    const bf16x8 ax0_=make_ax(cst[(t)*KVBLK+r32]), ax1_=make_ax(cst[(t)*KVBLK+32+r32]); \
    C0=__builtin_amdgcn_mfma_f32_32x32x16_bf16(ax0_,qx,f32x16{},0,0,0); C1=__builtin_amdgcn_mfma_f32_32x32x16_bf16(ax1_,qx,f32x16{},0,0,0); SBAR(); \
    bf16x8 q0_=QLD(0), q1_=QLD(1); \
    VRD(0); SBAR(); float sacc=(P0[0]+P0[1]); \
    GAPA(C0=__builtin_amdgcn_mfma_f32_32x32x16_bf16(kf[0],q0_,C0,0,0,0), P0[2],P0[3],P0[4],P0[5],     pw0[0]=PKW(P0,0), pw0[1]=PKW(P0,2), pw0); \
    VRD(4); SBAR(); GAPA(C1=__builtin_amdgcn_mfma_f32_32x32x16_bf16(kf[1],q0_,C1,0,0,0), P0[6],P0[7],P0[8],P0[9],     pw0[2]=PKW(P0,4), pw0[3]=PKW(P0,6), pw0); q0_=QLD(2); \
    VRD(1); SBAR(); GAPA(C0=__builtin_amdgcn_mfma_f32_32x32x16_bf16(kf[2],q1_,C0,0,0,0),   P0[10],P0[11],P0[12],P0[13], pw1[0]=PKW(P0,8), pw1[1]=PKW(P0,10), pw1); \
    VRD(5); SBAR(); GAPA(C1=__builtin_amdgcn_mfma_f32_32x32x16_bf16(kf[3],q1_,C1,0,0,0),   P0[14],P0[15],P1[0],P1[1],   pw1[2]=PKW(P0,12),pw1[3]=PKW(P0,14), pw1); q1_=QLD(3); \
    VRD(2); SBAR(); GAPA(C0=__builtin_amdgcn_mfma_f32_32x32x16_bf16(kf[4],q0_,C0,0,0,0),   P1[2],P1[3],P1[4],P1[5],     pw2[0]=PKW(P1,0), pw2[1]=PKW(P1,2), pw2); \
    VRD(6); SBAR(); GAPA(C1=__builtin_amdgcn_mfma_f32_32x32x16_bf16(kf[5],q0_,C1,0,0,0),   P1[6],P1[7],P1[8],P1[9],     pw2[2]=PKW(P1,4), pw2[3]=PKW(P1,6), pw2); \
    VRD(3); SBAR(); GAPA(C0=__builtin_amdgcn_mfma_f32_32x32x16_bf16(kf[6],q1_,C0,0,0,0),   P1[10],P1[11],P1[12],P1[13], pw3[0]=PKW(P1,8), pw3[1]=PKW(P1,10), pw3); \
    VRD(7); SBAR(); GAPA(C1=__builtin_amdgcn_mfma_f32_32x32x16_bf16(kf[7],q1_,C1,0,0,0),   P1[14],P1[15],0.f,0.f,       pw3[2]=PKW(P1,12),pw3[3]=PKW(P1,14), pw3); \
    l_reg+=sacc; \
    if(GK){DMA_K((t)+3,sl_cur);} if(GV){DMA_V((t)+1,sl_next);} \
    CMASK(C0,C1,t); \
    { float a=MX3(C0[0],C0[1],C1[0]),b=MX3(C0[2],C0[3],C1[1]); a=MX3(a,C1[2],C1[3]); \
      _Pragma("unroll") for(int r=4;r<16;r+=4){a=MX3(a,C0[r],C0[r+1]);b=MX3(b,C0[r+2],C0[r+3]);a=MX3(a,C1[r],C1[r+1]);b=MX3(b,C1[r+2],C1[r+3]);} \
      float rm=__builtin_fmaxf(a,b); { auto rr=__builtin_amdgcn_permlane32_swap(__float_as_uint(rm),__float_as_uint(rm),false,false); rm=__builtin_fmaxf(__uint_as_float(rr[0]),__uint_as_float(rr[1])); } \
      resc=false; \
      if(__builtin_expect(__any(rm>(float)THRL),0)){ const float dl=__builtin_fmaxf(rm,0.f); mhat+=dl; \
        _Pragma("unroll") for(int r=0;r<16;++r){C0[r]-=dl;C1[r]-=dl;} \
        qx=make_qx(-mhat,hm); \
        const float f=__builtin_amdgcn_exp2f(-dl); l_reg*=f; if(hi==0)wsf[r32]=f; resc=true; } } \
    SBAR(); \
    GAPB(o[0]=__builtin_amdgcn_mfma_f32_32x32x16_bf16(PAF(0),VFR(0),o[0],0,0,0), C0,0); \
    GAPB(o[1]=__builtin_amdgcn_mfma_f32_32x32x16_bf16(PAF(0),VFR(4),o[1],0,0,0), C0,4); \
    KRD(GL,0); GAPB(o[0]=__builtin_amdgcn_mfma_f32_32x32x16_bf16(PAF(1),VFR(1),o[0],0,0,0), C0,8); \
    KRD(GL,1); GAPB(o[1]=__builtin_amdgcn_mfma_f32_32x32x16_bf16(PAF(1),VFR(5),o[1],0,0,0), C0,12); \
    KRD(GL,2); GAPB(o[0]=__builtin_amdgcn_mfma_f32_32x32x16_bf16(PAF(2),VFR(2),o[0],0,0,0), C1,0); \
    KRD(GL,3); GAPB(o[1]=__builtin_amdgcn_mfma_f32_32x32x16_bf16(PAF(2),VFR(6),o[1],0,0,0), C1,4); \
    GAPB(o[0]=__builtin_amdgcn_mfma_f32_32x32x16_bf16(PAF(3),VFR(3),o[0],0,0,0), C1,8); \
    GAPB(o[1]=__builtin_amdgcn_mfma_f32_32x32x16_bf16(PAF(3),VFR(7),o[1],0,0,0), C1,12); \
    }while(0)
  int t=1;
  #undef CMASK
  #define CMASK(P0,P1,t) do{}while(0)
  for(;t+5<NT;t+=2){
    STEP(pB0,pB1,pA0,pA1,t,true,true,true);     WAIT_BAR(2); RESC(); ROT();
    STEP(pA0,pA1,pB0,pB1,t+1,true,true,true);   WAIT_BAR(2); RESC(); ROT();
  }
  #undef CMASK
  #define CMASK(P0,P1,t) do{int jb_=(t)-(NT-4); if(jb_>=0)cmask(P0,P1,jb_,qrel,hi);}while(0)
  #define ENDW(tt) do{ if((tt)+3<NT){WAIT_BAR(2);} else if((tt)+2<NT){WAIT_BAR(1);} else {WAIT_BAR(0);} }while(0)
  for(;t+1<NT;t+=2){
    STEP(pB0,pB1,pA0,pA1,t,(t+3<NT),(t+1<NT),(t+1<NT));       ENDW(t);   RESC(); ROT();
    STEP(pA0,pA1,pB0,pB1,t+1,(t+4<NT),(t+2<NT),(t+2<NT));     ENDW(t+1); RESC(); ROT();
  }
  STEP(pB0,pB1,pA0,pA1,NT-1,false,false,false); RESC();
  { float sacc=pB0[0]+pB0[1]; _Pragma("unroll") for(int r=2;r<16;++r)sacc+=pB0[r]; _Pragma("unroll") for(int r=0;r<16;++r)sacc+=pB1[r]; l_reg+=sacc;
    pw0=(u32x4){PKW(pB0,0),PKW(pB0,2),PKW(pB0,4),PKW(pB0,6)};pw1=(u32x4){PKW(pB0,8),PKW(pB0,10),PKW(pB0,12),PKW(pB0,14)};pw2=(u32x4){PKW(pB1,0),PKW(pB1,2),PKW(pB1,4),PKW(pB1,6)};pw3=(u32x4){PKW(pB1,8),PKW(pB1,10),PKW(pB1,12),PKW(pB1,14)};
    SBAR(); pv(o,vb0+sl_cur,PAF(0),PAF(1),PAF(2),PAF(3)); }
  #undef PKW
  #undef PAF
  #undef VFR
  #undef PIN
  #undef MX3
  #undef GAPA
  #undef GAPB
  #undef EX
  #undef VRD
  #undef KRD
  #undef STEP
  #undef ENDW
  {auto rr=__builtin_amdgcn_permlane32_swap(__float_as_uint(l_reg),__float_as_uint(l_reg),false,false);l_reg=__uint_as_float(rr[0])+__uint_as_float(rr[1]);}
  { int te=tid; asm volatile("":"+v"(te));
    const int lane_e=te&63,r32e=lane_e&31,hie=lane_e>>5;
    if(hie==0)wsf[32+r32e]=l_reg;asm volatile("s_waitcnt lgkmcnt(0)":::"memory");
    float rli[16];
    #pragma unroll
    for(int r=0;r<16;++r)rli[r]=__builtin_amdgcn_rcpf(wsf[32+crow(r,hie)]);
    bf16*Ow=O+(rowbase+q0+wid*QBLK)*DM+h*D; const bf16*Gw=Gt+(rowbase+q0+wid*QBLK)*DM+h*D;
    bf16*stg=(bf16*)(shm+LDS_OST)+wid*2048;
    #pragma unroll
    for(int r=0;r<16;++r){const int orow=crow(r,hie);
      #pragma unroll
      for(int d0=0;d0<2;++d0)stg[orow*64+d0*32+r32e]=__float2bfloat16(o[d0][r]*rli[r]);}
    asm volatile("s_waitcnt lgkmcnt(0)":::"memory");
    #pragma unroll
    for(int i=0;i<4;++i){const int row=i*8+(lane_e>>3),ch=lane_e&7; u32x4 v=*(const u32x4*)(stg+row*64+ch*8); const u32x4 gv=*(const u32x4*)(Gw+(long)row*DM+ch*8);
      #pragma unroll
      for(int e=0;e<4;++e){ const float g0=__uint_as_float(gv[e]<<16),g1=__uint_as_float(gv[e]&0xffff0000u),x0=__uint_as_float(v[e]<<16),x1=__uint_as_float(v[e]&0xffff0000u);
        v[e]=cvtpk_s(x0*__builtin_amdgcn_rcpf(1.f+__expf(-g0)),x1*__builtin_amdgcn_rcpf(1.f+__expf(-g1))); }
      ATTN_STORE16(Ow+(long)row*DM+ch*8,v);} }
  asm volatile("s_waitcnt lgkmcnt(0)\n\ts_barrier":::"memory");
  #undef DMA_K
  #undef QLD
  #undef DMA_V
  #undef CMASK
  #undef START
  #undef RESC
  #undef ROT
}
constexpr int ATTN_LDS_BYTES=LDS_BYTES;
struct AttnTensors { const bf16* Q; const bf16* K; const bf16* V; bf16* O; const bf16* G; const float* CUM; float THR; };
struct AttnUnit { int bh; int qb; };
struct StaticOrder {
  int vcu;
  __device__ __forceinline__ explicit StaticOrder(int grid,int block):vcu((block%8)*(grid/8)+block/8){}
  __device__ __forceinline__ bool next(int i,AttnUnit&u)const{ if(i>=4)return false; const int s=2*(vcu&1)+(i>>1); u.bh=vcu>>1; u.qb=(i&1)?7-s:s; return true; }
  __device__ __forceinline__ void a_ready(const AttnUnit&)const{}
  __device__ __forceinline__ void done(const AttnUnit&)const{}
};
template<class Sched,int THRL=8> __device__ __forceinline__ void attn_phase(char*lds,const AttnTensors&T,const Sched&S,int tid_in){
  AttnUnit u; int tid_=tid_in; asm volatile("":"+v"(tid_));
  if(S.next(0,u)){ float*csp=(float*)(lds+LDS_CS); float*wt=(float*)(lds+LDS_WS); int tp=tid_in; asm volatile("":"+v"(tp));
    const float*lf=T.CUM+((long)(u.bh/NHEAD)*SEQ+4*tp)*NHEAD+u.bh%NHEAD;
    const float a0=lf[0],a1=a0+lf[NHEAD],a2=a1+lf[2*NHEAD],a3=a2+lf[3*NHEAD];
    float sc=a3; const int ln=tp&63;
    #pragma unroll
    for(int o=1;o<64;o<<=1){ const float up=__builtin_bit_cast(float,__builtin_amdgcn_ds_bpermute((ln-o)<<2,__builtin_bit_cast(int,sc))); if(ln>=o)sc+=up; }
    if(ln==63)wt[tp>>6]=sc;
    __syncthreads();
    float base=sc-a3;
    #pragma unroll
    for(int w=0;w<NW-1;++w)if(w<(tp>>6))base+=wt[w];
    const float k2=-1.4426950408889634f;
    csp[4*tp]=k2*(base+a0);csp[4*tp+1]=k2*(base+a1);csp[4*tp+2]=k2*(base+a2);csp[4*tp+3]=k2*(base+a3);
    __syncthreads(); }
  for(int i=0;S.next(i,u);++i){ S.a_ready(u); attn_unit<THRL>(u.bh/NHEAD,u.bh%NHEAD,u.qb,T.Q,T.K,T.V,T.O,T.G,lds,tid_,T.THR); S.done(u); }
}
#undef SBAR
#undef WAIT_BAR
}
#define GAS __attribute__((address_space(1)))
#define LAS __attribute__((address_space(3)))
typedef unsigned short bf16;
typedef unsigned v4u __attribute__((ext_vector_type(4)));
typedef float f32x4 __attribute__((ext_vector_type(4)));
typedef short bf16x8 __attribute__((ext_vector_type(8)));
typedef GAS unsigned gu32;
typedef GAS unsigned long long gu64;
#define RLX_AGENT __ATOMIC_RELAXED, __HIP_MEMORY_SCOPE_AGENT
#define LDS_WAIT() asm volatile("s_waitcnt lgkmcnt(0)" ::: "memory")
#define VM_WAIT() asm volatile("s_waitcnt vmcnt(0)" ::: "memory")
__device__ __forceinline__ unsigned long long rt() { return __builtin_amdgcn_s_memrealtime(); }
__device__ __forceinline__ unsigned f2bf(float f) { unsigned u = __builtin_bit_cast(unsigned, f); return (u + 0x7fffu + ((u >> 16) & 1u)) >> 16; }
__device__ __forceinline__ unsigned pk2(float lo, float hi) { return f2bf(lo) | (f2bf(hi) << 16); }
__device__ __forceinline__ unsigned pk2h(float lo, float hi) { unsigned r; asm("v_cvt_pk_bf16_f32 %0, %1, %2" : "=v"(r) : "v"(lo), "v"(hi)); return r; }
__device__ __forceinline__ unsigned f2bfh(float f) { return pk2h(f, 0.f) & 0xffffu; }

#define XB_TMO      128
#define XB_XCNT(j)  (256  + 64 * (j))
#define XB_XSUB(j)  (1280 + 64 * (j))
#define XB_XGEN(j)  (2304 + 64 * (j))
#define XB_TOP      3328
#define XB_TOPGEN   3392
#define XCD_BAR_WORDS 3456
#define XB_SPIN_CAP (1u << 27)

__device__ __forceinline__ unsigned xb_ld(unsigned* p)              { return __hip_atomic_load(p, __ATOMIC_RELAXED, __HIP_MEMORY_SCOPE_AGENT); }
__device__ __forceinline__ unsigned xb_add(unsigned* p, unsigned v) { return __hip_atomic_fetch_add(p, v, __ATOMIC_RELAXED, __HIP_MEMORY_SCOPE_AGENT); }
__device__ __forceinline__ unsigned xb_xcc_id() { return (unsigned)__builtin_amdgcn_s_getreg((3 << 11) | 20) & 0xFu; }
#define XB_SPIN(cond, bar) do { unsigned _sp = 0; while (cond) { __builtin_amdgcn_s_sleep(1); \
    if ((++_sp & 255u) == 0u) { if (xb_ld(&(bar)[XB_TMO])) break; if (_sp > XB_SPIN_CAP) { atomicAdd(&(bar)[XB_TMO], 1u); break; } } } } while (0)

struct XcdBarrier {
    unsigned* bar; unsigned x;
    volatile LAS unsigned* st;
};

__device__ __forceinline__ XcdBarrier xcd_barrier_post(unsigned* bar, volatile LAS unsigned* st) {
    XcdBarrier b; b.bar = bar; b.x = xb_xcc_id(); b.st = st;
    if (threadIdx.x == 0) (void)xb_add(&bar[XB_XCNT(b.x)], 1u);
    return b;
}
__device__ __forceinline__ void xcd_barrier_complete(unsigned* bar, unsigned x, unsigned& nloc, unsigned& nx) {
    const unsigned G = gridDim.x * gridDim.y * gridDim.z;
    unsigned sum, cnt, mine, sp = 0u;
    for (;;) {
        sum = 0u; cnt = 0u; mine = 0u;
#pragma unroll
        for (unsigned j = 0; j < 16; ++j) { const unsigned c = xb_ld(&bar[XB_XCNT(j)]); sum += c; cnt += (c > 0u) ? 1u : 0u; mine = (j == x) ? c : mine; }
        if (sum == G) break;
        __builtin_amdgcn_s_sleep(1);
        if ((++sp & 255u) == 0u) { if (xb_ld(&bar[XB_TMO])) break; if (sp > XB_SPIN_CAP) { atomicAdd(&bar[XB_TMO], 1u); break; } }
    }
    nloc = mine > 0u ? mine : 1u; nx = cnt > 0u ? cnt : 1u;
}

__device__ __forceinline__ void xcd_barrier(const XcdBarrier& b, const bool leader  ) {
    asm volatile("s_waitcnt vmcnt(0)" ::: "memory");
    __syncthreads();
    if (leader) {
        unsigned* bar = b.bar;
        __builtin_amdgcn_s_waitcnt(0);
        unsigned nloc = b.st[0], nx = b.st[1];
        if (nloc == 0u) { xcd_barrier_complete(bar, b.x, nloc, nx); b.st[0] = nloc; b.st[1] = nx; }
        const unsigned old = xb_add(&bar[XB_XSUB(b.x)], 1u);
        const unsigned gen = old / nloc;
        if (old + 1u == (gen + 1u) * nloc) {
            __builtin_amdgcn_fence(__ATOMIC_RELEASE, "agent");
            asm volatile("s_waitcnt vmcnt(0)" ::: "memory");
            const unsigned og = xb_add(&bar[XB_TOP], 1u);
            const unsigned tg = og / nx;
            if (og + 1u == (tg + 1u) * nx) xb_add(&bar[XB_TOPGEN], 1u);
            else XB_SPIN(xb_ld(&bar[XB_TOPGEN]) == tg, bar);
            __builtin_amdgcn_fence(__ATOMIC_ACQUIRE, "agent");
            xb_add(&bar[XB_XGEN(b.x)], 1u);
            asm volatile("s_waitcnt vmcnt(0)" ::: "memory");
        } else {
            XB_SPIN(xb_ld(&bar[XB_XGEN(b.x)]) == gen, bar);
            __builtin_amdgcn_fence(__ATOMIC_ACQUIRE, "agent");
            asm volatile("s_waitcnt vmcnt(0)" ::: "memory");
        }
    }
    __syncthreads();
}
#ifndef MK_FASTATTN
#define MK_FASTATTN 1
#endif
#ifndef MK_FASTREC
#define MK_FASTREC 1
#endif
namespace cg = cooperative_groups;
constexpr int NTOK = 16384, DMODEL = 1024, NBATCH = 8, SEQLEN = 2048, DEPTH = 4;
constexpr int FOX_IN = 4112, GLA_IN = 3088, HGRN_IN = 4096;
constexpr float RMS_EPS = 1e-6f;
constexpr float LOG2E = 1.4426950408889634f;
constexpr float FOX_C2 = 0.125f * LOG2E;
constexpr int NWAVES = 8;

constexpr size_t MiB = 1u << 20;
constexpr size_t WS_CTL = 0, CTL_ZERO_BYTES = 1 * MiB;
constexpr size_t WS_FOXWIN = 2 * MiB, WS_FOXWOUT = 18 * MiB, WS_GLAWIN = 22 * MiB, WS_GLAWOUT = 28 * MiB, WS_HGRNWIN = 30 * MiB, WS_HGRNWOUT = 38 * MiB;
constexpr size_t WS_PEERWQ = 40 * MiB, WS_KEYS = 56 * MiB, WS_LB = 58 * MiB;
#define FOXFUSE ((I8MASK & 9) == 9)
#ifndef RPROBE
#define RPROBE 0
#endif
#ifndef GPROBE
#define GPROBE 0
#endif
#ifndef BGQ
#define BGQ 1
#endif
#ifndef I8MASK
#define I8MASK 13
#endif
constexpr size_t WS_SW = 58 * MiB + 65536, WS_SX = 58 * MiB + 262144, WS_XN8 = 724 * MiB;
constexpr size_t WS_TAILW = 63 * MiB;
constexpr size_t WS_RS = 62 * MiB;
constexpr size_t WS_U = 64 * MiB, WS_V = 128 * MiB, WS_SU = 60 * MiB, WS_SV = 61 * MiB;
constexpr size_t WS_XN = 320 * MiB, WS_P = 352 * MiB, WS_OB = 480 * MiB, WS_Q2 = 512 * MiB, WS_TAIL = 576 * MiB, WS_CUM = 577 * MiB;
constexpr size_t WS_EXP = 580 * MiB, WS_GATE = 588 * MiB, WS_OF = 596 * MiB, WS_GLOG = 660 * MiB, WS_HB = 740 * MiB, WS_END = 772 * MiB;
constexpr size_t PSTRIDE = (size_t)NTOK * 1024;
constexpr int CW_BAR = 4096;

constexpr int RING_BYTES = 131072;
constexpr int LDSCTL_OFF = 162816, MISC_OFF = LDSCTL_OFF + 320;
constexpr int LDS_BYTES = 163840;

typedef unsigned u32x4v __attribute__((ext_vector_type(4)));
struct Ctx {
    LAS unsigned char* lds; int tid, lane, wave, vcu, G, gw, NGW, bx;
    const float* in[21]; float* out; unsigned char* ws;
};

__device__ __forceinline__ float bf2f(unsigned short b) { return __uint_as_float(((unsigned)b) << 16); }
__device__ __forceinline__ float bflo(unsigned w) { return __uint_as_float(w << 16); }
__device__ __forceinline__ float bfhi(unsigned w) { return __uint_as_float(w & 0xffff0000u); }
#define DPP_ADD(v, ctrl, rm, bm) (v + __builtin_bit_cast(float, __builtin_amdgcn_update_dpp(0, __builtin_bit_cast(int, v), ctrl, rm, bm, false)))
#define DPP_MAX(v, ctrl, rm, bm) fmaxf(v, __builtin_bit_cast(float, __builtin_amdgcn_update_dpp(__builtin_bit_cast(int, v), __builtin_bit_cast(int, v), ctrl, rm, bm, false)))
#define DPP_SUM31(v) do { v = DPP_ADD(v, 0x111, 0xf, 0xf); v = DPP_ADD(v, 0x112, 0xf, 0xf); v = DPP_ADD(v, 0x114, 0xf, 0xe); v = DPP_ADD(v, 0x118, 0xf, 0xc); v = DPP_ADD(v, 0x142, 0xa, 0xf); } while (0)
#define DPP_SUM63(v) do { DPP_SUM31(v); v = DPP_ADD(v, 0x143, 0xc, 0xf); } while (0)
__device__ __forceinline__ float rdlane(float v, int lane) { return __builtin_bit_cast(float, __builtin_amdgcn_readlane(__builtin_bit_cast(int, v), lane)); }
__device__ __forceinline__ float wave_sum(float v) { DPP_SUM63(v); return rdlane(v, 63); }
__device__ __forceinline__ float wave_max(float v) {
    v = DPP_MAX(v, 0x111, 0xf, 0xf); v = DPP_MAX(v, 0x112, 0xf, 0xf); v = DPP_MAX(v, 0x114, 0xf, 0xe); v = DPP_MAX(v, 0x118, 0xf, 0xc); v = DPP_MAX(v, 0x142, 0xa, 0xf); v = DPP_MAX(v, 0x143, 0xc, 0xf);
    return rdlane(v, 63);
}
typedef __bf16 bf16x2_t __attribute__((ext_vector_type(2)));
__device__ __forceinline__ float dot2bf(unsigned w, unsigned x, float acc) { return __builtin_amdgcn_fdot2_f32_bf16(__builtin_bit_cast(bf16x2_t, w), __builtin_bit_cast(bf16x2_t, x), acc, false); }
__device__ __forceinline__ float bperm(float v, int src_lane) { return __builtin_bit_cast(float, __builtin_amdgcn_ds_bpermute(src_lane << 2, __builtin_bit_cast(int, v))); }
__device__ __forceinline__ float log_sigmoid_f(float x) { return fminf(x, 0.f) - log1pf(__expf(-fabsf(x))); }
__device__ __forceinline__ float sigmoid_f(float x) { return 1.f / (1.f + __expf(-x)); }

__device__ __forceinline__ void p0_transpose_item(const float* W, int ldw, int K, int Nuse, bf16* WT, LAS float* scr, int item, int lane) {
    const int nblk = Nuse / 32, kb = item / nblk, nb = item % nblk, k0 = 64 * kb, n0 = 32 * nb;
#pragma unroll
    for (int i = 0; i < 8; ++i) { const int kk = 8 * i + (lane >> 3); const f32x4 v = *(const GAS f32x4*)(W + (size_t)(k0 + kk) * ldw + n0 + 4 * (lane & 7));
        LAS float* d = scr + kk * 33 + 4 * (lane & 7); d[0] = v.x; d[1] = v.y; d[2] = v.z; d[3] = v.w; }
    LDS_WAIT(); asm volatile("" ::: "memory");
    const int c = lane & 7;
#pragma unroll
    for (int j = 0; j < 4; ++j) { const int n = (lane >> 3) + 8 * j; const LAS float* s = scr + (8 * c) * 33 + n;
        v4u o; o.x = pk2(s[0 * 33], s[1 * 33]); o.y = pk2(s[2 * 33], s[3 * 33]); o.z = pk2(s[4 * 33], s[5 * 33]); o.w = pk2(s[6 * 33], s[7 * 33]);
        *(GAS v4u*)(WT + (size_t)(n0 + n) * K + k0 + 8 * c) = o; }
    LDS_WAIT(); asm volatile("" ::: "memory");
}
__device__ __forceinline__ unsigned q8x4(float a, float b, float c, float d) {
    return ((unsigned)(int)__builtin_rintf(a) & 0xffu) | (((unsigned)(int)__builtin_rintf(b) & 0xffu) << 8) | (((unsigned)(int)__builtin_rintf(c) & 0xffu) << 16) | ((unsigned)(int)__builtin_rintf(d) << 24);
}
__device__ __forceinline__ void p0_colmax_item(const float* W, int ldw, unsigned* cmax, int item, int lane) {
    const int nb = item >> 3, n0 = 32 * nb, k0 = 128 * (item & 7);
    f32x4 v[16];
#pragma unroll
    for (int i = 0; i < 16; ++i) v[i] = *(const GAS f32x4*)(W + (size_t)(k0 + 8 * i + (lane >> 3)) * ldw + n0 + 4 * (lane & 7));
    __builtin_amdgcn_sched_barrier(0);
    float mx[4] = {0.f, 0.f, 0.f, 0.f};
#pragma unroll
    for (int i = 0; i < 16; ++i) { mx[0] = fmaxf(mx[0], fabsf(v[i].x)); mx[1] = fmaxf(mx[1], fabsf(v[i].y)); mx[2] = fmaxf(mx[2], fabsf(v[i].z)); mx[3] = fmaxf(mx[3], fabsf(v[i].w)); }
#pragma unroll
    for (int j = 0; j < 4; ++j) { mx[j] = fmaxf(mx[j], bperm(mx[j], lane ^ 8)); mx[j] = fmaxf(mx[j], bperm(mx[j], lane ^ 16)); mx[j] = fmaxf(mx[j], bperm(mx[j], lane ^ 32)); }
    if (lane < 8) {
#pragma unroll
        for (int j = 0; j < 4; ++j) (void)__hip_atomic_fetch_max(cmax + n0 + 4 * lane + j, __float_as_uint(mx[j]), __ATOMIC_RELAXED, __HIP_MEMORY_SCOPE_AGENT);
    }
}
__device__ __forceinline__ void p0_quant_item(const float* W, int ldw, const unsigned* cmax, signed char* W8, float* sw, LAS float* scr, int item, int lane, bool headperm) {
    const int nb = item >> 3, n0 = 32 * nb, k0 = 128 * (item & 7);
    const int n0s = (headperm && nb < 64) ? (nb >> 3) * 256 + 64 * (nb & 3) + 32 * ((nb >> 2) & 1) : n0;
    f32x4 v[2][8];
#pragma unroll
    for (int h = 0; h < 2; ++h)
#pragma unroll
        for (int i = 0; i < 8; ++i) v[h][i] = *(const GAS f32x4*)(W + (size_t)(k0 + 64 * h + 8 * i + (lane >> 3)) * ldw + n0s + 4 * (lane & 7));
    float ci[4];
#pragma unroll
    for (int j = 0; j < 4; ++j) { const float m = __uint_as_float(*(const GAS unsigned*)(cmax + n0s + (lane >> 3) + 8 * j)); ci[j] = m > 0.f ? 127.f / m : 0.f; }
    if ((item & 7) == 0 && lane < 32) *(GAS float*)(sw + n0 + lane) = __uint_as_float(*(const GAS unsigned*)(cmax + n0s + lane)) * (1.f / 127.f);
    __builtin_amdgcn_sched_barrier(0);
    const int c = lane & 7;
#pragma unroll
    for (int h = 0; h < 2; ++h) {
        LDS_WAIT(); asm volatile("" ::: "memory");
#pragma unroll
        for (int i = 0; i < 8; ++i) { LAS float* d = scr + (8 * i + (lane >> 3)) * 33 + 4 * (lane & 7); d[0] = v[h][i].x; d[1] = v[h][i].y; d[2] = v[h][i].z; d[3] = v[h][i].w; }
        LDS_WAIT(); asm volatile("" ::: "memory");
#pragma unroll
        for (int j = 0; j < 4; ++j) { const int n = (lane >> 3) + 8 * j; const LAS float* sp = scr + (8 * c) * 33 + n;
            const unsigned lo = q8x4(sp[0] * ci[j], sp[33] * ci[j], sp[66] * ci[j], sp[99] * ci[j]), hi = q8x4(sp[132] * ci[j], sp[165] * ci[j], sp[198] * ci[j], sp[231] * ci[j]);
            *(GAS unsigned long long*)(W8 + (size_t)(n0 + n) * 1024 + k0 + 64 * h + 8 * c) = (unsigned long long)lo | ((unsigned long long)hi << 32); }
    }
    LDS_WAIT(); asm volatile("" ::: "memory");
}
__device__ __forceinline__ void rms_row_to_bf16(int lane, f32x4 (&v)[4], const float* gain, bf16* orow, signed char* orow8, float* sx) {
    const GAS f32x4* gr = (const GAS f32x4*)gain + lane;
    float s = 0.f;
#pragma unroll
    for (int j = 0; j < 4; ++j) s += (v[j].x * v[j].x + v[j].y * v[j].y) + (v[j].z * v[j].z + v[j].w * v[j].w);
    const float r = rsqrtf(wave_sum(s) * (1.f / 1024.f) + RMS_EPS);
    GAS unsigned long long* o8 = (GAS unsigned long long*)orow + lane; float am = 0.f;
#pragma unroll
    for (int j = 0; j < 4; ++j) { const f32x4 g = gr[64 * j]; v[j].x *= r * g.x; v[j].y *= r * g.y; v[j].z *= r * g.z; v[j].w *= r * g.w;
        am = fmaxf(fmaxf(am, fmaxf(fabsf(v[j].x), fabsf(v[j].y))), fmaxf(fabsf(v[j].z), fabsf(v[j].w)));
        o8[64 * j] = (unsigned long long)pk2(v[j].x, v[j].y) | ((unsigned long long)pk2(v[j].z, v[j].w) << 32); }
    am = wave_max(am); const float qi = am > 0.f ? 127.f / am : 0.f;
    GAS unsigned* q8 = (GAS unsigned*)orow8 + lane;
#pragma unroll
    for (int j = 0; j < 4; ++j) q8[64 * j] = q8x4(v[j].x * qi, v[j].y * qi, v[j].z * qi, v[j].w * qi);
    if (lane == 0) *(GAS float*)sx = am * (1.f / 127.f);
}
__device__ __forceinline__ void cvt_f32_bf16(const Ctx& C, const float* src, bf16* dst, size_t n) {
    const size_t nth = (size_t)C.G * 512, t0 = (size_t)C.vcu * 512 + C.tid;
    for (size_t i = t0; i < n / 8; i += nth) {
        const f32x4 a = ((const GAS f32x4*)src)[2 * i], b = ((const GAS f32x4*)src)[2 * i + 1];
        v4u o; o.x = pk2(a.x, a.y); o.y = pk2(a.z, a.w); o.z = pk2(b.x, b.y); o.w = pk2(b.z, b.w);
        ((GAS v4u*)dst)[i] = o;
    }
}
template <bool I8> __device__ __forceinline__ void quant_row_fp8(int lane, const f32x4 (&v)[4], unsigned char* drow, unsigned char* sc) {
    float am = 0.f;
#pragma unroll
    for (int i = 0; i < 4; ++i) am = fmaxf(am, fmaxf(fmaxf(fabsf(v[i].x), fabsf(v[i].y)), fmaxf(fabsf(v[i].z), fabsf(v[i].w))));
    am = wave_max(am);
    const unsigned sbits = __float_as_uint(am * (I8 ? 1.f / 127.f : 1.f / 448.f));
    unsigned e = (sbits >> 23) + ((sbits & 0x7fffffu) ? 1u : 0u); e = am > 0.f ? (e < 1u ? 1u : e > 254u ? 254u : e) : 127u;
    const float inv = __uint_as_float((254u - e) << 23);
    GAS unsigned* o = (GAS unsigned*)drow + lane;
#pragma unroll
    for (int i = 0; i < 4; ++i) {
        if (I8) { o[64 * i] = q8x4(v[i].x * inv, v[i].y * inv, v[i].z * inv, v[i].w * inv); continue; }
        const float a = fminf(fmaxf(v[i].x * inv, -448.f), 448.f), b = fminf(fmaxf(v[i].y * inv, -448.f), 448.f), c = fminf(fmaxf(v[i].z * inv, -448.f), 448.f), d = fminf(fmaxf(v[i].w * inv, -448.f), 448.f);
        int w = 0; w = __builtin_amdgcn_cvt_pk_fp8_f32(a, b, w, false); w = __builtin_amdgcn_cvt_pk_fp8_f32(c, d, w, true); o[64 * i] = (unsigned)w;
    }
    if (lane == 0) *(GAS unsigned char*)sc = (unsigned char)e;
}
template <bool I8> __device__ __forceinline__ void quant_rows_fp8(const Ctx& C, const float* src, unsigned char* dst, unsigned char* scales, int nrows) {
    int rw = C.gw;
    for (; rw + 3 * C.NGW < nrows; rw += 4 * C.NGW) {
        f32x4 v[4][4];
#pragma unroll
        for (int j = 0; j < 4; ++j) { const GAS f32x4* xr = (const GAS f32x4*)(src + (size_t)(rw + j * C.NGW) * 1024) + C.lane;
#pragma unroll
            for (int i = 0; i < 4; ++i) v[j][i] = xr[64 * i]; }
        __builtin_amdgcn_sched_barrier(0);
#pragma unroll
        for (int j = 0; j < 4; ++j) quant_row_fp8<I8>(C.lane, v[j], dst + (size_t)(rw + j * C.NGW) * 1024, scales + rw + j * C.NGW);
    }
    for (; rw < nrows; rw += C.NGW) {
        const GAS f32x4* xr = (const GAS f32x4*)(src + (size_t)rw * 1024) + C.lane;
        f32x4 v[4];
#pragma unroll
        for (int i = 0; i < 4; ++i) v[i] = xr[64 * i];
        quant_row_fp8<I8>(C.lane, v, dst + (size_t)rw * 1024, scales + rw);
    }
}
constexpr int BGQ_ROWS = 3 * 16384;
template <int JOB> __device__ __forceinline__ bool bgq_row(const Ctx& C, int idx, const float*& src, unsigned char*& dst, unsigned char*& sc) {
    const int seg = idx >> 14, row = idx & 16383;
    const bool isV = seg == 1 || (seg == 2 && JOB == 2);
    const size_t flat = (size_t)(seg < 2 ? JOB : 3) * 16384 + row;
    src = (isV ? C.in[20] : C.in[19]) + flat * 1024; dst = C.ws + (isV ? WS_V : WS_U) + flat * 1024; sc = C.ws + (isV ? WS_SV : WS_SU) + flat; return isV;
}
template <int JOB> __device__ __forceinline__ void bgq_step(const Ctx& C, int idx_prev, int idx, f32x4 (&v)[4]) {
    const float* src; unsigned char* dst; unsigned char* sc;
    if (idx_prev >= 0 && idx_prev < BGQ_ROWS) { if (bgq_row<JOB>(C, idx_prev, src, dst, sc)) quant_row_fp8<false>(C.lane, v, dst, sc); else quant_row_fp8<true>(C.lane, v, dst, sc); }
    if (idx < BGQ_ROWS) { (void)bgq_row<JOB>(C, idx, src, dst, sc); const GAS f32x4* xr = (const GAS f32x4*)src + C.lane;
#pragma unroll
        for (int i = 0; i < 4; ++i) v[i] = xr[64 * i]; }
}
#ifndef PRO_PROBE
#define PRO_PROBE 0
#endif
constexpr int CW_CMAX = 131072;
constexpr int I8_NF0 = (I8MASK & 1) ? 1024 : 0, I8_NF3 = (I8MASK & 8) ? 1024 : 0, I8_NG = (I8MASK & 2) ? 768 : 0, I8_NH = (I8MASK & 4) ? 1024 : 0, I8_NITEMS = I8_NF0 + I8_NF3 + I8_NG + I8_NH;
template <bool PASS2> __device__ __forceinline__ void p0_i8_items(const Ctx& C, LAS float* scr) {
    unsigned* CM = (unsigned*)(C.ws + WS_CTL) + CW_CMAX; float* SW = (float*)(C.ws + WS_SW);
    for (int it = C.gw; it < I8_NITEMS; it += C.NGW) {
        int r = it; const float* W; int ldw; signed char* W8; int q;
        if (r < I8_NF0) { W = C.in[3]; ldw = FOX_IN; W8 = (signed char*)(C.ws + WS_FOXWIN); q = 0; }
        else if ((r -= I8_NF0) < I8_NF3) { W = C.in[3] + (size_t)1024 * FOX_IN; ldw = FOX_IN; W8 = (signed char*)(C.ws + WS_FOXWIN + 8 * MiB); q = 1; }
        else if ((r -= I8_NF3) < I8_NG) { W = C.in[8]; ldw = GLA_IN; W8 = (signed char*)(C.ws + WS_GLAWIN); q = 2; }
        else { r -= I8_NG; W = C.in[13]; ldw = HGRN_IN; W8 = (signed char*)(C.ws + WS_HGRNWIN); q = 3; }
        const int swo = q == 0 ? 0 : q == 1 ? 4096 : q == 2 ? 8192 : 11264;
        if (PASS2) p0_quant_item(W, ldw, CM + q * 4096, W8, SW + swo, scr, r, C.lane, FOXFUSE && q < 2); else p0_colmax_item(W, ldw, CM + q * 4096, r, C.lane);
    }
}
__device__ __forceinline__ void p0_prologue_b(const Ctx& C) { p0_i8_items<true>(C, (LAS float*)(C.lds + C.wave * 16384)); }
__device__ __forceinline__ void p0_prologue(const Ctx& C) {
    LAS float* scr = (LAS float*)(C.lds + C.wave * 16384);
    for (int rep_ = 0; rep_ < (PRO_PROBE == 1 ? 2 : 1); ++rep_) {
    p0_i8_items<false>(C, scr);
    constexpr int I_SQ = 16 * 32, N_F0 = (I8MASK & 1) ? 0 : 16 * 128, N_F3 = (I8MASK & 8) ? 0 : 16 * 128, N_G = (I8MASK & 2) ? 0 : 16 * 96, N_H = (I8MASK & 4) ? 0 : 16 * 128;
    constexpr int NITEMS = N_F0 + N_F3 + N_G + N_H + 2 * I_SQ + I_SQ + I_SQ;
    for (int it = C.gw; it < NITEMS; it += C.NGW) {
        int r = it;
        if (r < N_F0) { p0_transpose_item(C.in[3], FOX_IN, 1024, 4096, (bf16*)(C.ws + WS_FOXWIN), scr, r, C.lane); continue; } r -= N_F0;
        if (r < N_F3) { p0_transpose_item(C.in[3] + (size_t)1024 * FOX_IN, FOX_IN, 1024, 4096, (bf16*)(C.ws + WS_FOXWIN + 8 * MiB), scr, r, C.lane); continue; } r -= N_F3;
        if (r < N_G) { p0_transpose_item(C.in[8], GLA_IN, 1024, 3072, (bf16*)(C.ws + WS_GLAWIN), scr, r, C.lane); continue; } r -= N_G;
        if (r < N_H) { p0_transpose_item(C.in[13], HGRN_IN, 1024, 4096, (bf16*)(C.ws + WS_HGRNWIN), scr, r, C.lane); continue; } r -= N_H;
        if (r < 2 * I_SQ) { const int j = r / I_SQ; p0_transpose_item(C.in[7] + (size_t)j * 1024 * 1024, 1024, 1024, 1024, (bf16*)(C.ws + WS_FOXWOUT) + (size_t)j * 1024 * 1024, scr, r % I_SQ, C.lane); continue; } r -= 2 * I_SQ;
        if (r < I_SQ) { p0_transpose_item(C.in[12], 1024, 1024, 1024, (bf16*)(C.ws + WS_GLAWOUT), scr, r, C.lane); continue; } r -= I_SQ;
        p0_transpose_item(C.in[16], 1024, 1024, 1024, (bf16*)(C.ws + WS_HGRNWOUT), scr, r, C.lane);
    }
    }
    for (int rep_ = 0; rep_ < (PRO_PROBE == 2 ? 2 : 1); ++rep_) {
    constexpr int MT_GROUPS = 4 * 16 * 4 * 32;
    for (int grp = C.gw; grp < MT_GROUPS; grp += C.NGW) {
        const int nb2 = grp & 31, kb2 = (grp >> 5) & 3, hp = (grp >> 7) & 15, layer = grp >> 11;
        const float* kp = C.in[18] + ((size_t)(layer * 16 + hp) * 128 + kb2 * 32 + (C.lane & 15)) * 128 + 4 * (C.lane >> 4);
        const float* wp = C.in[17] + ((size_t)layer * 1024 + nb2 * 32 + (C.lane & 15)) * 2048 + hp * 128 + 4 * (C.lane >> 4);
        f32x4 ka[2][8], wb[2][8];
#pragma unroll
        for (int u = 0; u < 2; ++u)
#pragma unroll
            for (int s8 = 0; s8 < 8; ++s8) { ka[u][s8] = *(const GAS f32x4*)(kp + (size_t)u * 16 * 128 + 16 * s8); wb[u][s8] = *(const GAS f32x4*)(wp + (size_t)u * 16 * 2048 + 16 * s8); }
        __builtin_amdgcn_sched_barrier(0);
        f32x4 acc[2][2];
#pragma unroll
        for (int a = 0; a < 2; ++a)
#pragma unroll
            for (int b = 0; b < 2; ++b) acc[a][b] = (f32x4){0.f, 0.f, 0.f, 0.f};
#pragma unroll
        for (int s8 = 0; s8 < 8; ++s8)
#pragma unroll
            for (int a = 0; a < 2; ++a)
#pragma unroll
                for (int b = 0; b < 2; ++b) { const f32x4 x = ka[a][s8], y = wb[b][s8];
                    acc[a][b] = __builtin_amdgcn_mfma_f32_16x16x4f32(x.x, y.x, acc[a][b], 0, 0, 0); acc[a][b] = __builtin_amdgcn_mfma_f32_16x16x4f32(x.y, y.y, acc[a][b], 0, 0, 0);
                    acc[a][b] = __builtin_amdgcn_mfma_f32_16x16x4f32(x.z, y.z, acc[a][b], 0, 0, 0); acc[a][b] = __builtin_amdgcn_mfma_f32_16x16x4f32(x.w, y.w, acc[a][b], 0, 0, 0); }
#pragma unroll
        for (int a = 0; a < 2; ++a)
#pragma unroll
            for (int b = 0; b < 2; ++b) {
                bf16* mt = (bf16*)(C.ws + WS_PEERWQ) + ((size_t)layer * 2048 + hp * 128 + kb2 * 32 + a * 16 + (C.lane >> 4) * 4) * 1024 + nb2 * 32 + b * 16 + (C.lane & 15);
#pragma unroll
                for (int r = 0; r < 4; ++r) mt[(size_t)r * 1024] = (bf16)f2bf(acc[a][b][r]); }
    }
    }
    for (int rep_ = 0; rep_ < (PRO_PROBE == 3 ? 2 : 1); ++rep_) {
    quant_rows_fp8<true>(C, C.in[19], C.ws + WS_U, C.ws + WS_SU, BGQ ? 16384 : 4 * 16384);
    quant_rows_fp8<false>(C, C.in[20], C.ws + WS_V, C.ws + WS_SV, BGQ ? 16384 : 4 * 16384);
    }
    for (int rep_ = 0; rep_ < (PRO_PROBE == 4 ? 2 : 1); ++rep_) {
    for (int i = C.vcu * 512 + C.tid; i < 3 * 16 * 1024; i += C.G * 512) {
        const int w = i >> 14, n = (i >> 10) & 15, k = i & 1023;
        const float v = w < 2 ? C.in[3][(size_t)w * 1024 * FOX_IN + (size_t)k * FOX_IN + 4096 + n] : C.in[8][(size_t)k * GLA_IN + 3072 + n];
        ((bf16*)(C.ws + WS_TAILW))[i] = (bf16)f2bf(v);
    }
    if (C.vcu == 0) for (int c = C.tid; c < 1024; c += 512) {
        const float l0 = C.in[14][c], l1 = C.in[14][1024 + c], l2 = C.in[14][2048 + c], l3 = C.in[14][3072 + c];
        const float m = fmaxf(fmaxf(l0, l1), fmaxf(l2, l3));
        const float e0 = expf(l0 - m), e1 = expf(l1 - m), e2 = expf(l2 - m), e3 = expf(l3 - m);
        ((float*)(C.ws + WS_LB))[c] = (e1 + e2) / (e0 + e1 + e2 + e3);
    }
    for (int m0 = C.gw; m0 < NTOK; m0 += 4 * C.NGW) {
        f32x4 v[4][4];
#pragma unroll
        for (int u = 0; u < 4; ++u) { const int m = m0 + u * C.NGW; if (m < NTOK) { const GAS f32x4* xr = (const GAS f32x4*)(C.in[0] + (size_t)m * 1024) + C.lane;
#pragma unroll
            for (int j = 0; j < 4; ++j) v[u][j] = xr[64 * j]; } }
        __builtin_amdgcn_sched_barrier(0);
#pragma unroll
        for (int u = 0; u < 4; ++u) { const int m = m0 + u * C.NGW; if (m < NTOK)
            rms_row_to_bf16(C.lane, v[u], C.in[1], (bf16*)(C.ws + WS_XN) + (size_t)m * 1024, (signed char*)(C.ws + WS_XN8) + (size_t)m * 1024, (float*)(C.ws + WS_SX) + m); }
    }
    }
}

__device__ __forceinline__ void tail_mfma(const Ctx& C, int tok0, const bf16* WT, LAS float* part) {
    const int l = C.lane, m = l & 15, g = l >> 4, tbk = C.wave & 3, kh = C.wave >> 2;
    const bf16* ap = (const bf16*)(C.ws + WS_XN) + (size_t)(tok0 + 16 * tbk + m) * 1024 + kh * 512 + 8 * g;
    const bf16* bp = WT + (size_t)m * 1024 + kh * 512 + 8 * g;
    f32x4 acc = (f32x4){0.f, 0.f, 0.f, 0.f};
#pragma unroll 4
    for (int ks = 0; ks < 16; ++ks) acc = __builtin_amdgcn_mfma_f32_16x16x32_bf16(*(const bf16x8*)(ap + 32 * ks), *(const bf16x8*)(bp + 32 * ks), acc, 0, 0, 0);
#pragma unroll
    for (int r = 0; r < 4; ++r) part[kh * 1024 + (16 * tbk + 4 * g + r) * 16 + m] = acc[r];
}
template <bool QK> __device__ __forceinline__ void fox_step1(const Ctx& C, int j) {
    float* TAIL = (float*)(C.ws + WS_TAIL); LAS float* part = (LAS float*)C.lds;
    const bf16* WT = (const bf16*)(C.ws + WS_TAILW) + (size_t)j * 16 * 1024;
    for (int tb = C.vcu; tb < NTOK / 64; tb += C.G) {
        __syncthreads();
        tail_mfma(C, tb * 64, WT, part);
        __syncthreads();
#pragma unroll
        for (int rep = 0; rep < 2; ++rep) { const int i = rep * 512 + C.tid; TAIL[(size_t)tb * 1024 + i] = log_sigmoid_f(part[i] + part[1024 + i] + C.in[4][j * 16 + (i & 15)]); }
        if (!QK) continue;
        const float* gq = C.in[5] + j * 64; const float* gk = C.in[6] + j * 64;
        v4u ra[2][8], rb[2][8];
#pragma unroll
        for (int which = 0; which < 2; ++which)
#pragma unroll
            for (int t = 0; t < 8; ++t) { const bf16* row = (const bf16*)(C.ws + WS_P) + (size_t)which * PSTRIDE + (size_t)(tb * 64 + C.wave * 8 + t) * 1024 + C.lane * 16;
                ra[which][t] = *(const GAS v4u*)row; rb[which][t] = *(const GAS v4u*)(row + 8); }
        __builtin_amdgcn_sched_barrier(0);
#pragma unroll
        for (int which = 0; which < 2; ++which) {
            const float* g = (which == 0 ? gq : gk) + (C.lane & 3) * 16;
            float gv[16];
#pragma unroll
            for (int i = 0; i < 16; ++i) gv[i] = g[i];
#pragma unroll
            for (int t = 0; t < 8; ++t) {
                bf16* row = (bf16*)(C.ws + WS_P) + (size_t)which * PSTRIDE + (size_t)(tb * 64 + C.wave * 8 + t) * 1024 + C.lane * 16;
                const v4u a = ra[which][t], b = rb[which][t];
                float v[16] = {bflo(a.x), bfhi(a.x), bflo(a.y), bfhi(a.y), bflo(a.z), bfhi(a.z), bflo(a.w), bfhi(a.w), bflo(b.x), bfhi(b.x), bflo(b.y), bfhi(b.y), bflo(b.z), bfhi(b.z), bflo(b.w), bfhi(b.w)};
                float ss = 0.f;
#pragma unroll
                for (int i = 0; i < 16; ++i) ss += v[i] * v[i];
                ss = DPP_ADD(ss, 0xB1, 0xf, 0xf); ss = DPP_ADD(ss, 0x4E, 0xf, 0xf);
                const float r = rsqrtf(ss * (1.f / 64.f) + RMS_EPS) * (which == 0 ? FOX_C2 : 1.f);
#pragma unroll
                for (int i = 0; i < 16; ++i) v[i] = v[i] * r * gv[i];
                v4u oa, ob; oa.x = pk2(v[0], v[1]); oa.y = pk2(v[2], v[3]); oa.z = pk2(v[4], v[5]); oa.w = pk2(v[6], v[7]);
                ob.x = pk2(v[8], v[9]); ob.y = pk2(v[10], v[11]); ob.z = pk2(v[12], v[13]); ob.w = pk2(v[14], v[15]);
                *(GAS v4u*)row = oa; *(GAS v4u*)(row + 8) = ob;
            }
        }
    }
}
constexpr size_t WS_ASC = WS_Q2, WS_Q1 = WS_Q2 + 16 * MiB, WS_KST = WS_Q2 + 48 * MiB, WS_DEC = 59 * MiB;
static_assert(WS_KST + 32 * MiB <= WS_OF && WS_Q1 + 32 * MiB <= WS_KST, "chunk workspace map");
template <int NH>
__device__ __forceinline__ void chunk_prepass(const Ctx& C) {
    bf16* ASC = (bf16*)(C.ws + WS_ASC); bf16* Q1 = (bf16*)(C.ws + WS_Q1); bf16* KST = (bf16*)(C.ws + WS_KST); float* DEC = (float*)(C.ws + WS_DEC);
    const bf16* P0 = (const bf16*)(C.ws + WS_P); const bf16* P1 = P0 + PSTRIDE;
    LAS bf16* tqs = (LAS bf16*)C.lds;
    LAS bf16* tks = tqs + 64 * 128;
    LAS bf16* q2s = tks + 64 * 128;
    LAS bf16* k2s = q2s + 64 * 136;
    LAS bf16* q1s = k2s + 64 * 136;
    LAS float* tot = (LAS float*)(q1s + 64 * 128);
    LAS float* part = tot + 512;
    const float qs = 0.08838834764831845f;
    const int d = C.tid & 127, tq = C.tid >> 7, l = C.lane, fr = l & 15, fq = l >> 4;
    const int dq = (d & ~31) + ((d & 16) ? 8 * ((d & 15) >> 2) + 4 + (d & 3) : 8 * ((d & 15) >> 2) + (d & 3));
    const int pr0 = C.tid >> 4, pc = (C.tid & 15) * 8;
#define PP_BAR() do { asm volatile("s_waitcnt lgkmcnt(0)" ::: "memory"); __builtin_amdgcn_s_barrier(); asm volatile("" ::: "memory"); } while (0)
    for (int itb = C.vcu; itb < NBATCH * 32; itb += C.G) {
        const int c = itb & 31, b = itb >> 5;
        const size_t rowb = (size_t)b * SEQLEN + c * 64;
        const size_t row0 = rowb + tq * 16;
        if (NH == 4) { __syncthreads(); tail_mfma(C, b * SEQLEN + c * 64, (const bf16*)(C.ws + WS_TAILW) + 2 * 16 * 1024, part); }
        v4u pq[2], pk[2];
#define PP_LOAD(h_) do { _Pragma("unroll") for (int j = 0; j < 2; ++j) { const size_t r_ = (rowb + pr0 + 32 * j) * 1024 + (h_) * 128 + pc; \
            pq[j] = *(const GAS v4u*)(P0 + r_); pk[j] = *(const GAS v4u*)((NH == 4 ? P0 + 512 : P1) + r_); } } while (0)
        PP_LOAD(0);
#pragma unroll 1
        for (int h = 0; h < NH; ++h) {
            const int it = (b * NH + h) * 32 + c;
            float wu[16]; float ba = 0.f, lb = 0.f;
            if (NH == 4) {
#pragma unroll
                for (int r = 0; r < 16; ++r) wu[r] = C.in[9][r * 512 + h * 128 + d];
                ba = C.in[10][h * 128 + d];
            } else lb = ((const float*)(C.ws + WS_LB))[h * 128 + d];
            PP_BAR();
#pragma unroll
            for (int j = 0; j < 2; ++j) { *(LAS v4u*)(tqs + (pr0 + 32 * j) * 128 + pc) = pq[j]; *(LAS v4u*)(tks + (pr0 + 32 * j) * 128 + pc) = pk[j]; }
            if (h + 1 < NH) PP_LOAD(h + 1);
            PP_BAR();
            float bl[16], kk[16]; float run = 0.f;
            if (NH == 4) {
#pragma unroll
                for (int i = 0; i < 16; ++i) { float z = ba; const int t = tq * 16 + i;
#pragma unroll
                    for (int r = 0; r < 16; r += 4) { const f32x4 p0 = *(const LAS f32x4*)(part + t * 16 + r), p1 = *(const LAS f32x4*)(part + 1024 + t * 16 + r);
                        z += (p0[0] + p1[0]) * wu[r] + (p0[1] + p1[1]) * wu[r + 1] + (p0[2] + p1[2]) * wu[r + 2] + (p0[3] + p1[3]) * wu[r + 3]; }
                    run += log_sigmoid_f(z) * (1.f / 16.f); bl[i] = run; kk[i] = bf2f(tks[t * 128 + d]); }
            } else {
#pragma unroll
                for (int i = 0; i < 16; ++i) { const float gate = lb + (1.f - lb) * sigmoid_f(bf2f(tks[(tq * 16 + i) * 128 + d])); run += __logf(gate); bl[i] = run; kk[i] = 1.f - gate; }
            }
            tot[tq * 128 + d] = run;
            PP_BAR();
            const float t0 = tot[d], t1 = tot[128 + d], t2 = tot[256 + d], t3 = tot[384 + d];
            const float off = tq == 0 ? 0.f : tq == 1 ? t0 : tq == 2 ? t0 + t1 : t0 + t1 + t2;
            const float bref = t0 + t1, bend = (t0 + t1) + (t2 + t3);
            unsigned ksw[8];
#pragma unroll
            for (int i = 0; i < 16; ++i) {
                const float bb = bl[i] + off;
                const float qv = bf2f(tqs[(tq * 16 + i) * 128 + d]) * qs, kv = kk[i];
                q1s[(tq * 16 + i) * 128 + dq] = (bf16)f2bfh(qv * __expf(bb));
                q2s[(tq * 16 + i) * 136 + d] = (bf16)f2bfh(qv * __expf(bb - bref));
                k2s[(tq * 16 + i) * 136 + d] = (bf16)f2bfh(kv * __expf(bref - bb));
                const unsigned kb = f2bfh(kv * __expf(bend - bb));
                if (i & 1) ksw[i >> 1] |= kb << 16; else ksw[i >> 1] = kb;
            }
            { bf16* kt = KST + ((size_t)it * 128 + d) * 64 + tq * 16; *(GAS v4u*)kt = (v4u){ksw[0], ksw[1], ksw[2], ksw[3]}; *(GAS v4u*)(kt + 8) = (v4u){ksw[4], ksw[5], ksw[6], ksw[7]}; }
            if (tq == 0) DEC[(size_t)it * 128 + d] = __expf(bend);
            PP_BAR();
#pragma unroll
            for (int j = 0; j < 2; ++j) *(GAS v4u*)(Q1 + (((size_t)it * 4 + (pc >> 5)) * 64 + pr0 + 32 * j) * 32 + (pc & 31)) = *(const LAS v4u*)(q1s + (pr0 + 32 * j) * 128 + pc);
            const int ti = C.wave >> 1;
#pragma unroll
            for (int sj = 0; sj < 2; ++sj) {
                const int si = 2 * (C.wave & 1) + sj;
                f32x4 acc = (f32x4){0.f, 0.f, 0.f, 0.f};
                if (si <= ti) {
#pragma unroll
                    for (int ks = 0; ks < 4; ++ks) {
                        const bf16x8 a = *(const LAS bf16x8*)(q2s + (16 * ti + fr) * 136 + ks * 32 + fq * 8), bb = *(const LAS bf16x8*)(k2s + (16 * si + fr) * 136 + ks * 32 + fq * 8);
                        acc = __builtin_amdgcn_mfma_f32_16x16x32_bf16(bb, a, acc, 0, 0, 0);
                    }
                }
                const int t = 16 * ti + fr, s0 = 16 * si + 4 * fq;
                typedef unsigned u32x2v __attribute__((ext_vector_type(2)));
                u32x2v w; w.x = pk2(s0 <= t ? acc[0] : 0.f, s0 + 1 <= t ? acc[1] : 0.f); w.y = pk2(s0 + 2 <= t ? acc[2] : 0.f, s0 + 3 <= t ? acc[3] : 0.f);
                *(GAS u32x2v*)(ASC + (size_t)it * 4096 + t * 64 + s0) = w;
            }
        }
    }
#undef PP_LOAD
#undef PP_BAR
}
struct RecFrag { bf16x8 a0, a1; bf16x8 q[4]; f32x4 dc[2]; bf16x8 ks[2][2]; };
template <int NH, int DV, int RP = 0  >
__device__ __forceinline__ void chunk_recur(const Ctx& C, const bf16* Vp) {
    const bf16* ASC = (const bf16*)(C.ws + WS_ASC); const bf16* Q1 = (const bf16*)(C.ws + WS_Q1); const bf16* KST = (const bf16*)(C.ws + WS_KST); const float* DEC = (const float*)(C.ws + WS_DEC);
    bf16* OF = (bf16*)(C.ws + (RP ? WS_GLOG : WS_OF));
    constexpr int NCB = DV / 16, NTASK = NBATCH * NH * NCB;
    const int l = C.lane, m = l & 15, g = l >> 4, gi = C.wave >> 2, kq = C.wave & 3;
    LAS float* red = (LAS float*)C.lds + gi * 8192;
    LAS bf16* vt = (LAS bf16*)(C.lds + 65536) + gi * 2048;
    typedef short v4i16_t __attribute__((ext_vector_type(4)));
#define REC_LOAD(F, c_) do { const size_t row0_ = (size_t)b * SEQLEN + (c_) * 64; const size_t ch_ = (size_t)bh * 32 + (c_); \
        F.a0 = *(const bf16x8*)(ASC + ch_ * 4096 + (16 * kq + m) * 64 + 8 * g); F.a1 = *(const bf16x8*)(ASC + ch_ * 4096 + (16 * kq + m) * 64 + 32 + 8 * g); \
        _Pragma("unroll") for (int tb = 0; tb < 4; ++tb) F.q[tb] = *(const bf16x8*)(Q1 + ((ch_ * 4 + kq) * 64 + 16 * tb + m) * 32 + 8 * g); \
        _Pragma("unroll") for (int i = 0; i < 2; ++i) { F.dc[i] = *(const f32x4*)(DEC + ch_ * 128 + 32 * kq + 16 * i + 4 * g); \
            _Pragma("unroll") for (int ks = 0; ks < 2; ++ks) F.ks[i][ks] = *(const bf16x8*)(KST + (ch_ * 128 + 32 * kq + 16 * i + m) * 64 + 32 * ks + 8 * g); } } while (0)
#define VP_LOAD(c_) (*(const unsigned long long*)(Vp + ((size_t)b * SEQLEN + (c_) * 64 + 16 * kq + (l >> 2)) * 1024 + h * DV + cb * 16 + 4 * (l & 3)))
#define VT_PUT(c_, v_) (*(LAS unsigned long long*)(vt + ((c_) & 1) * 1024 + (16 * kq + (l >> 2)) * 16 + 4 * (l & 3)) = (v_))
#define REC_BODY(F, Fn, c_, vcur_, vnew_) do { \
        if ((c_) + 1 < 32 && RP != 3) REC_LOAD(Fn, (c_) + 1); \
        if ((c_) + 2 < 32) vnew_ = VP_LOAD((c_) + 2); \
        bf16x8 vb[2]; \
        _Pragma("unroll") for (int ks = 0; ks < 2; ++ks) { const LAS bf16* tp_ = vt + ((c_) & 1) * 1024 + (32 * ks + 8 * g + ((l & 15) >> 2)) * 16 + 4 * (l & 3); \
            const v4i16_t lo_ = __builtin_amdgcn_ds_read_tr16_b64_v4i16((LAS v4i16_t*)tp_), hi_ = __builtin_amdgcn_ds_read_tr16_b64_v4i16((LAS v4i16_t*)(tp_ + 64)); \
            vb[ks] = (bf16x8){lo_[0], lo_[1], lo_[2], lo_[3], hi_[0], hi_[1], hi_[2], hi_[3]}; } \
        if ((c_) + 1 < 32) VT_PUT((c_) + 1, vcur_);              \
        if (BGQ && RP == 0) { const int bgn = (bgit * 32 + (c_)) * C.NGW + C.gw; bgq_step<JOB>(C, bgi, bgn, bgv); bgi = bgn; } \
        LAS float* rb = red + ((c_) & 1) * 4096; \
        f32x4 oin = __builtin_amdgcn_mfma_f32_16x16x32_bf16(F.a0, vb[0], (f32x4){0.f, 0.f, 0.f, 0.f}, 0, 0, 0); \
        if (kq >= 2) oin = __builtin_amdgcn_mfma_f32_16x16x32_bf16(F.a1, vb[1], oin, 0, 0, 0); \
        { u32x4v sw; sw.x = pk2(S[0][0], S[0][1]); sw.y = pk2(S[0][2], S[0][3]); sw.z = pk2(S[1][0], S[1][1]); sw.w = pk2(S[1][2], S[1][3]); \
          const bf16x8 sb = __builtin_bit_cast(bf16x8, sw); \
          _Pragma("unroll") for (int tb = 0; tb < 4; ++tb) { \
              const f32x4 po = __builtin_amdgcn_mfma_f32_16x16x32_bf16(F.q[tb], sb, (f32x4){0.f, 0.f, 0.f, 0.f}, 0, 0, 0); \
              *(LAS f32x4*)(rb + ((kq * 4 + tb) * 64 + l) * 4) = po; } } \
        _Pragma("unroll") for (int i = 0; i < 2; ++i) { S[i] = S[i] * F.dc[i]; \
            _Pragma("unroll") for (int ks = 0; ks < 2; ++ks) S[i] = __builtin_amdgcn_mfma_f32_16x16x32_bf16(F.ks[i][ks], vb[ks], S[i], 0, 0, 0); } \
        if (RP != 2) { asm volatile("s_waitcnt lgkmcnt(0)" ::: "memory"); __builtin_amdgcn_s_barrier(); asm volatile("" ::: "memory"); } \
        { f32x4 o = oin; \
          if (RP != 2) { _Pragma("unroll") for (int k2 = 0; k2 < 4; ++k2) o = o + *(const LAS f32x4*)(rb + ((k2 * 4 + kq) * 64 + l) * 4); } \
          const size_t orow = (size_t)b * SEQLEN + (c_) * 64 + 16 * kq + 4 * g; \
          if (RP != 4 || (c_) == 31) { _Pragma("unroll") for (int r = 0; r < 4; ++r) OF[(orow + r) * 1024 + col] = (bf16)f2bf(o[r]); } } } while (0)
    constexpr int JOB = NH == 4 ? 1 : 2;
    f32x4 bgv[4]; int bgi = -1, bgit = 0;
    for (int t0 = C.vcu; t0 < NTASK / 2; t0 += C.G, ++bgit) {
        const int task = gi * (NTASK / 2) + t0;
        const int cb = task % NCB, bh = task / NCB, b = bh / NH, h = bh % NH;
        const int col = h * DV + cb * 16 + m;
        f32x4 S[2];
        S[0] = (f32x4){0.f, 0.f, 0.f, 0.f}; S[1] = S[0];
        RecFrag FA, FB;
        REC_LOAD(FA, 0);
        if (RP == 3) REC_LOAD(FB, 1);
        unsigned long long vA = VP_LOAD(0), vB = VP_LOAD(1);
        VT_PUT(0, vA); vA = vB;
        asm volatile("s_waitcnt lgkmcnt(0)" ::: "memory"); __builtin_amdgcn_s_barrier(); asm volatile("" ::: "memory");
#pragma unroll 1
        for (int c = 0; c < 32; c += 2) { REC_BODY(FA, FB, c, vA, vB); REC_BODY(FB, FA, c + 1, vB, vA); }
        asm volatile("s_waitcnt lgkmcnt(0)" ::: "memory"); __builtin_amdgcn_s_barrier(); asm volatile("" ::: "memory");
    }
    if (BGQ && RP == 0) {
        for (int bgn = bgit * 32 * C.NGW + C.gw; bgi < BGQ_ROWS; bgn += C.NGW) { bgq_step<JOB>(C, bgi, bgn, bgv); bgi = bgn; }
    }
#undef REC_LOAD
#undef REC_BODY
#undef VP_LOAD
#undef VT_PUT
}

template <int DV>
__device__ __forceinline__ void rec_norm_gate(const Ctx& C, const float* gain, const bf16* gate) {
    const bf16* OF = (const bf16*)(C.ws + WS_OF); bf16* OB = (bf16*)(C.ws + WS_OB);
    f32x4 g[4];
#pragma unroll
    for (int j = 0; j < 4; ++j) g[j] = *((const GAS f32x4*)gain + C.lane + 64 * j);
    for (int tok0 = C.gw; tok0 < NTOK; tok0 += 4 * C.NGW) {
        unsigned long long vw[4][4], tw[4][4];
#pragma unroll
        for (int u = 0; u < 4; ++u) { const int tok = tok0 + u * C.NGW; if (tok < NTOK) {
            const GAS unsigned long long* xr = (const GAS unsigned long long*)(OF + (size_t)tok * 1024) + C.lane;
            const GAS unsigned long long* tr = (const GAS unsigned long long*)(gate + (size_t)tok * 1024) + C.lane;
#pragma unroll
            for (int j = 0; j < 4; ++j) { vw[u][j] = xr[64 * j]; tw[u][j] = tr[64 * j]; } } }
        __builtin_amdgcn_sched_barrier(0);
#pragma unroll
        for (int u = 0; u < 4; ++u) { const int tok = tok0 + u * C.NGW; if (tok < NTOK) {
            GAS unsigned long long* o8 = (GAS unsigned long long*)(OB + (size_t)tok * 1024) + C.lane;
#pragma unroll
            for (int j = 0; j < 4; ++j) {
                const f32x4 v = (f32x4){bflo((unsigned)vw[u][j]), bfhi((unsigned)vw[u][j]), bflo((unsigned)(vw[u][j] >> 32)), bfhi((unsigned)(vw[u][j] >> 32))}; float ss = (v.x * v.x + v.y * v.y) + (v.z * v.z + v.w * v.w);
                if (DV == 256) ss = wave_sum(ss); else { DPP_SUM31(ss); const float s_lo = rdlane(ss, 31), s_hi = rdlane(ss, 63); ss = C.lane < 32 ? s_lo : s_hi; }
                const float r = rsqrtf(ss * (1.f / DV) + RMS_EPS);
                const unsigned long long t8 = tw[u][j];
                const float t0 = bflo((unsigned)t8), t1 = bfhi((unsigned)t8), t2 = bflo((unsigned)(t8 >> 32)), t3 = bfhi((unsigned)(t8 >> 32));
                const float a0 = v.x * r * g[j].x * (t0 * sigmoid_f(t0)), a1 = v.y * r * g[j].y * (t1 * sigmoid_f(t1)), a2 = v.z * r * g[j].z * (t2 * sigmoid_f(t2)), a3 = v.w * r * g[j].w * (t3 * sigmoid_f(t3));
                o8[64 * j] = (unsigned long long)pk2h(a0, a1) | ((unsigned long long)pk2h(a2, a3) << 32);
            } } }
    }
}

#define CE_D(a, b) do { const unsigned mx_ = (a) > (b) ? (a) : (b); const unsigned mn_ = (a) > (b) ? (b) : (a); (a) = mx_; (b) = mn_; } while (0)
__device__ __forceinline__ void sort16_desc(unsigned (&a)[16]) {
#define S16(i, j) CE_D(a[i], a[j])
    S16(0,13); S16(1,12); S16(2,15); S16(3,14); S16(4,8); S16(5,6); S16(7,11); S16(9,10);
    S16(0,5); S16(1,7); S16(2,9); S16(3,4); S16(6,13); S16(8,14); S16(10,15); S16(11,12);
    S16(0,1); S16(2,3); S16(4,5); S16(6,8); S16(7,9); S16(10,11); S16(12,13); S16(14,15);
    S16(0,2); S16(1,3); S16(4,10); S16(5,11); S16(6,7); S16(8,9); S16(12,14); S16(13,15);
    S16(1,2); S16(3,12); S16(4,6); S16(5,7); S16(8,10); S16(9,11); S16(13,14);
    S16(1,4); S16(2,6); S16(5,8); S16(7,10); S16(9,13); S16(11,14);
    S16(2,4); S16(3,6); S16(9,12); S16(11,13);
    S16(3,5); S16(6,8); S16(7,9); S16(10,12);
    S16(3,4); S16(5,6); S16(7,8); S16(9,10); S16(11,12);
    S16(6,7); S16(8,9);
#undef S16
}
__device__ __forceinline__ void merge_top16(unsigned (&a)[16], const unsigned (&b)[16]) {
#pragma unroll
    for (int i = 0; i < 16; ++i) a[i] = a[i] > b[15 - i] ? a[i] : b[15 - i];
#pragma unroll
    for (int j = 8; j > 0; j >>= 1)
#pragma unroll
        for (int i = 0; i < 16; ++i) { const int l = i ^ j; if (l > i) CE_D(a[i], a[l]); }
}
__device__ __forceinline__ void merge_quad(unsigned (&a)[16], int lane) {
    unsigned p[16];
#pragma unroll
    for (int i = 0; i < 16; ++i) p[i] = (unsigned)__builtin_amdgcn_ds_bpermute((lane ^ 16) << 2, (int)a[i]);
    merge_top16(a, p);
#pragma unroll
    for (int i = 0; i < 16; ++i) p[i] = (unsigned)__builtin_amdgcn_ds_bpermute((lane ^ 32) << 2, (int)a[i]);
    merge_top16(a, p);
}
__device__ __forceinline__ unsigned mono_key(float f) { const unsigned u = __float_as_uint(f); return (u & 0x80000000u) ? ~u : (u | 0x80000000u); }
__device__ __forceinline__ float mono_inv(unsigned k) { return __uint_as_float((k & 0x80000000u) ? (k ^ 0x80000000u) : ~k); }
__constant__ __attribute__((aligned(16))) unsigned char PEER_CAND[64] = {0, 1, 2, 3, 4, 5, 6, 7, 8, 9, 10, 11, 12, 13, 14, 15, 16, 17, 18, 19, 20, 21, 22, 23, 32, 33, 34, 35, 36, 64, 65, 66, 48, 49, 50, 51, 80, 81, 96, 97, 112, 113, 128, 144, 160, 176, 192, 208, 224, 240, 255, 255, 255, 255, 255, 255, 255, 255, 255, 255, 255, 255, 255, 255};
typedef _Float16 h8 __attribute__((ext_vector_type(8)));
__device__ __forceinline__ void peer_topk_load(const Ctx& C, int tok0, int head, h8 (&hv)[2][4]) {
    int l = C.lane; asm volatile("" : "+v"(l));
    const _Float16* SC = (const _Float16*)(C.ws + WS_Q2);
#pragma unroll
    for (int p = 0; p < 2; ++p) { const _Float16* sp = SC + (size_t)(tok0 + (l & 15)) * 2048 + head * 256 + p * 128 + 32 * (l >> 4);
#pragma unroll
        for (int q = 0; q < 4; ++q) hv[p][q] = *(const GAS h8*)(sp + 8 * q); }
}
__device__ __forceinline__ void peer_topk_task(const Ctx& C, int layer, int tok0, int head, int trow0, LAS int* lexp, LAS float* lgate, const h8 (&hvin)[2][4]) {
    LAS unsigned* L0 = (LAS unsigned*)(C.lds + C.wave * 2048);
    LAS unsigned* L1 = L0 + 256;
    {
        int l = C.lane; asm volatile("" : "+v"(l));
        const int m = l & 15, g = l >> 4;
        unsigned cand_w[4];
#pragma unroll
        for (int c = 0; c < 4; ++c) cand_w[c] = ((const unsigned*)PEER_CAND)[g * 4 + c];
        unsigned top[2][16];
#pragma unroll
        for (int p = 0; p < 2; ++p) {
            h8 hv[4];
#pragma unroll
            for (int q = 0; q < 4; ++q) hv[q] = hvin[p][q];
            unsigned hi16[16];
#pragma unroll
            for (int q = 0; q < 4; ++q)
#pragma unroll
                for (int j = 0; j < 8; ++j) { const int i = 8 * q + j; const unsigned key = (mono_key((float)hv[q][j]) & ~0x7fu) | (unsigned)(127 - (32 * g + i));
                    if (i < 16) top[p][i] = key; else hi16[i - 16] = key; }
            sort16_desc(top[p]); sort16_desc(hi16); merge_top16(top[p], hi16);
            merge_quad(top[p], l);
        }
        if (g == 0) {
#pragma unroll
            for (int i = 0; i < 16; i += 4) { *(LAS u32x4v*)(L0 + m * 16 + i) = (u32x4v){top[0][i], top[0][i + 1], top[0][i + 2], top[0][i + 3]}; *(LAS u32x4v*)(L1 + m * 16 + i) = (u32x4v){top[1][i], top[1][i + 1], top[1][i + 2], top[1][i + 3]}; }
        }
        asm volatile("s_waitcnt lgkmcnt(0)" ::: "memory"); __builtin_amdgcn_wave_barrier();
        unsigned cd[16];
#pragma unroll
        for (int c = 0; c < 16; ++c) {
            const unsigned code = (cand_w[c >> 2] >> (8 * (c & 3))) & 0xffu, ci = (code >> 4) & 15u, cj = code & 15u;
            const float v = mono_inv(L0[m * 16 + ci]) + mono_inv(L1[m * 16 + cj]);
            cd[c] = code == 255u ? 0u : ((mono_key(v) & ~0xffu) | (255u - code));
        }
        sort16_desc(cd); merge_quad(cd, l);
        if (g == 0) {
            float best[16]; int ex[16]; float sum = 0.f;
#pragma unroll
            for (int r = 0; r < 16; ++r) { const unsigned pos = 255u - (cd[r] & 0xffu), pi = pos >> 4, pj = pos & 15u;
                ex[r] = (int)((127u - (L0[m * 16 + pi] & 0x7fu)) * 128u + (127u - (L1[m * 16 + pj] & 0x7fu))); best[r] = mono_inv(cd[r]); }
            const float bmax = best[0];
#pragma unroll
            for (int r = 0; r < 16; ++r) { best[r] = __expf(best[r] - bmax); sum += best[r]; }
            const float inv = 1.f / sum;
            const int ob = (trow0 + m) * 128 + head * 16;
#pragma unroll
            for (int r = 0; r < 16; r += 4) { *(LAS u32x4v*)(lexp + ob + r) = (u32x4v){(unsigned)ex[r], (unsigned)ex[r + 1], (unsigned)ex[r + 2], (unsigned)ex[r + 3]};
                *(LAS f32x4*)(lgate + ob + r) = (f32x4){best[r] * inv, best[r + 1] * inv, best[r + 2] * inv, best[r + 3] * inv}; }
        }
        asm volatile("s_waitcnt lgkmcnt(0)" ::: "memory"); __builtin_amdgcn_wave_barrier();
    }
}
typedef float f32x2v __attribute__((ext_vector_type(2)));
#define GRP8_SUM(v) do { v = DPP_ADD(v, 0xB1, 0xf, 0xf); v = DPP_ADD(v, 0x4E, 0xf, 0xf); v = DPP_ADD(v, 0x141, 0xf, 0xf); } while (0)
#ifndef MK_HOT
#define MK_HOT 0
#endif
__device__ __forceinline__ void wave_lds_sync() { asm volatile("s_waitcnt lgkmcnt(0)" ::: "memory"); __builtin_amdgcn_wave_barrier(); }
template <bool DRY>
__device__ __forceinline__ void peer_rounds(const Ctx& C, int layer, int tokw, LAS int* lexp_w, const LAS float* lgate_w, LAS unsigned* sorted_w, LAS unsigned* hist_w) {
    const unsigned char* U = C.ws + WS_U + (size_t)layer * 16384 * 1024; const unsigned char* V = C.ws + WS_V + (size_t)layer * 16384 * 1024;
    const LAS unsigned char* SU = (const LAS unsigned char*)(C.lds + 114688); const LAS unsigned char* SV = SU + 16384;
    const float* gf = C.in[2] + layer * 1024; const float* gn = C.in[1] + (layer + 1) * 1024;
    int l = C.lane; asm volatile("" : "+v"(l));
    LAS float* hbuf = (LAS float*)lexp_w;
    {
        const int t = l >> 3, s = l & 7;
#pragma unroll
        for (int k = 0; k < 8; ++k) hist_w[l + 64 * k] = 0u;
        wave_lds_sync();
        unsigned ev[16], pos[16];
#pragma unroll
        for (int k = 0; k < 16; ++k) { ev[k] = (unsigned)lexp_w[t * 128 + s + 8 * k]; pos[k] = __hip_atomic_fetch_add(hist_w + t * 64 + (ev[k] >> 8), 1u, __ATOMIC_RELAXED, __HIP_MEMORY_SCOPE_WORKGROUP); }
        wave_lds_sync();
        unsigned cnt[8], run = 0u;
#pragma unroll
        for (int j = 0; j < 8; ++j) { cnt[j] = hist_w[t * 64 + 8 * s + j]; run += cnt[j]; }
        unsigned inc = run;
#pragma unroll
        for (int o = 1; o < 8; o <<= 1) { const unsigned up = (unsigned)__builtin_amdgcn_ds_bpermute((l - o) << 2, (int)inc); if (s >= o) inc += up; }
        unsigned off = inc - run;
        wave_lds_sync();
#pragma unroll
        for (int j = 0; j < 8; ++j) { hist_w[t * 64 + 8 * s + j] = off; off += cnt[j]; }
        wave_lds_sync();
#pragma unroll
        for (int k = 0; k < 16; ++k) sorted_w[t * 128 + hist_w[t * 64 + (ev[k] >> 8)] + pos[k]] = (ev[k] << 7) | (unsigned)(s + 8 * k);
        wave_lds_sync();
    }
    asm volatile("" : "+v"(l));
    unsigned xh[8][4], xl[8][4]; float xs1, xs2;
    {
        unsigned xp[8][8];
        const int t = l >> 3, s = l & 7;
        const bf16* hrow = (const bf16*)(C.ws + WS_HB) + (size_t)(tokw + t) * 1024 + 16 * s;
        float ss = 0.f;
#pragma unroll
        for (int i = 0; i < 8; ++i) { const v4u a = *(const GAS v4u*)(hrow + 128 * i), b = *(const GAS v4u*)(hrow + 128 * i + 8);
            xp[i][0] = a.x; xp[i][1] = a.y; xp[i][2] = a.z; xp[i][3] = a.w; xp[i][4] = b.x; xp[i][5] = b.y; xp[i][6] = b.z; xp[i][7] = b.w;
#pragma unroll
            for (int j = 0; j < 8; ++j) { const float lo = bflo(xp[i][j]), hi = bfhi(xp[i][j]); ss += lo * lo + hi * hi; } }
        GRP8_SUM(ss);
        const float r = rsqrtf(ss * (1.f / 1024.f) + RMS_EPS);
#pragma unroll
        for (int i = 0; i < 8; ++i)
#pragma unroll
            for (int q = 0; q < 4; ++q) { const f32x4 a = *(const GAS f32x4*)(gf + 16 * s + 128 * i + 4 * q);
                xp[i][2 * q] = pk2(bflo(xp[i][2 * q]) * r * a.x, bfhi(xp[i][2 * q]) * r * a.y); xp[i][2 * q + 1] = pk2(bflo(xp[i][2 * q + 1]) * r * a.z, bfhi(xp[i][2 * q + 1]) * r * a.w); }
        float am = 0.f;
#pragma unroll
        for (int i = 0; i < 8; ++i)
#pragma unroll
            for (int j = 0; j < 8; ++j) am = fmaxf(am, fmaxf(fabsf(bflo(xp[i][j])), fabsf(bfhi(xp[i][j]))));
        am = DPP_MAX(am, 0xB1, 0xf, 0xf); am = DPP_MAX(am, 0x4E, 0xf, 0xf); am = DPP_MAX(am, 0x141, 0xf, 0xf);
        const float inv1 = am > 0.f ? 127.f / am : 0.f, inv2 = 254.f * inv1; xs1 = am * (1.f / 127.f); xs2 = xs1 * (1.f / 254.f);
#pragma unroll
        for (int i = 0; i < 8; ++i)
#pragma unroll
            for (int q = 0; q < 4; ++q) { const float x0 = bflo(xp[i][2 * q]), x1 = bfhi(xp[i][2 * q]), x2 = bflo(xp[i][2 * q + 1]), x3 = bfhi(xp[i][2 * q + 1]);
                const float q0 = __builtin_rintf(x0 * inv1), q1 = __builtin_rintf(x1 * inv1), q2 = __builtin_rintf(x2 * inv1), q3 = __builtin_rintf(x3 * inv1);
                xh[i][q] = q8x4(q0, q1, q2, q3); xl[i][q] = q8x4((x0 - q0 * xs1) * inv2, (x1 - q1 * xs1) * inv2, (x2 - q2 * xs1) * inv2, (x3 - q3 * xs1) * inv2); }
    }
    asm volatile("" : "+v"(l));
#define RND_LOAD(T, buf, item) do { const unsigned char* p_ = T + (size_t)((DRY && MK_HOT) ? (((item) >> 7) & 255u) : ((item) >> 7)) * 1024 + 16 * (l & 7); \
        _Pragma("unroll") for (int i = 0; i < 8; ++i) buf[i] = *(const GAS v4u*)(p_ + 128 * i); } while (0)
    {
        const int t = l >> 3, s = l & 7;
        const LAS unsigned* srt = sorted_w + t * 128;
        v4u bA[8], bB[8];
#define RND_DOT(buf, r_) do { int dh = 0, dl = 0; \
            _Pragma("unroll") for (int i = 0; i < 8; ++i) { _Pragma("unroll") for (int q = 0; q < 4; ++q) { \
                dh = __builtin_amdgcn_sdot4((int)buf[i][q], (int)xh[i][q], dh, false); dl = __builtin_amdgcn_sdot4((int)buf[i][q], (int)xl[i][q], dl, false); } } \
            float d = (float)dh * xs1 + (float)dl * xs2; \
            GRP8_SUM(d); if (s == 0) hbuf[t * 128 + (r_)] = d; } while (0)
        RND_LOAD(U, bA, srt[0]);
#pragma unroll 1
        for (int r = 0; r < 128; r += 2) {
            RND_LOAD(U, bB, srt[r + 1]);
            RND_DOT(bA, r);
            RND_LOAD(U, bA, srt[(r + 2) & 127]);
            RND_DOT(bB, r + 1);
        }
#undef RND_DOT
    }
    wave_lds_sync();
    asm volatile("" : "+v"(l));
    {
        const int t = l >> 3, s = l & 7;
#pragma unroll
        for (int k = 0; k < 16; k += 2) {
            const int r0 = t * 128 + s + 8 * k, r1 = r0 + 8;
            const unsigned i0 = sorted_w[r0], i1 = sorted_w[r1];
            const float h0 = hbuf[r0] * __uint_as_float((unsigned)SU[i0 >> 7] << 23), h1 = hbuf[r1] * __uint_as_float((unsigned)SU[i1 >> 7] << 23);
            const pg8::f32x2 gl = pg8::gelu_pk((pg8::f32x2){h0, h1});
            hbuf[r0] = gl.x * lgate_w[t * 128 + (i0 & 127u)] * __uint_as_float((unsigned)SV[i0 >> 7] << 23); hbuf[r1] = gl.y * lgate_w[t * 128 + (i1 & 127u)] * __uint_as_float((unsigned)SV[i1 >> 7] << 23);
        }
    }
    wave_lds_sync();
    asm volatile("" : "+v"(l));
    f32x2v y2[8][8];
#pragma unroll
    for (int i = 0; i < 8; ++i)
#pragma unroll
        for (int j = 0; j < 8; ++j) y2[i][j] = (f32x2v){0.f, 0.f};
    {
        const int t = l >> 3;
        const LAS unsigned* srt = sorted_w + t * 128; const LAS float* wv = hbuf + t * 128;
        v4u bA[8], bB[8];
#define RND_AXPY(buf, r_) do { const float w = wv[(r_)]; const f32x2v w2 = (f32x2v){w, w}; \
            _Pragma("unroll") for (int i = 0; i < 8; ++i) { asm volatile("" : "+v"(buf[i])); _Pragma("unroll") for (int q = 0; q < 4; ++q) { \
                const f32x2v lo_ = __builtin_amdgcn_cvt_pk_f32_fp8((int)buf[i][q], false), hi_ = __builtin_amdgcn_cvt_pk_f32_fp8((int)buf[i][q], true); \
                y2[i][2 * q] = w2 * lo_ + y2[i][2 * q]; y2[i][2 * q + 1] = w2 * hi_ + y2[i][2 * q + 1]; } } } while (0)
        RND_LOAD(V, bA, srt[0]);
#pragma unroll 1
        for (int r = 0; r < 128; r += 2) {
            RND_LOAD(V, bB, srt[r + 1]);
            RND_AXPY(bA, r);
            RND_LOAD(V, bA, srt[(r + 2) & 127]);
            RND_AXPY(bB, r + 1);
        }
#undef RND_AXPY
    }
#undef RND_LOAD
    asm volatile("" : "+v"(l));
    {
        const int t = l >> 3, s = l & 7;
        const bf16* hrow = (const bf16*)(C.ws + WS_HB) + (size_t)(tokw + t) * 1024 + 16 * s;
        float* hout = (DRY ? (float*)(C.ws + WS_OF) : C.out) + (size_t)(tokw + t) * 1024 + 16 * s;
        bf16* hb = (bf16*)(C.ws + (DRY ? WS_OF : WS_HB)) + (size_t)(tokw + t) * 1024 + 16 * s;
        float s2 = 0.f;
#pragma unroll
        for (int i = 0; i < 8; ++i) { const v4u a = *(const GAS v4u*)(hrow + 128 * i), b = *(const GAS v4u*)(hrow + 128 * i + 8);
            const unsigned hw[8] = {a.x, a.y, a.z, a.w, b.x, b.y, b.z, b.w};
#pragma unroll
            for (int j = 0; j < 8; ++j) { y2[i][j].x += bflo(hw[j]); y2[i][j].y += bfhi(hw[j]); s2 += y2[i][j].x * y2[i][j].x + y2[i][j].y * y2[i][j].y; }
            if (layer == DEPTH - 1) {
#pragma unroll
                for (int q = 0; q < 4; ++q) *(GAS f32x4*)(hout + 128 * i + 4 * q) = (f32x4){y2[i][2 * q].x, y2[i][2 * q].y, y2[i][2 * q + 1].x, y2[i][2 * q + 1].y};
            } else {
                *(GAS v4u*)(hb + 128 * i) = (v4u){pk2(y2[i][0].x, y2[i][0].y), pk2(y2[i][1].x, y2[i][1].y), pk2(y2[i][2].x, y2[i][2].y), pk2(y2[i][3].x, y2[i][3].y)};
                *(GAS v4u*)(hb + 128 * i + 8) = (v4u){pk2(y2[i][4].x, y2[i][4].y), pk2(y2[i][5].x, y2[i][5].y), pk2(y2[i][6].x, y2[i][6].y), pk2(y2[i][7].x, y2[i][7].y)};
            } }
        if (layer < DEPTH - 1) {
            GRP8_SUM(s2);
            const float r2 = rsqrtf(s2 * (1.f / 1024.f) + RMS_EPS);
            const bool wx8 = ((I8MASK >> (layer + 1)) & 1) != 0, wxn = ((layer + 1) % 3 != 2) || !wx8;
            bf16* xo = (bf16*)(C.ws + (DRY ? WS_GLOG : WS_XN)) + (size_t)(tokw + t) * 1024 + 16 * s; float am = 0.f;
#pragma unroll
            for (int i = 0; i < 8; ++i) { unsigned pw[8];
#pragma unroll
                for (int q = 0; q < 4; ++q) { const f32x4 a = *(const GAS f32x4*)(gn + 16 * s + 128 * i + 4 * q);
                    y2[i][2 * q].x *= r2 * a.x; y2[i][2 * q].y *= r2 * a.y; y2[i][2 * q + 1].x *= r2 * a.z; y2[i][2 * q + 1].y *= r2 * a.w;
                    am = fmaxf(fmaxf(am, fmaxf(fabsf(y2[i][2 * q].x), fabsf(y2[i][2 * q].y))), fmaxf(fabsf(y2[i][2 * q + 1].x), fabsf(y2[i][2 * q + 1].y)));
                    pw[2 * q] = pk2(y2[i][2 * q].x, y2[i][2 * q].y); pw[2 * q + 1] = pk2(y2[i][2 * q + 1].x, y2[i][2 * q + 1].y); }
                if (wxn) { *(GAS v4u*)(xo + 128 * i) = (v4u){pw[0], pw[1], pw[2], pw[3]}; *(GAS v4u*)(xo + 128 * i + 8) = (v4u){pw[4], pw[5], pw[6], pw[7]}; } }
            if (wx8) {
            am = DPP_MAX(am, 0xB1, 0xf, 0xf); am = DPP_MAX(am, 0x4E, 0xf, 0xf); am = DPP_MAX(am, 0x141, 0xf, 0xf);
            const float qi = am > 0.f ? 127.f / am : 0.f;
            signed char* xq = (signed char*)(C.ws + (DRY ? WS_GLOG + 32 * MiB : WS_XN8)) + (size_t)(tokw + t) * 1024 + 16 * s;
#pragma unroll
            for (int i = 0; i < 8; ++i) { unsigned pq[4];
#pragma unroll
                for (int q = 0; q < 4; ++q) pq[q] = q8x4(y2[i][2 * q].x * qi, y2[i][2 * q].y * qi, y2[i][2 * q + 1].x * qi, y2[i][2 * q + 1].y * qi);
                *(GAS v4u*)(xq + 128 * i) = (v4u){pq[0], pq[1], pq[2], pq[3]}; }
            if (s == 0) *(GAS float*)((float*)(C.ws + (DRY ? WS_GLOG + 48 * MiB : WS_SX)) + tokw + t) = am * (1.f / 127.f);
            }
        }
    }
}
#ifndef MK_SWEEP
#define MK_SWEEP 2
#endif
template <bool DRY>
__device__ __forceinline__ void peer_topk_gather(const Ctx& C, int layer) {
    LAS int* lexp = (LAS int*)(C.lds + 16384);
    LAS float* lgate = (LAS float*)(C.lds + 16384 + 32768);
    LAS unsigned* sorted = (LAS unsigned*)(C.lds + 16384 + 65536);
    {
        int tid = C.tid; asm volatile("" : "+v"(tid));
        const v4u a0 = *(const GAS v4u*)(C.ws + WS_SU + (size_t)layer * 16384 + tid * 32), a1 = *(const GAS v4u*)(C.ws + WS_SU + (size_t)layer * 16384 + tid * 32 + 16);
        const v4u b0 = *(const GAS v4u*)(C.ws + WS_SV + (size_t)layer * 16384 + tid * 32), b1 = *(const GAS v4u*)(C.ws + WS_SV + (size_t)layer * 16384 + tid * 32 + 16);
        LAS unsigned char* lsc = C.lds + 114688;
        *(LAS v4u*)(lsc + tid * 32) = a0; *(LAS v4u*)(lsc + tid * 32 + 16) = a1; *(LAS v4u*)(lsc + 16384 + tid * 32) = b0; *(LAS v4u*)(lsc + 16384 + tid * 32 + 16) = b1;
    }
    for (int tb = C.vcu; tb < NTOK / 64; tb += C.G) {
        {
            h8 hva[2][4], hvb[2][4];
            const int tk0 = tb * 64 + (C.wave & 3) * 16, hd0 = (C.wave >> 2) * 4, tr0 = (C.wave & 3) * 16;
            peer_topk_load(C, tk0, hd0, hva);
#pragma unroll 1
            for (int q = 0; q < 4; q += 2) {
                peer_topk_load(C, tk0, hd0 + q + 1, hvb);
                peer_topk_task(C, layer, tk0, hd0 + q, tr0, lexp, lgate, hva);
                if (q + 2 < 4) peer_topk_load(C, tk0, hd0 + q + 2, hva);
                peer_topk_task(C, layer, tk0, hd0 + q + 1, tr0, lexp, lgate, hvb);
            }
        }
        __syncthreads();
#if MK_SWEEP == 2
        peer_rounds<DRY>(C, layer, tb * 64 + C.wave * 8, lexp + C.wave * 1024, lgate + C.wave * 1024, sorted + C.wave * 1024, (LAS unsigned*)(C.lds + C.wave * 2048));
#elif MK_SWEEP == 1
#error removed variant
        peer_sweep<DRY>(C, layer, tb * 64 + C.wave * 8, lexp + C.wave * 1024, lgate + C.wave * 1024, sorted + C.wave * 1024, (LAS unsigned*)(C.lds + C.wave * 1024));
#else
#pragma unroll 1
        for (int t = 0; t < 8; ++t) peer_gather_token<DRY>(C, layer, tb * 64 + C.wave * 8 + t, lexp + (C.wave * 8 + t) * 128, lgate + (C.wave * 8 + t) * 128);
#endif
        __syncthreads();
    }
}

#ifndef MK_SINGLE
#define MK_SINGLE 1
#endif
#ifndef MK_FASTGEMM
#define MK_FASTGEMM 1
#endif
constexpr int STEPS = 10, NPHASE = 1 + DEPTH * STEPS;
struct Args { const float* in[21]; float* out; unsigned char* ws; int ph_lo, ph_hi; };

template <int EPI>
__device__ __forceinline__ void do_gemm(const Ctx& C, const bf16* A, const bf16* Bt, int N, bf16* Ob, int ldc, int split, const float* rs_in, const float* base, float* outf, bf16* hg, const float* gain, float* rs_out) {
    pg8::Gemm g{A, Bt, NTOK, N, 1024}; pg8::StaticOrder S; S.init(NTOK, N, C.G, C.bx);
    if constexpr (EPI == 0) { pg8::EpiBf16R<false> E{Ob, ldc, split ? 1024 : 0, PSTRIDE, rs_in}; pg8::gemm_phase<pg8::EpiBf16R<false>, pg8::StaticOrder, true, true>(C.lds, g, S, E, C.tid); }
    else if constexpr (EPI == 2) { pg8::EpiBf16R<true> E{Ob, ldc, 0, PSTRIDE, rs_in}; pg8::gemm_phase<pg8::EpiBf16R<true>, pg8::StaticOrder, true, true>(C.lds, g, S, E, C.tid); }
    else if constexpr (EPI == 3) {
        pg8::Gemm g8{A, Bt, NTOK, N, 512}; pg8::EpiI8<false> E{Ob, PSTRIDE, rs_in, gain, nullptr, nullptr, 1.f}; pg8::gemm_phase<pg8::EpiI8<false>, pg8::StaticOrder, true, true>(C.lds, g8, S, E, C.tid); }
    else if constexpr (EPI == 4) {
        pg8::Gemm g8{A, Bt, NTOK, N, 512}; pg8::EpiI8<true> E{Ob, PSTRIDE, rs_in, gain, base, (const float*)outf, FOX_C2}; pg8::gemm_phase<pg8::EpiI8<true>, pg8::StaticOrder, true, true>(C.lds, g8, S, E, C.tid); }
    else {
        bf16* HB = (bf16*)(C.ws + WS_HB); (void)outf;
        if (base) { pg8::EpiResNorm<false> E{base, HB, hg, gain, rs_out}; pg8::gemm_phase<pg8::EpiResNorm<false>, pg8::StaticOrder, true, true>(C.lds, g, S, E, C.tid); }
        else { pg8::EpiResNorm<true> E{HB, HB, hg, gain, rs_out}; pg8::gemm_phase<pg8::EpiResNorm<true>, pg8::StaticOrder, true, true>(C.lds, g, S, E, C.tid); } }
}

template <int STEP, int MIXER>
__device__ __forceinline__ void run_step(const Ctx& C, int layer) {
    const int jx = layer / 3;
    bf16* XN = (bf16*)(C.ws + WS_XN); bf16* P = (bf16*)(C.ws + WS_P); bf16* OB = (bf16*)(C.ws + WS_OB); bf16* Q2 = (bf16*)(C.ws + WS_Q2);
    if constexpr (STEP == 0) {
        const bf16* Wt = MIXER == 0 ? (const bf16*)(C.ws + WS_FOXWIN + (size_t)jx * 8 * MiB) : MIXER == 1 ? (const bf16*)(C.ws + WS_GLAWIN) : (const bf16*)(C.ws + WS_HGRNWIN);
        const float* sw = (const float*)(C.ws + WS_SW) + (MIXER == 0 ? jx * 4096 : MIXER == 1 ? 8192 : 11264);
        if (FOXFUSE && MIXER == 0) { do_gemm<4>(C, (const bf16*)(C.ws + WS_XN8), Wt, 4096, P, 1024, 1, (const float*)(C.ws + WS_SX), C.in[5] + jx * 64, (float*)(C.in[6] + jx * 64), nullptr, sw, nullptr); fox_step1<false>(C, jx); }
        else if ((I8MASK >> layer) & 1) do_gemm<3>(C, (const bf16*)(C.ws + WS_XN8), Wt, MIXER == 1 ? 3072 : 4096, P, 1024, 1, (const float*)(C.ws + WS_SX), nullptr, nullptr, nullptr, sw, nullptr);
        else do_gemm<0>(C, XN, Wt, MIXER == 1 ? 3072 : 4096, P, 1024, 1, nullptr, nullptr, nullptr, nullptr, nullptr, nullptr);
    } else if constexpr (STEP == 1) {
        if constexpr (MIXER == 0) { if (!FOXFUSE) fox_step1<true>(C, jx); }
    } else if constexpr (STEP == 2) {
        if constexpr (MIXER == 1) chunk_prepass<4>(C); else if constexpr (MIXER == 2) chunk_prepass<8>(C);
    } else if constexpr (STEP == 3) {
        if constexpr (MIXER == 0) {
            float gq = 0.f, gk = 0.f;
            for (int i = 0; i < 64; ++i) { gq = fmaxf(gq, fabsf(C.in[5][jx * 64 + i])); gk = fmaxf(gk, fabsf(C.in[6][jx * 64 + i])); }
            const float smax = 64.f * gq * gk * 0.125f * 1.4426950408889634f;
            const attn_body::AttnTensors AT{(const attn_body::bf16*)P, (const attn_body::bf16*)(P + PSTRIDE), (const attn_body::bf16*)(P + 2 * PSTRIDE), (attn_body::bf16*)OB, (const attn_body::bf16*)(P + 3 * PSTRIDE), (const float*)(C.ws + WS_TAIL), -(56.f + 2.f * smax)};
            const attn_body::StaticOrder S(C.G, C.bx);
            attn_body::attn_phase<attn_body::StaticOrder>((char*)C.lds, AT, S, C.tid);
        }
        else if constexpr (MIXER == 1) chunk_recur<4, 256>(C, P + PSTRIDE);
        else chunk_recur<8, 128>(C, P + 2 * PSTRIDE);
    } else if constexpr (STEP == 4) {
        if constexpr (MIXER == 1) rec_norm_gate<256>(C, C.in[11], P + 2 * PSTRIDE);
        else if constexpr (MIXER == 2) rec_norm_gate<128>(C, C.in[15], P + 3 * PSTRIDE);
    } else if constexpr (STEP == 5) {
        const bf16* Wt = MIXER == 0 ? (const bf16*)(C.ws + WS_FOXWOUT) + (size_t)jx * 1024 * 1024 : MIXER == 1 ? (const bf16*)(C.ws + WS_GLAWOUT) : (const bf16*)(C.ws + WS_HGRNWOUT);
        do_gemm<1>(C, OB, Wt, 1024, nullptr, 0, 0, nullptr, layer == 0 ? C.in[0] : nullptr, nullptr, XN, C.in[2] + layer * 1024, (float*)(C.ws + WS_RS));
    } else if constexpr (STEP == 6) {
    } else if constexpr (STEP == 7) {
        do_gemm<2>(C, XN, (const bf16*)(C.ws + WS_PEERWQ) + (size_t)layer * 2048 * 1024, 2048, Q2, 2048, 0, (const float*)(C.ws + WS_RS), nullptr, nullptr, nullptr, nullptr, nullptr);
    } else if constexpr (STEP == 8) {
        peer_topk_gather<false>(C, layer);
    } else if constexpr (STEP == 9) {
    } else if constexpr (STEP == 11) {
        peer_topk_gather<true>(C, layer);
    } else if constexpr (STEP == 12) {
        p0_prologue_b(C);
    } else {
        p0_prologue(C);
    }
}

__device__ __forceinline__ void make_ctx(Ctx& C, const Args& args, unsigned char* lds_raw) {
    C.lds = (LAS unsigned char*)lds_raw;
    C.tid = threadIdx.x; C.lane = C.tid & 63; C.wave = __builtin_amdgcn_readfirstlane(C.tid >> 6);
    C.G = gridDim.x; C.bx = blockIdx.x; { const int bx = blockIdx.x; C.vcu = (C.G % 8 == 0) ? (bx % 8) * (C.G / 8) + bx / 8 : bx; }
    C.gw = C.vcu * NWAVES + C.wave; C.NGW = C.G * NWAVES;
#pragma unroll
    for (int i = 0; i < 21; ++i) C.in[i] = args.in[i];
    C.out = args.out; C.ws = args.ws;
}

template <int STEP, int MIXER>
__global__ void __launch_bounds__(NWAVES * 64, 2) mk_phase(Args args, int layer) {
    extern __shared__ __attribute__((aligned(16))) unsigned char lds_raw[];
    Ctx C; make_ctx(C, args, lds_raw);
    run_step<STEP, MIXER>(C, layer);
}

template <int STEP, int MIXER>
static void launch_phase(const Args& a, int layer, int grid, hipStream_t stream) {
    static bool attr_set = false;
    if (!attr_set) { (void)hipFuncSetAttribute((const void*)mk_phase<STEP, MIXER>, hipFuncAttributeMaxDynamicSharedMemorySize, LDS_BYTES); attr_set = true; }
    hipLaunchKernelGGL((mk_phase<STEP, MIXER>), dim3(grid), dim3(NWAVES * 64), LDS_BYTES, stream, a, layer);
}
#ifndef MK_DUP
#define MK_DUP -1
#endif
#define LP(S, M) do { launch_phase<S, M>(a, layer, grid, stream); if (MK_DUP == S) launch_phase<(S == 8 ? 11 : S), M>(a, layer, grid, stream); } while (0)
template <int MIXER>
static void launch_layer(const Args& a, int layer, int grid, hipStream_t stream) {
    LP(0, MIXER);
    if (MIXER == 0) launch_phase<1, MIXER>(a, layer, grid, stream); else LP(2, MIXER);
    LP(3, MIXER);
    if (MIXER != 0) LP(4, MIXER);
    LP(5, MIXER);
    LP(7, 0);
    LP(8, 0);
}
#if MK_SINGLE
__device__ __forceinline__ const float* tab_ptr(volatile LAS unsigned long long* tab, int i) {
    const unsigned long long v = tab[i];
    const unsigned lo = __builtin_amdgcn_readfirstlane((unsigned)v), hi = __builtin_amdgcn_readfirstlane((unsigned)(v >> 32));
    return (const float*)(const GAS float*)(((unsigned long long)hi << 32) | lo);
}
__device__ __forceinline__ int lane_id_volatile() { int x; asm volatile("v_mbcnt_lo_u32_b32 %0, -1, 0\n\tv_mbcnt_hi_u32_b32 %0, -1, %0" : "=v"(x)); return x; }
__device__ __forceinline__ void make_ctx_opaque(Ctx& C, unsigned char* lds_raw, int wave_s) {
    int bx = blockIdx.x, G = gridDim.x; unsigned ldso = 0u;
    asm volatile("" : "+s"(bx), "+s"(G), "+s"(ldso), "+s"(wave_s));
    int tid = wave_s * 64 + lane_id_volatile();
    C.lds = (LAS unsigned char*)lds_raw + ldso;
    volatile LAS unsigned long long* tab = (volatile LAS unsigned long long*)(C.lds + LDSCTL_OFF);
    C.tid = tid; C.lane = tid & 63; C.wave = __builtin_amdgcn_readfirstlane(tid >> 6);
    C.G = G; C.bx = bx; C.vcu = (G % 8 == 0) ? (bx % 8) * (G / 8) + bx / 8 : bx;
    C.gw = C.vcu * NWAVES + C.wave; C.NGW = G * NWAVES;
#pragma unroll
    for (int i = 0; i < 21; ++i) C.in[i] = tab_ptr(tab, i);
    C.out = (float*)tab_ptr(tab, 21); C.ws = (unsigned char*)tab_ptr(tab, 22);
}
__device__ __forceinline__ void grid_bar(unsigned char* lds_raw, int wave_s) {
    unsigned ldso = 0u; asm volatile("" : "+s"(ldso), "+s"(wave_s));
    LAS unsigned char* lds = (LAS unsigned char*)lds_raw + ldso;
    volatile LAS unsigned long long* tab = (volatile LAS unsigned long long*)(lds + LDSCTL_OFF);
    XcdBarrier b; b.bar = (unsigned*)((unsigned char*)tab_ptr(tab, 22) + WS_CTL) + CW_BAR; b.x = xb_xcc_id(); b.st = (volatile LAS unsigned*)(lds + MISC_OFF) + 8;
    xcd_barrier(b, wave_s == 0 && lane_id_volatile() == 0);
}
#define MK_STEP(...) do { Ctx C; make_ctx_opaque(C, lds_raw, wave_s); __VA_ARGS__; } while (0)
__global__ void __launch_bounds__(NWAVES * 64, 2) mk_fwd(Args args) {
    extern __shared__ __attribute__((aligned(16))) unsigned char lds_raw[];
    const int wave_s = __builtin_amdgcn_readfirstlane(threadIdx.x >> 6);
    for (int u = threadIdx.x; u < (LDS_BYTES - LDSCTL_OFF) / 4; u += NWAVES * 64) ((LAS unsigned*)((LAS unsigned char*)lds_raw + LDSCTL_OFF))[u] = 0u;
    __syncthreads();
    if (threadIdx.x == 0) {
        LAS unsigned long long* tab = (LAS unsigned long long*)((LAS unsigned char*)lds_raw + LDSCTL_OFF);
#pragma unroll
        for (int i = 0; i < 21; ++i) tab[i] = (unsigned long long)args.in[i];
        tab[21] = (unsigned long long)args.out; tab[22] = (unsigned long long)args.ws;
    }
    (void)xcd_barrier_post((unsigned*)(args.ws + WS_CTL) + CW_BAR, (volatile LAS unsigned*)((LAS unsigned char*)lds_raw + MISC_OFF) + 8);
    __syncthreads();
    MK_STEP(p0_prologue(C));
    if (I8_NITEMS) { grid_bar(lds_raw, wave_s); MK_STEP(p0_prologue_b(C)); }
    cg::this_grid().sync();
#pragma unroll 1
    for (int layer = 0; layer < DEPTH; ++layer) {
        const int mixer = layer % 3, jx = layer / 3;
        MK_STEP(const bf16* Wt = mixer == 0 ? (const bf16*)(C.ws + WS_FOXWIN + (size_t)jx * 8 * MiB) : mixer == 1 ? (const bf16*)(C.ws + WS_GLAWIN) : (const bf16*)(C.ws + WS_HGRNWIN);
                const float* sw = (const float*)(C.ws + WS_SW) + (mixer == 0 ? jx * 4096 : mixer == 1 ? 8192 : 11264);
                if (FOXFUSE && mixer == 0) { do_gemm<4>(C, (const bf16*)(C.ws + WS_XN8), Wt, 4096, (bf16*)(C.ws + WS_P), 1024, 1, (const float*)(C.ws + WS_SX), C.in[5] + jx * 64, (float*)(C.in[6] + jx * 64), nullptr, sw, nullptr);
                    fox_step1<false>(C, jx); }
                else if (I8MASK == 15 || (I8MASK != 0 && ((I8MASK >> layer) & 1))) do_gemm<3>(C, (const bf16*)(C.ws + WS_XN8), Wt, mixer == 1 ? 3072 : 4096, (bf16*)(C.ws + WS_P), 1024, 1, (const float*)(C.ws + WS_SX), nullptr, nullptr, nullptr, sw, nullptr);
                else do_gemm<0>(C, (const bf16*)(C.ws + WS_XN), Wt, mixer == 1 ? 3072 : 4096, (bf16*)(C.ws + WS_P), 1024, 1, nullptr, nullptr, nullptr, nullptr, nullptr, nullptr));
        grid_bar(lds_raw, wave_s);
#if GPROBE == 1
        MK_STEP(const bf16* Wt = mixer == 0 ? (const bf16*)(C.ws + WS_FOXWIN + (size_t)jx * 8 * MiB) : mixer == 1 ? (const bf16*)(C.ws + WS_GLAWIN) : (const bf16*)(C.ws + WS_HGRNWIN);
                const float* sw = (const float*)(C.ws + WS_SW) + (mixer == 0 ? jx * 4096 : mixer == 1 ? 8192 : 11264);
                if (FOXFUSE && mixer == 0) { do_gemm<4>(C, (const bf16*)(C.ws + WS_XN8), Wt, 4096, (bf16*)(C.ws + WS_P), 1024, 1, (const float*)(C.ws + WS_SX), C.in[5] + jx * 64, (float*)(C.in[6] + jx * 64), nullptr, sw, nullptr);
                    fox_step1<false>(C, jx); }
                else if (I8MASK == 15 || (I8MASK != 0 && ((I8MASK >> layer) & 1))) do_gemm<3>(C, (const bf16*)(C.ws + WS_XN8), Wt, mixer == 1 ? 3072 : 4096, (bf16*)(C.ws + WS_P), 1024, 1, (const float*)(C.ws + WS_SX), nullptr, nullptr, nullptr, sw, nullptr);
                else do_gemm<0>(C, (const bf16*)(C.ws + WS_XN), Wt, mixer == 1 ? 3072 : 4096, (bf16*)(C.ws + WS_P), 1024, 1, nullptr, nullptr, nullptr, nullptr, nullptr, nullptr));
        grid_bar(lds_raw, wave_s);
#endif
        if (!(FOXFUSE && mixer == 0)) {
        MK_STEP(if (mixer == 0) run_step<1, 0>(C, layer); else if (mixer == 1) run_step<2, 1>(C, layer); else run_step<2, 2>(C, layer));
        grid_bar(lds_raw, wave_s); }
        MK_STEP(if (mixer == 0) run_step<3, 0>(C, layer); else if (mixer == 1) run_step<3, 1>(C, layer); else run_step<3, 2>(C, layer));
        grid_bar(lds_raw, wave_s);
#if RPROBE
        if (mixer != 0) { MK_STEP(if (mixer == 1) chunk_recur<4, 256, RPROBE>(C, (const bf16*)(C.ws + WS_P) + PSTRIDE); else chunk_recur<8, 128, RPROBE>(C, (const bf16*)(C.ws + WS_P) + 2 * PSTRIDE)); grid_bar(lds_raw, wave_s); }
#endif
        if (mixer != 0) { MK_STEP(if (mixer == 1) run_step<4, 1>(C, layer); else run_step<4, 2>(C, layer)); grid_bar(lds_raw, wave_s); }
        MK_STEP(const bf16* Wt = mixer == 0 ? (const bf16*)(C.ws + WS_FOXWOUT) + (size_t)jx * 1024 * 1024 : mixer == 1 ? (const bf16*)(C.ws + WS_GLAWOUT) : (const bf16*)(C.ws + WS_HGRNWOUT);
                do_gemm<1>(C, (const bf16*)(C.ws + WS_OB), Wt, 1024, nullptr, 0, 0, nullptr, layer == 0 ? C.in[0] : nullptr, nullptr, (bf16*)(C.ws + WS_XN), C.in[2] + layer * 1024, (float*)(C.ws + WS_RS)));
        grid_bar(lds_raw, wave_s);
        MK_STEP(run_step<7, 0>(C, layer));
        grid_bar(lds_raw, wave_s);
#if GPROBE == 7
        MK_STEP(run_step<7, 0>(C, layer));
        grid_bar(lds_raw, wave_s);
#endif
        MK_STEP(run_step<8, 0>(C, layer));
        if (layer + 1 < DEPTH) grid_bar(lds_raw, wave_s);
    }
}
#endif

extern "C" void kernel_launch(void* const* d_in, const int* in_sizes, int n_in, void* d_out, int out_size, void* d_ws, size_t ws_size, hipStream_t stream) {
    static int grid = 0;
    if (grid == 0) {
        if (n_in != 21 || out_size != NTOK * 1024 || ws_size < WS_END) { fprintf(stderr, "kernel_launch: unexpected shapes: n_in %d out %d ws %zu (need %zu)\n", n_in, out_size, ws_size, (size_t)WS_END); grid = -1; return; }
        int dev = 0, cus = 0, per_cu = 0;
        (void)hipGetDevice(&dev); (void)hipDeviceGetAttribute(&cus, hipDeviceAttributeMultiprocessorCount, dev);
#if MK_SINGLE
        if (hipFuncSetAttribute((const void*)mk_fwd, hipFuncAttributeMaxDynamicSharedMemorySize, LDS_BYTES) != hipSuccess) { fprintf(stderr, "kernel_launch: hipFuncSetAttribute failed\n"); grid = -1; return; }
        if (hipOccupancyMaxActiveBlocksPerMultiprocessor(&per_cu, (const void*)mk_fwd, NWAVES * 64, LDS_BYTES) != hipSuccess || per_cu < 1) { fprintf(stderr, "kernel_launch: occupancy query says %d blocks per CU\n", per_cu); (void)hipGetLastError(); grid = -1; return; }
#endif
        (void)per_cu;
        grid = cus;
    }
    if (grid < 0) return;
    Args a{};
    for (int i = 0; i < 21; ++i) a.in[i] = (const float*)d_in[i];
    a.out = (float*)d_out; a.ws = (unsigned char*)d_ws;
#if MK_SINGLE
    (void)hipMemsetAsync((char*)d_ws + WS_CTL, 0, CTL_ZERO_BYTES, stream);
    a.ph_lo = 0; a.ph_hi = NPHASE;
    void* kargs[] = {&a};
    hipError_t e = hipLaunchCooperativeKernel((const void*)mk_fwd, dim3(grid), dim3(NWAVES * 64), kargs, LDS_BYTES, stream);
    if (e != hipSuccess) fprintf(stderr, "cooperative launch failed: %s (grid %d)\n", hipGetErrorString(e), grid);
#else
    (void)hipMemsetAsync((char*)d_ws + WS_CTL, 0, CTL_ZERO_BYTES, stream);
    launch_phase<10, 0>(a, 0, grid, stream); if (MK_DUP == 10) launch_phase<10, 0>(a, 0, grid, stream);
    launch_phase<12, 0>(a, 0, grid, stream);
    launch_layer<0>(a, 0, grid, stream);
    launch_layer<1>(a, 1, grid, stream);
    launch_layer<2>(a, 2, grid, stream);
    launch_layer<0>(a, 3, grid, stream);
#endif
}
```

```cpp
#include <hip/hip_runtime.h>
#include <hip/hip_cooperative_groups.h>
#include <cstdio>
#include <cstdint>
#include <cmath>
namespace pg8 {
#define PG8_LAS __attribute__((address_space(3)))
typedef unsigned short bf16_t;
typedef short bf16x8 __attribute__((ext_vector_type(8)));
typedef float f32x4 __attribute__((ext_vector_type(4)));
typedef unsigned u32x4 __attribute__((ext_vector_type(4)));
typedef int i32x4 __attribute__((ext_vector_type(4)));
constexpr int BM = 256, BK = 64, HALF = 128, HTB = HALF * BK * 2  , STAGE_BYTES = 8 * HTB, NXCD = 8, WGM = 8;

__host__ __device__ __forceinline__ int lds_byte(int r, int c) { const int st = (r >> 4) * 2 + (c >> 5), rr = r & 15, cc = c & 31, ob = rr * 64 + cc * 2; return st * 1024 + (ob ^ (((ob >> 9) & 1) << 5)); }
__host__ __device__ __forceinline__ void stage_rc(int b, int& R, int& C) { const int st = b / 1024, sb = b % 1024, swz = sb ^ (((sb >> 9) & 1) << 5); R = (st >> 1) * 16 + swz / 64; C = (st & 1) * 32 + (swz % 64) / 2; }
__host__ __device__ __forceinline__ int perm32(int rho) { const int n = rho >> 4, i = rho & 15; return 8 * (i >> 2) + 4 * n + (i & 3); }

struct Unit { int pm, pn; };
struct Gemm { const bf16_t* A; const bf16_t* Bt; int M, N, K; };

struct StaticOrder {
    int nM, nN, nwg, G, c;
    __host__ __device__ void init(int M, int N, int G_, int c_) { nM = M / BM; nN = N / BM; nwg = nM * nN; G = G_; c = c_; }
    __host__ __device__ bool next(int i, Unit& u) const {
        const long L = (long)i * G + c; if (L >= nwg) return false;
        int wgid = (int)L; { const int q = nwg / NXCD, r = nwg % NXCD, xcd = wgid % NXCD, off = wgid / NXCD; wgid = (xcd < r ? xcd * (q + 1) : r * (q + 1) + (xcd - r) * q) + off; }
        const int nig = WGM * nN, gid = wgid / nig, fm = gid * WGM, gsz = (nM - fm) < WGM ? (nM - fm) : WGM;
        u.pm = fm + ((wgid % nig) % gsz); u.pn = (wgid % nig) / gsz; return true;
    }
    __device__ __forceinline__ void a_ready(const Unit&) const {}
    __device__ __forceinline__ void done(const Unit&) const {}
};

__device__ __forceinline__ unsigned cvt_pk_bf16(float lo, float hi) { unsigned r; asm volatile("v_cvt_pk_bf16_f32 %0, %1, %2" : "=v"(r) : "v"(lo), "v"(hi)); return r; }
typedef float f32x2 __attribute__((ext_vector_type(2)));
__device__ __forceinline__ f32x2 gelu_pk(f32x2 v) {
    const f32x2 av = __builtin_elementwise_abs(v), d = av * 0.2316418882f + 1.0f;
    f32x2 t; t.x = __builtin_amdgcn_rcpf(d.x); t.y = __builtin_amdgcn_rcpf(d.y);
    f32x2 q = t * 0.5307027145f + (-0.7265760135f); q = q * t + 0.7107068705f; q = q * t + (-0.142248368f); q = q * t + 0.127414796f; q = q * t;
    const f32x2 s = (v * v) * (-0.72134752044f);
    f32x2 e; e.x = __builtin_amdgcn_exp2f(s.x); e.y = __builtin_amdgcn_exp2f(s.y);
    const f32x2 m = v * (q * e), r = v - m;
    f32x2 o; o.x = v.x < 0.f ? m.x : r.x; o.y = v.y < 0.f ? m.y : r.y; return o;
}
#ifndef EPI_AUX
#define EPI_AUX 16
#endif
template <bool F16  > struct EpiBf16R {
    typedef f32x4 acc_t;
    static constexpr bool PERM = true, AFTER_DRAIN = false;
    bf16_t* O; int ldc; int split_cols; size_t split_stride; const float* rs;
    __device__ __forceinline__ void operator()(const f32x4 (&acc)[2][2][4][2], const Unit& u, int wr, int wc, int fr, int fq) const {
        const int row0 = u.pm * BM + wr * 64 + fr; int colt = u.pn * BM; unsigned boff = 0u;
        if (split_cols) { const int t = colt / split_cols; boff = (unsigned)(t * split_stride * 2); colt -= t * split_cols; }
        const int col0 = colt + wc * 32 + 8 * fq;
        const __amdgpu_buffer_rsrc_t orsrc = __builtin_amdgcn_make_buffer_rsrc((void*)O, (short)0, 0x7ffffff0, 0x00020000);
#pragma unroll
        for (int ai = 0; ai < 2; ++ai)
#pragma unroll
            for (int m = 0; m < 4; ++m) { const int row = row0 + ai * HALF + m * 16; const unsigned roff = boff + (unsigned)(row * ldc + col0) * 2u;
                float sc = 1.f;
                if (rs) {
                    const f32x4 a = *(const f32x4*)(rs + (size_t)row * 16 + 4 * fq); float s = (a[0] + a[1]) + (a[2] + a[3]); const int lane_ = fr + 16 * fq;
                    s += __builtin_bit_cast(float, __builtin_amdgcn_ds_bpermute((lane_ ^ 16) << 2, __builtin_bit_cast(int, s)));
                    s += __builtin_bit_cast(float, __builtin_amdgcn_ds_bpermute((lane_ ^ 32) << 2, __builtin_bit_cast(int, s)));
                    sc = __builtin_amdgcn_rsqf(s * (1.0f / 1024.0f) + 1e-6f); }
#pragma unroll
                for (int bj = 0; bj < 2; ++bj) { const f32x4 v0 = acc[ai][bj][m][0] * sc, v1 = acc[ai][bj][m][1] * sc;
                    u32x4 w;
                    if (F16) { w.x = __builtin_bit_cast(unsigned, __builtin_amdgcn_cvt_pkrtz(v0[0], v0[1])); w.y = __builtin_bit_cast(unsigned, __builtin_amdgcn_cvt_pkrtz(v0[2], v0[3])); w.z = __builtin_bit_cast(unsigned, __builtin_amdgcn_cvt_pkrtz(v1[0], v1[1])); w.w = __builtin_bit_cast(unsigned, __builtin_amdgcn_cvt_pkrtz(v1[2], v1[3])); }
                    else { w.x = cvt_pk_bf16(v0[0], v0[1]); w.y = cvt_pk_bf16(v0[2], v0[3]); w.z = cvt_pk_bf16(v1[0], v1[1]); w.w = cvt_pk_bf16(v1[2], v1[3]); }
                    __builtin_amdgcn_raw_buffer_store_b128(w, orsrc, (int)(roff + bj * HALF * 2), 0, EPI_AUX); } }
    }
};
template <bool QKN> struct EpiI8 {
    typedef i32x4 acc_t;
    static constexpr bool PERM = true, AFTER_DRAIN = false;
    bf16_t* O; size_t split_stride; const float* sx; const float* sw; const float* gq; const float* gk; float c2;
    __device__ __forceinline__ void operator()(const i32x4 (&acc)[2][2][4][2], const Unit& u, int wr, int wc, int fr, int fq) const {
        const int row0 = u.pm * BM + wr * 64 + fr; int colt = u.pn * BM; unsigned boff;
        { const int t = colt / 1024; boff = (unsigned)(t * split_stride * 2); colt -= t * 1024; }
        const __amdgpu_buffer_rsrc_t orsrc = __builtin_amdgcn_make_buffer_rsrc((void*)O, (short)0, 0x7ffffff0, 0x00020000);
        const int scol0 = u.pn * BM + wc * 32 + 8 * fq;
        f32x4 cw[2][2];
#pragma unroll
        for (int bj = 0; bj < 2; ++bj) { cw[bj][0] = *(const f32x4*)(sw + scol0 + bj * HALF); cw[bj][1] = *(const f32x4*)(sw + scol0 + bj * HALF + 4); }
        if (QKN && u.pn < 8) {
            const float* g = u.pn < 4 ? gq : gk; const float cc = u.pn < 4 ? c2 : 1.f; const int lane = fr + 16 * fq;
            f32x4 gv[2][2];
#pragma unroll
            for (int bj = 0; bj < 2; ++bj) { gv[bj][0] = *(const f32x4*)(g + 32 * bj + 8 * fq) * cc; gv[bj][1] = *(const f32x4*)(g + 32 * bj + 8 * fq + 4) * cc; }
            const int col0 = colt + 64 * wc + 8 * fq;
#pragma unroll
            for (int ai = 0; ai < 2; ++ai)
#pragma unroll
                for (int m = 0; m < 4; ++m) { const int row = row0 + ai * HALF + m * 16; const unsigned roff = boff + (unsigned)(row * 1024 + col0) * 2u; const float rs = sx[row];
                    f32x4 v[2][2]; float ss = 0.f;
#pragma unroll
                    for (int bj = 0; bj < 2; ++bj) { const i32x4 a0 = acc[ai][bj][m][0], a1 = acc[ai][bj][m][1];
                        v[bj][0] = (f32x4){(float)a0[0], (float)a0[1], (float)a0[2], (float)a0[3]} * cw[bj][0] * rs; v[bj][1] = (f32x4){(float)a1[0], (float)a1[1], (float)a1[2], (float)a1[3]} * cw[bj][1] * rs;
                        ss += ((v[bj][0][0] * v[bj][0][0] + v[bj][0][1] * v[bj][0][1]) + (v[bj][0][2] * v[bj][0][2] + v[bj][0][3] * v[bj][0][3])) + ((v[bj][1][0] * v[bj][1][0] + v[bj][1][1] * v[bj][1][1]) + (v[bj][1][2] * v[bj][1][2] + v[bj][1][3] * v[bj][1][3])); }
                    ss += __builtin_bit_cast(float, __builtin_amdgcn_ds_bpermute((lane ^ 16) << 2, __builtin_bit_cast(int, ss)));
                    ss += __builtin_bit_cast(float, __builtin_amdgcn_ds_bpermute((lane ^ 32) << 2, __builtin_bit_cast(int, ss)));
                    const float r = __builtin_amdgcn_rsqf(ss * (1.f / 64.f) + 1e-6f);
#pragma unroll
                    for (int bj = 0; bj < 2; ++bj) { const f32x4 o0 = v[bj][0] * r * gv[bj][0], o1 = v[bj][1] * r * gv[bj][1];
                        u32x4 w; w.x = cvt_pk_bf16(o0[0], o0[1]); w.y = cvt_pk_bf16(o0[2], o0[3]); w.z = cvt_pk_bf16(o1[0], o1[1]); w.w = cvt_pk_bf16(o1[2], o1[3]);
                        __builtin_amdgcn_raw_buffer_store_b128(w, orsrc, (int)(roff + bj * 32 * 2), 0, EPI_AUX); } }
            return;
        }
        const int col0 = colt + wc * 32 + 8 * fq;
#pragma unroll
        for (int ai = 0; ai < 2; ++ai)
#pragma unroll
            for (int m = 0; m < 4; ++m) { const int row = row0 + ai * HALF + m * 16; const unsigned roff = boff + (unsigned)(row * 1024 + col0) * 2u; const float rs = sx[row];
#pragma unroll
                for (int bj = 0; bj < 2; ++bj) { const i32x4 a0 = acc[ai][bj][m][0], a1 = acc[ai][bj][m][1];
                    const f32x4 v0 = (f32x4){(float)a0[0], (float)a0[1], (float)a0[2], (float)a0[3]} * cw[bj][0] * rs, v1 = (f32x4){(float)a1[0], (float)a1[1], (float)a1[2], (float)a1[3]} * cw[bj][1] * rs;
                    u32x4 w; w.x = cvt_pk_bf16(v0[0], v0[1]); w.y = cvt_pk_bf16(v0[2], v0[3]); w.z = cvt_pk_bf16(v1[0], v1[1]); w.w = cvt_pk_bf16(v1[2], v1[3]);
                    __builtin_amdgcn_raw_buffer_store_b128(w, orsrc, (int)(roff + bj * HALF * 2), 0, EPI_AUX); } }
    }
};
template <bool BASE16> struct EpiResNorm {
    typedef f32x4 acc_t;
    static constexpr bool PERM = true, AFTER_DRAIN = false;
    const void* base; bf16_t* out; bf16_t* hg; const float* gain; float* rs;
    __device__ __forceinline__ void operator()(const f32x4 (&acc)[2][2][4][2], const Unit& u, int wr, int wc, int fr, int fq) const {
        const int col0 = u.pn * BM + wc * 32 + 8 * fq, lane = fr + 16 * fq;
        f32x4 gv[2][2];
#pragma unroll
        for (int bj = 0; bj < 2; ++bj)
#pragma unroll
            for (int n = 0; n < 2; ++n) gv[bj][n] = *(const f32x4*)(gain + col0 + bj * HALF + n * 4);
#pragma unroll
        for (int ai = 0; ai < 2; ++ai)
#pragma unroll
            for (int m = 0; m < 4; ++m) { const int r = ai * HALF + wr * 64 + m * 16 + fr; const size_t off = (size_t)(u.pm * BM + r) * 1024 + col0;
                float ss = 0.f;
#pragma unroll
                for (int bj = 0; bj < 2; ++bj) { f32x4 b0, b1;
                    if (BASE16) { const u32x4 bw = *(const u32x4*)((const bf16_t*)base + off + bj * HALF);
                        b0 = (f32x4){__builtin_bit_cast(float, bw.x << 16), __builtin_bit_cast(float, bw.x & 0xffff0000u), __builtin_bit_cast(float, bw.y << 16), __builtin_bit_cast(float, bw.y & 0xffff0000u)};
                        b1 = (f32x4){__builtin_bit_cast(float, bw.z << 16), __builtin_bit_cast(float, bw.z & 0xffff0000u), __builtin_bit_cast(float, bw.w << 16), __builtin_bit_cast(float, bw.w & 0xffff0000u)}; }
                    else { b0 = *(const f32x4*)((const float*)base + off + bj * HALF); b1 = *(const f32x4*)((const float*)base + off + bj * HALF + 4); }
                    const f32x4 o0 = b0 + acc[ai][bj][m][0], o1 = b1 + acc[ai][bj][m][1];
                    u32x4 wo; wo.x = cvt_pk_bf16(o0[0], o0[1]); wo.y = cvt_pk_bf16(o0[2], o0[3]); wo.z = cvt_pk_bf16(o1[0], o1[1]); wo.w = cvt_pk_bf16(o1[2], o1[3]);
                    *(u32x4*)(out + off + bj * HALF) = wo;
                    ss += ((o0[0] * o0[0] + o0[1] * o0[1]) + (o0[2] * o0[2] + o0[3] * o0[3])) + ((o1[0] * o1[0] + o1[1] * o1[1]) + (o1[2] * o1[2] + o1[3] * o1[3]));
                    const f32x4 h0 = o0 * gv[bj][0], h1 = o1 * gv[bj][1];
                    u32x4 w; w.x = cvt_pk_bf16(h0[0], h0[1]); w.y = cvt_pk_bf16(h0[2], h0[3]); w.z = cvt_pk_bf16(h1[0], h1[1]); w.w = cvt_pk_bf16(h1[2], h1[3]);
                    *(u32x4*)(hg + off + bj * HALF) = w; }
                ss += __builtin_bit_cast(float, __builtin_amdgcn_ds_bpermute((lane ^ 16) << 2, __builtin_bit_cast(int, ss)));
                ss += __builtin_bit_cast(float, __builtin_amdgcn_ds_bpermute((lane ^ 32) << 2, __builtin_bit_cast(int, ss)));
                if (fq == 0) rs[(size_t)(u.pm * BM + r) * 16 + u.pn * 4 + wc] = ss; }
    }
};
__device__ __forceinline__ f32x4 mma16(bf16x8 a, bf16x8 b, f32x4 c) { return __builtin_amdgcn_mfma_f32_16x16x32_bf16(a, b, c, 0, 0, 0); }
__device__ __forceinline__ i32x4 mma16(bf16x8 a, bf16x8 b, i32x4 c) { return __builtin_amdgcn_mfma_i32_16x16x64_i8(__builtin_bit_cast(i32x4, a), __builtin_bit_cast(i32x4, b), c, 0, 0, 0); }
template <class Epi, class Sched, bool ALIGN_EPI = false, bool SP2 = false>
__device__ __forceinline__ void gemm_phase(PG8_LAS unsigned char* lds, const Gemm g, const Sched& S, const Epi& E, int tid_in) {
    int tid_ = tid_in; asm volatile("" : "+v"(tid_));
    const int tid = tid_, wid = __builtin_amdgcn_readfirstlane(tid >> 6), lane = tid & 63, wr = wid >> 2, wc = wid & 3, fr = lane & 15, fq = lane >> 4;
    const int K = g.K, nt = K / BK;
    unsigned voffA[2], voffB[2];
#pragma unroll
    for (int i = 0; i < 2; ++i) { int R, C; stage_rc(tid * 16 + i * 8192, R, C); const int Rb = Epi::PERM ? ((R & ~31) + perm32(R & 31)) : R;
        voffA[i] = (unsigned)(R * K + C) * 2u; voffB[i] = (unsigned)(Rb * K + C) * 2u; }
    const size_t kstep = (size_t)(BK * 2);
    const size_t hstep = (size_t)HALF * K * 2;
    const size_t tstep = 2 * hstep;
    const unsigned ldsw = (unsigned)wid * 1024u;
    const int aoff = lds_byte(wr * 64 + fr, fq * 8), boff = lds_byte(wc * 32 + fr, fq * 8);
#define PG8_SA(b, h) (((b) * 2 + (h)) * HTB)
#define PG8_SB(b, h) ((4 + (b) * 2 + (h)) * HTB)
#define PG8_STAGE(bufoff, gbase, voff) do { _Pragma("unroll") for (int _i = 0; _i < 2; ++_i) \
        __builtin_amdgcn_global_load_lds((const unsigned*)((const char*)(gbase) + (voff)[_i]), (PG8_LAS unsigned*)(lds + (bufoff) + ldsw + _i * 8192), 16, 0, 0); } while (0)
#define PG8_LDA(dst, b, h) do { _Pragma("unroll") for (int m = 0; m < 4; ++m) _Pragma("unroll") for (int k = 0; k < 2; ++k) dst[m][k] = *(const PG8_LAS bf16x8*)(lds + PG8_SA(b, h) + aoff + m * 2048 + k * 1024); } while (0)
#define PG8_LDB(dst, b, h) do { _Pragma("unroll") for (int n = 0; n < 2; ++n) _Pragma("unroll") for (int k = 0; k < 2; ++k) dst[n][k] = *(const PG8_LAS bf16x8*)(lds + PG8_SB(b, h) + boff + n * 2048 + k * 1024); } while (0)
#define PG8_MMA(ai, bj, At, Bt) do { __builtin_amdgcn_s_setprio(1); _Pragma("unroll") for (int m = 0; m < 4; ++m) _Pragma("unroll") for (int n = 0; n < 2; ++n) _Pragma("unroll") for (int k = 0; k < 2; ++k) \
        acc[ai][bj][m][n] = mma16(Bt[n][k], At[m][k], acc[ai][bj][m][n]); __builtin_amdgcn_s_setprio(0); } while (0)
#define PG8_WAIT_V(n) asm volatile("s_waitcnt vmcnt(" #n ")" ::: "memory")
#define PG8_WAIT_L(n) asm volatile("s_waitcnt lgkmcnt(" #n ")" ::: "memory")
#define PG8_BAR __builtin_amdgcn_s_barrier()
#define PG8_SCHED __builtin_amdgcn_sched_barrier(0)
    Unit cur, nxt; int ui = 0;
    if (!S.next(0, cur)) return;
    typedef typename Epi::acc_t acc_t;
    acc_t acc[2][2][4][2];
#pragma unroll
    for (int a = 0; a < 2; ++a)
#pragma unroll
        for (int b = 0; b < 2; ++b)
#pragma unroll
            for (int m = 0; m < 4; ++m)
#pragma unroll
                for (int n = 0; n < 2; ++n) acc[a][b][m][n] = (acc_t){0, 0, 0, 0};
    bf16x8 At[4][2], B0[2][2], B1[2][2];
    const char* cA = (const char*)g.A + (size_t)cur.pm * tstep; const char* cB = (const char*)g.Bt + (size_t)cur.pn * tstep;
    S.a_ready(cur);
    if constexpr (SP2) {
        PG8_STAGE(PG8_SB(0, 0), cB, voffB); PG8_STAGE(PG8_SB(0, 1), cB + hstep, voffB); PG8_STAGE(PG8_SA(0, 0), cA, voffA); PG8_STAGE(PG8_SA(0, 1), cA + hstep, voffA);
        if (wr == 1) PG8_BAR;
        PG8_WAIT_V(2); PG8_BAR;
        PG8_STAGE(PG8_SB(1, 0), cB + kstep, voffB); PG8_STAGE(PG8_SA(1, 0), cA + kstep, voffA); PG8_STAGE(PG8_SB(1, 1), cB + hstep + kstep, voffB);
        PG8_WAIT_V(6); PG8_BAR;
    } else {
        PG8_STAGE(PG8_SB(0, 0), cB, voffB); PG8_STAGE(PG8_SA(0, 0), cA, voffA); PG8_STAGE(PG8_SB(0, 1), cB + hstep, voffB); PG8_STAGE(PG8_SA(0, 1), cA + hstep, voffA);
        if (wr == 1) PG8_BAR;
        PG8_WAIT_V(4); PG8_BAR;
        PG8_STAGE(PG8_SB(1, 0), cB + kstep, voffB); PG8_STAGE(PG8_SA(1, 0), cA + kstep, voffA); PG8_STAGE(PG8_SB(1, 1), cB + hstep + kstep, voffB);
        PG8_WAIT_V(6); PG8_BAR;
    }
    for (;;) {
        const bool has_next = S.next(ui + 1, nxt);
        const char* nA = has_next ? (const char*)g.A + (size_t)nxt.pm * tstep : cA; const char* nB = has_next ? (const char*)g.Bt + (size_t)nxt.pn * tstep : cB;
        for (int t = 0; t < nt; t += 2) {
            const bool last = (t == nt - 2);
            const char* a1 = cA + (size_t)(t + 1) * kstep;
            const char* a2 = last ? nA : cA + (size_t)(t + 2) * kstep; const char* b2 = last ? nB : cB + (size_t)(t + 2) * kstep;
            const char* a3 = a2 + kstep; const char* b3 = b2 + kstep;
            if (last && has_next) S.a_ready(nxt);
            if constexpr (SP2) {
            PG8_LDB(B0, 0, 0); PG8_LDB(B1, 0, 1); PG8_SCHED; PG8_LDA(At, 0, 0); PG8_STAGE(PG8_SA(1, 1), a1 + hstep, voffA);
            PG8_WAIT_V(8); PG8_WAIT_L(0); PG8_BAR; PG8_MMA(0, 0, At, B0); PG8_MMA(0, 1, At, B1); PG8_BAR; PG8_SCHED;
            PG8_LDA(At, 0, 1); PG8_STAGE(PG8_SB(0, 0), b2, voffB); PG8_STAGE(PG8_SB(0, 1), b2 + hstep, voffB); PG8_STAGE(PG8_SA(0, 0), a2, voffA);
            PG8_WAIT_V(8); PG8_WAIT_L(0); PG8_BAR; PG8_MMA(1, 0, At, B0); PG8_MMA(1, 1, At, B1); PG8_BAR; PG8_SCHED;
            PG8_LDB(B0, 1, 0); PG8_LDB(B1, 1, 1); PG8_SCHED; PG8_LDA(At, 1, 0); PG8_STAGE(PG8_SA(0, 1), a2 + hstep, voffA);
            PG8_WAIT_V(8); PG8_WAIT_L(0); PG8_BAR; PG8_MMA(0, 0, At, B0); PG8_MMA(0, 1, At, B1); PG8_BAR; PG8_SCHED;
            PG8_LDA(At, 1, 1); PG8_STAGE(PG8_SB(1, 0), b3, voffB); PG8_STAGE(PG8_SB(1, 1), b3 + hstep, voffB); PG8_STAGE(PG8_SA(1, 0), a3, voffA);
            PG8_WAIT_V(8); PG8_WAIT_L(0); PG8_BAR; PG8_MMA(1, 0, At, B0); PG8_MMA(1, 1, At, B1); PG8_BAR; PG8_SCHED;
            } else {
            PG8_LDB(B0, 0, 0); PG8_SCHED; PG8_LDA(At, 0, 0); PG8_STAGE(PG8_SA(1, 1), a1 + hstep, voffA);
            PG8_WAIT_L(8); PG8_BAR; PG8_WAIT_L(0); PG8_MMA(0, 0, At, B0); PG8_BAR; PG8_SCHED;
            PG8_LDB(B1, 0, 1); PG8_STAGE(PG8_SB(0, 0), b2, voffB);
            PG8_BAR; PG8_WAIT_L(0); PG8_MMA(0, 1, At, B1); PG8_BAR;
            PG8_LDA(At, 0, 1); PG8_STAGE(PG8_SA(0, 0), a2, voffA);
            PG8_BAR; PG8_WAIT_L(0); PG8_MMA(1, 0, At, B0); PG8_BAR; PG8_SCHED;
            PG8_STAGE(PG8_SB(0, 1), b2 + hstep, voffB);
            PG8_WAIT_V(6); PG8_BAR; PG8_MMA(1, 1, At, B1); PG8_BAR;
            PG8_LDB(B0, 1, 0); PG8_SCHED; PG8_LDA(At, 1, 0); PG8_STAGE(PG8_SA(0, 1), a2 + hstep, voffA);
            PG8_WAIT_L(8); PG8_BAR; PG8_WAIT_L(0); PG8_MMA(0, 0, At, B0); PG8_BAR; PG8_SCHED;
            PG8_LDB(B1, 1, 1); PG8_STAGE(PG8_SB(1, 0), b3, voffB);
            PG8_BAR; PG8_WAIT_L(0); PG8_MMA(0, 1, At, B1); PG8_BAR;
            PG8_LDA(At, 1, 1); PG8_STAGE(PG8_SA(1, 0), a3, voffA);
            PG8_BAR; PG8_WAIT_L(0); PG8_MMA(1, 0, At, B0); PG8_BAR; PG8_SCHED;
            PG8_STAGE(PG8_SB(1, 1), b3 + hstep, voffB);
            PG8_WAIT_V(6); PG8_BAR; PG8_MMA(1, 1, At, B1); PG8_BAR;
            }
        }
        if constexpr (ALIGN_EPI) { if (wr == 0) PG8_BAR; }
        if constexpr (!Epi::AFTER_DRAIN) { E(acc, cur, wr, wc, fr, fq); S.done(cur); }
        if (!has_next) break;
#pragma unroll
        for (int a = 0; a < 2; ++a)
#pragma unroll
            for (int b = 0; b < 2; ++b)
#pragma unroll
                for (int m = 0; m < 4; ++m)
#pragma unroll
                    for (int n = 0; n < 2; ++n) acc[a][b][m][n] = (acc_t){0, 0, 0, 0};
        cur = nxt; cA = nA; cB = nB; ++ui;
        if constexpr (ALIGN_EPI) { if (wr == 1) PG8_BAR; }
    }
    PG8_WAIT_V(0);
    if constexpr (!ALIGN_EPI) { if (wr == 0) PG8_BAR; }
    PG8_BAR;
    if constexpr (Epi::AFTER_DRAIN) { E.fused(acc, cur, wr, wc, fr, fq, lds, wid, lane); S.done(cur); }
#undef PG8_SA
#undef PG8_SB
#undef PG8_STAGE
#undef PG8_LDA
#undef PG8_LDB
#undef PG8_MMA
#undef PG8_WAIT_V
#undef PG8_WAIT_L
#undef PG8_BAR
#undef PG8_SCHED
}
}
#include <hip/hip_bf16.h>
#include <cmath>
namespace attn_body {
using bf16=__hip_bfloat16;
using bf16x8=__attribute__((ext_vector_type(8)))short;
using s16x4=__attribute__((ext_vector_type(4)))short;
using f32x16=__attribute__((ext_vector_type(16)))float;
using u32x4=__attribute__((ext_vector_type(4)))unsigned;
constexpr int BATCH=8,NHEAD=16,SEQ=2048,D=64,DM=NHEAD*D;
constexpr int NW=8,QBLK=32,QB=QBLK*NW,KVBLK=64,NQB=SEQ/QB;
constexpr int ATTN_PITCH=DM, ATTN_UNIT_ROWS=QB;
__device__ __forceinline__ int crow(int r,int hi){return (r&3)+8*(r>>2)+4*hi;}
#define SBAR() __builtin_amdgcn_sched_barrier(0)
__device__ __forceinline__ void cmask(f32x16&p0,f32x16&p1,int jb,int qrel,int hi){
  const float NEG=-INFINITY; int kb=64*jb+4*hi;
  #pragma unroll
  for(int r=0;r<16;++r){int kv=kb+(r&3)+8*(r>>2); if(kv>qrel)p0[r]=NEG; if(kv+32>qrel)p1[r]=NEG;}
}

constexpr int NSLOT=3, SLOTB=8192;
constexpr int LDS_K=0, LDS_V=NSLOT*SLOTB, LDS_WS=2*NSLOT*SLOTB, LDS_OST=LDS_WS+NW*64*4, LDS_CS=LDS_OST+NW*4096, LDS_BYTES=LDS_CS+SEQ*4;
constexpr float C2=0.125f*1.4426950408889634f;
__device__ __forceinline__ void glds16(const void*gsrc,unsigned lds_dst){unsigned keep;
  asm volatile("s_mov_b32 %0, m0\n\ts_mov_b32 m0, %2\n\ts_nop 0\n\tglobal_load_lds_dwordx4 %1, off\n\ts_mov_b32 m0, %0":"=&s"(keep):"v"(gsrc),"s"(lds_dst):"memory");}
__device__ __forceinline__ float max3f(float a,float b,float c){float r;asm("v_max3_f32 %0, %1, %2, %3":"=v"(r):"v"(a),"v"(b),"v"(c));return r;}
__device__ __forceinline__ float max2f(float a,float b){float r;asm("v_max_f32_e32 %0, %1, %2":"=v"(r):"v"(a),"v"(b));return r;}
__device__ __forceinline__ float fadd_s(float a,float b){float r;asm("v_add_f32_e32 %0, %1, %2":"=v"(r):"v"(a),"v"(b));return r;}
__device__ __forceinline__ float fsub_s(float a,float b){float r;asm("v_sub_f32_e32 %0, %1, %2":"=v"(r):"v"(a),"v"(b));return r;}
typedef float f32x2_t __attribute__((ext_vector_type(2))); typedef __bf16 bf16x2_t __attribute__((ext_vector_type(2)));
__device__ __forceinline__ unsigned cvtpk_s(float lo,float hi){f32x2_t v={lo,hi};bf16x2_t b=__builtin_convertvector(v,bf16x2_t);return __builtin_bit_cast(unsigned,b);}
#define WAIT_BAR(N) asm volatile("s_waitcnt vmcnt(" #N ") lgkmcnt(0)\n\ts_barrier":::"memory")

typedef __attribute__((address_space(3))) const char* lds_cptr;
__device__ __forceinline__ void qkt(f32x16&p0,f32x16&p1,const char*Kslot,lds_cptr qls,bf16x8 ax0,bf16x8 ax1,bf16x8 qx,int r32,int hi){
  const char*kb=Kslot+hi*1024+r32*16; const f32x16 z16=f32x16{};
  p0=__builtin_amdgcn_mfma_f32_32x32x16_bf16(ax0,qx,z16,0,0,0);p1=__builtin_amdgcn_mfma_f32_32x32x16_bf16(ax1,qx,z16,0,0,0);
  #pragma unroll
  for(int d0=0;d0<4;++d0){
    const bf16x8 b0=*reinterpret_cast<const bf16x8*>(kb+d0*2048);
    const bf16x8 b1=*reinterpret_cast<const bf16x8*>(kb+d0*2048+512);
    const bf16x8 qd=*(const __attribute__((address_space(3))) bf16x8*)(qls+d0*1024);
    p0=__builtin_amdgcn_mfma_f32_32x32x16_bf16(b0,qd,p0,0,0,0);p1=__builtin_amdgcn_mfma_f32_32x32x16_bf16(b1,qd,p1,0,0,0);}
}
typedef short v4i16_t __attribute__((ext_vector_type(4)));
__device__ __forceinline__ void kload8(bf16x8*kf,lds_cptr kp){
  kf[0]=*(const __attribute__((address_space(3))) bf16x8*)(kp);      kf[1]=*(const __attribute__((address_space(3))) bf16x8*)(kp+512);
  kf[2]=*(const __attribute__((address_space(3))) bf16x8*)(kp+2048); kf[3]=*(const __attribute__((address_space(3))) bf16x8*)(kp+2560);
  kf[4]=*(const __attribute__((address_space(3))) bf16x8*)(kp+4096); kf[5]=*(const __attribute__((address_space(3))) bf16x8*)(kp+4608);
  kf[6]=*(const __attribute__((address_space(3))) bf16x8*)(kp+6144); kf[7]=*(const __attribute__((address_space(3))) bf16x8*)(kp+6656);
}
__device__ __forceinline__ void kload2(bf16x8*kf,lds_cptr kp,int j){ kf[2*j]=*(const __attribute__((address_space(3))) bf16x8*)(kp+j*2048); kf[2*j+1]=*(const __attribute__((address_space(3))) bf16x8*)(kp+j*2048+512); }
__device__ __forceinline__ s16x4 vtr(lds_cptr p){ return __builtin_bit_cast(s16x4,__builtin_amdgcn_ds_read_tr16_b64_v4i16((__attribute__((address_space(3))) v4i16_t*)p)); }
__device__ __forceinline__ float rowmax(const f32x16&p0,const f32x16&p1){
  float a=max3f(p0[0],p0[1],p1[0]),b=max3f(p0[2],p0[3],p1[1]);a=max3f(a,p1[2],p1[3]);
  #pragma unroll
  for(int r=4;r<16;r+=4){a=max3f(a,p0[r],p0[r+1]);b=max3f(b,p0[r+2],p0[r+3]);a=max3f(a,p1[r],p1[r+1]);b=max3f(b,p1[r+2],p1[r+3]);}
  const float m=max2f(a,b);
  auto rr=__builtin_amdgcn_permlane32_swap(__float_as_uint(m),__float_as_uint(m),false,false);
  return max2f(__uint_as_float(rr[0]),__uint_as_float(rr[1]));
}
__device__ __forceinline__ void pv(f32x16*o,int vb,bf16x8 pa0,bf16x8 pa1,bf16x8 pa2,bf16x8 pa3){
  #pragma unroll
  for(int d0=0;d0<2;++d0){s16x4 lo[4],hi[4];
    #pragma unroll
    for(int ks=0;ks<4;++ks){
      asm volatile("ds_read_b64_tr_b16 %0,%1 offset:%c2":"=&v"(lo[ks]):"v"(vb),"i"(d0*4096+ks*1024):"memory");
      asm volatile("ds_read_b64_tr_b16 %0,%1 offset:%c2":"=&v"(hi[ks]):"v"(vb),"i"(d0*4096+ks*1024+512):"memory");}
    asm volatile("s_waitcnt lgkmcnt(0)":::"memory");SBAR();
    #define PK(k) (bf16x8){lo[k][0],lo[k][1],lo[k][2],lo[k][3],hi[k][0],hi[k][1],hi[k][2],hi[k][3]}
    o[d0]=__builtin_amdgcn_mfma_f32_32x32x16_bf16(pa0,PK(0),o[d0],0,0,0);
    o[d0]=__builtin_amdgcn_mfma_f32_32x32x16_bf16(pa1,PK(1),o[d0],0,0,0);
    o[d0]=__builtin_amdgcn_mfma_f32_32x32x16_bf16(pa2,PK(2),o[d0],0,0,0);
    o[d0]=__builtin_amdgcn_mfma_f32_32x32x16_bf16(pa3,PK(3),o[d0],0,0,0);
    #undef PK
  }
}

__device__ __forceinline__ void split3(float c,unsigned&hb,unsigned&mb,unsigned&lb){
  hb=__float_as_uint(c)&0xffff0000u; const float r1=c-__uint_as_float(hb); mb=__float_as_uint(r1)&0xffff0000u; const float r2=r1-__uint_as_float(mb); lb=__float_as_uint(r2)&0xffff0000u; }
__device__ __forceinline__ bf16x8 make_ax(float negc){ unsigned hb,mb,lb; split3(negc,hb,mb,lb);
  u32x4 w; w.x=(hb>>16)|mb; w.y=(lb>>16)|0x3f800000u; w.z=0x3f803f80u; w.w=0u; return __builtin_bit_cast(bf16x8,w); }
__device__ __forceinline__ bf16x8 make_qx(float negm,unsigned hm){ unsigned hb,mb,lb; split3(negm,hb,mb,lb);
  u32x4 w; w.x=0x3f803f80u&hm; w.y=(0x3f80u|hb)&hm; w.z=((mb>>16)|lb)&hm; w.w=0u; return __builtin_bit_cast(bf16x8,w); }
#ifndef ATTN_STORE16
#define ATTN_STORE16(p,v) (*(u32x4*)(p)=(v))
#endif
template<int THRL> __device__ __forceinline__ void attn_unit(int b,int h,int qb,const bf16*Q,const bf16*__restrict__ K,const bf16*__restrict__ V,bf16*O,const bf16*__restrict__ Gt,char*shm,const int tid_u,const float skip_thr){
  int tid=tid_u; asm volatile("":"+v"(tid));
  const int lane=tid&63,r32=lane&31,hi=lane>>5; const int wid=__builtin_amdgcn_readfirstlane(tid>>6);
  const long rowbase=(long)b*SEQ; const int q0=qb*QB;
  const bf16*Qw=Q+(rowbase+q0+wid*QBLK)*DM+h*D;
  float*csp=(float*)(shm+LDS_CS);
  int tskip=0;
  { const float cq0=csp[q0]; const int ntall=(q0+QB)/KVBLK; while(tskip+2<=ntall-4 && csp[KVBLK*(tskip+1)+KVBLK-1]-cq0<skip_thr)tskip+=2; tskip=__builtin_amdgcn_readfirstlane(tskip); }
  const bf16*Kh=K+(rowbase+(long)tskip*KVBLK)*DM+h*D,*Vh=V+(rowbase+(long)tskip*KVBLK)*DM+h*D;
  const unsigned lds0=(unsigned)(uintptr_t)shm;
  float*wsf=(float*)(shm+LDS_WS)+wid*64;
  const unsigned koff=(unsigned)(lane*DM+wid*8), voff=(unsigned)((16*(wid&3)+(lane>>2))*DM+(wid>>2)*32+(lane&3)*8);
  const unsigned kdst=lds0+LDS_K+wid*1024, vdst=lds0+LDS_V+wid*1024;
  #define DMA_K(t,slot) do{unsigned o_=koff;asm volatile("":"+v"(o_));glds16(Kh+(long)(t)*KVBLK*DM+o_,(unsigned)__builtin_amdgcn_readfirstlane(kdst+(slot)));}while(0)
  #define DMA_V(t,slot) do{unsigned o_=voff;asm volatile("":"+v"(o_));glds16(Vh+(long)(t)*KVBLK*DM+o_,(unsigned)__builtin_amdgcn_readfirstlane(vdst+(slot)));}while(0)
  const int vb0=(int)(lds0+LDS_V)+((lane>>4)&1)*32+(lane&3)*8+(4*hi+((lane&15)>>2))*64;
  const char*Kbase=shm+LDS_K; bf16x8 kf[8];
  const lds_cptr shm3=(lds_cptr)shm; const lds_cptr kp0=shm3+LDS_K+hi*1024+r32*16; const lds_cptr vp0=shm3+LDS_V+((lane>>4)&1)*32+(lane&3)*8+(4*hi+((lane&15)>>2))*64;
  const int NT=(q0+QB)/KVBLK-tskip;
  const float*cst=csp+tskip*KVBLK;
  const unsigned hm=hi?0u:0xffffffffu;
  DMA_K(0,0);DMA_V(0,0);DMA_K(1,SLOTB);
  const lds_cptr qls=shm3+LDS_OST+wid*4096+hi*512+r32*16;
  { bf16x8 qr[4];
    #pragma unroll
    for(int d0=0;d0<4;++d0)qr[d0]=*reinterpret_cast<const bf16x8*>(&Qw[(long)r32*DM+d0*16+hi*8]);
    #pragma unroll
    for(int d0=0;d0<4;++d0)*(__attribute__((address_space(3))) bf16x8*)(shm3+LDS_OST+wid*4096+hi*512+r32*16+d0*1024)=qr[d0]; }
  #define QLD(k) (*(const __attribute__((address_space(3))) bf16x8*)(qls+(k)*1024))
  float mhat=csp[q0+wid*QBLK+r32],l_reg=0.f;f32x16 o[2];o[0]=f32x16{};o[1]=f32x16{}; bf16x8 qx=make_qx(-mhat,hm);
  const int qrel=wid*QBLK+r32;
  #define CMASK(P0,P1,t) do{int jb_=(t)-(NT-4); if(jb_>=0)cmask(P0,P1,jb_,qrel,hi);}while(0)
  bool resc=false;
  #define START(P0,P1) do{ const float rm=rowmax(P0,P1); resc=false; \
    if(__any(rm>(float)THRL)){ const float dl=__builtin_fmaxf(rm,0.f); mhat=fadd_s(mhat,dl); \
      _Pragma("unroll") for(int r=0;r<16;++r){P0[r]=fsub_s(P0[r],dl);P1[r]=fsub_s(P1[r],dl);} \
      qx=make_qx(-mhat,hm); } \
    _Pragma("unroll") for(int r=0;r<16;++r)P0[r]=__builtin_amdgcn_exp2f(P0[r]); }while(0)
  #define RESC() do{ if(resc){ asm volatile("s_waitcnt lgkmcnt(0)":::"memory"); \
      _Pragma("unroll") for(int d_=0;d_<2;++d_) _Pragma("unroll") for(int r=0;r<16;++r)o[d_][r]*=wsf[crow(r,hi)]; } }while(0)
  f32x16 pA0,pA1,pB0,pB1;
  int sl_prev=0,sl_cur=0,sl_next=SLOTB;
  #define ROT() do{sl_prev=sl_cur;sl_cur=sl_next;sl_next=(sl_next==(NSLOT-1)*SLOTB)?0:sl_next+SLOTB;}while(0)
  DMA_K(2,2*SLOTB);
  WAIT_BAR(3);
  qkt(pA0,pA1,Kbase,qls,make_ax(cst[r32]),make_ax(cst[32+r32]),qx,r32,hi);asm volatile("s_nop 15\n\ts_nop 7":"+v"(pA0),"+v"(pA1));CMASK(pA0,pA1,0);
  START(pA0,pA1);
  _Pragma("unroll") for(int r=0;r<16;++r)pA1[r]=__builtin_amdgcn_exp2f(pA1[r]);
  WAIT_BAR(0);
  DMA_K(3,0);DMA_V(1,SLOTB);
  ROT();
  kload8(kf,kp0+sl_cur);
  WAIT_BAR(2);
  s16x4 vlo[8],vhi[8]; u32x4 pw0,pw1,pw2,pw3;
  #define PKW(P,B) cvtpk_s(P[B],P[B+1])
  #define PAF(k) __builtin_bit_cast(bf16x8,pw##k)
  #define VFR(i) (bf16x8){vlo[i][0],vlo[i][1],vlo[i][2],vlo[i][3],vhi[i][0],vhi[i][1],vhi[i][2],vhi[i][3]}
  #define PIN(x) asm volatile("":"+v"(x))
  #define MX3(a,b,c) __builtin_fmaxf(__builtin_fmaxf((a),(b)),(c))
  #define GAPA(MF,A0,A1,A2,A3,W0,W1,PW) do{ MF; sacc+=A0; sacc+=A1; sacc+=A2; sacc+=A3; PIN(sacc); W0; W1; PIN(PW); SBAR(); }while(0)
  #define EX(v) __builtin_amdgcn_exp2f(v)
  #define GAPB(MF,X,B) do{ MF; X[B]=EX(X[B]); X[B+1]=EX(X[B+1]); X[B+2]=EX(X[B+2]); X[B+3]=EX(X[B+3]); PIN(X); SBAR(); }while(0)
  #define VRD(i) do{ vlo[i]=vtr(vp_+(((i)>>2)*4096+((i)&3)*1024)); vhi[i]=vtr(vp_+(((i)>>2)*4096+((i)&3)*1024+512)); }while(0)
  #define KRD(G,j) do{ if(G){ kload2(kf,kp0+sl_next,j); SBAR(); } }while(0)
  #define STEP(C0,C1,P0,P1,t,GK,GV,GL) do{ SBAR(); \
    const lds_cptr vp_=vp0+sl_prev; \
    const bf16x8 ax0_=make_ax(cst[(t)*KVBLK+r32]), ax1_=make_ax(cst[(t)*KVBLK+32+r32]); \
    C0=__builtin_amdgcn_mfma_f32_32x32x16_bf16(ax0_,qx,f32x16{},0,0,0); C1=__builtin_amdgcn_mfma_f32_32x32x16_bf16(ax1_,qx,f32x16{},0,0,0); SBAR(); \
    bf16x8 q0_=QLD(0), q1_=QLD(1); \
    VRD(0); SBAR(); float sacc=(P0[0]+P0[1]); \
    GAPA(C0=__builtin_amdgcn_mfma_f32_32x32x16_bf16(kf[0],q0_,C0,0,0,0), P0[2],P0[3],P0[4],P0[5],     pw0[0]=PKW(P0,0), pw0[1]=PKW(P0,2), pw0); \
    VRD(4); SBAR(); GAPA(C1=__builtin_amdgcn_mfma_f32_32x32x16_bf16(kf[1],q0_,C1,0,0,0), P0[6],P0[7],P0[8],P0[9],     pw0[2]=PKW(P0,4), pw0[3]=PKW(P0,6), pw0); q0_=QLD(2); \
    VRD(1); SBAR(); GAPA(C0=__builtin_amdgcn_mfma_f32_32x32x16_bf16(kf[2],q1_,C0,0,0,0),   P0[10],P0[11],P0[12],P0[13], pw1[0]=PKW(P0,8), pw1[1]=PKW(P0,10), pw1); \
    VRD(5); SBAR(); GAPA(C1=__builtin_amdgcn_mfma_f32_32x32x16_bf16(kf[3],q1_,C1,0,0,0),   P0[14],P0[15],P1[0],P1[1],   pw1[2]=PKW(P0,12),pw1[3]=PKW(P0,14), pw1); q1_=QLD(3); \
    VRD(2); SBAR(); GAPA(C0=__builtin_amdgcn_mfma_f32_32x32x16_bf16(kf[4],q0_,C0,0,0,0),   P1[2],P1[3],P1[4],P1[5],     pw2[0]=PKW(P1,0), pw2[1]=PKW(P1,2), pw2); \
    VRD(6); SBAR(); GAPA(C1=__builtin_amdgcn_mfma_f32_32x32x16_bf16(kf[5],q0_,C1,0,0,0),   P1[6],P1[7],P1[8],P1[9],     pw2[2]=PKW(P1,4), pw2[3]=PKW(P1,6), pw2); \
    VRD(3); SBAR(); GAPA(C0=__builtin_amdgcn_mfma_f32_32x32x16_bf16(kf[6],q1_,C0,0,0,0),   P1[10],P1[11],P1[12],P1[13], pw3[0]=PKW(P1,8), pw3[1]=PKW(P1,10), pw3); \
    VRD(7); SBAR(); GAPA(C1=__builtin_amdgcn_mfma_f32_32x32x16_bf16(kf[7],q1_,C1,0,0,0),   P1[14],P1[15],0.f,0.f,       pw3[2]=PKW(P1,12),pw3[3]=PKW(P1,14), pw3); \
    l_reg+=sacc; \
    if(GK){DMA_K((t)+3,sl_cur);} if(GV){DMA_V((t)+1,sl_next);} \
    CMASK(C0,C1,t); \
    { float a=MX3(C0[0],C0[1],C1[0]),b=MX3(C0[2],C0[3],C1[1]); a=MX3(a,C1[2],C1[3]); \
      _Pragma("unroll") for(int r=4;r<16;r+=4){a=MX3(a,C0[r],C0[r+1]);b=MX3(b,C0[r+2],C0[r+3]);a=MX3(a,C1[r],C1[r+1]);b=MX3(b,C1[r+2],C1[r+3]);} \
      float rm=__builtin_fmaxf(a,b); { auto rr=__builtin_amdgcn_permlane32_swap(__float_as_uint(rm),__float_as_uint(rm),false,false); rm=__builtin_fmaxf(__uint_as_float(rr[0]),__uint_as_float(rr[1])); } \
      resc=false; \
      if(__builtin_expect(__any(rm>(float)THRL),0)){ const float dl=__builtin_fmaxf(rm,0.f); mhat+=dl; \
        _Pragma("unroll") for(int r=0;r<16;++r){C0[r]-=dl;C1[r]-=dl;} \
        qx=make_qx(-mhat,hm); \
        const float f=__builtin_amdgcn_exp2f(-dl); l_reg*=f; if(hi==0)wsf[r32]=f; resc=true; } } \
    SBAR(); \
    GAPB(o[0]=__builtin_amdgcn_mfma_f32_32x32x16_bf16(PAF(0),VFR(0),o[0],0,0,0), C0,0); \
    GAPB(o[1]=__builtin_amdgcn_mfma_f32_32x32x16_bf16(PAF(0),VFR(4),o[1],0,0,0), C0,4); \
    KRD(GL,0); GAPB(o[0]=__builtin_amdgcn_mfma_f32_32x32x16_bf16(PAF(1),VFR(1),o[0],0,0,0), C0,8); \
    KRD(GL,1); GAPB(o[1]=__builtin_amdgcn_mfma_f32_32x32x16_bf16(PAF(1),VFR(5),o[1],0,0,0), C0,12); \
    KRD(GL,2); GAPB(o[0]=__builtin_amdgcn_mfma_f32_32x32x16_bf16(PAF(2),VFR(2),o[0],0,0,0), C1,0); \
    KRD(GL,3); GAPB(o[1]=__builtin_amdgcn_mfma_f32_32x32x16_bf16(PAF(2),VFR(6),o[1],0,0,0), C1,4); \
    GAPB(o[0]=__builtin_amdgcn_mfma_f32_32x32x16_bf16(PAF(3),VFR(3),o[0],0,0,0), C1,8); \
    GAPB(o[1]=__builtin_amdgcn_mfma_f32_32x32x16_bf16(PAF(3),VFR(7),o[1],0,0,0), C1,12); \
    }while(0)
  int t=1;
  #undef CMASK
  #define CMASK(P0,P1,t) do{}while(0)
  for(;t+5<NT;t+=2){
    STEP(pB0,pB1,pA0,pA1,t,true,true,true);     WAIT_BAR(2); RESC(); ROT();
    STEP(pA0,pA1,pB0,pB1,t+1,true,true,true);   WAIT_BAR(2); RESC(); ROT();
  }
  #undef CMASK
  #define CMASK(P0,P1,t) do{int jb_=(t)-(NT-4); if(jb_>=0)cmask(P0,P1,jb_,qrel,hi);}while(0)
  #define ENDW(tt) do{ if((tt)+3<NT){WAIT_BAR(2);} else if((tt)+2<NT){WAIT_BAR(1);} else {WAIT_BAR(0);} }while(0)
  for(;t+1<NT;t+=2){
    STEP(pB0,pB1,pA0,pA1,t,(t+3<NT),(t+1<NT),(t+1<NT));       ENDW(t);   RESC(); ROT();
    STEP(pA0,pA1,pB0,pB1,t+1,(t+4<NT),(t+2<NT),(t+2<NT));     ENDW(t+1); RESC(); ROT();
  }
  STEP(pB0,pB1,pA0,pA1,NT-1,false,false,false); RESC();
  { float sacc=pB0[0]+pB0[1]; _Pragma("unroll") for(int r=2;r<16;++r)sacc+=pB0[r]; _Pragma("unroll") for(int r=0;r<16;++r)sacc+=pB1[r]; l_reg+=sacc;
    pw0=(u32x4){PKW(pB0,0),PKW(pB0,2),PKW(pB0,4),PKW(pB0,6)};pw1=(u32x4){PKW(pB0,8),PKW(pB0,10),PKW(pB0,12),PKW(pB0,14)};pw2=(u32x4){PKW(pB1,0),PKW(pB1,2),PKW(pB1,4),PKW(pB1,6)};pw3=(u32x4){PKW(pB1,8),PKW(pB1,10),PKW(pB1,12),PKW(pB1,14)};
    SBAR(); pv(o,vb0+sl_cur,PAF(0),PAF(1),PAF(2),PAF(3)); }
  #undef PKW
  #undef PAF
  #undef VFR
  #undef PIN
  #undef MX3
  #undef GAPA
  #undef GAPB
  #undef EX
  #undef VRD
  #undef KRD
  #undef STEP
  #undef ENDW
  {auto rr=__builtin_amdgcn_permlane32_swap(__float_as_uint(l_reg),__float_as_uint(l_reg),false,false);l_reg=__uint_as_float(rr[0])+__uint_as_float(rr[1]);}
  { int te=tid; asm volatile("":"+v"(te));
    const int lane_e=te&63,r32e=lane_e&31,hie=lane_e>>5;
    if(hie==0)wsf[32+r32e]=l_reg;asm volatile("s_waitcnt lgkmcnt(0)":::"memory");
    float rli[16];
    #pragma unroll
    for(int r=0;r<16;++r)rli[r]=__builtin_amdgcn_rcpf(wsf[32+crow(r,hie)]);
    bf16*Ow=O+(rowbase+q0+wid*QBLK)*DM+h*D; const bf16*Gw=Gt+(rowbase+q0+wid*QBLK)*DM+h*D;
    bf16*stg=(bf16*)(shm+LDS_OST)+wid*2048;
    #pragma unroll
    for(int r=0;r<16;++r){const int orow=crow(r,hie);
      #pragma unroll
      for(int d0=0;d0<2;++d0)stg[orow*64+d0*32+r32e]=__float2bfloat16(o[d0][r]*rli[r]);}
    asm volatile("s_waitcnt lgkmcnt(0)":::"memory");
    #pragma unroll
    for(int i=0;i<4;++i){const int row=i*8+(lane_e>>3),ch=lane_e&7; u32x4 v=*(const u32x4*)(stg+row*64+ch*8); const u32x4 gv=*(const u32x4*)(Gw+(long)row*DM+ch*8);
      #pragma unroll
      for(int e=0;e<4;++e){ const float g0=__uint_as_float(gv[e]<<16),g1=__uint_as_float(gv[e]&0xffff0000u),x0=__uint_as_float(v[e]<<16),x1=__uint_as_float(v[e]&0xffff0000u);
        v[e]=cvtpk_s(x0*__builtin_amdgcn_rcpf(1.f+__expf(-g0)),x1*__builtin_amdgcn_rcpf(1.f+__expf(-g1))); }
      ATTN_STORE16(Ow+(long)row*DM+ch*8,v);} }
  asm volatile("s_waitcnt lgkmcnt(0)\n\ts_barrier":::"memory");
  #undef DMA_K
  #undef QLD
  #undef DMA_V
  #undef CMASK
  #undef START
  #undef RESC
  #undef ROT
}
constexpr int ATTN_LDS_BYTES=LDS_BYTES;
struct AttnTensors { const bf16* Q; const bf16* K; const bf16* V; bf16* O; const bf16* G; const float* CUM; float THR; };
struct AttnUnit { int bh; int qb; };
struct StaticOrder {
  int vcu;
  __device__ __forceinline__ explicit StaticOrder(int grid,int block):vcu((block%8)*(grid/8)+block/8){}
  __device__ __forceinline__ bool next(int i,AttnUnit&u)const{ if(i>=4)return false; const int s=2*(vcu&1)+(i>>1); u.bh=vcu>>1; u.qb=(i&1)?7-s:s; return true; }
  __device__ __forceinline__ void a_ready(const AttnUnit&)const{}
  __device__ __forceinline__ void done(const AttnUnit&)const{}
};
template<class Sched,int THRL=8> __device__ __forceinline__ void attn_phase(char*lds,const AttnTensors&T,const Sched&S,int tid_in){
  AttnUnit u; int tid_=tid_in; asm volatile("":"+v"(tid_));
  if(S.next(0,u)){ float*csp=(float*)(lds+LDS_CS); float*wt=(float*)(lds+LDS_WS); int tp=tid_in; asm volatile("":"+v"(tp));
    const float*lf=T.CUM+((long)(u.bh/NHEAD)*SEQ+4*tp)*NHEAD+u.bh%NHEAD;
    const float a0=lf[0],a1=a0+lf[NHEAD],a2=a1+lf[2*NHEAD],a3=a2+lf[3*NHEAD];
    float sc=a3; const int ln=tp&63;
    #pragma unroll
    for(int o=1;o<64;o<<=1){ const float up=__builtin_bit_cast(float,__builtin_amdgcn_ds_bpermute((ln-o)<<2,__builtin_bit_cast(int,sc))); if(ln>=o)sc+=up; }
    if(ln==63)wt[tp>>6]=sc;
    __syncthreads();
    float base=sc-a3;
    #pragma unroll
    for(int w=0;w<NW-1;++w)if(w<(tp>>6))base+=wt[w];
    const float k2=-1.4426950408889634f;
    csp[4*tp]=k2*(base+a0);csp[4*tp+1]=k2*(base+a1);csp[4*tp+2]=k2*(base+a2);csp[4*tp+3]=k2*(base+a3);
    __syncthreads(); }
  for(int i=0;S.next(i,u);++i){ S.a_ready(u); attn_unit<THRL>(u.bh/NHEAD,u.bh%NHEAD,u.qb,T.Q,T.K,T.V,T.O,T.G,lds,tid_,T.THR); S.done(u); }
}
#undef SBAR
#undef WAIT_BAR
}
#define GAS __attribute__((address_space(1)))
#define LAS __attribute__((address_space(3)))
typedef unsigned short bf16;
typedef unsigned v4u __attribute__((ext_vector_type(4)));
typedef float f32x4 __attribute__((ext_vector_type(4)));
typedef short bf16x8 __attribute__((ext_vector_type(8)));
typedef GAS unsigned gu32;
typedef GAS unsigned long long gu64;
#define RLX_AGENT __ATOMIC_RELAXED, __HIP_MEMORY_SCOPE_AGENT
#define LDS_WAIT() asm volatile("s_waitcnt lgkmcnt(0)" ::: "memory")
#define VM_WAIT() asm volatile("s_waitcnt vmcnt(0)" ::: "memory")
__device__ __forceinline__ unsigned long long rt() { return __builtin_amdgcn_s_memrealtime(); }
__device__ __forceinline__ unsigned f2bf(float f) { unsigned u = __builtin_bit_cast(unsigned, f); return (u + 0x7fffu + ((u >> 16) & 1u)) >> 16; }
__device__ __forceinline__ unsigned pk2(float lo, float hi) { return f2bf(lo) | (f2bf(hi) << 16); }
__device__ __forceinline__ unsigned pk2h(float lo, float hi) { unsigned r; asm("v_cvt_pk_bf16_f32 %0, %1, %2" : "=v"(r) : "v"(lo), "v"(hi)); return r; }
__device__ __forceinline__ unsigned f2bfh(float f) { return pk2h(f, 0.f) & 0xffffu; }

#define XB_TMO      128
#define XB_XCNT(j)  (256  + 64 * (j))
#define XB_XSUB(j)  (1280 + 64 * (j))
#define XB_XGEN(j)  (2304 + 64 * (j))
#define XB_TOP      3328
#define XB_TOPGEN   3392
#define XCD_BAR_WORDS 3456
#define XB_SPIN_CAP (1u << 27)

__device__ __forceinline__ unsigned xb_ld(unsigned* p)              { return __hip_atomic_load(p, __ATOMIC_RELAXED, __HIP_MEMORY_SCOPE_AGENT); }
__device__ __forceinline__ unsigned xb_add(unsigned* p, unsigned v) { return __hip_atomic_fetch_add(p, v, __ATOMIC_RELAXED, __HIP_MEMORY_SCOPE_AGENT); }
__device__ __forceinline__ unsigned xb_xcc_id() { return (unsigned)__builtin_amdgcn_s_getreg((3 << 11) | 20) & 0xFu; }
#define XB_SPIN(cond, bar) do { unsigned _sp = 0; while (cond) { __builtin_amdgcn_s_sleep(1); \
    if ((++_sp & 255u) == 0u) { if (xb_ld(&(bar)[XB_TMO])) break; if (_sp > XB_SPIN_CAP) { atomicAdd(&(bar)[XB_TMO], 1u); break; } } } } while (0)

struct XcdBarrier {
    unsigned* bar; unsigned x;
    volatile LAS unsigned* st;
};

__device__ __forceinline__ XcdBarrier xcd_barrier_post(unsigned* bar, volatile LAS unsigned* st) {
    XcdBarrier b; b.bar = bar; b.x = xb_xcc_id(); b.st = st;
    if (threadIdx.x == 0) (void)xb_add(&bar[XB_XCNT(b.x)], 1u);
    return b;
}
__device__ __forceinline__ void xcd_barrier_complete(unsigned* bar, unsigned x, unsigned& nloc, unsigned& nx) {
    const unsigned G = gridDim.x * gridDim.y * gridDim.z;
    unsigned sum, cnt, mine, sp = 0u;
    for (;;) {
        sum = 0u; cnt = 0u; mine = 0u;
#pragma unroll
        for (unsigned j = 0; j < 16; ++j) { const unsigned c = xb_ld(&bar[XB_XCNT(j)]); sum += c; cnt += (c > 0u) ? 1u : 0u; mine = (j == x) ? c : mine; }
        if (sum == G) break;
        __builtin_amdgcn_s_sleep(1);
        if ((++sp & 255u) == 0u) { if (xb_ld(&bar[XB_TMO])) break; if (sp > XB_SPIN_CAP) { atomicAdd(&bar[XB_TMO], 1u); break; } }
    }
    nloc = mine > 0u ? mine : 1u; nx = cnt > 0u ? cnt : 1u;
}

__device__ __forceinline__ void xcd_barrier(const XcdBarrier& b, const bool leader  ) {
    asm volatile("s_waitcnt vmcnt(0)" ::: "memory");
    __syncthreads();
    if (leader) {
        unsigned* bar = b.bar;
        __builtin_amdgcn_s_waitcnt(0);
        unsigned nloc = b.st[0], nx = b.st[1];
        if (nloc == 0u) { xcd_barrier_complete(bar, b.x, nloc, nx); b.st[0] = nloc; b.st[1] = nx; }
        const unsigned old = xb_add(&bar[XB_XSUB(b.x)], 1u);
        const unsigned gen = old / nloc;
        if (old + 1u == (gen + 1u) * nloc) {
            __builtin_amdgcn_fence(__ATOMIC_RELEASE, "agent");
            asm volatile("s_waitcnt vmcnt(0)" ::: "memory");
            const unsigned og = xb_add(&bar[XB_TOP], 1u);
            const unsigned tg = og / nx;
            if (og + 1u == (tg + 1u) * nx) xb_add(&bar[XB_TOPGEN], 1u);
            else XB_SPIN(xb_ld(&bar[XB_TOPGEN]) == tg, bar);
            __builtin_amdgcn_fence(__ATOMIC_ACQUIRE, "agent");
            xb_add(&bar[XB_XGEN(b.x)], 1u);
            asm volatile("s_waitcnt vmcnt(0)" ::: "memory");
        } else {
            XB_SPIN(xb_ld(&bar[XB_XGEN(b.x)]) == gen, bar);
            __builtin_amdgcn_fence(__ATOMIC_ACQUIRE, "agent");
            asm volatile("s_waitcnt vmcnt(0)" ::: "memory");
        }
    }
    __syncthreads();
}
#ifndef MK_FASTATTN
#define MK_FASTATTN 1
#endif
#ifndef MK_FASTREC
#define MK_FASTREC 1
#endif
namespace cg = cooperative_groups;
constexpr int NTOK = 16384, DMODEL = 1024, NBATCH = 8, SEQLEN = 2048, DEPTH = 4;
constexpr int FOX_IN = 4112, GLA_IN = 3088, HGRN_IN = 4096;
constexpr float RMS_EPS = 1e-6f;
constexpr float LOG2E = 1.4426950408889634f;
constexpr float FOX_C2 = 0.125f * LOG2E;
constexpr int NWAVES = 8;

constexpr size_t MiB = 1u << 20;
constexpr size_t WS_CTL = 0, CTL_ZERO_BYTES = 1 * MiB;
constexpr size_t WS_FOXWIN = 2 * MiB, WS_FOXWOUT = 18 * MiB, WS_GLAWIN = 22 * MiB, WS_GLAWOUT = 28 * MiB, WS_HGRNWIN = 30 * MiB, WS_HGRNWOUT = 38 * MiB;
constexpr size_t WS_PEERWQ = 40 * MiB, WS_KEYS = 56 * MiB, WS_LB = 58 * MiB;
#define FOXFUSE ((I8MASK & 9) == 9)
#ifndef RPROBE
#define RPROBE 0
#endif
#ifndef GPROBE
#define GPROBE 0
#endif
#ifndef BGQ
#define BGQ 1
#endif
#ifndef I8MASK
#define I8MASK 13
#endif
constexpr size_t WS_SW = 58 * MiB + 65536, WS_SX = 58 * MiB + 262144, WS_XN8 = 724 * MiB;
constexpr size_t WS_TAILW = 63 * MiB;
constexpr size_t WS_RS = 62 * MiB;
constexpr size_t WS_U = 64 * MiB, WS_V = 128 * MiB, WS_SU = 60 * MiB, WS_SV = 61 * MiB;
constexpr size_t WS_XN = 320 * MiB, WS_P = 352 * MiB, WS_OB = 480 * MiB, WS_Q2 = 512 * MiB, WS_TAIL = 576 * MiB, WS_CUM = 577 * MiB;
constexpr size_t WS_EXP = 580 * MiB, WS_GATE = 588 * MiB, WS_OF = 596 * MiB, WS_GLOG = 660 * MiB, WS_HB = 740 * MiB, WS_END = 772 * MiB;
constexpr size_t PSTRIDE = (size_t)NTOK * 1024;
constexpr int CW_BAR = 4096;

constexpr int RING_BYTES = 131072;
constexpr int LDSCTL_OFF = 162816, MISC_OFF = LDSCTL_OFF + 320;
constexpr int LDS_BYTES = 163840;

typedef unsigned u32x4v __attribute__((ext_vector_type(4)));
struct Ctx {
    LAS unsigned char* lds; int tid, lane, wave, vcu, G, gw, NGW, bx;
    const float* in[21]; float* out; unsigned char* ws;
};

__device__ __forceinline__ float bf2f(unsigned short b) { return __uint_as_float(((unsigned)b) << 16); }
__device__ __forceinline__ float bflo(unsigned w) { return __uint_as_float(w << 16); }
__device__ __forceinline__ float bfhi(unsigned w) { return __uint_as_float(w & 0xffff0000u); }
#define DPP_ADD(v, ctrl, rm, bm) (v + __builtin_bit_cast(float, __builtin_amdgcn_update_dpp(0, __builtin_bit_cast(int, v), ctrl, rm, bm, false)))
#define DPP_MAX(v, ctrl, rm, bm) fmaxf(v, __builtin_bit_cast(float, __builtin_amdgcn_update_dpp(__builtin_bit_cast(int, v), __builtin_bit_cast(int, v), ctrl, rm, bm, false)))
#define DPP_SUM31(v) do { v = DPP_ADD(v, 0x111, 0xf, 0xf); v = DPP_ADD(v, 0x112, 0xf, 0xf); v = DPP_ADD(v, 0x114, 0xf, 0xe); v = DPP_ADD(v, 0x118, 0xf, 0xc); v = DPP_ADD(v, 0x142, 0xa, 0xf); } while (0)
#define DPP_SUM63(v) do { DPP_SUM31(v); v = DPP_ADD(v, 0x143, 0xc, 0xf); } while (0)
__device__ __forceinline__ float rdlane(float v, int lane) { return __builtin_bit_cast(float, __builtin_amdgcn_readlane(__builtin_bit_cast(int, v), lane)); }
__device__ __forceinline__ float wave_sum(float v) { DPP_SUM63(v); return rdlane(v, 63); }
__device__ __forceinline__ float wave_max(float v) {
    v = DPP_MAX(v, 0x111, 0xf, 0xf); v = DPP_MAX(v, 0x112, 0xf, 0xf); v = DPP_MAX(v, 0x114, 0xf, 0xe); v = DPP_MAX(v, 0x118, 0xf, 0xc); v = DPP_MAX(v, 0x142, 0xa, 0xf); v = DPP_MAX(v, 0x143, 0xc, 0xf);
    return rdlane(v, 63);
}
typedef __bf16 bf16x2_t __attribute__((ext_vector_type(2)));
__device__ __forceinline__ float dot2bf(unsigned w, unsigned x, float acc) { return __builtin_amdgcn_fdot2_f32_bf16(__builtin_bit_cast(bf16x2_t, w), __builtin_bit_cast(bf16x2_t, x), acc, false); }
__device__ __forceinline__ float bperm(float v, int src_lane) { return __builtin_bit_cast(float, __builtin_amdgcn_ds_bpermute(src_lane << 2, __builtin_bit_cast(int, v))); }
__device__ __forceinline__ float log_sigmoid_f(float x) { return fminf(x, 0.f) - log1pf(__expf(-fabsf(x))); }
__device__ __forceinline__ float sigmoid_f(float x) { return 1.f / (1.f + __expf(-x)); }

__device__ __forceinline__ void p0_transpose_item(const float* W, int ldw, int K, int Nuse, bf16* WT, LAS float* scr, int item, int lane) {
    const int nblk = Nuse / 32, kb = item / nblk, nb = item % nblk, k0 = 64 * kb, n0 = 32 * nb;
#pragma unroll
    for (int i = 0; i < 8; ++i) { const int kk = 8 * i + (lane >> 3); const f32x4 v = *(const GAS f32x4*)(W + (size_t)(k0 + kk) * ldw + n0 + 4 * (lane & 7));
        LAS float* d = scr + kk * 33 + 4 * (lane & 7); d[0] = v.x; d[1] = v.y; d[2] = v.z; d[3] = v.w; }
    LDS_WAIT(); asm volatile("" ::: "memory");
    const int c = lane & 7;
#pragma unroll
    for (int j = 0; j < 4; ++j) { const int n = (lane >> 3) + 8 * j; const LAS float* s = scr + (8 * c) * 33 + n;
        v4u o; o.x = pk2(s[0 * 33], s[1 * 33]); o.y = pk2(s[2 * 33], s[3 * 33]); o.z = pk2(s[4 * 33], s[5 * 33]); o.w = pk2(s[6 * 33], s[7 * 33]);
        *(GAS v4u*)(WT + (size_t)(n0 + n) * K + k0 + 8 * c) = o; }
    LDS_WAIT(); asm volatile("" ::: "memory");
}
__device__ __forceinline__ unsigned q8x4(float a, float b, float c, float d) {
    return ((unsigned)(int)__builtin_rintf(a) & 0xffu) | (((unsigned)(int)__builtin_rintf(b) & 0xffu) << 8) | (((unsigned)(int)__builtin_rintf(c) & 0xffu) << 16) | ((unsigned)(int)__builtin_rintf(d) << 24);
}
__device__ __forceinline__ void p0_colmax_item(const float* W, int ldw, unsigned* cmax, int item, int lane) {
    const int nb = item >> 3, n0 = 32 * nb, k0 = 128 * (item & 7);
    f32x4 v[16];
#pragma unroll
    for (int i = 0; i < 16; ++i) v[i] = *(const GAS f32x4*)(W + (size_t)(k0 + 8 * i + (lane >> 3)) * ldw + n0 + 4 * (lane & 7));
    __builtin_amdgcn_sched_barrier(0);
    float mx[4] = {0.f, 0.f, 0.f, 0.f};
#pragma unroll
    for (int i = 0; i < 16; ++i) { mx[0] = fmaxf(mx[0], fabsf(v[i].x)); mx[1] = fmaxf(mx[1], fabsf(v[i].y)); mx[2] = fmaxf(mx[2], fabsf(v[i].z)); mx[3] = fmaxf(mx[3], fabsf(v[i].w)); }
#pragma unroll
    for (int j = 0; j < 4; ++j) { mx[j] = fmaxf(mx[j], bperm(mx[j], lane ^ 8)); mx[j] = fmaxf(mx[j], bperm(mx[j], lane ^ 16)); mx[j] = fmaxf(mx[j], bperm(mx[j], lane ^ 32)); }
    if (lane < 8) {
#pragma unroll
        for (int j = 0; j < 4; ++j) (void)__hip_atomic_fetch_max(cmax + n0 + 4 * lane + j, __float_as_uint(mx[j]), __ATOMIC_RELAXED, __HIP_MEMORY_SCOPE_AGENT);
    }
}
__device__ __forceinline__ void p0_quant_item(const float* W, int ldw, const unsigned* cmax, signed char* W8, float* sw, LAS float* scr, int item, int lane, bool headperm) {
    const int nb = item >> 3, n0 = 32 * nb, k0 = 128 * (item & 7);
    const int n0s = (headperm && nb < 64) ? (nb >> 3) * 256 + 64 * (nb & 3) + 32 * ((nb >> 2) & 1) : n0;
    f32x4 v[2][8];
#pragma unroll
    for (int h = 0; h < 2; ++h)
#pragma unroll
        for (int i = 0; i < 8; ++i) v[h][i] = *(const GAS f32x4*)(W + (size_t)(k0 + 64 * h + 8 * i + (lane >> 3)) * ldw + n0s + 4 * (lane & 7));
    float ci[4];
#pragma unroll
    for (int j = 0; j < 4; ++j) { const float m = __uint_as_float(*(const GAS unsigned*)(cmax + n0s + (lane >> 3) + 8 * j)); ci[j] = m > 0.f ? 127.f / m : 0.f; }
    if ((item & 7) == 0 && lane < 32) *(GAS float*)(sw + n0 + lane) = __uint_as_float(*(const GAS unsigned*)(cmax + n0s + lane)) * (1.f / 127.f);
    __builtin_amdgcn_sched_barrier(0);
    const int c = lane & 7;
#pragma unroll
    for (int h = 0; h < 2; ++h) {
        LDS_WAIT(); asm volatile("" ::: "memory");
#pragma unroll
        for (int i = 0; i < 8; ++i) { LAS float* d = scr + (8 * i + (lane >> 3)) * 33 + 4 * (lane & 7); d[0] = v[h][i].x; d[1] = v[h][i].y; d[2] = v[h][i].z; d[3] = v[h][i].w; }
        LDS_WAIT(); asm volatile("" ::: "memory");
#pragma unroll
        for (int j = 0; j < 4; ++j) { const int n = (lane >> 3) + 8 * j; const LAS float* sp = scr + (8 * c) * 33 + n;
            const unsigned lo = q8x4(sp[0] * ci[j], sp[33] * ci[j], sp[66] * ci[j], sp[99] * ci[j]), hi = q8x4(sp[132] * ci[j], sp[165] * ci[j], sp[198] * ci[j], sp[231] * ci[j]);
            *(GAS unsigned long long*)(W8 + (size_t)(n0 + n) * 1024 + k0 + 64 * h + 8 * c) = (unsigned long long)lo | ((unsigned long long)hi << 32); }
    }
    LDS_WAIT(); asm volatile("" ::: "memory");
}
__device__ __forceinline__ void rms_row_to_bf16(int lane, f32x4 (&v)[4], const float* gain, bf16* orow, signed char* orow8, float* sx) {
    const GAS f32x4* gr = (const GAS f32x4*)gain + lane;
    float s = 0.f;
#pragma unroll
    for (int j = 0; j < 4; ++j) s += (v[j].x * v[j].x + v[j].y * v[j].y) + (v[j].z * v[j].z + v[j].w * v[j].w);
    const float r = rsqrtf(wave_sum(s) * (1.f / 1024.f) + RMS_EPS);
    GAS unsigned long long* o8 = (GAS unsigned long long*)orow + lane; float am = 0.f;
#pragma unroll
    for (int j = 0; j < 4; ++j) { const f32x4 g = gr[64 * j]; v[j].x *= r * g.x; v[j].y *= r * g.y; v[j].z *= r * g.z; v[j].w *= r * g.w;
        am = fmaxf(fmaxf(am, fmaxf(fabsf(v[j].x), fabsf(v[j].y))), fmaxf(fabsf(v[j].z), fabsf(v[j].w)));
        o8[64 * j] = (unsigned long long)pk2(v[j].x, v[j].y) | ((unsigned long long)pk2(v[j].z, v[j].w) << 32); }
    am = wave_max(am); const float qi = am > 0.f ? 127.f / am : 0.f;
    GAS unsigned* q8 = (GAS unsigned*)orow8 + lane;
#pragma unroll
    for (int j = 0; j < 4; ++j) q8[64 * j] = q8x4(v[j].x * qi, v[j].y * qi, v[j].z * qi, v[j].w * qi);
    if (lane == 0) *(GAS float*)sx = am * (1.f / 127.f);
}
__device__ __forceinline__ void cvt_f32_bf16(const Ctx& C, const float* src, bf16* dst, size_t n) {
    const size_t nth = (size_t)C.G * 512, t0 = (size_t)C.vcu * 512 + C.tid;
    for (size_t i = t0; i < n / 8; i += nth) {
        const f32x4 a = ((const GAS f32x4*)src)[2 * i], b = ((const GAS f32x4*)src)[2 * i + 1];
        v4u o; o.x = pk2(a.x, a.y); o.y = pk2(a.z, a.w); o.z = pk2(b.x, b.y); o.w = pk2(b.z, b.w);
        ((GAS v4u*)dst)[i] = o;
    }
}
template <bool I8> __device__ __forceinline__ void quant_row_fp8(int lane, const f32x4 (&v)[4], unsigned char* drow, unsigned char* sc) {
    float am = 0.f;
#pragma unroll
    for (int i = 0; i < 4; ++i) am = fmaxf(am, fmaxf(fmaxf(fabsf(v[i].x), fabsf(v[i].y)), fmaxf(fabsf(v[i].z), fabsf(v[i].w))));
    am = wave_max(am);
    const unsigned sbits = __float_as_uint(am * (I8 ? 1.f / 127.f : 1.f / 448.f));
    unsigned e = (sbits >> 23) + ((sbits & 0x7fffffu) ? 1u : 0u); e = am > 0.f ? (e < 1u ? 1u : e > 254u ? 254u : e) : 127u;
    const float inv = __uint_as_float((254u - e) << 23);
    GAS unsigned* o = (GAS unsigned*)drow + lane;
#pragma unroll
    for (int i = 0; i < 4; ++i) {
        if (I8) { o[64 * i] = q8x4(v[i].x * inv, v[i].y * inv, v[i].z * inv, v[i].w * inv); continue; }
        const float a = fminf(fmaxf(v[i].x * inv, -448.f), 448.f), b = fminf(fmaxf(v[i].y * inv, -448.f), 448.f), c = fminf(fmaxf(v[i].z * inv, -448.f), 448.f), d = fminf(fmaxf(v[i].w * inv, -448.f), 448.f);
        int w = 0; w = __builtin_amdgcn_cvt_pk_fp8_f32(a, b, w, false); w = __builtin_amdgcn_cvt_pk_fp8_f32(c, d, w, true); o[64 * i] = (unsigned)w;
    }
    if (lane == 0) *(GAS unsigned char*)sc = (unsigned char)e;
}
template <bool I8> __device__ __forceinline__ void quant_rows_fp8(const Ctx& C, const float* src, unsigned char* dst, unsigned char* scales, int nrows) {
    int rw = C.gw;
    for (; rw + 3 * C.NGW < nrows; rw += 4 * C.NGW) {
        f32x4 v[4][4];
#pragma unroll
        for (int j = 0; j < 4; ++j) { const GAS f32x4* xr = (const GAS f32x4*)(src + (size_t)(rw + j * C.NGW) * 1024) + C.lane;
#pragma unroll
            for (int i = 0; i < 4; ++i) v[j][i] = xr[64 * i]; }
        __builtin_amdgcn_sched_barrier(0);
#pragma unroll
        for (int j = 0; j < 4; ++j) quant_row_fp8<I8>(C.lane, v[j], dst + (size_t)(rw + j * C.NGW) * 1024, scales + rw + j * C.NGW);
    }
    for (; rw < nrows; rw += C.NGW) {
        const GAS f32x4* xr = (const GAS f32x4*)(src + (size_t)rw * 1024) + C.lane;
        f32x4 v[4];
#pragma unroll
        for (int i = 0; i < 4; ++i) v[i] = xr[64 * i];
        quant_row_fp8<I8>(C.lane, v, dst + (size_t)rw * 1024, scales + rw);
    }
}
constexpr int BGQ_ROWS = 3 * 16384;
template <int JOB> __device__ __forceinline__ bool bgq_row(const Ctx& C, int idx, const float*& src, unsigned char*& dst, unsigned char*& sc) {
    const int seg = idx >> 14, row = idx & 16383;
    const bool isV = seg == 1 || (seg == 2 && JOB == 2);
    const size_t flat = (size_t)(seg < 2 ? JOB : 3) * 16384 + row;
    src = (isV ? C.in[20] : C.in[19]) + flat * 1024; dst = C.ws + (isV ? WS_V : WS_U) + flat * 1024; sc = C.ws + (isV ? WS_SV : WS_SU) + flat; return isV;
}
template <int JOB> __device__ __forceinline__ void bgq_step(const Ctx& C, int idx_prev, int idx, f32x4 (&v)[4]) {
    const float* src; unsigned char* dst; unsigned char* sc;
    if (idx_prev >= 0 && idx_prev < BGQ_ROWS) { if (bgq_row<JOB>(C, idx_prev, src, dst, sc)) quant_row_fp8<false>(C.lane, v, dst, sc); else quant_row_fp8<true>(C.lane, v, dst, sc); }
    if (idx < BGQ_ROWS) { (void)bgq_row<JOB>(C, idx, src, dst, sc); const GAS f32x4* xr = (const GAS f32x4*)src + C.lane;
#pragma unroll
        for (int i = 0; i < 4; ++i) v[i] = xr[64 * i]; }
}
#ifndef PRO_PROBE
#define PRO_PROBE 0
#endif
constexpr int CW_CMAX = 131072;
constexpr int I8_NF0 = (I8MASK & 1) ? 1024 : 0, I8_NF3 = (I8MASK & 8) ? 1024 : 0, I8_NG = (I8MASK & 2) ? 768 : 0, I8_NH = (I8MASK & 4) ? 1024 : 0, I8_NITEMS = I8_NF0 + I8_NF3 + I8_NG + I8_NH;
template <bool PASS2> __device__ __forceinline__ void p0_i8_items(const Ctx& C, LAS float* scr) {
    unsigned* CM = (unsigned*)(C.ws + WS_CTL) + CW_CMAX; float* SW = (float*)(C.ws + WS_SW);
    for (int it = C.gw; it < I8_NITEMS; it += C.NGW) {
        int r = it; const float* W; int ldw; signed char* W8; int q;
        if (r < I8_NF0) { W = C.in[3]; ldw = FOX_IN; W8 = (signed char*)(C.ws + WS_FOXWIN); q = 0; }
        else if ((r -= I8_NF0) < I8_NF3) { W = C.in[3] + (size_t)1024 * FOX_IN; ldw = FOX_IN; W8 = (signed char*)(C.ws + WS_FOXWIN + 8 * MiB); q = 1; }
        else if ((r -= I8_NF3) < I8_NG) { W = C.in[8]; ldw = GLA_IN; W8 = (signed char*)(C.ws + WS_GLAWIN); q = 2; }
        else { r -= I8_NG; W = C.in[13]; ldw = HGRN_IN; W8 = (signed char*)(C.ws + WS_HGRNWIN); q = 3; }
        const int swo = q == 0 ? 0 : q == 1 ? 4096 : q == 2 ? 8192 : 11264;
        if (PASS2) p0_quant_item(W, ldw, CM + q * 4096, W8, SW + swo, scr, r, C.lane, FOXFUSE && q < 2); else p0_colmax_item(W, ldw, CM + q * 4096, r, C.lane);
    }
}
__device__ __forceinline__ void p0_prologue_b(const Ctx& C) { p0_i8_items<true>(C, (LAS float*)(C.lds + C.wave * 16384)); }
__device__ __forceinline__ void p0_prologue(const Ctx& C) {
    LAS float* scr = (LAS float*)(C.lds + C.wave * 16384);
    for (int rep_ = 0; rep_ < (PRO_PROBE == 1 ? 2 : 1); ++rep_) {
    p0_i8_items<false>(C, scr);
    constexpr int I_SQ = 16 * 32, N_F0 = (I8MASK & 1) ? 0 : 16 * 128, N_F3 = (I8MASK & 8) ? 0 : 16 * 128, N_G = (I8MASK & 2) ? 0 : 16 * 96, N_H = (I8MASK & 4) ? 0 : 16 * 128;
    constexpr int NITEMS = N_F0 + N_F3 + N_G + N_H + 2 * I_SQ + I_SQ + I_SQ;
    for (int it = C.gw; it < NITEMS; it += C.NGW) {
        int r = it;
        if (r < N_F0) { p0_transpose_item(C.in[3], FOX_IN, 1024, 4096, (bf16*)(C.ws + WS_FOXWIN), scr, r, C.lane); continue; } r -= N_F0;
        if (r < N_F3) { p0_transpose_item(C.in[3] + (size_t)1024 * FOX_IN, FOX_IN, 1024, 4096, (bf16*)(C.ws + WS_FOXWIN + 8 * MiB), scr, r, C.lane); continue; } r -= N_F3;
        if (r < N_G) { p0_transpose_item(C.in[8], GLA_IN, 1024, 3072, (bf16*)(C.ws + WS_GLAWIN), scr, r, C.lane); continue; } r -= N_G;
        if (r < N_H) { p0_transpose_item(C.in[13], HGRN_IN, 1024, 4096, (bf16*)(C.ws + WS_HGRNWIN), scr, r, C.lane); continue; } r -= N_H;
        if (r < 2 * I_SQ) { const int j = r / I_SQ; p0_transpose_item(C.in[7] + (size_t)j * 1024 * 1024, 1024, 1024, 1024, (bf16*)(C.ws + WS_FOXWOUT) + (size_t)j * 1024 * 1024, scr, r % I_SQ, C.lane); continue; } r -= 2 * I_SQ;
        if (r < I_SQ) { p0_transpose_item(C.in[12], 1024, 1024, 1024, (bf16*)(C.ws + WS_GLAWOUT), scr, r, C.lane); continue; } r -= I_SQ;
        p0_transpose_item(C.in[16], 1024, 1024, 1024, (bf16*)(C.ws + WS_HGRNWOUT), scr, r, C.lane);
    }
    }
    for (int rep_ = 0; rep_ < (PRO_PROBE == 2 ? 2 : 1); ++rep_) {
    constexpr int MT_GROUPS = 4 * 16 * 4 * 32;
    for (int grp = C.gw; grp < MT_GROUPS; grp += C.NGW) {
        const int nb2 = grp & 31, kb2 = (grp >> 5) & 3, hp = (grp >> 7) & 15, layer = grp >> 11;
        const float* kp = C.in[18] + ((size_t)(layer * 16 + hp) * 128 + kb2 * 32 + (C.lane & 15)) * 128 + 4 * (C.lane >> 4);
        const float* wp = C.in[17] + ((size_t)layer * 1024 + nb2 * 32 + (C.lane & 15)) * 2048 + hp * 128 + 4 * (C.lane >> 4);
        f32x4 ka[2][8], wb[2][8];
#pragma unroll
        for (int u = 0; u < 2; ++u)
#pragma unroll
            for (int s8 = 0; s8 < 8; ++s8) { ka[u][s8] = *(const GAS f32x4*)(kp + (size_t)u * 16 * 128 + 16 * s8); wb[u][s8] = *(const GAS f32x4*)(wp + (size_t)u * 16 * 2048 + 16 * s8); }
        __builtin_amdgcn_sched_barrier(0);
        f32x4 acc[2][2];
#pragma unroll
        for (int a = 0; a < 2; ++a)
#pragma unroll
            for (int b = 0; b < 2; ++b) acc[a][b] = (f32x4){0.f, 0.f, 0.f, 0.f};
#pragma unroll
        for (int s8 = 0; s8 < 8; ++s8)
#pragma unroll
            for (int a = 0; a < 2; ++a)
#pragma unroll
                for (int b = 0; b < 2; ++b) { const f32x4 x = ka[a][s8], y = wb[b][s8];
                    acc[a][b] = __builtin_amdgcn_mfma_f32_16x16x4f32(x.x, y.x, acc[a][b], 0, 0, 0); acc[a][b] = __builtin_amdgcn_mfma_f32_16x16x4f32(x.y, y.y, acc[a][b], 0, 0, 0);
                    acc[a][b] = __builtin_amdgcn_mfma_f32_16x16x4f32(x.z, y.z, acc[a][b], 0, 0, 0); acc[a][b] = __builtin_amdgcn_mfma_f32_16x16x4f32(x.w, y.w, acc[a][b], 0, 0, 0); }
#pragma unroll
        for (int a = 0; a < 2; ++a)
#pragma unroll
            for (int b = 0; b < 2; ++b) {
                bf16* mt = (bf16*)(C.ws + WS_PEERWQ) + ((size_t)layer * 2048 + hp * 128 + kb2 * 32 + a * 16 + (C.lane >> 4) * 4) * 1024 + nb2 * 32 + b * 16 + (C.lane & 15);
#pragma unroll
                for (int r = 0; r < 4; ++r) mt[(size_t)r * 1024] = (bf16)f2bf(acc[a][b][r]); }
    }
    }
    for (int rep_ = 0; rep_ < (PRO_PROBE == 3 ? 2 : 1); ++rep_) {
    quant_rows_fp8<true>(C, C.in[19], C.ws + WS_U, C.ws + WS_SU, BGQ ? 16384 : 4 * 16384);
    quant_rows_fp8<false>(C, C.in[20], C.ws + WS_V, C.ws + WS_SV, BGQ ? 16384 : 4 * 16384);
    }
    for (int rep_ = 0; rep_ < (PRO_PROBE == 4 ? 2 : 1); ++rep_) {
    for (int i = C.vcu * 512 + C.tid; i < 3 * 16 * 1024; i += C.G * 512) {
        const int w = i >> 14, n = (i >> 10) & 15, k = i & 1023;
        const float v = w < 2 ? C.in[3][(size_t)w * 1024 * FOX_IN + (size_t)k * FOX_IN + 4096 + n] : C.in[8][(size_t)k * GLA_IN + 3072 + n];
        ((bf16*)(C.ws + WS_TAILW))[i] = (bf16)f2bf(v);
    }
    if (C.vcu == 0) for (int c = C.tid; c < 1024; c += 512) {
        const float l0 = C.in[14][c], l1 = C.in[14][1024 + c], l2 = C.in[14][2048 + c], l3 = C.in[14][3072 + c];
        const float m = fmaxf(fmaxf(l0, l1), fmaxf(l2, l3));
        const float e0 = expf(l0 - m), e1 = expf(l1 - m), e2 = expf(l2 - m), e3 = expf(l3 - m);
        ((float*)(C.ws + WS_LB))[c] = (e1 + e2) / (e0 + e1 + e2 + e3);
    }
    for (int m0 = C.gw; m0 < NTOK; m0 += 4 * C.NGW) {
        f32x4 v[4][4];
#pragma unroll
        for (int u = 0; u < 4; ++u) { const int m = m0 + u * C.NGW; if (m < NTOK) { const GAS f32x4* xr = (const GAS f32x4*)(C.in[0] + (size_t)m * 1024) + C.lane;
#pragma unroll
            for (int j = 0; j < 4; ++j) v[u][j] = xr[64 * j]; } }
        __builtin_amdgcn_sched_barrier(0);
#pragma unroll
        for (int u = 0; u < 4; ++u) { const int m = m0 + u * C.NGW; if (m < NTOK)
            rms_row_to_bf16(C.lane, v[u], C.in[1], (bf16*)(C.ws + WS_XN) + (size_t)m * 1024, (signed char*)(C.ws + WS_XN8) + (size_t)m * 1024, (float*)(C.ws + WS_SX) + m); }
    }
    }
}

__device__ __forceinline__ void tail_mfma(const Ctx& C, int tok0, const bf16* WT, LAS float* part) {
    const int l = C.lane, m = l & 15, g = l >> 4, tbk = C.wave & 3, kh = C.wave >> 2;
    const bf16* ap = (const bf16*)(C.ws + WS_XN) + (size_t)(tok0 + 16 * tbk + m) * 1024 + kh * 512 + 8 * g;
    const bf16* bp = WT + (size_t)m * 1024 + kh * 512 + 8 * g;
    f32x4 acc = (f32x4){0.f, 0.f, 0.f, 0.f};
#pragma unroll 4
    for (int ks = 0; ks < 16; ++ks) acc = __builtin_amdgcn_mfma_f32_16x16x32_bf16(*(const bf16x8*)(ap + 32 * ks), *(const bf16x8*)(bp + 32 * ks), acc, 0, 0, 0);
#pragma unroll
    for (int r = 0; r < 4; ++r) part[kh * 1024 + (16 * tbk + 4 * g + r) * 16 + m] = acc[r];
}
template <bool QK> __device__ __forceinline__ void fox_step1(const Ctx& C, int j) {
    float* TAIL = (float*)(C.ws + WS_TAIL); LAS float* part = (LAS float*)C.lds;
    const bf16* WT = (const bf16*)(C.ws + WS_TAILW) + (size_t)j * 16 * 1024;
    for (int tb = C.vcu; tb < NTOK / 64; tb += C.G) {
        __syncthreads();
        tail_mfma(C, tb * 64, WT, part);
        __syncthreads();
#pragma unroll
        for (int rep = 0; rep < 2; ++rep) { const int i = rep * 512 + C.tid; TAIL[(size_t)tb * 1024 + i] = log_sigmoid_f(part[i] + part[1024 + i] + C.in[4][j * 16 + (i & 15)]); }
        if (!QK) continue;
        const float* gq = C.in[5] + j * 64; const float* gk = C.in[6] + j * 64;
        v4u ra[2][8], rb[2][8];
#pragma unroll
        for (int which = 0; which < 2; ++which)
#pragma unroll
            for (int t = 0; t < 8; ++t) { const bf16* row = (const bf16*)(C.ws + WS_P) + (size_t)which * PSTRIDE + (size_t)(tb * 64 + C.wave * 8 + t) * 1024 + C.lane * 16;
                ra[which][t] = *(const GAS v4u*)row; rb[which][t] = *(const GAS v4u*)(row + 8); }
        __builtin_amdgcn_sched_barrier(0);
#pragma unroll
        for (int which = 0; which < 2; ++which) {
            const float* g = (which == 0 ? gq : gk) + (C.lane & 3) * 16;
            float gv[16];
#pragma unroll
            for (int i = 0; i < 16; ++i) gv[i] = g[i];
#pragma unroll
            for (int t = 0; t < 8; ++t) {
                bf16* row = (bf16*)(C.ws + WS_P) + (size_t)which * PSTRIDE + (size_t)(tb * 64 + C.wave * 8 + t) * 1024 + C.lane * 16;
                const v4u a = ra[which][t], b = rb[which][t];
                float v[16] = {bflo(a.x), bfhi(a.x), bflo(a.y), bfhi(a.y), bflo(a.z), bfhi(a.z), bflo(a.w), bfhi(a.w), bflo(b.x), bfhi(b.x), bflo(b.y), bfhi(b.y), bflo(b.z), bfhi(b.z), bflo(b.w), bfhi(b.w)};
                float ss = 0.f;
#pragma unroll
                for (int i = 0; i < 16; ++i) ss += v[i] * v[i];
                ss = DPP_ADD(ss, 0xB1, 0xf, 0xf); ss = DPP_ADD(ss, 0x4E, 0xf, 0xf);
                const float r = rsqrtf(ss * (1.f / 64.f) + RMS_EPS) * (which == 0 ? FOX_C2 : 1.f);
#pragma unroll
                for (int i = 0; i < 16; ++i) v[i] = v[i] * r * gv[i];
                v4u oa, ob; oa.x = pk2(v[0], v[1]); oa.y = pk2(v[2], v[3]); oa.z = pk2(v[4], v[5]); oa.w = pk2(v[6], v[7]);
                ob.x = pk2(v[8], v[9]); ob.y = pk2(v[10], v[11]); ob.z = pk2(v[12], v[13]); ob.w = pk2(v[14], v[15]);
                *(GAS v4u*)row = oa; *(GAS v4u*)(row + 8) = ob;
            }
        }
    }
}
constexpr size_t WS_ASC = WS_Q2, WS_Q1 = WS_Q2 + 16 * MiB, WS_KST = WS_Q2 + 48 * MiB, WS_DEC = 59 * MiB;
static_assert(WS_KST + 32 * MiB <= WS_OF && WS_Q1 + 32 * MiB <= WS_KST, "chunk workspace map");
template <int NH>
__device__ __forceinline__ void chunk_prepass(const Ctx& C) {
    bf16* ASC = (bf16*)(C.ws + WS_ASC); bf16* Q1 = (bf16*)(C.ws + WS_Q1); bf16* KST = (bf16*)(C.ws + WS_KST); float* DEC = (float*)(C.ws + WS_DEC);
    const bf16* P0 = (const bf16*)(C.ws + WS_P); const bf16* P1 = P0 + PSTRIDE;
    LAS bf16* tqs = (LAS bf16*)C.lds;
    LAS bf16* tks = tqs + 64 * 128;
    LAS bf16* q2s = tks + 64 * 128;
    LAS bf16* k2s = q2s + 64 * 136;
    LAS bf16* q1s = k2s + 64 * 136;
    LAS float* tot = (LAS float*)(q1s + 64 * 128);
    LAS float* part = tot + 512;
    const float qs = 0.08838834764831845f;
    const int d = C.tid & 127, tq = C.tid >> 7, l = C.lane, fr = l & 15, fq = l >> 4;
    const int dq = (d & ~31) + ((d & 16) ? 8 * ((d & 15) >> 2) + 4 + (d & 3) : 8 * ((d & 15) >> 2) + (d & 3));
    const int pr0 = C.tid >> 4, pc = (C.tid & 15) * 8;
#define PP_BAR() do { asm volatile("s_waitcnt lgkmcnt(0)" ::: "memory"); __builtin_amdgcn_s_barrier(); asm volatile("" ::: "memory"); } while (0)
    for (int itb = C.vcu; itb < NBATCH * 32; itb += C.G) {
        const int c = itb & 31, b = itb >> 5;
        const size_t rowb = (size_t)b * SEQLEN + c * 64;
        const size_t row0 = rowb + tq * 16;
        if (NH == 4) { __syncthreads(); tail_mfma(C, b * SEQLEN + c * 64, (const bf16*)(C.ws + WS_TAILW) + 2 * 16 * 1024, part); }
        v4u pq[2], pk[2];
#define PP_LOAD(h_) do { _Pragma("unroll") for (int j = 0; j < 2; ++j) { const size_t r_ = (rowb + pr0 + 32 * j) * 1024 + (h_) * 128 + pc; \
            pq[j] = *(const GAS v4u*)(P0 + r_); pk[j] = *(const GAS v4u*)((NH == 4 ? P0 + 512 : P1) + r_); } } while (0)
        PP_LOAD(0);
#pragma unroll 1
        for (int h = 0; h < NH; ++h) {
            const int it = (b * NH + h) * 32 + c;
            float wu[16]; float ba = 0.f, lb = 0.f;
            if (NH == 4) {
#pragma unroll
                for (int r = 0; r < 16; ++r) wu[r] = C.in[9][r * 512 + h * 128 + d];
                ba = C.in[10][h * 128 + d];
            } else lb = ((const float*)(C.ws + WS_LB))[h * 128 + d];
            PP_BAR();
#pragma unroll
            for (int j = 0; j < 2; ++j) { *(LAS v4u*)(tqs + (pr0 + 32 * j) * 128 + pc) = pq[j]; *(LAS v4u*)(tks + (pr0 + 32 * j) * 128 + pc) = pk[j]; }
            if (h + 1 < NH) PP_LOAD(h + 1);
            PP_BAR();
            float bl[16], kk[16]; float run = 0.f;
            if (NH == 4) {
#pragma unroll
                for (int i = 0; i < 16; ++i) { float z = ba; const int t = tq * 16 + i;
#pragma unroll
                    for (int r = 0; r < 16; r += 4) { const f32x4 p0 = *(const LAS f32x4*)(part + t * 16 + r), p1 = *(const LAS f32x4*)(part + 1024 + t * 16 + r);
                        z += (p0[0] + p1[0]) * wu[r] + (p0[1] + p1[1]) * wu[r + 1] + (p0[2] + p1[2]) * wu[r + 2] + (p0[3] + p1[3]) * wu[r + 3]; }
                    run += log_sigmoid_f(z) * (1.f / 16.f); bl[i] = run; kk[i] = bf2f(tks[t * 128 + d]); }
            } else {
#pragma unroll
                for (int i = 0; i < 16; ++i) { const float gate = lb + (1.f - lb) * sigmoid_f(bf2f(tks[(tq * 16 + i) * 128 + d])); run += __logf(gate); bl[i] = run; kk[i] = 1.f - gate; }
            }
            tot[tq * 128 + d] = run;
            PP_BAR();
            const float t0 = tot[d], t1 = tot[128 + d], t2 = tot[256 + d], t3 = tot[384 + d];
            const float off = tq == 0 ? 0.f : tq == 1 ? t0 : tq == 2 ? t0 + t1 : t0 + t1 + t2;
            const float bref = t0 + t1, bend = (t0 + t1) + (t2 + t3);
            unsigned ksw[8];
#pragma unroll
            for (int i = 0; i < 16; ++i) {
                const float bb = bl[i] + off;
                const float qv = bf2f(tqs[(tq * 16 + i) * 128 + d]) * qs, kv = kk[i];
                q1s[(tq * 16 + i) * 128 + dq] = (bf16)f2bfh(qv * __expf(bb));
                q2s[(tq * 16 + i) * 136 + d] = (bf16)f2bfh(qv * __expf(bb - bref));
                k2s[(tq * 16 + i) * 136 + d] = (bf16)f2bfh(kv * __expf(bref - bb));
                const unsigned kb = f2bfh(kv * __expf(bend - bb));
                if (i & 1) ksw[i >> 1] |= kb << 16; else ksw[i >> 1] = kb;
            }
            { bf16* kt = KST + ((size_t)it * 128 + d) * 64 + tq * 16; *(GAS v4u*)kt = (v4u){ksw[0], ksw[1], ksw[2], ksw[3]}; *(GAS v4u*)(kt + 8) = (v4u){ksw[4], ksw[5], ksw[6], ksw[7]}; }
            if (tq == 0) DEC[(size_t)it * 128 + d] = __expf(bend);
            PP_BAR();
#pragma unroll
            for (int j = 0; j < 2; ++j) *(GAS v4u*)(Q1 + (((size_t)it * 4 + (pc >> 5)) * 64 + pr0 + 32 * j) * 32 + (pc & 31)) = *(const LAS v4u*)(q1s + (pr0 + 32 * j) * 128 + pc);
            const int ti = C.wave >> 1;
#pragma unroll
            for (int sj = 0; sj < 2; ++sj) {
                const int si = 2 * (C.wave & 1) + sj;
                f32x4 acc = (f32x4){0.f, 0.f, 0.f, 0.f};
                if (si <= ti) {
#pragma unroll
                    for (int ks = 0; ks < 4; ++ks) {
                        const bf16x8 a = *(const LAS bf16x8*)(q2s + (16 * ti + fr) * 136 + ks * 32 + fq * 8), bb = *(const LAS bf16x8*)(k2s + (16 * si + fr) * 136 + ks * 32 + fq * 8);
                        acc = __builtin_amdgcn_mfma_f32_16x16x32_bf16(bb, a, acc, 0, 0, 0);
                    }
                }
                const int t = 16 * ti + fr, s0 = 16 * si + 4 * fq;
                typedef unsigned u32x2v __attribute__((ext_vector_type(2)));
                u32x2v w; w.x = pk2(s0 <= t ? acc[0] : 0.f, s0 + 1 <= t ? acc[1] : 0.f); w.y = pk2(s0 + 2 <= t ? acc[2] : 0.f, s0 + 3 <= t ? acc[3] : 0.f);
                *(GAS u32x2v*)(ASC + (size_t)it * 4096 + t * 64 + s0) = w;
            }
        }
    }
#undef PP_LOAD
#undef PP_BAR
}
template <int NH, int DV>
__device__ __forceinline__ void chunk_recur2(const Ctx& C, const bf16* Vp) {
    const bf16* ASC = (const bf16*)(C.ws + WS_ASC); const bf16* Q1 = (const bf16*)(C.ws + WS_Q1); const bf16* KST = (const bf16*)(C.ws + WS_KST); const float* DEC = (const float*)(C.ws + WS_DEC);
    bf16* OF = (bf16*)(C.ws + WS_OF);
    constexpr int NCB = DV / 32, NTASK = NBATCH * NH * NCB, JOB = NH == 4 ? 1 : 2;
    const int l = C.lane, m = l & 15, g = l >> 4, kq = C.wave & 3;
    LAS float* red = (LAS float*)C.lds;
    LAS bf16* vt = (LAS bf16*)(C.lds + 65536);
    typedef short v4i16_t __attribute__((ext_vector_type(4)));
    int bgit = 0;
    if (C.wave >= 4) {
        const int NBW = C.G * 4, bw = C.vcu * 4 + (C.wave - 4);
        f32x4 r0[2][4], r1[2][4], r2[2][4]; int i0[2] = {-1, -1}, i1[2] = {-1, -1}, i2[2] = {-1, -1};
#define BG_STEP(c_, RA, IA) do { _Pragma("unroll") for (int j = 0; j < 2; ++j) { const int nx = (BGQ && (c_) < 24) ? ((bgit * 24 + (c_)) * 2 + j) * NBW + bw : BGQ_ROWS; bgq_step<JOB>(C, IA[j], nx, RA[j]); IA[j] = nx; } \
        asm volatile("s_waitcnt lgkmcnt(0)" ::: "memory"); __builtin_amdgcn_s_barrier(); asm volatile("" ::: "memory"); } while (0)
        for (int t0 = C.vcu; t0 < NTASK; t0 += C.G, ++bgit) {
            asm volatile("s_waitcnt lgkmcnt(0)" ::: "memory"); __builtin_amdgcn_s_barrier(); asm volatile("" ::: "memory");
#pragma unroll 1
            for (int c = 0; c < 30; c += 3) { BG_STEP(c, r0, i0); BG_STEP(c + 1, r1, i1); BG_STEP(c + 2, r2, i2); }
            BG_STEP(30, r0, i0); BG_STEP(31, r1, i1);
#pragma unroll
            for (int j = 0; j < 2; ++j) { bgq_step<JOB>(C, i2[j], BGQ_ROWS, r2[j]); i2[j] = BGQ_ROWS; bgq_step<JOB>(C, i0[j], BGQ_ROWS, r0[j]); i0[j] = BGQ_ROWS; bgq_step<JOB>(C, i1[j], BGQ_ROWS, r1[j]); i1[j] = BGQ_ROWS; }
            asm volatile("s_waitcnt lgkmcnt(0)" ::: "memory"); __builtin_amdgcn_s_barrier(); asm volatile("" ::: "memory");
        }
#undef BG_STEP
        if (BGQ) { int ip = BGQ_ROWS;
            for (int nx = bgit * 48 * NBW + bw; nx < BGQ_ROWS || ip < BGQ_ROWS; nx += NBW) { bgq_step<JOB>(C, ip, nx, r0[0]); ip = nx; } }
        return;
    }
    struct Frag { bf16x8 a0, a1; bf16x8 q[4]; f32x4 dc[2]; bf16x8 ks[2][2]; };
#define REC_LOAD(F, c_) do { const size_t ch_ = (size_t)bh * 32 + (c_); \
        F.a0 = *(const bf16x8*)(ASC + ch_ * 4096 + (16 * kq + m) * 64 + 8 * g); F.a1 = *(const bf16x8*)(ASC + ch_ * 4096 + (16 * kq + m) * 64 + 32 + 8 * g); \
        _Pragma("unroll") for (int tb = 0; tb < 4; ++tb) F.q[tb] = *(const bf16x8*)(Q1 + ((ch_ * 4 + kq) * 64 + 16 * tb + m) * 32 + 8 * g); \
        _Pragma("unroll") for (int i = 0; i < 2; ++i) { F.dc[i] = *(const f32x4*)(DEC + ch_ * 128 + 32 * kq + 16 * i + 4 * g); \
            _Pragma("unroll") for (int ks = 0; ks < 2; ++ks) F.ks[i][ks] = *(const bf16x8*)(KST + (ch_ * 128 + 32 * kq + 16 * i + m) * 64 + 32 * ks + 8 * g); } } while (0)
#define VP_LOAD(c_) (*(const v4u*)(Vp + ((size_t)b * SEQLEN + (c_) * 64 + 16 * kq + (l >> 2)) * 1024 + h * DV + cb * 32 + 8 * (l & 3)))
#define VT_PUT(c_, v_) (*(LAS v4u*)(vt + ((c_) & 1) * 2048 + ((l & 3) >> 1) * 1024 + (16 * kq + (l >> 2)) * 16 + 8 * (l & 1)) = (v_))
#define REC_BODY(F, Fn, c_, vcur_, vnew_) do { \
        if ((c_) + 1 < 32) REC_LOAD(Fn, (c_) + 1); \
        if ((c_) + 2 < 32) vnew_ = VP_LOAD((c_) + 2); \
        bf16x8 vb[2][2]; \
        _Pragma("unroll") for (int hf = 0; hf < 2; ++hf) _Pragma("unroll") for (int ks = 0; ks < 2; ++ks) { const LAS bf16* tp_ = vt + ((c_) & 1) * 2048 + hf * 1024 + (32 * ks + 8 * g + ((l & 15) >> 2)) * 16 + 4 * (l & 3); \
            const v4i16_t lo_ = __builtin_amdgcn_ds_read_tr16_b64_v4i16((LAS v4i16_t*)tp_), hi_ = __builtin_amdgcn_ds_read_tr16_b64_v4i16((LAS v4i16_t*)(tp_ + 64)); \
            vb[hf][ks] = (bf16x8){lo_[0], lo_[1], lo_[2], lo_[3], hi_[0], hi_[1], hi_[2], hi_[3]}; } \
        if ((c_) + 1 < 32) VT_PUT((c_) + 1, vcur_); \
        LAS float* rb = red + ((c_) & 1) * 8192; \
        f32x4 oin[2]; \
        _Pragma("unroll") for (int hf = 0; hf < 2; ++hf) { oin[hf] = __builtin_amdgcn_mfma_f32_16x16x32_bf16(F.a0, vb[hf][0], (f32x4){0.f, 0.f, 0.f, 0.f}, 0, 0, 0); \
            if (kq >= 2) oin[hf] = __builtin_amdgcn_mfma_f32_16x16x32_bf16(F.a1, vb[hf][1], oin[hf], 0, 0, 0); } \
        _Pragma("unroll") for (int hf = 0; hf < 2; ++hf) { u32x4v sw; sw.x = pk2(S[hf][0][0], S[hf][0][1]); sw.y = pk2(S[hf][0][2], S[hf][0][3]); sw.z = pk2(S[hf][1][0], S[hf][1][1]); sw.w = pk2(S[hf][1][2], S[hf][1][3]); \
          const bf16x8 sb = __builtin_bit_cast(bf16x8, sw); \
          _Pragma("unroll") for (int tb = 0; tb < 4; ++tb) { \
              const f32x4 po = __builtin_amdgcn_mfma_f32_16x16x32_bf16(F.q[tb], sb, (f32x4){0.f, 0.f, 0.f, 0.f}, 0, 0, 0); \
              *(LAS f32x4*)(rb + hf * 4096 + ((kq * 4 + tb) * 64 + l) * 4) = po; } } \
        _Pragma("unroll") for (int hf = 0; hf < 2; ++hf) _Pragma("unroll") for (int i = 0; i < 2; ++i) { S[hf][i] = S[hf][i] * F.dc[i]; \
            _Pragma("unroll") for (int ks = 0; ks < 2; ++ks) S[hf][i] = __builtin_amdgcn_mfma_f32_16x16x32_bf16(F.ks[i][ks], vb[hf][ks], S[hf][i], 0, 0, 0); } \
        asm volatile("s_waitcnt lgkmcnt(0)" ::: "memory"); __builtin_amdgcn_s_barrier(); asm volatile("" ::: "memory"); \
        _Pragma("unroll") for (int hf = 0; hf < 2; ++hf) { f32x4 o = oin[hf]; \
          _Pragma("unroll") for (int k2 = 0; k2 < 4; ++k2) o = o + *(const LAS f32x4*)(rb + hf * 4096 + ((k2 * 4 + kq) * 64 + l) * 4); \
          const size_t orow = (size_t)b * SEQLEN + (c_) * 64 + 16 * kq + 4 * g; \
          _Pragma("unroll") for (int r = 0; r < 4; ++r) OF[(orow + r) * 1024 + col + 16 * hf] = (bf16)f2bf(o[r]); } } while (0)
    for (int t0 = C.vcu; t0 < NTASK; t0 += C.G) {
        const int cb = t0 % NCB, bh = t0 / NCB, b = bh / NH, h = bh % NH;
        const int col = h * DV + cb * 32 + m;
        f32x4 S[2][2];
#pragma unroll
        for (int hf = 0; hf < 2; ++hf) { S[hf][0] = (f32x4){0.f, 0.f, 0.f, 0.f}; S[hf][1] = S[hf][0]; }
        Frag FA, FB;
        REC_LOAD(FA, 0);
        v4u vA = VP_LOAD(0), vB = VP_LOAD(1);
        VT_PUT(0, vA); vA = vB;
        asm volatile("s_waitcnt lgkmcnt(0)" ::: "memory"); __builtin_amdgcn_s_barrier(); asm volatile("" ::: "memory");
#pragma unroll 1
        for (int c = 0; c < 32; c += 2) { REC_BODY(FA, FB, c, vA, vB); REC_BODY(FB, FA, c + 1, vB, vA); }
        asm volatile("s_waitcnt lgkmcnt(0)" ::: "memory"); __builtin_amdgcn_s_barrier(); asm volatile("" ::: "memory");
    }
#undef REC_LOAD
#undef REC_BODY
#undef VP_LOAD
#undef VT_PUT
}
struct RecFrag { bf16x8 a0, a1; bf16x8 q[4]; f32x4 dc[2]; bf16x8 ks[2][2]; };
template <int NH, int DV, int RP = 0  >
__device__ __forceinline__ void chunk_recur(const Ctx& C, const bf16* Vp) {
    const bf16* ASC = (const bf16*)(C.ws + WS_ASC); const bf16* Q1 = (const bf16*)(C.ws + WS_Q1); const bf16* KST = (const bf16*)(C.ws + WS_KST); const float* DEC = (const float*)(C.ws + WS_DEC);
    bf16* OF = (bf16*)(C.ws + (RP ? WS_GLOG : WS_OF));
    constexpr int NCB = DV / 16, NTASK = NBATCH * NH * NCB;
    const int l = C.lane, m = l & 15, g = l >> 4, gi = C.wave >> 2, kq = C.wave & 3;
    LAS float* red = (LAS float*)C.lds + gi * 8192;
    LAS bf16* vt = (LAS bf16*)(C.lds + 65536) + gi * 2048;
    typedef short v4i16_t __attribute__((ext_vector_type(4)));
#define REC_LOAD(F, c_) do { const size_t row0_ = (size_t)b * SEQLEN + (c_) * 64; const size_t ch_ = (size_t)bh * 32 + (c_); \
        F.a0 = *(const bf16x8*)(ASC + ch_ * 4096 + (16 * kq + m) * 64 + 8 * g); F.a1 = *(const bf16x8*)(ASC + ch_ * 4096 + (16 * kq + m) * 64 + 32 + 8 * g); \
        _Pragma("unroll") for (int tb = 0; tb < 4; ++tb) F.q[tb] = *(const bf16x8*)(Q1 + ((ch_ * 4 + kq) * 64 + 16 * tb + m) * 32 + 8 * g); \
        _Pragma("unroll") for (int i = 0; i < 2; ++i) { F.dc[i] = *(const f32x4*)(DEC + ch_ * 128 + 32 * kq + 16 * i + 4 * g); \
            _Pragma("unroll") for (int ks = 0; ks < 2; ++ks) F.ks[i][ks] = *(const bf16x8*)(KST + (ch_ * 128 + 32 * kq + 16 * i + m) * 64 + 32 * ks + 8 * g); } } while (0)
#define VP_LOAD(c_) (*(const unsigned long long*)(Vp + ((size_t)b * SEQLEN + (c_) * 64 + 16 * kq + (l >> 2)) * 1024 + h * DV + cb * 16 + 4 * (l & 3)))
#define VT_PUT(c_, v_) (*(LAS unsigned long long*)(vt + ((c_) & 1) * 1024 + (16 * kq + (l >> 2)) * 16 + 4 * (l & 3)) = (v_))
#define REC_BODY(F, Fn, c_, vcur_, vnew_) do { \
        if ((c_) + 1 < 32 && RP != 3) REC_LOAD(Fn, (c_) + 1); \
        if ((c_) + 2 < 32) vnew_ = VP_LOAD((c_) + 2); \
        bf16x8 vb[2]; \
        _Pragma("unroll") for (int ks = 0; ks < 2; ++ks) { const LAS bf16* tp_ = vt + ((c_) & 1) * 1024 + (32 * ks + 8 * g + ((l & 15) >> 2)) * 16 + 4 * (l & 3); \
            const v4i16_t lo_ = __builtin_amdgcn_ds_read_tr16_b64_v4i16((LAS v4i16_t*)tp_), hi_ = __builtin_amdgcn_ds_read_tr16_b64_v4i16((LAS v4i16_t*)(tp_ + 64)); \
            vb[ks] = (bf16x8){lo_[0], lo_[1], lo_[2], lo_[3], hi_[0], hi_[1], hi_[2], hi_[3]}; } \
        if ((c_) + 1 < 32) VT_PUT((c_) + 1, vcur_);              \
        if (BGQ && RP == 0) { const int bgn = (bgit * 32 + (c_)) * C.NGW + C.gw; bgq_step<JOB>(C, bgi, bgn, bgv); bgi = bgn; } \
        LAS float* rb = red + ((c_) & 1) * 4096; \
        f32x4 oin = __builtin_amdgcn_mfma_f32_16x16x32_bf16(F.a0, vb[0], (f32x4){0.f, 0.f, 0.f, 0.f}, 0, 0, 0); \
        if (kq >= 2) oin = __builtin_amdgcn_mfma_f32_16x16x32_bf16(F.a1, vb[1], oin, 0, 0, 0); \
        { u32x4v sw; sw.x = pk2(S[0][0], S[0][1]); sw.y = pk2(S[0][2], S[0][3]); sw.z = pk2(S[1][0], S[1][1]); sw.w = pk2(S[1][2], S[1][3]); \
          const bf16x8 sb = __builtin_bit_cast(bf16x8, sw); \
          _Pragma("unroll") for (int tb = 0; tb < 4; ++tb) { \
              const f32x4 po = __builtin_amdgcn_mfma_f32_16x16x32_bf16(F.q[tb], sb, (f32x4){0.f, 0.f, 0.f, 0.f}, 0, 0, 0); \
              *(LAS f32x4*)(rb + ((kq * 4 + tb) * 64 + l) * 4) = po; } } \
        _Pragma("unroll") for (int i = 0; i < 2; ++i) { S[i] = S[i] * F.dc[i]; \
            _Pragma("unroll") for (int ks = 0; ks < 2; ++ks) S[i] = __builtin_amdgcn_mfma_f32_16x16x32_bf16(F.ks[i][ks], vb[ks], S[i], 0, 0, 0); } \
        if (RP != 2) { asm volatile("s_waitcnt lgkmcnt(0)" ::: "memory"); __builtin_amdgcn_s_barrier(); asm volatile("" ::: "memory"); } \
        { f32x4 o = oin; \
          if (RP != 2) { _Pragma("unroll") for (int k2 = 0; k2 < 4; ++k2) o = o + *(const LAS f32x4*)(rb + ((k2 * 4 + kq) * 64 + l) * 4); } \
          const size_t orow = (size_t)b * SEQLEN + (c_) * 64 + 16 * kq + 4 * g; \
          if (RP != 4 || (c_) == 31) { _Pragma("unroll") for (int r = 0; r < 4; ++r) OF[(orow + r) * 1024 + col] = (bf16)f2bf(o[r]); } } } while (0)
    constexpr int JOB = NH == 4 ? 1 : 2;
    f32x4 bgv[4]; int bgi = -1, bgit = 0;
    for (int t0 = C.vcu; t0 < NTASK / 2; t0 += C.G, ++bgit) {
        const int task = gi * (NTASK / 2) + t0;
        const int cb = task % NCB, bh = task / NCB, b = bh / NH, h = bh % NH;
        const int col = h * DV + cb * 16 + m;
        f32x4 S[2];
        S[0] = (f32x4){0.f, 0.f, 0.f, 0.f}; S[1] = S[0];
        RecFrag FA, FB;
        REC_LOAD(FA, 0);
        if (RP == 3) REC_LOAD(FB, 1);
        unsigned long long vA = VP_LOAD(0), vB = VP_LOAD(1);
        VT_PUT(0, vA); vA = vB;
        asm volatile("s_waitcnt lgkmcnt(0)" ::: "memory"); __builtin_amdgcn_s_barrier(); asm volatile("" ::: "memory");
#pragma unroll 1
        for (int c = 0; c < 32; c += 2) { REC_BODY(FA, FB, c, vA, vB); REC_BODY(FB, FA, c + 1, vB, vA); }
        asm volatile("s_waitcnt lgkmcnt(0)" ::: "memory"); __builtin_amdgcn_s_barrier(); asm volatile("" ::: "memory");
    }
    if (BGQ && RP == 0) {
        for (int bgn = bgit * 32 * C.NGW + C.gw; bgi < BGQ_ROWS; bgn += C.NGW) { bgq_step<JOB>(C, bgi, bgn, bgv); bgi = bgn; }
    }
#undef REC_LOAD
#undef REC_BODY
#undef VP_LOAD
#undef VT_PUT
}

template <int DV>
__device__ __forceinline__ void rec_norm_gate(const Ctx& C, const float* gain, const bf16* gate) {
    const bf16* OF = (const bf16*)(C.ws + WS_OF); bf16* OB = (bf16*)(C.ws + WS_OB);
    f32x4 g[4];
#pragma unroll
    for (int j = 0; j < 4; ++j) g[j] = *((const GAS f32x4*)gain + C.lane + 64 * j);
    for (int tok0 = C.gw; tok0 < NTOK; tok0 += 4 * C.NGW) {
        unsigned long long vw[4][4], tw[4][4];
#pragma unroll
        for (int u = 0; u < 4; ++u) { const int tok = tok0 + u * C.NGW; if (tok < NTOK) {
            const GAS unsigned long long* xr = (const GAS unsigned long long*)(OF + (size_t)tok * 1024) + C.lane;
            const GAS unsigned long long* tr = (const GAS unsigned long long*)(gate + (size_t)tok * 1024) + C.lane;
#pragma unroll
            for (int j = 0; j < 4; ++j) { vw[u][j] = xr[64 * j]; tw[u][j] = tr[64 * j]; } } }
        __builtin_amdgcn_sched_barrier(0);
#pragma unroll
        for (int u = 0; u < 4; ++u) { const int tok = tok0 + u * C.NGW; if (tok < NTOK) {
            GAS unsigned long long* o8 = (GAS unsigned long long*)(OB + (size_t)tok * 1024) + C.lane;
#pragma unroll
            for (int j = 0; j < 4; ++j) {
                const f32x4 v = (f32x4){bflo((unsigned)vw[u][j]), bfhi((unsigned)vw[u][j]), bflo((unsigned)(vw[u][j] >> 32)), bfhi((unsigned)(vw[u][j] >> 32))}; float ss = (v.x * v.x + v.y * v.y) + (v.z * v.z + v.w * v.w);
                if (DV == 256) ss = wave_sum(ss); else { DPP_SUM31(ss); const float s_lo = rdlane(ss, 31), s_hi = rdlane(ss, 63); ss = C.lane < 32 ? s_lo : s_hi; }
                const float r = rsqrtf(ss * (1.f / DV) + RMS_EPS);
                const unsigned long long t8 = tw[u][j];
                const float t0 = bflo((unsigned)t8), t1 = bfhi((unsigned)t8), t2 = bflo((unsigned)(t8 >> 32)), t3 = bfhi((unsigned)(t8 >> 32));
                const float a0 = v.x * r * g[j].x * (t0 * sigmoid_f(t0)), a1 = v.y * r * g[j].y * (t1 * sigmoid_f(t1)), a2 = v.z * r * g[j].z * (t2 * sigmoid_f(t2)), a3 = v.w * r * g[j].w * (t3 * sigmoid_f(t3));
                o8[64 * j] = (unsigned long long)pk2h(a0, a1) | ((unsigned long long)pk2h(a2, a3) << 32);
            } } }
    }
}

#define CE_D(a, b) do { const unsigned mx_ = (a) > (b) ? (a) : (b); const unsigned mn_ = (a) > (b) ? (b) : (a); (a) = mx_; (b) = mn_; } while (0)
__device__ __forceinline__ void sort16_desc(unsigned (&a)[16]) {
#define S16(i, j) CE_D(a[i], a[j])
    S16(0,13); S16(1,12); S16(2,15); S16(3,14); S16(4,8); S16(5,6); S16(7,11); S16(9,10);
    S16(0,5); S16(1,7); S16(2,9); S16(3,4); S16(6,13); S16(8,14); S16(10,15); S16(11,12);
    S16(0,1); S16(2,3); S16(4,5); S16(6,8); S16(7,9); S16(10,11); S16(12,13); S16(14,15);
    S16(0,2); S16(1,3); S16(4,10); S16(5,11); S16(6,7); S16(8,9); S16(12,14); S16(13,15);
    S16(1,2); S16(3,12); S16(4,6); S16(5,7); S16(8,10); S16(9,11); S16(13,14);
    S16(1,4); S16(2,6); S16(5,8); S16(7,10); S16(9,13); S16(11,14);
    S16(2,4); S16(3,6); S16(9,12); S16(11,13);
    S16(3,5); S16(6,8); S16(7,9); S16(10,12);
    S16(3,4); S16(5,6); S16(7,8); S16(9,10); S16(11,12);
    S16(6,7); S16(8,9);
#undef S16
}
__device__ __forceinline__ void merge_top16(unsigned (&a)[16], const unsigned (&b)[16]) {
#pragma unroll
    for (int i = 0; i < 16; ++i) a[i] = a[i] > b[15 - i] ? a[i] : b[15 - i];
#pragma unroll
    for (int j = 8; j > 0; j >>= 1)
#pragma unroll
        for (int i = 0; i < 16; ++i) { const int l = i ^ j; if (l > i) CE_D(a[i], a[l]); }
}
__device__ __forceinline__ void merge_quad(unsigned (&a)[16], int lane) {
    unsigned p[16];
#pragma unroll
    for (int i = 0; i < 16; ++i) p[i] = (unsigned)__builtin_amdgcn_ds_bpermute((lane ^ 16) << 2, (int)a[i]);
    merge_top16(a, p);
#pragma unroll
    for (int i = 0; i < 16; ++i) p[i] = (unsigned)__builtin_amdgcn_ds_bpermute((lane ^ 32) << 2, (int)a[i]);
    merge_top16(a, p);
}
__device__ __forceinline__ unsigned mono_key(float f) { const unsigned u = __float_as_uint(f); return (u & 0x80000000u) ? ~u : (u | 0x80000000u); }
__device__ __forceinline__ float mono_inv(unsigned k) { return __uint_as_float((k & 0x80000000u) ? (k ^ 0x80000000u) : ~k); }
__constant__ __attribute__((aligned(16))) unsigned char PEER_CAND[64] = {0, 1, 2, 3, 4, 5, 6, 7, 8, 9, 10, 11, 12, 13, 14, 15, 16, 17, 18, 19, 20, 21, 22, 23, 32, 33, 34, 35, 36, 64, 65, 66, 48, 49, 50, 51, 80, 81, 96, 97, 112, 113, 128, 144, 160, 176, 192, 208, 224, 240, 255, 255, 255, 255, 255, 255, 255, 255, 255, 255, 255, 255, 255, 255};
typedef _Float16 h8 __attribute__((ext_vector_type(8)));
__device__ __forceinline__ void peer_topk_load(const Ctx& C, int tok0, int head, h8 (&hv)[2][4]) {
    int l = C.lane; asm volatile("" : "+v"(l));
    const _Float16* SC = (const _Float16*)(C.ws + WS_Q2);
#pragma unroll
    for (int p = 0; p < 2; ++p) { const _Float16* sp = SC + (size_t)(tok0 + (l & 15)) * 2048 + head * 256 + p * 128 + 32 * (l >> 4);
#pragma unroll
        for (int q = 0; q < 4; ++q) hv[p][q] = *(const GAS h8*)(sp + 8 * q); }
}
__device__ __forceinline__ void peer_topk_task(const Ctx& C, int layer, int tok0, int head, int trow0, LAS int* lexp, LAS float* lgate, const h8 (&hvin)[2][4]) {
    LAS unsigned* L0 = (LAS unsigned*)(C.lds + C.wave * 2048);
    LAS unsigned* L1 = L0 + 256;
    {
        int l = C.lane; asm volatile("" : "+v"(l));
        const int m = l & 15, g = l >> 4;
        unsigned cand_w[4];
#pragma unroll
        for (int c = 0; c < 4; ++c) cand_w[c] = ((const unsigned*)PEER_CAND)[g * 4 + c];
        unsigned top[2][16];
#pragma unroll
        for (int p = 0; p < 2; ++p) {
            h8 hv[4];
#pragma unroll
            for (int q = 0; q < 4; ++q) hv[q] = hvin[p][q];
            unsigned hi16[16];
#pragma unroll
            for (int q = 0; q < 4; ++q)
#pragma unroll
                for (int j = 0; j < 8; ++j) { const int i = 8 * q + j; const unsigned key = (mono_key((float)hv[q][j]) & ~0x7fu) | (unsigned)(127 - (32 * g + i));
                    if (i < 16) top[p][i] = key; else hi16[i - 16] = key; }
            sort16_desc(top[p]); sort16_desc(hi16); merge_top16(top[p], hi16);
            merge_quad(top[p], l);
        }
        if (g == 0) {
#pragma unroll
            for (int i = 0; i < 16; i += 4) { *(LAS u32x4v*)(L0 + m * 16 + i) = (u32x4v){top[0][i], top[0][i + 1], top[0][i + 2], top[0][i + 3]}; *(LAS u32x4v*)(L1 + m * 16 + i) = (u32x4v){top[1][i], top[1][i + 1], top[1][i + 2], top[1][i + 3]}; }
        }
        asm volatile("s_waitcnt lgkmcnt(0)" ::: "memory"); __builtin_amdgcn_wave_barrier();
        unsigned cd[16];
#pragma unroll
        for (int c = 0; c < 16; ++c) {
            const unsigned code = (cand_w[c >> 2] >> (8 * (c & 3))) & 0xffu, ci = (code >> 4) & 15u, cj = code & 15u;
            const float v = mono_inv(L0[m * 16 + ci]) + mono_inv(L1[m * 16 + cj]);
            cd[c] = code == 255u ? 0u : ((mono_key(v) & ~0xffu) | (255u - code));
        }
        sort16_desc(cd); merge_quad(cd, l);
        if (g == 0) {
            float best[16]; int ex[16]; float sum = 0.f;
#pragma unroll
            for (int r = 0; r < 16; ++r) { const unsigned pos = 255u - (cd[r] & 0xffu), pi = pos >> 4, pj = pos & 15u;
                ex[r] = (int)((127u - (L0[m * 16 + pi] & 0x7fu)) * 128u + (127u - (L1[m * 16 + pj] & 0x7fu))); best[r] = mono_inv(cd[r]); }
            const float bmax = best[0];
#pragma unroll
            for (int r = 0; r < 16; ++r) { best[r] = __expf(best[r] - bmax); sum += best[r]; }
            const float inv = 1.f / sum;
            const int ob = (trow0 + m) * 128 + head * 16;
#pragma unroll
            for (int r = 0; r < 16; r += 4) { *(LAS u32x4v*)(lexp + ob + r) = (u32x4v){(unsigned)ex[r], (unsigned)ex[r + 1], (unsigned)ex[r + 2], (unsigned)ex[r + 3]};
                *(LAS f32x4*)(lgate + ob + r) = (f32x4){best[r] * inv, best[r + 1] * inv, best[r + 2] * inv, best[r + 3] * inv}; }
        }
        asm volatile("s_waitcnt lgkmcnt(0)" ::: "memory"); __builtin_amdgcn_wave_barrier();
    }
}
typedef float f32x2v __attribute__((ext_vector_type(2)));
#define GRP8_SUM(v) do { v = DPP_ADD(v, 0xB1, 0xf, 0xf); v = DPP_ADD(v, 0x4E, 0xf, 0xf); v = DPP_ADD(v, 0x141, 0xf, 0xf); } while (0)
#ifndef MK_HOT
#define MK_HOT 0
#endif
__device__ __forceinline__ void wave_lds_sync() { asm volatile("s_waitcnt lgkmcnt(0)" ::: "memory"); __builtin_amdgcn_wave_barrier(); }
template <bool DRY>
__device__ __forceinline__ void peer_rounds(const Ctx& C, int layer, int tokw, LAS int* lexp_w, const LAS float* lgate_w, LAS unsigned* sorted_w, LAS unsigned* hist_w) {
    const unsigned char* U = C.ws + WS_U + (size_t)layer * 16384 * 1024; const unsigned char* V = C.ws + WS_V + (size_t)layer * 16384 * 1024;
    const LAS unsigned char* SU = (const LAS unsigned char*)(C.lds + 114688); const LAS unsigned char* SV = SU + 16384;
    const float* gf = C.in[2] + layer * 1024; const float* gn = C.in[1] + (layer + 1) * 1024;
    int l = C.lane; asm volatile("" : "+v"(l));
    LAS float* hbuf = (LAS float*)lexp_w;
    {
        const int t = l >> 3, s = l & 7;
#pragma unroll
        for (int k = 0; k < 8; ++k) hist_w[l + 64 * k] = 0u;
        wave_lds_sync();
        unsigned ev[16], pos[16];
#pragma unroll
        for (int k = 0; k < 16; ++k) { ev[k] = (unsigned)lexp_w[t * 128 + s + 8 * k]; pos[k] = __hip_atomic_fetch_add(hist_w + t * 64 + (ev[k] >> 8), 1u, __ATOMIC_RELAXED, __HIP_MEMORY_SCOPE_WORKGROUP); }
        wave_lds_sync();
        unsigned cnt[8], run = 0u;
#pragma unroll
        for (int j = 0; j < 8; ++j) { cnt[j] = hist_w[t * 64 + 8 * s + j]; run += cnt[j]; }
        unsigned inc = run;
#pragma unroll
        for (int o = 1; o < 8; o <<= 1) { const unsigned up = (unsigned)__builtin_amdgcn_ds_bpermute((l - o) << 2, (int)inc); if (s >= o) inc += up; }
        unsigned off = inc - run;
        wave_lds_sync();
#pragma unroll
        for (int j = 0; j < 8; ++j) { hist_w[t * 64 + 8 * s + j] = off; off += cnt[j]; }
        wave_lds_sync();
#pragma unroll
        for (int k = 0; k < 16; ++k) sorted_w[t * 128 + hist_w[t * 64 + (ev[k] >> 8)] + pos[k]] = (ev[k] << 7) | (unsigned)(s + 8 * k);
        wave_lds_sync();
    }
    asm volatile("" : "+v"(l));
    unsigned xh[8][4], xl[8][4]; float xs1, xs2;
    {
        unsigned xp[8][8];
        const int t = l >> 3, s = l & 7;
        const bf16* hrow = (const bf16*)(C.ws + WS_HB) + (size_t)(tokw + t) * 1024 + 16 * s;
        float ss = 0.f;
#pragma unroll
        for (int i = 0; i < 8; ++i) { const v4u a = *(const GAS v4u*)(hrow + 128 * i), b = *(const GAS v4u*)(hrow + 128 * i + 8);
            xp[i][0] = a.x; xp[i][1] = a.y; xp[i][2] = a.z; xp[i][3] = a.w; xp[i][4] = b.x; xp[i][5] = b.y; xp[i][6] = b.z; xp[i][7] = b.w;
#pragma unroll
            for (int j = 0; j < 8; ++j) { const float lo = bflo(xp[i][j]), hi = bfhi(xp[i][j]); ss += lo * lo + hi * hi; } }
        GRP8_SUM(ss);
        const float r = rsqrtf(ss * (1.f / 1024.f) + RMS_EPS);
#pragma unroll
        for (int i = 0; i < 8; ++i)
#pragma unroll
            for (int q = 0; q < 4; ++q) { const f32x4 a = *(const GAS f32x4*)(gf + 16 * s + 128 * i + 4 * q);
                xp[i][2 * q] = pk2(bflo(xp[i][2 * q]) * r * a.x, bfhi(xp[i][2 * q]) * r * a.y); xp[i][2 * q + 1] = pk2(bflo(xp[i][2 * q + 1]) * r * a.z, bfhi(xp[i][2 * q + 1]) * r * a.w); }
        float am = 0.f;
#pragma unroll
        for (int i = 0; i < 8; ++i)
#pragma unroll
            for (int j = 0; j < 8; ++j) am = fmaxf(am, fmaxf(fabsf(bflo(xp[i][j])), fabsf(bfhi(xp[i][j]))));
        am = DPP_MAX(am, 0xB1, 0xf, 0xf); am = DPP_MAX(am, 0x4E, 0xf, 0xf); am = DPP_MAX(am, 0x141, 0xf, 0xf);
        const float inv1 = am > 0.f ? 127.f / am : 0.f, inv2 = 254.f * inv1; xs1 = am * (1.f / 127.f); xs2 = xs1 * (1.f / 254.f);
#pragma unroll
        for (int i = 0; i < 8; ++i)
#pragma unroll
            for (int q = 0; q < 4; ++q) { const float x0 = bflo(xp[i][2 * q]), x1 = bfhi(xp[i][2 * q]), x2 = bflo(xp[i][2 * q + 1]), x3 = bfhi(xp[i][2 * q + 1]);
                const float q0 = __builtin_rintf(x0 * inv1), q1 = __builtin_rintf(x1 * inv1), q2 = __builtin_rintf(x2 * inv1), q3 = __builtin_rintf(x3 * inv1);
                xh[i][q] = q8x4(q0, q1, q2, q3); xl[i][q] = q8x4((x0 - q0 * xs1) * inv2, (x1 - q1 * xs1) * inv2, (x2 - q2 * xs1) * inv2, (x3 - q3 * xs1) * inv2); }
    }
    asm volatile("" : "+v"(l));
#define RND_LOAD(T, buf, item) do { const unsigned char* p_ = T + (size_t)((DRY && MK_HOT) ? (((item) >> 7) & 255u) : ((item) >> 7)) * 1024 + 16 * (l & 7); \
        _Pragma("unroll") for (int i = 0; i < 8; ++i) buf[i] = *(const GAS v4u*)(p_ + 128 * i); } while (0)
    {
        const int t = l >> 3, s = l & 7;
        const LAS unsigned* srt = sorted_w + t * 128;
        v4u bA[8], bB[8];
#define RND_DOT(buf, r_) do { int dh = 0, dl = 0; \
            _Pragma("unroll") for (int i = 0; i < 8; ++i) { _Pragma("unroll") for (int q = 0; q < 4; ++q) { \
                dh = __builtin_amdgcn_sdot4((int)buf[i][q], (int)xh[i][q], dh, false); dl = __builtin_amdgcn_sdot4((int)buf[i][q], (int)xl[i][q], dl, false); } } \
            float d = (float)dh * xs1 + (float)dl * xs2; \
            GRP8_SUM(d); if (s == 0) hbuf[t * 128 + (r_)] = d; } while (0)
        RND_LOAD(U, bA, srt[0]);
#pragma unroll 1
        for (int r = 0; r < 128; r += 2) {
            RND_LOAD(U, bB, srt[r + 1]);
            RND_DOT(bA, r);
            RND_LOAD(U, bA, srt[(r + 2) & 127]);
            RND_DOT(bB, r + 1);
        }
#undef RND_DOT
    }
    wave_lds_sync();
    asm volatile("" : "+v"(l));
    {
        const int t = l >> 3, s = l & 7;
#pragma unroll
        for (int k = 0; k < 16; k += 2) {
            const int r0 = t * 128 + s + 8 * k, r1 = r0 + 8;
            const unsigned i0 = sorted_w[r0], i1 = sorted_w[r1];
            const float h0 = hbuf[r0] * __uint_as_float((unsigned)SU[i0 >> 7] << 23), h1 = hbuf[r1] * __uint_as_float((unsigned)SU[i1 >> 7] << 23);
            const pg8::f32x2 gl = pg8::gelu_pk((pg8::f32x2){h0, h1});
            hbuf[r0] = gl.x * lgate_w[t * 128 + (i0 & 127u)] * __uint_as_float((unsigned)SV[i0 >> 7] << 23); hbuf[r1] = gl.y * lgate_w[t * 128 + (i1 & 127u)] * __uint_as_float((unsigned)SV[i1 >> 7] << 23);
        }
    }
    wave_lds_sync();
    asm volatile("" : "+v"(l));
    f32x2v y2[8][8];
#pragma unroll
    for (int i = 0; i < 8; ++i)
#pragma unroll
        for (int j = 0; j < 8; ++j) y2[i][j] = (f32x2v){0.f, 0.f};
    {
        const int t = l >> 3;
        const LAS unsigned* srt = sorted_w + t * 128; const LAS float* wv = hbuf + t * 128;
        v4u bA[8], bB[8];
#define RND_AXPY(buf, r_) do { const float w = wv[(r_)]; const f32x2v w2 = (f32x2v){w, w}; \
            _Pragma("unroll") for (int i = 0; i < 8; ++i) { asm volatile("" : "+v"(buf[i])); _Pragma("unroll") for (int q = 0; q < 4; ++q) { \
                const f32x2v lo_ = __builtin_amdgcn_cvt_pk_f32_fp8((int)buf[i][q], false), hi_ = __builtin_amdgcn_cvt_pk_f32_fp8((int)buf[i][q], true); \
                y2[i][2 * q] = w2 * lo_ + y2[i][2 * q]; y2[i][2 * q + 1] = w2 * hi_ + y2[i][2 * q + 1]; } } } while (0)
        RND_LOAD(V, bA, srt[0]);
#pragma unroll 1
        for (int r = 0; r < 128; r += 2) {
            RND_LOAD(V, bB, srt[r + 1]);
            RND_AXPY(bA, r);
            RND_LOAD(V, bA, srt[(r + 2) & 127]);
            RND_AXPY(bB, r + 1);
        }
#undef RND_AXPY
    }
#undef RND_LOAD
    asm volatile("" : "+v"(l));
    {
        const int t = l >> 3, s = l & 7;
        const bf16* hrow = (const bf16*)(C.ws + WS_HB) + (size_t)(tokw + t) * 1024 + 16 * s;
        float* hout = (DRY ? (float*)(C.ws + WS_OF) : C.out) + (size_t)(tokw + t) * 1024 + 16 * s;
        bf16* hb = (bf16*)(C.ws + (DRY ? WS_OF : WS_HB)) + (size_t)(tokw + t) * 1024 + 16 * s;
        float s2 = 0.f;
#pragma unroll
        for (int i = 0; i < 8; ++i) { const v4u a = *(const GAS v4u*)(hrow + 128 * i), b = *(const GAS v4u*)(hrow + 128 * i + 8);
            const unsigned hw[8] = {a.x, a.y, a.z, a.w, b.x, b.y, b.z, b.w};
#pragma unroll
            for (int j = 0; j < 8; ++j) { y2[i][j].x += bflo(hw[j]); y2[i][j].y += bfhi(hw[j]); s2 += y2[i][j].x * y2[i][j].x + y2[i][j].y * y2[i][j].y; }
            if (layer == DEPTH - 1) {
#pragma unroll
                for (int q = 0; q < 4; ++q) *(GAS f32x4*)(hout + 128 * i + 4 * q) = (f32x4){y2[i][2 * q].x, y2[i][2 * q].y, y2[i][2 * q + 1].x, y2[i][2 * q + 1].y};
            } else {
                *(GAS v4u*)(hb + 128 * i) = (v4u){pk2(y2[i][0].x, y2[i][0].y), pk2(y2[i][1].x, y2[i][1].y), pk2(y2[i][2].x, y2[i][2].y), pk2(y2[i][3].x, y2[i][3].y)};
                *(GAS v4u*)(hb + 128 * i + 8) = (v4u){pk2(y2[i][4].x, y2[i][4].y), pk2(y2[i][5].x, y2[i][5].y), pk2(y2[i][6].x, y2[i][6].y), pk2(y2[i][7].x, y2[i][7].y)};
            } }
        if (layer < DEPTH - 1) {
            GRP8_SUM(s2);
            const float r2 = rsqrtf(s2 * (1.f / 1024.f) + RMS_EPS);
            const bool wx8 = ((I8MASK >> (layer + 1)) & 1) != 0, wxn = ((layer + 1) % 3 != 2) || !wx8;
            bf16* xo = (bf16*)(C.ws + (DRY ? WS_GLOG : WS_XN)) + (size_t)(tokw + t) * 1024 + 16 * s; float am = 0.f;
#pragma unroll
            for (int i = 0; i < 8; ++i) { unsigned pw[8];
#pragma unroll
                for (int q = 0; q < 4; ++q) { const f32x4 a = *(const GAS f32x4*)(gn + 16 * s + 128 * i + 4 * q);
                    y2[i][2 * q].x *= r2 * a.x; y2[i][2 * q].y *= r2 * a.y; y2[i][2 * q + 1].x *= r2 * a.z; y2[i][2 * q + 1].y *= r2 * a.w;
                    am = fmaxf(fmaxf(am, fmaxf(fabsf(y2[i][2 * q].x), fabsf(y2[i][2 * q].y))), fmaxf(fabsf(y2[i][2 * q + 1].x), fabsf(y2[i][2 * q + 1].y)));
                    pw[2 * q] = pk2(y2[i][2 * q].x, y2[i][2 * q].y); pw[2 * q + 1] = pk2(y2[i][2 * q + 1].x, y2[i][2 * q + 1].y); }
                if (wxn) { *(GAS v4u*)(xo + 128 * i) = (v4u){pw[0], pw[1], pw[2], pw[3]}; *(GAS v4u*)(xo + 128 * i + 8) = (v4u){pw[4], pw[5], pw[6], pw[7]}; } }
            if (wx8) {
            am = DPP_MAX(am, 0xB1, 0xf, 0xf); am = DPP_MAX(am, 0x4E, 0xf, 0xf); am = DPP_MAX(am, 0x141, 0xf, 0xf);
            const float qi = am > 0.f ? 127.f / am : 0.f;
            signed char* xq = (signed char*)(C.ws + (DRY ? WS_GLOG + 32 * MiB : WS_XN8)) + (size_t)(tokw + t) * 1024 + 16 * s;
#pragma unroll
            for (int i = 0; i < 8; ++i) { unsigned pq[4];
#pragma unroll
                for (int q = 0; q < 4; ++q) pq[q] = q8x4(y2[i][2 * q].x * qi, y2[i][2 * q].y * qi, y2[i][2 * q + 1].x * qi, y2[i][2 * q + 1].y * qi);
                *(GAS v4u*)(xq + 128 * i) = (v4u){pq[0], pq[1], pq[2], pq[3]}; }
            if (s == 0) *(GAS float*)((float*)(C.ws + (DRY ? WS_GLOG + 48 * MiB : WS_SX)) + tokw + t) = am * (1.f / 127.f);
            }
        }
    }
}
#ifndef MK_SWEEP
#define MK_SWEEP 2
#endif
template <bool DRY>
__device__ __forceinline__ void peer_topk_gather(const Ctx& C, int layer) {
    LAS int* lexp = (LAS int*)(C.lds + 16384);
    LAS float* lgate = (LAS float*)(C.lds + 16384 + 32768);
    LAS unsigned* sorted = (LAS unsigned*)(C.lds + 16384 + 65536);
    {
        int tid = C.tid; asm volatile("" : "+v"(tid));
        const v4u a0 = *(const GAS v4u*)(C.ws + WS_SU + (size_t)layer * 16384 + tid * 32), a1 = *(const GAS v4u*)(C.ws + WS_SU + (size_t)layer * 16384 + tid * 32 + 16);
        const v4u b0 = *(const GAS v4u*)(C.ws + WS_SV + (size_t)layer * 16384 + tid * 32), b1 = *(const GAS v4u*)(C.ws + WS_SV + (size_t)layer * 16384 + tid * 32 + 16);
        LAS unsigned char* lsc = C.lds + 114688;
        *(LAS v4u*)(lsc + tid * 32) = a0; *(LAS v4u*)(lsc + tid * 32 + 16) = a1; *(LAS v4u*)(lsc + 16384 + tid * 32) = b0; *(LAS v4u*)(lsc + 16384 + tid * 32 + 16) = b1;
    }
    for (int tb = C.vcu; tb < NTOK / 64; tb += C.G) {
        {
            h8 hva[2][4], hvb[2][4];
            const int tk0 = tb * 64 + (C.wave & 3) * 16, hd0 = (C.wave >> 2) * 4, tr0 = (C.wave & 3) * 16;
            peer_topk_load(C, tk0, hd0, hva);
#pragma unroll 1
            for (int q = 0; q < 4; q += 2) {
                peer_topk_load(C, tk0, hd0 + q + 1, hvb);
                peer_topk_task(C, layer, tk0, hd0 + q, tr0, lexp, lgate, hva);
                if (q + 2 < 4) peer_topk_load(C, tk0, hd0 + q + 2, hva);
                peer_topk_task(C, layer, tk0, hd0 + q + 1, tr0, lexp, lgate, hvb);
            }
        }
        __syncthreads();
#if MK_SWEEP == 2
        peer_rounds<DRY>(C, layer, tb * 64 + C.wave * 8, lexp + C.wave * 1024, lgate + C.wave * 1024, sorted + C.wave * 1024, (LAS unsigned*)(C.lds + C.wave * 2048));
#elif MK_SWEEP == 1
#error removed variant
        peer_sweep<DRY>(C, layer, tb * 64 + C.wave * 8, lexp + C.wave * 1024, lgate + C.wave * 1024, sorted + C.wave * 1024, (LAS unsigned*)(C.lds + C.wave * 1024));
#else
#pragma unroll 1
        for (int t = 0; t < 8; ++t) peer_gather_token<DRY>(C, layer, tb * 64 + C.wave * 8 + t, lexp + (C.wave * 8 + t) * 128, lgate + (C.wave * 8 + t) * 128);
#endif
        __syncthreads();
    }
}

#ifndef MK_SINGLE
#define MK_SINGLE 1
#endif
#ifndef MK_FASTGEMM
#define MK_FASTGEMM 1
#endif
constexpr int STEPS = 10, NPHASE = 1 + DEPTH * STEPS;
struct Args { const float* in[21]; float* out; unsigned char* ws; int ph_lo, ph_hi; };

template <int EPI>
__device__ __forceinline__ void do_gemm(const Ctx& C, const bf16* A, const bf16* Bt, int N, bf16* Ob, int ldc, int split, const float* rs_in, const float* base, float* outf, bf16* hg, const float* gain, float* rs_out) {
    pg8::Gemm g{A, Bt, NTOK, N, 1024}; pg8::StaticOrder S; S.init(NTOK, N, C.G, C.bx);
    if constexpr (EPI == 0) { pg8::EpiBf16R<false> E{Ob, ldc, split ? 1024 : 0, PSTRIDE, rs_in}; pg8::gemm_phase<pg8::EpiBf16R<false>, pg8::StaticOrder, true, true>(C.lds, g, S, E, C.tid); }
    else if constexpr (EPI == 2) { pg8::EpiBf16R<true> E{Ob, ldc, 0, PSTRIDE, rs_in}; pg8::gemm_phase<pg8::EpiBf16R<true>, pg8::StaticOrder, true, true>(C.lds, g, S, E, C.tid); }
    else if constexpr (EPI == 3) {
        pg8::Gemm g8{A, Bt, NTOK, N, 512}; pg8::EpiI8<false> E{Ob, PSTRIDE, rs_in, gain, nullptr, nullptr, 1.f}; pg8::gemm_phase<pg8::EpiI8<false>, pg8::StaticOrder, true, true>(C.lds, g8, S, E, C.tid); }
    else if constexpr (EPI == 4) {
        pg8::Gemm g8{A, Bt, NTOK, N, 512}; pg8::EpiI8<true> E{Ob, PSTRIDE, rs_in, gain, base, (const float*)outf, FOX_C2}; pg8::gemm_phase<pg8::EpiI8<true>, pg8::StaticOrder, true, true>(C.lds, g8, S, E, C.tid); }
    else {
        bf16* HB = (bf16*)(C.ws + WS_HB); (void)outf;
        if (base) { pg8::EpiResNorm<false> E{base, HB, hg, gain, rs_out}; pg8::gemm_phase<pg8::EpiResNorm<false>, pg8::StaticOrder, true, true>(C.lds, g, S, E, C.tid); }
        else { pg8::EpiResNorm<true> E{HB, HB, hg, gain, rs_out}; pg8::gemm_phase<pg8::EpiResNorm<true>, pg8::StaticOrder, true, true>(C.lds, g, S, E, C.tid); } }
}

template <int STEP, int MIXER>
__device__ __forceinline__ void run_step(const Ctx& C, int layer) {
    const int jx = layer / 3;
    bf16* XN = (bf16*)(C.ws + WS_XN); bf16* P = (bf16*)(C.ws + WS_P); bf16* OB = (bf16*)(C.ws + WS_OB); bf16* Q2 = (bf16*)(C.ws + WS_Q2);
    if constexpr (STEP == 0) {
        const bf16* Wt = MIXER == 0 ? (const bf16*)(C.ws + WS_FOXWIN + (size_t)jx * 8 * MiB) : MIXER == 1 ? (const bf16*)(C.ws + WS_GLAWIN) : (const bf16*)(C.ws + WS_HGRNWIN);
        const float* sw = (const float*)(C.ws + WS_SW) + (MIXER == 0 ? jx * 4096 : MIXER == 1 ? 8192 : 11264);
        if (FOXFUSE && MIXER == 0) { do_gemm<4>(C, (const bf16*)(C.ws + WS_XN8), Wt, 4096, P, 1024, 1, (const float*)(C.ws + WS_SX), C.in[5] + jx * 64, (float*)(C.in[6] + jx * 64), nullptr, sw, nullptr); fox_step1<false>(C, jx); }
        else if ((I8MASK >> layer) & 1) do_gemm<3>(C, (const bf16*)(C.ws + WS_XN8), Wt, MIXER == 1 ? 3072 : 4096, P, 1024, 1, (const float*)(C.ws + WS_SX), nullptr, nullptr, nullptr, sw, nullptr);
        else do_gemm<0>(C, XN, Wt, MIXER == 1 ? 3072 : 4096, P, 1024, 1, nullptr, nullptr, nullptr, nullptr, nullptr, nullptr);
    } else if constexpr (STEP == 1) {
        if constexpr (MIXER == 0) { if (!FOXFUSE) fox_step1<true>(C, jx); }
    } else if constexpr (STEP == 2) {
        if constexpr (MIXER == 1) chunk_prepass<4>(C); else if constexpr (MIXER == 2) chunk_prepass<8>(C);
    } else if constexpr (STEP == 3) {
        if constexpr (MIXER == 0) {
            float gq = 0.f, gk = 0.f;
            for (int i = 0; i < 64; ++i) { gq = fmaxf(gq, fabsf(C.in[5][jx * 64 + i])); gk = fmaxf(gk, fabsf(C.in[6][jx * 64 + i])); }
            const float smax = 64.f * gq * gk * 0.125f * 1.4426950408889634f;
            const attn_body::AttnTensors AT{(const attn_body::bf16*)P, (const attn_body::bf16*)(P + PSTRIDE), (const attn_body::bf16*)(P + 2 * PSTRIDE), (attn_body::bf16*)OB, (const attn_body::bf16*)(P + 3 * PSTRIDE), (const float*)(C.ws + WS_TAIL), -(56.f + 2.f * smax)};
            const attn_body::StaticOrder S(C.G, C.bx);
            attn_body::attn_phase<attn_body::StaticOrder>((char*)C.lds, AT, S, C.tid);
        }
        else if constexpr (MIXER == 1) chunk_recur2<4, 256>(C, P + PSTRIDE);
        else chunk_recur2<8, 128>(C, P + 2 * PSTRIDE);
    } else if constexpr (STEP == 4) {
        if constexpr (MIXER == 1) rec_norm_gate<256>(C, C.in[11], P + 2 * PSTRIDE);
        else if constexpr (MIXER == 2) rec_norm_gate<128>(C, C.in[15], P + 3 * PSTRIDE);
    } else if constexpr (STEP == 5) {
        const bf16* Wt = MIXER == 0 ? (const bf16*)(C.ws + WS_FOXWOUT) + (size_t)jx * 1024 * 1024 : MIXER == 1 ? (const bf16*)(C.ws + WS_GLAWOUT) : (const bf16*)(C.ws + WS_HGRNWOUT);
        do_gemm<1>(C, OB, Wt, 1024, nullptr, 0, 0, nullptr, layer == 0 ? C.in[0] : nullptr, nullptr, XN, C.in[2] + layer * 1024, (float*)(C.ws + WS_RS));
    } else if constexpr (STEP == 6) {
    } else if constexpr (STEP == 7) {
        do_gemm<2>(C, XN, (const bf16*)(C.ws + WS_PEERWQ) + (size_t)layer * 2048 * 1024, 2048, Q2, 2048, 0, (const float*)(C.ws + WS_RS), nullptr, nullptr, nullptr, nullptr, nullptr);
    } else if constexpr (STEP == 8) {
        peer_topk_gather<false>(C, layer);
    } else if constexpr (STEP == 9) {
    } else if constexpr (STEP == 11) {
        peer_topk_gather<true>(C, layer);
    } else if constexpr (STEP == 12) {
        p0_prologue_b(C);
    } else {
        p0_prologue(C);
    }
}

__device__ __forceinline__ void make_ctx(Ctx& C, const Args& args, unsigned char* lds_raw) {
    C.lds = (LAS unsigned char*)lds_raw;
    C.tid = threadIdx.x; C.lane = C.tid & 63; C.wave = __builtin_amdgcn_readfirstlane(C.tid >> 6);
    C.G = gridDim.x; C.bx = blockIdx.x; { const int bx = blockIdx.x; C.vcu = (C.G % 8 == 0) ? (bx % 8) * (C.G / 8) + bx / 8 : bx; }
    C.gw = C.vcu * NWAVES + C.wave; C.NGW = C.G * NWAVES;
#pragma unroll
    for (int i = 0; i < 21; ++i) C.in[i] = args.in[i];
    C.out = args.out; C.ws = args.ws;
}

template <int STEP, int MIXER>
__global__ void __launch_bounds__(NWAVES * 64, 2) mk_phase(Args args, int layer) {
    extern __shared__ __attribute__((aligned(16))) unsigned char lds_raw[];
    Ctx C; make_ctx(C, args, lds_raw);
    run_step<STEP, MIXER>(C, layer);
}

template <int STEP, int MIXER>
static void launch_phase(const Args& a, int layer, int grid, hipStream_t stream) {
    static bool attr_set = false;
    if (!attr_set) { (void)hipFuncSetAttribute((const void*)mk_phase<STEP, MIXER>, hipFuncAttributeMaxDynamicSharedMemorySize, LDS_BYTES); attr_set = true; }
    hipLaunchKernelGGL((mk_phase<STEP, MIXER>), dim3(grid), dim3(NWAVES * 64), LDS_BYTES, stream, a, layer);
}
#ifndef MK_DUP
#define MK_DUP -1
#endif
#define LP(S, M) do { launch_phase<S, M>(a, layer, grid, stream); if (MK_DUP == S) launch_phase<(S == 8 ? 11 : S), M>(a, layer, grid, stream); } while (0)
template <int MIXER>
static void launch_layer(const Args& a, int layer, int grid, hipStream_t stream) {
    LP(0, MIXER);
    if (MIXER == 0) launch_phase<1, MIXER>(a, layer, grid, stream); else LP(2, MIXER);
    LP(3, MIXER);
    if (MIXER != 0) LP(4, MIXER);
    LP(5, MIXER);
    LP(7, 0);
    LP(8, 0);
}
#if MK_SINGLE
__device__ __forceinline__ const float* tab_ptr(volatile LAS unsigned long long* tab, int i) {
    const unsigned long long v = tab[i];
    const unsigned lo = __builtin_amdgcn_readfirstlane((unsigned)v), hi = __builtin_amdgcn_readfirstlane((unsigned)(v >> 32));
    return (const float*)(const GAS float*)(((unsigned long long)hi << 32) | lo);
}
__device__ __forceinline__ int lane_id_volatile() { int x; asm volatile("v_mbcnt_lo_u32_b32 %0, -1, 0\n\tv_mbcnt_hi_u32_b32 %0, -1, %0" : "=v"(x)); return x; }
__device__ __forceinline__ void make_ctx_opaque(Ctx& C, unsigned char* lds_raw, int wave_s) {
    int bx = blockIdx.x, G = gridDim.x; unsigned ldso = 0u;
    asm volatile("" : "+s"(bx), "+s"(G), "+s"(ldso), "+s"(wave_s));
    int tid = wave_s * 64 + lane_id_volatile();
    C.lds = (LAS unsigned char*)lds_raw + ldso;
    volatile LAS unsigned long long* tab = (volatile LAS unsigned long long*)(C.lds + LDSCTL_OFF);
    C.tid = tid; C.lane = tid & 63; C.wave = __builtin_amdgcn_readfirstlane(tid >> 6);
    C.G = G; C.bx = bx; C.vcu = (G % 8 == 0) ? (bx % 8) * (G / 8) + bx / 8 : bx;
    C.gw = C.vcu * NWAVES + C.wave; C.NGW = G * NWAVES;
#pragma unroll
    for (int i = 0; i < 21; ++i) C.in[i] = tab_ptr(tab, i);
    C.out = (float*)tab_ptr(tab, 21); C.ws = (unsigned char*)tab_ptr(tab, 22);
}
__device__ __forceinline__ void grid_bar(unsigned char* lds_raw, int wave_s) {
    unsigned ldso = 0u; asm volatile("" : "+s"(ldso), "+s"(wave_s));
    LAS unsigned char* lds = (LAS unsigned char*)lds_raw + ldso;
    volatile LAS unsigned long long* tab = (volatile LAS unsigned long long*)(lds + LDSCTL_OFF);
    XcdBarrier b; b.bar = (unsigned*)((unsigned char*)tab_ptr(tab, 22) + WS_CTL) + CW_BAR; b.x = xb_xcc_id(); b.st = (volatile LAS unsigned*)(lds + MISC_OFF) + 8;
    xcd_barrier(b, wave_s == 0 && lane_id_volatile() == 0);
}
#define MK_STEP(...) do { Ctx C; make_ctx_opaque(C, lds_raw, wave_s); __VA_ARGS__; } while (0)
__global__ void __launch_bounds__(NWAVES * 64, 2) mk_fwd(Args args) {
    extern __shared__ __attribute__((aligned(16))) unsigned char lds_raw[];
    const int wave_s = __builtin_amdgcn_readfirstlane(threadIdx.x >> 6);
    for (int u = threadIdx.x; u < (LDS_BYTES - LDSCTL_OFF) / 4; u += NWAVES * 64) ((LAS unsigned*)((LAS unsigned char*)lds_raw + LDSCTL_OFF))[u] = 0u;
    __syncthreads();
    if (threadIdx.x == 0) {
        LAS unsigned long long* tab = (LAS unsigned long long*)((LAS unsigned char*)lds_raw + LDSCTL_OFF);
#pragma unroll
        for (int i = 0; i < 21; ++i) tab[i] = (unsigned long long)args.in[i];
        tab[21] = (unsigned long long)args.out; tab[22] = (unsigned long long)args.ws;
    }
    (void)xcd_barrier_post((unsigned*)(args.ws + WS_CTL) + CW_BAR, (volatile LAS unsigned*)((LAS unsigned char*)lds_raw + MISC_OFF) + 8);
    __syncthreads();
    MK_STEP(p0_prologue(C));
    if (I8_NITEMS) { grid_bar(lds_raw, wave_s); MK_STEP(p0_prologue_b(C)); }
    cg::this_grid().sync();
#pragma unroll 1
    for (int layer = 0; layer < DEPTH; ++layer) {
        const int mixer = layer % 3, jx = layer / 3;
        MK_STEP(const bf16* Wt = mixer == 0 ? (const bf16*)(C.ws + WS_FOXWIN + (size_t)jx * 8 * MiB) : mixer == 1 ? (const bf16*)(C.ws + WS_GLAWIN) : (const bf16*)(C.ws + WS_HGRNWIN);
                const float* sw = (const float*)(C.ws + WS_SW) + (mixer == 0 ? jx * 4096 : mixer == 1 ? 8192 : 11264);
                if (FOXFUSE && mixer == 0) { do_gemm<4>(C, (const bf16*)(C.ws + WS_XN8), Wt, 4096, (bf16*)(C.ws + WS_P), 1024, 1, (const float*)(C.ws + WS_SX), C.in[5] + jx * 64, (float*)(C.in[6] + jx * 64), nullptr, sw, nullptr);
                    fox_step1<false>(C, jx); }
                else if (I8MASK == 15 || (I8MASK != 0 && ((I8MASK >> layer) & 1))) do_gemm<3>(C, (const bf16*)(C.ws + WS_XN8), Wt, mixer == 1 ? 3072 : 4096, (bf16*)(C.ws + WS_P), 1024, 1, (const float*)(C.ws + WS_SX), nullptr, nullptr, nullptr, sw, nullptr);
                else do_gemm<0>(C, (const bf16*)(C.ws + WS_XN), Wt, mixer == 1 ? 3072 : 4096, (bf16*)(C.ws + WS_P), 1024, 1, nullptr, nullptr, nullptr, nullptr, nullptr, nullptr));
        grid_bar(lds_raw, wave_s);
#if GPROBE == 1
        MK_STEP(const bf16* Wt = mixer == 0 ? (const bf16*)(C.ws + WS_FOXWIN + (size_t)jx * 8 * MiB) : mixer == 1 ? (const bf16*)(C.ws + WS_GLAWIN) : (const bf16*)(C.ws + WS_HGRNWIN);
                const float* sw = (const float*)(C.ws + WS_SW) + (mixer == 0 ? jx * 4096 : mixer == 1 ? 8192 : 11264);
                if (FOXFUSE && mixer == 0) { do_gemm<4>(C, (const bf16*)(C.ws + WS_XN8), Wt, 4096, (bf16*)(C.ws + WS_P), 1024, 1, (const float*)(C.ws + WS_SX), C.in[5] + jx * 64, (float*)(C.in[6] + jx * 64), nullptr, sw, nullptr);
                    fox_step1<false>(C, jx); }
                else if (I8MASK == 15 || (I8MASK != 0 && ((I8MASK >> layer) & 1))) do_gemm<3>(C, (const bf16*)(C.ws + WS_XN8), Wt, mixer == 1 ? 3072 : 4096, (bf16*)(C.ws + WS_P), 1024, 1, (const float*)(C.ws + WS_SX), nullptr, nullptr, nullptr, sw, nullptr);
                else do_gemm<0>(C, (const bf16*)(C.ws + WS_XN), Wt, mixer == 1 ? 3072 : 4096, (bf16*)(C.ws + WS_P), 1024, 1, nullptr, nullptr, nullptr, nullptr, nullptr, nullptr));
        grid_bar(lds_raw, wave_s);
#endif
        if (!(FOXFUSE && mixer == 0)) {
        MK_STEP(if (mixer == 0) run_step<1, 0>(C, layer); else if (mixer == 1) run_step<2, 1>(C, layer); else run_step<2, 2>(C, layer));
        grid_bar(lds_raw, wave_s); }
        MK_STEP(if (mixer == 0) run_step<3, 0>(C, layer); else if (mixer == 1) run_step<3, 1>(C, layer); else run_step<3, 2>(C, layer));
        grid_bar(lds_raw, wave_s);
#if RPROBE
        if (mixer != 0) { MK_STEP(if (mixer == 1) chunk_recur<4, 256, RPROBE>(C, (const bf16*)(C.ws + WS_P) + PSTRIDE); else chunk_recur<8, 128, RPROBE>(C, (const bf16*)(C.ws + WS_P) + 2 * PSTRIDE)); grid_bar(lds_raw, wave_s); }
#endif
        if (mixer != 0) { MK_STEP(if (mixer == 1) run_step<4, 1>(C, layer); else run_step<4, 2>(C, layer)); grid_bar(lds_raw, wave_s); }
        MK_STEP(const bf16* Wt = mixer == 0 ? (const bf16*)(C.ws + WS_FOXWOUT) + (size_t)jx * 1024 * 1024 : mixer == 1 ? (const bf16*)(C.ws + WS_GLAWOUT) : (const bf16*)(C.ws + WS_HGRNWOUT);
                do_gemm<1>(C, (const bf16*)(C.ws + WS_OB), Wt, 1024, nullptr, 0, 0, nullptr, layer == 0 ? C.in[0] : nullptr, nullptr, (bf16*)(C.ws + WS_XN), C.in[2] + layer * 1024, (float*)(C.ws + WS_RS)));
        grid_bar(lds_raw, wave_s);
        MK_STEP(run_step<7, 0>(C, layer));
        grid_bar(lds_raw, wave_s);
#if GPROBE == 7
        MK_STEP(run_step<7, 0>(C, layer));
        grid_bar(lds_raw, wave_s);
#endif
        MK_STEP(run_step<8, 0>(C, layer));
        if (layer + 1 < DEPTH) grid_bar(lds_raw, wave_s);
    }
}
#endif

extern "C" void kernel_launch(void* const* d_in, const int* in_sizes, int n_in, void* d_out, int out_size, void* d_ws, size_t ws_size, hipStream_t stream) {
    static int grid = 0;
    if (grid == 0) {
        if (n_in != 21 || out_size != NTOK * 1024 || ws_size < WS_END) { fprintf(stderr, "kernel_launch: unexpected shapes: n_in %d out %d ws %zu (need %zu)\n", n_in, out_size, ws_size, (size_t)WS_END); grid = -1; return; }
        int dev = 0, cus = 0, per_cu = 0;
        (void)hipGetDevice(&dev); (void)hipDeviceGetAttribute(&cus, hipDeviceAttributeMultiprocessorCount, dev);
#if MK_SINGLE
        if (hipFuncSetAttribute((const void*)mk_fwd, hipFuncAttributeMaxDynamicSharedMemorySize, LDS_BYTES) != hipSuccess) { fprintf(stderr, "kernel_launch: hipFuncSetAttribute failed\n"); grid = -1; return; }
        if (hipOccupancyMaxActiveBlocksPerMultiprocessor(&per_cu, (const void*)mk_fwd, NWAVES * 64, LDS_BYTES) != hipSuccess || per_cu < 1) { fprintf(stderr, "kernel_launch: occupancy query says %d blocks per CU\n", per_cu); (void)hipGetLastError(); grid = -1; return; }
#endif
        (void)per_cu;
        grid = cus;
    }
    if (grid < 0) return;
    Args a{};
    for (int i = 0; i < 21; ++i) a.in[i] = (const float*)d_in[i];
    a.out = (float*)d_out; a.ws = (unsigned char*)d_ws;
#if MK_SINGLE
    (void)hipMemsetAsync((char*)d_ws + WS_CTL, 0, CTL_ZERO_BYTES, stream);
    a.ph_lo = 0; a.ph_hi = NPHASE;
    void* kargs[] = {&a};
    hipError_t e = hipLaunchCooperativeKernel((const void*)mk_fwd, dim3(grid), dim3(NWAVES * 64), kargs, LDS_BYTES, stream);
    if (e != hipSuccess) fprintf(stderr, "cooperative launch failed: %s (grid %d)\n", hipGetErrorString(e), grid);
#else
    (void)hipMemsetAsync((char*)d_ws + WS_CTL, 0, CTL_ZERO_BYTES, stream);
    launch_phase<10, 0>(a, 0, grid, stream); if (MK_DUP == 10) launch_phase<10, 0>(a, 0, grid, stream);
    launch_phase<12, 0>(a, 0, grid, stream);
    launch_layer<0>(a, 0, grid, stream);
    launch_layer<1>(a, 1, grid, stream);
    launch_layer<2>(a, 2, grid, stream);
    launch_layer<0>(a, 3, grid, stream);
#endif
}
```

```cpp
#include <hip/hip_runtime.h>
#include <hip/hip_cooperative_groups.h>
#include <cstdio>
#include <cstdint>
#include <cmath>
namespace pg8 {
#define PG8_LAS __attribute__((address_space(3)))
typedef unsigned short bf16_t;
typedef short bf16x8 __attribute__((ext_vector_type(8)));
typedef float f32x4 __attribute__((ext_vector_type(4)));
typedef unsigned u32x4 __attribute__((ext_vector_type(4)));
typedef int i32x4 __attribute__((ext_vector_type(4)));
constexpr int BM = 256, BK = 64, HALF = 128, HTB = HALF * BK * 2  , STAGE_BYTES = 8 * HTB, NXCD = 8, WGM = 8;

__host__ __device__ __forceinline__ int lds_byte(int r, int c) { const int st = (r >> 4) * 2 + (c >> 5), rr = r & 15, cc = c & 31, ob = rr * 64 + cc * 2; return st * 1024 + (ob ^ (((ob >> 9) & 1) << 5)); }
__host__ __device__ __forceinline__ void stage_rc(int b, int& R, int& C) { const int st = b / 1024, sb = b % 1024, swz = sb ^ (((sb >> 9) & 1) << 5); R = (st >> 1) * 16 + swz / 64; C = (st & 1) * 32 + (swz % 64) / 2; }
__host__ __device__ __forceinline__ int perm32(int rho) { const int n = rho >> 4, i = rho & 15; return 8 * (i >> 2) + 4 * n + (i & 3); }

struct Unit { int pm, pn; };
struct Gemm { const bf16_t* A; const bf16_t* Bt; int M, N, K; };

struct StaticOrder {
    int nM, nN, nwg, G, c;
    __host__ __device__ void init(int M, int N, int G_, int c_) { nM = M / BM; nN = N / BM; nwg = nM * nN; G = G_; c = c_; }
    __host__ __device__ bool next(int i, Unit& u) const {
        const long L = (long)i * G + c; if (L >= nwg) return false;
        int wgid = (int)L; { const int q = nwg / NXCD, r = nwg % NXCD, xcd = wgid % NXCD, off = wgid / NXCD; wgid = (xcd < r ? xcd * (q + 1) : r * (q + 1) + (xcd - r) * q) + off; }
        const int nig = WGM * nN, gid = wgid / nig, fm = gid * WGM, gsz = (nM - fm) < WGM ? (nM - fm) : WGM;
        u.pm = fm + ((wgid % nig) % gsz); u.pn = (wgid % nig) / gsz; return true;
    }
    __device__ __forceinline__ void a_ready(const Unit&) const {}
    __device__ __forceinline__ void done(const Unit&) const {}
};

__device__ __forceinline__ unsigned cvt_pk_bf16(float lo, float hi) { unsigned r; asm volatile("v_cvt_pk_bf16_f32 %0, %1, %2" : "=v"(r) : "v"(lo), "v"(hi)); return r; }
typedef float f32x2 __attribute__((ext_vector_type(2)));
__device__ __forceinline__ f32x2 gelu_pk(f32x2 v) {
    const f32x2 av = __builtin_elementwise_abs(v), d = av * 0.2316418882f + 1.0f;
    f32x2 t; t.x = __builtin_amdgcn_rcpf(d.x); t.y = __builtin_amdgcn_rcpf(d.y);
    f32x2 q = t * 0.5307027145f + (-0.7265760135f); q = q * t + 0.7107068705f; q = q * t + (-0.142248368f); q = q * t + 0.127414796f; q = q * t;
    const f32x2 s = (v * v) * (-0.72134752044f);
    f32x2 e; e.x = __builtin_amdgcn_exp2f(s.x); e.y = __builtin_amdgcn_exp2f(s.y);
    const f32x2 m = v * (q * e), r = v - m;
    f32x2 o; o.x = v.x < 0.f ? m.x : r.x; o.y = v.y < 0.f ? m.y : r.y; return o;
}
#ifndef EPI_AUX
#define EPI_AUX 16
#endif
template <bool F16  > struct EpiBf16R {
    typedef f32x4 acc_t;
    static constexpr bool PERM = true, AFTER_DRAIN = false;
    bf16_t* O; int ldc; int split_cols; size_t split_stride; const float* rs;
    __device__ __forceinline__ void operator()(const f32x4 (&acc)[2][2][4][2], const Unit& u, int wr, int wc, int fr, int fq) const {
        const int row0 = u.pm * BM + wr * 64 + fr; int colt = u.pn * BM; unsigned boff = 0u;
        if (split_cols) { const int t = colt / split_cols; boff = (unsigned)(t * split_stride * 2); colt -= t * split_cols; }
        const int col0 = colt + wc * 32 + 8 * fq;
        const __amdgpu_buffer_rsrc_t orsrc = __builtin_amdgcn_make_buffer_rsrc((void*)O, (short)0, 0x7ffffff0, 0x00020000);
#pragma unroll
        for (int ai = 0; ai < 2; ++ai)
#pragma unroll
            for (int m = 0; m < 4; ++m) { const int row = row0 + ai * HALF + m * 16; const unsigned roff = boff + (unsigned)(row * ldc + col0) * 2u;
                float sc = 1.f;
                if (rs) {
                    const f32x4 a = *(const f32x4*)(rs + (size_t)row * 16 + 4 * fq); float s = (a[0] + a[1]) + (a[2] + a[3]); const int lane_ = fr + 16 * fq;
                    s += __builtin_bit_cast(float, __builtin_amdgcn_ds_bpermute((lane_ ^ 16) << 2, __builtin_bit_cast(int, s)));
                    s += __builtin_bit_cast(float, __builtin_amdgcn_ds_bpermute((lane_ ^ 32) << 2, __builtin_bit_cast(int, s)));
                    sc = __builtin_amdgcn_rsqf(s * (1.0f / 1024.0f) + 1e-6f); }
#pragma unroll
                for (int bj = 0; bj < 2; ++bj) { const f32x4 v0 = acc[ai][bj][m][0] * sc, v1 = acc[ai][bj][m][1] * sc;
                    u32x4 w;
                    if (F16) { w.x = __builtin_bit_cast(unsigned, __builtin_amdgcn_cvt_pkrtz(v0[0], v0[1])); w.y = __builtin_bit_cast(unsigned, __builtin_amdgcn_cvt_pkrtz(v0[2], v0[3])); w.z = __builtin_bit_cast(unsigned, __builtin_amdgcn_cvt_pkrtz(v1[0], v1[1])); w.w = __builtin_bit_cast(unsigned, __builtin_amdgcn_cvt_pkrtz(v1[2], v1[3])); }
                    else { w.x = cvt_pk_bf16(v0[0], v0[1]); w.y = cvt_pk_bf16(v0[2], v0[3]); w.z = cvt_pk_bf16(v1[0], v1[1]); w.w = cvt_pk_bf16(v1[2], v1[3]); }
                    __builtin_amdgcn_raw_buffer_store_b128(w, orsrc, (int)(roff + bj * HALF * 2), 0, EPI_AUX); } }
    }
};
template <bool QKN> struct EpiI8 {
    typedef i32x4 acc_t;
    static constexpr bool PERM = true, AFTER_DRAIN = false;
    bf16_t* O; size_t split_stride; const float* sx; const float* sw; const float* gq; const float* gk; float c2;
    __device__ __forceinline__ void operator()(const i32x4 (&acc)[2][2][4][2], const Unit& u, int wr, int wc, int fr, int fq) const {
        const int row0 = u.pm * BM + wr * 64 + fr; int colt = u.pn * BM; unsigned boff;
        { const int t = colt / 1024; boff = (unsigned)(t * split_stride * 2); colt -= t * 1024; }
        const __amdgpu_buffer_rsrc_t orsrc = __builtin_amdgcn_make_buffer_rsrc((void*)O, (short)0, 0x7ffffff0, 0x00020000);
        const int scol0 = u.pn * BM + wc * 32 + 8 * fq;
        f32x4 cw[2][2];
#pragma unroll
        for (int bj = 0; bj < 2; ++bj) { cw[bj][0] = *(const f32x4*)(sw + scol0 + bj * HALF); cw[bj][1] = *(const f32x4*)(sw + scol0 + bj * HALF + 4); }
        if (QKN && u.pn < 8) {
            const float* g = u.pn < 4 ? gq : gk; const float cc = u.pn < 4 ? c2 : 1.f; const int lane = fr + 16 * fq;
            f32x4 gv[2][2];
#pragma unroll
            for (int bj = 0; bj < 2; ++bj) { gv[bj][0] = *(const f32x4*)(g + 32 * bj + 8 * fq) * cc; gv[bj][1] = *(const f32x4*)(g + 32 * bj + 8 * fq + 4) * cc; }
            const int col0 = colt + 64 * wc + 8 * fq;
#pragma unroll
            for (int ai = 0; ai < 2; ++ai)
#pragma unroll
                for (int m = 0; m < 4; ++m) { const int row = row0 + ai * HALF + m * 16; const unsigned roff = boff + (unsigned)(row * 1024 + col0) * 2u; const float rs = sx[row];
                    f32x4 v[2][2]; float ss = 0.f;
#pragma unroll
                    for (int bj = 0; bj < 2; ++bj) { const i32x4 a0 = acc[ai][bj][m][0], a1 = acc[ai][bj][m][1];
                        v[bj][0] = (f32x4){(float)a0[0], (float)a0[1], (float)a0[2], (float)a0[3]} * cw[bj][0] * rs; v[bj][1] = (f32x4){(float)a1[0], (float)a1[1], (float)a1[2], (float)a1[3]} * cw[bj][1] * rs;
                        ss += ((v[bj][0][0] * v[bj][0][0] + v[bj][0][1] * v[bj][0][1]) + (v[bj][0][2] * v[bj][0][2] + v[bj][0][3] * v[bj][0][3])) + ((v[bj][1][0] * v[bj][1][0] + v[bj][1][1] * v[bj][1][1]) + (v[bj][1][2] * v[bj][1][2] + v[bj][1][3] * v[bj][1][3])); }
                    ss += __builtin_bit_cast(float, __builtin_amdgcn_ds_bpermute((lane ^ 16) << 2, __builtin_bit_cast(int, ss)));
                    ss += __builtin_bit_cast(float, __builtin_amdgcn_ds_bpermute((lane ^ 32) << 2, __builtin_bit_cast(int, ss)));
                    const float r = __builtin_amdgcn_rsqf(ss * (1.f / 64.f) + 1e-6f);
#pragma unroll
                    for (int bj = 0; bj < 2; ++bj) { const f32x4 o0 = v[bj][0] * r * gv[bj][0], o1 = v[bj][1] * r * gv[bj][1];
                        u32x4 w; w.x = cvt_pk_bf16(o0[0], o0[1]); w.y = cvt_pk_bf16(o0[2], o0[3]); w.z = cvt_pk_bf16(o1[0], o1[1]); w.w = cvt_pk_bf16(o1[2], o1[3]);
                        __builtin_amdgcn_raw_buffer_store_b128(w, orsrc, (int)(roff + bj * 32 * 2), 0, EPI_AUX); } }
            return;
        }
        const int col0 = colt + wc * 32 + 8 * fq;
#pragma unroll
        for (int ai = 0; ai < 2; ++ai)
#pragma unroll
            for (int m = 0; m < 4; ++m) { const int row = row0 + ai * HALF + m * 16; const unsigned roff = boff + (unsigned)(row * 1024 + col0) * 2u; const float rs = sx[row];
#pragma unroll
                for (int bj = 0; bj < 2; ++bj) { const i32x4 a0 = acc[ai][bj][m][0], a1 = acc[ai][bj][m][1];
                    const f32x4 v0 = (f32x4){(float)a0[0], (float)a0[1], (float)a0[2], (float)a0[3]} * cw[bj][0] * rs, v1 = (f32x4){(float)a1[0], (float)a1[1], (float)a1[2], (float)a1[3]} * cw[bj][1] * rs;
                    u32x4 w; w.x = cvt_pk_bf16(v0[0], v0[1]); w.y = cvt_pk_bf16(v0[2], v0[3]); w.z = cvt_pk_bf16(v1[0], v1[1]); w.w = cvt_pk_bf16(v1[2], v1[3]);
                    __builtin_amdgcn_raw_buffer_store_b128(w, orsrc, (int)(roff + bj * HALF * 2), 0, EPI_AUX); } }
    }
};
template <bool BASE16> struct EpiResNorm {
    typedef f32x4 acc_t;
    static constexpr bool PERM = true, AFTER_DRAIN = false;
    const void* base; bf16_t* out; bf16_t* hg; const float* gain; float* rs;
    __device__ __forceinline__ void operator()(const f32x4 (&acc)[2][2][4][2], const Unit& u, int wr, int wc, int fr, int fq) const {
        const int col0 = u.pn * BM + wc * 32 + 8 * fq, lane = fr + 16 * fq;
        f32x4 gv[2][2];
#pragma unroll
        for (int bj = 0; bj < 2; ++bj)
#pragma unroll
            for (int n = 0; n < 2; ++n) gv[bj][n] = *(const f32x4*)(gain + col0 + bj * HALF + n * 4);
#pragma unroll
        for (int ai = 0; ai < 2; ++ai)
#pragma unroll
            for (int m = 0; m < 4; ++m) { const int r = ai * HALF + wr * 64 + m * 16 + fr; const size_t off = (size_t)(u.pm * BM + r) * 1024 + col0;
                float ss = 0.f;
#pragma unroll
                for (int bj = 0; bj < 2; ++bj) { f32x4 b0, b1;
                    if (BASE16) { const u32x4 bw = *(const u32x4*)((const bf16_t*)base + off + bj * HALF);
                        b0 = (f32x4){__builtin_bit_cast(float, bw.x << 16), __builtin_bit_cast(float, bw.x & 0xffff0000u), __builtin_bit_cast(float, bw.y << 16), __builtin_bit_cast(float, bw.y & 0xffff0000u)};
                        b1 = (f32x4){__builtin_bit_cast(float, bw.z << 16), __builtin_bit_cast(float, bw.z & 0xffff0000u), __builtin_bit_cast(float, bw.w << 16), __builtin_bit_cast(float, bw.w & 0xffff0000u)}; }
                    else { b0 = *(const f32x4*)((const float*)base + off + bj * HALF); b1 = *(const f32x4*)((const float*)base + off + bj * HALF + 4); }
                    const f32x4 o0 = b0 + acc[ai][bj][m][0], o1 = b1 + acc[ai][bj][m][1];
                    u32x4 wo; wo.x = cvt_pk_bf16(o0[0], o0[1]); wo.y = cvt_pk_bf16(o0[2], o0[3]); wo.z = cvt_pk_bf16(o1[0], o1[1]); wo.w = cvt_pk_bf16(o1[2], o1[3]);
                    *(u32x4*)(out + off + bj * HALF) = wo;
                    ss += ((o0[0] * o0[0] + o0[1] * o0[1]) + (o0[2] * o0[2] + o0[3] * o0[3])) + ((o1[0] * o1[0] + o1[1] * o1[1]) + (o1[2] * o1[2] + o1[3] * o1[3]));
                    const f32x4 h0 = o0 * gv[bj][0], h1 = o1 * gv[bj][1];
                    u32x4 w; w.x = cvt_pk_bf16(h0[0], h0[1]); w.y = cvt_pk_bf16(h0[2], h0[3]); w.z = cvt_pk_bf16(h1[0], h1[1]); w.w = cvt_pk_bf16(h1[2], h1[3]);
                    *(u32x4*)(hg + off + bj * HALF) = w; }
                ss += __builtin_bit_cast(float, __builtin_amdgcn_ds_bpermute((lane ^ 16) << 2, __builtin_bit_cast(int, ss)));
                ss += __builtin_bit_cast(float, __builtin_amdgcn_ds_bpermute((lane ^ 32) << 2, __builtin_bit_cast(int, ss)));
                if (fq == 0) rs[(size_t)(u.pm * BM + r) * 16 + u.pn * 4 + wc] = ss; }
    }
};
__device__ __forceinline__ f32x4 mma16(bf16x8 a, bf16x8 b, f32x4 c) { return __builtin_amdgcn_mfma_f32_16x16x32_bf16(a, b, c, 0, 0, 0); }
__device__ __forceinline__ i32x4 mma16(bf16x8 a, bf16x8 b, i32x4 c) { return __builtin_amdgcn_mfma_i32_16x16x64_i8(__builtin_bit_cast(i32x4, a), __builtin_bit_cast(i32x4, b), c, 0, 0, 0); }
template <class Epi, class Sched, bool ALIGN_EPI = false, bool SP2 = false>
__device__ __forceinline__ void gemm_phase(PG8_LAS unsigned char* lds, const Gemm g, const Sched& S, const Epi& E, int tid_in) {
    int tid_ = tid_in; asm volatile("" : "+v"(tid_));
    const int tid = tid_, wid = __builtin_amdgcn_readfirstlane(tid >> 6), lane = tid & 63, wr = wid >> 2, wc = wid & 3, fr = lane & 15, fq = lane >> 4;
    const int K = g.K, nt = K / BK;
    unsigned voffA[2], voffB[2];
#pragma unroll
    for (int i = 0; i < 2; ++i) { int R, C; stage_rc(tid * 16 + i * 8192, R, C); const int Rb = Epi::PERM ? ((R & ~31) + perm32(R & 31)) : R;
        voffA[i] = (unsigned)(R * K + C) * 2u; voffB[i] = (unsigned)(Rb * K + C) * 2u; }
    const size_t kstep = (size_t)(BK * 2);
    const size_t hstep = (size_t)HALF * K * 2;
    const size_t tstep = 2 * hstep;
    const unsigned ldsw = (unsigned)wid * 1024u;
    const int aoff = lds_byte(wr * 64 + fr, fq * 8), boff = lds_byte(wc * 32 + fr, fq * 8);
#define PG8_SA(b, h) (((b) * 2 + (h)) * HTB)
#define PG8_SB(b, h) ((4 + (b) * 2 + (h)) * HTB)
#define PG8_STAGE(bufoff, gbase, voff) do { _Pragma("unroll") for (int _i = 0; _i < 2; ++_i) \
        __builtin_amdgcn_global_load_lds((const unsigned*)((const char*)(gbase) + (voff)[_i]), (PG8_LAS unsigned*)(lds + (bufoff) + ldsw + _i * 8192), 16, 0, 0); } while (0)
#define PG8_LDA(dst, b, h) do { _Pragma("unroll") for (int m = 0; m < 4; ++m) _Pragma("unroll") for (int k = 0; k < 2; ++k) dst[m][k] = *(const PG8_LAS bf16x8*)(lds + PG8_SA(b, h) + aoff + m * 2048 + k * 1024); } while (0)
#define PG8_LDB(dst, b, h) do { _Pragma("unroll") for (int n = 0; n < 2; ++n) _Pragma("unroll") for (int k = 0; k < 2; ++k) dst[n][k] = *(const PG8_LAS bf16x8*)(lds + PG8_SB(b, h) + boff + n * 2048 + k * 1024); } while (0)
#define PG8_MMA(ai, bj, At, Bt) do { __builtin_amdgcn_s_setprio(1); _Pragma("unroll") for (int m = 0; m < 4; ++m) _Pragma("unroll") for (int n = 0; n < 2; ++n) _Pragma("unroll") for (int k = 0; k < 2; ++k) \
        acc[ai][bj][m][n] = mma16(Bt[n][k], At[m][k], acc[ai][bj][m][n]); __builtin_amdgcn_s_setprio(0); } while (0)
#define PG8_WAIT_V(n) asm volatile("s_waitcnt vmcnt(" #n ")" ::: "memory")
#define PG8_WAIT_L(n) asm volatile("s_waitcnt lgkmcnt(" #n ")" ::: "memory")
#define PG8_BAR __builtin_amdgcn_s_barrier()
#define PG8_SCHED __builtin_amdgcn_sched_barrier(0)
    Unit cur, nxt; int ui = 0;
    if (!S.next(0, cur)) return;
    typedef typename Epi::acc_t acc_t;
    acc_t acc[2][2][4][2];
#pragma unroll
    for (int a = 0; a < 2; ++a)
#pragma unroll
        for (int b = 0; b < 2; ++b)
#pragma unroll
            for (int m = 0; m < 4; ++m)
#pragma unroll
                for (int n = 0; n < 2; ++n) acc[a][b][m][n] = (acc_t){0, 0, 0, 0};
    bf16x8 At[4][2], B0[2][2], B1[2][2];
    const char* cA = (const char*)g.A + (size_t)cur.pm * tstep; const char* cB = (const char*)g.Bt + (size_t)cur.pn * tstep;
    S.a_ready(cur);
    if constexpr (SP2) {
        PG8_STAGE(PG8_SB(0, 0), cB, voffB); PG8_STAGE(PG8_SB(0, 1), cB + hstep, voffB); PG8_STAGE(PG8_SA(0, 0), cA, voffA); PG8_STAGE(PG8_SA(0, 1), cA + hstep, voffA);
        if (wr == 1) PG8_BAR;
        PG8_WAIT_V(2); PG8_BAR;
        PG8_STAGE(PG8_SB(1, 0), cB + kstep, voffB); PG8_STAGE(PG8_SA(1, 0), cA + kstep, voffA); PG8_STAGE(PG8_SB(1, 1), cB + hstep + kstep, voffB);
        PG8_WAIT_V(6); PG8_BAR;
    } else {
        PG8_STAGE(PG8_SB(0, 0), cB, voffB); PG8_STAGE(PG8_SA(0, 0), cA, voffA); PG8_STAGE(PG8_SB(0, 1), cB + hstep, voffB); PG8_STAGE(PG8_SA(0, 1), cA + hstep, voffA);
        if (wr == 1) PG8_BAR;
        PG8_WAIT_V(4); PG8_BAR;
        PG8_STAGE(PG8_SB(1, 0), cB + kstep, voffB); PG8_STAGE(PG8_SA(1, 0), cA + kstep, voffA); PG8_STAGE(PG8_SB(1, 1), cB + hstep + kstep, voffB);
        PG8_WAIT_V(6); PG8_BAR;
    }
    for (;;) {
        const bool has_next = S.next(ui + 1, nxt);
        const char* nA = has_next ? (const char*)g.A + (size_t)nxt.pm * tstep : cA; const char* nB = has_next ? (const char*)g.Bt + (size_t)nxt.pn * tstep : cB;
        for (int t = 0; t < nt; t += 2) {
            const bool last = (t == nt - 2);
            const char* a1 = cA + (size_t)(t + 1) * kstep;
            const char* a2 = last ? nA : cA + (size_t)(t + 2) * kstep; const char* b2 = last ? nB : cB + (size_t)(t + 2) * kstep;
            const char* a3 = a2 + kstep; const char* b3 = b2 + kstep;
            if (last && has_next) S.a_ready(nxt);
            if constexpr (SP2) {
            PG8_LDB(B0, 0, 0); PG8_LDB(B1, 0, 1); PG8_SCHED; PG8_LDA(At, 0, 0); PG8_STAGE(PG8_SA(1, 1), a1 + hstep, voffA);
            PG8_WAIT_V(8); PG8_WAIT_L(0); PG8_BAR; PG8_MMA(0, 0, At, B0); PG8_MMA(0, 1, At, B1); PG8_BAR; PG8_SCHED;
            PG8_LDA(At, 0, 1); PG8_STAGE(PG8_SB(0, 0), b2, voffB); PG8_STAGE(PG8_SB(0, 1), b2 + hstep, voffB); PG8_STAGE(PG8_SA(0, 0), a2, voffA);
            PG8_WAIT_V(8); PG8_WAIT_L(0); PG8_BAR; PG8_MMA(1, 0, At, B0); PG8_MMA(1, 1, At, B1); PG8_BAR; PG8_SCHED;
            PG8_LDB(B0, 1, 0); PG8_LDB(B1, 1, 1); PG8_SCHED; PG8_LDA(At, 1, 0); PG8_STAGE(PG8_SA(0, 1), a2 + hstep, voffA);
            PG8_WAIT_V(8); PG8_WAIT_L(0); PG8_BAR; PG8_MMA(0, 0, At, B0); PG8_MMA(0, 1, At, B1); PG8_BAR; PG8_SCHED;
            PG8_LDA(At, 1, 1); PG8_STAGE(PG8_SB(1, 0), b3, voffB); PG8_STAGE(PG8_SB(1, 1), b3 + hstep, voffB); PG8_STAGE(PG8_SA(1, 0), a3, voffA);
            PG8_WAIT_V(8); PG8_WAIT_L(0); PG8_BAR; PG8_MMA(1, 0, At, B0); PG8_MMA(1, 1, At, B1); PG8_BAR; PG8_SCHED;
            } else {
            PG8_LDB(B0, 0, 0); PG8_SCHED; PG8_LDA(At, 0, 0); PG8_STAGE(PG8_SA(1, 1), a1 + hstep, voffA);
            PG8_WAIT_L(8); PG8_BAR; PG8_WAIT_L(0); PG8_MMA(0, 0, At, B0); PG8_BAR; PG8_SCHED;
            PG8_LDB(B1, 0, 1); PG8_STAGE(PG8_SB(0, 0), b2, voffB);
            PG8_BAR; PG8_WAIT_L(0); PG8_MMA(0, 1, At, B1); PG8_BAR;
            PG8_LDA(At, 0, 1); PG8_STAGE(PG8_SA(0, 0), a2, voffA);
            PG8_BAR; PG8_WAIT_L(0); PG8_MMA(1, 0, At, B0); PG8_BAR; PG8_SCHED;
            PG8_STAGE(PG8_SB(0, 1), b2 + hstep, voffB);
            PG8_WAIT_V(6); PG8_BAR; PG8_MMA(1, 1, At, B1); PG8_BAR;
            PG8_LDB(B0, 1, 0); PG8_SCHED; PG8_LDA(At, 1, 0); PG8_STAGE(PG8_SA(0, 1), a2 + hstep, voffA);
            PG8_WAIT_L(8); PG8_BAR; PG8_WAIT_L(0); PG8_MMA(0, 0, At, B0); PG8_BAR; PG8_SCHED;
            PG8_LDB(B1, 1, 1); PG8_STAGE(PG8_SB(1, 0), b3, voffB);
            PG8_BAR; PG8_WAIT_L(0); PG8_MMA(0, 1, At, B1); PG8_BAR;
            PG8_LDA(At, 1, 1); PG8_STAGE(PG8_SA(1, 0), a3, voffA);
            PG8_BAR; PG8_WAIT_L(0); PG8_MMA(1, 0, At, B0); PG8_BAR; PG8_SCHED;
            PG8_STAGE(PG8_SB(1, 1), b3 + hstep, voffB);
            PG8_WAIT_V(6); PG8_BAR; PG8_MMA(1, 1, At, B1); PG8_BAR;
            }
        }
        if constexpr (ALIGN_EPI) { if (wr == 0) PG8_BAR; }
        if constexpr (!Epi::AFTER_DRAIN) { E(acc, cur, wr, wc, fr, fq); S.done(cur); }
        if (!has_next) break;
#pragma unroll
        for (int a = 0; a < 2; ++a)
#pragma unroll
            for (int b = 0; b < 2; ++b)
#pragma unroll
                for (int m = 0; m < 4; ++m)
#pragma unroll
                    for (int n = 0; n < 2; ++n) acc[a][b][m][n] = (acc_t){0, 0, 0, 0};
        cur = nxt; cA = nA; cB = nB; ++ui;
        if constexpr (ALIGN_EPI) { if (wr == 1) PG8_BAR; }
    }
    PG8_WAIT_V(0);
    if constexpr (!ALIGN_EPI) { if (wr == 0) PG8_BAR; }
    PG8_BAR;
    if constexpr (Epi::AFTER_DRAIN) { E.fused(acc, cur, wr, wc, fr, fq, lds, wid, lane); S.done(cur); }
#undef PG8_SA
#undef PG8_SB
#undef PG8_STAGE
#undef PG8_LDA
#undef PG8_LDB
#undef PG8_MMA
#undef PG8_WAIT_V
#undef PG8_WAIT_L
#undef PG8_BAR
#undef PG8_SCHED
}
}
#include <hip/hip_bf16.h>
#include <cmath>
namespace attn_body {
using bf16=__hip_bfloat16;
using bf16x8=__attribute__((ext_vector_type(8)))short;
using s16x4=__attribute__((ext_vector_type(4)))short;
using f32x16=__attribute__((ext_vector_type(16)))float;
using u32x4=__attribute__((ext_vector_type(4)))unsigned;
constexpr int BATCH=8,NHEAD=16,SEQ=2048,D=64,DM=NHEAD*D;
constexpr int NW=8,QBLK=32,QB=QBLK*NW,KVBLK=64,NQB=SEQ/QB;
constexpr int ATTN_PITCH=DM, ATTN_UNIT_ROWS=QB;
__device__ __forceinline__ int crow(int r,int hi){return (r&3)+8*(r>>2)+4*hi;}
#define SBAR() __builtin_amdgcn_sched_barrier(0)
__device__ __forceinline__ void cmask(f32x16&p0,f32x16&p1,int jb,int qrel,int hi){
  const float NEG=-INFINITY; int kb=64*jb+4*hi;
  #pragma unroll
  for(int r=0;r<16;++r){int kv=kb+(r&3)+8*(r>>2); if(kv>qrel)p0[r]=NEG; if(kv+32>qrel)p1[r]=NEG;}
}

constexpr int NSLOT=3, SLOTB=8192;
constexpr int LDS_K=0, LDS_V=NSLOT*SLOTB, LDS_WS=2*NSLOT*SLOTB, LDS_OST=LDS_WS+NW*64*4, LDS_CS=LDS_OST+NW*4096, LDS_BYTES=LDS_CS+SEQ*4;
constexpr float C2=0.125f*1.4426950408889634f;
__device__ __forceinline__ void glds16(const void*gsrc,unsigned lds_dst){unsigned keep;
  asm volatile("s_mov_b32 %0, m0\n\ts_mov_b32 m0, %2\n\ts_nop 0\n\tglobal_load_lds_dwordx4 %1, off\n\ts_mov_b32 m0, %0":"=&s"(keep):"v"(gsrc),"s"(lds_dst):"memory");}
__device__ __forceinline__ float max3f(float a,float b,float c){float r;asm("v_max3_f32 %0, %1, %2, %3":"=v"(r):"v"(a),"v"(b),"v"(c));return r;}
__device__ __forceinline__ float max2f(float a,float b){float r;asm("v_max_f32_e32 %0, %1, %2":"=v"(r):"v"(a),"v"(b));return r;}
__device__ __forceinline__ float fadd_s(float a,float b){float r;asm("v_add_f32_e32 %0, %1, %2":"=v"(r):"v"(a),"v"(b));return r;}
__device__ __forceinline__ float fsub_s(float a,float b){float r;asm("v_sub_f32_e32 %0, %1, %2":"=v"(r):"v"(a),"v"(b));return r;}
typedef float f32x2_t __attribute__((ext_vector_type(2))); typedef __bf16 bf16x2_t __attribute__((ext_vector_type(2)));
__device__ __forceinline__ unsigned cvtpk_s(float lo,float hi){f32x2_t v={lo,hi};bf16x2_t b=__builtin_convertvector(v,bf16x2_t);return __builtin_bit_cast(unsigned,b);}
#define WAIT_BAR(N) asm volatile("s_waitcnt vmcnt(" #N ") lgkmcnt(0)\n\ts_barrier":::"memory")

typedef __attribute__((address_space(3))) const char* lds_cptr;
__device__ __forceinline__ void qkt(f32x16&p0,f32x16&p1,const char*Kslot,lds_cptr qls,bf16x8 ax0,bf16x8 ax1,bf16x8 qx,int r32,int hi){
  const char*kb=Kslot+hi*1024+r32*16; const f32x16 z16=f32x16{};
  p0=__builtin_amdgcn_mfma_f32_32x32x16_bf16(ax0,qx,z16,0,0,0);p1=__builtin_amdgcn_mfma_f32_32x32x16_bf16(ax1,qx,z16,0,0,0);
  #pragma unroll
  for(int d0=0;d0<4;++d0){
    const bf16x8 b0=*reinterpret_cast<const bf16x8*>(kb+d0*2048);
    const bf16x8 b1=*reinterpret_cast<const bf16x8*>(kb+d0*2048+512);
    const bf16x8 qd=*(const __attribute__((address_space(3))) bf16x8*)(qls+d0*1024);
    p0=__builtin_amdgcn_mfma_f32_32x32x16_bf16(b0,qd,p0,0,0,0);p1=__builtin_amdgcn_mfma_f32_32x32x16_bf16(b1,qd,p1,0,0,0);}
}
typedef short v4i16_t __attribute__((ext_vector_type(4)));
__device__ __forceinline__ void kload8(bf16x8*kf,lds_cptr kp){
  kf[0]=*(const __attribute__((address_space(3))) bf16x8*)(kp);      kf[1]=*(const __attribute__((address_space(3))) bf16x8*)(kp+512);
  kf[2]=*(const __attribute__((address_space(3))) bf16x8*)(kp+2048); kf[3]=*(const __attribute__((address_space(3))) bf16x8*)(kp+2560);
  kf[4]=*(const __attribute__((address_space(3))) bf16x8*)(kp+4096); kf[5]=*(const __attribute__((address_space(3))) bf16x8*)(kp+4608);
  kf[6]=*(const __attribute__((address_space(3))) bf16x8*)(kp+6144); kf[7]=*(const __attribute__((address_space(3))) bf16x8*)(kp+6656);
}
__device__ __forceinline__ void kload2(bf16x8*kf,lds_cptr kp,int j){ kf[2*j]=*(const __attribute__((address_space(3))) bf16x8*)(kp+j*2048); kf[2*j+1]=*(const __attribute__((address_space(3))) bf16x8*)(kp+j*2048+512); }
__device__ __forceinline__ s16x4 vtr(lds_cptr p){ return __builtin_bit_cast(s16x4,__builtin_amdgcn_ds_read_tr16_b64_v4i16((__attribute__((address_space(3))) v4i16_t*)p)); }
__device__ __forceinline__ float rowmax(const f32x16&p0,const f32x16&p1){
  float a=max3f(p0[0],p0[1],p1[0]),b=max3f(p0[2],p0[3],p1[1]);a=max3f(a,p1[2],p1[3]);
  #pragma unroll
  for(int r=4;r<16;r+=4){a=max3f(a,p0[r],p0[r+1]);b=max3f(b,p0[r+2],p0[r+3]);a=max3f(a,p1[r],p1[r+1]);b=max3f(b,p1[r+2],p1[r+3]);}
  const float m=max2f(a,b);
  auto rr=__builtin_amdgcn_permlane32_swap(__float_as_uint(m),__float_as_uint(m),false,false);
  return max2f(__uint_as_float(rr[0]),__uint_as_float(rr[1]));
}
__device__ __forceinline__ void pv(f32x16*o,int vb,bf16x8 pa0,bf16x8 pa1,bf16x8 pa2,bf16x8 pa3){
  #pragma unroll
  for(int d0=0;d0<2;++d0){s16x4 lo[4],hi[4];
    #pragma unroll
    for(int ks=0;ks<4;++ks){
      asm volatile("ds_read_b64_tr_b16 %0,%1 offset:%c2":"=&v"(lo[ks]):"v"(vb),"i"(d0*4096+ks*1024):"memory");
      asm volatile("ds_read_b64_tr_b16 %0,%1 offset:%c2":"=&v"(hi[ks]):"v"(vb),"i"(d0*4096+ks*1024+512):"memory");}
    asm volatile("s_waitcnt lgkmcnt(0)":::"memory");SBAR();
    #define PK(k) (bf16x8){lo[k][0],lo[k][1],lo[k][2],lo[k][3],hi[k][0],hi[k][1],hi[k][2],hi[k][3]}
    o[d0]=__builtin_amdgcn_mfma_f32_32x32x16_bf16(pa0,PK(0),o[d0],0,0,0);
    o[d0]=__builtin_amdgcn_mfma_f32_32x32x16_bf16(pa1,PK(1),o[d0],0,0,0);
    o[d0]=__builtin_amdgcn_mfma_f32_32x32x16_bf16(pa2,PK(2),o[d0],0,0,0);
    o[d0]=__builtin_amdgcn_mfma_f32_32x32x16_bf16(pa3,PK(3),o[d0],0,0,0);
    #undef PK
  }
}

__device__ __forceinline__ void split3(float c,unsigned&hb,unsigned&mb,unsigned&lb){
  hb=__float_as_uint(c)&0xffff0000u; const float r1=c-__uint_as_float(hb); mb=__float_as_uint(r1)&0xffff0000u; const float r2=r1-__uint_as_float(mb); lb=__float_as_uint(r2)&0xffff0000u; }
__device__ __forceinline__ bf16x8 make_ax(float negc){ unsigned hb,mb,lb; split3(negc,hb,mb,lb);
  u32x4 w; w.x=(hb>>16)|mb; w.y=(lb>>16)|0x3f800000u; w.z=0x3f803f80u; w.w=0u; return __builtin_bit_cast(bf16x8,w); }
__device__ __forceinline__ bf16x8 make_qx(float negm,unsigned hm){ unsigned hb,mb,lb; split3(negm,hb,mb,lb);
  u32x4 w; w.x=0x3f803f80u&hm; w.y=(0x3f80u|hb)&hm; w.z=((mb>>16)|lb)&hm; w.w=0u; return __builtin_bit_cast(bf16x8,w); }
#ifndef ATTN_STORE16
#define ATTN_STORE16(p,v) (*(u32x4*)(p)=(v))
#endif
template<int THRL> __device__ __forceinline__ void attn_unit(int b,int h,int qb,const bf16*Q,const bf16*__restrict__ K,const bf16*__restrict__ V,bf16*O,const bf16*__restrict__ Gt,char*shm,const int tid_u,const float skip_thr){
  int tid=tid_u; asm volatile("":"+v"(tid));
  const int lane=tid&63,r32=lane&31,hi=lane>>5; const int wid=__builtin_amdgcn_readfirstlane(tid>>6);
  const long rowbase=(long)b*SEQ; const int q0=qb*QB;
  const bf16*Qw=Q+(rowbase+q0+wid*QBLK)*DM+h*D;
  float*csp=(float*)(shm+LDS_CS);
  int tskip=0;
  { const float cq0=csp[q0]; const int ntall=(q0+QB)/KVBLK; while(tskip+2<=ntall-4 && csp[KVBLK*(tskip+1)+KVBLK-1]-cq0<skip_thr)tskip+=2; tskip=__builtin_amdgcn_readfirstlane(tskip); }
  const bf16*Kh=K+(rowbase+(long)tskip*KVBLK)*DM+h*D,*Vh=V+(rowbase+(long)tskip*KVBLK)*DM+h*D;
  const unsigned lds0=(unsigned)(uintptr_t)shm;
  float*wsf=(float*)(shm+LDS_WS)+wid*64;
  const unsigned koff=(unsigned)(lane*DM+wid*8), voff=(unsigned)((16*(wid&3)+(lane>>2))*DM+(wid>>2)*32+(lane&3)*8);
  const unsigned kdst=lds0+LDS_K+wid*1024, vdst=lds0+LDS_V+wid*1024;
  #define DMA_K(t,slot) do{unsigned o_=koff;asm volatile("":"+v"(o_));glds16(Kh+(long)(t)*KVBLK*DM+o_,(unsigned)__builtin_amdgcn_readfirstlane(kdst+(slot)));}while(0)
  #define DMA_V(t,slot) do{unsigned o_=voff;asm volatile("":"+v"(o_));glds16(Vh+(long)(t)*KVBLK*DM+o_,(unsigned)__builtin_amdgcn_readfirstlane(vdst+(slot)));}while(0)
  const int vb0=(int)(lds0+LDS_V)+((lane>>4)&1)*32+(lane&3)*8+(4*hi+((lane&15)>>2))*64;
  const char*Kbase=shm+LDS_K; bf16x8 kf[8];
  const lds_cptr shm3=(lds_cptr)shm; const lds_cptr kp0=shm3+LDS_K+hi*1024+r32*16; const lds_cptr vp0=shm3+LDS_V+((lane>>4)&1)*32+(lane&3)*8+(4*hi+((lane&15)>>2))*64;
  const int NT=(q0+QB)/KVBLK-tskip;
  const float*cst=csp+tskip*KVBLK;
  const unsigned hm=hi?0u:0xffffffffu;
  DMA_K(0,0);DMA_V(0,0);DMA_K(1,SLOTB);
  const lds_cptr qls=shm3+LDS_OST+wid*4096+hi*512+r32*16;
  { bf16x8 qr[4];
    #pragma unroll
    for(int d0=0;d0<4;++d0)qr[d0]=*reinterpret_cast<const bf16x8*>(&Qw[(long)r32*DM+d0*16+hi*8]);
    #pragma unroll
    for(int d0=0;d0<4;++d0)*(__attribute__((address_space(3))) bf16x8*)(shm3+LDS_OST+wid*4096+hi*512+r32*16+d0*1024)=qr[d0]; }
  #define QLD(k) (*(const __attribute__((address_space(3))) bf16x8*)(qls+(k)*1024))
  float mhat=csp[q0+wid*QBLK+r32],l_reg=0.f;f32x16 o[2];o[0]=f32x16{};o[1]=f32x16{}; bf16x8 qx=make_qx(-mhat,hm);
  const int qrel=wid*QBLK+r32;
  #define CMASK(P0,P1,t) do{int jb_=(t)-(NT-4); if(jb_>=0)cmask(P0,P1,jb_,qrel,hi);}while(0)
  bool resc=false;
  #define START(P0,P1) do{ const float rm=rowmax(P0,P1); resc=false; \
    if(__any(rm>(float)THRL)){ const float dl=__builtin_fmaxf(rm,0.f); mhat=fadd_s(mhat,dl); \
      _Pragma("unroll") for(int r=0;r<16;++r){P0[r]=fsub_s(P0[r],dl);P1[r]=fsub_s(P1[r],dl);} \
      qx=make_qx(-mhat,hm); } \
    _Pragma("unroll") for(int r=0;r<16;++r)P0[r]=__builtin_amdgcn_exp2f(P0[r]); }while(0)
  #define RESC() do{ if(resc){ asm volatile("s_waitcnt lgkmcnt(0)":::"memory"); \
      _Pragma("unroll") for(int d_=0;d_<2;++d_) _Pragma("unroll") for(int r=0;r<16;++r)o[d_][r]*=wsf[crow(r,hi)]; } }while(0)
  f32x16 pA0,pA1,pB0,pB1;
  int sl_prev=0,sl_cur=0,sl_next=SLOTB;
  #define ROT() do{sl_prev=sl_cur;sl_cur=sl_next;sl_next=(sl_next==(NSLOT-1)*SLOTB)?0:sl_next+SLOTB;}while(0)
  DMA_K(2,2*SLOTB);
  WAIT_BAR(3);
  qkt(pA0,pA1,Kbase,qls,make_ax(cst[r32]),make_ax(cst[32+r32]),qx,r32,hi);asm volatile("s_nop 15\n\ts_nop 7":"+v"(pA0),"+v"(pA1));CMASK(pA0,pA1,0);
  START(pA0,pA1);
  _Pragma("unroll") for(int r=0;r<16;++r)pA1[r]=__builtin_amdgcn_exp2f(pA1[r]);
  WAIT_BAR(0);
  DMA_K(3,0);DMA_V(1,SLOTB);
  ROT();
  kload8(kf,kp0+sl_cur);
  WAIT_BAR(2);
  s16x4 vlo[8],vhi[8]; u32x4 pw0,pw1,pw2,pw3;
  #define PKW(P,B) cvtpk_s(P[B],P[B+1])
  #define PAF(k) __builtin_bit_cast(bf16x8,pw##k)
  #define VFR(i) (bf16x8){vlo[i][0],vlo[i][1],vlo[i][2],vlo[i][3],vhi[i][0],vhi[i][1],vhi[i][2],vhi[i][3]}
  #define PIN(x) asm volatile("":"+v"(x))
  #define MX3(a,b,c) __builtin_fmaxf(__builtin_fmaxf((a),(b)),(c))
  #define GAPA(MF,A0,A1,A2,A3,W0,W1,PW) do{ MF; sacc+=A0; sacc+=A1; sacc+=A2; sacc+=A3; PIN(sacc); W0; W1; PIN(PW); SBAR(); }while(0)
  #define EX(v) __builtin_amdgcn_exp2f(v)
  #define GAPB(MF,X,B) do{ MF; X[B]=EX(X[B]); X[B+1]=EX(X[B+1]); X[B+2]=EX(X[B+2]); X[B+3]=EX(X[B+3]); PIN(X); SBAR(); }while(0)
  #define VRD(i) do{ vlo[i]=vtr(vp_+(((i)>>2)*4096+((i)&3)*1024)); vhi[i]=vtr(vp_+(((i)>>2)*4096+((i)&3)*1024+512)); }while(0)
  #define KRD(G,j) do{ if(G){ kload2(kf,kp0+sl_next,j); SBAR(); } }while(0)
  #define STEP(C0,C1,P0,P1,t,GK,GV,GL) do{ SBAR(); \
    const lds_cptr vp_=vp0+sl_prev; \
    const bf16x8 ax0_=make_ax(cst[(t)*KVBLK+r32]), ax1_=make_ax(cst[(t)*KVBLK+32+r32]); \
    C0=__builtin_amdgcn_mfma_f32_32x32x16_bf16(ax0_,qx,f32x16{},0,0,0); C1=__builtin_amdgcn_mfma_f32_32x32x16_bf16(ax1_,qx,f32x16{},0,0,0); SBAR(); \
    bf16x8 q0_=QLD(0), q1_=QLD(1); \
    VRD(0); SBAR(); float sacc=(P0[0]+P0[1]); \
    GAPA(C0=__builtin_amdgcn_mfma_f32_32x32x16_bf16(kf[0],q0_,C0,0,0,0), P0[2],P0[3],P0[4],P0[5],     pw0[0]=PKW(P0,0), pw0[1]=PKW(P0,2), pw0); \
    VRD(4); SBAR(); GAPA(C1=__builtin_amdgcn_mfma_f32_32x32x16_bf16(kf[1],q0_,C1,0,0,0), P0[6],P0[7],P0[8],P0[9],     pw0[2]=PKW(P0,4), pw0[3]=PKW(P0,6), pw0); q0_=QLD(2); \
    VRD(1); SBAR(); GAPA(C0=__builtin_amdgcn_mfma_f32_32x32x16_bf16(kf[2],q1_,C0,0,0,0),   P0[10],P0[11],P0[12],P0[13], pw1[0]=PKW(P0,8), pw1[1]=PKW(P0,10), pw1); \
    VRD(5); SBAR(); GAPA(C1=__builtin_amdgcn_mfma_f32_32x32x16_bf16(kf[3],q1_,C1,0,0,0),   P0[14],P0[15],P1[0],P1[1],   pw1[2]=PKW(P0,12),pw1[3]=PKW(P0,14), pw1); q1_=QLD(3); \
    VRD(2); SBAR(); GAPA(C0=__builtin_amdgcn_mfma_f32_32x32x16_bf16(kf[4],q0_,C0,0,0,0),   P1[2],P1[3],P1[4],P1[5],     pw2[0]=PKW(P1,0), pw2[1]=PKW(P1,2), pw2); \
    VRD(6); SBAR(); GAPA(C1=__builtin_amdgcn_mfma_f32_32x32x16_bf16(kf[5],q0_,C1,0,0,0),   P1[6],P1[7],P1[8],P1[9],     pw2[2]=PKW(P1,4), pw2[3]=PKW(P1,6), pw2); \
    VRD(3); SBAR(); GAPA(C0=__builtin_amdgcn_mfma_f32_32x32x16_bf16(kf[6],q1_,C0,0,0,0),   P1[10],P1[11],P1[12],P1[13], pw3[0]=PKW(P1,8), pw3[1]=PKW(P1,10), pw3); \
    VRD(7); SBAR(); GAPA(C1=__builtin_amdgcn_mfma_f32_32x32x16_bf16(kf[7],q1_,C1,0,0,0),   P1[14],P1[15],0.f,0.f,       pw3[2]=PKW(P1,12),pw3[3]=PKW(P1,14), pw3); \
    l_reg+=sacc; \
    if(GK){DMA_K((t)+3,sl_cur);} if(GV){DMA_V((t)+1,sl_next);} \
    CMASK(C0,C1,t); \
    { float a=MX3(C0[0],C0[1],C1[0]),b=MX3(C0[2],C0[3],C1[1]); a=MX3(a,C1[2],C1[3]); \
      _Pragma("unroll") for(int r=4;r<16;r+=4){a=MX3(a,C0[r],C0[r+1]);b=MX3(b,C0[r+2],C0[r+3]);a=MX3(a,C1[r],C1[r+1]);b=MX3(b,C1[r+2],C1[r+3]);} \
      float rm=__builtin_fmaxf(a,b); { auto rr=__builtin_amdgcn_permlane32_swap(__float_as_uint(rm),__float_as_uint(rm),false,false); rm=__builtin_fmaxf(__uint_as_float(rr[0]),__uint_as_float(rr[1])); } \
      resc=false; \
      if(__builtin_expect(__any(rm>(float)THRL),0)){ const float dl=__builtin_fmaxf(rm,0.f); mhat+=dl; \
        _Pragma("unroll") for(int r=0;r<16;++r){C0[r]-=dl;C1[r]-=dl;} \
        qx=make_qx(-mhat,hm); \
        const float f=__builtin_amdgcn_exp2f(-dl); l_reg*=f; if(hi==0)wsf[r32]=f; resc=true; } } \
    SBAR(); \
    GAPB(o[0]=__builtin_amdgcn_mfma_f32_32x32x16_bf16(PAF(0),VFR(0),o[0],0,0,0), C0,0); \
    GAPB(o[1]=__builtin_amdgcn_mfma_f32_32x32x16_bf16(PAF(0),VFR(4),o[1],0,0,0), C0,4); \
    KRD(GL,0); GAPB(o[0]=__builtin_amdgcn_mfma_f32_32x32x16_bf16(PAF(1),VFR(1),o[0],0,0,0), C0,8); \
    KRD(GL,1); GAPB(o[1]=__builtin_amdgcn_mfma_f32_32x32x16_bf16(PAF(1),VFR(5),o[1],0,0,0), C0,12); \
    KRD(GL,2); GAPB(o[0]=__builtin_amdgcn_mfma_f32_32x32x16_bf16(PAF(2),VFR(2),o[0],0,0,0), C1,0); \
    KRD(GL,3); GAPB(o[1]=__builtin_amdgcn_mfma_f32_32x32x16_bf16(PAF(2),VFR(6),o[1],0,0,0), C1,4); \
    GAPB(o[0]=__builtin_amdgcn_mfma_f32_32x32x16_bf16(PAF(3),VFR(3),o[0],0,0,0), C1,8); \
    GAPB(o[1]=__builtin_amdgcn_mfma_f32_32x32x16_bf16(PAF(3),VFR(7),o[1],0,0,0), C1,12); \
    }while(0)
  int t=1;
  #undef CMASK
  #define CMASK(P0,P1,t) do{}while(0)
  for(;t+5<NT;t+=2){
    STEP(pB0,pB1,pA0,pA1,t,true,true,true);     WAIT_BAR(2); RESC(); ROT();
    STEP(pA0,pA1,pB0,pB1,t+1,true,true,true);   WAIT_BAR(2); RESC(); ROT();
  }
  #undef CMASK
  #define CMASK(P0,P1,t) do{int jb_=(t)-(NT-4); if(jb_>=0)cmask(P0,P1,jb_,qrel,hi);}while(0)
  #define ENDW(tt) do{ if((tt)+3<NT){WAIT_BAR(2);} else if((tt)+2<NT){WAIT_BAR(1);} else {WAIT_BAR(0);} }while(0)
  for(;t+1<NT;t+=2){
    STEP(pB0,pB1,pA0,pA1,t,(t+3<NT),(t+1<NT),(t+1<NT));       ENDW(t);   RESC(); ROT();
    STEP(pA0,pA1,pB0,pB1,t+1,(t+4<NT),(t+2<NT),(t+2<NT));     ENDW(t+1); RESC(); ROT();
  }
  STEP(pB0,pB1,pA0,pA1,NT-1,false,false,false); RESC();
  { float sacc=pB0[0]+pB0[1]; _Pragma("unroll") for(int r=2;r<16;++r)sacc+=pB0[r]; _Pragma("unroll") for(int r=0;r<16;++r)sacc+=pB1[r]; l_reg+=sacc;
    pw0=(u32x4){PKW(pB0,0),PKW(pB0,2),PKW(pB0,4),PKW(pB0,6)};pw1=(u32x4){PKW(pB0,8),PKW(pB0,10),PKW(pB0,12),PKW(pB0,14)};pw2=(u32x4){PKW(pB1,0),PKW(pB1,2),PKW(pB1,4),PKW(pB1,6)};pw3=(u32x4){PKW(pB1,8),PKW(pB1,10),PKW(pB1,12),PKW(pB1,14)};
    SBAR(); pv(o,vb0+sl_cur,PAF(0),PAF(1),PAF(2),PAF(3)); }
  #undef PKW
  #undef PAF
  #undef VFR
  #undef PIN
  #undef MX3
  #undef GAPA
  #undef GAPB
  #undef EX
  #undef VRD
  #undef KRD
  #undef STEP
  #undef ENDW
  {auto rr=__builtin_amdgcn_permlane32_swap(__float_as_uint(l_reg),__float_as_uint(l_reg),false,false);l_reg=__uint_as_float(rr[0])+__uint_as_float(rr[1]);}
  { int te=tid; asm volatile("":"+v"(te));
    const int lane_e=te&63,r32e=lane_e&31,hie=lane_e>>5;
    if(hie==0)wsf[32+r32e]=l_reg;asm volatile("s_waitcnt lgkmcnt(0)":::"memory");
    float rli[16];
    #pragma unroll
    for(int r=0;r<16;++r)rli[r]=__builtin_amdgcn_rcpf(wsf[32+crow(r,hie)]);
    bf16*Ow=O+(rowbase+q0+wid*QBLK)*DM+h*D; const bf16*Gw=Gt+(rowbase+q0+wid*QBLK)*DM+h*D;
    bf16*stg=(bf16*)(shm+LDS_OST)+wid*2048;
    #pragma unroll
    for(int r=0;r<16;++r){const int orow=crow(r,hie);
      #pragma unroll
      for(int d0=0;d0<2;++d0)stg[orow*64+d0*32+r32e]=__float2bfloat16(o[d0][r]*rli[r]);}
    asm volatile("s_waitcnt lgkmcnt(0)":::"memory");
    #pragma unroll
    for(int i=0;i<4;++i){const int row=i*8+(lane_e>>3),ch=lane_e&7; u32x4 v=*(const u32x4*)(stg+row*64+ch*8); const u32x4 gv=*(const u32x4*)(Gw+(long)row*DM+ch*8);
      #pragma unroll
      for(int e=0;e<4;++e){ const float g0=__uint_as_float(gv[e]<<16),g1=__uint_as_float(gv[e]&0xffff0000u),x0=__uint_as_float(v[e]<<16),x1=__uint_as_float(v[e]&0xffff0000u);
        v[e]=cvtpk_s(x0*__builtin_amdgcn_rcpf(1.f+__expf(-g0)),x1*__builtin_amdgcn_rcpf(1.f+__expf(-g1))); }
      ATTN_STORE16(Ow+(long)row*DM+ch*8,v);} }
  asm volatile("s_waitcnt lgkmcnt(0)\n\ts_barrier":::"memory");
  #undef DMA_K
  #undef QLD
  #undef DMA_V
  #undef CMASK
  #undef START
  #undef RESC
  #undef ROT
}
constexpr int ATTN_LDS_BYTES=LDS_BYTES;
struct AttnTensors { const bf16* Q; const bf16* K; const bf16* V; bf16* O; const bf16* G; const float* CUM; float THR; };
struct AttnUnit { int bh; int qb; };
struct StaticOrder {
  int vcu;
  __device__ __forceinline__ explicit StaticOrder(int grid,int block):vcu((block%8)*(grid/8)+block/8){}
  __device__ __forceinline__ bool next(int i,AttnUnit&u)const{ if(i>=4)return false; const int s=2*(vcu&1)+(i>>1); u.bh=vcu>>1; u.qb=(i&1)?7-s:s; return true; }
  __device__ __forceinline__ void a_ready(const AttnUnit&)const{}
  __device__ __forceinline__ void done(const AttnUnit&)const{}
};
template<class Sched,int THRL=8> __device__ __forceinline__ void attn_phase(char*lds,const AttnTensors&T,const Sched&S,int tid_in){
  AttnUnit u; int tid_=tid_in; asm volatile("":"+v"(tid_));
  if(S.next(0,u)){ float*csp=(float*)(lds+LDS_CS); float*wt=(float*)(lds+LDS_WS); int tp=tid_in; asm volatile("":"+v"(tp));
    const float*lf=T.CUM+((long)(u.bh/NHEAD)*SEQ+4*tp)*NHEAD+u.bh%NHEAD;
    const float a0=lf[0],a1=a0+lf[NHEAD],a2=a1+lf[2*NHEAD],a3=a2+lf[3*NHEAD];
    float sc=a3; const int ln=tp&63;
    #pragma unroll
    for(int o=1;o<64;o<<=1){ const float up=__builtin_bit_cast(float,__builtin_amdgcn_ds_bpermute((ln-o)<<2,__builtin_bit_cast(int,sc))); if(ln>=o)sc+=up; }
    if(ln==63)wt[tp>>6]=sc;
    __syncthreads();
    float base=sc-a3;
    #pragma unroll
    for(int w=0;w<NW-1;++w)if(w<(tp>>6))base+=wt[w];
    const float k2=-1.4426950408889634f;
    csp[4*tp]=k2*(base+a0);csp[4*tp+1]=k2*(base+a1);csp[4*tp+2]=k2*(base+a2);csp[4*tp+3]=k2*(base+a3);
    __syncthreads(); }
  for(int i=0;S.next(i,u);++i){ S.a_ready(u); attn_unit<THRL>(u.bh/NHEAD,u.bh%NHEAD,u.qb,T.Q,T.K,T.V,T.O,T.G,lds,tid_,T.THR); S.done(u); }
}
#undef SBAR
#undef WAIT_BAR
}
#define GAS __attribute__((address_space(1)))
#define LAS __attribute__((address_space(3)))
typedef unsigned short bf16;
typedef unsigned v4u __attribute__((ext_vector_type(4)));
typedef float f32x4 __attribute__((ext_vector_type(4)));
typedef short bf16x8 __attribute__((ext_vector_type(8)));
typedef GAS unsigned gu32;
typedef GAS unsigned long long gu64;
#define RLX_AGENT __ATOMIC_RELAXED, __HIP_MEMORY_SCOPE_AGENT
#define LDS_WAIT() asm volatile("s_waitcnt lgkmcnt(0)" ::: "memory")
#define VM_WAIT() asm volatile("s_waitcnt vmcnt(0)" ::: "memory")
__device__ __forceinline__ unsigned long long rt() { return __builtin_amdgcn_s_memrealtime(); }
__device__ __forceinline__ unsigned f2bf(float f) { unsigned u = __builtin_bit_cast(unsigned, f); return (u + 0x7fffu + ((u >> 16) & 1u)) >> 16; }
__device__ __forceinline__ unsigned pk2(float lo, float hi) { return f2bf(lo) | (f2bf(hi) << 16); }
__device__ __forceinline__ unsigned pk2h(float lo, float hi) { unsigned r; asm("v_cvt_pk_bf16_f32 %0, %1, %2" : "=v"(r) : "v"(lo), "v"(hi)); return r; }
__device__ __forceinline__ unsigned f2bfh(float f) { return pk2h(f, 0.f) & 0xffffu; }

#define XB_TMO      128
#define XB_XCNT(j)  (256  + 64 * (j))
#define XB_XSUB(j)  (1280 + 64 * (j))
#define XB_XGEN(j)  (2304 + 64 * (j))
#define XB_TOP      3328
#define XB_TOPGEN   3392
#define XCD_BAR_WORDS 3456
#define XB_SPIN_CAP (1u << 27)

__device__ __forceinline__ unsigned xb_ld(unsigned* p)              { return __hip_atomic_load(p, __ATOMIC_RELAXED, __HIP_MEMORY_SCOPE_AGENT); }
__device__ __forceinline__ unsigned xb_add(unsigned* p, unsigned v) { return __hip_atomic_fetch_add(p, v, __ATOMIC_RELAXED, __HIP_MEMORY_SCOPE_AGENT); }
__device__ __forceinline__ unsigned xb_xcc_id() { return (unsigned)__builtin_amdgcn_s_getreg((3 << 11) | 20) & 0xFu; }
#define XB_SPIN(cond, bar) do { unsigned _sp = 0; while (cond) { __builtin_amdgcn_s_sleep(1); \
    if ((++_sp & 255u) == 0u) { if (xb_ld(&(bar)[XB_TMO])) break; if (_sp > XB_SPIN_CAP) { atomicAdd(&(bar)[XB_TMO], 1u); break; } } } } while (0)

struct XcdBarrier {
    unsigned* bar; unsigned x;
    volatile LAS unsigned* st;
};

__device__ __forceinline__ XcdBarrier xcd_barrier_post(unsigned* bar, volatile LAS unsigned* st) {
    XcdBarrier b; b.bar = bar; b.x = xb_xcc_id(); b.st = st;
    if (threadIdx.x == 0) (void)xb_add(&bar[XB_XCNT(b.x)], 1u);
    return b;
}
__device__ __forceinline__ void xcd_barrier_complete(unsigned* bar, unsigned x, unsigned& nloc, unsigned& nx) {
    const unsigned G = gridDim.x * gridDim.y * gridDim.z;
    unsigned sum, cnt, mine, sp = 0u;
    for (;;) {
        sum = 0u; cnt = 0u; mine = 0u;
#pragma unroll
        for (unsigned j = 0; j < 16; ++j) { const unsigned c = xb_ld(&bar[XB_XCNT(j)]); sum += c; cnt += (c > 0u) ? 1u : 0u; mine = (j == x) ? c : mine; }
        if (sum == G) break;
        __builtin_amdgcn_s_sleep(1);
        if ((++sp & 255u) == 0u) { if (xb_ld(&bar[XB_TMO])) break; if (sp > XB_SPIN_CAP) { atomicAdd(&bar[XB_TMO], 1u); break; } }
    }
    nloc = mine > 0u ? mine : 1u; nx = cnt > 0u ? cnt : 1u;
}

__device__ __forceinline__ void xcd_barrier(const XcdBarrier& b, const bool leader  ) {
    asm volatile("s_waitcnt vmcnt(0)" ::: "memory");
    __syncthreads();
    if (leader) {
        unsigned* bar = b.bar;
        __builtin_amdgcn_s_waitcnt(0);
        unsigned nloc = b.st[0], nx = b.st[1];
        if (nloc == 0u) { xcd_barrier_complete(bar, b.x, nloc, nx); b.st[0] = nloc; b.st[1] = nx; }
        const unsigned old = xb_add(&bar[XB_XSUB(b.x)], 1u);
        const unsigned gen = old / nloc;
        if (old + 1u == (gen + 1u) * nloc) {
            __builtin_amdgcn_fence(__ATOMIC_RELEASE, "agent");
            asm volatile("s_waitcnt vmcnt(0)" ::: "memory");
            const unsigned og = xb_add(&bar[XB_TOP], 1u);
            const unsigned tg = og / nx;
            if (og + 1u == (tg + 1u) * nx) xb_add(&bar[XB_TOPGEN], 1u);
            else XB_SPIN(xb_ld(&bar[XB_TOPGEN]) == tg, bar);
            __builtin_amdgcn_fence(__ATOMIC_ACQUIRE, "agent");
            xb_add(&bar[XB_XGEN(b.x)], 1u);
            asm volatile("s_waitcnt vmcnt(0)" ::: "memory");
        } else {
            XB_SPIN(xb_ld(&bar[XB_XGEN(b.x)]) == gen, bar);
            __builtin_amdgcn_fence(__ATOMIC_ACQUIRE, "agent");
            asm volatile("s_waitcnt vmcnt(0)" ::: "memory");
        }
    }
    __syncthreads();
}
#ifndef MK_FASTATTN
#define MK_FASTATTN 1
#endif
#ifndef MK_FASTREC
#define MK_FASTREC 1
#endif
namespace cg = cooperative_groups;
constexpr int NTOK = 16384, DMODEL = 1024, NBATCH = 8, SEQLEN = 2048, DEPTH = 4;
constexpr int FOX_IN = 4112, GLA_IN = 3088, HGRN_IN = 4096;
constexpr float RMS_EPS = 1e-6f;
constexpr float LOG2E = 1.4426950408889634f;
constexpr float FOX_C2 = 0.125f * LOG2E;
constexpr int NWAVES = 8;

constexpr size_t MiB = 1u << 20;
constexpr size_t WS_CTL = 0, CTL_ZERO_BYTES = 1 * MiB;
constexpr size_t WS_FOXWIN = 2 * MiB, WS_FOXWOUT = 18 * MiB, WS_GLAWIN = 22 * MiB, WS_GLAWOUT = 28 * MiB, WS_HGRNWIN = 30 * MiB, WS_HGRNWOUT = 38 * MiB;
constexpr size_t WS_PEERWQ = 40 * MiB, WS_KEYS = 56 * MiB, WS_LB = 58 * MiB;
#define FOXFUSE ((I8MASK & 9) == 9)
#ifndef RPROBE
#define RPROBE 0
#endif
#ifndef GPROBE
#define GPROBE 0
#endif
#ifndef BGQ
#define BGQ 1
#endif
#ifndef I8MASK
#define I8MASK 13
#endif
constexpr size_t WS_SW = 58 * MiB + 65536, WS_SX = 58 * MiB + 262144, WS_XN8 = 724 * MiB;
constexpr size_t WS_TAILW = 63 * MiB;
constexpr size_t WS_RS = 62 * MiB;
constexpr size_t WS_U = 64 * MiB, WS_V = 128 * MiB, WS_SU = 60 * MiB, WS_SV = 61 * MiB;
constexpr size_t WS_XN = 320 * MiB, WS_P = 352 * MiB, WS_OB = 480 * MiB, WS_Q2 = 512 * MiB, WS_TAIL = 576 * MiB, WS_CUM = 577 * MiB;
constexpr size_t WS_EXP = 580 * MiB, WS_GATE = 588 * MiB, WS_OF = 596 * MiB, WS_GLOG = 660 * MiB, WS_HB = 740 * MiB, WS_END = 772 * MiB;
constexpr size_t PSTRIDE = (size_t)NTOK * 1024;
constexpr int CW_BAR = 4096;

constexpr int RING_BYTES = 131072;
constexpr int LDSCTL_OFF = 162816, MISC_OFF = LDSCTL_OFF + 320;
constexpr int LDS_BYTES = 163840;

typedef unsigned u32x4v __attribute__((ext_vector_type(4)));
struct Ctx {
    LAS unsigned char* lds; int tid, lane, wave, vcu, G, gw, NGW, bx;
    const float* in[21]; float* out; unsigned char* ws;
};

__device__ __forceinline__ float bf2f(unsigned short b) { return __uint_as_float(((unsigned)b) << 16); }
__device__ __forceinline__ float bflo(unsigned w) { return __uint_as_float(w << 16); }
__device__ __forceinline__ float bfhi(unsigned w) { return __uint_as_float(w & 0xffff0000u); }
#define DPP_ADD(v, ctrl, rm, bm) (v + __builtin_bit_cast(float, __builtin_amdgcn_update_dpp(0, __builtin_bit_cast(int, v), ctrl, rm, bm, false)))
#define DPP_MAX(v, ctrl, rm, bm) fmaxf(v, __builtin_bit_cast(float, __builtin_amdgcn_update_dpp(__builtin_bit_cast(int, v), __builtin_bit_cast(int, v), ctrl, rm, bm, false)))
#define DPP_SUM31(v) do { v = DPP_ADD(v, 0x111, 0xf, 0xf); v = DPP_ADD(v, 0x112, 0xf, 0xf); v = DPP_ADD(v, 0x114, 0xf, 0xe); v = DPP_ADD(v, 0x118, 0xf, 0xc); v = DPP_ADD(v, 0x142, 0xa, 0xf); } while (0)
#define DPP_SUM63(v) do { DPP_SUM31(v); v = DPP_ADD(v, 0x143, 0xc, 0xf); } while (0)
__device__ __forceinline__ float rdlane(float v, int lane) { return __builtin_bit_cast(float, __builtin_amdgcn_readlane(__builtin_bit_cast(int, v), lane)); }
__device__ __forceinline__ float wave_sum(float v) { DPP_SUM63(v); return rdlane(v, 63); }
__device__ __forceinline__ float wave_max(float v) {
    v = DPP_MAX(v, 0x111, 0xf, 0xf); v = DPP_MAX(v, 0x112, 0xf, 0xf); v = DPP_MAX(v, 0x114, 0xf, 0xe); v = DPP_MAX(v, 0x118, 0xf, 0xc); v = DPP_MAX(v, 0x142, 0xa, 0xf); v = DPP_MAX(v, 0x143, 0xc, 0xf);
    return rdlane(v, 63);
}
typedef __bf16 bf16x2_t __attribute__((ext_vector_type(2)));
__device__ __forceinline__ float dot2bf(unsigned w, unsigned x, float acc) { return __builtin_amdgcn_fdot2_f32_bf16(__builtin_bit_cast(bf16x2_t, w), __builtin_bit_cast(bf16x2_t, x), acc, false); }
__device__ __forceinline__ float bperm(float v, int src_lane) { return __builtin_bit_cast(float, __builtin_amdgcn_ds_bpermute(src_lane << 2, __builtin_bit_cast(int, v))); }
__device__ __forceinline__ float log_sigmoid_f(float x) { return fminf(x, 0.f) - log1pf(__expf(-fabsf(x))); }
__device__ __forceinline__ float sigmoid_f(float x) { return 1.f / (1.f + __expf(-x)); }

__device__ __forceinline__ void p0_transpose_item(const float* W, int ldw, int K, int Nuse, bf16* WT, LAS float* scr, int item, int lane) {
    const int nblk = Nuse / 32, kb = item / nblk, nb = item % nblk, k0 = 64 * kb, n0 = 32 * nb;
#pragma unroll
    for (int i = 0; i < 8; ++i) { const int kk = 8 * i + (lane >> 3); const f32x4 v = *(const GAS f32x4*)(W + (size_t)(k0 + kk) * ldw + n0 + 4 * (lane & 7));
        LAS float* d = scr + kk * 33 + 4 * (lane & 7); d[0] = v.x; d[1] = v.y; d[2] = v.z; d[3] = v.w; }
    LDS_WAIT(); asm volatile("" ::: "memory");
    const int c = lane & 7;
#pragma unroll
    for (int j = 0; j < 4; ++j) { const int n = (lane >> 3) + 8 * j; const LAS float* s = scr + (8 * c) * 33 + n;
        v4u o; o.x = pk2(s[0 * 33], s[1 * 33]); o.y = pk2(s[2 * 33], s[3 * 33]); o.z = pk2(s[4 * 33], s[5 * 33]); o.w = pk2(s[6 * 33], s[7 * 33]);
        *(GAS v4u*)(WT + (size_t)(n0 + n) * K + k0 + 8 * c) = o; }
    LDS_WAIT(); asm volatile("" ::: "memory");
}
__device__ __forceinline__ unsigned q8x4(float a, float b, float c, float d) {
    return ((unsigned)(int)__builtin_rintf(a) & 0xffu) | (((unsigned)(int)__builtin_rintf(b) & 0xffu) << 8) | (((unsigned)(int)__builtin_rintf(c) & 0xffu) << 16) | ((unsigned)(int)__builtin_rintf(d) << 24);
}
__device__ __forceinline__ void p0_colmax_item(const float* W, int ldw, unsigned* cmax, int item, int lane) {
    const int nb = item >> 3, n0 = 32 * nb, k0 = 128 * (item & 7);
    f32x4 v[16];
#pragma unroll
    for (int i = 0; i < 16; ++i) v[i] = *(const GAS f32x4*)(W + (size_t)(k0 + 8 * i + (lane >> 3)) * ldw + n0 + 4 * (lane & 7));
    __builtin_amdgcn_sched_barrier(0);
    float mx[4] = {0.f, 0.f, 0.f, 0.f};
#pragma unroll
    for (int i = 0; i < 16; ++i) { mx[0] = fmaxf(mx[0], fabsf(v[i].x)); mx[1] = fmaxf(mx[1], fabsf(v[i].y)); mx[2] = fmaxf(mx[2], fabsf(v[i].z)); mx[3] = fmaxf(mx[3], fabsf(v[i].w)); }
#pragma unroll
    for (int j = 0; j < 4; ++j) { mx[j] = fmaxf(mx[j], bperm(mx[j], lane ^ 8)); mx[j] = fmaxf(mx[j], bperm(mx[j], lane ^ 16)); mx[j] = fmaxf(mx[j], bperm(mx[j], lane ^ 32)); }
    if (lane < 8) {
#pragma unroll
        for (int j = 0; j < 4; ++j) (void)__hip_atomic_fetch_max(cmax + n0 + 4 * lane + j, __float_as_uint(mx[j]), __ATOMIC_RELAXED, __HIP_MEMORY_SCOPE_AGENT);
    }
}
__device__ __forceinline__ void p0_quant_item(const float* W, int ldw, const unsigned* cmax, signed char* W8, float* sw, LAS float* scr, int item, int lane, bool headperm) {
    const int nb = item >> 3, n0 = 32 * nb, k0 = 128 * (item & 7);
    const int n0s = (headperm && nb < 64) ? (nb >> 3) * 256 + 64 * (nb & 3) + 32 * ((nb >> 2) & 1) : n0;
    f32x4 v[2][8];
#pragma unroll
    for (int h = 0; h < 2; ++h)
#pragma unroll
        for (int i = 0; i < 8; ++i) v[h][i] = *(const GAS f32x4*)(W + (size_t)(k0 + 64 * h + 8 * i + (lane >> 3)) * ldw + n0s + 4 * (lane & 7));
    float ci[4];
#pragma unroll
    for (int j = 0; j < 4; ++j) { const float m = __uint_as_float(*(const GAS unsigned*)(cmax + n0s + (lane >> 3) + 8 * j)); ci[j] = m > 0.f ? 127.f / m : 0.f; }
    if ((item & 7) == 0 && lane < 32) *(GAS float*)(sw + n0 + lane) = __uint_as_float(*(const GAS unsigned*)(cmax + n0s + lane)) * (1.f / 127.f);
    __builtin_amdgcn_sched_barrier(0);
    const int c = lane & 7;
#pragma unroll
    for (int h = 0; h < 2; ++h) {
        LDS_WAIT(); asm volatile("" ::: "memory");
#pragma unroll
        for (int i = 0; i < 8; ++i) { LAS float* d = scr + (8 * i + (lane >> 3)) * 33 + 4 * (lane & 7); d[0] = v[h][i].x; d[1] = v[h][i].y; d[2] = v[h][i].z; d[3] = v[h][i].w; }
        LDS_WAIT(); asm volatile("" ::: "memory");
#pragma unroll
        for (int j = 0; j < 4; ++j) { const int n = (lane >> 3) + 8 * j; const LAS float* sp = scr + (8 * c) * 33 + n;
            const unsigned lo = q8x4(sp[0] * ci[j], sp[33] * ci[j], sp[66] * ci[j], sp[99] * ci[j]), hi = q8x4(sp[132] * ci[j], sp[165] * ci[j], sp[198] * ci[j], sp[231] * ci[j]);
            *(GAS unsigned long long*)(W8 + (size_t)(n0 + n) * 1024 + k0 + 64 * h + 8 * c) = (unsigned long long)lo | ((unsigned long long)hi << 32); }
    }
    LDS_WAIT(); asm volatile("" ::: "memory");
}
__device__ __forceinline__ void rms_row_to_bf16(int lane, f32x4 (&v)[4], const float* gain, bf16* orow, signed char* orow8, float* sx) {
    const GAS f32x4* gr = (const GAS f32x4*)gain + lane;
    float s = 0.f;
#pragma unroll
    for (int j = 0; j < 4; ++j) s += (v[j].x * v[j].x + v[j].y * v[j].y) + (v[j].z * v[j].z + v[j].w * v[j].w);
    const float r = rsqrtf(wave_sum(s) * (1.f / 1024.f) + RMS_EPS);
    GAS unsigned long long* o8 = (GAS unsigned long long*)orow + lane; float am = 0.f;
#pragma unroll
    for (int j = 0; j < 4; ++j) { const f32x4 g = gr[64 * j]; v[j].x *= r * g.x; v[j].y *= r * g.y; v[j].z *= r * g.z; v[j].w *= r * g.w;
        am = fmaxf(fmaxf(am, fmaxf(fabsf(v[j].x), fabsf(v[j].y))), fmaxf(fabsf(v[j].z), fabsf(v[j].w)));
        o8[64 * j] = (unsigned long long)pk2(v[j].x, v[j].y) | ((unsigned long long)pk2(v[j].z, v[j].w) << 32); }
    am = wave_max(am); const float qi = am > 0.f ? 127.f / am : 0.f;
    GAS unsigned* q8 = (GAS unsigned*)orow8 + lane;
#pragma unroll
    for (int j = 0; j < 4; ++j) q8[64 * j] = q8x4(v[j].x * qi, v[j].y * qi, v[j].z * qi, v[j].w * qi);
    if (lane == 0) *(GAS float*)sx = am * (1.f / 127.f);
}
__device__ __forceinline__ void cvt_f32_bf16(const Ctx& C, const float* src, bf16* dst, size_t n) {
    const size_t nth = (size_t)C.G * 512, t0 = (size_t)C.vcu * 512 + C.tid;
    for (size_t i = t0; i < n / 8; i += nth) {
        const f32x4 a = ((const GAS f32x4*)src)[2 * i], b = ((const GAS f32x4*)src)[2 * i + 1];
        v4u o; o.x = pk2(a.x, a.y); o.y = pk2(a.z, a.w); o.z = pk2(b.x, b.y); o.w = pk2(b.z, b.w);
        ((GAS v4u*)dst)[i] = o;
    }
}
template <bool I8> __device__ __forceinline__ void quant_row_fp8(int lane, const f32x4 (&v)[4], unsigned char* drow, unsigned char* sc) {
    float am = 0.f;
#pragma unroll
    for (int i = 0; i < 4; ++i) am = fmaxf(am, fmaxf(fmaxf(fabsf(v[i].x), fabsf(v[i].y)), fmaxf(fabsf(v[i].z), fabsf(v[i].w))));
    am = wave_max(am);
    const unsigned sbits = __float_as_uint(am * (I8 ? 1.f / 127.f : 1.f / 448.f));
    unsigned e = (sbits >> 23) + ((sbits & 0x7fffffu) ? 1u : 0u); e = am > 0.f ? (e < 1u ? 1u : e > 254u ? 254u : e) : 127u;
    const float inv = __uint_as_float((254u - e) << 23);
    GAS unsigned* o = (GAS unsigned*)drow + lane;
#pragma unroll
    for (int i = 0; i < 4; ++i) {
        if (I8) { o[64 * i] = q8x4(v[i].x * inv, v[i].y * inv, v[i].z * inv, v[i].w * inv); continue; }
        const float a = fminf(fmaxf(v[i].x * inv, -448.f), 448.f), b = fminf(fmaxf(v[i].y * inv, -448.f), 448.f), c = fminf(fmaxf(v[i].z * inv, -448.f), 448.f), d = fminf(fmaxf(v[i].w * inv, -448.f), 448.f);
        int w = 0; w = __builtin_amdgcn_cvt_pk_fp8_f32(a, b, w, false); w = __builtin_amdgcn_cvt_pk_fp8_f32(c, d, w, true); o[64 * i] = (unsigned)w;
    }
    if (lane == 0) *(GAS unsigned char*)sc = (unsigned char)e;
}
template <bool I8> __device__ __forceinline__ void quant_rows_fp8(const Ctx& C, const float* src, unsigned char* dst, unsigned char* scales, int nrows) {
    int rw = C.gw;
    for (; rw + 3 * C.NGW < nrows; rw += 4 * C.NGW) {
        f32x4 v[4][4];
#pragma unroll
        for (int j = 0; j < 4; ++j) { const GAS f32x4* xr = (const GAS f32x4*)(src + (size_t)(rw + j * C.NGW) * 1024) + C.lane;
#pragma unroll
            for (int i = 0; i < 4; ++i) v[j][i] = xr[64 * i]; }
        __builtin_amdgcn_sched_barrier(0);
#pragma unroll
        for (int j = 0; j < 4; ++j) quant_row_fp8<I8>(C.lane, v[j], dst + (size_t)(rw + j * C.NGW) * 1024, scales + rw + j * C.NGW);
    }
    for (; rw < nrows; rw += C.NGW) {
        const GAS f32x4* xr = (const GAS f32x4*)(src + (size_t)rw * 1024) + C.lane;
        f32x4 v[4];
#pragma unroll
        for (int i = 0; i < 4; ++i) v[i] = xr[64 * i];
        quant_row_fp8<I8>(C.lane, v, dst + (size_t)rw * 1024, scales + rw);
    }
}
constexpr int BGQ_ROWS = 3 * 16384;
template <int JOB> __device__ __forceinline__ bool bgq_row(const Ctx& C, int idx, const float*& src, unsigned char*& dst, unsigned char*& sc) {
    const int seg = idx >> 14, row = idx & 16383;
    const bool isV = seg == 1 || (seg == 2 && JOB == 2);
    const size_t flat = (size_t)(seg < 2 ? JOB : 3) * 16384 + row;
    src = (isV ? C.in[20] : C.in[19]) + flat * 1024; dst = C.ws + (isV ? WS_V : WS_U) + flat * 1024; sc = C.ws + (isV ? WS_SV : WS_SU) + flat; return isV;
}
template <int JOB> __device__ __forceinline__ void bgq_step(const Ctx& C, int idx_prev, int idx, f32x4 (&v)[4]) {
    const float* src; unsigned char* dst; unsigned char* sc;
    if (idx_prev >= 0 && idx_prev < BGQ_ROWS) { if (bgq_row<JOB>(C, idx_prev, src, dst, sc)) quant_row_fp8<false>(C.lane, v, dst, sc); else quant_row_fp8<true>(C.lane, v, dst, sc); }
    if (idx < BGQ_ROWS) { (void)bgq_row<JOB>(C, idx, src, dst, sc); const GAS f32x4* xr = (const GAS f32x4*)src + C.lane;
#pragma unroll
        for (int i = 0; i < 4; ++i) v[i] = xr[64 * i]; }
}
#ifndef PRO_PROBE
#define PRO_PROBE 0
#endif
constexpr int CW_CMAX = 131072;
constexpr int I8_NF0 = (I8MASK & 1) ? 1024 : 0, I8_NF3 = (I8MASK & 8) ? 1024 : 0, I8_NG = (I8MASK & 2) ? 768 : 0, I8_NH = (I8MASK & 4) ? 1024 : 0, I8_NITEMS = I8_NF0 + I8_NF3 + I8_NG + I8_NH;
template <bool PASS2> __device__ __forceinline__ void p0_i8_items(const Ctx& C, LAS float* scr) {
    unsigned* CM = (unsigned*)(C.ws + WS_CTL) + CW_CMAX; float* SW = (float*)(C.ws + WS_SW);
    for (int it = C.gw; it < I8_NITEMS; it += C.NGW) {
        int r = it; const float* W; int ldw; signed char* W8; int q;
        if (r < I8_NF0) { W = C.in[3]; ldw = FOX_IN; W8 = (signed char*)(C.ws + WS_FOXWIN); q = 0; }
        else if ((r -= I8_NF0) < I8_NF3) { W = C.in[3] + (size_t)1024 * FOX_IN; ldw = FOX_IN; W8 = (signed char*)(C.ws + WS_FOXWIN + 8 * MiB); q = 1; }
        else if ((r -= I8_NF3) < I8_NG) { W = C.in[8]; ldw = GLA_IN; W8 = (signed char*)(C.ws + WS_GLAWIN); q = 2; }
        else { r -= I8_NG; W = C.in[13]; ldw = HGRN_IN; W8 = (signed char*)(C.ws + WS_HGRNWIN); q = 3; }
        const int swo = q == 0 ? 0 : q == 1 ? 4096 : q == 2 ? 8192 : 11264;
        if (PASS2) p0_quant_item(W, ldw, CM + q * 4096, W8, SW + swo, scr, r, C.lane, FOXFUSE && q < 2); else p0_colmax_item(W, ldw, CM + q * 4096, r, C.lane);
    }
}
__device__ __forceinline__ void p0_prologue_b(const Ctx& C) { p0_i8_items<true>(C, (LAS float*)(C.lds + C.wave * 16384)); }
__device__ __forceinline__ void p0_prologue(const Ctx& C) {
    LAS float* scr = (LAS float*)(C.lds + C.wave * 16384);
    for (int rep_ = 0; rep_ < (PRO_PROBE == 1 ? 2 : 1); ++rep_) {
    p0_i8_items<false>(C, scr);
    constexpr int I_SQ = 16 * 32, N_F0 = (I8MASK & 1) ? 0 : 16 * 128, N_F3 = (I8MASK & 8) ? 0 : 16 * 128, N_G = (I8MASK & 2) ? 0 : 16 * 96, N_H = (I8MASK & 4) ? 0 : 16 * 128;
    constexpr int NITEMS = N_F0 + N_F3 + N_G + N_H + 2 * I_SQ + I_SQ + I_SQ;
    for (int it = C.gw; it < NITEMS; it += C.NGW) {
        int r = it;
        if (r < N_F0) { p0_transpose_item(C.in[3], FOX_IN, 1024, 4096, (bf16*)(C.ws + WS_FOXWIN), scr, r, C.lane); continue; } r -= N_F0;
        if (r < N_F3) { p0_transpose_item(C.in[3] + (size_t)1024 * FOX_IN, FOX_IN, 1024, 4096, (bf16*)(C.ws + WS_FOXWIN + 8 * MiB), scr, r, C.lane); continue; } r -= N_F3;
        if (r < N_G) { p0_transpose_item(C.in[8], GLA_IN, 1024, 3072, (bf16*)(C.ws + WS_GLAWIN), scr, r, C.lane); continue; } r -= N_G;
        if (r < N_H) { p0_transpose_item(C.in[13], HGRN_IN, 1024, 4096, (bf16*)(C.ws + WS_HGRNWIN), scr, r, C.lane); continue; } r -= N_H;
        if (r < 2 * I_SQ) { const int j = r / I_SQ; p0_transpose_item(C.in[7] + (size_t)j * 1024 * 1024, 1024, 1024, 1024, (bf16*)(C.ws + WS_FOXWOUT) + (size_t)j * 1024 * 1024, scr, r % I_SQ, C.lane); continue; } r -= 2 * I_SQ;
        if (r < I_SQ) { p0_transpose_item(C.in[12], 1024, 1024, 1024, (bf16*)(C.ws + WS_GLAWOUT), scr, r, C.lane); continue; } r -= I_SQ;
        p0_transpose_item(C.in[16], 1024, 1024, 1024, (bf16*)(C.ws + WS_HGRNWOUT), scr, r, C.lane);
    }
    }
    for (int rep_ = 0; rep_ < (PRO_PROBE == 2 ? 2 : 1); ++rep_) {
    constexpr int MT_GROUPS = 4 * 16 * 4 * 32;
    for (int grp = C.gw; grp < MT_GROUPS; grp += C.NGW) {
        const int nb2 = grp & 31, kb2 = (grp >> 5) & 3, hp = (grp >> 7) & 15, layer = grp >> 11;
        const float* kp = C.in[18] + ((size_t)(layer * 16 + hp) * 128 + kb2 * 32 + (C.lane & 15)) * 128 + 4 * (C.lane >> 4);
        const float* wp = C.in[17] + ((size_t)layer * 1024 + nb2 * 32 + (C.lane & 15)) * 2048 + hp * 128 + 4 * (C.lane >> 4);
        f32x4 ka[2][8], wb[2][8];
#pragma unroll
        for (int u = 0; u < 2; ++u)
#pragma unroll
            for (int s8 = 0; s8 < 8; ++s8) { ka[u][s8] = *(const GAS f32x4*)(kp + (size_t)u * 16 * 128 + 16 * s8); wb[u][s8] = *(const GAS f32x4*)(wp + (size_t)u * 16 * 2048 + 16 * s8); }
        __builtin_amdgcn_sched_barrier(0);
        f32x4 acc[2][2];
#pragma unroll
        for (int a = 0; a < 2; ++a)
#pragma unroll
            for (int b = 0; b < 2; ++b) acc[a][b] = (f32x4){0.f, 0.f, 0.f, 0.f};
#pragma unroll
        for (int s8 = 0; s8 < 8; ++s8)
#pragma unroll
            for (int a = 0; a < 2; ++a)
#pragma unroll
                for (int b = 0; b < 2; ++b) { const f32x4 x = ka[a][s8], y = wb[b][s8];
                    acc[a][b] = __builtin_amdgcn_mfma_f32_16x16x4f32(x.x, y.x, acc[a][b], 0, 0, 0); acc[a][b] = __builtin_amdgcn_mfma_f32_16x16x4f32(x.y, y.y, acc[a][b], 0, 0, 0);
                    acc[a][b] = __builtin_amdgcn_mfma_f32_16x16x4f32(x.z, y.z, acc[a][b], 0, 0, 0); acc[a][b] = __builtin_amdgcn_mfma_f32_16x16x4f32(x.w, y.w, acc[a][b], 0, 0, 0); }
#pragma unroll
        for (int a = 0; a < 2; ++a)
#pragma unroll
            for (int b = 0; b < 2; ++b) {
                bf16* mt = (bf16*)(C.ws + WS_PEERWQ) + ((size_t)layer * 2048 + hp * 128 + kb2 * 32 + a * 16 + (C.lane >> 4) * 4) * 1024 + nb2 * 32 + b * 16 + (C.lane & 15);
#pragma unroll
                for (int r = 0; r < 4; ++r) mt[(size_t)r * 1024] = (bf16)f2bf(acc[a][b][r]); }
    }
    }
    for (int rep_ = 0; rep_ < (PRO_PROBE == 3 ? 2 : 1); ++rep_) {
    quant_rows_fp8<true>(C, C.in[19], C.ws + WS_U, C.ws + WS_SU, BGQ ? 16384 : 4 * 16384);
    quant_rows_fp8<false>(C, C.in[20], C.ws + WS_V, C.ws + WS_SV, BGQ ? 16384 : 4 * 16384);
    }
    for (int rep_ = 0; rep_ < (PRO_PROBE == 4 ? 2 : 1); ++rep_) {
    for (int i = C.vcu * 512 + C.tid; i < 3 * 16 * 1024; i += C.G * 512) {
        const int w = i >> 14, n = (i >> 10) & 15, k = i & 1023;
        const float v = w < 2 ? C.in[3][(size_t)w * 1024 * FOX_IN + (size_t)k * FOX_IN + 4096 + n] : C.in[8][(size_t)k * GLA_IN + 3072 + n];
        ((bf16*)(C.ws + WS_TAILW))[i] = (bf16)f2bf(v);
    }
    if (C.vcu == 0) for (int c = C.tid; c < 1024; c += 512) {
        const float l0 = C.in[14][c], l1 = C.in[14][1024 + c], l2 = C.in[14][2048 + c], l3 = C.in[14][3072 + c];
        const float m = fmaxf(fmaxf(l0, l1), fmaxf(l2, l3));
        const float e0 = expf(l0 - m), e1 = expf(l1 - m), e2 = expf(l2 - m), e3 = expf(l3 - m);
        ((float*)(C.ws + WS_LB))[c] = (e1 + e2) / (e0 + e1 + e2 + e3);
    }
    for (int m0 = C.gw; m0 < NTOK; m0 += 4 * C.NGW) {
        f32x4 v[4][4];
#pragma unroll
        for (int u = 0; u < 4; ++u) { const int m = m0 + u * C.NGW; if (m < NTOK) { const GAS f32x4* xr = (const GAS f32x4*)(C.in[0] + (size_t)m * 1024) + C.lane;
#pragma unroll
            for (int j = 0; j < 4; ++j) v[u][j] = xr[64 * j]; } }
        __builtin_amdgcn_sched_barrier(0);
#pragma unroll
        for (int u = 0; u < 4; ++u) { const int m = m0 + u * C.NGW; if (m < NTOK)
            rms_row_to_bf16(C.lane, v[u], C.in[1], (bf16*)(C.ws + WS_XN) + (size_t)m * 1024, (signed char*)(C.ws + WS_XN8) + (size_t)m * 1024, (float*)(C.ws + WS_SX) + m); }
    }
    }
}

__device__ __forceinline__ void tail_mfma(const Ctx& C, int tok0, const bf16* WT, LAS float* part) {
    const int l = C.lane, m = l & 15, g = l >> 4, tbk = C.wave & 3, kh = C.wave >> 2;
    const bf16* ap = (const bf16*)(C.ws + WS_XN) + (size_t)(tok0 + 16 * tbk + m) * 1024 + kh * 512 + 8 * g;
    const bf16* bp = WT + (size_t)m * 1024 + kh * 512 + 8 * g;
    f32x4 acc = (f32x4){0.f, 0.f, 0.f, 0.f};
#pragma unroll 4
    for (int ks = 0; ks < 16; ++ks) acc = __builtin_amdgcn_mfma_f32_16x16x32_bf16(*(const bf16x8*)(ap + 32 * ks), *(const bf16x8*)(bp + 32 * ks), acc, 0, 0, 0);
#pragma unroll
    for (int r = 0; r < 4; ++r) part[kh * 1024 + (16 * tbk + 4 * g + r) * 16 + m] = acc[r];
}
template <bool QK> __device__ __forceinline__ void fox_step1(const Ctx& C, int j) {
    float* TAIL = (float*)(C.ws + WS_TAIL); LAS float* part = (LAS float*)C.lds;
    const bf16* WT = (const bf16*)(C.ws + WS_TAILW) + (size_t)j * 16 * 1024;
    for (int tb = C.vcu; tb < NTOK / 64; tb += C.G) {
        __syncthreads();
        tail_mfma(C, tb * 64, WT, part);
        __syncthreads();
#pragma unroll
        for (int rep = 0; rep < 2; ++rep) { const int i = rep * 512 + C.tid; TAIL[(size_t)tb * 1024 + i] = log_sigmoid_f(part[i] + part[1024 + i] + C.in[4][j * 16 + (i & 15)]); }
        if (!QK) continue;
        const float* gq = C.in[5] + j * 64; const float* gk = C.in[6] + j * 64;
        v4u ra[2][8], rb[2][8];
#pragma unroll
        for (int which = 0; which < 2; ++which)
#pragma unroll
            for (int t = 0; t < 8; ++t) { const bf16* row = (const bf16*)(C.ws + WS_P) + (size_t)which * PSTRIDE + (size_t)(tb * 64 + C.wave * 8 + t) * 1024 + C.lane * 16;
                ra[which][t] = *(const GAS v4u*)row; rb[which][t] = *(const GAS v4u*)(row + 8); }
        __builtin_amdgcn_sched_barrier(0);
#pragma unroll
        for (int which = 0; which < 2; ++which) {
            const float* g = (which == 0 ? gq : gk) + (C.lane & 3) * 16;
            float gv[16];
#pragma unroll
            for (int i = 0; i < 16; ++i) gv[i] = g[i];
#pragma unroll
            for (int t = 0; t < 8; ++t) {
                bf16* row = (bf16*)(C.ws + WS_P) + (size_t)which * PSTRIDE + (size_t)(tb * 64 + C.wave * 8 + t) * 1024 + C.lane * 16;
                const v4u a = ra[which][t], b = rb[which][t];
                float v[16] = {bflo(a.x), bfhi(a.x), bflo(a.y), bfhi(a.y), bflo(a.z), bfhi(a.z), bflo(a.w), bfhi(a.w), bflo(b.x), bfhi(b.x), bflo(b.y), bfhi(b.y), bflo(b.z), bfhi(b.z), bflo(b.w), bfhi(b.w)};
                float ss = 0.f;
#pragma unroll
                for (int i = 0; i < 16; ++i) ss += v[i] * v[i];
                ss = DPP_ADD(ss, 0xB1, 0xf, 0xf); ss = DPP_ADD(ss, 0x4E, 0xf, 0xf);
                const float r = rsqrtf(ss * (1.f / 64.f) + RMS_EPS) * (which == 0 ? FOX_C2 : 1.f);
#pragma unroll
                for (int i = 0; i < 16; ++i) v[i] = v[i] * r * gv[i];
                v4u oa, ob; oa.x = pk2(v[0], v[1]); oa.y = pk2(v[2], v[3]); oa.z = pk2(v[4], v[5]); oa.w = pk2(v[6], v[7]);
                ob.x = pk2(v[8], v[9]); ob.y = pk2(v[10], v[11]); ob.z = pk2(v[12], v[13]); ob.w = pk2(v[14], v[15]);
                *(GAS v4u*)row = oa; *(GAS v4u*)(row + 8) = ob;
            }
        }
    }
}
constexpr size_t WS_ASC = WS_Q2, WS_Q1 = WS_Q2 + 16 * MiB, WS_KST = WS_Q2 + 48 * MiB, WS_DEC = 59 * MiB;
static_assert(WS_KST + 32 * MiB <= WS_OF && WS_Q1 + 32 * MiB <= WS_KST, "chunk workspace map");
template <int NH>
__device__ __forceinline__ void chunk_prepass(const Ctx& C) {
    bf16* ASC = (bf16*)(C.ws + WS_ASC); bf16* Q1 = (bf16*)(C.ws + WS_Q1); bf16* KST = (bf16*)(C.ws + WS_KST); float* DEC = (float*)(C.ws + WS_DEC);
    const bf16* P0 = (const bf16*)(C.ws + WS_P); const bf16* P1 = P0 + PSTRIDE;
    LAS bf16* tqs = (LAS bf16*)C.lds;
    LAS bf16* tks = tqs + 64 * 128;
    LAS bf16* q2s = tks + 64 * 128;
    LAS bf16* k2s = q2s + 64 * 136;
    LAS bf16* q1s = k2s + 64 * 136;
    LAS float* tot = (LAS float*)(q1s + 64 * 128);
    LAS float* part = tot + 512;
    const float qs = 0.08838834764831845f;
    const int d = C.tid & 127, tq = C.tid >> 7, l = C.lane, fr = l & 15, fq = l >> 4;
    const int dq = (d & ~31) + ((d & 16) ? 8 * ((d & 15) >> 2) + 4 + (d & 3) : 8 * ((d & 15) >> 2) + (d & 3));
    const int pr0 = C.tid >> 4, pc = (C.tid & 15) * 8;
#define PP_BAR() do { asm volatile("s_waitcnt lgkmcnt(0)" ::: "memory"); __builtin_amdgcn_s_barrier(); asm volatile("" ::: "memory"); } while (0)
    for (int itb = C.vcu; itb < NBATCH * 32; itb += C.G) {
        const int c = itb & 31, b = itb >> 5;
        const size_t rowb = (size_t)b * SEQLEN + c * 64;
        const size_t row0 = rowb + tq * 16;
        if (NH == 4) { __syncthreads(); tail_mfma(C, b * SEQLEN + c * 64, (const bf16*)(C.ws + WS_TAILW) + 2 * 16 * 1024, part); }
        v4u pq[2], pk[2];
#define PP_LOAD(h_) do { _Pragma("unroll") for (int j = 0; j < 2; ++j) { const size_t r_ = (rowb + pr0 + 32 * j) * 1024 + (h_) * 128 + pc; \
            pq[j] = *(const GAS v4u*)(P0 + r_); pk[j] = *(const GAS v4u*)((NH == 4 ? P0 + 512 : P1) + r_); } } while (0)
        PP_LOAD(0);
#pragma unroll 1
        for (int h = 0; h < NH; ++h) {
            const int it = (b * NH + h) * 32 + c;
            float wu[16]; float ba = 0.f, lb = 0.f;
            if (NH == 4) {
#pragma unroll
                for (int r = 0; r < 16; ++r) wu[r] = C.in[9][r * 512 + h * 128 + d];
                ba = C.in[10][h * 128 + d];
            } else lb = ((const float*)(C.ws + WS_LB))[h * 128 + d];
            PP_BAR();
#pragma unroll
            for (int j = 0; j < 2; ++j) { *(LAS v4u*)(tqs + (pr0 + 32 * j) * 128 + pc) = pq[j]; *(LAS v4u*)(tks + (pr0 + 32 * j) * 128 + pc) = pk[j]; }
            if (h + 1 < NH) PP_LOAD(h + 1);
            PP_BAR();
            float bl[16], kk[16]; float run = 0.f;
            if (NH == 4) {
#pragma unroll
                for (int i = 0; i < 16; ++i) { float z = ba; const int t = tq * 16 + i;
#pragma unroll
                    for (int r = 0; r < 16; r += 4) { const f32x4 p0 = *(const LAS f32x4*)(part + t * 16 + r), p1 = *(const LAS f32x4*)(part + 1024 + t * 16 + r);
                        z += (p0[0] + p1[0]) * wu[r] + (p0[1] + p1[1]) * wu[r + 1] + (p0[2] + p1[2]) * wu[r + 2] + (p0[3] + p1[3]) * wu[r + 3]; }
                    run += log_sigmoid_f(z) * (1.f / 16.f); bl[i] = run; kk[i] = bf2f(tks[t * 128 + d]); }
            } else {
#pragma unroll
                for (int i = 0; i < 16; ++i) { const float gate = lb + (1.f - lb) * sigmoid_f(bf2f(tks[(tq * 16 + i) * 128 + d])); run += __logf(gate); bl[i] = run; kk[i] = 1.f - gate; }
            }
            tot[tq * 128 + d] = run;
            PP_BAR();
            const float t0 = tot[d], t1 = tot[128 + d], t2 = tot[256 + d], t3 = tot[384 + d];
            const float off = tq == 0 ? 0.f : tq == 1 ? t0 : tq == 2 ? t0 + t1 : t0 + t1 + t2;
            const float bref = t0 + t1, bend = (t0 + t1) + (t2 + t3);
            unsigned ksw[8];
#pragma unroll
            for (int i = 0; i < 16; ++i) {
                const float bb = bl[i] + off;
                const float qv = bf2f(tqs[(tq * 16 + i) * 128 + d]) * qs, kv = kk[i];
                q1s[(tq * 16 + i) * 128 + dq] = (bf16)f2bfh(qv * __expf(bb));
                q2s[(tq * 16 + i) * 136 + d] = (bf16)f2bfh(qv * __expf(bb - bref));
                k2s[(tq * 16 + i) * 136 + d] = (bf16)f2bfh(kv * __expf(bref - bb));
                const unsigned kb = f2bfh(kv * __expf(bend - bb));
                if (i & 1) ksw[i >> 1] |= kb << 16; else ksw[i >> 1] = kb;
            }
            { bf16* kt = KST + ((size_t)it * 128 + d) * 64 + tq * 16; *(GAS v4u*)kt = (v4u){ksw[0], ksw[1], ksw[2], ksw[3]}; *(GAS v4u*)(kt + 8) = (v4u){ksw[4], ksw[5], ksw[6], ksw[7]}; }
            if (tq == 0) DEC[(size_t)it * 128 + d] = __expf(bend);
            PP_BAR();
#pragma unroll
            for (int j = 0; j < 2; ++j) *(GAS v4u*)(Q1 + (((size_t)it * 4 + (pc >> 5)) * 64 + pr0 + 32 * j) * 32 + (pc & 31)) = *(const LAS v4u*)(q1s + (pr0 + 32 * j) * 128 + pc);
            const int ti = C.wave >> 1;
#pragma unroll
            for (int sj = 0; sj < 2; ++sj) {
                const int si = 2 * (C.wave & 1) + sj;
                f32x4 acc = (f32x4){0.f, 0.f, 0.f, 0.f};
                if (si <= ti) {
#pragma unroll
                    for (int ks = 0; ks < 4; ++ks) {
                        const bf16x8 a = *(const LAS bf16x8*)(q2s + (16 * ti + fr) * 136 + ks * 32 + fq * 8), bb = *(const LAS bf16x8*)(k2s + (16 * si + fr) * 136 + ks * 32 + fq * 8);
                        acc = __builtin_amdgcn_mfma_f32_16x16x32_bf16(bb, a, acc, 0, 0, 0);
                    }
                }
                const int t = 16 * ti + fr, s0 = 16 * si + 4 * fq;
                typedef unsigned u32x2v __attribute__((ext_vector_type(2)));
                u32x2v w; w.x = pk2(s0 <= t ? acc[0] : 0.f, s0 + 1 <= t ? acc[1] : 0.f); w.y = pk2(s0 + 2 <= t ? acc[2] : 0.f, s0 + 3 <= t ? acc[3] : 0.f);
                *(GAS u32x2v*)(ASC + (size_t)it * 4096 + t * 64 + s0) = w;
            }
        }
    }
#undef PP_LOAD
#undef PP_BAR
}
template <int NH, int DV>
__device__ __forceinline__ void chunk_recur2(const Ctx& C, const bf16* Vp) {
    const bf16* ASC = (const bf16*)(C.ws + WS_ASC); const bf16* Q1 = (const bf16*)(C.ws + WS_Q1); const bf16* KST = (const bf16*)(C.ws + WS_KST); const float* DEC = (const float*)(C.ws + WS_DEC);
    bf16* OF = (bf16*)(C.ws + WS_OF);
    constexpr int NCB = DV / 32, NTASK = NBATCH * NH * NCB, JOB = NH == 4 ? 1 : 2;
    const int l = C.lane, m = l & 15, g = l >> 4, kq = C.wave & 3;
    LAS float* red = (LAS float*)C.lds;
    LAS bf16* vt = (LAS bf16*)(C.lds + 65536);
    typedef short v4i16_t __attribute__((ext_vector_type(4)));
    int bgit = 0;
    if (C.wave >= 4) {
        const int NBW = C.G * 4, bw = C.vcu * 4 + (C.wave - 4);
        f32x4 r0[2][4], r1[2][4], r2[2][4]; int i0[2] = {-1, -1}, i1[2] = {-1, -1}, i2[2] = {-1, -1};
#define BG_STEP(c_, RA, IA) do { _Pragma("unroll") for (int j = 0; j < 2; ++j) { const int nx = (BGQ && (c_) < 24) ? ((bgit * 24 + (c_)) * 2 + j) * NBW + bw : BGQ_ROWS; bgq_step<JOB>(C, IA[j], nx, RA[j]); IA[j] = nx; } \
        asm volatile("s_waitcnt lgkmcnt(0)" ::: "memory"); __builtin_amdgcn_s_barrier(); asm volatile("" ::: "memory"); } while (0)
        for (int t0 = C.vcu; t0 < NTASK; t0 += C.G, ++bgit) {
            asm volatile("s_waitcnt lgkmcnt(0)" ::: "memory"); __builtin_amdgcn_s_barrier(); asm volatile("" ::: "memory");
#pragma unroll 1
            for (int c = 0; c < 30; c += 3) { BG_STEP(c, r0, i0); BG_STEP(c + 1, r1, i1); BG_STEP(c + 2, r2, i2); }
            BG_STEP(30, r0, i0); BG_STEP(31, r1, i1);
#pragma unroll
            for (int j = 0; j < 2; ++j) { bgq_step<JOB>(C, i2[j], BGQ_ROWS, r2[j]); i2[j] = BGQ_ROWS; bgq_step<JOB>(C, i0[j], BGQ_ROWS, r0[j]); i0[j] = BGQ_ROWS; bgq_step<JOB>(C, i1[j], BGQ_ROWS, r1[j]); i1[j] = BGQ_ROWS; }
            asm volatile("s_waitcnt lgkmcnt(0)" ::: "memory"); __builtin_amdgcn_s_barrier(); asm volatile("" ::: "memory");
        }
#undef BG_STEP
        if (BGQ) { int ip = BGQ_ROWS;
            for (int nx = bgit * 48 * NBW + bw; nx < BGQ_ROWS || ip < BGQ_ROWS; nx += NBW) { bgq_step<JOB>(C, ip, nx, r0[0]); ip = nx; } }
        return;
    }
    __builtin_amdgcn_s_setprio(2);
    struct Frag { bf16x8 a0, a1; bf16x8 q[4]; f32x4 dc[2]; bf16x8 ks[2][2]; };
#define REC_LOAD(F, c_) do { const size_t ch_ = (size_t)bh * 32 + (c_); \
        F.a0 = *(const bf16x8*)(ASC + ch_ * 4096 + (16 * kq + m) * 64 + 8 * g); F.a1 = *(const bf16x8*)(ASC + ch_ * 4096 + (16 * kq + m) * 64 + 32 + 8 * g); \
        _Pragma("unroll") for (int tb = 0; tb < 4; ++tb) F.q[tb] = *(const bf16x8*)(Q1 + ((ch_ * 4 + kq) * 64 + 16 * tb + m) * 32 + 8 * g); \
        _Pragma("unroll") for (int i = 0; i < 2; ++i) { F.dc[i] = *(const f32x4*)(DEC + ch_ * 128 + 32 * kq + 16 * i + 4 * g); \
            _Pragma("unroll") for (int ks = 0; ks < 2; ++ks) F.ks[i][ks] = *(const bf16x8*)(KST + (ch_ * 128 + 32 * kq + 16 * i + m) * 64 + 32 * ks + 8 * g); } } while (0)
#define VP_LOAD(c_) (*(const v4u*)(Vp + ((size_t)b * SEQLEN + (c_) * 64 + 16 * kq + (l >> 2)) * 1024 + h * DV + cb * 32 + 8 * (l & 3)))
#define VT_PUT(c_, v_) (*(LAS v4u*)(vt + ((c_) & 1) * 2048 + ((l & 3) >> 1) * 1024 + (16 * kq + (l >> 2)) * 16 + 8 * (l & 1)) = (v_))
#define REC_BODY(F, Fn, c_, vcur_, vnew_) do { \
        if ((c_) + 1 < 32) REC_LOAD(Fn, (c_) + 1); \
        if ((c_) + 2 < 32) vnew_ = VP_LOAD((c_) + 2); \
        bf16x8 vb[2][2]; \
        _Pragma("unroll") for (int hf = 0; hf < 2; ++hf) _Pragma("unroll") for (int ks = 0; ks < 2; ++ks) { const LAS bf16* tp_ = vt + ((c_) & 1) * 2048 + hf * 1024 + (32 * ks + 8 * g + ((l & 15) >> 2)) * 16 + 4 * (l & 3); \
            const v4i16_t lo_ = __builtin_amdgcn_ds_read_tr16_b64_v4i16((LAS v4i16_t*)tp_), hi_ = __builtin_amdgcn_ds_read_tr16_b64_v4i16((LAS v4i16_t*)(tp_ + 64)); \
            vb[hf][ks] = (bf16x8){lo_[0], lo_[1], lo_[2], lo_[3], hi_[0], hi_[1], hi_[2], hi_[3]}; } \
        if ((c_) + 1 < 32) VT_PUT((c_) + 1, vcur_); \
        LAS float* rb = red + ((c_) & 1) * 8192; \
        f32x4 oin[2]; \
        _Pragma("unroll") for (int hf = 0; hf < 2; ++hf) { oin[hf] = __builtin_amdgcn_mfma_f32_16x16x32_bf16(F.a0, vb[hf][0], (f32x4){0.f, 0.f, 0.f, 0.f}, 0, 0, 0); \
            if (kq >= 2) oin[hf] = __builtin_amdgcn_mfma_f32_16x16x32_bf16(F.a1, vb[hf][1], oin[hf], 0, 0, 0); } \
        _Pragma("unroll") for (int hf = 0; hf < 2; ++hf) { u32x4v sw; sw.x = pk2(S[hf][0][0], S[hf][0][1]); sw.y = pk2(S[hf][0][2], S[hf][0][3]); sw.z = pk2(S[hf][1][0], S[hf][1][1]); sw.w = pk2(S[hf][1][2], S[hf][1][3]); \
          const bf16x8 sb = __builtin_bit_cast(bf16x8, sw); \
          _Pragma("unroll") for (int tb = 0; tb < 4; ++tb) { \
              const f32x4 po = __builtin_amdgcn_mfma_f32_16x16x32_bf16(F.q[tb], sb, (f32x4){0.f, 0.f, 0.f, 0.f}, 0, 0, 0); \
              *(LAS f32x4*)(rb + hf * 4096 + ((kq * 4 + tb) * 64 + l) * 4) = po; } } \
        _Pragma("unroll") for (int hf = 0; hf < 2; ++hf) _Pragma("unroll") for (int i = 0; i < 2; ++i) { S[hf][i] = S[hf][i] * F.dc[i]; \
            _Pragma("unroll") for (int ks = 0; ks < 2; ++ks) S[hf][i] = __builtin_amdgcn_mfma_f32_16x16x32_bf16(F.ks[i][ks], vb[hf][ks], S[hf][i], 0, 0, 0); } \
        asm volatile("s_waitcnt lgkmcnt(0)" ::: "memory"); __builtin_amdgcn_s_barrier(); asm volatile("" ::: "memory"); \
        _Pragma("unroll") for (int hf = 0; hf < 2; ++hf) { f32x4 o = oin[hf]; \
          _Pragma("unroll") for (int k2 = 0; k2 < 4; ++k2) o = o + *(const LAS f32x4*)(rb + hf * 4096 + ((k2 * 4 + kq) * 64 + l) * 4); \
          const size_t orow = (size_t)b * SEQLEN + (c_) * 64 + 16 * kq + 4 * g; \
          _Pragma("unroll") for (int r = 0; r < 4; ++r) OF[(orow + r) * 1024 + col + 16 * hf] = (bf16)f2bf(o[r]); } } while (0)
    for (int t0 = C.vcu; t0 < NTASK; t0 += C.G) {
        const int cb = t0 % NCB, bh = t0 / NCB, b = bh / NH, h = bh % NH;
        const int col = h * DV + cb * 32 + m;
        f32x4 S[2][2];
#pragma unroll
        for (int hf = 0; hf < 2; ++hf) { S[hf][0] = (f32x4){0.f, 0.f, 0.f, 0.f}; S[hf][1] = S[hf][0]; }
        Frag FA, FB;
        REC_LOAD(FA, 0);
        v4u vA = VP_LOAD(0), vB = VP_LOAD(1);
        VT_PUT(0, vA); vA = vB;
        asm volatile("s_waitcnt lgkmcnt(0)" ::: "memory"); __builtin_amdgcn_s_barrier(); asm volatile("" ::: "memory");
#pragma unroll 1
        for (int c = 0; c < 32; c += 2) { REC_BODY(FA, FB, c, vA, vB); REC_BODY(FB, FA, c + 1, vB, vA); }
        asm volatile("s_waitcnt lgkmcnt(0)" ::: "memory"); __builtin_amdgcn_s_barrier(); asm volatile("" ::: "memory");
    }
    __builtin_amdgcn_s_setprio(0);
#undef REC_LOAD
#undef REC_BODY
#undef VP_LOAD
#undef VT_PUT
}
struct RecFrag { bf16x8 a0, a1; bf16x8 q[4]; f32x4 dc[2]; bf16x8 ks[2][2]; };
template <int NH, int DV, int RP = 0  >
__device__ __forceinline__ void chunk_recur(const Ctx& C, const bf16* Vp) {
    const bf16* ASC = (const bf16*)(C.ws + WS_ASC); const bf16* Q1 = (const bf16*)(C.ws + WS_Q1); const bf16* KST = (const bf16*)(C.ws + WS_KST); const float* DEC = (const float*)(C.ws + WS_DEC);
    bf16* OF = (bf16*)(C.ws + (RP ? WS_GLOG : WS_OF));
    constexpr int NCB = DV / 16, NTASK = NBATCH * NH * NCB;
    const int l = C.lane, m = l & 15, g = l >> 4, gi = C.wave >> 2, kq = C.wave & 3;
    LAS float* red = (LAS float*)C.lds + gi * 8192;
    LAS bf16* vt = (LAS bf16*)(C.lds + 65536) + gi * 2048;
    typedef short v4i16_t __attribute__((ext_vector_type(4)));
#define REC_LOAD(F, c_) do { const size_t row0_ = (size_t)b * SEQLEN + (c_) * 64; const size_t ch_ = (size_t)bh * 32 + (c_); \
        F.a0 = *(const bf16x8*)(ASC + ch_ * 4096 + (16 * kq + m) * 64 + 8 * g); F.a1 = *(const bf16x8*)(ASC + ch_ * 4096 + (16 * kq + m) * 64 + 32 + 8 * g); \
        _Pragma("unroll") for (int tb = 0; tb < 4; ++tb) F.q[tb] = *(const bf16x8*)(Q1 + ((ch_ * 4 + kq) * 64 + 16 * tb + m) * 32 + 8 * g); \
        _Pragma("unroll") for (int i = 0; i < 2; ++i) { F.dc[i] = *(const f32x4*)(DEC + ch_ * 128 + 32 * kq + 16 * i + 4 * g); \
            _Pragma("unroll") for (int ks = 0; ks < 2; ++ks) F.ks[i][ks] = *(const bf16x8*)(KST + (ch_ * 128 + 32 * kq + 16 * i + m) * 64 + 32 * ks + 8 * g); } } while (0)
#define VP_LOAD(c_) (*(const unsigned long long*)(Vp + ((size_t)b * SEQLEN + (c_) * 64 + 16 * kq + (l >> 2)) * 1024 + h * DV + cb * 16 + 4 * (l & 3)))
#define VT_PUT(c_, v_) (*(LAS unsigned long long*)(vt + ((c_) & 1) * 1024 + (16 * kq + (l >> 2)) * 16 + 4 * (l & 3)) = (v_))
#define REC_BODY(F, Fn, c_, vcur_, vnew_) do { \
        if ((c_) + 1 < 32 && RP != 3) REC_LOAD(Fn, (c_) + 1); \
        if ((c_) + 2 < 32) vnew_ = VP_LOAD((c_) + 2); \
        bf16x8 vb[2]; \
        _Pragma("unroll") for (int ks = 0; ks < 2; ++ks) { const LAS bf16* tp_ = vt + ((c_) & 1) * 1024 + (32 * ks + 8 * g + ((l & 15) >> 2)) * 16 + 4 * (l & 3); \
            const v4i16_t lo_ = __builtin_amdgcn_ds_read_tr16_b64_v4i16((LAS v4i16_t*)tp_), hi_ = __builtin_amdgcn_ds_read_tr16_b64_v4i16((LAS v4i16_t*)(tp_ + 64)); \
            vb[ks] = (bf16x8){lo_[0], lo_[1], lo_[2], lo_[3], hi_[0], hi_[1], hi_[2], hi_[3]}; } \
        if ((c_) + 1 < 32) VT_PUT((c_) + 1, vcur_);              \
        if (BGQ && RP == 0) { const int bgn = (bgit * 32 + (c_)) * C.NGW + C.gw; bgq_step<JOB>(C, bgi, bgn, bgv); bgi = bgn; } \
        LAS float* rb = red + ((c_) & 1) * 4096; \
        f32x4 oin = __builtin_amdgcn_mfma_f32_16x16x32_bf16(F.a0, vb[0], (f32x4){0.f, 0.f, 0.f, 0.f}, 0, 0, 0); \
        if (kq >= 2) oin = __builtin_amdgcn_mfma_f32_16x16x32_bf16(F.a1, vb[1], oin, 0, 0, 0); \
        { u32x4v sw; sw.x = pk2(S[0][0], S[0][1]); sw.y = pk2(S[0][2], S[0][3]); sw.z = pk2(S[1][0], S[1][1]); sw.w = pk2(S[1][2], S[1][3]); \
          const bf16x8 sb = __builtin_bit_cast(bf16x8, sw); \
          _Pragma("unroll") for (int tb = 0; tb < 4; ++tb) { \
              const f32x4 po = __builtin_amdgcn_mfma_f32_16x16x32_bf16(F.q[tb], sb, (f32x4){0.f, 0.f, 0.f, 0.f}, 0, 0, 0); \
              *(LAS f32x4*)(rb + ((kq * 4 + tb) * 64 + l) * 4) = po; } } \
        _Pragma("unroll") for (int i = 0; i < 2; ++i) { S[i] = S[i] * F.dc[i]; \
            _Pragma("unroll") for (int ks = 0; ks < 2; ++ks) S[i] = __builtin_amdgcn_mfma_f32_16x16x32_bf16(F.ks[i][ks], vb[ks], S[i], 0, 0, 0); } \
        if (RP != 2) { asm volatile("s_waitcnt lgkmcnt(0)" ::: "memory"); __builtin_amdgcn_s_barrier(); asm volatile("" ::: "memory"); } \
        { f32x4 o = oin; \
          if (RP != 2) { _Pragma("unroll") for (int k2 = 0; k2 < 4; ++k2) o = o + *(const LAS f32x4*)(rb + ((k2 * 4 + kq) * 64 + l) * 4); } \
          const size_t orow = (size_t)b * SEQLEN + (c_) * 64 + 16 * kq + 4 * g; \
          if (RP != 4 || (c_) == 31) { _Pragma("unroll") for (int r = 0; r < 4; ++r) OF[(orow + r) * 1024 + col] = (bf16)f2bf(o[r]); } } } while (0)
    constexpr int JOB = NH == 4 ? 1 : 2;
    f32x4 bgv[4]; int bgi = -1, bgit = 0;
    for (int t0 = C.vcu; t0 < NTASK / 2; t0 += C.G, ++bgit) {
        const int task = gi * (NTASK / 2) + t0;
        const int cb = task % NCB, bh = task / NCB, b = bh / NH, h = bh % NH;
        const int col = h * DV + cb * 16 + m;
        f32x4 S[2];
        S[0] = (f32x4){0.f, 0.f, 0.f, 0.f}; S[1] = S[0];
        RecFrag FA, FB;
        REC_LOAD(FA, 0);
        if (RP == 3) REC_LOAD(FB, 1);
        unsigned long long vA = VP_LOAD(0), vB = VP_LOAD(1);
        VT_PUT(0, vA); vA = vB;
        asm volatile("s_waitcnt lgkmcnt(0)" ::: "memory"); __builtin_amdgcn_s_barrier(); asm volatile("" ::: "memory");
#pragma unroll 1
        for (int c = 0; c < 32; c += 2) { REC_BODY(FA, FB, c, vA, vB); REC_BODY(FB, FA, c + 1, vB, vA); }
        asm volatile("s_waitcnt lgkmcnt(0)" ::: "memory"); __builtin_amdgcn_s_barrier(); asm volatile("" ::: "memory");
    }
    if (BGQ && RP == 0) {
        for (int bgn = bgit * 32 * C.NGW + C.gw; bgi < BGQ_ROWS; bgn += C.NGW) { bgq_step<JOB>(C, bgi, bgn, bgv); bgi = bgn; }
    }
#undef REC_LOAD
#undef REC_BODY
#undef VP_LOAD
#undef VT_PUT
}

template <int DV>
__device__ __forceinline__ void rec_norm_gate(const Ctx& C, const float* gain, const bf16* gate) {
    const bf16* OF = (const bf16*)(C.ws + WS_OF); bf16* OB = (bf16*)(C.ws + WS_OB);
    f32x4 g[4];
#pragma unroll
    for (int j = 0; j < 4; ++j) g[j] = *((const GAS f32x4*)gain + C.lane + 64 * j);
    for (int tok0 = C.gw; tok0 < NTOK; tok0 += 4 * C.NGW) {
        unsigned long long vw[4][4], tw[4][4];
#pragma unroll
        for (int u = 0; u < 4; ++u) { const int tok = tok0 + u * C.NGW; if (tok < NTOK) {
            const GAS unsigned long long* xr = (const GAS unsigned long long*)(OF + (size_t)tok * 1024) + C.lane;
            const GAS unsigned long long* tr = (const GAS unsigned long long*)(gate + (size_t)tok * 1024) + C.lane;
#pragma unroll
            for (int j = 0; j < 4; ++j) { vw[u][j] = xr[64 * j]; tw[u][j] = tr[64 * j]; } } }
        __builtin_amdgcn_sched_barrier(0);
#pragma unroll
        for (int u = 0; u < 4; ++u) { const int tok = tok0 + u * C.NGW; if (tok < NTOK) {
            GAS unsigned long long* o8 = (GAS unsigned long long*)(OB + (size_t)tok * 1024) + C.lane;
#pragma unroll
            for (int j = 0; j < 4; ++j) {
                const f32x4 v = (f32x4){bflo((unsigned)vw[u][j]), bfhi((unsigned)vw[u][j]), bflo((unsigned)(vw[u][j] >> 32)), bfhi((unsigned)(vw[u][j] >> 32))}; float ss = (v.x * v.x + v.y * v.y) + (v.z * v.z + v.w * v.w);
                if (DV == 256) ss = wave_sum(ss); else { DPP_SUM31(ss); const float s_lo = rdlane(ss, 31), s_hi = rdlane(ss, 63); ss = C.lane < 32 ? s_lo : s_hi; }
                const float r = rsqrtf(ss * (1.f / DV) + RMS_EPS);
                const unsigned long long t8 = tw[u][j];
                const float t0 = bflo((unsigned)t8), t1 = bfhi((unsigned)t8), t2 = bflo((unsigned)(t8 >> 32)), t3 = bfhi((unsigned)(t8 >> 32));
                const float a0 = v.x * r * g[j].x * (t0 * sigmoid_f(t0)), a1 = v.y * r * g[j].y * (t1 * sigmoid_f(t1)), a2 = v.z * r * g[j].z * (t2 * sigmoid_f(t2)), a3 = v.w * r * g[j].w * (t3 * sigmoid_f(t3));
                o8[64 * j] = (unsigned long long)pk2h(a0, a1) | ((unsigned long long)pk2h(a2, a3) << 32);
            } } }
    }
}

#define CE_D(a, b) do { const unsigned mx_ = (a) > (b) ? (a) : (b); const unsigned mn_ = (a) > (b) ? (b) : (a); (a) = mx_; (b) = mn_; } while (0)
__device__ __forceinline__ void sort16_desc(unsigned (&a)[16]) {
#define S16(i, j) CE_D(a[i], a[j])
    S16(0,13); S16(1,12); S16(2,15); S16(3,14); S16(4,8); S16(5,6); S16(7,11); S16(9,10);
    S16(0,5); S16(1,7); S16(2,9); S16(3,4); S16(6,13); S16(8,14); S16(10,15); S16(11,12);
    S16(0,1); S16(2,3); S16(4,5); S16(6,8); S16(7,9); S16(10,11); S16(12,13); S16(14,15);
    S16(0,2); S16(1,3); S16(4,10); S16(5,11); S16(6,7); S16(8,9); S16(12,14); S16(13,15);
    S16(1,2); S16(3,12); S16(4,6); S16(5,7); S16(8,10); S16(9,11); S16(13,14);
    S16(1,4); S16(2,6); S16(5,8); S16(7,10); S16(9,13); S16(11,14);
    S16(2,4); S16(3,6); S16(9,12); S16(11,13);
    S16(3,5); S16(6,8); S16(7,9); S16(10,12);
    S16(3,4); S16(5,6); S16(7,8); S16(9,10); S16(11,12);
    S16(6,7); S16(8,9);
#undef S16
}
__device__ __forceinline__ void merge_top16(unsigned (&a)[16], const unsigned (&b)[16]) {
#pragma unroll
    for (int i = 0; i < 16; ++i) a[i] = a[i] > b[15 - i] ? a[i] : b[15 - i];
#pragma unroll
    for (int j = 8; j > 0; j >>= 1)
#pragma unroll
        for (int i = 0; i < 16; ++i) { const int l = i ^ j; if (l > i) CE_D(a[i], a[l]); }
}
__device__ __forceinline__ void merge_quad(unsigned (&a)[16], int lane) {
    unsigned p[16];
#pragma unroll
    for (int i = 0; i < 16; ++i) p[i] = (unsigned)__builtin_amdgcn_ds_bpermute((lane ^ 16) << 2, (int)a[i]);
    merge_top16(a, p);
#pragma unroll
    for (int i = 0; i < 16; ++i) p[i] = (unsigned)__builtin_amdgcn_ds_bpermute((lane ^ 32) << 2, (int)a[i]);
    merge_top16(a, p);
}
__device__ __forceinline__ unsigned mono_key(float f) { const unsigned u = __float_as_uint(f); return (u & 0x80000000u) ? ~u : (u | 0x80000000u); }
__device__ __forceinline__ float mono_inv(unsigned k) { return __uint_as_float((k & 0x80000000u) ? (k ^ 0x80000000u) : ~k); }
__constant__ __attribute__((aligned(16))) unsigned char PEER_CAND[64] = {0, 1, 2, 3, 4, 5, 6, 7, 8, 9, 10, 11, 12, 13, 14, 15, 16, 17, 18, 19, 20, 21, 22, 23, 32, 33, 34, 35, 36, 64, 65, 66, 48, 49, 50, 51, 80, 81, 96, 97, 112, 113, 128, 144, 160, 176, 192, 208, 224, 240, 255, 255, 255, 255, 255, 255, 255, 255, 255, 255, 255, 255, 255, 255};
typedef _Float16 h8 __attribute__((ext_vector_type(8)));
__device__ __forceinline__ void peer_topk_load(const Ctx& C, int tok0, int head, h8 (&hv)[2][4]) {
    int l = C.lane; asm volatile("" : "+v"(l));
    const _Float16* SC = (const _Float16*)(C.ws + WS_Q2);
#pragma unroll
    for (int p = 0; p < 2; ++p) { const _Float16* sp = SC + (size_t)(tok0 + (l & 15)) * 2048 + head * 256 + p * 128 + 32 * (l >> 4);
#pragma unroll
        for (int q = 0; q < 4; ++q) hv[p][q] = *(const GAS h8*)(sp + 8 * q); }
}
__device__ __forceinline__ void peer_topk_task(const Ctx& C, int layer, int tok0, int head, int trow0, LAS int* lexp, LAS float* lgate, const h8 (&hvin)[2][4]) {
    LAS unsigned* L0 = (LAS unsigned*)(C.lds + C.wave * 2048);
    LAS unsigned* L1 = L0 + 256;
    {
        int l = C.lane; asm volatile("" : "+v"(l));
        const int m = l & 15, g = l >> 4;
        unsigned cand_w[4];
#pragma unroll
        for (int c = 0; c < 4; ++c) cand_w[c] = ((const unsigned*)PEER_CAND)[g * 4 + c];
        unsigned top[2][16];
#pragma unroll
        for (int p = 0; p < 2; ++p) {
            h8 hv[4];
#pragma unroll
            for (int q = 0; q < 4; ++q) hv[q] = hvin[p][q];
            unsigned hi16[16];
#pragma unroll
            for (int q = 0; q < 4; ++q)
#pragma unroll
                for (int j = 0; j < 8; ++j) { const int i = 8 * q + j; const unsigned key = (mono_key((float)hv[q][j]) & ~0x7fu) | (unsigned)(127 - (32 * g + i));
                    if (i < 16) top[p][i] = key; else hi16[i - 16] = key; }
            sort16_desc(top[p]); sort16_desc(hi16); merge_top16(top[p], hi16);
            merge_quad(top[p], l);
        }
        if (g == 0) {
#pragma unroll
            for (int i = 0; i < 16; i += 4) { *(LAS u32x4v*)(L0 + m * 16 + i) = (u32x4v){top[0][i], top[0][i + 1], top[0][i + 2], top[0][i + 3]}; *(LAS u32x4v*)(L1 + m * 16 + i) = (u32x4v){top[1][i], top[1][i + 1], top[1][i + 2], top[1][i + 3]}; }
        }
        asm volatile("s_waitcnt lgkmcnt(0)" ::: "memory"); __builtin_amdgcn_wave_barrier();
        unsigned cd[16];
#pragma unroll
        for (int c = 0; c < 16; ++c) {
            const unsigned code = (cand_w[c >> 2] >> (8 * (c & 3))) & 0xffu, ci = (code >> 4) & 15u, cj = code & 15u;
            const float v = mono_inv(L0[m * 16 + ci]) + mono_inv(L1[m * 16 + cj]);
            cd[c] = code == 255u ? 0u : ((mono_key(v) & ~0xffu) | (255u - code));
        }
        sort16_desc(cd); merge_quad(cd, l);
        if (g == 0) {
            float best[16]; int ex[16]; float sum = 0.f;
#pragma unroll
            for (int r = 0; r < 16; ++r) { const unsigned pos = 255u - (cd[r] & 0xffu), pi = pos >> 4, pj = pos & 15u;
                ex[r] = (int)((127u - (L0[m * 16 + pi] & 0x7fu)) * 128u + (127u - (L1[m * 16 + pj] & 0x7fu))); best[r] = mono_inv(cd[r]); }
            const float bmax = best[0];
#pragma unroll
            for (int r = 0; r < 16; ++r) { best[r] = __expf(best[r] - bmax); sum += best[r]; }
            const float inv = 1.f / sum;
            const int ob = (trow0 + m) * 128 + head * 16;
#pragma unroll
            for (int r = 0; r < 16; r += 4) { *(LAS u32x4v*)(lexp + ob + r) = (u32x4v){(unsigned)ex[r], (unsigned)ex[r + 1], (unsigned)ex[r + 2], (unsigned)ex[r + 3]};
                *(LAS f32x4*)(lgate + ob + r) = (f32x4){best[r] * inv, best[r + 1] * inv, best[r + 2] * inv, best[r + 3] * inv}; }
        }
        asm volatile("s_waitcnt lgkmcnt(0)" ::: "memory"); __builtin_amdgcn_wave_barrier();
    }
}
typedef float f32x2v __attribute__((ext_vector_type(2)));
#define GRP8_SUM(v) do { v = DPP_ADD(v, 0xB1, 0xf, 0xf); v = DPP_ADD(v, 0x4E, 0xf, 0xf); v = DPP_ADD(v, 0x141, 0xf, 0xf); } while (0)
#ifndef MK_HOT
#define MK_HOT 0
#endif
__device__ __forceinline__ void wave_lds_sync() { asm volatile("s_waitcnt lgkmcnt(0)" ::: "memory"); __builtin_amdgcn_wave_barrier(); }
template <bool DRY>
__device__ __forceinline__ void peer_rounds(const Ctx& C, int layer, int tokw, LAS int* lexp_w, const LAS float* lgate_w, LAS unsigned* sorted_w, LAS unsigned* hist_w) {
    const unsigned char* U = C.ws + WS_U + (size_t)layer * 16384 * 1024; const unsigned char* V = C.ws + WS_V + (size_t)layer * 16384 * 1024;
    const LAS unsigned char* SU = (const LAS unsigned char*)(C.lds + 114688); const LAS unsigned char* SV = SU + 16384;
    const float* gf = C.in[2] + layer * 1024; const float* gn = C.in[1] + (layer + 1) * 1024;
    int l = C.lane; asm volatile("" : "+v"(l));
    LAS float* hbuf = (LAS float*)lexp_w;
    {
        const int t = l >> 3, s = l & 7;
#pragma unroll
        for (int k = 0; k < 8; ++k) hist_w[l + 64 * k] = 0u;
        wave_lds_sync();
        unsigned ev[16], pos[16];
#pragma unroll
        for (int k = 0; k < 16; ++k) { ev[k] = (unsigned)lexp_w[t * 128 + s + 8 * k]; pos[k] = __hip_atomic_fetch_add(hist_w + t * 64 + (ev[k] >> 8), 1u, __ATOMIC_RELAXED, __HIP_MEMORY_SCOPE_WORKGROUP); }
        wave_lds_sync();
        unsigned cnt[8], run = 0u;
#pragma unroll
        for (int j = 0; j < 8; ++j) { cnt[j] = hist_w[t * 64 + 8 * s + j]; run += cnt[j]; }
        unsigned inc = run;
#pragma unroll
        for (int o = 1; o < 8; o <<= 1) { const unsigned up = (unsigned)__builtin_amdgcn_ds_bpermute((l - o) << 2, (int)inc); if (s >= o) inc += up; }
        unsigned off = inc - run;
        wave_lds_sync();
#pragma unroll
        for (int j = 0; j < 8; ++j) { hist_w[t * 64 + 8 * s + j] = off; off += cnt[j]; }
        wave_lds_sync();
#pragma unroll
        for (int k = 0; k < 16; ++k) sorted_w[t * 128 + hist_w[t * 64 + (ev[k] >> 8)] + pos[k]] = (ev[k] << 7) | (unsigned)(s + 8 * k);
        wave_lds_sync();
    }
    asm volatile("" : "+v"(l));
    unsigned xh[8][4], xl[8][4]; float xs1, xs2;
    {
        unsigned xp[8][8];
        const int t = l >> 3, s = l & 7;
        const bf16* hrow = (const bf16*)(C.ws + WS_HB) + (size_t)(tokw + t) * 1024 + 16 * s;
        float ss = 0.f;
#pragma unroll
        for (int i = 0; i < 8; ++i) { const v4u a = *(const GAS v4u*)(hrow + 128 * i), b = *(const GAS v4u*)(hrow + 128 * i + 8);
            xp[i][0] = a.x; xp[i][1] = a.y; xp[i][2] = a.z; xp[i][3] = a.w; xp[i][4] = b.x; xp[i][5] = b.y; xp[i][6] = b.z; xp[i][7] = b.w;
#pragma unroll
            for (int j = 0; j < 8; ++j) { const float lo = bflo(xp[i][j]), hi = bfhi(xp[i][j]); ss += lo * lo + hi * hi; } }
        GRP8_SUM(ss);
        const float r = rsqrtf(ss * (1.f / 1024.f) + RMS_EPS);
#pragma unroll
        for (int i = 0; i < 8; ++i)
#pragma unroll
            for (int q = 0; q < 4; ++q) { const f32x4 a = *(const GAS f32x4*)(gf + 16 * s + 128 * i + 4 * q);
                xp[i][2 * q] = pk2(bflo(xp[i][2 * q]) * r * a.x, bfhi(xp[i][2 * q]) * r * a.y); xp[i][2 * q + 1] = pk2(bflo(xp[i][2 * q + 1]) * r * a.z, bfhi(xp[i][2 * q + 1]) * r * a.w); }
        float am = 0.f;
#pragma unroll
        for (int i = 0; i < 8; ++i)
#pragma unroll
            for (int j = 0; j < 8; ++j) am = fmaxf(am, fmaxf(fabsf(bflo(xp[i][j])), fabsf(bfhi(xp[i][j]))));
        am = DPP_MAX(am, 0xB1, 0xf, 0xf); am = DPP_MAX(am, 0x4E, 0xf, 0xf); am = DPP_MAX(am, 0x141, 0xf, 0xf);
        const float inv1 = am > 0.f ? 127.f / am : 0.f, inv2 = 254.f * inv1; xs1 = am * (1.f / 127.f); xs2 = xs1 * (1.f / 254.f);
#pragma unroll
        for (int i = 0; i < 8; ++i)
#pragma unroll
            for (int q = 0; q < 4; ++q) { const float x0 = bflo(xp[i][2 * q]), x1 = bfhi(xp[i][2 * q]), x2 = bflo(xp[i][2 * q + 1]), x3 = bfhi(xp[i][2 * q + 1]);
                const float q0 = __builtin_rintf(x0 * inv1), q1 = __builtin_rintf(x1 * inv1), q2 = __builtin_rintf(x2 * inv1), q3 = __builtin_rintf(x3 * inv1);
                xh[i][q] = q8x4(q0, q1, q2, q3); xl[i][q] = q8x4((x0 - q0 * xs1) * inv2, (x1 - q1 * xs1) * inv2, (x2 - q2 * xs1) * inv2, (x3 - q3 * xs1) * inv2); }
    }
    asm volatile("" : "+v"(l));
#define RND_LOAD(T, buf, item) do { const unsigned char* p_ = T + (size_t)((DRY && MK_HOT) ? (((item) >> 7) & 255u) : ((item) >> 7)) * 1024 + 16 * (l & 7); \
        _Pragma("unroll") for (int i = 0; i < 8; ++i) buf[i] = *(const GAS v4u*)(p_ + 128 * i); } while (0)
    {
        const int t = l >> 3, s = l & 7;
        const LAS unsigned* srt = sorted_w + t * 128;
        v4u bA[8], bB[8];
#define RND_DOT(buf, r_) do { int dh = 0, dl = 0; \
            _Pragma("unroll") for (int i = 0; i < 8; ++i) { _Pragma("unroll") for (int q = 0; q < 4; ++q) { \
                dh = __builtin_amdgcn_sdot4((int)buf[i][q], (int)xh[i][q], dh, false); dl = __builtin_amdgcn_sdot4((int)buf[i][q], (int)xl[i][q], dl, false); } } \
            float d = (float)dh * xs1 + (float)dl * xs2; \
            GRP8_SUM(d); if (s == 0) hbuf[t * 128 + (r_)] = d; } while (0)
        RND_LOAD(U, bA, srt[0]);
#pragma unroll 1
        for (int r = 0; r < 128; r += 2) {
            RND_LOAD(U, bB, srt[r + 1]);
            RND_DOT(bA, r);
            RND_LOAD(U, bA, srt[(r + 2) & 127]);
            RND_DOT(bB, r + 1);
        }
#undef RND_DOT
    }
    wave_lds_sync();
    asm volatile("" : "+v"(l));
    {
        const int t = l >> 3, s = l & 7;
#pragma unroll
        for (int k = 0; k < 16; k += 2) {
            const int r0 = t * 128 + s + 8 * k, r1 = r0 + 8;
            const unsigned i0 = sorted_w[r0], i1 = sorted_w[r1];
            const float h0 = hbuf[r0] * __uint_as_float((unsigned)SU[i0 >> 7] << 23), h1 = hbuf[r1] * __uint_as_float((unsigned)SU[i1 >> 7] << 23);
            const pg8::f32x2 gl = pg8::gelu_pk((pg8::f32x2){h0, h1});
            hbuf[r0] = gl.x * lgate_w[t * 128 + (i0 & 127u)] * __uint_as_float((unsigned)SV[i0 >> 7] << 23); hbuf[r1] = gl.y * lgate_w[t * 128 + (i1 & 127u)] * __uint_as_float((unsigned)SV[i1 >> 7] << 23);
        }
    }
    wave_lds_sync();
    asm volatile("" : "+v"(l));
    f32x2v y2[8][8];
#pragma unroll
    for (int i = 0; i < 8; ++i)
#pragma unroll
        for (int j = 0; j < 8; ++j) y2[i][j] = (f32x2v){0.f, 0.f};
    {
        const int t = l >> 3;
        const LAS unsigned* srt = sorted_w + t * 128; const LAS float* wv = hbuf + t * 128;
        v4u bA[8], bB[8];
#define RND_AXPY(buf, r_) do { const float w = wv[(r_)]; const f32x2v w2 = (f32x2v){w, w}; \
            _Pragma("unroll") for (int i = 0; i < 8; ++i) { asm volatile("" : "+v"(buf[i])); _Pragma("unroll") for (int q = 0; q < 4; ++q) { \
                const f32x2v lo_ = __builtin_amdgcn_cvt_pk_f32_fp8((int)buf[i][q], false), hi_ = __builtin_amdgcn_cvt_pk_f32_fp8((int)buf[i][q], true); \
                y2[i][2 * q] = w2 * lo_ + y2[i][2 * q]; y2[i][2 * q + 1] = w2 * hi_ + y2[i][2 * q + 1]; } } } while (0)
        RND_LOAD(V, bA, srt[0]);
#pragma unroll 1
        for (int r = 0; r < 128; r += 2) {
            RND_LOAD(V, bB, srt[r + 1]);
            RND_AXPY(bA, r);
            RND_LOAD(V, bA, srt[(r + 2) & 127]);
            RND_AXPY(bB, r + 1);
        }
#undef RND_AXPY
    }
#undef RND_LOAD
    asm volatile("" : "+v"(l));
    {
        const int t = l >> 3, s = l & 7;
        const bf16* hrow = (const bf16*)(C.ws + WS_HB) + (size_t)(tokw + t) * 1024 + 16 * s;
        float* hout = (DRY ? (float*)(C.ws + WS_OF) : C.out) + (size_t)(tokw + t) * 1024 + 16 * s;
        bf16* hb = (bf16*)(C.ws + (DRY ? WS_OF : WS_HB)) + (size_t)(tokw + t) * 1024 + 16 * s;
        float s2 = 0.f;
#pragma unroll
        for (int i = 0; i < 8; ++i) { const v4u a = *(const GAS v4u*)(hrow + 128 * i), b = *(const GAS v4u*)(hrow + 128 * i + 8);
            const unsigned hw[8] = {a.x, a.y, a.z, a.w, b.x, b.y, b.z, b.w};
#pragma unroll
            for (int j = 0; j < 8; ++j) { y2[i][j].x += bflo(hw[j]); y2[i][j].y += bfhi(hw[j]); s2 += y2[i][j].x * y2[i][j].x + y2[i][j].y * y2[i][j].y; }
            if (layer == DEPTH - 1) {
#pragma unroll
                for (int q = 0; q < 4; ++q) *(GAS f32x4*)(hout + 128 * i + 4 * q) = (f32x4){y2[i][2 * q].x, y2[i][2 * q].y, y2[i][2 * q + 1].x, y2[i][2 * q + 1].y};
            } else {
                *(GAS v4u*)(hb + 128 * i) = (v4u){pk2(y2[i][0].x, y2[i][0].y), pk2(y2[i][1].x, y2[i][1].y), pk2(y2[i][2].x, y2[i][2].y), pk2(y2[i][3].x, y2[i][3].y)};
                *(GAS v4u*)(hb + 128 * i + 8) = (v4u){pk2(y2[i][4].x, y2[i][4].y), pk2(y2[i][5].x, y2[i][5].y), pk2(y2[i][6].x, y2[i][6].y), pk2(y2[i][7].x, y2[i][7].y)};
            } }
        if (layer < DEPTH - 1) {
            GRP8_SUM(s2);
            const float r2 = rsqrtf(s2 * (1.f / 1024.f) + RMS_EPS);
            const bool wx8 = ((I8MASK >> (layer + 1)) & 1) != 0, wxn = ((layer + 1) % 3 != 2) || !wx8;
            bf16* xo = (bf16*)(C.ws + (DRY ? WS_GLOG : WS_XN)) + (size_t)(tokw + t) * 1024 + 16 * s; float am = 0.f;
#pragma unroll
            for (int i = 0; i < 8; ++i) { unsigned pw[8];
#pragma unroll
                for (int q = 0; q < 4; ++q) { const f32x4 a = *(const GAS f32x4*)(gn + 16 * s + 128 * i + 4 * q);
                    y2[i][2 * q].x *= r2 * a.x; y2[i][2 * q].y *= r2 * a.y; y2[i][2 * q + 1].x *= r2 * a.z; y2[i][2 * q + 1].y *= r2 * a.w;
                    am = fmaxf(fmaxf(am, fmaxf(fabsf(y2[i][2 * q].x), fabsf(y2[i][2 * q].y))), fmaxf(fabsf(y2[i][2 * q + 1].x), fabsf(y2[i][2 * q + 1].y)));
                    pw[2 * q] = pk2(y2[i][2 * q].x, y2[i][2 * q].y); pw[2 * q + 1] = pk2(y2[i][2 * q + 1].x, y2[i][2 * q + 1].y); }
                if (wxn) { *(GAS v4u*)(xo + 128 * i) = (v4u){pw[0], pw[1], pw[2], pw[3]}; *(GAS v4u*)(xo + 128 * i + 8) = (v4u){pw[4], pw[5], pw[6], pw[7]}; } }
            if (wx8) {
            am = DPP_MAX(am, 0xB1, 0xf, 0xf); am = DPP_MAX(am, 0x4E, 0xf, 0xf); am = DPP_MAX(am, 0x141, 0xf, 0xf);
            const float qi = am > 0.f ? 127.f / am : 0.f;
            signed char* xq = (signed char*)(C.ws + (DRY ? WS_GLOG + 32 * MiB : WS_XN8)) + (size_t)(tokw + t) * 1024 + 16 * s;
#pragma unroll
            for (int i = 0; i < 8; ++i) { unsigned pq[4];
#pragma unroll
                for (int q = 0; q < 4; ++q) pq[q] = q8x4(y2[i][2 * q].x * qi, y2[i][2 * q].y * qi, y2[i][2 * q + 1].x * qi, y2[i][2 * q + 1].y * qi);
                *(GAS v4u*)(xq + 128 * i) = (v4u){pq[0], pq[1], pq[2], pq[3]}; }
            if (s == 0) *(GAS float*)((float*)(C.ws + (DRY ? WS_GLOG + 48 * MiB : WS_SX)) + tokw + t) = am * (1.f / 127.f);
            }
        }
    }
}
#ifndef MK_SWEEP
#define MK_SWEEP 2
#endif
template <bool DRY>
__device__ __forceinline__ void peer_topk_gather(const Ctx& C, int layer) {
    LAS int* lexp = (LAS int*)(C.lds + 16384);
    LAS float* lgate = (LAS float*)(C.lds + 16384 + 32768);
    LAS unsigned* sorted = (LAS unsigned*)(C.lds + 16384 + 65536);
    {
        int tid = C.tid; asm volatile("" : "+v"(tid));
        const v4u a0 = *(const GAS v4u*)(C.ws + WS_SU + (size_t)layer * 16384 + tid * 32), a1 = *(const GAS v4u*)(C.ws + WS_SU + (size_t)layer * 16384 + tid * 32 + 16);
        const v4u b0 = *(const GAS v4u*)(C.ws + WS_SV + (size_t)layer * 16384 + tid * 32), b1 = *(const GAS v4u*)(C.ws + WS_SV + (size_t)layer * 16384 + tid * 32 + 16);
        LAS unsigned char* lsc = C.lds + 114688;
        *(LAS v4u*)(lsc + tid * 32) = a0; *(LAS v4u*)(lsc + tid * 32 + 16) = a1; *(LAS v4u*)(lsc + 16384 + tid * 32) = b0; *(LAS v4u*)(lsc + 16384 + tid * 32 + 16) = b1;
    }
    for (int tb = C.vcu; tb < NTOK / 64; tb += C.G) {
        {
            h8 hva[2][4], hvb[2][4];
            const int tk0 = tb * 64 + (C.wave & 3) * 16, hd0 = (C.wave >> 2) * 4, tr0 = (C.wave & 3) * 16;
            peer_topk_load(C, tk0, hd0, hva);
#pragma unroll 1
            for (int q = 0; q < 4; q += 2) {
                peer_topk_load(C, tk0, hd0 + q + 1, hvb);
                peer_topk_task(C, layer, tk0, hd0 + q, tr0, lexp, lgate, hva);
                if (q + 2 < 4) peer_topk_load(C, tk0, hd0 + q + 2, hva);
                peer_topk_task(C, layer, tk0, hd0 + q + 1, tr0, lexp, lgate, hvb);
            }
        }
        __syncthreads();
#if MK_SWEEP == 2
        peer_rounds<DRY>(C, layer, tb * 64 + C.wave * 8, lexp + C.wave * 1024, lgate + C.wave * 1024, sorted + C.wave * 1024, (LAS unsigned*)(C.lds + C.wave * 2048));
#elif MK_SWEEP == 1
#error removed variant
        peer_sweep<DRY>(C, layer, tb * 64 + C.wave * 8, lexp + C.wave * 1024, lgate + C.wave * 1024, sorted + C.wave * 1024, (LAS unsigned*)(C.lds + C.wave * 1024));
#else
#pragma unroll 1
        for (int t = 0; t < 8; ++t) peer_gather_token<DRY>(C, layer, tb * 64 + C.wave * 8 + t, lexp + (C.wave * 8 + t) * 128, lgate + (C.wave * 8 + t) * 128);
#endif
        __syncthreads();
    }
}

#ifndef MK_SINGLE
#define MK_SINGLE 1
#endif
#ifndef MK_FASTGEMM
#define MK_FASTGEMM 1
#endif
constexpr int STEPS = 10, NPHASE = 1 + DEPTH * STEPS;
struct Args { const float* in[21]; float* out; unsigned char* ws; int ph_lo, ph_hi; };

template <int EPI>
__device__ __forceinline__ void do_gemm(const Ctx& C, const bf16* A, const bf16* Bt, int N, bf16* Ob, int ldc, int split, const float* rs_in, const float* base, float* outf, bf16* hg, const float* gain, float* rs_out) {
    pg8::Gemm g{A, Bt, NTOK, N, 1024}; pg8::StaticOrder S; S.init(NTOK, N, C.G, C.bx);
    if constexpr (EPI == 0) { pg8::EpiBf16R<false> E{Ob, ldc, split ? 1024 : 0, PSTRIDE, rs_in}; pg8::gemm_phase<pg8::EpiBf16R<false>, pg8::StaticOrder, true, true>(C.lds, g, S, E, C.tid); }
    else if constexpr (EPI == 2) { pg8::EpiBf16R<true> E{Ob, ldc, 0, PSTRIDE, rs_in}; pg8::gemm_phase<pg8::EpiBf16R<true>, pg8::StaticOrder, true, true>(C.lds, g, S, E, C.tid); }
    else if constexpr (EPI == 3) {
        pg8::Gemm g8{A, Bt, NTOK, N, 512}; pg8::EpiI8<false> E{Ob, PSTRIDE, rs_in, gain, nullptr, nullptr, 1.f}; pg8::gemm_phase<pg8::EpiI8<false>, pg8::StaticOrder, true, true>(C.lds, g8, S, E, C.tid); }
    else if constexpr (EPI == 4) {
        pg8::Gemm g8{A, Bt, NTOK, N, 512}; pg8::EpiI8<true> E{Ob, PSTRIDE, rs_in, gain, base, (const float*)outf, FOX_C2}; pg8::gemm_phase<pg8::EpiI8<true>, pg8::StaticOrder, true, true>(C.lds, g8, S, E, C.tid); }
    else {
        bf16* HB = (bf16*)(C.ws + WS_HB); (void)outf;
        if (base) { pg8::EpiResNorm<false> E{base, HB, hg, gain, rs_out}; pg8::gemm_phase<pg8::EpiResNorm<false>, pg8::StaticOrder, true, true>(C.lds, g, S, E, C.tid); }
        else { pg8::EpiResNorm<true> E{HB, HB, hg, gain, rs_out}; pg8::gemm_phase<pg8::EpiResNorm<true>, pg8::StaticOrder, true, true>(C.lds, g, S, E, C.tid); } }
}

template <int STEP, int MIXER>
__device__ __forceinline__ void run_step(const Ctx& C, int layer) {
    const int jx = layer / 3;
    bf16* XN = (bf16*)(C.ws + WS_XN); bf16* P = (bf16*)(C.ws + WS_P); bf16* OB = (bf16*)(C.ws + WS_OB); bf16* Q2 = (bf16*)(C.ws + WS_Q2);
    if constexpr (STEP == 0) {
        const bf16* Wt = MIXER == 0 ? (const bf16*)(C.ws + WS_FOXWIN + (size_t)jx * 8 * MiB) : MIXER == 1 ? (const bf16*)(C.ws + WS_GLAWIN) : (const bf16*)(C.ws + WS_HGRNWIN);
        const float* sw = (const float*)(C.ws + WS_SW) + (MIXER == 0 ? jx * 4096 : MIXER == 1 ? 8192 : 11264);
        if (FOXFUSE && MIXER == 0) { do_gemm<4>(C, (const bf16*)(C.ws + WS_XN8), Wt, 4096, P, 1024, 1, (const float*)(C.ws + WS_SX), C.in[5] + jx * 64, (float*)(C.in[6] + jx * 64), nullptr, sw, nullptr); fox_step1<false>(C, jx); }
        else if ((I8MASK >> layer) & 1) do_gemm<3>(C, (const bf16*)(C.ws + WS_XN8), Wt, MIXER == 1 ? 3072 : 4096, P, 1024, 1, (const float*)(C.ws + WS_SX), nullptr, nullptr, nullptr, sw, nullptr);
        else do_gemm<0>(C, XN, Wt, MIXER == 1 ? 3072 : 4096, P, 1024, 1, nullptr, nullptr, nullptr, nullptr, nullptr, nullptr);
    } else if constexpr (STEP == 1) {
        if constexpr (MIXER == 0) { if (!FOXFUSE) fox_step1<true>(C, jx); }
    } else if constexpr (STEP == 2) {
        if constexpr (MIXER == 1) chunk_prepass<4>(C); else if constexpr (MIXER == 2) chunk_prepass<8>(C);
    } else if constexpr (STEP == 3) {
        if constexpr (MIXER == 0) {
            float gq = 0.f, gk = 0.f;
            for (int i = 0; i < 64; ++i) { gq = fmaxf(gq, fabsf(C.in[5][jx * 64 + i])); gk = fmaxf(gk, fabsf(C.in[6][jx * 64 + i])); }
            const float smax = 64.f * gq * gk * 0.125f * 1.4426950408889634f;
            const attn_body::AttnTensors AT{(const attn_body::bf16*)P, (const attn_body::bf16*)(P + PSTRIDE), (const attn_body::bf16*)(P + 2 * PSTRIDE), (attn_body::bf16*)OB, (const attn_body::bf16*)(P + 3 * PSTRIDE), (const float*)(C.ws + WS_TAIL), -(56.f + 2.f * smax)};
            const attn_body::StaticOrder S(C.G, C.bx);
            attn_body::attn_phase<attn_body::StaticOrder>((char*)C.lds, AT, S, C.tid);
        }
        else if constexpr (MIXER == 1) chunk_recur2<4, 256>(C, P + PSTRIDE);
        else chunk_recur2<8, 128>(C, P + 2 * PSTRIDE);
    } else if constexpr (STEP == 4) {
        if constexpr (MIXER == 1) rec_norm_gate<256>(C, C.in[11], P + 2 * PSTRIDE);
        else if constexpr (MIXER == 2) rec_norm_gate<128>(C, C.in[15], P + 3 * PSTRIDE);
    } else if constexpr (STEP == 5) {
        const bf16* Wt = MIXER == 0 ? (const bf16*)(C.ws + WS_FOXWOUT) + (size_t)jx * 1024 * 1024 : MIXER == 1 ? (const bf16*)(C.ws + WS_GLAWOUT) : (const bf16*)(C.ws + WS_HGRNWOUT);
        do_gemm<1>(C, OB, Wt, 1024, nullptr, 0, 0, nullptr, layer == 0 ? C.in[0] : nullptr, nullptr, XN, C.in[2] + layer * 1024, (float*)(C.ws + WS_RS));
    } else if constexpr (STEP == 6) {
    } else if constexpr (STEP == 7) {
        do_gemm<2>(C, XN, (const bf16*)(C.ws + WS_PEERWQ) + (size_t)layer * 2048 * 1024, 2048, Q2, 2048, 0, (const float*)(C.ws + WS_RS), nullptr, nullptr, nullptr, nullptr, nullptr);
    } else if constexpr (STEP == 8) {
        peer_topk_gather<false>(C, layer);
    } else if constexpr (STEP == 9) {
    } else if constexpr (STEP == 11) {
        peer_topk_gather<true>(C, layer);
    } else if constexpr (STEP == 12) {
        p0_prologue_b(C);
    } else {
        p0_prologue(C);
    }
}

__device__ __forceinline__ void make_ctx(Ctx& C, const Args& args, unsigned char* lds_raw) {
    C.lds = (LAS unsigned char*)lds_raw;
    C.tid = threadIdx.x; C.lane = C.tid & 63; C.wave = __builtin_amdgcn_readfirstlane(C.tid >> 6);
    C.G = gridDim.x; C.bx = blockIdx.x; { const int bx = blockIdx.x; C.vcu = (C.G % 8 == 0) ? (bx % 8) * (C.G / 8) + bx / 8 : bx; }
    C.gw = C.vcu * NWAVES + C.wave; C.NGW = C.G * NWAVES;
#pragma unroll
    for (int i = 0; i < 21; ++i) C.in[i] = args.in[i];
    C.out = args.out; C.ws = args.ws;
}

template <int STEP, int MIXER>
__global__ void __launch_bounds__(NWAVES * 64, 2) mk_phase(Args args, int layer) {
    extern __shared__ __attribute__((aligned(16))) unsigned char lds_raw[];
    Ctx C; make_ctx(C, args, lds_raw);
    run_step<STEP, MIXER>(C, layer);
}

template <int STEP, int MIXER>
static void launch_phase(const Args& a, int layer, int grid, hipStream_t stream) {
    static bool attr_set = false;
    if (!attr_set) { (void)hipFuncSetAttribute((const void*)mk_phase<STEP, MIXER>, hipFuncAttributeMaxDynamicSharedMemorySize, LDS_BYTES); attr_set = true; }
    hipLaunchKernelGGL((mk_phase<STEP, MIXER>), dim3(grid), dim3(NWAVES * 64), LDS_BYTES, stream, a, layer);
}
#ifndef MK_DUP
#define MK_DUP -1
#endif
#define LP(S, M) do { launch_phase<S, M>(a, layer, grid, stream); if (MK_DUP == S) launch_phase<(S == 8 ? 11 : S), M>(a, layer, grid, stream); } while (0)
template <int MIXER>
static void launch_layer(const Args& a, int layer, int grid, hipStream_t stream) {
    LP(0, MIXER);
    if (MIXER == 0) launch_phase<1, MIXER>(a, layer, grid, stream); else LP(2, MIXER);
    LP(3, MIXER);
    if (MIXER != 0) LP(4, MIXER);
    LP(5, MIXER);
    LP(7, 0);
    LP(8, 0);
}
#if MK_SINGLE
__device__ __forceinline__ const float* tab_ptr(volatile LAS unsigned long long* tab, int i) {
    const unsigned long long v = tab[i];
    const unsigned lo = __builtin_amdgcn_readfirstlane((unsigned)v), hi = __builtin_amdgcn_readfirstlane((unsigned)(v >> 32));
    return (const float*)(const GAS float*)(((unsigned long long)hi << 32) | lo);
}
__device__ __forceinline__ int lane_id_volatile() { int x; asm volatile("v_mbcnt_lo_u32_b32 %0, -1, 0\n\tv_mbcnt_hi_u32_b32 %0, -1, %0" : "=v"(x)); return x; }
__device__ __forceinline__ void make_ctx_opaque(Ctx& C, unsigned char* lds_raw, int wave_s) {
    int bx = blockIdx.x, G = gridDim.x; unsigned ldso = 0u;
    asm volatile("" : "+s"(bx), "+s"(G), "+s"(ldso), "+s"(wave_s));
    int tid = wave_s * 64 + lane_id_volatile();
    C.lds = (LAS unsigned char*)lds_raw + ldso;
    volatile LAS unsigned long long* tab = (volatile LAS unsigned long long*)(C.lds + LDSCTL_OFF);
    C.tid = tid; C.lane = tid & 63; C.wave = __builtin_amdgcn_readfirstlane(tid >> 6);
    C.G = G; C.bx = bx; C.vcu = (G % 8 == 0) ? (bx % 8) * (G / 8) + bx / 8 : bx;
    C.gw = C.vcu * NWAVES + C.wave; C.NGW = G * NWAVES;
#pragma unroll
    for (int i = 0; i < 21; ++i) C.in[i] = tab_ptr(tab, i);
    C.out = (float*)tab_ptr(tab, 21); C.ws = (unsigned char*)tab_ptr(tab, 22);
}
__device__ __forceinline__ void grid_bar(unsigned char* lds_raw, int wave_s) {
    unsigned ldso = 0u; asm volatile("" : "+s"(ldso), "+s"(wave_s));
    LAS unsigned char* lds = (LAS unsigned char*)lds_raw + ldso;
    volatile LAS unsigned long long* tab = (volatile LAS unsigned long long*)(lds + LDSCTL_OFF);
    XcdBarrier b; b.bar = (unsigned*)((unsigned char*)tab_ptr(tab, 22) + WS_CTL) + CW_BAR; b.x = xb_xcc_id(); b.st = (volatile LAS unsigned*)(lds + MISC_OFF) + 8;
    xcd_barrier(b, wave_s == 0 && lane_id_volatile() == 0);
}
#define MK_STEP(...) do { Ctx C; make_ctx_opaque(C, lds_raw, wave_s); __VA_ARGS__; } while (0)
__global__ void __launch_bounds__(NWAVES * 64, 2) mk_fwd(Args args) {
    extern __shared__ __attribute__((aligned(16))) unsigned char lds_raw[];
    const int wave_s = __builtin_amdgcn_readfirstlane(threadIdx.x >> 6);
    for (int u = threadIdx.x; u < (LDS_BYTES - LDSCTL_OFF) / 4; u += NWAVES * 64) ((LAS unsigned*)((LAS unsigned char*)lds_raw + LDSCTL_OFF))[u] = 0u;
    __syncthreads();
    if (threadIdx.x == 0) {
        LAS unsigned long long* tab = (LAS unsigned long long*)((LAS unsigned char*)lds_raw + LDSCTL_OFF);
#pragma unroll
        for (int i = 0; i < 21; ++i) tab[i] = (unsigned long long)args.in[i];
        tab[21] = (unsigned long long)args.out; tab[22] = (unsigned long long)args.ws;
    }
    (void)xcd_barrier_post((unsigned*)(args.ws + WS_CTL) + CW_BAR, (volatile LAS unsigned*)((LAS unsigned char*)lds_raw + MISC_OFF) + 8);
    __syncthreads();
    MK_STEP(p0_prologue(C));
    if (I8_NITEMS) { grid_bar(lds_raw, wave_s); MK_STEP(p0_prologue_b(C)); }
    cg::this_grid().sync();
#pragma unroll 1
    for (int layer = 0; layer < DEPTH; ++layer) {
        const int mixer = layer % 3, jx = layer / 3;
        MK_STEP(const bf16* Wt = mixer == 0 ? (const bf16*)(C.ws + WS_FOXWIN + (size_t)jx * 8 * MiB) : mixer == 1 ? (const bf16*)(C.ws + WS_GLAWIN) : (const bf16*)(C.ws + WS_HGRNWIN);
                const float* sw = (const float*)(C.ws + WS_SW) + (mixer == 0 ? jx * 4096 : mixer == 1 ? 8192 : 11264);
                if (FOXFUSE && mixer == 0) { do_gemm<4>(C, (const bf16*)(C.ws + WS_XN8), Wt, 4096, (bf16*)(C.ws + WS_P), 1024, 1, (const float*)(C.ws + WS_SX), C.in[5] + jx * 64, (float*)(C.in[6] + jx * 64), nullptr, sw, nullptr);
                    fox_step1<false>(C, jx); }
                else if (I8MASK == 15 || (I8MASK != 0 && ((I8MASK >> layer) & 1))) do_gemm<3>(C, (const bf16*)(C.ws + WS_XN8), Wt, mixer == 1 ? 3072 : 4096, (bf16*)(C.ws + WS_P), 1024, 1, (const float*)(C.ws + WS_SX), nullptr, nullptr, nullptr, sw, nullptr);
                else do_gemm<0>(C, (const bf16*)(C.ws + WS_XN), Wt, mixer == 1 ? 3072 : 4096, (bf16*)(C.ws + WS_P), 1024, 1, nullptr, nullptr, nullptr, nullptr, nullptr, nullptr));
        grid_bar(lds_raw, wave_s);
#if GPROBE == 1
        MK_STEP(const bf16* Wt = mixer == 0 ? (const bf16*)(C.ws + WS_FOXWIN + (size_t)jx * 8 * MiB) : mixer == 1 ? (const bf16*)(C.ws + WS_GLAWIN) : (const bf16*)(C.ws + WS_HGRNWIN);
                const float* sw = (const float*)(C.ws + WS_SW) + (mixer == 0 ? jx * 4096 : mixer == 1 ? 8192 : 11264);
                if (FOXFUSE && mixer == 0) { do_gemm<4>(C, (const bf16*)(C.ws + WS_XN8), Wt, 4096, (bf16*)(C.ws + WS_P), 1024, 1, (const float*)(C.ws + WS_SX), C.in[5] + jx * 64, (float*)(C.in[6] + jx * 64), nullptr, sw, nullptr);
                    fox_step1<false>(C, jx); }
                else if (I8MASK == 15 || (I8MASK != 0 && ((I8MASK >> layer) & 1))) do_gemm<3>(C, (const bf16*)(C.ws + WS_XN8), Wt, mixer == 1 ? 3072 : 4096, (bf16*)(C.ws + WS_P), 1024, 1, (const float*)(C.ws + WS_SX), nullptr, nullptr, nullptr, sw, nullptr);
                else do_gemm<0>(C, (const bf16*)(C.ws + WS_XN), Wt, mixer == 1 ? 3072 : 4096, (bf16*)(C.ws + WS_P), 1024, 1, nullptr, nullptr, nullptr, nullptr, nullptr, nullptr));
        grid_bar(lds_raw, wave_s);
#endif
        if (!(FOXFUSE && mixer == 0)) {
        MK_STEP(if (mixer == 0) run_step<1, 0>(C, layer); else if (mixer == 1) run_step<2, 1>(C, layer); else run_step<2, 2>(C, layer));
        grid_bar(lds_raw, wave_s); }
        MK_STEP(if (mixer == 0) run_step<3, 0>(C, layer); else if (mixer == 1) run_step<3, 1>(C, layer); else run_step<3, 2>(C, layer));
        grid_bar(lds_raw, wave_s);
#if RPROBE
        if (mixer != 0) { MK_STEP(if (mixer == 1) chunk_recur<4, 256, RPROBE>(C, (const bf16*)(C.ws + WS_P) + PSTRIDE); else chunk_recur<8, 128, RPROBE>(C, (const bf16*)(C.ws + WS_P) + 2 * PSTRIDE)); grid_bar(lds_raw, wave_s); }
#endif
        if (mixer != 0) { MK_STEP(if (mixer == 1) run_step<4, 1>(C, layer); else run_step<4, 2>(C, layer)); grid_bar(lds_raw, wave_s); }
        MK_STEP(const bf16* Wt = mixer == 0 ? (const bf16*)(C.ws + WS_FOXWOUT) + (size_t)jx * 1024 * 1024 : mixer == 1 ? (const bf16*)(C.ws + WS_GLAWOUT) : (const bf16*)(C.ws + WS_HGRNWOUT);
                do_gemm<1>(C, (const bf16*)(C.ws + WS_OB), Wt, 1024, nullptr, 0, 0, nullptr, layer == 0 ? C.in[0] : nullptr, nullptr, (bf16*)(C.ws + WS_XN), C.in[2] + layer * 1024, (float*)(C.ws + WS_RS)));
        grid_bar(lds_raw, wave_s);
        MK_STEP(run_step<7, 0>(C, layer));
        grid_bar(lds_raw, wave_s);
#if GPROBE == 7
        MK_STEP(run_step<7, 0>(C, layer));
        grid_bar(lds_raw, wave_s);
#endif
        MK_STEP(run_step<8, 0>(C, layer));
        if (layer + 1 < DEPTH) grid_bar(lds_raw, wave_s);
    }
}
#endif

extern "C" void kernel_launch(void* const* d_in, const int* in_sizes, int n_in, void* d_out, int out_size, void* d_ws, size_t ws_size, hipStream_t stream) {
    static int grid = 0;
    if (grid == 0) {
        if (n_in != 21 || out_size != NTOK * 1024 || ws_size < WS_END) { fprintf(stderr, "kernel_launch: unexpected shapes: n_in %d out %d ws %zu (need %zu)\n", n_in, out_size, ws_size, (size_t)WS_END); grid = -1; return; }
        int dev = 0, cus = 0, per_cu = 0;
        (void)hipGetDevice(&dev); (void)hipDeviceGetAttribute(&cus, hipDeviceAttributeMultiprocessorCount, dev);
#if MK_SINGLE
        if (hipFuncSetAttribute((const void*)mk_fwd, hipFuncAttributeMaxDynamicSharedMemorySize, LDS_BYTES) != hipSuccess) { fprintf(stderr, "kernel_launch: hipFuncSetAttribute failed\n"); grid = -1; return; }
        if (hipOccupancyMaxActiveBlocksPerMultiprocessor(&per_cu, (const void*)mk_fwd, NWAVES * 64, LDS_BYTES) != hipSuccess || per_cu < 1) { fprintf(stderr, "kernel_launch: occupancy query says %d blocks per CU\n", per_cu); (void)hipGetLastError(); grid = -1; return; }
#endif
        (void)per_cu;
        grid = cus;
    }
    if (grid < 0) return;
    Args a{};
    for (int i = 0; i < 21; ++i) a.in[i] = (const float*)d_in[i];
    a.out = (float*)d_out; a.ws = (unsigned char*)d_ws;
#if MK_SINGLE
    (void)hipMemsetAsync((char*)d_ws + WS_CTL, 0, CTL_ZERO_BYTES, stream);
    a.ph_lo = 0; a.ph_hi = NPHASE;
    void* kargs[] = {&a};
    hipError_t e = hipLaunchCooperativeKernel((const void*)mk_fwd, dim3(grid), dim3(NWAVES * 64), kargs, LDS_BYTES, stream);
    if (e != hipSuccess) fprintf(stderr, "cooperative launch failed: %s (grid %d)\n", hipGetErrorString(e), grid);
#else
    (void)hipMemsetAsync((char*)d_ws + WS_CTL, 0, CTL_ZERO_BYTES, stream);
    launch_phase<10, 0>(a, 0, grid, stream); if (MK_DUP == 10) launch_phase<10, 0>(a, 0, grid, stream);
    launch_phase<12, 0>(a, 0, grid, stream);
    launch_layer<0>(a, 0, grid, stream);
    launch_layer<1>(a, 1, grid, stream);
    launch_layer<2>(a, 2, grid, stream);
    launch_layer<0>(a, 3, grid, stream);
#endif
}
```

```cpp
#include <hip/hip_runtime.h>
#include <hip/hip_cooperative_groups.h>
#include <cstdio>
#include <cstdint>
#include <cmath>
namespace pg8 {
#define PG8_LAS __attribute__((address_space(3)))
typedef unsigned short bf16_t;
typedef short bf16x8 __attribute__((ext_vector_type(8)));
typedef float f32x4 __attribute__((ext_vector_type(4)));
typedef unsigned u32x4 __attribute__((ext_vector_type(4)));
typedef int i32x4 __attribute__((ext_vector_type(4)));
constexpr int BM = 256, BK = 64, HALF = 128, HTB = HALF * BK * 2  , STAGE_BYTES = 8 * HTB, NXCD = 8, WGM = 8;

__host__ __device__ __forceinline__ int lds_byte(int r, int c) { const int st = (r >> 4) * 2 + (c >> 5), rr = r & 15, cc = c & 31, ob = rr * 64 + cc * 2; return st * 1024 + (ob ^ (((ob >> 9) & 1) << 5)); }
__host__ __device__ __forceinline__ void stage_rc(int b, int& R, int& C) { const int st = b / 1024, sb = b % 1024, swz = sb ^ (((sb >> 9) & 1) << 5); R = (st >> 1) * 16 + swz / 64; C = (st & 1) * 32 + (swz % 64) / 2; }
__host__ __device__ __forceinline__ int perm32(int rho) { const int n = rho >> 4, i = rho & 15; return 8 * (i >> 2) + 4 * n + (i & 3); }

struct Unit { int pm, pn; };
struct Gemm { const bf16_t* A; const bf16_t* Bt; int M, N, K; };

struct StaticOrder {
    int nM, nN, nwg, G, c;
    __host__ __device__ void init(int M, int N, int G_, int c_) { nM = M / BM; nN = N / BM; nwg = nM * nN; G = G_; c = c_; }
    __host__ __device__ bool next(int i, Unit& u) const {
        const long L = (long)i * G + c; if (L >= nwg) return false;
        int wgid = (int)L; { const int q = nwg / NXCD, r = nwg % NXCD, xcd = wgid % NXCD, off = wgid / NXCD; wgid = (xcd < r ? xcd * (q + 1) : r * (q + 1) + (xcd - r) * q) + off; }
        const int nig = WGM * nN, gid = wgid / nig, fm = gid * WGM, gsz = (nM - fm) < WGM ? (nM - fm) : WGM;
        u.pm = fm + ((wgid % nig) % gsz); u.pn = (wgid % nig) / gsz; return true;
    }
    __device__ __forceinline__ void a_ready(const Unit&) const {}
    __device__ __forceinline__ void done(const Unit&) const {}
};

__device__ __forceinline__ unsigned cvt_pk_bf16(float lo, float hi) { unsigned r; asm volatile("v_cvt_pk_bf16_f32 %0, %1, %2" : "=v"(r) : "v"(lo), "v"(hi)); return r; }
typedef float f32x2 __attribute__((ext_vector_type(2)));
__device__ __forceinline__ f32x2 gelu_pk(f32x2 v) {
    const f32x2 av = __builtin_elementwise_abs(v), d = av * 0.2316418882f + 1.0f;
    f32x2 t; t.x = __builtin_amdgcn_rcpf(d.x); t.y = __builtin_amdgcn_rcpf(d.y);
    f32x2 q = t * 0.5307027145f + (-0.7265760135f); q = q * t + 0.7107068705f; q = q * t + (-0.142248368f); q = q * t + 0.127414796f; q = q * t;
    const f32x2 s = (v * v) * (-0.72134752044f);
    f32x2 e; e.x = __builtin_amdgcn_exp2f(s.x); e.y = __builtin_amdgcn_exp2f(s.y);
    const f32x2 m = v * (q * e), r = v - m;
    f32x2 o; o.x = v.x < 0.f ? m.x : r.x; o.y = v.y < 0.f ? m.y : r.y; return o;
}
#ifndef EPI_AUX
#define EPI_AUX 16
#endif
template <bool F16  > struct EpiBf16R {
    typedef f32x4 acc_t;
    static constexpr bool PERM = true, AFTER_DRAIN = false;
    bf16_t* O; int ldc; int split_cols; size_t split_stride; const float* rs;
    __device__ __forceinline__ void operator()(const f32x4 (&acc)[2][2][4][2], const Unit& u, int wr, int wc, int fr, int fq) const {
        const int row0 = u.pm * BM + wr * 64 + fr; int colt = u.pn * BM; unsigned boff = 0u;
        if (split_cols) { const int t = colt / split_cols; boff = (unsigned)(t * split_stride * 2); colt -= t * split_cols; }
        const int col0 = colt + wc * 32 + 8 * fq;
        const __amdgpu_buffer_rsrc_t orsrc = __builtin_amdgcn_make_buffer_rsrc((void*)O, (short)0, 0x7ffffff0, 0x00020000);
#pragma unroll
        for (int ai = 0; ai < 2; ++ai) {
            f32x4 rsp[4];
            if (rs) {
#pragma unroll
                for (int m = 0; m < 4; ++m) rsp[m] = *(const f32x4*)(rs + (size_t)(row0 + ai * HALF + m * 16) * 16 + 4 * fq);
            }
#pragma unroll
            for (int m = 0; m < 4; ++m) { const int row = row0 + ai * HALF + m * 16; const unsigned roff = boff + (unsigned)(row * ldc + col0) * 2u;
                float sc = 1.f;
                if (rs) {
                    const f32x4 a = rsp[m]; float s = (a[0] + a[1]) + (a[2] + a[3]); const int lane_ = fr + 16 * fq;
                    s += __builtin_bit_cast(float, __builtin_amdgcn_ds_bpermute((lane_ ^ 16) << 2, __builtin_bit_cast(int, s)));
                    s += __builtin_bit_cast(float, __builtin_amdgcn_ds_bpermute((lane_ ^ 32) << 2, __builtin_bit_cast(int, s)));
                    sc = __builtin_amdgcn_rsqf(s * (1.0f / 1024.0f) + 1e-6f); }
#pragma unroll
                for (int bj = 0; bj < 2; ++bj) { const f32x4 v0 = acc[ai][bj][m][0] * sc, v1 = acc[ai][bj][m][1] * sc;
                    u32x4 w;
                    if (F16) { w.x = __builtin_bit_cast(unsigned, __builtin_amdgcn_cvt_pkrtz(v0[0], v0[1])); w.y = __builtin_bit_cast(unsigned, __builtin_amdgcn_cvt_pkrtz(v0[2], v0[3])); w.z = __builtin_bit_cast(unsigned, __builtin_amdgcn_cvt_pkrtz(v1[0], v1[1])); w.w = __builtin_bit_cast(unsigned, __builtin_amdgcn_cvt_pkrtz(v1[2], v1[3])); }
                    else { w.x = cvt_pk_bf16(v0[0], v0[1]); w.y = cvt_pk_bf16(v0[2], v0[3]); w.z = cvt_pk_bf16(v1[0], v1[1]); w.w = cvt_pk_bf16(v1[2], v1[3]); }
                    __builtin_amdgcn_raw_buffer_store_b128(w, orsrc, (int)(roff + bj * HALF * 2), 0, EPI_AUX); } } }
    }
};
template <bool QKN> struct EpiI8 {
    typedef i32x4 acc_t;
    static constexpr bool PERM = true, AFTER_DRAIN = false;
    bf16_t* O; size_t split_stride; const float* sx; const float* sw; const float* gq; const float* gk; float c2;
    __device__ __forceinline__ void operator()(const i32x4 (&acc)[2][2][4][2], const Unit& u, int wr, int wc, int fr, int fq) const {
        const int row0 = u.pm * BM + wr * 64 + fr; int colt = u.pn * BM; unsigned boff;
        { const int t = colt / 1024; boff = (unsigned)(t * split_stride * 2); colt -= t * 1024; }
        const __amdgpu_buffer_rsrc_t orsrc = __builtin_amdgcn_make_buffer_rsrc((void*)O, (short)0, 0x7ffffff0, 0x00020000);
        const int scol0 = u.pn * BM + wc * 32 + 8 * fq;
        f32x4 cw[2][2];
#pragma unroll
        for (int bj = 0; bj < 2; ++bj) { cw[bj][0] = *(const f32x4*)(sw + scol0 + bj * HALF); cw[bj][1] = *(const f32x4*)(sw + scol0 + bj * HALF + 4); }
        if (QKN && u.pn < 8) {
            const float* g = u.pn < 4 ? gq : gk; const float cc = u.pn < 4 ? c2 : 1.f; const int lane = fr + 16 * fq;
            f32x4 gv[2][2];
#pragma unroll
            for (int bj = 0; bj < 2; ++bj) { gv[bj][0] = *(const f32x4*)(g + 32 * bj + 8 * fq) * cc; gv[bj][1] = *(const f32x4*)(g + 32 * bj + 8 * fq + 4) * cc; }
            const int col0 = colt + 64 * wc + 8 * fq;
#pragma unroll
            for (int ai = 0; ai < 2; ++ai) {
                float rsx[4];
#pragma unroll
                for (int m = 0; m < 4; ++m) rsx[m] = sx[row0 + ai * HALF + m * 16];
#pragma unroll
                for (int m = 0; m < 4; ++m) { const int row = row0 + ai * HALF + m * 16; const unsigned roff = boff + (unsigned)(row * 1024 + col0) * 2u; const float rs = rsx[m];
                    f32x4 v[2][2]; float ss = 0.f;
#pragma unroll
                    for (int bj = 0; bj < 2; ++bj) { const i32x4 a0 = acc[ai][bj][m][0], a1 = acc[ai][bj][m][1];
                        v[bj][0] = (f32x4){(float)a0[0], (float)a0[1], (float)a0[2], (float)a0[3]} * cw[bj][0] * rs; v[bj][1] = (f32x4){(float)a1[0], (float)a1[1], (float)a1[2], (float)a1[3]} * cw[bj][1] * rs;
                        ss += ((v[bj][0][0] * v[bj][0][0] + v[bj][0][1] * v[bj][0][1]) + (v[bj][0][2] * v[bj][0][2] + v[bj][0][3] * v[bj][0][3])) + ((v[bj][1][0] * v[bj][1][0] + v[bj][1][1] * v[bj][1][1]) + (v[bj][1][2] * v[bj][1][2] + v[bj][1][3] * v[bj][1][3])); }
                    ss += __builtin_bit_cast(float, __builtin_amdgcn_ds_bpermute((lane ^ 16) << 2, __builtin_bit_cast(int, ss)));
                    ss += __builtin_bit_cast(float, __builtin_amdgcn_ds_bpermute((lane ^ 32) << 2, __builtin_bit_cast(int, ss)));
                    const float r = __builtin_amdgcn_rsqf(ss * (1.f / 64.f) + 1e-6f);
#pragma unroll
                    for (int bj = 0; bj < 2; ++bj) { const f32x4 o0 = v[bj][0] * r * gv[bj][0], o1 = v[bj][1] * r * gv[bj][1];
                        u32x4 w; w.x = cvt_pk_bf16(o0[0], o0[1]); w.y = cvt_pk_bf16(o0[2], o0[3]); w.z = cvt_pk_bf16(o1[0], o1[1]); w.w = cvt_pk_bf16(o1[2], o1[3]);
                        __builtin_amdgcn_raw_buffer_store_b128(w, orsrc, (int)(roff + bj * 32 * 2), 0, EPI_AUX); } } }
            return;
        }
        const int col0 = colt + wc * 32 + 8 * fq;
#pragma unroll
        for (int ai = 0; ai < 2; ++ai) {
            float rsx[4];
#pragma unroll
            for (int m = 0; m < 4; ++m) rsx[m] = sx[row0 + ai * HALF + m * 16];
#pragma unroll
            for (int m = 0; m < 4; ++m) { const int row = row0 + ai * HALF + m * 16; const unsigned roff = boff + (unsigned)(row * 1024 + col0) * 2u; const float rs = rsx[m];
#pragma unroll
                for (int bj = 0; bj < 2; ++bj) { const i32x4 a0 = acc[ai][bj][m][0], a1 = acc[ai][bj][m][1];
                    const f32x4 v0 = (f32x4){(float)a0[0], (float)a0[1], (float)a0[2], (float)a0[3]} * cw[bj][0] * rs, v1 = (f32x4){(float)a1[0], (float)a1[1], (float)a1[2], (float)a1[3]} * cw[bj][1] * rs;
                    u32x4 w; w.x = cvt_pk_bf16(v0[0], v0[1]); w.y = cvt_pk_bf16(v0[2], v0[3]); w.z = cvt_pk_bf16(v1[0], v1[1]); w.w = cvt_pk_bf16(v1[2], v1[3]);
                    __builtin_amdgcn_raw_buffer_store_b128(w, orsrc, (int)(roff + bj * HALF * 2), 0, EPI_AUX); } } }
    }
};
template <bool BASE16> struct EpiResNorm {
    typedef f32x4 acc_t;
    static constexpr bool PERM = true, AFTER_DRAIN = false;
    const void* base; bf16_t* out; bf16_t* hg; const float* gain; float* rs;
    __device__ __forceinline__ void operator()(const f32x4 (&acc)[2][2][4][2], const Unit& u, int wr, int wc, int fr, int fq) const {
        const int col0 = u.pn * BM + wc * 32 + 8 * fq, lane = fr + 16 * fq;
        f32x4 gv[2][2];
#pragma unroll
        for (int bj = 0; bj < 2; ++bj)
#pragma unroll
            for (int n = 0; n < 2; ++n) gv[bj][n] = *(const f32x4*)(gain + col0 + bj * HALF + n * 4);
#pragma unroll
        for (int ai = 0; ai < 2; ++ai) {
            u32x4 bwp[4][2];
            if (BASE16) {
#pragma unroll
            for (int m = 0; m < 4; ++m)
#pragma unroll
                for (int bj = 0; bj < 2; ++bj) bwp[m][bj] = *(const u32x4*)((const bf16_t*)base + (size_t)(u.pm * BM + ai * HALF + wr * 64 + m * 16 + fr) * 1024 + col0 + bj * HALF);
            __builtin_amdgcn_sched_barrier(0);
            }
#pragma unroll
            for (int m = 0; m < 4; ++m) { const int r = ai * HALF + wr * 64 + m * 16 + fr; const size_t off = (size_t)(u.pm * BM + r) * 1024 + col0;
                float ss = 0.f;
#pragma unroll
                for (int bj = 0; bj < 2; ++bj) { f32x4 b0, b1;
                    if (BASE16) { const u32x4 bw = bwp[m][bj];
                        b0 = (f32x4){__builtin_bit_cast(float, bw.x << 16), __builtin_bit_cast(float, bw.x & 0xffff0000u), __builtin_bit_cast(float, bw.y << 16), __builtin_bit_cast(float, bw.y & 0xffff0000u)};
                        b1 = (f32x4){__builtin_bit_cast(float, bw.z << 16), __builtin_bit_cast(float, bw.z & 0xffff0000u), __builtin_bit_cast(float, bw.w << 16), __builtin_bit_cast(float, bw.w & 0xffff0000u)}; }
                    else { b0 = *(const f32x4*)((const float*)base + off + bj * HALF); b1 = *(const f32x4*)((const float*)base + off + bj * HALF + 4); }
                    const f32x4 o0 = b0 + acc[ai][bj][m][0], o1 = b1 + acc[ai][bj][m][1];
                    u32x4 wo; wo.x = cvt_pk_bf16(o0[0], o0[1]); wo.y = cvt_pk_bf16(o0[2], o0[3]); wo.z = cvt_pk_bf16(o1[0], o1[1]); wo.w = cvt_pk_bf16(o1[2], o1[3]);
                    *(u32x4*)(out + off + bj * HALF) = wo;
                    ss += ((o0[0] * o0[0] + o0[1] * o0[1]) + (o0[2] * o0[2] + o0[3] * o0[3])) + ((o1[0] * o1[0] + o1[1] * o1[1]) + (o1[2] * o1[2] + o1[3] * o1[3]));
                    const f32x4 h0 = o0 * gv[bj][0], h1 = o1 * gv[bj][1];
                    u32x4 w; w.x = cvt_pk_bf16(h0[0], h0[1]); w.y = cvt_pk_bf16(h0[2], h0[3]); w.z = cvt_pk_bf16(h1[0], h1[1]); w.w = cvt_pk_bf16(h1[2], h1[3]);
                    *(u32x4*)(hg + off + bj * HALF) = w; }
                ss += __builtin_bit_cast(float, __builtin_amdgcn_ds_bpermute((lane ^ 16) << 2, __builtin_bit_cast(int, ss)));
                ss += __builtin_bit_cast(float, __builtin_amdgcn_ds_bpermute((lane ^ 32) << 2, __builtin_bit_cast(int, ss)));
                if (fq == 0) rs[(size_t)(u.pm * BM + r) * 16 + u.pn * 4 + wc] = ss; } }
    }
};
__device__ __forceinline__ f32x4 mma16(bf16x8 a, bf16x8 b, f32x4 c) { return __builtin_amdgcn_mfma_f32_16x16x32_bf16(a, b, c, 0, 0, 0); }
__device__ __forceinline__ i32x4 mma16(bf16x8 a, bf16x8 b, i32x4 c) { return __builtin_amdgcn_mfma_i32_16x16x64_i8(__builtin_bit_cast(i32x4, a), __builtin_bit_cast(i32x4, b), c, 0, 0, 0); }
template <class Epi, class Sched, bool ALIGN_EPI = false, bool SP2 = false>
__device__ __forceinline__ void gemm_phase(PG8_LAS unsigned char* lds, const Gemm g, const Sched& S, const Epi& E, int tid_in) {
    int tid_ = tid_in; asm volatile("" : "+v"(tid_));
    const int tid = tid_, wid = __builtin_amdgcn_readfirstlane(tid >> 6), lane = tid & 63, wr = wid >> 2, wc = wid & 3, fr = lane & 15, fq = lane >> 4;
    const int K = g.K, nt = K / BK;
    unsigned voffA[2], voffB[2];
#pragma unroll
    for (int i = 0; i < 2; ++i) { int R, C; stage_rc(tid * 16 + i * 8192, R, C); const int Rb = Epi::PERM ? ((R & ~31) + perm32(R & 31)) : R;
        voffA[i] = (unsigned)(R * K + C) * 2u; voffB[i] = (unsigned)(Rb * K + C) * 2u; }
    const size_t kstep = (size_t)(BK * 2);
    const size_t hstep = (size_t)HALF * K * 2;
    const size_t tstep = 2 * hstep;
    const unsigned ldsw = (unsigned)wid * 1024u;
    const int aoff = lds_byte(wr * 64 + fr, fq * 8), boff = lds_byte(wc * 32 + fr, fq * 8);
#define PG8_SA(b, h) (((b) * 2 + (h)) * HTB)
#define PG8_SB(b, h) ((4 + (b) * 2 + (h)) * HTB)
#define PG8_STAGE(bufoff, gbase, voff) do { _Pragma("unroll") for (int _i = 0; _i < 2; ++_i) \
        __builtin_amdgcn_global_load_lds((const unsigned*)((const char*)(gbase) + (voff)[_i]), (PG8_LAS unsigned*)(lds + (bufoff) + ldsw + _i * 8192), 16, 0, 0); } while (0)
#define PG8_LDA(dst, b, h) do { _Pragma("unroll") for (int m = 0; m < 4; ++m) _Pragma("unroll") for (int k = 0; k < 2; ++k) dst[m][k] = *(const PG8_LAS bf16x8*)(lds + PG8_SA(b, h) + aoff + m * 2048 + k * 1024); } while (0)
#define PG8_LDB(dst, b, h) do { _Pragma("unroll") for (int n = 0; n < 2; ++n) _Pragma("unroll") for (int k = 0; k < 2; ++k) dst[n][k] = *(const PG8_LAS bf16x8*)(lds + PG8_SB(b, h) + boff + n * 2048 + k * 1024); } while (0)
#define PG8_MMA(ai, bj, At, Bt) do { __builtin_amdgcn_s_setprio(1); _Pragma("unroll") for (int m = 0; m < 4; ++m) _Pragma("unroll") for (int n = 0; n < 2; ++n) _Pragma("unroll") for (int k = 0; k < 2; ++k) \
        acc[ai][bj][m][n] = mma16(Bt[n][k], At[m][k], acc[ai][bj][m][n]); __builtin_amdgcn_s_setprio(0); } while (0)
#define PG8_WAIT_V(n) asm volatile("s_waitcnt vmcnt(" #n ")" ::: "memory")
#define PG8_WAIT_L(n) asm volatile("s_waitcnt lgkmcnt(" #n ")" ::: "memory")
#define PG8_BAR __builtin_amdgcn_s_barrier()
#define PG8_SCHED __builtin_amdgcn_sched_barrier(0)
    Unit cur, nxt; int ui = 0;
    if (!S.next(0, cur)) return;
    typedef typename Epi::acc_t acc_t;
    acc_t acc[2][2][4][2];
#pragma unroll
    for (int a = 0; a < 2; ++a)
#pragma unroll
        for (int b = 0; b < 2; ++b)
#pragma unroll
            for (int m = 0; m < 4; ++m)
#pragma unroll
                for (int n = 0; n < 2; ++n) acc[a][b][m][n] = (acc_t){0, 0, 0, 0};
    bf16x8 At[4][2], B0[2][2], B1[2][2];
    const char* cA = (const char*)g.A + (size_t)cur.pm * tstep; const char* cB = (const char*)g.Bt + (size_t)cur.pn * tstep;
    S.a_ready(cur);
    if constexpr (SP2) {
        PG8_STAGE(PG8_SB(0, 0), cB, voffB); PG8_STAGE(PG8_SB(0, 1), cB + hstep, voffB); PG8_STAGE(PG8_SA(0, 0), cA, voffA); PG8_STAGE(PG8_SA(0, 1), cA + hstep, voffA);
        if (wr == 1) PG8_BAR;
        PG8_WAIT_V(2); PG8_BAR;
        PG8_STAGE(PG8_SB(1, 0), cB + kstep, voffB); PG8_STAGE(PG8_SA(1, 0), cA + kstep, voffA); PG8_STAGE(PG8_SB(1, 1), cB + hstep + kstep, voffB);
        PG8_WAIT_V(6); PG8_BAR;
    } else {
        PG8_STAGE(PG8_SB(0, 0), cB, voffB); PG8_STAGE(PG8_SA(0, 0), cA, voffA); PG8_STAGE(PG8_SB(0, 1), cB + hstep, voffB); PG8_STAGE(PG8_SA(0, 1), cA + hstep, voffA);
        if (wr == 1) PG8_BAR;
        PG8_WAIT_V(4); PG8_BAR;
        PG8_STAGE(PG8_SB(1, 0), cB + kstep, voffB); PG8_STAGE(PG8_SA(1, 0), cA + kstep, voffA); PG8_STAGE(PG8_SB(1, 1), cB + hstep + kstep, voffB);
        PG8_WAIT_V(6); PG8_BAR;
    }
    for (;;) {
        const bool has_next = S.next(ui + 1, nxt);
        const char* nA = has_next ? (const char*)g.A + (size_t)nxt.pm * tstep : cA; const char* nB = has_next ? (const char*)g.Bt + (size_t)nxt.pn * tstep : cB;
        for (int t = 0; t < nt; t += 2) {
            const bool last = (t == nt - 2);
            const char* a1 = cA + (size_t)(t + 1) * kstep;
            const char* a2 = last ? nA : cA + (size_t)(t + 2) * kstep; const char* b2 = last ? nB : cB + (size_t)(t + 2) * kstep;
            const char* a3 = a2 + kstep; const char* b3 = b2 + kstep;
            if (last && has_next) S.a_ready(nxt);
            if constexpr (SP2) {
            PG8_LDB(B0, 0, 0); PG8_LDB(B1, 0, 1); PG8_SCHED; PG8_LDA(At, 0, 0); PG8_STAGE(PG8_SA(1, 1), a1 + hstep, voffA);
            PG8_WAIT_V(8); PG8_WAIT_L(0); PG8_BAR; PG8_MMA(0, 0, At, B0); PG8_MMA(0, 1, At, B1); PG8_BAR; PG8_SCHED;
            PG8_LDA(At, 0, 1); PG8_STAGE(PG8_SB(0, 0), b2, voffB); PG8_STAGE(PG8_SB(0, 1), b2 + hstep, voffB); PG8_STAGE(PG8_SA(0, 0), a2, voffA);
            PG8_WAIT_V(8); PG8_WAIT_L(0); PG8_BAR; PG8_MMA(1, 0, At, B0); PG8_MMA(1, 1, At, B1); PG8_BAR; PG8_SCHED;
            PG8_LDB(B0, 1, 0); PG8_LDB(B1, 1, 1); PG8_SCHED; PG8_LDA(At, 1, 0); PG8_STAGE(PG8_SA(0, 1), a2 + hstep, voffA);
            PG8_WAIT_V(8); PG8_WAIT_L(0); PG8_BAR; PG8_MMA(0, 0, At, B0); PG8_MMA(0, 1, At, B1); PG8_BAR; PG8_SCHED;
            PG8_LDA(At, 1, 1); PG8_STAGE(PG8_SB(1, 0), b3, voffB); PG8_STAGE(PG8_SB(1, 1), b3 + hstep, voffB); PG8_STAGE(PG8_SA(1, 0), a3, voffA);
            PG8_WAIT_V(8); PG8_WAIT_L(0); PG8_BAR; PG8_MMA(1, 0, At, B0); PG8_MMA(1, 1, At, B1); PG8_BAR; PG8_SCHED;
            } else {
            PG8_LDB(B0, 0, 0); PG8_SCHED; PG8_LDA(At, 0, 0); PG8_STAGE(PG8_SA(1, 1), a1 + hstep, voffA);
            PG8_WAIT_L(8); PG8_BAR; PG8_WAIT_L(0); PG8_MMA(0, 0, At, B0); PG8_BAR; PG8_SCHED;
            PG8_LDB(B1, 0, 1); PG8_STAGE(PG8_SB(0, 0), b2, voffB);
            PG8_BAR; PG8_WAIT_L(0); PG8_MMA(0, 1, At, B1); PG8_BAR;
            PG8_LDA(At, 0, 1); PG8_STAGE(PG8_SA(0, 0), a2, voffA);
            PG8_BAR; PG8_WAIT_L(0); PG8_MMA(1, 0, At, B0); PG8_BAR; PG8_SCHED;
            PG8_STAGE(PG8_SB(0, 1), b2 + hstep, voffB);
            PG8_WAIT_V(6); PG8_BAR; PG8_MMA(1, 1, At, B1); PG8_BAR;
            PG8_LDB(B0, 1, 0); PG8_SCHED; PG8_LDA(At, 1, 0); PG8_STAGE(PG8_SA(0, 1), a2 + hstep, voffA);
            PG8_WAIT_L(8); PG8_BAR; PG8_WAIT_L(0); PG8_MMA(0, 0, At, B0); PG8_BAR; PG8_SCHED;
            PG8_LDB(B1, 1, 1); PG8_STAGE(PG8_SB(1, 0), b3, voffB);
            PG8_BAR; PG8_WAIT_L(0); PG8_MMA(0, 1, At, B1); PG8_BAR;
            PG8_LDA(At, 1, 1); PG8_STAGE(PG8_SA(1, 0), a3, voffA);
            PG8_BAR; PG8_WAIT_L(0); PG8_MMA(1, 0, At, B0); PG8_BAR; PG8_SCHED;
            PG8_STAGE(PG8_SB(1, 1), b3 + hstep, voffB);
            PG8_WAIT_V(6); PG8_BAR; PG8_MMA(1, 1, At, B1); PG8_BAR;
            }
        }
        if constexpr (ALIGN_EPI) { if (wr == 0) PG8_BAR; }
        if constexpr (!Epi::AFTER_DRAIN) { E(acc, cur, wr, wc, fr, fq); S.done(cur); }
        if (!has_next) break;
#pragma unroll
        for (int a = 0; a < 2; ++a)
#pragma unroll
            for (int b = 0; b < 2; ++b)
#pragma unroll
                for (int m = 0; m < 4; ++m)
#pragma unroll
                    for (int n = 0; n < 2; ++n) acc[a][b][m][n] = (acc_t){0, 0, 0, 0};
        cur = nxt; cA = nA; cB = nB; ++ui;
        if constexpr (ALIGN_EPI) { if (wr == 1) PG8_BAR; }
    }
    PG8_WAIT_V(0);
    if constexpr (!ALIGN_EPI) { if (wr == 0) PG8_BAR; }
    PG8_BAR;
    if constexpr (Epi::AFTER_DRAIN) { E.fused(acc, cur, wr, wc, fr, fq, lds, wid, lane); S.done(cur); }
#undef PG8_SA
#undef PG8_SB
#undef PG8_STAGE
#undef PG8_LDA
#undef PG8_LDB
#undef PG8_MMA
#undef PG8_WAIT_V
#undef PG8_WAIT_L
#undef PG8_BAR
#undef PG8_SCHED
}
}
#include <hip/hip_bf16.h>
#include <cmath>
namespace attn_body {
using bf16=__hip_bfloat16;
using bf16x8=__attribute__((ext_vector_type(8)))short;
using s16x4=__attribute__((ext_vector_type(4)))short;
using f32x16=__attribute__((ext_vector_type(16)))float;
using u32x4=__attribute__((ext_vector_type(4)))unsigned;
constexpr int BATCH=8,NHEAD=16,SEQ=2048,D=64,DM=NHEAD*D;
constexpr int NW=8,QBLK=32,QB=QBLK*NW,KVBLK=64,NQB=SEQ/QB;
constexpr int ATTN_PITCH=DM, ATTN_UNIT_ROWS=QB;
__device__ __forceinline__ int crow(int r,int hi){return (r&3)+8*(r>>2)+4*hi;}
#define SBAR() __builtin_amdgcn_sched_barrier(0)
__device__ __forceinline__ void cmask(f32x16&p0,f32x16&p1,int jb,int qrel,int hi){
  const float NEG=-INFINITY; int kb=64*jb+4*hi;
  #pragma unroll
  for(int r=0;r<16;++r){int kv=kb+(r&3)+8*(r>>2); if(kv>qrel)p0[r]=NEG; if(kv+32>qrel)p1[r]=NEG;}
}

constexpr int NSLOT=3, SLOTB=8192;
constexpr int LDS_K=0, LDS_V=NSLOT*SLOTB, LDS_WS=2*NSLOT*SLOTB, LDS_OST=LDS_WS+NW*64*4, LDS_CS=LDS_OST+NW*4096, LDS_BYTES=LDS_CS+SEQ*4;
constexpr int LDS_QB=94208;
constexpr float C2=0.125f*1.4426950408889634f;
__device__ __forceinline__ void glds16(const void*gsrc,unsigned lds_dst){unsigned keep;
  asm volatile("s_mov_b32 %0, m0\n\ts_mov_b32 m0, %2\n\ts_nop 0\n\tglobal_load_lds_dwordx4 %1, off\n\ts_mov_b32 m0, %0":"=&s"(keep):"v"(gsrc),"s"(lds_dst):"memory");}
__device__ __forceinline__ float max3f(float a,float b,float c){float r;asm("v_max3_f32 %0, %1, %2, %3":"=v"(r):"v"(a),"v"(b),"v"(c));return r;}
__device__ __forceinline__ float max2f(float a,float b){float r;asm("v_max_f32_e32 %0, %1, %2":"=v"(r):"v"(a),"v"(b));return r;}
__device__ __forceinline__ float fadd_s(float a,float b){float r;asm("v_add_f32_e32 %0, %1, %2":"=v"(r):"v"(a),"v"(b));return r;}
__device__ __forceinline__ float fsub_s(float a,float b){float r;asm("v_sub_f32_e32 %0, %1, %2":"=v"(r):"v"(a),"v"(b));return r;}
typedef float f32x2_t __attribute__((ext_vector_type(2))); typedef __bf16 bf16x2_t __attribute__((ext_vector_type(2)));
__device__ __forceinline__ unsigned cvtpk_s(float lo,float hi){f32x2_t v={lo,hi};bf16x2_t b=__builtin_convertvector(v,bf16x2_t);return __builtin_bit_cast(unsigned,b);}
#define WAIT_BAR(N) asm volatile("s_waitcnt vmcnt(" #N ") lgkmcnt(0)\n\ts_barrier":::"memory")

typedef __attribute__((address_space(3))) const char* lds_cptr;
__device__ __forceinline__ void qkt(f32x16&p0,f32x16&p1,const char*Kslot,lds_cptr qls,bf16x8 ax0,bf16x8 ax1,bf16x8 qx,int r32,int hi){
  const char*kb=Kslot+hi*1024+r32*16; const f32x16 z16=f32x16{};
  p0=__builtin_amdgcn_mfma_f32_32x32x16_bf16(ax0,qx,z16,0,0,0);p1=__builtin_amdgcn_mfma_f32_32x32x16_bf16(ax1,qx,z16,0,0,0);
  #pragma unroll
  for(int d0=0;d0<4;++d0){
    const bf16x8 b0=*reinterpret_cast<const bf16x8*>(kb+d0*2048);
    const bf16x8 b1=*reinterpret_cast<const bf16x8*>(kb+d0*2048+512);
    const bf16x8 qd=*(const __attribute__((address_space(3))) bf16x8*)(qls+d0*1024);
    p0=__builtin_amdgcn_mfma_f32_32x32x16_bf16(b0,qd,p0,0,0,0);p1=__builtin_amdgcn_mfma_f32_32x32x16_bf16(b1,qd,p1,0,0,0);}
}
typedef short v4i16_t __attribute__((ext_vector_type(4)));
__device__ __forceinline__ void kload8(bf16x8*kf,lds_cptr kp){
  kf[0]=*(const __attribute__((address_space(3))) bf16x8*)(kp);      kf[1]=*(const __attribute__((address_space(3))) bf16x8*)(kp+512);
  kf[2]=*(const __attribute__((address_space(3))) bf16x8*)(kp+2048); kf[3]=*(const __attribute__((address_space(3))) bf16x8*)(kp+2560);
  kf[4]=*(const __attribute__((address_space(3))) bf16x8*)(kp+4096); kf[5]=*(const __attribute__((address_space(3))) bf16x8*)(kp+4608);
  kf[6]=*(const __attribute__((address_space(3))) bf16x8*)(kp+6144); kf[7]=*(const __attribute__((address_space(3))) bf16x8*)(kp+6656);
}
__device__ __forceinline__ void kload2(bf16x8*kf,lds_cptr kp,int j){ kf[2*j]=*(const __attribute__((address_space(3))) bf16x8*)(kp+j*2048); kf[2*j+1]=*(const __attribute__((address_space(3))) bf16x8*)(kp+j*2048+512); }
__device__ __forceinline__ s16x4 vtr(lds_cptr p){ return __builtin_bit_cast(s16x4,__builtin_amdgcn_ds_read_tr16_b64_v4i16((__attribute__((address_space(3))) v4i16_t*)p)); }
__device__ __forceinline__ float rowmax(const f32x16&p0,const f32x16&p1){
  float a=max3f(p0[0],p0[1],p1[0]),b=max3f(p0[2],p0[3],p1[1]);a=max3f(a,p1[2],p1[3]);
  #pragma unroll
  for(int r=4;r<16;r+=4){a=max3f(a,p0[r],p0[r+1]);b=max3f(b,p0[r+2],p0[r+3]);a=max3f(a,p1[r],p1[r+1]);b=max3f(b,p1[r+2],p1[r+3]);}
  const float m=max2f(a,b);
  auto rr=__builtin_amdgcn_permlane32_swap(__float_as_uint(m),__float_as_uint(m),false,false);
  return max2f(__uint_as_float(rr[0]),__uint_as_float(rr[1]));
}
__device__ __forceinline__ void pv(f32x16*o,int vb,bf16x8 pa0,bf16x8 pa1,bf16x8 pa2,bf16x8 pa3){
  #pragma unroll
  for(int d0=0;d0<2;++d0){s16x4 lo[4],hi[4];
    #pragma unroll
    for(int ks=0;ks<4;++ks){
      asm volatile("ds_read_b64_tr_b16 %0,%1 offset:%c2":"=&v"(lo[ks]):"v"(vb),"i"(d0*4096+ks*1024):"memory");
      asm volatile("ds_read_b64_tr_b16 %0,%1 offset:%c2":"=&v"(hi[ks]):"v"(vb),"i"(d0*4096+ks*1024+512):"memory");}
    asm volatile("s_waitcnt lgkmcnt(0)":::"memory");SBAR();
    #define PK(k) (bf16x8){lo[k][0],lo[k][1],lo[k][2],lo[k][3],hi[k][0],hi[k][1],hi[k][2],hi[k][3]}
    o[d0]=__builtin_amdgcn_mfma_f32_32x32x16_bf16(pa0,PK(0),o[d0],0,0,0);
    o[d0]=__builtin_amdgcn_mfma_f32_32x32x16_bf16(pa1,PK(1),o[d0],0,0,0);
    o[d0]=__builtin_amdgcn_mfma_f32_32x32x16_bf16(pa2,PK(2),o[d0],0,0,0);
    o[d0]=__builtin_amdgcn_mfma_f32_32x32x16_bf16(pa3,PK(3),o[d0],0,0,0);
    #undef PK
  }
}

__device__ __forceinline__ void split3(float c,unsigned&hb,unsigned&mb,unsigned&lb){
  hb=__float_as_uint(c)&0xffff0000u; const float r1=c-__uint_as_float(hb); mb=__float_as_uint(r1)&0xffff0000u; const float r2=r1-__uint_as_float(mb); lb=__float_as_uint(r2)&0xffff0000u; }
__device__ __forceinline__ bf16x8 make_ax(float negc){ unsigned hb,mb,lb; split3(negc,hb,mb,lb);
  u32x4 w; w.x=(hb>>16)|mb; w.y=(lb>>16)|0x3f800000u; w.z=0x3f803f80u; w.w=0u; return __builtin_bit_cast(bf16x8,w); }
__device__ __forceinline__ bf16x8 make_qx(float negm,unsigned hm){ unsigned hb,mb,lb; split3(negm,hb,mb,lb);
  u32x4 w; w.x=0x3f803f80u&hm; w.y=(0x3f80u|hb)&hm; w.z=((mb>>16)|lb)&hm; w.w=0u; return __builtin_bit_cast(bf16x8,w); }
#ifndef ATTN_STORE16
#define ATTN_STORE16(p,v) (*(u32x4*)(p)=(v))
#endif
template<int THRL> __device__ __forceinline__ void attn_unit(int b,int h,int qb,const bf16*Q,const bf16*__restrict__ K,const bf16*__restrict__ V,bf16*O,const bf16*__restrict__ Gt,char*shm,const int tid_u,const float skip_thr,const bool pre,const int nqb,const int par){
  int tid=tid_u; asm volatile("":"+v"(tid));
  const int lane=tid&63,r32=lane&31,hi=lane>>5; const int wid=__builtin_amdgcn_readfirstlane(tid>>6);
  const long rowbase=(long)b*SEQ; const int q0=qb*QB;
  const bf16*Qw=Q+(rowbase+q0+wid*QBLK)*DM+h*D;
  float*csp=(float*)(shm+LDS_CS);
  int tskip=0;
  { const float cq0=csp[q0]; const int ntall=(q0+QB)/KVBLK; while(tskip+2<=ntall-4 && csp[KVBLK*(tskip+1)+KVBLK-1]-cq0<skip_thr)tskip+=2; tskip=__builtin_amdgcn_readfirstlane(tskip); }
  const bf16*Kh=K+(rowbase+(long)tskip*KVBLK)*DM+h*D,*Vh=V+(rowbase+(long)tskip*KVBLK)*DM+h*D;
  const unsigned lds0=(unsigned)(uintptr_t)shm;
  float*wsf=(float*)(shm+LDS_WS)+wid*64;
  const unsigned koff=(unsigned)(lane*DM+wid*8), voff=(unsigned)((16*(wid&3)+(lane>>2))*DM+(wid>>2)*32+(lane&3)*8);
  const unsigned kdst=lds0+LDS_K+wid*1024, vdst=lds0+LDS_V+wid*1024;
  #define DMA_K(t,slot) do{unsigned o_=koff;asm volatile("":"+v"(o_));glds16(Kh+(long)(t)*KVBLK*DM+o_,(unsigned)__builtin_amdgcn_readfirstlane(kdst+(slot)));}while(0)
  #define DMA_V(t,slot) do{unsigned o_=voff;asm volatile("":"+v"(o_));glds16(Vh+(long)(t)*KVBLK*DM+o_,(unsigned)__builtin_amdgcn_readfirstlane(vdst+(slot)));}while(0)
  const int vb0=(int)(lds0+LDS_V)+((lane>>4)&1)*32+(lane&3)*8+(4*hi+((lane&15)>>2))*64;
  const char*Kbase=shm+LDS_K; bf16x8 kf[8];
  const lds_cptr shm3=(lds_cptr)shm; const lds_cptr kp0=shm3+LDS_K+hi*1024+r32*16; const lds_cptr vp0=shm3+LDS_V+((lane>>4)&1)*32+(lane&3)*8+(4*hi+((lane&15)>>2))*64;
  const int NT=(q0+QB)/KVBLK-tskip;
  const float*cst=csp+tskip*KVBLK;
  const unsigned hm=hi?0u:0xffffffffu;
  const unsigned qdst=lds0+LDS_QB+par*32768+wid*4096;
  #define DMA_Q(Qp,dst) do{ _Pragma("unroll") for(int d0=0;d0<4;++d0){ unsigned o_=(unsigned)(r32*DM+hi*8); asm volatile("":"+v"(o_)); glds16((Qp)+o_+d0*16,(unsigned)__builtin_amdgcn_readfirstlane((dst)+d0*1024)); } }while(0)
  if(!pre){ DMA_Q(Qw,qdst); DMA_K(0,0);DMA_V(0,0);DMA_K(1,SLOTB); }
  const lds_cptr qls=shm3+LDS_QB+par*32768+wid*4096+hi*512+r32*16;
  #define QLD(k) (*(const __attribute__((address_space(3))) bf16x8*)(qls+(k)*1024))
  float mhat=csp[q0+wid*QBLK+r32],l_reg=0.f;f32x16 o[2];o[0]=f32x16{};o[1]=f32x16{}; bf16x8 qx=make_qx(-mhat,hm);
  const int qrel=wid*QBLK+r32;
  #define CMASK(P0,P1,t) do{int jb_=(t)-(NT-4); if(jb_>=0)cmask(P0,P1,jb_,qrel,hi);}while(0)
  bool resc=false;
  #define START(P0,P1) do{ const float rm=rowmax(P0,P1); resc=false; \
    if(__any(rm>(float)THRL)){ const float dl=__builtin_fmaxf(rm,0.f); mhat=fadd_s(mhat,dl); \
      _Pragma("unroll") for(int r=0;r<16;++r){P0[r]=fsub_s(P0[r],dl);P1[r]=fsub_s(P1[r],dl);} \
      qx=make_qx(-mhat,hm); } \
    _Pragma("unroll") for(int r=0;r<16;++r)P0[r]=__builtin_amdgcn_exp2f(P0[r]); }while(0)
  #define RESC() do{ if(resc){ asm volatile("s_waitcnt lgkmcnt(0)":::"memory"); \
      _Pragma("unroll") for(int d_=0;d_<2;++d_) _Pragma("unroll") for(int r=0;r<16;++r)o[d_][r]*=wsf[crow(r,hi)]; } }while(0)
  f32x16 pA0,pA1,pB0,pB1;
  int sl_prev=0,sl_cur=0,sl_next=SLOTB;
  #define ROT() do{sl_prev=sl_cur;sl_cur=sl_next;sl_next=(sl_next==(NSLOT-1)*SLOTB)?0:sl_next+SLOTB;}while(0)
  DMA_K(2,2*SLOTB);
  WAIT_BAR(3);
  qkt(pA0,pA1,Kbase,qls,make_ax(cst[r32]),make_ax(cst[32+r32]),qx,r32,hi);asm volatile("s_nop 15\n\ts_nop 7":"+v"(pA0),"+v"(pA1));CMASK(pA0,pA1,0);
  START(pA0,pA1);
  _Pragma("unroll") for(int r=0;r<16;++r)pA1[r]=__builtin_amdgcn_exp2f(pA1[r]);
  WAIT_BAR(0);
  DMA_K(3,0);DMA_V(1,SLOTB);
  ROT();
  kload8(kf,kp0+sl_cur);
  WAIT_BAR(2);
  s16x4 vlo[8],vhi[8]; u32x4 pw0,pw1,pw2,pw3;
  #define PKW(P,B) cvtpk_s(P[B],P[B+1])
  #define PAF(k) __builtin_bit_cast(bf16x8,pw##k)
  #define VFR(i) (bf16x8){vlo[i][0],vlo[i][1],vlo[i][2],vlo[i][3],vhi[i][0],vhi[i][1],vhi[i][2],vhi[i][3]}
  #define PIN(x) asm volatile("":"+v"(x))
  #define MX3(a,b,c) __builtin_fmaxf(__builtin_fmaxf((a),(b)),(c))
  #define GAPA(MF,A0,A1,A2,A3,W0,W1,PW) do{ MF; sacc+=A0; sacc+=A1; sacc+=A2; sacc+=A3; PIN(sacc); W0; W1; PIN(PW); SBAR(); }while(0)
  #define EX(v) __builtin_amdgcn_exp2f(v)
  #define GAPB(MF,X,B) do{ MF; X[B]=EX(X[B]); X[B+1]=EX(X[B+1]); X[B+2]=EX(X[B+2]); X[B+3]=EX(X[B+3]); PIN(X); SBAR(); }while(0)
  #define VRD(i) do{ vlo[i]=vtr(vp_+(((i)>>2)*4096+((i)&3)*1024)); vhi[i]=vtr(vp_+(((i)>>2)*4096+((i)&3)*1024+512)); }while(0)
  #define KRD(G,j) do{ if(G){ kload2(kf,kp0+sl_next,j); SBAR(); } }while(0)
  #define STEP(C0,C1,P0,P1,t,GK,GV,GL) do{ SBAR(); \
    const lds_cptr vp_=vp0+sl_prev; \
    const bf16x8 ax0_=make_ax(cst[(t)*KVBLK+r32]), ax1_=make_ax(cst[(t)*KVBLK+32+r32]); \
    C0=__builtin_amdgcn_mfma_f32_32x32x16_bf16(ax0_,qx,f32x16{},0,0,0); C1=__builtin_amdgcn_mfma_f32_32x32x16_bf16(ax1_,qx,f32x16{},0,0,0); SBAR(); \
    bf16x8 q0_=QLD(0), q1_=QLD(1); \
    VRD(0); SBAR(); float sacc=(P0[0]+P0[1]); \
    GAPA(C0=__builtin_amdgcn_mfma_f32_32x32x16_bf16(kf[0],q0_,C0,0,0,0), P0[2],P0[3],P0[4],P0[5],     pw0[0]=PKW(P0,0), pw0[1]=PKW(P0,2), pw0); \
    VRD(4); SBAR(); GAPA(C1=__builtin_amdgcn_mfma_f32_32x32x16_bf16(kf[1],q0_,C1,0,0,0), P0[6],P0[7],P0[8],P0[9],     pw0[2]=PKW(P0,4), pw0[3]=PKW(P0,6), pw0); q0_=QLD(2); \
    VRD(1); SBAR(); GAPA(C0=__builtin_amdgcn_mfma_f32_32x32x16_bf16(kf[2],q1_,C0,0,0,0),   P0[10],P0[11],P0[12],P0[13], pw1[0]=PKW(P0,8), pw1[1]=PKW(P0,10), pw1); \
    VRD(5); SBAR(); GAPA(C1=__builtin_amdgcn_mfma_f32_32x32x16_bf16(kf[3],q1_,C1,0,0,0),   P0[14],P0[15],P1[0],P1[1],   pw1[2]=PKW(P0,12),pw1[3]=PKW(P0,14), pw1); q1_=QLD(3); \
    VRD(2); SBAR(); GAPA(C0=__builtin_amdgcn_mfma_f32_32x32x16_bf16(kf[4],q0_,C0,0,0,0),   P1[2],P1[3],P1[4],P1[5],     pw2[0]=PKW(P1,0), pw2[1]=PKW(P1,2), pw2); \
    VRD(6); SBAR(); GAPA(C1=__builtin_amdgcn_mfma_f32_32x32x16_bf16(kf[5],q0_,C1,0,0,0),   P1[6],P1[7],P1[8],P1[9],     pw2[2]=PKW(P1,4), pw2[3]=PKW(P1,6), pw2); \
    VRD(3); SBAR(); GAPA(C0=__builtin_amdgcn_mfma_f32_32x32x16_bf16(kf[6],q1_,C0,0,0,0),   P1[10],P1[11],P1[12],P1[13], pw3[0]=PKW(P1,8), pw3[1]=PKW(P1,10), pw3); \
    VRD(7); SBAR(); GAPA(C1=__builtin_amdgcn_mfma_f32_32x32x16_bf16(kf[7],q1_,C1,0,0,0),   P1[14],P1[15],0.f,0.f,       pw3[2]=PKW(P1,12),pw3[3]=PKW(P1,14), pw3); \
    l_reg+=sacc; \
    if(GK){DMA_K((t)+3,sl_cur);} if(GV){DMA_V((t)+1,sl_next);} \
    CMASK(C0,C1,t); \
    { float a=MX3(C0[0],C0[1],C1[0]),b=MX3(C0[2],C0[3],C1[1]); a=MX3(a,C1[2],C1[3]); \
      _Pragma("unroll") for(int r=4;r<16;r+=4){a=MX3(a,C0[r],C0[r+1]);b=MX3(b,C0[r+2],C0[r+3]);a=MX3(a,C1[r],C1[r+1]);b=MX3(b,C1[r+2],C1[r+3]);} \
      float rm=__builtin_fmaxf(a,b); { auto rr=__builtin_amdgcn_permlane32_swap(__float_as_uint(rm),__float_as_uint(rm),false,false); rm=__builtin_fmaxf(__uint_as_float(rr[0]),__uint_as_float(rr[1])); } \
      resc=false; \
      if(__builtin_expect(__any(rm>(float)THRL),0)){ const float dl=__builtin_fmaxf(rm,0.f); mhat+=dl; \
        _Pragma("unroll") for(int r=0;r<16;++r){C0[r]-=dl;C1[r]-=dl;} \
        qx=make_qx(-mhat,hm); \
        const float f=__builtin_amdgcn_exp2f(-dl); l_reg*=f; if(hi==0)wsf[r32]=f; resc=true; } } \
    SBAR(); \
    GAPB(o[0]=__builtin_amdgcn_mfma_f32_32x32x16_bf16(PAF(0),VFR(0),o[0],0,0,0), C0,0); \
    GAPB(o[1]=__builtin_amdgcn_mfma_f32_32x32x16_bf16(PAF(0),VFR(4),o[1],0,0,0), C0,4); \
    KRD(GL,0); GAPB(o[0]=__builtin_amdgcn_mfma_f32_32x32x16_bf16(PAF(1),VFR(1),o[0],0,0,0), C0,8); \
    KRD(GL,1); GAPB(o[1]=__builtin_amdgcn_mfma_f32_32x32x16_bf16(PAF(1),VFR(5),o[1],0,0,0), C0,12); \
    KRD(GL,2); GAPB(o[0]=__builtin_amdgcn_mfma_f32_32x32x16_bf16(PAF(2),VFR(2),o[0],0,0,0), C1,0); \
    KRD(GL,3); GAPB(o[1]=__builtin_amdgcn_mfma_f32_32x32x16_bf16(PAF(2),VFR(6),o[1],0,0,0), C1,4); \
    GAPB(o[0]=__builtin_amdgcn_mfma_f32_32x32x16_bf16(PAF(3),VFR(3),o[0],0,0,0), C1,8); \
    GAPB(o[1]=__builtin_amdgcn_mfma_f32_32x32x16_bf16(PAF(3),VFR(7),o[1],0,0,0), C1,12); \
    }while(0)
  int t=1;
  #undef CMASK
  #define CMASK(P0,P1,t) do{}while(0)
  for(;t+5<NT;t+=2){
    STEP(pB0,pB1,pA0,pA1,t,true,true,true);     WAIT_BAR(2); RESC(); ROT();
    STEP(pA0,pA1,pB0,pB1,t+1,true,true,true);   WAIT_BAR(2); RESC(); ROT();
  }
  #undef CMASK
  #define CMASK(P0,P1,t) do{int jb_=(t)-(NT-4); if(jb_>=0)cmask(P0,P1,jb_,qrel,hi);}while(0)
  #define ENDW(tt) do{ if((tt)+3<NT){WAIT_BAR(2);} else if((tt)+2<NT){WAIT_BAR(1);} else {WAIT_BAR(0);} }while(0)
  for(;t+1<NT;t+=2){
    STEP(pB0,pB1,pA0,pA1,t,(t+3<NT),(t+1<NT),(t+1<NT));       ENDW(t);   RESC(); ROT();
    STEP(pA0,pA1,pB0,pB1,t+1,(t+4<NT),(t+2<NT),(t+2<NT));     ENDW(t+1); RESC(); ROT();
  }
  u32x4 gpre[4];
  { int tg_=tid; asm volatile("":"+v"(tg_)); const int lg_=tg_&63; const bf16*Gp=Gt+(rowbase+q0+wid*QBLK)*DM+h*D+(long)(lg_>>3)*DM+(lg_&7)*8;
    #pragma unroll
    for(int i=0;i<4;++i)gpre[i]=*(const u32x4*)(Gp+(long)i*8*DM); }
  STEP(pB0,pB1,pA0,pA1,NT-1,false,false,false); RESC();
  { float sacc=pB0[0]+pB0[1]; _Pragma("unroll") for(int r=2;r<16;++r)sacc+=pB0[r]; _Pragma("unroll") for(int r=0;r<16;++r)sacc+=pB1[r]; l_reg+=sacc;
    pw0=(u32x4){PKW(pB0,0),PKW(pB0,2),PKW(pB0,4),PKW(pB0,6)};pw1=(u32x4){PKW(pB0,8),PKW(pB0,10),PKW(pB0,12),PKW(pB0,14)};pw2=(u32x4){PKW(pB1,0),PKW(pB1,2),PKW(pB1,4),PKW(pB1,6)};pw3=(u32x4){PKW(pB1,8),PKW(pB1,10),PKW(pB1,12),PKW(pB1,14)};
    SBAR(); pv(o,vb0+sl_cur,PAF(0),PAF(1),PAF(2),PAF(3)); }
  asm volatile("s_waitcnt lgkmcnt(0)\n\ts_barrier":::"memory");
  if(nqb>=0){ const int q0n=nqb*QB; int tskn=0;
    { const float cq0=csp[q0n]; const int ntall=(q0n+QB)/KVBLK; while(tskn+2<=ntall-4 && csp[KVBLK*(tskn+1)+KVBLK-1]-cq0<skip_thr)tskn+=2; tskn=__builtin_amdgcn_readfirstlane(tskn); }
    const bf16*Khn=K+(rowbase+(long)tskn*KVBLK)*DM+h*D,*Vhn=V+(rowbase+(long)tskn*KVBLK)*DM+h*D;
    { unsigned o_=koff;asm volatile("":"+v"(o_));glds16(Khn+o_,(unsigned)__builtin_amdgcn_readfirstlane(kdst)); }
    { unsigned o_=voff;asm volatile("":"+v"(o_));glds16(Vhn+o_,(unsigned)__builtin_amdgcn_readfirstlane(vdst)); }
    { unsigned o_=koff;asm volatile("":"+v"(o_));glds16(Khn+(long)KVBLK*DM+o_,(unsigned)__builtin_amdgcn_readfirstlane(kdst+SLOTB)); }
    DMA_Q(Q+(rowbase+q0n+wid*QBLK)*DM+h*D,lds0+LDS_QB+(par^1)*32768+wid*4096); }
  #undef PKW
  #undef PAF
  #undef VFR
  #undef PIN
  #undef MX3
  #undef GAPA
  #undef GAPB
  #undef EX
  #undef VRD
  #undef KRD
  #undef STEP
  #undef ENDW
  {auto rr=__builtin_amdgcn_permlane32_swap(__float_as_uint(l_reg),__float_as_uint(l_reg),false,false);l_reg=__uint_as_float(rr[0])+__uint_as_float(rr[1]);}
  { int te=tid; asm volatile("":"+v"(te));
    const int lane_e=te&63,r32e=lane_e&31,hie=lane_e>>5;
    if(hie==0)wsf[32+r32e]=l_reg;asm volatile("s_waitcnt lgkmcnt(0)":::"memory");
    float rli[16];
    #pragma unroll
    for(int r=0;r<16;++r)rli[r]=__builtin_amdgcn_rcpf(wsf[32+crow(r,hie)]);
    bf16*Ow=O+(rowbase+q0+wid*QBLK)*DM+h*D;
    bf16*stg=(bf16*)(shm+LDS_OST)+wid*2048;
    #pragma unroll
    for(int r=0;r<16;++r){const int orow=crow(r,hie);
      #pragma unroll
      for(int d0=0;d0<2;++d0)stg[orow*64+d0*32+r32e]=__float2bfloat16(o[d0][r]*rli[r]);}
    asm volatile("s_waitcnt lgkmcnt(0)":::"memory");
    #pragma unroll
    for(int i=0;i<4;++i){const int row=i*8+(lane_e>>3),ch=lane_e&7; u32x4 v=*(const u32x4*)(stg+row*64+ch*8); const u32x4 gv=gpre[i];
      #pragma unroll
      for(int e=0;e<4;++e){ const float g0=__uint_as_float(gv[e]<<16),g1=__uint_as_float(gv[e]&0xffff0000u),x0=__uint_as_float(v[e]<<16),x1=__uint_as_float(v[e]&0xffff0000u);
        v[e]=cvtpk_s(x0*__builtin_amdgcn_rcpf(1.f+__expf(-g0)),x1*__builtin_amdgcn_rcpf(1.f+__expf(-g1))); }
      ATTN_STORE16(Ow+(long)row*DM+ch*8,v);} }
  asm volatile("s_waitcnt lgkmcnt(0)\n\ts_barrier":::"memory");
  #undef DMA_K
  #undef QLD
  #undef DMA_V
  #undef DMA_Q
  #undef CMASK
  #undef START
  #undef RESC
  #undef ROT
}
constexpr int ATTN_LDS_BYTES=LDS_BYTES;
struct AttnTensors { const bf16* Q; const bf16* K; const bf16* V; bf16* O; const bf16* G; const float* CUM; float THR; };
struct AttnUnit { int bh; int qb; };
struct StaticOrder {
  int vcu;
  __device__ __forceinline__ explicit StaticOrder(int grid,int block):vcu((block%8)*(grid/8)+block/8){}
  __device__ __forceinline__ bool next(int i,AttnUnit&u)const{ if(i>=4)return false; u.bh=vcu>>1; u.qb=(((vcu&1)?0x1247:0x0356)>>(4*i))&15; return true; }
  __device__ __forceinline__ void a_ready(const AttnUnit&)const{}
  __device__ __forceinline__ void done(const AttnUnit&)const{}
};
template<class Sched,int THRL=8> __device__ __forceinline__ void attn_phase(char*lds,const AttnTensors&T,const Sched&S,int tid_in){
  AttnUnit u; int tid_=tid_in; asm volatile("":"+v"(tid_));
  if(S.next(0,u)){ float*csp=(float*)(lds+LDS_CS); float*wt=(float*)(lds+LDS_WS); int tp=tid_in; asm volatile("":"+v"(tp));
    const float*lf=T.CUM+((long)(u.bh/NHEAD)*SEQ+4*tp)*NHEAD+u.bh%NHEAD;
    const float a0=lf[0],a1=a0+lf[NHEAD],a2=a1+lf[2*NHEAD],a3=a2+lf[3*NHEAD];
    float sc=a3; const int ln=tp&63;
    #pragma unroll
    for(int o=1;o<64;o<<=1){ const float up=__builtin_bit_cast(float,__builtin_amdgcn_ds_bpermute((ln-o)<<2,__builtin_bit_cast(int,sc))); if(ln>=o)sc+=up; }
    if(ln==63)wt[tp>>6]=sc;
    __syncthreads();
    float base=sc-a3;
    #pragma unroll
    for(int w=0;w<NW-1;++w)if(w<(tp>>6))base+=wt[w];
    const float k2=-1.4426950408889634f;
    csp[4*tp]=k2*(base+a0);csp[4*tp+1]=k2*(base+a1);csp[4*tp+2]=k2*(base+a2);csp[4*tp+3]=k2*(base+a3);
    __syncthreads(); }
  { AttnUnit un; bool has=S.next(0,u),pre=false;
    for(int i=0;has;++i){ const bool hn=S.next(i+1,un); const bool pn=hn&&un.bh==u.bh; S.a_ready(u); attn_unit<THRL>(u.bh/NHEAD,u.bh%NHEAD,u.qb,T.Q,T.K,T.V,T.O,T.G,lds,tid_,T.THR,pre,pn?un.qb:-1,i&1); S.done(u); has=hn; pre=pn; u=un; } }
}
#undef SBAR
#undef WAIT_BAR
}
#define GAS __attribute__((address_space(1)))
#define LAS __attribute__((address_space(3)))
typedef unsigned short bf16;
typedef unsigned v4u __attribute__((ext_vector_type(4)));
typedef float f32x4 __attribute__((ext_vector_type(4)));
typedef short bf16x8 __attribute__((ext_vector_type(8)));
typedef GAS unsigned gu32;
typedef GAS unsigned long long gu64;
#define RLX_AGENT __ATOMIC_RELAXED, __HIP_MEMORY_SCOPE_AGENT
#define LDS_WAIT() asm volatile("s_waitcnt lgkmcnt(0)" ::: "memory")
#define VM_WAIT() asm volatile("s_waitcnt vmcnt(0)" ::: "memory")
__device__ __forceinline__ unsigned long long rt() { return __builtin_amdgcn_s_memrealtime(); }
__device__ __forceinline__ unsigned f2bf(float f) { unsigned u = __builtin_bit_cast(unsigned, f); return (u + 0x7fffu + ((u >> 16) & 1u)) >> 16; }
__device__ __forceinline__ unsigned pk2(float lo, float hi) { return f2bf(lo) | (f2bf(hi) << 16); }
__device__ __forceinline__ unsigned pk2h(float lo, float hi) { unsigned r; asm("v_cvt_pk_bf16_f32 %0, %1, %2" : "=v"(r) : "v"(lo), "v"(hi)); return r; }
__device__ __forceinline__ unsigned f2bfh(float f) { return pk2h(f, 0.f) & 0xffffu; }

#define XB_TMO      128
#define XB_XCNT(j)  (256  + 64 * (j))
#define XB_XSUB(j)  (1280 + 64 * (j))
#define XB_XGEN(j)  (2304 + 64 * (j))
#define XB_TOP      3328
#define XB_TOPGEN   3392
#define XCD_BAR_WORDS 3456
#define XB_SPIN_CAP (1u << 27)

__device__ __forceinline__ unsigned xb_ld(unsigned* p)              { return __hip_atomic_load(p, __ATOMIC_RELAXED, __HIP_MEMORY_SCOPE_AGENT); }
__device__ __forceinline__ unsigned xb_add(unsigned* p, unsigned v) { return __hip_atomic_fetch_add(p, v, __ATOMIC_RELAXED, __HIP_MEMORY_SCOPE_AGENT); }
__device__ __forceinline__ unsigned xb_xcc_id() { return (unsigned)__builtin_amdgcn_s_getreg((3 << 11) | 20) & 0xFu; }
#define XB_SPIN(cond, bar) do { unsigned _sp = 0; while (cond) { __builtin_amdgcn_s_sleep(1); \
    if ((++_sp & 255u) == 0u) { if (xb_ld(&(bar)[XB_TMO])) break; if (_sp > XB_SPIN_CAP) { atomicAdd(&(bar)[XB_TMO], 1u); break; } } } } while (0)

struct XcdBarrier {
    unsigned* bar; unsigned x;
    volatile LAS unsigned* st;
};

__device__ __forceinline__ XcdBarrier xcd_barrier_post(unsigned* bar, volatile LAS unsigned* st) {
    XcdBarrier b; b.bar = bar; b.x = xb_xcc_id(); b.st = st;
    if (threadIdx.x == 0) (void)xb_add(&bar[XB_XCNT(b.x)], 1u);
    return b;
}
__device__ __forceinline__ void xcd_barrier_complete(unsigned* bar, unsigned x, unsigned& nloc, unsigned& nx) {
    const unsigned G = gridDim.x * gridDim.y * gridDim.z;
    unsigned sum, cnt, mine, sp = 0u;
    for (;;) {
        sum = 0u; cnt = 0u; mine = 0u;
#pragma unroll
        for (unsigned j = 0; j < 16; ++j) { const unsigned c = xb_ld(&bar[XB_XCNT(j)]); sum += c; cnt += (c > 0u) ? 1u : 0u; mine = (j == x) ? c : mine; }
        if (sum == G) break;
        __builtin_amdgcn_s_sleep(1);
        if ((++sp & 255u) == 0u) { if (xb_ld(&bar[XB_TMO])) break; if (sp > XB_SPIN_CAP) { atomicAdd(&bar[XB_TMO], 1u); break; } }
    }
    nloc = mine > 0u ? mine : 1u; nx = cnt > 0u ? cnt : 1u;
}

template <bool FENCE = true, bool LOCAL = false>
__device__ __forceinline__ void xcd_barrier(const XcdBarrier& b, const bool leader  ) {
    if (FENCE) asm volatile("s_waitcnt vmcnt(0)" ::: "memory");
    if (FENCE) __syncthreads(); else { asm volatile("s_waitcnt lgkmcnt(0)" ::: "memory"); __builtin_amdgcn_s_barrier(); asm volatile("" ::: "memory"); }
    if (leader) {
        unsigned* bar = b.bar;
        if (FENCE) __builtin_amdgcn_s_waitcnt(0);
        unsigned nloc = b.st[0], nx = b.st[1];
        if (nloc == 0u) { xcd_barrier_complete(bar, b.x, nloc, nx); b.st[0] = nloc; b.st[1] = nx; }
        const unsigned old = xb_add(&bar[XB_XSUB(b.x)], 1u);
        const unsigned gen = old / nloc;
        if (old + 1u == (gen + 1u) * nloc) {
            if (FENCE) { __builtin_amdgcn_fence(__ATOMIC_RELEASE, "agent");
            asm volatile("s_waitcnt vmcnt(0)" ::: "memory"); }
            if (!LOCAL) {
            const unsigned og = xb_add(&bar[XB_TOP], 1u);
            const unsigned tg = og / nx;
            if (og + 1u == (tg + 1u) * nx) xb_add(&bar[XB_TOPGEN], 1u);
            else XB_SPIN(xb_ld(&bar[XB_TOPGEN]) == tg, bar);
            }
            if (FENCE) __builtin_amdgcn_fence(__ATOMIC_ACQUIRE, "agent");
            xb_add(&bar[XB_XGEN(b.x)], 1u);
            if (FENCE) asm volatile("s_waitcnt vmcnt(0)" ::: "memory");
        } else {
            XB_SPIN(xb_ld(&bar[XB_XGEN(b.x)]) == gen, bar);
            if (FENCE) __builtin_amdgcn_fence(__ATOMIC_ACQUIRE, "agent");
            if (FENCE) asm volatile("s_waitcnt vmcnt(0)" ::: "memory");
        }
    }
    if (FENCE) __syncthreads(); else { asm volatile("s_waitcnt lgkmcnt(0)" ::: "memory"); __builtin_amdgcn_s_barrier(); asm volatile("" ::: "memory"); }
}
#ifndef MK_FASTATTN
#define MK_FASTATTN 1
#endif
#ifndef MK_FASTREC
#define MK_FASTREC 1
#endif
namespace cg = cooperative_groups;
constexpr int NTOK = 16384, DMODEL = 1024, NBATCH = 8, SEQLEN = 2048, DEPTH = 4;
constexpr int FOX_IN = 4112, GLA_IN = 3088, HGRN_IN = 4096;
constexpr float RMS_EPS = 1e-6f;
constexpr float LOG2E = 1.4426950408889634f;
constexpr float FOX_C2 = 0.125f * LOG2E;
constexpr int NWAVES = 8;

constexpr size_t MiB = 1u << 20;
constexpr size_t WS_CTL = 0, CTL_ZERO_BYTES = 1 * MiB;
constexpr size_t WS_FOXWIN = 2 * MiB, WS_FOXWOUT = 18 * MiB, WS_GLAWIN = 22 * MiB, WS_GLAWOUT = 28 * MiB, WS_HGRNWIN = 30 * MiB, WS_HGRNWOUT = 38 * MiB;
constexpr size_t WS_PEERWQ = 40 * MiB, WS_KEYS = 56 * MiB, WS_LB = 58 * MiB;
#define FOXFUSE ((I8MASK & 9) == 9)
#ifndef RPROBE
#define RPROBE 0
#endif
#ifndef UVSYNC
#define UVSYNC 0
#endif
#ifndef SYNC_LOCAL
#define SYNC_LOCAL true
#endif
#ifndef SYNC_U
#define SYNC_U 0x24
#endif
#ifndef SYNC_V
#define SYNC_V 0x24
#endif
#ifndef GPROBE
#define GPROBE 0
#endif
#ifndef BGQ
#define BGQ 1
#endif
#ifndef I8MASK
#define I8MASK 13
#endif
constexpr size_t WS_SW = 58 * MiB + 65536, WS_SX = 58 * MiB + 262144, WS_XN8 = 724 * MiB;
constexpr size_t WS_TAILW = 63 * MiB;
constexpr size_t WS_RS = 62 * MiB;
constexpr size_t WS_U = 64 * MiB, WS_V = 128 * MiB, WS_SU = 60 * MiB, WS_SV = 61 * MiB;
constexpr size_t WS_XN = 320 * MiB, WS_P = 352 * MiB, WS_OB = 480 * MiB, WS_Q2 = 512 * MiB, WS_TAIL = 576 * MiB, WS_CUM = 577 * MiB;
constexpr size_t WS_EXP = 580 * MiB, WS_GATE = 588 * MiB, WS_OF = 596 * MiB, WS_GLOG = 660 * MiB, WS_HB = 740 * MiB, WS_END = 772 * MiB;
constexpr size_t PSTRIDE = (size_t)NTOK * 1024;
constexpr int CW_BAR = 4096;

constexpr int RING_BYTES = 131072;
constexpr int LDSCTL_OFF = 162816, MISC_OFF = LDSCTL_OFF + 320;
constexpr int LDS_BYTES = 163840;

typedef unsigned u32x4v __attribute__((ext_vector_type(4)));
struct Ctx {
    LAS unsigned char* lds; int tid, lane, wave, vcu, G, gw, NGW, bx;
    const float* in[21]; float* out; unsigned char* ws;
};

__device__ __forceinline__ float bf2f(unsigned short b) { return __uint_as_float(((unsigned)b) << 16); }
__device__ __forceinline__ float bflo(unsigned w) { return __uint_as_float(w << 16); }
__device__ __forceinline__ float bfhi(unsigned w) { return __uint_as_float(w & 0xffff0000u); }
#define DPP_ADD(v, ctrl, rm, bm) (v + __builtin_bit_cast(float, __builtin_amdgcn_update_dpp(0, __builtin_bit_cast(int, v), ctrl, rm, bm, false)))
#define DPP_MAX(v, ctrl, rm, bm) fmaxf(v, __builtin_bit_cast(float, __builtin_amdgcn_update_dpp(__builtin_bit_cast(int, v), __builtin_bit_cast(int, v), ctrl, rm, bm, false)))
#define DPP_SUM31(v) do { v = DPP_ADD(v, 0x111, 0xf, 0xf); v = DPP_ADD(v, 0x112, 0xf, 0xf); v = DPP_ADD(v, 0x114, 0xf, 0xe); v = DPP_ADD(v, 0x118, 0xf, 0xc); v = DPP_ADD(v, 0x142, 0xa, 0xf); } while (0)
#define DPP_SUM63(v) do { DPP_SUM31(v); v = DPP_ADD(v, 0x143, 0xc, 0xf); } while (0)
__device__ __forceinline__ float rdlane(float v, int lane) { return __builtin_bit_cast(float, __builtin_amdgcn_readlane(__builtin_bit_cast(int, v), lane)); }
__device__ __forceinline__ float wave_sum(float v) { DPP_SUM63(v); return rdlane(v, 63); }
__device__ __forceinline__ float wave_max(float v) {
    v = DPP_MAX(v, 0x111, 0xf, 0xf); v = DPP_MAX(v, 0x112, 0xf, 0xf); v = DPP_MAX(v, 0x114, 0xf, 0xe); v = DPP_MAX(v, 0x118, 0xf, 0xc); v = DPP_MAX(v, 0x142, 0xa, 0xf); v = DPP_MAX(v, 0x143, 0xc, 0xf);
    return rdlane(v, 63);
}
typedef __bf16 bf16x2_t __attribute__((ext_vector_type(2)));
__device__ __forceinline__ float dot2bf(unsigned w, unsigned x, float acc) { return __builtin_amdgcn_fdot2_f32_bf16(__builtin_bit_cast(bf16x2_t, w), __builtin_bit_cast(bf16x2_t, x), acc, false); }
__device__ __forceinline__ float bperm(float v, int src_lane) { return __builtin_bit_cast(float, __builtin_amdgcn_ds_bpermute(src_lane << 2, __builtin_bit_cast(int, v))); }
__device__ __forceinline__ float log_sigmoid_f(float x) { return fminf(x, 0.f) - log1pf(__expf(-fabsf(x))); }
__device__ __forceinline__ float sigmoid_f(float x) { return 1.f / (1.f + __expf(-x)); }

__device__ __forceinline__ void p0_transpose_item(const float* W, int ldw, int K, int Nuse, bf16* WT, LAS float* scr, int item, int lane) {
    const int nblk = Nuse / 32, kb = item / nblk, nb = item % nblk, k0 = 64 * kb, n0 = 32 * nb;
#pragma unroll
    for (int i = 0; i < 8; ++i) { const int kk = 8 * i + (lane >> 3); const f32x4 v = *(const GAS f32x4*)(W + (size_t)(k0 + kk) * ldw + n0 + 4 * (lane & 7));
        LAS float* d = scr + kk * 33 + 4 * (lane & 7); d[0] = v.x; d[1] = v.y; d[2] = v.z; d[3] = v.w; }
    LDS_WAIT(); asm volatile("" ::: "memory");
    const int c = lane & 7;
#pragma unroll
    for (int j = 0; j < 4; ++j) { const int n = (lane >> 3) + 8 * j; const LAS float* s = scr + (8 * c) * 33 + n;
        v4u o; o.x = pk2(s[0 * 33], s[1 * 33]); o.y = pk2(s[2 * 33], s[3 * 33]); o.z = pk2(s[4 * 33], s[5 * 33]); o.w = pk2(s[6 * 33], s[7 * 33]);
        *(GAS v4u*)(WT + (size_t)(n0 + n) * K + k0 + 8 * c) = o; }
    LDS_WAIT(); asm volatile("" ::: "memory");
}
__device__ __forceinline__ unsigned q8x4(float a, float b, float c, float d) {
    return ((unsigned)(int)__builtin_rintf(a) & 0xffu) | (((unsigned)(int)__builtin_rintf(b) & 0xffu) << 8) | (((unsigned)(int)__builtin_rintf(c) & 0xffu) << 16) | ((unsigned)(int)__builtin_rintf(d) << 24);
}
__device__ __forceinline__ void p0_colmax_item(const float* W, int ldw, unsigned* cmax, int item, int lane) {
    const int nb = item >> 3, n0 = 32 * nb, k0 = 128 * (item & 7);
    f32x4 v[16];
#pragma unroll
    for (int i = 0; i < 16; ++i) v[i] = *(const GAS f32x4*)(W + (size_t)(k0 + 8 * i + (lane >> 3)) * ldw + n0 + 4 * (lane & 7));
    __builtin_amdgcn_sched_barrier(0);
    float mx[4] = {0.f, 0.f, 0.f, 0.f};
#pragma unroll
    for (int i = 0; i < 16; ++i) { mx[0] = fmaxf(mx[0], fabsf(v[i].x)); mx[1] = fmaxf(mx[1], fabsf(v[i].y)); mx[2] = fmaxf(mx[2], fabsf(v[i].z)); mx[3] = fmaxf(mx[3], fabsf(v[i].w)); }
#pragma unroll
    for (int j = 0; j < 4; ++j) { mx[j] = fmaxf(mx[j], bperm(mx[j], lane ^ 8)); mx[j] = fmaxf(mx[j], bperm(mx[j], lane ^ 16)); mx[j] = fmaxf(mx[j], bperm(mx[j], lane ^ 32)); }
    if (lane < 8) {
#pragma unroll
        for (int j = 0; j < 4; ++j) (void)__hip_atomic_fetch_max(cmax + n0 + 4 * lane + j, __float_as_uint(mx[j]), __ATOMIC_RELAXED, __HIP_MEMORY_SCOPE_AGENT);
    }
}
__device__ __forceinline__ void p0_quant_item(const float* W, int ldw, const unsigned* cmax, signed char* W8, float* sw, LAS float* scr, int item, int lane, bool headperm) {
    const int nb = item >> 3, n0 = 32 * nb, k0 = 128 * (item & 7);
    const int n0s = (headperm && nb < 64) ? (nb >> 3) * 256 + 64 * (nb & 3) + 32 * ((nb >> 2) & 1) : n0;
    f32x4 v[2][8];
#pragma unroll
    for (int h = 0; h < 2; ++h)
#pragma unroll
        for (int i = 0; i < 8; ++i) v[h][i] = *(const GAS f32x4*)(W + (size_t)(k0 + 64 * h + 8 * i + (lane >> 3)) * ldw + n0s + 4 * (lane & 7));
    float ci[4];
#pragma unroll
    for (int j = 0; j < 4; ++j) { const float m = __uint_as_float(*(const GAS unsigned*)(cmax + n0s + (lane >> 3) + 8 * j)); ci[j] = m > 0.f ? 127.f / m : 0.f; }
    if ((item & 7) == 0 && lane < 32) *(GAS float*)(sw + n0 + lane) = __uint_as_float(*(const GAS unsigned*)(cmax + n0s + lane)) * (1.f / 127.f);
    __builtin_amdgcn_sched_barrier(0);
    const int c = lane & 7;
#pragma unroll
    for (int h = 0; h < 2; ++h) {
        LDS_WAIT(); asm volatile("" ::: "memory");
#pragma unroll
        for (int i = 0; i < 8; ++i) { LAS float* d = scr + (8 * i + (lane >> 3)) * 33 + 4 * (lane & 7); d[0] = v[h][i].x; d[1] = v[h][i].y; d[2] = v[h][i].z; d[3] = v[h][i].w; }
        LDS_WAIT(); asm volatile("" ::: "memory");
#pragma unroll
        for (int j = 0; j < 4; ++j) { const int n = (lane >> 3) + 8 * j; const LAS float* sp = scr + (8 * c) * 33 + n;
            const unsigned lo = q8x4(sp[0] * ci[j], sp[33] * ci[j], sp[66] * ci[j], sp[99] * ci[j]), hi = q8x4(sp[132] * ci[j], sp[165] * ci[j], sp[198] * ci[j], sp[231] * ci[j]);
            *(GAS unsigned long long*)(W8 + (size_t)(n0 + n) * 1024 + k0 + 64 * h + 8 * c) = (unsigned long long)lo | ((unsigned long long)hi << 32); }
    }
    LDS_WAIT(); asm volatile("" ::: "memory");
}
__device__ __forceinline__ void rms_row_to_bf16(int lane, f32x4 (&v)[4], const float* gain, bf16* orow, signed char* orow8, float* sx) {
    const GAS f32x4* gr = (const GAS f32x4*)gain + lane;
    float s = 0.f;
#pragma unroll
    for (int j = 0; j < 4; ++j) s += (v[j].x * v[j].x + v[j].y * v[j].y) + (v[j].z * v[j].z + v[j].w * v[j].w);
    const float r = rsqrtf(wave_sum(s) * (1.f / 1024.f) + RMS_EPS);
    GAS unsigned long long* o8 = (GAS unsigned long long*)orow + lane; float am = 0.f;
#pragma unroll
    for (int j = 0; j < 4; ++j) { const f32x4 g = gr[64 * j]; v[j].x *= r * g.x; v[j].y *= r * g.y; v[j].z *= r * g.z; v[j].w *= r * g.w;
        am = fmaxf(fmaxf(am, fmaxf(fabsf(v[j].x), fabsf(v[j].y))), fmaxf(fabsf(v[j].z), fabsf(v[j].w)));
        o8[64 * j] = (unsigned long long)pk2(v[j].x, v[j].y) | ((unsigned long long)pk2(v[j].z, v[j].w) << 32); }
    am = wave_max(am); const float qi = am > 0.f ? 127.f / am : 0.f;
    GAS unsigned* q8 = (GAS unsigned*)orow8 + lane;
#pragma unroll
    for (int j = 0; j < 4; ++j) q8[64 * j] = q8x4(v[j].x * qi, v[j].y * qi, v[j].z * qi, v[j].w * qi);
    if (lane == 0) *(GAS float*)sx = am * (1.f / 127.f);
}
__device__ __forceinline__ void cvt_f32_bf16(const Ctx& C, const float* src, bf16* dst, size_t n) {
    const size_t nth = (size_t)C.G * 512, t0 = (size_t)C.vcu * 512 + C.tid;
    for (size_t i = t0; i < n / 8; i += nth) {
        const f32x4 a = ((const GAS f32x4*)src)[2 * i], b = ((const GAS f32x4*)src)[2 * i + 1];
        v4u o; o.x = pk2(a.x, a.y); o.y = pk2(a.z, a.w); o.z = pk2(b.x, b.y); o.w = pk2(b.z, b.w);
        ((GAS v4u*)dst)[i] = o;
    }
}
template <bool I8> __device__ __forceinline__ void quant_row_fp8(int lane, const f32x4 (&v)[4], unsigned char* drow, unsigned char* sc) {
    float am = 0.f;
#pragma unroll
    for (int i = 0; i < 4; ++i) am = fmaxf(am, fmaxf(fmaxf(fabsf(v[i].x), fabsf(v[i].y)), fmaxf(fabsf(v[i].z), fabsf(v[i].w))));
    am = wave_max(am);
    const unsigned sbits = __float_as_uint(am * (I8 ? 1.f / 127.f : 1.f / 448.f));
    unsigned e = (sbits >> 23) + ((sbits & 0x7fffffu) ? 1u : 0u); e = am > 0.f ? (e < 1u ? 1u : e > 254u ? 254u : e) : 127u;
    const float inv = __uint_as_float((254u - e) << 23);
    GAS unsigned* o = (GAS unsigned*)drow + lane;
#pragma unroll
    for (int i = 0; i < 4; ++i) {
        if (I8) { o[64 * i] = q8x4(v[i].x * inv, v[i].y * inv, v[i].z * inv, v[i].w * inv); continue; }
        const float a = fminf(fmaxf(v[i].x * inv, -448.f), 448.f), b = fminf(fmaxf(v[i].y * inv, -448.f), 448.f), c = fminf(fmaxf(v[i].z * inv, -448.f), 448.f), d = fminf(fmaxf(v[i].w * inv, -448.f), 448.f);
        int w = 0; w = __builtin_amdgcn_cvt_pk_fp8_f32(a, b, w, false); w = __builtin_amdgcn_cvt_pk_fp8_f32(c, d, w, true); o[64 * i] = (unsigned)w;
    }
    if (lane == 0) *(GAS unsigned char*)sc = (unsigned char)e;
}
template <bool I8> __device__ __forceinline__ void quant_rows_fp8(const Ctx& C, const float* src, unsigned char* dst, unsigned char* scales, int nrows) {
    int rw = C.gw;
    for (; rw + 7 * C.NGW < nrows; rw += 8 * C.NGW) {
        f32x4 v[8][4];
#pragma unroll
        for (int j = 0; j < 8; ++j) { const GAS f32x4* xr = (const GAS f32x4*)(src + (size_t)(rw + j * C.NGW) * 1024) + C.lane;
#pragma unroll
            for (int i = 0; i < 4; ++i) v[j][i] = xr[64 * i]; }
        __builtin_amdgcn_sched_barrier(0);
#pragma unroll
        for (int j = 0; j < 8; ++j) quant_row_fp8<I8>(C.lane, v[j], dst + (size_t)(rw + j * C.NGW) * 1024, scales + rw + j * C.NGW);
    }
    for (; rw + 3 * C.NGW < nrows; rw += 4 * C.NGW) {
        f32x4 v[4][4];
#pragma unroll
        for (int j = 0; j < 4; ++j) { const GAS f32x4* xr = (const GAS f32x4*)(src + (size_t)(rw + j * C.NGW) * 1024) + C.lane;
#pragma unroll
            for (int i = 0; i < 4; ++i) v[j][i] = xr[64 * i]; }
        __builtin_amdgcn_sched_barrier(0);
#pragma unroll
        for (int j = 0; j < 4; ++j) quant_row_fp8<I8>(C.lane, v[j], dst + (size_t)(rw + j * C.NGW) * 1024, scales + rw + j * C.NGW);
    }
    for (; rw < nrows; rw += C.NGW) {
        const GAS f32x4* xr = (const GAS f32x4*)(src + (size_t)rw * 1024) + C.lane;
        f32x4 v[4];
#pragma unroll
        for (int i = 0; i < 4; ++i) v[i] = xr[64 * i];
        quant_row_fp8<I8>(C.lane, v, dst + (size_t)rw * 1024, scales + rw);
    }
}
constexpr int BGQ_ROWS = 3 * 16384;
template <int JOB> __device__ __forceinline__ bool bgq_row(const Ctx& C, int idx, const float*& src, unsigned char*& dst, unsigned char*& sc) {
    const int seg = idx >> 14, row = idx & 16383;
    const bool isV = seg == 1 || (seg == 2 && JOB == 2);
    const size_t flat = (size_t)(seg < 2 ? JOB : 3) * 16384 + row;
    src = (isV ? C.in[20] : C.in[19]) + flat * 1024; dst = C.ws + (isV ? WS_V : WS_U) + flat * 1024; sc = C.ws + (isV ? WS_SV : WS_SU) + flat; return isV;
}
template <int JOB> __device__ __forceinline__ void bgq_step(const Ctx& C, int idx_prev, int idx, f32x4 (&v)[4]) {
    const float* src; unsigned char* dst; unsigned char* sc;
    if (idx_prev >= 0 && idx_prev < BGQ_ROWS) { if (bgq_row<JOB>(C, idx_prev, src, dst, sc)) quant_row_fp8<false>(C.lane, v, dst, sc); else quant_row_fp8<true>(C.lane, v, dst, sc); }
    if (idx < BGQ_ROWS) { (void)bgq_row<JOB>(C, idx, src, dst, sc); const GAS f32x4* xr = (const GAS f32x4*)src + C.lane;
#pragma unroll
        for (int i = 0; i < 4; ++i) v[i] = xr[64 * i]; }
}
#ifndef PRO_PROBE
#define PRO_PROBE 0
#endif
constexpr int CW_CMAX = 131072;
constexpr int I8_NF0 = (I8MASK & 1) ? 1024 : 0, I8_NF3 = (I8MASK & 8) ? 1024 : 0, I8_NG = (I8MASK & 2) ? 768 : 0, I8_NH = (I8MASK & 4) ? 1024 : 0, I8_NITEMS = I8_NF0 + I8_NF3 + I8_NG + I8_NH;
template <bool PASS2> __device__ __forceinline__ void p0_i8_items(const Ctx& C, LAS float* scr) {
    unsigned* CM = (unsigned*)(C.ws + WS_CTL) + CW_CMAX; float* SW = (float*)(C.ws + WS_SW);
    for (int k = 0, it = C.gw; it < I8_NITEMS; ++k, it = k * C.NGW + ((k & 1) ? C.wave * C.G + C.vcu : C.gw)) {
        int r = it; const float* W; int ldw; signed char* W8; int q;
        if (r < I8_NF0) { W = C.in[3]; ldw = FOX_IN; W8 = (signed char*)(C.ws + WS_FOXWIN); q = 0; }
        else if ((r -= I8_NF0) < I8_NF3) { W = C.in[3] + (size_t)1024 * FOX_IN; ldw = FOX_IN; W8 = (signed char*)(C.ws + WS_FOXWIN + 8 * MiB); q = 1; }
        else if ((r -= I8_NF3) < I8_NG) { W = C.in[8]; ldw = GLA_IN; W8 = (signed char*)(C.ws + WS_GLAWIN); q = 2; }
        else { r -= I8_NG; W = C.in[13]; ldw = HGRN_IN; W8 = (signed char*)(C.ws + WS_HGRNWIN); q = 3; }
        const int swo = q == 0 ? 0 : q == 1 ? 4096 : q == 2 ? 8192 : 11264;
        if (PASS2) p0_quant_item(W, ldw, CM + q * 4096, W8, SW + swo, scr, r, C.lane, FOXFUSE && q < 2); else p0_colmax_item(W, ldw, CM + q * 4096, r, C.lane);
    }
}
__device__ __forceinline__ void p0_prologue_b(const Ctx& C) { p0_i8_items<true>(C, (LAS float*)(C.lds + C.wave * 16384)); }
__device__ __forceinline__ void p0_prologue(const Ctx& C) {
    LAS float* scr = (LAS float*)(C.lds + C.wave * 16384);
    for (int rep_ = 0; rep_ < (PRO_PROBE == 1 ? 2 : 1); ++rep_) {
    p0_i8_items<false>(C, scr);
    constexpr int I_SQ = 16 * 32, N_F0 = (I8MASK & 1) ? 0 : 16 * 128, N_F3 = (I8MASK & 8) ? 0 : 16 * 128, N_G = (I8MASK & 2) ? 0 : 16 * 96, N_H = (I8MASK & 4) ? 0 : 16 * 128;
    constexpr int NITEMS = N_F0 + N_F3 + N_G + N_H + 2 * I_SQ + I_SQ + I_SQ;
    for (int k = 0, it = C.gw; it < NITEMS; ++k, it = k * C.NGW + ((k & 1) ? (NWAVES - 1 - C.wave) * C.G + C.vcu : C.gw)) {
        int r = it;
        if (r < N_F0) { p0_transpose_item(C.in[3], FOX_IN, 1024, 4096, (bf16*)(C.ws + WS_FOXWIN), scr, r, C.lane); continue; } r -= N_F0;
        if (r < N_F3) { p0_transpose_item(C.in[3] + (size_t)1024 * FOX_IN, FOX_IN, 1024, 4096, (bf16*)(C.ws + WS_FOXWIN + 8 * MiB), scr, r, C.lane); continue; } r -= N_F3;
        if (r < N_G) { p0_transpose_item(C.in[8], GLA_IN, 1024, 3072, (bf16*)(C.ws + WS_GLAWIN), scr, r, C.lane); continue; } r -= N_G;
        if (r < N_H) { p0_transpose_item(C.in[13], HGRN_IN, 1024, 4096, (bf16*)(C.ws + WS_HGRNWIN), scr, r, C.lane); continue; } r -= N_H;
        if (r < 2 * I_SQ) { const int j = r / I_SQ; p0_transpose_item(C.in[7] + (size_t)j * 1024 * 1024, 1024, 1024, 1024, (bf16*)(C.ws + WS_FOXWOUT) + (size_t)j * 1024 * 1024, scr, r % I_SQ, C.lane); continue; } r -= 2 * I_SQ;
        if (r < I_SQ) { p0_transpose_item(C.in[12], 1024, 1024, 1024, (bf16*)(C.ws + WS_GLAWOUT), scr, r, C.lane); continue; } r -= I_SQ;
        p0_transpose_item(C.in[16], 1024, 1024, 1024, (bf16*)(C.ws + WS_HGRNWOUT), scr, r, C.lane);
    }
    }
    for (int rep_ = 0; rep_ < (PRO_PROBE == 2 ? 2 : 1); ++rep_) {
    constexpr int MT_GROUPS = 4 * 16 * 4 * 32;
    for (int grp = C.gw; grp < MT_GROUPS; grp += C.NGW) {
        const int nb2 = grp & 31, kb2 = (grp >> 5) & 3, hp = (grp >> 7) & 15, layer = grp >> 11;
        const float* kp = C.in[18] + ((size_t)(layer * 16 + hp) * 128 + kb2 * 32 + (C.lane & 15)) * 128 + 4 * (C.lane >> 4);
        const float* wp = C.in[17] + ((size_t)layer * 1024 + nb2 * 32 + (C.lane & 15)) * 2048 + hp * 128 + 4 * (C.lane >> 4);
        f32x4 ka[2][8], wb[2][8];
#pragma unroll
        for (int u = 0; u < 2; ++u)
#pragma unroll
            for (int s8 = 0; s8 < 8; ++s8) { ka[u][s8] = *(const GAS f32x4*)(kp + (size_t)u * 16 * 128 + 16 * s8); wb[u][s8] = *(const GAS f32x4*)(wp + (size_t)u * 16 * 2048 + 16 * s8); }
        __builtin_amdgcn_sched_barrier(0);
        f32x4 acc[2][2];
#pragma unroll
        for (int a = 0; a < 2; ++a)
#pragma unroll
            for (int b = 0; b < 2; ++b) acc[a][b] = (f32x4){0.f, 0.f, 0.f, 0.f};
#pragma unroll
        for (int s8 = 0; s8 < 8; ++s8)
#pragma unroll
            for (int a = 0; a < 2; ++a)
#pragma unroll
                for (int b = 0; b < 2; ++b) { const f32x4 x = ka[a][s8], y = wb[b][s8];
                    acc[a][b] = __builtin_amdgcn_mfma_f32_16x16x4f32(x.x, y.x, acc[a][b], 0, 0, 0); acc[a][b] = __builtin_amdgcn_mfma_f32_16x16x4f32(x.y, y.y, acc[a][b], 0, 0, 0);
                    acc[a][b] = __builtin_amdgcn_mfma_f32_16x16x4f32(x.z, y.z, acc[a][b], 0, 0, 0); acc[a][b] = __builtin_amdgcn_mfma_f32_16x16x4f32(x.w, y.w, acc[a][b], 0, 0, 0); }
#pragma unroll
        for (int a = 0; a < 2; ++a)
#pragma unroll
            for (int b = 0; b < 2; ++b) {
                bf16* mt = (bf16*)(C.ws + WS_PEERWQ) + ((size_t)layer * 2048 + hp * 128 + kb2 * 32 + a * 16 + (C.lane >> 4) * 4) * 1024 + nb2 * 32 + b * 16 + (C.lane & 15);
#pragma unroll
                for (int r = 0; r < 4; ++r) mt[(size_t)r * 1024] = (bf16)f2bf(acc[a][b][r]); }
    }
    }
    for (int rep_ = 0; rep_ < (PRO_PROBE == 3 ? 2 : 1); ++rep_) {
    quant_rows_fp8<true>(C, C.in[19], C.ws + WS_U, C.ws + WS_SU, BGQ ? 16384 : 4 * 16384);
    quant_rows_fp8<false>(C, C.in[20], C.ws + WS_V, C.ws + WS_SV, BGQ ? 16384 : 4 * 16384);
    }
    for (int rep_ = 0; rep_ < (PRO_PROBE == 4 ? 2 : 1); ++rep_) {
    for (int i = C.vcu * 512 + C.tid; i < 3 * 16 * 1024; i += C.G * 512) {
        const int w = i >> 14, n = (i >> 10) & 15, k = i & 1023;
        const float v = w < 2 ? C.in[3][(size_t)w * 1024 * FOX_IN + (size_t)k * FOX_IN + 4096 + n] : C.in[8][(size_t)k * GLA_IN + 3072 + n];
        ((bf16*)(C.ws + WS_TAILW))[i] = (bf16)f2bf(v);
    }
    if (C.vcu == 0) for (int c = C.tid; c < 1024; c += 512) {
        const float l0 = C.in[14][c], l1 = C.in[14][1024 + c], l2 = C.in[14][2048 + c], l3 = C.in[14][3072 + c];
        const float m = fmaxf(fmaxf(l0, l1), fmaxf(l2, l3));
        const float e0 = expf(l0 - m), e1 = expf(l1 - m), e2 = expf(l2 - m), e3 = expf(l3 - m);
        ((float*)(C.ws + WS_LB))[c] = (e1 + e2) / (e0 + e1 + e2 + e3);
    }
    for (int m0 = C.gw; m0 < NTOK; m0 += 8 * C.NGW) {
        f32x4 v[8][4];
#pragma unroll
        for (int u = 0; u < 8; ++u) { const int m = m0 + u * C.NGW; if (m < NTOK) { const GAS f32x4* xr = (const GAS f32x4*)(C.in[0] + (size_t)m * 1024) + C.lane;
#pragma unroll
            for (int j = 0; j < 4; ++j) v[u][j] = xr[64 * j]; } }
        __builtin_amdgcn_sched_barrier(0);
#pragma unroll
        for (int u = 0; u < 8; ++u) { const int m = m0 + u * C.NGW; if (m < NTOK)
            rms_row_to_bf16(C.lane, v[u], C.in[1], (bf16*)(C.ws + WS_XN) + (size_t)m * 1024, (signed char*)(C.ws + WS_XN8) + (size_t)m * 1024, (float*)(C.ws + WS_SX) + m); }
    }
    }
}

__device__ __forceinline__ void tail_mfma(const Ctx& C, int tok0, const bf16* WT, LAS float* part) {
    const int l = C.lane, m = l & 15, g = l >> 4, tbk = C.wave & 3, kh = C.wave >> 2;
    const bf16* ap = (const bf16*)(C.ws + WS_XN) + (size_t)(tok0 + 16 * tbk + m) * 1024 + kh * 512 + 8 * g;
    const bf16* bp = WT + (size_t)m * 1024 + kh * 512 + 8 * g;
    f32x4 acc = (f32x4){0.f, 0.f, 0.f, 0.f};
#pragma unroll 4
    for (int ks = 0; ks < 16; ++ks) acc = __builtin_amdgcn_mfma_f32_16x16x32_bf16(*(const bf16x8*)(ap + 32 * ks), *(const bf16x8*)(bp + 32 * ks), acc, 0, 0, 0);
#pragma unroll
    for (int r = 0; r < 4; ++r) part[kh * 1024 + (16 * tbk + 4 * g + r) * 16 + m] = acc[r];
}
template <bool QK> __device__ __forceinline__ void fox_step1(const Ctx& C, int j) {
    float* TAIL = (float*)(C.ws + WS_TAIL); LAS float* part = (LAS float*)C.lds;
    const bf16* WT = (const bf16*)(C.ws + WS_TAILW) + (size_t)j * 16 * 1024;
    for (int tb = C.vcu; tb < NTOK / 64; tb += C.G) {
        __syncthreads();
        tail_mfma(C, tb * 64, WT, part);
        __syncthreads();
#pragma unroll
        for (int rep = 0; rep < 2; ++rep) { const int i = rep * 512 + C.tid; TAIL[(size_t)tb * 1024 + i] = log_sigmoid_f(part[i] + part[1024 + i] + C.in[4][j * 16 + (i & 15)]); }
        if (!QK) continue;
        const float* gq = C.in[5] + j * 64; const float* gk = C.in[6] + j * 64;
        v4u ra[2][8], rb[2][8];
#pragma unroll
        for (int which = 0; which < 2; ++which)
#pragma unroll
            for (int t = 0; t < 8; ++t) { const bf16* row = (const bf16*)(C.ws + WS_P) + (size_t)which * PSTRIDE + (size_t)(tb * 64 + C.wave * 8 + t) * 1024 + C.lane * 16;
                ra[which][t] = *(const GAS v4u*)row; rb[which][t] = *(const GAS v4u*)(row + 8); }
        __builtin_amdgcn_sched_barrier(0);
#pragma unroll
        for (int which = 0; which < 2; ++which) {
            const float* g = (which == 0 ? gq : gk) + (C.lane & 3) * 16;
            float gv[16];
#pragma unroll
            for (int i = 0; i < 16; ++i) gv[i] = g[i];
#pragma unroll
            for (int t = 0; t < 8; ++t) {
                bf16* row = (bf16*)(C.ws + WS_P) + (size_t)which * PSTRIDE + (size_t)(tb * 64 + C.wave * 8 + t) * 1024 + C.lane * 16;
                const v4u a = ra[which][t], b = rb[which][t];
                float v[16] = {bflo(a.x), bfhi(a.x), bflo(a.y), bfhi(a.y), bflo(a.z), bfhi(a.z), bflo(a.w), bfhi(a.w), bflo(b.x), bfhi(b.x), bflo(b.y), bfhi(b.y), bflo(b.z), bfhi(b.z), bflo(b.w), bfhi(b.w)};
                float ss = 0.f;
#pragma unroll
                for (int i = 0; i < 16; ++i) ss += v[i] * v[i];
                ss = DPP_ADD(ss, 0xB1, 0xf, 0xf); ss = DPP_ADD(ss, 0x4E, 0xf, 0xf);
                const float r = rsqrtf(ss * (1.f / 64.f) + RMS_EPS) * (which == 0 ? FOX_C2 : 1.f);
#pragma unroll
                for (int i = 0; i < 16; ++i) v[i] = v[i] * r * gv[i];
                v4u oa, ob; oa.x = pk2(v[0], v[1]); oa.y = pk2(v[2], v[3]); oa.z = pk2(v[4], v[5]); oa.w = pk2(v[6], v[7]);
                ob.x = pk2(v[8], v[9]); ob.y = pk2(v[10], v[11]); ob.z = pk2(v[12], v[13]); ob.w = pk2(v[14], v[15]);
                *(GAS v4u*)row = oa; *(GAS v4u*)(row + 8) = ob;
            }
        }
    }
}
constexpr size_t WS_ASC = WS_Q2, WS_Q1 = WS_Q2 + 16 * MiB, WS_KST = WS_Q2 + 48 * MiB, WS_DEC = 59 * MiB;
static_assert(WS_KST + 32 * MiB <= WS_OF && WS_Q1 + 32 * MiB <= WS_KST, "chunk workspace map");
template <int NH>
__device__ __forceinline__ void chunk_prepass(const Ctx& C) {
    bf16* ASC = (bf16*)(C.ws + WS_ASC); bf16* Q1 = (bf16*)(C.ws + WS_Q1); bf16* KST = (bf16*)(C.ws + WS_KST); float* DEC = (float*)(C.ws + WS_DEC);
    const bf16* P0 = (const bf16*)(C.ws + WS_P); const bf16* P1 = P0 + PSTRIDE;
    LAS bf16* tqs = (LAS bf16*)C.lds;
    LAS bf16* tks = tqs + 64 * 128;
    LAS bf16* q2s = tks + 64 * 128;
    LAS bf16* k2s = q2s + 64 * 136;
    LAS bf16* q1s = k2s + 64 * 136;
    LAS float* tot = (LAS float*)(q1s + 64 * 128);
    LAS float* part = tot + 512;
    const float qs = 0.08838834764831845f;
    const int d = C.tid & 127, tq = C.tid >> 7, l = C.lane, fr = l & 15, fq = l >> 4;
    const int dq = (d & ~31) + ((d & 16) ? 8 * ((d & 15) >> 2) + 4 + (d & 3) : 8 * ((d & 15) >> 2) + (d & 3));
    const int pr0 = C.tid >> 4, pc = (C.tid & 15) * 8;
#define PP_BAR() do { asm volatile("s_waitcnt lgkmcnt(0)" ::: "memory"); __builtin_amdgcn_s_barrier(); asm volatile("" ::: "memory"); } while (0)
    for (int itb = C.vcu; itb < NBATCH * 32; itb += C.G) {
        const int c = itb & 31, b = itb >> 5;
        const size_t rowb = (size_t)b * SEQLEN + c * 64;
        const size_t row0 = rowb + tq * 16;
        if (NH == 4) { __syncthreads(); tail_mfma(C, b * SEQLEN + c * 64, (const bf16*)(C.ws + WS_TAILW) + 2 * 16 * 1024, part); }
        v4u pq[2], pk[2];
#define PP_LOAD(h_) do { _Pragma("unroll") for (int j = 0; j < 2; ++j) { const size_t r_ = (rowb + pr0 + 32 * j) * 1024 + (h_) * 128 + pc; \
            pq[j] = *(const GAS v4u*)(P0 + r_); pk[j] = *(const GAS v4u*)((NH == 4 ? P0 + 512 : P1) + r_); } } while (0)
        PP_LOAD(0);
#pragma unroll 1
        for (int h = 0; h < NH; ++h) {
            const int it = (b * NH + h) * 32 + c;
            float wu[16]; float ba = 0.f, lb = 0.f;
            if (NH == 4) {
#pragma unroll
                for (int r = 0; r < 16; ++r) wu[r] = C.in[9][r * 512 + h * 128 + d];
                ba = C.in[10][h * 128 + d];
            } else lb = ((const float*)(C.ws + WS_LB))[h * 128 + d];
            PP_BAR();
#pragma unroll
            for (int j = 0; j < 2; ++j) { *(LAS v4u*)(tqs + (pr0 + 32 * j) * 128 + pc) = pq[j]; *(LAS v4u*)(tks + (pr0 + 32 * j) * 128 + pc) = pk[j]; }
            if (h + 1 < NH) PP_LOAD(h + 1);
            PP_BAR();
            float bl[16], kk[16]; float run = 0.f;
            if (NH == 4) {
#pragma unroll
                for (int i = 0; i < 16; ++i) { float z = ba; const int t = tq * 16 + i;
#pragma unroll
                    for (int r = 0; r < 16; r += 4) { const f32x4 p0 = *(const LAS f32x4*)(part + t * 16 + r), p1 = *(const LAS f32x4*)(part + 1024 + t * 16 + r);
                        z += (p0[0] + p1[0]) * wu[r] + (p0[1] + p1[1]) * wu[r + 1] + (p0[2] + p1[2]) * wu[r + 2] + (p0[3] + p1[3]) * wu[r + 3]; }
                    run += log_sigmoid_f(z) * (1.f / 16.f); bl[i] = run; kk[i] = bf2f(tks[t * 128 + d]); }
            } else {
#pragma unroll
                for (int i = 0; i < 16; ++i) { const float gate = lb + (1.f - lb) * sigmoid_f(bf2f(tks[(tq * 16 + i) * 128 + d])); run += __logf(gate); bl[i] = run; kk[i] = 1.f - gate; }
            }
            tot[tq * 128 + d] = run;
            PP_BAR();
            const float t0 = tot[d], t1 = tot[128 + d], t2 = tot[256 + d], t3 = tot[384 + d];
            const float off = tq == 0 ? 0.f : tq == 1 ? t0 : tq == 2 ? t0 + t1 : t0 + t1 + t2;
            const float bref = t0 + t1, bend = (t0 + t1) + (t2 + t3);
            unsigned ksw[8];
#pragma unroll
            for (int i = 0; i < 16; ++i) {
                const float bb = bl[i] + off;
                const float qv = bf2f(tqs[(tq * 16 + i) * 128 + d]) * qs, kv = kk[i];
                q1s[(tq * 16 + i) * 128 + dq] = (bf16)f2bfh(qv * __expf(bb));
                q2s[(tq * 16 + i) * 136 + d] = (bf16)f2bfh(qv * __expf(bb - bref));
                k2s[(tq * 16 + i) * 136 + d] = (bf16)f2bfh(kv * __expf(bref - bb));
                const unsigned kb = f2bfh(kv * __expf(bend - bb));
                if (i & 1) ksw[i >> 1] |= kb << 16; else ksw[i >> 1] = kb;
            }
            { bf16* kt = KST + ((size_t)it * 128 + d) * 64 + tq * 16; *(GAS v4u*)kt = (v4u){ksw[0], ksw[1], ksw[2], ksw[3]}; *(GAS v4u*)(kt + 8) = (v4u){ksw[4], ksw[5], ksw[6], ksw[7]}; }
            if (tq == 0) DEC[(size_t)it * 128 + d] = __expf(bend);
            PP_BAR();
#pragma unroll
            for (int j = 0; j < 2; ++j) *(GAS v4u*)(Q1 + (((size_t)it * 4 + (pc >> 5)) * 64 + pr0 + 32 * j) * 32 + (pc & 31)) = *(const LAS v4u*)(q1s + (pr0 + 32 * j) * 128 + pc);
            const int ti = C.wave >> 1;
#pragma unroll
            for (int sj = 0; sj < 2; ++sj) {
                const int si = 2 * (C.wave & 1) + sj;
                f32x4 acc = (f32x4){0.f, 0.f, 0.f, 0.f};
                if (si <= ti) {
#pragma unroll
                    for (int ks = 0; ks < 4; ++ks) {
                        const bf16x8 a = *(const LAS bf16x8*)(q2s + (16 * ti + fr) * 136 + ks * 32 + fq * 8), bb = *(const LAS bf16x8*)(k2s + (16 * si + fr) * 136 + ks * 32 + fq * 8);
                        acc = __builtin_amdgcn_mfma_f32_16x16x32_bf16(bb, a, acc, 0, 0, 0);
                    }
                }
                const int t = 16 * ti + fr, s0 = 16 * si + 4 * fq;
                typedef unsigned u32x2v __attribute__((ext_vector_type(2)));
                u32x2v w; w.x = pk2(s0 <= t ? acc[0] : 0.f, s0 + 1 <= t ? acc[1] : 0.f); w.y = pk2(s0 + 2 <= t ? acc[2] : 0.f, s0 + 3 <= t ? acc[3] : 0.f);
                *(GAS u32x2v*)(ASC + (size_t)it * 4096 + t * 64 + s0) = w;
            }
        }
    }
#undef PP_LOAD
#undef PP_BAR
}
template <int NH, int DV>
__device__ __forceinline__ void chunk_recur2(const Ctx& C, const bf16* Vp) {
    const bf16* ASC = (const bf16*)(C.ws + WS_ASC); const bf16* Q1 = (const bf16*)(C.ws + WS_Q1); const bf16* KST = (const bf16*)(C.ws + WS_KST); const float* DEC = (const float*)(C.ws + WS_DEC);
    bf16* OF = (bf16*)(C.ws + WS_OF);
    constexpr int NCB = DV / 32, NTASK = NBATCH * NH * NCB, JOB = NH == 4 ? 1 : 2;
    const int l = C.lane, m = l & 15, g = l >> 4, kq = C.wave & 3;
    LAS float* red = (LAS float*)C.lds;
    LAS bf16* vt = (LAS bf16*)(C.lds + 65536);
    typedef short v4i16_t __attribute__((ext_vector_type(4)));
    int bgit = 0;
    if (C.wave >= 4) {
        const int NBW = C.G * 4, bw = C.vcu * 4 + (C.wave - 4);
        f32x4 r0[2][4], r1[2][4], r2[2][4]; int i0[2] = {-1, -1}, i1[2] = {-1, -1}, i2[2] = {-1, -1};
#define BG_STEP(c_, RA, IA) do { _Pragma("unroll") for (int j = 0; j < 2; ++j) { const int nx = (BGQ && (c_) < 24) ? ((bgit * 24 + (c_)) * 2 + j) * NBW + bw : BGQ_ROWS; bgq_step<JOB>(C, IA[j], nx, RA[j]); IA[j] = nx; } \
        asm volatile("s_waitcnt lgkmcnt(0)" ::: "memory"); __builtin_amdgcn_s_barrier(); asm volatile("" ::: "memory"); } while (0)
        for (int t0 = C.vcu; t0 < NTASK; t0 += C.G, ++bgit) {
            asm volatile("s_waitcnt lgkmcnt(0)" ::: "memory"); __builtin_amdgcn_s_barrier(); asm volatile("" ::: "memory");
#pragma unroll 1
            for (int c = 0; c < 30; c += 3) { BG_STEP(c, r0, i0); BG_STEP(c + 1, r1, i1); BG_STEP(c + 2, r2, i2); }
            BG_STEP(30, r0, i0); BG_STEP(31, r1, i1);
#pragma unroll
            for (int j = 0; j < 2; ++j) { bgq_step<JOB>(C, i2[j], BGQ_ROWS, r2[j]); i2[j] = BGQ_ROWS; bgq_step<JOB>(C, i0[j], BGQ_ROWS, r0[j]); i0[j] = BGQ_ROWS; bgq_step<JOB>(C, i1[j], BGQ_ROWS, r1[j]); i1[j] = BGQ_ROWS; }
            asm volatile("s_waitcnt lgkmcnt(0)" ::: "memory"); __builtin_amdgcn_s_barrier(); asm volatile("" ::: "memory");
        }
#undef BG_STEP
        if (BGQ) { int ip = BGQ_ROWS;
            for (int nx = bgit * 48 * NBW + bw; nx < BGQ_ROWS || ip < BGQ_ROWS; nx += NBW) { bgq_step<JOB>(C, ip, nx, r0[0]); ip = nx; } }
        return;
    }
    __builtin_amdgcn_s_setprio(2);
    struct Frag { bf16x8 a0, a1; bf16x8 q[4]; f32x4 dc[2]; bf16x8 ks[2][2]; };
#define REC_LOAD(F, c_) do { const size_t ch_ = (size_t)bh * 32 + (c_); \
        F.a0 = *(const bf16x8*)(ASC + ch_ * 4096 + (16 * kq + m) * 64 + 8 * g); F.a1 = *(const bf16x8*)(ASC + ch_ * 4096 + (16 * kq + m) * 64 + 32 + 8 * g); \
        _Pragma("unroll") for (int tb = 0; tb < 4; ++tb) F.q[tb] = *(const bf16x8*)(Q1 + ((ch_ * 4 + kq) * 64 + 16 * tb + m) * 32 + 8 * g); \
        _Pragma("unroll") for (int i = 0; i < 2; ++i) { F.dc[i] = *(const f32x4*)(DEC + ch_ * 128 + 32 * kq + 16 * i + 4 * g); \
            _Pragma("unroll") for (int ks = 0; ks < 2; ++ks) F.ks[i][ks] = *(const bf16x8*)(KST + (ch_ * 128 + 32 * kq + 16 * i + m) * 64 + 32 * ks + 8 * g); } } while (0)
#define VP_LOAD(c_) (*(const v4u*)(Vp + ((size_t)b * SEQLEN + (c_) * 64 + 16 * kq + (l >> 2)) * 1024 + h * DV + cb * 32 + 8 * (l & 3)))
#define VT_PUT(c_, v_) (*(LAS v4u*)(vt + ((c_) & 1) * 2048 + ((l & 3) >> 1) * 1024 + (16 * kq + (l >> 2)) * 16 + 8 * (l & 1)) = (v_))
#define REC_BODY(F, Fn, c_, vcur_, vnew_) do { \
        if ((c_) + 1 < 32) REC_LOAD(Fn, (c_) + 1); \
        if ((c_) + 2 < 32) vnew_ = VP_LOAD((c_) + 2); \
        bf16x8 vb[2][2]; \
        _Pragma("unroll") for (int hf = 0; hf < 2; ++hf) _Pragma("unroll") for (int ks = 0; ks < 2; ++ks) { const LAS bf16* tp_ = vt + ((c_) & 1) * 2048 + hf * 1024 + (32 * ks + 8 * g + ((l & 15) >> 2)) * 16 + 4 * (l & 3); \
            const v4i16_t lo_ = __builtin_amdgcn_ds_read_tr16_b64_v4i16((LAS v4i16_t*)tp_), hi_ = __builtin_amdgcn_ds_read_tr16_b64_v4i16((LAS v4i16_t*)(tp_ + 64)); \
            vb[hf][ks] = (bf16x8){lo_[0], lo_[1], lo_[2], lo_[3], hi_[0], hi_[1], hi_[2], hi_[3]}; } \
        if ((c_) + 1 < 32) VT_PUT((c_) + 1, vcur_); \
        LAS float* rb = red + ((c_) & 1) * 8192; \
        f32x4 oin[2]; \
        _Pragma("unroll") for (int hf = 0; hf < 2; ++hf) { oin[hf] = __builtin_amdgcn_mfma_f32_16x16x32_bf16(F.a0, vb[hf][0], (f32x4){0.f, 0.f, 0.f, 0.f}, 0, 0, 0); \
            if (kq >= 2) oin[hf] = __builtin_amdgcn_mfma_f32_16x16x32_bf16(F.a1, vb[hf][1], oin[hf], 0, 0, 0); } \
        _Pragma("unroll") for (int hf = 0; hf < 2; ++hf) { u32x4v sw; sw.x = pk2(S[hf][0][0], S[hf][0][1]); sw.y = pk2(S[hf][0][2], S[hf][0][3]); sw.z = pk2(S[hf][1][0], S[hf][1][1]); sw.w = pk2(S[hf][1][2], S[hf][1][3]); \
          const bf16x8 sb = __builtin_bit_cast(bf16x8, sw); \
          _Pragma("unroll") for (int tb = 0; tb < 4; ++tb) { \
              const f32x4 po = __builtin_amdgcn_mfma_f32_16x16x32_bf16(F.q[tb], sb, (f32x4){0.f, 0.f, 0.f, 0.f}, 0, 0, 0); \
              *(LAS f32x4*)(rb + hf * 4096 + ((kq * 4 + tb) * 64 + l) * 4) = po; } } \
        _Pragma("unroll") for (int hf = 0; hf < 2; ++hf) _Pragma("unroll") for (int i = 0; i < 2; ++i) { S[hf][i] = S[hf][i] * F.dc[i]; \
            _Pragma("unroll") for (int ks = 0; ks < 2; ++ks) S[hf][i] = __builtin_amdgcn_mfma_f32_16x16x32_bf16(F.ks[i][ks], vb[hf][ks], S[hf][i], 0, 0, 0); } \
        asm volatile("s_waitcnt lgkmcnt(0)" ::: "memory"); __builtin_amdgcn_s_barrier(); asm volatile("" ::: "memory"); \
        _Pragma("unroll") for (int hf = 0; hf < 2; ++hf) { f32x4 o = oin[hf]; \
          _Pragma("unroll") for (int k2 = 0; k2 < 4; ++k2) o = o + *(const LAS f32x4*)(rb + hf * 4096 + ((k2 * 4 + kq) * 64 + l) * 4); \
          const size_t orow = (size_t)b * SEQLEN + (c_) * 64 + 16 * kq + 4 * g; \
          _Pragma("unroll") for (int r = 0; r < 4; ++r) OF[(orow + r) * 1024 + col + 16 * hf] = (bf16)f2bf(o[r]); } } while (0)
    for (int t0 = C.vcu; t0 < NTASK; t0 += C.G) {
        const int cb = t0 % NCB, bh = t0 / NCB, b = bh / NH, h = bh % NH;
        const int col = h * DV + cb * 32 + m;
        f32x4 S[2][2];
#pragma unroll
        for (int hf = 0; hf < 2; ++hf) { S[hf][0] = (f32x4){0.f, 0.f, 0.f, 0.f}; S[hf][1] = S[hf][0]; }
        Frag FA, FB;
        REC_LOAD(FA, 0);
        v4u vA = VP_LOAD(0), vB = VP_LOAD(1);
        VT_PUT(0, vA); vA = vB;
        asm volatile("s_waitcnt lgkmcnt(0)" ::: "memory"); __builtin_amdgcn_s_barrier(); asm volatile("" ::: "memory");
#pragma unroll 1
        for (int c = 0; c < 32; c += 2) { REC_BODY(FA, FB, c, vA, vB); REC_BODY(FB, FA, c + 1, vB, vA); }
        asm volatile("s_waitcnt lgkmcnt(0)" ::: "memory"); __builtin_amdgcn_s_barrier(); asm volatile("" ::: "memory");
    }
    __builtin_amdgcn_s_setprio(0);
#undef REC_LOAD
#undef REC_BODY
#undef VP_LOAD
#undef VT_PUT
}
struct RecFrag { bf16x8 a0, a1; bf16x8 q[4]; f32x4 dc[2]; bf16x8 ks[2][2]; };
template <int NH, int DV, int RP = 0  >
__device__ __forceinline__ void chunk_recur(const Ctx& C, const bf16* Vp) {
    const bf16* ASC = (const bf16*)(C.ws + WS_ASC); const bf16* Q1 = (const bf16*)(C.ws + WS_Q1); const bf16* KST = (const bf16*)(C.ws + WS_KST); const float* DEC = (const float*)(C.ws + WS_DEC);
    bf16* OF = (bf16*)(C.ws + (RP ? WS_GLOG : WS_OF));
    constexpr int NCB = DV / 16, NTASK = NBATCH * NH * NCB;
    const int l = C.lane, m = l & 15, g = l >> 4, gi = C.wave >> 2, kq = C.wave & 3;
    LAS float* red = (LAS float*)C.lds + gi * 8192;
    LAS bf16* vt = (LAS bf16*)(C.lds + 65536) + gi * 2048;
    typedef short v4i16_t __attribute__((ext_vector_type(4)));
#define REC_LOAD(F, c_) do { const size_t row0_ = (size_t)b * SEQLEN + (c_) * 64; const size_t ch_ = (size_t)bh * 32 + (c_); \
        F.a0 = *(const bf16x8*)(ASC + ch_ * 4096 + (16 * kq + m) * 64 + 8 * g); F.a1 = *(const bf16x8*)(ASC + ch_ * 4096 + (16 * kq + m) * 64 + 32 + 8 * g); \
        _Pragma("unroll") for (int tb = 0; tb < 4; ++tb) F.q[tb] = *(const bf16x8*)(Q1 + ((ch_ * 4 + kq) * 64 + 16 * tb + m) * 32 + 8 * g); \
        _Pragma("unroll") for (int i = 0; i < 2; ++i) { F.dc[i] = *(const f32x4*)(DEC + ch_ * 128 + 32 * kq + 16 * i + 4 * g); \
            _Pragma("unroll") for (int ks = 0; ks < 2; ++ks) F.ks[i][ks] = *(const bf16x8*)(KST + (ch_ * 128 + 32 * kq + 16 * i + m) * 64 + 32 * ks + 8 * g); } } while (0)
#define VP_LOAD(c_) (*(const unsigned long long*)(Vp + ((size_t)b * SEQLEN + (c_) * 64 + 16 * kq + (l >> 2)) * 1024 + h * DV + cb * 16 + 4 * (l & 3)))
#define VT_PUT(c_, v_) (*(LAS unsigned long long*)(vt + ((c_) & 1) * 1024 + (16 * kq + (l >> 2)) * 16 + 4 * (l & 3)) = (v_))
#define REC_BODY(F, Fn, c_, vcur_, vnew_) do { \
        if ((c_) + 1 < 32 && RP != 3) REC_LOAD(Fn, (c_) + 1); \
        if ((c_) + 2 < 32) vnew_ = VP_LOAD((c_) + 2); \
        bf16x8 vb[2]; \
        _Pragma("unroll") for (int ks = 0; ks < 2; ++ks) { const LAS bf16* tp_ = vt + ((c_) & 1) * 1024 + (32 * ks + 8 * g + ((l & 15) >> 2)) * 16 + 4 * (l & 3); \
            const v4i16_t lo_ = __builtin_amdgcn_ds_read_tr16_b64_v4i16((LAS v4i16_t*)tp_), hi_ = __builtin_amdgcn_ds_read_tr16_b64_v4i16((LAS v4i16_t*)(tp_ + 64)); \
            vb[ks] = (bf16x8){lo_[0], lo_[1], lo_[2], lo_[3], hi_[0], hi_[1], hi_[2], hi_[3]}; } \
        if ((c_) + 1 < 32) VT_PUT((c_) + 1, vcur_);              \
        if (BGQ && RP == 0) { const int bgn = (bgit * 32 + (c_)) * C.NGW + C.gw; bgq_step<JOB>(C, bgi, bgn, bgv); bgi = bgn; } \
        LAS float* rb = red + ((c_) & 1) * 4096; \
        f32x4 oin = __builtin_amdgcn_mfma_f32_16x16x32_bf16(F.a0, vb[0], (f32x4){0.f, 0.f, 0.f, 0.f}, 0, 0, 0); \
        if (kq >= 2) oin = __builtin_amdgcn_mfma_f32_16x16x32_bf16(F.a1, vb[1], oin, 0, 0, 0); \
        { u32x4v sw; sw.x = pk2(S[0][0], S[0][1]); sw.y = pk2(S[0][2], S[0][3]); sw.z = pk2(S[1][0], S[1][1]); sw.w = pk2(S[1][2], S[1][3]); \
          const bf16x8 sb = __builtin_bit_cast(bf16x8, sw); \
          _Pragma("unroll") for (int tb = 0; tb < 4; ++tb) { \
              const f32x4 po = __builtin_amdgcn_mfma_f32_16x16x32_bf16(F.q[tb], sb, (f32x4){0.f, 0.f, 0.f, 0.f}, 0, 0, 0); \
              *(LAS f32x4*)(rb + ((kq * 4 + tb) * 64 + l) * 4) = po; } } \
        _Pragma("unroll") for (int i = 0; i < 2; ++i) { S[i] = S[i] * F.dc[i]; \
            _Pragma("unroll") for (int ks = 0; ks < 2; ++ks) S[i] = __builtin_amdgcn_mfma_f32_16x16x32_bf16(F.ks[i][ks], vb[ks], S[i], 0, 0, 0); } \
        if (RP != 2) { asm volatile("s_waitcnt lgkmcnt(0)" ::: "memory"); __builtin_amdgcn_s_barrier(); asm volatile("" ::: "memory"); } \
        { f32x4 o = oin; \
          if (RP != 2) { _Pragma("unroll") for (int k2 = 0; k2 < 4; ++k2) o = o + *(const LAS f32x4*)(rb + ((k2 * 4 + kq) * 64 + l) * 4); } \
          const size_t orow = (size_t)b * SEQLEN + (c_) * 64 + 16 * kq + 4 * g; \
          if (RP != 4 || (c_) == 31) { _Pragma("unroll") for (int r = 0; r < 4; ++r) OF[(orow + r) * 1024 + col] = (bf16)f2bf(o[r]); } } } while (0)
    constexpr int JOB = NH == 4 ? 1 : 2;
    f32x4 bgv[4]; int bgi = -1, bgit = 0;
    for (int t0 = C.vcu; t0 < NTASK / 2; t0 += C.G, ++bgit) {
        const int task = gi * (NTASK / 2) + t0;
        const int cb = task % NCB, bh = task / NCB, b = bh / NH, h = bh % NH;
        const int col = h * DV + cb * 16 + m;
        f32x4 S[2];
        S[0] = (f32x4){0.f, 0.f, 0.f, 0.f}; S[1] = S[0];
        RecFrag FA, FB;
        REC_LOAD(FA, 0);
        if (RP == 3) REC_LOAD(FB, 1);
        unsigned long long vA = VP_LOAD(0), vB = VP_LOAD(1);
        VT_PUT(0, vA); vA = vB;
        asm volatile("s_waitcnt lgkmcnt(0)" ::: "memory"); __builtin_amdgcn_s_barrier(); asm volatile("" ::: "memory");
#pragma unroll 1
        for (int c = 0; c < 32; c += 2) { REC_BODY(FA, FB, c, vA, vB); REC_BODY(FB, FA, c + 1, vB, vA); }
        asm volatile("s_waitcnt lgkmcnt(0)" ::: "memory"); __builtin_amdgcn_s_barrier(); asm volatile("" ::: "memory");
    }
    if (BGQ && RP == 0) {
        for (int bgn = bgit * 32 * C.NGW + C.gw; bgi < BGQ_ROWS; bgn += C.NGW) { bgq_step<JOB>(C, bgi, bgn, bgv); bgi = bgn; }
    }
#undef REC_LOAD
#undef REC_BODY
#undef VP_LOAD
#undef VT_PUT
}

template <int DV>
__device__ __forceinline__ void rec_norm_gate(const Ctx& C, const float* gain, const bf16* gate) {
    const bf16* OF = (const bf16*)(C.ws + WS_OF); bf16* OB = (bf16*)(C.ws + WS_OB);
    f32x4 g[4];
#pragma unroll
    for (int j = 0; j < 4; ++j) g[j] = *((const GAS f32x4*)gain + C.lane + 64 * j);
    for (int tok0 = C.gw; tok0 < NTOK; tok0 += 4 * C.NGW) {
        unsigned long long vw[4][4], tw[4][4];
#pragma unroll
        for (int u = 0; u < 4; ++u) { const int tok = tok0 + u * C.NGW; if (tok < NTOK) {
            const GAS unsigned long long* xr = (const GAS unsigned long long*)(OF + (size_t)tok * 1024) + C.lane;
            const GAS unsigned long long* tr = (const GAS unsigned long long*)(gate + (size_t)tok * 1024) + C.lane;
#pragma unroll
            for (int j = 0; j < 4; ++j) { vw[u][j] = xr[64 * j]; tw[u][j] = tr[64 * j]; } } }
        __builtin_amdgcn_sched_barrier(0);
#pragma unroll
        for (int u = 0; u < 4; ++u) { const int tok = tok0 + u * C.NGW; if (tok < NTOK) {
            GAS unsigned long long* o8 = (GAS unsigned long long*)(OB + (size_t)tok * 1024) + C.lane;
#pragma unroll
            for (int j = 0; j < 4; ++j) {
                const f32x4 v = (f32x4){bflo((unsigned)vw[u][j]), bfhi((unsigned)vw[u][j]), bflo((unsigned)(vw[u][j] >> 32)), bfhi((unsigned)(vw[u][j] >> 32))}; float ss = (v.x * v.x + v.y * v.y) + (v.z * v.z + v.w * v.w);
                if (DV == 256) ss = wave_sum(ss); else { DPP_SUM31(ss); const float s_lo = rdlane(ss, 31), s_hi = rdlane(ss, 63); ss = C.lane < 32 ? s_lo : s_hi; }
                const float r = rsqrtf(ss * (1.f / DV) + RMS_EPS);
                const unsigned long long t8 = tw[u][j];
                const float t0 = bflo((unsigned)t8), t1 = bfhi((unsigned)t8), t2 = bflo((unsigned)(t8 >> 32)), t3 = bfhi((unsigned)(t8 >> 32));
                const float a0 = v.x * r * g[j].x * (t0 * sigmoid_f(t0)), a1 = v.y * r * g[j].y * (t1 * sigmoid_f(t1)), a2 = v.z * r * g[j].z * (t2 * sigmoid_f(t2)), a3 = v.w * r * g[j].w * (t3 * sigmoid_f(t3));
                o8[64 * j] = (unsigned long long)pk2h(a0, a1) | ((unsigned long long)pk2h(a2, a3) << 32);
            } } }
    }
}

#define CE_D(a, b) do { const unsigned mx_ = (a) > (b) ? (a) : (b); const unsigned mn_ = (a) > (b) ? (b) : (a); (a) = mx_; (b) = mn_; } while (0)
__device__ __forceinline__ void sort16_desc(unsigned (&a)[16]) {
#define S16(i, j) CE_D(a[i], a[j])
    S16(0,13); S16(1,12); S16(2,15); S16(3,14); S16(4,8); S16(5,6); S16(7,11); S16(9,10);
    S16(0,5); S16(1,7); S16(2,9); S16(3,4); S16(6,13); S16(8,14); S16(10,15); S16(11,12);
    S16(0,1); S16(2,3); S16(4,5); S16(6,8); S16(7,9); S16(10,11); S16(12,13); S16(14,15);
    S16(0,2); S16(1,3); S16(4,10); S16(5,11); S16(6,7); S16(8,9); S16(12,14); S16(13,15);
    S16(1,2); S16(3,12); S16(4,6); S16(5,7); S16(8,10); S16(9,11); S16(13,14);
    S16(1,4); S16(2,6); S16(5,8); S16(7,10); S16(9,13); S16(11,14);
    S16(2,4); S16(3,6); S16(9,12); S16(11,13);
    S16(3,5); S16(6,8); S16(7,9); S16(10,12);
    S16(3,4); S16(5,6); S16(7,8); S16(9,10); S16(11,12);
    S16(6,7); S16(8,9);
#undef S16
}
__device__ __forceinline__ void merge_top16(unsigned (&a)[16], const unsigned (&b)[16]) {
#pragma unroll
    for (int i = 0; i < 16; ++i) a[i] = a[i] > b[15 - i] ? a[i] : b[15 - i];
#pragma unroll
    for (int j = 8; j > 0; j >>= 1)
#pragma unroll
        for (int i = 0; i < 16; ++i) { const int l = i ^ j; if (l > i) CE_D(a[i], a[l]); }
}
__device__ __forceinline__ void merge_quad(unsigned (&a)[16], int lane) {
    unsigned p[16];
#pragma unroll
    for (int i = 0; i < 16; ++i) p[i] = (unsigned)__builtin_amdgcn_ds_bpermute((lane ^ 16) << 2, (int)a[i]);
    merge_top16(a, p);
#pragma unroll
    for (int i = 0; i < 16; ++i) p[i] = (unsigned)__builtin_amdgcn_ds_bpermute((lane ^ 32) << 2, (int)a[i]);
    merge_top16(a, p);
}
__device__ __forceinline__ unsigned mono_key(float f) { const unsigned u = __float_as_uint(f); return (u & 0x80000000u) ? ~u : (u | 0x80000000u); }
__device__ __forceinline__ float mono_inv(unsigned k) { return __uint_as_float((k & 0x80000000u) ? (k ^ 0x80000000u) : ~k); }
__constant__ __attribute__((aligned(16))) unsigned char PEER_CAND[64] = {0, 1, 2, 3, 4, 5, 6, 7, 8, 9, 10, 11, 12, 13, 14, 15, 16, 17, 18, 19, 20, 21, 22, 23, 32, 33, 34, 35, 36, 64, 65, 66, 48, 49, 50, 51, 80, 81, 96, 97, 112, 113, 128, 144, 160, 176, 192, 208, 224, 240, 255, 255, 255, 255, 255, 255, 255, 255, 255, 255, 255, 255, 255, 255};
typedef _Float16 h8 __attribute__((ext_vector_type(8)));
__device__ __forceinline__ void peer_topk_load(const Ctx& C, int tok0, int head, h8 (&hv)[2][4]) {
    int l = C.lane; asm volatile("" : "+v"(l));
    const _Float16* SC = (const _Float16*)(C.ws + WS_Q2);
#pragma unroll
    for (int p = 0; p < 2; ++p) { const _Float16* sp = SC + (size_t)(tok0 + (l & 15)) * 2048 + head * 256 + p * 128 + 32 * (l >> 4);
#pragma unroll
        for (int q = 0; q < 4; ++q) hv[p][q] = *(const GAS h8*)(sp + 8 * q); }
}
__device__ __forceinline__ void peer_topk_task(const Ctx& C, int layer, int tok0, int head, int trow0, LAS int* lexp, LAS float* lgate, const h8 (&hvin)[2][4]) {
    LAS unsigned* L0 = (LAS unsigned*)(C.lds + C.wave * 2048);
    LAS unsigned* L1 = L0 + 256;
    {
        int l = C.lane; asm volatile("" : "+v"(l));
        const int m = l & 15, g = l >> 4;
        unsigned cand_w[4];
#pragma unroll
        for (int c = 0; c < 4; ++c) cand_w[c] = ((const unsigned*)PEER_CAND)[g * 4 + c];
        unsigned top[2][16];
#pragma unroll
        for (int p = 0; p < 2; ++p) {
            h8 hv[4];
#pragma unroll
            for (int q = 0; q < 4; ++q) hv[q] = hvin[p][q];
            unsigned hi16[16];
#pragma unroll
            for (int q = 0; q < 4; ++q)
#pragma unroll
                for (int j = 0; j < 8; ++j) { const int i = 8 * q + j; const unsigned key = (mono_key((float)hv[q][j]) & ~0x7fu) | (unsigned)(127 - (32 * g + i));
                    if (i < 16) top[p][i] = key; else hi16[i - 16] = key; }
            sort16_desc(top[p]); sort16_desc(hi16); merge_top16(top[p], hi16);
            merge_quad(top[p], l);
        }
        if (g == 0) {
#pragma unroll
            for (int i = 0; i < 16; i += 4) { *(LAS u32x4v*)(L0 + m * 16 + i) = (u32x4v){top[0][i], top[0][i + 1], top[0][i + 2], top[0][i + 3]}; *(LAS u32x4v*)(L1 + m * 16 + i) = (u32x4v){top[1][i], top[1][i + 1], top[1][i + 2], top[1][i + 3]}; }
        }
        asm volatile("s_waitcnt lgkmcnt(0)" ::: "memory"); __builtin_amdgcn_wave_barrier();
        unsigned cd[16];
#pragma unroll
        for (int c = 0; c < 16; ++c) {
            const unsigned code = (cand_w[c >> 2] >> (8 * (c & 3))) & 0xffu, ci = (code >> 4) & 15u, cj = code & 15u;
            const float v = mono_inv(L0[m * 16 + ci]) + mono_inv(L1[m * 16 + cj]);
            cd[c] = code == 255u ? 0u : ((mono_key(v) & ~0xffu) | (255u - code));
        }
        sort16_desc(cd); merge_quad(cd, l);
        if (g == 0) {
            float best[16]; int ex[16]; float sum = 0.f;
#pragma unroll
            for (int r = 0; r < 16; ++r) { const unsigned pos = 255u - (cd[r] & 0xffu), pi = pos >> 4, pj = pos & 15u;
                ex[r] = (int)((127u - (L0[m * 16 + pi] & 0x7fu)) * 128u + (127u - (L1[m * 16 + pj] & 0x7fu))); best[r] = mono_inv(cd[r]); }
            const float bmax = best[0];
#pragma unroll
            for (int r = 0; r < 16; ++r) { best[r] = __expf(best[r] - bmax); sum += best[r]; }
            const float inv = 1.f / sum;
            const int ob = (trow0 + m) * 128 + head * 16;
#pragma unroll
            for (int r = 0; r < 16; r += 4) { *(LAS u32x4v*)(lexp + ob + r) = (u32x4v){(unsigned)ex[r], (unsigned)ex[r + 1], (unsigned)ex[r + 2], (unsigned)ex[r + 3]};
                *(LAS f32x4*)(lgate + ob + r) = (f32x4){best[r] * inv, best[r + 1] * inv, best[r + 2] * inv, best[r + 3] * inv}; }
        }
        asm volatile("s_waitcnt lgkmcnt(0)" ::: "memory"); __builtin_amdgcn_wave_barrier();
    }
}
__constant__ __attribute__((aligned(16))) unsigned char PEER_CAND2[64] = {0, 1, 2, 3, 4, 5, 6, 7, 8, 9, 10, 11, 12, 13, 14, 15, 16, 17, 18, 19, 20, 21, 22, 23, 32, 255, 255, 255, 255, 255, 255, 255, 33, 34, 35, 36, 64, 65, 66, 48, 49, 50, 51, 80, 81, 96, 97, 112, 113, 128, 144, 160, 176, 192, 208, 224, 240, 255, 255, 255, 255, 255, 255, 255};
__device__ __forceinline__ float mono_inv16(unsigned key) { const unsigned k = key >> 16; const unsigned short hb = (unsigned short)((k & 0x8000u) ? (k ^ 0x8000u) : ~k); return (float)__builtin_bit_cast(_Float16, hb); }
__device__ __forceinline__ void peer_topk_load2(const Ctx& C, int tok0, int head, int p, h8 (&hv)[8]) {
    int l = C.lane; asm volatile("" : "+v"(l));
    const _Float16* sp = (const _Float16*)(C.ws + WS_Q2) + (size_t)(tok0 + (l & 31)) * 2048 + head * 256 + p * 128 + 64 * (l >> 5);
#pragma unroll
    for (int q = 0; q < 8; ++q) hv[q] = *(const GAS h8*)(sp + 8 * q);
}
__device__ __forceinline__ void peer_topk_half2(int l, const h8 (&hv)[8], unsigned (&top)[16]) {
    const int g = l >> 5;
    typedef short s16x2_t __attribute__((ext_vector_type(2)));
#pragma unroll
    for (int grp = 0; grp < 4; ++grp) {
        unsigned t[16];
#pragma unroll
        for (int j = 0; j < 16; j += 2) {
            const u32x4v wv = __builtin_bit_cast(u32x4v, hv[2 * grp + (j >> 3)]); const unsigned w = wv[(j & 7) >> 1];
            const s16x2_t sg = __builtin_bit_cast(s16x2_t, w) >> (s16x2_t){15, 15};
            const unsigned k = w ^ (__builtin_bit_cast(unsigned, sg) | 0x80008000u);
            const unsigned k0 = (k << 16) | (unsigned)(127 - (64 * g + 16 * grp + j)), k1 = (k & 0xffff0000u) | (unsigned)(127 - (64 * g + 16 * grp + j + 1));
            if (grp == 0) { top[j] = k0; top[j + 1] = k1; } else { t[j] = k0; t[j + 1] = k1; }
        }
        if (grp == 0) sort16_desc(top); else { sort16_desc(t); merge_top16(top, t); }
    }
    unsigned pz[16];
#pragma unroll
    for (int i = 0; i < 16; ++i) pz[i] = (unsigned)__builtin_amdgcn_ds_bpermute((l ^ 32) << 2, (int)top[i]);
    merge_top16(top, pz);
}
__device__ __forceinline__ void ctx_grid_bar(const Ctx& C) {
    XcdBarrier b; b.bar = (unsigned*)(C.ws + WS_CTL) + CW_BAR; b.x = xb_xcc_id(); b.st = (volatile LAS unsigned*)(C.lds + MISC_OFF) + 8;
    int l = C.lane; asm volatile("" : "+v"(l));
    xcd_barrier<false, SYNC_LOCAL>(b, C.wave == 0 && l == 0);
}
__device__ __forceinline__ void peer_topk_wave2(const Ctx& C, int tb, LAS int* lexp, LAS float* lgate, LAS unsigned* Lw) {
    const int tg = C.wave & 1, hd0 = (C.wave >> 1) * 2, tok0 = tb * 64 + tg * 32, trow0 = tg * 32;
    LAS unsigned* L0 = Lw; LAS unsigned* L1 = Lw + 512;
    h8 hA[8], hB[8];
    peer_topk_load2(C, tok0, hd0, 0, hA);
#pragma unroll 1
    for (int q = 0; q < 2; ++q) {
        const int head = hd0 + q;
        int l = C.lane; asm volatile("" : "+v"(l));
        const int m = l & 31, g = l >> 5;
        unsigned top0[16], top1[16];
        peer_topk_load2(C, tok0, head, 1, hB);
        peer_topk_half2(l, hA, top0);
        if (q + 1 < 2) peer_topk_load2(C, tok0, head + 1, 0, hA);
        peer_topk_half2(l, hB, top1);
        if (g == 0) {
#pragma unroll
            for (int i = 0; i < 16; i += 4) { *(LAS u32x4v*)(L0 + m * 16 + i) = (u32x4v){top0[i], top0[i + 1], top0[i + 2], top0[i + 3]}; *(LAS u32x4v*)(L1 + m * 16 + i) = (u32x4v){top1[i], top1[i + 1], top1[i + 2], top1[i + 3]}; }
        }
        asm volatile("s_waitcnt lgkmcnt(0)" ::: "memory"); __builtin_amdgcn_wave_barrier();
        unsigned cdA[16], cdB[16];
        {
            unsigned cw[8];
#pragma unroll
            for (int c = 0; c < 8; ++c) cw[c] = ((const unsigned*)PEER_CAND2)[g * 8 + c];
#pragma unroll
            for (int c = 0; c < 32; ++c) {
                const unsigned code = (cw[c >> 2] >> (8 * (c & 3))) & 0xffu, ci = (code >> 4) & 15u, cj = code & 15u;
                const float v = mono_inv16(L0[m * 16 + ci]) + mono_inv16(L1[m * 16 + cj]);
                const unsigned key = code == 255u ? 0u : ((mono_key(v) & ~0xffu) | (255u - code));
                if (c < 16) cdA[c] = key; else cdB[c - 16] = key;
            }
        }
        sort16_desc(cdA); sort16_desc(cdB); merge_top16(cdA, cdB);
        {
            unsigned pz[16];
#pragma unroll
            for (int i = 0; i < 16; ++i) pz[i] = (unsigned)__builtin_amdgcn_ds_bpermute((l ^ 32) << 2, (int)cdA[i]);
            merge_top16(cdA, pz);
        }
        if (g == 0) {
            float best[16]; int ex[16]; float sum = 0.f;
#pragma unroll
            for (int r = 0; r < 16; ++r) { const unsigned pos = 255u - (cdA[r] & 0xffu), pi = pos >> 4, pj = pos & 15u;
                ex[r] = (int)((127u - (L0[m * 16 + pi] & 0x7fu)) * 128u + (127u - (L1[m * 16 + pj] & 0x7fu))); best[r] = mono_inv(cdA[r]); }
            const float bmax = best[0];
#pragma unroll
            for (int r = 0; r < 16; ++r) { best[r] = __expf(best[r] - bmax); sum += best[r]; }
            const float inv = 1.f / sum;
            const int ob = (trow0 + m) * 128 + head * 16;
#pragma unroll
            for (int r = 0; r < 16; r += 4) { *(LAS u32x4v*)(lexp + ob + r) = (u32x4v){(unsigned)ex[r], (unsigned)ex[r + 1], (unsigned)ex[r + 2], (unsigned)ex[r + 3]};
                *(LAS f32x4*)(lgate + ob + r) = (f32x4){best[r] * inv, best[r + 1] * inv, best[r + 2] * inv, best[r + 3] * inv}; }
        }
        asm volatile("s_waitcnt lgkmcnt(0)" ::: "memory"); __builtin_amdgcn_wave_barrier();
    }
}
typedef float f32x2v __attribute__((ext_vector_type(2)));
#define GRP8_SUM(v) do { v = DPP_ADD(v, 0xB1, 0xf, 0xf); v = DPP_ADD(v, 0x4E, 0xf, 0xf); v = DPP_ADD(v, 0x141, 0xf, 0xf); } while (0)
#ifndef MK_HOT
#define MK_HOT 0
#endif
__device__ __forceinline__ void wave_lds_sync() { asm volatile("s_waitcnt lgkmcnt(0)" ::: "memory"); __builtin_amdgcn_wave_barrier(); }
template <bool DRY>
__device__ __forceinline__ void peer_rounds(const Ctx& C, int layer, int tokw, LAS int* lexp_w, const LAS float* lgate_w, LAS unsigned* sorted_w, LAS unsigned* hist_w) {
    const unsigned char* U = C.ws + WS_U + (size_t)layer * 16384 * 1024; const unsigned char* V = C.ws + WS_V + (size_t)layer * 16384 * 1024;
    const LAS unsigned char* SU = (const LAS unsigned char*)(C.lds + 114688); const LAS unsigned char* SV = SU + 16384;
    const float* gf = C.in[2] + layer * 1024; const float* gn = C.in[1] + (layer + 1) * 1024;
    int l = C.lane; asm volatile("" : "+v"(l));
    LAS float* hbuf = (LAS float*)lexp_w;
    {
        const int t = l >> 3, s = l & 7;
#pragma unroll
        for (int k = 0; k < 8; ++k) hist_w[l + 64 * k] = 0u;
        wave_lds_sync();
        unsigned ev[16], pos[16];
#pragma unroll
        for (int k = 0; k < 16; ++k) { ev[k] = (unsigned)lexp_w[t * 128 + s + 8 * k]; pos[k] = __hip_atomic_fetch_add(hist_w + t * 64 + (ev[k] >> 8), 1u, __ATOMIC_RELAXED, __HIP_MEMORY_SCOPE_WORKGROUP); }
        wave_lds_sync();
        unsigned cnt[8], run = 0u;
#pragma unroll
        for (int j = 0; j < 8; ++j) { cnt[j] = hist_w[t * 64 + 8 * s + j]; run += cnt[j]; }
        unsigned inc = run;
#pragma unroll
        for (int o = 1; o < 8; o <<= 1) { const unsigned up = (unsigned)__builtin_amdgcn_ds_bpermute((l - o) << 2, (int)inc); if (s >= o) inc += up; }
        unsigned off = inc - run;
        wave_lds_sync();
#pragma unroll
        for (int j = 0; j < 8; ++j) { hist_w[t * 64 + 8 * s + j] = off; off += cnt[j]; }
        wave_lds_sync();
#pragma unroll
        for (int k = 0; k < 16; ++k) sorted_w[t * 128 + hist_w[t * 64 + (ev[k] >> 8)] + pos[k]] = (ev[k] << 7) | (unsigned)(s + 8 * k);
        wave_lds_sync();
    }
    asm volatile("" : "+v"(l));
    unsigned xh[8][4], xl[8][4]; float xs1, xs2;
    {
        unsigned xp[8][8];
        const int t = l >> 3, s = l & 7;
        const bf16* hrow = (const bf16*)(C.ws + WS_HB) + (size_t)(tokw + t) * 1024 + 16 * s;
        float ss = 0.f;
#pragma unroll
        for (int i = 0; i < 8; ++i) { const v4u a = *(const GAS v4u*)(hrow + 128 * i), b = *(const GAS v4u*)(hrow + 128 * i + 8);
            xp[i][0] = a.x; xp[i][1] = a.y; xp[i][2] = a.z; xp[i][3] = a.w; xp[i][4] = b.x; xp[i][5] = b.y; xp[i][6] = b.z; xp[i][7] = b.w;
#pragma unroll
            for (int j = 0; j < 8; ++j) { const float lo = bflo(xp[i][j]), hi = bfhi(xp[i][j]); ss += lo * lo + hi * hi; } }
        GRP8_SUM(ss);
        const float r = rsqrtf(ss * (1.f / 1024.f) + RMS_EPS);
#pragma unroll
        for (int i = 0; i < 8; ++i)
#pragma unroll
            for (int q = 0; q < 4; ++q) { const f32x4 a = *(const GAS f32x4*)(gf + 16 * s + 128 * i + 4 * q);
                xp[i][2 * q] = pk2(bflo(xp[i][2 * q]) * r * a.x, bfhi(xp[i][2 * q]) * r * a.y); xp[i][2 * q + 1] = pk2(bflo(xp[i][2 * q + 1]) * r * a.z, bfhi(xp[i][2 * q + 1]) * r * a.w); }
        float am = 0.f;
#pragma unroll
        for (int i = 0; i < 8; ++i)
#pragma unroll
            for (int j = 0; j < 8; ++j) am = fmaxf(am, fmaxf(fabsf(bflo(xp[i][j])), fabsf(bfhi(xp[i][j]))));
        am = DPP_MAX(am, 0xB1, 0xf, 0xf); am = DPP_MAX(am, 0x4E, 0xf, 0xf); am = DPP_MAX(am, 0x141, 0xf, 0xf);
        const float inv1 = am > 0.f ? 127.f / am : 0.f, inv2 = 254.f * inv1; xs1 = am * (1.f / 127.f); xs2 = xs1 * (1.f / 254.f);
#pragma unroll
        for (int i = 0; i < 8; ++i)
#pragma unroll
            for (int q = 0; q < 4; ++q) { const float x0 = bflo(xp[i][2 * q]), x1 = bfhi(xp[i][2 * q]), x2 = bflo(xp[i][2 * q + 1]), x3 = bfhi(xp[i][2 * q + 1]);
                const float q0 = __builtin_rintf(x0 * inv1), q1 = __builtin_rintf(x1 * inv1), q2 = __builtin_rintf(x2 * inv1), q3 = __builtin_rintf(x3 * inv1);
                xh[i][q] = q8x4(q0, q1, q2, q3); xl[i][q] = q8x4((x0 - q0 * xs1) * inv2, (x1 - q1 * xs1) * inv2, (x2 - q2 * xs1) * inv2, (x3 - q3 * xs1) * inv2); }
    }
    asm volatile("" : "+v"(l));
#define RND_LOAD(T, buf, item) do { const unsigned char* p_ = T + (size_t)((DRY && MK_HOT) ? (((item) >> 7) & 255u) : ((item) >> 7)) * 1024 + 16 * (l & 7); \
        _Pragma("unroll") for (int i = 0; i < 8; ++i) buf[i] = *(const GAS v4u*)(p_ + 128 * i); } while (0)
    {
        const int t = l >> 3, s = l & 7;
        const LAS unsigned* srt = sorted_w + t * 128;
        v4u bA[8], bB[8];
#define RND_DOT(buf, r_) do { int dh = 0, dl = 0; \
            _Pragma("unroll") for (int i = 0; i < 8; ++i) { _Pragma("unroll") for (int q = 0; q < 4; ++q) { \
                dh = __builtin_amdgcn_sdot4((int)buf[i][q], (int)xh[i][q], dh, false); dl = __builtin_amdgcn_sdot4((int)buf[i][q], (int)xl[i][q], dl, false); } } \
            float d = (float)dh * xs1 + (float)dl * xs2; \
            GRP8_SUM(d); if (s == 0) hbuf[t * 128 + (r_)] = d; } while (0)
        RND_LOAD(U, bA, srt[0]);
#pragma unroll 1
        for (int r = 0; r < 128; r += 2) {
            if (!DRY && (r & 15) == 0 && ((SYNC_U >> (r >> 4)) & 1) && C.G == NTOK / 64) ctx_grid_bar(C);
            RND_LOAD(U, bB, srt[r + 1]);
            RND_DOT(bA, r);
            RND_LOAD(U, bA, srt[(r + 2) & 127]);
            RND_DOT(bB, r + 1);
        }
#undef RND_DOT
    }
    wave_lds_sync();
    asm volatile("" : "+v"(l));
    if (!DRY && UVSYNC && C.G == NTOK / 64) ctx_grid_bar(C);
    {
        const int t = l >> 3, s = l & 7;
#pragma unroll
        for (int k = 0; k < 16; k += 2) {
            const int r0 = t * 128 + s + 8 * k, r1 = r0 + 8;
            const unsigned i0 = sorted_w[r0], i1 = sorted_w[r1];
            const float h0 = hbuf[r0] * __uint_as_float((unsigned)SU[i0 >> 7] << 23), h1 = hbuf[r1] * __uint_as_float((unsigned)SU[i1 >> 7] << 23);
            const pg8::f32x2 gl = pg8::gelu_pk((pg8::f32x2){h0, h1});
            hbuf[r0] = gl.x * lgate_w[t * 128 + (i0 & 127u)] * __uint_as_float((unsigned)SV[i0 >> 7] << 23); hbuf[r1] = gl.y * lgate_w[t * 128 + (i1 & 127u)] * __uint_as_float((unsigned)SV[i1 >> 7] << 23);
        }
    }
    wave_lds_sync();
    asm volatile("" : "+v"(l));
    f32x2v y2[8][8];
#pragma unroll
    for (int i = 0; i < 8; ++i)
#pragma unroll
        for (int j = 0; j < 8; ++j) y2[i][j] = (f32x2v){0.f, 0.f};
    {
        const int t = l >> 3;
        const LAS unsigned* srt = sorted_w + t * 128; const LAS float* wv = hbuf + t * 128;
        v4u bA[8], bB[8];
#define RND_AXPY(buf, r_) do { const float w = wv[(r_)]; const f32x2v w2 = (f32x2v){w, w}; \
            _Pragma("unroll") for (int i = 0; i < 8; ++i) { asm volatile("" : "+v"(buf[i])); _Pragma("unroll") for (int q = 0; q < 4; ++q) { \
                const f32x2v lo_ = __builtin_amdgcn_cvt_pk_f32_fp8((int)buf[i][q], false), hi_ = __builtin_amdgcn_cvt_pk_f32_fp8((int)buf[i][q], true); \
                y2[i][2 * q] = w2 * lo_ + y2[i][2 * q]; y2[i][2 * q + 1] = w2 * hi_ + y2[i][2 * q + 1]; } } } while (0)
        RND_LOAD(V, bA, srt[0]);
#pragma unroll 1
        for (int r = 0; r < 128; r += 2) {
            if (!DRY && (r & 15) == 0 && ((SYNC_V >> (r >> 4)) & 1) && C.G == NTOK / 64) ctx_grid_bar(C);
            RND_LOAD(V, bB, srt[r + 1]);
            RND_AXPY(bA, r);
            RND_LOAD(V, bA, srt[(r + 2) & 127]);
            RND_AXPY(bB, r + 1);
        }
#undef RND_AXPY
    }
#undef RND_LOAD
    asm volatile("" : "+v"(l));
    {
        const int t = l >> 3, s = l & 7;
        const bf16* hrow = (const bf16*)(C.ws + WS_HB) + (size_t)(tokw + t) * 1024 + 16 * s;
        float* hout = (DRY ? (float*)(C.ws + WS_OF) : C.out) + (size_t)(tokw + t) * 1024 + 16 * s;
        bf16* hb = (bf16*)(C.ws + (DRY ? WS_OF : WS_HB)) + (size_t)(tokw + t) * 1024 + 16 * s;
        float s2 = 0.f;
        v4u hpa[4], hpb[4];
#pragma unroll
        for (int i = 0; i < 8; ++i) {
            if ((i & 3) == 0) {
#pragma unroll
                for (int k = 0; k < 4; ++k) { hpa[k] = *(const GAS v4u*)(hrow + 128 * (i + k)); hpb[k] = *(const GAS v4u*)(hrow + 128 * (i + k) + 8); } }
            const v4u a = hpa[i & 3], b = hpb[i & 3];
            const unsigned hw[8] = {a.x, a.y, a.z, a.w, b.x, b.y, b.z, b.w};
#pragma unroll
            for (int j = 0; j < 8; ++j) { y2[i][j].x += bflo(hw[j]); y2[i][j].y += bfhi(hw[j]); s2 += y2[i][j].x * y2[i][j].x + y2[i][j].y * y2[i][j].y; }
            if (layer == DEPTH - 1) {
#pragma unroll
                for (int q = 0; q < 4; ++q) *(GAS f32x4*)(hout + 128 * i + 4 * q) = (f32x4){y2[i][2 * q].x, y2[i][2 * q].y, y2[i][2 * q + 1].x, y2[i][2 * q + 1].y};
            } else {
                *(GAS v4u*)(hb + 128 * i) = (v4u){pk2(y2[i][0].x, y2[i][0].y), pk2(y2[i][1].x, y2[i][1].y), pk2(y2[i][2].x, y2[i][2].y), pk2(y2[i][3].x, y2[i][3].y)};
                *(GAS v4u*)(hb + 128 * i + 8) = (v4u){pk2(y2[i][4].x, y2[i][4].y), pk2(y2[i][5].x, y2[i][5].y), pk2(y2[i][6].x, y2[i][6].y), pk2(y2[i][7].x, y2[i][7].y)};
            } }
        if (layer < DEPTH - 1) {
            GRP8_SUM(s2);
            const float r2 = rsqrtf(s2 * (1.f / 1024.f) + RMS_EPS);
            const bool wx8 = ((I8MASK >> (layer + 1)) & 1) != 0, wxn = ((layer + 1) % 3 != 2) || !wx8;
            bf16* xo = (bf16*)(C.ws + (DRY ? WS_GLOG : WS_XN)) + (size_t)(tokw + t) * 1024 + 16 * s; float am = 0.f;
#pragma unroll
            for (int i = 0; i < 8; ++i) { unsigned pw[8];
#pragma unroll
                for (int q = 0; q < 4; ++q) { const f32x4 a = *(const GAS f32x4*)(gn + 16 * s + 128 * i + 4 * q);
                    y2[i][2 * q].x *= r2 * a.x; y2[i][2 * q].y *= r2 * a.y; y2[i][2 * q + 1].x *= r2 * a.z; y2[i][2 * q + 1].y *= r2 * a.w;
                    am = fmaxf(fmaxf(am, fmaxf(fabsf(y2[i][2 * q].x), fabsf(y2[i][2 * q].y))), fmaxf(fabsf(y2[i][2 * q + 1].x), fabsf(y2[i][2 * q + 1].y)));
                    pw[2 * q] = pk2(y2[i][2 * q].x, y2[i][2 * q].y); pw[2 * q + 1] = pk2(y2[i][2 * q + 1].x, y2[i][2 * q + 1].y); }
                if (wxn) { *(GAS v4u*)(xo + 128 * i) = (v4u){pw[0], pw[1], pw[2], pw[3]}; *(GAS v4u*)(xo + 128 * i + 8) = (v4u){pw[4], pw[5], pw[6], pw[7]}; } }
            if (wx8) {
            am = DPP_MAX(am, 0xB1, 0xf, 0xf); am = DPP_MAX(am, 0x4E, 0xf, 0xf); am = DPP_MAX(am, 0x141, 0xf, 0xf);
            const float qi = am > 0.f ? 127.f / am : 0.f;
            signed char* xq = (signed char*)(C.ws + (DRY ? WS_GLOG + 32 * MiB : WS_XN8)) + (size_t)(tokw + t) * 1024 + 16 * s;
#pragma unroll
            for (int i = 0; i < 8; ++i) { unsigned pq[4];
#pragma unroll
                for (int q = 0; q < 4; ++q) pq[q] = q8x4(y2[i][2 * q].x * qi, y2[i][2 * q].y * qi, y2[i][2 * q + 1].x * qi, y2[i][2 * q + 1].y * qi);
                *(GAS v4u*)(xq + 128 * i) = (v4u){pq[0], pq[1], pq[2], pq[3]}; }
            if (s == 0) *(GAS float*)((float*)(C.ws + (DRY ? WS_GLOG + 48 * MiB : WS_SX)) + tokw + t) = am * (1.f / 127.f);
            }
        }
    }
}
#ifndef MK_SWEEP
#define MK_SWEEP 2
#endif
template <bool DRY>
__device__ __forceinline__ void peer_topk_gather(const Ctx& C, int layer) {
    LAS int* lexp = (LAS int*)(C.lds + 16384);
    LAS float* lgate = (LAS float*)(C.lds + 16384 + 32768);
    LAS unsigned* sorted = (LAS unsigned*)(C.lds + 16384 + 65536);
    {
        int tid = C.tid; asm volatile("" : "+v"(tid));
        const v4u a0 = *(const GAS v4u*)(C.ws + WS_SU + (size_t)layer * 16384 + tid * 32), a1 = *(const GAS v4u*)(C.ws + WS_SU + (size_t)layer * 16384 + tid * 32 + 16);
        const v4u b0 = *(const GAS v4u*)(C.ws + WS_SV + (size_t)layer * 16384 + tid * 32), b1 = *(const GAS v4u*)(C.ws + WS_SV + (size_t)layer * 16384 + tid * 32 + 16);
        LAS unsigned char* lsc = C.lds + 114688;
        *(LAS v4u*)(lsc + tid * 32) = a0; *(LAS v4u*)(lsc + tid * 32 + 16) = a1; *(LAS v4u*)(lsc + 16384 + tid * 32) = b0; *(LAS v4u*)(lsc + 16384 + tid * 32 + 16) = b1;
    }
    for (int tb = C.vcu; tb < NTOK / 64; tb += C.G) {
        peer_topk_wave2(C, tb, lexp, lgate, sorted + C.wave * 1024);
        __syncthreads();
#if MK_SWEEP == 2
        peer_rounds<DRY>(C, layer, tb * 64 + C.wave * 8, lexp + C.wave * 1024, lgate + C.wave * 1024, sorted + C.wave * 1024, (LAS unsigned*)(C.lds + C.wave * 2048));
#elif MK_SWEEP == 1
#error removed variant
        peer_sweep<DRY>(C, layer, tb * 64 + C.wave * 8, lexp + C.wave * 1024, lgate + C.wave * 1024, sorted + C.wave * 1024, (LAS unsigned*)(C.lds + C.wave * 1024));
#else
#pragma unroll 1
        for (int t = 0; t < 8; ++t) peer_gather_token<DRY>(C, layer, tb * 64 + C.wave * 8 + t, lexp + (C.wave * 8 + t) * 128, lgate + (C.wave * 8 + t) * 128);
#endif
        __syncthreads();
    }
}

#ifndef MK_SINGLE
#define MK_SINGLE 1
#endif
#ifndef MK_FASTGEMM
#define MK_FASTGEMM 1
#endif
constexpr int STEPS = 10, NPHASE = 1 + DEPTH * STEPS;
struct Args { const float* in[21]; float* out; unsigned char* ws; int ph_lo, ph_hi; };

template <int EPI>
__device__ __forceinline__ void do_gemm(const Ctx& C, const bf16* A, const bf16* Bt, int N, bf16* Ob, int ldc, int split, const float* rs_in, const float* base, float* outf, bf16* hg, const float* gain, float* rs_out) {
    pg8::Gemm g{A, Bt, NTOK, N, 1024}; pg8::StaticOrder S; S.init(NTOK, N, C.G, C.bx);
    if constexpr (EPI == 0) { pg8::EpiBf16R<false> E{Ob, ldc, split ? 1024 : 0, PSTRIDE, rs_in}; pg8::gemm_phase<pg8::EpiBf16R<false>, pg8::StaticOrder, true, true>(C.lds, g, S, E, C.tid); }
    else if constexpr (EPI == 2) { pg8::EpiBf16R<true> E{Ob, ldc, 0, PSTRIDE, rs_in}; pg8::gemm_phase<pg8::EpiBf16R<true>, pg8::StaticOrder, true, true>(C.lds, g, S, E, C.tid); }
    else if constexpr (EPI == 3) {
        pg8::Gemm g8{A, Bt, NTOK, N, 512}; pg8::EpiI8<false> E{Ob, PSTRIDE, rs_in, gain, nullptr, nullptr, 1.f}; pg8::gemm_phase<pg8::EpiI8<false>, pg8::StaticOrder, true, true>(C.lds, g8, S, E, C.tid); }
    else if constexpr (EPI == 4) {
        pg8::Gemm g8{A, Bt, NTOK, N, 512}; pg8::EpiI8<true> E{Ob, PSTRIDE, rs_in, gain, base, (const float*)outf, FOX_C2}; pg8::gemm_phase<pg8::EpiI8<true>, pg8::StaticOrder, true, true>(C.lds, g8, S, E, C.tid); }
    else {
        bf16* HB = (bf16*)(C.ws + WS_HB); (void)outf;
        if (base) { pg8::EpiResNorm<false> E{base, HB, hg, gain, rs_out}; pg8::gemm_phase<pg8::EpiResNorm<false>, pg8::StaticOrder, true, true>(C.lds, g, S, E, C.tid); }
        else { pg8::EpiResNorm<true> E{HB, HB, hg, gain, rs_out}; pg8::gemm_phase<pg8::EpiResNorm<true>, pg8::StaticOrder, true, true>(C.lds, g, S, E, C.tid); } }
}

template <int STEP, int MIXER>
__device__ __forceinline__ void run_step(const Ctx& C, int layer) {
    const int jx = layer / 3;
    bf16* XN = (bf16*)(C.ws + WS_XN); bf16* P = (bf16*)(C.ws + WS_P); bf16* OB = (bf16*)(C.ws + WS_OB); bf16* Q2 = (bf16*)(C.ws + WS_Q2);
    if constexpr (STEP == 0) {
        const bf16* Wt = MIXER == 0 ? (const bf16*)(C.ws + WS_FOXWIN + (size_t)jx * 8 * MiB) : MIXER == 1 ? (const bf16*)(C.ws + WS_GLAWIN) : (const bf16*)(C.ws + WS_HGRNWIN);
        const float* sw = (const float*)(C.ws + WS_SW) + (MIXER == 0 ? jx * 4096 : MIXER == 1 ? 8192 : 11264);
        if (FOXFUSE && MIXER == 0) { do_gemm<4>(C, (const bf16*)(C.ws + WS_XN8), Wt, 4096, P, 1024, 1, (const float*)(C.ws + WS_SX), C.in[5] + jx * 64, (float*)(C.in[6] + jx * 64), nullptr, sw, nullptr); fox_step1<false>(C, jx); }
        else if ((I8MASK >> layer) & 1) do_gemm<3>(C, (const bf16*)(C.ws + WS_XN8), Wt, MIXER == 1 ? 3072 : 4096, P, 1024, 1, (const float*)(C.ws + WS_SX), nullptr, nullptr, nullptr, sw, nullptr);
        else do_gemm<0>(C, XN, Wt, MIXER == 1 ? 3072 : 4096, P, 1024, 1, nullptr, nullptr, nullptr, nullptr, nullptr, nullptr);
    } else if constexpr (STEP == 1) {
        if constexpr (MIXER == 0) { if (!FOXFUSE) fox_step1<true>(C, jx); }
    } else if constexpr (STEP == 2) {
        if constexpr (MIXER == 1) chunk_prepass<4>(C); else if constexpr (MIXER == 2) chunk_prepass<8>(C);
    } else if constexpr (STEP == 3) {
        if constexpr (MIXER == 0) {
            float gq = 0.f, gk = 0.f;
            for (int i = 0; i < 64; ++i) { gq = fmaxf(gq, fabsf(C.in[5][jx * 64 + i])); gk = fmaxf(gk, fabsf(C.in[6][jx * 64 + i])); }
            const float smax = 64.f * gq * gk * 0.125f * 1.4426950408889634f;
            const attn_body::AttnTensors AT{(const attn_body::bf16*)P, (const attn_body::bf16*)(P + PSTRIDE), (const attn_body::bf16*)(P + 2 * PSTRIDE), (attn_body::bf16*)OB, (const attn_body::bf16*)(P + 3 * PSTRIDE), (const float*)(C.ws + WS_TAIL), -(56.f + 2.f * smax)};
            const attn_body::StaticOrder S(C.G, C.bx);
            attn_body::attn_phase<attn_body::StaticOrder>((char*)C.lds, AT, S, C.tid);
        }
        else if constexpr (MIXER == 1) chunk_recur2<4, 256>(C, P + PSTRIDE);
        else chunk_recur2<8, 128>(C, P + 2 * PSTRIDE);
    } else if constexpr (STEP == 4) {
        if constexpr (MIXER == 1) rec_norm_gate<256>(C, C.in[11], P + 2 * PSTRIDE);
        else if constexpr (MIXER == 2) rec_norm_gate<128>(C, C.in[15], P + 3 * PSTRIDE);
    } else if constexpr (STEP == 5) {
        const bf16* Wt = MIXER == 0 ? (const bf16*)(C.ws + WS_FOXWOUT) + (size_t)jx * 1024 * 1024 : MIXER == 1 ? (const bf16*)(C.ws + WS_GLAWOUT) : (const bf16*)(C.ws + WS_HGRNWOUT);
        do_gemm<1>(C, OB, Wt, 1024, nullptr, 0, 0, nullptr, layer == 0 ? C.in[0] : nullptr, nullptr, XN, C.in[2] + layer * 1024, (float*)(C.ws + WS_RS));
    } else if constexpr (STEP == 6) {
    } else if constexpr (STEP == 7) {
        do_gemm<2>(C, XN, (const bf16*)(C.ws + WS_PEERWQ) + (size_t)layer * 2048 * 1024, 2048, Q2, 2048, 0, (const float*)(C.ws + WS_RS), nullptr, nullptr, nullptr, nullptr, nullptr);
    } else if constexpr (STEP == 8) {
        peer_topk_gather<false>(C, layer);
    } else if constexpr (STEP == 9) {
    } else if constexpr (STEP == 11) {
        peer_topk_gather<true>(C, layer);
    } else if constexpr (STEP == 12) {
        p0_prologue_b(C);
    } else {
        p0_prologue(C);
    }
}

__device__ __forceinline__ void make_ctx(Ctx& C, const Args& args, unsigned char* lds_raw) {
    C.lds = (LAS unsigned char*)lds_raw;
    C.tid = threadIdx.x; C.lane = C.tid & 63; C.wave = __builtin_amdgcn_readfirstlane(C.tid >> 6);
    C.G = gridDim.x; C.bx = blockIdx.x; { const int bx = blockIdx.x; C.vcu = (C.G % 8 == 0) ? (bx % 8) * (C.G / 8) + bx / 8 : bx; }
    C.gw = C.vcu * NWAVES + C.wave; C.NGW = C.G * NWAVES;
#pragma unroll
    for (int i = 0; i < 21; ++i) C.in[i] = args.in[i];
    C.out = args.out; C.ws = args.ws;
}

template <int STEP, int MIXER>
__global__ void __launch_bounds__(NWAVES * 64, 2) mk_phase(Args args, int layer) {
    extern __shared__ __attribute__((aligned(16))) unsigned char lds_raw[];
    Ctx C; make_ctx(C, args, lds_raw);
    run_step<STEP, MIXER>(C, layer);
}

template <int STEP, int MIXER>
static void launch_phase(const Args& a, int layer, int grid, hipStream_t stream) {
    static bool attr_set = false;
    if (!attr_set) { (void)hipFuncSetAttribute((const void*)mk_phase<STEP, MIXER>, hipFuncAttributeMaxDynamicSharedMemorySize, LDS_BYTES); attr_set = true; }
    hipLaunchKernelGGL((mk_phase<STEP, MIXER>), dim3(grid), dim3(NWAVES * 64), LDS_BYTES, stream, a, layer);
}
#ifndef MK_DUP
#define MK_DUP -1
#endif
#define LP(S, M) do { launch_phase<S, M>(a, layer, grid, stream); if (MK_DUP == S) launch_phase<(S == 8 ? 11 : S), M>(a, layer, grid, stream); } while (0)
template <int MIXER>
static void launch_layer(const Args& a, int layer, int grid, hipStream_t stream) {
    LP(0, MIXER);
    if (MIXER == 0) launch_phase<1, MIXER>(a, layer, grid, stream); else LP(2, MIXER);
    LP(3, MIXER);
    if (MIXER != 0) LP(4, MIXER);
    LP(5, MIXER);
    LP(7, 0);
    LP(8, 0);
}
#if MK_SINGLE
__device__ __forceinline__ const float* tab_ptr(volatile LAS unsigned long long* tab, int i) {
    const unsigned long long v = tab[i];
    const unsigned lo = __builtin_amdgcn_readfirstlane((unsigned)v), hi = __builtin_amdgcn_readfirstlane((unsigned)(v >> 32));
    return (const float*)(const GAS float*)(((unsigned long long)hi << 32) | lo);
}
__device__ __forceinline__ int lane_id_volatile() { int x; asm volatile("v_mbcnt_lo_u32_b32 %0, -1, 0\n\tv_mbcnt_hi_u32_b32 %0, -1, %0" : "=v"(x)); return x; }
__device__ __forceinline__ void make_ctx_opaque(Ctx& C, unsigned char* lds_raw, int wave_s) {
    int bx = blockIdx.x, G = gridDim.x; unsigned ldso = 0u;
    asm volatile("" : "+s"(bx), "+s"(G), "+s"(ldso), "+s"(wave_s));
    int tid = wave_s * 64 + lane_id_volatile();
    C.lds = (LAS unsigned char*)lds_raw + ldso;
    volatile LAS unsigned long long* tab = (volatile LAS unsigned long long*)(C.lds + LDSCTL_OFF);
    C.tid = tid; C.lane = tid & 63; C.wave = __builtin_amdgcn_readfirstlane(tid >> 6);
    C.G = G; C.bx = bx; C.vcu = (G % 8 == 0) ? (bx % 8) * (G / 8) + bx / 8 : bx;
    C.gw = C.vcu * NWAVES + C.wave; C.NGW = G * NWAVES;
#pragma unroll
    for (int i = 0; i < 21; ++i) C.in[i] = tab_ptr(tab, i);
    C.out = (float*)tab_ptr(tab, 21); C.ws = (unsigned char*)tab_ptr(tab, 22);
}
__device__ __forceinline__ void grid_bar(unsigned char* lds_raw, int wave_s) {
    unsigned ldso = 0u; asm volatile("" : "+s"(ldso), "+s"(wave_s));
    LAS unsigned char* lds = (LAS unsigned char*)lds_raw + ldso;
    volatile LAS unsigned long long* tab = (volatile LAS unsigned long long*)(lds + LDSCTL_OFF);
    XcdBarrier b; b.bar = (unsigned*)((unsigned char*)tab_ptr(tab, 22) + WS_CTL) + CW_BAR; b.x = xb_xcc_id(); b.st = (volatile LAS unsigned*)(lds + MISC_OFF) + 8;
    xcd_barrier(b, wave_s == 0 && lane_id_volatile() == 0);
}
#define MK_STEP(...) do { Ctx C; make_ctx_opaque(C, lds_raw, wave_s); __VA_ARGS__; } while (0)
__global__ void __launch_bounds__(NWAVES * 64, 2) mk_fwd(Args args) {
    extern __shared__ __attribute__((aligned(16))) unsigned char lds_raw[];
    const int wave_s = __builtin_amdgcn_readfirstlane(threadIdx.x >> 6);
    for (int u = threadIdx.x; u < (LDS_BYTES - LDSCTL_OFF) / 4; u += NWAVES * 64) ((LAS unsigned*)((LAS unsigned char*)lds_raw + LDSCTL_OFF))[u] = 0u;
    __syncthreads();
    if (threadIdx.x == 0) {
        LAS unsigned long long* tab = (LAS unsigned long long*)((LAS unsigned char*)lds_raw + LDSCTL_OFF);
#pragma unroll
        for (int i = 0; i < 21; ++i) tab[i] = (unsigned long long)args.in[i];
        tab[21] = (unsigned long long)args.out; tab[22] = (unsigned long long)args.ws;
    }
    (void)xcd_barrier_post((unsigned*)(args.ws + WS_CTL) + CW_BAR, (volatile LAS unsigned*)((LAS unsigned char*)lds_raw + MISC_OFF) + 8);
    __syncthreads();
    MK_STEP(p0_prologue(C));
    if (I8_NITEMS) { grid_bar(lds_raw, wave_s); MK_STEP(p0_prologue_b(C)); }
    cg::this_grid().sync();
#pragma unroll 1
    for (int layer = 0; layer < DEPTH; ++layer) {
        const int mixer = layer % 3, jx = layer / 3;
        MK_STEP(const bf16* Wt = mixer == 0 ? (const bf16*)(C.ws + WS_FOXWIN + (size_t)jx * 8 * MiB) : mixer == 1 ? (const bf16*)(C.ws + WS_GLAWIN) : (const bf16*)(C.ws + WS_HGRNWIN);
                const float* sw = (const float*)(C.ws + WS_SW) + (mixer == 0 ? jx * 4096 : mixer == 1 ? 8192 : 11264);
                if (FOXFUSE && mixer == 0) { do_gemm<4>(C, (const bf16*)(C.ws + WS_XN8), Wt, 4096, (bf16*)(C.ws + WS_P), 1024, 1, (const float*)(C.ws + WS_SX), C.in[5] + jx * 64, (float*)(C.in[6] + jx * 64), nullptr, sw, nullptr);
                    fox_step1<false>(C, jx); }
                else if (I8MASK == 15 || (I8MASK != 0 && ((I8MASK >> layer) & 1))) do_gemm<3>(C, (const bf16*)(C.ws + WS_XN8), Wt, mixer == 1 ? 3072 : 4096, (bf16*)(C.ws + WS_P), 1024, 1, (const float*)(C.ws + WS_SX), nullptr, nullptr, nullptr, sw, nullptr);
                else do_gemm<0>(C, (const bf16*)(C.ws + WS_XN), Wt, mixer == 1 ? 3072 : 4096, (bf16*)(C.ws + WS_P), 1024, 1, nullptr, nullptr, nullptr, nullptr, nullptr, nullptr));
        grid_bar(lds_raw, wave_s);
#if GPROBE == 1
        MK_STEP(const bf16* Wt = mixer == 0 ? (const bf16*)(C.ws + WS_FOXWIN + (size_t)jx * 8 * MiB) : mixer == 1 ? (const bf16*)(C.ws + WS_GLAWIN) : (const bf16*)(C.ws + WS_HGRNWIN);
                const float* sw = (const float*)(C.ws + WS_SW) + (mixer == 0 ? jx * 4096 : mixer == 1 ? 8192 : 11264);
                if (FOXFUSE && mixer == 0) { do_gemm<4>(C, (const bf16*)(C.ws + WS_XN8), Wt, 4096, (bf16*)(C.ws + WS_P), 1024, 1, (const float*)(C.ws + WS_SX), C.in[5] + jx * 64, (float*)(C.in[6] + jx * 64), nullptr, sw, nullptr);
                    fox_step1<false>(C, jx); }
                else if (I8MASK == 15 || (I8MASK != 0 && ((I8MASK >> layer) & 1))) do_gemm<3>(C, (const bf16*)(C.ws + WS_XN8), Wt, mixer == 1 ? 3072 : 4096, (bf16*)(C.ws + WS_P), 1024, 1, (const float*)(C.ws + WS_SX), nullptr, nullptr, nullptr, sw, nullptr);
                else do_gemm<0>(C, (const bf16*)(C.ws + WS_XN), Wt, mixer == 1 ? 3072 : 4096, (bf16*)(C.ws + WS_P), 1024, 1, nullptr, nullptr, nullptr, nullptr, nullptr, nullptr));
        grid_bar(lds_raw, wave_s);
#endif
        if (!(FOXFUSE && mixer == 0)) {
        MK_STEP(if (mixer == 0) run_step<1, 0>(C, layer); else if (mixer == 1) run_step<2, 1>(C, layer); else run_step<2, 2>(C, layer));
        grid_bar(lds_raw, wave_s); }
        MK_STEP(if (mixer == 0) run_step<3, 0>(C, layer); else if (mixer == 1) run_step<3, 1>(C, layer); else run_step<3, 2>(C, layer));
        grid_bar(lds_raw, wave_s);
#if RPROBE
        if (mixer != 0) { MK_STEP(if (mixer == 1) chunk_recur<4, 256, RPROBE>(C, (const bf16*)(C.ws + WS_P) + PSTRIDE); else chunk_recur<8, 128, RPROBE>(C, (const bf16*)(C.ws + WS_P) + 2 * PSTRIDE)); grid_bar(lds_raw, wave_s); }
#endif
        if (mixer != 0) { MK_STEP(if (mixer == 1) run_step<4, 1>(C, layer); else run_step<4, 2>(C, layer)); grid_bar(lds_raw, wave_s); }
        MK_STEP(const bf16* Wt = mixer == 0 ? (const bf16*)(C.ws + WS_FOXWOUT) + (size_t)jx * 1024 * 1024 : mixer == 1 ? (const bf16*)(C.ws + WS_GLAWOUT) : (const bf16*)(C.ws + WS_HGRNWOUT);
                do_gemm<1>(C, (const bf16*)(C.ws + WS_OB), Wt, 1024, nullptr, 0, 0, nullptr, layer == 0 ? C.in[0] : nullptr, nullptr, (bf16*)(C.ws + WS_XN), C.in[2] + layer * 1024, (float*)(C.ws + WS_RS)));
        grid_bar(lds_raw, wave_s);
        MK_STEP(run_step<7, 0>(C, layer));
        grid_bar(lds_raw, wave_s);
#if GPROBE == 7
        MK_STEP(run_step<7, 0>(C, layer));
        grid_bar(lds_raw, wave_s);
#endif
        MK_STEP(run_step<8, 0>(C, layer));
        if (layer + 1 < DEPTH) grid_bar(lds_raw, wave_s);
    }
}
#endif

extern "C" void kernel_launch(void* const* d_in, const int* in_sizes, int n_in, void* d_out, int out_size, void* d_ws, size_t ws_size, hipStream_t stream) {
    static int grid = 0;
    if (grid == 0) {
        if (n_in != 21 || out_size != NTOK * 1024 || ws_size < WS_END) { fprintf(stderr, "kernel_launch: unexpected shapes: n_in %d out %d ws %zu (need %zu)\n", n_in, out_size, ws_size, (size_t)WS_END); grid = -1; return; }
        int dev = 0, cus = 0, per_cu = 0;
        (void)hipGetDevice(&dev); (void)hipDeviceGetAttribute(&cus, hipDeviceAttributeMultiprocessorCount, dev);
#if MK_SINGLE
        if (hipFuncSetAttribute((const void*)mk_fwd, hipFuncAttributeMaxDynamicSharedMemorySize, LDS_BYTES) != hipSuccess) { fprintf(stderr, "kernel_launch: hipFuncSetAttribute failed\n"); grid = -1; return; }
        if (hipOccupancyMaxActiveBlocksPerMultiprocessor(&per_cu, (const void*)mk_fwd, NWAVES * 64, LDS_BYTES) != hipSuccess || per_cu < 1) { fprintf(stderr, "kernel_launch: occupancy query says %d blocks per CU\n", per_cu); (void)hipGetLastError(); grid = -1; return; }
#endif
        (void)per_cu;
        grid = cus;
    }
    if (grid < 0) return;
    Args a{};
    for (int i = 0; i < 21; ++i) a.in[i] = (const float*)d_in[i];
    a.out = (float*)d_out; a.ws = (unsigned char*)d_ws;
#if MK_SINGLE
    (void)hipMemsetAsync((char*)d_ws + WS_CTL, 0, CTL_ZERO_BYTES, stream);
    a.ph_lo = 0; a.ph_hi = NPHASE;
    void* kargs[] = {&a};
    hipError_t e = hipLaunchCooperativeKernel((const void*)mk_fwd, dim3(grid), dim3(NWAVES * 64), kargs, LDS_BYTES, stream);
    if (e != hipSuccess) fprintf(stderr, "cooperative launch failed: %s (grid %d)\n", hipGetErrorString(e), grid);
#else
    (void)hipMemsetAsync((char*)d_ws + WS_CTL, 0, CTL_ZERO_BYTES, stream);
    launch_phase<10, 0>(a, 0, grid, stream); if (MK_DUP == 10) launch_phase<10, 0>(a, 0, grid, stream);
    launch_phase<12, 0>(a, 0, grid, stream);
    launch_layer<0>(a, 0, grid, stream);
    launch_layer<1>(a, 1, grid, stream);
    launch_layer<2>(a, 2, grid, stream);
    launch_layer<0>(a, 3, grid, stream);
#endif
}
```
